# Optimizing an MI355X kernel written in HIP

```python
import math
import jax, jax.numpy as jnp
from jax import lax
import numpy as np

D_MODEL = 1024
BATCH = 8
SEQ = 8192
DEPTH = 4

HEAD_DIM = 64
A_WIDTH = D_MODEL // 2
A_HEADS = A_WIDTH // HEAD_DIM
B_WIDTH = D_MODEL // 4
B_HEADS = B_WIDTH // HEAD_DIM
C_WIDTH = D_MODEL // 4
MIX_WIDTH = A_WIDTH + B_WIDTH + C_WIDTH
IN_WIDTH = 3 * A_WIDTH + 3 * B_WIDTH + C_WIDTH
DILATED_CONFIGS = ((128, 1), (512, 4), (2048, 16))
GRID_W = 64
NA_ROWS = 8
NA_COLS = 16
NA_QC = 16
NA_KC = NA_QC + NA_COLS
S5_GROUP = 16
S5_GROUPS = C_WIDTH // S5_GROUP
S5_STATE = 64
S5_DT_MIN = 1e-3
S5_DT_MAX = 1e-1
N_EXPERTS = 16
EC_CAPACITY = 2
EXPERT_FF = 2 * D_MODEL
EPS = 1e-6
NEG_INF = -1e30

kernel_name = "hybrid_dilated_natten_s5_ec_encoder"


def rms_norm(x, g):
    xf = x.astype(jnp.float32)
    y = xf * lax.rsqrt(jnp.mean(xf * xf, axis=-1, keepdims=True) + EPS)
    return y.astype(x.dtype) * g


def split_heads(t, n):
    b, s, _ = t.shape
    return t.reshape(b, s, n, HEAD_DIM).transpose(0, 2, 1, 3)


def merge_heads(t):
    b, h, s, d = t.shape
    return t.transpose(0, 2, 1, 3).reshape(b, s, h * d)


def alibi_slopes(n):
    return np.array([2.0 ** (-8.0 * (i + 1) / n) for i in range(n)], dtype=np.float32)


def dilated_branch(q, k, v, window, dil, slopes):
    b, h, s, dh = q.shape
    half = window // (2 * dil)
    L = s // dil
    nb = -(-L // half)
    lp = nb * half

    def classes(t):
        return t.reshape(b, h, L, dil, dh).transpose(0, 1, 3, 2, 4)

    qb = jnp.pad(classes(q), ((0, 0), (0, 0), (0, 0), (0, lp - L), (0, 0))).reshape(b, h, dil, nb, half, dh)

    def band(t):
        t = jnp.pad(classes(t), ((0, 0), (0, 0), (0, 0), (half, lp - L + half), (0, 0)))
        t = t.reshape(b, h, dil, nb + 2, half, dh)
        return jnp.concatenate([t[:, :, :, :-2], t[:, :, :, 1:-1], t[:, :, :, 2:]], axis=4)

    kb, vb = band(k), band(v)
    rel = np.arange(3 * half)[None, :] - half - np.arange(half)[:, None]
    kpos = np.arange(nb)[:, None, None] * half + np.arange(half)[None, :, None] + rel[None]
    valid = (np.abs(rel) <= half)[None] & (kpos >= 0) & (kpos < L)
    bias = -(slopes[:, None, None] * (dil * np.abs(rel)).astype(np.float32)[None])
    sc = jnp.einsum('bhrnqd,bhrnkd->bhrnqk', qb, kb).astype(jnp.float32) * (HEAD_DIM ** -0.5)
    sc = jnp.where(valid, sc + bias[:, None, None], NEG_INF)
    m = jnp.max(sc, axis=-1, keepdims=True)
    p = jnp.exp(sc - m)
    den = jnp.sum(p, axis=-1, keepdims=True)
    o = (jnp.einsum('bhrnqk,bhrnkd->bhrnqd', p.astype(v.dtype), vb).astype(jnp.float32) / den).astype(v.dtype)
    lse = (m + jnp.log(den))[..., 0]
    o = o.reshape(b, h, dil, lp, dh)[:, :, :, :L].transpose(0, 1, 3, 2, 4).reshape(b, h, s, dh)
    lse = lse.reshape(b, h, dil, lp)[..., :L].transpose(0, 1, 3, 2).reshape(b, h, s)
    return o, lse


def dilated_attention(q, k, v):
    slopes = alibi_slopes(q.shape[1])
    outs, lses = [], []
    for window, dil in DILATED_CONFIGS:
        o, lse = dilated_branch(q, k, v, window, dil, slopes)
        outs.append(o)
        lses.append(lse)
    w = jax.nn.softmax(jnp.stack(lses, axis=0), axis=0)
    return jnp.sum(w[..., None].astype(q.dtype) * jnp.stack(outs, axis=0), axis=0)


def neighborhood_attention(q, k, v, rpb):
    b, h, s, dh = q.shape
    rows = s // GRID_W
    kr = min(NA_ROWS, rows)
    ncb = GRID_W // NA_QC
    kk = kr * NA_KC
    r = np.arange(rows)
    rs = np.clip(r - NA_ROWS // 2, 0, rows - kr)
    key_row = rs[:, None] + np.arange(kr)[None]
    kcs = np.clip(np.arange(ncb) * NA_QC - NA_COLS // 2, 0, GRID_W - NA_KC)
    key_col = kcs[:, None] + np.arange(NA_KC)[None]
    idx = (key_row[:, None, :, None] * GRID_W + key_col[None, :, None, :]).reshape(-1)
    kg = jnp.take(k, jnp.asarray(idx, dtype=jnp.int32), axis=2).reshape(b, h, rows, ncb, kk, dh)
    vg = jnp.take(v, jnp.asarray(idx, dtype=jnp.int32), axis=2).reshape(b, h, rows, ncb, kk, dh)
    qb = q.reshape(b, h, rows, ncb, NA_QC, dh)
    qcol = np.arange(ncb)[:, None] * NA_QC + np.arange(NA_QC)[None]
    cs = np.clip(qcol - NA_COLS // 2, 0, GRID_W - NA_COLS)
    kcol = np.broadcast_to(key_col[:, None, :], (ncb, kr, NA_KC)).reshape(ncb, kk)
    valid = (kcol[:, None, :] >= cs[:, :, None]) & (kcol[:, None, :] < cs[:, :, None] + NA_COLS)
    krow = np.broadcast_to(key_row[:, :, None], (rows, kr, NA_KC)).reshape(rows, kk)
    dr_idx = (krow - r[:, None] + NA_ROWS - 1)[:, None, None, :]
    dc_idx = np.clip(kcol[:, None, :] - qcol[:, :, None] + NA_COLS - 1, 0, 2 * NA_COLS - 2)[None]
    bias = rpb.astype(jnp.float32)[:, dr_idx, dc_idx]
    sc = jnp.einsum('bhrjqd,bhrjkd->bhrjqk', qb, kg).astype(jnp.float32) * (HEAD_DIM ** -0.5) + bias
    p = jax.nn.softmax(jnp.where(valid, sc, NEG_INF), axis=-1)
    o = jnp.einsum('bhrjqk,bhrjkd->bhrjqd', p.astype(v.dtype), vg)
    return o.reshape(b, h, s, dh)


def complex_affine_combine(e1, e2):
    a1r, a1i, b1r, b1i = e1
    a2r, a2i, b2r, b2i = e2
    return (a2r * a1r - a2i * a1i,
            a2r * a1i + a2i * a1r,
            a2r * b1r - a2i * b1i + b2r,
            a2r * b1i + a2i * b1r + b2i)


def s5_scan(u, a_re, a_im, log_dt, b_re, b_im, c_re, c_im):
    s = u.shape[1]
    dt = jnp.exp(log_dt.astype(jnp.float32))[:, None]
    a = jnp.minimum(a_re.astype(jnp.float32), -1e-4)
    w = a_im.astype(jnp.float32)
    mag = jnp.exp(a * dt)
    abar_r, abar_i = mag * jnp.cos(w * dt), mag * jnp.sin(w * dt)
    den = a * a + w * w
    zr = abar_r - 1.0
    gr = (zr * a + abar_i * w) / den
    gi = (abar_i * a - zr * w) / den
    br, bi = b_re.astype(jnp.float32), b_im.astype(jnp.float32)
    bbar_r = gr[..., None] * br - gi[..., None] * bi
    bbar_i = gr[..., None] * bi + gi[..., None] * br
    bu_r = jnp.einsum('bsgc,gpc->bsgp', u, bbar_r)
    bu_i = jnp.einsum('bsgc,gpc->bsgp', u, bbar_i)
    ar_seq = jnp.broadcast_to(abar_r, (1, s) + abar_r.shape)
    ai_seq = jnp.broadcast_to(abar_i, (1, s) + abar_i.shape)
    _, _, xr, xi = lax.associative_scan(complex_affine_combine, (ar_seq, ai_seq, bu_r, bu_i), axis=1)
    return (jnp.einsum('bsgp,gcp->bsgc', xr, c_re.astype(jnp.float32))
            - jnp.einsum('bsgp,gcp->bsgc', xi, c_im.astype(jnp.float32)))


def s5_mixer(u, a_re, a_im, log_dt, b_re, b_im, c_re, c_im, d_skip, w_glu):
    bsz, s, _ = u.shape
    uf = u.astype(jnp.float32).reshape(bsz, s, S5_GROUPS, S5_GROUP)
    y_f = s5_scan(uf, a_re[0], a_im[0], log_dt[0], b_re[0], b_im[0], c_re[0], c_im[0])
    y_b = jnp.flip(s5_scan(jnp.flip(uf, axis=1), a_re[1], a_im[1], log_dt[1],
                           b_re[1], b_im[1], c_re[1], c_im[1]), axis=1)
    y = (y_f + y_b).reshape(bsz, s, C_WIDTH) + d_skip.astype(jnp.float32) * uf.reshape(bsz, s, C_WIDTH)
    g = jax.nn.gelu(y).astype(u.dtype)
    return g * jax.nn.sigmoid(g @ w_glu)


def ec_moe(h, w_router, w_gate, w_up, w_down):
    b, s, d = h.shape
    cap = EC_CAPACITY * s // N_EXPERTS
    aff = jax.nn.softmax(jnp.einsum('bsd,de->bse', h, w_router).astype(jnp.float32), axis=-1)
    gate, idx = lax.top_k(aff.transpose(0, 2, 1), cap)
    xe = jax.vmap(lambda hb, ib: hb[ib])(h, idx)
    hid = jax.nn.silu(jnp.einsum('becd,edf->becf', xe, w_gate)) * jnp.einsum('becd,edf->becf', xe, w_up)
    ye = jnp.einsum('becf,efd->becd', hid, w_down) * gate[..., None].astype(h.dtype)
    return jax.vmap(lambda ib, yb: jnp.zeros((s, d), yb.dtype).at[ib.reshape(-1)].add(yb.reshape(-1, d)))(idx, ye)


def setup_inputs(seed: int = 0) -> dict:
    key = jax.random.key(seed)
    ks = jax.random.split(key, 26)

    def nrm(k, shape, scale):
        return scale * jax.random.normal(k, shape, jnp.float32)

    def gain(k, shape):
        return 1.0 + 0.02 * jax.random.normal(k, shape, jnp.float32)

    sh5 = (DEPTH, 2, S5_GROUPS, S5_STATE)
    return {
        "x": nrm(ks[0], (BATCH, SEQ, D_MODEL), 1.0),
        "attn_norm": gain(ks[1], (DEPTH, D_MODEL)),
        "w_in": nrm(ks[2], (DEPTH, D_MODEL, IN_WIDTH), D_MODEL ** -0.5),
        "q_norm_a": gain(ks[3], (DEPTH, HEAD_DIM)),
        "k_norm_a": gain(ks[4], (DEPTH, HEAD_DIM)),
        "q_norm_b": gain(ks[5], (DEPTH, HEAD_DIM)),
        "k_norm_b": gain(ks[6], (DEPTH, HEAD_DIM)),
        "rel_pos_bias": nrm(ks[7], (DEPTH, B_HEADS, 2 * NA_ROWS - 1, 2 * NA_COLS - 1), 0.1),
        "s5_a_re": -0.5 * jnp.exp(nrm(ks[8], sh5, 0.05)),
        "s5_a_im": math.pi * jnp.arange(S5_STATE, dtype=jnp.float32) + nrm(ks[9], sh5, 0.01),
        "s5_log_dt": jax.random.uniform(ks[10], (DEPTH, 2, S5_GROUPS), jnp.float32,
                                        math.log(S5_DT_MIN), math.log(S5_DT_MAX)),
        "s5_b_re": nrm(ks[11], (DEPTH, 2, S5_GROUPS, S5_STATE, S5_GROUP), (2 * S5_GROUP) ** -0.5),
        "s5_b_im": nrm(ks[12], (DEPTH, 2, S5_GROUPS, S5_STATE, S5_GROUP), (2 * S5_GROUP) ** -0.5),
        "s5_c_re": nrm(ks[13], (DEPTH, 2, S5_GROUPS, S5_GROUP, S5_STATE), 0.5),
        "s5_c_im": nrm(ks[14], (DEPTH, 2, S5_GROUPS, S5_GROUP, S5_STATE), 0.5),
        "s5_d": nrm(ks[15], (DEPTH, C_WIDTH), 0.5),
        "w_glu": nrm(ks[16], (DEPTH, C_WIDTH, C_WIDTH), C_WIDTH ** -0.5),
        "out_norm_a": gain(ks[17], (DEPTH, A_WIDTH)),
        "out_norm_b": gain(ks[18], (DEPTH, B_WIDTH)),
        "out_norm_c": gain(ks[19], (DEPTH, C_WIDTH)),
        "w_out": nrm(ks[20], (DEPTH, MIX_WIDTH, D_MODEL), MIX_WIDTH ** -0.5),
        "ffn_norm": gain(ks[21], (DEPTH, D_MODEL)),
        "w_router": nrm(ks[22], (DEPTH, D_MODEL, N_EXPERTS), D_MODEL ** -0.5),
        "w_gate": nrm(ks[23], (DEPTH, N_EXPERTS, D_MODEL, EXPERT_FF), D_MODEL ** -0.5),
        "w_up": nrm(ks[24], (DEPTH, N_EXPERTS, D_MODEL, EXPERT_FF), D_MODEL ** -0.5),
        "w_down": nrm(ks[25], (DEPTH, N_EXPERTS, EXPERT_FF, D_MODEL), EXPERT_FF ** -0.5),
    }


def reference(x, attn_norm, w_in, q_norm_a, k_norm_a, q_norm_b, k_norm_b, rel_pos_bias,
              s5_a_re, s5_a_im, s5_log_dt, s5_b_re, s5_b_im, s5_c_re, s5_c_im, s5_d, w_glu,
              out_norm_a, out_norm_b, out_norm_c, w_out, ffn_norm, w_router, w_gate, w_up, w_down):
    splits = np.cumsum([A_WIDTH, A_WIDTH, A_WIDTH, B_WIDTH, B_WIDTH, B_WIDTH]).tolist()
    for l in range(DEPTH):
        h = rms_norm(x, attn_norm[l])
        proj = h @ w_in[l]
        qa, ka, va, qb, kb, vb, u = jnp.split(proj, splits, axis=-1)
        qa = rms_norm(split_heads(qa, A_HEADS), q_norm_a[l])
        ka = rms_norm(split_heads(ka, A_HEADS), k_norm_a[l])
        oa = merge_heads(dilated_attention(qa, ka, split_heads(va, A_HEADS)))
        qb = rms_norm(split_heads(qb, B_HEADS), q_norm_b[l])
        kb = rms_norm(split_heads(kb, B_HEADS), k_norm_b[l])
        ob = merge_heads(neighborhood_attention(qb, kb, split_heads(vb, B_HEADS), rel_pos_bias[l]))
        oc = s5_mixer(u, s5_a_re[l], s5_a_im[l], s5_log_dt[l], s5_b_re[l], s5_b_im[l],
                      s5_c_re[l], s5_c_im[l], s5_d[l], w_glu[l])
        mix = jnp.concatenate([rms_norm(oa, out_norm_a[l]), rms_norm(ob, out_norm_b[l]),
                               rms_norm(oc, out_norm_c[l])], axis=-1)
        x = x + mix @ w_out[l]
        x = x + ec_moe(rms_norm(x, ffn_norm[l]), w_router[l], w_gate[l], w_up[l], w_down[l])
    return x
```

```cpp
#include <hip/hip_runtime.h>
#include <stdint.h>
#include <stdio.h>

#define DEVI __device__ __forceinline__
typedef unsigned short bf16_t;
typedef short bf16x8 __attribute__((ext_vector_type(8)));
typedef float f32x4 __attribute__((ext_vector_type(4)));
typedef float f32x2 __attribute__((ext_vector_type(2)));
typedef unsigned u32x4 __attribute__((ext_vector_type(4)));
typedef unsigned u32x2 __attribute__((ext_vector_type(2)));

constexpr int kB = 8, kS = 8192, kD = 1024, kL = 4, kTok = kB * kS;
constexpr int kINW = 2560;
constexpr int kE = 16, kCap = 1024, kFF = 2048;
constexpr int kNT = 512;
constexpr float kEps = 1e-6f;

constexpr size_t MiB = 1024ull * 1024ull;
constexpr size_t WS_CTL   = 0;
constexpr size_t WS_WINT  = 1 * MiB;
constexpr size_t WS_WOUTT = WS_WINT + 20 * MiB;
constexpr size_t WS_WGLUT = WS_WOUTT + 8 * MiB;
constexpr size_t WS_WGUT  = WS_WGLUT + 1 * MiB;
constexpr size_t WS_WDT   = WS_WGUT + 512 * MiB;
constexpr size_t WS_H     = WS_WDT + 256 * MiB;
constexpr size_t WS_R1    = WS_H + 128 * MiB;
constexpr size_t WS_R2    = WS_R1 + 512 * MiB;
constexpr size_t WS_AFF   = WS_R2 + 256 * MiB;
constexpr size_t WS_IDX   = WS_AFF + 4 * MiB;
constexpr size_t WS_GATE  = WS_IDX + 1 * MiB;
constexpr size_t WS_TSLOT = WS_GATE + 1 * MiB;
constexpr size_t WS_LSE   = WS_TSLOT + 4 * MiB;
constexpr size_t WS_YS    = WS_LSE + 8 * MiB;
constexpr size_t WS_END   = WS_YS + 128 * MiB;
constexpr size_t R1_QA = 0, R1_KA = 64 * MiB, R1_VA = 128 * MiB, R1_QB = 192 * MiB, R1_KB = 224 * MiB, R1_VB = 256 * MiB,
                 R1_UX = 288 * MiB, R1_OB = 352 * MiB, R1_OC = 384 * MiB, R1_G = 416 * MiB;

struct Params {
    const float* x; const float* attn_norm; const float* w_in; const float* q_norm_a; const float* k_norm_a; const float* q_norm_b; const float* k_norm_b;
    const float* rpb; const float* s5_a_re; const float* s5_a_im; const float* s5_log_dt; const float* s5_b_re; const float* s5_b_im; const float* s5_c_re; const float* s5_c_im;
    const float* s5_d; const float* w_glu; const float* out_norm_a; const float* out_norm_b; const float* out_norm_c; const float* w_out; const float* ffn_norm;
    const float* w_router; const float* w_gate; const float* w_up; const float* w_down;
    float* out; unsigned char* ws;
};

DEVI float bf2f(bf16_t b) { return __uint_as_float(((unsigned)b) << 16); }
DEVI bf16_t f2bf(float f) { unsigned u = __float_as_uint(f); u += 0x7FFFu + ((u >> 16) & 1u); return (bf16_t)(u >> 16); }
DEVI unsigned pk2(float lo, float hi) { return (unsigned)f2bf(lo) | ((unsigned)f2bf(hi) << 16); }
DEVI float wave_sum(float v) {
#pragma unroll
    for (int m = 32; m >= 1; m >>= 1) v += __shfl_xor(v, m);
    return v;
}
DEVI float gelu_tanh(float y) { const float z = 0.7978845608028654f * (y + 0.044715f * y * y * y); const float t = 1.f - 2.f / (1.f + __expf(2.f * z)); return 0.5f * y * (1.f + t); }

DEVI int cmap_head(int cs) { const int bj = cs >> 7, wc = (cs >> 5) & 3, n = (cs >> 4) & 1, fq = (cs >> 2) & 3, j = cs & 3; return 64 * wc + 32 * bj + 8 * fq + 4 * n + j; }
DEVI int cmap_pk(int cs)   { const int bj = cs >> 7, wc = (cs >> 5) & 3, n = (cs >> 4) & 1, fq = (cs >> 2) & 3, j = cs & 3; return 128 * bj + 32 * wc + 8 * fq + 4 * n + j; }
DEVI int cmap_gu(int cs)   { const int wc = (cs >> 5) & 3, n = (cs >> 4) & 1, fq = (cs >> 2) & 3, j = cs & 3; return 32 * wc + 8 * fq + 4 * n + j; }

template <int MODE>
DEVI void convert_item(const float* W0, const float* W1, int ldw, int K, bf16_t* Bt, int kt, int pn, unsigned char* lds) {
    bf16_t* t = (bf16_t*)lds;
    const int tid = threadIdx.x;
#pragma unroll 4
    for (int it = 0; it < 32; ++it) {
        const int e = it * kNT + tid, k = e >> 8, cs = e & 255;
        float v;
        if (MODE == 0) v = W0[(size_t)(kt * 64 + k) * ldw + pn * 256 + cs];
        else if (MODE == 1) v = W0[(size_t)(kt * 64 + k) * ldw + pn * 256 + cmap_head(cs)];
        else if (MODE == 2) v = W0[(size_t)(kt * 64 + k) * ldw + pn * 256 + cmap_pk(cs)];
        else v = ((cs >> 7) ? W1 : W0)[(size_t)(kt * 64 + k) * ldw + pn * 128 + cmap_gu(cs)];
        t[cs * 72 + k] = f2bf(v);
    }
    __syncthreads();
#pragma unroll
    for (int it = 0; it < 4; ++it) {
        const int c = it * kNT + tid, row = c >> 3, part = c & 7;
        const u32x4 v = *(const u32x4*)(t + row * 72 + part * 8);
        *(u32x4*)(Bt + (size_t)(pn * 256 + row) * K + kt * 64 + part * 8) = v;
    }
    __syncthreads();
}

DEVI void phase_convert(const Params& P, unsigned char* lds, int bid, int nblk) {
    constexpr int N_WIN = kL * 16 * 10, N_WOUT = kL * 16 * 4, N_WGLU = kL * 4 * 1, N_WGU = kL * kE * 16 * 16, N_WD = kL * kE * 32 * 4;
    constexpr int TOT = N_WIN + N_WOUT + N_WGLU + N_WGU + N_WD;
    for (int it = bid; it < TOT; it += nblk) {
        int i = it;
        if (i < N_WIN) { const int l = i / 160, r = i % 160, kt = r / 10, pn = r % 10;
            convert_item<1>(P.w_in + (size_t)l * kD * kINW, nullptr, kINW, kD, (bf16_t*)(P.ws + WS_WINT) + (size_t)l * kINW * kD, kt, pn, lds); continue; }
        i -= N_WIN;
        if (i < N_WOUT) { const int l = i / 64, r = i % 64, kt = r / 4, pn = r % 4;
            convert_item<0>(P.w_out + (size_t)l * kD * kD, nullptr, kD, kD, (bf16_t*)(P.ws + WS_WOUTT) + (size_t)l * kD * kD, kt, pn, lds); continue; }
        i -= N_WOUT;
        if (i < N_WGLU) { const int l = i / 4, kt = i % 4;
            convert_item<2>(P.w_glu + (size_t)l * 256 * 256, nullptr, 256, 256, (bf16_t*)(P.ws + WS_WGLUT) + (size_t)l * 256 * 256, kt, 0, lds); continue; }
        i -= N_WGLU;
        if (i < N_WGU) { const int le = i / 256, r = i % 256, kt = r / 16, pn = r % 16;
            convert_item<3>(P.w_gate + (size_t)le * kD * kFF, P.w_up + (size_t)le * kD * kFF, kFF, kD, (bf16_t*)(P.ws + WS_WGUT) + (size_t)le * 4096 * kD, kt, pn, lds); continue; }
        i -= N_WGU;
        { const int le = i / 128, r = i % 128, kt = r / 4, pn = r % 4;
            convert_item<2>(P.w_down + (size_t)le * kFF * kD, nullptr, kD, kFF, (bf16_t*)(P.ws + WS_WDT) + (size_t)le * kD * kFF, kt, pn, lds); }
    }
}

DEVI void phase_norm(const float* x, const float* gain, bf16_t* h, int bid, int nblk) {
    const int wid = threadIdx.x >> 6, lane = threadIdx.x & 63;
    f32x4 g[4];
#pragma unroll
    for (int q = 0; q < 4; ++q) g[q] = *(const f32x4*)(gain + q * 256 + lane * 4);
    for (int row = bid * 8 + wid; row < kTok; row += nblk * 8) {
        f32x4 v[4]; float ss = 0.f;
#pragma unroll
        for (int q = 0; q < 4; ++q) { v[q] = *(const f32x4*)(x + (size_t)row * kD + q * 256 + lane * 4); ss += v[q].x * v[q].x + v[q].y * v[q].y + v[q].z * v[q].z + v[q].w * v[q].w; }
        ss = wave_sum(ss);
        const float rstd = rsqrtf(ss * (1.f / kD) + kEps);
#pragma unroll
        for (int q = 0; q < 4; ++q) { u32x2 o; o.x = pk2(v[q].x * rstd * g[q].x, v[q].y * rstd * g[q].y); o.y = pk2(v[q].z * rstd * g[q].z, v[q].w * rstd * g[q].w);
            *(u32x2*)(h + (size_t)row * kD + q * 256 + lane * 4) = o; }
    }
}

DEVI void phase_router(const float* x, const float* gain, const float* wr  , bf16_t* h, float* aff, unsigned char* lds, int bid, int nblk) {
    float* wT = (float*)lds;
    for (int i = threadIdx.x; i < 16 * 1024; i += kNT) { const int k = i >> 4, e = i & 15; wT[e * 1024 + k] = wr[i]; }
    __syncthreads();
    const int wid = threadIdx.x >> 6, lane = threadIdx.x & 63;
    f32x4 g[4];
#pragma unroll
    for (int q = 0; q < 4; ++q) g[q] = *(const f32x4*)(gain + q * 256 + lane * 4);
    for (int row0 = (bid * 8 + wid) * 2; row0 < kTok; row0 += nblk * 8 * 2) {
        asm volatile("" ::: "memory");
        f32x4 v[2][4];
#pragma unroll
        for (int r = 0; r < 2; ++r) { float ss = 0.f;
#pragma unroll
            for (int q = 0; q < 4; ++q) { v[r][q] = *(const f32x4*)(x + (size_t)(row0 + r) * kD + q * 256 + lane * 4); ss += v[r][q].x * v[r][q].x + v[r][q].y * v[r][q].y + v[r][q].z * v[r][q].z + v[r][q].w * v[r][q].w; }
            ss = wave_sum(ss); const float rstd = rsqrtf(ss * (1.f / kD) + kEps);
#pragma unroll
            for (int q = 0; q < 4; ++q) { v[r][q] = v[r][q] * rstd * g[q];
                u32x2 o; o.x = pk2(v[r][q].x, v[r][q].y); o.y = pk2(v[r][q].z, v[r][q].w);
                *(u32x2*)(h + (size_t)(row0 + r) * kD + q * 256 + lane * 4) = o; }
        }
        float pa[32];
#pragma unroll
        for (int e = 0; e < 16; ++e) {
            float s0 = 0.f, s1 = 0.f;
#pragma unroll
            for (int q = 0; q < 4; ++q) { const f32x4 w = *(const f32x4*)(wT + e * 1024 + q * 256 + lane * 4);
                s0 += v[0][q].x * w.x + v[0][q].y * w.y + v[0][q].z * w.z + v[0][q].w * w.w;
                s1 += v[1][q].x * w.x + v[1][q].y * w.y + v[1][q].z * w.z + v[1][q].w * w.w; }
            pa[e] = s0; pa[16 + e] = s1;
        }
#define RS_STEP(HALF, MASK) { const bool up = (lane & (MASK)) != 0; _Pragma("unroll") for (int i = 0; i < (HALF); ++i) { const float keep = up ? pa[i + (HALF)] : pa[i], send = up ? pa[i] : pa[i + (HALF)]; pa[i] = keep + __shfl_xor(send, (MASK)); } }
        RS_STEP(16, 32) RS_STEP(8, 16) RS_STEP(4, 8) RS_STEP(2, 4) RS_STEP(1, 2)
#undef RS_STEP
        const float logit = pa[0] + __shfl_xor(pa[0], 1);
        float mx = logit;
#pragma unroll
        for (int m = 16; m >= 2; m >>= 1) mx = fmaxf(mx, __shfl_xor(mx, m));
        const float ex = __expf(logit - mx);
        float sm = ex;
#pragma unroll
        for (int m = 16; m >= 2; m >>= 1) sm += __shfl_xor(sm, m);
        const int row = row0 + (lane >> 5), e = (lane >> 1) & 15, b = row >> 13, s = row & (kS - 1);
        if (!(lane & 1)) aff[((size_t)(b * kE + e)) * kS + s] = ex / sm;
    }
    __syncthreads();
}

DEVI int block_excl_scan(int v, int* sh  , int& total) {
    const int lane = threadIdx.x & 63, wid = threadIdx.x >> 6;
    int incl = v;
#pragma unroll
    for (int d = 1; d < 64; d <<= 1) { const int o = __shfl_up(incl, d); if (lane >= d) incl += o; }
    __syncthreads();
    if (lane == 63) sh[wid] = incl;
    __syncthreads();
    int base = 0, tot = 0;
#pragma unroll
    for (int w = 0; w < 8; ++w) { const int c = sh[w]; if (w < wid) base += c; tot += c; }
    total = tot;
    return base + incl - v;
}

DEVI void phase_topk(const float* aff, int* idx, float* gate, int* tokslot, unsigned char* lds, int bid, int nblk) {
    int* hist = (int*)lds;
    int* sh = hist + 256;
    int* res = sh + 16;
    const int tid = threadIdx.x, lane = tid & 63, wid = tid >> 6;
    for (int item = bid; item < kB * kE; item += nblk) {
        const int b = item >> 4, e = item & 15;
        const float* a = aff + (size_t)item * kS;
        unsigned key[16];
#pragma unroll
        for (int q = 0; q < 4; ++q) { const u32x4 v = *(const u32x4*)(a + tid * 16 + q * 4); key[q * 4 + 0] = v.x; key[q * 4 + 1] = v.y; key[q * 4 + 2] = v.z; key[q * 4 + 3] = v.w; }
        unsigned prefix = 0; int kk = kCap;
#pragma unroll 1
        for (int pass = 0; pass < 4; ++pass) {
            const int shift = 24 - 8 * pass;
            __syncthreads();
            if (tid < 256) hist[tid] = 0;
            __syncthreads();
#pragma unroll
            for (int i = 0; i < 16; ++i) { const bool in = (pass == 0) || ((key[i] >> (shift + 8)) == prefix); if (in) atomicAdd(&hist[(key[i] >> shift) & 255], 1); }
            __syncthreads();
            if (wid == 0) {
                int c[4], loc = 0;
#pragma unroll
                for (int j = 0; j < 4; ++j) { c[j] = hist[255 - 4 * lane - j]; loc += c[j]; }
                int incl = loc;
#pragma unroll
                for (int d = 1; d < 64; d <<= 1) { const int o = __shfl_up(incl, d); if (lane >= d) incl += o; }
                const int excl = incl - loc;
                if (excl < kk && kk <= incl) { int run = excl; int bin = 0, nk = 0; bool found = false;
#pragma unroll
                    for (int j = 0; j < 4; ++j) { if (!found && run + c[j] >= kk) { bin = 255 - 4 * lane - j; nk = kk - run; found = true; } if (!found) run += c[j]; }
                    res[0] = bin; res[1] = nk; }
            }
            __syncthreads();
            prefix = (prefix << 8) | (unsigned)res[0]; kk = res[1];
        }
        const unsigned T = prefix;
        int ceq = 0;
#pragma unroll
        for (int i = 0; i < 16; ++i) ceq += (key[i] == T) ? 1 : 0;
        int tot;
        int eqb = block_excl_scan(ceq, sh, tot);
        int csel = 0; unsigned selmask = 0;
#pragma unroll
        for (int i = 0; i < 16; ++i) { bool s = key[i] > T; if (key[i] == T) { s = eqb < kk; ++eqb; } if (s) { selmask |= 1u << i; ++csel; } }
        int slot = block_excl_scan(csel, sh, tot);
        const size_t rbase = (size_t)(e * kB + b) * kCap;
#pragma unroll
        for (int i = 0; i < 16; ++i) { const int s = tid * 16 + i; const bool sel = (selmask >> i) & 1u;
            if (sel) { idx[rbase + slot] = b * kS + s; gate[rbase + slot] = __uint_as_float(key[i]); }
            tokslot[((size_t)(b * kS + s)) * kE + e] = sel ? slot : -1;
            if (sel) ++slot; }
    }
    __syncthreads();
}

struct Unit { int pm, pn; };
DEVI bool unit_of(int Lid, int nM, int nN, Unit& u) {
    const int nwg = nM * nN; if (Lid >= nwg) return false;
    int wgid = Lid; { const int q = nwg / 8, r = nwg % 8, xcd = wgid % 8, off = wgid / 8; wgid = (xcd < r ? xcd * (q + 1) : r * (q + 1) + (xcd - r) * q) + off; }
    const int nig = 8 * nN, gid = wgid / nig, fm = gid * 8, gsz = (nM - fm) < 8 ? (nM - fm) : 8;
    u.pm = fm + ((wgid % nig) % gsz); u.pn = (wgid % nig) / gsz; return true;
}
struct GemmD { const bf16_t* A; const bf16_t* Bt; int lda, K, nM, nN; const int* rowidx; size_t bstride; int pmg; };

template <class Epi>
DEVI void gemm_simple(const GemmD g, const Epi& E, int bid, int nblk) {
    const int tid = threadIdx.x, wid = tid >> 6, lane = tid & 63, wr = wid >> 2, wc = wid & 3, fr = lane & 15, fq = lane >> 4;
    for (int i = 0;; ++i) {
        Unit u; if (!unit_of(i * nblk + bid, g.nM, g.nN, u)) break;
        f32x4 acc[2][2][4][2];
#pragma unroll
        for (int a = 0; a < 2; ++a)
#pragma unroll
            for (int b = 0; b < 2; ++b)
#pragma unroll
                for (int m = 0; m < 4; ++m)
#pragma unroll
                    for (int n = 0; n < 2; ++n) acc[a][b][m][n] = (f32x4){0.f, 0.f, 0.f, 0.f};
        const bf16_t* Bu = g.Bt + (size_t)(u.pm / g.pmg) * g.bstride + (size_t)u.pn * 256 * g.K;
        const bf16_t* ap[2][4]; const bf16_t* bp[2][2];
#pragma unroll
        for (int a = 0; a < 2; ++a)
#pragma unroll
            for (int m = 0; m < 4; ++m) { const int r = u.pm * 256 + 128 * a + 64 * wr + 16 * m + fr; const size_t rr = g.rowidx ? (size_t)g.rowidx[r] : (size_t)r; ap[a][m] = g.A + rr * g.lda + 8 * fq; }
#pragma unroll
        for (int b = 0; b < 2; ++b)
#pragma unroll
            for (int n = 0; n < 2; ++n) bp[b][n] = Bu + (size_t)(128 * b + 32 * wc + 16 * n + fr) * g.K + 8 * fq;
#pragma unroll 2
        for (int k0 = 0; k0 < g.K; k0 += 32) {
            bf16x8 av[2][4], bv[2][2];
#pragma unroll
            for (int a = 0; a < 2; ++a)
#pragma unroll
                for (int m = 0; m < 4; ++m) av[a][m] = *(const bf16x8*)(ap[a][m] + k0);
#pragma unroll
            for (int b = 0; b < 2; ++b)
#pragma unroll
                for (int n = 0; n < 2; ++n) bv[b][n] = *(const bf16x8*)(bp[b][n] + k0);
#pragma unroll
            for (int a = 0; a < 2; ++a)
#pragma unroll
                for (int b = 0; b < 2; ++b)
#pragma unroll
                    for (int m = 0; m < 4; ++m)
#pragma unroll
                        for (int n = 0; n < 2; ++n) acc[a][b][m][n] = __builtin_amdgcn_mfma_f32_16x16x32_bf16(bv[b][n], av[a][m], acc[a][b][m][n], 0, 0, 0);
        }
        E(acc, u, wr, wc, fr, fq);
    }
}

struct EpiQKV {
    bf16_t *qa, *ka, *va, *qb, *kb, *vb, *ux; const float *qna, *kna, *qnb, *knb;
    DEVI void operator()(const f32x4 (&acc)[2][2][4][2], const Unit& u, int wr, int wc, int fr, int fq) const {
        bf16_t* dst; const float* gn = nullptr; int H = 8, head0 = 0; const int pn = u.pn;
        if (pn < 2) { dst = qa; gn = qna; head0 = pn * 4; }
        else if (pn < 4) { dst = ka; gn = kna; head0 = (pn - 2) * 4; }
        else if (pn < 6) { dst = va; head0 = (pn - 4) * 4; }
        else if (pn == 6) { dst = qb; gn = qnb; H = 4; }
        else if (pn == 7) { dst = kb; gn = knb; H = 4; }
        else if (pn == 8) { dst = vb; H = 4; }
        else { dst = ux; }
        const int head = head0 + wc;
        f32x4 gv[2][2];
#pragma unroll
        for (int bj = 0; bj < 2; ++bj)
#pragma unroll
            for (int n = 0; n < 2; ++n) gv[bj][n] = gn ? *(const f32x4*)(gn + 32 * bj + 8 * fq + 4 * n) : (f32x4){1.f, 1.f, 1.f, 1.f};
#pragma unroll
        for (int ai = 0; ai < 2; ++ai)
#pragma unroll
            for (int m = 0; m < 4; ++m) {
                const int row = u.pm * 256 + 128 * ai + 64 * wr + 16 * m + fr;
                float rstd = 1.f;
                if (gn) { float ss = 0.f;
#pragma unroll
                    for (int bj = 0; bj < 2; ++bj)
#pragma unroll
                        for (int n = 0; n < 2; ++n) { const f32x4 v = acc[ai][bj][m][n]; ss += v.x * v.x + v.y * v.y + v.z * v.z + v.w * v.w; }
                    ss += __shfl_xor(ss, 16); ss += __shfl_xor(ss, 32);
                    rstd = rsqrtf(ss * (1.f / 64.f) + kEps); }
#pragma unroll
                for (int bj = 0; bj < 2; ++bj) {
                    const f32x4 v0 = acc[ai][bj][m][0] * rstd * gv[bj][0], v1 = acc[ai][bj][m][1] * rstd * gv[bj][1];
                    u32x4 w; w.x = pk2(v0.x, v0.y); w.y = pk2(v0.z, v0.w); w.z = pk2(v1.x, v1.y); w.w = pk2(v1.z, v1.w);
                    if (pn < 9) { const int b = row >> 13, s = row & (kS - 1);
                        *(u32x4*)(dst + (((size_t)(b * H + head)) * kS + s) * 64 + 32 * bj + 8 * fq) = w; }
                    else { const int gidx = 4 * wc + 2 * bj + (fq >> 1), c0 = 8 * (fq & 1);
                        *(u32x4*)(dst + ((size_t)gidx * 4096 + (row >> 4)) * 512 + (row & 15) * 16 + c0) = w; }
                }
            }
    }
};
struct EpiResid {
    const float* xin; float* xout;
    DEVI void operator()(const f32x4 (&acc)[2][2][4][2], const Unit& u, int wr, int wc, int fr, int fq) const {
#pragma unroll
        for (int ai = 0; ai < 2; ++ai)
#pragma unroll
            for (int m = 0; m < 4; ++m) { const size_t ro = (size_t)(u.pm * 256 + 128 * ai + 64 * wr + 16 * m + fr) * kD + u.pn * 256 + 32 * wc + 4 * fq;
#pragma unroll
                for (int bj = 0; bj < 2; ++bj)
#pragma unroll
                    for (int n = 0; n < 2; ++n) { const size_t o = ro + 128 * bj + 16 * n; *(f32x4*)(xout + o) = *(const f32x4*)(xin + o) + acc[ai][bj][m][n]; } }
    }
};
struct EpiGU {
    bf16_t* hid;
    DEVI void operator()(const f32x4 (&acc)[2][2][4][2], const Unit& u, int wr, int wc, int fr, int fq) const {
#pragma unroll
        for (int ai = 0; ai < 2; ++ai)
#pragma unroll
            for (int m = 0; m < 4; ++m) { const size_t row = (size_t)(u.pm * 256 + 128 * ai + 64 * wr + 16 * m + fr);
                float o[8];
#pragma unroll
                for (int n = 0; n < 2; ++n)
#pragma unroll
                    for (int j = 0; j < 4; ++j) { const float gt = acc[ai][0][m][n][j], up = acc[ai][1][m][n][j]; o[n * 4 + j] = gt / (1.f + __expf(-gt)) * up; }
                u32x4 w; w.x = pk2(o[0], o[1]); w.y = pk2(o[2], o[3]); w.z = pk2(o[4], o[5]); w.w = pk2(o[6], o[7]);
                *(u32x4*)(hid + row * kFF + u.pn * 128 + 32 * wc + 8 * fq) = w; }
    }
};
struct EpiDown {
    bf16_t* y; const float* gate;
    DEVI void operator()(const f32x4 (&acc)[2][2][4][2], const Unit& u, int wr, int wc, int fr, int fq) const {
#pragma unroll
        for (int ai = 0; ai < 2; ++ai)
#pragma unroll
            for (int m = 0; m < 4; ++m) { const size_t row = (size_t)(u.pm * 256 + 128 * ai + 64 * wr + 16 * m + fr); const float gv = gate[row];
#pragma unroll
                for (int bj = 0; bj < 2; ++bj) { const f32x4 v0 = acc[ai][bj][m][0] * gv, v1 = acc[ai][bj][m][1] * gv;
                    u32x4 w; w.x = pk2(v0.x, v0.y); w.y = pk2(v0.z, v0.w); w.z = pk2(v1.x, v1.y); w.w = pk2(v1.z, v1.w);
                    *(u32x4*)(y + row * kD + u.pn * 256 + 128 * bj + 32 * wc + 8 * fq) = w; } }
    }
};
struct EpiGlu {
    const bf16_t* g; bf16_t* oc;
    DEVI void operator()(const f32x4 (&acc)[2][2][4][2], const Unit& u, int wr, int wc, int fr, int fq) const {
#pragma unroll
        for (int ai = 0; ai < 2; ++ai)
#pragma unroll
            for (int m = 0; m < 4; ++m) { const size_t row = (size_t)(u.pm * 256 + 128 * ai + 64 * wr + 16 * m + fr);
#pragma unroll
                for (int bj = 0; bj < 2; ++bj) { const size_t o = row * 256 + 128 * bj + 32 * wc + 8 * fq;
                    const u32x4 gw = *(const u32x4*)(g + o); float o8[8];
#pragma unroll
                    for (int n = 0; n < 2; ++n)
#pragma unroll
                        for (int j = 0; j < 4; ++j) { const int t = n * 4 + j; const unsigned wv = (t < 2) ? gw.x : (t < 4) ? gw.y : (t < 6) ? gw.z : gw.w;
                            const float gg = __uint_as_float((t & 1) ? (wv & 0xFFFF0000u) : (wv << 16)); o8[t] = gg / (1.f + __expf(-acc[ai][bj][m][n][j])); }
                    u32x4 w; w.x = pk2(o8[0], o8[1]); w.y = pk2(o8[2], o8[3]); w.z = pk2(o8[4], o8[5]); w.w = pk2(o8[6], o8[7]);
                    *(u32x4*)(oc + o) = w; } }
    }
};

DEVI void load_row64(const bf16_t* p, float* d) {
#pragma unroll
    for (int i = 0; i < 8; ++i) { const u32x4 v = *(const u32x4*)(p + i * 8);
        d[i * 8 + 0] = __uint_as_float(v.x << 16); d[i * 8 + 1] = __uint_as_float(v.x & 0xFFFF0000u); d[i * 8 + 2] = __uint_as_float(v.y << 16); d[i * 8 + 3] = __uint_as_float(v.y & 0xFFFF0000u);
        d[i * 8 + 4] = __uint_as_float(v.z << 16); d[i * 8 + 5] = __uint_as_float(v.z & 0xFFFF0000u); d[i * 8 + 6] = __uint_as_float(v.w << 16); d[i * 8 + 7] = __uint_as_float(v.w & 0xFFFF0000u); }
}
DEVI void store_row64(bf16_t* p, const float* d, float sc) {
#pragma unroll
    for (int i = 0; i < 8; ++i) { u32x4 w; w.x = pk2(d[i * 8] * sc, d[i * 8 + 1] * sc); w.y = pk2(d[i * 8 + 2] * sc, d[i * 8 + 3] * sc); w.z = pk2(d[i * 8 + 4] * sc, d[i * 8 + 5] * sc); w.w = pk2(d[i * 8 + 6] * sc, d[i * 8 + 7] * sc);
        *(u32x4*)(p + i * 8) = w; }
}
DEVI void phase_dilated_naive(const bf16_t* qa, const bf16_t* ka, const bf16_t* va, bf16_t* oac, float* lse, int bid, int nblk) {
    const int nitems = 3 * kB * 8 * (kS / kNT);
    for (int it = bid; it < nitems; it += nblk) {
        const int c = it / (kB * 8 * 16), r = it % (kB * 8 * 16), bh = r / 16, t = (r % 16) * kNT + threadIdx.x, b = bh >> 3, h = bh & 7;
        const int dil = (c == 0) ? 1 : (c == 1) ? 4 : 16;
        const float slope = exp2f(-(float)(h + 1));
        const bf16_t* kb_ = ka + (size_t)bh * kS * 64; const bf16_t* vb_ = va + (size_t)bh * kS * 64;
        float q[64], o[64];
        load_row64(qa + ((size_t)bh * kS + t) * 64, q);
#pragma unroll
        for (int d = 0; d < 64; ++d) o[d] = 0.f;
        float m = -1e30f, l = 0.f;
        for (int rel = -64; rel <= 64; ++rel) {
            const int pos = t + rel * dil;
            if (pos < 0 || pos >= kS) continue;
            float kv[64]; load_row64(kb_ + (size_t)pos * 64, kv);
            float dot = 0.f;
#pragma unroll
            for (int d = 0; d < 64; ++d) dot += q[d] * kv[d];
            const float sc = dot * 0.125f - slope * (float)(dil * (rel < 0 ? -rel : rel));
            const float mn = fmaxf(m, sc), corr = __expf(m - mn), p = __expf(sc - mn);
            load_row64(vb_ + (size_t)pos * 64, kv);
            l = l * corr + p;
#pragma unroll
            for (int d = 0; d < 64; ++d) o[d] = o[d] * corr + p * kv[d];
            m = mn;
        }
        const size_t tok = (size_t)b * kS + t;
        store_row64(oac + ((size_t)c * kTok + tok) * 512 + h * 64, o, 1.f / l);
        lse[((size_t)c * kTok + tok) * 8 + h] = m + __logf(l);
    }
}
DEVI void phase_na_naive(const bf16_t* qb, const bf16_t* kbuf, const bf16_t* vbuf, const float* rpb  , bf16_t* ob, int bid, int nblk) {
    const int nitems = kB * 4 * (kS / kNT);
    for (int it = bid; it < nitems; it += nblk) {
        const int bh = it / 16, t = (it % 16) * kNT + threadIdx.x, b = bh >> 2, h = bh & 3;
        const int r = t >> 6, cq = t & 63;
        int rs = r - 4; rs = rs < 0 ? 0 : (rs > 120 ? 120 : rs);
        int cs = cq - 8; cs = cs < 0 ? 0 : (cs > 48 ? 48 : cs);
        const bf16_t* kb_ = kbuf + (size_t)bh * kS * 64; const bf16_t* vb_ = vbuf + (size_t)bh * kS * 64;
        float q[64], o[64];
        load_row64(qb + ((size_t)bh * kS + t) * 64, q);
#pragma unroll
        for (int d = 0; d < 64; ++d) o[d] = 0.f;
        float m = -1e30f, l = 0.f;
        for (int kr = 0; kr < 8; ++kr)
            for (int kc = 0; kc < 16; ++kc) {
                const int krow = rs + kr, kcol = cs + kc, pos = krow * 64 + kcol;
                float kv[64]; load_row64(kb_ + (size_t)pos * 64, kv);
                float dot = 0.f;
#pragma unroll
                for (int d = 0; d < 64; ++d) dot += q[d] * kv[d];
                const float sc = dot * 0.125f + rpb[(h * 15 + (krow - r + 7)) * 31 + (kcol - cq + 15)];
                const float mn = fmaxf(m, sc), corr = __expf(m - mn), p = __expf(sc - mn);
                load_row64(vb_ + (size_t)pos * 64, kv);
                l = l * corr + p;
#pragma unroll
                for (int d = 0; d < 64; ++d) o[d] = o[d] * corr + p * kv[d];
                m = mn;
            }
        store_row64(ob + ((size_t)b * kS + t) * 256 + h * 64, o, 1.f / l);
    }
}
DEVI void phase_s5_naive(const Params& P, int l, const bf16_t* ux, float* ys, unsigned char* lds, int bid, int nblk) {
    const int wid = threadIdx.x >> 6, lane = threadIdx.x & 63;
    float* xs = (float*)lds + wid * 128;
    for (int item = bid * 8 + wid; item < kB * 16 * 2; item += nblk * 8) {
        const int dir = item & 1, g = (item >> 1) & 15, b = item >> 5;
        const size_t pbase = (((size_t)l * 2 + dir) * 16 + g) * 64;
        const float dt = __expf(P.s5_log_dt[((size_t)l * 2 + dir) * 16 + g]);
        const float a = fminf(P.s5_a_re[pbase + lane], -1e-4f), w = P.s5_a_im[pbase + lane];
        const float mag = __expf(a * dt), ar = mag * cosf(w * dt), ai = mag * sinf(w * dt);
        const float den = a * a + w * w, zr = ar - 1.f, gr = (zr * a + ai * w) / den, gi = (ai * a - zr * w) / den;
        float bbr[16], bbi[16];
#pragma unroll
        for (int c = 0; c < 16; ++c) { const float br = P.s5_b_re[(pbase + lane) * 16 + c], bi = P.s5_b_im[(pbase + lane) * 16 + c]; bbr[c] = gr * br - gi * bi; bbi[c] = gr * bi + gi * br; }
        const int cch = lane & 15, qt = lane >> 4;
        float cre[16], cim[16];
#pragma unroll
        for (int pp = 0; pp < 16; ++pp) { cre[pp] = P.s5_c_re[(pbase / 64 * 16 + cch) * 64 + qt * 16 + pp]; cim[pp] = P.s5_c_im[(pbase / 64 * 16 + cch) * 64 + qt * 16 + pp]; }
        float xr = 0.f, xi = 0.f;
        const bf16_t* ug = ux + (size_t)g * 4096 * 512;
        for (int st = 0; st < kS; ++st) {
            const int s = dir ? (kS - 1 - st) : st; const size_t tok = (size_t)b * kS + s;
            const bf16_t* up = ug + (tok >> 4) * 512 + (tok & 15) * 16;
            const u32x4 u0 = *(const u32x4*)up, u1 = *(const u32x4*)(up + 8);
            float uv[16];
            uv[0] = __uint_as_float(u0.x << 16); uv[1] = __uint_as_float(u0.x & 0xFFFF0000u); uv[2] = __uint_as_float(u0.y << 16); uv[3] = __uint_as_float(u0.y & 0xFFFF0000u);
            uv[4] = __uint_as_float(u0.z << 16); uv[5] = __uint_as_float(u0.z & 0xFFFF0000u); uv[6] = __uint_as_float(u0.w << 16); uv[7] = __uint_as_float(u0.w & 0xFFFF0000u);
            uv[8] = __uint_as_float(u1.x << 16); uv[9] = __uint_as_float(u1.x & 0xFFFF0000u); uv[10] = __uint_as_float(u1.y << 16); uv[11] = __uint_as_float(u1.y & 0xFFFF0000u);
            uv[12] = __uint_as_float(u1.z << 16); uv[13] = __uint_as_float(u1.z & 0xFFFF0000u); uv[14] = __uint_as_float(u1.w << 16); uv[15] = __uint_as_float(u1.w & 0xFFFF0000u);
            float bur = 0.f, bui = 0.f;
#pragma unroll
            for (int c = 0; c < 16; ++c) { bur += bbr[c] * uv[c]; bui += bbi[c] * uv[c]; }
            const float nr = ar * xr - ai * xi + bur, ni = ar * xi + ai * xr + bui; xr = nr; xi = ni;
            xs[lane] = xr; xs[64 + lane] = xi;
            asm volatile("s_waitcnt lgkmcnt(0)" ::: "memory");
            float y = 0.f;
#pragma unroll
            for (int pp = 0; pp < 16; ++pp) y += cre[pp] * xs[qt * 16 + pp] - cim[pp] * xs[64 + qt * 16 + pp];
            asm volatile("s_waitcnt lgkmcnt(0)" ::: "memory");
            y += __shfl_xor(y, 16); y += __shfl_xor(y, 32);
            if (lane < 16) ys[((size_t)dir * kTok + tok) * 256 + g * 16 + cch] = y;
        }
    }
}
DEVI void phase_s5_finish(const float* ys, const bf16_t* ux, const float* dskip, bf16_t* G, int bid, int nblk) {
    for (size_t i = (size_t)bid * kNT + threadIdx.x; i < (size_t)kTok * 256; i += (size_t)nblk * kNT) {
        const size_t tok = i >> 8; const int ch = (int)(i & 255), g = ch >> 4, c = ch & 15;
        const float u = bf2f(ux[((size_t)g * 4096 + (tok >> 4)) * 512 + (tok & 15) * 16 + c]);
        const float y = ys[i] + ys[(size_t)kTok * 256 + i] + dskip[ch] * u;
        G[i] = f2bf(gelu_tanh(y));
    }
}
DEVI void phase_mixnorm(const bf16_t* oac, const float* lse, const bf16_t* ob, const bf16_t* oc, const float* ga, const float* gb, const float* gc, bf16_t* mix, int bid, int nblk) {
    const int wid = threadIdx.x >> 6, lane = threadIdx.x & 63;
    float gn[16];
    { const float* gp = (lane < 32) ? ga + lane * 16 : (lane < 48) ? gb + (lane - 32) * 16 : gc + (lane - 48) * 16;
#pragma unroll
      for (int i = 0; i < 16; ++i) gn[i] = gp[i]; }
    for (int row = bid * 8 + wid; row < kTok; row += nblk * 8) {
        float v[16];
        if (lane < 32) {
            const int h = lane >> 2;
            const float l0 = lse[(size_t)row * 8 + h], l1 = lse[((size_t)kTok + row) * 8 + h], l2 = lse[((size_t)2 * kTok + row) * 8 + h];
            const float mx = fmaxf(l0, fmaxf(l1, l2)); float w0 = __expf(l0 - mx), w1 = __expf(l1 - mx), w2 = __expf(l2 - mx); const float inv = 1.f / (w0 + w1 + w2); w0 *= inv; w1 *= inv; w2 *= inv;
#pragma unroll
            for (int i = 0; i < 16; ++i) v[i] = 0.f;
#pragma unroll
            for (int c = 0; c < 3; ++c) { const float wc_ = (c == 0) ? w0 : (c == 1) ? w1 : w2; const bf16_t* p = oac + ((size_t)c * kTok + row) * 512 + lane * 16;
#pragma unroll
                for (int i = 0; i < 16; ++i) v[i] += wc_ * bf2f(p[i]); }
        } else {
            const bf16_t* p = (lane < 48) ? ob + (size_t)row * 256 + (lane - 32) * 16 : oc + (size_t)row * 256 + (lane - 48) * 16;
#pragma unroll
            for (int i = 0; i < 16; ++i) v[i] = bf2f(p[i]);
        }
        float ss = 0.f;
#pragma unroll
        for (int i = 0; i < 16; ++i) ss += v[i] * v[i];
#pragma unroll
        for (int m = 1; m <= 8; m <<= 1) ss += __shfl_xor(ss, m);
        const float o16 = __shfl_xor(ss, 16);
        if (lane < 32) ss += o16;
        const float rstd = rsqrtf(ss * ((lane < 32) ? (1.f / 512.f) : (1.f / 256.f)) + kEps);
        u32x4 w0, w1;
        w0.x = pk2(v[0] * rstd * gn[0], v[1] * rstd * gn[1]); w0.y = pk2(v[2] * rstd * gn[2], v[3] * rstd * gn[3]); w0.z = pk2(v[4] * rstd * gn[4], v[5] * rstd * gn[5]); w0.w = pk2(v[6] * rstd * gn[6], v[7] * rstd * gn[7]);
        w1.x = pk2(v[8] * rstd * gn[8], v[9] * rstd * gn[9]); w1.y = pk2(v[10] * rstd * gn[10], v[11] * rstd * gn[11]); w1.z = pk2(v[12] * rstd * gn[12], v[13] * rstd * gn[13]); w1.w = pk2(v[14] * rstd * gn[14], v[15] * rstd * gn[15]);
        *(u32x4*)(mix + (size_t)row * kD + lane * 16) = w0; *(u32x4*)(mix + (size_t)row * kD + lane * 16 + 8) = w1;
    }
}
DEVI void phase_combine(float* x, const bf16_t* y, const int* tokslot, const float* gain_next, bf16_t* h, int bid, int nblk) {
    const int wid = threadIdx.x >> 6, lane = threadIdx.x & 63;
    f32x4 g[4];
#pragma unroll
    for (int q = 0; q < 4; ++q) g[q] = gain_next ? *(const f32x4*)(gain_next + q * 256 + lane * 4) : (f32x4){0.f, 0.f, 0.f, 0.f};
    for (int row = bid * 8 + wid; row < kTok; row += nblk * 8) {
        const int b = row >> 13;
        const int ts = tokslot[(size_t)row * kE + (lane & 15)];
        f32x4 v[4];
#pragma unroll
        for (int q = 0; q < 4; ++q) v[q] = *(const f32x4*)(x + (size_t)row * kD + q * 256 + lane * 4);
#pragma unroll
        for (int e = 0; e < kE; ++e) { const int slot = __builtin_amdgcn_readlane(ts, e);
            if (slot >= 0) { const bf16_t* yr = y + ((size_t)(e * kB + b) * kCap + slot) * kD;
#pragma unroll
                for (int q = 0; q < 4; ++q) { const u32x2 w = *(const u32x2*)(yr + q * 256 + lane * 4);
                    v[q].x += __uint_as_float(w.x << 16); v[q].y += __uint_as_float(w.x & 0xFFFF0000u); v[q].z += __uint_as_float(w.y << 16); v[q].w += __uint_as_float(w.y & 0xFFFF0000u); } } }
        float ss = 0.f;
#pragma unroll
        for (int q = 0; q < 4; ++q) { *(f32x4*)(x + (size_t)row * kD + q * 256 + lane * 4) = v[q]; ss += v[q].x * v[q].x + v[q].y * v[q].y + v[q].z * v[q].z + v[q].w * v[q].w; }
        if (gain_next) { ss = wave_sum(ss); const float rstd = rsqrtf(ss * (1.f / kD) + kEps);
#pragma unroll
            for (int q = 0; q < 4; ++q) { u32x2 o; o.x = pk2(v[q].x * rstd * g[q].x, v[q].y * rstd * g[q].y); o.y = pk2(v[q].z * rstd * g[q].z, v[q].w * rstd * g[q].w);
                *(u32x2*)(h + (size_t)row * kD + q * 256 + lane * 4) = o; } }
    }
}

extern __shared__ __attribute__((aligned(16))) unsigned char dyn_lds[];
#define KB __global__ void __launch_bounds__(kNT, 2)
KB k_convert(Params P) { phase_convert(P, dyn_lds, blockIdx.x, gridDim.x); }
KB k_norm(Params P, const float* x, int l) { phase_norm(x, P.attn_norm + (size_t)l * kD, (bf16_t*)(P.ws + WS_H), blockIdx.x, gridDim.x); }
KB k_win(Params P, int l) {
    GemmD g; g.A = (const bf16_t*)(P.ws + WS_H); g.Bt = (const bf16_t*)(P.ws + WS_WINT) + (size_t)l * kINW * kD; g.lda = kD; g.K = kD; g.nM = kTok / 256; g.nN = 10; g.rowidx = nullptr; g.bstride = 0; g.pmg = 1 << 30;
    unsigned char* r1 = P.ws + WS_R1;
    EpiQKV E; E.qa = (bf16_t*)(r1 + R1_QA); E.ka = (bf16_t*)(r1 + R1_KA); E.va = (bf16_t*)(r1 + R1_VA); E.qb = (bf16_t*)(r1 + R1_QB); E.kb = (bf16_t*)(r1 + R1_KB); E.vb = (bf16_t*)(r1 + R1_VB); E.ux = (bf16_t*)(r1 + R1_UX);
    E.qna = P.q_norm_a + l * 64; E.kna = P.k_norm_a + l * 64; E.qnb = P.q_norm_b + l * 64; E.knb = P.k_norm_b + l * 64;
    gemm_simple(g, E, blockIdx.x, gridDim.x);
}
KB k_dilated(Params P) { unsigned char* r1 = P.ws + WS_R1; phase_dilated_naive((const bf16_t*)(r1 + R1_QA), (const bf16_t*)(r1 + R1_KA), (const bf16_t*)(r1 + R1_VA), (bf16_t*)(P.ws + WS_R2), (float*)(P.ws + WS_LSE), blockIdx.x, gridDim.x); }
KB k_na(Params P, int l) { unsigned char* r1 = P.ws + WS_R1; phase_na_naive((const bf16_t*)(r1 + R1_QB), (const bf16_t*)(r1 + R1_KB), (const bf16_t*)(r1 + R1_VB), P.rpb + (size_t)l * 4 * 15 * 31, (bf16_t*)(r1 + R1_OB), blockIdx.x, gridDim.x); }
KB k_s5(Params P, int l) { phase_s5_naive(P, l, (const bf16_t*)(P.ws + WS_R1 + R1_UX), (float*)(P.ws + WS_YS), dyn_lds, blockIdx.x, gridDim.x); }
KB k_s5fin(Params P, int l) { phase_s5_finish((const float*)(P.ws + WS_YS), (const bf16_t*)(P.ws + WS_R1 + R1_UX), P.s5_d + l * 256, (bf16_t*)(P.ws + WS_R1 + R1_G), blockIdx.x, gridDim.x); }
KB k_glu(Params P, int l) {
    GemmD g; g.A = (const bf16_t*)(P.ws + WS_R1 + R1_G); g.Bt = (const bf16_t*)(P.ws + WS_WGLUT) + (size_t)l * 256 * 256; g.lda = 256; g.K = 256; g.nM = kTok / 256; g.nN = 1; g.rowidx = nullptr; g.bstride = 0; g.pmg = 1 << 30;
    EpiGlu E; E.g = (const bf16_t*)(P.ws + WS_R1 + R1_G); E.oc = (bf16_t*)(P.ws + WS_R1 + R1_OC);
    gemm_simple(g, E, blockIdx.x, gridDim.x);
}
KB k_mixnorm(Params P, int l) { unsigned char* r1 = P.ws + WS_R1;
    phase_mixnorm((const bf16_t*)(P.ws + WS_R2), (const float*)(P.ws + WS_LSE), (const bf16_t*)(r1 + R1_OB), (const bf16_t*)(r1 + R1_OC), P.out_norm_a + l * 512, P.out_norm_b + l * 256, P.out_norm_c + l * 256, (bf16_t*)(P.ws + WS_H), blockIdx.x, gridDim.x); }
KB k_wout(Params P, const float* xin, int l) {
    GemmD g; g.A = (const bf16_t*)(P.ws + WS_H); g.Bt = (const bf16_t*)(P.ws + WS_WOUTT) + (size_t)l * kD * kD; g.lda = kD; g.K = kD; g.nM = kTok / 256; g.nN = 4; g.rowidx = nullptr; g.bstride = 0; g.pmg = 1 << 30;
    EpiResid E; E.xin = xin; E.xout = P.out;
    gemm_simple(g, E, blockIdx.x, gridDim.x);
}
KB k_router(Params P, int l) { phase_router(P.out, P.ffn_norm + (size_t)l * kD, P.w_router + (size_t)l * kD * kE, (bf16_t*)(P.ws + WS_H), (float*)(P.ws + WS_AFF), dyn_lds, blockIdx.x, gridDim.x); }
KB k_topk(Params P) { phase_topk((const float*)(P.ws + WS_AFF), (int*)(P.ws + WS_IDX), (float*)(P.ws + WS_GATE), (int*)(P.ws + WS_TSLOT), dyn_lds, blockIdx.x, gridDim.x); }
KB k_gu(Params P, int l) {
    GemmD g; g.A = (const bf16_t*)(P.ws + WS_H); g.Bt = (const bf16_t*)(P.ws + WS_WGUT) + (size_t)l * kE * 4096 * kD; g.lda = kD; g.K = kD; g.nM = 512; g.nN = 16; g.rowidx = (const int*)(P.ws + WS_IDX); g.bstride = (size_t)4096 * kD; g.pmg = 32;
    EpiGU E; E.hid = (bf16_t*)(P.ws + WS_R1);
    gemm_simple(g, E, blockIdx.x, gridDim.x);
}
KB k_down(Params P, int l) {
    GemmD g; g.A = (const bf16_t*)(P.ws + WS_R1); g.Bt = (const bf16_t*)(P.ws + WS_WDT) + (size_t)l * kE * kD * kFF; g.lda = kFF; g.K = kFF; g.nM = 512; g.nN = 4; g.rowidx = nullptr; g.bstride = (size_t)kD * kFF; g.pmg = 32;
    EpiDown E; E.y = (bf16_t*)(P.ws + WS_R2); E.gate = (const float*)(P.ws + WS_GATE);
    gemm_simple(g, E, blockIdx.x, gridDim.x);
}
KB k_combine(Params P, int l) { phase_combine(P.out, (const bf16_t*)(P.ws + WS_R2), (const int*)(P.ws + WS_TSLOT), (l + 1 < kL) ? P.attn_norm + (size_t)(l + 1) * kD : nullptr, (bf16_t*)(P.ws + WS_H), blockIdx.x, gridDim.x); }

extern "C" void kernel_launch(void* const* d_in, const int* in_sizes, int n_in, void* d_out, int out_size, void* d_ws, size_t ws_size, hipStream_t stream) {
    (void)in_sizes; (void)n_in; (void)out_size;
    if (ws_size < WS_END) { fprintf(stderr, "workspace too small: %zu < %zu\n", ws_size, (size_t)WS_END); return; }
    Params P{};
    const float** pp = (const float**)&P;
    for (int i = 0; i < 26; ++i) pp[i] = (const float*)d_in[i];
    P.out = (float*)d_out; P.ws = (unsigned char*)d_ws;
    (void)hipFuncSetAttribute((const void*)k_router, hipFuncAttributeMaxDynamicSharedMemorySize, 65536);
    const int G = 1024;
    k_convert<<<G, kNT, 256 * 72 * 2, stream>>>(P);
    k_norm<<<G, kNT, 0, stream>>>(P, P.x, 0);
    for (int l = 0; l < kL; ++l) {
        k_win<<<G, kNT, 0, stream>>>(P, l);
        k_dilated<<<G, kNT, 0, stream>>>(P);
        k_na<<<G, kNT, 0, stream>>>(P, l);
        k_s5<<<32, kNT, 8 * 128 * 4, stream>>>(P, l);
        k_s5fin<<<G, kNT, 0, stream>>>(P, l);
        k_glu<<<256, kNT, 0, stream>>>(P, l);
        k_mixnorm<<<G, kNT, 0, stream>>>(P, l);
        k_wout<<<G, kNT, 0, stream>>>(P, l == 0 ? P.x : P.out, l);
        k_router<<<512, kNT, 65536, stream>>>(P, l);
        k_topk<<<128, kNT, 4096, stream>>>(P);
        k_gu<<<G, kNT, 0, stream>>>(P, l);
        k_down<<<G, kNT, 0, stream>>>(P, l);
        k_combine<<<G, kNT, 0, stream>>>(P, l);
    }
}
```

```cpp
#include <hip/hip_runtime.h>
#include <stdint.h>
#include <stdio.h>

#define DEVI __device__ __forceinline__
typedef unsigned short bf16_t;
typedef short bf16x8 __attribute__((ext_vector_type(8)));
typedef float f32x4 __attribute__((ext_vector_type(4)));
typedef float f32x2 __attribute__((ext_vector_type(2)));
typedef unsigned u32x4 __attribute__((ext_vector_type(4)));
typedef unsigned u32x2 __attribute__((ext_vector_type(2)));

constexpr int kB = 8, kS = 8192, kD = 1024, kL = 4, kTok = kB * kS;
constexpr int kINW = 2560;
constexpr int kE = 16, kCap = 1024, kFF = 2048;
constexpr int kNT = 512;
constexpr float kEps = 1e-6f;

constexpr size_t MiB = 1024ull * 1024ull;
constexpr size_t WS_CTL   = 0;
constexpr size_t WS_WINT  = 1 * MiB;
constexpr size_t WS_WOUTT = WS_WINT + 20 * MiB;
constexpr size_t WS_WGLUT = WS_WOUTT + 8 * MiB;
constexpr size_t WS_WGUT  = WS_WGLUT + 1 * MiB;
constexpr size_t WS_WDT   = WS_WGUT + 512 * MiB;
constexpr size_t WS_H     = WS_WDT + 256 * MiB;
constexpr size_t WS_R1    = WS_H + 128 * MiB;
constexpr size_t WS_R2    = WS_R1 + 512 * MiB;
constexpr size_t WS_AFF   = WS_R2 + 256 * MiB;
constexpr size_t WS_IDX   = WS_AFF + 4 * MiB;
constexpr size_t WS_GATE  = WS_IDX + 1 * MiB;
constexpr size_t WS_TSLOT = WS_GATE + 1 * MiB;
constexpr size_t WS_LSE   = WS_TSLOT + 4 * MiB;
constexpr size_t WS_YS    = WS_LSE + 8 * MiB;
constexpr size_t WS_END   = WS_YS + 128 * MiB;
constexpr size_t R1_QA = 0, R1_KA = 64 * MiB, R1_VA = 128 * MiB, R1_QB = 192 * MiB, R1_KB = 224 * MiB, R1_VB = 256 * MiB,
                 R1_UX = 288 * MiB, R1_OB = 352 * MiB, R1_OC = 384 * MiB, R1_G = 416 * MiB;

struct Params {
    const float* x; const float* attn_norm; const float* w_in; const float* q_norm_a; const float* k_norm_a; const float* q_norm_b; const float* k_norm_b;
    const float* rpb; const float* s5_a_re; const float* s5_a_im; const float* s5_log_dt; const float* s5_b_re; const float* s5_b_im; const float* s5_c_re; const float* s5_c_im;
    const float* s5_d; const float* w_glu; const float* out_norm_a; const float* out_norm_b; const float* out_norm_c; const float* w_out; const float* ffn_norm;
    const float* w_router; const float* w_gate; const float* w_up; const float* w_down;
    float* out; unsigned char* ws;
};

DEVI float bf2f(bf16_t b) { return __uint_as_float(((unsigned)b) << 16); }
DEVI bf16_t f2bf(float f) { unsigned u = __float_as_uint(f); u += 0x7FFFu + ((u >> 16) & 1u); return (bf16_t)(u >> 16); }
DEVI unsigned pk2(float lo, float hi) { return (unsigned)f2bf(lo) | ((unsigned)f2bf(hi) << 16); }
DEVI int tidx() { int t = threadIdx.x; asm volatile("" : "+v"(t)); return t; }
DEVI float wave_sum(float v) {
#pragma unroll
    for (int m = 32; m >= 1; m >>= 1) v += __shfl_xor(v, m);
    return v;
}
DEVI float gelu_tanh(float y) { const float z = 0.7978845608028654f * (y + 0.044715f * y * y * y); const float t = 1.f - 2.f / (1.f + __expf(2.f * z)); return 0.5f * y * (1.f + t); }

DEVI int cmap_head(int cs) { const int bj = cs >> 7, wc = (cs >> 5) & 3, n = (cs >> 4) & 1, fq = (cs >> 2) & 3, j = cs & 3; return 64 * wc + 32 * bj + 8 * fq + 4 * n + j; }
DEVI int cmap_pk(int cs)   { const int bj = cs >> 7, wc = (cs >> 5) & 3, n = (cs >> 4) & 1, fq = (cs >> 2) & 3, j = cs & 3; return 128 * bj + 32 * wc + 8 * fq + 4 * n + j; }
DEVI int cmap_gu(int cs)   { const int wc = (cs >> 5) & 3, n = (cs >> 4) & 1, fq = (cs >> 2) & 3, j = cs & 3; return 32 * wc + 8 * fq + 4 * n + j; }

template <int MODE>
DEVI void convert_item(const float* W0, const float* W1, int ldw, int K, bf16_t* Bt, int kt, int pn, unsigned char* lds) {
    bf16_t* t = (bf16_t*)lds;
    const int tid = tidx();
#pragma unroll 4
    for (int it = 0; it < 32; ++it) {
        const int e = it * kNT + tid, k = e >> 8, cs = e & 255;
        float v;
        if (MODE == 0) v = W0[(size_t)(kt * 64 + k) * ldw + pn * 256 + cs];
        else if (MODE == 1) v = W0[(size_t)(kt * 64 + k) * ldw + pn * 256 + cmap_head(cs)];
        else if (MODE == 2) v = W0[(size_t)(kt * 64 + k) * ldw + pn * 256 + cmap_pk(cs)];
        else v = ((cs >> 7) ? W1 : W0)[(size_t)(kt * 64 + k) * ldw + pn * 128 + cmap_gu(cs)];
        t[cs * 72 + k] = f2bf(v);
    }
    __syncthreads();
#pragma unroll
    for (int it = 0; it < 4; ++it) {
        const int c = it * kNT + tid, row = c >> 3, part = c & 7;
        const u32x4 v = *(const u32x4*)(t + row * 72 + part * 8);
        *(u32x4*)(Bt + (size_t)(pn * 256 + row) * K + kt * 64 + part * 8) = v;
    }
    __syncthreads();
}

DEVI void phase_convert(const Params& P, unsigned char* lds, int bid, int nblk) {
    constexpr int N_WIN = kL * 16 * 10, N_WOUT = kL * 16 * 4, N_WGLU = kL * 4 * 1, N_WGU = kL * kE * 16 * 16, N_WD = kL * kE * 32 * 4;
    constexpr int TOT = N_WIN + N_WOUT + N_WGLU + N_WGU + N_WD;
    for (int it = bid; it < TOT; it += nblk) {
        int i = it;
        if (i < N_WIN) { const int l = i / 160, r = i % 160, kt = r / 10, pn = r % 10;
            convert_item<1>(P.w_in + (size_t)l * kD * kINW, nullptr, kINW, kD, (bf16_t*)(P.ws + WS_WINT) + (size_t)l * kINW * kD, kt, pn, lds); continue; }
        i -= N_WIN;
        if (i < N_WOUT) { const int l = i / 64, r = i % 64, kt = r / 4, pn = r % 4;
            convert_item<0>(P.w_out + (size_t)l * kD * kD, nullptr, kD, kD, (bf16_t*)(P.ws + WS_WOUTT) + (size_t)l * kD * kD, kt, pn, lds); continue; }
        i -= N_WOUT;
        if (i < N_WGLU) { const int l = i / 4, kt = i % 4;
            convert_item<2>(P.w_glu + (size_t)l * 256 * 256, nullptr, 256, 256, (bf16_t*)(P.ws + WS_WGLUT) + (size_t)l * 256 * 256, kt, 0, lds); continue; }
        i -= N_WGLU;
        if (i < N_WGU) { const int le = i / 256, r = i % 256, kt = r / 16, pn = r % 16;
            convert_item<3>(P.w_gate + (size_t)le * kD * kFF, P.w_up + (size_t)le * kD * kFF, kFF, kD, (bf16_t*)(P.ws + WS_WGUT) + (size_t)le * 4096 * kD, kt, pn, lds); continue; }
        i -= N_WGU;
        { const int le = i / 128, r = i % 128, kt = r / 4, pn = r % 4;
            convert_item<2>(P.w_down + (size_t)le * kFF * kD, nullptr, kD, kFF, (bf16_t*)(P.ws + WS_WDT) + (size_t)le * kD * kFF, kt, pn, lds); }
    }
}

DEVI void phase_norm(const float* x, const float* gain, bf16_t* h, int bid, int nblk) {
    const int wid = tidx() >> 6, lane = tidx() & 63;
    f32x4 g[4];
#pragma unroll
    for (int q = 0; q < 4; ++q) g[q] = *(const f32x4*)(gain + q * 256 + lane * 4);
    for (int row = bid * 8 + wid; row < kTok; row += nblk * 8) {
        f32x4 v[4]; float ss = 0.f;
#pragma unroll
        for (int q = 0; q < 4; ++q) { v[q] = *(const f32x4*)(x + (size_t)row * kD + q * 256 + lane * 4); ss += v[q].x * v[q].x + v[q].y * v[q].y + v[q].z * v[q].z + v[q].w * v[q].w; }
        ss = wave_sum(ss);
        const float rstd = rsqrtf(ss * (1.f / kD) + kEps);
#pragma unroll
        for (int q = 0; q < 4; ++q) { u32x2 o; o.x = pk2(v[q].x * rstd * g[q].x, v[q].y * rstd * g[q].y); o.y = pk2(v[q].z * rstd * g[q].z, v[q].w * rstd * g[q].w);
            *(u32x2*)(h + (size_t)row * kD + q * 256 + lane * 4) = o; }
    }
}

DEVI void phase_router(const float* x, const float* gain, const float* wr  , bf16_t* h, float* aff, unsigned char* lds, int bid, int nblk) {
    float* wT = (float*)lds;
    for (int i = tidx(); i < 16 * 1024; i += kNT) { const int k = i >> 4, e = i & 15; wT[e * 1024 + k] = wr[i]; }
    __syncthreads();
    const int wid = tidx() >> 6, lane = tidx() & 63;
    f32x4 g[4];
#pragma unroll
    for (int q = 0; q < 4; ++q) g[q] = *(const f32x4*)(gain + q * 256 + lane * 4);
    for (int row0 = (bid * 8 + wid) * 2; row0 < kTok; row0 += nblk * 8 * 2) {
        asm volatile("" ::: "memory");
        f32x4 v[2][4];
#pragma unroll
        for (int r = 0; r < 2; ++r) { float ss = 0.f;
#pragma unroll
            for (int q = 0; q < 4; ++q) { v[r][q] = *(const f32x4*)(x + (size_t)(row0 + r) * kD + q * 256 + lane * 4); ss += v[r][q].x * v[r][q].x + v[r][q].y * v[r][q].y + v[r][q].z * v[r][q].z + v[r][q].w * v[r][q].w; }
            ss = wave_sum(ss); const float rstd = rsqrtf(ss * (1.f / kD) + kEps);
#pragma unroll
            for (int q = 0; q < 4; ++q) { v[r][q] = v[r][q] * rstd * g[q];
                u32x2 o; o.x = pk2(v[r][q].x, v[r][q].y); o.y = pk2(v[r][q].z, v[r][q].w);
                *(u32x2*)(h + (size_t)(row0 + r) * kD + q * 256 + lane * 4) = o; }
        }
        float pa[32];
#pragma unroll
        for (int e = 0; e < 16; ++e) {
            float s0 = 0.f, s1 = 0.f;
#pragma unroll
            for (int q = 0; q < 4; ++q) { const f32x4 w = *(const f32x4*)(wT + e * 1024 + q * 256 + lane * 4);
                s0 += v[0][q].x * w.x + v[0][q].y * w.y + v[0][q].z * w.z + v[0][q].w * w.w;
                s1 += v[1][q].x * w.x + v[1][q].y * w.y + v[1][q].z * w.z + v[1][q].w * w.w; }
            pa[e] = s0; pa[16 + e] = s1;
        }
#define RS_STEP(HALF, MASK) { const bool up = (lane & (MASK)) != 0; _Pragma("unroll") for (int i = 0; i < (HALF); ++i) { const float keep = up ? pa[i + (HALF)] : pa[i], send = up ? pa[i] : pa[i + (HALF)]; pa[i] = keep + __shfl_xor(send, (MASK)); } }
        RS_STEP(16, 32) RS_STEP(8, 16) RS_STEP(4, 8) RS_STEP(2, 4) RS_STEP(1, 2)
#undef RS_STEP
        const float logit = pa[0] + __shfl_xor(pa[0], 1);
        float mx = logit;
#pragma unroll
        for (int m = 16; m >= 2; m >>= 1) mx = fmaxf(mx, __shfl_xor(mx, m));
        const float ex = __expf(logit - mx);
        float sm = ex;
#pragma unroll
        for (int m = 16; m >= 2; m >>= 1) sm += __shfl_xor(sm, m);
        const int row = row0 + (lane >> 5), e = (lane >> 1) & 15, b = row >> 13, s = row & (kS - 1);
        if (!(lane & 1)) aff[((size_t)(b * kE + e)) * kS + s] = ex / sm;
    }
    __syncthreads();
}

DEVI int block_excl_scan(int v, int* sh  , int& total) {
    const int lane = tidx() & 63, wid = tidx() >> 6;
    int incl = v;
#pragma unroll
    for (int d = 1; d < 64; d <<= 1) { const int o = __shfl_up(incl, d); if (lane >= d) incl += o; }
    __syncthreads();
    if (lane == 63) sh[wid] = incl;
    __syncthreads();
    int base = 0, tot = 0;
#pragma unroll
    for (int w = 0; w < 8; ++w) { const int c = sh[w]; if (w < wid) base += c; tot += c; }
    total = tot;
    return base + incl - v;
}

DEVI void phase_topk(const float* aff, int* idx, float* gate, int* tokslot, unsigned char* lds, int bid, int nblk) {
    int* hist = (int*)lds;
    int* sh = hist + 256;
    int* res = sh + 16;
    const int tid = tidx(), lane = tid & 63, wid = tid >> 6;
    for (int item = bid; item < kB * kE; item += nblk) {
        const int b = item >> 4, e = item & 15;
        const float* a = aff + (size_t)item * kS;
        unsigned key[16];
#pragma unroll
        for (int q = 0; q < 4; ++q) { const u32x4 v = *(const u32x4*)(a + tid * 16 + q * 4); key[q * 4 + 0] = v.x; key[q * 4 + 1] = v.y; key[q * 4 + 2] = v.z; key[q * 4 + 3] = v.w; }
        unsigned prefix = 0; int kk = kCap;
#pragma unroll 1
        for (int pass = 0; pass < 4; ++pass) {
            const int shift = 24 - 8 * pass;
            __syncthreads();
            if (tid < 256) hist[tid] = 0;
            __syncthreads();
#pragma unroll
            for (int i = 0; i < 16; ++i) { const bool in = (pass == 0) || ((key[i] >> (shift + 8)) == prefix); if (in) atomicAdd(&hist[(key[i] >> shift) & 255], 1); }
            __syncthreads();
            if (wid == 0) {
                int c[4], loc = 0;
#pragma unroll
                for (int j = 0; j < 4; ++j) { c[j] = hist[255 - 4 * lane - j]; loc += c[j]; }
                int incl = loc;
#pragma unroll
                for (int d = 1; d < 64; d <<= 1) { const int o = __shfl_up(incl, d); if (lane >= d) incl += o; }
                const int excl = incl - loc;
                if (excl < kk && kk <= incl) { int run = excl; int bin = 0, nk = 0; bool found = false;
#pragma unroll
                    for (int j = 0; j < 4; ++j) { if (!found && run + c[j] >= kk) { bin = 255 - 4 * lane - j; nk = kk - run; found = true; } if (!found) run += c[j]; }
                    res[0] = bin; res[1] = nk; }
            }
            __syncthreads();
            prefix = (prefix << 8) | (unsigned)res[0]; kk = res[1];
        }
        const unsigned T = prefix;
        int ceq = 0;
#pragma unroll
        for (int i = 0; i < 16; ++i) ceq += (key[i] == T) ? 1 : 0;
        int tot;
        int eqb = block_excl_scan(ceq, sh, tot);
        int csel = 0; unsigned selmask = 0;
#pragma unroll
        for (int i = 0; i < 16; ++i) { bool s = key[i] > T; if (key[i] == T) { s = eqb < kk; ++eqb; } if (s) { selmask |= 1u << i; ++csel; } }
        int slot = block_excl_scan(csel, sh, tot);
        const size_t rbase = (size_t)(e * kB + b) * kCap;
#pragma unroll
        for (int i = 0; i < 16; ++i) { const int s = tid * 16 + i; const bool sel = (selmask >> i) & 1u;
            if (sel) { idx[rbase + slot] = b * kS + s; gate[rbase + slot] = __uint_as_float(key[i]); }
            tokslot[((size_t)(b * kS + s)) * kE + e] = sel ? slot : -1;
            if (sel) ++slot; }
    }
    __syncthreads();
}

struct Unit { int pm, pn; };
DEVI bool unit_of(int Lid, int nM, int nN, Unit& u) {
    const int nwg = nM * nN; if (Lid >= nwg) return false;
    int wgid = Lid; { const int q = nwg / 8, r = nwg % 8, xcd = wgid % 8, off = wgid / 8; wgid = (xcd < r ? xcd * (q + 1) : r * (q + 1) + (xcd - r) * q) + off; }
    const int nig = 8 * nN, gid = wgid / nig, fm = gid * 8, gsz = (nM - fm) < 8 ? (nM - fm) : 8;
    u.pm = fm + ((wgid % nig) % gsz); u.pn = (wgid % nig) / gsz; return true;
}
struct GemmD { const bf16_t* A; const bf16_t* Bt; int lda, K, nM, nN; const int* rowidx; size_t bstride; int pmg; };

template <class Epi>
DEVI void gemm_simple(const GemmD g, const Epi& E, int bid, int nblk) {
    const int tid = tidx(), wid = tid >> 6, lane = tid & 63, wr = wid >> 2, wc = wid & 3, fr = lane & 15, fq = lane >> 4;
    for (int i = 0;; ++i) {
        Unit u; if (!unit_of(i * nblk + bid, g.nM, g.nN, u)) break;
        f32x4 acc[2][2][4][2];
#pragma unroll
        for (int a = 0; a < 2; ++a)
#pragma unroll
            for (int b = 0; b < 2; ++b)
#pragma unroll
                for (int m = 0; m < 4; ++m)
#pragma unroll
                    for (int n = 0; n < 2; ++n) acc[a][b][m][n] = (f32x4){0.f, 0.f, 0.f, 0.f};
        const bf16_t* Bu = g.Bt + (size_t)(u.pm / g.pmg) * g.bstride + (size_t)u.pn * 256 * g.K;
        unsigned ao[2][4], bo[2][2];
#pragma unroll
        for (int a = 0; a < 2; ++a)
#pragma unroll
            for (int m = 0; m < 4; ++m) { const int r = u.pm * 256 + 128 * a + 64 * wr + 16 * m + fr; const unsigned rr = g.rowidx ? (unsigned)g.rowidx[r] : (unsigned)r; ao[a][m] = rr * (unsigned)g.lda + 8u * fq; }
#pragma unroll
        for (int b = 0; b < 2; ++b)
#pragma unroll
            for (int n = 0; n < 2; ++n) bo[b][n] = (unsigned)(128 * b + 32 * wc + 16 * n + fr) * (unsigned)g.K + 8u * fq;
#pragma unroll 1
        for (int k0 = 0; k0 < g.K; k0 += 32) {
            bf16x8 av[2][4], bv[2][2];
#pragma unroll
            for (int a = 0; a < 2; ++a)
#pragma unroll
                for (int m = 0; m < 4; ++m) av[a][m] = *(const bf16x8*)(g.A + ao[a][m] + k0);
#pragma unroll
            for (int b = 0; b < 2; ++b)
#pragma unroll
                for (int n = 0; n < 2; ++n) bv[b][n] = *(const bf16x8*)(Bu + bo[b][n] + k0);
#pragma unroll
            for (int a = 0; a < 2; ++a)
#pragma unroll
                for (int b = 0; b < 2; ++b)
#pragma unroll
                    for (int m = 0; m < 4; ++m)
#pragma unroll
                        for (int n = 0; n < 2; ++n) acc[a][b][m][n] = __builtin_amdgcn_mfma_f32_16x16x32_bf16(bv[b][n], av[a][m], acc[a][b][m][n], 0, 0, 0);
        }
        E(acc, u, wr, wc, fr, fq);
    }
}

struct EpiQKV {
    bf16_t *qa, *ka, *va, *qb, *kb, *vb, *ux; const float *qna, *kna, *qnb, *knb;
    DEVI void operator()(const f32x4 (&acc)[2][2][4][2], const Unit& u, int wr, int wc, int fr, int fq) const {
        bf16_t* dst; const float* gn = nullptr; int H = 8, head0 = 0; const int pn = u.pn;
        if (pn < 2) { dst = qa; gn = qna; head0 = pn * 4; }
        else if (pn < 4) { dst = ka; gn = kna; head0 = (pn - 2) * 4; }
        else if (pn < 6) { dst = va; head0 = (pn - 4) * 4; }
        else if (pn == 6) { dst = qb; gn = qnb; H = 4; }
        else if (pn == 7) { dst = kb; gn = knb; H = 4; }
        else if (pn == 8) { dst = vb; H = 4; }
        else { dst = ux; }
        const int head = head0 + wc;
        f32x4 gv[2][2];
#pragma unroll
        for (int bj = 0; bj < 2; ++bj)
#pragma unroll
            for (int n = 0; n < 2; ++n) gv[bj][n] = gn ? *(const f32x4*)(gn + 32 * bj + 8 * fq + 4 * n) : (f32x4){1.f, 1.f, 1.f, 1.f};
#pragma unroll
        for (int ai = 0; ai < 2; ++ai)
#pragma unroll
            for (int m = 0; m < 4; ++m) {
                const int row = u.pm * 256 + 128 * ai + 64 * wr + 16 * m + fr;
                float rstd = 1.f;
                if (gn) { float ss = 0.f;
#pragma unroll
                    for (int bj = 0; bj < 2; ++bj)
#pragma unroll
                        for (int n = 0; n < 2; ++n) { const f32x4 v = acc[ai][bj][m][n]; ss += v.x * v.x + v.y * v.y + v.z * v.z + v.w * v.w; }
                    ss += __shfl_xor(ss, 16); ss += __shfl_xor(ss, 32);
                    rstd = rsqrtf(ss * (1.f / 64.f) + kEps); }
#pragma unroll
                for (int bj = 0; bj < 2; ++bj) {
                    const f32x4 v0 = acc[ai][bj][m][0] * rstd * gv[bj][0], v1 = acc[ai][bj][m][1] * rstd * gv[bj][1];
                    u32x4 w; w.x = pk2(v0.x, v0.y); w.y = pk2(v0.z, v0.w); w.z = pk2(v1.x, v1.y); w.w = pk2(v1.z, v1.w);
                    if (pn < 9) { const int b = row >> 13, s = row & (kS - 1);
                        *(u32x4*)(dst + (((size_t)(b * H + head)) * kS + s) * 64 + 32 * bj + 8 * fq) = w; }
                    else { const int gidx = 4 * wc + 2 * bj + (fq >> 1), c0 = 8 * (fq & 1);
                        *(u32x4*)(dst + ((size_t)gidx * 4096 + (row >> 4)) * 512 + (row & 15) * 16 + c0) = w; }
                }
            }
    }
};
struct EpiResid {
    const float* xin; float* xout;
    DEVI void operator()(const f32x4 (&acc)[2][2][4][2], const Unit& u, int wr, int wc, int fr, int fq) const {
#pragma unroll
        for (int ai = 0; ai < 2; ++ai)
#pragma unroll
            for (int m = 0; m < 4; ++m) { const size_t ro = (size_t)(u.pm * 256 + 128 * ai + 64 * wr + 16 * m + fr) * kD + u.pn * 256 + 32 * wc + 4 * fq;
#pragma unroll
                for (int bj = 0; bj < 2; ++bj)
#pragma unroll
                    for (int n = 0; n < 2; ++n) { const size_t o = ro + 128 * bj + 16 * n; *(f32x4*)(xout + o) = *(const f32x4*)(xin + o) + acc[ai][bj][m][n]; } }
    }
};
struct EpiGU {
    bf16_t* hid;
    DEVI void operator()(const f32x4 (&acc)[2][2][4][2], const Unit& u, int wr, int wc, int fr, int fq) const {
#pragma unroll
        for (int ai = 0; ai < 2; ++ai)
#pragma unroll
            for (int m = 0; m < 4; ++m) { const size_t row = (size_t)(u.pm * 256 + 128 * ai + 64 * wr + 16 * m + fr);
                float o[8];
#pragma unroll
                for (int n = 0; n < 2; ++n)
#pragma unroll
                    for (int j = 0; j < 4; ++j) { const float gt = acc[ai][0][m][n][j], up = acc[ai][1][m][n][j]; o[n * 4 + j] = gt / (1.f + __expf(-gt)) * up; }
                u32x4 w; w.x = pk2(o[0], o[1]); w.y = pk2(o[2], o[3]); w.z = pk2(o[4], o[5]); w.w = pk2(o[6], o[7]);
                *(u32x4*)(hid + row * kFF + u.pn * 128 + 32 * wc + 8 * fq) = w; }
    }
};
struct EpiDown {
    bf16_t* y; const float* gate;
    DEVI void operator()(const f32x4 (&acc)[2][2][4][2], const Unit& u, int wr, int wc, int fr, int fq) const {
#pragma unroll
        for (int ai = 0; ai < 2; ++ai)
#pragma unroll
            for (int m = 0; m < 4; ++m) { const size_t row = (size_t)(u.pm * 256 + 128 * ai + 64 * wr + 16 * m + fr); const float gv = gate[row];
#pragma unroll
                for (int bj = 0; bj < 2; ++bj) { const f32x4 v0 = acc[ai][bj][m][0] * gv, v1 = acc[ai][bj][m][1] * gv;
                    u32x4 w; w.x = pk2(v0.x, v0.y); w.y = pk2(v0.z, v0.w); w.z = pk2(v1.x, v1.y); w.w = pk2(v1.z, v1.w);
                    *(u32x4*)(y + row * kD + u.pn * 256 + 128 * bj + 32 * wc + 8 * fq) = w; } }
    }
};
struct EpiGlu {
    const bf16_t* g; bf16_t* oc;
    DEVI void operator()(const f32x4 (&acc)[2][2][4][2], const Unit& u, int wr, int wc, int fr, int fq) const {
#pragma unroll
        for (int ai = 0; ai < 2; ++ai)
#pragma unroll
            for (int m = 0; m < 4; ++m) { const size_t row = (size_t)(u.pm * 256 + 128 * ai + 64 * wr + 16 * m + fr);
#pragma unroll
                for (int bj = 0; bj < 2; ++bj) { const size_t o = row * 256 + 128 * bj + 32 * wc + 8 * fq;
                    const u32x4 gw = *(const u32x4*)(g + o); float o8[8];
#pragma unroll
                    for (int n = 0; n < 2; ++n)
#pragma unroll
                        for (int j = 0; j < 4; ++j) { const int t = n * 4 + j; const unsigned wv = (t < 2) ? gw.x : (t < 4) ? gw.y : (t < 6) ? gw.z : gw.w;
                            const float gg = __uint_as_float((t & 1) ? (wv & 0xFFFF0000u) : (wv << 16)); o8[t] = gg / (1.f + __expf(-acc[ai][bj][m][n][j])); }
                    u32x4 w; w.x = pk2(o8[0], o8[1]); w.y = pk2(o8[2], o8[3]); w.z = pk2(o8[4], o8[5]); w.w = pk2(o8[6], o8[7]);
                    *(u32x4*)(oc + o) = w; } }
    }
};

DEVI void load_row64(const bf16_t* p, float* d) {
#pragma unroll
    for (int i = 0; i < 8; ++i) { const u32x4 v = *(const u32x4*)(p + i * 8);
        d[i * 8 + 0] = __uint_as_float(v.x << 16); d[i * 8 + 1] = __uint_as_float(v.x & 0xFFFF0000u); d[i * 8 + 2] = __uint_as_float(v.y << 16); d[i * 8 + 3] = __uint_as_float(v.y & 0xFFFF0000u);
        d[i * 8 + 4] = __uint_as_float(v.z << 16); d[i * 8 + 5] = __uint_as_float(v.z & 0xFFFF0000u); d[i * 8 + 6] = __uint_as_float(v.w << 16); d[i * 8 + 7] = __uint_as_float(v.w & 0xFFFF0000u); }
}
DEVI void store_row64(bf16_t* p, const float* d, float sc) {
#pragma unroll
    for (int i = 0; i < 8; ++i) { u32x4 w; w.x = pk2(d[i * 8] * sc, d[i * 8 + 1] * sc); w.y = pk2(d[i * 8 + 2] * sc, d[i * 8 + 3] * sc); w.z = pk2(d[i * 8 + 4] * sc, d[i * 8 + 5] * sc); w.w = pk2(d[i * 8 + 6] * sc, d[i * 8 + 7] * sc);
        *(u32x4*)(p + i * 8) = w; }
}
DEVI void phase_dilated_naive(const bf16_t* qa, const bf16_t* ka, const bf16_t* va, bf16_t* oac, float* lse, int bid, int nblk) {
    const int nitems = 3 * kB * 8 * (kS / kNT);
    for (int it = bid; it < nitems; it += nblk) {
        const int c = it / (kB * 8 * 16), r = it % (kB * 8 * 16), bh = r / 16, t = (r % 16) * kNT + tidx(), b = bh >> 3, h = bh & 7;
        const int dil = (c == 0) ? 1 : (c == 1) ? 4 : 16;
        const float slope = exp2f(-(float)(h + 1));
        const bf16_t* kb_ = ka + (size_t)bh * kS * 64; const bf16_t* vb_ = va + (size_t)bh * kS * 64;
        float q[64], o[64];
        load_row64(qa + ((size_t)bh * kS + t) * 64, q);
#pragma unroll
        for (int d = 0; d < 64; ++d) o[d] = 0.f;
        float m = -1e30f, l = 0.f;
        for (int rel = -64; rel <= 64; ++rel) {
            const int pos = t + rel * dil;
            if (pos < 0 || pos >= kS) continue;
            float kv[64]; load_row64(kb_ + (size_t)pos * 64, kv);
            float dot = 0.f;
#pragma unroll
            for (int d = 0; d < 64; ++d) dot += q[d] * kv[d];
            const float sc = dot * 0.125f - slope * (float)(dil * (rel < 0 ? -rel : rel));
            const float mn = fmaxf(m, sc), corr = __expf(m - mn), p = __expf(sc - mn);
            load_row64(vb_ + (size_t)pos * 64, kv);
            l = l * corr + p;
#pragma unroll
            for (int d = 0; d < 64; ++d) o[d] = o[d] * corr + p * kv[d];
            m = mn;
        }
        const size_t tok = (size_t)b * kS + t;
        store_row64(oac + ((size_t)c * kTok + tok) * 512 + h * 64, o, 1.f / l);
        lse[((size_t)c * kTok + tok) * 8 + h] = m + __logf(l);
    }
}
DEVI void phase_na_naive(const bf16_t* qb, const bf16_t* kbuf, const bf16_t* vbuf, const float* rpb  , bf16_t* ob, int bid, int nblk) {
    const int nitems = kB * 4 * (kS / kNT);
    for (int it = bid; it < nitems; it += nblk) {
        const int bh = it / 16, t = (it % 16) * kNT + tidx(), b = bh >> 2, h = bh & 3;
        const int r = t >> 6, cq = t & 63;
        int rs = r - 4; rs = rs < 0 ? 0 : (rs > 120 ? 120 : rs);
        int cs = cq - 8; cs = cs < 0 ? 0 : (cs > 48 ? 48 : cs);
        const bf16_t* kb_ = kbuf + (size_t)bh * kS * 64; const bf16_t* vb_ = vbuf + (size_t)bh * kS * 64;
        float q[64], o[64];
        load_row64(qb + ((size_t)bh * kS + t) * 64, q);
#pragma unroll
        for (int d = 0; d < 64; ++d) o[d] = 0.f;
        float m = -1e30f, l = 0.f;
        for (int kr = 0; kr < 8; ++kr)
            for (int kc = 0; kc < 16; ++kc) {
                const int krow = rs + kr, kcol = cs + kc, pos = krow * 64 + kcol;
                float kv[64]; load_row64(kb_ + (size_t)pos * 64, kv);
                float dot = 0.f;
#pragma unroll
                for (int d = 0; d < 64; ++d) dot += q[d] * kv[d];
                const float sc = dot * 0.125f + rpb[(h * 15 + (krow - r + 7)) * 31 + (kcol - cq + 15)];
                const float mn = fmaxf(m, sc), corr = __expf(m - mn), p = __expf(sc - mn);
                load_row64(vb_ + (size_t)pos * 64, kv);
                l = l * corr + p;
#pragma unroll
                for (int d = 0; d < 64; ++d) o[d] = o[d] * corr + p * kv[d];
                m = mn;
            }
        store_row64(ob + ((size_t)b * kS + t) * 256 + h * 64, o, 1.f / l);
    }
}
DEVI void phase_s5_naive(const Params& P, int l, const bf16_t* ux, float* ys, unsigned char* lds, int bid, int nblk) {
    const int wid = tidx() >> 6, lane = tidx() & 63;
    float* xs = (float*)lds + wid * 128;
    for (int item = wid * nblk + bid; item < kB * 16 * 2; item += nblk * 8) {
        const int dir = item & 1, g = (item >> 1) & 15, b = item >> 5;
        const size_t pbase = (((size_t)l * 2 + dir) * 16 + g) * 64;
        const float dt = __expf(P.s5_log_dt[((size_t)l * 2 + dir) * 16 + g]);
        const float a = fminf(P.s5_a_re[pbase + lane], -1e-4f), w = P.s5_a_im[pbase + lane];
        const float mag = __expf(a * dt), ar = mag * cosf(w * dt), ai = mag * sinf(w * dt);
        const float den = a * a + w * w, zr = ar - 1.f, gr = (zr * a + ai * w) / den, gi = (ai * a - zr * w) / den;
        float bbr[16], bbi[16];
#pragma unroll
        for (int c = 0; c < 16; ++c) { const float br = P.s5_b_re[(pbase + lane) * 16 + c], bi = P.s5_b_im[(pbase + lane) * 16 + c]; bbr[c] = gr * br - gi * bi; bbi[c] = gr * bi + gi * br; }
        const int cch = lane & 15, qt = lane >> 4;
        float cre[16], cim[16];
#pragma unroll
        for (int pp = 0; pp < 16; ++pp) { cre[pp] = P.s5_c_re[(pbase / 64 * 16 + cch) * 64 + qt * 16 + pp]; cim[pp] = P.s5_c_im[(pbase / 64 * 16 + cch) * 64 + qt * 16 + pp]; }
        float xr = 0.f, xi = 0.f;
        const bf16_t* ug = ux + (size_t)g * 4096 * 512;
        for (int st = 0; st < kS; ++st) {
            const int s = dir ? (kS - 1 - st) : st; const size_t tok = (size_t)b * kS + s;
            const bf16_t* up = ug + (tok >> 4) * 512 + (tok & 15) * 16;
            const u32x4 u0 = *(const u32x4*)up, u1 = *(const u32x4*)(up + 8);
            float uv[16];
            uv[0] = __uint_as_float(u0.x << 16); uv[1] = __uint_as_float(u0.x & 0xFFFF0000u); uv[2] = __uint_as_float(u0.y << 16); uv[3] = __uint_as_float(u0.y & 0xFFFF0000u);
            uv[4] = __uint_as_float(u0.z << 16); uv[5] = __uint_as_float(u0.z & 0xFFFF0000u); uv[6] = __uint_as_float(u0.w << 16); uv[7] = __uint_as_float(u0.w & 0xFFFF0000u);
            uv[8] = __uint_as_float(u1.x << 16); uv[9] = __uint_as_float(u1.x & 0xFFFF0000u); uv[10] = __uint_as_float(u1.y << 16); uv[11] = __uint_as_float(u1.y & 0xFFFF0000u);
            uv[12] = __uint_as_float(u1.z << 16); uv[13] = __uint_as_float(u1.z & 0xFFFF0000u); uv[14] = __uint_as_float(u1.w << 16); uv[15] = __uint_as_float(u1.w & 0xFFFF0000u);
            float bur = 0.f, bui = 0.f;
#pragma unroll
            for (int c = 0; c < 16; ++c) { bur += bbr[c] * uv[c]; bui += bbi[c] * uv[c]; }
            const float nr = ar * xr - ai * xi + bur, ni = ar * xi + ai * xr + bui; xr = nr; xi = ni;
            xs[lane] = xr; xs[64 + lane] = xi;
            asm volatile("s_waitcnt lgkmcnt(0)" ::: "memory");
            float y = 0.f;
#pragma unroll
            for (int pp = 0; pp < 16; ++pp) y += cre[pp] * xs[qt * 16 + pp] - cim[pp] * xs[64 + qt * 16 + pp];
            asm volatile("s_waitcnt lgkmcnt(0)" ::: "memory");
            y += __shfl_xor(y, 16); y += __shfl_xor(y, 32);
            if (lane < 16) ys[((size_t)dir * kTok + tok) * 256 + g * 16 + cch] = y;
        }
    }
}
DEVI void phase_s5_finish(const float* ys, const bf16_t* ux, const float* dskip, bf16_t* G, int bid, int nblk) {
    for (size_t i = (size_t)bid * kNT + tidx(); i < (size_t)kTok * 256; i += (size_t)nblk * kNT) {
        const size_t tok = i >> 8; const int ch = (int)(i & 255), g = ch >> 4, c = ch & 15;
        const float u = bf2f(ux[((size_t)g * 4096 + (tok >> 4)) * 512 + (tok & 15) * 16 + c]);
        const float y = ys[i] + ys[(size_t)kTok * 256 + i] + dskip[ch] * u;
        G[i] = f2bf(gelu_tanh(y));
    }
}
DEVI void phase_mixnorm(const bf16_t* oac, const float* lse, const bf16_t* ob, const bf16_t* oc, const float* ga, const float* gb, const float* gc, bf16_t* mix, int bid, int nblk) {
    const int wid = tidx() >> 6, lane = tidx() & 63;
    float gn[16];
    { const float* gp = (lane < 32) ? ga + lane * 16 : (lane < 48) ? gb + (lane - 32) * 16 : gc + (lane - 48) * 16;
#pragma unroll
      for (int i = 0; i < 16; ++i) gn[i] = gp[i]; }
    for (int row = bid * 8 + wid; row < kTok; row += nblk * 8) {
        float v[16];
        if (lane < 32) {
            const int h = lane >> 2;
            const float l0 = lse[(size_t)row * 8 + h], l1 = lse[((size_t)kTok + row) * 8 + h], l2 = lse[((size_t)2 * kTok + row) * 8 + h];
            const float mx = fmaxf(l0, fmaxf(l1, l2)); float w0 = __expf(l0 - mx), w1 = __expf(l1 - mx), w2 = __expf(l2 - mx); const float inv = 1.f / (w0 + w1 + w2); w0 *= inv; w1 *= inv; w2 *= inv;
#pragma unroll
            for (int i = 0; i < 16; ++i) v[i] = 0.f;
#pragma unroll
            for (int c = 0; c < 3; ++c) { const float wc_ = (c == 0) ? w0 : (c == 1) ? w1 : w2; const bf16_t* p = oac + ((size_t)c * kTok + row) * 512 + lane * 16;
#pragma unroll
                for (int i = 0; i < 16; ++i) v[i] += wc_ * bf2f(p[i]); }
        } else {
            const bf16_t* p = (lane < 48) ? ob + (size_t)row * 256 + (lane - 32) * 16 : oc + (size_t)row * 256 + (lane - 48) * 16;
#pragma unroll
            for (int i = 0; i < 16; ++i) v[i] = bf2f(p[i]);
        }
        float ss = 0.f;
#pragma unroll
        for (int i = 0; i < 16; ++i) ss += v[i] * v[i];
#pragma unroll
        for (int m = 1; m <= 8; m <<= 1) ss += __shfl_xor(ss, m);
        const float o16 = __shfl_xor(ss, 16);
        if (lane < 32) ss += o16;
        const float rstd = rsqrtf(ss * ((lane < 32) ? (1.f / 512.f) : (1.f / 256.f)) + kEps);
        u32x4 w0, w1;
        w0.x = pk2(v[0] * rstd * gn[0], v[1] * rstd * gn[1]); w0.y = pk2(v[2] * rstd * gn[2], v[3] * rstd * gn[3]); w0.z = pk2(v[4] * rstd * gn[4], v[5] * rstd * gn[5]); w0.w = pk2(v[6] * rstd * gn[6], v[7] * rstd * gn[7]);
        w1.x = pk2(v[8] * rstd * gn[8], v[9] * rstd * gn[9]); w1.y = pk2(v[10] * rstd * gn[10], v[11] * rstd * gn[11]); w1.z = pk2(v[12] * rstd * gn[12], v[13] * rstd * gn[13]); w1.w = pk2(v[14] * rstd * gn[14], v[15] * rstd * gn[15]);
        *(u32x4*)(mix + (size_t)row * kD + lane * 16) = w0; *(u32x4*)(mix + (size_t)row * kD + lane * 16 + 8) = w1;
    }
}
DEVI void phase_combine(float* x, const bf16_t* y, const int* tokslot, const float* gain_next, bf16_t* h, int bid, int nblk) {
    const int wid = tidx() >> 6, lane = tidx() & 63;
    f32x4 g[4];
#pragma unroll
    for (int q = 0; q < 4; ++q) g[q] = gain_next ? *(const f32x4*)(gain_next + q * 256 + lane * 4) : (f32x4){0.f, 0.f, 0.f, 0.f};
    for (int row = bid * 8 + wid; row < kTok; row += nblk * 8) {
        const int b = row >> 13;
        const int ts = tokslot[(size_t)row * kE + (lane & 15)];
        f32x4 v[4];
#pragma unroll
        for (int q = 0; q < 4; ++q) v[q] = *(const f32x4*)(x + (size_t)row * kD + q * 256 + lane * 4);
#pragma unroll
        for (int e = 0; e < kE; ++e) { const int slot = __builtin_amdgcn_readlane(ts, e);
            if (slot >= 0) { const bf16_t* yr = y + ((size_t)(e * kB + b) * kCap + slot) * kD;
#pragma unroll
                for (int q = 0; q < 4; ++q) { const u32x2 w = *(const u32x2*)(yr + q * 256 + lane * 4);
                    v[q].x += __uint_as_float(w.x << 16); v[q].y += __uint_as_float(w.x & 0xFFFF0000u); v[q].z += __uint_as_float(w.y << 16); v[q].w += __uint_as_float(w.y & 0xFFFF0000u); } } }
        float ss = 0.f;
#pragma unroll
        for (int q = 0; q < 4; ++q) { *(f32x4*)(x + (size_t)row * kD + q * 256 + lane * 4) = v[q]; ss += v[q].x * v[q].x + v[q].y * v[q].y + v[q].z * v[q].z + v[q].w * v[q].w; }
        if (gain_next) { ss = wave_sum(ss); const float rstd = rsqrtf(ss * (1.f / kD) + kEps);
#pragma unroll
            for (int q = 0; q < 4; ++q) { u32x2 o; o.x = pk2(v[q].x * rstd * g[q].x, v[q].y * rstd * g[q].y); o.y = pk2(v[q].z * rstd * g[q].z, v[q].w * rstd * g[q].w);
                *(u32x2*)(h + (size_t)row * kD + q * 256 + lane * 4) = o; } }
    }
}

#define XB_TMO      128
#define XB_XCNT(j)  (256  + 64 * (j))
#define XB_XSUB(j)  (1280 + 64 * (j))
#define XB_XGEN(j)  (2304 + 64 * (j))
#define XB_TOP      3328
#define XB_TOPGEN   3392
#define XCD_BAR_WORDS 3456
#define XB_SPIN_CAP (1u << 26)
#define LAS __attribute__((address_space(3)))
DEVI unsigned xb_ld(unsigned* p)              { return __hip_atomic_load(p, __ATOMIC_RELAXED, __HIP_MEMORY_SCOPE_AGENT); }
DEVI unsigned xb_add(unsigned* p, unsigned v) { return __hip_atomic_fetch_add(p, v, __ATOMIC_RELAXED, __HIP_MEMORY_SCOPE_AGENT); }
DEVI unsigned xb_xcc_id() { return (unsigned)__builtin_amdgcn_s_getreg((3 << 11) | 20) & 0xFu; }
#define XB_SPIN(cond, bar) do { unsigned _sp = 0; while (cond) { __builtin_amdgcn_s_sleep(1); \
    if ((++_sp & 255u) == 0u) { if (xb_ld(&(bar)[XB_TMO])) break; if (_sp > XB_SPIN_CAP) { atomicAdd(&(bar)[XB_TMO], 1u); break; } } } } while (0)
struct XcdBarrier { unsigned* bar; unsigned x; volatile LAS unsigned* st; };
DEVI XcdBarrier xcd_barrier_post(unsigned* bar, volatile LAS unsigned* st) {
    XcdBarrier b; b.bar = bar; b.x = xb_xcc_id(); b.st = st;
    if (threadIdx.x == 0) (void)xb_add(&bar[XB_XCNT(b.x)], 1u);
    return b;
}
DEVI void xcd_barrier_complete(unsigned* bar, unsigned x, unsigned& nloc, unsigned& nx) {
    const unsigned G = gridDim.x * gridDim.y * gridDim.z;
    unsigned sum, cnt, mine, sp = 0u;
    for (;;) {
        sum = 0u; cnt = 0u; mine = 0u;
#pragma unroll
        for (unsigned j = 0; j < 16; ++j) { const unsigned c = xb_ld(&bar[XB_XCNT(j)]); sum += c; cnt += (c > 0u) ? 1u : 0u; mine = (j == x) ? c : mine; }
        if (sum == G) break;
        __builtin_amdgcn_s_sleep(1);
        if ((++sp & 255u) == 0u) { if (xb_ld(&bar[XB_TMO])) break; if (sp > XB_SPIN_CAP) { atomicAdd(&bar[XB_TMO], 1u); break; } }
    }
    nloc = mine > 0u ? mine : 1u; nx = cnt > 0u ? cnt : 1u;
}
DEVI void xcd_barrier(const XcdBarrier& b) {
    asm volatile("s_waitcnt vmcnt(0)" ::: "memory");
    __syncthreads();
    if (threadIdx.x == 0) {
        unsigned* bar = b.bar;
        __builtin_amdgcn_s_waitcnt(0);
        unsigned nloc = b.st[0], nx = b.st[1];
        if (nloc == 0u) { xcd_barrier_complete(bar, b.x, nloc, nx); b.st[0] = nloc; b.st[1] = nx; }
        const unsigned old = xb_add(&bar[XB_XSUB(b.x)], 1u);
        const unsigned gen = old / nloc;
        if (old + 1u == (gen + 1u) * nloc) {
            __builtin_amdgcn_fence(__ATOMIC_RELEASE, "agent");
            asm volatile("s_waitcnt vmcnt(0)" ::: "memory");
            const unsigned og = xb_add(&bar[XB_TOP], 1u);
            const unsigned tg = og / nx;
            if (og + 1u == (tg + 1u) * nx) xb_add(&bar[XB_TOPGEN], 1u);
            else XB_SPIN(xb_ld(&bar[XB_TOPGEN]) == tg, bar);
            __builtin_amdgcn_fence(__ATOMIC_ACQUIRE, "agent");
            xb_add(&bar[XB_XGEN(b.x)], 1u);
            asm volatile("s_waitcnt vmcnt(0)" ::: "memory");
        } else {
            XB_SPIN(xb_ld(&bar[XB_XGEN(b.x)]) == gen, bar);
            __builtin_amdgcn_fence(__ATOMIC_ACQUIRE, "agent");
            asm volatile("s_waitcnt vmcnt(0)" ::: "memory");
        }
    }
    __syncthreads();
}

#ifndef MEGA
#define MEGA 1
#endif
constexpr int LDS_BYTES = 65536 + 16;
extern __shared__ __attribute__((aligned(16))) unsigned char dyn_lds[];

DEVI GemmD mk_gemm(const bf16_t* A, const bf16_t* Bt, int lda, int K, int nM, int nN, const int* rowidx, size_t bstride, int pmg) {
    GemmD g; g.A = A; g.Bt = Bt; g.lda = lda; g.K = K; g.nM = nM; g.nN = nN; g.rowidx = rowidx; g.bstride = bstride; g.pmg = pmg; return g; }

DEVI void ph_win(const Params& P, int l, int bid, int nblk) {
    const GemmD g = mk_gemm((const bf16_t*)(P.ws + WS_H), (const bf16_t*)(P.ws + WS_WINT) + (size_t)l * kINW * kD, kD, kD, kTok / 256, 10, nullptr, 0, 1 << 30);
    unsigned char* r1 = P.ws + WS_R1;
    EpiQKV E; E.qa = (bf16_t*)(r1 + R1_QA); E.ka = (bf16_t*)(r1 + R1_KA); E.va = (bf16_t*)(r1 + R1_VA); E.qb = (bf16_t*)(r1 + R1_QB); E.kb = (bf16_t*)(r1 + R1_KB); E.vb = (bf16_t*)(r1 + R1_VB); E.ux = (bf16_t*)(r1 + R1_UX);
    E.qna = P.q_norm_a + l * 64; E.kna = P.k_norm_a + l * 64; E.qnb = P.q_norm_b + l * 64; E.knb = P.k_norm_b + l * 64;
    gemm_simple(g, E, bid, nblk);
}
DEVI void ph_dilated(const Params& P, int bid, int nblk) { unsigned char* r1 = P.ws + WS_R1;
    phase_dilated_naive((const bf16_t*)(r1 + R1_QA), (const bf16_t*)(r1 + R1_KA), (const bf16_t*)(r1 + R1_VA), (bf16_t*)(P.ws + WS_R2), (float*)(P.ws + WS_LSE), bid, nblk); }
DEVI void ph_na(const Params& P, int l, int bid, int nblk) { unsigned char* r1 = P.ws + WS_R1;
    phase_na_naive((const bf16_t*)(r1 + R1_QB), (const bf16_t*)(r1 + R1_KB), (const bf16_t*)(r1 + R1_VB), P.rpb + (size_t)l * 4 * 15 * 31, (bf16_t*)(r1 + R1_OB), bid, nblk); }
DEVI void ph_s5(const Params& P, int l, unsigned char* lds, int bid, int nblk) { phase_s5_naive(P, l, (const bf16_t*)(P.ws + WS_R1 + R1_UX), (float*)(P.ws + WS_YS), lds, bid, nblk); }
DEVI void ph_s5fin(const Params& P, int l, int bid, int nblk) { phase_s5_finish((const float*)(P.ws + WS_YS), (const bf16_t*)(P.ws + WS_R1 + R1_UX), P.s5_d + l * 256, (bf16_t*)(P.ws + WS_R1 + R1_G), bid, nblk); }
DEVI void ph_glu(const Params& P, int l, int bid, int nblk) {
    const GemmD g = mk_gemm((const bf16_t*)(P.ws + WS_R1 + R1_G), (const bf16_t*)(P.ws + WS_WGLUT) + (size_t)l * 256 * 256, 256, 256, kTok / 256, 1, nullptr, 0, 1 << 30);
    EpiGlu E; E.g = (const bf16_t*)(P.ws + WS_R1 + R1_G); E.oc = (bf16_t*)(P.ws + WS_R1 + R1_OC);
    gemm_simple(g, E, bid, nblk);
}
DEVI void ph_mixnorm(const Params& P, int l, int bid, int nblk) { unsigned char* r1 = P.ws + WS_R1;
    phase_mixnorm((const bf16_t*)(P.ws + WS_R2), (const float*)(P.ws + WS_LSE), (const bf16_t*)(r1 + R1_OB), (const bf16_t*)(r1 + R1_OC), P.out_norm_a + l * 512, P.out_norm_b + l * 256, P.out_norm_c + l * 256, (bf16_t*)(P.ws + WS_H), bid, nblk); }
DEVI void ph_wout(const Params& P, int l, int bid, int nblk) {
    const GemmD g = mk_gemm((const bf16_t*)(P.ws + WS_H), (const bf16_t*)(P.ws + WS_WOUTT) + (size_t)l * kD * kD, kD, kD, kTok / 256, 4, nullptr, 0, 1 << 30);
    EpiResid E; E.xin = (l == 0) ? P.x : P.out; E.xout = P.out;
    gemm_simple(g, E, bid, nblk);
}
DEVI void ph_router(const Params& P, int l, unsigned char* lds, int bid, int nblk) { phase_router(P.out, P.ffn_norm + (size_t)l * kD, P.w_router + (size_t)l * kD * kE, (bf16_t*)(P.ws + WS_H), (float*)(P.ws + WS_AFF), lds, bid, nblk); }
DEVI void ph_topk(const Params& P, unsigned char* lds, int bid, int nblk) { phase_topk((const float*)(P.ws + WS_AFF), (int*)(P.ws + WS_IDX), (float*)(P.ws + WS_GATE), (int*)(P.ws + WS_TSLOT), lds, bid, nblk); }
DEVI void ph_gu(const Params& P, int l, int bid, int nblk) {
    const GemmD g = mk_gemm((const bf16_t*)(P.ws + WS_H), (const bf16_t*)(P.ws + WS_WGUT) + (size_t)l * kE * 4096 * kD, kD, kD, 512, 16, (const int*)(P.ws + WS_IDX), (size_t)4096 * kD, 32);
    EpiGU E; E.hid = (bf16_t*)(P.ws + WS_R1);
    gemm_simple(g, E, bid, nblk);
}
DEVI void ph_down(const Params& P, int l, int bid, int nblk) {
    const GemmD g = mk_gemm((const bf16_t*)(P.ws + WS_R1), (const bf16_t*)(P.ws + WS_WDT) + (size_t)l * kE * kD * kFF, kFF, kFF, 512, 4, nullptr, (size_t)kD * kFF, 32);
    EpiDown E; E.y = (bf16_t*)(P.ws + WS_R2); E.gate = (const float*)(P.ws + WS_GATE);
    gemm_simple(g, E, bid, nblk);
}
DEVI void ph_combine(const Params& P, int l, int bid, int nblk) { phase_combine(P.out, (const bf16_t*)(P.ws + WS_R2), (const int*)(P.ws + WS_TSLOT), (l + 1 < kL) ? P.attn_norm + (size_t)(l + 1) * kD : nullptr, (bf16_t*)(P.ws + WS_H), bid, nblk); }

#if MEGA
__global__ void __launch_bounds__(kNT, 2) mega_fwd(Params P) {
    volatile LAS unsigned* st = (volatile LAS unsigned*)(dyn_lds + LDS_BYTES - 16);
    if (threadIdx.x == 0) { st[0] = 0u; st[1] = 0u; st[2] = 0u; st[3] = 0u; }
    __syncthreads();
    const XcdBarrier bar = xcd_barrier_post((unsigned*)(P.ws + WS_CTL), st);
    const int bid = blockIdx.x, nblk = gridDim.x;
    unsigned char* lds = dyn_lds;
    phase_convert(P, lds, bid, nblk);
    phase_norm(P.x, P.attn_norm, (bf16_t*)(P.ws + WS_H), bid, nblk);
    xcd_barrier(bar);
#pragma unroll 1
    for (int l = 0; l < kL; ++l) {
        ph_win(P, l, bid, nblk);            xcd_barrier(bar);
        ph_s5(P, l, lds, bid, nblk);
        ph_dilated(P, bid, nblk);
        ph_na(P, l, bid, nblk);             xcd_barrier(bar);
        ph_s5fin(P, l, bid, nblk);          xcd_barrier(bar);
        ph_glu(P, l, bid, nblk);            xcd_barrier(bar);
        ph_mixnorm(P, l, bid, nblk);        xcd_barrier(bar);
        ph_wout(P, l, bid, nblk);           xcd_barrier(bar);
        ph_router(P, l, lds, bid, nblk);    xcd_barrier(bar);
        ph_topk(P, lds, bid, nblk);         xcd_barrier(bar);
        ph_gu(P, l, bid, nblk);             xcd_barrier(bar);
        ph_down(P, l, bid, nblk);           xcd_barrier(bar);
        ph_combine(P, l, bid, nblk);        xcd_barrier(bar);
    }
}
#else
#define KB __global__ void __launch_bounds__(kNT, 2)
KB k_convert(Params P) { phase_convert(P, dyn_lds, blockIdx.x, gridDim.x); }
KB k_norm(Params P) { phase_norm(P.x, P.attn_norm, (bf16_t*)(P.ws + WS_H), blockIdx.x, gridDim.x); }
KB k_win(Params P, int l) { ph_win(P, l, blockIdx.x, gridDim.x); }
KB k_dilated(Params P) { ph_dilated(P, blockIdx.x, gridDim.x); }
KB k_na(Params P, int l) { ph_na(P, l, blockIdx.x, gridDim.x); }
KB k_s5(Params P, int l) { ph_s5(P, l, dyn_lds, blockIdx.x, gridDim.x); }
KB k_s5fin(Params P, int l) { ph_s5fin(P, l, blockIdx.x, gridDim.x); }
KB k_glu(Params P, int l) { ph_glu(P, l, blockIdx.x, gridDim.x); }
KB k_mixnorm(Params P, int l) { ph_mixnorm(P, l, blockIdx.x, gridDim.x); }
KB k_wout(Params P, int l) { ph_wout(P, l, blockIdx.x, gridDim.x); }
KB k_router(Params P, int l) { ph_router(P, l, dyn_lds, blockIdx.x, gridDim.x); }
KB k_topk(Params P) { ph_topk(P, dyn_lds, blockIdx.x, gridDim.x); }
KB k_gu(Params P, int l) { ph_gu(P, l, blockIdx.x, gridDim.x); }
KB k_down(Params P, int l) { ph_down(P, l, blockIdx.x, gridDim.x); }
KB k_combine(Params P, int l) { ph_combine(P, l, blockIdx.x, gridDim.x); }
#endif

extern "C" void kernel_launch(void* const* d_in, const int* in_sizes, int n_in, void* d_out, int out_size, void* d_ws, size_t ws_size, hipStream_t stream) {
    (void)in_sizes; (void)n_in; (void)out_size;
    if (ws_size < WS_END) { fprintf(stderr, "workspace too small: %zu < %zu\n", ws_size, (size_t)WS_END); return; }
    Params P{};
    const float** pp = (const float**)&P;
    for (int i = 0; i < 26; ++i) pp[i] = (const float*)d_in[i];
    P.out = (float*)d_out; P.ws = (unsigned char*)d_ws;
#if MEGA
    static int grid = 0;
    if (!grid) {
        int dev = 0, cus = 0, per_cu = 0;
        (void)hipGetDevice(&dev);
        (void)hipDeviceGetAttribute(&cus, hipDeviceAttributeMultiprocessorCount, dev);
        (void)hipFuncSetAttribute((const void*)mega_fwd, hipFuncAttributeMaxDynamicSharedMemorySize, LDS_BYTES);
        (void)hipOccupancyMaxActiveBlocksPerMultiprocessor(&per_cu, (const void*)mega_fwd, kNT, LDS_BYTES);
        grid = (per_cu >= 1) ? cus : 0;
        if (!grid) fprintf(stderr, "mega_fwd does not fit a CU\n");
    }
    if (!grid) return;
    (void)hipMemsetAsync(P.ws + WS_CTL, 0, XCD_BAR_WORDS * sizeof(unsigned), stream);
    mega_fwd<<<grid, kNT, LDS_BYTES, stream>>>(P);
#else
    (void)hipFuncSetAttribute((const void*)k_router, hipFuncAttributeMaxDynamicSharedMemorySize, 65536);
    const int G = 1024;
    k_convert<<<G, kNT, 256 * 72 * 2, stream>>>(P);
    k_norm<<<G, kNT, 0, stream>>>(P);
    for (int l = 0; l < kL; ++l) {
        k_win<<<G, kNT, 0, stream>>>(P, l);
        k_dilated<<<G, kNT, 0, stream>>>(P);
        k_na<<<G, kNT, 0, stream>>>(P, l);
        k_s5<<<256, kNT, 8 * 128 * 4, stream>>>(P, l);
        k_s5fin<<<G, kNT, 0, stream>>>(P, l);
        k_glu<<<256, kNT, 0, stream>>>(P, l);
        k_mixnorm<<<G, kNT, 0, stream>>>(P, l);
        k_wout<<<G, kNT, 0, stream>>>(P, l);
        k_router<<<512, kNT, 65536, stream>>>(P, l);
        k_topk<<<128, kNT, 4096, stream>>>(P);
        k_gu<<<G, kNT, 0, stream>>>(P, l);
        k_down<<<G, kNT, 0, stream>>>(P, l);
        k_combine<<<G, kNT, 0, stream>>>(P, l);
    }
#endif
}
```

```cpp
#include <hip/hip_runtime.h>
#include <stdint.h>
#include <stdio.h>

#define DEVI __device__ __forceinline__
typedef unsigned short bf16_t;
typedef short bf16x8 __attribute__((ext_vector_type(8)));
typedef float f32x4 __attribute__((ext_vector_type(4)));
typedef float f32x2 __attribute__((ext_vector_type(2)));
typedef unsigned u32x4 __attribute__((ext_vector_type(4)));
typedef unsigned u32x2 __attribute__((ext_vector_type(2)));

constexpr int kB = 8, kS = 8192, kD = 1024, kL = 4, kTok = kB * kS;
constexpr int kINW = 2560;
constexpr int kE = 16, kCap = 1024, kFF = 2048;
constexpr int kNT = 512;
constexpr float kEps = 1e-6f;

constexpr size_t MiB = 1024ull * 1024ull;
constexpr size_t WS_CTL   = 0;
constexpr size_t WS_WINT  = 1 * MiB;
constexpr size_t WS_WOUTT = WS_WINT + 20 * MiB;
constexpr size_t WS_WGLUT = WS_WOUTT + 8 * MiB;
constexpr size_t WS_WGUT  = WS_WGLUT + 1 * MiB;
constexpr size_t WS_WDT   = WS_WGUT + 512 * MiB;
constexpr size_t WS_H     = WS_WDT + 256 * MiB;
constexpr size_t WS_R1    = WS_H + 128 * MiB;
constexpr size_t WS_R2    = WS_R1 + 512 * MiB;
constexpr size_t WS_AFF   = WS_R2 + 256 * MiB;
constexpr size_t WS_IDX   = WS_AFF + 4 * MiB;
constexpr size_t WS_GATE  = WS_IDX + 1 * MiB;
constexpr size_t WS_TSLOT = WS_GATE + 1 * MiB;
constexpr size_t WS_LSE   = WS_TSLOT + 4 * MiB;
constexpr size_t WS_YS    = WS_LSE + 8 * MiB;
constexpr size_t WS_END   = WS_YS + 128 * MiB;
constexpr size_t R1_QA = 0, R1_KA = 64 * MiB, R1_VA = 128 * MiB, R1_QB = 192 * MiB, R1_KB = 224 * MiB, R1_VB = 256 * MiB,
                 R1_UX = 288 * MiB, R1_OB = 352 * MiB, R1_OC = 384 * MiB, R1_G = 416 * MiB;

struct Params {
    const float* x; const float* attn_norm; const float* w_in; const float* q_norm_a; const float* k_norm_a; const float* q_norm_b; const float* k_norm_b;
    const float* rpb; const float* s5_a_re; const float* s5_a_im; const float* s5_log_dt; const float* s5_b_re; const float* s5_b_im; const float* s5_c_re; const float* s5_c_im;
    const float* s5_d; const float* w_glu; const float* out_norm_a; const float* out_norm_b; const float* out_norm_c; const float* w_out; const float* ffn_norm;
    const float* w_router; const float* w_gate; const float* w_up; const float* w_down;
    float* out; unsigned char* ws;
};

DEVI float bf2f(bf16_t b) { return __uint_as_float(((unsigned)b) << 16); }
DEVI bf16_t f2bf(float f) { unsigned u = __float_as_uint(f); u += 0x7FFFu + ((u >> 16) & 1u); return (bf16_t)(u >> 16); }
DEVI unsigned pk2(float lo, float hi) { return (unsigned)f2bf(lo) | ((unsigned)f2bf(hi) << 16); }
DEVI int tidx() { int t = threadIdx.x; asm volatile("" : "+v"(t)); return t; }
DEVI float wave_sum(float v) {
#pragma unroll
    for (int m = 32; m >= 1; m >>= 1) v += __shfl_xor(v, m);
    return v;
}
DEVI float gelu_tanh(float y) { const float z = 0.7978845608028654f * (y + 0.044715f * y * y * y); const float t = 1.f - 2.f / (1.f + __expf(2.f * z)); return 0.5f * y * (1.f + t); }

DEVI int cmap_head(int cs) { const int bj = cs >> 7, wc = (cs >> 5) & 3, n = (cs >> 4) & 1, fq = (cs >> 2) & 3, j = cs & 3; return 64 * wc + 32 * bj + 8 * fq + 4 * n + j; }
DEVI int cmap_pk(int cs)   { const int bj = cs >> 7, wc = (cs >> 5) & 3, n = (cs >> 4) & 1, fq = (cs >> 2) & 3, j = cs & 3; return 128 * bj + 32 * wc + 8 * fq + 4 * n + j; }
DEVI int cmap_gu(int cs)   { const int wc = (cs >> 5) & 3, n = (cs >> 4) & 1, fq = (cs >> 2) & 3, j = cs & 3; return 32 * wc + 8 * fq + 4 * n + j; }

template <int MODE>
DEVI void convert_item(const float* W0, const float* W1, int ldw, int K, bf16_t* Bt, int kt, int pn, unsigned char* lds) {
    bf16_t* t = (bf16_t*)lds;
    const int tid = tidx();
#pragma unroll 4
    for (int it = 0; it < 32; ++it) {
        const int e = it * kNT + tid, k = e >> 8, cs = e & 255;
        float v;
        if (MODE == 0) v = W0[(size_t)(kt * 64 + k) * ldw + pn * 256 + cs];
        else if (MODE == 1) v = W0[(size_t)(kt * 64 + k) * ldw + pn * 256 + cmap_head(cs)];
        else if (MODE == 2) v = W0[(size_t)(kt * 64 + k) * ldw + pn * 256 + cmap_pk(cs)];
        else v = ((cs >> 7) ? W1 : W0)[(size_t)(kt * 64 + k) * ldw + pn * 128 + cmap_gu(cs)];
        t[cs * 72 + k] = f2bf(v);
    }
    __syncthreads();
#pragma unroll
    for (int it = 0; it < 4; ++it) {
        const int c = it * kNT + tid, row = c >> 3, part = c & 7;
        const u32x4 v = *(const u32x4*)(t + row * 72 + part * 8);
        *(u32x4*)(Bt + (size_t)(pn * 256 + row) * K + kt * 64 + part * 8) = v;
    }
    __syncthreads();
}

DEVI void phase_convert(const Params& P, unsigned char* lds, int bid, int nblk) {
    constexpr int N_WIN = kL * 16 * 10, N_WOUT = kL * 16 * 4, N_WGLU = kL * 4 * 1, N_WGU = kL * kE * 16 * 16, N_WD = kL * kE * 32 * 4;
    constexpr int TOT = N_WIN + N_WOUT + N_WGLU + N_WGU + N_WD;
    for (int it = bid; it < TOT; it += nblk) {
        int i = it;
        if (i < N_WIN) { const int l = i / 160, r = i % 160, kt = r / 10, pn = r % 10;
            convert_item<1>(P.w_in + (size_t)l * kD * kINW, nullptr, kINW, kD, (bf16_t*)(P.ws + WS_WINT) + (size_t)l * kINW * kD, kt, pn, lds); continue; }
        i -= N_WIN;
        if (i < N_WOUT) { const int l = i / 64, r = i % 64, kt = r / 4, pn = r % 4;
            convert_item<0>(P.w_out + (size_t)l * kD * kD, nullptr, kD, kD, (bf16_t*)(P.ws + WS_WOUTT) + (size_t)l * kD * kD, kt, pn, lds); continue; }
        i -= N_WOUT;
        if (i < N_WGLU) { const int l = i / 4, kt = i % 4;
            convert_item<2>(P.w_glu + (size_t)l * 256 * 256, nullptr, 256, 256, (bf16_t*)(P.ws + WS_WGLUT) + (size_t)l * 256 * 256, kt, 0, lds); continue; }
        i -= N_WGLU;
        if (i < N_WGU) { const int le = i / 256, r = i % 256, kt = r / 16, pn = r % 16;
            convert_item<3>(P.w_gate + (size_t)le * kD * kFF, P.w_up + (size_t)le * kD * kFF, kFF, kD, (bf16_t*)(P.ws + WS_WGUT) + (size_t)le * 4096 * kD, kt, pn, lds); continue; }
        i -= N_WGU;
        { const int le = i / 128, r = i % 128, kt = r / 4, pn = r % 4;
            convert_item<2>(P.w_down + (size_t)le * kFF * kD, nullptr, kD, kFF, (bf16_t*)(P.ws + WS_WDT) + (size_t)le * kD * kFF, kt, pn, lds); }
    }
}

DEVI void phase_norm(const float* x, const float* gain, bf16_t* h, int bid, int nblk) {
    const int wid = tidx() >> 6, lane = tidx() & 63;
    f32x4 g[4];
#pragma unroll
    for (int q = 0; q < 4; ++q) g[q] = *(const f32x4*)(gain + q * 256 + lane * 4);
    for (int row = bid * 8 + wid; row < kTok; row += nblk * 8) {
        f32x4 v[4]; float ss = 0.f;
#pragma unroll
        for (int q = 0; q < 4; ++q) { v[q] = *(const f32x4*)(x + (size_t)row * kD + q * 256 + lane * 4); ss += v[q].x * v[q].x + v[q].y * v[q].y + v[q].z * v[q].z + v[q].w * v[q].w; }
        ss = wave_sum(ss);
        const float rstd = rsqrtf(ss * (1.f / kD) + kEps);
#pragma unroll
        for (int q = 0; q < 4; ++q) { u32x2 o; o.x = pk2(v[q].x * rstd * g[q].x, v[q].y * rstd * g[q].y); o.y = pk2(v[q].z * rstd * g[q].z, v[q].w * rstd * g[q].w);
            *(u32x2*)(h + (size_t)row * kD + q * 256 + lane * 4) = o; }
    }
}

DEVI void phase_router(const float* x, const float* gain, const float* wr  , bf16_t* h, float* aff, unsigned char* lds, int bid, int nblk) {
    float* wT = (float*)lds;
    for (int i = tidx(); i < 16 * 1024; i += kNT) { const int k = i >> 4, e = i & 15; wT[e * 1024 + k] = wr[i]; }
    __syncthreads();
    const int wid = tidx() >> 6, lane = tidx() & 63;
    f32x4 g[4];
#pragma unroll
    for (int q = 0; q < 4; ++q) g[q] = *(const f32x4*)(gain + q * 256 + lane * 4);
    for (int row0 = (bid * 8 + wid) * 2; row0 < kTok; row0 += nblk * 8 * 2) {
        asm volatile("" ::: "memory");
        f32x4 v[2][4];
#pragma unroll
        for (int r = 0; r < 2; ++r) { float ss = 0.f;
#pragma unroll
            for (int q = 0; q < 4; ++q) { v[r][q] = *(const f32x4*)(x + (size_t)(row0 + r) * kD + q * 256 + lane * 4); ss += v[r][q].x * v[r][q].x + v[r][q].y * v[r][q].y + v[r][q].z * v[r][q].z + v[r][q].w * v[r][q].w; }
            ss = wave_sum(ss); const float rstd = rsqrtf(ss * (1.f / kD) + kEps);
#pragma unroll
            for (int q = 0; q < 4; ++q) { v[r][q] = v[r][q] * rstd * g[q];
                u32x2 o; o.x = pk2(v[r][q].x, v[r][q].y); o.y = pk2(v[r][q].z, v[r][q].w);
                *(u32x2*)(h + (size_t)(row0 + r) * kD + q * 256 + lane * 4) = o; }
        }
        float pa[32];
#pragma unroll
        for (int e = 0; e < 16; ++e) {
            float s0 = 0.f, s1 = 0.f;
#pragma unroll
            for (int q = 0; q < 4; ++q) { const f32x4 w = *(const f32x4*)(wT + e * 1024 + q * 256 + lane * 4);
                s0 += v[0][q].x * w.x + v[0][q].y * w.y + v[0][q].z * w.z + v[0][q].w * w.w;
                s1 += v[1][q].x * w.x + v[1][q].y * w.y + v[1][q].z * w.z + v[1][q].w * w.w; }
            pa[e] = s0; pa[16 + e] = s1;
        }
#define RS_STEP(HALF, MASK) { const bool up = (lane & (MASK)) != 0; _Pragma("unroll") for (int i = 0; i < (HALF); ++i) { const float keep = up ? pa[i + (HALF)] : pa[i], send = up ? pa[i] : pa[i + (HALF)]; pa[i] = keep + __shfl_xor(send, (MASK)); } }
        RS_STEP(16, 32) RS_STEP(8, 16) RS_STEP(4, 8) RS_STEP(2, 4) RS_STEP(1, 2)
#undef RS_STEP
        const float logit = pa[0] + __shfl_xor(pa[0], 1);
        float mx = logit;
#pragma unroll
        for (int m = 16; m >= 2; m >>= 1) mx = fmaxf(mx, __shfl_xor(mx, m));
        const float ex = __expf(logit - mx);
        float sm = ex;
#pragma unroll
        for (int m = 16; m >= 2; m >>= 1) sm += __shfl_xor(sm, m);
        const int row = row0 + (lane >> 5), e = (lane >> 1) & 15, b = row >> 13, s = row & (kS - 1);
        if (!(lane & 1)) aff[((size_t)(b * kE + e)) * kS + s] = ex / sm;
    }
    __syncthreads();
}

DEVI int block_excl_scan(int v, int* sh  , int& total) {
    const int lane = tidx() & 63, wid = tidx() >> 6;
    int incl = v;
#pragma unroll
    for (int d = 1; d < 64; d <<= 1) { const int o = __shfl_up(incl, d); if (lane >= d) incl += o; }
    __syncthreads();
    if (lane == 63) sh[wid] = incl;
    __syncthreads();
    int base = 0, tot = 0;
#pragma unroll
    for (int w = 0; w < 8; ++w) { const int c = sh[w]; if (w < wid) base += c; tot += c; }
    total = tot;
    return base + incl - v;
}

DEVI void phase_topk(const float* aff, int* idx, float* gate, int* tokslot, unsigned char* lds, int bid, int nblk) {
    int* hist = (int*)lds;
    int* sh = hist + 256;
    int* res = sh + 16;
    const int tid = tidx(), lane = tid & 63, wid = tid >> 6;
    for (int item = bid; item < kB * kE; item += nblk) {
        const int b = item >> 4, e = item & 15;
        const float* a = aff + (size_t)item * kS;
        unsigned key[16];
#pragma unroll
        for (int q = 0; q < 4; ++q) { const u32x4 v = *(const u32x4*)(a + tid * 16 + q * 4); key[q * 4 + 0] = v.x; key[q * 4 + 1] = v.y; key[q * 4 + 2] = v.z; key[q * 4 + 3] = v.w; }
        unsigned prefix = 0; int kk = kCap;
#pragma unroll 1
        for (int pass = 0; pass < 4; ++pass) {
            const int shift = 24 - 8 * pass;
            __syncthreads();
            if (tid < 256) hist[tid] = 0;
            __syncthreads();
#pragma unroll
            for (int i = 0; i < 16; ++i) { const bool in = (pass == 0) || ((key[i] >> (shift + 8)) == prefix); if (in) atomicAdd(&hist[(key[i] >> shift) & 255], 1); }
            __syncthreads();
            if (wid == 0) {
                int c[4], loc = 0;
#pragma unroll
                for (int j = 0; j < 4; ++j) { c[j] = hist[255 - 4 * lane - j]; loc += c[j]; }
                int incl = loc;
#pragma unroll
                for (int d = 1; d < 64; d <<= 1) { const int o = __shfl_up(incl, d); if (lane >= d) incl += o; }
                const int excl = incl - loc;
                if (excl < kk && kk <= incl) { int run = excl; int bin = 0, nk = 0; bool found = false;
#pragma unroll
                    for (int j = 0; j < 4; ++j) { if (!found && run + c[j] >= kk) { bin = 255 - 4 * lane - j; nk = kk - run; found = true; } if (!found) run += c[j]; }
                    res[0] = bin; res[1] = nk; }
            }
            __syncthreads();
            prefix = (prefix << 8) | (unsigned)res[0]; kk = res[1];
        }
        const unsigned T = prefix;
        int ceq = 0;
#pragma unroll
        for (int i = 0; i < 16; ++i) ceq += (key[i] == T) ? 1 : 0;
        int tot;
        int eqb = block_excl_scan(ceq, sh, tot);
        int csel = 0; unsigned selmask = 0;
#pragma unroll
        for (int i = 0; i < 16; ++i) { bool s = key[i] > T; if (key[i] == T) { s = eqb < kk; ++eqb; } if (s) { selmask |= 1u << i; ++csel; } }
        int slot = block_excl_scan(csel, sh, tot);
        const size_t rbase = (size_t)(e * kB + b) * kCap;
#pragma unroll
        for (int i = 0; i < 16; ++i) { const int s = tid * 16 + i; const bool sel = (selmask >> i) & 1u;
            if (sel) { idx[rbase + slot] = b * kS + s; gate[rbase + slot] = __uint_as_float(key[i]); }
            tokslot[((size_t)(b * kS + s)) * kE + e] = sel ? slot : -1;
            if (sel) ++slot; }
    }
    __syncthreads();
}

struct Unit { int pm, pn; };
DEVI bool unit_of(int Lid, int nM, int nN, Unit& u) {
    const int nwg = nM * nN; if (Lid >= nwg) return false;
    int wgid = Lid; { const int q = nwg / 8, r = nwg % 8, xcd = wgid % 8, off = wgid / 8; wgid = (xcd < r ? xcd * (q + 1) : r * (q + 1) + (xcd - r) * q) + off; }
    const int nig = 8 * nN, gid = wgid / nig, fm = gid * 8, gsz = (nM - fm) < 8 ? (nM - fm) : 8;
    u.pm = fm + ((wgid % nig) % gsz); u.pn = (wgid % nig) / gsz; return true;
}
struct GemmD { const bf16_t* A; const bf16_t* Bt; int lda, K, nM, nN; const int* rowidx; size_t bstride; int pmg; };

template <class Epi>
DEVI void gemm_simple(const GemmD g, const Epi& E, int bid, int nblk) {
    const int tid = tidx(), wid = tid >> 6, lane = tid & 63, wr = wid >> 2, wc = wid & 3, fr = lane & 15, fq = lane >> 4;
    for (int i = 0;; ++i) {
        Unit u; if (!unit_of(i * nblk + bid, g.nM, g.nN, u)) break;
        f32x4 acc[2][2][4][2];
#pragma unroll
        for (int a = 0; a < 2; ++a)
#pragma unroll
            for (int b = 0; b < 2; ++b)
#pragma unroll
                for (int m = 0; m < 4; ++m)
#pragma unroll
                    for (int n = 0; n < 2; ++n) acc[a][b][m][n] = (f32x4){0.f, 0.f, 0.f, 0.f};
        const bf16_t* Bu = g.Bt + (size_t)(u.pm / g.pmg) * g.bstride + (size_t)u.pn * 256 * g.K;
        unsigned ao[2][4], bo[2][2];
#pragma unroll
        for (int a = 0; a < 2; ++a)
#pragma unroll
            for (int m = 0; m < 4; ++m) { const int r = u.pm * 256 + 128 * a + 64 * wr + 16 * m + fr; const unsigned rr = g.rowidx ? (unsigned)g.rowidx[r] : (unsigned)r; ao[a][m] = rr * (unsigned)g.lda + 8u * fq; }
#pragma unroll
        for (int b = 0; b < 2; ++b)
#pragma unroll
            for (int n = 0; n < 2; ++n) bo[b][n] = (unsigned)(128 * b + 32 * wc + 16 * n + fr) * (unsigned)g.K + 8u * fq;
#pragma unroll 1
        for (int k0 = 0; k0 < g.K; k0 += 32) {
            bf16x8 av[2][4], bv[2][2];
#pragma unroll
            for (int a = 0; a < 2; ++a)
#pragma unroll
                for (int m = 0; m < 4; ++m) av[a][m] = *(const bf16x8*)(g.A + ao[a][m] + k0);
#pragma unroll
            for (int b = 0; b < 2; ++b)
#pragma unroll
                for (int n = 0; n < 2; ++n) bv[b][n] = *(const bf16x8*)(Bu + bo[b][n] + k0);
#pragma unroll
            for (int a = 0; a < 2; ++a)
#pragma unroll
                for (int b = 0; b < 2; ++b)
#pragma unroll
                    for (int m = 0; m < 4; ++m)
#pragma unroll
                        for (int n = 0; n < 2; ++n) acc[a][b][m][n] = __builtin_amdgcn_mfma_f32_16x16x32_bf16(bv[b][n], av[a][m], acc[a][b][m][n], 0, 0, 0);
        }
        E(acc, u, wr, wc, fr, fq);
    }
}


#define LAS __attribute__((address_space(3)))
constexpr int PG_HTB = 128 * 64 * 2;
DEVI int pg_lds_byte(int r, int c) { const int st = (r >> 4) * 2 + (c >> 5), rr = r & 15, cc = c & 31, ob = rr * 64 + cc * 2; return st * 1024 + (ob ^ (((ob >> 9) & 1) << 5)); }
DEVI void pg_stage_rc(int b, int& R, int& C) { const int st = b / 1024, sb = b % 1024, swz = sb ^ (((sb >> 9) & 1) << 5); R = (st >> 1) * 16 + swz / 64; C = (st & 1) * 32 + (swz % 64) / 2; }

template <class Epi, bool ALIGN_EPI, bool SP2>
DEVI void gemm_engine(LAS unsigned char* lds, const GemmD g, const Epi& E, int bid, int nblk) {
    const int tid = tidx(), wid = __builtin_amdgcn_readfirstlane(tid >> 6), lane = tid & 63, wr = wid >> 2, wc = wid & 3, fr = lane & 15, fq = lane >> 4;
    const int K = g.K, nt = K / 64;
    int RA[2], CA[2]; unsigned voffB[2];
#pragma unroll
    for (int i = 0; i < 2; ++i) { pg_stage_rc(tid * 16 + i * 8192, RA[i], CA[i]); voffB[i] = (unsigned)(RA[i] * K + CA[i]) * 2u; }
    const size_t kstep = 128;
    const size_t hstepB = (size_t)128 * K * 2;
    const unsigned ldsw = (unsigned)wid * 1024u;
    const int aoff = pg_lds_byte(wr * 64 + fr, fq * 8), boff = pg_lds_byte(wc * 32 + fr, fq * 8);
#define PG8_SA(b, h) (((b) * 2 + (h)) * PG_HTB)
#define PG8_SB(b, h) ((4 + (b) * 2 + (h)) * PG_HTB)
#define PG8_STAGE(bufoff, gbase, voff) do { _Pragma("unroll") for (int _i = 0; _i < 2; ++_i) \
        __builtin_amdgcn_global_load_lds((const unsigned*)((const char*)(gbase) + (voff)[_i]), (LAS unsigned*)(lds + (bufoff) + ldsw + _i * 8192), 16, 0, 0); } while (0)
#define PG8_LDA(dst, b, h) do { _Pragma("unroll") for (int m = 0; m < 4; ++m) _Pragma("unroll") for (int k = 0; k < 2; ++k) dst[m][k] = *(const LAS bf16x8*)(lds + PG8_SA(b, h) + aoff + m * 2048 + k * 1024); } while (0)
#define PG8_LDB(dst, b, h) do { _Pragma("unroll") for (int n = 0; n < 2; ++n) _Pragma("unroll") for (int k = 0; k < 2; ++k) dst[n][k] = *(const LAS bf16x8*)(lds + PG8_SB(b, h) + boff + n * 2048 + k * 1024); } while (0)
#define PG8_MMA(ai, bj, At, Bt) do { __builtin_amdgcn_s_setprio(1); _Pragma("unroll") for (int m = 0; m < 4; ++m) _Pragma("unroll") for (int n = 0; n < 2; ++n) _Pragma("unroll") for (int k = 0; k < 2; ++k) \
        acc[ai][bj][m][n] = __builtin_amdgcn_mfma_f32_16x16x32_bf16(Bt[n][k], At[m][k], acc[ai][bj][m][n], 0, 0, 0); __builtin_amdgcn_s_setprio(0); } while (0)
#define PG8_WAIT_V(n) asm volatile("s_waitcnt vmcnt(" #n ")" ::: "memory")
#define PG8_WAIT_L(n) asm volatile("s_waitcnt lgkmcnt(" #n ")" ::: "memory")
#define PG8_BAR __builtin_amdgcn_s_barrier()
#define PG8_SCHED __builtin_amdgcn_sched_barrier(0)
#define PG8_VOFFA(dst, pm_) do { _Pragma("unroll") for (int _h = 0; _h < 2; ++_h) _Pragma("unroll") for (int _i = 0; _i < 2; ++_i) { const int _r = (pm_) * 256 + 128 * _h + RA[_i]; \
        const unsigned _rr = g.rowidx ? (unsigned)g.rowidx[_r] : (unsigned)_r; dst[_h][_i] = (_rr * (unsigned)g.lda + (unsigned)CA[_i]) * 2u; } } while (0)
    Unit cur, nxt, nn; int ui = 0;
    if (!unit_of(bid, g.nM, g.nN, cur)) return;
    f32x4 acc[2][2][4][2];
#pragma unroll
    for (int a = 0; a < 2; ++a)
#pragma unroll
        for (int b = 0; b < 2; ++b)
#pragma unroll
            for (int m = 0; m < 4; ++m)
#pragma unroll
                for (int n = 0; n < 2; ++n) acc[a][b][m][n] = (f32x4){0.f, 0.f, 0.f, 0.f};
    bf16x8 At[4][2], B0[2][2], B1[2][2];
    const char* const A0 = (const char*)g.A;
    const char* cB = (const char*)(g.Bt + (size_t)(cur.pm / g.pmg) * g.bstride + (size_t)cur.pn * 256 * K);
    unsigned cvA[2][2], nvA[2][2];
    PG8_VOFFA(cvA, cur.pm);
    { const bool hn = unit_of(nblk + bid, g.nM, g.nN, nxt); if (hn) PG8_VOFFA(nvA, nxt.pm); else { _Pragma("unroll") for (int h = 0; h < 2; ++h) _Pragma("unroll") for (int i = 0; i < 2; ++i) nvA[h][i] = cvA[h][i]; } }
    if constexpr (SP2) {
        PG8_STAGE(PG8_SB(0, 0), cB, voffB); PG8_STAGE(PG8_SB(0, 1), cB + hstepB, voffB); PG8_STAGE(PG8_SA(0, 0), A0, cvA[0]); PG8_STAGE(PG8_SA(0, 1), A0, cvA[1]);
        if (wr == 1) PG8_BAR;
        PG8_WAIT_V(2); PG8_BAR;
        PG8_STAGE(PG8_SB(1, 0), cB + kstep, voffB); PG8_STAGE(PG8_SA(1, 0), A0 + kstep, cvA[0]); PG8_STAGE(PG8_SB(1, 1), cB + hstepB + kstep, voffB);
        PG8_WAIT_V(6); PG8_BAR;
    } else {
        PG8_STAGE(PG8_SB(0, 0), cB, voffB); PG8_STAGE(PG8_SA(0, 0), A0, cvA[0]); PG8_STAGE(PG8_SB(0, 1), cB + hstepB, voffB); PG8_STAGE(PG8_SA(0, 1), A0, cvA[1]);
        if (wr == 1) PG8_BAR;
        PG8_WAIT_V(4); PG8_BAR;
        PG8_STAGE(PG8_SB(1, 0), cB + kstep, voffB); PG8_STAGE(PG8_SA(1, 0), A0 + kstep, cvA[0]); PG8_STAGE(PG8_SB(1, 1), cB + hstepB + kstep, voffB);
        PG8_WAIT_V(6); PG8_BAR;
    }
    for (;;) {
        const bool has_next = unit_of((ui + 1) * nblk + bid, g.nM, g.nN, nxt);
        const char* nB = has_next ? (const char*)(g.Bt + (size_t)(nxt.pm / g.pmg) * g.bstride + (size_t)nxt.pn * 256 * K) : cB;
        for (int t = 0; t < nt; t += 2) {
            const bool last = (t == nt - 2);
            const char* a1 = A0 + (size_t)(t + 1) * kstep;
            const char* a2 = last ? A0 : A0 + (size_t)(t + 2) * kstep; const char* b2 = last ? nB : cB + (size_t)(t + 2) * kstep;
            const char* a3 = a2 + kstep; const char* b3 = b2 + kstep;
            unsigned v2[2][2];
#pragma unroll
            for (int h = 0; h < 2; ++h)
#pragma unroll
                for (int i = 0; i < 2; ++i) v2[h][i] = last ? nvA[h][i] : cvA[h][i];
            if constexpr (SP2) {
            PG8_LDB(B0, 0, 0); PG8_LDB(B1, 0, 1); PG8_SCHED; PG8_LDA(At, 0, 0); PG8_STAGE(PG8_SA(1, 1), a1, cvA[1]);
            PG8_WAIT_V(8); PG8_WAIT_L(0); PG8_BAR; PG8_MMA(0, 0, At, B0); PG8_MMA(0, 1, At, B1); PG8_BAR; PG8_SCHED;
            PG8_LDA(At, 0, 1); PG8_STAGE(PG8_SB(0, 0), b2, voffB); PG8_STAGE(PG8_SB(0, 1), b2 + hstepB, voffB); PG8_STAGE(PG8_SA(0, 0), a2, v2[0]);
            PG8_WAIT_V(8); PG8_WAIT_L(0); PG8_BAR; PG8_MMA(1, 0, At, B0); PG8_MMA(1, 1, At, B1); PG8_BAR; PG8_SCHED;
            PG8_LDB(B0, 1, 0); PG8_LDB(B1, 1, 1); PG8_SCHED; PG8_LDA(At, 1, 0); PG8_STAGE(PG8_SA(0, 1), a2, v2[1]);
            PG8_WAIT_V(8); PG8_WAIT_L(0); PG8_BAR; PG8_MMA(0, 0, At, B0); PG8_MMA(0, 1, At, B1); PG8_BAR; PG8_SCHED;
            PG8_LDA(At, 1, 1); PG8_STAGE(PG8_SB(1, 0), b3, voffB); PG8_STAGE(PG8_SB(1, 1), b3 + hstepB, voffB); PG8_STAGE(PG8_SA(1, 0), a3, v2[0]);
            PG8_WAIT_V(8); PG8_WAIT_L(0); PG8_BAR; PG8_MMA(1, 0, At, B0); PG8_MMA(1, 1, At, B1); PG8_BAR; PG8_SCHED;
            } else {
            PG8_LDB(B0, 0, 0); PG8_SCHED; PG8_LDA(At, 0, 0); PG8_STAGE(PG8_SA(1, 1), a1, cvA[1]);
            PG8_WAIT_L(8); PG8_BAR; PG8_WAIT_L(0); PG8_MMA(0, 0, At, B0); PG8_BAR; PG8_SCHED;
            PG8_LDB(B1, 0, 1); PG8_STAGE(PG8_SB(0, 0), b2, voffB);
            PG8_BAR; PG8_WAIT_L(0); PG8_MMA(0, 1, At, B1); PG8_BAR;
            PG8_LDA(At, 0, 1); PG8_STAGE(PG8_SA(0, 0), a2, v2[0]);
            PG8_BAR; PG8_WAIT_L(0); PG8_MMA(1, 0, At, B0); PG8_BAR; PG8_SCHED;
            PG8_STAGE(PG8_SB(0, 1), b2 + hstepB, voffB);
            PG8_WAIT_V(6); PG8_BAR; PG8_MMA(1, 1, At, B1); PG8_BAR;
            PG8_LDB(B0, 1, 0); PG8_SCHED; PG8_LDA(At, 1, 0); PG8_STAGE(PG8_SA(0, 1), a2, v2[1]);
            PG8_WAIT_L(8); PG8_BAR; PG8_WAIT_L(0); PG8_MMA(0, 0, At, B0); PG8_BAR; PG8_SCHED;
            PG8_LDB(B1, 1, 1); PG8_STAGE(PG8_SB(1, 0), b3, voffB);
            PG8_BAR; PG8_WAIT_L(0); PG8_MMA(0, 1, At, B1); PG8_BAR;
            PG8_LDA(At, 1, 1); PG8_STAGE(PG8_SA(1, 0), a3, v2[0]);
            PG8_BAR; PG8_WAIT_L(0); PG8_MMA(1, 0, At, B0); PG8_BAR; PG8_SCHED;
            PG8_STAGE(PG8_SB(1, 1), b3 + hstepB, voffB);
            PG8_WAIT_V(6); PG8_BAR; PG8_MMA(1, 1, At, B1); PG8_BAR;
            }
        }
        if constexpr (ALIGN_EPI) { if (wr == 0) PG8_BAR; }
        const bool has_nn = has_next && unit_of((ui + 2) * nblk + bid, g.nM, g.nN, nn);
        int ridx[2][2];
        if (g.rowidx && has_nn) {
#pragma unroll
            for (int h = 0; h < 2; ++h)
#pragma unroll
                for (int i = 0; i < 2; ++i) ridx[h][i] = g.rowidx[nn.pm * 256 + 128 * h + RA[i]];
        }
        E(acc, cur, wr, wc, fr, fq);
        if (!has_next) break;
#pragma unroll
        for (int a = 0; a < 2; ++a)
#pragma unroll
            for (int b = 0; b < 2; ++b)
#pragma unroll
                for (int m = 0; m < 4; ++m)
#pragma unroll
                    for (int n = 0; n < 2; ++n) acc[a][b][m][n] = (f32x4){0.f, 0.f, 0.f, 0.f};
        cur = nxt; cB = nB; ++ui;
#pragma unroll
        for (int h = 0; h < 2; ++h)
#pragma unroll
            for (int i = 0; i < 2; ++i) { cvA[h][i] = nvA[h][i];
                if (has_nn) { const unsigned rr = g.rowidx ? (unsigned)ridx[h][i] : (unsigned)(nn.pm * 256 + 128 * h + RA[i]); nvA[h][i] = (rr * (unsigned)g.lda + (unsigned)CA[i]) * 2u; } }
        if constexpr (ALIGN_EPI) { if (wr == 1) PG8_BAR; }
    }
    PG8_WAIT_V(0);
    if constexpr (!ALIGN_EPI) { if (wr == 0) PG8_BAR; }
    PG8_BAR;
#undef PG8_SA
#undef PG8_SB
#undef PG8_STAGE
#undef PG8_LDA
#undef PG8_LDB
#undef PG8_MMA
#undef PG8_WAIT_V
#undef PG8_WAIT_L
#undef PG8_BAR
#undef PG8_SCHED
#undef PG8_VOFFA
}

struct EpiQKV {
    bf16_t *qa, *ka, *va, *qb, *kb, *vb, *ux; const float *qna, *kna, *qnb, *knb;
    DEVI void operator()(const f32x4 (&acc)[2][2][4][2], const Unit& u, int wr, int wc, int fr, int fq) const {
        bf16_t* dst; const float* gn = nullptr; int H = 8, head0 = 0; const int pn = u.pn;
        if (pn < 2) { dst = qa; gn = qna; head0 = pn * 4; }
        else if (pn < 4) { dst = ka; gn = kna; head0 = (pn - 2) * 4; }
        else if (pn < 6) { dst = va; head0 = (pn - 4) * 4; }
        else if (pn == 6) { dst = qb; gn = qnb; H = 4; }
        else if (pn == 7) { dst = kb; gn = knb; H = 4; }
        else if (pn == 8) { dst = vb; H = 4; }
        else { dst = ux; }
        const int head = head0 + wc;
        f32x4 gv[2][2];
#pragma unroll
        for (int bj = 0; bj < 2; ++bj)
#pragma unroll
            for (int n = 0; n < 2; ++n) gv[bj][n] = gn ? *(const f32x4*)(gn + 32 * bj + 8 * fq + 4 * n) : (f32x4){1.f, 1.f, 1.f, 1.f};
#pragma unroll
        for (int ai = 0; ai < 2; ++ai)
#pragma unroll
            for (int m = 0; m < 4; ++m) {
                const int row = u.pm * 256 + 128 * ai + 64 * wr + 16 * m + fr;
                float rstd = 1.f;
                if (gn) { float ss = 0.f;
#pragma unroll
                    for (int bj = 0; bj < 2; ++bj)
#pragma unroll
                        for (int n = 0; n < 2; ++n) { const f32x4 v = acc[ai][bj][m][n]; ss += v.x * v.x + v.y * v.y + v.z * v.z + v.w * v.w; }
                    ss += __shfl_xor(ss, 16); ss += __shfl_xor(ss, 32);
                    rstd = rsqrtf(ss * (1.f / 64.f) + kEps); }
#pragma unroll
                for (int bj = 0; bj < 2; ++bj) {
                    const f32x4 v0 = acc[ai][bj][m][0] * rstd * gv[bj][0], v1 = acc[ai][bj][m][1] * rstd * gv[bj][1];
                    u32x4 w; w.x = pk2(v0.x, v0.y); w.y = pk2(v0.z, v0.w); w.z = pk2(v1.x, v1.y); w.w = pk2(v1.z, v1.w);
                    if (pn < 9) { const int b = row >> 13, s = row & (kS - 1);
                        *(u32x4*)(dst + (((size_t)(b * H + head)) * kS + s) * 64 + 32 * bj + 8 * fq) = w; }
                    else { const int gidx = 4 * wc + 2 * bj + (fq >> 1), c0 = 8 * (fq & 1);
                        *(u32x4*)(dst + ((size_t)gidx * 4096 + (row >> 4)) * 512 + (row & 15) * 16 + c0) = w; }
                }
            }
    }
};
struct EpiResid {
    const float* xin; float* xout;
    DEVI void operator()(const f32x4 (&acc)[2][2][4][2], const Unit& u, int wr, int wc, int fr, int fq) const {
#pragma unroll
        for (int ai = 0; ai < 2; ++ai)
#pragma unroll
            for (int m = 0; m < 4; ++m) { const size_t ro = (size_t)(u.pm * 256 + 128 * ai + 64 * wr + 16 * m + fr) * kD + u.pn * 256 + 32 * wc + 4 * fq;
#pragma unroll
                for (int bj = 0; bj < 2; ++bj)
#pragma unroll
                    for (int n = 0; n < 2; ++n) { const size_t o = ro + 128 * bj + 16 * n; *(f32x4*)(xout + o) = *(const f32x4*)(xin + o) + acc[ai][bj][m][n]; } }
    }
};
struct EpiGU {
    bf16_t* hid;
    DEVI void operator()(const f32x4 (&acc)[2][2][4][2], const Unit& u, int wr, int wc, int fr, int fq) const {
#pragma unroll
        for (int ai = 0; ai < 2; ++ai)
#pragma unroll
            for (int m = 0; m < 4; ++m) { const size_t row = (size_t)(u.pm * 256 + 128 * ai + 64 * wr + 16 * m + fr);
                float o[8];
#pragma unroll
                for (int n = 0; n < 2; ++n)
#pragma unroll
                    for (int j = 0; j < 4; ++j) { const float gt = acc[ai][0][m][n][j], up = acc[ai][1][m][n][j]; o[n * 4 + j] = gt / (1.f + __expf(-gt)) * up; }
                u32x4 w; w.x = pk2(o[0], o[1]); w.y = pk2(o[2], o[3]); w.z = pk2(o[4], o[5]); w.w = pk2(o[6], o[7]);
                *(u32x4*)(hid + row * kFF + u.pn * 128 + 32 * wc + 8 * fq) = w; }
    }
};
struct EpiDown {
    bf16_t* y; const float* gate;
    DEVI void operator()(const f32x4 (&acc)[2][2][4][2], const Unit& u, int wr, int wc, int fr, int fq) const {
#pragma unroll
        for (int ai = 0; ai < 2; ++ai)
#pragma unroll
            for (int m = 0; m < 4; ++m) { const size_t row = (size_t)(u.pm * 256 + 128 * ai + 64 * wr + 16 * m + fr); const float gv = gate[row];
#pragma unroll
                for (int bj = 0; bj < 2; ++bj) { const f32x4 v0 = acc[ai][bj][m][0] * gv, v1 = acc[ai][bj][m][1] * gv;
                    u32x4 w; w.x = pk2(v0.x, v0.y); w.y = pk2(v0.z, v0.w); w.z = pk2(v1.x, v1.y); w.w = pk2(v1.z, v1.w);
                    *(u32x4*)(y + row * kD + u.pn * 256 + 128 * bj + 32 * wc + 8 * fq) = w; } }
    }
};
struct EpiGlu {
    const bf16_t* g; bf16_t* oc;
    DEVI void operator()(const f32x4 (&acc)[2][2][4][2], const Unit& u, int wr, int wc, int fr, int fq) const {
#pragma unroll
        for (int ai = 0; ai < 2; ++ai)
#pragma unroll
            for (int m = 0; m < 4; ++m) { const size_t row = (size_t)(u.pm * 256 + 128 * ai + 64 * wr + 16 * m + fr);
#pragma unroll
                for (int bj = 0; bj < 2; ++bj) { const size_t o = row * 256 + 128 * bj + 32 * wc + 8 * fq;
                    const u32x4 gw = *(const u32x4*)(g + o); float o8[8];
#pragma unroll
                    for (int n = 0; n < 2; ++n)
#pragma unroll
                        for (int j = 0; j < 4; ++j) { const int t = n * 4 + j; const unsigned wv = (t < 2) ? gw.x : (t < 4) ? gw.y : (t < 6) ? gw.z : gw.w;
                            const float gg = __uint_as_float((t & 1) ? (wv & 0xFFFF0000u) : (wv << 16)); o8[t] = gg / (1.f + __expf(-acc[ai][bj][m][n][j])); }
                    u32x4 w; w.x = pk2(o8[0], o8[1]); w.y = pk2(o8[2], o8[3]); w.z = pk2(o8[4], o8[5]); w.w = pk2(o8[6], o8[7]);
                    *(u32x4*)(oc + o) = w; } }
    }
};

DEVI void load_row64(const bf16_t* p, float* d) {
#pragma unroll
    for (int i = 0; i < 8; ++i) { const u32x4 v = *(const u32x4*)(p + i * 8);
        d[i * 8 + 0] = __uint_as_float(v.x << 16); d[i * 8 + 1] = __uint_as_float(v.x & 0xFFFF0000u); d[i * 8 + 2] = __uint_as_float(v.y << 16); d[i * 8 + 3] = __uint_as_float(v.y & 0xFFFF0000u);
        d[i * 8 + 4] = __uint_as_float(v.z << 16); d[i * 8 + 5] = __uint_as_float(v.z & 0xFFFF0000u); d[i * 8 + 6] = __uint_as_float(v.w << 16); d[i * 8 + 7] = __uint_as_float(v.w & 0xFFFF0000u); }
}
DEVI void store_row64(bf16_t* p, const float* d, float sc) {
#pragma unroll
    for (int i = 0; i < 8; ++i) { u32x4 w; w.x = pk2(d[i * 8] * sc, d[i * 8 + 1] * sc); w.y = pk2(d[i * 8 + 2] * sc, d[i * 8 + 3] * sc); w.z = pk2(d[i * 8 + 4] * sc, d[i * 8 + 5] * sc); w.w = pk2(d[i * 8 + 6] * sc, d[i * 8 + 7] * sc);
        *(u32x4*)(p + i * 8) = w; }
}
DEVI void phase_dilated_naive(const bf16_t* qa, const bf16_t* ka, const bf16_t* va, bf16_t* oac, float* lse, int bid, int nblk) {
    const int nitems = 3 * kB * 8 * (kS / kNT);
    for (int it = bid; it < nitems; it += nblk) {
        const int c = it / (kB * 8 * 16), r = it % (kB * 8 * 16), bh = r / 16, t = (r % 16) * kNT + tidx(), b = bh >> 3, h = bh & 7;
        const int dil = (c == 0) ? 1 : (c == 1) ? 4 : 16;
        const float slope = exp2f(-(float)(h + 1));
        const bf16_t* kb_ = ka + (size_t)bh * kS * 64; const bf16_t* vb_ = va + (size_t)bh * kS * 64;
        float q[64], o[64];
        load_row64(qa + ((size_t)bh * kS + t) * 64, q);
#pragma unroll
        for (int d = 0; d < 64; ++d) o[d] = 0.f;
        float m = -1e30f, l = 0.f;
        for (int rel = -64; rel <= 64; ++rel) {
            const int pos = t + rel * dil;
            if (pos < 0 || pos >= kS) continue;
            float kv[64]; load_row64(kb_ + (size_t)pos * 64, kv);
            float dot = 0.f;
#pragma unroll
            for (int d = 0; d < 64; ++d) dot += q[d] * kv[d];
            const float sc = dot * 0.125f - slope * (float)(dil * (rel < 0 ? -rel : rel));
            const float mn = fmaxf(m, sc), corr = __expf(m - mn), p = __expf(sc - mn);
            load_row64(vb_ + (size_t)pos * 64, kv);
            l = l * corr + p;
#pragma unroll
            for (int d = 0; d < 64; ++d) o[d] = o[d] * corr + p * kv[d];
            m = mn;
        }
        const size_t tok = (size_t)b * kS + t;
        store_row64(oac + ((size_t)c * kTok + tok) * 512 + h * 64, o, 1.f / l);
        lse[((size_t)c * kTok + tok) * 8 + h] = m + __logf(l);
    }
}
DEVI void phase_na_naive(const bf16_t* qb, const bf16_t* kbuf, const bf16_t* vbuf, const float* rpb  , bf16_t* ob, int bid, int nblk) {
    const int nitems = kB * 4 * (kS / kNT);
    for (int it = bid; it < nitems; it += nblk) {
        const int bh = it / 16, t = (it % 16) * kNT + tidx(), b = bh >> 2, h = bh & 3;
        const int r = t >> 6, cq = t & 63;
        int rs = r - 4; rs = rs < 0 ? 0 : (rs > 120 ? 120 : rs);
        int cs = cq - 8; cs = cs < 0 ? 0 : (cs > 48 ? 48 : cs);
        const bf16_t* kb_ = kbuf + (size_t)bh * kS * 64; const bf16_t* vb_ = vbuf + (size_t)bh * kS * 64;
        float q[64], o[64];
        load_row64(qb + ((size_t)bh * kS + t) * 64, q);
#pragma unroll
        for (int d = 0; d < 64; ++d) o[d] = 0.f;
        float m = -1e30f, l = 0.f;
        for (int kr = 0; kr < 8; ++kr)
            for (int kc = 0; kc < 16; ++kc) {
                const int krow = rs + kr, kcol = cs + kc, pos = krow * 64 + kcol;
                float kv[64]; load_row64(kb_ + (size_t)pos * 64, kv);
                float dot = 0.f;
#pragma unroll
                for (int d = 0; d < 64; ++d) dot += q[d] * kv[d];
                const float sc = dot * 0.125f + rpb[(h * 15 + (krow - r + 7)) * 31 + (kcol - cq + 15)];
                const float mn = fmaxf(m, sc), corr = __expf(m - mn), p = __expf(sc - mn);
                load_row64(vb_ + (size_t)pos * 64, kv);
                l = l * corr + p;
#pragma unroll
                for (int d = 0; d < 64; ++d) o[d] = o[d] * corr + p * kv[d];
                m = mn;
            }
        store_row64(ob + ((size_t)b * kS + t) * 256 + h * 64, o, 1.f / l);
    }
}
DEVI void phase_s5_naive(const Params& P, int l, const bf16_t* ux, float* ys, unsigned char* lds, int bid, int nblk) {
    const int wid = tidx() >> 6, lane = tidx() & 63;
    float* xs = (float*)lds + wid * 128;
    for (int item = wid * nblk + bid; item < kB * 16 * 2; item += nblk * 8) {
        const int dir = item & 1, g = (item >> 1) & 15, b = item >> 5;
        const size_t pbase = (((size_t)l * 2 + dir) * 16 + g) * 64;
        const float dt = __expf(P.s5_log_dt[((size_t)l * 2 + dir) * 16 + g]);
        const float a = fminf(P.s5_a_re[pbase + lane], -1e-4f), w = P.s5_a_im[pbase + lane];
        const float mag = __expf(a * dt), ar = mag * cosf(w * dt), ai = mag * sinf(w * dt);
        const float den = a * a + w * w, zr = ar - 1.f, gr = (zr * a + ai * w) / den, gi = (ai * a - zr * w) / den;
        float bbr[16], bbi[16];
#pragma unroll
        for (int c = 0; c < 16; ++c) { const float br = P.s5_b_re[(pbase + lane) * 16 + c], bi = P.s5_b_im[(pbase + lane) * 16 + c]; bbr[c] = gr * br - gi * bi; bbi[c] = gr * bi + gi * br; }
        const int cch = lane & 15, qt = lane >> 4;
        float cre[16], cim[16];
#pragma unroll
        for (int pp = 0; pp < 16; ++pp) { cre[pp] = P.s5_c_re[(pbase / 64 * 16 + cch) * 64 + qt * 16 + pp]; cim[pp] = P.s5_c_im[(pbase / 64 * 16 + cch) * 64 + qt * 16 + pp]; }
        float xr = 0.f, xi = 0.f;
        const bf16_t* ug = ux + (size_t)g * 4096 * 512;
        for (int st = 0; st < kS; ++st) {
            const int s = dir ? (kS - 1 - st) : st; const size_t tok = (size_t)b * kS + s;
            const bf16_t* up = ug + (tok >> 4) * 512 + (tok & 15) * 16;
            const u32x4 u0 = *(const u32x4*)up, u1 = *(const u32x4*)(up + 8);
            float uv[16];
            uv[0] = __uint_as_float(u0.x << 16); uv[1] = __uint_as_float(u0.x & 0xFFFF0000u); uv[2] = __uint_as_float(u0.y << 16); uv[3] = __uint_as_float(u0.y & 0xFFFF0000u);
            uv[4] = __uint_as_float(u0.z << 16); uv[5] = __uint_as_float(u0.z & 0xFFFF0000u); uv[6] = __uint_as_float(u0.w << 16); uv[7] = __uint_as_float(u0.w & 0xFFFF0000u);
            uv[8] = __uint_as_float(u1.x << 16); uv[9] = __uint_as_float(u1.x & 0xFFFF0000u); uv[10] = __uint_as_float(u1.y << 16); uv[11] = __uint_as_float(u1.y & 0xFFFF0000u);
            uv[12] = __uint_as_float(u1.z << 16); uv[13] = __uint_as_float(u1.z & 0xFFFF0000u); uv[14] = __uint_as_float(u1.w << 16); uv[15] = __uint_as_float(u1.w & 0xFFFF0000u);
            float bur = 0.f, bui = 0.f;
#pragma unroll
            for (int c = 0; c < 16; ++c) { bur += bbr[c] * uv[c]; bui += bbi[c] * uv[c]; }
            const float nr = ar * xr - ai * xi + bur, ni = ar * xi + ai * xr + bui; xr = nr; xi = ni;
            xs[lane] = xr; xs[64 + lane] = xi;
            asm volatile("s_waitcnt lgkmcnt(0)" ::: "memory");
            float y = 0.f;
#pragma unroll
            for (int pp = 0; pp < 16; ++pp) y += cre[pp] * xs[qt * 16 + pp] - cim[pp] * xs[64 + qt * 16 + pp];
            asm volatile("s_waitcnt lgkmcnt(0)" ::: "memory");
            y += __shfl_xor(y, 16); y += __shfl_xor(y, 32);
            if (lane < 16) ys[((size_t)dir * kTok + tok) * 256 + g * 16 + cch] = y;
        }
    }
}
DEVI void phase_s5_finish(const float* ys, const bf16_t* ux, const float* dskip, bf16_t* G, int bid, int nblk) {
    for (size_t i = (size_t)bid * kNT + tidx(); i < (size_t)kTok * 256; i += (size_t)nblk * kNT) {
        const size_t tok = i >> 8; const int ch = (int)(i & 255), g = ch >> 4, c = ch & 15;
        const float u = bf2f(ux[((size_t)g * 4096 + (tok >> 4)) * 512 + (tok & 15) * 16 + c]);
        const float y = ys[i] + ys[(size_t)kTok * 256 + i] + dskip[ch] * u;
        G[i] = f2bf(gelu_tanh(y));
    }
}
DEVI void phase_mixnorm(const bf16_t* oac, const float* lse, const bf16_t* ob, const bf16_t* oc, const float* ga, const float* gb, const float* gc, bf16_t* mix, int bid, int nblk) {
    const int wid = tidx() >> 6, lane = tidx() & 63;
    float gn[16];
    { const float* gp = (lane < 32) ? ga + lane * 16 : (lane < 48) ? gb + (lane - 32) * 16 : gc + (lane - 48) * 16;
#pragma unroll
      for (int i = 0; i < 16; ++i) gn[i] = gp[i]; }
    for (int row = bid * 8 + wid; row < kTok; row += nblk * 8) {
        float v[16];
        if (lane < 32) {
            const int h = lane >> 2;
            const float l0 = lse[(size_t)row * 8 + h], l1 = lse[((size_t)kTok + row) * 8 + h], l2 = lse[((size_t)2 * kTok + row) * 8 + h];
            const float mx = fmaxf(l0, fmaxf(l1, l2)); float w0 = __expf(l0 - mx), w1 = __expf(l1 - mx), w2 = __expf(l2 - mx); const float inv = 1.f / (w0 + w1 + w2); w0 *= inv; w1 *= inv; w2 *= inv;
#pragma unroll
            for (int i = 0; i < 16; ++i) v[i] = 0.f;
#pragma unroll
            for (int c = 0; c < 3; ++c) { const float wc_ = (c == 0) ? w0 : (c == 1) ? w1 : w2; const bf16_t* p = oac + ((size_t)c * kTok + row) * 512 + lane * 16;
#pragma unroll
                for (int i = 0; i < 16; ++i) v[i] += wc_ * bf2f(p[i]); }
        } else {
            const bf16_t* p = (lane < 48) ? ob + (size_t)row * 256 + (lane - 32) * 16 : oc + (size_t)row * 256 + (lane - 48) * 16;
#pragma unroll
            for (int i = 0; i < 16; ++i) v[i] = bf2f(p[i]);
        }
        float ss = 0.f;
#pragma unroll
        for (int i = 0; i < 16; ++i) ss += v[i] * v[i];
#pragma unroll
        for (int m = 1; m <= 8; m <<= 1) ss += __shfl_xor(ss, m);
        const float o16 = __shfl_xor(ss, 16);
        if (lane < 32) ss += o16;
        const float rstd = rsqrtf(ss * ((lane < 32) ? (1.f / 512.f) : (1.f / 256.f)) + kEps);
        u32x4 w0, w1;
        w0.x = pk2(v[0] * rstd * gn[0], v[1] * rstd * gn[1]); w0.y = pk2(v[2] * rstd * gn[2], v[3] * rstd * gn[3]); w0.z = pk2(v[4] * rstd * gn[4], v[5] * rstd * gn[5]); w0.w = pk2(v[6] * rstd * gn[6], v[7] * rstd * gn[7]);
        w1.x = pk2(v[8] * rstd * gn[8], v[9] * rstd * gn[9]); w1.y = pk2(v[10] * rstd * gn[10], v[11] * rstd * gn[11]); w1.z = pk2(v[12] * rstd * gn[12], v[13] * rstd * gn[13]); w1.w = pk2(v[14] * rstd * gn[14], v[15] * rstd * gn[15]);
        *(u32x4*)(mix + (size_t)row * kD + lane * 16) = w0; *(u32x4*)(mix + (size_t)row * kD + lane * 16 + 8) = w1;
    }
}
DEVI void phase_combine(float* x, const bf16_t* y, const int* tokslot, const float* gain_next, bf16_t* h, int bid, int nblk) {
    const int wid = tidx() >> 6, lane = tidx() & 63;
    f32x4 g[4];
#pragma unroll
    for (int q = 0; q < 4; ++q) g[q] = gain_next ? *(const f32x4*)(gain_next + q * 256 + lane * 4) : (f32x4){0.f, 0.f, 0.f, 0.f};
    for (int row = bid * 8 + wid; row < kTok; row += nblk * 8) {
        const int b = row >> 13;
        const int ts = tokslot[(size_t)row * kE + (lane & 15)];
        f32x4 v[4];
#pragma unroll
        for (int q = 0; q < 4; ++q) v[q] = *(const f32x4*)(x + (size_t)row * kD + q * 256 + lane * 4);
#pragma unroll
        for (int e = 0; e < kE; ++e) { const int slot = __builtin_amdgcn_readlane(ts, e);
            if (slot >= 0) { const bf16_t* yr = y + ((size_t)(e * kB + b) * kCap + slot) * kD;
#pragma unroll
                for (int q = 0; q < 4; ++q) { const u32x2 w = *(const u32x2*)(yr + q * 256 + lane * 4);
                    v[q].x += __uint_as_float(w.x << 16); v[q].y += __uint_as_float(w.x & 0xFFFF0000u); v[q].z += __uint_as_float(w.y << 16); v[q].w += __uint_as_float(w.y & 0xFFFF0000u); } } }
        float ss = 0.f;
#pragma unroll
        for (int q = 0; q < 4; ++q) { *(f32x4*)(x + (size_t)row * kD + q * 256 + lane * 4) = v[q]; ss += v[q].x * v[q].x + v[q].y * v[q].y + v[q].z * v[q].z + v[q].w * v[q].w; }
        if (gain_next) { ss = wave_sum(ss); const float rstd = rsqrtf(ss * (1.f / kD) + kEps);
#pragma unroll
            for (int q = 0; q < 4; ++q) { u32x2 o; o.x = pk2(v[q].x * rstd * g[q].x, v[q].y * rstd * g[q].y); o.y = pk2(v[q].z * rstd * g[q].z, v[q].w * rstd * g[q].w);
                *(u32x2*)(h + (size_t)row * kD + q * 256 + lane * 4) = o; } }
    }
}

#define XB_TMO      128
#define XB_XCNT(j)  (256  + 64 * (j))
#define XB_XSUB(j)  (1280 + 64 * (j))
#define XB_XGEN(j)  (2304 + 64 * (j))
#define XB_TOP      3328
#define XB_TOPGEN   3392
#define XCD_BAR_WORDS 3456
#define XB_SPIN_CAP (1u << 26)
DEVI unsigned xb_ld(unsigned* p)              { return __hip_atomic_load(p, __ATOMIC_RELAXED, __HIP_MEMORY_SCOPE_AGENT); }
DEVI unsigned xb_add(unsigned* p, unsigned v) { return __hip_atomic_fetch_add(p, v, __ATOMIC_RELAXED, __HIP_MEMORY_SCOPE_AGENT); }
DEVI unsigned xb_xcc_id() { return (unsigned)__builtin_amdgcn_s_getreg((3 << 11) | 20) & 0xFu; }
#define XB_SPIN(cond, bar) do { unsigned _sp = 0; while (cond) { __builtin_amdgcn_s_sleep(1); \
    if ((++_sp & 255u) == 0u) { if (xb_ld(&(bar)[XB_TMO])) break; if (_sp > XB_SPIN_CAP) { atomicAdd(&(bar)[XB_TMO], 1u); break; } } } } while (0)
struct XcdBarrier { unsigned* bar; unsigned x; volatile LAS unsigned* st; };
DEVI XcdBarrier xcd_barrier_post(unsigned* bar, volatile LAS unsigned* st) {
    XcdBarrier b; b.bar = bar; b.x = xb_xcc_id(); b.st = st;
    if (threadIdx.x == 0) (void)xb_add(&bar[XB_XCNT(b.x)], 1u);
    return b;
}
DEVI void xcd_barrier_complete(unsigned* bar, unsigned x, unsigned& nloc, unsigned& nx) {
    const unsigned G = gridDim.x * gridDim.y * gridDim.z;
    unsigned sum, cnt, mine, sp = 0u;
    for (;;) {
        sum = 0u; cnt = 0u; mine = 0u;
#pragma unroll
        for (unsigned j = 0; j < 16; ++j) { const unsigned c = xb_ld(&bar[XB_XCNT(j)]); sum += c; cnt += (c > 0u) ? 1u : 0u; mine = (j == x) ? c : mine; }
        if (sum == G) break;
        __builtin_amdgcn_s_sleep(1);
        if ((++sp & 255u) == 0u) { if (xb_ld(&bar[XB_TMO])) break; if (sp > XB_SPIN_CAP) { atomicAdd(&bar[XB_TMO], 1u); break; } }
    }
    nloc = mine > 0u ? mine : 1u; nx = cnt > 0u ? cnt : 1u;
}
DEVI void xcd_barrier(const XcdBarrier& b) {
    asm volatile("s_waitcnt vmcnt(0)" ::: "memory");
    __syncthreads();
    if (threadIdx.x == 0) {
        unsigned long long bp_ = (unsigned long long)b.bar; asm volatile("" : "+s"(bp_));
        unsigned* bar = (unsigned*)bp_;
        const unsigned bx = xb_xcc_id();
        __builtin_amdgcn_s_waitcnt(0);
        unsigned nloc = b.st[0], nx = b.st[1];
        if (nloc == 0u) { xcd_barrier_complete(bar, bx, nloc, nx); b.st[0] = nloc; b.st[1] = nx; }
        const unsigned old = xb_add(&bar[XB_XSUB(bx)], 1u);
        const unsigned gen = old / nloc;
        if (old + 1u == (gen + 1u) * nloc) {
            __builtin_amdgcn_fence(__ATOMIC_RELEASE, "agent");
            asm volatile("s_waitcnt vmcnt(0)" ::: "memory");
            const unsigned og = xb_add(&bar[XB_TOP], 1u);
            const unsigned tg = og / nx;
            if (og + 1u == (tg + 1u) * nx) xb_add(&bar[XB_TOPGEN], 1u);
            else XB_SPIN(xb_ld(&bar[XB_TOPGEN]) == tg, bar);
            __builtin_amdgcn_fence(__ATOMIC_ACQUIRE, "agent");
            xb_add(&bar[XB_XGEN(bx)], 1u);
            asm volatile("s_waitcnt vmcnt(0)" ::: "memory");
        } else {
            XB_SPIN(xb_ld(&bar[XB_XGEN(bx)]) == gen, bar);
            __builtin_amdgcn_fence(__ATOMIC_ACQUIRE, "agent");
            asm volatile("s_waitcnt vmcnt(0)" ::: "memory");
        }
    }
    __syncthreads();
}

#ifndef MEGA
#define MEGA 1
#endif
#ifndef USE_ENGINE
#define USE_ENGINE 1
#endif
constexpr int LDS_BYTES = 131072 + 16;
#if USE_ENGINE
#define GEMM_RUN(g, E) gemm_engine<decltype(E), true, true>((LAS unsigned char*)dyn_lds, g, E, bid, nblk)
#else
#define GEMM_RUN(g, E) gemm_simple(g, E, bid, nblk)
#endif
extern __shared__ __attribute__((aligned(16))) unsigned char dyn_lds[];

DEVI GemmD mk_gemm(const bf16_t* A, const bf16_t* Bt, int lda, int K, int nM, int nN, const int* rowidx, size_t bstride, int pmg) {
    GemmD g; g.A = A; g.Bt = Bt; g.lda = lda; g.K = K; g.nM = nM; g.nN = nN; g.rowidx = rowidx; g.bstride = bstride; g.pmg = pmg; return g; }

DEVI void ph_win(const Params& P, int l, int bid, int nblk) {
    const GemmD g = mk_gemm((const bf16_t*)(P.ws + WS_H), (const bf16_t*)(P.ws + WS_WINT) + (size_t)l * kINW * kD, kD, kD, kTok / 256, 10, nullptr, 0, 1 << 30);
    unsigned char* r1 = P.ws + WS_R1;
    EpiQKV E; E.qa = (bf16_t*)(r1 + R1_QA); E.ka = (bf16_t*)(r1 + R1_KA); E.va = (bf16_t*)(r1 + R1_VA); E.qb = (bf16_t*)(r1 + R1_QB); E.kb = (bf16_t*)(r1 + R1_KB); E.vb = (bf16_t*)(r1 + R1_VB); E.ux = (bf16_t*)(r1 + R1_UX);
    E.qna = P.q_norm_a + l * 64; E.kna = P.k_norm_a + l * 64; E.qnb = P.q_norm_b + l * 64; E.knb = P.k_norm_b + l * 64;
    GEMM_RUN(g, E);
}
DEVI void ph_dilated(const Params& P, int bid, int nblk) { unsigned char* r1 = P.ws + WS_R1;
    phase_dilated_naive((const bf16_t*)(r1 + R1_QA), (const bf16_t*)(r1 + R1_KA), (const bf16_t*)(r1 + R1_VA), (bf16_t*)(P.ws + WS_R2), (float*)(P.ws + WS_LSE), bid, nblk); }
DEVI void ph_na(const Params& P, int l, int bid, int nblk) { unsigned char* r1 = P.ws + WS_R1;
    phase_na_naive((const bf16_t*)(r1 + R1_QB), (const bf16_t*)(r1 + R1_KB), (const bf16_t*)(r1 + R1_VB), P.rpb + (size_t)l * 4 * 15 * 31, (bf16_t*)(r1 + R1_OB), bid, nblk); }
DEVI void ph_s5(const Params& P, int l, unsigned char* lds, int bid, int nblk) { phase_s5_naive(P, l, (const bf16_t*)(P.ws + WS_R1 + R1_UX), (float*)(P.ws + WS_YS), lds, bid, nblk); }
DEVI void ph_s5fin(const Params& P, int l, int bid, int nblk) { phase_s5_finish((const float*)(P.ws + WS_YS), (const bf16_t*)(P.ws + WS_R1 + R1_UX), P.s5_d + l * 256, (bf16_t*)(P.ws + WS_R1 + R1_G), bid, nblk); }
DEVI void ph_glu(const Params& P, int l, int bid, int nblk) {
    const GemmD g = mk_gemm((const bf16_t*)(P.ws + WS_R1 + R1_G), (const bf16_t*)(P.ws + WS_WGLUT) + (size_t)l * 256 * 256, 256, 256, kTok / 256, 1, nullptr, 0, 1 << 30);
    EpiGlu E; E.g = (const bf16_t*)(P.ws + WS_R1 + R1_G); E.oc = (bf16_t*)(P.ws + WS_R1 + R1_OC);
    GEMM_RUN(g, E);
}
DEVI void ph_mixnorm(const Params& P, int l, int bid, int nblk) { unsigned char* r1 = P.ws + WS_R1;
    phase_mixnorm((const bf16_t*)(P.ws + WS_R2), (const float*)(P.ws + WS_LSE), (const bf16_t*)(r1 + R1_OB), (const bf16_t*)(r1 + R1_OC), P.out_norm_a + l * 512, P.out_norm_b + l * 256, P.out_norm_c + l * 256, (bf16_t*)(P.ws + WS_H), bid, nblk); }
DEVI void ph_wout(const Params& P, int l, int bid, int nblk) {
    const GemmD g = mk_gemm((const bf16_t*)(P.ws + WS_H), (const bf16_t*)(P.ws + WS_WOUTT) + (size_t)l * kD * kD, kD, kD, kTok / 256, 4, nullptr, 0, 1 << 30);
    EpiResid E; E.xin = (l == 0) ? P.x : P.out; E.xout = P.out;
    GEMM_RUN(g, E);
}
DEVI void ph_router(const Params& P, int l, unsigned char* lds, int bid, int nblk) { phase_router(P.out, P.ffn_norm + (size_t)l * kD, P.w_router + (size_t)l * kD * kE, (bf16_t*)(P.ws + WS_H), (float*)(P.ws + WS_AFF), lds, bid, nblk); }
DEVI void ph_topk(const Params& P, unsigned char* lds, int bid, int nblk) { phase_topk((const float*)(P.ws + WS_AFF), (int*)(P.ws + WS_IDX), (float*)(P.ws + WS_GATE), (int*)(P.ws + WS_TSLOT), lds, bid, nblk); }
DEVI void ph_gu(const Params& P, int l, int bid, int nblk) {
    const GemmD g = mk_gemm((const bf16_t*)(P.ws + WS_H), (const bf16_t*)(P.ws + WS_WGUT) + (size_t)l * kE * 4096 * kD, kD, kD, 512, 16, (const int*)(P.ws + WS_IDX), (size_t)4096 * kD, 32);
    EpiGU E; E.hid = (bf16_t*)(P.ws + WS_R1);
    GEMM_RUN(g, E);
}
DEVI void ph_down(const Params& P, int l, int bid, int nblk) {
    const GemmD g = mk_gemm((const bf16_t*)(P.ws + WS_R1), (const bf16_t*)(P.ws + WS_WDT) + (size_t)l * kE * kD * kFF, kFF, kFF, 512, 4, nullptr, (size_t)kD * kFF, 32);
    EpiDown E; E.y = (bf16_t*)(P.ws + WS_R2); E.gate = (const float*)(P.ws + WS_GATE);
    GEMM_RUN(g, E);
}
DEVI void ph_combine(const Params& P, int l, int bid, int nblk) { phase_combine(P.out, (const bf16_t*)(P.ws + WS_R2), (const int*)(P.ws + WS_TSLOT), (l + 1 < kL) ? P.attn_norm + (size_t)(l + 1) * kD : nullptr, (bf16_t*)(P.ws + WS_H), bid, nblk); }

#if MEGA
__global__ void __launch_bounds__(kNT, 2) mega_fwd(Params P) {
    volatile LAS unsigned* st = (volatile LAS unsigned*)(dyn_lds + LDS_BYTES - 16);
    if (threadIdx.x == 0) { st[0] = 0u; st[1] = 0u; st[2] = 0u; st[3] = 0u; }
    __syncthreads();
    const XcdBarrier bar = xcd_barrier_post((unsigned*)(P.ws + WS_CTL), st);
    const int bid = blockIdx.x, nblk = gridDim.x;
    unsigned char* lds = dyn_lds;
    phase_convert(P, lds, bid, nblk);
    phase_norm(P.x, P.attn_norm, (bf16_t*)(P.ws + WS_H), bid, nblk);
    xcd_barrier(bar);
#pragma unroll 1
    for (int l = 0; l < kL; ++l) {
        ph_win(P, l, bid, nblk);            xcd_barrier(bar);
        ph_s5(P, l, lds, bid, nblk);
        ph_dilated(P, bid, nblk);
        ph_na(P, l, bid, nblk);             xcd_barrier(bar);
        ph_s5fin(P, l, bid, nblk);          xcd_barrier(bar);
        ph_glu(P, l, bid, nblk);            xcd_barrier(bar);
        ph_mixnorm(P, l, bid, nblk);        xcd_barrier(bar);
        ph_wout(P, l, bid, nblk);           xcd_barrier(bar);
        ph_router(P, l, lds, bid, nblk);    xcd_barrier(bar);
        ph_topk(P, lds, bid, nblk);         xcd_barrier(bar);
        ph_gu(P, l, bid, nblk);             xcd_barrier(bar);
        ph_down(P, l, bid, nblk);           xcd_barrier(bar);
        ph_combine(P, l, bid, nblk);        xcd_barrier(bar);
    }
}
#else
#define KB __global__ void __launch_bounds__(kNT, 2)
KB k_convert(Params P) { phase_convert(P, dyn_lds, blockIdx.x, gridDim.x); }
KB k_norm(Params P) { phase_norm(P.x, P.attn_norm, (bf16_t*)(P.ws + WS_H), blockIdx.x, gridDim.x); }
KB k_win(Params P, int l) { ph_win(P, l, blockIdx.x, gridDim.x); }
KB k_dilated(Params P) { ph_dilated(P, blockIdx.x, gridDim.x); }
KB k_na(Params P, int l) { ph_na(P, l, blockIdx.x, gridDim.x); }
KB k_s5(Params P, int l) { ph_s5(P, l, dyn_lds, blockIdx.x, gridDim.x); }
KB k_s5fin(Params P, int l) { ph_s5fin(P, l, blockIdx.x, gridDim.x); }
KB k_glu(Params P, int l) { ph_glu(P, l, blockIdx.x, gridDim.x); }
KB k_mixnorm(Params P, int l) { ph_mixnorm(P, l, blockIdx.x, gridDim.x); }
KB k_wout(Params P, int l) { ph_wout(P, l, blockIdx.x, gridDim.x); }
KB k_router(Params P, int l) { ph_router(P, l, dyn_lds, blockIdx.x, gridDim.x); }
KB k_topk(Params P) { ph_topk(P, dyn_lds, blockIdx.x, gridDim.x); }
KB k_gu(Params P, int l) { ph_gu(P, l, blockIdx.x, gridDim.x); }
KB k_down(Params P, int l) { ph_down(P, l, blockIdx.x, gridDim.x); }
KB k_combine(Params P, int l) { ph_combine(P, l, blockIdx.x, gridDim.x); }
#endif

extern "C" void kernel_launch(void* const* d_in, const int* in_sizes, int n_in, void* d_out, int out_size, void* d_ws, size_t ws_size, hipStream_t stream) {
    (void)in_sizes; (void)n_in; (void)out_size;
    if (ws_size < WS_END) { fprintf(stderr, "workspace too small: %zu < %zu\n", ws_size, (size_t)WS_END); return; }
    Params P{};
    const float** pp = (const float**)&P;
    for (int i = 0; i < 26; ++i) pp[i] = (const float*)d_in[i];
    P.out = (float*)d_out; P.ws = (unsigned char*)d_ws;
#if MEGA
    static int grid = 0;
    if (!grid) {
        int dev = 0, cus = 0, per_cu = 0;
        (void)hipGetDevice(&dev);
        (void)hipDeviceGetAttribute(&cus, hipDeviceAttributeMultiprocessorCount, dev);
        (void)hipFuncSetAttribute((const void*)mega_fwd, hipFuncAttributeMaxDynamicSharedMemorySize, LDS_BYTES);
        (void)hipOccupancyMaxActiveBlocksPerMultiprocessor(&per_cu, (const void*)mega_fwd, kNT, LDS_BYTES);
        grid = (per_cu >= 1) ? cus : 0;
        if (!grid) fprintf(stderr, "mega_fwd does not fit a CU\n");
    }
    if (!grid) return;
    (void)hipMemsetAsync(P.ws + WS_CTL, 0, XCD_BAR_WORDS * sizeof(unsigned), stream);
    mega_fwd<<<grid, kNT, LDS_BYTES, stream>>>(P);
#else
    (void)hipFuncSetAttribute((const void*)k_router, hipFuncAttributeMaxDynamicSharedMemorySize, 65536);
    const int G = 1024;
    k_convert<<<G, kNT, 256 * 72 * 2, stream>>>(P);
    k_norm<<<G, kNT, 0, stream>>>(P);
    for (int l = 0; l < kL; ++l) {
        k_win<<<G, kNT, 0, stream>>>(P, l);
        k_dilated<<<G, kNT, 0, stream>>>(P);
        k_na<<<G, kNT, 0, stream>>>(P, l);
        k_s5<<<256, kNT, 8 * 128 * 4, stream>>>(P, l);
        k_s5fin<<<G, kNT, 0, stream>>>(P, l);
        k_glu<<<256, kNT, 0, stream>>>(P, l);
        k_mixnorm<<<G, kNT, 0, stream>>>(P, l);
        k_wout<<<G, kNT, 0, stream>>>(P, l);
        k_router<<<512, kNT, 65536, stream>>>(P, l);
        k_topk<<<128, kNT, 4096, stream>>>(P);
        k_gu<<<G, kNT, 0, stream>>>(P, l);
        k_down<<<G, kNT, 0, stream>>>(P, l);
        k_combine<<<G, kNT, 0, stream>>>(P, l);
    }
#endif
}
```

```cpp
#include <hip/hip_runtime.h>
#include <stdint.h>
#include <stdio.h>

#define DEVI __device__ __forceinline__
#define LAS __attribute__((address_space(3)))
typedef unsigned short bf16_t;
typedef short bf16x8 __attribute__((ext_vector_type(8)));
typedef float f32x4 __attribute__((ext_vector_type(4)));
typedef float f32x2 __attribute__((ext_vector_type(2)));
typedef unsigned u32x4 __attribute__((ext_vector_type(4)));
typedef unsigned u32x2 __attribute__((ext_vector_type(2)));

constexpr int kB = 8, kS = 8192, kD = 1024, kL = 4, kTok = kB * kS;
constexpr int kINW = 2560;
constexpr int kE = 16, kCap = 1024, kFF = 2048;
constexpr int kNT = 512;
constexpr float kEps = 1e-6f;

constexpr size_t MiB = 1024ull * 1024ull;
constexpr size_t WS_CTL   = 0;
constexpr size_t WS_WINT  = 1 * MiB;
constexpr size_t WS_WOUTT = WS_WINT + 20 * MiB;
constexpr size_t WS_WGLUT = WS_WOUTT + 8 * MiB;
constexpr size_t WS_WGUT  = WS_WGLUT + 1 * MiB;
constexpr size_t WS_WDT   = WS_WGUT + 512 * MiB;
constexpr size_t WS_H     = WS_WDT + 256 * MiB;
constexpr size_t WS_R1    = WS_H + 128 * MiB;
constexpr size_t WS_R2    = WS_R1 + 512 * MiB;
constexpr size_t WS_AFF   = WS_R2 + 256 * MiB;
constexpr size_t WS_IDX   = WS_AFF + 4 * MiB;
constexpr size_t WS_GATE  = WS_IDX + 1 * MiB;
constexpr size_t WS_TSLOT = WS_GATE + 1 * MiB;
constexpr size_t WS_LSE   = WS_TSLOT + 4 * MiB;
constexpr size_t WS_YS    = WS_LSE + 8 * MiB;
constexpr size_t WS_END   = WS_YS + 128 * MiB;
constexpr size_t R1_QA = 0, R1_KA = 64 * MiB, R1_VA = 128 * MiB, R1_QB = 192 * MiB, R1_KB = 224 * MiB, R1_VB = 256 * MiB,
                 R1_UX = 288 * MiB, R1_OB = 352 * MiB, R1_OC = 384 * MiB, R1_G = 416 * MiB;

struct Params {
    const float* x; const float* attn_norm; const float* w_in; const float* q_norm_a; const float* k_norm_a; const float* q_norm_b; const float* k_norm_b;
    const float* rpb; const float* s5_a_re; const float* s5_a_im; const float* s5_log_dt; const float* s5_b_re; const float* s5_b_im; const float* s5_c_re; const float* s5_c_im;
    const float* s5_d; const float* w_glu; const float* out_norm_a; const float* out_norm_b; const float* out_norm_c; const float* w_out; const float* ffn_norm;
    const float* w_router; const float* w_gate; const float* w_up; const float* w_down;
    float* out; unsigned char* ws;
};

DEVI float bf2f(bf16_t b) { return __uint_as_float(((unsigned)b) << 16); }
DEVI bf16_t f2bf(float f) { unsigned u = __float_as_uint(f); u += 0x7FFFu + ((u >> 16) & 1u); return (bf16_t)(u >> 16); }
typedef __bf16 bf16x2_t __attribute__((ext_vector_type(2)));
DEVI unsigned pk2(float lo, float hi) { const f32x2 v = {lo, hi}; return __builtin_bit_cast(unsigned, __builtin_convertvector(v, bf16x2_t)); }
DEVI int tidx() { int t = threadIdx.x; asm volatile("" : "+v"(t)); return t; }
DEVI float wave_sum(float v) {
#pragma unroll
    for (int m = 32; m >= 1; m >>= 1) v += __shfl_xor(v, m);
    return v;
}
DEVI float gelu_tanh(float y) { const float z = 0.7978845608028654f * (y + 0.044715f * y * y * y); const float t = 1.f - 2.f / (1.f + __expf(2.f * z)); return 0.5f * y * (1.f + t); }

DEVI int cmap_head(int cs) { const int bj = cs >> 7, wc = (cs >> 5) & 3, n = (cs >> 4) & 1, fq = (cs >> 2) & 3, j = cs & 3; return 64 * wc + 32 * bj + 8 * fq + 4 * n + j; }
DEVI int cmap_pk(int cs)   { const int bj = cs >> 7, wc = (cs >> 5) & 3, n = (cs >> 4) & 1, fq = (cs >> 2) & 3, j = cs & 3; return 128 * bj + 32 * wc + 8 * fq + 4 * n + j; }
DEVI int cmap_gu(int cs)   { const int wc = (cs >> 5) & 3, n = (cs >> 4) & 1, fq = (cs >> 2) & 3, j = cs & 3; return 32 * wc + 8 * fq + 4 * n + j; }

template <int MODE>
DEVI void convert_item(const float* W0, const float* W1, int ldw, int K, bf16_t* Bt, int kt, int pn, unsigned char* lds) {
    bf16_t* t = (bf16_t*)lds;
    const int tid = tidx();
#pragma unroll 4
    for (int it = 0; it < 32; ++it) {
        const int e = it * kNT + tid, k = e >> 8, cs = e & 255;
        float v;
        if (MODE == 0) v = W0[(size_t)(kt * 64 + k) * ldw + pn * 256 + cs];
        else if (MODE == 1) v = W0[(size_t)(kt * 64 + k) * ldw + pn * 256 + cmap_head(cs)];
        else if (MODE == 2) v = W0[(size_t)(kt * 64 + k) * ldw + pn * 256 + cmap_pk(cs)];
        else v = ((cs >> 7) ? W1 : W0)[(size_t)(kt * 64 + k) * ldw + pn * 128 + cmap_gu(cs)];
        t[cs * 72 + k] = f2bf(v);
    }
    __syncthreads();
#pragma unroll
    for (int it = 0; it < 4; ++it) {
        const int c = it * kNT + tid, row = c >> 3, part = c & 7;
        const u32x4 v = *(const u32x4*)(t + row * 72 + part * 8);
        *(u32x4*)(Bt + (size_t)(pn * 256 + row) * K + kt * 64 + part * 8) = v;
    }
    __syncthreads();
}

DEVI void phase_convert(const Params& P, unsigned char* lds, int bid, int nblk) {
    constexpr int N_WIN = kL * 16 * 10, N_WOUT = kL * 16 * 4, N_WGLU = kL * 4 * 1, N_WGU = kL * kE * 16 * 16, N_WD = kL * kE * 32 * 4;
    constexpr int TOT = N_WIN + N_WOUT + N_WGLU + N_WGU + N_WD;
    for (int it = bid; it < TOT; it += nblk) {
        int i = it;
        if (i < N_WIN) { const int l = i / 160, r = i % 160, kt = r / 10, pn = r % 10;
            convert_item<1>(P.w_in + (size_t)l * kD * kINW, nullptr, kINW, kD, (bf16_t*)(P.ws + WS_WINT) + (size_t)l * kINW * kD, kt, pn, lds); continue; }
        i -= N_WIN;
        if (i < N_WOUT) { const int l = i / 64, r = i % 64, kt = r / 4, pn = r % 4;
            convert_item<0>(P.w_out + (size_t)l * kD * kD, nullptr, kD, kD, (bf16_t*)(P.ws + WS_WOUTT) + (size_t)l * kD * kD, kt, pn, lds); continue; }
        i -= N_WOUT;
        if (i < N_WGLU) { const int l = i / 4, kt = i % 4;
            convert_item<2>(P.w_glu + (size_t)l * 256 * 256, nullptr, 256, 256, (bf16_t*)(P.ws + WS_WGLUT) + (size_t)l * 256 * 256, kt, 0, lds); continue; }
        i -= N_WGLU;
        if (i < N_WGU) { const int le = i / 256, r = i % 256, kt = r / 16, pn = r % 16;
            convert_item<3>(P.w_gate + (size_t)le * kD * kFF, P.w_up + (size_t)le * kD * kFF, kFF, kD, (bf16_t*)(P.ws + WS_WGUT) + (size_t)le * 4096 * kD, kt, pn, lds); continue; }
        i -= N_WGU;
        { const int le = i / 128, r = i % 128, kt = r / 4, pn = r % 4;
            convert_item<2>(P.w_down + (size_t)le * kFF * kD, nullptr, kD, kFF, (bf16_t*)(P.ws + WS_WDT) + (size_t)le * kD * kFF, kt, pn, lds); }
    }
}

DEVI void phase_norm(const float* x, const float* gain, bf16_t* h, int bid, int nblk) {
    const int wid = tidx() >> 6, lane = tidx() & 63;
    f32x4 g[4];
#pragma unroll
    for (int q = 0; q < 4; ++q) g[q] = *(const f32x4*)(gain + q * 256 + lane * 4);
    for (int row = bid * 8 + wid; row < kTok; row += nblk * 8) {
        f32x4 v[4]; float ss = 0.f;
#pragma unroll
        for (int q = 0; q < 4; ++q) { v[q] = *(const f32x4*)(x + (size_t)row * kD + q * 256 + lane * 4); ss += v[q].x * v[q].x + v[q].y * v[q].y + v[q].z * v[q].z + v[q].w * v[q].w; }
        ss = wave_sum(ss);
        const float rstd = rsqrtf(ss * (1.f / kD) + kEps);
#pragma unroll
        for (int q = 0; q < 4; ++q) { u32x2 o; o.x = pk2(v[q].x * rstd * g[q].x, v[q].y * rstd * g[q].y); o.y = pk2(v[q].z * rstd * g[q].z, v[q].w * rstd * g[q].w);
            *(u32x2*)(h + (size_t)row * kD + q * 256 + lane * 4) = o; }
    }
}

DEVI void phase_router(const float* x, const float* gain, const float* wr  , bf16_t* h, float* aff, unsigned char* lds, int bid, int nblk) {
    float* wT = (float*)lds;
    for (int i = tidx(); i < 16 * 1024; i += kNT) { const int k = i >> 4, e = i & 15; wT[e * 1024 + k] = wr[i]; }
    __syncthreads();
    const int wid = tidx() >> 6, lane = tidx() & 63;
    f32x4 g[4];
#pragma unroll
    for (int q = 0; q < 4; ++q) g[q] = *(const f32x4*)(gain + q * 256 + lane * 4);
    for (int row0 = (bid * 8 + wid) * 2; row0 < kTok; row0 += nblk * 8 * 2) {
        asm volatile("" ::: "memory");
        f32x4 v[2][4];
#pragma unroll
        for (int r = 0; r < 2; ++r) { float ss = 0.f;
#pragma unroll
            for (int q = 0; q < 4; ++q) { v[r][q] = *(const f32x4*)(x + (size_t)(row0 + r) * kD + q * 256 + lane * 4); ss += v[r][q].x * v[r][q].x + v[r][q].y * v[r][q].y + v[r][q].z * v[r][q].z + v[r][q].w * v[r][q].w; }
            ss = wave_sum(ss); const float rstd = rsqrtf(ss * (1.f / kD) + kEps);
#pragma unroll
            for (int q = 0; q < 4; ++q) { v[r][q] = v[r][q] * rstd * g[q];
                u32x2 o; o.x = pk2(v[r][q].x, v[r][q].y); o.y = pk2(v[r][q].z, v[r][q].w);
                *(u32x2*)(h + (size_t)(row0 + r) * kD + q * 256 + lane * 4) = o; }
        }
        float pa[32];
#pragma unroll
        for (int e = 0; e < 16; ++e) {
            float s0 = 0.f, s1 = 0.f;
#pragma unroll
            for (int q = 0; q < 4; ++q) { const f32x4 w = *(const f32x4*)(wT + e * 1024 + q * 256 + lane * 4);
                s0 += v[0][q].x * w.x + v[0][q].y * w.y + v[0][q].z * w.z + v[0][q].w * w.w;
                s1 += v[1][q].x * w.x + v[1][q].y * w.y + v[1][q].z * w.z + v[1][q].w * w.w; }
            pa[e] = s0; pa[16 + e] = s1;
        }
#define RS_STEP(HALF, MASK) { const bool up = (lane & (MASK)) != 0; _Pragma("unroll") for (int i = 0; i < (HALF); ++i) { const float keep = up ? pa[i + (HALF)] : pa[i], send = up ? pa[i] : pa[i + (HALF)]; pa[i] = keep + __shfl_xor(send, (MASK)); } }
        RS_STEP(16, 32) RS_STEP(8, 16) RS_STEP(4, 8) RS_STEP(2, 4) RS_STEP(1, 2)
#undef RS_STEP
        const float logit = pa[0] + __shfl_xor(pa[0], 1);
        float mx = logit;
#pragma unroll
        for (int m = 16; m >= 2; m >>= 1) mx = fmaxf(mx, __shfl_xor(mx, m));
        const float ex = __expf(logit - mx);
        float sm = ex;
#pragma unroll
        for (int m = 16; m >= 2; m >>= 1) sm += __shfl_xor(sm, m);
        const int row = row0 + (lane >> 5), e = (lane >> 1) & 15, b = row >> 13, s = row & (kS - 1);
        if (!(lane & 1)) aff[((size_t)(b * kE + e)) * kS + s] = ex / sm;
    }
    __syncthreads();
}

DEVI int block_excl_scan(int v, int* sh  , int& total) {
    const int lane = tidx() & 63, wid = tidx() >> 6;
    int incl = v;
#pragma unroll
    for (int d = 1; d < 64; d <<= 1) { const int o = __shfl_up(incl, d); if (lane >= d) incl += o; }
    __syncthreads();
    if (lane == 63) sh[wid] = incl;
    __syncthreads();
    int base = 0, tot = 0;
#pragma unroll
    for (int w = 0; w < 8; ++w) { const int c = sh[w]; if (w < wid) base += c; tot += c; }
    total = tot;
    return base + incl - v;
}

DEVI void phase_topk(const float* aff, int* idx, float* gate, int* tokslot, unsigned char* lds, int bid, int nblk) {
    int* hist = (int*)lds;
    int* sh = hist + 256;
    int* res = sh + 16;
    const int tid = tidx(), lane = tid & 63, wid = tid >> 6;
    for (int item = bid; item < kB * kE; item += nblk) {
        const int b = item >> 4, e = item & 15;
        const float* a = aff + (size_t)item * kS;
        unsigned key[16];
#pragma unroll
        for (int q = 0; q < 4; ++q) { const u32x4 v = *(const u32x4*)(a + tid * 16 + q * 4); key[q * 4 + 0] = v.x; key[q * 4 + 1] = v.y; key[q * 4 + 2] = v.z; key[q * 4 + 3] = v.w; }
        unsigned prefix = 0; int kk = kCap;
#pragma unroll 1
        for (int pass = 0; pass < 4; ++pass) {
            const int shift = 24 - 8 * pass;
            __syncthreads();
            if (tid < 256) hist[tid] = 0;
            __syncthreads();
#pragma unroll
            for (int i = 0; i < 16; ++i) { const bool in = (pass == 0) || ((key[i] >> (shift + 8)) == prefix); if (in) atomicAdd(&hist[(key[i] >> shift) & 255], 1); }
            __syncthreads();
            if (wid == 0) {
                int c[4], loc = 0;
#pragma unroll
                for (int j = 0; j < 4; ++j) { c[j] = hist[255 - 4 * lane - j]; loc += c[j]; }
                int incl = loc;
#pragma unroll
                for (int d = 1; d < 64; d <<= 1) { const int o = __shfl_up(incl, d); if (lane >= d) incl += o; }
                const int excl = incl - loc;
                if (excl < kk && kk <= incl) { int run = excl; int bin = 0, nk = 0; bool found = false;
#pragma unroll
                    for (int j = 0; j < 4; ++j) { if (!found && run + c[j] >= kk) { bin = 255 - 4 * lane - j; nk = kk - run; found = true; } if (!found) run += c[j]; }
                    res[0] = bin; res[1] = nk; }
            }
            __syncthreads();
            prefix = (prefix << 8) | (unsigned)res[0]; kk = res[1];
        }
        const unsigned T = prefix;
        int ceq = 0;
#pragma unroll
        for (int i = 0; i < 16; ++i) ceq += (key[i] == T) ? 1 : 0;
        int tot;
        int eqb = block_excl_scan(ceq, sh, tot);
        int csel = 0; unsigned selmask = 0;
#pragma unroll
        for (int i = 0; i < 16; ++i) { bool s = key[i] > T; if (key[i] == T) { s = eqb < kk; ++eqb; } if (s) { selmask |= 1u << i; ++csel; } }
        int slot = block_excl_scan(csel, sh, tot);
        const size_t rbase = (size_t)(e * kB + b) * kCap;
#pragma unroll
        for (int i = 0; i < 16; ++i) { const int s = tid * 16 + i; const bool sel = (selmask >> i) & 1u;
            if (sel) { idx[rbase + slot] = b * kS + s; gate[rbase + slot] = __uint_as_float(key[i]); }
            tokslot[((size_t)(b * kS + s)) * kE + e] = sel ? slot : -1;
            if (sel) ++slot; }
    }
    __syncthreads();
}

struct Unit { int pm, pn; };
DEVI bool unit_of(int Lid, int nM, int nN, Unit& u) {
    const int nwg = nM * nN; if (Lid >= nwg) return false;
    int wgid = Lid; { const int q = nwg / 8, r = nwg % 8, xcd = wgid % 8, off = wgid / 8; wgid = (xcd < r ? xcd * (q + 1) : r * (q + 1) + (xcd - r) * q) + off; }
    const int nig = 8 * nN, gid = wgid / nig, fm = gid * 8, gsz = (nM - fm) < 8 ? (nM - fm) : 8;
    u.pm = fm + ((wgid % nig) % gsz); u.pn = (wgid % nig) / gsz; return true;
}
struct GemmD { const bf16_t* A; const bf16_t* Bt; int lda, K, nM, nN; const int* rowidx; size_t bstride; int pmg; };

template <class Epi>
DEVI void gemm_simple(const GemmD g, const Epi& E, int bid, int nblk) {
    const int tid = tidx(), wid = tid >> 6, lane = tid & 63, wr = wid >> 2, wc = wid & 3, fr = lane & 15, fq = lane >> 4;
    for (int i = 0;; ++i) {
        Unit u; if (!unit_of(i * nblk + bid, g.nM, g.nN, u)) break;
        f32x4 acc[2][2][4][2];
#pragma unroll
        for (int a = 0; a < 2; ++a)
#pragma unroll
            for (int b = 0; b < 2; ++b)
#pragma unroll
                for (int m = 0; m < 4; ++m)
#pragma unroll
                    for (int n = 0; n < 2; ++n) acc[a][b][m][n] = (f32x4){0.f, 0.f, 0.f, 0.f};
        const bf16_t* Bu = g.Bt + (size_t)(u.pm / g.pmg) * g.bstride + (size_t)u.pn * 256 * g.K;
        unsigned ao[2][4], bo[2][2];
#pragma unroll
        for (int a = 0; a < 2; ++a)
#pragma unroll
            for (int m = 0; m < 4; ++m) { const int r = u.pm * 256 + 128 * a + 64 * wr + 16 * m + fr; const unsigned rr = g.rowidx ? (unsigned)g.rowidx[r] : (unsigned)r; ao[a][m] = rr * (unsigned)g.lda + 8u * fq; }
#pragma unroll
        for (int b = 0; b < 2; ++b)
#pragma unroll
            for (int n = 0; n < 2; ++n) bo[b][n] = (unsigned)(128 * b + 32 * wc + 16 * n + fr) * (unsigned)g.K + 8u * fq;
#pragma unroll 1
        for (int k0 = 0; k0 < g.K; k0 += 32) {
            bf16x8 av[2][4], bv[2][2];
#pragma unroll
            for (int a = 0; a < 2; ++a)
#pragma unroll
                for (int m = 0; m < 4; ++m) av[a][m] = *(const bf16x8*)(g.A + ao[a][m] + k0);
#pragma unroll
            for (int b = 0; b < 2; ++b)
#pragma unroll
                for (int n = 0; n < 2; ++n) bv[b][n] = *(const bf16x8*)(Bu + bo[b][n] + k0);
#pragma unroll
            for (int a = 0; a < 2; ++a)
#pragma unroll
                for (int b = 0; b < 2; ++b)
#pragma unroll
                    for (int m = 0; m < 4; ++m)
#pragma unroll
                        for (int n = 0; n < 2; ++n) acc[a][b][m][n] = __builtin_amdgcn_mfma_f32_16x16x32_bf16(bv[b][n], av[a][m], acc[a][b][m][n], 0, 0, 0);
        }
        E(acc, u, wr, wc, fr, fq);
    }
}


constexpr int PG_HTB = 128 * 64 * 2;
DEVI int pg_lds_byte(int r, int c) { const int st = (r >> 4) * 2 + (c >> 5), rr = r & 15, cc = c & 31, ob = rr * 64 + cc * 2; return st * 1024 + (ob ^ (((ob >> 9) & 1) << 5)); }
DEVI void pg_stage_rc(int b, int& R, int& C) { const int st = b / 1024, sb = b % 1024, swz = sb ^ (((sb >> 9) & 1) << 5); R = (st >> 1) * 16 + swz / 64; C = (st & 1) * 32 + (swz % 64) / 2; }

template <class Epi, bool ALIGN_EPI, bool SP2>
DEVI void gemm_engine(LAS unsigned char* lds, const GemmD g, const Epi& E, int bid, int nblk) {
    const int tid = tidx(), wid = __builtin_amdgcn_readfirstlane(tid >> 6), lane = tid & 63, wr = wid >> 2, wc = wid & 3, fr = lane & 15, fq = lane >> 4;
    const int K = g.K, nt = K / 64;
    int RA[2], CA[2]; unsigned voffB[2];
#pragma unroll
    for (int i = 0; i < 2; ++i) { pg_stage_rc(tid * 16 + i * 8192, RA[i], CA[i]); voffB[i] = (unsigned)(RA[i] * K + CA[i]) * 2u; }
    const size_t kstep = 128;
    const size_t hstepB = (size_t)128 * K * 2;
    const unsigned ldsw = (unsigned)wid * 1024u;
    const int aoff = pg_lds_byte(wr * 64 + fr, fq * 8), boff = pg_lds_byte(wc * 32 + fr, fq * 8);
#define PG8_SA(b, h) (((b) * 2 + (h)) * PG_HTB)
#define PG8_SB(b, h) ((4 + (b) * 2 + (h)) * PG_HTB)
#define PG8_STAGE(bufoff, gbase, voff) do { _Pragma("unroll") for (int _i = 0; _i < 2; ++_i) \
        __builtin_amdgcn_global_load_lds((const unsigned*)((const char*)(gbase) + (voff)[_i]), (LAS unsigned*)(lds + (bufoff) + ldsw + _i * 8192), 16, 0, 0); } while (0)
#define PG8_LDA(dst, b, h) do { _Pragma("unroll") for (int m = 0; m < 4; ++m) _Pragma("unroll") for (int k = 0; k < 2; ++k) dst[m][k] = *(const LAS bf16x8*)(lds + PG8_SA(b, h) + aoff + m * 2048 + k * 1024); } while (0)
#define PG8_LDB(dst, b, h) do { _Pragma("unroll") for (int n = 0; n < 2; ++n) _Pragma("unroll") for (int k = 0; k < 2; ++k) dst[n][k] = *(const LAS bf16x8*)(lds + PG8_SB(b, h) + boff + n * 2048 + k * 1024); } while (0)
#define PG8_MMA(ai, bj, At, Bt) do { __builtin_amdgcn_s_setprio(1); _Pragma("unroll") for (int m = 0; m < 4; ++m) _Pragma("unroll") for (int n = 0; n < 2; ++n) _Pragma("unroll") for (int k = 0; k < 2; ++k) \
        acc[ai][bj][m][n] = __builtin_amdgcn_mfma_f32_16x16x32_bf16(Bt[n][k], At[m][k], acc[ai][bj][m][n], 0, 0, 0); __builtin_amdgcn_s_setprio(0); } while (0)
#define PG8_WAIT_V(n) asm volatile("s_waitcnt vmcnt(" #n ")" ::: "memory")
#define PG8_WAIT_L(n) asm volatile("s_waitcnt lgkmcnt(" #n ")" ::: "memory")
#define PG8_BAR __builtin_amdgcn_s_barrier()
#define PG8_SCHED __builtin_amdgcn_sched_barrier(0)
#define PG8_VOFFA(dst, pm_) do { _Pragma("unroll") for (int _h = 0; _h < 2; ++_h) _Pragma("unroll") for (int _i = 0; _i < 2; ++_i) { const int _r = (pm_) * 256 + 128 * _h + RA[_i]; \
        const unsigned _rr = g.rowidx ? (unsigned)g.rowidx[_r] : (unsigned)_r; dst[_h][_i] = (_rr * (unsigned)g.lda + (unsigned)CA[_i]) * 2u; } } while (0)
    Unit cur, nxt, nn; int ui = 0;
    if (!unit_of(bid, g.nM, g.nN, cur)) return;
    f32x4 acc[2][2][4][2];
#pragma unroll
    for (int a = 0; a < 2; ++a)
#pragma unroll
        for (int b = 0; b < 2; ++b)
#pragma unroll
            for (int m = 0; m < 4; ++m)
#pragma unroll
                for (int n = 0; n < 2; ++n) acc[a][b][m][n] = (f32x4){0.f, 0.f, 0.f, 0.f};
    bf16x8 At[4][2], B0[2][2], B1[2][2];
    const char* const A0 = (const char*)g.A;
    const char* cB = (const char*)(g.Bt + (size_t)(cur.pm / g.pmg) * g.bstride + (size_t)cur.pn * 256 * K);
    unsigned cvA[2][2], nvA[2][2];
    PG8_VOFFA(cvA, cur.pm);
    { const bool hn = unit_of(nblk + bid, g.nM, g.nN, nxt); if (hn) PG8_VOFFA(nvA, nxt.pm); else { _Pragma("unroll") for (int h = 0; h < 2; ++h) _Pragma("unroll") for (int i = 0; i < 2; ++i) nvA[h][i] = cvA[h][i]; } }
    if constexpr (SP2) {
        PG8_STAGE(PG8_SB(0, 0), cB, voffB); PG8_STAGE(PG8_SB(0, 1), cB + hstepB, voffB); PG8_STAGE(PG8_SA(0, 0), A0, cvA[0]); PG8_STAGE(PG8_SA(0, 1), A0, cvA[1]);
        if (wr == 1) PG8_BAR;
        PG8_WAIT_V(2); PG8_BAR;
        PG8_STAGE(PG8_SB(1, 0), cB + kstep, voffB); PG8_STAGE(PG8_SA(1, 0), A0 + kstep, cvA[0]); PG8_STAGE(PG8_SB(1, 1), cB + hstepB + kstep, voffB);
        PG8_WAIT_V(6); PG8_BAR;
    } else {
        PG8_STAGE(PG8_SB(0, 0), cB, voffB); PG8_STAGE(PG8_SA(0, 0), A0, cvA[0]); PG8_STAGE(PG8_SB(0, 1), cB + hstepB, voffB); PG8_STAGE(PG8_SA(0, 1), A0, cvA[1]);
        if (wr == 1) PG8_BAR;
        PG8_WAIT_V(4); PG8_BAR;
        PG8_STAGE(PG8_SB(1, 0), cB + kstep, voffB); PG8_STAGE(PG8_SA(1, 0), A0 + kstep, cvA[0]); PG8_STAGE(PG8_SB(1, 1), cB + hstepB + kstep, voffB);
        PG8_WAIT_V(6); PG8_BAR;
    }
    for (;;) {
        const bool has_next = unit_of((ui + 1) * nblk + bid, g.nM, g.nN, nxt);
        const char* nB = has_next ? (const char*)(g.Bt + (size_t)(nxt.pm / g.pmg) * g.bstride + (size_t)nxt.pn * 256 * K) : cB;
        for (int t = 0; t < nt; t += 2) {
            const bool last = (t == nt - 2);
            const char* a1 = A0 + (size_t)(t + 1) * kstep;
            const char* a2 = last ? A0 : A0 + (size_t)(t + 2) * kstep; const char* b2 = last ? nB : cB + (size_t)(t + 2) * kstep;
            const char* a3 = a2 + kstep; const char* b3 = b2 + kstep;
            unsigned v2[2][2];
#pragma unroll
            for (int h = 0; h < 2; ++h)
#pragma unroll
                for (int i = 0; i < 2; ++i) v2[h][i] = last ? nvA[h][i] : cvA[h][i];
            if constexpr (SP2) {
            PG8_LDB(B0, 0, 0); PG8_LDB(B1, 0, 1); PG8_SCHED; PG8_LDA(At, 0, 0); PG8_STAGE(PG8_SA(1, 1), a1, cvA[1]);
            PG8_WAIT_V(8); PG8_WAIT_L(0); PG8_BAR; PG8_MMA(0, 0, At, B0); PG8_MMA(0, 1, At, B1); PG8_BAR; PG8_SCHED;
            PG8_LDA(At, 0, 1); PG8_STAGE(PG8_SB(0, 0), b2, voffB); PG8_STAGE(PG8_SB(0, 1), b2 + hstepB, voffB); PG8_STAGE(PG8_SA(0, 0), a2, v2[0]);
            PG8_WAIT_V(8); PG8_WAIT_L(0); PG8_BAR; PG8_MMA(1, 0, At, B0); PG8_MMA(1, 1, At, B1); PG8_BAR; PG8_SCHED;
            PG8_LDB(B0, 1, 0); PG8_LDB(B1, 1, 1); PG8_SCHED; PG8_LDA(At, 1, 0); PG8_STAGE(PG8_SA(0, 1), a2, v2[1]);
            PG8_WAIT_V(8); PG8_WAIT_L(0); PG8_BAR; PG8_MMA(0, 0, At, B0); PG8_MMA(0, 1, At, B1); PG8_BAR; PG8_SCHED;
            PG8_LDA(At, 1, 1); PG8_STAGE(PG8_SB(1, 0), b3, voffB); PG8_STAGE(PG8_SB(1, 1), b3 + hstepB, voffB); PG8_STAGE(PG8_SA(1, 0), a3, v2[0]);
            PG8_WAIT_V(8); PG8_WAIT_L(0); PG8_BAR; PG8_MMA(1, 0, At, B0); PG8_MMA(1, 1, At, B1); PG8_BAR; PG8_SCHED;
            } else {
            PG8_LDB(B0, 0, 0); PG8_SCHED; PG8_LDA(At, 0, 0); PG8_STAGE(PG8_SA(1, 1), a1, cvA[1]);
            PG8_WAIT_L(8); PG8_BAR; PG8_WAIT_L(0); PG8_MMA(0, 0, At, B0); PG8_BAR; PG8_SCHED;
            PG8_LDB(B1, 0, 1); PG8_STAGE(PG8_SB(0, 0), b2, voffB);
            PG8_BAR; PG8_WAIT_L(0); PG8_MMA(0, 1, At, B1); PG8_BAR;
            PG8_LDA(At, 0, 1); PG8_STAGE(PG8_SA(0, 0), a2, v2[0]);
            PG8_BAR; PG8_WAIT_L(0); PG8_MMA(1, 0, At, B0); PG8_BAR; PG8_SCHED;
            PG8_STAGE(PG8_SB(0, 1), b2 + hstepB, voffB);
            PG8_WAIT_V(6); PG8_BAR; PG8_MMA(1, 1, At, B1); PG8_BAR;
            PG8_LDB(B0, 1, 0); PG8_SCHED; PG8_LDA(At, 1, 0); PG8_STAGE(PG8_SA(0, 1), a2, v2[1]);
            PG8_WAIT_L(8); PG8_BAR; PG8_WAIT_L(0); PG8_MMA(0, 0, At, B0); PG8_BAR; PG8_SCHED;
            PG8_LDB(B1, 1, 1); PG8_STAGE(PG8_SB(1, 0), b3, voffB);
            PG8_BAR; PG8_WAIT_L(0); PG8_MMA(0, 1, At, B1); PG8_BAR;
            PG8_LDA(At, 1, 1); PG8_STAGE(PG8_SA(1, 0), a3, v2[0]);
            PG8_BAR; PG8_WAIT_L(0); PG8_MMA(1, 0, At, B0); PG8_BAR; PG8_SCHED;
            PG8_STAGE(PG8_SB(1, 1), b3 + hstepB, voffB);
            PG8_WAIT_V(6); PG8_BAR; PG8_MMA(1, 1, At, B1); PG8_BAR;
            }
        }
        if constexpr (ALIGN_EPI) { if (wr == 0) PG8_BAR; }
        const bool has_nn = has_next && unit_of((ui + 2) * nblk + bid, g.nM, g.nN, nn);
        int ridx[2][2];
        if (g.rowidx && has_nn) {
#pragma unroll
            for (int h = 0; h < 2; ++h)
#pragma unroll
                for (int i = 0; i < 2; ++i) ridx[h][i] = g.rowidx[nn.pm * 256 + 128 * h + RA[i]];
        }
        E(acc, cur, wr, wc, fr, fq);
        if (!has_next) break;
#pragma unroll
        for (int a = 0; a < 2; ++a)
#pragma unroll
            for (int b = 0; b < 2; ++b)
#pragma unroll
                for (int m = 0; m < 4; ++m)
#pragma unroll
                    for (int n = 0; n < 2; ++n) acc[a][b][m][n] = (f32x4){0.f, 0.f, 0.f, 0.f};
        cur = nxt; cB = nB; ++ui;
#pragma unroll
        for (int h = 0; h < 2; ++h)
#pragma unroll
            for (int i = 0; i < 2; ++i) { cvA[h][i] = nvA[h][i];
                if (has_nn) { const unsigned rr = g.rowidx ? (unsigned)ridx[h][i] : (unsigned)(nn.pm * 256 + 128 * h + RA[i]); nvA[h][i] = (rr * (unsigned)g.lda + (unsigned)CA[i]) * 2u; } }
        if constexpr (ALIGN_EPI) { if (wr == 1) PG8_BAR; }
    }
    PG8_WAIT_V(0);
    if constexpr (!ALIGN_EPI) { if (wr == 0) PG8_BAR; }
    PG8_BAR;
#undef PG8_SA
#undef PG8_SB
#undef PG8_STAGE
#undef PG8_LDA
#undef PG8_LDB
#undef PG8_MMA
#undef PG8_WAIT_V
#undef PG8_WAIT_L
#undef PG8_BAR
#undef PG8_SCHED
#undef PG8_VOFFA
}

struct EpiQKV {
    bf16_t *qa, *ka, *va, *qb, *kb, *vb, *ux; const float *qna, *kna, *qnb, *knb;
    DEVI void operator()(const f32x4 (&acc)[2][2][4][2], const Unit& u, int wr, int wc, int fr, int fq) const {
        bf16_t* dst; const float* gn = nullptr; int H = 8, head0 = 0; const int pn = u.pn;
        if (pn < 2) { dst = qa; gn = qna; head0 = pn * 4; }
        else if (pn < 4) { dst = ka; gn = kna; head0 = (pn - 2) * 4; }
        else if (pn < 6) { dst = va; head0 = (pn - 4) * 4; }
        else if (pn == 6) { dst = qb; gn = qnb; H = 4; }
        else if (pn == 7) { dst = kb; gn = knb; H = 4; }
        else if (pn == 8) { dst = vb; H = 4; }
        else { dst = ux; }
        const int head = head0 + wc;
        f32x4 gv[2][2];
#pragma unroll
        for (int bj = 0; bj < 2; ++bj)
#pragma unroll
            for (int n = 0; n < 2; ++n) gv[bj][n] = gn ? *(const f32x4*)(gn + 32 * bj + 8 * fq + 4 * n) : (f32x4){1.f, 1.f, 1.f, 1.f};
#pragma unroll
        for (int ai = 0; ai < 2; ++ai)
#pragma unroll
            for (int m = 0; m < 4; ++m) {
                const int row = u.pm * 256 + 128 * ai + 64 * wr + 16 * m + fr;
                float rstd = 1.f;
                if (gn) { float ss = 0.f;
#pragma unroll
                    for (int bj = 0; bj < 2; ++bj)
#pragma unroll
                        for (int n = 0; n < 2; ++n) { const f32x4 v = acc[ai][bj][m][n]; ss += v.x * v.x + v.y * v.y + v.z * v.z + v.w * v.w; }
                    ss += __shfl_xor(ss, 16); ss += __shfl_xor(ss, 32);
                    rstd = rsqrtf(ss * (1.f / 64.f) + kEps); }
#pragma unroll
                for (int bj = 0; bj < 2; ++bj) {
                    const f32x4 v0 = acc[ai][bj][m][0] * rstd * gv[bj][0], v1 = acc[ai][bj][m][1] * rstd * gv[bj][1];
                    u32x4 w; w.x = pk2(v0.x, v0.y); w.y = pk2(v0.z, v0.w); w.z = pk2(v1.x, v1.y); w.w = pk2(v1.z, v1.w);
                    if (pn < 9) { const int b = row >> 13, s = row & (kS - 1);
                        *(u32x4*)(dst + (((size_t)(b * H + head)) * kS + s) * 64 + 32 * bj + 8 * fq) = w; }
                    else { const int gidx = 4 * wc + 2 * bj + (fq >> 1), c0 = 8 * (fq & 1);
                        *(u32x4*)(dst + ((size_t)gidx * 4096 + (row >> 4)) * 512 + (row & 15) * 16 + c0) = w; }
                }
            }
    }
};
struct EpiResid {
    const float* xin; float* xout;
    DEVI void operator()(const f32x4 (&acc)[2][2][4][2], const Unit& u, int wr, int wc, int fr, int fq) const {
#pragma unroll
        for (int ai = 0; ai < 2; ++ai)
#pragma unroll
            for (int m = 0; m < 4; ++m) { const size_t ro = (size_t)(u.pm * 256 + 128 * ai + 64 * wr + 16 * m + fr) * kD + u.pn * 256 + 32 * wc + 4 * fq;
#pragma unroll
                for (int bj = 0; bj < 2; ++bj)
#pragma unroll
                    for (int n = 0; n < 2; ++n) { const size_t o = ro + 128 * bj + 16 * n; *(f32x4*)(xout + o) = *(const f32x4*)(xin + o) + acc[ai][bj][m][n]; } }
    }
};
struct EpiGU {
    bf16_t* hid;
    DEVI void operator()(const f32x4 (&acc)[2][2][4][2], const Unit& u, int wr, int wc, int fr, int fq) const {
#pragma unroll
        for (int ai = 0; ai < 2; ++ai)
#pragma unroll
            for (int m = 0; m < 4; ++m) { const size_t row = (size_t)(u.pm * 256 + 128 * ai + 64 * wr + 16 * m + fr);
                float o[8];
#pragma unroll
                for (int n = 0; n < 2; ++n)
#pragma unroll
                    for (int j = 0; j < 4; ++j) { const float gt = acc[ai][0][m][n][j], up = acc[ai][1][m][n][j]; o[n * 4 + j] = gt / (1.f + __expf(-gt)) * up; }
                u32x4 w; w.x = pk2(o[0], o[1]); w.y = pk2(o[2], o[3]); w.z = pk2(o[4], o[5]); w.w = pk2(o[6], o[7]);
                *(u32x4*)(hid + row * kFF + u.pn * 128 + 32 * wc + 8 * fq) = w; }
    }
};
struct EpiDown {
    bf16_t* y; const float* gate;
    DEVI void operator()(const f32x4 (&acc)[2][2][4][2], const Unit& u, int wr, int wc, int fr, int fq) const {
#pragma unroll
        for (int ai = 0; ai < 2; ++ai)
#pragma unroll
            for (int m = 0; m < 4; ++m) { const size_t row = (size_t)(u.pm * 256 + 128 * ai + 64 * wr + 16 * m + fr); const float gv = gate[row];
#pragma unroll
                for (int bj = 0; bj < 2; ++bj) { const f32x4 v0 = acc[ai][bj][m][0] * gv, v1 = acc[ai][bj][m][1] * gv;
                    u32x4 w; w.x = pk2(v0.x, v0.y); w.y = pk2(v0.z, v0.w); w.z = pk2(v1.x, v1.y); w.w = pk2(v1.z, v1.w);
                    *(u32x4*)(y + row * kD + u.pn * 256 + 128 * bj + 32 * wc + 8 * fq) = w; } }
    }
};
struct EpiGlu {
    const bf16_t* g; bf16_t* oc;
    DEVI void operator()(const f32x4 (&acc)[2][2][4][2], const Unit& u, int wr, int wc, int fr, int fq) const {
#pragma unroll
        for (int ai = 0; ai < 2; ++ai)
#pragma unroll
            for (int m = 0; m < 4; ++m) { const size_t row = (size_t)(u.pm * 256 + 128 * ai + 64 * wr + 16 * m + fr);
#pragma unroll
                for (int bj = 0; bj < 2; ++bj) { const size_t o = row * 256 + 128 * bj + 32 * wc + 8 * fq;
                    const u32x4 gw = *(const u32x4*)(g + o); float o8[8];
#pragma unroll
                    for (int n = 0; n < 2; ++n)
#pragma unroll
                        for (int j = 0; j < 4; ++j) { const int t = n * 4 + j; const unsigned wv = (t < 2) ? gw.x : (t < 4) ? gw.y : (t < 6) ? gw.z : gw.w;
                            const float gg = __uint_as_float((t & 1) ? (wv & 0xFFFF0000u) : (wv << 16)); o8[t] = gg / (1.f + __expf(-acc[ai][bj][m][n][j])); }
                    u32x4 w; w.x = pk2(o8[0], o8[1]); w.y = pk2(o8[2], o8[3]); w.z = pk2(o8[4], o8[5]); w.w = pk2(o8[6], o8[7]);
                    *(u32x4*)(oc + o) = w; } }
    }
};

DEVI void load_row64(const bf16_t* p, float* d) {
#pragma unroll
    for (int i = 0; i < 8; ++i) { const u32x4 v = *(const u32x4*)(p + i * 8);
        d[i * 8 + 0] = __uint_as_float(v.x << 16); d[i * 8 + 1] = __uint_as_float(v.x & 0xFFFF0000u); d[i * 8 + 2] = __uint_as_float(v.y << 16); d[i * 8 + 3] = __uint_as_float(v.y & 0xFFFF0000u);
        d[i * 8 + 4] = __uint_as_float(v.z << 16); d[i * 8 + 5] = __uint_as_float(v.z & 0xFFFF0000u); d[i * 8 + 6] = __uint_as_float(v.w << 16); d[i * 8 + 7] = __uint_as_float(v.w & 0xFFFF0000u); }
}
DEVI void store_row64(bf16_t* p, const float* d, float sc) {
#pragma unroll
    for (int i = 0; i < 8; ++i) { u32x4 w; w.x = pk2(d[i * 8] * sc, d[i * 8 + 1] * sc); w.y = pk2(d[i * 8 + 2] * sc, d[i * 8 + 3] * sc); w.z = pk2(d[i * 8 + 4] * sc, d[i * 8 + 5] * sc); w.w = pk2(d[i * 8 + 6] * sc, d[i * 8 + 7] * sc);
        *(u32x4*)(p + i * 8) = w; }
}
DEVI void phase_dilated_naive(const bf16_t* qa, const bf16_t* ka, const bf16_t* va, bf16_t* oac, float* lse, int bid, int nblk) {
    const int nitems = 3 * kB * 8 * (kS / kNT);
    for (int it = bid; it < nitems; it += nblk) {
        const int c = it / (kB * 8 * 16), r = it % (kB * 8 * 16), bh = r / 16, t = (r % 16) * kNT + tidx(), b = bh >> 3, h = bh & 7;
        const int dil = (c == 0) ? 1 : (c == 1) ? 4 : 16;
        const float slope = exp2f(-(float)(h + 1));
        const bf16_t* kb_ = ka + (size_t)bh * kS * 64; const bf16_t* vb_ = va + (size_t)bh * kS * 64;
        float q[64], o[64];
        load_row64(qa + ((size_t)bh * kS + t) * 64, q);
#pragma unroll
        for (int d = 0; d < 64; ++d) o[d] = 0.f;
        float m = -1e30f, l = 0.f;
        for (int rel = -64; rel <= 64; ++rel) {
            const int pos = t + rel * dil;
            if (pos < 0 || pos >= kS) continue;
            float kv[64]; load_row64(kb_ + (size_t)pos * 64, kv);
            float dot = 0.f;
#pragma unroll
            for (int d = 0; d < 64; ++d) dot += q[d] * kv[d];
            const float sc = dot * 0.125f - slope * (float)(dil * (rel < 0 ? -rel : rel));
            const float mn = fmaxf(m, sc), corr = __expf(m - mn), p = __expf(sc - mn);
            load_row64(vb_ + (size_t)pos * 64, kv);
            l = l * corr + p;
#pragma unroll
            for (int d = 0; d < 64; ++d) o[d] = o[d] * corr + p * kv[d];
            m = mn;
        }
        const size_t tok = (size_t)b * kS + t;
        store_row64(oac + ((size_t)c * kTok + tok) * 512 + h * 64, o, 1.f / l);
        lse[((size_t)c * kTok + tok) * 8 + h] = m + __logf(l);
    }
}
DEVI void phase_na_naive(const bf16_t* qb, const bf16_t* kbuf, const bf16_t* vbuf, const float* rpb  , bf16_t* ob, int bid, int nblk) {
    const int nitems = kB * 4 * (kS / kNT);
    for (int it = bid; it < nitems; it += nblk) {
        const int bh = it / 16, t = (it % 16) * kNT + tidx(), b = bh >> 2, h = bh & 3;
        const int r = t >> 6, cq = t & 63;
        int rs = r - 4; rs = rs < 0 ? 0 : (rs > 120 ? 120 : rs);
        int cs = cq - 8; cs = cs < 0 ? 0 : (cs > 48 ? 48 : cs);
        const bf16_t* kb_ = kbuf + (size_t)bh * kS * 64; const bf16_t* vb_ = vbuf + (size_t)bh * kS * 64;
        float q[64], o[64];
        load_row64(qb + ((size_t)bh * kS + t) * 64, q);
#pragma unroll
        for (int d = 0; d < 64; ++d) o[d] = 0.f;
        float m = -1e30f, l = 0.f;
        for (int kr = 0; kr < 8; ++kr)
            for (int kc = 0; kc < 16; ++kc) {
                const int krow = rs + kr, kcol = cs + kc, pos = krow * 64 + kcol;
                float kv[64]; load_row64(kb_ + (size_t)pos * 64, kv);
                float dot = 0.f;
#pragma unroll
                for (int d = 0; d < 64; ++d) dot += q[d] * kv[d];
                const float sc = dot * 0.125f + rpb[(h * 15 + (krow - r + 7)) * 31 + (kcol - cq + 15)];
                const float mn = fmaxf(m, sc), corr = __expf(m - mn), p = __expf(sc - mn);
                load_row64(vb_ + (size_t)pos * 64, kv);
                l = l * corr + p;
#pragma unroll
                for (int d = 0; d < 64; ++d) o[d] = o[d] * corr + p * kv[d];
                m = mn;
            }
        store_row64(ob + ((size_t)b * kS + t) * 256 + h * 64, o, 1.f / l);
    }
}

typedef float f32x16 __attribute__((ext_vector_type(16)));
typedef short s16x4 __attribute__((ext_vector_type(4)));
constexpr float kLog2e = 1.4426950408889634f, kLn2 = 0.6931471805599453f;
DEVI bf16x8 tr_pair(LAS unsigned char* p0, LAS unsigned char* p1) {
    const s16x4 a = __builtin_amdgcn_ds_read_tr16_b64_v4i16((LAS s16x4*)p0), b = __builtin_amdgcn_ds_read_tr16_b64_v4i16((LAS s16x4*)p1);
    return (bf16x8){a.x, a.y, a.z, a.w, b.x, b.y, b.z, b.w};
}
DEVI void phase_dilated(const bf16_t* qa, const bf16_t* ka, const bf16_t* va, bf16_t* oac, float* lse, LAS unsigned char* lds, int bid, int nblk) {
    const int tid = tidx(), wid = __builtin_amdgcn_readfirstlane(tid >> 6), lane = tid & 63, h5 = lane >> 5, qc = lane & 31;
    LAS unsigned char* Kimg = lds; LAS unsigned char* Vimg = lds + 49152;
    unsigned koff[4];
#pragma unroll
    for (int s = 0; s < 4; ++s) koff[s] = (unsigned)((32 * wid + qc) * 128 + (((2 * s + h5) ^ (qc & 7)) << 4));
    unsigned voff[2];
    { const int g = lane >> 4, i16 = lane & 15, q = i16 >> 2, p = i16 & 3;
#pragma unroll
      for (int dt = 0; dt < 2; ++dt) { const int c = (2 * (g & 1) + (p >> 1) + 4 * dt) ^ ((q >> 1) << 2); voff[dt] = (unsigned)((32 * wid + 4 * h5 + q) * 128 + (c << 4) + 8 * (p & 1)); } }
    for (int unit = bid; unit < 6144; unit += nblk) {
        const int c = unit >> 11, rem = unit & 2047, bh = rem >> 5, ub = rem & 31;
        const int dsh = 2 * c, dil = 1 << dsh, L = kS >> dsh, upc = 32 >> dsh, cls = ub >> (5 - dsh), u0 = (ub & (upc - 1)) << 8;
        const bf16_t* kbase = ka + (size_t)bh * kS * 64; const bf16_t* vbase = va + (size_t)bh * kS * 64;
        __syncthreads();
#pragma unroll
        for (int it = 0; it < 6; ++it) {
            const int id = it * kNT + tid, row = id >> 3, ch = id & 7;
            int ki = u0 - 64 + row; ki = ki < 0 ? 0 : (ki > L - 1 ? L - 1 : ki);
            const size_t tok = (size_t)((ki << dsh) + cls);
            const u32x4 kv = *(const u32x4*)(kbase + tok * 64 + ch * 8), vv = *(const u32x4*)(vbase + tok * 64 + ch * 8);
            *(LAS u32x4*)(Kimg + row * 128 + ((ch ^ (row & 7)) << 4)) = kv;
            *(LAS u32x4*)(Vimg + row * 128 + ((ch ^ (((row >> 1) & 1) << 2)) << 4)) = vv;
        }
        __syncthreads();
        const int q0 = u0 + 32 * wid, qtok = ((q0 + qc) << dsh) + cls;
        bf16x8 Qf[4];
#pragma unroll
        for (int s = 0; s < 4; ++s) Qf[s] = *(const bf16x8*)(qa + ((size_t)bh * kS + qtok) * 64 + 16 * s + 8 * h5);
        f32x16 S[5];
#pragma unroll
        for (int kt = 0; kt < 5; ++kt) {
#pragma unroll
            for (int i = 0; i < 16; ++i) S[kt][i] = 0.f;
#pragma unroll
            for (int s = 0; s < 4; ++s) { const bf16x8 Kf = *(const LAS bf16x8*)(Kimg + koff[s] + kt * 4096); S[kt] = __builtin_amdgcn_mfma_f32_32x32x16_bf16(Kf, Qf[s], S[kt], 0, 0, 0); }
        }
        const float slope = exp2f(-(float)((bh & 7) + 1));
        const float c1 = 0.125f * kLog2e, c2 = slope * (float)dil * kLog2e;
        float mx = -1e30f;
        int qcv = qc; asm volatile("" : "+v"(qcv));
#pragma unroll
        for (int kt = 0; kt < 5; ++kt)
#pragma unroll
            for (int i = 0; i < 16; ++i) {
                const int kr = (i & 3) + 8 * (i >> 2) + 4 * h5, rel = 32 * kt + kr - 64 - qcv, kpos = q0 - 64 + 32 * kt + kr;
                const float relf = fabsf((float)rel);
                const bool valid = ((unsigned)kpos < (unsigned)L) && (relf <= 64.f);
                const float sv = valid ? (S[kt][i] * c1 - c2 * relf) : -1e30f;
                S[kt][i] = sv; mx = fmaxf(mx, sv);
            }
        mx = fmaxf(mx, __shfl_xor(mx, 32));
        float sum = 0.f;
#pragma unroll
        for (int kt = 0; kt < 5; ++kt)
#pragma unroll
            for (int i = 0; i < 16; ++i) { const float pv = __builtin_amdgcn_exp2f(S[kt][i] - mx); S[kt][i] = pv; sum += pv; }
        sum += __shfl_xor(sum, 32);
        f32x16 O[2];
#pragma unroll
        for (int dt = 0; dt < 2; ++dt)
#pragma unroll
            for (int i = 0; i < 16; ++i) O[dt][i] = 0.f;
#pragma unroll
        for (int kt = 0; kt < 5; ++kt)
#pragma unroll
            for (int s2 = 0; s2 < 2; ++s2) {
                u32x4 pw; pw.x = pk2(S[kt][8 * s2 + 0], S[kt][8 * s2 + 1]); pw.y = pk2(S[kt][8 * s2 + 2], S[kt][8 * s2 + 3]); pw.z = pk2(S[kt][8 * s2 + 4], S[kt][8 * s2 + 5]); pw.w = pk2(S[kt][8 * s2 + 6], S[kt][8 * s2 + 7]);
                const bf16x8 Pf = __builtin_bit_cast(bf16x8, pw);
#pragma unroll
                for (int dt = 0; dt < 2; ++dt) { LAS unsigned char* vp = Vimg + voff[dt] + kt * 4096 + s2 * 2048;
                    const bf16x8 Vf = tr_pair(vp, vp + 1024);
                    O[dt] = __builtin_amdgcn_mfma_f32_32x32x16_bf16(Vf, Pf, O[dt], 0, 0, 0); }
            }
        const float inv = 1.f / sum;
        const size_t tok = (size_t)(bh >> 3) * kS + qtok;
        bf16_t* orow = oac + ((size_t)c * kTok + tok) * 512 + (bh & 7) * 64;
#pragma unroll
        for (int dt = 0; dt < 2; ++dt)
#pragma unroll
            for (int g4 = 0; g4 < 4; ++g4) { u32x2 w; w.x = pk2(O[dt][4 * g4] * inv, O[dt][4 * g4 + 1] * inv); w.y = pk2(O[dt][4 * g4 + 2] * inv, O[dt][4 * g4 + 3] * inv);
                *(u32x2*)(orow + 32 * dt + 8 * g4 + 4 * h5) = w; }
        if (h5 == 0) lse[((size_t)c * kTok + tok) * 8 + (bh & 7)] = mx * kLn2 + __logf(sum);
    }
    __syncthreads();
}
DEVI void phase_na(const bf16_t* qb, const bf16_t* kb, const bf16_t* vb, const float* rpb  , bf16_t* ob, LAS unsigned char* lds, int bid, int nblk) {
    const int tid = tidx(), wid = __builtin_amdgcn_readfirstlane(tid >> 6), lane = tid & 63, g4 = lane >> 4, i16 = lane & 15;
    LAS unsigned char* Kimg = lds; LAS unsigned char* Vimg = lds + 73728; LAS float* tab = (LAS float*)(lds + 147456);
    for (int i = tid; i < 4 * 465; i += kNT) tab[i] = rpb[i];
    const int g = wid & 3, kcs = (16 * g - 8) < 0 ? 0 : ((16 * g - 8) > 32 ? 32 : (16 * g - 8));
    const int qcol = 16 * g + i16, cs = (qcol - 8) < 0 ? 0 : ((qcol - 8) > 48 ? 48 : (qcol - 8));
    unsigned kswz[2];
#pragma unroll
    for (int s = 0; s < 2; ++s) kswz[s] = (unsigned)(((4 * s + g4) ^ (i16 & 7)) << 4);
    const int q = i16 >> 2, p = i16 & 3, sw = 2 * (g4 & 1) + (q >> 1);
    unsigned vsw[4];
#pragma unroll
    for (int dt = 0; dt < 4; ++dt) vsw[dt] = (unsigned)((((2 * dt + (p >> 1)) ^ (sw << 1)) << 4) + 8 * (p & 1));
    for (int unit = bid; unit < 2048; unit += nblk) {
        const int bh = unit >> 6, rp = unit & 63, r0 = 2 * rp, h = bh & 3;
        const int rsA = (r0 - 4) < 0 ? 0 : ((r0 - 4) > 120 ? 120 : (r0 - 4));
        const bf16_t* kbase = kb + (size_t)bh * kS * 64; const bf16_t* vbase = vb + (size_t)bh * kS * 64;
        __syncthreads();
#pragma unroll
        for (int it = 0; it < 9; ++it) {
            const int id = it * kNT + tid, row = id >> 3, ch = id & 7;
            int gr = rsA + (row >> 6); gr = gr > 127 ? 127 : gr;
            const size_t tok = (size_t)(gr * 64 + (row & 63));
            const u32x4 kv = *(const u32x4*)(kbase + tok * 64 + ch * 8), vv = *(const u32x4*)(vbase + tok * 64 + ch * 8);
            *(LAS u32x4*)(Kimg + row * 128 + ((ch ^ (row & 7)) << 4)) = kv;
            *(LAS u32x4*)(Vimg + row * 128 + ((ch ^ (((row >> 1) & 3) << 1)) << 4)) = vv;
        }
        __syncthreads();
        const int rr = r0 + (wid >> 2);
        const int rs = (rr - 4) < 0 ? 0 : ((rr - 4) > 120 ? 120 : (rr - 4)), ro = rs - rsA;
        const int qtok = rr * 64 + qcol;
        bf16x8 Qf[2];
#pragma unroll
        for (int s = 0; s < 2; ++s) Qf[s] = *(const bf16x8*)(qb + ((size_t)bh * kS + qtok) * 64 + 32 * s + 8 * g4);
        f32x4 S[16];
        const unsigned kb0 = (unsigned)((ro * 64 + kcs + i16) * 128);
#pragma unroll
        for (int t = 0; t < 16; ++t) { S[t] = (f32x4){0.f, 0.f, 0.f, 0.f};
#pragma unroll
            for (int s = 0; s < 2; ++s) { const bf16x8 Kf = *(const LAS bf16x8*)(Kimg + kb0 + (t >> 1) * 8192 + (t & 1) * 2048 + kswz[s]); S[t] = __builtin_amdgcn_mfma_f32_16x16x32_bf16(Kf, Qf[s], S[t], 0, 0, 0); } }
        float mx = -1e30f;
        const LAS float* th = tab + h * 465;
        int g4v = g4; asm volatile("" : "+v"(g4v));
#pragma unroll
        for (int t = 0; t < 16; ++t)
#pragma unroll
            for (int j = 0; j < 4; ++j) {
                const int krow = rs + (t >> 1), kcol = kcs + 16 * (t & 1) + 4 * g4v + j;
                const bool valid = (kcol >= cs) && (kcol < cs + 16);
                int dc = kcol - qcol + 15; dc = dc < 0 ? 0 : (dc > 30 ? 30 : dc);
                const float bias = th[(krow - rr + 7) * 31 + dc];
                const float sv = valid ? (S[t][j] * 0.125f + bias) * kLog2e : -1e30f;
                S[t][j] = sv; mx = fmaxf(mx, sv);
            }
        mx = fmaxf(mx, __shfl_xor(mx, 16)); mx = fmaxf(mx, __shfl_xor(mx, 32));
        float sum = 0.f;
#pragma unroll
        for (int t = 0; t < 16; ++t)
#pragma unroll
            for (int j = 0; j < 4; ++j) { const float pv = __builtin_amdgcn_exp2f(S[t][j] - mx); S[t][j] = pv; sum += pv; }
        sum += __shfl_xor(sum, 16); sum += __shfl_xor(sum, 32);
        f32x4 O[4];
#pragma unroll
        for (int dt = 0; dt < 4; ++dt) O[dt] = (f32x4){0.f, 0.f, 0.f, 0.f};
        const unsigned vb0 = (unsigned)((ro * 64 + kcs + 4 * g4 + q) * 128);
#pragma unroll
        for (int u = 0; u < 8; ++u) {
            u32x4 pw; pw.x = pk2(S[2 * u][0], S[2 * u][1]); pw.y = pk2(S[2 * u][2], S[2 * u][3]); pw.z = pk2(S[2 * u + 1][0], S[2 * u + 1][1]); pw.w = pk2(S[2 * u + 1][2], S[2 * u + 1][3]);
            const bf16x8 Pf = __builtin_bit_cast(bf16x8, pw);
#pragma unroll
            for (int dt = 0; dt < 4; ++dt) { LAS unsigned char* vp = Vimg + vb0 + u * 8192 + vsw[dt];
                const bf16x8 Vf = tr_pair(vp, vp + 2048);
                O[dt] = __builtin_amdgcn_mfma_f32_16x16x32_bf16(Vf, Pf, O[dt], 0, 0, 0); }
        }
        const float inv = 1.f / sum;
        bf16_t* orow = ob + ((size_t)(bh >> 2) * kS + qtok) * 256 + h * 64;
#pragma unroll
        for (int dt = 0; dt < 4; ++dt) { u32x2 w; w.x = pk2(O[dt][0] * inv, O[dt][1] * inv); w.y = pk2(O[dt][2] * inv, O[dt][3] * inv); *(u32x2*)(orow + 16 * dt + 4 * g4) = w; }
    }
    __syncthreads();
}
DEVI void phase_s5_naive(const Params& P, int l, const bf16_t* ux, float* ys, unsigned char* lds, int bid, int nblk) {
    const int wid = tidx() >> 6, lane = tidx() & 63;
    float* xs = (float*)lds + wid * 128;
    for (int item = wid * nblk + bid; item < kB * 16 * 2; item += nblk * 8) {
        const int dir = item & 1, g = (item >> 1) & 15, b = item >> 5;
        const size_t pbase = (((size_t)l * 2 + dir) * 16 + g) * 64;
        const float dt = __expf(P.s5_log_dt[((size_t)l * 2 + dir) * 16 + g]);
        const float a = fminf(P.s5_a_re[pbase + lane], -1e-4f), w = P.s5_a_im[pbase + lane];
        const float mag = __expf(a * dt), ar = mag * cosf(w * dt), ai = mag * sinf(w * dt);
        const float den = a * a + w * w, zr = ar - 1.f, gr = (zr * a + ai * w) / den, gi = (ai * a - zr * w) / den;
        float bbr[16], bbi[16];
#pragma unroll
        for (int c = 0; c < 16; ++c) { const float br = P.s5_b_re[(pbase + lane) * 16 + c], bi = P.s5_b_im[(pbase + lane) * 16 + c]; bbr[c] = gr * br - gi * bi; bbi[c] = gr * bi + gi * br; }
        const int cch = lane & 15, qt = lane >> 4;
        float cre[16], cim[16];
#pragma unroll
        for (int pp = 0; pp < 16; ++pp) { cre[pp] = P.s5_c_re[(pbase / 64 * 16 + cch) * 64 + qt * 16 + pp]; cim[pp] = P.s5_c_im[(pbase / 64 * 16 + cch) * 64 + qt * 16 + pp]; }
        float xr = 0.f, xi = 0.f;
        const bf16_t* ug = ux + (size_t)g * 4096 * 512;
        for (int st = 0; st < kS; ++st) {
            const int s = dir ? (kS - 1 - st) : st; const size_t tok = (size_t)b * kS + s;
            const bf16_t* up = ug + (tok >> 4) * 512 + (tok & 15) * 16;
            const u32x4 u0 = *(const u32x4*)up, u1 = *(const u32x4*)(up + 8);
            float uv[16];
            uv[0] = __uint_as_float(u0.x << 16); uv[1] = __uint_as_float(u0.x & 0xFFFF0000u); uv[2] = __uint_as_float(u0.y << 16); uv[3] = __uint_as_float(u0.y & 0xFFFF0000u);
            uv[4] = __uint_as_float(u0.z << 16); uv[5] = __uint_as_float(u0.z & 0xFFFF0000u); uv[6] = __uint_as_float(u0.w << 16); uv[7] = __uint_as_float(u0.w & 0xFFFF0000u);
            uv[8] = __uint_as_float(u1.x << 16); uv[9] = __uint_as_float(u1.x & 0xFFFF0000u); uv[10] = __uint_as_float(u1.y << 16); uv[11] = __uint_as_float(u1.y & 0xFFFF0000u);
            uv[12] = __uint_as_float(u1.z << 16); uv[13] = __uint_as_float(u1.z & 0xFFFF0000u); uv[14] = __uint_as_float(u1.w << 16); uv[15] = __uint_as_float(u1.w & 0xFFFF0000u);
            float bur = 0.f, bui = 0.f;
#pragma unroll
            for (int c = 0; c < 16; ++c) { bur += bbr[c] * uv[c]; bui += bbi[c] * uv[c]; }
            const float nr = ar * xr - ai * xi + bur, ni = ar * xi + ai * xr + bui; xr = nr; xi = ni;
            xs[lane] = xr; xs[64 + lane] = xi;
            asm volatile("s_waitcnt lgkmcnt(0)" ::: "memory");
            float y = 0.f;
#pragma unroll
            for (int pp = 0; pp < 16; ++pp) y += cre[pp] * xs[qt * 16 + pp] - cim[pp] * xs[64 + qt * 16 + pp];
            asm volatile("s_waitcnt lgkmcnt(0)" ::: "memory");
            y += __shfl_xor(y, 16); y += __shfl_xor(y, 32);
            if (lane < 16) ys[((size_t)dir * kTok + tok) * 256 + g * 16 + cch] = y;
        }
    }
}
DEVI void phase_s5_finish(const float* ys, const bf16_t* ux, const float* dskip, bf16_t* G, int bid, int nblk) {
    for (size_t i = (size_t)bid * kNT + tidx(); i < (size_t)kTok * 256; i += (size_t)nblk * kNT) {
        const size_t tok = i >> 8; const int ch = (int)(i & 255), g = ch >> 4, c = ch & 15;
        const float u = bf2f(ux[((size_t)g * 4096 + (tok >> 4)) * 512 + (tok & 15) * 16 + c]);
        const float y = ys[i] + ys[(size_t)kTok * 256 + i] + dskip[ch] * u;
        G[i] = f2bf(gelu_tanh(y));
    }
}
DEVI void phase_mixnorm(const bf16_t* oac, const float* lse, const bf16_t* ob, const bf16_t* oc, const float* ga, const float* gb, const float* gc, bf16_t* mix, int bid, int nblk) {
    const int wid = tidx() >> 6, lane = tidx() & 63;
    float gn[16];
    { const float* gp = (lane < 32) ? ga + lane * 16 : (lane < 48) ? gb + (lane - 32) * 16 : gc + (lane - 48) * 16;
#pragma unroll
      for (int i = 0; i < 16; ++i) gn[i] = gp[i]; }
    for (int row = bid * 8 + wid; row < kTok; row += nblk * 8) {
        float v[16];
        if (lane < 32) {
            const int h = lane >> 2;
            const float l0 = lse[(size_t)row * 8 + h], l1 = lse[((size_t)kTok + row) * 8 + h], l2 = lse[((size_t)2 * kTok + row) * 8 + h];
            const float mx = fmaxf(l0, fmaxf(l1, l2)); float w0 = __expf(l0 - mx), w1 = __expf(l1 - mx), w2 = __expf(l2 - mx); const float inv = 1.f / (w0 + w1 + w2); w0 *= inv; w1 *= inv; w2 *= inv;
#pragma unroll
            for (int i = 0; i < 16; ++i) v[i] = 0.f;
#pragma unroll
            for (int c = 0; c < 3; ++c) { const float wc_ = (c == 0) ? w0 : (c == 1) ? w1 : w2; const bf16_t* p = oac + ((size_t)c * kTok + row) * 512 + lane * 16;
#pragma unroll
                for (int i = 0; i < 16; ++i) v[i] += wc_ * bf2f(p[i]); }
        } else {
            const bf16_t* p = (lane < 48) ? ob + (size_t)row * 256 + (lane - 32) * 16 : oc + (size_t)row * 256 + (lane - 48) * 16;
#pragma unroll
            for (int i = 0; i < 16; ++i) v[i] = bf2f(p[i]);
        }
        float ss = 0.f;
#pragma unroll
        for (int i = 0; i < 16; ++i) ss += v[i] * v[i];
#pragma unroll
        for (int m = 1; m <= 8; m <<= 1) ss += __shfl_xor(ss, m);
        const float o16 = __shfl_xor(ss, 16);
        if (lane < 32) ss += o16;
        const float rstd = rsqrtf(ss * ((lane < 32) ? (1.f / 512.f) : (1.f / 256.f)) + kEps);
        u32x4 w0, w1;
        w0.x = pk2(v[0] * rstd * gn[0], v[1] * rstd * gn[1]); w0.y = pk2(v[2] * rstd * gn[2], v[3] * rstd * gn[3]); w0.z = pk2(v[4] * rstd * gn[4], v[5] * rstd * gn[5]); w0.w = pk2(v[6] * rstd * gn[6], v[7] * rstd * gn[7]);
        w1.x = pk2(v[8] * rstd * gn[8], v[9] * rstd * gn[9]); w1.y = pk2(v[10] * rstd * gn[10], v[11] * rstd * gn[11]); w1.z = pk2(v[12] * rstd * gn[12], v[13] * rstd * gn[13]); w1.w = pk2(v[14] * rstd * gn[14], v[15] * rstd * gn[15]);
        *(u32x4*)(mix + (size_t)row * kD + lane * 16) = w0; *(u32x4*)(mix + (size_t)row * kD + lane * 16 + 8) = w1;
    }
}
DEVI void phase_combine(float* x, const bf16_t* y, const int* tokslot, const float* gain_next, bf16_t* h, int bid, int nblk) {
    const int wid = tidx() >> 6, lane = tidx() & 63;
    f32x4 g[4];
#pragma unroll
    for (int q = 0; q < 4; ++q) g[q] = gain_next ? *(const f32x4*)(gain_next + q * 256 + lane * 4) : (f32x4){0.f, 0.f, 0.f, 0.f};
    for (int row = bid * 8 + wid; row < kTok; row += nblk * 8) {
        const int b = row >> 13;
        const int ts = tokslot[(size_t)row * kE + (lane & 15)];
        f32x4 v[4];
#pragma unroll
        for (int q = 0; q < 4; ++q) v[q] = *(const f32x4*)(x + (size_t)row * kD + q * 256 + lane * 4);
#pragma unroll
        for (int e = 0; e < kE; ++e) { const int slot = __builtin_amdgcn_readlane(ts, e);
            if (slot >= 0) { const bf16_t* yr = y + ((size_t)(e * kB + b) * kCap + slot) * kD;
#pragma unroll
                for (int q = 0; q < 4; ++q) { const u32x2 w = *(const u32x2*)(yr + q * 256 + lane * 4);
                    v[q].x += __uint_as_float(w.x << 16); v[q].y += __uint_as_float(w.x & 0xFFFF0000u); v[q].z += __uint_as_float(w.y << 16); v[q].w += __uint_as_float(w.y & 0xFFFF0000u); } } }
        float ss = 0.f;
#pragma unroll
        for (int q = 0; q < 4; ++q) { *(f32x4*)(x + (size_t)row * kD + q * 256 + lane * 4) = v[q]; ss += v[q].x * v[q].x + v[q].y * v[q].y + v[q].z * v[q].z + v[q].w * v[q].w; }
        if (gain_next) { ss = wave_sum(ss); const float rstd = rsqrtf(ss * (1.f / kD) + kEps);
#pragma unroll
            for (int q = 0; q < 4; ++q) { u32x2 o; o.x = pk2(v[q].x * rstd * g[q].x, v[q].y * rstd * g[q].y); o.y = pk2(v[q].z * rstd * g[q].z, v[q].w * rstd * g[q].w);
                *(u32x2*)(h + (size_t)row * kD + q * 256 + lane * 4) = o; } }
    }
}

#define XB_TMO      128
#define XB_XCNT(j)  (256  + 64 * (j))
#define XB_XSUB(j)  (1280 + 64 * (j))
#define XB_XGEN(j)  (2304 + 64 * (j))
#define XB_TOP      3328
#define XB_TOPGEN   3392
#define XCD_BAR_WORDS 3456
#define XB_SPIN_CAP (1u << 26)
DEVI unsigned xb_ld(unsigned* p)              { return __hip_atomic_load(p, __ATOMIC_RELAXED, __HIP_MEMORY_SCOPE_AGENT); }
DEVI unsigned xb_add(unsigned* p, unsigned v) { return __hip_atomic_fetch_add(p, v, __ATOMIC_RELAXED, __HIP_MEMORY_SCOPE_AGENT); }
DEVI unsigned xb_xcc_id() { return (unsigned)__builtin_amdgcn_s_getreg((3 << 11) | 20) & 0xFu; }
#define XB_SPIN(cond, bar) do { unsigned _sp = 0; while (cond) { __builtin_amdgcn_s_sleep(1); \
    if ((++_sp & 255u) == 0u) { if (xb_ld(&(bar)[XB_TMO])) break; if (_sp > XB_SPIN_CAP) { atomicAdd(&(bar)[XB_TMO], 1u); break; } } } } while (0)
struct XcdBarrier { unsigned* bar; unsigned x; volatile LAS unsigned* st; };
DEVI XcdBarrier xcd_barrier_post(unsigned* bar, volatile LAS unsigned* st) {
    XcdBarrier b; b.bar = bar; b.x = xb_xcc_id(); b.st = st;
    if (threadIdx.x == 0) (void)xb_add(&bar[XB_XCNT(b.x)], 1u);
    return b;
}
DEVI void xcd_barrier_complete(unsigned* bar, unsigned x, unsigned& nloc, unsigned& nx) {
    const unsigned G = gridDim.x * gridDim.y * gridDim.z;
    unsigned sum, cnt, mine, sp = 0u;
    for (;;) {
        sum = 0u; cnt = 0u; mine = 0u;
#pragma unroll
        for (unsigned j = 0; j < 16; ++j) { const unsigned c = xb_ld(&bar[XB_XCNT(j)]); sum += c; cnt += (c > 0u) ? 1u : 0u; mine = (j == x) ? c : mine; }
        if (sum == G) break;
        __builtin_amdgcn_s_sleep(1);
        if ((++sp & 255u) == 0u) { if (xb_ld(&bar[XB_TMO])) break; if (sp > XB_SPIN_CAP) { atomicAdd(&bar[XB_TMO], 1u); break; } }
    }
    nloc = mine > 0u ? mine : 1u; nx = cnt > 0u ? cnt : 1u;
}
DEVI void xcd_barrier(const XcdBarrier& b) {
    asm volatile("s_waitcnt vmcnt(0)" ::: "memory");
    __syncthreads();
    if (threadIdx.x == 0) {
        unsigned long long bp_ = (unsigned long long)b.bar; asm volatile("" : "+s"(bp_));
        unsigned* bar = (unsigned*)bp_;
        const unsigned bx = xb_xcc_id();
        __builtin_amdgcn_s_waitcnt(0);
        unsigned nloc = b.st[0], nx = b.st[1];
        if (nloc == 0u) { xcd_barrier_complete(bar, bx, nloc, nx); b.st[0] = nloc; b.st[1] = nx; }
        const unsigned old = xb_add(&bar[XB_XSUB(bx)], 1u);
        const unsigned gen = old / nloc;
        if (old + 1u == (gen + 1u) * nloc) {
            __builtin_amdgcn_fence(__ATOMIC_RELEASE, "agent");
            asm volatile("s_waitcnt vmcnt(0)" ::: "memory");
            const unsigned og = xb_add(&bar[XB_TOP], 1u);
            const unsigned tg = og / nx;
            if (og + 1u == (tg + 1u) * nx) xb_add(&bar[XB_TOPGEN], 1u);
            else XB_SPIN(xb_ld(&bar[XB_TOPGEN]) == tg, bar);
            __builtin_amdgcn_fence(__ATOMIC_ACQUIRE, "agent");
            xb_add(&bar[XB_XGEN(bx)], 1u);
            asm volatile("s_waitcnt vmcnt(0)" ::: "memory");
        } else {
            XB_SPIN(xb_ld(&bar[XB_XGEN(bx)]) == gen, bar);
            __builtin_amdgcn_fence(__ATOMIC_ACQUIRE, "agent");
            asm volatile("s_waitcnt vmcnt(0)" ::: "memory");
        }
    }
    __syncthreads();
}

#ifndef MEGA
#define MEGA 1
#endif
#ifndef USE_ENGINE
#define USE_ENGINE 1
#endif
constexpr int LDS_BYTES = 147456 + 8192 + 16;
#if USE_ENGINE
#define GEMM_RUN(g, E) gemm_engine<decltype(E), true, true>((LAS unsigned char*)dyn_lds, g, E, bid, nblk)
#else
#define GEMM_RUN(g, E) gemm_simple(g, E, bid, nblk)
#endif
extern __shared__ __attribute__((aligned(16))) unsigned char dyn_lds[];

DEVI GemmD mk_gemm(const bf16_t* A, const bf16_t* Bt, int lda, int K, int nM, int nN, const int* rowidx, size_t bstride, int pmg) {
    GemmD g; g.A = A; g.Bt = Bt; g.lda = lda; g.K = K; g.nM = nM; g.nN = nN; g.rowidx = rowidx; g.bstride = bstride; g.pmg = pmg; return g; }

DEVI void ph_win(const Params& P, int l, int bid, int nblk) {
    const GemmD g = mk_gemm((const bf16_t*)(P.ws + WS_H), (const bf16_t*)(P.ws + WS_WINT) + (size_t)l * kINW * kD, kD, kD, kTok / 256, 10, nullptr, 0, 1 << 30);
    unsigned char* r1 = P.ws + WS_R1;
    EpiQKV E; E.qa = (bf16_t*)(r1 + R1_QA); E.ka = (bf16_t*)(r1 + R1_KA); E.va = (bf16_t*)(r1 + R1_VA); E.qb = (bf16_t*)(r1 + R1_QB); E.kb = (bf16_t*)(r1 + R1_KB); E.vb = (bf16_t*)(r1 + R1_VB); E.ux = (bf16_t*)(r1 + R1_UX);
    E.qna = P.q_norm_a + l * 64; E.kna = P.k_norm_a + l * 64; E.qnb = P.q_norm_b + l * 64; E.knb = P.k_norm_b + l * 64;
    GEMM_RUN(g, E);
}
#ifndef USE_MFMA_ATTN
#define USE_MFMA_ATTN 1
#endif
DEVI void ph_dilated(const Params& P, int bid, int nblk) { unsigned char* r1 = P.ws + WS_R1;
#if USE_MFMA_ATTN
    phase_dilated((const bf16_t*)(r1 + R1_QA), (const bf16_t*)(r1 + R1_KA), (const bf16_t*)(r1 + R1_VA), (bf16_t*)(P.ws + WS_R2), (float*)(P.ws + WS_LSE), (LAS unsigned char*)dyn_lds, bid, nblk);
#else
    phase_dilated_naive((const bf16_t*)(r1 + R1_QA), (const bf16_t*)(r1 + R1_KA), (const bf16_t*)(r1 + R1_VA), (bf16_t*)(P.ws + WS_R2), (float*)(P.ws + WS_LSE), bid, nblk);
#endif
}
DEVI void ph_na(const Params& P, int l, int bid, int nblk) { unsigned char* r1 = P.ws + WS_R1;
#if USE_MFMA_ATTN
    phase_na((const bf16_t*)(r1 + R1_QB), (const bf16_t*)(r1 + R1_KB), (const bf16_t*)(r1 + R1_VB), P.rpb + (size_t)l * 4 * 15 * 31, (bf16_t*)(r1 + R1_OB), (LAS unsigned char*)dyn_lds, bid, nblk);
#else
    phase_na_naive((const bf16_t*)(r1 + R1_QB), (const bf16_t*)(r1 + R1_KB), (const bf16_t*)(r1 + R1_VB), P.rpb + (size_t)l * 4 * 15 * 31, (bf16_t*)(r1 + R1_OB), bid, nblk);
#endif
}
DEVI void ph_s5(const Params& P, int l, unsigned char* lds, int bid, int nblk) { phase_s5_naive(P, l, (const bf16_t*)(P.ws + WS_R1 + R1_UX), (float*)(P.ws + WS_YS), lds, bid, nblk); }
DEVI void ph_s5fin(const Params& P, int l, int bid, int nblk) { phase_s5_finish((const float*)(P.ws + WS_YS), (const bf16_t*)(P.ws + WS_R1 + R1_UX), P.s5_d + l * 256, (bf16_t*)(P.ws + WS_R1 + R1_G), bid, nblk); }
DEVI void ph_glu(const Params& P, int l, int bid, int nblk) {
    const GemmD g = mk_gemm((const bf16_t*)(P.ws + WS_R1 + R1_G), (const bf16_t*)(P.ws + WS_WGLUT) + (size_t)l * 256 * 256, 256, 256, kTok / 256, 1, nullptr, 0, 1 << 30);
    EpiGlu E; E.g = (const bf16_t*)(P.ws + WS_R1 + R1_G); E.oc = (bf16_t*)(P.ws + WS_R1 + R1_OC);
    GEMM_RUN(g, E);
}
DEVI void ph_mixnorm(const Params& P, int l, int bid, int nblk) { unsigned char* r1 = P.ws + WS_R1;
    phase_mixnorm((const bf16_t*)(P.ws + WS_R2), (const float*)(P.ws + WS_LSE), (const bf16_t*)(r1 + R1_OB), (const bf16_t*)(r1 + R1_OC), P.out_norm_a + l * 512, P.out_norm_b + l * 256, P.out_norm_c + l * 256, (bf16_t*)(P.ws + WS_H), bid, nblk); }
DEVI void ph_wout(const Params& P, int l, int bid, int nblk) {
    const GemmD g = mk_gemm((const bf16_t*)(P.ws + WS_H), (const bf16_t*)(P.ws + WS_WOUTT) + (size_t)l * kD * kD, kD, kD, kTok / 256, 4, nullptr, 0, 1 << 30);
    EpiResid E; E.xin = (l == 0) ? P.x : P.out; E.xout = P.out;
    GEMM_RUN(g, E);
}
DEVI void ph_router(const Params& P, int l, unsigned char* lds, int bid, int nblk) { phase_router(P.out, P.ffn_norm + (size_t)l * kD, P.w_router + (size_t)l * kD * kE, (bf16_t*)(P.ws + WS_H), (float*)(P.ws + WS_AFF), lds, bid, nblk); }
DEVI void ph_topk(const Params& P, unsigned char* lds, int bid, int nblk) { phase_topk((const float*)(P.ws + WS_AFF), (int*)(P.ws + WS_IDX), (float*)(P.ws + WS_GATE), (int*)(P.ws + WS_TSLOT), lds, bid, nblk); }
DEVI void ph_gu(const Params& P, int l, int bid, int nblk) {
    const GemmD g = mk_gemm((const bf16_t*)(P.ws + WS_H), (const bf16_t*)(P.ws + WS_WGUT) + (size_t)l * kE * 4096 * kD, kD, kD, 512, 16, (const int*)(P.ws + WS_IDX), (size_t)4096 * kD, 32);
    EpiGU E; E.hid = (bf16_t*)(P.ws + WS_R1);
    GEMM_RUN(g, E);
}
DEVI void ph_down(const Params& P, int l, int bid, int nblk) {
    const GemmD g = mk_gemm((const bf16_t*)(P.ws + WS_R1), (const bf16_t*)(P.ws + WS_WDT) + (size_t)l * kE * kD * kFF, kFF, kFF, 512, 4, nullptr, (size_t)kD * kFF, 32);
    EpiDown E; E.y = (bf16_t*)(P.ws + WS_R2); E.gate = (const float*)(P.ws + WS_GATE);
    GEMM_RUN(g, E);
}
DEVI void ph_combine(const Params& P, int l, int bid, int nblk) { phase_combine(P.out, (const bf16_t*)(P.ws + WS_R2), (const int*)(P.ws + WS_TSLOT), (l + 1 < kL) ? P.attn_norm + (size_t)(l + 1) * kD : nullptr, (bf16_t*)(P.ws + WS_H), bid, nblk); }

#if MEGA
__global__ void __launch_bounds__(kNT, 2) mega_fwd(Params P) {
    volatile LAS unsigned* st = (volatile LAS unsigned*)(dyn_lds + LDS_BYTES - 16);
    if (threadIdx.x == 0) { st[0] = 0u; st[1] = 0u; st[2] = 0u; st[3] = 0u; }
    __syncthreads();
    const XcdBarrier bar = xcd_barrier_post((unsigned*)(P.ws + WS_CTL), st);
    const int bid = blockIdx.x, nblk = gridDim.x;
    unsigned char* lds = dyn_lds;
    phase_convert(P, lds, bid, nblk);
    phase_norm(P.x, P.attn_norm, (bf16_t*)(P.ws + WS_H), bid, nblk);
    xcd_barrier(bar);
#pragma unroll 1
    for (int l = 0; l < kL; ++l) {
        ph_win(P, l, bid, nblk);            xcd_barrier(bar);
        ph_s5(P, l, lds, bid, nblk);
        ph_dilated(P, bid, nblk);
        ph_na(P, l, bid, nblk);             xcd_barrier(bar);
        ph_s5fin(P, l, bid, nblk);          xcd_barrier(bar);
        ph_glu(P, l, bid, nblk);            xcd_barrier(bar);
        ph_mixnorm(P, l, bid, nblk);        xcd_barrier(bar);
        ph_wout(P, l, bid, nblk);           xcd_barrier(bar);
        ph_router(P, l, lds, bid, nblk);    xcd_barrier(bar);
        ph_topk(P, lds, bid, nblk);         xcd_barrier(bar);
        ph_gu(P, l, bid, nblk);             xcd_barrier(bar);
        ph_down(P, l, bid, nblk);           xcd_barrier(bar);
        ph_combine(P, l, bid, nblk);        xcd_barrier(bar);
    }
}
#else
#define KB __global__ void __launch_bounds__(kNT, 2)
KB k_convert(Params P) { phase_convert(P, dyn_lds, blockIdx.x, gridDim.x); }
KB k_norm(Params P) { phase_norm(P.x, P.attn_norm, (bf16_t*)(P.ws + WS_H), blockIdx.x, gridDim.x); }
KB k_win(Params P, int l) { ph_win(P, l, blockIdx.x, gridDim.x); }
KB k_dilated(Params P) { ph_dilated(P, blockIdx.x, gridDim.x); }
KB k_na(Params P, int l) { ph_na(P, l, blockIdx.x, gridDim.x); }
KB k_s5(Params P, int l) { ph_s5(P, l, dyn_lds, blockIdx.x, gridDim.x); }
KB k_s5fin(Params P, int l) { ph_s5fin(P, l, blockIdx.x, gridDim.x); }
KB k_glu(Params P, int l) { ph_glu(P, l, blockIdx.x, gridDim.x); }
KB k_mixnorm(Params P, int l) { ph_mixnorm(P, l, blockIdx.x, gridDim.x); }
KB k_wout(Params P, int l) { ph_wout(P, l, blockIdx.x, gridDim.x); }
KB k_router(Params P, int l) { ph_router(P, l, dyn_lds, blockIdx.x, gridDim.x); }
KB k_topk(Params P) { ph_topk(P, dyn_lds, blockIdx.x, gridDim.x); }
KB k_gu(Params P, int l) { ph_gu(P, l, blockIdx.x, gridDim.x); }
KB k_down(Params P, int l) { ph_down(P, l, blockIdx.x, gridDim.x); }
KB k_combine(Params P, int l) { ph_combine(P, l, blockIdx.x, gridDim.x); }
#endif

extern "C" void kernel_launch(void* const* d_in, const int* in_sizes, int n_in, void* d_out, int out_size, void* d_ws, size_t ws_size, hipStream_t stream) {
    (void)in_sizes; (void)n_in; (void)out_size;
    if (ws_size < WS_END) { fprintf(stderr, "workspace too small: %zu < %zu\n", ws_size, (size_t)WS_END); return; }
    Params P{};
    const float** pp = (const float**)&P;
    for (int i = 0; i < 26; ++i) pp[i] = (const float*)d_in[i];
    P.out = (float*)d_out; P.ws = (unsigned char*)d_ws;
#if MEGA
    static int grid = 0;
    if (!grid) {
        int dev = 0, cus = 0, per_cu = 0;
        (void)hipGetDevice(&dev);
        (void)hipDeviceGetAttribute(&cus, hipDeviceAttributeMultiprocessorCount, dev);
        (void)hipFuncSetAttribute((const void*)mega_fwd, hipFuncAttributeMaxDynamicSharedMemorySize, LDS_BYTES);
        (void)hipOccupancyMaxActiveBlocksPerMultiprocessor(&per_cu, (const void*)mega_fwd, kNT, LDS_BYTES);
        grid = (per_cu >= 1) ? cus : 0;
        if (!grid) fprintf(stderr, "mega_fwd does not fit a CU\n");
    }
    if (!grid) return;
    (void)hipMemsetAsync(P.ws + WS_CTL, 0, XCD_BAR_WORDS * sizeof(unsigned), stream);
    mega_fwd<<<grid, kNT, LDS_BYTES, stream>>>(P);
#else
    (void)hipFuncSetAttribute((const void*)k_router, hipFuncAttributeMaxDynamicSharedMemorySize, 65536);
    const int G = 1024;
    k_convert<<<G, kNT, 256 * 72 * 2, stream>>>(P);
    k_norm<<<G, kNT, 0, stream>>>(P);
    for (int l = 0; l < kL; ++l) {
        k_win<<<G, kNT, 0, stream>>>(P, l);
        k_dilated<<<G, kNT, 0, stream>>>(P);
        k_na<<<G, kNT, 0, stream>>>(P, l);
        k_s5<<<256, kNT, 8 * 128 * 4, stream>>>(P, l);
        k_s5fin<<<G, kNT, 0, stream>>>(P, l);
        k_glu<<<256, kNT, 0, stream>>>(P, l);
        k_mixnorm<<<G, kNT, 0, stream>>>(P, l);
        k_wout<<<G, kNT, 0, stream>>>(P, l);
        k_router<<<512, kNT, 65536, stream>>>(P, l);
        k_topk<<<128, kNT, 4096, stream>>>(P);
        k_gu<<<G, kNT, 0, stream>>>(P, l);
        k_down<<<G, kNT, 0, stream>>>(P, l);
        k_combine<<<G, kNT, 0, stream>>>(P, l);
    }
#endif
}
```

```cpp
#include <hip/hip_runtime.h>
#include <stdint.h>
#include <stdio.h>

#define DEVI __device__ __forceinline__
#define LAS __attribute__((address_space(3)))
typedef unsigned short bf16_t;
typedef short bf16x8 __attribute__((ext_vector_type(8)));
typedef float f32x4 __attribute__((ext_vector_type(4)));
typedef float f32x2 __attribute__((ext_vector_type(2)));
typedef unsigned u32x4 __attribute__((ext_vector_type(4)));
typedef unsigned u32x2 __attribute__((ext_vector_type(2)));

constexpr int kB = 8, kS = 8192, kD = 1024, kL = 4, kTok = kB * kS;
constexpr int kINW = 2560;
constexpr int kE = 16, kCap = 1024, kFF = 2048;
constexpr int kNT = 512;
constexpr float kEps = 1e-6f;

constexpr size_t MiB = 1024ull * 1024ull;
constexpr size_t WS_CTL   = 0;
constexpr size_t WS_WINT  = 1 * MiB;
constexpr size_t WS_WOUTT = WS_WINT + 20 * MiB;
constexpr size_t WS_WGLUT = WS_WOUTT + 8 * MiB;
constexpr size_t WS_WGUT  = WS_WGLUT + 1 * MiB;
constexpr size_t WS_WDT   = WS_WGUT + 512 * MiB;
constexpr size_t WS_H     = WS_WDT + 256 * MiB;
constexpr size_t WS_R1    = WS_H + 128 * MiB;
constexpr size_t WS_R2    = WS_R1 + 512 * MiB;
constexpr size_t WS_AFF   = WS_R2 + 256 * MiB;
constexpr size_t WS_IDX   = WS_AFF + 4 * MiB;
constexpr size_t WS_GATE  = WS_IDX + 1 * MiB;
constexpr size_t WS_TSLOT = WS_GATE + 1 * MiB;
constexpr size_t WS_LSE   = WS_TSLOT + 4 * MiB;
constexpr size_t WS_WST   = WS_LSE + 8 * MiB;
constexpr size_t WS_WSO   = WS_WST + 8 * MiB;
constexpr size_t WS_YS    = WS_WSO + 16 * MiB;
constexpr size_t WS_END   = WS_YS + 128 * MiB;
constexpr size_t R2_Z     = 192 * MiB;
constexpr size_t R1_QA = 0, R1_KA = 64 * MiB, R1_VA = 128 * MiB, R1_QB = 192 * MiB, R1_KB = 224 * MiB, R1_VB = 256 * MiB,
                 R1_UX = 288 * MiB, R1_OB = 352 * MiB, R1_OC = 384 * MiB, R1_G = 416 * MiB;

struct Params {
    const float* x; const float* attn_norm; const float* w_in; const float* q_norm_a; const float* k_norm_a; const float* q_norm_b; const float* k_norm_b;
    const float* rpb; const float* s5_a_re; const float* s5_a_im; const float* s5_log_dt; const float* s5_b_re; const float* s5_b_im; const float* s5_c_re; const float* s5_c_im;
    const float* s5_d; const float* w_glu; const float* out_norm_a; const float* out_norm_b; const float* out_norm_c; const float* w_out; const float* ffn_norm;
    const float* w_router; const float* w_gate; const float* w_up; const float* w_down;
    float* out; unsigned char* ws;
};

DEVI float bf2f(bf16_t b) { return __uint_as_float(((unsigned)b) << 16); }
DEVI bf16_t f2bf(float f) { unsigned u = __float_as_uint(f); u += 0x7FFFu + ((u >> 16) & 1u); return (bf16_t)(u >> 16); }
typedef __bf16 bf16x2_t __attribute__((ext_vector_type(2)));
DEVI unsigned pk2(float lo, float hi) { const f32x2 v = {lo, hi}; return __builtin_bit_cast(unsigned, __builtin_convertvector(v, bf16x2_t)); }
DEVI int tidx() { int t = threadIdx.x; asm volatile("" : "+v"(t)); return t; }
DEVI int lnd(int v) { asm volatile("" : "+s"(v)); return v; }
DEVI float wave_sum(float v) {
#pragma unroll
    for (int m = 32; m >= 1; m >>= 1) v += __shfl_xor(v, m);
    return v;
}
DEVI float gelu_tanh(float y) { const float z = 0.7978845608028654f * (y + 0.044715f * y * y * y); const float t = 1.f - 2.f / (1.f + __expf(2.f * z)); return 0.5f * y * (1.f + t); }

DEVI int cmap_head(int cs) { const int bj = cs >> 7, wc = (cs >> 5) & 3, n = (cs >> 4) & 1, fq = (cs >> 2) & 3, j = cs & 3; return 64 * wc + 32 * bj + 8 * fq + 4 * n + j; }
DEVI int cmap_pk(int cs)   { const int bj = cs >> 7, wc = (cs >> 5) & 3, n = (cs >> 4) & 1, fq = (cs >> 2) & 3, j = cs & 3; return 128 * bj + 32 * wc + 8 * fq + 4 * n + j; }
DEVI int cmap_gu(int cs)   { const int wc = (cs >> 5) & 3, n = (cs >> 4) & 1, fq = (cs >> 2) & 3, j = cs & 3; return 32 * wc + 8 * fq + 4 * n + j; }

template <int MODE>
DEVI void convert_item(const float* W0, const float* W1, int ldw, int K, bf16_t* Bt, int kt, int pn, unsigned char* lds) {
    bf16_t* t = (bf16_t*)lds;
    const int tid = tidx();
#pragma unroll 4
    for (int it = 0; it < 32; ++it) {
        const int e = it * kNT + tid, k = e >> 8, cs = e & 255;
        float v;
        if (MODE == 0) v = W0[(size_t)(kt * 64 + k) * ldw + pn * 256 + cs];
        else if (MODE == 1) v = W0[(size_t)(kt * 64 + k) * ldw + pn * 256 + cmap_head(cs)];
        else if (MODE == 2) v = W0[(size_t)(kt * 64 + k) * ldw + pn * 256 + cmap_pk(cs)];
        else v = ((cs >> 7) ? W1 : W0)[(size_t)(kt * 64 + k) * ldw + pn * 128 + cmap_gu(cs)];
        t[cs * 72 + k] = f2bf(v);
    }
    __syncthreads();
#pragma unroll
    for (int it = 0; it < 4; ++it) {
        const int c = it * kNT + tid, row = c >> 3, part = c & 7;
        const u32x4 v = *(const u32x4*)(t + row * 72 + part * 8);
        *(u32x4*)(Bt + (size_t)(pn * 256 + row) * K + kt * 64 + part * 8) = v;
    }
    __syncthreads();
}

DEVI void phase_convert(const Params& P, unsigned char* lds, int bid, int nblk) {
    constexpr int N_WIN = kL * 16 * 10, N_WOUT = kL * 16 * 4, N_WGLU = kL * 4 * 1, N_WGU = kL * kE * 16 * 16, N_WD = kL * kE * 32 * 4;
    constexpr int TOT = N_WIN + N_WOUT + N_WGLU + N_WGU + N_WD;
    for (int it = bid; it < TOT; it += nblk) {
        int i = it;
        if (i < N_WIN) { const int l = i / 160, r = i % 160, kt = r / 10, pn = r % 10;
            convert_item<1>(P.w_in + (size_t)l * kD * kINW, nullptr, kINW, kD, (bf16_t*)(P.ws + WS_WINT) + (size_t)l * kINW * kD, kt, pn, lds); continue; }
        i -= N_WIN;
        if (i < N_WOUT) { const int l = i / 64, r = i % 64, kt = r / 4, pn = r % 4;
            convert_item<0>(P.w_out + (size_t)l * kD * kD, nullptr, kD, kD, (bf16_t*)(P.ws + WS_WOUTT) + (size_t)l * kD * kD, kt, pn, lds); continue; }
        i -= N_WOUT;
        if (i < N_WGLU) { const int l = i / 4, kt = i % 4;
            convert_item<2>(P.w_glu + (size_t)l * 256 * 256, nullptr, 256, 256, (bf16_t*)(P.ws + WS_WGLUT) + (size_t)l * 256 * 256, kt, 0, lds); continue; }
        i -= N_WGLU;
        if (i < N_WGU) { const int le = i / 256, r = i % 256, kt = r / 16, pn = r % 16;
            convert_item<3>(P.w_gate + (size_t)le * kD * kFF, P.w_up + (size_t)le * kD * kFF, kFF, kD, (bf16_t*)(P.ws + WS_WGUT) + (size_t)le * 4096 * kD, kt, pn, lds); continue; }
        i -= N_WGU;
        { const int le = i / 128, r = i % 128, kt = r / 4, pn = r % 4;
            convert_item<2>(P.w_down + (size_t)le * kFF * kD, nullptr, kD, kFF, (bf16_t*)(P.ws + WS_WDT) + (size_t)le * kD * kFF, kt, pn, lds); }
    }
}

DEVI void phase_norm(const float* x, const float* gain, bf16_t* h, int bid, int nblk) {
    const int wid = tidx() >> 6, lane = tidx() & 63;
    f32x4 g[4];
#pragma unroll
    for (int q = 0; q < 4; ++q) g[q] = *(const f32x4*)(gain + q * 256 + lane * 4);
    for (int row = bid * 8 + wid; row < kTok; row += nblk * 8) {
        f32x4 v[4]; float ss = 0.f;
#pragma unroll
        for (int q = 0; q < 4; ++q) { v[q] = *(const f32x4*)(x + (size_t)row * kD + q * 256 + lane * 4); ss += v[q].x * v[q].x + v[q].y * v[q].y + v[q].z * v[q].z + v[q].w * v[q].w; }
        ss = wave_sum(ss);
        const float rstd = rsqrtf(ss * (1.f / kD) + kEps);
#pragma unroll
        for (int q = 0; q < 4; ++q) { u32x2 o; o.x = pk2(v[q].x * rstd * g[q].x, v[q].y * rstd * g[q].y); o.y = pk2(v[q].z * rstd * g[q].z, v[q].w * rstd * g[q].w);
            *(u32x2*)(h + (size_t)row * kD + q * 256 + lane * 4) = o; }
    }
}

DEVI void phase_router(const float* x, const float* gain, const float* wr  , bf16_t* h, float* aff, unsigned char* lds, int bid, int nblk) {
    float* wT = (float*)lds;
    for (int i = tidx(); i < 16 * 1024; i += kNT) { const int k = i >> 4, e = i & 15; wT[e * 1024 + k] = wr[i]; }
    __syncthreads();
    const int wid = tidx() >> 6, lane = tidx() & 63;
    f32x4 g[4];
#pragma unroll
    for (int q = 0; q < 4; ++q) g[q] = *(const f32x4*)(gain + q * 256 + lane * 4);
    for (int row0 = (bid * 8 + wid) * 2; row0 < kTok; row0 += nblk * 8 * 2) {
        asm volatile("" ::: "memory");
        f32x4 v[2][4];
#pragma unroll
        for (int r = 0; r < 2; ++r) { float ss = 0.f;
#pragma unroll
            for (int q = 0; q < 4; ++q) { v[r][q] = *(const f32x4*)(x + (size_t)(row0 + r) * kD + q * 256 + lane * 4); ss += v[r][q].x * v[r][q].x + v[r][q].y * v[r][q].y + v[r][q].z * v[r][q].z + v[r][q].w * v[r][q].w; }
            ss = wave_sum(ss); const float rstd = rsqrtf(ss * (1.f / kD) + kEps);
#pragma unroll
            for (int q = 0; q < 4; ++q) { v[r][q] = v[r][q] * rstd * g[q];
                u32x2 o; o.x = pk2(v[r][q].x, v[r][q].y); o.y = pk2(v[r][q].z, v[r][q].w);
                *(u32x2*)(h + (size_t)(row0 + r) * kD + q * 256 + lane * 4) = o; }
        }
        float pa[32];
#pragma unroll
        for (int e = 0; e < 16; ++e) {
            float s0 = 0.f, s1 = 0.f;
#pragma unroll
            for (int q = 0; q < 4; ++q) { const f32x4 w = *(const f32x4*)(wT + e * 1024 + q * 256 + lane * 4);
                s0 += v[0][q].x * w.x + v[0][q].y * w.y + v[0][q].z * w.z + v[0][q].w * w.w;
                s1 += v[1][q].x * w.x + v[1][q].y * w.y + v[1][q].z * w.z + v[1][q].w * w.w; }
            pa[e] = s0; pa[16 + e] = s1;
        }
#define RS_STEP(HALF, MASK) { const bool up = (lane & (MASK)) != 0; _Pragma("unroll") for (int i = 0; i < (HALF); ++i) { const float keep = up ? pa[i + (HALF)] : pa[i], send = up ? pa[i] : pa[i + (HALF)]; pa[i] = keep + __shfl_xor(send, (MASK)); } }
        RS_STEP(16, 32) RS_STEP(8, 16) RS_STEP(4, 8) RS_STEP(2, 4) RS_STEP(1, 2)
#undef RS_STEP
        const float logit = pa[0] + __shfl_xor(pa[0], 1);
        float mx = logit;
#pragma unroll
        for (int m = 16; m >= 2; m >>= 1) mx = fmaxf(mx, __shfl_xor(mx, m));
        const float ex = __expf(logit - mx);
        float sm = ex;
#pragma unroll
        for (int m = 16; m >= 2; m >>= 1) sm += __shfl_xor(sm, m);
        const int row = row0 + (lane >> 5), e = (lane >> 1) & 15, b = row >> 13, s = row & (kS - 1);
        if (!(lane & 1)) aff[((size_t)(b * kE + e)) * kS + s] = ex / sm;
    }
    __syncthreads();
}

DEVI int block_excl_scan(int v, int* sh  , int& total) {
    const int lane = tidx() & 63, wid = tidx() >> 6;
    int incl = v;
#pragma unroll
    for (int d = 1; d < 64; d <<= 1) { const int o = __shfl_up(incl, d); if (lane >= d) incl += o; }
    __syncthreads();
    if (lane == 63) sh[wid] = incl;
    __syncthreads();
    int base = 0, tot = 0;
#pragma unroll
    for (int w = 0; w < 8; ++w) { const int c = sh[w]; if (w < wid) base += c; tot += c; }
    total = tot;
    return base + incl - v;
}

DEVI void phase_topk(const float* aff, int* idx, float* gate, int* tokslot, unsigned char* lds, int bid, int nblk) {
    int* hist = (int*)lds;
    int* sh = hist + 256;
    int* res = sh + 16;
    const int tid = tidx(), lane = tid & 63, wid = tid >> 6;
    for (int item = bid; item < kB * kE; item += nblk) {
        const int b = item >> 4, e = item & 15;
        const float* a = aff + (size_t)item * kS;
        unsigned key[16];
#pragma unroll
        for (int q = 0; q < 4; ++q) { const u32x4 v = *(const u32x4*)(a + tid * 16 + q * 4); key[q * 4 + 0] = v.x; key[q * 4 + 1] = v.y; key[q * 4 + 2] = v.z; key[q * 4 + 3] = v.w; }
        unsigned prefix = 0; int kk = kCap;
#pragma unroll 1
        for (int pass = 0; pass < 4; ++pass) {
            const int shift = 24 - 8 * pass;
            __syncthreads();
            if (tid < 256) hist[tid] = 0;
            __syncthreads();
#pragma unroll
            for (int i = 0; i < 16; ++i) { const bool in = (pass == 0) || ((key[i] >> (shift + 8)) == prefix); if (in) atomicAdd(&hist[(key[i] >> shift) & 255], 1); }
            __syncthreads();
            if (wid == 0) {
                int c[4], loc = 0;
#pragma unroll
                for (int j = 0; j < 4; ++j) { c[j] = hist[255 - 4 * lane - j]; loc += c[j]; }
                int incl = loc;
#pragma unroll
                for (int d = 1; d < 64; d <<= 1) { const int o = __shfl_up(incl, d); if (lane >= d) incl += o; }
                const int excl = incl - loc;
                if (excl < kk && kk <= incl) { int run = excl; int bin = 0, nk = 0; bool found = false;
#pragma unroll
                    for (int j = 0; j < 4; ++j) { if (!found && run + c[j] >= kk) { bin = 255 - 4 * lane - j; nk = kk - run; found = true; } if (!found) run += c[j]; }
                    res[0] = bin; res[1] = nk; }
            }
            __syncthreads();
            prefix = (prefix << 8) | (unsigned)res[0]; kk = res[1];
        }
        const unsigned T = prefix;
        int ceq = 0;
#pragma unroll
        for (int i = 0; i < 16; ++i) ceq += (key[i] == T) ? 1 : 0;
        int tot;
        int eqb = block_excl_scan(ceq, sh, tot);
        int csel = 0; unsigned selmask = 0;
#pragma unroll
        for (int i = 0; i < 16; ++i) { bool s = key[i] > T; if (key[i] == T) { s = eqb < kk; ++eqb; } if (s) { selmask |= 1u << i; ++csel; } }
        int slot = block_excl_scan(csel, sh, tot);
        const size_t rbase = (size_t)(e * kB + b) * kCap;
#pragma unroll
        for (int i = 0; i < 16; ++i) { const int s = tid * 16 + i; const bool sel = (selmask >> i) & 1u;
            if (sel) { idx[rbase + slot] = b * kS + s; gate[rbase + slot] = __uint_as_float(key[i]); }
            tokslot[((size_t)(b * kS + s)) * kE + e] = sel ? slot : -1;
            if (sel) ++slot; }
    }
    __syncthreads();
}

struct Unit { int pm, pn; };
DEVI bool unit_of(int Lid, int nM, int nN, Unit& u) {
    const int nwg = nM * nN; if (Lid >= nwg) return false;
    int wgid = Lid; { const int q = nwg / 8, r = nwg % 8, xcd = wgid % 8, off = wgid / 8; wgid = (xcd < r ? xcd * (q + 1) : r * (q + 1) + (xcd - r) * q) + off; }
    const int nig = 8 * nN, gid = wgid / nig, fm = gid * 8, gsz = (nM - fm) < 8 ? (nM - fm) : 8;
    u.pm = fm + ((wgid % nig) % gsz); u.pn = (wgid % nig) / gsz; return true;
}
struct GemmD { const bf16_t* A; const bf16_t* Bt; int lda, K, nM, nN; const int* rowidx; size_t bstride; int pmg; };

template <class Epi>
DEVI void gemm_simple(const GemmD g, const Epi& E, int bid, int nblk) {
    const int tid = tidx(), wid = tid >> 6, lane = tid & 63, wr = wid >> 2, wc = wid & 3, fr = lane & 15, fq = lane >> 4;
    for (int i = 0;; ++i) {
        Unit u; if (!unit_of(i * nblk + bid, g.nM, g.nN, u)) break;
        f32x4 acc[2][2][4][2];
#pragma unroll
        for (int a = 0; a < 2; ++a)
#pragma unroll
            for (int b = 0; b < 2; ++b)
#pragma unroll
                for (int m = 0; m < 4; ++m)
#pragma unroll
                    for (int n = 0; n < 2; ++n) acc[a][b][m][n] = (f32x4){0.f, 0.f, 0.f, 0.f};
        const bf16_t* Bu = g.Bt + (size_t)(u.pm / g.pmg) * g.bstride + (size_t)u.pn * 256 * g.K;
        unsigned ao[2][4], bo[2][2];
#pragma unroll
        for (int a = 0; a < 2; ++a)
#pragma unroll
            for (int m = 0; m < 4; ++m) { const int r = u.pm * 256 + 128 * a + 64 * wr + 16 * m + fr; const unsigned rr = g.rowidx ? (unsigned)g.rowidx[r] : (unsigned)r; ao[a][m] = rr * (unsigned)g.lda + 8u * fq; }
#pragma unroll
        for (int b = 0; b < 2; ++b)
#pragma unroll
            for (int n = 0; n < 2; ++n) bo[b][n] = (unsigned)(128 * b + 32 * wc + 16 * n + fr) * (unsigned)g.K + 8u * fq;
#pragma unroll 1
        for (int k0 = 0; k0 < g.K; k0 += 32) {
            bf16x8 av[2][4], bv[2][2];
#pragma unroll
            for (int a = 0; a < 2; ++a)
#pragma unroll
                for (int m = 0; m < 4; ++m) av[a][m] = *(const bf16x8*)(g.A + ao[a][m] + k0);
#pragma unroll
            for (int b = 0; b < 2; ++b)
#pragma unroll
                for (int n = 0; n < 2; ++n) bv[b][n] = *(const bf16x8*)(Bu + bo[b][n] + k0);
#pragma unroll
            for (int a = 0; a < 2; ++a)
#pragma unroll
                for (int b = 0; b < 2; ++b)
#pragma unroll
                    for (int m = 0; m < 4; ++m)
#pragma unroll
                        for (int n = 0; n < 2; ++n) acc[a][b][m][n] = __builtin_amdgcn_mfma_f32_16x16x32_bf16(bv[b][n], av[a][m], acc[a][b][m][n], 0, 0, 0);
        }
        E(acc, u, wr, wc, fr, fq);
    }
}


constexpr int PG_HTB = 128 * 64 * 2;
DEVI int pg_lds_byte(int r, int c) { const int st = (r >> 4) * 2 + (c >> 5), rr = r & 15, cc = c & 31, ob = rr * 64 + cc * 2; return st * 1024 + (ob ^ (((ob >> 9) & 1) << 5)); }
DEVI void pg_stage_rc(int b, int& R, int& C) { const int st = b / 1024, sb = b % 1024, swz = sb ^ (((sb >> 9) & 1) << 5); R = (st >> 1) * 16 + swz / 64; C = (st & 1) * 32 + (swz % 64) / 2; }

template <class Epi, bool ALIGN_EPI, bool SP2>
DEVI void gemm_engine(LAS unsigned char* lds, const GemmD g, const Epi& E, int bid, int nblk) {
    const int tid = tidx(), wid = __builtin_amdgcn_readfirstlane(tid >> 6), lane = tid & 63, wr = wid >> 2, wc = wid & 3, fr = lane & 15, fq = lane >> 4;
    const int K = g.K, nt = K / 64;
    int RA[2], CA[2]; unsigned voffB[2];
#pragma unroll
    for (int i = 0; i < 2; ++i) { pg_stage_rc(tid * 16 + i * 8192, RA[i], CA[i]); voffB[i] = (unsigned)(RA[i] * K + CA[i]) * 2u; }
    const size_t kstep = 128;
    const size_t hstepB = (size_t)128 * K * 2;
    const unsigned ldsw = (unsigned)wid * 1024u;
    const int aoff = pg_lds_byte(wr * 64 + fr, fq * 8), boff = pg_lds_byte(wc * 32 + fr, fq * 8);
#define PG8_SA(b, h) (((b) * 2 + (h)) * PG_HTB)
#define PG8_SB(b, h) ((4 + (b) * 2 + (h)) * PG_HTB)
#define PG8_STAGE(bufoff, gbase, voff) do { _Pragma("unroll") for (int _i = 0; _i < 2; ++_i) \
        __builtin_amdgcn_global_load_lds((const unsigned*)((const char*)(gbase) + (voff)[_i]), (LAS unsigned*)(lds + (bufoff) + ldsw + _i * 8192), 16, 0, 0); } while (0)
#define PG8_LDA(dst, b, h) do { _Pragma("unroll") for (int m = 0; m < 4; ++m) _Pragma("unroll") for (int k = 0; k < 2; ++k) dst[m][k] = *(const LAS bf16x8*)(lds + PG8_SA(b, h) + aoff + m * 2048 + k * 1024); } while (0)
#define PG8_LDB(dst, b, h) do { _Pragma("unroll") for (int n = 0; n < 2; ++n) _Pragma("unroll") for (int k = 0; k < 2; ++k) dst[n][k] = *(const LAS bf16x8*)(lds + PG8_SB(b, h) + boff + n * 2048 + k * 1024); } while (0)
#define PG8_MMA(ai, bj, At, Bt) do { __builtin_amdgcn_s_setprio(1); _Pragma("unroll") for (int m = 0; m < 4; ++m) _Pragma("unroll") for (int n = 0; n < 2; ++n) _Pragma("unroll") for (int k = 0; k < 2; ++k) \
        acc[ai][bj][m][n] = __builtin_amdgcn_mfma_f32_16x16x32_bf16(Bt[n][k], At[m][k], acc[ai][bj][m][n], 0, 0, 0); __builtin_amdgcn_s_setprio(0); } while (0)
#define PG8_WAIT_V(n) asm volatile("s_waitcnt vmcnt(" #n ")" ::: "memory")
#define PG8_WAIT_L(n) asm volatile("s_waitcnt lgkmcnt(" #n ")" ::: "memory")
#define PG8_BAR __builtin_amdgcn_s_barrier()
#define PG8_SCHED __builtin_amdgcn_sched_barrier(0)
#define PG8_VOFFA(dst, pm_) do { _Pragma("unroll") for (int _h = 0; _h < 2; ++_h) _Pragma("unroll") for (int _i = 0; _i < 2; ++_i) { const int _r = (pm_) * 256 + 128 * _h + RA[_i]; \
        const unsigned _rr = g.rowidx ? (unsigned)g.rowidx[_r] : (unsigned)_r; dst[_h][_i] = (_rr * (unsigned)g.lda + (unsigned)CA[_i]) * 2u; } } while (0)
    Unit cur, nxt, nn; int ui = 0;
    if (!unit_of(bid, g.nM, g.nN, cur)) return;
    f32x4 acc[2][2][4][2];
#pragma unroll
    for (int a = 0; a < 2; ++a)
#pragma unroll
        for (int b = 0; b < 2; ++b)
#pragma unroll
            for (int m = 0; m < 4; ++m)
#pragma unroll
                for (int n = 0; n < 2; ++n) acc[a][b][m][n] = (f32x4){0.f, 0.f, 0.f, 0.f};
    bf16x8 At[4][2], B0[2][2], B1[2][2];
    const char* const A0 = (const char*)g.A;
    const char* cB = (const char*)(g.Bt + (size_t)(cur.pm / g.pmg) * g.bstride + (size_t)cur.pn * 256 * K);
    unsigned cvA[2][2], nvA[2][2];
    PG8_VOFFA(cvA, cur.pm);
    { const bool hn = unit_of(nblk + bid, g.nM, g.nN, nxt); if (hn) PG8_VOFFA(nvA, nxt.pm); else { _Pragma("unroll") for (int h = 0; h < 2; ++h) _Pragma("unroll") for (int i = 0; i < 2; ++i) nvA[h][i] = cvA[h][i]; } }
    if constexpr (SP2) {
        PG8_STAGE(PG8_SB(0, 0), cB, voffB); PG8_STAGE(PG8_SB(0, 1), cB + hstepB, voffB); PG8_STAGE(PG8_SA(0, 0), A0, cvA[0]); PG8_STAGE(PG8_SA(0, 1), A0, cvA[1]);
        if (wr == 1) PG8_BAR;
        PG8_WAIT_V(2); PG8_BAR;
        PG8_STAGE(PG8_SB(1, 0), cB + kstep, voffB); PG8_STAGE(PG8_SA(1, 0), A0 + kstep, cvA[0]); PG8_STAGE(PG8_SB(1, 1), cB + hstepB + kstep, voffB);
        PG8_WAIT_V(6); PG8_BAR;
    } else {
        PG8_STAGE(PG8_SB(0, 0), cB, voffB); PG8_STAGE(PG8_SA(0, 0), A0, cvA[0]); PG8_STAGE(PG8_SB(0, 1), cB + hstepB, voffB); PG8_STAGE(PG8_SA(0, 1), A0, cvA[1]);
        if (wr == 1) PG8_BAR;
        PG8_WAIT_V(4); PG8_BAR;
        PG8_STAGE(PG8_SB(1, 0), cB + kstep, voffB); PG8_STAGE(PG8_SA(1, 0), A0 + kstep, cvA[0]); PG8_STAGE(PG8_SB(1, 1), cB + hstepB + kstep, voffB);
        PG8_WAIT_V(6); PG8_BAR;
    }
    for (;;) {
        const bool has_next = unit_of((ui + 1) * nblk + bid, g.nM, g.nN, nxt);
        const char* nB = has_next ? (const char*)(g.Bt + (size_t)(nxt.pm / g.pmg) * g.bstride + (size_t)nxt.pn * 256 * K) : cB;
        for (int t = 0; t < nt; t += 2) {
            const bool last = (t == nt - 2);
            const char* a1 = A0 + (size_t)(t + 1) * kstep;
            const char* a2 = last ? A0 : A0 + (size_t)(t + 2) * kstep; const char* b2 = last ? nB : cB + (size_t)(t + 2) * kstep;
            const char* a3 = a2 + kstep; const char* b3 = b2 + kstep;
            unsigned v2[2][2];
#pragma unroll
            for (int h = 0; h < 2; ++h)
#pragma unroll
                for (int i = 0; i < 2; ++i) v2[h][i] = last ? nvA[h][i] : cvA[h][i];
            if constexpr (SP2) {
            PG8_LDB(B0, 0, 0); PG8_LDB(B1, 0, 1); PG8_SCHED; PG8_LDA(At, 0, 0); PG8_STAGE(PG8_SA(1, 1), a1, cvA[1]);
            PG8_WAIT_V(8); PG8_WAIT_L(0); PG8_BAR; PG8_MMA(0, 0, At, B0); PG8_MMA(0, 1, At, B1); PG8_BAR; PG8_SCHED;
            PG8_LDA(At, 0, 1); PG8_STAGE(PG8_SB(0, 0), b2, voffB); PG8_STAGE(PG8_SB(0, 1), b2 + hstepB, voffB); PG8_STAGE(PG8_SA(0, 0), a2, v2[0]);
            PG8_WAIT_V(8); PG8_WAIT_L(0); PG8_BAR; PG8_MMA(1, 0, At, B0); PG8_MMA(1, 1, At, B1); PG8_BAR; PG8_SCHED;
            PG8_LDB(B0, 1, 0); PG8_LDB(B1, 1, 1); PG8_SCHED; PG8_LDA(At, 1, 0); PG8_STAGE(PG8_SA(0, 1), a2, v2[1]);
            PG8_WAIT_V(8); PG8_WAIT_L(0); PG8_BAR; PG8_MMA(0, 0, At, B0); PG8_MMA(0, 1, At, B1); PG8_BAR; PG8_SCHED;
            PG8_LDA(At, 1, 1); PG8_STAGE(PG8_SB(1, 0), b3, voffB); PG8_STAGE(PG8_SB(1, 1), b3 + hstepB, voffB); PG8_STAGE(PG8_SA(1, 0), a3, v2[0]);
            PG8_WAIT_V(8); PG8_WAIT_L(0); PG8_BAR; PG8_MMA(1, 0, At, B0); PG8_MMA(1, 1, At, B1); PG8_BAR; PG8_SCHED;
            } else {
            PG8_LDB(B0, 0, 0); PG8_SCHED; PG8_LDA(At, 0, 0); PG8_STAGE(PG8_SA(1, 1), a1, cvA[1]);
            PG8_WAIT_L(8); PG8_BAR; PG8_WAIT_L(0); PG8_MMA(0, 0, At, B0); PG8_BAR; PG8_SCHED;
            PG8_LDB(B1, 0, 1); PG8_STAGE(PG8_SB(0, 0), b2, voffB);
            PG8_BAR; PG8_WAIT_L(0); PG8_MMA(0, 1, At, B1); PG8_BAR;
            PG8_LDA(At, 0, 1); PG8_STAGE(PG8_SA(0, 0), a2, v2[0]);
            PG8_BAR; PG8_WAIT_L(0); PG8_MMA(1, 0, At, B0); PG8_BAR; PG8_SCHED;
            PG8_STAGE(PG8_SB(0, 1), b2 + hstepB, voffB);
            PG8_WAIT_V(6); PG8_BAR; PG8_MMA(1, 1, At, B1); PG8_BAR;
            PG8_LDB(B0, 1, 0); PG8_SCHED; PG8_LDA(At, 1, 0); PG8_STAGE(PG8_SA(0, 1), a2, v2[1]);
            PG8_WAIT_L(8); PG8_BAR; PG8_WAIT_L(0); PG8_MMA(0, 0, At, B0); PG8_BAR; PG8_SCHED;
            PG8_LDB(B1, 1, 1); PG8_STAGE(PG8_SB(1, 0), b3, voffB);
            PG8_BAR; PG8_WAIT_L(0); PG8_MMA(0, 1, At, B1); PG8_BAR;
            PG8_LDA(At, 1, 1); PG8_STAGE(PG8_SA(1, 0), a3, v2[0]);
            PG8_BAR; PG8_WAIT_L(0); PG8_MMA(1, 0, At, B0); PG8_BAR; PG8_SCHED;
            PG8_STAGE(PG8_SB(1, 1), b3 + hstepB, voffB);
            PG8_WAIT_V(6); PG8_BAR; PG8_MMA(1, 1, At, B1); PG8_BAR;
            }
        }
        if constexpr (ALIGN_EPI) { if (wr == 0) PG8_BAR; }
        const bool has_nn = has_next && unit_of((ui + 2) * nblk + bid, g.nM, g.nN, nn);
        int ridx[2][2];
        if (g.rowidx && has_nn) {
#pragma unroll
            for (int h = 0; h < 2; ++h)
#pragma unroll
                for (int i = 0; i < 2; ++i) ridx[h][i] = g.rowidx[nn.pm * 256 + 128 * h + RA[i]];
        }
        E(acc, cur, wr, wc, fr, fq);
        if (!has_next) break;
#pragma unroll
        for (int a = 0; a < 2; ++a)
#pragma unroll
            for (int b = 0; b < 2; ++b)
#pragma unroll
                for (int m = 0; m < 4; ++m)
#pragma unroll
                    for (int n = 0; n < 2; ++n) acc[a][b][m][n] = (f32x4){0.f, 0.f, 0.f, 0.f};
        cur = nxt; cB = nB; ++ui;
#pragma unroll
        for (int h = 0; h < 2; ++h)
#pragma unroll
            for (int i = 0; i < 2; ++i) { cvA[h][i] = nvA[h][i];
                if (has_nn) { const unsigned rr = g.rowidx ? (unsigned)ridx[h][i] : (unsigned)(nn.pm * 256 + 128 * h + RA[i]); nvA[h][i] = (rr * (unsigned)g.lda + (unsigned)CA[i]) * 2u; } }
        if constexpr (ALIGN_EPI) { if (wr == 1) PG8_BAR; }
    }
    PG8_WAIT_V(0);
    if constexpr (!ALIGN_EPI) { if (wr == 0) PG8_BAR; }
    PG8_BAR;
#undef PG8_SA
#undef PG8_SB
#undef PG8_STAGE
#undef PG8_LDA
#undef PG8_LDB
#undef PG8_MMA
#undef PG8_WAIT_V
#undef PG8_WAIT_L
#undef PG8_BAR
#undef PG8_SCHED
#undef PG8_VOFFA
}

struct EpiQKV {
    bf16_t *qa, *ka, *va, *qb, *kb, *vb, *ux; const float *qna, *kna, *qnb, *knb;
    DEVI void operator()(const f32x4 (&acc)[2][2][4][2], const Unit& u, int wr, int wc, int fr, int fq) const {
        bf16_t* dst; const float* gn = nullptr; int H = 8, head0 = 0; const int pn = u.pn;
        if (pn < 2) { dst = qa; gn = qna; head0 = pn * 4; }
        else if (pn < 4) { dst = ka; gn = kna; head0 = (pn - 2) * 4; }
        else if (pn < 6) { dst = va; head0 = (pn - 4) * 4; }
        else if (pn == 6) { dst = qb; gn = qnb; H = 4; }
        else if (pn == 7) { dst = kb; gn = knb; H = 4; }
        else if (pn == 8) { dst = vb; H = 4; }
        else { dst = ux; }
        const int head = head0 + wc;
        f32x4 gv[2][2];
#pragma unroll
        for (int bj = 0; bj < 2; ++bj)
#pragma unroll
            for (int n = 0; n < 2; ++n) gv[bj][n] = gn ? *(const f32x4*)(gn + 32 * bj + 8 * fq + 4 * n) : (f32x4){1.f, 1.f, 1.f, 1.f};
#pragma unroll
        for (int ai = 0; ai < 2; ++ai)
#pragma unroll
            for (int m = 0; m < 4; ++m) {
                const int row = u.pm * 256 + 128 * ai + 64 * wr + 16 * m + fr;
                float rstd = 1.f;
                if (gn) { float ss = 0.f;
#pragma unroll
                    for (int bj = 0; bj < 2; ++bj)
#pragma unroll
                        for (int n = 0; n < 2; ++n) { const f32x4 v = acc[ai][bj][m][n]; ss += v.x * v.x + v.y * v.y + v.z * v.z + v.w * v.w; }
                    ss += __shfl_xor(ss, 16); ss += __shfl_xor(ss, 32);
                    rstd = rsqrtf(ss * (1.f / 64.f) + kEps); }
#pragma unroll
                for (int bj = 0; bj < 2; ++bj) {
                    const f32x4 v0 = acc[ai][bj][m][0] * rstd * gv[bj][0], v1 = acc[ai][bj][m][1] * rstd * gv[bj][1];
                    u32x4 w; w.x = pk2(v0.x, v0.y); w.y = pk2(v0.z, v0.w); w.z = pk2(v1.x, v1.y); w.w = pk2(v1.z, v1.w);
                    if (pn < 9) { const int b = row >> 13, s = row & (kS - 1);
                        *(u32x4*)(dst + (((size_t)(b * H + head)) * kS + s) * 64 + 32 * bj + 8 * fq) = w; }
                    else { const int gidx = 4 * wc + 2 * bj + (fq >> 1), c0 = 8 * (fq & 1);
                        *(u32x4*)(dst + ((size_t)gidx * 4096 + (row >> 4)) * 512 + (row & 15) * 16 + c0) = w; }
                }
            }
    }
};
struct EpiResid {
    const float* xin; float* xout;
    DEVI void operator()(const f32x4 (&acc)[2][2][4][2], const Unit& u, int wr, int wc, int fr, int fq) const {
#pragma unroll
        for (int ai = 0; ai < 2; ++ai)
#pragma unroll
            for (int m = 0; m < 4; ++m) { const size_t ro = (size_t)(u.pm * 256 + 128 * ai + 64 * wr + 16 * m + fr) * kD + u.pn * 256 + 32 * wc + 4 * fq;
#pragma unroll
                for (int bj = 0; bj < 2; ++bj)
#pragma unroll
                    for (int n = 0; n < 2; ++n) { const size_t o = ro + 128 * bj + 16 * n; *(f32x4*)(xout + o) = *(const f32x4*)(xin + o) + acc[ai][bj][m][n]; } }
    }
};
struct EpiGU {
    bf16_t* hid;
    DEVI void operator()(const f32x4 (&acc)[2][2][4][2], const Unit& u, int wr, int wc, int fr, int fq) const {
#pragma unroll
        for (int ai = 0; ai < 2; ++ai)
#pragma unroll
            for (int m = 0; m < 4; ++m) { const size_t row = (size_t)(u.pm * 256 + 128 * ai + 64 * wr + 16 * m + fr);
                float o[8];
#pragma unroll
                for (int n = 0; n < 2; ++n)
#pragma unroll
                    for (int j = 0; j < 4; ++j) { const float gt = acc[ai][0][m][n][j], up = acc[ai][1][m][n][j]; o[n * 4 + j] = gt / (1.f + __expf(-gt)) * up; }
                u32x4 w; w.x = pk2(o[0], o[1]); w.y = pk2(o[2], o[3]); w.z = pk2(o[4], o[5]); w.w = pk2(o[6], o[7]);
                *(u32x4*)(hid + row * kFF + u.pn * 128 + 32 * wc + 8 * fq) = w; }
    }
};
struct EpiDown {
    bf16_t* y; const float* gate;
    DEVI void operator()(const f32x4 (&acc)[2][2][4][2], const Unit& u, int wr, int wc, int fr, int fq) const {
#pragma unroll
        for (int ai = 0; ai < 2; ++ai)
#pragma unroll
            for (int m = 0; m < 4; ++m) { const size_t row = (size_t)(u.pm * 256 + 128 * ai + 64 * wr + 16 * m + fr); const float gv = gate[row];
#pragma unroll
                for (int bj = 0; bj < 2; ++bj) { const f32x4 v0 = acc[ai][bj][m][0] * gv, v1 = acc[ai][bj][m][1] * gv;
                    u32x4 w; w.x = pk2(v0.x, v0.y); w.y = pk2(v0.z, v0.w); w.z = pk2(v1.x, v1.y); w.w = pk2(v1.z, v1.w);
                    *(u32x4*)(y + row * kD + u.pn * 256 + 128 * bj + 32 * wc + 8 * fq) = w; } }
    }
};
struct EpiGlu {
    const bf16_t* g; bf16_t* oc;
    DEVI void operator()(const f32x4 (&acc)[2][2][4][2], const Unit& u, int wr, int wc, int fr, int fq) const {
#pragma unroll
        for (int ai = 0; ai < 2; ++ai)
#pragma unroll
            for (int m = 0; m < 4; ++m) { const size_t row = (size_t)(u.pm * 256 + 128 * ai + 64 * wr + 16 * m + fr);
#pragma unroll
                for (int bj = 0; bj < 2; ++bj) { const size_t o = row * 256 + 128 * bj + 32 * wc + 8 * fq;
                    const u32x4 gw = *(const u32x4*)(g + o); float o8[8];
#pragma unroll
                    for (int n = 0; n < 2; ++n)
#pragma unroll
                        for (int j = 0; j < 4; ++j) { const int t = n * 4 + j; const unsigned wv = (t < 2) ? gw.x : (t < 4) ? gw.y : (t < 6) ? gw.z : gw.w;
                            const float gg = __uint_as_float((t & 1) ? (wv & 0xFFFF0000u) : (wv << 16)); o8[t] = gg / (1.f + __expf(-acc[ai][bj][m][n][j])); }
                    u32x4 w; w.x = pk2(o8[0], o8[1]); w.y = pk2(o8[2], o8[3]); w.z = pk2(o8[4], o8[5]); w.w = pk2(o8[6], o8[7]);
                    *(u32x4*)(oc + o) = w; } }
    }
};

DEVI void load_row64(const bf16_t* p, float* d) {
#pragma unroll
    for (int i = 0; i < 8; ++i) { const u32x4 v = *(const u32x4*)(p + i * 8);
        d[i * 8 + 0] = __uint_as_float(v.x << 16); d[i * 8 + 1] = __uint_as_float(v.x & 0xFFFF0000u); d[i * 8 + 2] = __uint_as_float(v.y << 16); d[i * 8 + 3] = __uint_as_float(v.y & 0xFFFF0000u);
        d[i * 8 + 4] = __uint_as_float(v.z << 16); d[i * 8 + 5] = __uint_as_float(v.z & 0xFFFF0000u); d[i * 8 + 6] = __uint_as_float(v.w << 16); d[i * 8 + 7] = __uint_as_float(v.w & 0xFFFF0000u); }
}
DEVI void store_row64(bf16_t* p, const float* d, float sc) {
#pragma unroll
    for (int i = 0; i < 8; ++i) { u32x4 w; w.x = pk2(d[i * 8] * sc, d[i * 8 + 1] * sc); w.y = pk2(d[i * 8 + 2] * sc, d[i * 8 + 3] * sc); w.z = pk2(d[i * 8 + 4] * sc, d[i * 8 + 5] * sc); w.w = pk2(d[i * 8 + 6] * sc, d[i * 8 + 7] * sc);
        *(u32x4*)(p + i * 8) = w; }
}
DEVI void phase_dilated_naive(const bf16_t* qa, const bf16_t* ka, const bf16_t* va, bf16_t* oac, float* lse, int bid, int nblk) {
    const int nitems = 3 * kB * 8 * (kS / kNT);
    for (int it = bid; it < nitems; it += nblk) {
        const int c = it / (kB * 8 * 16), r = it % (kB * 8 * 16), bh = r / 16, t = (r % 16) * kNT + tidx(), b = bh >> 3, h = bh & 7;
        const int dil = (c == 0) ? 1 : (c == 1) ? 4 : 16;
        const float slope = exp2f(-(float)(h + 1));
        const bf16_t* kb_ = ka + (size_t)bh * kS * 64; const bf16_t* vb_ = va + (size_t)bh * kS * 64;
        float q[64], o[64];
        load_row64(qa + ((size_t)bh * kS + t) * 64, q);
#pragma unroll
        for (int d = 0; d < 64; ++d) o[d] = 0.f;
        float m = -1e30f, l = 0.f;
        for (int rel = -64; rel <= 64; ++rel) {
            const int pos = t + rel * dil;
            if (pos < 0 || pos >= kS) continue;
            float kv[64]; load_row64(kb_ + (size_t)pos * 64, kv);
            float dot = 0.f;
#pragma unroll
            for (int d = 0; d < 64; ++d) dot += q[d] * kv[d];
            const float sc = dot * 0.125f - slope * (float)(dil * (rel < 0 ? -rel : rel));
            const float mn = fmaxf(m, sc), corr = __expf(m - mn), p = __expf(sc - mn);
            load_row64(vb_ + (size_t)pos * 64, kv);
            l = l * corr + p;
#pragma unroll
            for (int d = 0; d < 64; ++d) o[d] = o[d] * corr + p * kv[d];
            m = mn;
        }
        const size_t tok = (size_t)b * kS + t;
        store_row64(oac + ((size_t)c * kTok + tok) * 512 + h * 64, o, 1.f / l);
        lse[((size_t)c * kTok + tok) * 8 + h] = m + __logf(l);
    }
}
DEVI void phase_na_naive(const bf16_t* qb, const bf16_t* kbuf, const bf16_t* vbuf, const float* rpb  , bf16_t* ob, int bid, int nblk) {
    const int nitems = kB * 4 * (kS / kNT);
    for (int it = bid; it < nitems; it += nblk) {
        const int bh = it / 16, t = (it % 16) * kNT + tidx(), b = bh >> 2, h = bh & 3;
        const int r = t >> 6, cq = t & 63;
        int rs = r - 4; rs = rs < 0 ? 0 : (rs > 120 ? 120 : rs);
        int cs = cq - 8; cs = cs < 0 ? 0 : (cs > 48 ? 48 : cs);
        const bf16_t* kb_ = kbuf + (size_t)bh * kS * 64; const bf16_t* vb_ = vbuf + (size_t)bh * kS * 64;
        float q[64], o[64];
        load_row64(qb + ((size_t)bh * kS + t) * 64, q);
#pragma unroll
        for (int d = 0; d < 64; ++d) o[d] = 0.f;
        float m = -1e30f, l = 0.f;
        for (int kr = 0; kr < 8; ++kr)
            for (int kc = 0; kc < 16; ++kc) {
                const int krow = rs + kr, kcol = cs + kc, pos = krow * 64 + kcol;
                float kv[64]; load_row64(kb_ + (size_t)pos * 64, kv);
                float dot = 0.f;
#pragma unroll
                for (int d = 0; d < 64; ++d) dot += q[d] * kv[d];
                const float sc = dot * 0.125f + rpb[(h * 15 + (krow - r + 7)) * 31 + (kcol - cq + 15)];
                const float mn = fmaxf(m, sc), corr = __expf(m - mn), p = __expf(sc - mn);
                load_row64(vb_ + (size_t)pos * 64, kv);
                l = l * corr + p;
#pragma unroll
                for (int d = 0; d < 64; ++d) o[d] = o[d] * corr + p * kv[d];
                m = mn;
            }
        store_row64(ob + ((size_t)b * kS + t) * 256 + h * 64, o, 1.f / l);
    }
}

typedef float f32x16 __attribute__((ext_vector_type(16)));
typedef short s16x4 __attribute__((ext_vector_type(4)));
constexpr float kLog2e = 1.4426950408889634f, kLn2 = 0.6931471805599453f;
DEVI bf16x8 tr_pair(LAS unsigned char* p0, LAS unsigned char* p1) {
    const s16x4 a = __builtin_amdgcn_ds_read_tr16_b64_v4i16((LAS s16x4*)p0), b = __builtin_amdgcn_ds_read_tr16_b64_v4i16((LAS s16x4*)p1);
    return (bf16x8){a.x, a.y, a.z, a.w, b.x, b.y, b.z, b.w};
}
DEVI void phase_dilated(const bf16_t* qa, const bf16_t* ka, const bf16_t* va, bf16_t* oac, float* lse, LAS unsigned char* lds, int bid, int nblk) {
    const int tid = tidx(), wid = __builtin_amdgcn_readfirstlane(tid >> 6), lane = tid & 63, h5 = lane >> 5, qc = lane & 31;
    LAS unsigned char* Kimg = lds; LAS unsigned char* Vimg = lds + 49152;
    unsigned koff[4];
#pragma unroll
    for (int s = 0; s < 4; ++s) koff[s] = (unsigned)((32 * wid + qc) * 128 + (((2 * s + h5) ^ (qc & 7)) << 4));
    unsigned voff[2];
    { const int g = lane >> 4, i16 = lane & 15, q = i16 >> 2, p = i16 & 3;
#pragma unroll
      for (int dt = 0; dt < 2; ++dt) { const int c = (2 * (g & 1) + (p >> 1) + 4 * dt) ^ ((q >> 1) << 2); voff[dt] = (unsigned)((32 * wid + 4 * h5 + q) * 128 + (c << 4) + 8 * (p & 1)); } }
    for (int unit = bid; unit < 6144; unit += nblk) {
        const int c = unit >> 11, rem = unit & 2047, bh = rem >> 5, ub = rem & 31;
        const int dsh = 2 * c, dil = 1 << dsh, L = kS >> dsh, upc = 32 >> dsh, cls = ub >> (5 - dsh), u0 = (ub & (upc - 1)) << 8;
        const bf16_t* kbase = ka + (size_t)bh * kS * 64; const bf16_t* vbase = va + (size_t)bh * kS * 64;
        __syncthreads();
#pragma unroll
        for (int it = 0; it < 6; ++it) {
            const int id = it * kNT + tid, row = id >> 3, ch = id & 7;
            int ki = u0 - 64 + row; ki = ki < 0 ? 0 : (ki > L - 1 ? L - 1 : ki);
            const size_t tok = (size_t)((ki << dsh) + cls);
            const u32x4 kv = *(const u32x4*)(kbase + tok * 64 + ch * 8), vv = *(const u32x4*)(vbase + tok * 64 + ch * 8);
            *(LAS u32x4*)(Kimg + row * 128 + ((ch ^ (row & 7)) << 4)) = kv;
            *(LAS u32x4*)(Vimg + row * 128 + ((ch ^ (((row >> 1) & 1) << 2)) << 4)) = vv;
        }
        __syncthreads();
        const int q0 = u0 + 32 * wid, qtok = ((q0 + qc) << dsh) + cls;
        bf16x8 Qf[4];
#pragma unroll
        for (int s = 0; s < 4; ++s) Qf[s] = *(const bf16x8*)(qa + ((size_t)bh * kS + qtok) * 64 + 16 * s + 8 * h5);
        f32x16 S[5];
#pragma unroll
        for (int kt = 0; kt < 5; ++kt) {
#pragma unroll
            for (int i = 0; i < 16; ++i) S[kt][i] = 0.f;
#pragma unroll
            for (int s = 0; s < 4; ++s) { const bf16x8 Kf = *(const LAS bf16x8*)(Kimg + koff[s] + kt * 4096); S[kt] = __builtin_amdgcn_mfma_f32_32x32x16_bf16(Kf, Qf[s], S[kt], 0, 0, 0); }
        }
        const float slope = exp2f(-(float)((bh & 7) + 1));
        const float c1 = 0.125f * kLog2e, c2 = slope * (float)dil * kLog2e;
        float mx = -1e30f;
        int qcv = qc; asm volatile("" : "+v"(qcv));
#pragma unroll
        for (int kt = 0; kt < 5; ++kt)
#pragma unroll
            for (int i = 0; i < 16; ++i) {
                const int kr = (i & 3) + 8 * (i >> 2) + 4 * h5, rel = 32 * kt + kr - 64 - qcv, kpos = q0 - 64 + 32 * kt + kr;
                const float relf = fabsf((float)rel);
                const bool valid = ((unsigned)kpos < (unsigned)L) && (relf <= 64.f);
                const float sv = valid ? (S[kt][i] * c1 - c2 * relf) : -1e30f;
                S[kt][i] = sv; mx = fmaxf(mx, sv);
            }
        mx = fmaxf(mx, __shfl_xor(mx, 32));
        float sum = 0.f;
#pragma unroll
        for (int kt = 0; kt < 5; ++kt)
#pragma unroll
            for (int i = 0; i < 16; ++i) { const float pv = __builtin_amdgcn_exp2f(S[kt][i] - mx); S[kt][i] = pv; sum += pv; }
        sum += __shfl_xor(sum, 32);
        f32x16 O[2];
#pragma unroll
        for (int dt = 0; dt < 2; ++dt)
#pragma unroll
            for (int i = 0; i < 16; ++i) O[dt][i] = 0.f;
#pragma unroll
        for (int kt = 0; kt < 5; ++kt)
#pragma unroll
            for (int s2 = 0; s2 < 2; ++s2) {
                u32x4 pw; pw.x = pk2(S[kt][8 * s2 + 0], S[kt][8 * s2 + 1]); pw.y = pk2(S[kt][8 * s2 + 2], S[kt][8 * s2 + 3]); pw.z = pk2(S[kt][8 * s2 + 4], S[kt][8 * s2 + 5]); pw.w = pk2(S[kt][8 * s2 + 6], S[kt][8 * s2 + 7]);
                const bf16x8 Pf = __builtin_bit_cast(bf16x8, pw);
#pragma unroll
                for (int dt = 0; dt < 2; ++dt) { LAS unsigned char* vp = Vimg + voff[dt] + kt * 4096 + s2 * 2048;
                    const bf16x8 Vf = tr_pair(vp, vp + 1024);
                    O[dt] = __builtin_amdgcn_mfma_f32_32x32x16_bf16(Vf, Pf, O[dt], 0, 0, 0); }
            }
        const float inv = 1.f / sum;
        const size_t tok = (size_t)(bh >> 3) * kS + qtok;
        bf16_t* orow = oac + ((size_t)c * kTok + tok) * 512 + (bh & 7) * 64;
#pragma unroll
        for (int dt = 0; dt < 2; ++dt)
#pragma unroll
            for (int g4 = 0; g4 < 4; ++g4) { u32x2 w; w.x = pk2(O[dt][4 * g4] * inv, O[dt][4 * g4 + 1] * inv); w.y = pk2(O[dt][4 * g4 + 2] * inv, O[dt][4 * g4 + 3] * inv);
                *(u32x2*)(orow + 32 * dt + 8 * g4 + 4 * h5) = w; }
        if (h5 == 0) lse[((size_t)c * kTok + tok) * 8 + (bh & 7)] = mx * kLn2 + __logf(sum);
    }
    __syncthreads();
}
DEVI void phase_na(const bf16_t* qb, const bf16_t* kb, const bf16_t* vb, const float* rpb  , bf16_t* ob, LAS unsigned char* lds, int bid, int nblk) {
    const int tid = tidx(), wid = __builtin_amdgcn_readfirstlane(tid >> 6), lane = tid & 63, g4 = lane >> 4, i16 = lane & 15;
    LAS unsigned char* Kimg = lds; LAS unsigned char* Vimg = lds + 73728; LAS float* tab = (LAS float*)(lds + 147456);
    for (int i = tid; i < 4 * 465; i += kNT) tab[i] = rpb[i];
    const int g = wid & 3, kcs = (16 * g - 8) < 0 ? 0 : ((16 * g - 8) > 32 ? 32 : (16 * g - 8));
    const int qcol = 16 * g + i16, cs = (qcol - 8) < 0 ? 0 : ((qcol - 8) > 48 ? 48 : (qcol - 8));
    unsigned kswz[2];
#pragma unroll
    for (int s = 0; s < 2; ++s) kswz[s] = (unsigned)(((4 * s + g4) ^ (i16 & 7)) << 4);
    const int q = i16 >> 2, p = i16 & 3, sw = 2 * (g4 & 1) + (q >> 1);
    unsigned vsw[4];
#pragma unroll
    for (int dt = 0; dt < 4; ++dt) vsw[dt] = (unsigned)((((2 * dt + (p >> 1)) ^ (sw << 1)) << 4) + 8 * (p & 1));
    for (int unit = bid; unit < 2048; unit += nblk) {
        const int bh = unit >> 6, rp = unit & 63, r0 = 2 * rp, h = bh & 3;
        const int rsA = (r0 - 4) < 0 ? 0 : ((r0 - 4) > 120 ? 120 : (r0 - 4));
        const bf16_t* kbase = kb + (size_t)bh * kS * 64; const bf16_t* vbase = vb + (size_t)bh * kS * 64;
        __syncthreads();
#pragma unroll
        for (int it = 0; it < 9; ++it) {
            const int id = it * kNT + tid, row = id >> 3, ch = id & 7;
            int gr = rsA + (row >> 6); gr = gr > 127 ? 127 : gr;
            const size_t tok = (size_t)(gr * 64 + (row & 63));
            const u32x4 kv = *(const u32x4*)(kbase + tok * 64 + ch * 8), vv = *(const u32x4*)(vbase + tok * 64 + ch * 8);
            *(LAS u32x4*)(Kimg + row * 128 + ((ch ^ (row & 7)) << 4)) = kv;
            *(LAS u32x4*)(Vimg + row * 128 + ((ch ^ (((row >> 1) & 3) << 1)) << 4)) = vv;
        }
        __syncthreads();
        const int rr = r0 + (wid >> 2);
        const int rs = (rr - 4) < 0 ? 0 : ((rr - 4) > 120 ? 120 : (rr - 4)), ro = rs - rsA;
        const int qtok = rr * 64 + qcol;
        bf16x8 Qf[2];
#pragma unroll
        for (int s = 0; s < 2; ++s) Qf[s] = *(const bf16x8*)(qb + ((size_t)bh * kS + qtok) * 64 + 32 * s + 8 * g4);
        f32x4 S[16];
        const unsigned kb0 = (unsigned)((ro * 64 + kcs + i16) * 128);
#pragma unroll
        for (int t = 0; t < 16; ++t) { S[t] = (f32x4){0.f, 0.f, 0.f, 0.f};
#pragma unroll
            for (int s = 0; s < 2; ++s) { const bf16x8 Kf = *(const LAS bf16x8*)(Kimg + kb0 + (t >> 1) * 8192 + (t & 1) * 2048 + kswz[s]); S[t] = __builtin_amdgcn_mfma_f32_16x16x32_bf16(Kf, Qf[s], S[t], 0, 0, 0); } }
        float mx = -1e30f;
        const LAS float* th = tab + h * 465;
        int g4v = g4; asm volatile("" : "+v"(g4v));
#pragma unroll
        for (int t = 0; t < 16; ++t)
#pragma unroll
            for (int j = 0; j < 4; ++j) {
                const int krow = rs + (t >> 1), kcol = kcs + 16 * (t & 1) + 4 * g4v + j;
                const bool valid = (kcol >= cs) && (kcol < cs + 16);
                int dc = kcol - qcol + 15; dc = dc < 0 ? 0 : (dc > 30 ? 30 : dc);
                const float bias = th[(krow - rr + 7) * 31 + dc];
                const float sv = valid ? (S[t][j] * 0.125f + bias) * kLog2e : -1e30f;
                S[t][j] = sv; mx = fmaxf(mx, sv);
            }
        mx = fmaxf(mx, __shfl_xor(mx, 16)); mx = fmaxf(mx, __shfl_xor(mx, 32));
        float sum = 0.f;
#pragma unroll
        for (int t = 0; t < 16; ++t)
#pragma unroll
            for (int j = 0; j < 4; ++j) { const float pv = __builtin_amdgcn_exp2f(S[t][j] - mx); S[t][j] = pv; sum += pv; }
        sum += __shfl_xor(sum, 16); sum += __shfl_xor(sum, 32);
        f32x4 O[4];
#pragma unroll
        for (int dt = 0; dt < 4; ++dt) O[dt] = (f32x4){0.f, 0.f, 0.f, 0.f};
        const unsigned vb0 = (unsigned)((ro * 64 + kcs + 4 * g4 + q) * 128);
#pragma unroll
        for (int u = 0; u < 8; ++u) {
            u32x4 pw; pw.x = pk2(S[2 * u][0], S[2 * u][1]); pw.y = pk2(S[2 * u][2], S[2 * u][3]); pw.z = pk2(S[2 * u + 1][0], S[2 * u + 1][1]); pw.w = pk2(S[2 * u + 1][2], S[2 * u + 1][3]);
            const bf16x8 Pf = __builtin_bit_cast(bf16x8, pw);
#pragma unroll
            for (int dt = 0; dt < 4; ++dt) { LAS unsigned char* vp = Vimg + vb0 + u * 8192 + vsw[dt];
                const bf16x8 Vf = tr_pair(vp, vp + 2048);
                O[dt] = __builtin_amdgcn_mfma_f32_16x16x32_bf16(Vf, Pf, O[dt], 0, 0, 0); }
        }
        const float inv = 1.f / sum;
        bf16_t* orow = ob + ((size_t)(bh >> 2) * kS + qtok) * 256 + h * 64;
#pragma unroll
        for (int dt = 0; dt < 4; ++dt) { u32x2 w; w.x = pk2(O[dt][0] * inv, O[dt][1] * inv); w.y = pk2(O[dt][2] * inv, O[dt][3] * inv); *(u32x2*)(orow + 16 * dt + 4 * g4) = w; }
    }
    __syncthreads();
}
DEVI void phase_s5_naive(const Params& P, int l, const bf16_t* ux, float* ys, unsigned char* lds, int bid, int nblk) {
    const int wid = tidx() >> 6, lane = tidx() & 63;
    float* xs = (float*)lds + wid * 128;
    for (int item = wid * nblk + bid; item < kB * 16 * 2; item += nblk * 8) {
        const int dir = item & 1, g = (item >> 1) & 15, b = item >> 5;
        const size_t pbase = (((size_t)l * 2 + dir) * 16 + g) * 64;
        const float dt = __expf(P.s5_log_dt[((size_t)l * 2 + dir) * 16 + g]);
        const float a = fminf(P.s5_a_re[pbase + lane], -1e-4f), w = P.s5_a_im[pbase + lane];
        const float mag = __expf(a * dt), ar = mag * cosf(w * dt), ai = mag * sinf(w * dt);
        const float den = a * a + w * w, zr = ar - 1.f, gr = (zr * a + ai * w) / den, gi = (ai * a - zr * w) / den;
        float bbr[16], bbi[16];
#pragma unroll
        for (int c = 0; c < 16; ++c) { const float br = P.s5_b_re[(pbase + lane) * 16 + c], bi = P.s5_b_im[(pbase + lane) * 16 + c]; bbr[c] = gr * br - gi * bi; bbi[c] = gr * bi + gi * br; }
        const int cch = lane & 15, qt = lane >> 4;
        float cre[16], cim[16];
#pragma unroll
        for (int pp = 0; pp < 16; ++pp) { cre[pp] = P.s5_c_re[(pbase / 64 * 16 + cch) * 64 + qt * 16 + pp]; cim[pp] = P.s5_c_im[(pbase / 64 * 16 + cch) * 64 + qt * 16 + pp]; }
        float xr = 0.f, xi = 0.f;
        const bf16_t* ug = ux + (size_t)g * 4096 * 512;
        for (int st = 0; st < kS; ++st) {
            const int s = dir ? (kS - 1 - st) : st; const size_t tok = (size_t)b * kS + s;
            const bf16_t* up = ug + (tok >> 4) * 512 + (tok & 15) * 16;
            const u32x4 u0 = *(const u32x4*)up, u1 = *(const u32x4*)(up + 8);
            float uv[16];
            uv[0] = __uint_as_float(u0.x << 16); uv[1] = __uint_as_float(u0.x & 0xFFFF0000u); uv[2] = __uint_as_float(u0.y << 16); uv[3] = __uint_as_float(u0.y & 0xFFFF0000u);
            uv[4] = __uint_as_float(u0.z << 16); uv[5] = __uint_as_float(u0.z & 0xFFFF0000u); uv[6] = __uint_as_float(u0.w << 16); uv[7] = __uint_as_float(u0.w & 0xFFFF0000u);
            uv[8] = __uint_as_float(u1.x << 16); uv[9] = __uint_as_float(u1.x & 0xFFFF0000u); uv[10] = __uint_as_float(u1.y << 16); uv[11] = __uint_as_float(u1.y & 0xFFFF0000u);
            uv[12] = __uint_as_float(u1.z << 16); uv[13] = __uint_as_float(u1.z & 0xFFFF0000u); uv[14] = __uint_as_float(u1.w << 16); uv[15] = __uint_as_float(u1.w & 0xFFFF0000u);
            float bur = 0.f, bui = 0.f;
#pragma unroll
            for (int c = 0; c < 16; ++c) { bur += bbr[c] * uv[c]; bui += bbi[c] * uv[c]; }
            const float nr = ar * xr - ai * xi + bur, ni = ar * xi + ai * xr + bui; xr = nr; xi = ni;
            xs[lane] = xr; xs[64 + lane] = xi;
            asm volatile("s_waitcnt lgkmcnt(0)" ::: "memory");
            float y = 0.f;
#pragma unroll
            for (int pp = 0; pp < 16; ++pp) y += cre[pp] * xs[qt * 16 + pp] - cim[pp] * xs[64 + qt * 16 + pp];
            asm volatile("s_waitcnt lgkmcnt(0)" ::: "memory");
            y += __shfl_xor(y, 16); y += __shfl_xor(y, 32);
            if (lane < 16) ys[((size_t)dir * kTok + tok) * 256 + g * 16 + cch] = y;
        }
    }
}
DEVI void phase_s5_finish(const float* ys, const bf16_t* ux, const float* dskip, bf16_t* G, int bid, int nblk) {
    for (size_t i = (size_t)bid * kNT + tidx(); i < (size_t)kTok * 256; i += (size_t)nblk * kNT) {
        const size_t tok = i >> 8; const int ch = (int)(i & 255), g = ch >> 4, c = ch & 15;
        const float u = bf2f(ux[((size_t)g * 4096 + (tok >> 4)) * 512 + (tok & 15) * 16 + c]);
        const float y = ys[i] + ys[(size_t)kTok * 256 + i] + dskip[ch] * u;
        G[i] = f2bf(gelu_tanh(y));
    }
}
DEVI void phase_mixnorm(const bf16_t* oac, const float* lse, const bf16_t* ob, const bf16_t* oc, const float* ga, const float* gb, const float* gc, bf16_t* mix, int bid, int nblk) {
    const int wid = tidx() >> 6, lane = tidx() & 63;
    float gn[16];
    { const float* gp = (lane < 32) ? ga + lane * 16 : (lane < 48) ? gb + (lane - 32) * 16 : gc + (lane - 48) * 16;
#pragma unroll
      for (int i = 0; i < 16; ++i) gn[i] = gp[i]; }
    for (int row = bid * 8 + wid; row < kTok; row += nblk * 8) {
        float v[16];
        if (lane < 32) {
            const int h = lane >> 2;
            const float l0 = lse[(size_t)row * 8 + h], l1 = lse[((size_t)kTok + row) * 8 + h], l2 = lse[((size_t)2 * kTok + row) * 8 + h];
            const float mx = fmaxf(l0, fmaxf(l1, l2)); float w0 = __expf(l0 - mx), w1 = __expf(l1 - mx), w2 = __expf(l2 - mx); const float inv = 1.f / (w0 + w1 + w2); w0 *= inv; w1 *= inv; w2 *= inv;
#pragma unroll
            for (int i = 0; i < 16; ++i) v[i] = 0.f;
#pragma unroll
            for (int c = 0; c < 3; ++c) { const float wc_ = (c == 0) ? w0 : (c == 1) ? w1 : w2; const bf16_t* p = oac + ((size_t)c * kTok + row) * 512 + lane * 16;
#pragma unroll
                for (int i = 0; i < 16; ++i) v[i] += wc_ * bf2f(p[i]); }
        } else {
            const bf16_t* p = (lane < 48) ? ob + (size_t)row * 256 + (lane - 32) * 16 : oc + (size_t)row * 256 + (lane - 48) * 16;
#pragma unroll
            for (int i = 0; i < 16; ++i) v[i] = bf2f(p[i]);
        }
        float ss = 0.f;
#pragma unroll
        for (int i = 0; i < 16; ++i) ss += v[i] * v[i];
#pragma unroll
        for (int m = 1; m <= 8; m <<= 1) ss += __shfl_xor(ss, m);
        const float o16 = __shfl_xor(ss, 16);
        if (lane < 32) ss += o16;
        const float rstd = rsqrtf(ss * ((lane < 32) ? (1.f / 512.f) : (1.f / 256.f)) + kEps);
        u32x4 w0, w1;
        w0.x = pk2(v[0] * rstd * gn[0], v[1] * rstd * gn[1]); w0.y = pk2(v[2] * rstd * gn[2], v[3] * rstd * gn[3]); w0.z = pk2(v[4] * rstd * gn[4], v[5] * rstd * gn[5]); w0.w = pk2(v[6] * rstd * gn[6], v[7] * rstd * gn[7]);
        w1.x = pk2(v[8] * rstd * gn[8], v[9] * rstd * gn[9]); w1.y = pk2(v[10] * rstd * gn[10], v[11] * rstd * gn[11]); w1.z = pk2(v[12] * rstd * gn[12], v[13] * rstd * gn[13]); w1.w = pk2(v[14] * rstd * gn[14], v[15] * rstd * gn[15]);
        *(u32x4*)(mix + (size_t)row * kD + lane * 16) = w0; *(u32x4*)(mix + (size_t)row * kD + lane * 16 + 8) = w1;
    }
}
DEVI void phase_combine(float* x, const bf16_t* y, const int* tokslot, const float* gain_next, bf16_t* h, int bid, int nblk) {
    const int wid = tidx() >> 6, lane = tidx() & 63;
    f32x4 g[4];
#pragma unroll
    for (int q = 0; q < 4; ++q) g[q] = gain_next ? *(const f32x4*)(gain_next + q * 256 + lane * 4) : (f32x4){0.f, 0.f, 0.f, 0.f};
    for (int row = bid * 8 + wid; row < kTok; row += nblk * 8) {
        const int b = row >> 13;
        const int ts = tokslot[(size_t)row * kE + (lane & 15)];
        f32x4 v[4];
#pragma unroll
        for (int q = 0; q < 4; ++q) v[q] = *(const f32x4*)(x + (size_t)row * kD + q * 256 + lane * 4);
#pragma unroll
        for (int e = 0; e < kE; ++e) { const int slot = __builtin_amdgcn_readlane(ts, e);
            if (slot >= 0) { const bf16_t* yr = y + ((size_t)(e * kB + b) * kCap + slot) * kD;
#pragma unroll
                for (int q = 0; q < 4; ++q) { const u32x2 w = *(const u32x2*)(yr + q * 256 + lane * 4);
                    v[q].x += __uint_as_float(w.x << 16); v[q].y += __uint_as_float(w.x & 0xFFFF0000u); v[q].z += __uint_as_float(w.y << 16); v[q].w += __uint_as_float(w.y & 0xFFFF0000u); } } }
        float ss = 0.f;
#pragma unroll
        for (int q = 0; q < 4; ++q) { *(f32x4*)(x + (size_t)row * kD + q * 256 + lane * 4) = v[q]; ss += v[q].x * v[q].x + v[q].y * v[q].y + v[q].z * v[q].z + v[q].w * v[q].w; }
        if (gain_next) { ss = wave_sum(ss); const float rstd = rsqrtf(ss * (1.f / kD) + kEps);
#pragma unroll
            for (int q = 0; q < 4; ++q) { u32x2 o; o.x = pk2(v[q].x * rstd * g[q].x, v[q].y * rstd * g[q].y); o.y = pk2(v[q].z * rstd * g[q].z, v[q].w * rstd * g[q].w);
                *(u32x2*)(h + (size_t)row * kD + q * 256 + lane * 4) = o; } }
    }
}


DEVI void cpow_m(double a, double w, double dt, int m, float& re, float& im) {
    const float mag = __expf((float)m * (float)a * (float)dt);
    const double turns = (double)m * w * dt * 0.15915494309189535; const float ang = (float)((turns - floor(turns)) * 6.283185307179586);
    re = mag * cosf(ang); im = mag * sinf(ang);
}
DEVI void s5_prep_item(const Params& P, int l, int g, unsigned char* lds_) {
    float* pw = (float*)lds_;
    float* bb = pw + 4352;
    float* cc = bb + 4096;
    float* kt = cc + 4096;
    const int tid = tidx();
    __syncthreads();
    for (int i = tid; i < 128; i += kNT) { const int dir = i >> 6, p = i & 63; const size_t pb = (((size_t)l * 2 + dir) * 16 + g) * 64 + p;
        const double dt = (double)__expf(P.s5_log_dt[((size_t)l * 2 + dir) * 16 + g]); const double a = (double)fminf(P.s5_a_re[pb], -1e-4f), w = (double)P.s5_a_im[pb];
        for (int m = 0; m < 17; ++m) { float re, im; cpow_m(a, w, dt, m, re, im); pw[((dir * 64 + p) * 17 + m) * 2] = re; pw[((dir * 64 + p) * 17 + m) * 2 + 1] = im; }
        const float af = (float)a, wf = (float)w, ar = pw[((dir * 64 + p) * 17 + 1) * 2], ai = pw[((dir * 64 + p) * 17 + 1) * 2 + 1];
        const float den = af * af + wf * wf, zr = ar - 1.f, gr = (zr * af + ai * wf) / den, gi = (ai * af - zr * wf) / den;
        for (int c = 0; c < 16; ++c) { const float br = P.s5_b_re[pb * 16 + c], bi = P.s5_b_im[pb * 16 + c]; bb[((dir * 64 + p) * 16 + c) * 2] = gr * br - gi * bi; bb[((dir * 64 + p) * 16 + c) * 2 + 1] = gr * bi + gi * br; }
    }
    for (int i = tid; i < 2048; i += kNT) { const int dir = i >> 10, c = (i >> 6) & 15, p = i & 63; const size_t o = ((((size_t)l * 2 + dir) * 16 + g) * 16 + c) * 64 + p; cc[i * 2] = P.s5_c_re[o]; cc[i * 2 + 1] = P.s5_c_im[o]; }
    __syncthreads();
    for (int i = tid; i < 8192; i += kNT) { const int dir = i >> 12, m = (i >> 8) & 15, c = (i >> 4) & 15, c2 = i & 15; float acc = 0.f;
        for (int p = 0; p < 64; ++p) { const float cr = cc[((dir * 16 + c) * 64 + p) * 2], ci = cc[((dir * 16 + c) * 64 + p) * 2 + 1], wr_ = pw[((dir * 64 + p) * 17 + m) * 2], wi_ = pw[((dir * 64 + p) * 17 + m) * 2 + 1];
            const float br = bb[((dir * 64 + p) * 16 + c2) * 2], bi = bb[((dir * 64 + p) * 16 + c2) * 2 + 1]; const float tr = cr * wr_ - ci * wi_, ti = cr * wi_ + ci * wr_; acc += tr * br - ti * bi; }
        kt[i] = acc; }
    __syncthreads();
    bf16_t* wst = (bf16_t*)(P.ws + WS_WST) + ((size_t)l * 16 + g) * 256 * 256;
    bf16_t* wso = (bf16_t*)(P.ws + WS_WSO) + ((size_t)l * 16 + g) * 256 * 512;
    for (int id = tid; id < 8192; id += kNT) { const int n = id >> 5, k0 = (id & 31) * 8, dir = n >> 7, p = (n >> 1) & 63, ri = n & 1; float v[8];
#pragma unroll
        for (int kk = 0; kk < 8; ++kk) { const int k = k0 + kk, t = k >> 4, c = k & 15, e = dir ? t : 15 - t; const float wr_ = pw[((dir * 64 + p) * 17 + e) * 2], wi_ = pw[((dir * 64 + p) * 17 + e) * 2 + 1], br = bb[((dir * 64 + p) * 16 + c) * 2], bi = bb[((dir * 64 + p) * 16 + c) * 2 + 1];
            v[kk] = ri ? (wr_ * bi + wi_ * br) : (wr_ * br - wi_ * bi); }
        u32x4 o; o.x = pk2(v[0], v[1]); o.y = pk2(v[2], v[3]); o.z = pk2(v[4], v[5]); o.w = pk2(v[6], v[7]); *(u32x4*)(wst + (size_t)n * 256 + k0) = o; }
    for (int id = tid; id < 16384; id += kNT) { const int ns = id >> 6, k0 = (id & 63) * 8, n = cmap_pk(ns), t = n >> 4, c = n & 15; float v[8];
#pragma unroll
        for (int kk = 0; kk < 8; ++kk) { const int k = k0 + kk; float x;
            if (k < 256) { const int j = k >> 4, c2 = k & 15; x = 0.f; if (j <= t) x += kt[(t - j) * 256 + c * 16 + c2]; if (j >= t) x += kt[4096 + (j - t) * 256 + c * 16 + c2]; if (j == t && c == c2) x += P.s5_d[l * 256 + g * 16 + c]; }
            else { const int q = k - 256, dir = q >> 7, p = (q >> 1) & 63, ri = q & 1, e = dir ? 16 - t : t + 1; const float cr = cc[((dir * 16 + c) * 64 + p) * 2], ci = cc[((dir * 16 + c) * 64 + p) * 2 + 1], wr_ = pw[((dir * 64 + p) * 17 + e) * 2], wi_ = pw[((dir * 64 + p) * 17 + e) * 2 + 1];
                x = ri ? -(cr * wi_ + ci * wr_) : (cr * wr_ - ci * wi_); }
            v[kk] = x; }
        u32x4 o; o.x = pk2(v[0], v[1]); o.y = pk2(v[2], v[3]); o.z = pk2(v[4], v[5]); o.w = pk2(v[6], v[7]); *(u32x4*)(wso + (size_t)ns * 512 + k0) = o; }
    __syncthreads();
}
DEVI void phase_s5_scan(const Params& P, int l, const float* Z, bf16_t* ux, unsigned char* lds_, int bid, int nblk) {
    const int tid = tidx(), wid = tid >> 6, lane = tid & 63;
    float* E = (float*)lds_;
    for (int item = bid; item < 256; item += nblk) {
        const int dir = item & 1, g = (item >> 1) & 15, b = item >> 5;
        const size_t pb = (((size_t)l * 2 + dir) * 16 + g) * 64 + lane;
        const double dt = (double)__expf(P.s5_log_dt[((size_t)l * 2 + dir) * 16 + g]); const double a = (double)fminf(P.s5_a_re[pb], -1e-4f), w = (double)P.s5_a_im[pb];
        float a16r, a16i, Ar, Ai; cpow_m(a, w, dt, 16, a16r, a16i); cpow_m(a, w, dt, 1024, Ar, Ai);
        const int kk0 = dir ? 511 - 64 * wid : 64 * wid; const long sstep = dir ? -1 : 1;
        const float* zp = Z + ((size_t)g * 4096 + b * 512 + kk0) * 256 + dir * 128 + 2 * lane;
        f32x2 z[64];
#pragma unroll
        for (int i = 0; i < 64; ++i) { z[i] = *(const f32x2*)zp; zp += sstep * 256; }
        float xr = 0.f, xi = 0.f;
#pragma unroll
        for (int i = 0; i < 64; ++i) { const float nr = a16r * xr - a16i * xi + z[i].x, ni = a16r * xi + a16i * xr + z[i].y; xr = nr; xi = ni; }
        __syncthreads();
        E[(wid * 64 + lane) * 2] = xr; E[(wid * 64 + lane) * 2 + 1] = xi;
        __syncthreads();
        float sr = 0.f, si = 0.f;
#pragma unroll
        for (int s2 = 0; s2 < 7; ++s2) if (s2 < wid) { const float er = E[(s2 * 64 + lane) * 2], ei = E[(s2 * 64 + lane) * 2 + 1]; const float nr = Ar * sr - Ai * si + er, ni = Ar * si + Ai * sr + ei; sr = nr; si = ni; }
        bf16_t* up = ux + ((size_t)g * 4096 + b * 512 + kk0) * 512 + 256 + dir * 128 + 2 * lane;
#pragma unroll
        for (int i = 0; i < 64; ++i) { *(unsigned*)up = pk2(sr, si); up += sstep * 512;
            const float nr = a16r * sr - a16i * si + z[i].x, ni = a16r * si + a16i * sr + z[i].y; sr = nr; si = ni; }
    }
    __syncthreads();
}
struct EpiF32N {
    float* z; int ldz;
    DEVI void operator()(const f32x4 (&acc)[2][2][4][2], const Unit& u, int wr, int wc, int fr, int fq) const {
#pragma unroll
        for (int ai = 0; ai < 2; ++ai)
#pragma unroll
            for (int m = 0; m < 4; ++m) { const size_t ro = (size_t)(u.pm * 256 + 128 * ai + 64 * wr + 16 * m + fr) * ldz + u.pn * 256 + 32 * wc + 4 * fq;
#pragma unroll
                for (int bj = 0; bj < 2; ++bj)
#pragma unroll
                    for (int n = 0; n < 2; ++n) *(f32x4*)(z + ro + 128 * bj + 16 * n) = acc[ai][bj][m][n]; }
    }
};
struct EpiS5Out {
    bf16_t* G;
    DEVI void operator()(const f32x4 (&acc)[2][2][4][2], const Unit& u, int wr, int wc, int fr, int fq) const {
#pragma unroll
        for (int ai = 0; ai < 2; ++ai)
#pragma unroll
            for (int m = 0; m < 4; ++m) { const int R = u.pm * 256 + 128 * ai + 64 * wr + 16 * m + fr, g = R >> 12, ck = R & 4095;
#pragma unroll
                for (int bj = 0; bj < 2; ++bj) { const int t = 8 * bj + 2 * wc + (fq >> 1), c0 = 8 * (fq & 1);
                    const f32x4 v0 = acc[ai][bj][m][0], v1 = acc[ai][bj][m][1];
                    u32x4 w; w.x = pk2(gelu_tanh(v0.x), gelu_tanh(v0.y)); w.y = pk2(gelu_tanh(v0.z), gelu_tanh(v0.w)); w.z = pk2(gelu_tanh(v1.x), gelu_tanh(v1.y)); w.w = pk2(gelu_tanh(v1.z), gelu_tanh(v1.w));
                    *(u32x4*)(G + ((size_t)ck * 16 + t) * 256 + g * 16 + c0) = w; } }
    }
};
#define XB_TMO      128
#define XB_XCNT(j)  (256  + 64 * (j))
#define XB_XSUB(j)  (1280 + 64 * (j))
#define XB_XGEN(j)  (2304 + 64 * (j))
#define XB_TOP      3328
#define XB_TOPGEN   3392
#define XCD_BAR_WORDS 3456
#define XB_SPIN_CAP (1u << 26)
DEVI unsigned xb_ld(unsigned* p)              { return __hip_atomic_load(p, __ATOMIC_RELAXED, __HIP_MEMORY_SCOPE_AGENT); }
DEVI unsigned xb_add(unsigned* p, unsigned v) { return __hip_atomic_fetch_add(p, v, __ATOMIC_RELAXED, __HIP_MEMORY_SCOPE_AGENT); }
DEVI unsigned xb_xcc_id() { return (unsigned)__builtin_amdgcn_s_getreg((3 << 11) | 20) & 0xFu; }
#define XB_SPIN(cond, bar) do { unsigned _sp = 0; while (cond) { __builtin_amdgcn_s_sleep(1); \
    if ((++_sp & 255u) == 0u) { if (xb_ld(&(bar)[XB_TMO])) break; if (_sp > XB_SPIN_CAP) { atomicAdd(&(bar)[XB_TMO], 1u); break; } } } } while (0)
struct XcdBarrier { unsigned* bar; unsigned x; volatile LAS unsigned* st; };
DEVI XcdBarrier xcd_barrier_post(unsigned* bar, volatile LAS unsigned* st) {
    XcdBarrier b; b.bar = bar; b.x = xb_xcc_id(); b.st = st;
    if (threadIdx.x == 0) (void)xb_add(&bar[XB_XCNT(b.x)], 1u);
    return b;
}
DEVI void xcd_barrier_complete(unsigned* bar, unsigned x, unsigned& nloc, unsigned& nx) {
    const unsigned G = gridDim.x * gridDim.y * gridDim.z;
    unsigned sum, cnt, mine, sp = 0u;
    for (;;) {
        sum = 0u; cnt = 0u; mine = 0u;
#pragma unroll
        for (unsigned j = 0; j < 16; ++j) { const unsigned c = xb_ld(&bar[XB_XCNT(j)]); sum += c; cnt += (c > 0u) ? 1u : 0u; mine = (j == x) ? c : mine; }
        if (sum == G) break;
        __builtin_amdgcn_s_sleep(1);
        if ((++sp & 255u) == 0u) { if (xb_ld(&bar[XB_TMO])) break; if (sp > XB_SPIN_CAP) { atomicAdd(&bar[XB_TMO], 1u); break; } }
    }
    nloc = mine > 0u ? mine : 1u; nx = cnt > 0u ? cnt : 1u;
}
DEVI void xcd_barrier(const XcdBarrier& b) {
    asm volatile("s_waitcnt vmcnt(0)" ::: "memory");
    __syncthreads();
    if (threadIdx.x == 0) {
        unsigned long long bp_ = (unsigned long long)b.bar; asm volatile("" : "+s"(bp_));
        unsigned* bar = (unsigned*)bp_;
        const unsigned bx = xb_xcc_id();
        __builtin_amdgcn_s_waitcnt(0);
        unsigned nloc = b.st[0], nx = b.st[1];
        if (nloc == 0u) { xcd_barrier_complete(bar, bx, nloc, nx); b.st[0] = nloc; b.st[1] = nx; }
        const unsigned old = xb_add(&bar[XB_XSUB(bx)], 1u);
        const unsigned gen = old / nloc;
        if (old + 1u == (gen + 1u) * nloc) {
            __builtin_amdgcn_fence(__ATOMIC_RELEASE, "agent");
            asm volatile("s_waitcnt vmcnt(0)" ::: "memory");
            const unsigned og = xb_add(&bar[XB_TOP], 1u);
            const unsigned tg = og / nx;
            if (og + 1u == (tg + 1u) * nx) xb_add(&bar[XB_TOPGEN], 1u);
            else XB_SPIN(xb_ld(&bar[XB_TOPGEN]) == tg, bar);
            __builtin_amdgcn_fence(__ATOMIC_ACQUIRE, "agent");
            xb_add(&bar[XB_XGEN(bx)], 1u);
            asm volatile("s_waitcnt vmcnt(0)" ::: "memory");
        } else {
            XB_SPIN(xb_ld(&bar[XB_XGEN(bx)]) == gen, bar);
            __builtin_amdgcn_fence(__ATOMIC_ACQUIRE, "agent");
            asm volatile("s_waitcnt vmcnt(0)" ::: "memory");
        }
    }
    __syncthreads();
}

#ifndef MEGA
#define MEGA 1
#endif
#ifndef USE_ENGINE
#define USE_ENGINE 1
#endif
constexpr int LDS_BYTES = 147456 + 8192 + 16;
#if USE_ENGINE
#define GEMM_RUN(g, E) gemm_engine<decltype(E), true, true>((LAS unsigned char*)dyn_lds, g, E, bid, nblk)
#else
#define GEMM_RUN(g, E) gemm_simple(g, E, bid, nblk)
#endif
extern __shared__ __attribute__((aligned(16))) unsigned char dyn_lds[];

DEVI GemmD mk_gemm(const bf16_t* A, const bf16_t* Bt, int lda, int K, int nM, int nN, const int* rowidx, size_t bstride, int pmg) {
    GemmD g; g.A = A; g.Bt = Bt; g.lda = lda; g.K = K; g.nM = nM; g.nN = nN; g.rowidx = rowidx; g.bstride = bstride; g.pmg = pmg; return g; }

DEVI void ph_win(const Params& P, int l, int bid, int nblk) {
    const GemmD g = mk_gemm((const bf16_t*)(P.ws + WS_H), (const bf16_t*)(P.ws + WS_WINT) + (size_t)l * kINW * kD, kD, kD, kTok / 256, 10, nullptr, 0, 1 << 30);
    unsigned char* r1 = P.ws + WS_R1;
    EpiQKV E; E.qa = (bf16_t*)(r1 + R1_QA); E.ka = (bf16_t*)(r1 + R1_KA); E.va = (bf16_t*)(r1 + R1_VA); E.qb = (bf16_t*)(r1 + R1_QB); E.kb = (bf16_t*)(r1 + R1_KB); E.vb = (bf16_t*)(r1 + R1_VB); E.ux = (bf16_t*)(r1 + R1_UX);
    E.qna = P.q_norm_a + l * 64; E.kna = P.k_norm_a + l * 64; E.qnb = P.q_norm_b + l * 64; E.knb = P.k_norm_b + l * 64;
    GEMM_RUN(g, E);
}
#ifndef USE_MFMA_ATTN
#define USE_MFMA_ATTN 1
#endif
#ifndef USE_S5_GEMM
#define USE_S5_GEMM 1
#endif
DEVI void ph_dilated(const Params& P, int bid, int nblk) { unsigned char* r1 = P.ws + WS_R1;
#if USE_MFMA_ATTN
    phase_dilated((const bf16_t*)(r1 + R1_QA), (const bf16_t*)(r1 + R1_KA), (const bf16_t*)(r1 + R1_VA), (bf16_t*)(P.ws + WS_R2), (float*)(P.ws + WS_LSE), (LAS unsigned char*)dyn_lds, bid, nblk);
#else
    phase_dilated_naive((const bf16_t*)(r1 + R1_QA), (const bf16_t*)(r1 + R1_KA), (const bf16_t*)(r1 + R1_VA), (bf16_t*)(P.ws + WS_R2), (float*)(P.ws + WS_LSE), bid, nblk);
#endif
}
DEVI void ph_na(const Params& P, int l, int bid, int nblk) { unsigned char* r1 = P.ws + WS_R1;
#if USE_MFMA_ATTN
    phase_na((const bf16_t*)(r1 + R1_QB), (const bf16_t*)(r1 + R1_KB), (const bf16_t*)(r1 + R1_VB), P.rpb + (size_t)l * 4 * 15 * 31, (bf16_t*)(r1 + R1_OB), (LAS unsigned char*)dyn_lds, bid, nblk);
#else
    phase_na_naive((const bf16_t*)(r1 + R1_QB), (const bf16_t*)(r1 + R1_KB), (const bf16_t*)(r1 + R1_VB), P.rpb + (size_t)l * 4 * 15 * 31, (bf16_t*)(r1 + R1_OB), bid, nblk);
#endif
}
DEVI void ph_s5(const Params& P, int l, unsigned char* lds, int bid, int nblk) { phase_s5_naive(P, l, (const bf16_t*)(P.ws + WS_R1 + R1_UX), (float*)(P.ws + WS_YS), lds, bid, nblk); }
DEVI void ph_s5_prep(const Params& P, unsigned char* lds, int bid, int nblk) { for (int it = bid; it < kL * 16; it += nblk) s5_prep_item(P, it >> 4, it & 15, lds); }
DEVI void ph_s5_state(const Params& P, int l, int bid, int nblk) {
    const GemmD g = mk_gemm((const bf16_t*)(P.ws + WS_R1 + R1_UX), (const bf16_t*)(P.ws + WS_WST) + (size_t)l * 16 * 256 * 256, 512, 256, 256, 1, nullptr, (size_t)256 * 256, 16);
    EpiF32N E; E.z = (float*)(P.ws + WS_R2 + R2_Z); E.ldz = 256;
    GEMM_RUN(g, E);
}
DEVI void ph_s5_scan(const Params& P, int l, unsigned char* lds, int bid, int nblk) { phase_s5_scan(P, l, (const float*)(P.ws + WS_R2 + R2_Z), (bf16_t*)(P.ws + WS_R1 + R1_UX), lds, bid, nblk); }
DEVI void ph_s5_out(const Params& P, int l, int bid, int nblk) {
    const GemmD g = mk_gemm((const bf16_t*)(P.ws + WS_R1 + R1_UX), (const bf16_t*)(P.ws + WS_WSO) + (size_t)l * 16 * 256 * 512, 512, 512, 256, 1, nullptr, (size_t)256 * 512, 16);
    EpiS5Out E; E.G = (bf16_t*)(P.ws + WS_R1 + R1_G);
    GEMM_RUN(g, E);
}
DEVI void ph_s5fin(const Params& P, int l, int bid, int nblk) { phase_s5_finish((const float*)(P.ws + WS_YS), (const bf16_t*)(P.ws + WS_R1 + R1_UX), P.s5_d + l * 256, (bf16_t*)(P.ws + WS_R1 + R1_G), bid, nblk); }
DEVI void ph_glu(const Params& P, int l, int bid, int nblk) {
    const GemmD g = mk_gemm((const bf16_t*)(P.ws + WS_R1 + R1_G), (const bf16_t*)(P.ws + WS_WGLUT) + (size_t)l * 256 * 256, 256, 256, kTok / 256, 1, nullptr, 0, 1 << 30);
    EpiGlu E; E.g = (const bf16_t*)(P.ws + WS_R1 + R1_G); E.oc = (bf16_t*)(P.ws + WS_R1 + R1_OC);
    GEMM_RUN(g, E);
}
DEVI void ph_mixnorm(const Params& P, int l, int bid, int nblk) { unsigned char* r1 = P.ws + WS_R1;
    phase_mixnorm((const bf16_t*)(P.ws + WS_R2), (const float*)(P.ws + WS_LSE), (const bf16_t*)(r1 + R1_OB), (const bf16_t*)(r1 + R1_OC), P.out_norm_a + l * 512, P.out_norm_b + l * 256, P.out_norm_c + l * 256, (bf16_t*)(P.ws + WS_H), bid, nblk); }
DEVI void ph_wout(const Params& P, int l, int bid, int nblk) {
    const GemmD g = mk_gemm((const bf16_t*)(P.ws + WS_H), (const bf16_t*)(P.ws + WS_WOUTT) + (size_t)l * kD * kD, kD, kD, kTok / 256, 4, nullptr, 0, 1 << 30);
    EpiResid E; E.xin = (l == 0) ? P.x : P.out; E.xout = P.out;
    GEMM_RUN(g, E);
}
DEVI void ph_router(const Params& P, int l, unsigned char* lds, int bid, int nblk) { phase_router(P.out, P.ffn_norm + (size_t)l * kD, P.w_router + (size_t)l * kD * kE, (bf16_t*)(P.ws + WS_H), (float*)(P.ws + WS_AFF), lds, bid, nblk); }
DEVI void ph_topk(const Params& P, unsigned char* lds, int bid, int nblk) { phase_topk((const float*)(P.ws + WS_AFF), (int*)(P.ws + WS_IDX), (float*)(P.ws + WS_GATE), (int*)(P.ws + WS_TSLOT), lds, bid, nblk); }
DEVI void ph_gu(const Params& P, int l, int bid, int nblk) {
    const GemmD g = mk_gemm((const bf16_t*)(P.ws + WS_H), (const bf16_t*)(P.ws + WS_WGUT) + (size_t)l * kE * 4096 * kD, kD, kD, 512, 16, (const int*)(P.ws + WS_IDX), (size_t)4096 * kD, 32);
    EpiGU E; E.hid = (bf16_t*)(P.ws + WS_R1);
    GEMM_RUN(g, E);
}
DEVI void ph_down(const Params& P, int l, int bid, int nblk) {
    const GemmD g = mk_gemm((const bf16_t*)(P.ws + WS_R1), (const bf16_t*)(P.ws + WS_WDT) + (size_t)l * kE * kD * kFF, kFF, kFF, 512, 4, nullptr, (size_t)kD * kFF, 32);
    EpiDown E; E.y = (bf16_t*)(P.ws + WS_R2); E.gate = (const float*)(P.ws + WS_GATE);
    GEMM_RUN(g, E);
}
DEVI void ph_combine(const Params& P, int l, int bid, int nblk) { phase_combine(P.out, (const bf16_t*)(P.ws + WS_R2), (const int*)(P.ws + WS_TSLOT), (l + 1 < kL) ? P.attn_norm + (size_t)(l + 1) * kD : nullptr, (bf16_t*)(P.ws + WS_H), bid, nblk); }

#if MEGA
__global__ void __launch_bounds__(kNT, 2) mega_fwd(Params P) {
    volatile LAS unsigned* st = (volatile LAS unsigned*)(dyn_lds + LDS_BYTES - 16);
    if (threadIdx.x == 0) { st[0] = 0u; st[1] = 0u; st[2] = 0u; st[3] = 0u; }
    __syncthreads();
    const XcdBarrier bar = xcd_barrier_post((unsigned*)(P.ws + WS_CTL), st);
    const int bid = blockIdx.x, nblk = gridDim.x;
    unsigned char* lds = dyn_lds;
    phase_convert(P, lds, lnd(bid), nblk);
#if USE_S5_GEMM
    ph_s5_prep(P, lds, lnd(bid), nblk);
#endif
    phase_norm(P.x, P.attn_norm, (bf16_t*)(P.ws + WS_H), lnd(bid), nblk);
    xcd_barrier(bar);
#pragma unroll 1
    for (int l = 0; l < kL; ++l) {
        ph_win(P, l, lnd(bid), nblk);            xcd_barrier(bar);
#if USE_S5_GEMM
        ph_s5_state(P, l, lnd(bid), nblk);       xcd_barrier(bar);
        ph_s5_scan(P, l, lds, lnd(bid), nblk);
        ph_dilated(P, lnd(bid), nblk);
        ph_na(P, l, lnd(bid), nblk);             xcd_barrier(bar);
        ph_s5_out(P, l, lnd(bid), nblk);         xcd_barrier(bar);
#else
        ph_s5(P, l, lds, lnd(bid), nblk);
        ph_dilated(P, lnd(bid), nblk);
        ph_na(P, l, lnd(bid), nblk);             xcd_barrier(bar);
        ph_s5fin(P, l, lnd(bid), nblk);          xcd_barrier(bar);
#endif
        ph_glu(P, l, lnd(bid), nblk);            xcd_barrier(bar);
        ph_mixnorm(P, l, lnd(bid), nblk);        xcd_barrier(bar);
        ph_wout(P, l, lnd(bid), nblk);           xcd_barrier(bar);
        ph_router(P, l, lds, lnd(bid), nblk);    xcd_barrier(bar);
        ph_topk(P, lds, lnd(bid), nblk);         xcd_barrier(bar);
        ph_gu(P, l, lnd(bid), nblk);             xcd_barrier(bar);
        ph_down(P, l, lnd(bid), nblk);           xcd_barrier(bar);
        ph_combine(P, l, lnd(bid), nblk);        xcd_barrier(bar);
    }
}
#else
#define KB __global__ void __launch_bounds__(kNT, 2)
KB k_convert(Params P) { phase_convert(P, dyn_lds, blockIdx.x, gridDim.x); }
KB k_norm(Params P) { phase_norm(P.x, P.attn_norm, (bf16_t*)(P.ws + WS_H), blockIdx.x, gridDim.x); }
KB k_win(Params P, int l) { ph_win(P, l, blockIdx.x, gridDim.x); }
KB k_dilated(Params P) { ph_dilated(P, blockIdx.x, gridDim.x); }
KB k_na(Params P, int l) { ph_na(P, l, blockIdx.x, gridDim.x); }
KB k_s5(Params P, int l) { ph_s5(P, l, dyn_lds, blockIdx.x, gridDim.x); }
KB k_s5fin(Params P, int l) { ph_s5fin(P, l, blockIdx.x, gridDim.x); }
KB k_glu(Params P, int l) { ph_glu(P, l, blockIdx.x, gridDim.x); }
KB k_mixnorm(Params P, int l) { ph_mixnorm(P, l, blockIdx.x, gridDim.x); }
KB k_wout(Params P, int l) { ph_wout(P, l, blockIdx.x, gridDim.x); }
KB k_router(Params P, int l) { ph_router(P, l, dyn_lds, blockIdx.x, gridDim.x); }
KB k_topk(Params P) { ph_topk(P, dyn_lds, blockIdx.x, gridDim.x); }
KB k_gu(Params P, int l) { ph_gu(P, l, blockIdx.x, gridDim.x); }
KB k_down(Params P, int l) { ph_down(P, l, blockIdx.x, gridDim.x); }
KB k_combine(Params P, int l) { ph_combine(P, l, blockIdx.x, gridDim.x); }
#endif

extern "C" void kernel_launch(void* const* d_in, const int* in_sizes, int n_in, void* d_out, int out_size, void* d_ws, size_t ws_size, hipStream_t stream) {
    (void)in_sizes; (void)n_in; (void)out_size;
    if (ws_size < WS_END) { fprintf(stderr, "workspace too small: %zu < %zu\n", ws_size, (size_t)WS_END); return; }
    Params P{};
    const float** pp = (const float**)&P;
    for (int i = 0; i < 26; ++i) pp[i] = (const float*)d_in[i];
    P.out = (float*)d_out; P.ws = (unsigned char*)d_ws;
#if MEGA
    static int grid = 0;
    if (!grid) {
        int dev = 0, cus = 0, per_cu = 0;
        (void)hipGetDevice(&dev);
        (void)hipDeviceGetAttribute(&cus, hipDeviceAttributeMultiprocessorCount, dev);
        (void)hipFuncSetAttribute((const void*)mega_fwd, hipFuncAttributeMaxDynamicSharedMemorySize, LDS_BYTES);
        (void)hipOccupancyMaxActiveBlocksPerMultiprocessor(&per_cu, (const void*)mega_fwd, kNT, LDS_BYTES);
        grid = (per_cu >= 1) ? cus : 0;
        if (!grid) fprintf(stderr, "mega_fwd does not fit a CU\n");
    }
    if (!grid) return;
    (void)hipMemsetAsync(P.ws + WS_CTL, 0, XCD_BAR_WORDS * sizeof(unsigned), stream);
    mega_fwd<<<grid, kNT, LDS_BYTES, stream>>>(P);
#else
    (void)hipFuncSetAttribute((const void*)k_router, hipFuncAttributeMaxDynamicSharedMemorySize, 65536);
    const int G = 1024;
    k_convert<<<G, kNT, 256 * 72 * 2, stream>>>(P);
    k_norm<<<G, kNT, 0, stream>>>(P);
    for (int l = 0; l < kL; ++l) {
        k_win<<<G, kNT, 0, stream>>>(P, l);
        k_dilated<<<G, kNT, 0, stream>>>(P);
        k_na<<<G, kNT, 0, stream>>>(P, l);
        k_s5<<<256, kNT, 8 * 128 * 4, stream>>>(P, l);
        k_s5fin<<<G, kNT, 0, stream>>>(P, l);
        k_glu<<<256, kNT, 0, stream>>>(P, l);
        k_mixnorm<<<G, kNT, 0, stream>>>(P, l);
        k_wout<<<G, kNT, 0, stream>>>(P, l);
        k_router<<<512, kNT, 65536, stream>>>(P, l);
        k_topk<<<128, kNT, 4096, stream>>>(P);
        k_gu<<<G, kNT, 0, stream>>>(P, l);
        k_down<<<G, kNT, 0, stream>>>(P, l);
        k_combine<<<G, kNT, 0, stream>>>(P, l);
    }
#endif
}
```

```cpp
#include <hip/hip_runtime.h>
#include <stdint.h>
#include <stdio.h>

#define DEVI __device__ __forceinline__
#define LAS __attribute__((address_space(3)))
typedef unsigned short bf16_t;
typedef short bf16x8 __attribute__((ext_vector_type(8)));
typedef float f32x4 __attribute__((ext_vector_type(4)));
typedef float f32x2 __attribute__((ext_vector_type(2)));
typedef unsigned u32x4 __attribute__((ext_vector_type(4)));
typedef unsigned u32x2 __attribute__((ext_vector_type(2)));

constexpr int kB = 8, kS = 8192, kD = 1024, kL = 4, kTok = kB * kS;
constexpr int kINW = 2560;
constexpr int kE = 16, kCap = 1024, kFF = 2048;
constexpr int kNT = 512;
constexpr float kEps = 1e-6f;

constexpr size_t MiB = 1024ull * 1024ull;
constexpr size_t WS_CTL   = 0;
constexpr size_t WS_WINT  = 1 * MiB;
constexpr size_t WS_WOUTT = WS_WINT + 20 * MiB;
constexpr size_t WS_WGLUT = WS_WOUTT + 8 * MiB;
constexpr size_t WS_WGUT  = WS_WGLUT + 1 * MiB;
constexpr size_t WS_WDT   = WS_WGUT + 512 * MiB;
constexpr size_t WS_H     = WS_WDT + 256 * MiB;
constexpr size_t WS_R1    = WS_H + 128 * MiB;
constexpr size_t WS_R2    = WS_R1 + 512 * MiB;
constexpr size_t WS_AFF   = WS_R2 + 256 * MiB;
constexpr size_t WS_IDX   = WS_AFF + 4 * MiB;
constexpr size_t WS_GATE  = WS_IDX + 1 * MiB;
constexpr size_t WS_TSLOT = WS_GATE + 1 * MiB;
constexpr size_t WS_LSE   = WS_TSLOT + 4 * MiB;
constexpr size_t WS_WST   = WS_LSE + 8 * MiB;
constexpr size_t WS_WSO   = WS_WST + 8 * MiB;
constexpr size_t WS_YS    = WS_WSO + 16 * MiB;
constexpr size_t WS_END   = WS_YS + 128 * MiB;
constexpr size_t R2_Z     = 192 * MiB;
constexpr size_t R1_QA = 0, R1_KA = 64 * MiB, R1_VA = 128 * MiB, R1_QB = 192 * MiB, R1_KB = 224 * MiB, R1_VB = 256 * MiB,
                 R1_UX = 288 * MiB, R1_OB = 352 * MiB, R1_OC = 384 * MiB, R1_G = 416 * MiB;

struct Params {
    const float* x; const float* attn_norm; const float* w_in; const float* q_norm_a; const float* k_norm_a; const float* q_norm_b; const float* k_norm_b;
    const float* rpb; const float* s5_a_re; const float* s5_a_im; const float* s5_log_dt; const float* s5_b_re; const float* s5_b_im; const float* s5_c_re; const float* s5_c_im;
    const float* s5_d; const float* w_glu; const float* out_norm_a; const float* out_norm_b; const float* out_norm_c; const float* w_out; const float* ffn_norm;
    const float* w_router; const float* w_gate; const float* w_up; const float* w_down;
    float* out; unsigned char* ws;
};

DEVI float bf2f(bf16_t b) { return __uint_as_float(((unsigned)b) << 16); }
DEVI bf16_t f2bf(float f) { unsigned u = __float_as_uint(f); u += 0x7FFFu + ((u >> 16) & 1u); return (bf16_t)(u >> 16); }
typedef __bf16 bf16x2_t __attribute__((ext_vector_type(2)));
DEVI unsigned pk2(float lo, float hi) { const f32x2 v = {lo, hi}; return __builtin_bit_cast(unsigned, __builtin_convertvector(v, bf16x2_t)); }
DEVI int tidx() { int t = threadIdx.x; asm volatile("" : "+v"(t)); return t; }
DEVI int lnd(int v) { asm volatile("" : "+s"(v)); return v; }
DEVI float wave_sum(float v) {
#pragma unroll
    for (int m = 32; m >= 1; m >>= 1) v += __shfl_xor(v, m);
    return v;
}
DEVI float frcp(float x) { return __builtin_amdgcn_rcpf(x); }
DEVI float gelu_tanh(float y) { const float z = 0.7978845608028654f * (y + 0.044715f * y * y * y); const float t = 1.f - 2.f * frcp(1.f + __expf(2.f * z)); return 0.5f * y * (1.f + t); }

DEVI int cmap_head(int cs) { const int bj = cs >> 7, wc = (cs >> 5) & 3, n = (cs >> 4) & 1, fq = (cs >> 2) & 3, j = cs & 3; return 64 * wc + 32 * bj + 8 * fq + 4 * n + j; }
DEVI int cmap_pk(int cs)   { const int bj = cs >> 7, wc = (cs >> 5) & 3, n = (cs >> 4) & 1, fq = (cs >> 2) & 3, j = cs & 3; return 128 * bj + 32 * wc + 8 * fq + 4 * n + j; }
DEVI int cmap_gu(int cs)   { const int wc = (cs >> 5) & 3, n = (cs >> 4) & 1, fq = (cs >> 2) & 3, j = cs & 3; return 32 * wc + 8 * fq + 4 * n + j; }

template <int MODE>
DEVI void convert_item(const float* W0, const float* W1, int ldw, int K, bf16_t* Bt, int kt, int pn, unsigned char* lds) {
    bf16_t* t = (bf16_t*)lds;
    const int tid = tidx();
#pragma unroll 4
    for (int it = 0; it < 32; ++it) {
        const int e = it * kNT + tid, k = e >> 8, cs = e & 255;
        float v;
        if (MODE == 0) v = W0[(size_t)(kt * 64 + k) * ldw + pn * 256 + cs];
        else if (MODE == 1) v = W0[(size_t)(kt * 64 + k) * ldw + pn * 256 + cmap_head(cs)];
        else if (MODE == 2) v = W0[(size_t)(kt * 64 + k) * ldw + pn * 256 + cmap_pk(cs)];
        else v = ((cs >> 7) ? W1 : W0)[(size_t)(kt * 64 + k) * ldw + pn * 128 + cmap_gu(cs)];
        t[cs * 72 + k] = f2bf(v);
    }
    __syncthreads();
#pragma unroll
    for (int it = 0; it < 4; ++it) {
        const int c = it * kNT + tid, row = c >> 3, part = c & 7;
        const u32x4 v = *(const u32x4*)(t + row * 72 + part * 8);
        *(u32x4*)(Bt + (size_t)(pn * 256 + row) * K + kt * 64 + part * 8) = v;
    }
    __syncthreads();
}

DEVI void phase_convert(const Params& P, unsigned char* lds, int bid, int nblk) {
    constexpr int N_WIN = kL * 16 * 10, N_WOUT = kL * 16 * 4, N_WGLU = kL * 4 * 1, N_WGU = kL * kE * 16 * 16, N_WD = kL * kE * 32 * 4;
    constexpr int TOT = N_WIN + N_WOUT + N_WGLU + N_WGU + N_WD;
    for (int it = bid; it < TOT; it += nblk) {
        int i = it;
        if (i < N_WIN) { const int l = i / 160, r = i % 160, kt = r / 10, pn = r % 10;
            convert_item<1>(P.w_in + (size_t)l * kD * kINW, nullptr, kINW, kD, (bf16_t*)(P.ws + WS_WINT) + (size_t)l * kINW * kD, kt, pn, lds); continue; }
        i -= N_WIN;
        if (i < N_WOUT) { const int l = i / 64, r = i % 64, kt = r / 4, pn = r % 4;
            convert_item<0>(P.w_out + (size_t)l * kD * kD, nullptr, kD, kD, (bf16_t*)(P.ws + WS_WOUTT) + (size_t)l * kD * kD, kt, pn, lds); continue; }
        i -= N_WOUT;
        if (i < N_WGLU) { const int l = i / 4, kt = i % 4;
            convert_item<2>(P.w_glu + (size_t)l * 256 * 256, nullptr, 256, 256, (bf16_t*)(P.ws + WS_WGLUT) + (size_t)l * 256 * 256, kt, 0, lds); continue; }
        i -= N_WGLU;
        if (i < N_WGU) { const int le = i / 256, r = i % 256, kt = r / 16, pn = r % 16;
            convert_item<3>(P.w_gate + (size_t)le * kD * kFF, P.w_up + (size_t)le * kD * kFF, kFF, kD, (bf16_t*)(P.ws + WS_WGUT) + (size_t)le * 4096 * kD, kt, pn, lds); continue; }
        i -= N_WGU;
        { const int le = i / 128, r = i % 128, kt = r / 4, pn = r % 4;
            convert_item<2>(P.w_down + (size_t)le * kFF * kD, nullptr, kD, kFF, (bf16_t*)(P.ws + WS_WDT) + (size_t)le * kD * kFF, kt, pn, lds); }
    }
}

DEVI void phase_norm(const float* x, const float* gain, bf16_t* h, int bid, int nblk) {
    const int wid = tidx() >> 6, lane = tidx() & 63;
    f32x4 g[4];
#pragma unroll
    for (int q = 0; q < 4; ++q) g[q] = *(const f32x4*)(gain + q * 256 + lane * 4);
    for (int row = bid * 8 + wid; row < kTok; row += nblk * 8) {
        f32x4 v[4]; float ss = 0.f;
#pragma unroll
        for (int q = 0; q < 4; ++q) { v[q] = *(const f32x4*)(x + (size_t)row * kD + q * 256 + lane * 4); ss += v[q].x * v[q].x + v[q].y * v[q].y + v[q].z * v[q].z + v[q].w * v[q].w; }
        ss = wave_sum(ss);
        const float rstd = rsqrtf(ss * (1.f / kD) + kEps);
#pragma unroll
        for (int q = 0; q < 4; ++q) { u32x2 o; o.x = pk2(v[q].x * rstd * g[q].x, v[q].y * rstd * g[q].y); o.y = pk2(v[q].z * rstd * g[q].z, v[q].w * rstd * g[q].w);
            *(u32x2*)(h + (size_t)row * kD + q * 256 + lane * 4) = o; }
    }
}

DEVI void phase_router(const float* x, const float* gain, const float* wr  , bf16_t* h, float* aff, unsigned char* lds, int bid, int nblk) {
    float* wT = (float*)lds;
    for (int i = tidx(); i < 16 * 1024; i += kNT) { const int k = i >> 4, e = i & 15; wT[e * 1024 + k] = wr[i]; }
    __syncthreads();
    const int wid = tidx() >> 6, lane = tidx() & 63;
    f32x4 g[4];
#pragma unroll
    for (int q = 0; q < 4; ++q) g[q] = *(const f32x4*)(gain + q * 256 + lane * 4);
    for (int row0 = (bid * 8 + wid) * 2; row0 < kTok; row0 += nblk * 8 * 2) {
        asm volatile("" ::: "memory");
        f32x4 v[2][4];
#pragma unroll
        for (int r = 0; r < 2; ++r) { float ss = 0.f;
#pragma unroll
            for (int q = 0; q < 4; ++q) { v[r][q] = *(const f32x4*)(x + (size_t)(row0 + r) * kD + q * 256 + lane * 4); ss += v[r][q].x * v[r][q].x + v[r][q].y * v[r][q].y + v[r][q].z * v[r][q].z + v[r][q].w * v[r][q].w; }
            ss = wave_sum(ss); const float rstd = rsqrtf(ss * (1.f / kD) + kEps);
#pragma unroll
            for (int q = 0; q < 4; ++q) { v[r][q] = v[r][q] * rstd * g[q];
                u32x2 o; o.x = pk2(v[r][q].x, v[r][q].y); o.y = pk2(v[r][q].z, v[r][q].w);
                *(u32x2*)(h + (size_t)(row0 + r) * kD + q * 256 + lane * 4) = o; }
        }
        float pa[32];
#pragma unroll
        for (int e = 0; e < 16; ++e) {
            float s0 = 0.f, s1 = 0.f;
#pragma unroll
            for (int q = 0; q < 4; ++q) { const f32x4 w = *(const f32x4*)(wT + e * 1024 + q * 256 + lane * 4);
                s0 += v[0][q].x * w.x + v[0][q].y * w.y + v[0][q].z * w.z + v[0][q].w * w.w;
                s1 += v[1][q].x * w.x + v[1][q].y * w.y + v[1][q].z * w.z + v[1][q].w * w.w; }
            pa[e] = s0; pa[16 + e] = s1;
        }
#define RS_STEP(HALF, MASK) { const bool up = (lane & (MASK)) != 0; _Pragma("unroll") for (int i = 0; i < (HALF); ++i) { const float keep = up ? pa[i + (HALF)] : pa[i], send = up ? pa[i] : pa[i + (HALF)]; pa[i] = keep + __shfl_xor(send, (MASK)); } }
        RS_STEP(16, 32) RS_STEP(8, 16) RS_STEP(4, 8) RS_STEP(2, 4) RS_STEP(1, 2)
#undef RS_STEP
        const float logit = pa[0] + __shfl_xor(pa[0], 1);
        float mx = logit;
#pragma unroll
        for (int m = 16; m >= 2; m >>= 1) mx = fmaxf(mx, __shfl_xor(mx, m));
        const float ex = __expf(logit - mx);
        float sm = ex;
#pragma unroll
        for (int m = 16; m >= 2; m >>= 1) sm += __shfl_xor(sm, m);
        const int row = row0 + (lane >> 5), e = (lane >> 1) & 15, b = row >> 13, s = row & (kS - 1);
        if (!(lane & 1)) aff[((size_t)(b * kE + e)) * kS + s] = ex / sm;
    }
    __syncthreads();
}

DEVI int block_excl_scan(int v, int* sh  , int& total) {
    const int lane = tidx() & 63, wid = tidx() >> 6;
    int incl = v;
#pragma unroll
    for (int d = 1; d < 64; d <<= 1) { const int o = __shfl_up(incl, d); if (lane >= d) incl += o; }
    __syncthreads();
    if (lane == 63) sh[wid] = incl;
    __syncthreads();
    int base = 0, tot = 0;
#pragma unroll
    for (int w = 0; w < 8; ++w) { const int c = sh[w]; if (w < wid) base += c; tot += c; }
    total = tot;
    return base + incl - v;
}

DEVI void phase_topk(const float* aff, int* idx, float* gate, int* tokslot, unsigned char* lds, int bid, int nblk) {
    int* hist = (int*)lds;
    int* sh = hist + 256;
    int* res = sh + 16;
    const int tid = tidx(), lane = tid & 63, wid = tid >> 6;
    for (int item = bid; item < kB * kE; item += nblk) {
        const int b = item >> 4, e = item & 15;
        const float* a = aff + (size_t)item * kS;
        unsigned key[16];
#pragma unroll
        for (int q = 0; q < 4; ++q) { const u32x4 v = *(const u32x4*)(a + tid * 16 + q * 4); key[q * 4 + 0] = v.x; key[q * 4 + 1] = v.y; key[q * 4 + 2] = v.z; key[q * 4 + 3] = v.w; }
        unsigned prefix = 0; int kk = kCap;
#pragma unroll 1
        for (int pass = 0; pass < 4; ++pass) {
            const int shift = 24 - 8 * pass;
            __syncthreads();
            if (tid < 256) hist[tid] = 0;
            __syncthreads();
#pragma unroll
            for (int i = 0; i < 16; ++i) { const bool in = (pass == 0) || ((key[i] >> (shift + 8)) == prefix); if (in) atomicAdd(&hist[(key[i] >> shift) & 255], 1); }
            __syncthreads();
            if (wid == 0) {
                int c[4], loc = 0;
#pragma unroll
                for (int j = 0; j < 4; ++j) { c[j] = hist[255 - 4 * lane - j]; loc += c[j]; }
                int incl = loc;
#pragma unroll
                for (int d = 1; d < 64; d <<= 1) { const int o = __shfl_up(incl, d); if (lane >= d) incl += o; }
                const int excl = incl - loc;
                if (excl < kk && kk <= incl) { int run = excl; int bin = 0, nk = 0; bool found = false;
#pragma unroll
                    for (int j = 0; j < 4; ++j) { if (!found && run + c[j] >= kk) { bin = 255 - 4 * lane - j; nk = kk - run; found = true; } if (!found) run += c[j]; }
                    res[0] = bin; res[1] = nk; }
            }
            __syncthreads();
            prefix = (prefix << 8) | (unsigned)res[0]; kk = res[1];
        }
        const unsigned T = prefix;
        int ceq = 0;
#pragma unroll
        for (int i = 0; i < 16; ++i) ceq += (key[i] == T) ? 1 : 0;
        int tot;
        int eqb = block_excl_scan(ceq, sh, tot);
        int csel = 0; unsigned selmask = 0;
#pragma unroll
        for (int i = 0; i < 16; ++i) { bool s = key[i] > T; if (key[i] == T) { s = eqb < kk; ++eqb; } if (s) { selmask |= 1u << i; ++csel; } }
        int slot = block_excl_scan(csel, sh, tot);
        const size_t rbase = (size_t)(e * kB + b) * kCap;
#pragma unroll
        for (int i = 0; i < 16; ++i) { const int s = tid * 16 + i; const bool sel = (selmask >> i) & 1u;
            if (sel) { idx[rbase + slot] = b * kS + s; gate[rbase + slot] = __uint_as_float(key[i]); }
            tokslot[((size_t)(b * kS + s)) * kE + e] = sel ? slot : -1;
            if (sel) ++slot; }
    }
    __syncthreads();
}

struct Unit { int pm, pn; };
DEVI bool unit_of(int Lid, int nM, int nN, Unit& u) {
    const int nwg = nM * nN; if (Lid >= nwg) return false;
    int wgid = Lid; { const int q = nwg / 8, r = nwg % 8, xcd = wgid % 8, off = wgid / 8; wgid = (xcd < r ? xcd * (q + 1) : r * (q + 1) + (xcd - r) * q) + off; }
    const int nig = 8 * nN, gid = wgid / nig, fm = gid * 8, gsz = (nM - fm) < 8 ? (nM - fm) : 8;
    u.pm = fm + ((wgid % nig) % gsz); u.pn = (wgid % nig) / gsz; return true;
}
struct GemmD { const bf16_t* A; const bf16_t* Bt; int lda, K, nM, nN; const int* rowidx; size_t bstride; int pmg; };

template <class Epi>
DEVI void gemm_simple(const GemmD g, const Epi& E, int bid, int nblk) {
    const int tid = tidx(), wid = tid >> 6, lane = tid & 63, wr = wid >> 2, wc = wid & 3, fr = lane & 15, fq = lane >> 4;
    for (int i = 0;; ++i) {
        Unit u; if (!unit_of(i * nblk + bid, g.nM, g.nN, u)) break;
        f32x4 acc[2][2][4][2];
#pragma unroll
        for (int a = 0; a < 2; ++a)
#pragma unroll
            for (int b = 0; b < 2; ++b)
#pragma unroll
                for (int m = 0; m < 4; ++m)
#pragma unroll
                    for (int n = 0; n < 2; ++n) acc[a][b][m][n] = (f32x4){0.f, 0.f, 0.f, 0.f};
        const bf16_t* Bu = g.Bt + (size_t)(u.pm / g.pmg) * g.bstride + (size_t)u.pn * 256 * g.K;
        unsigned ao[2][4], bo[2][2];
#pragma unroll
        for (int a = 0; a < 2; ++a)
#pragma unroll
            for (int m = 0; m < 4; ++m) { const int r = u.pm * 256 + 128 * a + 64 * wr + 16 * m + fr; const unsigned rr = g.rowidx ? (unsigned)g.rowidx[r] : (unsigned)r; ao[a][m] = rr * (unsigned)g.lda + 8u * fq; }
#pragma unroll
        for (int b = 0; b < 2; ++b)
#pragma unroll
            for (int n = 0; n < 2; ++n) bo[b][n] = (unsigned)(128 * b + 32 * wc + 16 * n + fr) * (unsigned)g.K + 8u * fq;
#pragma unroll 1
        for (int k0 = 0; k0 < g.K; k0 += 32) {
            bf16x8 av[2][4], bv[2][2];
#pragma unroll
            for (int a = 0; a < 2; ++a)
#pragma unroll
                for (int m = 0; m < 4; ++m) av[a][m] = *(const bf16x8*)(g.A + ao[a][m] + k0);
#pragma unroll
            for (int b = 0; b < 2; ++b)
#pragma unroll
                for (int n = 0; n < 2; ++n) bv[b][n] = *(const bf16x8*)(Bu + bo[b][n] + k0);
#pragma unroll
            for (int a = 0; a < 2; ++a)
#pragma unroll
                for (int b = 0; b < 2; ++b)
#pragma unroll
                    for (int m = 0; m < 4; ++m)
#pragma unroll
                        for (int n = 0; n < 2; ++n) acc[a][b][m][n] = __builtin_amdgcn_mfma_f32_16x16x32_bf16(bv[b][n], av[a][m], acc[a][b][m][n], 0, 0, 0);
        }
        E(acc, u, wr, wc, fr, fq);
    }
}


constexpr int PG_HTB = 128 * 64 * 2;
DEVI int pg_lds_byte(int r, int c) { const int st = (r >> 4) * 2 + (c >> 5), rr = r & 15, cc = c & 31, ob = rr * 64 + cc * 2; return st * 1024 + (ob ^ (((ob >> 9) & 1) << 5)); }
DEVI void pg_stage_rc(int b, int& R, int& C) { const int st = b / 1024, sb = b % 1024, swz = sb ^ (((sb >> 9) & 1) << 5); R = (st >> 1) * 16 + swz / 64; C = (st & 1) * 32 + (swz % 64) / 2; }

template <class Epi, bool ALIGN_EPI, bool SP2>
DEVI void gemm_engine(LAS unsigned char* lds, const GemmD g, const Epi& E, int bid, int nblk) {
    const int tid = tidx(), wid = __builtin_amdgcn_readfirstlane(tid >> 6), lane = tid & 63, wr = wid >> 2, wc = wid & 3, fr = lane & 15, fq = lane >> 4;
    const int K = g.K, nt = K / 64;
    int RA[2], CA[2]; unsigned voffB[2];
#pragma unroll
    for (int i = 0; i < 2; ++i) { pg_stage_rc(tid * 16 + i * 8192, RA[i], CA[i]); voffB[i] = (unsigned)(RA[i] * K + CA[i]) * 2u; }
    const size_t kstep = 128;
    const size_t hstepB = (size_t)128 * K * 2;
    const unsigned ldsw = (unsigned)wid * 1024u;
    const int aoff = pg_lds_byte(wr * 64 + fr, fq * 8), boff = pg_lds_byte(wc * 32 + fr, fq * 8);
#define PG8_SA(b, h) (((b) * 2 + (h)) * PG_HTB)
#define PG8_SB(b, h) ((4 + (b) * 2 + (h)) * PG_HTB)
#define PG8_STAGE(bufoff, gbase, voff) do { _Pragma("unroll") for (int _i = 0; _i < 2; ++_i) \
        __builtin_amdgcn_global_load_lds((const unsigned*)((const char*)(gbase) + (voff)[_i]), (LAS unsigned*)(lds + (bufoff) + ldsw + _i * 8192), 16, 0, 0); } while (0)
#define PG8_LDA(dst, b, h) do { _Pragma("unroll") for (int m = 0; m < 4; ++m) _Pragma("unroll") for (int k = 0; k < 2; ++k) dst[m][k] = *(const LAS bf16x8*)(lds + PG8_SA(b, h) + aoff + m * 2048 + k * 1024); } while (0)
#define PG8_LDB(dst, b, h) do { _Pragma("unroll") for (int n = 0; n < 2; ++n) _Pragma("unroll") for (int k = 0; k < 2; ++k) dst[n][k] = *(const LAS bf16x8*)(lds + PG8_SB(b, h) + boff + n * 2048 + k * 1024); } while (0)
#define PG8_MMA(ai, bj, At, Bt) do { __builtin_amdgcn_s_setprio(1); _Pragma("unroll") for (int m = 0; m < 4; ++m) _Pragma("unroll") for (int n = 0; n < 2; ++n) _Pragma("unroll") for (int k = 0; k < 2; ++k) \
        acc[ai][bj][m][n] = __builtin_amdgcn_mfma_f32_16x16x32_bf16(Bt[n][k], At[m][k], acc[ai][bj][m][n], 0, 0, 0); __builtin_amdgcn_s_setprio(0); } while (0)
#define PG8_WAIT_V(n) asm volatile("s_waitcnt vmcnt(" #n ")" ::: "memory")
#define PG8_WAIT_L(n) asm volatile("s_waitcnt lgkmcnt(" #n ")" ::: "memory")
#define PG8_BAR __builtin_amdgcn_s_barrier()
#define PG8_SCHED __builtin_amdgcn_sched_barrier(0)
#define PG8_VOFFA(dst, pm_) do { _Pragma("unroll") for (int _h = 0; _h < 2; ++_h) _Pragma("unroll") for (int _i = 0; _i < 2; ++_i) { const int _r = (pm_) * 256 + 128 * _h + RA[_i]; \
        const unsigned _rr = g.rowidx ? (unsigned)g.rowidx[_r] : (unsigned)_r; dst[_h][_i] = (_rr * (unsigned)g.lda + (unsigned)CA[_i]) * 2u; } } while (0)
    Unit cur, nxt, nn; int ui = 0;
    if (!unit_of(bid, g.nM, g.nN, cur)) return;
    f32x4 acc[2][2][4][2];
#pragma unroll
    for (int a = 0; a < 2; ++a)
#pragma unroll
        for (int b = 0; b < 2; ++b)
#pragma unroll
            for (int m = 0; m < 4; ++m)
#pragma unroll
                for (int n = 0; n < 2; ++n) acc[a][b][m][n] = (f32x4){0.f, 0.f, 0.f, 0.f};
    bf16x8 At[4][2], B0[2][2], B1[2][2];
    const char* const A0 = (const char*)g.A;
    const char* cB = (const char*)(g.Bt + (size_t)(cur.pm / g.pmg) * g.bstride + (size_t)cur.pn * 256 * K);
    unsigned cvA[2][2], nvA[2][2];
    PG8_VOFFA(cvA, cur.pm);
    { const bool hn = unit_of(nblk + bid, g.nM, g.nN, nxt); if (hn) PG8_VOFFA(nvA, nxt.pm); else { _Pragma("unroll") for (int h = 0; h < 2; ++h) _Pragma("unroll") for (int i = 0; i < 2; ++i) nvA[h][i] = cvA[h][i]; } }
    if constexpr (SP2) {
        PG8_STAGE(PG8_SB(0, 0), cB, voffB); PG8_STAGE(PG8_SB(0, 1), cB + hstepB, voffB); PG8_STAGE(PG8_SA(0, 0), A0, cvA[0]); PG8_STAGE(PG8_SA(0, 1), A0, cvA[1]);
        if (wr == 1) PG8_BAR;
        PG8_WAIT_V(2); PG8_BAR;
        PG8_STAGE(PG8_SB(1, 0), cB + kstep, voffB); PG8_STAGE(PG8_SA(1, 0), A0 + kstep, cvA[0]); PG8_STAGE(PG8_SB(1, 1), cB + hstepB + kstep, voffB);
        PG8_WAIT_V(6); PG8_BAR;
    } else {
        PG8_STAGE(PG8_SB(0, 0), cB, voffB); PG8_STAGE(PG8_SA(0, 0), A0, cvA[0]); PG8_STAGE(PG8_SB(0, 1), cB + hstepB, voffB); PG8_STAGE(PG8_SA(0, 1), A0, cvA[1]);
        if (wr == 1) PG8_BAR;
        PG8_WAIT_V(4); PG8_BAR;
        PG8_STAGE(PG8_SB(1, 0), cB + kstep, voffB); PG8_STAGE(PG8_SA(1, 0), A0 + kstep, cvA[0]); PG8_STAGE(PG8_SB(1, 1), cB + hstepB + kstep, voffB);
        PG8_WAIT_V(6); PG8_BAR;
    }
    for (;;) {
        const bool has_next = unit_of((ui + 1) * nblk + bid, g.nM, g.nN, nxt);
        const char* nB = has_next ? (const char*)(g.Bt + (size_t)(nxt.pm / g.pmg) * g.bstride + (size_t)nxt.pn * 256 * K) : cB;
        for (int t = 0; t < nt; t += 2) {
            const bool last = (t == nt - 2);
            const char* a1 = A0 + (size_t)(t + 1) * kstep;
            const char* a2 = last ? A0 : A0 + (size_t)(t + 2) * kstep; const char* b2 = last ? nB : cB + (size_t)(t + 2) * kstep;
            const char* a3 = a2 + kstep; const char* b3 = b2 + kstep;
            unsigned v2[2][2];
#pragma unroll
            for (int h = 0; h < 2; ++h)
#pragma unroll
                for (int i = 0; i < 2; ++i) v2[h][i] = last ? nvA[h][i] : cvA[h][i];
            if constexpr (SP2) {
            PG8_LDB(B0, 0, 0); PG8_LDB(B1, 0, 1); PG8_SCHED; PG8_LDA(At, 0, 0); PG8_STAGE(PG8_SA(1, 1), a1, cvA[1]);
            PG8_WAIT_V(8); PG8_WAIT_L(0); PG8_BAR; PG8_MMA(0, 0, At, B0); PG8_MMA(0, 1, At, B1); PG8_BAR; PG8_SCHED;
            PG8_LDA(At, 0, 1); PG8_STAGE(PG8_SB(0, 0), b2, voffB); PG8_STAGE(PG8_SB(0, 1), b2 + hstepB, voffB); PG8_STAGE(PG8_SA(0, 0), a2, v2[0]);
            PG8_WAIT_V(8); PG8_WAIT_L(0); PG8_BAR; PG8_MMA(1, 0, At, B0); PG8_MMA(1, 1, At, B1); PG8_BAR; PG8_SCHED;
            PG8_LDB(B0, 1, 0); PG8_LDB(B1, 1, 1); PG8_SCHED; PG8_LDA(At, 1, 0); PG8_STAGE(PG8_SA(0, 1), a2, v2[1]);
            PG8_WAIT_V(8); PG8_WAIT_L(0); PG8_BAR; PG8_MMA(0, 0, At, B0); PG8_MMA(0, 1, At, B1); PG8_BAR; PG8_SCHED;
            PG8_LDA(At, 1, 1); PG8_STAGE(PG8_SB(1, 0), b3, voffB); PG8_STAGE(PG8_SB(1, 1), b3 + hstepB, voffB); PG8_STAGE(PG8_SA(1, 0), a3, v2[0]);
            PG8_WAIT_V(8); PG8_WAIT_L(0); PG8_BAR; PG8_MMA(1, 0, At, B0); PG8_MMA(1, 1, At, B1); PG8_BAR; PG8_SCHED;
            } else {
            PG8_LDB(B0, 0, 0); PG8_SCHED; PG8_LDA(At, 0, 0); PG8_STAGE(PG8_SA(1, 1), a1, cvA[1]);
            PG8_WAIT_L(8); PG8_BAR; PG8_WAIT_L(0); PG8_MMA(0, 0, At, B0); PG8_BAR; PG8_SCHED;
            PG8_LDB(B1, 0, 1); PG8_STAGE(PG8_SB(0, 0), b2, voffB);
            PG8_BAR; PG8_WAIT_L(0); PG8_MMA(0, 1, At, B1); PG8_BAR;
            PG8_LDA(At, 0, 1); PG8_STAGE(PG8_SA(0, 0), a2, v2[0]);
            PG8_BAR; PG8_WAIT_L(0); PG8_MMA(1, 0, At, B0); PG8_BAR; PG8_SCHED;
            PG8_STAGE(PG8_SB(0, 1), b2 + hstepB, voffB);
            PG8_WAIT_V(6); PG8_BAR; PG8_MMA(1, 1, At, B1); PG8_BAR;
            PG8_LDB(B0, 1, 0); PG8_SCHED; PG8_LDA(At, 1, 0); PG8_STAGE(PG8_SA(0, 1), a2, v2[1]);
            PG8_WAIT_L(8); PG8_BAR; PG8_WAIT_L(0); PG8_MMA(0, 0, At, B0); PG8_BAR; PG8_SCHED;
            PG8_LDB(B1, 1, 1); PG8_STAGE(PG8_SB(1, 0), b3, voffB);
            PG8_BAR; PG8_WAIT_L(0); PG8_MMA(0, 1, At, B1); PG8_BAR;
            PG8_LDA(At, 1, 1); PG8_STAGE(PG8_SA(1, 0), a3, v2[0]);
            PG8_BAR; PG8_WAIT_L(0); PG8_MMA(1, 0, At, B0); PG8_BAR; PG8_SCHED;
            PG8_STAGE(PG8_SB(1, 1), b3 + hstepB, voffB);
            PG8_WAIT_V(6); PG8_BAR; PG8_MMA(1, 1, At, B1); PG8_BAR;
            }
        }
        if constexpr (ALIGN_EPI) { if (wr == 0) PG8_BAR; }
        const bool has_nn = has_next && unit_of((ui + 2) * nblk + bid, g.nM, g.nN, nn);
        int ridx[2][2];
        if (g.rowidx && has_nn) {
#pragma unroll
            for (int h = 0; h < 2; ++h)
#pragma unroll
                for (int i = 0; i < 2; ++i) ridx[h][i] = g.rowidx[nn.pm * 256 + 128 * h + RA[i]];
        }
        E(acc, cur, wr, wc, fr, fq);
        if (!has_next) break;
#pragma unroll
        for (int a = 0; a < 2; ++a)
#pragma unroll
            for (int b = 0; b < 2; ++b)
#pragma unroll
                for (int m = 0; m < 4; ++m)
#pragma unroll
                    for (int n = 0; n < 2; ++n) acc[a][b][m][n] = (f32x4){0.f, 0.f, 0.f, 0.f};
        cur = nxt; cB = nB; ++ui;
#pragma unroll
        for (int h = 0; h < 2; ++h)
#pragma unroll
            for (int i = 0; i < 2; ++i) { cvA[h][i] = nvA[h][i];
                if (has_nn) { const unsigned rr = g.rowidx ? (unsigned)ridx[h][i] : (unsigned)(nn.pm * 256 + 128 * h + RA[i]); nvA[h][i] = (rr * (unsigned)g.lda + (unsigned)CA[i]) * 2u; } }
        if constexpr (ALIGN_EPI) { if (wr == 1) PG8_BAR; }
    }
    PG8_WAIT_V(0);
    if constexpr (!ALIGN_EPI) { if (wr == 0) PG8_BAR; }
    PG8_BAR;
#undef PG8_SA
#undef PG8_SB
#undef PG8_STAGE
#undef PG8_LDA
#undef PG8_LDB
#undef PG8_MMA
#undef PG8_WAIT_V
#undef PG8_WAIT_L
#undef PG8_BAR
#undef PG8_SCHED
#undef PG8_VOFFA
}

struct EpiQKV {
    static constexpr int VMOPS = 16;
    bf16_t *qa, *ka, *va, *qb, *kb, *vb, *ux; const float *qna, *kna, *qnb, *knb;
    DEVI void operator()(const f32x4 (&acc)[2][2][4][2], const Unit& u, int wr, int wc, int fr, int fq) const {
        bf16_t* dst; const float* gn = nullptr; int H = 8, head0 = 0; const int pn = u.pn;
        if (pn < 2) { dst = qa; gn = qna; head0 = pn * 4; }
        else if (pn < 4) { dst = ka; gn = kna; head0 = (pn - 2) * 4; }
        else if (pn < 6) { dst = va; head0 = (pn - 4) * 4; }
        else if (pn == 6) { dst = qb; gn = qnb; H = 4; }
        else if (pn == 7) { dst = kb; gn = knb; H = 4; }
        else if (pn == 8) { dst = vb; H = 4; }
        else { dst = ux; }
        const int head = head0 + wc;
        f32x4 gv[2][2];
#pragma unroll
        for (int bj = 0; bj < 2; ++bj)
#pragma unroll
            for (int n = 0; n < 2; ++n) gv[bj][n] = gn ? *(const f32x4*)(gn + 32 * bj + 8 * fq + 4 * n) : (f32x4){1.f, 1.f, 1.f, 1.f};
#pragma unroll
        for (int ai = 0; ai < 2; ++ai)
#pragma unroll
            for (int m = 0; m < 4; ++m) {
                const int row = u.pm * 256 + 128 * ai + 64 * wr + 16 * m + fr;
                float rstd = 1.f;
                if (gn) { float ss = 0.f;
#pragma unroll
                    for (int bj = 0; bj < 2; ++bj)
#pragma unroll
                        for (int n = 0; n < 2; ++n) { const f32x4 v = acc[ai][bj][m][n]; ss += v.x * v.x + v.y * v.y + v.z * v.z + v.w * v.w; }
                    ss += __shfl_xor(ss, 16); ss += __shfl_xor(ss, 32);
                    rstd = rsqrtf(ss * (1.f / 64.f) + kEps); }
#pragma unroll
                for (int bj = 0; bj < 2; ++bj) {
                    const f32x4 v0 = acc[ai][bj][m][0] * rstd * gv[bj][0], v1 = acc[ai][bj][m][1] * rstd * gv[bj][1];
                    u32x4 w; w.x = pk2(v0.x, v0.y); w.y = pk2(v0.z, v0.w); w.z = pk2(v1.x, v1.y); w.w = pk2(v1.z, v1.w);
                    if (pn < 9) { const int b = row >> 13, s = row & (kS - 1);
                        *(u32x4*)(dst + (((size_t)(b * H + head)) * kS + s) * 64 + 32 * bj + 8 * fq) = w; }
                    else { const int gidx = 4 * wc + 2 * bj + (fq >> 1), c0 = 8 * (fq & 1);
                        *(u32x4*)(dst + ((size_t)gidx * 4096 + (row >> 4)) * 512 + (row & 15) * 16 + c0) = w; }
                }
            }
    }
};
struct EpiResid {
    static constexpr int VMOPS = 32;
    const float* xin; float* xout;
    DEVI void operator()(const f32x4 (&acc)[2][2][4][2], const Unit& u, int wr, int wc, int fr, int fq) const {
#pragma unroll
        for (int ai = 0; ai < 2; ++ai)
#pragma unroll
            for (int m = 0; m < 4; ++m) { const size_t ro = (size_t)(u.pm * 256 + 128 * ai + 64 * wr + 16 * m + fr) * kD + u.pn * 256 + 32 * wc + 4 * fq;
#pragma unroll
                for (int bj = 0; bj < 2; ++bj)
#pragma unroll
                    for (int n = 0; n < 2; ++n) { const size_t o = ro + 128 * bj + 16 * n; *(f32x4*)(xout + o) = *(const f32x4*)(xin + o) + acc[ai][bj][m][n]; } }
    }
};
struct EpiGU {
    static constexpr int VMOPS = 8;
    bf16_t* hid;
    DEVI void operator()(const f32x4 (&acc)[2][2][4][2], const Unit& u, int wr, int wc, int fr, int fq) const {
#pragma unroll
        for (int ai = 0; ai < 2; ++ai)
#pragma unroll
            for (int m = 0; m < 4; ++m) { const size_t row = (size_t)(u.pm * 256 + 128 * ai + 64 * wr + 16 * m + fr);
                float o[8];
#pragma unroll
                for (int n = 0; n < 2; ++n)
#pragma unroll
                    for (int j = 0; j < 4; ++j) { const float gt = acc[ai][0][m][n][j], up = acc[ai][1][m][n][j]; o[n * 4 + j] = gt * frcp(1.f + __expf(-gt)) * up; }
                u32x4 w; w.x = pk2(o[0], o[1]); w.y = pk2(o[2], o[3]); w.z = pk2(o[4], o[5]); w.w = pk2(o[6], o[7]);
                *(u32x4*)(hid + row * kFF + u.pn * 128 + 32 * wc + 8 * fq) = w; }
    }
};
struct EpiDry {
    static constexpr int VMOPS = 0;
    float* sink;
    DEVI void operator()(const f32x4 (&acc)[2][2][4][2], const Unit& u, int wr, int wc, int fr, int fq) const {
        float t = 0.f;
#pragma unroll
        for (int ai = 0; ai < 2; ++ai)
#pragma unroll
            for (int bj = 0; bj < 2; ++bj)
#pragma unroll
                for (int m = 0; m < 4; ++m)
#pragma unroll
                    for (int n = 0; n < 2; ++n) t += acc[ai][bj][m][n].x + acc[ai][bj][m][n].y + acc[ai][bj][m][n].z + acc[ai][bj][m][n].w;
        if (t == 1.2345e30f) sink[0] = t;
    }
};
struct EpiDown {
    static constexpr int VMOPS = 16;
    bf16_t* y; const float* gate;
    DEVI void operator()(const f32x4 (&acc)[2][2][4][2], const Unit& u, int wr, int wc, int fr, int fq) const {
#pragma unroll
        for (int ai = 0; ai < 2; ++ai)
#pragma unroll
            for (int m = 0; m < 4; ++m) { const size_t row = (size_t)(u.pm * 256 + 128 * ai + 64 * wr + 16 * m + fr); const float gv = gate[row];
#pragma unroll
                for (int bj = 0; bj < 2; ++bj) { const f32x4 v0 = acc[ai][bj][m][0] * gv, v1 = acc[ai][bj][m][1] * gv;
                    u32x4 w; w.x = pk2(v0.x, v0.y); w.y = pk2(v0.z, v0.w); w.z = pk2(v1.x, v1.y); w.w = pk2(v1.z, v1.w);
                    *(u32x4*)(y + row * kD + u.pn * 256 + 128 * bj + 32 * wc + 8 * fq) = w; } }
    }
};
struct EpiGlu {
    static constexpr int VMOPS = 16;
    const bf16_t* g; bf16_t* oc;
    DEVI void operator()(const f32x4 (&acc)[2][2][4][2], const Unit& u, int wr, int wc, int fr, int fq) const {
#pragma unroll
        for (int ai = 0; ai < 2; ++ai)
#pragma unroll
            for (int m = 0; m < 4; ++m) { const size_t row = (size_t)(u.pm * 256 + 128 * ai + 64 * wr + 16 * m + fr);
#pragma unroll
                for (int bj = 0; bj < 2; ++bj) { const size_t o = row * 256 + 128 * bj + 32 * wc + 8 * fq;
                    const u32x4 gw = *(const u32x4*)(g + o); float o8[8];
#pragma unroll
                    for (int n = 0; n < 2; ++n)
#pragma unroll
                        for (int j = 0; j < 4; ++j) { const int t = n * 4 + j; const unsigned wv = (t < 2) ? gw.x : (t < 4) ? gw.y : (t < 6) ? gw.z : gw.w;
                            const float gg = __uint_as_float((t & 1) ? (wv & 0xFFFF0000u) : (wv << 16)); o8[t] = gg * frcp(1.f + __expf(-acc[ai][bj][m][n][j])); }
                    u32x4 w; w.x = pk2(o8[0], o8[1]); w.y = pk2(o8[2], o8[3]); w.z = pk2(o8[4], o8[5]); w.w = pk2(o8[6], o8[7]);
                    *(u32x4*)(oc + o) = w; } }
    }
};

DEVI void load_row64(const bf16_t* p, float* d) {
#pragma unroll
    for (int i = 0; i < 8; ++i) { const u32x4 v = *(const u32x4*)(p + i * 8);
        d[i * 8 + 0] = __uint_as_float(v.x << 16); d[i * 8 + 1] = __uint_as_float(v.x & 0xFFFF0000u); d[i * 8 + 2] = __uint_as_float(v.y << 16); d[i * 8 + 3] = __uint_as_float(v.y & 0xFFFF0000u);
        d[i * 8 + 4] = __uint_as_float(v.z << 16); d[i * 8 + 5] = __uint_as_float(v.z & 0xFFFF0000u); d[i * 8 + 6] = __uint_as_float(v.w << 16); d[i * 8 + 7] = __uint_as_float(v.w & 0xFFFF0000u); }
}
DEVI void store_row64(bf16_t* p, const float* d, float sc) {
#pragma unroll
    for (int i = 0; i < 8; ++i) { u32x4 w; w.x = pk2(d[i * 8] * sc, d[i * 8 + 1] * sc); w.y = pk2(d[i * 8 + 2] * sc, d[i * 8 + 3] * sc); w.z = pk2(d[i * 8 + 4] * sc, d[i * 8 + 5] * sc); w.w = pk2(d[i * 8 + 6] * sc, d[i * 8 + 7] * sc);
        *(u32x4*)(p + i * 8) = w; }
}
DEVI void phase_dilated_naive(const bf16_t* qa, const bf16_t* ka, const bf16_t* va, bf16_t* oac, float* lse, int bid, int nblk) {
    const int nitems = 3 * kB * 8 * (kS / kNT);
    for (int it = bid; it < nitems; it += nblk) {
        const int c = it / (kB * 8 * 16), r = it % (kB * 8 * 16), bh = r / 16, t = (r % 16) * kNT + tidx(), b = bh >> 3, h = bh & 7;
        const int dil = (c == 0) ? 1 : (c == 1) ? 4 : 16;
        const float slope = exp2f(-(float)(h + 1));
        const bf16_t* kb_ = ka + (size_t)bh * kS * 64; const bf16_t* vb_ = va + (size_t)bh * kS * 64;
        float q[64], o[64];
        load_row64(qa + ((size_t)bh * kS + t) * 64, q);
#pragma unroll
        for (int d = 0; d < 64; ++d) o[d] = 0.f;
        float m = -1e30f, l = 0.f;
        for (int rel = -64; rel <= 64; ++rel) {
            const int pos = t + rel * dil;
            if (pos < 0 || pos >= kS) continue;
            float kv[64]; load_row64(kb_ + (size_t)pos * 64, kv);
            float dot = 0.f;
#pragma unroll
            for (int d = 0; d < 64; ++d) dot += q[d] * kv[d];
            const float sc = dot * 0.125f - slope * (float)(dil * (rel < 0 ? -rel : rel));
            const float mn = fmaxf(m, sc), corr = __expf(m - mn), p = __expf(sc - mn);
            load_row64(vb_ + (size_t)pos * 64, kv);
            l = l * corr + p;
#pragma unroll
            for (int d = 0; d < 64; ++d) o[d] = o[d] * corr + p * kv[d];
            m = mn;
        }
        const size_t tok = (size_t)b * kS + t;
        store_row64(oac + ((size_t)c * kTok + tok) * 512 + h * 64, o, 1.f / l);
        lse[((size_t)c * kTok + tok) * 8 + h] = m + __logf(l);
    }
}
DEVI void phase_na_naive(const bf16_t* qb, const bf16_t* kbuf, const bf16_t* vbuf, const float* rpb  , bf16_t* ob, int bid, int nblk) {
    const int nitems = kB * 4 * (kS / kNT);
    for (int it = bid; it < nitems; it += nblk) {
        const int bh = it / 16, t = (it % 16) * kNT + tidx(), b = bh >> 2, h = bh & 3;
        const int r = t >> 6, cq = t & 63;
        int rs = r - 4; rs = rs < 0 ? 0 : (rs > 120 ? 120 : rs);
        int cs = cq - 8; cs = cs < 0 ? 0 : (cs > 48 ? 48 : cs);
        const bf16_t* kb_ = kbuf + (size_t)bh * kS * 64; const bf16_t* vb_ = vbuf + (size_t)bh * kS * 64;
        float q[64], o[64];
        load_row64(qb + ((size_t)bh * kS + t) * 64, q);
#pragma unroll
        for (int d = 0; d < 64; ++d) o[d] = 0.f;
        float m = -1e30f, l = 0.f;
        for (int kr = 0; kr < 8; ++kr)
            for (int kc = 0; kc < 16; ++kc) {
                const int krow = rs + kr, kcol = cs + kc, pos = krow * 64 + kcol;
                float kv[64]; load_row64(kb_ + (size_t)pos * 64, kv);
                float dot = 0.f;
#pragma unroll
                for (int d = 0; d < 64; ++d) dot += q[d] * kv[d];
                const float sc = dot * 0.125f + rpb[(h * 15 + (krow - r + 7)) * 31 + (kcol - cq + 15)];
                const float mn = fmaxf(m, sc), corr = __expf(m - mn), p = __expf(sc - mn);
                load_row64(vb_ + (size_t)pos * 64, kv);
                l = l * corr + p;
#pragma unroll
                for (int d = 0; d < 64; ++d) o[d] = o[d] * corr + p * kv[d];
                m = mn;
            }
        store_row64(ob + ((size_t)b * kS + t) * 256 + h * 64, o, 1.f / l);
    }
}

typedef float f32x16 __attribute__((ext_vector_type(16)));
typedef short s16x4 __attribute__((ext_vector_type(4)));
constexpr float kLog2e = 1.4426950408889634f, kLn2 = 0.6931471805599453f;
DEVI bf16x8 tr_pair(LAS unsigned char* p0, LAS unsigned char* p1) {
    const s16x4 a = __builtin_amdgcn_ds_read_tr16_b64_v4i16((LAS s16x4*)p0), b = __builtin_amdgcn_ds_read_tr16_b64_v4i16((LAS s16x4*)p1);
    return (bf16x8){a.x, a.y, a.z, a.w, b.x, b.y, b.z, b.w};
}
DEVI void phase_dilated(const bf16_t* qa, const bf16_t* ka, const bf16_t* va, const float* gq, const float* gk, bf16_t* oac, float* lse, LAS unsigned char* lds, int bid, int nblk) {
    const int tid = tidx(), wid = __builtin_amdgcn_readfirstlane(tid >> 6), lane = tid & 63, h5 = lane >> 5, qc = lane & 31;
    LAS unsigned char* Kimg = lds; LAS unsigned char* Vimg = lds + 49152;
    float Mn;
    { float a = fabsf(gq[lane]), b = fabsf(gk[lane]);
#pragma unroll
      for (int m = 32; m >= 1; m >>= 1) { a = fmaxf(a, __shfl_xor(a, m)); b = fmaxf(b, __shfl_xor(b, m)); }
      Mn = 8.f * a * b; }
    const float Mb = Mn * kLog2e;
    unsigned koff[4];
#pragma unroll
    for (int s = 0; s < 4; ++s) koff[s] = (unsigned)((32 * wid + qc) * 128 + (((2 * s + h5) ^ (qc & 7)) << 4));
    unsigned voff[2];
    { const int g = lane >> 4, i16 = lane & 15, q = i16 >> 2, p = i16 & 3;
#pragma unroll
      for (int dt = 0; dt < 2; ++dt) { const int c = (2 * (g & 1) + (p >> 1) + 4 * dt) ^ ((q >> 1) << 2); voff[dt] = (unsigned)((32 * wid + 4 * h5 + q) * 128 + (c << 4) + 8 * (p & 1)); } }
    float dv[16];
#pragma unroll
    for (int i = 0; i < 16; ++i) dv[i] = (float)((i & 3) + 8 * (i >> 2) + 4 * h5 - qc);
    u32x4 pK[6], pV[6]; bf16x8 pQ[4];
#define DIL_DECODE(unit_) const int c = (unit_) >> 11, rem = (unit_) & 2047, bh = rem >> 5, ub = rem & 31; \
        const int dsh = 2 * c, L = kS >> dsh, upc = 32 >> dsh, cls = ub >> (5 - dsh), u0 = (ub & (upc - 1)) << 8;
#define DIL_PREFETCH(unit_) do { DIL_DECODE(unit_) \
        const bf16_t* kbase = ka + (size_t)bh * kS * 64; const bf16_t* vbase = va + (size_t)bh * kS * 64; \
        { const int qtok_ = ((u0 + 32 * wid + qc) << dsh) + cls; _Pragma("unroll") for (int s = 0; s < 4; ++s) pQ[s] = *(const bf16x8*)(qa + ((size_t)bh * kS + qtok_) * 64 + 16 * s + 8 * h5); } \
        _Pragma("unroll") for (int it = 0; it < 6; ++it) { const int id = it * kNT + tid, row = id >> 3, ch = id & 7; \
            int ki = u0 - 64 + row; ki = ki < 0 ? 0 : (ki > L - 1 ? L - 1 : ki); const size_t tok = (size_t)((ki << dsh) + cls); \
            pK[it] = *(const u32x4*)(kbase + tok * 64 + ch * 8); pV[it] = *(const u32x4*)(vbase + tok * 64 + ch * 8); } } while (0)
    if (bid < 6144) DIL_PREFETCH(bid);
    for (int unit = bid; unit < 6144; unit += nblk) {
        DIL_DECODE(unit)
        __syncthreads();
#pragma unroll
        for (int it = 0; it < 6; ++it) { const int id = it * kNT + tid, row = id >> 3, ch = id & 7;
            *(LAS u32x4*)(Kimg + row * 128 + ((ch ^ (row & 7)) << 4)) = pK[it];
            *(LAS u32x4*)(Vimg + row * 128 + ((ch ^ (((row >> 1) & 1) << 2)) << 4)) = pV[it]; }
        bf16x8 Qf[4];
#pragma unroll
        for (int s = 0; s < 4; ++s) Qf[s] = pQ[s];
        __syncthreads();
        if (unit + nblk < 6144) DIL_PREFETCH(unit + nblk);
        const int q0 = u0 + 32 * wid, qtok = ((q0 + qc) << dsh) + cls;
        const float slope = exp2f(-(float)((bh & 7) + 1));
        const float c1 = 0.125f * kLog2e, c2 = slope * (float)(1 << dsh) * kLog2e;
        float sum = 0.f;
        f32x16 O[2];
#pragma unroll
        for (int dt = 0; dt < 2; ++dt)
#pragma unroll
            for (int i = 0; i < 16; ++i) O[dt][i] = 0.f;
#pragma unroll
        for (int kt = 0; kt < 5; ++kt) {
            const int kp0 = q0 - 64 + 32 * kt;
            if (kp0 >= 0 && kp0 < L) {
                f32x16 S;
#pragma unroll
                for (int i = 0; i < 16; ++i) S[i] = 0.f;
#pragma unroll
                for (int s = 0; s < 4; ++s) { const bf16x8 Kf = *(const LAS bf16x8*)(Kimg + koff[s] + kt * 4096); S = __builtin_amdgcn_mfma_f32_32x32x16_bf16(Kf, Qf[s], S, 0, 0, 0); }
                const float cs = (kt < 2) ? c2 : -c2, c0 = ((kt == 0 || kt == 4) ? -64.f : (kt == 2 ? 0.f : -32.f)) * c2 - Mb;
#pragma unroll
                for (int i = 0; i < 16; ++i) {
                    const float d = (kt == 2) ? fabsf(dv[i]) : dv[i];
                    float sv = S[i] * c1 + (d * cs + c0);
                    if (kt == 0) sv = (dv[i] >= 0.f) ? sv : -1e30f;
                    if (kt == 4) sv = (dv[i] <= 0.f) ? sv : -1e30f;
                    const float pv = __builtin_amdgcn_exp2f(sv); S[i] = pv; sum += pv;
                }
#pragma unroll
                for (int s2 = 0; s2 < 2; ++s2) {
                    u32x4 pw; pw.x = pk2(S[8 * s2 + 0], S[8 * s2 + 1]); pw.y = pk2(S[8 * s2 + 2], S[8 * s2 + 3]); pw.z = pk2(S[8 * s2 + 4], S[8 * s2 + 5]); pw.w = pk2(S[8 * s2 + 6], S[8 * s2 + 7]);
                    const bf16x8 Pf = __builtin_bit_cast(bf16x8, pw);
#pragma unroll
                    for (int dt = 0; dt < 2; ++dt) { LAS unsigned char* vp = Vimg + voff[dt] + kt * 4096 + s2 * 2048;
                        const bf16x8 Vf = tr_pair(vp, vp + 1024);
                        O[dt] = __builtin_amdgcn_mfma_f32_32x32x16_bf16(Vf, Pf, O[dt], 0, 0, 0); }
                }
            }
        }
        sum += __shfl_xor(sum, 32);
        const float inv = 1.f / sum;
        const size_t tok = (size_t)(bh >> 3) * kS + qtok;
        bf16_t* orow = oac + ((size_t)c * kTok + tok) * 512 + (bh & 7) * 64;
#pragma unroll
        for (int dt = 0; dt < 2; ++dt)
#pragma unroll
            for (int g4 = 0; g4 < 4; ++g4) { u32x2 w; w.x = pk2(O[dt][4 * g4] * inv, O[dt][4 * g4 + 1] * inv); w.y = pk2(O[dt][4 * g4 + 2] * inv, O[dt][4 * g4 + 3] * inv);
                *(u32x2*)(orow + 32 * dt + 8 * g4 + 4 * h5) = w; }
        if (h5 == 0) lse[((size_t)c * kTok + tok) * 8 + (bh & 7)] = Mn + __logf(sum);
    }
#undef DIL_DECODE
#undef DIL_PREFETCH
    __syncthreads();
}
DEVI void phase_na(const bf16_t* qb, const bf16_t* kb, const bf16_t* vb, const float* rpb  , bf16_t* ob, LAS unsigned char* lds, int bid, int nblk) {
    const int tid = tidx(), wid = __builtin_amdgcn_readfirstlane(tid >> 6), lane = tid & 63, g4 = lane >> 4, i16 = lane & 15;
    LAS unsigned char* Kimg = lds; LAS unsigned char* Vimg = lds + 73728; LAS float* tab = (LAS float*)(lds + 147456);
    for (int i = tid; i < 4 * 465; i += kNT) tab[i] = rpb[i];
    const int g = wid & 3, kcs = (16 * g - 8) < 0 ? 0 : ((16 * g - 8) > 32 ? 32 : (16 * g - 8));
    const int qcol = 16 * g + i16, cs = (qcol - 8) < 0 ? 0 : ((qcol - 8) > 48 ? 48 : (qcol - 8));
    unsigned kswz[2];
#pragma unroll
    for (int s = 0; s < 2; ++s) kswz[s] = (unsigned)(((4 * s + g4) ^ (i16 & 7)) << 4);
    const int q = i16 >> 2, p = i16 & 3, sw = 2 * (g4 & 1) + (q >> 1);
    unsigned vsw[4];
#pragma unroll
    for (int dt = 0; dt < 4; ++dt) vsw[dt] = (unsigned)((((2 * dt + (p >> 1)) ^ (sw << 1)) << 4) + 8 * (p & 1));
    for (int unit = bid; unit < 2048; unit += nblk) {
        const int bh = unit >> 6, rp = unit & 63, r0 = 2 * rp, h = bh & 3;
        const int rsA = (r0 - 4) < 0 ? 0 : ((r0 - 4) > 120 ? 120 : (r0 - 4));
        const bf16_t* kbase = kb + (size_t)bh * kS * 64; const bf16_t* vbase = vb + (size_t)bh * kS * 64;
        __syncthreads();
#pragma unroll
        for (int it = 0; it < 9; ++it) {
            const int id = it * kNT + tid, row = id >> 3, ch = id & 7;
            int gr = rsA + (row >> 6); gr = gr > 127 ? 127 : gr;
            const size_t tok = (size_t)(gr * 64 + (row & 63));
            const u32x4 kv = *(const u32x4*)(kbase + tok * 64 + ch * 8), vv = *(const u32x4*)(vbase + tok * 64 + ch * 8);
            *(LAS u32x4*)(Kimg + row * 128 + ((ch ^ (row & 7)) << 4)) = kv;
            *(LAS u32x4*)(Vimg + row * 128 + ((ch ^ (((row >> 1) & 3) << 1)) << 4)) = vv;
        }
        __syncthreads();
        const int rr = r0 + (wid >> 2);
        const int rs = (rr - 4) < 0 ? 0 : ((rr - 4) > 120 ? 120 : (rr - 4)), ro = rs - rsA;
        const int qtok = rr * 64 + qcol;
        bf16x8 Qf[2];
#pragma unroll
        for (int s = 0; s < 2; ++s) Qf[s] = *(const bf16x8*)(qb + ((size_t)bh * kS + qtok) * 64 + 32 * s + 8 * g4);
        f32x4 S[16];
        const unsigned kb0 = (unsigned)((ro * 64 + kcs + i16) * 128);
#pragma unroll
        for (int t = 0; t < 16; ++t) { S[t] = (f32x4){0.f, 0.f, 0.f, 0.f};
#pragma unroll
            for (int s = 0; s < 2; ++s) { const bf16x8 Kf = *(const LAS bf16x8*)(Kimg + kb0 + (t >> 1) * 8192 + (t & 1) * 2048 + kswz[s]); S[t] = __builtin_amdgcn_mfma_f32_16x16x32_bf16(Kf, Qf[s], S[t], 0, 0, 0); } }
        float mx = -1e30f;
        const LAS float* th = tab + h * 465;
        int g4v = g4; asm volatile("" : "+v"(g4v));
#pragma unroll
        for (int t = 0; t < 16; ++t)
#pragma unroll
            for (int j = 0; j < 4; ++j) {
                const int krow = rs + (t >> 1), kcol = kcs + 16 * (t & 1) + 4 * g4v + j;
                const bool valid = (kcol >= cs) && (kcol < cs + 16);
                int dc = kcol - qcol + 15; dc = dc < 0 ? 0 : (dc > 30 ? 30 : dc);
                const float bias = th[(krow - rr + 7) * 31 + dc];
                const float sv = valid ? (S[t][j] * 0.125f + bias) * kLog2e : -1e30f;
                S[t][j] = sv; mx = fmaxf(mx, sv);
            }
        mx = fmaxf(mx, __shfl_xor(mx, 16)); mx = fmaxf(mx, __shfl_xor(mx, 32));
        float sum = 0.f;
#pragma unroll
        for (int t = 0; t < 16; ++t)
#pragma unroll
            for (int j = 0; j < 4; ++j) { const float pv = __builtin_amdgcn_exp2f(S[t][j] - mx); S[t][j] = pv; sum += pv; }
        sum += __shfl_xor(sum, 16); sum += __shfl_xor(sum, 32);
        f32x4 O[4];
#pragma unroll
        for (int dt = 0; dt < 4; ++dt) O[dt] = (f32x4){0.f, 0.f, 0.f, 0.f};
        const unsigned vb0 = (unsigned)((ro * 64 + kcs + 4 * g4 + q) * 128);
#pragma unroll
        for (int u = 0; u < 8; ++u) {
            u32x4 pw; pw.x = pk2(S[2 * u][0], S[2 * u][1]); pw.y = pk2(S[2 * u][2], S[2 * u][3]); pw.z = pk2(S[2 * u + 1][0], S[2 * u + 1][1]); pw.w = pk2(S[2 * u + 1][2], S[2 * u + 1][3]);
            const bf16x8 Pf = __builtin_bit_cast(bf16x8, pw);
#pragma unroll
            for (int dt = 0; dt < 4; ++dt) { LAS unsigned char* vp = Vimg + vb0 + u * 8192 + vsw[dt];
                const bf16x8 Vf = tr_pair(vp, vp + 2048);
                O[dt] = __builtin_amdgcn_mfma_f32_16x16x32_bf16(Vf, Pf, O[dt], 0, 0, 0); }
        }
        const float inv = 1.f / sum;
        bf16_t* orow = ob + ((size_t)(bh >> 2) * kS + qtok) * 256 + h * 64;
#pragma unroll
        for (int dt = 0; dt < 4; ++dt) { u32x2 w; w.x = pk2(O[dt][0] * inv, O[dt][1] * inv); w.y = pk2(O[dt][2] * inv, O[dt][3] * inv); *(u32x2*)(orow + 16 * dt + 4 * g4) = w; }
    }
    __syncthreads();
}
DEVI void phase_s5_naive(const Params& P, int l, const bf16_t* ux, float* ys, unsigned char* lds, int bid, int nblk) {
    const int wid = tidx() >> 6, lane = tidx() & 63;
    float* xs = (float*)lds + wid * 128;
    for (int item = wid * nblk + bid; item < kB * 16 * 2; item += nblk * 8) {
        const int dir = item & 1, g = (item >> 1) & 15, b = item >> 5;
        const size_t pbase = (((size_t)l * 2 + dir) * 16 + g) * 64;
        const float dt = __expf(P.s5_log_dt[((size_t)l * 2 + dir) * 16 + g]);
        const float a = fminf(P.s5_a_re[pbase + lane], -1e-4f), w = P.s5_a_im[pbase + lane];
        const float mag = __expf(a * dt), ar = mag * cosf(w * dt), ai = mag * sinf(w * dt);
        const float den = a * a + w * w, zr = ar - 1.f, gr = (zr * a + ai * w) / den, gi = (ai * a - zr * w) / den;
        float bbr[16], bbi[16];
#pragma unroll
        for (int c = 0; c < 16; ++c) { const float br = P.s5_b_re[(pbase + lane) * 16 + c], bi = P.s5_b_im[(pbase + lane) * 16 + c]; bbr[c] = gr * br - gi * bi; bbi[c] = gr * bi + gi * br; }
        const int cch = lane & 15, qt = lane >> 4;
        float cre[16], cim[16];
#pragma unroll
        for (int pp = 0; pp < 16; ++pp) { cre[pp] = P.s5_c_re[(pbase / 64 * 16 + cch) * 64 + qt * 16 + pp]; cim[pp] = P.s5_c_im[(pbase / 64 * 16 + cch) * 64 + qt * 16 + pp]; }
        float xr = 0.f, xi = 0.f;
        const bf16_t* ug = ux + (size_t)g * 4096 * 512;
        for (int st = 0; st < kS; ++st) {
            const int s = dir ? (kS - 1 - st) : st; const size_t tok = (size_t)b * kS + s;
            const bf16_t* up = ug + (tok >> 4) * 512 + (tok & 15) * 16;
            const u32x4 u0 = *(const u32x4*)up, u1 = *(const u32x4*)(up + 8);
            float uv[16];
            uv[0] = __uint_as_float(u0.x << 16); uv[1] = __uint_as_float(u0.x & 0xFFFF0000u); uv[2] = __uint_as_float(u0.y << 16); uv[3] = __uint_as_float(u0.y & 0xFFFF0000u);
            uv[4] = __uint_as_float(u0.z << 16); uv[5] = __uint_as_float(u0.z & 0xFFFF0000u); uv[6] = __uint_as_float(u0.w << 16); uv[7] = __uint_as_float(u0.w & 0xFFFF0000u);
            uv[8] = __uint_as_float(u1.x << 16); uv[9] = __uint_as_float(u1.x & 0xFFFF0000u); uv[10] = __uint_as_float(u1.y << 16); uv[11] = __uint_as_float(u1.y & 0xFFFF0000u);
            uv[12] = __uint_as_float(u1.z << 16); uv[13] = __uint_as_float(u1.z & 0xFFFF0000u); uv[14] = __uint_as_float(u1.w << 16); uv[15] = __uint_as_float(u1.w & 0xFFFF0000u);
            float bur = 0.f, bui = 0.f;
#pragma unroll
            for (int c = 0; c < 16; ++c) { bur += bbr[c] * uv[c]; bui += bbi[c] * uv[c]; }
            const float nr = ar * xr - ai * xi + bur, ni = ar * xi + ai * xr + bui; xr = nr; xi = ni;
            xs[lane] = xr; xs[64 + lane] = xi;
            asm volatile("s_waitcnt lgkmcnt(0)" ::: "memory");
            float y = 0.f;
#pragma unroll
            for (int pp = 0; pp < 16; ++pp) y += cre[pp] * xs[qt * 16 + pp] - cim[pp] * xs[64 + qt * 16 + pp];
            asm volatile("s_waitcnt lgkmcnt(0)" ::: "memory");
            y += __shfl_xor(y, 16); y += __shfl_xor(y, 32);
            if (lane < 16) ys[((size_t)dir * kTok + tok) * 256 + g * 16 + cch] = y;
        }
    }
}
DEVI void phase_s5_finish(const float* ys, const bf16_t* ux, const float* dskip, bf16_t* G, int bid, int nblk) {
    for (size_t i = (size_t)bid * kNT + tidx(); i < (size_t)kTok * 256; i += (size_t)nblk * kNT) {
        const size_t tok = i >> 8; const int ch = (int)(i & 255), g = ch >> 4, c = ch & 15;
        const float u = bf2f(ux[((size_t)g * 4096 + (tok >> 4)) * 512 + (tok & 15) * 16 + c]);
        const float y = ys[i] + ys[(size_t)kTok * 256 + i] + dskip[ch] * u;
        G[i] = f2bf(gelu_tanh(y));
    }
}
DEVI void unpk8(float* d, const u32x4 q, const float sc) {
    d[0] += sc * __uint_as_float(q.x << 16); d[1] += sc * __uint_as_float(q.x & 0xFFFF0000u); d[2] += sc * __uint_as_float(q.y << 16); d[3] += sc * __uint_as_float(q.y & 0xFFFF0000u);
    d[4] += sc * __uint_as_float(q.z << 16); d[5] += sc * __uint_as_float(q.z & 0xFFFF0000u); d[6] += sc * __uint_as_float(q.w << 16); d[7] += sc * __uint_as_float(q.w & 0xFFFF0000u);
}
DEVI void phase_mixnorm(const bf16_t* oac, const float* lse, const bf16_t* ob, const bf16_t* oc, const float* ga, const float* gb, const float* gc, bf16_t* mix, int bid, int nblk) {
    const int wid = tidx() >> 6, lane = tidx() & 63;
    float gn[16];
    { const float* gp = (lane < 32) ? ga + lane * 16 : (lane < 48) ? gb + (lane - 32) * 16 : gc + (lane - 48) * 16;
#pragma unroll
      for (int i = 0; i < 16; ++i) gn[i] = gp[i]; }
    for (int row = bid * 8 + wid; row < kTok; row += nblk * 8) {
        float v[16];
#pragma unroll
        for (int i = 0; i < 16; ++i) v[i] = 0.f;
        if (lane < 32) {
            const int h = lane >> 2;
            const float l0 = lse[(size_t)row * 8 + h], l1 = lse[((size_t)kTok + row) * 8 + h], l2 = lse[((size_t)2 * kTok + row) * 8 + h];
            const bf16_t* p0 = oac + (size_t)row * 512 + lane * 16; const bf16_t* p1 = p0 + (size_t)kTok * 512; const bf16_t* p2 = p1 + (size_t)kTok * 512;
            const u32x4 a0 = *(const u32x4*)p0, a1 = *(const u32x4*)(p0 + 8), b0 = *(const u32x4*)p1, b1 = *(const u32x4*)(p1 + 8), c0 = *(const u32x4*)p2, c1 = *(const u32x4*)(p2 + 8);
            const float mx = fmaxf(l0, fmaxf(l1, l2)); float w0 = __expf(l0 - mx), w1 = __expf(l1 - mx), w2 = __expf(l2 - mx); const float inv = frcp(w0 + w1 + w2); w0 *= inv; w1 *= inv; w2 *= inv;
            unpk8(v, a0, w0); unpk8(v + 8, a1, w0); unpk8(v, b0, w1); unpk8(v + 8, b1, w1); unpk8(v, c0, w2); unpk8(v + 8, c1, w2);
        } else {
            const bf16_t* p = (lane < 48) ? ob + (size_t)row * 256 + (lane - 32) * 16 : oc + (size_t)row * 256 + (lane - 48) * 16;
            const u32x4 a0 = *(const u32x4*)p, a1 = *(const u32x4*)(p + 8);
            unpk8(v, a0, 1.f); unpk8(v + 8, a1, 1.f);
        }
        float ss = 0.f;
#pragma unroll
        for (int i = 0; i < 16; ++i) ss += v[i] * v[i];
#pragma unroll
        for (int m = 1; m <= 8; m <<= 1) ss += __shfl_xor(ss, m);
        const float o16 = __shfl_xor(ss, 16);
        if (lane < 32) ss += o16;
        const float rstd = rsqrtf(ss * ((lane < 32) ? (1.f / 512.f) : (1.f / 256.f)) + kEps);
        u32x4 w0, w1;
        w0.x = pk2(v[0] * rstd * gn[0], v[1] * rstd * gn[1]); w0.y = pk2(v[2] * rstd * gn[2], v[3] * rstd * gn[3]); w0.z = pk2(v[4] * rstd * gn[4], v[5] * rstd * gn[5]); w0.w = pk2(v[6] * rstd * gn[6], v[7] * rstd * gn[7]);
        w1.x = pk2(v[8] * rstd * gn[8], v[9] * rstd * gn[9]); w1.y = pk2(v[10] * rstd * gn[10], v[11] * rstd * gn[11]); w1.z = pk2(v[12] * rstd * gn[12], v[13] * rstd * gn[13]); w1.w = pk2(v[14] * rstd * gn[14], v[15] * rstd * gn[15]);
        *(u32x4*)(mix + (size_t)row * kD + lane * 16) = w0; *(u32x4*)(mix + (size_t)row * kD + lane * 16 + 8) = w1;
    }
}
DEVI void phase_combine(float* x, const bf16_t* y, const int* tokslot, const float* gain_next, bf16_t* h, int bid, int nblk) {
    const int wid = tidx() >> 6, lane = tidx() & 63;
    f32x4 g[4];
#pragma unroll
    for (int q = 0; q < 4; ++q) g[q] = gain_next ? *(const f32x4*)(gain_next + q * 256 + lane * 4) : (f32x4){0.f, 0.f, 0.f, 0.f};
    for (int row = bid * 8 + wid; row < kTok; row += nblk * 8) {
        const int b = row >> 13;
        const int ts = tokslot[(size_t)row * kE + (lane & 15)];
        f32x4 v[4];
#pragma unroll
        for (int q = 0; q < 4; ++q) v[q] = *(const f32x4*)(x + (size_t)row * kD + q * 256 + lane * 4);
#pragma unroll
        for (int e = 0; e < kE; ++e) { const int slot = __builtin_amdgcn_readlane(ts, e);
            if (slot >= 0) { const bf16_t* yr = y + ((size_t)(e * kB + b) * kCap + slot) * kD;
#pragma unroll
                for (int q = 0; q < 4; ++q) { const u32x2 w = *(const u32x2*)(yr + q * 256 + lane * 4);
                    v[q].x += __uint_as_float(w.x << 16); v[q].y += __uint_as_float(w.x & 0xFFFF0000u); v[q].z += __uint_as_float(w.y << 16); v[q].w += __uint_as_float(w.y & 0xFFFF0000u); } } }
        float ss = 0.f;
#pragma unroll
        for (int q = 0; q < 4; ++q) { *(f32x4*)(x + (size_t)row * kD + q * 256 + lane * 4) = v[q]; ss += v[q].x * v[q].x + v[q].y * v[q].y + v[q].z * v[q].z + v[q].w * v[q].w; }
        if (gain_next) { ss = wave_sum(ss); const float rstd = rsqrtf(ss * (1.f / kD) + kEps);
#pragma unroll
            for (int q = 0; q < 4; ++q) { u32x2 o; o.x = pk2(v[q].x * rstd * g[q].x, v[q].y * rstd * g[q].y); o.y = pk2(v[q].z * rstd * g[q].z, v[q].w * rstd * g[q].w);
                *(u32x2*)(h + (size_t)row * kD + q * 256 + lane * 4) = o; } }
    }
}


DEVI void cpow_m(double a, double w, double dt, int m, float& re, float& im) {
    const float mag = __expf((float)m * (float)a * (float)dt);
    const double turns = (double)m * w * dt * 0.15915494309189535; const float ang = (float)((turns - floor(turns)) * 6.283185307179586);
    re = mag * cosf(ang); im = mag * sinf(ang);
}
DEVI void s5_prep_item(const Params& P, int l, int g, unsigned char* lds_) {
    float* pw = (float*)lds_;
    float* bb = pw + 4352;
    float* cc = bb + 4096;
    float* kt = cc + 4096;
    const int tid = tidx();
    __syncthreads();
    for (int i = tid; i < 128; i += kNT) { const int dir = i >> 6, p = i & 63; const size_t pb = (((size_t)l * 2 + dir) * 16 + g) * 64 + p;
        const double dt = (double)__expf(P.s5_log_dt[((size_t)l * 2 + dir) * 16 + g]); const double a = (double)fminf(P.s5_a_re[pb], -1e-4f), w = (double)P.s5_a_im[pb];
        for (int m = 0; m < 17; ++m) { float re, im; cpow_m(a, w, dt, m, re, im); pw[((dir * 64 + p) * 17 + m) * 2] = re; pw[((dir * 64 + p) * 17 + m) * 2 + 1] = im; }
        const float af = (float)a, wf = (float)w, ar = pw[((dir * 64 + p) * 17 + 1) * 2], ai = pw[((dir * 64 + p) * 17 + 1) * 2 + 1];
        const float den = af * af + wf * wf, zr = ar - 1.f, gr = (zr * af + ai * wf) / den, gi = (ai * af - zr * wf) / den;
        for (int c = 0; c < 16; ++c) { const float br = P.s5_b_re[pb * 16 + c], bi = P.s5_b_im[pb * 16 + c]; bb[((dir * 64 + p) * 16 + c) * 2] = gr * br - gi * bi; bb[((dir * 64 + p) * 16 + c) * 2 + 1] = gr * bi + gi * br; }
    }
    for (int i = tid; i < 2048; i += kNT) { const int dir = i >> 10, c = (i >> 6) & 15, p = i & 63; const size_t o = ((((size_t)l * 2 + dir) * 16 + g) * 16 + c) * 64 + p; cc[i * 2] = P.s5_c_re[o]; cc[i * 2 + 1] = P.s5_c_im[o]; }
    __syncthreads();
    for (int i = tid; i < 8192; i += kNT) { const int dir = i >> 12, m = (i >> 8) & 15, c = (i >> 4) & 15, c2 = i & 15; float acc = 0.f;
        for (int p = 0; p < 64; ++p) { const float cr = cc[((dir * 16 + c) * 64 + p) * 2], ci = cc[((dir * 16 + c) * 64 + p) * 2 + 1], wr_ = pw[((dir * 64 + p) * 17 + m) * 2], wi_ = pw[((dir * 64 + p) * 17 + m) * 2 + 1];
            const float br = bb[((dir * 64 + p) * 16 + c2) * 2], bi = bb[((dir * 64 + p) * 16 + c2) * 2 + 1]; const float tr = cr * wr_ - ci * wi_, ti = cr * wi_ + ci * wr_; acc += tr * br - ti * bi; }
        kt[i] = acc; }
    __syncthreads();
    bf16_t* wst = (bf16_t*)(P.ws + WS_WST) + ((size_t)l * 16 + g) * 256 * 256;
    bf16_t* wso = (bf16_t*)(P.ws + WS_WSO) + ((size_t)l * 16 + g) * 256 * 512;
    for (int id = tid; id < 8192; id += kNT) { const int n = id >> 5, k0 = (id & 31) * 8, dir = n >> 7, p = (n >> 1) & 63, ri = n & 1; float v[8];
#pragma unroll
        for (int kk = 0; kk < 8; ++kk) { const int k = k0 + kk, t = k >> 4, c = k & 15, e = dir ? t : 15 - t; const float wr_ = pw[((dir * 64 + p) * 17 + e) * 2], wi_ = pw[((dir * 64 + p) * 17 + e) * 2 + 1], br = bb[((dir * 64 + p) * 16 + c) * 2], bi = bb[((dir * 64 + p) * 16 + c) * 2 + 1];
            v[kk] = ri ? (wr_ * bi + wi_ * br) : (wr_ * br - wi_ * bi); }
        u32x4 o; o.x = pk2(v[0], v[1]); o.y = pk2(v[2], v[3]); o.z = pk2(v[4], v[5]); o.w = pk2(v[6], v[7]); *(u32x4*)(wst + (size_t)n * 256 + k0) = o; }
    for (int id = tid; id < 16384; id += kNT) { const int ns = id >> 6, k0 = (id & 63) * 8, n = cmap_pk(ns), t = n >> 4, c = n & 15; float v[8];
#pragma unroll
        for (int kk = 0; kk < 8; ++kk) { const int k = k0 + kk; float x;
            if (k < 256) { const int j = k >> 4, c2 = k & 15; x = 0.f; if (j <= t) x += kt[(t - j) * 256 + c * 16 + c2]; if (j >= t) x += kt[4096 + (j - t) * 256 + c * 16 + c2]; if (j == t && c == c2) x += P.s5_d[l * 256 + g * 16 + c]; }
            else { const int q = k - 256, dir = q >> 7, p = (q >> 1) & 63, ri = q & 1, e = dir ? 16 - t : t + 1; const float cr = cc[((dir * 16 + c) * 64 + p) * 2], ci = cc[((dir * 16 + c) * 64 + p) * 2 + 1], wr_ = pw[((dir * 64 + p) * 17 + e) * 2], wi_ = pw[((dir * 64 + p) * 17 + e) * 2 + 1];
                x = ri ? -(cr * wi_ + ci * wr_) : (cr * wr_ - ci * wi_); }
            v[kk] = x; }
        u32x4 o; o.x = pk2(v[0], v[1]); o.y = pk2(v[2], v[3]); o.z = pk2(v[4], v[5]); o.w = pk2(v[6], v[7]); *(u32x4*)(wso + (size_t)ns * 512 + k0) = o; }
    __syncthreads();
}
DEVI void phase_s5_scan(const Params& P, int l, const float* Z, bf16_t* ux, unsigned char* lds_, int bid, int nblk) {
    const int tid = tidx(), wid = tid >> 6, lane = tid & 63;
    float* E = (float*)lds_;
    for (int item = bid; item < 256; item += nblk) {
        const int dir = item & 1, g = (item >> 1) & 15, b = item >> 5;
        const size_t pb = (((size_t)l * 2 + dir) * 16 + g) * 64 + lane;
        const double dt = (double)__expf(P.s5_log_dt[((size_t)l * 2 + dir) * 16 + g]); const double a = (double)fminf(P.s5_a_re[pb], -1e-4f), w = (double)P.s5_a_im[pb];
        float a16r, a16i, Ar, Ai; cpow_m(a, w, dt, 16, a16r, a16i); cpow_m(a, w, dt, 1024, Ar, Ai);
        const int kk0 = dir ? 511 - 64 * wid : 64 * wid; const long sstep = dir ? -1 : 1;
        const float* zp = Z + ((size_t)g * 4096 + b * 512 + kk0) * 256 + dir * 128 + 2 * lane;
        f32x2 z[64];
#pragma unroll
        for (int i = 0; i < 64; ++i) { z[i] = *(const f32x2*)zp; zp += sstep * 256; }
        float xr = 0.f, xi = 0.f;
#pragma unroll
        for (int i = 0; i < 64; ++i) { const float nr = a16r * xr - a16i * xi + z[i].x, ni = a16r * xi + a16i * xr + z[i].y; xr = nr; xi = ni; }
        __syncthreads();
        E[(wid * 64 + lane) * 2] = xr; E[(wid * 64 + lane) * 2 + 1] = xi;
        __syncthreads();
        float sr = 0.f, si = 0.f;
#pragma unroll
        for (int s2 = 0; s2 < 7; ++s2) if (s2 < wid) { const float er = E[(s2 * 64 + lane) * 2], ei = E[(s2 * 64 + lane) * 2 + 1]; const float nr = Ar * sr - Ai * si + er, ni = Ar * si + Ai * sr + ei; sr = nr; si = ni; }
        bf16_t* up = ux + ((size_t)g * 4096 + b * 512 + kk0) * 512 + 256 + dir * 128 + 2 * lane;
#pragma unroll
        for (int i = 0; i < 64; ++i) { *(unsigned*)up = pk2(sr, si); up += sstep * 512;
            const float nr = a16r * sr - a16i * si + z[i].x, ni = a16r * si + a16i * sr + z[i].y; sr = nr; si = ni; }
    }
    __syncthreads();
}
struct EpiF32N {
    static constexpr int VMOPS = 32;
    float* z; int ldz;
    DEVI void operator()(const f32x4 (&acc)[2][2][4][2], const Unit& u, int wr, int wc, int fr, int fq) const {
#pragma unroll
        for (int ai = 0; ai < 2; ++ai)
#pragma unroll
            for (int m = 0; m < 4; ++m) { const size_t ro = (size_t)(u.pm * 256 + 128 * ai + 64 * wr + 16 * m + fr) * ldz + u.pn * 256 + 32 * wc + 4 * fq;
#pragma unroll
                for (int bj = 0; bj < 2; ++bj)
#pragma unroll
                    for (int n = 0; n < 2; ++n) *(f32x4*)(z + ro + 128 * bj + 16 * n) = acc[ai][bj][m][n]; }
    }
};
struct EpiS5Out {
    static constexpr int VMOPS = 16;
    bf16_t* G;
    DEVI void operator()(const f32x4 (&acc)[2][2][4][2], const Unit& u, int wr, int wc, int fr, int fq) const {
#pragma unroll
        for (int ai = 0; ai < 2; ++ai)
#pragma unroll
            for (int m = 0; m < 4; ++m) { const int R = u.pm * 256 + 128 * ai + 64 * wr + 16 * m + fr, g = R >> 12, ck = R & 4095;
#pragma unroll
                for (int bj = 0; bj < 2; ++bj) { const int t = 8 * bj + 2 * wc + (fq >> 1), c0 = 8 * (fq & 1);
                    const f32x4 v0 = acc[ai][bj][m][0], v1 = acc[ai][bj][m][1];
                    u32x4 w; w.x = pk2(gelu_tanh(v0.x), gelu_tanh(v0.y)); w.y = pk2(gelu_tanh(v0.z), gelu_tanh(v0.w)); w.z = pk2(gelu_tanh(v1.x), gelu_tanh(v1.y)); w.w = pk2(gelu_tanh(v1.z), gelu_tanh(v1.w));
                    *(u32x4*)(G + ((size_t)ck * 16 + t) * 256 + g * 16 + c0) = w; } }
    }
};
#define XB_TMO      128
#define XB_XCNT(j)  (256  + 64 * (j))
#define XB_XSUB(j)  (1280 + 64 * (j))
#define XB_XGEN(j)  (2304 + 64 * (j))
#define XB_TOP      3328
#define XB_TOPGEN   3392
#define XCD_BAR_WORDS 3456
#define XB_SPIN_CAP (1u << 26)
DEVI unsigned xb_ld(unsigned* p)              { return __hip_atomic_load(p, __ATOMIC_RELAXED, __HIP_MEMORY_SCOPE_AGENT); }
DEVI unsigned xb_add(unsigned* p, unsigned v) { return __hip_atomic_fetch_add(p, v, __ATOMIC_RELAXED, __HIP_MEMORY_SCOPE_AGENT); }
DEVI unsigned xb_xcc_id() { return (unsigned)__builtin_amdgcn_s_getreg((3 << 11) | 20) & 0xFu; }
#define XB_SPIN(cond, bar) do { unsigned _sp = 0; while (cond) { __builtin_amdgcn_s_sleep(1); \
    if ((++_sp & 255u) == 0u) { if (xb_ld(&(bar)[XB_TMO])) break; if (_sp > XB_SPIN_CAP) { atomicAdd(&(bar)[XB_TMO], 1u); break; } } } } while (0)
struct XcdBarrier { unsigned* bar; unsigned x; volatile LAS unsigned* st; };
DEVI XcdBarrier xcd_barrier_post(unsigned* bar, volatile LAS unsigned* st) {
    XcdBarrier b; b.bar = bar; b.x = xb_xcc_id(); b.st = st;
    if (threadIdx.x == 0) (void)xb_add(&bar[XB_XCNT(b.x)], 1u);
    return b;
}
DEVI void xcd_barrier_complete(unsigned* bar, unsigned x, unsigned& nloc, unsigned& nx) {
    const unsigned G = gridDim.x * gridDim.y * gridDim.z;
    unsigned sum, cnt, mine, sp = 0u;
    for (;;) {
        sum = 0u; cnt = 0u; mine = 0u;
#pragma unroll
        for (unsigned j = 0; j < 16; ++j) { const unsigned c = xb_ld(&bar[XB_XCNT(j)]); sum += c; cnt += (c > 0u) ? 1u : 0u; mine = (j == x) ? c : mine; }
        if (sum == G) break;
        __builtin_amdgcn_s_sleep(1);
        if ((++sp & 255u) == 0u) { if (xb_ld(&bar[XB_TMO])) break; if (sp > XB_SPIN_CAP) { atomicAdd(&bar[XB_TMO], 1u); break; } }
    }
    nloc = mine > 0u ? mine : 1u; nx = cnt > 0u ? cnt : 1u;
}
DEVI void xcd_barrier(const XcdBarrier& b) {
    asm volatile("s_waitcnt vmcnt(0)" ::: "memory");
    __syncthreads();
    if (threadIdx.x == 0) {
        unsigned long long bp_ = (unsigned long long)b.bar; asm volatile("" : "+s"(bp_));
        unsigned* bar = (unsigned*)bp_;
        const unsigned bx = xb_xcc_id();
        __builtin_amdgcn_s_waitcnt(0);
        unsigned nloc = b.st[0], nx = b.st[1];
        if (nloc == 0u) { xcd_barrier_complete(bar, bx, nloc, nx); b.st[0] = nloc; b.st[1] = nx; }
        const unsigned old = xb_add(&bar[XB_XSUB(bx)], 1u);
        const unsigned gen = old / nloc;
        if (old + 1u == (gen + 1u) * nloc) {
            __builtin_amdgcn_fence(__ATOMIC_RELEASE, "agent");
            asm volatile("s_waitcnt vmcnt(0)" ::: "memory");
            const unsigned og = xb_add(&bar[XB_TOP], 1u);
            const unsigned tg = og / nx;
            if (og + 1u == (tg + 1u) * nx) xb_add(&bar[XB_TOPGEN], 1u);
            else XB_SPIN(xb_ld(&bar[XB_TOPGEN]) == tg, bar);
            __builtin_amdgcn_fence(__ATOMIC_ACQUIRE, "agent");
            xb_add(&bar[XB_XGEN(bx)], 1u);
            asm volatile("s_waitcnt vmcnt(0)" ::: "memory");
        } else {
            XB_SPIN(xb_ld(&bar[XB_XGEN(bx)]) == gen, bar);
            __builtin_amdgcn_fence(__ATOMIC_ACQUIRE, "agent");
            asm volatile("s_waitcnt vmcnt(0)" ::: "memory");
        }
    }
    __syncthreads();
}

#ifndef MEGA
#define MEGA 1
#endif
#ifndef USE_ENGINE
#define USE_ENGINE 1
#endif
constexpr int LDS_BYTES = 147456 + 8192 + 16;
#if USE_ENGINE
#define GEMM_RUN(g, E) gemm_engine<decltype(E), true, true>((LAS unsigned char*)dyn_lds, g, E, bid, nblk)
#else
#define GEMM_RUN(g, E) gemm_simple(g, E, bid, nblk)
#endif
extern __shared__ __attribute__((aligned(16))) unsigned char dyn_lds[];

DEVI GemmD mk_gemm(const bf16_t* A, const bf16_t* Bt, int lda, int K, int nM, int nN, const int* rowidx, size_t bstride, int pmg) {
    GemmD g; g.A = A; g.Bt = Bt; g.lda = lda; g.K = K; g.nM = nM; g.nN = nN; g.rowidx = rowidx; g.bstride = bstride; g.pmg = pmg; return g; }

DEVI void ph_win(const Params& P, int l, int bid, int nblk) {
    const GemmD g = mk_gemm((const bf16_t*)(P.ws + WS_H), (const bf16_t*)(P.ws + WS_WINT) + (size_t)l * kINW * kD, kD, kD, kTok / 256, 10, nullptr, 0, 1 << 30);
    unsigned char* r1 = P.ws + WS_R1;
    EpiQKV E; E.qa = (bf16_t*)(r1 + R1_QA); E.ka = (bf16_t*)(r1 + R1_KA); E.va = (bf16_t*)(r1 + R1_VA); E.qb = (bf16_t*)(r1 + R1_QB); E.kb = (bf16_t*)(r1 + R1_KB); E.vb = (bf16_t*)(r1 + R1_VB); E.ux = (bf16_t*)(r1 + R1_UX);
    E.qna = P.q_norm_a + l * 64; E.kna = P.k_norm_a + l * 64; E.qnb = P.q_norm_b + l * 64; E.knb = P.k_norm_b + l * 64;
    GEMM_RUN(g, E);
}
#ifndef USE_MFMA_ATTN
#define USE_MFMA_ATTN 1
#endif
#ifndef USE_S5_GEMM
#define USE_S5_GEMM 1
#endif
#ifndef PROBE_ATTN
#define PROBE_ATTN 1
#endif
#ifndef PROBE_GU
#define PROBE_GU 1
#endif
#ifndef PROBE_DOWN
#define PROBE_DOWN 1
#endif
#ifndef PROBE_NA
#define PROBE_NA 1
#endif
#ifndef PROBE_MIX
#define PROBE_MIX 1
#endif
#ifndef PROBE_RT
#define PROBE_RT 1
#endif
#ifndef PROBE_TK
#define PROBE_TK 1
#endif
#ifndef PROBE_GUDRY
#define PROBE_GUDRY 0
#endif
#ifndef PROBE_CONV
#define PROBE_CONV 1
#endif
DEVI void ph_dilated(const Params& P, int l, int bid, int nblk) { unsigned char* r1 = P.ws + WS_R1;
#if USE_MFMA_ATTN
    phase_dilated((const bf16_t*)(r1 + R1_QA), (const bf16_t*)(r1 + R1_KA), (const bf16_t*)(r1 + R1_VA), P.q_norm_a + l * 64, P.k_norm_a + l * 64, (bf16_t*)(P.ws + WS_R2), (float*)(P.ws + WS_LSE), (LAS unsigned char*)dyn_lds, bid, nblk);
#else
    phase_dilated_naive((const bf16_t*)(r1 + R1_QA), (const bf16_t*)(r1 + R1_KA), (const bf16_t*)(r1 + R1_VA), (bf16_t*)(P.ws + WS_R2), (float*)(P.ws + WS_LSE), bid, nblk);
#endif
}
DEVI void ph_na(const Params& P, int l, int bid, int nblk) { unsigned char* r1 = P.ws + WS_R1;
#if USE_MFMA_ATTN
    phase_na((const bf16_t*)(r1 + R1_QB), (const bf16_t*)(r1 + R1_KB), (const bf16_t*)(r1 + R1_VB), P.rpb + (size_t)l * 4 * 15 * 31, (bf16_t*)(r1 + R1_OB), (LAS unsigned char*)dyn_lds, bid, nblk);
#else
    phase_na_naive((const bf16_t*)(r1 + R1_QB), (const bf16_t*)(r1 + R1_KB), (const bf16_t*)(r1 + R1_VB), P.rpb + (size_t)l * 4 * 15 * 31, (bf16_t*)(r1 + R1_OB), bid, nblk);
#endif
}
DEVI void ph_s5(const Params& P, int l, unsigned char* lds, int bid, int nblk) { phase_s5_naive(P, l, (const bf16_t*)(P.ws + WS_R1 + R1_UX), (float*)(P.ws + WS_YS), lds, bid, nblk); }
DEVI void ph_s5_prep(const Params& P, unsigned char* lds, int bid, int nblk) { for (int it = bid; it < kL * 16; it += nblk) s5_prep_item(P, it >> 4, it & 15, lds); }
DEVI void ph_s5_state(const Params& P, int l, int bid, int nblk) {
    const GemmD g = mk_gemm((const bf16_t*)(P.ws + WS_R1 + R1_UX), (const bf16_t*)(P.ws + WS_WST) + (size_t)l * 16 * 256 * 256, 512, 256, 256, 1, nullptr, (size_t)256 * 256, 16);
    EpiF32N E; E.z = (float*)(P.ws + WS_R2 + R2_Z); E.ldz = 256;
    GEMM_RUN(g, E);
}
DEVI void ph_s5_scan(const Params& P, int l, unsigned char* lds, int bid, int nblk) { phase_s5_scan(P, l, (const float*)(P.ws + WS_R2 + R2_Z), (bf16_t*)(P.ws + WS_R1 + R1_UX), lds, bid, nblk); }
DEVI void ph_s5_out(const Params& P, int l, int bid, int nblk) {
    const GemmD g = mk_gemm((const bf16_t*)(P.ws + WS_R1 + R1_UX), (const bf16_t*)(P.ws + WS_WSO) + (size_t)l * 16 * 256 * 512, 512, 512, 256, 1, nullptr, (size_t)256 * 512, 16);
    EpiS5Out E; E.G = (bf16_t*)(P.ws + WS_R1 + R1_G);
    GEMM_RUN(g, E);
}
DEVI void ph_s5fin(const Params& P, int l, int bid, int nblk) { phase_s5_finish((const float*)(P.ws + WS_YS), (const bf16_t*)(P.ws + WS_R1 + R1_UX), P.s5_d + l * 256, (bf16_t*)(P.ws + WS_R1 + R1_G), bid, nblk); }
DEVI void ph_glu(const Params& P, int l, int bid, int nblk) {
    const GemmD g = mk_gemm((const bf16_t*)(P.ws + WS_R1 + R1_G), (const bf16_t*)(P.ws + WS_WGLUT) + (size_t)l * 256 * 256, 256, 256, kTok / 256, 1, nullptr, 0, 1 << 30);
    EpiGlu E; E.g = (const bf16_t*)(P.ws + WS_R1 + R1_G); E.oc = (bf16_t*)(P.ws + WS_R1 + R1_OC);
    GEMM_RUN(g, E);
}
DEVI void ph_mixnorm(const Params& P, int l, int bid, int nblk) { unsigned char* r1 = P.ws + WS_R1;
    phase_mixnorm((const bf16_t*)(P.ws + WS_R2), (const float*)(P.ws + WS_LSE), (const bf16_t*)(r1 + R1_OB), (const bf16_t*)(r1 + R1_OC), P.out_norm_a + l * 512, P.out_norm_b + l * 256, P.out_norm_c + l * 256, (bf16_t*)(P.ws + WS_H), bid, nblk); }
DEVI void ph_wout(const Params& P, int l, int bid, int nblk) {
    const GemmD g = mk_gemm((const bf16_t*)(P.ws + WS_H), (const bf16_t*)(P.ws + WS_WOUTT) + (size_t)l * kD * kD, kD, kD, kTok / 256, 4, nullptr, 0, 1 << 30);
    EpiResid E; E.xin = (l == 0) ? P.x : P.out; E.xout = P.out;
    GEMM_RUN(g, E);
}
DEVI void ph_router(const Params& P, int l, unsigned char* lds, int bid, int nblk) { phase_router(P.out, P.ffn_norm + (size_t)l * kD, P.w_router + (size_t)l * kD * kE, (bf16_t*)(P.ws + WS_H), (float*)(P.ws + WS_AFF), lds, bid, nblk); }
DEVI void ph_topk(const Params& P, unsigned char* lds, int bid, int nblk) { phase_topk((const float*)(P.ws + WS_AFF), (int*)(P.ws + WS_IDX), (float*)(P.ws + WS_GATE), (int*)(P.ws + WS_TSLOT), lds, bid, nblk); }
DEVI void ph_gu(const Params& P, int l, int bid, int nblk) {
    const GemmD g = mk_gemm((const bf16_t*)(P.ws + WS_H), (const bf16_t*)(P.ws + WS_WGUT) + (size_t)l * kE * 4096 * kD, kD, kD, 512, 16, (const int*)(P.ws + WS_IDX), (size_t)4096 * kD, 32);
    EpiGU E; E.hid = (bf16_t*)(P.ws + WS_R1);
    GEMM_RUN(g, E);
}
DEVI void ph_gu_dry(const Params& P, int l, int bid, int nblk) {
    const GemmD g = mk_gemm((const bf16_t*)(P.ws + WS_H), (const bf16_t*)(P.ws + WS_WGUT) + (size_t)l * kE * 4096 * kD, kD, kD, 512, 16, (const int*)(P.ws + WS_IDX), (size_t)4096 * kD, 32);
    EpiDry E; E.sink = (float*)(P.ws + WS_YS);
    GEMM_RUN(g, E);
}
DEVI void ph_down(const Params& P, int l, int bid, int nblk) {
    const GemmD g = mk_gemm((const bf16_t*)(P.ws + WS_R1), (const bf16_t*)(P.ws + WS_WDT) + (size_t)l * kE * kD * kFF, kFF, kFF, 512, 4, nullptr, (size_t)kD * kFF, 32);
    EpiDown E; E.y = (bf16_t*)(P.ws + WS_R2); E.gate = (const float*)(P.ws + WS_GATE);
    GEMM_RUN(g, E);
}
DEVI void ph_combine(const Params& P, int l, int bid, int nblk) { phase_combine(P.out, (const bf16_t*)(P.ws + WS_R2), (const int*)(P.ws + WS_TSLOT), (l + 1 < kL) ? P.attn_norm + (size_t)(l + 1) * kD : nullptr, (bf16_t*)(P.ws + WS_H), bid, nblk); }

#if MEGA
__global__ void __launch_bounds__(kNT, 2) mega_fwd(Params P) {
    volatile LAS unsigned* st = (volatile LAS unsigned*)(dyn_lds + LDS_BYTES - 16);
    if (threadIdx.x == 0) { st[0] = 0u; st[1] = 0u; st[2] = 0u; st[3] = 0u; }
    __syncthreads();
    const XcdBarrier bar = xcd_barrier_post((unsigned*)(P.ws + WS_CTL), st);
    const int bid = blockIdx.x, nblk = gridDim.x;
    unsigned char* lds = dyn_lds;
#pragma unroll 1
    for (int rep = 0; rep < PROBE_CONV; ++rep)
    phase_convert(P, lds, lnd(bid), nblk);
#if USE_S5_GEMM
    ph_s5_prep(P, lds, lnd(bid), nblk);
#endif
    phase_norm(P.x, P.attn_norm, (bf16_t*)(P.ws + WS_H), lnd(bid), nblk);
    xcd_barrier(bar);
#pragma unroll 1
    for (int l = 0; l < kL; ++l) {
        ph_win(P, l, lnd(bid), nblk);            xcd_barrier(bar);
#if USE_S5_GEMM
        ph_s5_state(P, l, lnd(bid), nblk);       xcd_barrier(bar);
        ph_s5_scan(P, l, lds, lnd(bid), nblk);
#pragma unroll 1
        for (int rep = 0; rep < PROBE_ATTN; ++rep)
        ph_dilated(P, l, lnd(bid), nblk);
#pragma unroll 1
        for (int rep = 0; rep < PROBE_NA; ++rep)
        ph_na(P, l, lnd(bid), nblk);             xcd_barrier(bar);
        ph_s5_out(P, l, lnd(bid), nblk);         xcd_barrier(bar);
#else
        ph_s5(P, l, lds, lnd(bid), nblk);
        ph_dilated(P, l, lnd(bid), nblk);
        ph_na(P, l, lnd(bid), nblk);             xcd_barrier(bar);
        ph_s5fin(P, l, lnd(bid), nblk);          xcd_barrier(bar);
#endif
        ph_glu(P, l, lnd(bid), nblk);            xcd_barrier(bar);
#pragma unroll 1
        for (int rep = 0; rep < PROBE_MIX; ++rep) {
        ph_mixnorm(P, l, lnd(bid), nblk);        xcd_barrier(bar); }
        ph_wout(P, l, lnd(bid), nblk);           xcd_barrier(bar);
#pragma unroll 1
        for (int rep = 0; rep < PROBE_RT; ++rep) {
        ph_router(P, l, lds, lnd(bid), nblk);    xcd_barrier(bar); }
#pragma unroll 1
        for (int rep = 0; rep < PROBE_TK; ++rep) {
        ph_topk(P, lds, lnd(bid), nblk);         xcd_barrier(bar); }
#pragma unroll 1
        for (int rep = 0; rep < PROBE_GU; ++rep) {
        ph_gu(P, l, lnd(bid), nblk);             xcd_barrier(bar); }
#if PROBE_GUDRY
        ph_gu_dry(P, l, lnd(bid), nblk);         xcd_barrier(bar);
#endif
#pragma unroll 1
        for (int rep = 0; rep < PROBE_DOWN; ++rep) {
        ph_down(P, l, lnd(bid), nblk);           xcd_barrier(bar); }
        ph_combine(P, l, lnd(bid), nblk);        xcd_barrier(bar);
    }
}
#else
#define KB __global__ void __launch_bounds__(kNT, 2)
KB k_convert(Params P) { phase_convert(P, dyn_lds, blockIdx.x, gridDim.x); }
KB k_norm(Params P) { phase_norm(P.x, P.attn_norm, (bf16_t*)(P.ws + WS_H), blockIdx.x, gridDim.x); }
KB k_win(Params P, int l) { ph_win(P, l, blockIdx.x, gridDim.x); }
KB k_dilated(Params P, int l) { ph_dilated(P, l, blockIdx.x, gridDim.x); }
KB k_na(Params P, int l) { ph_na(P, l, blockIdx.x, gridDim.x); }
KB k_s5(Params P, int l) { ph_s5(P, l, dyn_lds, blockIdx.x, gridDim.x); }
KB k_s5fin(Params P, int l) { ph_s5fin(P, l, blockIdx.x, gridDim.x); }
KB k_glu(Params P, int l) { ph_glu(P, l, blockIdx.x, gridDim.x); }
KB k_mixnorm(Params P, int l) { ph_mixnorm(P, l, blockIdx.x, gridDim.x); }
KB k_wout(Params P, int l) { ph_wout(P, l, blockIdx.x, gridDim.x); }
KB k_router(Params P, int l) { ph_router(P, l, dyn_lds, blockIdx.x, gridDim.x); }
KB k_topk(Params P) { ph_topk(P, dyn_lds, blockIdx.x, gridDim.x); }
KB k_gu(Params P, int l) { ph_gu(P, l, blockIdx.x, gridDim.x); }
KB k_down(Params P, int l) { ph_down(P, l, blockIdx.x, gridDim.x); }
KB k_combine(Params P, int l) { ph_combine(P, l, blockIdx.x, gridDim.x); }
#endif

extern "C" void kernel_launch(void* const* d_in, const int* in_sizes, int n_in, void* d_out, int out_size, void* d_ws, size_t ws_size, hipStream_t stream) {
    (void)in_sizes; (void)n_in; (void)out_size;
    if (ws_size < WS_END) { fprintf(stderr, "workspace too small: %zu < %zu\n", ws_size, (size_t)WS_END); return; }
    Params P{};
    const float** pp = (const float**)&P;
    for (int i = 0; i < 26; ++i) pp[i] = (const float*)d_in[i];
    P.out = (float*)d_out; P.ws = (unsigned char*)d_ws;
#if MEGA
    static int grid = 0;
    if (!grid) {
        int dev = 0, cus = 0, per_cu = 0;
        (void)hipGetDevice(&dev);
        (void)hipDeviceGetAttribute(&cus, hipDeviceAttributeMultiprocessorCount, dev);
        (void)hipFuncSetAttribute((const void*)mega_fwd, hipFuncAttributeMaxDynamicSharedMemorySize, LDS_BYTES);
        (void)hipOccupancyMaxActiveBlocksPerMultiprocessor(&per_cu, (const void*)mega_fwd, kNT, LDS_BYTES);
        grid = (per_cu >= 1) ? cus : 0;
        if (!grid) fprintf(stderr, "mega_fwd does not fit a CU\n");
    }
    if (!grid) return;
    (void)hipMemsetAsync(P.ws + WS_CTL, 0, XCD_BAR_WORDS * sizeof(unsigned), stream);
    mega_fwd<<<grid, kNT, LDS_BYTES, stream>>>(P);
#else
    (void)hipFuncSetAttribute((const void*)k_router, hipFuncAttributeMaxDynamicSharedMemorySize, 65536);
    const int G = 1024;
    k_convert<<<G, kNT, 256 * 72 * 2, stream>>>(P);
    k_norm<<<G, kNT, 0, stream>>>(P);
    for (int l = 0; l < kL; ++l) {
        k_win<<<G, kNT, 0, stream>>>(P, l);
        k_dilated<<<G, kNT, 0, stream>>>(P, l);
        k_na<<<G, kNT, 0, stream>>>(P, l);
        k_s5<<<256, kNT, 8 * 128 * 4, stream>>>(P, l);
        k_s5fin<<<G, kNT, 0, stream>>>(P, l);
        k_glu<<<256, kNT, 0, stream>>>(P, l);
        k_mixnorm<<<G, kNT, 0, stream>>>(P, l);
        k_wout<<<G, kNT, 0, stream>>>(P, l);
        k_router<<<512, kNT, 65536, stream>>>(P, l);
        k_topk<<<128, kNT, 4096, stream>>>(P);
        k_gu<<<G, kNT, 0, stream>>>(P, l);
        k_down<<<G, kNT, 0, stream>>>(P, l);
        k_combine<<<G, kNT, 0, stream>>>(P, l);
    }
#endif
}
```

```cpp
#include <hip/hip_runtime.h>
#include <stdint.h>
#include <stdio.h>

#define DEVI __device__ __forceinline__
#define LAS __attribute__((address_space(3)))
typedef unsigned short bf16_t;
typedef short bf16x8 __attribute__((ext_vector_type(8)));
typedef float f32x4 __attribute__((ext_vector_type(4)));
typedef float f32x2 __attribute__((ext_vector_type(2)));
typedef unsigned u32x4 __attribute__((ext_vector_type(4)));
typedef unsigned u32x2 __attribute__((ext_vector_type(2)));

constexpr int kB = 8, kS = 8192, kD = 1024, kL = 4, kTok = kB * kS;
constexpr int kINW = 2560;
constexpr int kE = 16, kCap = 1024, kFF = 2048;
constexpr int kNT = 512;
constexpr float kEps = 1e-6f;

constexpr size_t MiB = 1024ull * 1024ull;
constexpr size_t WS_CTL   = 0;
constexpr size_t WS_WINT  = 1 * MiB;
constexpr size_t WS_WOUTT = WS_WINT + 20 * MiB;
constexpr size_t WS_WGLUT = WS_WOUTT + 8 * MiB;
constexpr size_t WS_WGUT  = WS_WGLUT + 1 * MiB;
constexpr size_t WS_WDT   = WS_WGUT + 512 * MiB;
constexpr size_t WS_H     = WS_WDT + 256 * MiB;
constexpr size_t WS_R1    = WS_H + 128 * MiB;
constexpr size_t WS_R2    = WS_R1 + 512 * MiB;
constexpr size_t WS_AFF   = WS_R2 + 256 * MiB;
constexpr size_t WS_IDX   = WS_AFF + 4 * MiB;
constexpr size_t WS_GATE  = WS_IDX + 1 * MiB;
constexpr size_t WS_TSLOT = WS_GATE + 1 * MiB;
constexpr size_t WS_LSE   = WS_TSLOT + 4 * MiB;
constexpr size_t WS_WST   = WS_LSE + 8 * MiB;
constexpr size_t WS_WSO   = WS_WST + 8 * MiB;
constexpr size_t WS_YS    = WS_WSO + 16 * MiB;
constexpr size_t WS_END   = WS_YS + 128 * MiB;
constexpr size_t R2_Z     = 192 * MiB;
constexpr size_t R1_QA = 0, R1_KA = 64 * MiB, R1_VA = 128 * MiB, R1_QB = 192 * MiB, R1_KB = 224 * MiB, R1_VB = 256 * MiB,
                 R1_UX = 288 * MiB, R1_OB = 352 * MiB, R1_OC = 384 * MiB, R1_G = 416 * MiB;

struct Params {
    const float* x; const float* attn_norm; const float* w_in; const float* q_norm_a; const float* k_norm_a; const float* q_norm_b; const float* k_norm_b;
    const float* rpb; const float* s5_a_re; const float* s5_a_im; const float* s5_log_dt; const float* s5_b_re; const float* s5_b_im; const float* s5_c_re; const float* s5_c_im;
    const float* s5_d; const float* w_glu; const float* out_norm_a; const float* out_norm_b; const float* out_norm_c; const float* w_out; const float* ffn_norm;
    const float* w_router; const float* w_gate; const float* w_up; const float* w_down;
    float* out; unsigned char* ws;
};

DEVI float bf2f(bf16_t b) { return __uint_as_float(((unsigned)b) << 16); }
DEVI bf16_t f2bf(float f) { unsigned u = __float_as_uint(f); u += 0x7FFFu + ((u >> 16) & 1u); return (bf16_t)(u >> 16); }
typedef __bf16 bf16x2_t __attribute__((ext_vector_type(2)));
DEVI unsigned pk2(float lo, float hi) { const f32x2 v = {lo, hi}; return __builtin_bit_cast(unsigned, __builtin_convertvector(v, bf16x2_t)); }
DEVI int tidx() { int t = threadIdx.x; asm volatile("" : "+v"(t)); return t; }
DEVI int lnd(int v) { asm volatile("" : "+s"(v)); return v; }
DEVI float wave_sum(float v) {
#pragma unroll
    for (int m = 32; m >= 1; m >>= 1) v += __shfl_xor(v, m);
    return v;
}
DEVI float frcp(float x) { return __builtin_amdgcn_rcpf(x); }
DEVI float gelu_tanh(float y) { const float z = 0.7978845608028654f * (y + 0.044715f * y * y * y); const float t = 1.f - 2.f * frcp(1.f + __expf(2.f * z)); return 0.5f * y * (1.f + t); }

DEVI int cmap_head(int cs) { const int bj = cs >> 7, wc = (cs >> 5) & 3, n = (cs >> 4) & 1, fq = (cs >> 2) & 3, j = cs & 3; return 64 * wc + 32 * bj + 8 * fq + 4 * n + j; }
DEVI int cmap_pk(int cs)   { const int bj = cs >> 7, wc = (cs >> 5) & 3, n = (cs >> 4) & 1, fq = (cs >> 2) & 3, j = cs & 3; return 128 * bj + 32 * wc + 8 * fq + 4 * n + j; }
DEVI int cmap_gu(int cs)   { const int wc = (cs >> 5) & 3, n = (cs >> 4) & 1, fq = (cs >> 2) & 3, j = cs & 3; return 32 * wc + 8 * fq + 4 * n + j; }

template <int MODE>
DEVI void convert_item(const float* W0, const float* W1, int ldw, int K, bf16_t* Bt, int kt, int pn, unsigned char* lds) {
    bf16_t* t = (bf16_t*)lds;
    const int tid = tidx();
#pragma unroll 4
    for (int it = 0; it < 32; ++it) {
        const int e = it * kNT + tid, k = e >> 8, cs = e & 255;
        float v;
        if (MODE == 0) v = W0[(size_t)(kt * 64 + k) * ldw + pn * 256 + cs];
        else if (MODE == 1) v = W0[(size_t)(kt * 64 + k) * ldw + pn * 256 + cmap_head(cs)];
        else if (MODE == 2) v = W0[(size_t)(kt * 64 + k) * ldw + pn * 256 + cmap_pk(cs)];
        else v = ((cs >> 7) ? W1 : W0)[(size_t)(kt * 64 + k) * ldw + pn * 128 + cmap_gu(cs)];
        t[cs * 72 + k] = f2bf(v);
    }
    __syncthreads();
#pragma unroll
    for (int it = 0; it < 4; ++it) {
        const int c = it * kNT + tid, row = c >> 3, part = c & 7;
        const u32x4 v = *(const u32x4*)(t + row * 72 + part * 8);
        *(u32x4*)(Bt + (size_t)(pn * 256 + row) * K + kt * 64 + part * 8) = v;
    }
    __syncthreads();
}

DEVI void phase_convert(const Params& P, unsigned char* lds, int bid, int nblk) {
    constexpr int N_WIN = kL * 16 * 10, N_WOUT = kL * 16 * 4, N_WGLU = kL * 4 * 1, N_WGU = kL * kE * 16 * 16, N_WD = kL * kE * 32 * 4;
    constexpr int TOT = N_WIN + N_WOUT + N_WGLU + N_WGU + N_WD;
    for (int it = bid; it < TOT; it += nblk) {
        int i = it;
        if (i < N_WIN) { const int l = i / 160, r = i % 160, kt = r / 10, pn = r % 10;
            convert_item<1>(P.w_in + (size_t)l * kD * kINW, nullptr, kINW, kD, (bf16_t*)(P.ws + WS_WINT) + (size_t)l * kINW * kD, kt, pn, lds); continue; }
        i -= N_WIN;
        if (i < N_WOUT) { const int l = i / 64, r = i % 64, kt = r / 4, pn = r % 4;
            convert_item<0>(P.w_out + (size_t)l * kD * kD, nullptr, kD, kD, (bf16_t*)(P.ws + WS_WOUTT) + (size_t)l * kD * kD, kt, pn, lds); continue; }
        i -= N_WOUT;
        if (i < N_WGLU) { const int l = i / 4, kt = i % 4;
            convert_item<2>(P.w_glu + (size_t)l * 256 * 256, nullptr, 256, 256, (bf16_t*)(P.ws + WS_WGLUT) + (size_t)l * 256 * 256, kt, 0, lds); continue; }
        i -= N_WGLU;
        if (i < N_WGU) { const int le = i / 256, r = i % 256, kt = r / 16, pn = r % 16;
            convert_item<3>(P.w_gate + (size_t)le * kD * kFF, P.w_up + (size_t)le * kD * kFF, kFF, kD, (bf16_t*)(P.ws + WS_WGUT) + (size_t)le * 4096 * kD, kt, pn, lds); continue; }
        i -= N_WGU;
        { const int le = i / 128, r = i % 128, kt = r / 4, pn = r % 4;
            convert_item<2>(P.w_down + (size_t)le * kFF * kD, nullptr, kD, kFF, (bf16_t*)(P.ws + WS_WDT) + (size_t)le * kD * kFF, kt, pn, lds); }
    }
}

DEVI void phase_norm(const float* x, const float* gain, bf16_t* h, int bid, int nblk) {
    const int wid = tidx() >> 6, lane = tidx() & 63;
    f32x4 g[4];
#pragma unroll
    for (int q = 0; q < 4; ++q) g[q] = *(const f32x4*)(gain + q * 256 + lane * 4);
    for (int row = bid * 8 + wid; row < kTok; row += nblk * 8) {
        f32x4 v[4]; float ss = 0.f;
#pragma unroll
        for (int q = 0; q < 4; ++q) { v[q] = *(const f32x4*)(x + (size_t)row * kD + q * 256 + lane * 4); ss += v[q].x * v[q].x + v[q].y * v[q].y + v[q].z * v[q].z + v[q].w * v[q].w; }
        ss = wave_sum(ss);
        const float rstd = rsqrtf(ss * (1.f / kD) + kEps);
#pragma unroll
        for (int q = 0; q < 4; ++q) { u32x2 o; o.x = pk2(v[q].x * rstd * g[q].x, v[q].y * rstd * g[q].y); o.y = pk2(v[q].z * rstd * g[q].z, v[q].w * rstd * g[q].w);
            *(u32x2*)(h + (size_t)row * kD + q * 256 + lane * 4) = o; }
    }
}

DEVI void phase_router(const float* x, const float* gain, const float* wr  , bf16_t* h, float* aff, unsigned char* lds, int bid, int nblk) {
    float* wT = (float*)lds;
    for (int i = tidx(); i < 16 * 1024; i += kNT) { const int k = i >> 4, e = i & 15; wT[e * 1024 + k] = wr[i]; }
    __syncthreads();
    const int wid = tidx() >> 6, lane = tidx() & 63;
    f32x4 g[4];
#pragma unroll
    for (int q = 0; q < 4; ++q) g[q] = *(const f32x4*)(gain + q * 256 + lane * 4);
    f32x4 nvx[2][4];
    { const int r0 = (bid * 8 + wid) * 2;
      if (r0 < kTok) {
#pragma unroll
        for (int r = 0; r < 2; ++r)
#pragma unroll
            for (int q = 0; q < 4; ++q) nvx[r][q] = *(const f32x4*)(x + (size_t)(r0 + r) * kD + q * 256 + lane * 4); } }
    for (int row0 = (bid * 8 + wid) * 2; row0 < kTok; row0 += nblk * 8 * 2) {
        asm volatile("" ::: "memory");
        f32x4 v[2][4];
#pragma unroll
        for (int r = 0; r < 2; ++r)
#pragma unroll
            for (int q = 0; q < 4; ++q) v[r][q] = nvx[r][q];
        { const int nr0 = row0 + nblk * 8 * 2;
          if (nr0 < kTok) {
#pragma unroll
            for (int r = 0; r < 2; ++r)
#pragma unroll
                for (int q = 0; q < 4; ++q) nvx[r][q] = *(const f32x4*)(x + (size_t)(nr0 + r) * kD + q * 256 + lane * 4); } }
#pragma unroll
        for (int r = 0; r < 2; ++r) { float ss = 0.f;
#pragma unroll
            for (int q = 0; q < 4; ++q) { ss += v[r][q].x * v[r][q].x + v[r][q].y * v[r][q].y + v[r][q].z * v[r][q].z + v[r][q].w * v[r][q].w; }
            ss = wave_sum(ss); const float rstd = rsqrtf(ss * (1.f / kD) + kEps);
#pragma unroll
            for (int q = 0; q < 4; ++q) { v[r][q] = v[r][q] * rstd * g[q];
                u32x2 o; o.x = pk2(v[r][q].x, v[r][q].y); o.y = pk2(v[r][q].z, v[r][q].w);
                *(u32x2*)(h + (size_t)(row0 + r) * kD + q * 256 + lane * 4) = o; }
        }
        float pa[32];
#pragma unroll
        for (int e = 0; e < 16; ++e) {
            float s0 = 0.f, s1 = 0.f;
#pragma unroll
            for (int q = 0; q < 4; ++q) { const f32x4 w = *(const f32x4*)(wT + e * 1024 + q * 256 + lane * 4);
                s0 += v[0][q].x * w.x + v[0][q].y * w.y + v[0][q].z * w.z + v[0][q].w * w.w;
                s1 += v[1][q].x * w.x + v[1][q].y * w.y + v[1][q].z * w.z + v[1][q].w * w.w; }
            pa[e] = s0; pa[16 + e] = s1;
        }
#define RS_STEP(HALF, MASK) { const bool up = (lane & (MASK)) != 0; _Pragma("unroll") for (int i = 0; i < (HALF); ++i) { const float keep = up ? pa[i + (HALF)] : pa[i], send = up ? pa[i] : pa[i + (HALF)]; pa[i] = keep + __shfl_xor(send, (MASK)); } }
        RS_STEP(16, 32) RS_STEP(8, 16) RS_STEP(4, 8) RS_STEP(2, 4) RS_STEP(1, 2)
#undef RS_STEP
        const float logit = pa[0] + __shfl_xor(pa[0], 1);
        float mx = logit;
#pragma unroll
        for (int m = 16; m >= 2; m >>= 1) mx = fmaxf(mx, __shfl_xor(mx, m));
        const float ex = __expf(logit - mx);
        float sm = ex;
#pragma unroll
        for (int m = 16; m >= 2; m >>= 1) sm += __shfl_xor(sm, m);
        const int row = row0 + (lane >> 5), e = (lane >> 1) & 15, b = row >> 13, s = row & (kS - 1);
        if (!(lane & 1)) aff[((size_t)(b * kE + e)) * kS + s] = ex * frcp(sm);
    }
    __syncthreads();
}

DEVI int block_excl_scan(int v, int* sh  , int& total) {
    const int lane = tidx() & 63, wid = tidx() >> 6;
    int incl = v;
#pragma unroll
    for (int d = 1; d < 64; d <<= 1) { const int o = __shfl_up(incl, d); if (lane >= d) incl += o; }
    __syncthreads();
    if (lane == 63) sh[wid] = incl;
    __syncthreads();
    int base = 0, tot = 0;
#pragma unroll
    for (int w = 0; w < 8; ++w) { const int c = sh[w]; if (w < wid) base += c; tot += c; }
    total = tot;
    return base + incl - v;
}

DEVI void phase_topk(const float* aff, int* idx, float* gate, int* tokslot, unsigned char* lds, int bid, int nblk) {
    int* hist = (int*)lds;
    int* sh = hist + 256;
    int* res = sh + 16;
    const int tid = tidx(), lane = tid & 63, wid = tid >> 6;
    for (int item = bid; item < kB * kE; item += nblk) {
        const int b = item >> 4, e = item & 15;
        const float* a = aff + (size_t)item * kS;
        unsigned key[16];
#pragma unroll
        for (int q = 0; q < 4; ++q) { const u32x4 v = *(const u32x4*)(a + tid * 16 + q * 4); key[q * 4 + 0] = v.x; key[q * 4 + 1] = v.y; key[q * 4 + 2] = v.z; key[q * 4 + 3] = v.w; }
        unsigned prefix = 0; int kk = kCap;
#pragma unroll 1
        for (int pass = 0; pass < 4; ++pass) {
            const int shift = 24 - 8 * pass;
            __syncthreads();
            if (tid < 256) hist[tid] = 0;
            __syncthreads();
#pragma unroll
            for (int i = 0; i < 16; ++i) { const bool in = (pass == 0) || ((key[i] >> (shift + 8)) == prefix); if (in) atomicAdd(&hist[(key[i] >> shift) & 255], 1); }
            __syncthreads();
            if (wid == 0) {
                int c[4], loc = 0;
#pragma unroll
                for (int j = 0; j < 4; ++j) { c[j] = hist[255 - 4 * lane - j]; loc += c[j]; }
                int incl = loc;
#pragma unroll
                for (int d = 1; d < 64; d <<= 1) { const int o = __shfl_up(incl, d); if (lane >= d) incl += o; }
                const int excl = incl - loc;
                if (excl < kk && kk <= incl) { int run = excl; int bin = 0, nk = 0; bool found = false;
#pragma unroll
                    for (int j = 0; j < 4; ++j) { if (!found && run + c[j] >= kk) { bin = 255 - 4 * lane - j; nk = kk - run; found = true; } if (!found) run += c[j]; }
                    res[0] = bin; res[1] = nk; }
            }
            __syncthreads();
            prefix = (prefix << 8) | (unsigned)res[0]; kk = res[1];
        }
        const unsigned T = prefix;
        int ceq = 0;
#pragma unroll
        for (int i = 0; i < 16; ++i) ceq += (key[i] == T) ? 1 : 0;
        int tot;
        int eqb = block_excl_scan(ceq, sh, tot);
        int csel = 0; unsigned selmask = 0;
#pragma unroll
        for (int i = 0; i < 16; ++i) { bool s = key[i] > T; if (key[i] == T) { s = eqb < kk; ++eqb; } if (s) { selmask |= 1u << i; ++csel; } }
        int slot = block_excl_scan(csel, sh, tot);
        const size_t rbase = (size_t)(e * kB + b) * kCap;
#pragma unroll
        for (int i = 0; i < 16; ++i) { const int s = tid * 16 + i; const bool sel = (selmask >> i) & 1u;
            if (sel) { idx[rbase + slot] = b * kS + s; gate[rbase + slot] = __uint_as_float(key[i]); }
            tokslot[((size_t)(b * kS + s)) * kE + e] = sel ? slot : -1;
            if (sel) ++slot; }
    }
    __syncthreads();
}

struct Unit { int pm, pn; };
DEVI bool unit_of(int Lid, int nM, int nN, Unit& u) {
    const int nwg = nM * nN; if (Lid >= nwg) return false;
    int wgid = Lid; { const int q = nwg / 8, r = nwg % 8, xcd = wgid % 8, off = wgid / 8; wgid = (xcd < r ? xcd * (q + 1) : r * (q + 1) + (xcd - r) * q) + off; }
    const int nig = 8 * nN, gid = wgid / nig, fm = gid * 8, gsz = (nM - fm) < 8 ? (nM - fm) : 8;
    u.pm = fm + ((wgid % nig) % gsz); u.pn = (wgid % nig) / gsz; return true;
}
struct GemmD { const bf16_t* A; const bf16_t* Bt; int lda, K, nM, nN; const int* rowidx; size_t bstride; int pmg; };

template <class Epi>
DEVI void gemm_simple(const GemmD g, const Epi& E, int bid, int nblk) {
    const int tid = tidx(), wid = tid >> 6, lane = tid & 63, wr = wid >> 2, wc = wid & 3, fr = lane & 15, fq = lane >> 4;
    for (int i = 0;; ++i) {
        Unit u; if (!unit_of(i * nblk + bid, g.nM, g.nN, u)) break;
        f32x4 acc[2][2][4][2];
#pragma unroll
        for (int a = 0; a < 2; ++a)
#pragma unroll
            for (int b = 0; b < 2; ++b)
#pragma unroll
                for (int m = 0; m < 4; ++m)
#pragma unroll
                    for (int n = 0; n < 2; ++n) acc[a][b][m][n] = (f32x4){0.f, 0.f, 0.f, 0.f};
        const bf16_t* Bu = g.Bt + (size_t)(u.pm / g.pmg) * g.bstride + (size_t)u.pn * 256 * g.K;
        unsigned ao[2][4], bo[2][2];
#pragma unroll
        for (int a = 0; a < 2; ++a)
#pragma unroll
            for (int m = 0; m < 4; ++m) { const int r = u.pm * 256 + 128 * a + 64 * wr + 16 * m + fr; const unsigned rr = g.rowidx ? (unsigned)g.rowidx[r] : (unsigned)r; ao[a][m] = rr * (unsigned)g.lda + 8u * fq; }
#pragma unroll
        for (int b = 0; b < 2; ++b)
#pragma unroll
            for (int n = 0; n < 2; ++n) bo[b][n] = (unsigned)(128 * b + 32 * wc + 16 * n + fr) * (unsigned)g.K + 8u * fq;
#pragma unroll 1
        for (int k0 = 0; k0 < g.K; k0 += 32) {
            bf16x8 av[2][4], bv[2][2];
#pragma unroll
            for (int a = 0; a < 2; ++a)
#pragma unroll
                for (int m = 0; m < 4; ++m) av[a][m] = *(const bf16x8*)(g.A + ao[a][m] + k0);
#pragma unroll
            for (int b = 0; b < 2; ++b)
#pragma unroll
                for (int n = 0; n < 2; ++n) bv[b][n] = *(const bf16x8*)(Bu + bo[b][n] + k0);
#pragma unroll
            for (int a = 0; a < 2; ++a)
#pragma unroll
                for (int b = 0; b < 2; ++b)
#pragma unroll
                    for (int m = 0; m < 4; ++m)
#pragma unroll
                        for (int n = 0; n < 2; ++n) acc[a][b][m][n] = __builtin_amdgcn_mfma_f32_16x16x32_bf16(bv[b][n], av[a][m], acc[a][b][m][n], 0, 0, 0);
        }
        E(acc, u, wr, wc, fr, fq);
    }
}


constexpr int PG_HTB = 128 * 64 * 2;
DEVI int pg_lds_byte(int r, int c) { const int st = (r >> 4) * 2 + (c >> 5), rr = r & 15, cc = c & 31, ob = rr * 64 + cc * 2; return st * 1024 + (ob ^ (((ob >> 9) & 1) << 5)); }
DEVI void pg_stage_rc(int b, int& R, int& C) { const int st = b / 1024, sb = b % 1024, swz = sb ^ (((sb >> 9) & 1) << 5); R = (st >> 1) * 16 + swz / 64; C = (st & 1) * 32 + (swz % 64) / 2; }

template <class Epi, bool ALIGN_EPI, bool SP2>
DEVI void gemm_engine(LAS unsigned char* lds, const GemmD g, const Epi& E, int bid, int nblk) {
    const int tid = tidx(), wid = __builtin_amdgcn_readfirstlane(tid >> 6), lane = tid & 63, wr = wid >> 2, wc = wid & 3, fr = lane & 15, fq = lane >> 4;
    const int K = g.K, nt = K / 64;
    int RA[2], CA[2]; unsigned voffB[2];
#pragma unroll
    for (int i = 0; i < 2; ++i) { pg_stage_rc(tid * 16 + i * 8192, RA[i], CA[i]); voffB[i] = (unsigned)(RA[i] * K + CA[i]) * 2u; }
    const size_t kstep = 128;
    const size_t hstepB = (size_t)128 * K * 2;
    const unsigned ldsw = (unsigned)wid * 1024u;
    const int aoff = pg_lds_byte(wr * 64 + fr, fq * 8), boff = pg_lds_byte(wc * 32 + fr, fq * 8);
#define PG8_SA(b, h) (((b) * 2 + (h)) * PG_HTB)
#define PG8_SB(b, h) ((4 + (b) * 2 + (h)) * PG_HTB)
#define PG8_STAGE(bufoff, gbase, voff) do { _Pragma("unroll") for (int _i = 0; _i < 2; ++_i) \
        __builtin_amdgcn_global_load_lds((const unsigned*)((const char*)(gbase) + (voff)[_i]), (LAS unsigned*)(lds + (bufoff) + ldsw + _i * 8192), 16, 0, 0); } while (0)
#define PG8_LDA(dst, b, h) do { _Pragma("unroll") for (int m = 0; m < 4; ++m) _Pragma("unroll") for (int k = 0; k < 2; ++k) dst[m][k] = *(const LAS bf16x8*)(lds + PG8_SA(b, h) + aoff + m * 2048 + k * 1024); } while (0)
#define PG8_LDB(dst, b, h) do { _Pragma("unroll") for (int n = 0; n < 2; ++n) _Pragma("unroll") for (int k = 0; k < 2; ++k) dst[n][k] = *(const LAS bf16x8*)(lds + PG8_SB(b, h) + boff + n * 2048 + k * 1024); } while (0)
#define PG8_MMA(ai, bj, At, Bt) do { __builtin_amdgcn_s_setprio(1); _Pragma("unroll") for (int m = 0; m < 4; ++m) _Pragma("unroll") for (int n = 0; n < 2; ++n) _Pragma("unroll") for (int k = 0; k < 2; ++k) \
        acc[ai][bj][m][n] = __builtin_amdgcn_mfma_f32_16x16x32_bf16(Bt[n][k], At[m][k], acc[ai][bj][m][n], 0, 0, 0); __builtin_amdgcn_s_setprio(0); } while (0)
#define PG8_WAIT_V(n) asm volatile("s_waitcnt vmcnt(" #n ")" ::: "memory")
#define PG8_WAIT_L(n) asm volatile("s_waitcnt lgkmcnt(" #n ")" ::: "memory")
#define PG8_BAR __builtin_amdgcn_s_barrier()
#define PG8_SCHED __builtin_amdgcn_sched_barrier(0)
#define PG8_VOFFA(dst, pm_) do { _Pragma("unroll") for (int _h = 0; _h < 2; ++_h) _Pragma("unroll") for (int _i = 0; _i < 2; ++_i) { const int _r = (pm_) * 256 + 128 * _h + RA[_i]; \
        const unsigned _rr = g.rowidx ? (unsigned)g.rowidx[_r] : (unsigned)_r; dst[_h][_i] = (_rr * (unsigned)g.lda + (unsigned)CA[_i]) * 2u; } } while (0)
    Unit cur, nxt, nn; int ui = 0;
    if (!unit_of(bid, g.nM, g.nN, cur)) return;
    f32x4 acc[2][2][4][2];
#pragma unroll
    for (int a = 0; a < 2; ++a)
#pragma unroll
        for (int b = 0; b < 2; ++b)
#pragma unroll
            for (int m = 0; m < 4; ++m)
#pragma unroll
                for (int n = 0; n < 2; ++n) acc[a][b][m][n] = (f32x4){0.f, 0.f, 0.f, 0.f};
    bf16x8 At[4][2], B0[2][2], B1[2][2];
    const char* const A0 = (const char*)g.A;
    const char* cB = (const char*)(g.Bt + (size_t)(cur.pm / g.pmg) * g.bstride + (size_t)cur.pn * 256 * K);
    unsigned cvA[2][2], nvA[2][2];
    PG8_VOFFA(cvA, cur.pm);
    { const bool hn = unit_of(nblk + bid, g.nM, g.nN, nxt); if (hn) PG8_VOFFA(nvA, nxt.pm); else { _Pragma("unroll") for (int h = 0; h < 2; ++h) _Pragma("unroll") for (int i = 0; i < 2; ++i) nvA[h][i] = cvA[h][i]; } }
    if constexpr (SP2) {
        PG8_STAGE(PG8_SB(0, 0), cB, voffB); PG8_STAGE(PG8_SB(0, 1), cB + hstepB, voffB); PG8_STAGE(PG8_SA(0, 0), A0, cvA[0]); PG8_STAGE(PG8_SA(0, 1), A0, cvA[1]);
        if (wr == 1) PG8_BAR;
        PG8_WAIT_V(2); PG8_BAR;
        PG8_STAGE(PG8_SB(1, 0), cB + kstep, voffB); PG8_STAGE(PG8_SA(1, 0), A0 + kstep, cvA[0]); PG8_STAGE(PG8_SB(1, 1), cB + hstepB + kstep, voffB);
        PG8_WAIT_V(6); PG8_BAR;
    } else {
        PG8_STAGE(PG8_SB(0, 0), cB, voffB); PG8_STAGE(PG8_SA(0, 0), A0, cvA[0]); PG8_STAGE(PG8_SB(0, 1), cB + hstepB, voffB); PG8_STAGE(PG8_SA(0, 1), A0, cvA[1]);
        if (wr == 1) PG8_BAR;
        PG8_WAIT_V(4); PG8_BAR;
        PG8_STAGE(PG8_SB(1, 0), cB + kstep, voffB); PG8_STAGE(PG8_SA(1, 0), A0 + kstep, cvA[0]); PG8_STAGE(PG8_SB(1, 1), cB + hstepB + kstep, voffB);
        PG8_WAIT_V(6); PG8_BAR;
    }
    for (;;) {
        const bool has_next = unit_of((ui + 1) * nblk + bid, g.nM, g.nN, nxt);
        const char* nB = has_next ? (const char*)(g.Bt + (size_t)(nxt.pm / g.pmg) * g.bstride + (size_t)nxt.pn * 256 * K) : cB;
        for (int t = 0; t < nt; t += 2) {
            const bool last = (t == nt - 2);
            const char* a1 = A0 + (size_t)(t + 1) * kstep;
            const char* a2 = last ? A0 : A0 + (size_t)(t + 2) * kstep; const char* b2 = last ? nB : cB + (size_t)(t + 2) * kstep;
            const char* a3 = a2 + kstep; const char* b3 = b2 + kstep;
            unsigned v2[2][2];
#pragma unroll
            for (int h = 0; h < 2; ++h)
#pragma unroll
                for (int i = 0; i < 2; ++i) v2[h][i] = last ? nvA[h][i] : cvA[h][i];
            if constexpr (SP2) {
            PG8_LDB(B0, 0, 0); PG8_LDB(B1, 0, 1); PG8_SCHED; PG8_LDA(At, 0, 0); PG8_STAGE(PG8_SA(1, 1), a1, cvA[1]);
            PG8_WAIT_V(8); PG8_WAIT_L(0); PG8_BAR; PG8_MMA(0, 0, At, B0); PG8_MMA(0, 1, At, B1); PG8_BAR; PG8_SCHED;
            PG8_LDA(At, 0, 1); PG8_STAGE(PG8_SB(0, 0), b2, voffB); PG8_STAGE(PG8_SB(0, 1), b2 + hstepB, voffB); PG8_STAGE(PG8_SA(0, 0), a2, v2[0]);
            PG8_WAIT_V(8); PG8_WAIT_L(0); PG8_BAR; PG8_MMA(1, 0, At, B0); PG8_MMA(1, 1, At, B1); PG8_BAR; PG8_SCHED;
            PG8_LDB(B0, 1, 0); PG8_LDB(B1, 1, 1); PG8_SCHED; PG8_LDA(At, 1, 0); PG8_STAGE(PG8_SA(0, 1), a2, v2[1]);
            PG8_WAIT_V(8); PG8_WAIT_L(0); PG8_BAR; PG8_MMA(0, 0, At, B0); PG8_MMA(0, 1, At, B1); PG8_BAR; PG8_SCHED;
            PG8_LDA(At, 1, 1); PG8_STAGE(PG8_SB(1, 0), b3, voffB); PG8_STAGE(PG8_SB(1, 1), b3 + hstepB, voffB); PG8_STAGE(PG8_SA(1, 0), a3, v2[0]);
            PG8_WAIT_V(8); PG8_WAIT_L(0); PG8_BAR; PG8_MMA(1, 0, At, B0); PG8_MMA(1, 1, At, B1); PG8_BAR; PG8_SCHED;
            } else {
            PG8_LDB(B0, 0, 0); PG8_SCHED; PG8_LDA(At, 0, 0); PG8_STAGE(PG8_SA(1, 1), a1, cvA[1]);
            PG8_WAIT_L(8); PG8_BAR; PG8_WAIT_L(0); PG8_MMA(0, 0, At, B0); PG8_BAR; PG8_SCHED;
            PG8_LDB(B1, 0, 1); PG8_STAGE(PG8_SB(0, 0), b2, voffB);
            PG8_BAR; PG8_WAIT_L(0); PG8_MMA(0, 1, At, B1); PG8_BAR;
            PG8_LDA(At, 0, 1); PG8_STAGE(PG8_SA(0, 0), a2, v2[0]);
            PG8_BAR; PG8_WAIT_L(0); PG8_MMA(1, 0, At, B0); PG8_BAR; PG8_SCHED;
            PG8_STAGE(PG8_SB(0, 1), b2 + hstepB, voffB);
            PG8_WAIT_V(6); PG8_BAR; PG8_MMA(1, 1, At, B1); PG8_BAR;
            PG8_LDB(B0, 1, 0); PG8_SCHED; PG8_LDA(At, 1, 0); PG8_STAGE(PG8_SA(0, 1), a2, v2[1]);
            PG8_WAIT_L(8); PG8_BAR; PG8_WAIT_L(0); PG8_MMA(0, 0, At, B0); PG8_BAR; PG8_SCHED;
            PG8_LDB(B1, 1, 1); PG8_STAGE(PG8_SB(1, 0), b3, voffB);
            PG8_BAR; PG8_WAIT_L(0); PG8_MMA(0, 1, At, B1); PG8_BAR;
            PG8_LDA(At, 1, 1); PG8_STAGE(PG8_SA(1, 0), a3, v2[0]);
            PG8_BAR; PG8_WAIT_L(0); PG8_MMA(1, 0, At, B0); PG8_BAR; PG8_SCHED;
            PG8_STAGE(PG8_SB(1, 1), b3 + hstepB, voffB);
            PG8_WAIT_V(6); PG8_BAR; PG8_MMA(1, 1, At, B1); PG8_BAR;
            }
        }
        if constexpr (ALIGN_EPI) { if (wr == 0) PG8_BAR; }
        const bool has_nn = has_next && unit_of((ui + 2) * nblk + bid, g.nM, g.nN, nn);
        int ridx[2][2];
        if (g.rowidx && has_nn) {
#pragma unroll
            for (int h = 0; h < 2; ++h)
#pragma unroll
                for (int i = 0; i < 2; ++i) ridx[h][i] = g.rowidx[nn.pm * 256 + 128 * h + RA[i]];
        }
        E(acc, cur, wr, wc, fr, fq);
        if (!has_next) break;
#pragma unroll
        for (int a = 0; a < 2; ++a)
#pragma unroll
            for (int b = 0; b < 2; ++b)
#pragma unroll
                for (int m = 0; m < 4; ++m)
#pragma unroll
                    for (int n = 0; n < 2; ++n) acc[a][b][m][n] = (f32x4){0.f, 0.f, 0.f, 0.f};
        cur = nxt; cB = nB; ++ui;
#pragma unroll
        for (int h = 0; h < 2; ++h)
#pragma unroll
            for (int i = 0; i < 2; ++i) { cvA[h][i] = nvA[h][i];
                if (has_nn) { const unsigned rr = g.rowidx ? (unsigned)ridx[h][i] : (unsigned)(nn.pm * 256 + 128 * h + RA[i]); nvA[h][i] = (rr * (unsigned)g.lda + (unsigned)CA[i]) * 2u; } }
        if constexpr (ALIGN_EPI) { if (wr == 1) PG8_BAR; }
    }
    PG8_WAIT_V(0);
    if constexpr (!ALIGN_EPI) { if (wr == 0) PG8_BAR; }
    PG8_BAR;
#undef PG8_SA
#undef PG8_SB
#undef PG8_STAGE
#undef PG8_LDA
#undef PG8_LDB
#undef PG8_MMA
#undef PG8_WAIT_V
#undef PG8_WAIT_L
#undef PG8_BAR
#undef PG8_SCHED
#undef PG8_VOFFA
}

struct EpiQKV {
    static constexpr int VMOPS = 16;
    bf16_t *qa, *ka, *va, *qb, *kb, *vb, *ux; const float *qna, *kna, *qnb, *knb;
    DEVI void operator()(const f32x4 (&acc)[2][2][4][2], const Unit& u, int wr, int wc, int fr, int fq) const {
        bf16_t* dst; const float* gn = nullptr; int H = 8, head0 = 0; const int pn = u.pn;
        if (pn < 2) { dst = qa; gn = qna; head0 = pn * 4; }
        else if (pn < 4) { dst = ka; gn = kna; head0 = (pn - 2) * 4; }
        else if (pn < 6) { dst = va; head0 = (pn - 4) * 4; }
        else if (pn == 6) { dst = qb; gn = qnb; H = 4; }
        else if (pn == 7) { dst = kb; gn = knb; H = 4; }
        else if (pn == 8) { dst = vb; H = 4; }
        else { dst = ux; }
        const int head = head0 + wc;
        f32x4 gv[2][2];
#pragma unroll
        for (int bj = 0; bj < 2; ++bj)
#pragma unroll
            for (int n = 0; n < 2; ++n) gv[bj][n] = gn ? *(const f32x4*)(gn + 32 * bj + 8 * fq + 4 * n) : (f32x4){1.f, 1.f, 1.f, 1.f};
#pragma unroll
        for (int ai = 0; ai < 2; ++ai)
#pragma unroll
            for (int m = 0; m < 4; ++m) {
                const int row = u.pm * 256 + 128 * ai + 64 * wr + 16 * m + fr;
                float rstd = 1.f;
                if (gn) { float ss = 0.f;
#pragma unroll
                    for (int bj = 0; bj < 2; ++bj)
#pragma unroll
                        for (int n = 0; n < 2; ++n) { const f32x4 v = acc[ai][bj][m][n]; ss += v.x * v.x + v.y * v.y + v.z * v.z + v.w * v.w; }
                    ss += __shfl_xor(ss, 16); ss += __shfl_xor(ss, 32);
                    rstd = rsqrtf(ss * (1.f / 64.f) + kEps); }
#pragma unroll
                for (int bj = 0; bj < 2; ++bj) {
                    const f32x4 v0 = acc[ai][bj][m][0] * rstd * gv[bj][0], v1 = acc[ai][bj][m][1] * rstd * gv[bj][1];
                    u32x4 w; w.x = pk2(v0.x, v0.y); w.y = pk2(v0.z, v0.w); w.z = pk2(v1.x, v1.y); w.w = pk2(v1.z, v1.w);
                    if (pn < 9) { const int b = row >> 13, s = row & (kS - 1);
                        *(u32x4*)(dst + (((size_t)(b * H + head)) * kS + s) * 64 + 32 * bj + 8 * fq) = w; }
                    else { const int gidx = 4 * wc + 2 * bj + (fq >> 1), c0 = 8 * (fq & 1);
                        *(u32x4*)(dst + ((size_t)gidx * 4096 + (row >> 4)) * 512 + (row & 15) * 16 + c0) = w; }
                }
            }
    }
};
struct EpiResid {
    static constexpr int VMOPS = 32;
    const float* xin; float* xout;
    DEVI void operator()(const f32x4 (&acc)[2][2][4][2], const Unit& u, int wr, int wc, int fr, int fq) const {
#pragma unroll
        for (int ai = 0; ai < 2; ++ai)
#pragma unroll
            for (int m = 0; m < 4; ++m) { const size_t ro = (size_t)(u.pm * 256 + 128 * ai + 64 * wr + 16 * m + fr) * kD + u.pn * 256 + 32 * wc + 4 * fq;
#pragma unroll
                for (int bj = 0; bj < 2; ++bj)
#pragma unroll
                    for (int n = 0; n < 2; ++n) { const size_t o = ro + 128 * bj + 16 * n; *(f32x4*)(xout + o) = *(const f32x4*)(xin + o) + acc[ai][bj][m][n]; } }
    }
};
struct EpiGU {
    static constexpr int VMOPS = 8;
    bf16_t* hid;
    DEVI void operator()(const f32x4 (&acc)[2][2][4][2], const Unit& u, int wr, int wc, int fr, int fq) const {
#pragma unroll
        for (int ai = 0; ai < 2; ++ai)
#pragma unroll
            for (int m = 0; m < 4; ++m) { const size_t row = (size_t)(u.pm * 256 + 128 * ai + 64 * wr + 16 * m + fr);
                float o[8];
#pragma unroll
                for (int n = 0; n < 2; ++n)
#pragma unroll
                    for (int j = 0; j < 4; ++j) { const float gt = acc[ai][0][m][n][j], up = acc[ai][1][m][n][j]; o[n * 4 + j] = gt * frcp(1.f + __expf(-gt)) * up; }
                u32x4 w; w.x = pk2(o[0], o[1]); w.y = pk2(o[2], o[3]); w.z = pk2(o[4], o[5]); w.w = pk2(o[6], o[7]);
                *(u32x4*)(hid + row * kFF + u.pn * 128 + 32 * wc + 8 * fq) = w; }
    }
};
struct EpiDry {
    static constexpr int VMOPS = 0;
    float* sink;
    DEVI void operator()(const f32x4 (&acc)[2][2][4][2], const Unit& u, int wr, int wc, int fr, int fq) const {
        float t = 0.f;
#pragma unroll
        for (int ai = 0; ai < 2; ++ai)
#pragma unroll
            for (int bj = 0; bj < 2; ++bj)
#pragma unroll
                for (int m = 0; m < 4; ++m)
#pragma unroll
                    for (int n = 0; n < 2; ++n) t += acc[ai][bj][m][n].x + acc[ai][bj][m][n].y + acc[ai][bj][m][n].z + acc[ai][bj][m][n].w;
        if (t == 1.2345e30f) sink[0] = t;
    }
};
struct EpiDown {
    static constexpr int VMOPS = 16;
    bf16_t* y; const float* gate;
    DEVI void operator()(const f32x4 (&acc)[2][2][4][2], const Unit& u, int wr, int wc, int fr, int fq) const {
#pragma unroll
        for (int ai = 0; ai < 2; ++ai)
#pragma unroll
            for (int m = 0; m < 4; ++m) { const size_t row = (size_t)(u.pm * 256 + 128 * ai + 64 * wr + 16 * m + fr); const float gv = gate[row];
#pragma unroll
                for (int bj = 0; bj < 2; ++bj) { const f32x4 v0 = acc[ai][bj][m][0] * gv, v1 = acc[ai][bj][m][1] * gv;
                    u32x4 w; w.x = pk2(v0.x, v0.y); w.y = pk2(v0.z, v0.w); w.z = pk2(v1.x, v1.y); w.w = pk2(v1.z, v1.w);
                    *(u32x4*)(y + row * kD + u.pn * 256 + 128 * bj + 32 * wc + 8 * fq) = w; } }
    }
};
struct EpiGlu {
    static constexpr int VMOPS = 16;
    const bf16_t* g; bf16_t* oc;
    DEVI void operator()(const f32x4 (&acc)[2][2][4][2], const Unit& u, int wr, int wc, int fr, int fq) const {
#pragma unroll
        for (int ai = 0; ai < 2; ++ai)
#pragma unroll
            for (int m = 0; m < 4; ++m) { const size_t row = (size_t)(u.pm * 256 + 128 * ai + 64 * wr + 16 * m + fr);
#pragma unroll
                for (int bj = 0; bj < 2; ++bj) { const size_t o = row * 256 + 128 * bj + 32 * wc + 8 * fq;
                    const u32x4 gw = *(const u32x4*)(g + o); float o8[8];
#pragma unroll
                    for (int n = 0; n < 2; ++n)
#pragma unroll
                        for (int j = 0; j < 4; ++j) { const int t = n * 4 + j; const unsigned wv = (t < 2) ? gw.x : (t < 4) ? gw.y : (t < 6) ? gw.z : gw.w;
                            const float gg = __uint_as_float((t & 1) ? (wv & 0xFFFF0000u) : (wv << 16)); o8[t] = gg * frcp(1.f + __expf(-acc[ai][bj][m][n][j])); }
                    u32x4 w; w.x = pk2(o8[0], o8[1]); w.y = pk2(o8[2], o8[3]); w.z = pk2(o8[4], o8[5]); w.w = pk2(o8[6], o8[7]);
                    *(u32x4*)(oc + o) = w; } }
    }
};

DEVI void load_row64(const bf16_t* p, float* d) {
#pragma unroll
    for (int i = 0; i < 8; ++i) { const u32x4 v = *(const u32x4*)(p + i * 8);
        d[i * 8 + 0] = __uint_as_float(v.x << 16); d[i * 8 + 1] = __uint_as_float(v.x & 0xFFFF0000u); d[i * 8 + 2] = __uint_as_float(v.y << 16); d[i * 8 + 3] = __uint_as_float(v.y & 0xFFFF0000u);
        d[i * 8 + 4] = __uint_as_float(v.z << 16); d[i * 8 + 5] = __uint_as_float(v.z & 0xFFFF0000u); d[i * 8 + 6] = __uint_as_float(v.w << 16); d[i * 8 + 7] = __uint_as_float(v.w & 0xFFFF0000u); }
}
DEVI void store_row64(bf16_t* p, const float* d, float sc) {
#pragma unroll
    for (int i = 0; i < 8; ++i) { u32x4 w; w.x = pk2(d[i * 8] * sc, d[i * 8 + 1] * sc); w.y = pk2(d[i * 8 + 2] * sc, d[i * 8 + 3] * sc); w.z = pk2(d[i * 8 + 4] * sc, d[i * 8 + 5] * sc); w.w = pk2(d[i * 8 + 6] * sc, d[i * 8 + 7] * sc);
        *(u32x4*)(p + i * 8) = w; }
}
DEVI void phase_dilated_naive(const bf16_t* qa, const bf16_t* ka, const bf16_t* va, bf16_t* oac, float* lse, int bid, int nblk) {
    const int nitems = 3 * kB * 8 * (kS / kNT);
    for (int it = bid; it < nitems; it += nblk) {
        const int c = it / (kB * 8 * 16), r = it % (kB * 8 * 16), bh = r / 16, t = (r % 16) * kNT + tidx(), b = bh >> 3, h = bh & 7;
        const int dil = (c == 0) ? 1 : (c == 1) ? 4 : 16;
        const float slope = exp2f(-(float)(h + 1));
        const bf16_t* kb_ = ka + (size_t)bh * kS * 64; const bf16_t* vb_ = va + (size_t)bh * kS * 64;
        float q[64], o[64];
        load_row64(qa + ((size_t)bh * kS + t) * 64, q);
#pragma unroll
        for (int d = 0; d < 64; ++d) o[d] = 0.f;
        float m = -1e30f, l = 0.f;
        for (int rel = -64; rel <= 64; ++rel) {
            const int pos = t + rel * dil;
            if (pos < 0 || pos >= kS) continue;
            float kv[64]; load_row64(kb_ + (size_t)pos * 64, kv);
            float dot = 0.f;
#pragma unroll
            for (int d = 0; d < 64; ++d) dot += q[d] * kv[d];
            const float sc = dot * 0.125f - slope * (float)(dil * (rel < 0 ? -rel : rel));
            const float mn = fmaxf(m, sc), corr = __expf(m - mn), p = __expf(sc - mn);
            load_row64(vb_ + (size_t)pos * 64, kv);
            l = l * corr + p;
#pragma unroll
            for (int d = 0; d < 64; ++d) o[d] = o[d] * corr + p * kv[d];
            m = mn;
        }
        const size_t tok = (size_t)b * kS + t;
        store_row64(oac + ((size_t)c * kTok + tok) * 512 + h * 64, o, 1.f / l);
        lse[((size_t)c * kTok + tok) * 8 + h] = m + __logf(l);
    }
}
DEVI void phase_na_naive(const bf16_t* qb, const bf16_t* kbuf, const bf16_t* vbuf, const float* rpb  , bf16_t* ob, int bid, int nblk) {
    const int nitems = kB * 4 * (kS / kNT);
    for (int it = bid; it < nitems; it += nblk) {
        const int bh = it / 16, t = (it % 16) * kNT + tidx(), b = bh >> 2, h = bh & 3;
        const int r = t >> 6, cq = t & 63;
        int rs = r - 4; rs = rs < 0 ? 0 : (rs > 120 ? 120 : rs);
        int cs = cq - 8; cs = cs < 0 ? 0 : (cs > 48 ? 48 : cs);
        const bf16_t* kb_ = kbuf + (size_t)bh * kS * 64; const bf16_t* vb_ = vbuf + (size_t)bh * kS * 64;
        float q[64], o[64];
        load_row64(qb + ((size_t)bh * kS + t) * 64, q);
#pragma unroll
        for (int d = 0; d < 64; ++d) o[d] = 0.f;
        float m = -1e30f, l = 0.f;
        for (int kr = 0; kr < 8; ++kr)
            for (int kc = 0; kc < 16; ++kc) {
                const int krow = rs + kr, kcol = cs + kc, pos = krow * 64 + kcol;
                float kv[64]; load_row64(kb_ + (size_t)pos * 64, kv);
                float dot = 0.f;
#pragma unroll
                for (int d = 0; d < 64; ++d) dot += q[d] * kv[d];
                const float sc = dot * 0.125f + rpb[(h * 15 + (krow - r + 7)) * 31 + (kcol - cq + 15)];
                const float mn = fmaxf(m, sc), corr = __expf(m - mn), p = __expf(sc - mn);
                load_row64(vb_ + (size_t)pos * 64, kv);
                l = l * corr + p;
#pragma unroll
                for (int d = 0; d < 64; ++d) o[d] = o[d] * corr + p * kv[d];
                m = mn;
            }
        store_row64(ob + ((size_t)b * kS + t) * 256 + h * 64, o, 1.f / l);
    }
}

typedef float f32x16 __attribute__((ext_vector_type(16)));
typedef short s16x4 __attribute__((ext_vector_type(4)));
constexpr float kLog2e = 1.4426950408889634f, kLn2 = 0.6931471805599453f;
DEVI bf16x8 tr_pair(LAS unsigned char* p0, LAS unsigned char* p1) {
    const s16x4 a = __builtin_amdgcn_ds_read_tr16_b64_v4i16((LAS s16x4*)p0), b = __builtin_amdgcn_ds_read_tr16_b64_v4i16((LAS s16x4*)p1);
    return (bf16x8){a.x, a.y, a.z, a.w, b.x, b.y, b.z, b.w};
}
DEVI void phase_dilated(const bf16_t* qa, const bf16_t* ka, const bf16_t* va, const float* gq, const float* gk, bf16_t* oac, float* lse, LAS unsigned char* lds, int bid, int nblk) {
    const int tid = tidx(), wid = __builtin_amdgcn_readfirstlane(tid >> 6), lane = tid & 63, h5 = lane >> 5, qc = lane & 31;
    LAS unsigned char* Kimg = lds; LAS unsigned char* Vimg = lds + 49152;
    float Mn;
    { float a = fabsf(gq[lane]), b = fabsf(gk[lane]);
#pragma unroll
      for (int m = 32; m >= 1; m >>= 1) { a = fmaxf(a, __shfl_xor(a, m)); b = fmaxf(b, __shfl_xor(b, m)); }
      Mn = 8.f * a * b; }
    const float Mb = Mn * kLog2e;
    unsigned koff[4];
#pragma unroll
    for (int s = 0; s < 4; ++s) koff[s] = (unsigned)((32 * wid + qc) * 128 + (((2 * s + h5) ^ (qc & 7)) << 4));
    unsigned voff[2];
    { const int g = lane >> 4, i16 = lane & 15, q = i16 >> 2, p = i16 & 3;
#pragma unroll
      for (int dt = 0; dt < 2; ++dt) { const int c = (2 * (g & 1) + (p >> 1) + 4 * dt) ^ ((q >> 1) << 2); voff[dt] = (unsigned)((32 * wid + 4 * h5 + q) * 128 + (c << 4) + 8 * (p & 1)); } }
    float dv[16];
#pragma unroll
    for (int i = 0; i < 16; ++i) dv[i] = (float)((i & 3) + 8 * (i >> 2) + 4 * h5 - qc);
    u32x4 pK[6], pV[6]; bf16x8 pQ[4];
#define DIL_DECODE(unit_) const int c = (unit_) >> 11, rem = (unit_) & 2047, bh = rem >> 5, ub = rem & 31; \
        const int dsh = 2 * c, L = kS >> dsh, upc = 32 >> dsh, cls = ub >> (5 - dsh), u0 = (ub & (upc - 1)) << 8;
#define DIL_PREFETCH(unit_) do { DIL_DECODE(unit_) \
        const bf16_t* kbase = ka + (size_t)bh * kS * 64; const bf16_t* vbase = va + (size_t)bh * kS * 64; \
        { const int qtok_ = ((u0 + 32 * wid + qc) << dsh) + cls; _Pragma("unroll") for (int s = 0; s < 4; ++s) pQ[s] = *(const bf16x8*)(qa + ((size_t)bh * kS + qtok_) * 64 + 16 * s + 8 * h5); } \
        _Pragma("unroll") for (int it = 0; it < 6; ++it) { const int id = it * kNT + tid, row = id >> 3, ch = id & 7; \
            int ki = u0 - 64 + row; ki = ki < 0 ? 0 : (ki > L - 1 ? L - 1 : ki); const size_t tok = (size_t)((ki << dsh) + cls); \
            pK[it] = *(const u32x4*)(kbase + tok * 64 + ch * 8); pV[it] = *(const u32x4*)(vbase + tok * 64 + ch * 8); } } while (0)
    if (bid < 6144) DIL_PREFETCH(bid);
    for (int unit = bid; unit < 6144; unit += nblk) {
        DIL_DECODE(unit)
        __syncthreads();
#pragma unroll
        for (int it = 0; it < 6; ++it) { const int id = it * kNT + tid, row = id >> 3, ch = id & 7;
            *(LAS u32x4*)(Kimg + row * 128 + ((ch ^ (row & 7)) << 4)) = pK[it];
            *(LAS u32x4*)(Vimg + row * 128 + ((ch ^ (((row >> 1) & 1) << 2)) << 4)) = pV[it]; }
        bf16x8 Qf[4];
#pragma unroll
        for (int s = 0; s < 4; ++s) Qf[s] = pQ[s];
        __syncthreads();
        if (unit + nblk < 6144) DIL_PREFETCH(unit + nblk);
        const int q0 = u0 + 32 * wid, qtok = ((q0 + qc) << dsh) + cls;
        const float slope = exp2f(-(float)((bh & 7) + 1));
        const float c1 = 0.125f * kLog2e, c2 = slope * (float)(1 << dsh) * kLog2e;
        float sum = 0.f;
        f32x16 O[2];
#pragma unroll
        for (int dt = 0; dt < 2; ++dt)
#pragma unroll
            for (int i = 0; i < 16; ++i) O[dt][i] = 0.f;
#pragma unroll
        for (int kt = 0; kt < 5; ++kt) {
            const int kp0 = q0 - 64 + 32 * kt;
            if (kp0 >= 0 && kp0 < L) {
                f32x16 S;
#pragma unroll
                for (int i = 0; i < 16; ++i) S[i] = 0.f;
#pragma unroll
                for (int s = 0; s < 4; ++s) { const bf16x8 Kf = *(const LAS bf16x8*)(Kimg + koff[s] + kt * 4096); S = __builtin_amdgcn_mfma_f32_32x32x16_bf16(Kf, Qf[s], S, 0, 0, 0); }
                const float cs = (kt < 2) ? c2 : -c2, c0 = ((kt == 0 || kt == 4) ? -64.f : (kt == 2 ? 0.f : -32.f)) * c2 - Mb;
#pragma unroll
                for (int i = 0; i < 16; ++i) {
                    const float d = (kt == 2) ? fabsf(dv[i]) : dv[i];
                    float sv = S[i] * c1 + (d * cs + c0);
                    if (kt == 0) sv = (dv[i] >= 0.f) ? sv : -1e30f;
                    if (kt == 4) sv = (dv[i] <= 0.f) ? sv : -1e30f;
                    const float pv = __builtin_amdgcn_exp2f(sv); S[i] = pv; sum += pv;
                }
#pragma unroll
                for (int s2 = 0; s2 < 2; ++s2) {
                    u32x4 pw; pw.x = pk2(S[8 * s2 + 0], S[8 * s2 + 1]); pw.y = pk2(S[8 * s2 + 2], S[8 * s2 + 3]); pw.z = pk2(S[8 * s2 + 4], S[8 * s2 + 5]); pw.w = pk2(S[8 * s2 + 6], S[8 * s2 + 7]);
                    const bf16x8 Pf = __builtin_bit_cast(bf16x8, pw);
#pragma unroll
                    for (int dt = 0; dt < 2; ++dt) { LAS unsigned char* vp = Vimg + voff[dt] + kt * 4096 + s2 * 2048;
                        const bf16x8 Vf = tr_pair(vp, vp + 1024);
                        O[dt] = __builtin_amdgcn_mfma_f32_32x32x16_bf16(Vf, Pf, O[dt], 0, 0, 0); }
                }
            }
        }
        sum += __shfl_xor(sum, 32);
        const float inv = 1.f / sum;
        const size_t tok = (size_t)(bh >> 3) * kS + qtok;
        bf16_t* orow = oac + ((size_t)c * kTok + tok) * 512 + (bh & 7) * 64;
#pragma unroll
        for (int dt = 0; dt < 2; ++dt)
#pragma unroll
            for (int g4 = 0; g4 < 4; ++g4) { u32x2 w; w.x = pk2(O[dt][4 * g4] * inv, O[dt][4 * g4 + 1] * inv); w.y = pk2(O[dt][4 * g4 + 2] * inv, O[dt][4 * g4 + 3] * inv);
                *(u32x2*)(orow + 32 * dt + 8 * g4 + 4 * h5) = w; }
        if (h5 == 0) lse[((size_t)c * kTok + tok) * 8 + (bh & 7)] = Mn + __logf(sum);
    }
#undef DIL_DECODE
#undef DIL_PREFETCH
    __syncthreads();
}
DEVI void phase_na(const bf16_t* qb, const bf16_t* kb, const bf16_t* vb, const float* rpb  , bf16_t* ob, LAS unsigned char* lds, int bid, int nblk) {
    const int tid = tidx(), wid = __builtin_amdgcn_readfirstlane(tid >> 6), lane = tid & 63, g4 = lane >> 4, i16 = lane & 15;
    LAS unsigned char* Kimg = lds; LAS unsigned char* Vimg = lds + 73728; LAS float* tab = (LAS float*)(lds + 147456);
    for (int i = tid; i < 4 * 465; i += kNT) tab[i] = rpb[i];
    const int g = wid & 3, kcs = (16 * g - 8) < 0 ? 0 : ((16 * g - 8) > 32 ? 32 : (16 * g - 8));
    const int qcol = 16 * g + i16, cs = (qcol - 8) < 0 ? 0 : ((qcol - 8) > 48 ? 48 : (qcol - 8));
    unsigned kswz[2];
#pragma unroll
    for (int s = 0; s < 2; ++s) kswz[s] = (unsigned)(((4 * s + g4) ^ (i16 & 7)) << 4);
    const int q = i16 >> 2, p = i16 & 3, sw = 2 * (g4 & 1) + (q >> 1);
    unsigned vsw[4];
#pragma unroll
    for (int dt = 0; dt < 4; ++dt) vsw[dt] = (unsigned)((((2 * dt + (p >> 1)) ^ (sw << 1)) << 4) + 8 * (p & 1));
    for (int unit = bid; unit < 2048; unit += nblk) {
        const int bh = unit >> 6, rp = unit & 63, r0 = 2 * rp, h = bh & 3;
        const int rsA = (r0 - 4) < 0 ? 0 : ((r0 - 4) > 120 ? 120 : (r0 - 4));
        const bf16_t* kbase = kb + (size_t)bh * kS * 64; const bf16_t* vbase = vb + (size_t)bh * kS * 64;
        __syncthreads();
#pragma unroll
        for (int it = 0; it < 9; ++it) {
            const int id = it * kNT + tid, row = id >> 3, ch = id & 7;
            int gr = rsA + (row >> 6); gr = gr > 127 ? 127 : gr;
            const size_t tok = (size_t)(gr * 64 + (row & 63));
            const u32x4 kv = *(const u32x4*)(kbase + tok * 64 + ch * 8), vv = *(const u32x4*)(vbase + tok * 64 + ch * 8);
            *(LAS u32x4*)(Kimg + row * 128 + ((ch ^ (row & 7)) << 4)) = kv;
            *(LAS u32x4*)(Vimg + row * 128 + ((ch ^ (((row >> 1) & 3) << 1)) << 4)) = vv;
        }
        __syncthreads();
        const int rr = r0 + (wid >> 2);
        const int rs = (rr - 4) < 0 ? 0 : ((rr - 4) > 120 ? 120 : (rr - 4)), ro = rs - rsA;
        const int qtok = rr * 64 + qcol;
        bf16x8 Qf[2];
#pragma unroll
        for (int s = 0; s < 2; ++s) Qf[s] = *(const bf16x8*)(qb + ((size_t)bh * kS + qtok) * 64 + 32 * s + 8 * g4);
        f32x4 S[16];
        const unsigned kb0 = (unsigned)((ro * 64 + kcs + i16) * 128);
#pragma unroll
        for (int t = 0; t < 16; ++t) { S[t] = (f32x4){0.f, 0.f, 0.f, 0.f};
#pragma unroll
            for (int s = 0; s < 2; ++s) { const bf16x8 Kf = *(const LAS bf16x8*)(Kimg + kb0 + (t >> 1) * 8192 + (t & 1) * 2048 + kswz[s]); S[t] = __builtin_amdgcn_mfma_f32_16x16x32_bf16(Kf, Qf[s], S[t], 0, 0, 0); } }
        float mx = -1e30f;
        const LAS float* th = tab + h * 465;
        int g4v = g4; asm volatile("" : "+v"(g4v));
#pragma unroll
        for (int t = 0; t < 16; ++t)
#pragma unroll
            for (int j = 0; j < 4; ++j) {
                const int krow = rs + (t >> 1), kcol = kcs + 16 * (t & 1) + 4 * g4v + j;
                const bool valid = (kcol >= cs) && (kcol < cs + 16);
                int dc = kcol - qcol + 15; dc = dc < 0 ? 0 : (dc > 30 ? 30 : dc);
                const float bias = th[(krow - rr + 7) * 31 + dc];
                const float sv = valid ? (S[t][j] * 0.125f + bias) * kLog2e : -1e30f;
                S[t][j] = sv; mx = fmaxf(mx, sv);
            }
        mx = fmaxf(mx, __shfl_xor(mx, 16)); mx = fmaxf(mx, __shfl_xor(mx, 32));
        float sum = 0.f;
#pragma unroll
        for (int t = 0; t < 16; ++t)
#pragma unroll
            for (int j = 0; j < 4; ++j) { const float pv = __builtin_amdgcn_exp2f(S[t][j] - mx); S[t][j] = pv; sum += pv; }
        sum += __shfl_xor(sum, 16); sum += __shfl_xor(sum, 32);
        f32x4 O[4];
#pragma unroll
        for (int dt = 0; dt < 4; ++dt) O[dt] = (f32x4){0.f, 0.f, 0.f, 0.f};
        const unsigned vb0 = (unsigned)((ro * 64 + kcs + 4 * g4 + q) * 128);
#pragma unroll
        for (int u = 0; u < 8; ++u) {
            u32x4 pw; pw.x = pk2(S[2 * u][0], S[2 * u][1]); pw.y = pk2(S[2 * u][2], S[2 * u][3]); pw.z = pk2(S[2 * u + 1][0], S[2 * u + 1][1]); pw.w = pk2(S[2 * u + 1][2], S[2 * u + 1][3]);
            const bf16x8 Pf = __builtin_bit_cast(bf16x8, pw);
#pragma unroll
            for (int dt = 0; dt < 4; ++dt) { LAS unsigned char* vp = Vimg + vb0 + u * 8192 + vsw[dt];
                const bf16x8 Vf = tr_pair(vp, vp + 2048);
                O[dt] = __builtin_amdgcn_mfma_f32_16x16x32_bf16(Vf, Pf, O[dt], 0, 0, 0); }
        }
        const float inv = 1.f / sum;
        bf16_t* orow = ob + ((size_t)(bh >> 2) * kS + qtok) * 256 + h * 64;
#pragma unroll
        for (int dt = 0; dt < 4; ++dt) { u32x2 w; w.x = pk2(O[dt][0] * inv, O[dt][1] * inv); w.y = pk2(O[dt][2] * inv, O[dt][3] * inv); *(u32x2*)(orow + 16 * dt + 4 * g4) = w; }
    }
    __syncthreads();
}
DEVI void phase_s5_naive(const Params& P, int l, const bf16_t* ux, float* ys, unsigned char* lds, int bid, int nblk) {
    const int wid = tidx() >> 6, lane = tidx() & 63;
    float* xs = (float*)lds + wid * 128;
    for (int item = wid * nblk + bid; item < kB * 16 * 2; item += nblk * 8) {
        const int dir = item & 1, g = (item >> 1) & 15, b = item >> 5;
        const size_t pbase = (((size_t)l * 2 + dir) * 16 + g) * 64;
        const float dt = __expf(P.s5_log_dt[((size_t)l * 2 + dir) * 16 + g]);
        const float a = fminf(P.s5_a_re[pbase + lane], -1e-4f), w = P.s5_a_im[pbase + lane];
        const float mag = __expf(a * dt), ar = mag * cosf(w * dt), ai = mag * sinf(w * dt);
        const float den = a * a + w * w, zr = ar - 1.f, gr = (zr * a + ai * w) / den, gi = (ai * a - zr * w) / den;
        float bbr[16], bbi[16];
#pragma unroll
        for (int c = 0; c < 16; ++c) { const float br = P.s5_b_re[(pbase + lane) * 16 + c], bi = P.s5_b_im[(pbase + lane) * 16 + c]; bbr[c] = gr * br - gi * bi; bbi[c] = gr * bi + gi * br; }
        const int cch = lane & 15, qt = lane >> 4;
        float cre[16], cim[16];
#pragma unroll
        for (int pp = 0; pp < 16; ++pp) { cre[pp] = P.s5_c_re[(pbase / 64 * 16 + cch) * 64 + qt * 16 + pp]; cim[pp] = P.s5_c_im[(pbase / 64 * 16 + cch) * 64 + qt * 16 + pp]; }
        float xr = 0.f, xi = 0.f;
        const bf16_t* ug = ux + (size_t)g * 4096 * 512;
        for (int st = 0; st < kS; ++st) {
            const int s = dir ? (kS - 1 - st) : st; const size_t tok = (size_t)b * kS + s;
            const bf16_t* up = ug + (tok >> 4) * 512 + (tok & 15) * 16;
            const u32x4 u0 = *(const u32x4*)up, u1 = *(const u32x4*)(up + 8);
            float uv[16];
            uv[0] = __uint_as_float(u0.x << 16); uv[1] = __uint_as_float(u0.x & 0xFFFF0000u); uv[2] = __uint_as_float(u0.y << 16); uv[3] = __uint_as_float(u0.y & 0xFFFF0000u);
            uv[4] = __uint_as_float(u0.z << 16); uv[5] = __uint_as_float(u0.z & 0xFFFF0000u); uv[6] = __uint_as_float(u0.w << 16); uv[7] = __uint_as_float(u0.w & 0xFFFF0000u);
            uv[8] = __uint_as_float(u1.x << 16); uv[9] = __uint_as_float(u1.x & 0xFFFF0000u); uv[10] = __uint_as_float(u1.y << 16); uv[11] = __uint_as_float(u1.y & 0xFFFF0000u);
            uv[12] = __uint_as_float(u1.z << 16); uv[13] = __uint_as_float(u1.z & 0xFFFF0000u); uv[14] = __uint_as_float(u1.w << 16); uv[15] = __uint_as_float(u1.w & 0xFFFF0000u);
            float bur = 0.f, bui = 0.f;
#pragma unroll
            for (int c = 0; c < 16; ++c) { bur += bbr[c] * uv[c]; bui += bbi[c] * uv[c]; }
            const float nr = ar * xr - ai * xi + bur, ni = ar * xi + ai * xr + bui; xr = nr; xi = ni;
            xs[lane] = xr; xs[64 + lane] = xi;
            asm volatile("s_waitcnt lgkmcnt(0)" ::: "memory");
            float y = 0.f;
#pragma unroll
            for (int pp = 0; pp < 16; ++pp) y += cre[pp] * xs[qt * 16 + pp] - cim[pp] * xs[64 + qt * 16 + pp];
            asm volatile("s_waitcnt lgkmcnt(0)" ::: "memory");
            y += __shfl_xor(y, 16); y += __shfl_xor(y, 32);
            if (lane < 16) ys[((size_t)dir * kTok + tok) * 256 + g * 16 + cch] = y;
        }
    }
}
DEVI void phase_s5_finish(const float* ys, const bf16_t* ux, const float* dskip, bf16_t* G, int bid, int nblk) {
    for (size_t i = (size_t)bid * kNT + tidx(); i < (size_t)kTok * 256; i += (size_t)nblk * kNT) {
        const size_t tok = i >> 8; const int ch = (int)(i & 255), g = ch >> 4, c = ch & 15;
        const float u = bf2f(ux[((size_t)g * 4096 + (tok >> 4)) * 512 + (tok & 15) * 16 + c]);
        const float y = ys[i] + ys[(size_t)kTok * 256 + i] + dskip[ch] * u;
        G[i] = f2bf(gelu_tanh(y));
    }
}
DEVI void unpk8(float* d, const u32x4 q, const float sc) {
    d[0] += sc * __uint_as_float(q.x << 16); d[1] += sc * __uint_as_float(q.x & 0xFFFF0000u); d[2] += sc * __uint_as_float(q.y << 16); d[3] += sc * __uint_as_float(q.y & 0xFFFF0000u);
    d[4] += sc * __uint_as_float(q.z << 16); d[5] += sc * __uint_as_float(q.z & 0xFFFF0000u); d[6] += sc * __uint_as_float(q.w << 16); d[7] += sc * __uint_as_float(q.w & 0xFFFF0000u);
}
DEVI void phase_mixnorm(const bf16_t* oac, const float* lse, const bf16_t* ob, const bf16_t* oc, const float* ga, const float* gb, const float* gc, bf16_t* mix, int bid, int nblk) {
    const int wid = tidx() >> 6, lane = tidx() & 63;
    float gn[16];
    { const float* gp = (lane < 32) ? ga + lane * 16 : (lane < 48) ? gb + (lane - 32) * 16 : gc + (lane - 48) * 16;
#pragma unroll
      for (int i = 0; i < 16; ++i) gn[i] = gp[i]; }
    for (int row = bid * 8 + wid; row < kTok; row += nblk * 8) {
        float v[16];
#pragma unroll
        for (int i = 0; i < 16; ++i) v[i] = 0.f;
        if (lane < 32) {
            const int h = lane >> 2;
            const float l0 = lse[(size_t)row * 8 + h], l1 = lse[((size_t)kTok + row) * 8 + h], l2 = lse[((size_t)2 * kTok + row) * 8 + h];
            const bf16_t* p0 = oac + (size_t)row * 512 + lane * 16; const bf16_t* p1 = p0 + (size_t)kTok * 512; const bf16_t* p2 = p1 + (size_t)kTok * 512;
            const u32x4 a0 = *(const u32x4*)p0, a1 = *(const u32x4*)(p0 + 8), b0 = *(const u32x4*)p1, b1 = *(const u32x4*)(p1 + 8), c0 = *(const u32x4*)p2, c1 = *(const u32x4*)(p2 + 8);
            const float mx = fmaxf(l0, fmaxf(l1, l2)); float w0 = __expf(l0 - mx), w1 = __expf(l1 - mx), w2 = __expf(l2 - mx); const float inv = frcp(w0 + w1 + w2); w0 *= inv; w1 *= inv; w2 *= inv;
            unpk8(v, a0, w0); unpk8(v + 8, a1, w0); unpk8(v, b0, w1); unpk8(v + 8, b1, w1); unpk8(v, c0, w2); unpk8(v + 8, c1, w2);
        } else {
            const bf16_t* p = (lane < 48) ? ob + (size_t)row * 256 + (lane - 32) * 16 : oc + (size_t)row * 256 + (lane - 48) * 16;
            const u32x4 a0 = *(const u32x4*)p, a1 = *(const u32x4*)(p + 8);
            unpk8(v, a0, 1.f); unpk8(v + 8, a1, 1.f);
        }
        float ss = 0.f;
#pragma unroll
        for (int i = 0; i < 16; ++i) ss += v[i] * v[i];
#pragma unroll
        for (int m = 1; m <= 8; m <<= 1) ss += __shfl_xor(ss, m);
        const float o16 = __shfl_xor(ss, 16);
        if (lane < 32) ss += o16;
        const float rstd = rsqrtf(ss * ((lane < 32) ? (1.f / 512.f) : (1.f / 256.f)) + kEps);
        u32x4 w0, w1;
        w0.x = pk2(v[0] * rstd * gn[0], v[1] * rstd * gn[1]); w0.y = pk2(v[2] * rstd * gn[2], v[3] * rstd * gn[3]); w0.z = pk2(v[4] * rstd * gn[4], v[5] * rstd * gn[5]); w0.w = pk2(v[6] * rstd * gn[6], v[7] * rstd * gn[7]);
        w1.x = pk2(v[8] * rstd * gn[8], v[9] * rstd * gn[9]); w1.y = pk2(v[10] * rstd * gn[10], v[11] * rstd * gn[11]); w1.z = pk2(v[12] * rstd * gn[12], v[13] * rstd * gn[13]); w1.w = pk2(v[14] * rstd * gn[14], v[15] * rstd * gn[15]);
        *(u32x4*)(mix + (size_t)row * kD + lane * 16) = w0; *(u32x4*)(mix + (size_t)row * kD + lane * 16 + 8) = w1;
    }
}
DEVI void phase_combine(float* x, const bf16_t* y, const int* tokslot, const float* gain_next, bf16_t* h, int bid, int nblk) {
    const int wid = tidx() >> 6, lane = tidx() & 63;
    f32x4 g[4];
#pragma unroll
    for (int q = 0; q < 4; ++q) g[q] = gain_next ? *(const f32x4*)(gain_next + q * 256 + lane * 4) : (f32x4){0.f, 0.f, 0.f, 0.f};
    const int stride = nblk * 8;
    int row = bid * 8 + wid;
    f32x4 nv[4]; int nts = 0;
    if (row < kTok) { nts = tokslot[(size_t)row * kE + (lane & 15)];
#pragma unroll
        for (int q = 0; q < 4; ++q) nv[q] = *(const f32x4*)(x + (size_t)row * kD + q * 256 + lane * 4); }
    for (; row < kTok; row += stride) {
        const int b = row >> 13;
        const int ts = nts;
        f32x4 v[4];
#pragma unroll
        for (int q = 0; q < 4; ++q) v[q] = nv[q];
        const int nrow = row + stride;
        if (nrow < kTok) { nts = tokslot[(size_t)nrow * kE + (lane & 15)];
#pragma unroll
            for (int q = 0; q < 4; ++q) nv[q] = *(const f32x4*)(x + (size_t)nrow * kD + q * 256 + lane * 4); }
#pragma unroll
        for (int e0 = 0; e0 < kE; e0 += 8) {
            u32x2 yv[8][4];
#pragma unroll
            for (int e = 0; e < 8; ++e) { const int slot = __builtin_amdgcn_readlane(ts, e0 + e);
                if (slot >= 0) { const bf16_t* yr = y + ((size_t)((e0 + e) * kB + b) * kCap + slot) * kD;
#pragma unroll
                    for (int q = 0; q < 4; ++q) yv[e][q] = *(const u32x2*)(yr + q * 256 + lane * 4); } }
#pragma unroll
            for (int e = 0; e < 8; ++e) { const int slot = __builtin_amdgcn_readlane(ts, e0 + e);
                if (slot >= 0) {
#pragma unroll
                    for (int q = 0; q < 4; ++q) { const u32x2 w = yv[e][q];
                        v[q].x += __uint_as_float(w.x << 16); v[q].y += __uint_as_float(w.x & 0xFFFF0000u); v[q].z += __uint_as_float(w.y << 16); v[q].w += __uint_as_float(w.y & 0xFFFF0000u); } } }
        }
        float ss = 0.f;
#pragma unroll
        for (int q = 0; q < 4; ++q) { *(f32x4*)(x + (size_t)row * kD + q * 256 + lane * 4) = v[q]; ss += v[q].x * v[q].x + v[q].y * v[q].y + v[q].z * v[q].z + v[q].w * v[q].w; }
        if (gain_next) { ss = wave_sum(ss); const float rstd = rsqrtf(ss * (1.f / kD) + kEps);
#pragma unroll
            for (int q = 0; q < 4; ++q) { u32x2 o; o.x = pk2(v[q].x * rstd * g[q].x, v[q].y * rstd * g[q].y); o.y = pk2(v[q].z * rstd * g[q].z, v[q].w * rstd * g[q].w);
                *(u32x2*)(h + (size_t)row * kD + q * 256 + lane * 4) = o; } }
    }
}

DEVI void cpow_m(double a, double w, double dt, int m, float& re, float& im) {
    const float mag = __expf((float)m * (float)a * (float)dt);
    const double turns = (double)m * w * dt * 0.15915494309189535; const float ang = (float)((turns - floor(turns)) * 6.283185307179586);
    re = mag * cosf(ang); im = mag * sinf(ang);
}
DEVI void s5_prep_item(const Params& P, int l, int g, unsigned char* lds_) {
    float* pw = (float*)lds_;
    float* bb = pw + 4352;
    float* cc = bb + 4096;
    float* kt = cc + 4096;
    const int tid = tidx();
    __syncthreads();
    for (int i = tid; i < 128; i += kNT) { const int dir = i >> 6, p = i & 63; const size_t pb = (((size_t)l * 2 + dir) * 16 + g) * 64 + p;
        const double dt = (double)__expf(P.s5_log_dt[((size_t)l * 2 + dir) * 16 + g]); const double a = (double)fminf(P.s5_a_re[pb], -1e-4f), w = (double)P.s5_a_im[pb];
        for (int m = 0; m < 17; ++m) { float re, im; cpow_m(a, w, dt, m, re, im); pw[((dir * 64 + p) * 17 + m) * 2] = re; pw[((dir * 64 + p) * 17 + m) * 2 + 1] = im; }
        const float af = (float)a, wf = (float)w, ar = pw[((dir * 64 + p) * 17 + 1) * 2], ai = pw[((dir * 64 + p) * 17 + 1) * 2 + 1];
        const float den = af * af + wf * wf, zr = ar - 1.f, gr = (zr * af + ai * wf) / den, gi = (ai * af - zr * wf) / den;
        for (int c = 0; c < 16; ++c) { const float br = P.s5_b_re[pb * 16 + c], bi = P.s5_b_im[pb * 16 + c]; bb[((dir * 64 + p) * 16 + c) * 2] = gr * br - gi * bi; bb[((dir * 64 + p) * 16 + c) * 2 + 1] = gr * bi + gi * br; }
    }
    for (int i = tid; i < 2048; i += kNT) { const int dir = i >> 10, c = (i >> 6) & 15, p = i & 63; const size_t o = ((((size_t)l * 2 + dir) * 16 + g) * 16 + c) * 64 + p; cc[i * 2] = P.s5_c_re[o]; cc[i * 2 + 1] = P.s5_c_im[o]; }
    __syncthreads();
    for (int i = tid; i < 8192; i += kNT) { const int dir = i >> 12, m = (i >> 8) & 15, c = (i >> 4) & 15, c2 = i & 15; float acc = 0.f;
        for (int p = 0; p < 64; ++p) { const float cr = cc[((dir * 16 + c) * 64 + p) * 2], ci = cc[((dir * 16 + c) * 64 + p) * 2 + 1], wr_ = pw[((dir * 64 + p) * 17 + m) * 2], wi_ = pw[((dir * 64 + p) * 17 + m) * 2 + 1];
            const float br = bb[((dir * 64 + p) * 16 + c2) * 2], bi = bb[((dir * 64 + p) * 16 + c2) * 2 + 1]; const float tr = cr * wr_ - ci * wi_, ti = cr * wi_ + ci * wr_; acc += tr * br - ti * bi; }
        kt[i] = acc; }
    __syncthreads();
    bf16_t* wst = (bf16_t*)(P.ws + WS_WST) + ((size_t)l * 16 + g) * 256 * 256;
    bf16_t* wso = (bf16_t*)(P.ws + WS_WSO) + ((size_t)l * 16 + g) * 256 * 512;
    for (int id = tid; id < 8192; id += kNT) { const int n = id >> 5, k0 = (id & 31) * 8, dir = n >> 7, p = (n >> 1) & 63, ri = n & 1; float v[8];
#pragma unroll
        for (int kk = 0; kk < 8; ++kk) { const int k = k0 + kk, t = k >> 4, c = k & 15, e = dir ? t : 15 - t; const float wr_ = pw[((dir * 64 + p) * 17 + e) * 2], wi_ = pw[((dir * 64 + p) * 17 + e) * 2 + 1], br = bb[((dir * 64 + p) * 16 + c) * 2], bi = bb[((dir * 64 + p) * 16 + c) * 2 + 1];
            v[kk] = ri ? (wr_ * bi + wi_ * br) : (wr_ * br - wi_ * bi); }
        u32x4 o; o.x = pk2(v[0], v[1]); o.y = pk2(v[2], v[3]); o.z = pk2(v[4], v[5]); o.w = pk2(v[6], v[7]); *(u32x4*)(wst + (size_t)n * 256 + k0) = o; }
    for (int id = tid; id < 16384; id += kNT) { const int ns = id >> 6, k0 = (id & 63) * 8, n = cmap_pk(ns), t = n >> 4, c = n & 15; float v[8];
#pragma unroll
        for (int kk = 0; kk < 8; ++kk) { const int k = k0 + kk; float x;
            if (k < 256) { const int j = k >> 4, c2 = k & 15; x = 0.f; if (j <= t) x += kt[(t - j) * 256 + c * 16 + c2]; if (j >= t) x += kt[4096 + (j - t) * 256 + c * 16 + c2]; if (j == t && c == c2) x += P.s5_d[l * 256 + g * 16 + c]; }
            else { const int q = k - 256, dir = q >> 7, p = (q >> 1) & 63, ri = q & 1, e = dir ? 16 - t : t + 1; const float cr = cc[((dir * 16 + c) * 64 + p) * 2], ci = cc[((dir * 16 + c) * 64 + p) * 2 + 1], wr_ = pw[((dir * 64 + p) * 17 + e) * 2], wi_ = pw[((dir * 64 + p) * 17 + e) * 2 + 1];
                x = ri ? -(cr * wi_ + ci * wr_) : (cr * wr_ - ci * wi_); }
            v[kk] = x; }
        u32x4 o; o.x = pk2(v[0], v[1]); o.y = pk2(v[2], v[3]); o.z = pk2(v[4], v[5]); o.w = pk2(v[6], v[7]); *(u32x4*)(wso + (size_t)ns * 512 + k0) = o; }
    __syncthreads();
}
DEVI void phase_s5_scan(const Params& P, int l, const float* Z, bf16_t* ux, unsigned char* lds_, int bid, int nblk) {
    const int tid = tidx(), wid = tid >> 6, lane = tid & 63;
    float* E = (float*)lds_;
    for (int item = bid; item < 256; item += nblk) {
        const int dir = item & 1, g = (item >> 1) & 15, b = item >> 5;
        const size_t pb = (((size_t)l * 2 + dir) * 16 + g) * 64 + lane;
        const double dt = (double)__expf(P.s5_log_dt[((size_t)l * 2 + dir) * 16 + g]); const double a = (double)fminf(P.s5_a_re[pb], -1e-4f), w = (double)P.s5_a_im[pb];
        float a16r, a16i, Ar, Ai; cpow_m(a, w, dt, 16, a16r, a16i); cpow_m(a, w, dt, 1024, Ar, Ai);
        const int kk0 = dir ? 511 - 64 * wid : 64 * wid; const long sstep = dir ? -1 : 1;
        const float* zp = Z + ((size_t)g * 4096 + b * 512 + kk0) * 256 + dir * 128 + 2 * lane;
        f32x2 z[64];
#pragma unroll
        for (int i = 0; i < 64; ++i) { z[i] = *(const f32x2*)zp; zp += sstep * 256; }
        float xr = 0.f, xi = 0.f;
#pragma unroll
        for (int i = 0; i < 64; ++i) { const float nr = a16r * xr - a16i * xi + z[i].x, ni = a16r * xi + a16i * xr + z[i].y; xr = nr; xi = ni; }
        __syncthreads();
        E[(wid * 64 + lane) * 2] = xr; E[(wid * 64 + lane) * 2 + 1] = xi;
        __syncthreads();
        float sr = 0.f, si = 0.f;
#pragma unroll
        for (int s2 = 0; s2 < 7; ++s2) if (s2 < wid) { const float er = E[(s2 * 64 + lane) * 2], ei = E[(s2 * 64 + lane) * 2 + 1]; const float nr = Ar * sr - Ai * si + er, ni = Ar * si + Ai * sr + ei; sr = nr; si = ni; }
        bf16_t* up = ux + ((size_t)g * 4096 + b * 512 + kk0) * 512 + 256 + dir * 128 + 2 * lane;
#pragma unroll
        for (int i = 0; i < 64; ++i) { *(unsigned*)up = pk2(sr, si); up += sstep * 512;
            const float nr = a16r * sr - a16i * si + z[i].x, ni = a16r * si + a16i * sr + z[i].y; sr = nr; si = ni; }
    }
    __syncthreads();
}
struct EpiF32N {
    static constexpr int VMOPS = 32;
    float* z; int ldz;
    DEVI void operator()(const f32x4 (&acc)[2][2][4][2], const Unit& u, int wr, int wc, int fr, int fq) const {
#pragma unroll
        for (int ai = 0; ai < 2; ++ai)
#pragma unroll
            for (int m = 0; m < 4; ++m) { const size_t ro = (size_t)(u.pm * 256 + 128 * ai + 64 * wr + 16 * m + fr) * ldz + u.pn * 256 + 32 * wc + 4 * fq;
#pragma unroll
                for (int bj = 0; bj < 2; ++bj)
#pragma unroll
                    for (int n = 0; n < 2; ++n) *(f32x4*)(z + ro + 128 * bj + 16 * n) = acc[ai][bj][m][n]; }
    }
};
struct EpiS5Out {
    static constexpr int VMOPS = 16;
    bf16_t* G;
    DEVI void operator()(const f32x4 (&acc)[2][2][4][2], const Unit& u, int wr, int wc, int fr, int fq) const {
#pragma unroll
        for (int ai = 0; ai < 2; ++ai)
#pragma unroll
            for (int m = 0; m < 4; ++m) { const int R = u.pm * 256 + 128 * ai + 64 * wr + 16 * m + fr, g = R >> 12, ck = R & 4095;
#pragma unroll
                for (int bj = 0; bj < 2; ++bj) { const int t = 8 * bj + 2 * wc + (fq >> 1), c0 = 8 * (fq & 1);
                    const f32x4 v0 = acc[ai][bj][m][0], v1 = acc[ai][bj][m][1];
                    u32x4 w; w.x = pk2(gelu_tanh(v0.x), gelu_tanh(v0.y)); w.y = pk2(gelu_tanh(v0.z), gelu_tanh(v0.w)); w.z = pk2(gelu_tanh(v1.x), gelu_tanh(v1.y)); w.w = pk2(gelu_tanh(v1.z), gelu_tanh(v1.w));
                    *(u32x4*)(G + ((size_t)ck * 16 + t) * 256 + g * 16 + c0) = w; } }
    }
};
#define XB_TMO      128
#define XB_XCNT(j)  (256  + 64 * (j))
#define XB_XSUB(j)  (1280 + 64 * (j))
#define XB_XGEN(j)  (2304 + 64 * (j))
#define XB_TOP      3328
#define XB_TOPGEN   3392
#define XCD_BAR_WORDS 3456
#define XB_SPIN_CAP (1u << 26)
DEVI unsigned xb_ld(unsigned* p)              { return __hip_atomic_load(p, __ATOMIC_RELAXED, __HIP_MEMORY_SCOPE_AGENT); }
DEVI unsigned xb_add(unsigned* p, unsigned v) { return __hip_atomic_fetch_add(p, v, __ATOMIC_RELAXED, __HIP_MEMORY_SCOPE_AGENT); }
DEVI unsigned xb_xcc_id() { return (unsigned)__builtin_amdgcn_s_getreg((3 << 11) | 20) & 0xFu; }
#define XB_SPIN(cond, bar) do { unsigned _sp = 0; while (cond) { __builtin_amdgcn_s_sleep(1); \
    if ((++_sp & 255u) == 0u) { if (xb_ld(&(bar)[XB_TMO])) break; if (_sp > XB_SPIN_CAP) { atomicAdd(&(bar)[XB_TMO], 1u); break; } } } } while (0)
struct XcdBarrier { unsigned* bar; unsigned x; volatile LAS unsigned* st; };
DEVI XcdBarrier xcd_barrier_post(unsigned* bar, volatile LAS unsigned* st) {
    XcdBarrier b; b.bar = bar; b.x = xb_xcc_id(); b.st = st;
    if (threadIdx.x == 0) (void)xb_add(&bar[XB_XCNT(b.x)], 1u);
    return b;
}
DEVI void xcd_barrier_complete(unsigned* bar, unsigned x, unsigned& nloc, unsigned& nx) {
    const unsigned G = gridDim.x * gridDim.y * gridDim.z;
    unsigned sum, cnt, mine, sp = 0u;
    for (;;) {
        sum = 0u; cnt = 0u; mine = 0u;
#pragma unroll
        for (unsigned j = 0; j < 16; ++j) { const unsigned c = xb_ld(&bar[XB_XCNT(j)]); sum += c; cnt += (c > 0u) ? 1u : 0u; mine = (j == x) ? c : mine; }
        if (sum == G) break;
        __builtin_amdgcn_s_sleep(1);
        if ((++sp & 255u) == 0u) { if (xb_ld(&bar[XB_TMO])) break; if (sp > XB_SPIN_CAP) { atomicAdd(&bar[XB_TMO], 1u); break; } }
    }
    nloc = mine > 0u ? mine : 1u; nx = cnt > 0u ? cnt : 1u;
}
DEVI void xcd_barrier(const XcdBarrier& b) {
    asm volatile("s_waitcnt vmcnt(0)" ::: "memory");
    __syncthreads();
    if (threadIdx.x == 0) {
        unsigned long long bp_ = (unsigned long long)b.bar; asm volatile("" : "+s"(bp_));
        unsigned* bar = (unsigned*)bp_;
        const unsigned bx = xb_xcc_id();
        __builtin_amdgcn_s_waitcnt(0);
        unsigned nloc = b.st[0], nx = b.st[1];
        if (nloc == 0u) { xcd_barrier_complete(bar, bx, nloc, nx); b.st[0] = nloc; b.st[1] = nx; }
        const unsigned old = xb_add(&bar[XB_XSUB(bx)], 1u);
        const unsigned gen = old / nloc;
        if (old + 1u == (gen + 1u) * nloc) {
            __builtin_amdgcn_fence(__ATOMIC_RELEASE, "agent");
            asm volatile("s_waitcnt vmcnt(0)" ::: "memory");
            const unsigned og = xb_add(&bar[XB_TOP], 1u);
            const unsigned tg = og / nx;
            if (og + 1u == (tg + 1u) * nx) xb_add(&bar[XB_TOPGEN], 1u);
            else XB_SPIN(xb_ld(&bar[XB_TOPGEN]) == tg, bar);
            __builtin_amdgcn_fence(__ATOMIC_ACQUIRE, "agent");
            xb_add(&bar[XB_XGEN(bx)], 1u);
            asm volatile("s_waitcnt vmcnt(0)" ::: "memory");
        } else {
            XB_SPIN(xb_ld(&bar[XB_XGEN(bx)]) == gen, bar);
            __builtin_amdgcn_fence(__ATOMIC_ACQUIRE, "agent");
            asm volatile("s_waitcnt vmcnt(0)" ::: "memory");
        }
    }
    __syncthreads();
}

#ifndef MEGA
#define MEGA 1
#endif
#ifndef USE_ENGINE
#define USE_ENGINE 1
#endif
constexpr int LDS_BYTES = 147456 + 8192 + 16;
#if USE_ENGINE
#define GEMM_RUN(g, E) gemm_engine<decltype(E), true, true>((LAS unsigned char*)dyn_lds, g, E, bid, nblk)
#else
#define GEMM_RUN(g, E) gemm_simple(g, E, bid, nblk)
#endif
extern __shared__ __attribute__((aligned(16))) unsigned char dyn_lds[];

DEVI GemmD mk_gemm(const bf16_t* A, const bf16_t* Bt, int lda, int K, int nM, int nN, const int* rowidx, size_t bstride, int pmg) {
    GemmD g; g.A = A; g.Bt = Bt; g.lda = lda; g.K = K; g.nM = nM; g.nN = nN; g.rowidx = rowidx; g.bstride = bstride; g.pmg = pmg; return g; }

DEVI void ph_win(const Params& P, int l, int bid, int nblk) {
    const GemmD g = mk_gemm((const bf16_t*)(P.ws + WS_H), (const bf16_t*)(P.ws + WS_WINT) + (size_t)l * kINW * kD, kD, kD, kTok / 256, 10, nullptr, 0, 1 << 30);
    unsigned char* r1 = P.ws + WS_R1;
    EpiQKV E; E.qa = (bf16_t*)(r1 + R1_QA); E.ka = (bf16_t*)(r1 + R1_KA); E.va = (bf16_t*)(r1 + R1_VA); E.qb = (bf16_t*)(r1 + R1_QB); E.kb = (bf16_t*)(r1 + R1_KB); E.vb = (bf16_t*)(r1 + R1_VB); E.ux = (bf16_t*)(r1 + R1_UX);
    E.qna = P.q_norm_a + l * 64; E.kna = P.k_norm_a + l * 64; E.qnb = P.q_norm_b + l * 64; E.knb = P.k_norm_b + l * 64;
    GEMM_RUN(g, E);
}
#ifndef USE_MFMA_ATTN
#define USE_MFMA_ATTN 1
#endif
#ifndef USE_S5_GEMM
#define USE_S5_GEMM 1
#endif
#ifndef PROBE_ATTN
#define PROBE_ATTN 1
#endif
#ifndef PROBE_GU
#define PROBE_GU 1
#endif
#ifndef PROBE_DOWN
#define PROBE_DOWN 1
#endif
#ifndef PROBE_NA
#define PROBE_NA 1
#endif
#ifndef PROBE_MIX
#define PROBE_MIX 1
#endif
#ifndef PROBE_RT
#define PROBE_RT 1
#endif
#ifndef PROBE_TK
#define PROBE_TK 1
#endif
#ifndef PROBE_GUDRY
#define PROBE_GUDRY 0
#endif
#ifndef PROBE_CONV
#define PROBE_CONV 1
#endif
DEVI void ph_dilated(const Params& P, int l, int bid, int nblk) { unsigned char* r1 = P.ws + WS_R1;
#if USE_MFMA_ATTN
    phase_dilated((const bf16_t*)(r1 + R1_QA), (const bf16_t*)(r1 + R1_KA), (const bf16_t*)(r1 + R1_VA), P.q_norm_a + l * 64, P.k_norm_a + l * 64, (bf16_t*)(P.ws + WS_R2), (float*)(P.ws + WS_LSE), (LAS unsigned char*)dyn_lds, bid, nblk);
#else
    phase_dilated_naive((const bf16_t*)(r1 + R1_QA), (const bf16_t*)(r1 + R1_KA), (const bf16_t*)(r1 + R1_VA), (bf16_t*)(P.ws + WS_R2), (float*)(P.ws + WS_LSE), bid, nblk);
#endif
}
DEVI void ph_na(const Params& P, int l, int bid, int nblk) { unsigned char* r1 = P.ws + WS_R1;
#if USE_MFMA_ATTN
    phase_na((const bf16_t*)(r1 + R1_QB), (const bf16_t*)(r1 + R1_KB), (const bf16_t*)(r1 + R1_VB), P.rpb + (size_t)l * 4 * 15 * 31, (bf16_t*)(r1 + R1_OB), (LAS unsigned char*)dyn_lds, bid, nblk);
#else
    phase_na_naive((const bf16_t*)(r1 + R1_QB), (const bf16_t*)(r1 + R1_KB), (const bf16_t*)(r1 + R1_VB), P.rpb + (size_t)l * 4 * 15 * 31, (bf16_t*)(r1 + R1_OB), bid, nblk);
#endif
}
DEVI void ph_s5(const Params& P, int l, unsigned char* lds, int bid, int nblk) { phase_s5_naive(P, l, (const bf16_t*)(P.ws + WS_R1 + R1_UX), (float*)(P.ws + WS_YS), lds, bid, nblk); }
DEVI void ph_s5_prep(const Params& P, unsigned char* lds, int bid, int nblk) { for (int it = bid; it < kL * 16; it += nblk) s5_prep_item(P, it >> 4, it & 15, lds); }
DEVI void ph_s5_state(const Params& P, int l, int bid, int nblk) {
    const GemmD g = mk_gemm((const bf16_t*)(P.ws + WS_R1 + R1_UX), (const bf16_t*)(P.ws + WS_WST) + (size_t)l * 16 * 256 * 256, 512, 256, 256, 1, nullptr, (size_t)256 * 256, 16);
    EpiF32N E; E.z = (float*)(P.ws + WS_R2 + R2_Z); E.ldz = 256;
    GEMM_RUN(g, E);
}
DEVI void ph_s5_scan(const Params& P, int l, unsigned char* lds, int bid, int nblk) { phase_s5_scan(P, l, (const float*)(P.ws + WS_R2 + R2_Z), (bf16_t*)(P.ws + WS_R1 + R1_UX), lds, bid, nblk); }
DEVI void ph_s5_out(const Params& P, int l, int bid, int nblk) {
    const GemmD g = mk_gemm((const bf16_t*)(P.ws + WS_R1 + R1_UX), (const bf16_t*)(P.ws + WS_WSO) + (size_t)l * 16 * 256 * 512, 512, 512, 256, 1, nullptr, (size_t)256 * 512, 16);
    EpiS5Out E; E.G = (bf16_t*)(P.ws + WS_R1 + R1_G);
    GEMM_RUN(g, E);
}
DEVI void ph_s5fin(const Params& P, int l, int bid, int nblk) { phase_s5_finish((const float*)(P.ws + WS_YS), (const bf16_t*)(P.ws + WS_R1 + R1_UX), P.s5_d + l * 256, (bf16_t*)(P.ws + WS_R1 + R1_G), bid, nblk); }
DEVI void ph_glu(const Params& P, int l, int bid, int nblk) {
    const GemmD g = mk_gemm((const bf16_t*)(P.ws + WS_R1 + R1_G), (const bf16_t*)(P.ws + WS_WGLUT) + (size_t)l * 256 * 256, 256, 256, kTok / 256, 1, nullptr, 0, 1 << 30);
    EpiGlu E; E.g = (const bf16_t*)(P.ws + WS_R1 + R1_G); E.oc = (bf16_t*)(P.ws + WS_R1 + R1_OC);
    GEMM_RUN(g, E);
}
DEVI void ph_mixnorm(const Params& P, int l, int bid, int nblk) { unsigned char* r1 = P.ws + WS_R1;
    phase_mixnorm((const bf16_t*)(P.ws + WS_R2), (const float*)(P.ws + WS_LSE), (const bf16_t*)(r1 + R1_OB), (const bf16_t*)(r1 + R1_OC), P.out_norm_a + l * 512, P.out_norm_b + l * 256, P.out_norm_c + l * 256, (bf16_t*)(P.ws + WS_H), bid, nblk); }
DEVI void ph_wout(const Params& P, int l, int bid, int nblk) {
    const GemmD g = mk_gemm((const bf16_t*)(P.ws + WS_H), (const bf16_t*)(P.ws + WS_WOUTT) + (size_t)l * kD * kD, kD, kD, kTok / 256, 4, nullptr, 0, 1 << 30);
    EpiResid E; E.xin = (l == 0) ? P.x : P.out; E.xout = P.out;
    GEMM_RUN(g, E);
}
DEVI void ph_router(const Params& P, int l, unsigned char* lds, int bid, int nblk) { phase_router(P.out, P.ffn_norm + (size_t)l * kD, P.w_router + (size_t)l * kD * kE, (bf16_t*)(P.ws + WS_H), (float*)(P.ws + WS_AFF), lds, bid, nblk); }
DEVI void ph_topk(const Params& P, unsigned char* lds, int bid, int nblk) { phase_topk((const float*)(P.ws + WS_AFF), (int*)(P.ws + WS_IDX), (float*)(P.ws + WS_GATE), (int*)(P.ws + WS_TSLOT), lds, bid, nblk); }
DEVI void ph_gu(const Params& P, int l, int bid, int nblk) {
    const GemmD g = mk_gemm((const bf16_t*)(P.ws + WS_H), (const bf16_t*)(P.ws + WS_WGUT) + (size_t)l * kE * 4096 * kD, kD, kD, 512, 16, (const int*)(P.ws + WS_IDX), (size_t)4096 * kD, 32);
    EpiGU E; E.hid = (bf16_t*)(P.ws + WS_R1);
    GEMM_RUN(g, E);
}
DEVI void ph_gu_dry(const Params& P, int l, int bid, int nblk) {
    const GemmD g = mk_gemm((const bf16_t*)(P.ws + WS_H), (const bf16_t*)(P.ws + WS_WGUT) + (size_t)l * kE * 4096 * kD, kD, kD, 512, 16, (const int*)(P.ws + WS_IDX), (size_t)4096 * kD, 32);
    EpiDry E; E.sink = (float*)(P.ws + WS_YS);
    GEMM_RUN(g, E);
}
DEVI void ph_down(const Params& P, int l, int bid, int nblk) {
    const GemmD g = mk_gemm((const bf16_t*)(P.ws + WS_R1), (const bf16_t*)(P.ws + WS_WDT) + (size_t)l * kE * kD * kFF, kFF, kFF, 512, 4, nullptr, (size_t)kD * kFF, 32);
    EpiDown E; E.y = (bf16_t*)(P.ws + WS_R2); E.gate = (const float*)(P.ws + WS_GATE);
    GEMM_RUN(g, E);
}
DEVI void ph_combine(const Params& P, int l, int bid, int nblk) { phase_combine(P.out, (const bf16_t*)(P.ws + WS_R2), (const int*)(P.ws + WS_TSLOT), (l + 1 < kL) ? P.attn_norm + (size_t)(l + 1) * kD : nullptr, (bf16_t*)(P.ws + WS_H), bid, nblk); }

#if MEGA
__global__ void __launch_bounds__(kNT, 2) mega_fwd(Params P) {
    volatile LAS unsigned* st = (volatile LAS unsigned*)(dyn_lds + LDS_BYTES - 16);
    if (threadIdx.x == 0) { st[0] = 0u; st[1] = 0u; st[2] = 0u; st[3] = 0u; }
    __syncthreads();
    const XcdBarrier bar = xcd_barrier_post((unsigned*)(P.ws + WS_CTL), st);
    const int bid = blockIdx.x, nblk = gridDim.x;
    unsigned char* lds = dyn_lds;
#pragma unroll 1
    for (int rep = 0; rep < PROBE_CONV; ++rep)
    phase_convert(P, lds, lnd(bid), nblk);
#if USE_S5_GEMM
    ph_s5_prep(P, lds, lnd(bid), nblk);
#endif
    phase_norm(P.x, P.attn_norm, (bf16_t*)(P.ws + WS_H), lnd(bid), nblk);
    xcd_barrier(bar);
#pragma unroll 1
    for (int l = 0; l < kL; ++l) {
        ph_win(P, l, lnd(bid), nblk);            xcd_barrier(bar);
#if USE_S5_GEMM
        ph_s5_state(P, l, lnd(bid), nblk);       xcd_barrier(bar);
        ph_s5_scan(P, l, lds, lnd(bid), nblk);
#pragma unroll 1
        for (int rep = 0; rep < PROBE_ATTN; ++rep)
        ph_dilated(P, l, lnd(bid), nblk);
#pragma unroll 1
        for (int rep = 0; rep < PROBE_NA; ++rep)
        ph_na(P, l, lnd(bid), nblk);             xcd_barrier(bar);
        ph_s5_out(P, l, lnd(bid), nblk);         xcd_barrier(bar);
#else
        ph_s5(P, l, lds, lnd(bid), nblk);
        ph_dilated(P, l, lnd(bid), nblk);
        ph_na(P, l, lnd(bid), nblk);             xcd_barrier(bar);
        ph_s5fin(P, l, lnd(bid), nblk);          xcd_barrier(bar);
#endif
        ph_glu(P, l, lnd(bid), nblk);            xcd_barrier(bar);
#pragma unroll 1
        for (int rep = 0; rep < PROBE_MIX; ++rep) {
        ph_mixnorm(P, l, lnd(bid), nblk);        xcd_barrier(bar); }
        ph_wout(P, l, lnd(bid), nblk);           xcd_barrier(bar);
#pragma unroll 1
        for (int rep = 0; rep < PROBE_RT; ++rep) {
        ph_router(P, l, lds, lnd(bid), nblk);    xcd_barrier(bar); }
#pragma unroll 1
        for (int rep = 0; rep < PROBE_TK; ++rep) {
        ph_topk(P, lds, lnd(bid), nblk);         xcd_barrier(bar); }
#pragma unroll 1
        for (int rep = 0; rep < PROBE_GU; ++rep) {
        ph_gu(P, l, lnd(bid), nblk);             xcd_barrier(bar); }
#if PROBE_GUDRY
        ph_gu_dry(P, l, lnd(bid), nblk);         xcd_barrier(bar);
#endif
#pragma unroll 1
        for (int rep = 0; rep < PROBE_DOWN; ++rep) {
        ph_down(P, l, lnd(bid), nblk);           xcd_barrier(bar); }
        ph_combine(P, l, lnd(bid), nblk);        xcd_barrier(bar);
    }
}
#else
#define KB __global__ void __launch_bounds__(kNT, 2)
KB k_convert(Params P) { phase_convert(P, dyn_lds, blockIdx.x, gridDim.x); }
KB k_norm(Params P) { phase_norm(P.x, P.attn_norm, (bf16_t*)(P.ws + WS_H), blockIdx.x, gridDim.x); }
KB k_win(Params P, int l) { ph_win(P, l, blockIdx.x, gridDim.x); }
KB k_dilated(Params P, int l) { ph_dilated(P, l, blockIdx.x, gridDim.x); }
KB k_na(Params P, int l) { ph_na(P, l, blockIdx.x, gridDim.x); }
KB k_s5(Params P, int l) { ph_s5(P, l, dyn_lds, blockIdx.x, gridDim.x); }
KB k_s5fin(Params P, int l) { ph_s5fin(P, l, blockIdx.x, gridDim.x); }
KB k_glu(Params P, int l) { ph_glu(P, l, blockIdx.x, gridDim.x); }
KB k_mixnorm(Params P, int l) { ph_mixnorm(P, l, blockIdx.x, gridDim.x); }
KB k_wout(Params P, int l) { ph_wout(P, l, blockIdx.x, gridDim.x); }
KB k_router(Params P, int l) { ph_router(P, l, dyn_lds, blockIdx.x, gridDim.x); }
KB k_topk(Params P) { ph_topk(P, dyn_lds, blockIdx.x, gridDim.x); }
KB k_gu(Params P, int l) { ph_gu(P, l, blockIdx.x, gridDim.x); }
KB k_down(Params P, int l) { ph_down(P, l, blockIdx.x, gridDim.x); }
KB k_combine(Params P, int l) { ph_combine(P, l, blockIdx.x, gridDim.x); }
#endif

extern "C" void kernel_launch(void* const* d_in, const int* in_sizes, int n_in, void* d_out, int out_size, void* d_ws, size_t ws_size, hipStream_t stream) {
    (void)in_sizes; (void)n_in; (void)out_size;
    if (ws_size < WS_END) { fprintf(stderr, "workspace too small: %zu < %zu\n", ws_size, (size_t)WS_END); return; }
    Params P{};
    const float** pp = (const float**)&P;
    for (int i = 0; i < 26; ++i) pp[i] = (const float*)d_in[i];
    P.out = (float*)d_out; P.ws = (unsigned char*)d_ws;
#if MEGA
    static int grid = 0;
    if (!grid) {
        int dev = 0, cus = 0, per_cu = 0;
        (void)hipGetDevice(&dev);
        (void)hipDeviceGetAttribute(&cus, hipDeviceAttributeMultiprocessorCount, dev);
        (void)hipFuncSetAttribute((const void*)mega_fwd, hipFuncAttributeMaxDynamicSharedMemorySize, LDS_BYTES);
        (void)hipOccupancyMaxActiveBlocksPerMultiprocessor(&per_cu, (const void*)mega_fwd, kNT, LDS_BYTES);
        grid = (per_cu >= 1) ? cus : 0;
        if (!grid) fprintf(stderr, "mega_fwd does not fit a CU\n");
    }
    if (!grid) return;
    (void)hipMemsetAsync(P.ws + WS_CTL, 0, XCD_BAR_WORDS * sizeof(unsigned), stream);
    mega_fwd<<<grid, kNT, LDS_BYTES, stream>>>(P);
#else
    (void)hipFuncSetAttribute((const void*)k_router, hipFuncAttributeMaxDynamicSharedMemorySize, 65536);
    const int G = 1024;
    k_convert<<<G, kNT, 256 * 72 * 2, stream>>>(P);
    k_norm<<<G, kNT, 0, stream>>>(P);
    for (int l = 0; l < kL; ++l) {
        k_win<<<G, kNT, 0, stream>>>(P, l);
        k_dilated<<<G, kNT, 0, stream>>>(P, l);
        k_na<<<G, kNT, 0, stream>>>(P, l);
        k_s5<<<256, kNT, 8 * 128 * 4, stream>>>(P, l);
        k_s5fin<<<G, kNT, 0, stream>>>(P, l);
        k_glu<<<256, kNT, 0, stream>>>(P, l);
        k_mixnorm<<<G, kNT, 0, stream>>>(P, l);
        k_wout<<<G, kNT, 0, stream>>>(P, l);
        k_router<<<512, kNT, 65536, stream>>>(P, l);
        k_topk<<<128, kNT, 4096, stream>>>(P);
        k_gu<<<G, kNT, 0, stream>>>(P, l);
        k_down<<<G, kNT, 0, stream>>>(P, l);
        k_combine<<<G, kNT, 0, stream>>>(P, l);
    }
#endif
}
```

```cpp
#include <hip/hip_runtime.h>
#include <stdint.h>
#include <stdio.h>

#define DEVI __device__ __forceinline__
#define LAS __attribute__((address_space(3)))
typedef unsigned short bf16_t;
typedef short bf16x8 __attribute__((ext_vector_type(8)));
typedef float f32x4 __attribute__((ext_vector_type(4)));
typedef float f32x2 __attribute__((ext_vector_type(2)));
typedef unsigned u32x4 __attribute__((ext_vector_type(4)));
typedef unsigned u32x2 __attribute__((ext_vector_type(2)));

constexpr int kB = 8, kS = 8192, kD = 1024, kL = 4, kTok = kB * kS;
constexpr int kINW = 2560;
constexpr int kE = 16, kCap = 1024, kFF = 2048;
constexpr int kNT = 512;
constexpr float kEps = 1e-6f;

constexpr size_t MiB = 1024ull * 1024ull;
constexpr size_t WS_CTL   = 0;
constexpr size_t WS_WINT  = 1 * MiB;
constexpr size_t WS_WOUTT = WS_WINT + 20 * MiB;
constexpr size_t WS_WGLUT = WS_WOUTT + 8 * MiB;
constexpr size_t WS_WGUT  = WS_WGLUT + 1 * MiB;
constexpr size_t WS_WDT   = WS_WGUT + 512 * MiB;
constexpr size_t WS_H     = WS_WDT + 256 * MiB;
constexpr size_t WS_R1    = WS_H + 128 * MiB;
constexpr size_t WS_R2    = WS_R1 + 512 * MiB;
constexpr size_t WS_AFF   = WS_R2 + 256 * MiB;
constexpr size_t WS_IDX   = WS_AFF + 4 * MiB;
constexpr size_t WS_GATE  = WS_IDX + 1 * MiB;
constexpr size_t WS_TSLOT = WS_GATE + 1 * MiB;
constexpr size_t WS_LSE   = WS_TSLOT + 4 * MiB;
constexpr size_t WS_WST   = WS_LSE + 8 * MiB;
constexpr size_t WS_WSO   = WS_WST + 8 * MiB;
constexpr size_t WS_YS    = WS_WSO + 16 * MiB;
constexpr size_t WS_END   = WS_YS + 128 * MiB;
constexpr size_t R2_Z     = 192 * MiB;
constexpr size_t R1_QA = 0, R1_KA = 64 * MiB, R1_VA = 128 * MiB, R1_QB = 192 * MiB, R1_KB = 224 * MiB, R1_VB = 256 * MiB,
                 R1_UX = 288 * MiB, R1_OB = 352 * MiB, R1_OC = 384 * MiB, R1_G = 416 * MiB;

struct Params {
    const float* x; const float* attn_norm; const float* w_in; const float* q_norm_a; const float* k_norm_a; const float* q_norm_b; const float* k_norm_b;
    const float* rpb; const float* s5_a_re; const float* s5_a_im; const float* s5_log_dt; const float* s5_b_re; const float* s5_b_im; const float* s5_c_re; const float* s5_c_im;
    const float* s5_d; const float* w_glu; const float* out_norm_a; const float* out_norm_b; const float* out_norm_c; const float* w_out; const float* ffn_norm;
    const float* w_router; const float* w_gate; const float* w_up; const float* w_down;
    float* out; unsigned char* ws;
};

DEVI float bf2f(bf16_t b) { return __uint_as_float(((unsigned)b) << 16); }
DEVI bf16_t f2bf(float f) { unsigned u = __float_as_uint(f); u += 0x7FFFu + ((u >> 16) & 1u); return (bf16_t)(u >> 16); }
typedef __bf16 bf16x2_t __attribute__((ext_vector_type(2)));
DEVI unsigned pk2(float lo, float hi) { const f32x2 v = {lo, hi}; return __builtin_bit_cast(unsigned, __builtin_convertvector(v, bf16x2_t)); }
DEVI int tidx() { int t = threadIdx.x; asm volatile("" : "+v"(t)); return t; }
DEVI unsigned char* wsp(const Params& P) { unsigned long long a = (unsigned long long)P.ws; asm volatile("" : "+s"(a)); return (unsigned char*)a; }
DEVI int lnd(int v) { asm volatile("" : "+s"(v)); return v; }
DEVI float wave_sum(float v) {
#pragma unroll
    for (int m = 32; m >= 1; m >>= 1) v += __shfl_xor(v, m);
    return v;
}
DEVI float frcp(float x) { return __builtin_amdgcn_rcpf(x); }
DEVI float gelu_tanh(float y) { const float z = 0.7978845608028654f * (y + 0.044715f * y * y * y); const float t = 1.f - 2.f * frcp(1.f + __expf(2.f * z)); return 0.5f * y * (1.f + t); }

#ifndef EMU_FP8_GU
#define EMU_FP8_GU 0
#endif
#ifndef EMU_FP8_DN
#define EMU_FP8_DN 0
#endif
DEVI float q8(float x, float sc, float inv) {
    float y = x * sc; const float ay = fabsf(y);
    if (ay < 0.015625f) y = rintf(y * 512.f) * (1.f / 512.f);
    else { unsigned u = __float_as_uint(y); u += 0x7FFFFu + ((u >> 20) & 1u); u &= 0xFFF00000u; y = __uint_as_float(u); y = fminf(fmaxf(y, -448.f), 448.f); }
    return y * inv;
}
#ifndef FP8_GU
#define FP8_GU 1
#endif
#ifndef FP8_DN
#define FP8_DN 0
#endif
constexpr float kW8 = 64.f, kH8 = 8.f;
DEVI unsigned pk4_fp8(float a, float b, float c, float d) { unsigned w = 0u; w = __builtin_amdgcn_cvt_pk_fp8_f32(a, b, w, false); w = __builtin_amdgcn_cvt_pk_fp8_f32(c, d, w, true); return w; }
DEVI int cmap_head(int cs) { const int bj = cs >> 7, wc = (cs >> 5) & 3, n = (cs >> 4) & 1, fq = (cs >> 2) & 3, j = cs & 3; return 64 * wc + 32 * bj + 8 * fq + 4 * n + j; }
DEVI int cmap_pk(int cs)   { const int bj = cs >> 7, wc = (cs >> 5) & 3, n = (cs >> 4) & 1, fq = (cs >> 2) & 3, j = cs & 3; return 128 * bj + 32 * wc + 8 * fq + 4 * n + j; }
DEVI int cmap_gu(int cs)   { const int wc = (cs >> 5) & 3, n = (cs >> 4) & 1, fq = (cs >> 2) & 3, j = cs & 3; return 32 * wc + 8 * fq + 4 * n + j; }

template <int MODE, int QEMU = 0>
DEVI void convert_item(const float* W0, const float* W1, int ldw, int K, bf16_t* Bt, int kt, int pn, unsigned char* lds) {
    bf16_t* t = (bf16_t*)lds;
    const int tid = tidx();
#pragma unroll 4
    for (int it = 0; it < 32; ++it) {
        const int e = it * kNT + tid, k = e >> 8, cs = e & 255;
        float v;
        if (MODE == 0) v = W0[(size_t)(kt * 64 + k) * ldw + pn * 256 + cs];
        else if (MODE == 1) v = W0[(size_t)(kt * 64 + k) * ldw + pn * 256 + cmap_head(cs)];
        else if (MODE == 2) v = W0[(size_t)(kt * 64 + k) * ldw + pn * 256 + cmap_pk(cs)];
        else v = ((cs >> 7) ? W1 : W0)[(size_t)(kt * 64 + k) * ldw + pn * 128 + cmap_gu(cs)];
        if (QEMU) v = q8(v, 64.f, 1.f / 64.f);
        t[cs * 72 + k] = f2bf(v);
    }
    __syncthreads();
#pragma unroll
    for (int it = 0; it < 4; ++it) {
        const int c = it * kNT + tid, row = c >> 3, part = c & 7;
        const u32x4 v = *(const u32x4*)(t + row * 72 + part * 8);
        *(u32x4*)(Bt + (size_t)(pn * 256 + row) * K + kt * 64 + part * 8) = v;
    }
    __syncthreads();
}

template <int MODE>
DEVI void convert_item8(const float* W0, const float* W1, int ldw, int K, unsigned char* Bt, int kt, int pn, unsigned char* lds) {
    unsigned char* t = lds;
    const int tid = tidx();
#pragma unroll 4
    for (int it = 0; it < 64; ++it) {
        const int e = it * kNT + tid, k = e >> 8, cs = e & 255;
        float v;
        if (MODE == 2) v = W0[(size_t)(kt * 128 + k) * ldw + pn * 256 + cmap_pk(cs)];
        else v = ((cs >> 7) ? W1 : W0)[(size_t)(kt * 128 + k) * ldw + pn * 128 + cmap_gu(cs)];
        v *= kW8;
        t[cs * 144 + k] = (unsigned char)(__builtin_amdgcn_cvt_pk_fp8_f32(v, v, 0u, false) & 0xFFu);
    }
    __syncthreads();
#pragma unroll
    for (int it = 0; it < 4; ++it) {
        const int c = it * kNT + tid, row = c >> 3, part = c & 7;
        const u32x4 v = *(const u32x4*)(t + row * 144 + part * 16);
        *(u32x4*)(Bt + (size_t)(pn * 256 + row) * K + kt * 128 + part * 16) = v;
    }
    __syncthreads();
}

DEVI void phase_convert(const Params& P, unsigned char* lds, int bid, int nblk) {
    constexpr int N_WIN = kL * 16 * 10, N_WOUT = kL * 16 * 4, N_WGLU = kL * 4 * 1, N_WGU = kL * kE * (FP8_GU ? 8 : 16) * 16, N_WD = kL * kE * (FP8_DN ? 16 : 32) * 4;
    constexpr int TOT = N_WIN + N_WOUT + N_WGLU + N_WGU + N_WD;
    for (int it = bid; it < TOT; it += nblk) {
        int i = it;
        if (i < N_WIN) { const int l = i / 160, r = i % 160, kt = r / 10, pn = r % 10;
            convert_item<1>(P.w_in + (size_t)l * kD * kINW, nullptr, kINW, kD, (bf16_t*)(wsp(P) + WS_WINT) + (size_t)l * kINW * kD, kt, pn, lds); continue; }
        i -= N_WIN;
        if (i < N_WOUT) { const int l = i / 64, r = i % 64, kt = r / 4, pn = r % 4;
            convert_item<0>(P.w_out + (size_t)l * kD * kD, nullptr, kD, kD, (bf16_t*)(wsp(P) + WS_WOUTT) + (size_t)l * kD * kD, kt, pn, lds); continue; }
        i -= N_WOUT;
        if (i < N_WGLU) { const int l = i / 4, kt = i % 4;
            convert_item<2>(P.w_glu + (size_t)l * 256 * 256, nullptr, 256, 256, (bf16_t*)(wsp(P) + WS_WGLUT) + (size_t)l * 256 * 256, kt, 0, lds); continue; }
        i -= N_WGLU;
#if FP8_GU
        if (i < N_WGU) { const int le = i / 128, r = i % 128, kt = r / 16, pn = r % 16;
            convert_item8<3>(P.w_gate + (size_t)le * kD * kFF, P.w_up + (size_t)le * kD * kFF, kFF, kD, wsp(P) + WS_WGUT + (size_t)le * 4096 * kD, kt, pn, lds); continue; }
#else
        if (i < N_WGU) { const int le = i / 256, r = i % 256, kt = r / 16, pn = r % 16;
            convert_item<3, EMU_FP8_GU>(P.w_gate + (size_t)le * kD * kFF, P.w_up + (size_t)le * kD * kFF, kFF, kD, (bf16_t*)(wsp(P) + WS_WGUT) + (size_t)le * 4096 * kD, kt, pn, lds); continue; }
#endif
        i -= N_WGU;
#if FP8_DN
        { const int le = i / 64, r = i % 64, kt = r / 4, pn = r % 4;
            convert_item8<2>(P.w_down + (size_t)le * kFF * kD, nullptr, kD, kFF, wsp(P) + WS_WDT + (size_t)le * kD * kFF, kt, pn, lds); }
#else
        { const int le = i / 128, r = i % 128, kt = r / 4, pn = r % 4;
            convert_item<2, EMU_FP8_DN>(P.w_down + (size_t)le * kFF * kD, nullptr, kD, kFF, (bf16_t*)(wsp(P) + WS_WDT) + (size_t)le * kD * kFF, kt, pn, lds); }
#endif
    }
}

DEVI void phase_norm(const float* x, const float* gain, bf16_t* h, int bid, int nblk) {
    const int wid = tidx() >> 6, lane = tidx() & 63;
    f32x4 g[4];
#pragma unroll
    for (int q = 0; q < 4; ++q) g[q] = *(const f32x4*)(gain + q * 256 + lane * 4);
    for (int row = bid * 8 + wid; row < kTok; row += nblk * 8) {
        f32x4 v[4]; float ss = 0.f;
#pragma unroll
        for (int q = 0; q < 4; ++q) { v[q] = *(const f32x4*)(x + (size_t)row * kD + q * 256 + lane * 4); ss += v[q].x * v[q].x + v[q].y * v[q].y + v[q].z * v[q].z + v[q].w * v[q].w; }
        ss = wave_sum(ss);
        const float rstd = rsqrtf(ss * (1.f / kD) + kEps);
#pragma unroll
        for (int q = 0; q < 4; ++q) { u32x2 o; o.x = pk2(v[q].x * rstd * g[q].x, v[q].y * rstd * g[q].y); o.y = pk2(v[q].z * rstd * g[q].z, v[q].w * rstd * g[q].w);
            *(u32x2*)(h + (size_t)row * kD + q * 256 + lane * 4) = o; }
    }
}

DEVI void phase_router(const float* x, const float* gain, const float* wr  , bf16_t* h, float* aff, unsigned char* lds, int bid, int nblk) {
    float* wT = (float*)lds;
    for (int i = tidx(); i < 16 * 1024; i += kNT) { const int k = i >> 4, e = i & 15; wT[e * 1024 + k] = wr[i]; }
    __syncthreads();
    const int wid = tidx() >> 6, lane = tidx() & 63;
    f32x4 g[4];
#pragma unroll
    for (int q = 0; q < 4; ++q) g[q] = *(const f32x4*)(gain + q * 256 + lane * 4);
    f32x4 nvx[2][4];
    { const int r0 = (bid * 8 + wid) * 2;
      if (r0 < kTok) {
#pragma unroll
        for (int r = 0; r < 2; ++r)
#pragma unroll
            for (int q = 0; q < 4; ++q) nvx[r][q] = *(const f32x4*)(x + (size_t)(r0 + r) * kD + q * 256 + lane * 4); } }
    for (int row0 = (bid * 8 + wid) * 2; row0 < kTok; row0 += nblk * 8 * 2) {
        asm volatile("" ::: "memory");
        f32x4 v[2][4];
#pragma unroll
        for (int r = 0; r < 2; ++r)
#pragma unroll
            for (int q = 0; q < 4; ++q) v[r][q] = nvx[r][q];
        { const int nr0 = row0 + nblk * 8 * 2;
          if (nr0 < kTok) {
#pragma unroll
            for (int r = 0; r < 2; ++r)
#pragma unroll
                for (int q = 0; q < 4; ++q) nvx[r][q] = *(const f32x4*)(x + (size_t)(nr0 + r) * kD + q * 256 + lane * 4); } }
#pragma unroll
        for (int r = 0; r < 2; ++r) { float ss = 0.f;
#pragma unroll
            for (int q = 0; q < 4; ++q) { ss += v[r][q].x * v[r][q].x + v[r][q].y * v[r][q].y + v[r][q].z * v[r][q].z + v[r][q].w * v[r][q].w; }
            ss = wave_sum(ss); const float rstd = rsqrtf(ss * (1.f / kD) + kEps);
#pragma unroll
            for (int q = 0; q < 4; ++q) { v[r][q] = v[r][q] * rstd * g[q];
#if FP8_GU
                *(unsigned*)((unsigned char*)h + (size_t)(row0 + r) * kD + q * 256 + lane * 4) = pk4_fp8(v[r][q].x, v[r][q].y, v[r][q].z, v[r][q].w); }
#else
                u32x2 o;
                if (EMU_FP8_GU) { o.x = pk2(q8(v[r][q].x, 1.f, 1.f), q8(v[r][q].y, 1.f, 1.f)); o.y = pk2(q8(v[r][q].z, 1.f, 1.f), q8(v[r][q].w, 1.f, 1.f)); }
                else { o.x = pk2(v[r][q].x, v[r][q].y); o.y = pk2(v[r][q].z, v[r][q].w); }
                *(u32x2*)(h + (size_t)(row0 + r) * kD + q * 256 + lane * 4) = o; }
#endif
        }
        float pa[32];
#pragma unroll
        for (int e = 0; e < 16; ++e) {
            float s0 = 0.f, s1 = 0.f;
#pragma unroll
            for (int q = 0; q < 4; ++q) { const f32x4 w = *(const f32x4*)(wT + e * 1024 + q * 256 + lane * 4);
                s0 += v[0][q].x * w.x + v[0][q].y * w.y + v[0][q].z * w.z + v[0][q].w * w.w;
                s1 += v[1][q].x * w.x + v[1][q].y * w.y + v[1][q].z * w.z + v[1][q].w * w.w; }
            pa[e] = s0; pa[16 + e] = s1;
        }
#define RS_STEP(HALF, MASK) { const bool up = (lane & (MASK)) != 0; _Pragma("unroll") for (int i = 0; i < (HALF); ++i) { const float keep = up ? pa[i + (HALF)] : pa[i], send = up ? pa[i] : pa[i + (HALF)]; pa[i] = keep + __shfl_xor(send, (MASK)); } }
        RS_STEP(16, 32) RS_STEP(8, 16) RS_STEP(4, 8) RS_STEP(2, 4) RS_STEP(1, 2)
#undef RS_STEP
        const float logit = pa[0] + __shfl_xor(pa[0], 1);
        float mx = logit;
#pragma unroll
        for (int m = 16; m >= 2; m >>= 1) mx = fmaxf(mx, __shfl_xor(mx, m));
        const float ex = __expf(logit - mx);
        float sm = ex;
#pragma unroll
        for (int m = 16; m >= 2; m >>= 1) sm += __shfl_xor(sm, m);
        const int row = row0 + (lane >> 5), e = (lane >> 1) & 15, b = row >> 13, s = row & (kS - 1);
        if (!(lane & 1)) aff[((size_t)(b * kE + e)) * kS + s] = ex * frcp(sm);
    }
    __syncthreads();
}

DEVI int block_excl_scan(int v, int* sh  , int& total) {
    const int lane = tidx() & 63, wid = tidx() >> 6;
    int incl = v;
#pragma unroll
    for (int d = 1; d < 64; d <<= 1) { const int o = __shfl_up(incl, d); if (lane >= d) incl += o; }
    __syncthreads();
    if (lane == 63) sh[wid] = incl;
    __syncthreads();
    int base = 0, tot = 0;
#pragma unroll
    for (int w = 0; w < 8; ++w) { const int c = sh[w]; if (w < wid) base += c; tot += c; }
    total = tot;
    return base + incl - v;
}

DEVI void phase_topk(const float* aff, int* idx, float* gate, int* tokslot, const unsigned char* hsrc, unsigned char* xe, int rowbytes, unsigned char* lds, int bid, int nblk) {
    int* hist = (int*)lds;
    int* sh = hist + 256;
    int* res = sh + 16;
    int* lsel = res + 16;
    const int tid = tidx(), lane = tid & 63, wid = tid >> 6;
    for (int item = bid; item < kB * kE; item += nblk) {
        const int b = item >> 4, e = item & 15;
        const float* a = aff + (size_t)item * kS;
        unsigned key[16];
#pragma unroll
        for (int q = 0; q < 4; ++q) { const u32x4 v = *(const u32x4*)(a + tid * 16 + q * 4); key[q * 4 + 0] = v.x; key[q * 4 + 1] = v.y; key[q * 4 + 2] = v.z; key[q * 4 + 3] = v.w; }
        unsigned prefix = 0; int kk = kCap;
#pragma unroll 1
        for (int pass = 0; pass < 4; ++pass) {
            const int shift = 24 - 8 * pass;
            __syncthreads();
            if (tid < 256) hist[tid] = 0;
            __syncthreads();
#pragma unroll
            for (int i = 0; i < 16; ++i) { const bool in = (pass == 0) || ((key[i] >> (shift + 8)) == prefix); if (in) atomicAdd(&hist[(key[i] >> shift) & 255], 1); }
            __syncthreads();
            if (wid == 0) {
                int c[4], loc = 0;
#pragma unroll
                for (int j = 0; j < 4; ++j) { c[j] = hist[255 - 4 * lane - j]; loc += c[j]; }
                int incl = loc;
#pragma unroll
                for (int d = 1; d < 64; d <<= 1) { const int o = __shfl_up(incl, d); if (lane >= d) incl += o; }
                const int excl = incl - loc;
                if (excl < kk && kk <= incl) { int run = excl; int bin = 0, nk = 0; bool found = false;
#pragma unroll
                    for (int j = 0; j < 4; ++j) { if (!found && run + c[j] >= kk) { bin = 255 - 4 * lane - j; nk = kk - run; found = true; } if (!found) run += c[j]; }
                    res[0] = bin; res[1] = nk; }
            }
            __syncthreads();
            prefix = (prefix << 8) | (unsigned)res[0]; kk = res[1];
        }
        const unsigned T = prefix;
        int ceq = 0;
#pragma unroll
        for (int i = 0; i < 16; ++i) ceq += (key[i] == T) ? 1 : 0;
        int tot;
        int eqb = block_excl_scan(ceq, sh, tot);
        int csel = 0; unsigned selmask = 0;
#pragma unroll
        for (int i = 0; i < 16; ++i) { bool s = key[i] > T; if (key[i] == T) { s = eqb < kk; ++eqb; } if (s) { selmask |= 1u << i; ++csel; } }
        int slot = block_excl_scan(csel, sh, tot);
        const size_t rbase = (size_t)(e * kB + b) * kCap;
#pragma unroll
        for (int i = 0; i < 16; ++i) { const int s = tid * 16 + i; const bool sel = (selmask >> i) & 1u;
            if (sel) { idx[rbase + slot] = b * kS + s; gate[rbase + slot] = __uint_as_float(key[i]); lsel[slot] = b * kS + s; }
            tokslot[((size_t)(b * kS + s)) * kE + e] = sel ? slot : -1;
            if (sel) ++slot; }
        __syncthreads();
        { const int cpr = rowbytes >> 4;
          for (int c0 = tid; c0 < kCap * cpr; c0 += kNT * 4) {
              u32x4 v[4];
#pragma unroll
              for (int j = 0; j < 4; ++j) { const int c = c0 + j * kNT; const int r = c / cpr, ch = c - r * cpr; v[j] = *(const u32x4*)(hsrc + (size_t)lsel[r] * rowbytes + ch * 16); }
#pragma unroll
              for (int j = 0; j < 4; ++j) { const int c = c0 + j * kNT; const int r = c / cpr, ch = c - r * cpr; *(u32x4*)(xe + (rbase + r) * rowbytes + ch * 16) = v[j]; }
          } }
    }
    __syncthreads();
}

struct Unit { int pm, pn; };
DEVI bool unit_of(int Lid, int nM, int nN, Unit& u) {
    const int nwg = nM * nN; if (Lid >= nwg) return false;
    int wgid = Lid; { const int q = nwg / 8, r = nwg % 8, xcd = wgid % 8, off = wgid / 8; wgid = (xcd < r ? xcd * (q + 1) : r * (q + 1) + (xcd - r) * q) + off; }
    const int nig = 8 * nN, gid = wgid / nig, fm = gid * 8, gsz = (nM - fm) < 8 ? (nM - fm) : 8;
    u.pm = fm + ((wgid % nig) % gsz); u.pn = (wgid % nig) / gsz; return true;
}
struct GemmD { const bf16_t* A; const bf16_t* Bt; int lda, K, nM, nN; const int* rowidx; size_t bstride; int pmg; };

template <class Epi>
DEVI void gemm_simple(const GemmD g, const Epi& E, int bid, int nblk) {
    const int tid = tidx(), wid = tid >> 6, lane = tid & 63, wr = wid >> 2, wc = wid & 3, fr = lane & 15, fq = lane >> 4;
    for (int i = 0;; ++i) {
        Unit u; if (!unit_of(i * nblk + bid, g.nM, g.nN, u)) break;
        f32x4 acc[2][2][4][2];
#pragma unroll
        for (int a = 0; a < 2; ++a)
#pragma unroll
            for (int b = 0; b < 2; ++b)
#pragma unroll
                for (int m = 0; m < 4; ++m)
#pragma unroll
                    for (int n = 0; n < 2; ++n) acc[a][b][m][n] = (f32x4){0.f, 0.f, 0.f, 0.f};
        const bf16_t* Bu = g.Bt + (size_t)(u.pm / g.pmg) * g.bstride + (size_t)u.pn * 256 * g.K;
        unsigned ao[2][4], bo[2][2];
#pragma unroll
        for (int a = 0; a < 2; ++a)
#pragma unroll
            for (int m = 0; m < 4; ++m) { const int r = u.pm * 256 + 128 * a + 64 * wr + 16 * m + fr; const unsigned rr = g.rowidx ? (unsigned)g.rowidx[r] : (unsigned)r; ao[a][m] = rr * (unsigned)g.lda + 8u * fq; }
#pragma unroll
        for (int b = 0; b < 2; ++b)
#pragma unroll
            for (int n = 0; n < 2; ++n) bo[b][n] = (unsigned)(128 * b + 32 * wc + 16 * n + fr) * (unsigned)g.K + 8u * fq;
#pragma unroll 1
        for (int k0 = 0; k0 < g.K; k0 += 32) {
            bf16x8 av[2][4], bv[2][2];
#pragma unroll
            for (int a = 0; a < 2; ++a)
#pragma unroll
                for (int m = 0; m < 4; ++m) av[a][m] = *(const bf16x8*)(g.A + ao[a][m] + k0);
#pragma unroll
            for (int b = 0; b < 2; ++b)
#pragma unroll
                for (int n = 0; n < 2; ++n) bv[b][n] = *(const bf16x8*)(Bu + bo[b][n] + k0);
#pragma unroll
            for (int a = 0; a < 2; ++a)
#pragma unroll
                for (int b = 0; b < 2; ++b)
#pragma unroll
                    for (int m = 0; m < 4; ++m)
#pragma unroll
                        for (int n = 0; n < 2; ++n) acc[a][b][m][n] = __builtin_amdgcn_mfma_f32_16x16x32_bf16(bv[b][n], av[a][m], acc[a][b][m][n], 0, 0, 0);
        }
        E(acc, u, wr, wc, fr, fq);
    }
}


constexpr int PG_HTB = 128 * 64 * 2;
DEVI int pg_lds_byte(int r, int c) { const int st = (r >> 4) * 2 + (c >> 5), rr = r & 15, cc = c & 31, ob = rr * 64 + cc * 2; return st * 1024 + (ob ^ (((ob >> 9) & 1) << 5)); }
DEVI void pg_stage_rc(int b, int& R, int& C) { const int st = b / 1024, sb = b % 1024, swz = sb ^ (((sb >> 9) & 1) << 5); R = (st >> 1) * 16 + swz / 64; C = (st & 1) * 32 + (swz % 64) / 2; }

typedef int v4i __attribute__((ext_vector_type(4)));
typedef int v8i __attribute__((ext_vector_type(8)));
template <class Epi, bool ALIGN_EPI, bool SP2, bool FP8 = false>
DEVI void gemm_engine(LAS unsigned char* lds, const GemmD g, const Epi& E, int bid, int nblk) {
    const int tid = tidx(), wid = __builtin_amdgcn_readfirstlane(tid >> 6), lane = tid & 63, wr = wid >> 2, wc = wid & 3, fr = lane & 15, fq = lane >> 4;
    constexpr int ES = FP8 ? 1 : 2;
    const int K = g.K * ES  , nt = K / 128; const unsigned ldaB = (unsigned)g.lda * ES;
    unsigned voffA[2], voffB[2];
#pragma unroll
    for (int i = 0; i < 2; ++i) { int R, C; pg_stage_rc(tid * 16 + i * 8192, R, C); voffA[i] = (unsigned)R * ldaB + (unsigned)C * 2u; voffB[i] = (unsigned)(R * K + C * 2); }
    const size_t kstep = 128;
    const size_t hstepB = (size_t)128 * K, hstepA = (size_t)128 * ldaB, tstepA = 2 * hstepA;
    const unsigned ldsw = (unsigned)wid * 1024u;
    const int aoff = pg_lds_byte(wr * 64 + fr, fq * 8), boff = pg_lds_byte(wc * 32 + fr, fq * 8);
#define PG8_SA(b, h) (((b) * 2 + (h)) * PG_HTB)
#define PG8_SB(b, h) ((4 + (b) * 2 + (h)) * PG_HTB)
#define PG8_STAGE(bufoff, gbase, voff) do { _Pragma("unroll") for (int _i = 0; _i < 2; ++_i) \
        __builtin_amdgcn_global_load_lds((const unsigned*)((const char*)(gbase) + (voff)[_i]), (LAS unsigned*)(lds + (bufoff) + ldsw + _i * 8192), 16, 0, 0); } while (0)
#define PG8_RD16(off) (*(const LAS v4i*)(lds + (off)))
#define PG8_CAT2(off) __builtin_shufflevector(PG8_RD16(off), PG8_RD16((off) + 1024), 0, 1, 2, 3, 4, 5, 6, 7)
#define PG8_LDA(dst, b, h) do { _Pragma("unroll") for (int m = 0; m < 4; ++m) { if constexpr (FP8) dst##8[m] = PG8_CAT2(PG8_SA(b, h) + aoff + m * 2048); \
        else { _Pragma("unroll") for (int k = 0; k < 2; ++k) dst[m][k] = *(const LAS bf16x8*)(lds + PG8_SA(b, h) + aoff + m * 2048 + k * 1024); } } } while (0)
#define PG8_LDB(dst, b, h) do { _Pragma("unroll") for (int n = 0; n < 2; ++n) { if constexpr (FP8) dst##8[n] = PG8_CAT2(PG8_SB(b, h) + boff + n * 2048); \
        else { _Pragma("unroll") for (int k = 0; k < 2; ++k) dst[n][k] = *(const LAS bf16x8*)(lds + PG8_SB(b, h) + boff + n * 2048 + k * 1024); } } } while (0)
#define PG8_MMA(ai, bj, At, Bt) do { __builtin_amdgcn_s_setprio(1); _Pragma("unroll") for (int m = 0; m < 4; ++m) _Pragma("unroll") for (int n = 0; n < 2; ++n) { \
        if constexpr (FP8) asm volatile("v_mfma_f32_16x16x128_f8f6f4 %0, %1, %2, %0" : "+v"(acc[ai][bj][m][n]) : "v"(Bt##8[n]), "v"(At##8[m]));   \
        else { _Pragma("unroll") for (int k = 0; k < 2; ++k) acc[ai][bj][m][n] = __builtin_amdgcn_mfma_f32_16x16x32_bf16(Bt[n][k], At[m][k], acc[ai][bj][m][n], 0, 0, 0); } } \
        __builtin_amdgcn_s_setprio(0); } while (0)
#define PG8_WAIT_V(n) asm volatile("s_waitcnt vmcnt(" #n ")" ::: "memory")
#define PG8_WAIT_L(n) asm volatile("s_waitcnt lgkmcnt(" #n ")" ::: "memory")
#define PG8_BAR __builtin_amdgcn_s_barrier()
#define PG8_SCHED __builtin_amdgcn_sched_barrier(0)
    Unit cur, nxt; int ui = 0;
    if (!unit_of(bid, g.nM, g.nN, cur)) return;
    f32x4 acc[2][2][4][2];
#pragma unroll
    for (int a = 0; a < 2; ++a)
#pragma unroll
        for (int b = 0; b < 2; ++b)
#pragma unroll
            for (int m = 0; m < 4; ++m)
#pragma unroll
                for (int n = 0; n < 2; ++n) acc[a][b][m][n] = (f32x4){0.f, 0.f, 0.f, 0.f};
    bf16x8 At[4][2], B0[2][2], B1[2][2]; v8i At8[4], B08[2], B18[2];
    (void)At; (void)B0; (void)B1; (void)At8; (void)B08; (void)B18;
    static_assert(SP2, "only the two-super-phase K-loop is kept");
    const char* cA = (const char*)g.A + (size_t)cur.pm * tstepA;
    const char* cB = (const char*)g.Bt + (size_t)(cur.pm / g.pmg) * g.bstride * ES + (size_t)cur.pn * 256 * K;
    PG8_STAGE(PG8_SB(0, 0), cB, voffB); PG8_STAGE(PG8_SB(0, 1), cB + hstepB, voffB); PG8_STAGE(PG8_SA(0, 0), cA, voffA); PG8_STAGE(PG8_SA(0, 1), cA + hstepA, voffA);
    if (wr == 1) PG8_BAR;
    PG8_WAIT_V(2); PG8_BAR;
    PG8_STAGE(PG8_SB(1, 0), cB + kstep, voffB); PG8_STAGE(PG8_SA(1, 0), cA + kstep, voffA); PG8_STAGE(PG8_SB(1, 1), cB + hstepB + kstep, voffB);
    PG8_WAIT_V(6); PG8_BAR;
    for (;;) {
        const bool has_next = unit_of((ui + 1) * nblk + bid, g.nM, g.nN, nxt);
        const char* nA = has_next ? (const char*)g.A + (size_t)nxt.pm * tstepA : cA;
        const char* nB = has_next ? (const char*)g.Bt + (size_t)(nxt.pm / g.pmg) * g.bstride * ES + (size_t)nxt.pn * 256 * K : cB;
#pragma unroll 1
        for (int t = 0; t < nt; t += 2) {
            const bool last = (t == nt - 2);
            const char* a1 = cA + (size_t)(t + 1) * kstep;
            const char* a2 = last ? nA : cA + (size_t)(t + 2) * kstep; const char* b2 = last ? nB : cB + (size_t)(t + 2) * kstep;
            const char* a3 = a2 + kstep; const char* b3 = b2 + kstep;
            PG8_LDB(B0, 0, 0); PG8_LDB(B1, 0, 1); PG8_SCHED; PG8_LDA(At, 0, 0); PG8_STAGE(PG8_SA(1, 1), a1 + hstepA, voffA);
            PG8_WAIT_V(8); PG8_WAIT_L(0); PG8_BAR; PG8_MMA(0, 0, At, B0); PG8_MMA(0, 1, At, B1); PG8_BAR; PG8_SCHED;
            PG8_LDA(At, 0, 1); PG8_STAGE(PG8_SB(0, 0), b2, voffB); PG8_STAGE(PG8_SB(0, 1), b2 + hstepB, voffB); PG8_STAGE(PG8_SA(0, 0), a2, voffA);
            PG8_WAIT_V(8); PG8_WAIT_L(0); PG8_BAR; PG8_MMA(1, 0, At, B0); PG8_MMA(1, 1, At, B1); PG8_BAR; PG8_SCHED;
            PG8_LDB(B0, 1, 0); PG8_LDB(B1, 1, 1); PG8_SCHED; PG8_LDA(At, 1, 0); PG8_STAGE(PG8_SA(0, 1), a2 + hstepA, voffA);
            PG8_WAIT_V(8); PG8_WAIT_L(0); PG8_BAR; PG8_MMA(0, 0, At, B0); PG8_MMA(0, 1, At, B1); PG8_BAR; PG8_SCHED;
            PG8_LDA(At, 1, 1); PG8_STAGE(PG8_SB(1, 0), b3, voffB); PG8_STAGE(PG8_SB(1, 1), b3 + hstepB, voffB); PG8_STAGE(PG8_SA(1, 0), a3, voffA);
            PG8_WAIT_V(8); PG8_WAIT_L(0); PG8_BAR; PG8_MMA(1, 0, At, B0); PG8_MMA(1, 1, At, B1); PG8_BAR; PG8_SCHED;
        }
        if constexpr (ALIGN_EPI) { if (wr == 0) PG8_BAR; }
        if constexpr (FP8) asm volatile("s_nop 15\n\ts_nop 15" ::: "memory");
        E(acc, cur, wr, wc, fr, fq);
        if (!has_next) break;
#pragma unroll
        for (int a = 0; a < 2; ++a)
#pragma unroll
            for (int b = 0; b < 2; ++b)
#pragma unroll
                for (int m = 0; m < 4; ++m)
#pragma unroll
                    for (int n = 0; n < 2; ++n) acc[a][b][m][n] = (f32x4){0.f, 0.f, 0.f, 0.f};
        cur = nxt; cA = nA; cB = nB; ++ui;
        if constexpr (ALIGN_EPI) { if (wr == 1) PG8_BAR; }
    }
    PG8_WAIT_V(0);
    if constexpr (!ALIGN_EPI) { if (wr == 0) PG8_BAR; }
    PG8_BAR;
#undef PG8_SA
#undef PG8_SB
#undef PG8_STAGE
#undef PG8_LDA
#undef PG8_LDB
#undef PG8_MMA
#undef PG8_RD16
#undef PG8_CAT2
#undef PG8_WAIT_V
#undef PG8_WAIT_L
#undef PG8_BAR
#undef PG8_SCHED
}

struct EpiQKV {
    static constexpr int VMOPS = 16;
    bf16_t *qa, *ka, *va, *qb, *kb, *vb, *ux; const float *qna, *kna, *qnb, *knb;
    DEVI void operator()(const f32x4 (&acc)[2][2][4][2], const Unit& u, int wr, int wc, int fr, int fq) const {
        bf16_t* dst; const float* gn = nullptr; int H = 8, head0 = 0; const int pn = u.pn;
        if (pn < 2) { dst = qa; gn = qna; head0 = pn * 4; }
        else if (pn < 4) { dst = ka; gn = kna; head0 = (pn - 2) * 4; }
        else if (pn < 6) { dst = va; head0 = (pn - 4) * 4; }
        else if (pn == 6) { dst = qb; gn = qnb; H = 4; }
        else if (pn == 7) { dst = kb; gn = knb; H = 4; }
        else if (pn == 8) { dst = vb; H = 4; }
        else { dst = ux; }
        const int head = head0 + wc;
        f32x4 gv[2][2];
#pragma unroll
        for (int bj = 0; bj < 2; ++bj)
#pragma unroll
            for (int n = 0; n < 2; ++n) gv[bj][n] = gn ? *(const f32x4*)(gn + 32 * bj + 8 * fq + 4 * n) : (f32x4){1.f, 1.f, 1.f, 1.f};
#pragma unroll
        for (int ai = 0; ai < 2; ++ai)
#pragma unroll
            for (int m = 0; m < 4; ++m) {
                const int row = u.pm * 256 + 128 * ai + 64 * wr + 16 * m + fr;
                float rstd = 1.f;
                if (gn) { float ss = 0.f;
#pragma unroll
                    for (int bj = 0; bj < 2; ++bj)
#pragma unroll
                        for (int n = 0; n < 2; ++n) { const f32x4 v = acc[ai][bj][m][n]; ss += v.x * v.x + v.y * v.y + v.z * v.z + v.w * v.w; }
                    ss += __shfl_xor(ss, 16); ss += __shfl_xor(ss, 32);
                    rstd = rsqrtf(ss * (1.f / 64.f) + kEps); }
#pragma unroll
                for (int bj = 0; bj < 2; ++bj) {
                    const f32x4 v0 = acc[ai][bj][m][0] * rstd * gv[bj][0], v1 = acc[ai][bj][m][1] * rstd * gv[bj][1];
                    u32x4 w; w.x = pk2(v0.x, v0.y); w.y = pk2(v0.z, v0.w); w.z = pk2(v1.x, v1.y); w.w = pk2(v1.z, v1.w);
                    if (pn < 9) { const int b = row >> 13, s = row & (kS - 1);
                        *(u32x4*)(dst + (((size_t)(b * H + head)) * kS + s) * 64 + 32 * bj + 8 * fq) = w; }
                    else { const int gidx = 4 * wc + 2 * bj + (fq >> 1), c0 = 8 * (fq & 1);
                        *(u32x4*)(dst + ((size_t)gidx * 4096 + (row >> 4)) * 512 + (row & 15) * 16 + c0) = w; }
                }
            }
    }
};
struct EpiResid {
    static constexpr int VMOPS = 32;
    const float* xin; float* xout;
    DEVI void operator()(const f32x4 (&acc)[2][2][4][2], const Unit& u, int wr, int wc, int fr, int fq) const {
#pragma unroll
        for (int ai = 0; ai < 2; ++ai)
#pragma unroll
            for (int m = 0; m < 4; ++m) { const size_t ro = (size_t)(u.pm * 256 + 128 * ai + 64 * wr + 16 * m + fr) * kD + u.pn * 256 + 32 * wc + 4 * fq;
#pragma unroll
                for (int bj = 0; bj < 2; ++bj)
#pragma unroll
                    for (int n = 0; n < 2; ++n) { const size_t o = ro + 128 * bj + 16 * n; *(f32x4*)(xout + o) = *(const f32x4*)(xin + o) + acc[ai][bj][m][n]; } }
    }
};
struct EpiGU {
    static constexpr int VMOPS = 8;
    bf16_t* hid; float sc;
    DEVI void operator()(const f32x4 (&acc)[2][2][4][2], const Unit& u, int wr, int wc, int fr, int fq) const {
#pragma unroll
        for (int ai = 0; ai < 2; ++ai)
#pragma unroll
            for (int m = 0; m < 4; ++m) { const size_t row = (size_t)(u.pm * 256 + 128 * ai + 64 * wr + 16 * m + fr);
                float o[8];
#pragma unroll
                for (int n = 0; n < 2; ++n)
#pragma unroll
                    for (int j = 0; j < 4; ++j) { const float gt = acc[ai][0][m][n][j] * sc, up = acc[ai][1][m][n][j] * sc; o[n * 4 + j] = gt * frcp(1.f + __expf(-gt)) * up; if (EMU_FP8_DN) o[n * 4 + j] = q8(o[n * 4 + j], 8.f, 0.125f); }
#if FP8_DN
                u32x2 w;
#pragma unroll
                for (int t = 0; t < 8; ++t) o[t] = fminf(fmaxf(o[t] * kH8, -448.f), 448.f);
                w.x = pk4_fp8(o[0], o[1], o[2], o[3]); w.y = pk4_fp8(o[4], o[5], o[6], o[7]);
                *(u32x2*)((unsigned char*)hid + row * kFF + u.pn * 128 + 32 * wc + 8 * fq) = w;
#else
                u32x4 w; w.x = pk2(o[0], o[1]); w.y = pk2(o[2], o[3]); w.z = pk2(o[4], o[5]); w.w = pk2(o[6], o[7]);
                *(u32x4*)(hid + row * kFF + u.pn * 128 + 32 * wc + 8 * fq) = w;
#endif
            }
    }
};
struct EpiDry {
    static constexpr int VMOPS = 0;
    float* sink;
    DEVI void operator()(const f32x4 (&acc)[2][2][4][2], const Unit& u, int wr, int wc, int fr, int fq) const {
        float t = 0.f;
#pragma unroll
        for (int ai = 0; ai < 2; ++ai)
#pragma unroll
            for (int bj = 0; bj < 2; ++bj)
#pragma unroll
                for (int m = 0; m < 4; ++m)
#pragma unroll
                    for (int n = 0; n < 2; ++n) t += acc[ai][bj][m][n].x + acc[ai][bj][m][n].y + acc[ai][bj][m][n].z + acc[ai][bj][m][n].w;
        if (t == 1.2345e30f) sink[0] = t;
    }
};
struct EpiDown {
    static constexpr int VMOPS = 16;
    bf16_t* y; const float* gate; float sc;
    DEVI void operator()(const f32x4 (&acc)[2][2][4][2], const Unit& u, int wr, int wc, int fr, int fq) const {
#pragma unroll
        for (int ai = 0; ai < 2; ++ai)
#pragma unroll
            for (int m = 0; m < 4; ++m) { const size_t row = (size_t)(u.pm * 256 + 128 * ai + 64 * wr + 16 * m + fr); const float gv = gate[row] * sc;
#pragma unroll
                for (int bj = 0; bj < 2; ++bj) { const f32x4 v0 = acc[ai][bj][m][0] * gv, v1 = acc[ai][bj][m][1] * gv;
                    u32x4 w; w.x = pk2(v0.x, v0.y); w.y = pk2(v0.z, v0.w); w.z = pk2(v1.x, v1.y); w.w = pk2(v1.z, v1.w);
                    *(u32x4*)(y + row * kD + u.pn * 256 + 128 * bj + 32 * wc + 8 * fq) = w; } }
    }
};
struct EpiGlu {
    static constexpr int VMOPS = 16;
    const bf16_t* g; bf16_t* oc;
    DEVI void operator()(const f32x4 (&acc)[2][2][4][2], const Unit& u, int wr, int wc, int fr, int fq) const {
#pragma unroll
        for (int ai = 0; ai < 2; ++ai)
#pragma unroll
            for (int m = 0; m < 4; ++m) { const size_t row = (size_t)(u.pm * 256 + 128 * ai + 64 * wr + 16 * m + fr);
#pragma unroll
                for (int bj = 0; bj < 2; ++bj) { const size_t o = row * 256 + 128 * bj + 32 * wc + 8 * fq;
                    const u32x4 gw = *(const u32x4*)(g + o); float o8[8];
#pragma unroll
                    for (int n = 0; n < 2; ++n)
#pragma unroll
                        for (int j = 0; j < 4; ++j) { const int t = n * 4 + j; const unsigned wv = (t < 2) ? gw.x : (t < 4) ? gw.y : (t < 6) ? gw.z : gw.w;
                            const float gg = __uint_as_float((t & 1) ? (wv & 0xFFFF0000u) : (wv << 16)); o8[t] = gg * frcp(1.f + __expf(-acc[ai][bj][m][n][j])); }
                    u32x4 w; w.x = pk2(o8[0], o8[1]); w.y = pk2(o8[2], o8[3]); w.z = pk2(o8[4], o8[5]); w.w = pk2(o8[6], o8[7]);
                    *(u32x4*)(oc + o) = w; } }
    }
};

DEVI void load_row64(const bf16_t* p, float* d) {
#pragma unroll
    for (int i = 0; i < 8; ++i) { const u32x4 v = *(const u32x4*)(p + i * 8);
        d[i * 8 + 0] = __uint_as_float(v.x << 16); d[i * 8 + 1] = __uint_as_float(v.x & 0xFFFF0000u); d[i * 8 + 2] = __uint_as_float(v.y << 16); d[i * 8 + 3] = __uint_as_float(v.y & 0xFFFF0000u);
        d[i * 8 + 4] = __uint_as_float(v.z << 16); d[i * 8 + 5] = __uint_as_float(v.z & 0xFFFF0000u); d[i * 8 + 6] = __uint_as_float(v.w << 16); d[i * 8 + 7] = __uint_as_float(v.w & 0xFFFF0000u); }
}
DEVI void store_row64(bf16_t* p, const float* d, float sc) {
#pragma unroll
    for (int i = 0; i < 8; ++i) { u32x4 w; w.x = pk2(d[i * 8] * sc, d[i * 8 + 1] * sc); w.y = pk2(d[i * 8 + 2] * sc, d[i * 8 + 3] * sc); w.z = pk2(d[i * 8 + 4] * sc, d[i * 8 + 5] * sc); w.w = pk2(d[i * 8 + 6] * sc, d[i * 8 + 7] * sc);
        *(u32x4*)(p + i * 8) = w; }
}
DEVI void phase_dilated_naive(const bf16_t* qa, const bf16_t* ka, const bf16_t* va, bf16_t* oac, float* lse, int bid, int nblk) {
    const int nitems = 3 * kB * 8 * (kS / kNT);
    for (int it = bid; it < nitems; it += nblk) {
        const int c = it / (kB * 8 * 16), r = it % (kB * 8 * 16), bh = r / 16, t = (r % 16) * kNT + tidx(), b = bh >> 3, h = bh & 7;
        const int dil = (c == 0) ? 1 : (c == 1) ? 4 : 16;
        const float slope = exp2f(-(float)(h + 1));
        const bf16_t* kb_ = ka + (size_t)bh * kS * 64; const bf16_t* vb_ = va + (size_t)bh * kS * 64;
        float q[64], o[64];
        load_row64(qa + ((size_t)bh * kS + t) * 64, q);
#pragma unroll
        for (int d = 0; d < 64; ++d) o[d] = 0.f;
        float m = -1e30f, l = 0.f;
        for (int rel = -64; rel <= 64; ++rel) {
            const int pos = t + rel * dil;
            if (pos < 0 || pos >= kS) continue;
            float kv[64]; load_row64(kb_ + (size_t)pos * 64, kv);
            float dot = 0.f;
#pragma unroll
            for (int d = 0; d < 64; ++d) dot += q[d] * kv[d];
            const float sc = dot * 0.125f - slope * (float)(dil * (rel < 0 ? -rel : rel));
            const float mn = fmaxf(m, sc), corr = __expf(m - mn), p = __expf(sc - mn);
            load_row64(vb_ + (size_t)pos * 64, kv);
            l = l * corr + p;
#pragma unroll
            for (int d = 0; d < 64; ++d) o[d] = o[d] * corr + p * kv[d];
            m = mn;
        }
        const size_t tok = (size_t)b * kS + t;
        store_row64(oac + ((size_t)c * kTok + tok) * 512 + h * 64, o, 1.f / l);
        lse[((size_t)c * kTok + tok) * 8 + h] = m + __logf(l);
    }
}
DEVI void phase_na_naive(const bf16_t* qb, const bf16_t* kbuf, const bf16_t* vbuf, const float* rpb  , bf16_t* ob, int bid, int nblk) {
    const int nitems = kB * 4 * (kS / kNT);
    for (int it = bid; it < nitems; it += nblk) {
        const int bh = it / 16, t = (it % 16) * kNT + tidx(), b = bh >> 2, h = bh & 3;
        const int r = t >> 6, cq = t & 63;
        int rs = r - 4; rs = rs < 0 ? 0 : (rs > 120 ? 120 : rs);
        int cs = cq - 8; cs = cs < 0 ? 0 : (cs > 48 ? 48 : cs);
        const bf16_t* kb_ = kbuf + (size_t)bh * kS * 64; const bf16_t* vb_ = vbuf + (size_t)bh * kS * 64;
        float q[64], o[64];
        load_row64(qb + ((size_t)bh * kS + t) * 64, q);
#pragma unroll
        for (int d = 0; d < 64; ++d) o[d] = 0.f;
        float m = -1e30f, l = 0.f;
        for (int kr = 0; kr < 8; ++kr)
            for (int kc = 0; kc < 16; ++kc) {
                const int krow = rs + kr, kcol = cs + kc, pos = krow * 64 + kcol;
                float kv[64]; load_row64(kb_ + (size_t)pos * 64, kv);
                float dot = 0.f;
#pragma unroll
                for (int d = 0; d < 64; ++d) dot += q[d] * kv[d];
                const float sc = dot * 0.125f + rpb[(h * 15 + (krow - r + 7)) * 31 + (kcol - cq + 15)];
                const float mn = fmaxf(m, sc), corr = __expf(m - mn), p = __expf(sc - mn);
                load_row64(vb_ + (size_t)pos * 64, kv);
                l = l * corr + p;
#pragma unroll
                for (int d = 0; d < 64; ++d) o[d] = o[d] * corr + p * kv[d];
                m = mn;
            }
        store_row64(ob + ((size_t)b * kS + t) * 256 + h * 64, o, 1.f / l);
    }
}

typedef float f32x16 __attribute__((ext_vector_type(16)));
typedef short s16x4 __attribute__((ext_vector_type(4)));
constexpr float kLog2e = 1.4426950408889634f, kLn2 = 0.6931471805599453f;
DEVI bf16x8 tr_pair(LAS unsigned char* p0, LAS unsigned char* p1) {
    const s16x4 a = __builtin_amdgcn_ds_read_tr16_b64_v4i16((LAS s16x4*)p0), b = __builtin_amdgcn_ds_read_tr16_b64_v4i16((LAS s16x4*)p1);
    return (bf16x8){a.x, a.y, a.z, a.w, b.x, b.y, b.z, b.w};
}
DEVI void phase_dilated(const bf16_t* qa, const bf16_t* ka, const bf16_t* va, const float* gq, const float* gk, bf16_t* oac, float* lse, LAS unsigned char* lds, int bid, int nblk) {
    const int tid = tidx(), wid = __builtin_amdgcn_readfirstlane(tid >> 6), lane = tid & 63, h5 = lane >> 5, qc = lane & 31;
    LAS unsigned char* Kimg = lds; LAS unsigned char* Vimg = lds + 49152;
    float Mn;
    { float a = fabsf(gq[lane]), b = fabsf(gk[lane]);
#pragma unroll
      for (int m = 32; m >= 1; m >>= 1) { a = fmaxf(a, __shfl_xor(a, m)); b = fmaxf(b, __shfl_xor(b, m)); }
      Mn = 8.f * a * b; }
    const float Mb = Mn * kLog2e;
    unsigned koff[4];
#pragma unroll
    for (int s = 0; s < 4; ++s) koff[s] = (unsigned)((32 * wid + qc) * 128 + (((2 * s + h5) ^ (qc & 7)) << 4));
    unsigned voff[2];
    { const int g = lane >> 4, i16 = lane & 15, q = i16 >> 2, p = i16 & 3;
#pragma unroll
      for (int dt = 0; dt < 2; ++dt) { const int c = (2 * (g & 1) + (p >> 1) + 4 * dt) ^ ((q >> 1) << 2); voff[dt] = (unsigned)((32 * wid + 4 * h5 + q) * 128 + (c << 4) + 8 * (p & 1)); } }
    float dv[16];
#pragma unroll
    for (int i = 0; i < 16; ++i) dv[i] = (float)((i & 3) + 8 * (i >> 2) + 4 * h5 - qc);
    u32x4 pK[6], pV[6]; bf16x8 pQ[4];
#define DIL_DECODE(unit_) const int c = (unit_) >> 11, rem = (unit_) & 2047, bh = rem >> 5, ub = rem & 31; \
        const int dsh = 2 * c, L = kS >> dsh, upc = 32 >> dsh, cls = ub >> (5 - dsh), u0 = (ub & (upc - 1)) << 8;
#define DIL_PREFETCH(unit_) do { DIL_DECODE(unit_) \
        const bf16_t* kbase = ka + (size_t)bh * kS * 64; const bf16_t* vbase = va + (size_t)bh * kS * 64; \
        { const int qtok_ = ((u0 + 32 * wid + qc) << dsh) + cls; _Pragma("unroll") for (int s = 0; s < 4; ++s) pQ[s] = *(const bf16x8*)(qa + ((size_t)bh * kS + qtok_) * 64 + 16 * s + 8 * h5); } \
        _Pragma("unroll") for (int it = 0; it < 6; ++it) { const int id = it * kNT + tid, row = id >> 3, ch = id & 7; \
            int ki = u0 - 64 + row; ki = ki < 0 ? 0 : (ki > L - 1 ? L - 1 : ki); const size_t tok = (size_t)((ki << dsh) + cls); \
            pK[it] = *(const u32x4*)(kbase + tok * 64 + ch * 8); pV[it] = *(const u32x4*)(vbase + tok * 64 + ch * 8); } } while (0)
    if (bid < 6144) DIL_PREFETCH(bid);
    for (int unit = bid; unit < 6144; unit += nblk) {
        DIL_DECODE(unit)
        __syncthreads();
#pragma unroll
        for (int it = 0; it < 6; ++it) { const int id = it * kNT + tid, row = id >> 3, ch = id & 7;
            *(LAS u32x4*)(Kimg + row * 128 + ((ch ^ (row & 7)) << 4)) = pK[it];
            *(LAS u32x4*)(Vimg + row * 128 + ((ch ^ (((row >> 1) & 1) << 2)) << 4)) = pV[it]; }
        bf16x8 Qf[4];
#pragma unroll
        for (int s = 0; s < 4; ++s) Qf[s] = pQ[s];
        __syncthreads();
        if (unit + nblk < 6144) DIL_PREFETCH(unit + nblk);
        const int q0 = u0 + 32 * wid, qtok = ((q0 + qc) << dsh) + cls;
        const float slope = exp2f(-(float)((bh & 7) + 1));
        const float c1 = 0.125f * kLog2e, c2 = slope * (float)(1 << dsh) * kLog2e;
        float sum = 0.f;
        f32x16 O[2];
#pragma unroll
        for (int dt = 0; dt < 2; ++dt)
#pragma unroll
            for (int i = 0; i < 16; ++i) O[dt][i] = 0.f;
#pragma unroll
        for (int kt = 0; kt < 5; ++kt) {
            const int kp0 = q0 - 64 + 32 * kt;
            if (kp0 >= 0 && kp0 < L) {
                f32x16 S;
#pragma unroll
                for (int i = 0; i < 16; ++i) S[i] = 0.f;
#pragma unroll
                for (int s = 0; s < 4; ++s) { const bf16x8 Kf = *(const LAS bf16x8*)(Kimg + koff[s] + kt * 4096); S = __builtin_amdgcn_mfma_f32_32x32x16_bf16(Kf, Qf[s], S, 0, 0, 0); }
                const float cs = (kt < 2) ? c2 : -c2, c0 = ((kt == 0 || kt == 4) ? -64.f : (kt == 2 ? 0.f : -32.f)) * c2 - Mb;
#pragma unroll
                for (int i = 0; i < 16; ++i) {
                    const float d = (kt == 2) ? fabsf(dv[i]) : dv[i];
                    float sv = S[i] * c1 + (d * cs + c0);
                    if (kt == 0) sv = (dv[i] >= 0.f) ? sv : -1e30f;
                    if (kt == 4) sv = (dv[i] <= 0.f) ? sv : -1e30f;
                    const float pv = __builtin_amdgcn_exp2f(sv); S[i] = pv; sum += pv;
                }
#pragma unroll
                for (int s2 = 0; s2 < 2; ++s2) {
                    u32x4 pw; pw.x = pk2(S[8 * s2 + 0], S[8 * s2 + 1]); pw.y = pk2(S[8 * s2 + 2], S[8 * s2 + 3]); pw.z = pk2(S[8 * s2 + 4], S[8 * s2 + 5]); pw.w = pk2(S[8 * s2 + 6], S[8 * s2 + 7]);
                    const bf16x8 Pf = __builtin_bit_cast(bf16x8, pw);
#pragma unroll
                    for (int dt = 0; dt < 2; ++dt) { LAS unsigned char* vp = Vimg + voff[dt] + kt * 4096 + s2 * 2048;
                        const bf16x8 Vf = tr_pair(vp, vp + 1024);
                        O[dt] = __builtin_amdgcn_mfma_f32_32x32x16_bf16(Vf, Pf, O[dt], 0, 0, 0); }
                }
            }
        }
        sum += __shfl_xor(sum, 32);
        const float inv = 1.f / sum;
        const size_t tok = (size_t)(bh >> 3) * kS + qtok;
        bf16_t* orow = oac + ((size_t)c * kTok + tok) * 512 + (bh & 7) * 64;
#pragma unroll
        for (int dt = 0; dt < 2; ++dt)
#pragma unroll
            for (int g4 = 0; g4 < 4; ++g4) { u32x2 w; w.x = pk2(O[dt][4 * g4] * inv, O[dt][4 * g4 + 1] * inv); w.y = pk2(O[dt][4 * g4 + 2] * inv, O[dt][4 * g4 + 3] * inv);
                *(u32x2*)(orow + 32 * dt + 8 * g4 + 4 * h5) = w; }
        if (h5 == 0) lse[((size_t)c * kTok + tok) * 8 + (bh & 7)] = Mn + __logf(sum);
    }
#undef DIL_DECODE
#undef DIL_PREFETCH
    __syncthreads();
}
DEVI void phase_na(const bf16_t* qb, const bf16_t* kb, const bf16_t* vb, const float* rpb  , bf16_t* ob, LAS unsigned char* lds, int bid, int nblk) {
    const int tid = tidx(), wid = __builtin_amdgcn_readfirstlane(tid >> 6), lane = tid & 63, g4 = lane >> 4, i16 = lane & 15;
    LAS unsigned char* Kimg = lds; LAS unsigned char* Vimg = lds + 73728; LAS float* tab = (LAS float*)(lds + 147456);
    for (int i = tid; i < 4 * 465; i += kNT) tab[i] = rpb[i];
    const int g = wid & 3, kcs = (16 * g - 8) < 0 ? 0 : ((16 * g - 8) > 32 ? 32 : (16 * g - 8));
    const int qcol = 16 * g + i16, cs = (qcol - 8) < 0 ? 0 : ((qcol - 8) > 48 ? 48 : (qcol - 8));
    unsigned kswz[2];
#pragma unroll
    for (int s = 0; s < 2; ++s) kswz[s] = (unsigned)(((4 * s + g4) ^ (i16 & 7)) << 4);
    const int q = i16 >> 2, p = i16 & 3, sw = 2 * (g4 & 1) + (q >> 1);
    unsigned vsw[4];
#pragma unroll
    for (int dt = 0; dt < 4; ++dt) vsw[dt] = (unsigned)((((2 * dt + (p >> 1)) ^ (sw << 1)) << 4) + 8 * (p & 1));
    for (int unit = bid; unit < 2048; unit += nblk) {
        const int bh = unit >> 6, rp = unit & 63, r0 = 2 * rp, h = bh & 3;
        const int rsA = (r0 - 4) < 0 ? 0 : ((r0 - 4) > 120 ? 120 : (r0 - 4));
        const bf16_t* kbase = kb + (size_t)bh * kS * 64; const bf16_t* vbase = vb + (size_t)bh * kS * 64;
        __syncthreads();
#pragma unroll
        for (int it = 0; it < 9; ++it) {
            const int id = it * kNT + tid, row = id >> 3, ch = id & 7;
            int gr = rsA + (row >> 6); gr = gr > 127 ? 127 : gr;
            const size_t tok = (size_t)(gr * 64 + (row & 63));
            const u32x4 kv = *(const u32x4*)(kbase + tok * 64 + ch * 8), vv = *(const u32x4*)(vbase + tok * 64 + ch * 8);
            *(LAS u32x4*)(Kimg + row * 128 + ((ch ^ (row & 7)) << 4)) = kv;
            *(LAS u32x4*)(Vimg + row * 128 + ((ch ^ (((row >> 1) & 3) << 1)) << 4)) = vv;
        }
        __syncthreads();
        const int rr = r0 + (wid >> 2);
        const int rs = (rr - 4) < 0 ? 0 : ((rr - 4) > 120 ? 120 : (rr - 4)), ro = rs - rsA;
        const int qtok = rr * 64 + qcol;
        bf16x8 Qf[2];
#pragma unroll
        for (int s = 0; s < 2; ++s) Qf[s] = *(const bf16x8*)(qb + ((size_t)bh * kS + qtok) * 64 + 32 * s + 8 * g4);
        f32x4 S[16];
        const unsigned kb0 = (unsigned)((ro * 64 + kcs + i16) * 128);
#pragma unroll
        for (int t = 0; t < 16; ++t) { S[t] = (f32x4){0.f, 0.f, 0.f, 0.f};
#pragma unroll
            for (int s = 0; s < 2; ++s) { const bf16x8 Kf = *(const LAS bf16x8*)(Kimg + kb0 + (t >> 1) * 8192 + (t & 1) * 2048 + kswz[s]); S[t] = __builtin_amdgcn_mfma_f32_16x16x32_bf16(Kf, Qf[s], S[t], 0, 0, 0); } }
        float mx = -1e30f;
        const LAS float* th = tab + h * 465;
        int g4v = g4; asm volatile("" : "+v"(g4v));
#pragma unroll
        for (int t = 0; t < 16; ++t)
#pragma unroll
            for (int j = 0; j < 4; ++j) {
                const int krow = rs + (t >> 1), kcol = kcs + 16 * (t & 1) + 4 * g4v + j;
                const bool valid = (kcol >= cs) && (kcol < cs + 16);
                int dc = kcol - qcol + 15; dc = dc < 0 ? 0 : (dc > 30 ? 30 : dc);
                const float bias = th[(krow - rr + 7) * 31 + dc];
                const float sv = valid ? (S[t][j] * 0.125f + bias) * kLog2e : -1e30f;
                S[t][j] = sv; mx = fmaxf(mx, sv);
            }
        mx = fmaxf(mx, __shfl_xor(mx, 16)); mx = fmaxf(mx, __shfl_xor(mx, 32));
        float sum = 0.f;
#pragma unroll
        for (int t = 0; t < 16; ++t)
#pragma unroll
            for (int j = 0; j < 4; ++j) { const float pv = __builtin_amdgcn_exp2f(S[t][j] - mx); S[t][j] = pv; sum += pv; }
        sum += __shfl_xor(sum, 16); sum += __shfl_xor(sum, 32);
        f32x4 O[4];
#pragma unroll
        for (int dt = 0; dt < 4; ++dt) O[dt] = (f32x4){0.f, 0.f, 0.f, 0.f};
        const unsigned vb0 = (unsigned)((ro * 64 + kcs + 4 * g4 + q) * 128);
#pragma unroll
        for (int u = 0; u < 8; ++u) {
            u32x4 pw; pw.x = pk2(S[2 * u][0], S[2 * u][1]); pw.y = pk2(S[2 * u][2], S[2 * u][3]); pw.z = pk2(S[2 * u + 1][0], S[2 * u + 1][1]); pw.w = pk2(S[2 * u + 1][2], S[2 * u + 1][3]);
            const bf16x8 Pf = __builtin_bit_cast(bf16x8, pw);
#pragma unroll
            for (int dt = 0; dt < 4; ++dt) { LAS unsigned char* vp = Vimg + vb0 + u * 8192 + vsw[dt];
                const bf16x8 Vf = tr_pair(vp, vp + 2048);
                O[dt] = __builtin_amdgcn_mfma_f32_16x16x32_bf16(Vf, Pf, O[dt], 0, 0, 0); }
        }
        const float inv = 1.f / sum;
        bf16_t* orow = ob + ((size_t)(bh >> 2) * kS + qtok) * 256 + h * 64;
#pragma unroll
        for (int dt = 0; dt < 4; ++dt) { u32x2 w; w.x = pk2(O[dt][0] * inv, O[dt][1] * inv); w.y = pk2(O[dt][2] * inv, O[dt][3] * inv); *(u32x2*)(orow + 16 * dt + 4 * g4) = w; }
    }
    __syncthreads();
}
DEVI void phase_s5_naive(const Params& P, int l, const bf16_t* ux, float* ys, unsigned char* lds, int bid, int nblk) {
    const int wid = tidx() >> 6, lane = tidx() & 63;
    float* xs = (float*)lds + wid * 128;
    for (int item = wid * nblk + bid; item < kB * 16 * 2; item += nblk * 8) {
        const int dir = item & 1, g = (item >> 1) & 15, b = item >> 5;
        const size_t pbase = (((size_t)l * 2 + dir) * 16 + g) * 64;
        const float dt = __expf(P.s5_log_dt[((size_t)l * 2 + dir) * 16 + g]);
        const float a = fminf(P.s5_a_re[pbase + lane], -1e-4f), w = P.s5_a_im[pbase + lane];
        const float mag = __expf(a * dt), ar = mag * cosf(w * dt), ai = mag * sinf(w * dt);
        const float den = a * a + w * w, zr = ar - 1.f, gr = (zr * a + ai * w) / den, gi = (ai * a - zr * w) / den;
        float bbr[16], bbi[16];
#pragma unroll
        for (int c = 0; c < 16; ++c) { const float br = P.s5_b_re[(pbase + lane) * 16 + c], bi = P.s5_b_im[(pbase + lane) * 16 + c]; bbr[c] = gr * br - gi * bi; bbi[c] = gr * bi + gi * br; }
        const int cch = lane & 15, qt = lane >> 4;
        float cre[16], cim[16];
#pragma unroll
        for (int pp = 0; pp < 16; ++pp) { cre[pp] = P.s5_c_re[(pbase / 64 * 16 + cch) * 64 + qt * 16 + pp]; cim[pp] = P.s5_c_im[(pbase / 64 * 16 + cch) * 64 + qt * 16 + pp]; }
        float xr = 0.f, xi = 0.f;
        const bf16_t* ug = ux + (size_t)g * 4096 * 512;
        for (int st = 0; st < kS; ++st) {
            const int s = dir ? (kS - 1 - st) : st; const size_t tok = (size_t)b * kS + s;
            const bf16_t* up = ug + (tok >> 4) * 512 + (tok & 15) * 16;
            const u32x4 u0 = *(const u32x4*)up, u1 = *(const u32x4*)(up + 8);
            float uv[16];
            uv[0] = __uint_as_float(u0.x << 16); uv[1] = __uint_as_float(u0.x & 0xFFFF0000u); uv[2] = __uint_as_float(u0.y << 16); uv[3] = __uint_as_float(u0.y & 0xFFFF0000u);
            uv[4] = __uint_as_float(u0.z << 16); uv[5] = __uint_as_float(u0.z & 0xFFFF0000u); uv[6] = __uint_as_float(u0.w << 16); uv[7] = __uint_as_float(u0.w & 0xFFFF0000u);
            uv[8] = __uint_as_float(u1.x << 16); uv[9] = __uint_as_float(u1.x & 0xFFFF0000u); uv[10] = __uint_as_float(u1.y << 16); uv[11] = __uint_as_float(u1.y & 0xFFFF0000u);
            uv[12] = __uint_as_float(u1.z << 16); uv[13] = __uint_as_float(u1.z & 0xFFFF0000u); uv[14] = __uint_as_float(u1.w << 16); uv[15] = __uint_as_float(u1.w & 0xFFFF0000u);
            float bur = 0.f, bui = 0.f;
#pragma unroll
            for (int c = 0; c < 16; ++c) { bur += bbr[c] * uv[c]; bui += bbi[c] * uv[c]; }
            const float nr = ar * xr - ai * xi + bur, ni = ar * xi + ai * xr + bui; xr = nr; xi = ni;
            xs[lane] = xr; xs[64 + lane] = xi;
            asm volatile("s_waitcnt lgkmcnt(0)" ::: "memory");
            float y = 0.f;
#pragma unroll
            for (int pp = 0; pp < 16; ++pp) y += cre[pp] * xs[qt * 16 + pp] - cim[pp] * xs[64 + qt * 16 + pp];
            asm volatile("s_waitcnt lgkmcnt(0)" ::: "memory");
            y += __shfl_xor(y, 16); y += __shfl_xor(y, 32);
            if (lane < 16) ys[((size_t)dir * kTok + tok) * 256 + g * 16 + cch] = y;
        }
    }
}
DEVI void phase_s5_finish(const float* ys, const bf16_t* ux, const float* dskip, bf16_t* G, int bid, int nblk) {
    for (size_t i = (size_t)bid * kNT + tidx(); i < (size_t)kTok * 256; i += (size_t)nblk * kNT) {
        const size_t tok = i >> 8; const int ch = (int)(i & 255), g = ch >> 4, c = ch & 15;
        const float u = bf2f(ux[((size_t)g * 4096 + (tok >> 4)) * 512 + (tok & 15) * 16 + c]);
        const float y = ys[i] + ys[(size_t)kTok * 256 + i] + dskip[ch] * u;
        G[i] = f2bf(gelu_tanh(y));
    }
}
DEVI void unpk8(float* d, const u32x4 q, const float sc) {
    d[0] += sc * __uint_as_float(q.x << 16); d[1] += sc * __uint_as_float(q.x & 0xFFFF0000u); d[2] += sc * __uint_as_float(q.y << 16); d[3] += sc * __uint_as_float(q.y & 0xFFFF0000u);
    d[4] += sc * __uint_as_float(q.z << 16); d[5] += sc * __uint_as_float(q.z & 0xFFFF0000u); d[6] += sc * __uint_as_float(q.w << 16); d[7] += sc * __uint_as_float(q.w & 0xFFFF0000u);
}
DEVI void phase_mixnorm(const bf16_t* oac, const float* lse, const bf16_t* ob, const bf16_t* oc, const float* ga, const float* gb, const float* gc, bf16_t* mix, int bid, int nblk) {
    const int wid = tidx() >> 6, lane = tidx() & 63;
    float gn[16];
    { const float* gp = (lane < 32) ? ga + lane * 16 : (lane < 48) ? gb + (lane - 32) * 16 : gc + (lane - 48) * 16;
#pragma unroll
      for (int i = 0; i < 16; ++i) gn[i] = gp[i]; }
    for (int row = bid * 8 + wid; row < kTok; row += nblk * 8) {
        float v[16];
#pragma unroll
        for (int i = 0; i < 16; ++i) v[i] = 0.f;
        if (lane < 32) {
            const int h = lane >> 2;
            const float l0 = lse[(size_t)row * 8 + h], l1 = lse[((size_t)kTok + row) * 8 + h], l2 = lse[((size_t)2 * kTok + row) * 8 + h];
            const bf16_t* p0 = oac + (size_t)row * 512 + lane * 16; const bf16_t* p1 = p0 + (size_t)kTok * 512; const bf16_t* p2 = p1 + (size_t)kTok * 512;
            const u32x4 a0 = *(const u32x4*)p0, a1 = *(const u32x4*)(p0 + 8), b0 = *(const u32x4*)p1, b1 = *(const u32x4*)(p1 + 8), c0 = *(const u32x4*)p2, c1 = *(const u32x4*)(p2 + 8);
            const float mx = fmaxf(l0, fmaxf(l1, l2)); float w0 = __expf(l0 - mx), w1 = __expf(l1 - mx), w2 = __expf(l2 - mx); const float inv = frcp(w0 + w1 + w2); w0 *= inv; w1 *= inv; w2 *= inv;
            unpk8(v, a0, w0); unpk8(v + 8, a1, w0); unpk8(v, b0, w1); unpk8(v + 8, b1, w1); unpk8(v, c0, w2); unpk8(v + 8, c1, w2);
        } else {
            const bf16_t* p = (lane < 48) ? ob + (size_t)row * 256 + (lane - 32) * 16 : oc + (size_t)row * 256 + (lane - 48) * 16;
            const u32x4 a0 = *(const u32x4*)p, a1 = *(const u32x4*)(p + 8);
            unpk8(v, a0, 1.f); unpk8(v + 8, a1, 1.f);
        }
        float ss = 0.f;
#pragma unroll
        for (int i = 0; i < 16; ++i) ss += v[i] * v[i];
#pragma unroll
        for (int m = 1; m <= 8; m <<= 1) ss += __shfl_xor(ss, m);
        const float o16 = __shfl_xor(ss, 16);
        if (lane < 32) ss += o16;
        const float rstd = rsqrtf(ss * ((lane < 32) ? (1.f / 512.f) : (1.f / 256.f)) + kEps);
        u32x4 w0, w1;
        w0.x = pk2(v[0] * rstd * gn[0], v[1] * rstd * gn[1]); w0.y = pk2(v[2] * rstd * gn[2], v[3] * rstd * gn[3]); w0.z = pk2(v[4] * rstd * gn[4], v[5] * rstd * gn[5]); w0.w = pk2(v[6] * rstd * gn[6], v[7] * rstd * gn[7]);
        w1.x = pk2(v[8] * rstd * gn[8], v[9] * rstd * gn[9]); w1.y = pk2(v[10] * rstd * gn[10], v[11] * rstd * gn[11]); w1.z = pk2(v[12] * rstd * gn[12], v[13] * rstd * gn[13]); w1.w = pk2(v[14] * rstd * gn[14], v[15] * rstd * gn[15]);
        *(u32x4*)(mix + (size_t)row * kD + lane * 16) = w0; *(u32x4*)(mix + (size_t)row * kD + lane * 16 + 8) = w1;
    }
}
DEVI void phase_combine(float* x, const bf16_t* y, const int* tokslot, const float* gain_next, bf16_t* h, int bid, int nblk) {
    const int wid = tidx() >> 6, lane = tidx() & 63;
    f32x4 g[4];
#pragma unroll
    for (int q = 0; q < 4; ++q) g[q] = gain_next ? *(const f32x4*)(gain_next + q * 256 + lane * 4) : (f32x4){0.f, 0.f, 0.f, 0.f};
    const int stride = nblk * 8;
    int row = bid * 8 + wid;
    f32x4 nv[4]; int nts = 0;
    if (row < kTok) { nts = tokslot[(size_t)row * kE + (lane & 15)];
#pragma unroll
        for (int q = 0; q < 4; ++q) nv[q] = *(const f32x4*)(x + (size_t)row * kD + q * 256 + lane * 4); }
    for (; row < kTok; row += stride) {
        const int b = row >> 13;
        const int ts = nts;
        f32x4 v[4];
#pragma unroll
        for (int q = 0; q < 4; ++q) v[q] = nv[q];
        const int nrow = row + stride;
        if (nrow < kTok) { nts = tokslot[(size_t)nrow * kE + (lane & 15)];
#pragma unroll
            for (int q = 0; q < 4; ++q) nv[q] = *(const f32x4*)(x + (size_t)nrow * kD + q * 256 + lane * 4); }
#pragma unroll
        for (int e0 = 0; e0 < kE; e0 += 8) {
            u32x2 yv[8][4];
#pragma unroll
            for (int e = 0; e < 8; ++e) { const int slot = __builtin_amdgcn_readlane(ts, e0 + e);
                if (slot >= 0) { const bf16_t* yr = y + ((size_t)((e0 + e) * kB + b) * kCap + slot) * kD;
#pragma unroll
                    for (int q = 0; q < 4; ++q) yv[e][q] = *(const u32x2*)(yr + q * 256 + lane * 4); } }
#pragma unroll
            for (int e = 0; e < 8; ++e) { const int slot = __builtin_amdgcn_readlane(ts, e0 + e);
                if (slot >= 0) {
#pragma unroll
                    for (int q = 0; q < 4; ++q) { const u32x2 w = yv[e][q];
                        v[q].x += __uint_as_float(w.x << 16); v[q].y += __uint_as_float(w.x & 0xFFFF0000u); v[q].z += __uint_as_float(w.y << 16); v[q].w += __uint_as_float(w.y & 0xFFFF0000u); } } }
        }
        float ss = 0.f;
#pragma unroll
        for (int q = 0; q < 4; ++q) { *(f32x4*)(x + (size_t)row * kD + q * 256 + lane * 4) = v[q]; ss += v[q].x * v[q].x + v[q].y * v[q].y + v[q].z * v[q].z + v[q].w * v[q].w; }
        if (gain_next) { ss = wave_sum(ss); const float rstd = rsqrtf(ss * (1.f / kD) + kEps);
#pragma unroll
            for (int q = 0; q < 4; ++q) { u32x2 o; o.x = pk2(v[q].x * rstd * g[q].x, v[q].y * rstd * g[q].y); o.y = pk2(v[q].z * rstd * g[q].z, v[q].w * rstd * g[q].w);
                *(u32x2*)(h + (size_t)row * kD + q * 256 + lane * 4) = o; } }
    }
}

DEVI void cpow_m(double a, double w, double dt, int m, float& re, float& im) {
    const float mag = __expf((float)m * (float)a * (float)dt);
    const double turns = (double)m * w * dt * 0.15915494309189535; const float ang = (float)((turns - floor(turns)) * 6.283185307179586);
    re = mag * cosf(ang); im = mag * sinf(ang);
}
DEVI void s5_prep_item(const Params& P, int l, int g, unsigned char* lds_) {
    float* pw = (float*)lds_;
    float* bb = pw + 4352;
    float* cc = bb + 4096;
    float* kt = cc + 4096;
    const int tid = tidx();
    __syncthreads();
    for (int i = tid; i < 128; i += kNT) { const int dir = i >> 6, p = i & 63; const size_t pb = (((size_t)l * 2 + dir) * 16 + g) * 64 + p;
        const double dt = (double)__expf(P.s5_log_dt[((size_t)l * 2 + dir) * 16 + g]); const double a = (double)fminf(P.s5_a_re[pb], -1e-4f), w = (double)P.s5_a_im[pb];
        for (int m = 0; m < 17; ++m) { float re, im; cpow_m(a, w, dt, m, re, im); pw[((dir * 64 + p) * 17 + m) * 2] = re; pw[((dir * 64 + p) * 17 + m) * 2 + 1] = im; }
        const float af = (float)a, wf = (float)w, ar = pw[((dir * 64 + p) * 17 + 1) * 2], ai = pw[((dir * 64 + p) * 17 + 1) * 2 + 1];
        const float den = af * af + wf * wf, zr = ar - 1.f, gr = (zr * af + ai * wf) / den, gi = (ai * af - zr * wf) / den;
        for (int c = 0; c < 16; ++c) { const float br = P.s5_b_re[pb * 16 + c], bi = P.s5_b_im[pb * 16 + c]; bb[((dir * 64 + p) * 16 + c) * 2] = gr * br - gi * bi; bb[((dir * 64 + p) * 16 + c) * 2 + 1] = gr * bi + gi * br; }
    }
    for (int i = tid; i < 2048; i += kNT) { const int dir = i >> 10, c = (i >> 6) & 15, p = i & 63; const size_t o = ((((size_t)l * 2 + dir) * 16 + g) * 16 + c) * 64 + p; cc[i * 2] = P.s5_c_re[o]; cc[i * 2 + 1] = P.s5_c_im[o]; }
    __syncthreads();
    for (int i = tid; i < 8192; i += kNT) { const int dir = i >> 12, m = (i >> 8) & 15, c = (i >> 4) & 15, c2 = i & 15; float acc = 0.f;
        for (int p = 0; p < 64; ++p) { const float cr = cc[((dir * 16 + c) * 64 + p) * 2], ci = cc[((dir * 16 + c) * 64 + p) * 2 + 1], wr_ = pw[((dir * 64 + p) * 17 + m) * 2], wi_ = pw[((dir * 64 + p) * 17 + m) * 2 + 1];
            const float br = bb[((dir * 64 + p) * 16 + c2) * 2], bi = bb[((dir * 64 + p) * 16 + c2) * 2 + 1]; const float tr = cr * wr_ - ci * wi_, ti = cr * wi_ + ci * wr_; acc += tr * br - ti * bi; }
        kt[i] = acc; }
    __syncthreads();
    bf16_t* wst = (bf16_t*)(wsp(P) + WS_WST) + ((size_t)l * 16 + g) * 256 * 256;
    bf16_t* wso = (bf16_t*)(wsp(P) + WS_WSO) + ((size_t)l * 16 + g) * 256 * 512;
    for (int id = tid; id < 8192; id += kNT) { const int n = id >> 5, k0 = (id & 31) * 8, dir = n >> 7, p = (n >> 1) & 63, ri = n & 1; float v[8];
#pragma unroll
        for (int kk = 0; kk < 8; ++kk) { const int k = k0 + kk, t = k >> 4, c = k & 15, e = dir ? t : 15 - t; const float wr_ = pw[((dir * 64 + p) * 17 + e) * 2], wi_ = pw[((dir * 64 + p) * 17 + e) * 2 + 1], br = bb[((dir * 64 + p) * 16 + c) * 2], bi = bb[((dir * 64 + p) * 16 + c) * 2 + 1];
            v[kk] = ri ? (wr_ * bi + wi_ * br) : (wr_ * br - wi_ * bi); }
        u32x4 o; o.x = pk2(v[0], v[1]); o.y = pk2(v[2], v[3]); o.z = pk2(v[4], v[5]); o.w = pk2(v[6], v[7]); *(u32x4*)(wst + (size_t)n * 256 + k0) = o; }
    for (int id = tid; id < 16384; id += kNT) { const int ns = id >> 6, k0 = (id & 63) * 8, n = cmap_pk(ns), t = n >> 4, c = n & 15; float v[8];
#pragma unroll
        for (int kk = 0; kk < 8; ++kk) { const int k = k0 + kk; float x;
            if (k < 256) { const int j = k >> 4, c2 = k & 15; x = 0.f; if (j <= t) x += kt[(t - j) * 256 + c * 16 + c2]; if (j >= t) x += kt[4096 + (j - t) * 256 + c * 16 + c2]; if (j == t && c == c2) x += P.s5_d[l * 256 + g * 16 + c]; }
            else { const int q = k - 256, dir = q >> 7, p = (q >> 1) & 63, ri = q & 1, e = dir ? 16 - t : t + 1; const float cr = cc[((dir * 16 + c) * 64 + p) * 2], ci = cc[((dir * 16 + c) * 64 + p) * 2 + 1], wr_ = pw[((dir * 64 + p) * 17 + e) * 2], wi_ = pw[((dir * 64 + p) * 17 + e) * 2 + 1];
                x = ri ? -(cr * wi_ + ci * wr_) : (cr * wr_ - ci * wi_); }
            v[kk] = x; }
        u32x4 o; o.x = pk2(v[0], v[1]); o.y = pk2(v[2], v[3]); o.z = pk2(v[4], v[5]); o.w = pk2(v[6], v[7]); *(u32x4*)(wso + (size_t)ns * 512 + k0) = o; }
    __syncthreads();
}
DEVI void phase_s5_scan(const Params& P, int l, const float* Z, bf16_t* ux, unsigned char* lds_, int bid, int nblk) {
    const int tid = tidx(), wid = tid >> 6, lane = tid & 63;
    float* E = (float*)lds_;
    for (int item = bid; item < 256; item += nblk) {
        const int dir = item & 1, g = (item >> 1) & 15, b = item >> 5;
        const size_t pb = (((size_t)l * 2 + dir) * 16 + g) * 64 + lane;
        const double dt = (double)__expf(P.s5_log_dt[((size_t)l * 2 + dir) * 16 + g]); const double a = (double)fminf(P.s5_a_re[pb], -1e-4f), w = (double)P.s5_a_im[pb];
        float a16r, a16i, Ar, Ai; cpow_m(a, w, dt, 16, a16r, a16i); cpow_m(a, w, dt, 1024, Ar, Ai);
        const int kk0 = dir ? 511 - 64 * wid : 64 * wid; const long sstep = dir ? -1 : 1;
        const float* zp = Z + ((size_t)g * 4096 + b * 512 + kk0) * 256 + dir * 128 + 2 * lane;
        f32x2 z[64];
#pragma unroll
        for (int i = 0; i < 64; ++i) { z[i] = *(const f32x2*)zp; zp += sstep * 256; }
        float xr = 0.f, xi = 0.f;
#pragma unroll
        for (int i = 0; i < 64; ++i) { const float nr = a16r * xr - a16i * xi + z[i].x, ni = a16r * xi + a16i * xr + z[i].y; xr = nr; xi = ni; }
        __syncthreads();
        E[(wid * 64 + lane) * 2] = xr; E[(wid * 64 + lane) * 2 + 1] = xi;
        __syncthreads();
        float sr = 0.f, si = 0.f;
#pragma unroll
        for (int s2 = 0; s2 < 7; ++s2) if (s2 < wid) { const float er = E[(s2 * 64 + lane) * 2], ei = E[(s2 * 64 + lane) * 2 + 1]; const float nr = Ar * sr - Ai * si + er, ni = Ar * si + Ai * sr + ei; sr = nr; si = ni; }
        bf16_t* up = ux + ((size_t)g * 4096 + b * 512 + kk0) * 512 + 256 + dir * 128 + 2 * lane;
#pragma unroll
        for (int i = 0; i < 64; ++i) { *(unsigned*)up = pk2(sr, si); up += sstep * 512;
            const float nr = a16r * sr - a16i * si + z[i].x, ni = a16r * si + a16i * sr + z[i].y; sr = nr; si = ni; }
    }
    __syncthreads();
}
struct EpiF32N {
    static constexpr int VMOPS = 32;
    float* z; int ldz;
    DEVI void operator()(const f32x4 (&acc)[2][2][4][2], const Unit& u, int wr, int wc, int fr, int fq) const {
#pragma unroll
        for (int ai = 0; ai < 2; ++ai)
#pragma unroll
            for (int m = 0; m < 4; ++m) { const size_t ro = (size_t)(u.pm * 256 + 128 * ai + 64 * wr + 16 * m + fr) * ldz + u.pn * 256 + 32 * wc + 4 * fq;
#pragma unroll
                for (int bj = 0; bj < 2; ++bj)
#pragma unroll
                    for (int n = 0; n < 2; ++n) *(f32x4*)(z + ro + 128 * bj + 16 * n) = acc[ai][bj][m][n]; }
    }
};
struct EpiS5Out {
    static constexpr int VMOPS = 16;
    bf16_t* G;
    DEVI void operator()(const f32x4 (&acc)[2][2][4][2], const Unit& u, int wr, int wc, int fr, int fq) const {
#pragma unroll
        for (int ai = 0; ai < 2; ++ai)
#pragma unroll
            for (int m = 0; m < 4; ++m) { const int R = u.pm * 256 + 128 * ai + 64 * wr + 16 * m + fr, g = R >> 12, ck = R & 4095;
#pragma unroll
                for (int bj = 0; bj < 2; ++bj) { const int t = 8 * bj + 2 * wc + (fq >> 1), c0 = 8 * (fq & 1);
                    const f32x4 v0 = acc[ai][bj][m][0], v1 = acc[ai][bj][m][1];
                    u32x4 w; w.x = pk2(gelu_tanh(v0.x), gelu_tanh(v0.y)); w.y = pk2(gelu_tanh(v0.z), gelu_tanh(v0.w)); w.z = pk2(gelu_tanh(v1.x), gelu_tanh(v1.y)); w.w = pk2(gelu_tanh(v1.z), gelu_tanh(v1.w));
                    *(u32x4*)(G + ((size_t)ck * 16 + t) * 256 + g * 16 + c0) = w; } }
    }
};
#define XB_TMO      128
#define XB_XCNT(j)  (256  + 64 * (j))
#define XB_XSUB(j)  (1280 + 64 * (j))
#define XB_XGEN(j)  (2304 + 64 * (j))
#define XB_TOP      3328
#define XB_TOPGEN   3392
#define XCD_BAR_WORDS 3456
#define XB_SPIN_CAP (1u << 26)
DEVI unsigned xb_ld(unsigned* p)              { return __hip_atomic_load(p, __ATOMIC_RELAXED, __HIP_MEMORY_SCOPE_AGENT); }
DEVI unsigned xb_add(unsigned* p, unsigned v) { return __hip_atomic_fetch_add(p, v, __ATOMIC_RELAXED, __HIP_MEMORY_SCOPE_AGENT); }
DEVI unsigned xb_xcc_id() { return (unsigned)__builtin_amdgcn_s_getreg((3 << 11) | 20) & 0xFu; }
#define XB_SPIN(cond, bar) do { unsigned _sp = 0; while (cond) { __builtin_amdgcn_s_sleep(1); \
    if ((++_sp & 255u) == 0u) { if (xb_ld(&(bar)[XB_TMO])) break; if (_sp > XB_SPIN_CAP) { atomicAdd(&(bar)[XB_TMO], 1u); break; } } } } while (0)
struct XcdBarrier { unsigned* bar; unsigned x; volatile LAS unsigned* st; };
DEVI XcdBarrier xcd_barrier_post(unsigned* bar, volatile LAS unsigned* st) {
    XcdBarrier b; b.bar = bar; b.x = xb_xcc_id(); b.st = st;
    if (threadIdx.x == 0) (void)xb_add(&bar[XB_XCNT(b.x)], 1u);
    return b;
}
DEVI void xcd_barrier_complete(unsigned* bar, unsigned x, unsigned& nloc, unsigned& nx) {
    const unsigned G = gridDim.x * gridDim.y * gridDim.z;
    unsigned sum, cnt, mine, sp = 0u;
    for (;;) {
        sum = 0u; cnt = 0u; mine = 0u;
#pragma unroll
        for (unsigned j = 0; j < 16; ++j) { const unsigned c = xb_ld(&bar[XB_XCNT(j)]); sum += c; cnt += (c > 0u) ? 1u : 0u; mine = (j == x) ? c : mine; }
        if (sum == G) break;
        __builtin_amdgcn_s_sleep(1);
        if ((++sp & 255u) == 0u) { if (xb_ld(&bar[XB_TMO])) break; if (sp > XB_SPIN_CAP) { atomicAdd(&bar[XB_TMO], 1u); break; } }
    }
    nloc = mine > 0u ? mine : 1u; nx = cnt > 0u ? cnt : 1u;
}
DEVI void xcd_barrier(const XcdBarrier& b) {
    asm volatile("s_waitcnt vmcnt(0)" ::: "memory");
    __syncthreads();
    if (threadIdx.x == 0) {
        unsigned long long bp_ = (unsigned long long)b.bar; asm volatile("" : "+s"(bp_));
        unsigned* bar = (unsigned*)bp_;
        const unsigned bx = xb_xcc_id();
        __builtin_amdgcn_s_waitcnt(0);
        unsigned nloc = b.st[0], nx = b.st[1];
        if (nloc == 0u) { xcd_barrier_complete(bar, bx, nloc, nx); b.st[0] = nloc; b.st[1] = nx; }
        const unsigned old = xb_add(&bar[XB_XSUB(bx)], 1u);
        const unsigned gen = old / nloc;
        if (old + 1u == (gen + 1u) * nloc) {
            __builtin_amdgcn_fence(__ATOMIC_RELEASE, "agent");
            asm volatile("s_waitcnt vmcnt(0)" ::: "memory");
            const unsigned og = xb_add(&bar[XB_TOP], 1u);
            const unsigned tg = og / nx;
            if (og + 1u == (tg + 1u) * nx) xb_add(&bar[XB_TOPGEN], 1u);
            else XB_SPIN(xb_ld(&bar[XB_TOPGEN]) == tg, bar);
            __builtin_amdgcn_fence(__ATOMIC_ACQUIRE, "agent");
            xb_add(&bar[XB_XGEN(bx)], 1u);
            asm volatile("s_waitcnt vmcnt(0)" ::: "memory");
        } else {
            XB_SPIN(xb_ld(&bar[XB_XGEN(bx)]) == gen, bar);
            __builtin_amdgcn_fence(__ATOMIC_ACQUIRE, "agent");
            asm volatile("s_waitcnt vmcnt(0)" ::: "memory");
        }
    }
    __syncthreads();
}

#ifndef MEGA
#define MEGA 1
#endif
#ifndef USE_ENGINE
#define USE_ENGINE 1
#endif
constexpr int LDS_BYTES = 147456 + 8192 + 16;
#if USE_ENGINE
#define GEMM_RUN(g, E) gemm_engine<decltype(E), true, true>((LAS unsigned char*)dyn_lds, g, E, bid, nblk)
#define GEMM_RUN8(g, E) gemm_engine<decltype(E), true, true, true>((LAS unsigned char*)dyn_lds, g, E, bid, nblk)
#else
#define GEMM_RUN(g, E) gemm_simple(g, E, bid, nblk)
#endif
extern __shared__ __attribute__((aligned(16))) unsigned char dyn_lds[];

DEVI GemmD mk_gemm(const bf16_t* A, const bf16_t* Bt, int lda, int K, int nM, int nN, const int* rowidx, size_t bstride, int pmg) {
    GemmD g; g.A = A; g.Bt = Bt; g.lda = lda; g.K = K; g.nM = nM; g.nN = nN; g.rowidx = rowidx; g.bstride = bstride; g.pmg = pmg; return g; }

DEVI void ph_win(const Params& P, int l, int bid, int nblk) {
    const GemmD g = mk_gemm((const bf16_t*)(wsp(P) + WS_H), (const bf16_t*)(wsp(P) + WS_WINT) + (size_t)l * kINW * kD, kD, kD, kTok / 256, 10, nullptr, 0, 1 << 30);
    unsigned char* r1 = wsp(P) + WS_R1;
    EpiQKV E; E.qa = (bf16_t*)(r1 + R1_QA); E.ka = (bf16_t*)(r1 + R1_KA); E.va = (bf16_t*)(r1 + R1_VA); E.qb = (bf16_t*)(r1 + R1_QB); E.kb = (bf16_t*)(r1 + R1_KB); E.vb = (bf16_t*)(r1 + R1_VB); E.ux = (bf16_t*)(r1 + R1_UX);
    E.qna = P.q_norm_a + l * 64; E.kna = P.k_norm_a + l * 64; E.qnb = P.q_norm_b + l * 64; E.knb = P.k_norm_b + l * 64;
    GEMM_RUN(g, E);
}
#ifndef USE_MFMA_ATTN
#define USE_MFMA_ATTN 1
#endif
#ifndef USE_S5_GEMM
#define USE_S5_GEMM 1
#endif
#ifndef PROBE_ATTN
#define PROBE_ATTN 1
#endif
#ifndef PROBE_GU
#define PROBE_GU 1
#endif
#ifndef PROBE_DOWN
#define PROBE_DOWN 1
#endif
#ifndef PROBE_NA
#define PROBE_NA 1
#endif
#ifndef PROBE_MIX
#define PROBE_MIX 1
#endif
#ifndef PROBE_RT
#define PROBE_RT 1
#endif
#ifndef PROBE_TK
#define PROBE_TK 1
#endif
#ifndef PROBE_GUDRY
#define PROBE_GUDRY 0
#endif
#ifndef PROBE_CONV
#define PROBE_CONV 1
#endif
DEVI void ph_dilated(const Params& P, int l, int bid, int nblk) { unsigned char* r1 = wsp(P) + WS_R1;
#if USE_MFMA_ATTN
    phase_dilated((const bf16_t*)(r1 + R1_QA), (const bf16_t*)(r1 + R1_KA), (const bf16_t*)(r1 + R1_VA), P.q_norm_a + l * 64, P.k_norm_a + l * 64, (bf16_t*)(wsp(P) + WS_R2), (float*)(wsp(P) + WS_LSE), (LAS unsigned char*)dyn_lds, bid, nblk);
#else
    phase_dilated_naive((const bf16_t*)(r1 + R1_QA), (const bf16_t*)(r1 + R1_KA), (const bf16_t*)(r1 + R1_VA), (bf16_t*)(wsp(P) + WS_R2), (float*)(wsp(P) + WS_LSE), bid, nblk);
#endif
}
DEVI void ph_na(const Params& P, int l, int bid, int nblk) { unsigned char* r1 = wsp(P) + WS_R1;
#if USE_MFMA_ATTN
    phase_na((const bf16_t*)(r1 + R1_QB), (const bf16_t*)(r1 + R1_KB), (const bf16_t*)(r1 + R1_VB), P.rpb + (size_t)l * 4 * 15 * 31, (bf16_t*)(r1 + R1_OB), (LAS unsigned char*)dyn_lds, bid, nblk);
#else
    phase_na_naive((const bf16_t*)(r1 + R1_QB), (const bf16_t*)(r1 + R1_KB), (const bf16_t*)(r1 + R1_VB), P.rpb + (size_t)l * 4 * 15 * 31, (bf16_t*)(r1 + R1_OB), bid, nblk);
#endif
}
DEVI void ph_s5(const Params& P, int l, unsigned char* lds, int bid, int nblk) { phase_s5_naive(P, l, (const bf16_t*)(wsp(P) + WS_R1 + R1_UX), (float*)(wsp(P) + WS_YS), lds, bid, nblk); }
DEVI void ph_s5_prep(const Params& P, unsigned char* lds, int bid, int nblk) { for (int it = bid; it < kL * 16; it += nblk) s5_prep_item(P, it >> 4, it & 15, lds); }
DEVI void ph_s5_state(const Params& P, int l, int bid, int nblk) {
    const GemmD g = mk_gemm((const bf16_t*)(wsp(P) + WS_R1 + R1_UX), (const bf16_t*)(wsp(P) + WS_WST) + (size_t)l * 16 * 256 * 256, 512, 256, 256, 1, nullptr, (size_t)256 * 256, 16);
    EpiF32N E; E.z = (float*)(wsp(P) + WS_R2 + R2_Z); E.ldz = 256;
    GEMM_RUN(g, E);
}
DEVI void ph_s5_scan(const Params& P, int l, unsigned char* lds, int bid, int nblk) { phase_s5_scan(P, l, (const float*)(wsp(P) + WS_R2 + R2_Z), (bf16_t*)(wsp(P) + WS_R1 + R1_UX), lds, bid, nblk); }
DEVI void ph_s5_out(const Params& P, int l, int bid, int nblk) {
    const GemmD g = mk_gemm((const bf16_t*)(wsp(P) + WS_R1 + R1_UX), (const bf16_t*)(wsp(P) + WS_WSO) + (size_t)l * 16 * 256 * 512, 512, 512, 256, 1, nullptr, (size_t)256 * 512, 16);
    EpiS5Out E; E.G = (bf16_t*)(wsp(P) + WS_R1 + R1_G);
    GEMM_RUN(g, E);
}
DEVI void ph_s5fin(const Params& P, int l, int bid, int nblk) { phase_s5_finish((const float*)(wsp(P) + WS_YS), (const bf16_t*)(wsp(P) + WS_R1 + R1_UX), P.s5_d + l * 256, (bf16_t*)(wsp(P) + WS_R1 + R1_G), bid, nblk); }
DEVI void ph_glu(const Params& P, int l, int bid, int nblk) {
    const GemmD g = mk_gemm((const bf16_t*)(wsp(P) + WS_R1 + R1_G), (const bf16_t*)(wsp(P) + WS_WGLUT) + (size_t)l * 256 * 256, 256, 256, kTok / 256, 1, nullptr, 0, 1 << 30);
    EpiGlu E; E.g = (const bf16_t*)(wsp(P) + WS_R1 + R1_G); E.oc = (bf16_t*)(wsp(P) + WS_R1 + R1_OC);
    GEMM_RUN(g, E);
}
DEVI void ph_mixnorm(const Params& P, int l, int bid, int nblk) { unsigned char* r1 = wsp(P) + WS_R1;
    phase_mixnorm((const bf16_t*)(wsp(P) + WS_R2), (const float*)(wsp(P) + WS_LSE), (const bf16_t*)(r1 + R1_OB), (const bf16_t*)(r1 + R1_OC), P.out_norm_a + l * 512, P.out_norm_b + l * 256, P.out_norm_c + l * 256, (bf16_t*)(wsp(P) + WS_H), bid, nblk); }
DEVI void ph_wout(const Params& P, int l, int bid, int nblk) {
    const GemmD g = mk_gemm((const bf16_t*)(wsp(P) + WS_H), (const bf16_t*)(wsp(P) + WS_WOUTT) + (size_t)l * kD * kD, kD, kD, kTok / 256, 4, nullptr, 0, 1 << 30);
    EpiResid E; E.xin = (l == 0) ? P.x : P.out; E.xout = P.out;
    GEMM_RUN(g, E);
}
DEVI void ph_router(const Params& P, int l, unsigned char* lds, int bid, int nblk) { phase_router(P.out, P.ffn_norm + (size_t)l * kD, P.w_router + (size_t)l * kD * kE, (bf16_t*)(wsp(P) + WS_H), (float*)(wsp(P) + WS_AFF), lds, bid, nblk); }
DEVI void ph_topk(const Params& P, unsigned char* lds, int bid, int nblk) { phase_topk((const float*)(wsp(P) + WS_AFF), (int*)(wsp(P) + WS_IDX), (float*)(wsp(P) + WS_GATE), (int*)(wsp(P) + WS_TSLOT), wsp(P) + WS_H, wsp(P) + WS_R2, FP8_GU ? kD : kD * 2, lds, bid, nblk); }
DEVI void ph_gu(const Params& P, int l, int bid, int nblk) {
#if FP8_GU
    const GemmD g = mk_gemm((const bf16_t*)(wsp(P) + WS_R2), (const bf16_t*)(wsp(P) + WS_WGUT + (size_t)l * kE * 4096 * kD), kD, kD, 512, 16, nullptr, (size_t)4096 * kD, 32);
    EpiGU E; E.hid = (bf16_t*)(wsp(P) + WS_R1); E.sc = 1.f / kW8;
    GEMM_RUN8(g, E);
#else
    const GemmD g = mk_gemm((const bf16_t*)(wsp(P) + WS_R2), (const bf16_t*)(wsp(P) + WS_WGUT) + (size_t)l * kE * 4096 * kD, kD, kD, 512, 16, nullptr, (size_t)4096 * kD, 32);
    EpiGU E; E.hid = (bf16_t*)(wsp(P) + WS_R1); E.sc = 1.f;
    GEMM_RUN(g, E);
#endif
}
DEVI void ph_gu_dry(const Params& P, int l, int bid, int nblk) {
    const GemmD g = mk_gemm((const bf16_t*)(wsp(P) + WS_R2), (const bf16_t*)(wsp(P) + WS_WGUT) + (size_t)l * kE * 4096 * kD, kD, kD, 512, 16, nullptr, (size_t)4096 * kD, 32);
    EpiDry E; E.sink = (float*)(wsp(P) + WS_YS);
    GEMM_RUN(g, E);
}
DEVI void ph_down(const Params& P, int l, int bid, int nblk) {
#if FP8_DN
    const GemmD g = mk_gemm((const bf16_t*)(wsp(P) + WS_R1), (const bf16_t*)(wsp(P) + WS_WDT + (size_t)l * kE * kD * kFF), kFF, kFF, 512, 4, nullptr, (size_t)kD * kFF, 32);
    EpiDown E; E.y = (bf16_t*)(wsp(P) + WS_R2); E.gate = (const float*)(wsp(P) + WS_GATE); E.sc = 1.f / (kW8 * kH8);
    GEMM_RUN8(g, E);
#else
    const GemmD g = mk_gemm((const bf16_t*)(wsp(P) + WS_R1), (const bf16_t*)(wsp(P) + WS_WDT) + (size_t)l * kE * kD * kFF, kFF, kFF, 512, 4, nullptr, (size_t)kD * kFF, 32);
    EpiDown E; E.y = (bf16_t*)(wsp(P) + WS_R2); E.gate = (const float*)(wsp(P) + WS_GATE); E.sc = 1.f;
    GEMM_RUN(g, E);
#endif
}
DEVI void ph_combine(const Params& P, int l, int bid, int nblk) { phase_combine(P.out, (const bf16_t*)(wsp(P) + WS_R2), (const int*)(wsp(P) + WS_TSLOT), (l + 1 < kL) ? P.attn_norm + (size_t)(l + 1) * kD : nullptr, (bf16_t*)(wsp(P) + WS_H), bid, nblk); }

typedef __attribute__((address_space(4))) const Params* CParams;
DEVI CParams kargs() { unsigned long long a = (unsigned long long)__builtin_amdgcn_kernarg_segment_ptr(); asm volatile("" : "+s"(a)); return (CParams)a; }
#if MEGA
__global__ void __launch_bounds__(kNT, 2) mega_fwd(Params P_) {
#define PK (*(const Params*)kargs())
    volatile LAS unsigned* st = (volatile LAS unsigned*)(dyn_lds + LDS_BYTES - 16);
    if (threadIdx.x == 0) { st[0] = 0u; st[1] = 0u; st[2] = 0u; st[3] = 0u; }
    __syncthreads();
    const XcdBarrier bar = xcd_barrier_post((unsigned*)(PK.ws + WS_CTL), st);
    const int bid = blockIdx.x, nblk = gridDim.x;
    unsigned char* lds = dyn_lds;
#pragma unroll 1
    for (int rep = 0; rep < PROBE_CONV; ++rep)
    phase_convert(PK, lds, lnd(bid), nblk);
#if USE_S5_GEMM
    ph_s5_prep(PK, lds, lnd(bid), nblk);
#endif
    phase_norm(PK.x, PK.attn_norm, (bf16_t*)(PK.ws + WS_H), lnd(bid), nblk);
    xcd_barrier(bar);
#pragma unroll 1
    for (int l = 0; l < kL; ++l) {
        ph_win(PK, l, lnd(bid), nblk);            xcd_barrier(bar);
#if USE_S5_GEMM
        ph_s5_state(PK, l, lnd(bid), nblk);       xcd_barrier(bar);
        ph_s5_scan(PK, l, lds, lnd(bid), nblk);
#pragma unroll 1
        for (int rep = 0; rep < PROBE_ATTN; ++rep)
        ph_dilated(PK, l, lnd(bid), nblk);
#pragma unroll 1
        for (int rep = 0; rep < PROBE_NA; ++rep)
        ph_na(PK, l, lnd(bid), nblk);             xcd_barrier(bar);
        ph_s5_out(PK, l, lnd(bid), nblk);         xcd_barrier(bar);
#else
        ph_s5(PK, l, lds, lnd(bid), nblk);
        ph_dilated(PK, l, lnd(bid), nblk);
        ph_na(PK, l, lnd(bid), nblk);             xcd_barrier(bar);
        ph_s5fin(PK, l, lnd(bid), nblk);          xcd_barrier(bar);
#endif
        ph_glu(PK, l, lnd(bid), nblk);            xcd_barrier(bar);
#pragma unroll 1
        for (int rep = 0; rep < PROBE_MIX; ++rep) {
        ph_mixnorm(PK, l, lnd(bid), nblk);        xcd_barrier(bar); }
        ph_wout(PK, l, lnd(bid), nblk);           xcd_barrier(bar);
#pragma unroll 1
        for (int rep = 0; rep < PROBE_RT; ++rep) {
        ph_router(PK, l, lds, lnd(bid), nblk);    xcd_barrier(bar); }
#pragma unroll 1
        for (int rep = 0; rep < PROBE_TK; ++rep) {
        ph_topk(PK, lds, lnd(bid), nblk);         xcd_barrier(bar); }
#pragma unroll 1
        for (int rep = 0; rep < PROBE_GU; ++rep) {
        ph_gu(PK, l, lnd(bid), nblk);             xcd_barrier(bar); }
#if PROBE_GUDRY
        ph_gu_dry(PK, l, lnd(bid), nblk);         xcd_barrier(bar);
#endif
#pragma unroll 1
        for (int rep = 0; rep < PROBE_DOWN; ++rep) {
        ph_down(PK, l, lnd(bid), nblk);           xcd_barrier(bar); }
        ph_combine(PK, l, lnd(bid), nblk);        xcd_barrier(bar);
    }
#undef PK
}
#else
#define KB __global__ void __launch_bounds__(kNT, 2)
KB k_convert(Params P) { phase_convert(P, dyn_lds, blockIdx.x, gridDim.x); }
KB k_norm(Params P) { phase_norm(P.x, P.attn_norm, (bf16_t*)(P.ws + WS_H), blockIdx.x, gridDim.x); }
KB k_win(Params P, int l) { ph_win(P, l, blockIdx.x, gridDim.x); }
KB k_dilated(Params P, int l) { ph_dilated(P, l, blockIdx.x, gridDim.x); }
KB k_na(Params P, int l) { ph_na(P, l, blockIdx.x, gridDim.x); }
KB k_s5(Params P, int l) { ph_s5(P, l, dyn_lds, blockIdx.x, gridDim.x); }
KB k_s5fin(Params P, int l) { ph_s5fin(P, l, blockIdx.x, gridDim.x); }
KB k_glu(Params P, int l) { ph_glu(P, l, blockIdx.x, gridDim.x); }
KB k_mixnorm(Params P, int l) { ph_mixnorm(P, l, blockIdx.x, gridDim.x); }
KB k_wout(Params P, int l) { ph_wout(P, l, blockIdx.x, gridDim.x); }
KB k_router(Params P, int l) { ph_router(P, l, dyn_lds, blockIdx.x, gridDim.x); }
KB k_topk(Params P) { ph_topk(P, dyn_lds, blockIdx.x, gridDim.x); }
KB k_gu(Params P, int l) { ph_gu(P, l, blockIdx.x, gridDim.x); }
KB k_down(Params P, int l) { ph_down(P, l, blockIdx.x, gridDim.x); }
KB k_combine(Params P, int l) { ph_combine(P, l, blockIdx.x, gridDim.x); }
#endif

extern "C" void kernel_launch(void* const* d_in, const int* in_sizes, int n_in, void* d_out, int out_size, void* d_ws, size_t ws_size, hipStream_t stream) {
    (void)in_sizes; (void)n_in; (void)out_size;
    if (ws_size < WS_END) { fprintf(stderr, "workspace too small: %zu < %zu\n", ws_size, (size_t)WS_END); return; }
    Params P{};
    const float** pp = (const float**)&P;
    for (int i = 0; i < 26; ++i) pp[i] = (const float*)d_in[i];
    P.out = (float*)d_out; P.ws = (unsigned char*)d_ws;
#if MEGA
    static int grid = 0;
    if (!grid) {
        int dev = 0, cus = 0, per_cu = 0;
        (void)hipGetDevice(&dev);
        (void)hipDeviceGetAttribute(&cus, hipDeviceAttributeMultiprocessorCount, dev);
        (void)hipFuncSetAttribute((const void*)mega_fwd, hipFuncAttributeMaxDynamicSharedMemorySize, LDS_BYTES);
        (void)hipOccupancyMaxActiveBlocksPerMultiprocessor(&per_cu, (const void*)mega_fwd, kNT, LDS_BYTES);
        grid = (per_cu >= 1) ? cus : 0;
        if (!grid) fprintf(stderr, "mega_fwd does not fit a CU\n");
    }
    if (!grid) return;
    (void)hipMemsetAsync(P.ws + WS_CTL, 0, XCD_BAR_WORDS * sizeof(unsigned), stream);
    mega_fwd<<<grid, kNT, LDS_BYTES, stream>>>(P);
#else
    (void)hipFuncSetAttribute((const void*)k_router, hipFuncAttributeMaxDynamicSharedMemorySize, 65536);
    const int G = 1024;
    k_convert<<<G, kNT, 256 * 72 * 2, stream>>>(P);
    k_norm<<<G, kNT, 0, stream>>>(P);
    for (int l = 0; l < kL; ++l) {
        k_win<<<G, kNT, 0, stream>>>(P, l);
        k_dilated<<<G, kNT, 0, stream>>>(P, l);
        k_na<<<G, kNT, 0, stream>>>(P, l);
        k_s5<<<256, kNT, 8 * 128 * 4, stream>>>(P, l);
        k_s5fin<<<G, kNT, 0, stream>>>(P, l);
        k_glu<<<256, kNT, 0, stream>>>(P, l);
        k_mixnorm<<<G, kNT, 0, stream>>>(P, l);
        k_wout<<<G, kNT, 0, stream>>>(P, l);
        k_router<<<512, kNT, 65536, stream>>>(P, l);
        k_topk<<<128, kNT, 4096, stream>>>(P);
        k_gu<<<G, kNT, 0, stream>>>(P, l);
        k_down<<<G, kNT, 0, stream>>>(P, l);
        k_combine<<<G, kNT, 0, stream>>>(P, l);
    }
#endif
}
```

```cpp
#include <hip/hip_runtime.h>
#include <stdint.h>
#include <stdio.h>

#define DEVI __device__ __forceinline__
#define LAS __attribute__((address_space(3)))
typedef unsigned short bf16_t;
typedef short bf16x8 __attribute__((ext_vector_type(8)));
typedef float f32x4 __attribute__((ext_vector_type(4)));
typedef float f32x2 __attribute__((ext_vector_type(2)));
typedef unsigned u32x4 __attribute__((ext_vector_type(4)));
typedef unsigned u32x2 __attribute__((ext_vector_type(2)));

constexpr int kB = 8, kS = 8192, kD = 1024, kL = 4, kTok = kB * kS;
constexpr int kINW = 2560;
constexpr int kE = 16, kCap = 1024, kFF = 2048;
constexpr int kNT = 512;
constexpr float kEps = 1e-6f;

constexpr size_t MiB = 1024ull * 1024ull;
constexpr size_t WS_CTL   = 0;
constexpr size_t WS_WINT  = 1 * MiB;
constexpr size_t WS_WOUTT = WS_WINT + 20 * MiB;
constexpr size_t WS_WGLUT = WS_WOUTT + 8 * MiB;
constexpr size_t WS_WGUT  = WS_WGLUT + 1 * MiB;
constexpr size_t WS_WDT   = WS_WGUT + 512 * MiB;
constexpr size_t WS_H     = WS_WDT + 256 * MiB;
constexpr size_t WS_R1    = WS_H + 128 * MiB;
constexpr size_t WS_R2    = WS_R1 + 512 * MiB;
constexpr size_t WS_AFF   = WS_R2 + 256 * MiB;
constexpr size_t WS_IDX   = WS_AFF + 4 * MiB;
constexpr size_t WS_GATE  = WS_IDX + 1 * MiB;
constexpr size_t WS_TSLOT = WS_GATE + 1 * MiB;
constexpr size_t WS_LSE   = WS_TSLOT + 4 * MiB;
constexpr size_t WS_WST   = WS_LSE + 8 * MiB;
constexpr size_t WS_WSO   = WS_WST + 8 * MiB;
constexpr size_t WS_YS    = WS_WSO + 16 * MiB;
constexpr size_t WS_END   = WS_YS + 128 * MiB;
constexpr size_t R2_Z     = 192 * MiB;
constexpr size_t R1_QA = 0, R1_KA = 64 * MiB, R1_VA = 128 * MiB, R1_QB = 192 * MiB, R1_KB = 224 * MiB, R1_VB = 256 * MiB,
                 R1_UX = 288 * MiB, R1_OB = 352 * MiB, R1_OC = 384 * MiB, R1_G = 416 * MiB;

struct Params {
    const float* x; const float* attn_norm; const float* w_in; const float* q_norm_a; const float* k_norm_a; const float* q_norm_b; const float* k_norm_b;
    const float* rpb; const float* s5_a_re; const float* s5_a_im; const float* s5_log_dt; const float* s5_b_re; const float* s5_b_im; const float* s5_c_re; const float* s5_c_im;
    const float* s5_d; const float* w_glu; const float* out_norm_a; const float* out_norm_b; const float* out_norm_c; const float* w_out; const float* ffn_norm;
    const float* w_router; const float* w_gate; const float* w_up; const float* w_down;
    float* out; unsigned char* ws;
};

DEVI float bf2f(bf16_t b) { return __uint_as_float(((unsigned)b) << 16); }
DEVI bf16_t f2bf(float f) { unsigned u = __float_as_uint(f); u += 0x7FFFu + ((u >> 16) & 1u); return (bf16_t)(u >> 16); }
typedef __bf16 bf16x2_t __attribute__((ext_vector_type(2)));
DEVI unsigned pk2(float lo, float hi) { const f32x2 v = {lo, hi}; return __builtin_bit_cast(unsigned, __builtin_convertvector(v, bf16x2_t)); }
DEVI int tidx() { int t = threadIdx.x; asm volatile("" : "+v"(t)); return t; }
DEVI unsigned char* wsp(const Params& P) { unsigned long long a = (unsigned long long)P.ws; asm volatile("" : "+s"(a)); return (unsigned char*)a; }
DEVI int lnd(int v) { asm volatile("" : "+s"(v)); return v; }
DEVI float wave_sum(float v) {
#pragma unroll
    for (int m = 32; m >= 1; m >>= 1) v += __shfl_xor(v, m);
    return v;
}
DEVI float frcp(float x) { return __builtin_amdgcn_rcpf(x); }
DEVI float gelu_tanh(float y) { const float z = 0.7978845608028654f * (y + 0.044715f * y * y * y); const float t = 1.f - 2.f * frcp(1.f + __expf(2.f * z)); return 0.5f * y * (1.f + t); }

#ifndef EMU_FP8_GU
#define EMU_FP8_GU 0
#endif
#ifndef EMU_FP8_DN
#define EMU_FP8_DN 0
#endif
DEVI float q8(float x, float sc, float inv) {
    float y = x * sc; const float ay = fabsf(y);
    if (ay < 0.015625f) y = rintf(y * 512.f) * (1.f / 512.f);
    else { unsigned u = __float_as_uint(y); u += 0x7FFFFu + ((u >> 20) & 1u); u &= 0xFFF00000u; y = __uint_as_float(u); y = fminf(fmaxf(y, -448.f), 448.f); }
    return y * inv;
}
#ifndef FP8_GU
#define FP8_GU 1
#endif
#ifndef FP8_DN
#define FP8_DN 1
#endif
constexpr float kW8 = 64.f, kH8 = 8.f;
DEVI unsigned pk4_fp8(float a, float b, float c, float d) { unsigned w = 0u; w = __builtin_amdgcn_cvt_pk_fp8_f32(a, b, w, false); w = __builtin_amdgcn_cvt_pk_fp8_f32(c, d, w, true); return w; }
DEVI int cmap_head(int cs) { const int bj = cs >> 7, wc = (cs >> 5) & 3, n = (cs >> 4) & 1, fq = (cs >> 2) & 3, j = cs & 3; return 64 * wc + 32 * bj + 8 * fq + 4 * n + j; }
DEVI int cmap_pk(int cs)   { const int bj = cs >> 7, wc = (cs >> 5) & 3, n = (cs >> 4) & 1, fq = (cs >> 2) & 3, j = cs & 3; return 128 * bj + 32 * wc + 8 * fq + 4 * n + j; }
DEVI int cmap_gu(int cs)   { const int wc = (cs >> 5) & 3, n = (cs >> 4) & 1, fq = (cs >> 2) & 3, j = cs & 3; return 32 * wc + 8 * fq + 4 * n + j; }

template <int MODE, int QEMU = 0>
DEVI void convert_item(const float* W0, const float* W1, int ldw, int K, bf16_t* Bt, int kt, int pn, unsigned char* lds) {
    bf16_t* t = (bf16_t*)lds;
    const int tid = tidx();
#pragma unroll 4
    for (int it = 0; it < 32; ++it) {
        const int e = it * kNT + tid, k = e >> 8, cs = e & 255;
        float v;
        if (MODE == 0) v = W0[(size_t)(kt * 64 + k) * ldw + pn * 256 + cs];
        else if (MODE == 1) v = W0[(size_t)(kt * 64 + k) * ldw + pn * 256 + cmap_head(cs)];
        else if (MODE == 2) v = W0[(size_t)(kt * 64 + k) * ldw + pn * 256 + cmap_pk(cs)];
        else v = ((cs >> 7) ? W1 : W0)[(size_t)(kt * 64 + k) * ldw + pn * 128 + cmap_gu(cs)];
        if (QEMU) v = q8(v, 64.f, 1.f / 64.f);
        t[cs * 72 + k] = f2bf(v);
    }
    __syncthreads();
#pragma unroll
    for (int it = 0; it < 4; ++it) {
        const int c = it * kNT + tid, row = c >> 3, part = c & 7;
        const u32x4 v = *(const u32x4*)(t + row * 72 + part * 8);
        *(u32x4*)(Bt + (size_t)(pn * 256 + row) * K + kt * 64 + part * 8) = v;
    }
    __syncthreads();
}

template <int MODE>
DEVI void convert_item8(const float* W0, const float* W1, int ldw, int K, unsigned char* Bt, int kt, int pn, unsigned char* lds) {
    unsigned char* t = lds;
    const int tid = tidx();
#pragma unroll 4
    for (int it = 0; it < 64; ++it) {
        const int e = it * kNT + tid, k = e >> 8, cs = e & 255;
        float v;
        if (MODE == 2) v = W0[(size_t)(kt * 128 + k) * ldw + pn * 256 + cmap_pk(cs)];
        else v = ((cs >> 7) ? W1 : W0)[(size_t)(kt * 128 + k) * ldw + pn * 128 + cmap_gu(cs)];
        v *= kW8;
        t[cs * 144 + k] = (unsigned char)(__builtin_amdgcn_cvt_pk_fp8_f32(v, v, 0u, false) & 0xFFu);
    }
    __syncthreads();
#pragma unroll
    for (int it = 0; it < 4; ++it) {
        const int c = it * kNT + tid, row = c >> 3, part = c & 7;
        const u32x4 v = *(const u32x4*)(t + row * 144 + part * 16);
        *(u32x4*)(Bt + (size_t)(pn * 256 + row) * K + kt * 128 + part * 16) = v;
    }
    __syncthreads();
}

DEVI void phase_convert(const Params& P, unsigned char* lds, int bid, int nblk) {
    constexpr int N_WIN = kL * 16 * 10, N_WOUT = kL * 16 * 4, N_WGLU = kL * 4 * 1, N_WGU = kL * kE * (FP8_GU ? 8 : 16) * 16, N_WD = kL * kE * (FP8_DN ? 16 : 32) * 4;
    constexpr int TOT = N_WIN + N_WOUT + N_WGLU + N_WGU + N_WD;
    for (int it = bid; it < TOT; it += nblk) {
        int i = it;
        if (i < N_WIN) { const int l = i / 160, r = i % 160, kt = r / 10, pn = r % 10;
            convert_item<1>(P.w_in + (size_t)l * kD * kINW, nullptr, kINW, kD, (bf16_t*)(wsp(P) + WS_WINT) + (size_t)l * kINW * kD, kt, pn, lds); continue; }
        i -= N_WIN;
        if (i < N_WOUT) { const int l = i / 64, r = i % 64, kt = r / 4, pn = r % 4;
            convert_item<0>(P.w_out + (size_t)l * kD * kD, nullptr, kD, kD, (bf16_t*)(wsp(P) + WS_WOUTT) + (size_t)l * kD * kD, kt, pn, lds); continue; }
        i -= N_WOUT;
        if (i < N_WGLU) { const int l = i / 4, kt = i % 4;
            convert_item<2>(P.w_glu + (size_t)l * 256 * 256, nullptr, 256, 256, (bf16_t*)(wsp(P) + WS_WGLUT) + (size_t)l * 256 * 256, kt, 0, lds); continue; }
        i -= N_WGLU;
#if FP8_GU
        if (i < N_WGU) { const int le = i / 128, r = i % 128, kt = r / 16, pn = r % 16;
            convert_item8<3>(P.w_gate + (size_t)le * kD * kFF, P.w_up + (size_t)le * kD * kFF, kFF, kD, wsp(P) + WS_WGUT + (size_t)le * 4096 * kD, kt, pn, lds); continue; }
#else
        if (i < N_WGU) { const int le = i / 256, r = i % 256, kt = r / 16, pn = r % 16;
            convert_item<3, EMU_FP8_GU>(P.w_gate + (size_t)le * kD * kFF, P.w_up + (size_t)le * kD * kFF, kFF, kD, (bf16_t*)(wsp(P) + WS_WGUT) + (size_t)le * 4096 * kD, kt, pn, lds); continue; }
#endif
        i -= N_WGU;
#if FP8_DN
        { const int le = i / 64, r = i % 64, kt = r / 4, pn = r % 4;
            convert_item8<2>(P.w_down + (size_t)le * kFF * kD, nullptr, kD, kFF, wsp(P) + WS_WDT + (size_t)le * kD * kFF, kt, pn, lds); }
#else
        { const int le = i / 128, r = i % 128, kt = r / 4, pn = r % 4;
            convert_item<2, EMU_FP8_DN>(P.w_down + (size_t)le * kFF * kD, nullptr, kD, kFF, (bf16_t*)(wsp(P) + WS_WDT) + (size_t)le * kD * kFF, kt, pn, lds); }
#endif
    }
}

DEVI void phase_norm(const float* x, const float* gain, bf16_t* h, int bid, int nblk) {
    const int wid = tidx() >> 6, lane = tidx() & 63;
    f32x4 g[4];
#pragma unroll
    for (int q = 0; q < 4; ++q) g[q] = *(const f32x4*)(gain + q * 256 + lane * 4);
    for (int row = bid * 8 + wid; row < kTok; row += nblk * 8) {
        f32x4 v[4]; float ss = 0.f;
#pragma unroll
        for (int q = 0; q < 4; ++q) { v[q] = *(const f32x4*)(x + (size_t)row * kD + q * 256 + lane * 4); ss += v[q].x * v[q].x + v[q].y * v[q].y + v[q].z * v[q].z + v[q].w * v[q].w; }
        ss = wave_sum(ss);
        const float rstd = rsqrtf(ss * (1.f / kD) + kEps);
#pragma unroll
        for (int q = 0; q < 4; ++q) { u32x2 o; o.x = pk2(v[q].x * rstd * g[q].x, v[q].y * rstd * g[q].y); o.y = pk2(v[q].z * rstd * g[q].z, v[q].w * rstd * g[q].w);
            *(u32x2*)(h + (size_t)row * kD + q * 256 + lane * 4) = o; }
    }
}

DEVI void phase_router(const float* x, const float* gain, const float* wr  , bf16_t* h, float* aff, unsigned char* lds, int bid, int nblk) {
    float* wT = (float*)lds;
    for (int i = tidx(); i < 16 * 1024; i += kNT) { const int k = i >> 4, e = i & 15; wT[e * 1024 + k] = wr[i]; }
    __syncthreads();
    const int wid = tidx() >> 6, lane = tidx() & 63;
    f32x4 g[4];
#pragma unroll
    for (int q = 0; q < 4; ++q) g[q] = *(const f32x4*)(gain + q * 256 + lane * 4);
    f32x4 nvx[2][4];
    { const int r0 = (bid * 8 + wid) * 2;
      if (r0 < kTok) {
#pragma unroll
        for (int r = 0; r < 2; ++r)
#pragma unroll
            for (int q = 0; q < 4; ++q) nvx[r][q] = *(const f32x4*)(x + (size_t)(r0 + r) * kD + q * 256 + lane * 4); } }
    for (int row0 = (bid * 8 + wid) * 2; row0 < kTok; row0 += nblk * 8 * 2) {
        asm volatile("" ::: "memory");
        f32x4 v[2][4];
#pragma unroll
        for (int r = 0; r < 2; ++r)
#pragma unroll
            for (int q = 0; q < 4; ++q) v[r][q] = nvx[r][q];
        { const int nr0 = row0 + nblk * 8 * 2;
          if (nr0 < kTok) {
#pragma unroll
            for (int r = 0; r < 2; ++r)
#pragma unroll
                for (int q = 0; q < 4; ++q) nvx[r][q] = *(const f32x4*)(x + (size_t)(nr0 + r) * kD + q * 256 + lane * 4); } }
#pragma unroll
        for (int r = 0; r < 2; ++r) { float ss = 0.f;
#pragma unroll
            for (int q = 0; q < 4; ++q) { ss += v[r][q].x * v[r][q].x + v[r][q].y * v[r][q].y + v[r][q].z * v[r][q].z + v[r][q].w * v[r][q].w; }
            ss = wave_sum(ss); const float rstd = rsqrtf(ss * (1.f / kD) + kEps);
#pragma unroll
            for (int q = 0; q < 4; ++q) { v[r][q] = v[r][q] * rstd * g[q];
#if FP8_GU
                *(unsigned*)((unsigned char*)h + (size_t)(row0 + r) * kD + q * 256 + lane * 4) = pk4_fp8(v[r][q].x, v[r][q].y, v[r][q].z, v[r][q].w); }
#else
                u32x2 o;
                if (EMU_FP8_GU) { o.x = pk2(q8(v[r][q].x, 1.f, 1.f), q8(v[r][q].y, 1.f, 1.f)); o.y = pk2(q8(v[r][q].z, 1.f, 1.f), q8(v[r][q].w, 1.f, 1.f)); }
                else { o.x = pk2(v[r][q].x, v[r][q].y); o.y = pk2(v[r][q].z, v[r][q].w); }
                *(u32x2*)(h + (size_t)(row0 + r) * kD + q * 256 + lane * 4) = o; }
#endif
        }
        float pa[32];
#pragma unroll
        for (int e = 0; e < 16; ++e) {
            float s0 = 0.f, s1 = 0.f;
#pragma unroll
            for (int q = 0; q < 4; ++q) { const f32x4 w = *(const f32x4*)(wT + e * 1024 + q * 256 + lane * 4);
                s0 += v[0][q].x * w.x + v[0][q].y * w.y + v[0][q].z * w.z + v[0][q].w * w.w;
                s1 += v[1][q].x * w.x + v[1][q].y * w.y + v[1][q].z * w.z + v[1][q].w * w.w; }
            pa[e] = s0; pa[16 + e] = s1;
        }
#define RS_STEP(HALF, MASK) { const bool up = (lane & (MASK)) != 0; _Pragma("unroll") for (int i = 0; i < (HALF); ++i) { const float keep = up ? pa[i + (HALF)] : pa[i], send = up ? pa[i] : pa[i + (HALF)]; pa[i] = keep + __shfl_xor(send, (MASK)); } }
        RS_STEP(16, 32) RS_STEP(8, 16) RS_STEP(4, 8) RS_STEP(2, 4) RS_STEP(1, 2)
#undef RS_STEP
        const float logit = pa[0] + __shfl_xor(pa[0], 1);
        float mx = logit;
#pragma unroll
        for (int m = 16; m >= 2; m >>= 1) mx = fmaxf(mx, __shfl_xor(mx, m));
        const float ex = __expf(logit - mx);
        float sm = ex;
#pragma unroll
        for (int m = 16; m >= 2; m >>= 1) sm += __shfl_xor(sm, m);
        const int row = row0 + (lane >> 5), e = (lane >> 1) & 15, b = row >> 13, s = row & (kS - 1);
        if (!(lane & 1)) aff[((size_t)(b * kE + e)) * kS + s] = ex * frcp(sm);
    }
    __syncthreads();
}

DEVI int block_excl_scan(int v, int* sh  , int& total) {
    const int lane = tidx() & 63, wid = tidx() >> 6;
    int incl = v;
#pragma unroll
    for (int d = 1; d < 64; d <<= 1) { const int o = __shfl_up(incl, d); if (lane >= d) incl += o; }
    __syncthreads();
    if (lane == 63) sh[wid] = incl;
    __syncthreads();
    int base = 0, tot = 0;
#pragma unroll
    for (int w = 0; w < 8; ++w) { const int c = sh[w]; if (w < wid) base += c; tot += c; }
    total = tot;
    return base + incl - v;
}

DEVI void phase_topk(const float* aff, int* idx, float* gate, int* tokslot, const unsigned char* hsrc, unsigned char* xe, int rowbytes, unsigned char* lds, int bid, int nblk) {
    int* hist = (int*)lds;
    int* sh = hist + 256;
    int* res = sh + 16;
    int* lsel = res + 16;
    const int tid = tidx(), lane = tid & 63, wid = tid >> 6;
    for (int item = bid; item < kB * kE; item += nblk) {
        const int b = item >> 4, e = item & 15;
        const float* a = aff + (size_t)item * kS;
        unsigned key[16];
#pragma unroll
        for (int q = 0; q < 4; ++q) { const u32x4 v = *(const u32x4*)(a + tid * 16 + q * 4); key[q * 4 + 0] = v.x; key[q * 4 + 1] = v.y; key[q * 4 + 2] = v.z; key[q * 4 + 3] = v.w; }
        unsigned prefix = 0; int kk = kCap;
#pragma unroll 1
        for (int pass = 0; pass < 4; ++pass) {
            const int shift = 24 - 8 * pass;
            __syncthreads();
            if (tid < 256) hist[tid] = 0;
            __syncthreads();
#pragma unroll
            for (int i = 0; i < 16; ++i) { const bool in = (pass == 0) || ((key[i] >> (shift + 8)) == prefix); if (in) atomicAdd(&hist[(key[i] >> shift) & 255], 1); }
            __syncthreads();
            if (wid == 0) {
                int c[4], loc = 0;
#pragma unroll
                for (int j = 0; j < 4; ++j) { c[j] = hist[255 - 4 * lane - j]; loc += c[j]; }
                int incl = loc;
#pragma unroll
                for (int d = 1; d < 64; d <<= 1) { const int o = __shfl_up(incl, d); if (lane >= d) incl += o; }
                const int excl = incl - loc;
                if (excl < kk && kk <= incl) { int run = excl; int bin = 0, nk = 0; bool found = false;
#pragma unroll
                    for (int j = 0; j < 4; ++j) { if (!found && run + c[j] >= kk) { bin = 255 - 4 * lane - j; nk = kk - run; found = true; } if (!found) run += c[j]; }
                    res[0] = bin; res[1] = nk; }
            }
            __syncthreads();
            prefix = (prefix << 8) | (unsigned)res[0]; kk = res[1];
        }
        const unsigned T = prefix;
        int ceq = 0;
#pragma unroll
        for (int i = 0; i < 16; ++i) ceq += (key[i] == T) ? 1 : 0;
        int tot;
        int eqb = block_excl_scan(ceq, sh, tot);
        int csel = 0; unsigned selmask = 0;
#pragma unroll
        for (int i = 0; i < 16; ++i) { bool s = key[i] > T; if (key[i] == T) { s = eqb < kk; ++eqb; } if (s) { selmask |= 1u << i; ++csel; } }
        int slot = block_excl_scan(csel, sh, tot);
        const size_t rbase = (size_t)(e * kB + b) * kCap;
#pragma unroll
        for (int i = 0; i < 16; ++i) { const int s = tid * 16 + i; const bool sel = (selmask >> i) & 1u;
            if (sel) { idx[rbase + slot] = b * kS + s; gate[rbase + slot] = __uint_as_float(key[i]); lsel[slot] = b * kS + s; }
            tokslot[((size_t)(b * kS + s)) * kE + e] = sel ? slot : -1;
            if (sel) ++slot; }
        __syncthreads();
        { const int cpr = rowbytes >> 4;
          for (int c0 = tid; c0 < kCap * cpr; c0 += kNT * 4) {
              u32x4 v[4];
#pragma unroll
              for (int j = 0; j < 4; ++j) { const int c = c0 + j * kNT; const int r = c / cpr, ch = c - r * cpr; v[j] = *(const u32x4*)(hsrc + (size_t)lsel[r] * rowbytes + ch * 16); }
#pragma unroll
              for (int j = 0; j < 4; ++j) { const int c = c0 + j * kNT; const int r = c / cpr, ch = c - r * cpr; *(u32x4*)(xe + (rbase + r) * rowbytes + ch * 16) = v[j]; }
          } }
    }
    __syncthreads();
}

struct Unit { int pm, pn; };
DEVI bool unit_of(int Lid, int nM, int nN, Unit& u) {
    const int nwg = nM * nN; if (Lid >= nwg) return false;
    int wgid = Lid; { const int q = nwg / 8, r = nwg % 8, xcd = wgid % 8, off = wgid / 8; wgid = (xcd < r ? xcd * (q + 1) : r * (q + 1) + (xcd - r) * q) + off; }
    const int nig = 8 * nN, gid = wgid / nig, fm = gid * 8, gsz = (nM - fm) < 8 ? (nM - fm) : 8;
    u.pm = fm + ((wgid % nig) % gsz); u.pn = (wgid % nig) / gsz; return true;
}
struct GemmD { const bf16_t* A; const bf16_t* Bt; int lda, K, nM, nN; const int* rowidx; size_t bstride; int pmg; };

template <class Epi>
DEVI void gemm_simple(const GemmD g, const Epi& E, int bid, int nblk) {
    const int tid = tidx(), wid = tid >> 6, lane = tid & 63, wr = wid >> 2, wc = wid & 3, fr = lane & 15, fq = lane >> 4;
    for (int i = 0;; ++i) {
        Unit u; if (!unit_of(i * nblk + bid, g.nM, g.nN, u)) break;
        f32x4 acc[2][2][4][2];
#pragma unroll
        for (int a = 0; a < 2; ++a)
#pragma unroll
            for (int b = 0; b < 2; ++b)
#pragma unroll
                for (int m = 0; m < 4; ++m)
#pragma unroll
                    for (int n = 0; n < 2; ++n) acc[a][b][m][n] = (f32x4){0.f, 0.f, 0.f, 0.f};
        const bf16_t* Bu = g.Bt + (size_t)(u.pm / g.pmg) * g.bstride + (size_t)u.pn * 256 * g.K;
        unsigned ao[2][4], bo[2][2];
#pragma unroll
        for (int a = 0; a < 2; ++a)
#pragma unroll
            for (int m = 0; m < 4; ++m) { const int r = u.pm * 256 + 128 * a + 64 * wr + 16 * m + fr; const unsigned rr = g.rowidx ? (unsigned)g.rowidx[r] : (unsigned)r; ao[a][m] = rr * (unsigned)g.lda + 8u * fq; }
#pragma unroll
        for (int b = 0; b < 2; ++b)
#pragma unroll
            for (int n = 0; n < 2; ++n) bo[b][n] = (unsigned)(128 * b + 32 * wc + 16 * n + fr) * (unsigned)g.K + 8u * fq;
#pragma unroll 1
        for (int k0 = 0; k0 < g.K; k0 += 32) {
            bf16x8 av[2][4], bv[2][2];
#pragma unroll
            for (int a = 0; a < 2; ++a)
#pragma unroll
                for (int m = 0; m < 4; ++m) av[a][m] = *(const bf16x8*)(g.A + ao[a][m] + k0);
#pragma unroll
            for (int b = 0; b < 2; ++b)
#pragma unroll
                for (int n = 0; n < 2; ++n) bv[b][n] = *(const bf16x8*)(Bu + bo[b][n] + k0);
#pragma unroll
            for (int a = 0; a < 2; ++a)
#pragma unroll
                for (int b = 0; b < 2; ++b)
#pragma unroll
                    for (int m = 0; m < 4; ++m)
#pragma unroll
                        for (int n = 0; n < 2; ++n) acc[a][b][m][n] = __builtin_amdgcn_mfma_f32_16x16x32_bf16(bv[b][n], av[a][m], acc[a][b][m][n], 0, 0, 0);
        }
        E(acc, u, wr, wc, fr, fq);
    }
}


constexpr int PG_HTB = 128 * 64 * 2;
DEVI int pg_lds_byte(int r, int c) { const int st = (r >> 4) * 2 + (c >> 5), rr = r & 15, cc = c & 31, ob = rr * 64 + cc * 2; return st * 1024 + (ob ^ (((ob >> 9) & 1) << 5)); }
DEVI void pg_stage_rc(int b, int& R, int& C) { const int st = b / 1024, sb = b % 1024, swz = sb ^ (((sb >> 9) & 1) << 5); R = (st >> 1) * 16 + swz / 64; C = (st & 1) * 32 + (swz % 64) / 2; }

typedef int v4i __attribute__((ext_vector_type(4)));
typedef int v8i __attribute__((ext_vector_type(8)));
template <class Epi, bool ALIGN_EPI, bool SP2, bool FP8 = false>
DEVI void gemm_engine(LAS unsigned char* lds, const GemmD g, const Epi& E, int bid, int nblk) {
    const int tid = tidx(), wid = __builtin_amdgcn_readfirstlane(tid >> 6), lane = tid & 63, wr = wid >> 2, wc = wid & 3, fr = lane & 15, fq = lane >> 4;
    constexpr int ES = FP8 ? 1 : 2;
    const int K = g.K * ES  , nt = K / 128; const unsigned ldaB = (unsigned)g.lda * ES;
    unsigned voffA[2], voffB[2];
#pragma unroll
    for (int i = 0; i < 2; ++i) { int R, C; pg_stage_rc(tid * 16 + i * 8192, R, C); voffA[i] = (unsigned)R * ldaB + (unsigned)C * 2u; voffB[i] = (unsigned)(R * K + C * 2); }
    const size_t kstep = 128;
    const size_t hstepB = (size_t)128 * K, hstepA = (size_t)128 * ldaB, tstepA = 2 * hstepA;
    const unsigned ldsw = (unsigned)wid * 1024u;
    const int aoff = pg_lds_byte(wr * 64 + fr, fq * 8), boff = pg_lds_byte(wc * 32 + fr, fq * 8);
#define PG8_SA(b, h) (((b) * 2 + (h)) * PG_HTB)
#define PG8_SB(b, h) ((4 + (b) * 2 + (h)) * PG_HTB)
#define PG8_STAGE(bufoff, gbase, voff) do { _Pragma("unroll") for (int _i = 0; _i < 2; ++_i) \
        __builtin_amdgcn_global_load_lds((const unsigned*)((const char*)(gbase) + (voff)[_i]), (LAS unsigned*)(lds + (bufoff) + ldsw + _i * 8192), 16, 0, 0); } while (0)
#define PG8_RD16(off) (*(const LAS v4i*)(lds + (off)))
#define PG8_CAT2(off) __builtin_shufflevector(PG8_RD16(off), PG8_RD16((off) + 1024), 0, 1, 2, 3, 4, 5, 6, 7)
#define PG8_LDA(dst, b, h) do { _Pragma("unroll") for (int m = 0; m < 4; ++m) { if constexpr (FP8) dst##8[m] = PG8_CAT2(PG8_SA(b, h) + aoff + m * 2048); \
        else { _Pragma("unroll") for (int k = 0; k < 2; ++k) dst[m][k] = *(const LAS bf16x8*)(lds + PG8_SA(b, h) + aoff + m * 2048 + k * 1024); } } } while (0)
#define PG8_LDB(dst, b, h) do { _Pragma("unroll") for (int n = 0; n < 2; ++n) { if constexpr (FP8) dst##8[n] = PG8_CAT2(PG8_SB(b, h) + boff + n * 2048); \
        else { _Pragma("unroll") for (int k = 0; k < 2; ++k) dst[n][k] = *(const LAS bf16x8*)(lds + PG8_SB(b, h) + boff + n * 2048 + k * 1024); } } } while (0)
#define PG8_MMA(ai, bj, At, Bt) do { __builtin_amdgcn_s_setprio(1); _Pragma("unroll") for (int m = 0; m < 4; ++m) _Pragma("unroll") for (int n = 0; n < 2; ++n) { \
        if constexpr (FP8) asm volatile("v_mfma_f32_16x16x128_f8f6f4 %0, %1, %2, %0" : "+v"(acc[ai][bj][m][n]) : "v"(Bt##8[n]), "v"(At##8[m]));   \
        else { _Pragma("unroll") for (int k = 0; k < 2; ++k) acc[ai][bj][m][n] = __builtin_amdgcn_mfma_f32_16x16x32_bf16(Bt[n][k], At[m][k], acc[ai][bj][m][n], 0, 0, 0); } } \
        __builtin_amdgcn_s_setprio(0); } while (0)
#define PG8_WAIT_V(n) asm volatile("s_waitcnt vmcnt(" #n ")" ::: "memory")
#define PG8_WAIT_L(n) asm volatile("s_waitcnt lgkmcnt(" #n ")" ::: "memory")
#define PG8_BAR __builtin_amdgcn_s_barrier()
#define PG8_SCHED __builtin_amdgcn_sched_barrier(0)
    Unit cur, nxt; int ui = 0;
    if (!unit_of(bid, g.nM, g.nN, cur)) return;
    f32x4 acc[2][2][4][2];
#pragma unroll
    for (int a = 0; a < 2; ++a)
#pragma unroll
        for (int b = 0; b < 2; ++b)
#pragma unroll
            for (int m = 0; m < 4; ++m)
#pragma unroll
                for (int n = 0; n < 2; ++n) acc[a][b][m][n] = (f32x4){0.f, 0.f, 0.f, 0.f};
    bf16x8 At[4][2], B0[2][2], B1[2][2]; v8i At8[4], B08[2], B18[2];
    (void)At; (void)B0; (void)B1; (void)At8; (void)B08; (void)B18;
    static_assert(SP2, "only the two-super-phase K-loop is kept");
    const char* cA = (const char*)g.A + (size_t)cur.pm * tstepA;
    const char* cB = (const char*)g.Bt + (size_t)(cur.pm / g.pmg) * g.bstride * ES + (size_t)cur.pn * 256 * K;
    PG8_STAGE(PG8_SB(0, 0), cB, voffB); PG8_STAGE(PG8_SB(0, 1), cB + hstepB, voffB); PG8_STAGE(PG8_SA(0, 0), cA, voffA); PG8_STAGE(PG8_SA(0, 1), cA + hstepA, voffA);
    if (wr == 1) PG8_BAR;
    PG8_WAIT_V(2); PG8_BAR;
    PG8_STAGE(PG8_SB(1, 0), cB + kstep, voffB); PG8_STAGE(PG8_SA(1, 0), cA + kstep, voffA); PG8_STAGE(PG8_SB(1, 1), cB + hstepB + kstep, voffB);
    PG8_WAIT_V(6); PG8_BAR;
    for (;;) {
        const bool has_next = unit_of((ui + 1) * nblk + bid, g.nM, g.nN, nxt);
        const char* nA = has_next ? (const char*)g.A + (size_t)nxt.pm * tstepA : cA;
        const char* nB = has_next ? (const char*)g.Bt + (size_t)(nxt.pm / g.pmg) * g.bstride * ES + (size_t)nxt.pn * 256 * K : cB;
#pragma unroll 1
        for (int t = 0; t < nt; t += 2) {
            const bool last = (t == nt - 2);
            const char* a1 = cA + (size_t)(t + 1) * kstep;
            const char* a2 = last ? nA : cA + (size_t)(t + 2) * kstep; const char* b2 = last ? nB : cB + (size_t)(t + 2) * kstep;
            const char* a3 = a2 + kstep; const char* b3 = b2 + kstep;
            PG8_LDB(B0, 0, 0); PG8_LDB(B1, 0, 1); PG8_SCHED; PG8_LDA(At, 0, 0); PG8_STAGE(PG8_SA(1, 1), a1 + hstepA, voffA);
            PG8_WAIT_V(8); PG8_WAIT_L(0); PG8_BAR; PG8_MMA(0, 0, At, B0); PG8_MMA(0, 1, At, B1); PG8_BAR; PG8_SCHED;
            PG8_LDA(At, 0, 1); PG8_STAGE(PG8_SB(0, 0), b2, voffB); PG8_STAGE(PG8_SB(0, 1), b2 + hstepB, voffB); PG8_STAGE(PG8_SA(0, 0), a2, voffA);
            PG8_WAIT_V(8); PG8_WAIT_L(0); PG8_BAR; PG8_MMA(1, 0, At, B0); PG8_MMA(1, 1, At, B1); PG8_BAR; PG8_SCHED;
            PG8_LDB(B0, 1, 0); PG8_LDB(B1, 1, 1); PG8_SCHED; PG8_LDA(At, 1, 0); PG8_STAGE(PG8_SA(0, 1), a2 + hstepA, voffA);
            PG8_WAIT_V(8); PG8_WAIT_L(0); PG8_BAR; PG8_MMA(0, 0, At, B0); PG8_MMA(0, 1, At, B1); PG8_BAR; PG8_SCHED;
            PG8_LDA(At, 1, 1); PG8_STAGE(PG8_SB(1, 0), b3, voffB); PG8_STAGE(PG8_SB(1, 1), b3 + hstepB, voffB); PG8_STAGE(PG8_SA(1, 0), a3, voffA);
            PG8_WAIT_V(8); PG8_WAIT_L(0); PG8_BAR; PG8_MMA(1, 0, At, B0); PG8_MMA(1, 1, At, B1); PG8_BAR; PG8_SCHED;
        }
        if constexpr (ALIGN_EPI) { if (wr == 0) PG8_BAR; }
        if constexpr (FP8) asm volatile("s_nop 15\n\ts_nop 15" ::: "memory");
        E(acc, cur, wr, wc, fr, fq);
        if (!has_next) break;
#pragma unroll
        for (int a = 0; a < 2; ++a)
#pragma unroll
            for (int b = 0; b < 2; ++b)
#pragma unroll
                for (int m = 0; m < 4; ++m)
#pragma unroll
                    for (int n = 0; n < 2; ++n) acc[a][b][m][n] = (f32x4){0.f, 0.f, 0.f, 0.f};
        cur = nxt; cA = nA; cB = nB; ++ui;
        if constexpr (ALIGN_EPI) { if (wr == 1) PG8_BAR; }
    }
    PG8_WAIT_V(0);
    if constexpr (!ALIGN_EPI) { if (wr == 0) PG8_BAR; }
    PG8_BAR;
#undef PG8_SA
#undef PG8_SB
#undef PG8_STAGE
#undef PG8_LDA
#undef PG8_LDB
#undef PG8_MMA
#undef PG8_RD16
#undef PG8_CAT2
#undef PG8_WAIT_V
#undef PG8_WAIT_L
#undef PG8_BAR
#undef PG8_SCHED
}

struct EpiQKV {
    static constexpr int VMOPS = 16;
    bf16_t *qa, *ka, *va, *qb, *kb, *vb, *ux; const float *qna, *kna, *qnb, *knb;
    DEVI void operator()(const f32x4 (&acc)[2][2][4][2], const Unit& u, int wr, int wc, int fr, int fq) const {
        bf16_t* dst; const float* gn = nullptr; int H = 8, head0 = 0; const int pn = u.pn;
        if (pn < 2) { dst = qa; gn = qna; head0 = pn * 4; }
        else if (pn < 4) { dst = ka; gn = kna; head0 = (pn - 2) * 4; }
        else if (pn < 6) { dst = va; head0 = (pn - 4) * 4; }
        else if (pn == 6) { dst = qb; gn = qnb; H = 4; }
        else if (pn == 7) { dst = kb; gn = knb; H = 4; }
        else if (pn == 8) { dst = vb; H = 4; }
        else { dst = ux; }
        const int head = head0 + wc;
        f32x4 gv[2][2];
#pragma unroll
        for (int bj = 0; bj < 2; ++bj)
#pragma unroll
            for (int n = 0; n < 2; ++n) gv[bj][n] = gn ? *(const f32x4*)(gn + 32 * bj + 8 * fq + 4 * n) : (f32x4){1.f, 1.f, 1.f, 1.f};
#pragma unroll
        for (int ai = 0; ai < 2; ++ai)
#pragma unroll
            for (int m = 0; m < 4; ++m) {
                const int row = u.pm * 256 + 128 * ai + 64 * wr + 16 * m + fr;
                float rstd = 1.f;
                if (gn) { float ss = 0.f;
#pragma unroll
                    for (int bj = 0; bj < 2; ++bj)
#pragma unroll
                        for (int n = 0; n < 2; ++n) { const f32x4 v = acc[ai][bj][m][n]; ss += v.x * v.x + v.y * v.y + v.z * v.z + v.w * v.w; }
                    ss += __shfl_xor(ss, 16); ss += __shfl_xor(ss, 32);
                    rstd = rsqrtf(ss * (1.f / 64.f) + kEps); }
#pragma unroll
                for (int bj = 0; bj < 2; ++bj) {
                    const f32x4 v0 = acc[ai][bj][m][0] * rstd * gv[bj][0], v1 = acc[ai][bj][m][1] * rstd * gv[bj][1];
                    u32x4 w; w.x = pk2(v0.x, v0.y); w.y = pk2(v0.z, v0.w); w.z = pk2(v1.x, v1.y); w.w = pk2(v1.z, v1.w);
                    if (pn < 9) { const int b = row >> 13, s = row & (kS - 1);
                        *(u32x4*)(dst + (((size_t)(b * H + head)) * kS + s) * 64 + 32 * bj + 8 * fq) = w; }
                    else { const int gidx = 4 * wc + 2 * bj + (fq >> 1), c0 = 8 * (fq & 1);
                        *(u32x4*)(dst + ((size_t)gidx * 4096 + (row >> 4)) * 512 + (row & 15) * 16 + c0) = w; }
                }
            }
    }
};
struct EpiResid {
    static constexpr int VMOPS = 32;
    const float* xin; float* xout;
    DEVI void operator()(const f32x4 (&acc)[2][2][4][2], const Unit& u, int wr, int wc, int fr, int fq) const {
#pragma unroll
        for (int ai = 0; ai < 2; ++ai)
#pragma unroll
            for (int m = 0; m < 4; ++m) { const size_t ro = (size_t)(u.pm * 256 + 128 * ai + 64 * wr + 16 * m + fr) * kD + u.pn * 256 + 32 * wc + 4 * fq;
#pragma unroll
                for (int bj = 0; bj < 2; ++bj)
#pragma unroll
                    for (int n = 0; n < 2; ++n) { const size_t o = ro + 128 * bj + 16 * n; *(f32x4*)(xout + o) = *(const f32x4*)(xin + o) + acc[ai][bj][m][n]; } }
    }
};
struct EpiGU {
    static constexpr int VMOPS = 8;
    bf16_t* hid; float sc;
    DEVI void operator()(const f32x4 (&acc)[2][2][4][2], const Unit& u, int wr, int wc, int fr, int fq) const {
#pragma unroll
        for (int ai = 0; ai < 2; ++ai)
#pragma unroll
            for (int m = 0; m < 4; ++m) { const size_t row = (size_t)(u.pm * 256 + 128 * ai + 64 * wr + 16 * m + fr);
                float o[8];
#pragma unroll
                for (int n = 0; n < 2; ++n)
#pragma unroll
                    for (int j = 0; j < 4; ++j) { const float gt = acc[ai][0][m][n][j] * sc, up = acc[ai][1][m][n][j] * sc; o[n * 4 + j] = gt * frcp(1.f + __expf(-gt)) * up; if (EMU_FP8_DN) o[n * 4 + j] = q8(o[n * 4 + j], 8.f, 0.125f); }
#if FP8_DN
                u32x2 w;
#pragma unroll
                for (int t = 0; t < 8; ++t) o[t] = fminf(fmaxf(o[t] * kH8, -448.f), 448.f);
                w.x = pk4_fp8(o[0], o[1], o[2], o[3]); w.y = pk4_fp8(o[4], o[5], o[6], o[7]);
                *(u32x2*)((unsigned char*)hid + row * kFF + u.pn * 128 + 32 * wc + 8 * fq) = w;
#else
                u32x4 w; w.x = pk2(o[0], o[1]); w.y = pk2(o[2], o[3]); w.z = pk2(o[4], o[5]); w.w = pk2(o[6], o[7]);
                *(u32x4*)(hid + row * kFF + u.pn * 128 + 32 * wc + 8 * fq) = w;
#endif
            }
    }
};
struct EpiDry {
    static constexpr int VMOPS = 0;
    float* sink;
    DEVI void operator()(const f32x4 (&acc)[2][2][4][2], const Unit& u, int wr, int wc, int fr, int fq) const {
        float t = 0.f;
#pragma unroll
        for (int ai = 0; ai < 2; ++ai)
#pragma unroll
            for (int bj = 0; bj < 2; ++bj)
#pragma unroll
                for (int m = 0; m < 4; ++m)
#pragma unroll
                    for (int n = 0; n < 2; ++n) t += acc[ai][bj][m][n].x + acc[ai][bj][m][n].y + acc[ai][bj][m][n].z + acc[ai][bj][m][n].w;
        if (t == 1.2345e30f) sink[0] = t;
    }
};
struct EpiDown {
    static constexpr int VMOPS = 16;
    bf16_t* y; const float* gate; float sc;
    DEVI void operator()(const f32x4 (&acc)[2][2][4][2], const Unit& u, int wr, int wc, int fr, int fq) const {
#pragma unroll
        for (int ai = 0; ai < 2; ++ai)
#pragma unroll
            for (int m = 0; m < 4; ++m) { const size_t row = (size_t)(u.pm * 256 + 128 * ai + 64 * wr + 16 * m + fr); const float gv = gate[row] * sc;
#pragma unroll
                for (int bj = 0; bj < 2; ++bj) { const f32x4 v0 = acc[ai][bj][m][0] * gv, v1 = acc[ai][bj][m][1] * gv;
                    u32x4 w; w.x = pk2(v0.x, v0.y); w.y = pk2(v0.z, v0.w); w.z = pk2(v1.x, v1.y); w.w = pk2(v1.z, v1.w);
                    *(u32x4*)(y + row * kD + u.pn * 256 + 128 * bj + 32 * wc + 8 * fq) = w; } }
    }
};
struct EpiGlu {
    static constexpr int VMOPS = 16;
    const bf16_t* g; bf16_t* oc;
    DEVI void operator()(const f32x4 (&acc)[2][2][4][2], const Unit& u, int wr, int wc, int fr, int fq) const {
#pragma unroll
        for (int ai = 0; ai < 2; ++ai)
#pragma unroll
            for (int m = 0; m < 4; ++m) { const size_t row = (size_t)(u.pm * 256 + 128 * ai + 64 * wr + 16 * m + fr);
#pragma unroll
                for (int bj = 0; bj < 2; ++bj) { const size_t o = row * 256 + 128 * bj + 32 * wc + 8 * fq;
                    const u32x4 gw = *(const u32x4*)(g + o); float o8[8];
#pragma unroll
                    for (int n = 0; n < 2; ++n)
#pragma unroll
                        for (int j = 0; j < 4; ++j) { const int t = n * 4 + j; const unsigned wv = (t < 2) ? gw.x : (t < 4) ? gw.y : (t < 6) ? gw.z : gw.w;
                            const float gg = __uint_as_float((t & 1) ? (wv & 0xFFFF0000u) : (wv << 16)); o8[t] = gg * frcp(1.f + __expf(-acc[ai][bj][m][n][j])); }
                    u32x4 w; w.x = pk2(o8[0], o8[1]); w.y = pk2(o8[2], o8[3]); w.z = pk2(o8[4], o8[5]); w.w = pk2(o8[6], o8[7]);
                    *(u32x4*)(oc + o) = w; } }
    }
};

DEVI void load_row64(const bf16_t* p, float* d) {
#pragma unroll
    for (int i = 0; i < 8; ++i) { const u32x4 v = *(const u32x4*)(p + i * 8);
        d[i * 8 + 0] = __uint_as_float(v.x << 16); d[i * 8 + 1] = __uint_as_float(v.x & 0xFFFF0000u); d[i * 8 + 2] = __uint_as_float(v.y << 16); d[i * 8 + 3] = __uint_as_float(v.y & 0xFFFF0000u);
        d[i * 8 + 4] = __uint_as_float(v.z << 16); d[i * 8 + 5] = __uint_as_float(v.z & 0xFFFF0000u); d[i * 8 + 6] = __uint_as_float(v.w << 16); d[i * 8 + 7] = __uint_as_float(v.w & 0xFFFF0000u); }
}
DEVI void store_row64(bf16_t* p, const float* d, float sc) {
#pragma unroll
    for (int i = 0; i < 8; ++i) { u32x4 w; w.x = pk2(d[i * 8] * sc, d[i * 8 + 1] * sc); w.y = pk2(d[i * 8 + 2] * sc, d[i * 8 + 3] * sc); w.z = pk2(d[i * 8 + 4] * sc, d[i * 8 + 5] * sc); w.w = pk2(d[i * 8 + 6] * sc, d[i * 8 + 7] * sc);
        *(u32x4*)(p + i * 8) = w; }
}
DEVI void phase_dilated_naive(const bf16_t* qa, const bf16_t* ka, const bf16_t* va, bf16_t* oac, float* lse, int bid, int nblk) {
    const int nitems = 3 * kB * 8 * (kS / kNT);
    for (int it = bid; it < nitems; it += nblk) {
        const int c = it / (kB * 8 * 16), r = it % (kB * 8 * 16), bh = r / 16, t = (r % 16) * kNT + tidx(), b = bh >> 3, h = bh & 7;
        const int dil = (c == 0) ? 1 : (c == 1) ? 4 : 16;
        const float slope = exp2f(-(float)(h + 1));
        const bf16_t* kb_ = ka + (size_t)bh * kS * 64; const bf16_t* vb_ = va + (size_t)bh * kS * 64;
        float q[64], o[64];
        load_row64(qa + ((size_t)bh * kS + t) * 64, q);
#pragma unroll
        for (int d = 0; d < 64; ++d) o[d] = 0.f;
        float m = -1e30f, l = 0.f;
        for (int rel = -64; rel <= 64; ++rel) {
            const int pos = t + rel * dil;
            if (pos < 0 || pos >= kS) continue;
            float kv[64]; load_row64(kb_ + (size_t)pos * 64, kv);
            float dot = 0.f;
#pragma unroll
            for (int d = 0; d < 64; ++d) dot += q[d] * kv[d];
            const float sc = dot * 0.125f - slope * (float)(dil * (rel < 0 ? -rel : rel));
            const float mn = fmaxf(m, sc), corr = __expf(m - mn), p = __expf(sc - mn);
            load_row64(vb_ + (size_t)pos * 64, kv);
            l = l * corr + p;
#pragma unroll
            for (int d = 0; d < 64; ++d) o[d] = o[d] * corr + p * kv[d];
            m = mn;
        }
        const size_t tok = (size_t)b * kS + t;
        store_row64(oac + ((size_t)c * kTok + tok) * 512 + h * 64, o, 1.f / l);
        lse[((size_t)c * kTok + tok) * 8 + h] = m + __logf(l);
    }
}
DEVI void phase_na_naive(const bf16_t* qb, const bf16_t* kbuf, const bf16_t* vbuf, const float* rpb  , bf16_t* ob, int bid, int nblk) {
    const int nitems = kB * 4 * (kS / kNT);
    for (int it = bid; it < nitems; it += nblk) {
        const int bh = it / 16, t = (it % 16) * kNT + tidx(), b = bh >> 2, h = bh & 3;
        const int r = t >> 6, cq = t & 63;
        int rs = r - 4; rs = rs < 0 ? 0 : (rs > 120 ? 120 : rs);
        int cs = cq - 8; cs = cs < 0 ? 0 : (cs > 48 ? 48 : cs);
        const bf16_t* kb_ = kbuf + (size_t)bh * kS * 64; const bf16_t* vb_ = vbuf + (size_t)bh * kS * 64;
        float q[64], o[64];
        load_row64(qb + ((size_t)bh * kS + t) * 64, q);
#pragma unroll
        for (int d = 0; d < 64; ++d) o[d] = 0.f;
        float m = -1e30f, l = 0.f;
        for (int kr = 0; kr < 8; ++kr)
            for (int kc = 0; kc < 16; ++kc) {
                const int krow = rs + kr, kcol = cs + kc, pos = krow * 64 + kcol;
                float kv[64]; load_row64(kb_ + (size_t)pos * 64, kv);
                float dot = 0.f;
#pragma unroll
                for (int d = 0; d < 64; ++d) dot += q[d] * kv[d];
                const float sc = dot * 0.125f + rpb[(h * 15 + (krow - r + 7)) * 31 + (kcol - cq + 15)];
                const float mn = fmaxf(m, sc), corr = __expf(m - mn), p = __expf(sc - mn);
                load_row64(vb_ + (size_t)pos * 64, kv);
                l = l * corr + p;
#pragma unroll
                for (int d = 0; d < 64; ++d) o[d] = o[d] * corr + p * kv[d];
                m = mn;
            }
        store_row64(ob + ((size_t)b * kS + t) * 256 + h * 64, o, 1.f / l);
    }
}

typedef float f32x16 __attribute__((ext_vector_type(16)));
typedef short s16x4 __attribute__((ext_vector_type(4)));
constexpr float kLog2e = 1.4426950408889634f, kLn2 = 0.6931471805599453f;
DEVI bf16x8 tr_pair(LAS unsigned char* p0, LAS unsigned char* p1) {
    const s16x4 a = __builtin_amdgcn_ds_read_tr16_b64_v4i16((LAS s16x4*)p0), b = __builtin_amdgcn_ds_read_tr16_b64_v4i16((LAS s16x4*)p1);
    return (bf16x8){a.x, a.y, a.z, a.w, b.x, b.y, b.z, b.w};
}
DEVI void phase_dilated(const bf16_t* qa, const bf16_t* ka, const bf16_t* va, const float* gq, const float* gk, bf16_t* oac, float* lse, LAS unsigned char* lds, int bid, int nblk) {
    const int tid = tidx(), wid = __builtin_amdgcn_readfirstlane(tid >> 6), lane = tid & 63, h5 = lane >> 5, qc = lane & 31;
    LAS unsigned char* Kimg = lds; LAS unsigned char* Vimg = lds + 49152;
    float Mn;
    { float a = fabsf(gq[lane]), b = fabsf(gk[lane]);
#pragma unroll
      for (int m = 32; m >= 1; m >>= 1) { a = fmaxf(a, __shfl_xor(a, m)); b = fmaxf(b, __shfl_xor(b, m)); }
      Mn = 8.f * a * b; }
    const float Mb = Mn * kLog2e;
    unsigned koff[4];
#pragma unroll
    for (int s = 0; s < 4; ++s) koff[s] = (unsigned)((32 * wid + qc) * 128 + (((2 * s + h5) ^ (qc & 7)) << 4));
    unsigned voff[2];
    { const int g = lane >> 4, i16 = lane & 15, q = i16 >> 2, p = i16 & 3;
#pragma unroll
      for (int dt = 0; dt < 2; ++dt) { const int c = (2 * (g & 1) + (p >> 1) + 4 * dt) ^ ((q >> 1) << 2); voff[dt] = (unsigned)((32 * wid + 4 * h5 + q) * 128 + (c << 4) + 8 * (p & 1)); } }
    float dv[16];
#pragma unroll
    for (int i = 0; i < 16; ++i) dv[i] = (float)((i & 3) + 8 * (i >> 2) + 4 * h5 - qc);
    u32x4 pK[6], pV[6]; bf16x8 pQ[4];
#define DIL_DECODE(unit_) const int c = (unit_) >> 11, rem = (unit_) & 2047, bh = rem >> 5, ub = rem & 31; \
        const int dsh = 2 * c, L = kS >> dsh, upc = 32 >> dsh, cls = ub >> (5 - dsh), u0 = (ub & (upc - 1)) << 8;
#define DIL_PREFETCH(unit_) do { DIL_DECODE(unit_) \
        const bf16_t* kbase = ka + (size_t)bh * kS * 64; const bf16_t* vbase = va + (size_t)bh * kS * 64; \
        { const int qtok_ = ((u0 + 32 * wid + qc) << dsh) + cls; _Pragma("unroll") for (int s = 0; s < 4; ++s) pQ[s] = *(const bf16x8*)(qa + ((size_t)bh * kS + qtok_) * 64 + 16 * s + 8 * h5); } \
        _Pragma("unroll") for (int it = 0; it < 6; ++it) { const int id = it * kNT + tid, row = id >> 3, ch = id & 7; \
            int ki = u0 - 64 + row; ki = ki < 0 ? 0 : (ki > L - 1 ? L - 1 : ki); const size_t tok = (size_t)((ki << dsh) + cls); \
            pK[it] = *(const u32x4*)(kbase + tok * 64 + ch * 8); pV[it] = *(const u32x4*)(vbase + tok * 64 + ch * 8); } } while (0)
    if (bid < 6144) DIL_PREFETCH(bid);
    for (int unit = bid; unit < 6144; unit += nblk) {
        DIL_DECODE(unit)
        __syncthreads();
#pragma unroll
        for (int it = 0; it < 6; ++it) { const int id = it * kNT + tid, row = id >> 3, ch = id & 7;
            *(LAS u32x4*)(Kimg + row * 128 + ((ch ^ (row & 7)) << 4)) = pK[it];
            *(LAS u32x4*)(Vimg + row * 128 + ((ch ^ (((row >> 1) & 1) << 2)) << 4)) = pV[it]; }
        bf16x8 Qf[4];
#pragma unroll
        for (int s = 0; s < 4; ++s) Qf[s] = pQ[s];
        __syncthreads();
        if (unit + nblk < 6144) DIL_PREFETCH(unit + nblk);
        const int q0 = u0 + 32 * wid, qtok = ((q0 + qc) << dsh) + cls;
        const float slope = exp2f(-(float)((bh & 7) + 1));
        const float c1 = 0.125f * kLog2e, c2 = slope * (float)(1 << dsh) * kLog2e;
        float sum = 0.f;
        f32x16 O[2];
#pragma unroll
        for (int dt = 0; dt < 2; ++dt)
#pragma unroll
            for (int i = 0; i < 16; ++i) O[dt][i] = 0.f;
#pragma unroll
        for (int kt = 0; kt < 5; ++kt) {
            const int kp0 = q0 - 64 + 32 * kt;
            if (kp0 >= 0 && kp0 < L) {
                f32x16 S;
#pragma unroll
                for (int i = 0; i < 16; ++i) S[i] = 0.f;
#pragma unroll
                for (int s = 0; s < 4; ++s) { const bf16x8 Kf = *(const LAS bf16x8*)(Kimg + koff[s] + kt * 4096); S = __builtin_amdgcn_mfma_f32_32x32x16_bf16(Kf, Qf[s], S, 0, 0, 0); }
                const float cs = (kt < 2) ? c2 : -c2, c0 = ((kt == 0 || kt == 4) ? -64.f : (kt == 2 ? 0.f : -32.f)) * c2 - Mb;
#pragma unroll
                for (int i = 0; i < 16; ++i) {
                    const float d = (kt == 2) ? fabsf(dv[i]) : dv[i];
                    float sv = S[i] * c1 + (d * cs + c0);
                    if (kt == 0) sv = (dv[i] >= 0.f) ? sv : -1e30f;
                    if (kt == 4) sv = (dv[i] <= 0.f) ? sv : -1e30f;
                    const float pv = __builtin_amdgcn_exp2f(sv); S[i] = pv; sum += pv;
                }
#pragma unroll
                for (int s2 = 0; s2 < 2; ++s2) {
                    u32x4 pw; pw.x = pk2(S[8 * s2 + 0], S[8 * s2 + 1]); pw.y = pk2(S[8 * s2 + 2], S[8 * s2 + 3]); pw.z = pk2(S[8 * s2 + 4], S[8 * s2 + 5]); pw.w = pk2(S[8 * s2 + 6], S[8 * s2 + 7]);
                    const bf16x8 Pf = __builtin_bit_cast(bf16x8, pw);
#pragma unroll
                    for (int dt = 0; dt < 2; ++dt) { LAS unsigned char* vp = Vimg + voff[dt] + kt * 4096 + s2 * 2048;
                        const bf16x8 Vf = tr_pair(vp, vp + 1024);
                        O[dt] = __builtin_amdgcn_mfma_f32_32x32x16_bf16(Vf, Pf, O[dt], 0, 0, 0); }
                }
            }
        }
        sum += __shfl_xor(sum, 32);
        const float inv = 1.f / sum;
        const size_t tok = (size_t)(bh >> 3) * kS + qtok;
        bf16_t* orow = oac + ((size_t)c * kTok + tok) * 512 + (bh & 7) * 64;
#pragma unroll
        for (int dt = 0; dt < 2; ++dt)
#pragma unroll
            for (int g4 = 0; g4 < 4; ++g4) { u32x2 w; w.x = pk2(O[dt][4 * g4] * inv, O[dt][4 * g4 + 1] * inv); w.y = pk2(O[dt][4 * g4 + 2] * inv, O[dt][4 * g4 + 3] * inv);
                *(u32x2*)(orow + 32 * dt + 8 * g4 + 4 * h5) = w; }
        if (h5 == 0) lse[((size_t)c * kTok + tok) * 8 + (bh & 7)] = Mn + __logf(sum);
    }
#undef DIL_DECODE
#undef DIL_PREFETCH
    __syncthreads();
}
DEVI void phase_na(const bf16_t* qb, const bf16_t* kb, const bf16_t* vb, const float* rpb  , bf16_t* ob, LAS unsigned char* lds, int bid, int nblk) {
    const int tid = tidx(), wid = __builtin_amdgcn_readfirstlane(tid >> 6), lane = tid & 63, g4 = lane >> 4, i16 = lane & 15;
    LAS unsigned char* Kimg = lds; LAS unsigned char* Vimg = lds + 73728; LAS float* tab = (LAS float*)(lds + 147456);
    for (int i = tid; i < 4 * 465; i += kNT) tab[i] = rpb[i];
    const int g = wid & 3, kcs = (16 * g - 8) < 0 ? 0 : ((16 * g - 8) > 32 ? 32 : (16 * g - 8));
    const int qcol = 16 * g + i16, cs = (qcol - 8) < 0 ? 0 : ((qcol - 8) > 48 ? 48 : (qcol - 8));
    unsigned kswz[2];
#pragma unroll
    for (int s = 0; s < 2; ++s) kswz[s] = (unsigned)(((4 * s + g4) ^ (i16 & 7)) << 4);
    const int q = i16 >> 2, p = i16 & 3, sw = 2 * (g4 & 1) + (q >> 1);
    unsigned vsw[4];
#pragma unroll
    for (int dt = 0; dt < 4; ++dt) vsw[dt] = (unsigned)((((2 * dt + (p >> 1)) ^ (sw << 1)) << 4) + 8 * (p & 1));
    for (int unit = bid; unit < 2048; unit += nblk) {
        const int bh = unit >> 6, rp = unit & 63, r0 = 2 * rp, h = bh & 3;
        const int rsA = (r0 - 4) < 0 ? 0 : ((r0 - 4) > 120 ? 120 : (r0 - 4));
        const bf16_t* kbase = kb + (size_t)bh * kS * 64; const bf16_t* vbase = vb + (size_t)bh * kS * 64;
        __syncthreads();
#pragma unroll
        for (int it = 0; it < 9; ++it) {
            const int id = it * kNT + tid, row = id >> 3, ch = id & 7;
            int gr = rsA + (row >> 6); gr = gr > 127 ? 127 : gr;
            const size_t tok = (size_t)(gr * 64 + (row & 63));
            const u32x4 kv = *(const u32x4*)(kbase + tok * 64 + ch * 8), vv = *(const u32x4*)(vbase + tok * 64 + ch * 8);
            *(LAS u32x4*)(Kimg + row * 128 + ((ch ^ (row & 7)) << 4)) = kv;
            *(LAS u32x4*)(Vimg + row * 128 + ((ch ^ (((row >> 1) & 3) << 1)) << 4)) = vv;
        }
        __syncthreads();
        const int rr = r0 + (wid >> 2);
        const int rs = (rr - 4) < 0 ? 0 : ((rr - 4) > 120 ? 120 : (rr - 4)), ro = rs - rsA;
        const int qtok = rr * 64 + qcol;
        bf16x8 Qf[2];
#pragma unroll
        for (int s = 0; s < 2; ++s) Qf[s] = *(const bf16x8*)(qb + ((size_t)bh * kS + qtok) * 64 + 32 * s + 8 * g4);
        f32x4 S[16];
        const unsigned kb0 = (unsigned)((ro * 64 + kcs + i16) * 128);
#pragma unroll
        for (int t = 0; t < 16; ++t) { S[t] = (f32x4){0.f, 0.f, 0.f, 0.f};
#pragma unroll
            for (int s = 0; s < 2; ++s) { const bf16x8 Kf = *(const LAS bf16x8*)(Kimg + kb0 + (t >> 1) * 8192 + (t & 1) * 2048 + kswz[s]); S[t] = __builtin_amdgcn_mfma_f32_16x16x32_bf16(Kf, Qf[s], S[t], 0, 0, 0); } }
        float mx = -1e30f;
        const LAS float* th = tab + h * 465;
        int g4v = g4; asm volatile("" : "+v"(g4v));
#pragma unroll
        for (int t = 0; t < 16; ++t)
#pragma unroll
            for (int j = 0; j < 4; ++j) {
                const int krow = rs + (t >> 1), kcol = kcs + 16 * (t & 1) + 4 * g4v + j;
                const bool valid = (kcol >= cs) && (kcol < cs + 16);
                int dc = kcol - qcol + 15; dc = dc < 0 ? 0 : (dc > 30 ? 30 : dc);
                const float bias = th[(krow - rr + 7) * 31 + dc];
                const float sv = valid ? (S[t][j] * 0.125f + bias) * kLog2e : -1e30f;
                S[t][j] = sv; mx = fmaxf(mx, sv);
            }
        mx = fmaxf(mx, __shfl_xor(mx, 16)); mx = fmaxf(mx, __shfl_xor(mx, 32));
        float sum = 0.f;
#pragma unroll
        for (int t = 0; t < 16; ++t)
#pragma unroll
            for (int j = 0; j < 4; ++j) { const float pv = __builtin_amdgcn_exp2f(S[t][j] - mx); S[t][j] = pv; sum += pv; }
        sum += __shfl_xor(sum, 16); sum += __shfl_xor(sum, 32);
        f32x4 O[4];
#pragma unroll
        for (int dt = 0; dt < 4; ++dt) O[dt] = (f32x4){0.f, 0.f, 0.f, 0.f};
        const unsigned vb0 = (unsigned)((ro * 64 + kcs + 4 * g4 + q) * 128);
#pragma unroll
        for (int u = 0; u < 8; ++u) {
            u32x4 pw; pw.x = pk2(S[2 * u][0], S[2 * u][1]); pw.y = pk2(S[2 * u][2], S[2 * u][3]); pw.z = pk2(S[2 * u + 1][0], S[2 * u + 1][1]); pw.w = pk2(S[2 * u + 1][2], S[2 * u + 1][3]);
            const bf16x8 Pf = __builtin_bit_cast(bf16x8, pw);
#pragma unroll
            for (int dt = 0; dt < 4; ++dt) { LAS unsigned char* vp = Vimg + vb0 + u * 8192 + vsw[dt];
                const bf16x8 Vf = tr_pair(vp, vp + 2048);
                O[dt] = __builtin_amdgcn_mfma_f32_16x16x32_bf16(Vf, Pf, O[dt], 0, 0, 0); }
        }
        const float inv = 1.f / sum;
        bf16_t* orow = ob + ((size_t)(bh >> 2) * kS + qtok) * 256 + h * 64;
#pragma unroll
        for (int dt = 0; dt < 4; ++dt) { u32x2 w; w.x = pk2(O[dt][0] * inv, O[dt][1] * inv); w.y = pk2(O[dt][2] * inv, O[dt][3] * inv); *(u32x2*)(orow + 16 * dt + 4 * g4) = w; }
    }
    __syncthreads();
}
DEVI void phase_s5_naive(const Params& P, int l, const bf16_t* ux, float* ys, unsigned char* lds, int bid, int nblk) {
    const int wid = tidx() >> 6, lane = tidx() & 63;
    float* xs = (float*)lds + wid * 128;
    for (int item = wid * nblk + bid; item < kB * 16 * 2; item += nblk * 8) {
        const int dir = item & 1, g = (item >> 1) & 15, b = item >> 5;
        const size_t pbase = (((size_t)l * 2 + dir) * 16 + g) * 64;
        const float dt = __expf(P.s5_log_dt[((size_t)l * 2 + dir) * 16 + g]);
        const float a = fminf(P.s5_a_re[pbase + lane], -1e-4f), w = P.s5_a_im[pbase + lane];
        const float mag = __expf(a * dt), ar = mag * cosf(w * dt), ai = mag * sinf(w * dt);
        const float den = a * a + w * w, zr = ar - 1.f, gr = (zr * a + ai * w) / den, gi = (ai * a - zr * w) / den;
        float bbr[16], bbi[16];
#pragma unroll
        for (int c = 0; c < 16; ++c) { const float br = P.s5_b_re[(pbase + lane) * 16 + c], bi = P.s5_b_im[(pbase + lane) * 16 + c]; bbr[c] = gr * br - gi * bi; bbi[c] = gr * bi + gi * br; }
        const int cch = lane & 15, qt = lane >> 4;
        float cre[16], cim[16];
#pragma unroll
        for (int pp = 0; pp < 16; ++pp) { cre[pp] = P.s5_c_re[(pbase / 64 * 16 + cch) * 64 + qt * 16 + pp]; cim[pp] = P.s5_c_im[(pbase / 64 * 16 + cch) * 64 + qt * 16 + pp]; }
        float xr = 0.f, xi = 0.f;
        const bf16_t* ug = ux + (size_t)g * 4096 * 512;
        for (int st = 0; st < kS; ++st) {
            const int s = dir ? (kS - 1 - st) : st; const size_t tok = (size_t)b * kS + s;
            const bf16_t* up = ug + (tok >> 4) * 512 + (tok & 15) * 16;
            const u32x4 u0 = *(const u32x4*)up, u1 = *(const u32x4*)(up + 8);
            float uv[16];
            uv[0] = __uint_as_float(u0.x << 16); uv[1] = __uint_as_float(u0.x & 0xFFFF0000u); uv[2] = __uint_as_float(u0.y << 16); uv[3] = __uint_as_float(u0.y & 0xFFFF0000u);
            uv[4] = __uint_as_float(u0.z << 16); uv[5] = __uint_as_float(u0.z & 0xFFFF0000u); uv[6] = __uint_as_float(u0.w << 16); uv[7] = __uint_as_float(u0.w & 0xFFFF0000u);
            uv[8] = __uint_as_float(u1.x << 16); uv[9] = __uint_as_float(u1.x & 0xFFFF0000u); uv[10] = __uint_as_float(u1.y << 16); uv[11] = __uint_as_float(u1.y & 0xFFFF0000u);
            uv[12] = __uint_as_float(u1.z << 16); uv[13] = __uint_as_float(u1.z & 0xFFFF0000u); uv[14] = __uint_as_float(u1.w << 16); uv[15] = __uint_as_float(u1.w & 0xFFFF0000u);
            float bur = 0.f, bui = 0.f;
#pragma unroll
            for (int c = 0; c < 16; ++c) { bur += bbr[c] * uv[c]; bui += bbi[c] * uv[c]; }
            const float nr = ar * xr - ai * xi + bur, ni = ar * xi + ai * xr + bui; xr = nr; xi = ni;
            xs[lane] = xr; xs[64 + lane] = xi;
            asm volatile("s_waitcnt lgkmcnt(0)" ::: "memory");
            float y = 0.f;
#pragma unroll
            for (int pp = 0; pp < 16; ++pp) y += cre[pp] * xs[qt * 16 + pp] - cim[pp] * xs[64 + qt * 16 + pp];
            asm volatile("s_waitcnt lgkmcnt(0)" ::: "memory");
            y += __shfl_xor(y, 16); y += __shfl_xor(y, 32);
            if (lane < 16) ys[((size_t)dir * kTok + tok) * 256 + g * 16 + cch] = y;
        }
    }
}
DEVI void phase_s5_finish(const float* ys, const bf16_t* ux, const float* dskip, bf16_t* G, int bid, int nblk) {
    for (size_t i = (size_t)bid * kNT + tidx(); i < (size_t)kTok * 256; i += (size_t)nblk * kNT) {
        const size_t tok = i >> 8; const int ch = (int)(i & 255), g = ch >> 4, c = ch & 15;
        const float u = bf2f(ux[((size_t)g * 4096 + (tok >> 4)) * 512 + (tok & 15) * 16 + c]);
        const float y = ys[i] + ys[(size_t)kTok * 256 + i] + dskip[ch] * u;
        G[i] = f2bf(gelu_tanh(y));
    }
}
DEVI void unpk8(float* d, const u32x4 q, const float sc) {
    d[0] += sc * __uint_as_float(q.x << 16); d[1] += sc * __uint_as_float(q.x & 0xFFFF0000u); d[2] += sc * __uint_as_float(q.y << 16); d[3] += sc * __uint_as_float(q.y & 0xFFFF0000u);
    d[4] += sc * __uint_as_float(q.z << 16); d[5] += sc * __uint_as_float(q.z & 0xFFFF0000u); d[6] += sc * __uint_as_float(q.w << 16); d[7] += sc * __uint_as_float(q.w & 0xFFFF0000u);
}
DEVI void phase_mixnorm(const bf16_t* oac, const float* lse, const bf16_t* ob, const bf16_t* oc, const float* ga, const float* gb, const float* gc, bf16_t* mix, int bid, int nblk) {
    const int wid = tidx() >> 6, lane = tidx() & 63;
    float gn[16];
    { const float* gp = (lane < 32) ? ga + lane * 16 : (lane < 48) ? gb + (lane - 32) * 16 : gc + (lane - 48) * 16;
#pragma unroll
      for (int i = 0; i < 16; ++i) gn[i] = gp[i]; }
    for (int row = bid * 8 + wid; row < kTok; row += nblk * 8) {
        float v[16];
#pragma unroll
        for (int i = 0; i < 16; ++i) v[i] = 0.f;
        if (lane < 32) {
            const int h = lane >> 2;
            const float l0 = lse[(size_t)row * 8 + h], l1 = lse[((size_t)kTok + row) * 8 + h], l2 = lse[((size_t)2 * kTok + row) * 8 + h];
            const bf16_t* p0 = oac + (size_t)row * 512 + lane * 16; const bf16_t* p1 = p0 + (size_t)kTok * 512; const bf16_t* p2 = p1 + (size_t)kTok * 512;
            const u32x4 a0 = *(const u32x4*)p0, a1 = *(const u32x4*)(p0 + 8), b0 = *(const u32x4*)p1, b1 = *(const u32x4*)(p1 + 8), c0 = *(const u32x4*)p2, c1 = *(const u32x4*)(p2 + 8);
            const float mx = fmaxf(l0, fmaxf(l1, l2)); float w0 = __expf(l0 - mx), w1 = __expf(l1 - mx), w2 = __expf(l2 - mx); const float inv = frcp(w0 + w1 + w2); w0 *= inv; w1 *= inv; w2 *= inv;
            unpk8(v, a0, w0); unpk8(v + 8, a1, w0); unpk8(v, b0, w1); unpk8(v + 8, b1, w1); unpk8(v, c0, w2); unpk8(v + 8, c1, w2);
        } else {
            const bf16_t* p = (lane < 48) ? ob + (size_t)row * 256 + (lane - 32) * 16 : oc + (size_t)row * 256 + (lane - 48) * 16;
            const u32x4 a0 = *(const u32x4*)p, a1 = *(const u32x4*)(p + 8);
            unpk8(v, a0, 1.f); unpk8(v + 8, a1, 1.f);
        }
        float ss = 0.f;
#pragma unroll
        for (int i = 0; i < 16; ++i) ss += v[i] * v[i];
#pragma unroll
        for (int m = 1; m <= 8; m <<= 1) ss += __shfl_xor(ss, m);
        const float o16 = __shfl_xor(ss, 16);
        if (lane < 32) ss += o16;
        const float rstd = rsqrtf(ss * ((lane < 32) ? (1.f / 512.f) : (1.f / 256.f)) + kEps);
        u32x4 w0, w1;
        w0.x = pk2(v[0] * rstd * gn[0], v[1] * rstd * gn[1]); w0.y = pk2(v[2] * rstd * gn[2], v[3] * rstd * gn[3]); w0.z = pk2(v[4] * rstd * gn[4], v[5] * rstd * gn[5]); w0.w = pk2(v[6] * rstd * gn[6], v[7] * rstd * gn[7]);
        w1.x = pk2(v[8] * rstd * gn[8], v[9] * rstd * gn[9]); w1.y = pk2(v[10] * rstd * gn[10], v[11] * rstd * gn[11]); w1.z = pk2(v[12] * rstd * gn[12], v[13] * rstd * gn[13]); w1.w = pk2(v[14] * rstd * gn[14], v[15] * rstd * gn[15]);
        *(u32x4*)(mix + (size_t)row * kD + lane * 16) = w0; *(u32x4*)(mix + (size_t)row * kD + lane * 16 + 8) = w1;
    }
}
DEVI void phase_combine(float* x, const bf16_t* y, const int* tokslot, const float* gain_next, bf16_t* h, int bid, int nblk) {
    const int wid = tidx() >> 6, lane = tidx() & 63;
    f32x4 g[4];
#pragma unroll
    for (int q = 0; q < 4; ++q) g[q] = gain_next ? *(const f32x4*)(gain_next + q * 256 + lane * 4) : (f32x4){0.f, 0.f, 0.f, 0.f};
    const int stride = nblk * 8;
    int row = bid * 8 + wid;
    f32x4 nv[4]; int nts = 0;
    if (row < kTok) { nts = tokslot[(size_t)row * kE + (lane & 15)];
#pragma unroll
        for (int q = 0; q < 4; ++q) nv[q] = *(const f32x4*)(x + (size_t)row * kD + q * 256 + lane * 4); }
    for (; row < kTok; row += stride) {
        const int b = row >> 13;
        const int ts = nts;
        f32x4 v[4];
#pragma unroll
        for (int q = 0; q < 4; ++q) v[q] = nv[q];
        const int nrow = row + stride;
        if (nrow < kTok) { nts = tokslot[(size_t)nrow * kE + (lane & 15)];
#pragma unroll
            for (int q = 0; q < 4; ++q) nv[q] = *(const f32x4*)(x + (size_t)nrow * kD + q * 256 + lane * 4); }
#pragma unroll
        for (int e0 = 0; e0 < kE; e0 += 8) {
            u32x2 yv[8][4];
#pragma unroll
            for (int e = 0; e < 8; ++e) { const int slot = __builtin_amdgcn_readlane(ts, e0 + e);
                if (slot >= 0) { const bf16_t* yr = y + ((size_t)((e0 + e) * kB + b) * kCap + slot) * kD;
#pragma unroll
                    for (int q = 0; q < 4; ++q) yv[e][q] = *(const u32x2*)(yr + q * 256 + lane * 4); } }
#pragma unroll
            for (int e = 0; e < 8; ++e) { const int slot = __builtin_amdgcn_readlane(ts, e0 + e);
                if (slot >= 0) {
#pragma unroll
                    for (int q = 0; q < 4; ++q) { const u32x2 w = yv[e][q];
                        v[q].x += __uint_as_float(w.x << 16); v[q].y += __uint_as_float(w.x & 0xFFFF0000u); v[q].z += __uint_as_float(w.y << 16); v[q].w += __uint_as_float(w.y & 0xFFFF0000u); } } }
        }
        float ss = 0.f;
#pragma unroll
        for (int q = 0; q < 4; ++q) { *(f32x4*)(x + (size_t)row * kD + q * 256 + lane * 4) = v[q]; ss += v[q].x * v[q].x + v[q].y * v[q].y + v[q].z * v[q].z + v[q].w * v[q].w; }
        if (gain_next) { ss = wave_sum(ss); const float rstd = rsqrtf(ss * (1.f / kD) + kEps);
#pragma unroll
            for (int q = 0; q < 4; ++q) { u32x2 o; o.x = pk2(v[q].x * rstd * g[q].x, v[q].y * rstd * g[q].y); o.y = pk2(v[q].z * rstd * g[q].z, v[q].w * rstd * g[q].w);
                *(u32x2*)(h + (size_t)row * kD + q * 256 + lane * 4) = o; } }
    }
}

DEVI void cpow_m(double a, double w, double dt, int m, float& re, float& im) {
    const float mag = __expf((float)m * (float)a * (float)dt);
    const double turns = (double)m * w * dt * 0.15915494309189535; const float ang = (float)((turns - floor(turns)) * 6.283185307179586);
    re = mag * cosf(ang); im = mag * sinf(ang);
}
DEVI void s5_prep_item(const Params& P, int l, int g, unsigned char* lds_) {
    float* pw = (float*)lds_;
    float* bb = pw + 4352;
    float* cc = bb + 4096;
    float* kt = cc + 4096;
    const int tid = tidx();
    __syncthreads();
    for (int i = tid; i < 128; i += kNT) { const int dir = i >> 6, p = i & 63; const size_t pb = (((size_t)l * 2 + dir) * 16 + g) * 64 + p;
        const double dt = (double)__expf(P.s5_log_dt[((size_t)l * 2 + dir) * 16 + g]); const double a = (double)fminf(P.s5_a_re[pb], -1e-4f), w = (double)P.s5_a_im[pb];
        for (int m = 0; m < 17; ++m) { float re, im; cpow_m(a, w, dt, m, re, im); pw[((dir * 64 + p) * 17 + m) * 2] = re; pw[((dir * 64 + p) * 17 + m) * 2 + 1] = im; }
        const float af = (float)a, wf = (float)w, ar = pw[((dir * 64 + p) * 17 + 1) * 2], ai = pw[((dir * 64 + p) * 17 + 1) * 2 + 1];
        const float den = af * af + wf * wf, zr = ar - 1.f, gr = (zr * af + ai * wf) / den, gi = (ai * af - zr * wf) / den;
        for (int c = 0; c < 16; ++c) { const float br = P.s5_b_re[pb * 16 + c], bi = P.s5_b_im[pb * 16 + c]; bb[((dir * 64 + p) * 16 + c) * 2] = gr * br - gi * bi; bb[((dir * 64 + p) * 16 + c) * 2 + 1] = gr * bi + gi * br; }
    }
    for (int i = tid; i < 2048; i += kNT) { const int dir = i >> 10, c = (i >> 6) & 15, p = i & 63; const size_t o = ((((size_t)l * 2 + dir) * 16 + g) * 16 + c) * 64 + p; cc[i * 2] = P.s5_c_re[o]; cc[i * 2 + 1] = P.s5_c_im[o]; }
    __syncthreads();
    for (int i = tid; i < 8192; i += kNT) { const int dir = i >> 12, m = (i >> 8) & 15, c = (i >> 4) & 15, c2 = i & 15; float acc = 0.f;
        for (int p = 0; p < 64; ++p) { const float cr = cc[((dir * 16 + c) * 64 + p) * 2], ci = cc[((dir * 16 + c) * 64 + p) * 2 + 1], wr_ = pw[((dir * 64 + p) * 17 + m) * 2], wi_ = pw[((dir * 64 + p) * 17 + m) * 2 + 1];
            const float br = bb[((dir * 64 + p) * 16 + c2) * 2], bi = bb[((dir * 64 + p) * 16 + c2) * 2 + 1]; const float tr = cr * wr_ - ci * wi_, ti = cr * wi_ + ci * wr_; acc += tr * br - ti * bi; }
        kt[i] = acc; }
    __syncthreads();
    bf16_t* wst = (bf16_t*)(wsp(P) + WS_WST) + ((size_t)l * 16 + g) * 256 * 256;
    bf16_t* wso = (bf16_t*)(wsp(P) + WS_WSO) + ((size_t)l * 16 + g) * 256 * 512;
    for (int id = tid; id < 8192; id += kNT) { const int n = id >> 5, k0 = (id & 31) * 8, dir = n >> 7, p = (n >> 1) & 63, ri = n & 1; float v[8];
#pragma unroll
        for (int kk = 0; kk < 8; ++kk) { const int k = k0 + kk, t = k >> 4, c = k & 15, e = dir ? t : 15 - t; const float wr_ = pw[((dir * 64 + p) * 17 + e) * 2], wi_ = pw[((dir * 64 + p) * 17 + e) * 2 + 1], br = bb[((dir * 64 + p) * 16 + c) * 2], bi = bb[((dir * 64 + p) * 16 + c) * 2 + 1];
            v[kk] = ri ? (wr_ * bi + wi_ * br) : (wr_ * br - wi_ * bi); }
        u32x4 o; o.x = pk2(v[0], v[1]); o.y = pk2(v[2], v[3]); o.z = pk2(v[4], v[5]); o.w = pk2(v[6], v[7]); *(u32x4*)(wst + (size_t)n * 256 + k0) = o; }
    for (int id = tid; id < 16384; id += kNT) { const int ns = id >> 6, k0 = (id & 63) * 8, n = cmap_pk(ns), t = n >> 4, c = n & 15; float v[8];
#pragma unroll
        for (int kk = 0; kk < 8; ++kk) { const int k = k0 + kk; float x;
            if (k < 256) { const int j = k >> 4, c2 = k & 15; x = 0.f; if (j <= t) x += kt[(t - j) * 256 + c * 16 + c2]; if (j >= t) x += kt[4096 + (j - t) * 256 + c * 16 + c2]; if (j == t && c == c2) x += P.s5_d[l * 256 + g * 16 + c]; }
            else { const int q = k - 256, dir = q >> 7, p = (q >> 1) & 63, ri = q & 1, e = dir ? 16 - t : t + 1; const float cr = cc[((dir * 16 + c) * 64 + p) * 2], ci = cc[((dir * 16 + c) * 64 + p) * 2 + 1], wr_ = pw[((dir * 64 + p) * 17 + e) * 2], wi_ = pw[((dir * 64 + p) * 17 + e) * 2 + 1];
                x = ri ? -(cr * wi_ + ci * wr_) : (cr * wr_ - ci * wi_); }
            v[kk] = x; }
        u32x4 o; o.x = pk2(v[0], v[1]); o.y = pk2(v[2], v[3]); o.z = pk2(v[4], v[5]); o.w = pk2(v[6], v[7]); *(u32x4*)(wso + (size_t)ns * 512 + k0) = o; }
    __syncthreads();
}
DEVI void phase_s5_scan(const Params& P, int l, const float* Z, bf16_t* ux, unsigned char* lds_, int bid, int nblk) {
    const int tid = tidx(), wid = tid >> 6, lane = tid & 63;
    float* E = (float*)lds_;
    for (int item = bid; item < 256; item += nblk) {
        const int dir = item & 1, g = (item >> 1) & 15, b = item >> 5;
        const size_t pb = (((size_t)l * 2 + dir) * 16 + g) * 64 + lane;
        const double dt = (double)__expf(P.s5_log_dt[((size_t)l * 2 + dir) * 16 + g]); const double a = (double)fminf(P.s5_a_re[pb], -1e-4f), w = (double)P.s5_a_im[pb];
        float a16r, a16i, Ar, Ai; cpow_m(a, w, dt, 16, a16r, a16i); cpow_m(a, w, dt, 1024, Ar, Ai);
        const int kk0 = dir ? 511 - 64 * wid : 64 * wid; const long sstep = dir ? -1 : 1;
        const float* zp = Z + ((size_t)g * 4096 + b * 512 + kk0) * 256 + dir * 128 + 2 * lane;
        f32x2 z[64];
#pragma unroll
        for (int i = 0; i < 64; ++i) { z[i] = *(const f32x2*)zp; zp += sstep * 256; }
        float xr = 0.f, xi = 0.f;
#pragma unroll
        for (int i = 0; i < 64; ++i) { const float nr = a16r * xr - a16i * xi + z[i].x, ni = a16r * xi + a16i * xr + z[i].y; xr = nr; xi = ni; }
        __syncthreads();
        E[(wid * 64 + lane) * 2] = xr; E[(wid * 64 + lane) * 2 + 1] = xi;
        __syncthreads();
        float sr = 0.f, si = 0.f;
#pragma unroll
        for (int s2 = 0; s2 < 7; ++s2) if (s2 < wid) { const float er = E[(s2 * 64 + lane) * 2], ei = E[(s2 * 64 + lane) * 2 + 1]; const float nr = Ar * sr - Ai * si + er, ni = Ar * si + Ai * sr + ei; sr = nr; si = ni; }
        bf16_t* up = ux + ((size_t)g * 4096 + b * 512 + kk0) * 512 + 256 + dir * 128 + 2 * lane;
#pragma unroll
        for (int i = 0; i < 64; ++i) { *(unsigned*)up = pk2(sr, si); up += sstep * 512;
            const float nr = a16r * sr - a16i * si + z[i].x, ni = a16r * si + a16i * sr + z[i].y; sr = nr; si = ni; }
    }
    __syncthreads();
}
struct EpiF32N {
    static constexpr int VMOPS = 32;
    float* z; int ldz;
    DEVI void operator()(const f32x4 (&acc)[2][2][4][2], const Unit& u, int wr, int wc, int fr, int fq) const {
#pragma unroll
        for (int ai = 0; ai < 2; ++ai)
#pragma unroll
            for (int m = 0; m < 4; ++m) { const size_t ro = (size_t)(u.pm * 256 + 128 * ai + 64 * wr + 16 * m + fr) * ldz + u.pn * 256 + 32 * wc + 4 * fq;
#pragma unroll
                for (int bj = 0; bj < 2; ++bj)
#pragma unroll
                    for (int n = 0; n < 2; ++n) *(f32x4*)(z + ro + 128 * bj + 16 * n) = acc[ai][bj][m][n]; }
    }
};
struct EpiS5Out {
    static constexpr int VMOPS = 16;
    bf16_t* G;
    DEVI void operator()(const f32x4 (&acc)[2][2][4][2], const Unit& u, int wr, int wc, int fr, int fq) const {
#pragma unroll
        for (int ai = 0; ai < 2; ++ai)
#pragma unroll
            for (int m = 0; m < 4; ++m) { const int R = u.pm * 256 + 128 * ai + 64 * wr + 16 * m + fr, g = R >> 12, ck = R & 4095;
#pragma unroll
                for (int bj = 0; bj < 2; ++bj) { const int t = 8 * bj + 2 * wc + (fq >> 1), c0 = 8 * (fq & 1);
                    const f32x4 v0 = acc[ai][bj][m][0], v1 = acc[ai][bj][m][1];
                    u32x4 w; w.x = pk2(gelu_tanh(v0.x), gelu_tanh(v0.y)); w.y = pk2(gelu_tanh(v0.z), gelu_tanh(v0.w)); w.z = pk2(gelu_tanh(v1.x), gelu_tanh(v1.y)); w.w = pk2(gelu_tanh(v1.z), gelu_tanh(v1.w));
                    *(u32x4*)(G + ((size_t)ck * 16 + t) * 256 + g * 16 + c0) = w; } }
    }
};
#define XB_TMO      128
#define XB_XCNT(j)  (256  + 64 * (j))
#define XB_XSUB(j)  (1280 + 64 * (j))
#define XB_XGEN(j)  (2304 + 64 * (j))
#define XB_TOP      3328
#define XB_TOPGEN   3392
#define XCD_BAR_WORDS 3456
#define XB_SPIN_CAP (1u << 26)
DEVI unsigned xb_ld(unsigned* p)              { return __hip_atomic_load(p, __ATOMIC_RELAXED, __HIP_MEMORY_SCOPE_AGENT); }
DEVI unsigned xb_add(unsigned* p, unsigned v) { return __hip_atomic_fetch_add(p, v, __ATOMIC_RELAXED, __HIP_MEMORY_SCOPE_AGENT); }
DEVI unsigned xb_xcc_id() { return (unsigned)__builtin_amdgcn_s_getreg((3 << 11) | 20) & 0xFu; }
#define XB_SPIN(cond, bar) do { unsigned _sp = 0; while (cond) { __builtin_amdgcn_s_sleep(1); \
    if ((++_sp & 255u) == 0u) { if (xb_ld(&(bar)[XB_TMO])) break; if (_sp > XB_SPIN_CAP) { atomicAdd(&(bar)[XB_TMO], 1u); break; } } } } while (0)
struct XcdBarrier { unsigned* bar; unsigned x; volatile LAS unsigned* st; };
DEVI XcdBarrier xcd_barrier_post(unsigned* bar, volatile LAS unsigned* st) {
    XcdBarrier b; b.bar = bar; b.x = xb_xcc_id(); b.st = st;
    if (threadIdx.x == 0) (void)xb_add(&bar[XB_XCNT(b.x)], 1u);
    return b;
}
DEVI void xcd_barrier_complete(unsigned* bar, unsigned x, unsigned& nloc, unsigned& nx) {
    const unsigned G = gridDim.x * gridDim.y * gridDim.z;
    unsigned sum, cnt, mine, sp = 0u;
    for (;;) {
        sum = 0u; cnt = 0u; mine = 0u;
#pragma unroll
        for (unsigned j = 0; j < 16; ++j) { const unsigned c = xb_ld(&bar[XB_XCNT(j)]); sum += c; cnt += (c > 0u) ? 1u : 0u; mine = (j == x) ? c : mine; }
        if (sum == G) break;
        __builtin_amdgcn_s_sleep(1);
        if ((++sp & 255u) == 0u) { if (xb_ld(&bar[XB_TMO])) break; if (sp > XB_SPIN_CAP) { atomicAdd(&bar[XB_TMO], 1u); break; } }
    }
    nloc = mine > 0u ? mine : 1u; nx = cnt > 0u ? cnt : 1u;
}
DEVI void xcd_barrier(const XcdBarrier& b) {
    asm volatile("s_waitcnt vmcnt(0)" ::: "memory");
    __syncthreads();
    if (threadIdx.x == 0) {
        unsigned long long bp_ = (unsigned long long)b.bar; asm volatile("" : "+s"(bp_));
        unsigned* bar = (unsigned*)bp_;
        const unsigned bx = xb_xcc_id();
        __builtin_amdgcn_s_waitcnt(0);
        unsigned nloc = b.st[0], nx = b.st[1];
        if (nloc == 0u) { xcd_barrier_complete(bar, bx, nloc, nx); b.st[0] = nloc; b.st[1] = nx; }
        const unsigned old = xb_add(&bar[XB_XSUB(bx)], 1u);
        const unsigned gen = old / nloc;
        if (old + 1u == (gen + 1u) * nloc) {
            __builtin_amdgcn_fence(__ATOMIC_RELEASE, "agent");
            asm volatile("s_waitcnt vmcnt(0)" ::: "memory");
            const unsigned og = xb_add(&bar[XB_TOP], 1u);
            const unsigned tg = og / nx;
            if (og + 1u == (tg + 1u) * nx) xb_add(&bar[XB_TOPGEN], 1u);
            else XB_SPIN(xb_ld(&bar[XB_TOPGEN]) == tg, bar);
            __builtin_amdgcn_fence(__ATOMIC_ACQUIRE, "agent");
            xb_add(&bar[XB_XGEN(bx)], 1u);
            asm volatile("s_waitcnt vmcnt(0)" ::: "memory");
        } else {
            XB_SPIN(xb_ld(&bar[XB_XGEN(bx)]) == gen, bar);
            __builtin_amdgcn_fence(__ATOMIC_ACQUIRE, "agent");
            asm volatile("s_waitcnt vmcnt(0)" ::: "memory");
        }
    }
    __syncthreads();
}

#ifndef MEGA
#define MEGA 1
#endif
#ifndef USE_ENGINE
#define USE_ENGINE 1
#endif
constexpr int LDS_BYTES = 147456 + 8192 + 16;
#if USE_ENGINE
#define GEMM_RUN(g, E) gemm_engine<decltype(E), true, true>((LAS unsigned char*)dyn_lds, g, E, bid, nblk)
#define GEMM_RUN8(g, E) gemm_engine<decltype(E), true, true, true>((LAS unsigned char*)dyn_lds, g, E, bid, nblk)
#else
#define GEMM_RUN(g, E) gemm_simple(g, E, bid, nblk)
#endif
extern __shared__ __attribute__((aligned(16))) unsigned char dyn_lds[];

DEVI GemmD mk_gemm(const bf16_t* A, const bf16_t* Bt, int lda, int K, int nM, int nN, const int* rowidx, size_t bstride, int pmg) {
    GemmD g; g.A = A; g.Bt = Bt; g.lda = lda; g.K = K; g.nM = nM; g.nN = nN; g.rowidx = rowidx; g.bstride = bstride; g.pmg = pmg; return g; }

DEVI void ph_win(const Params& P, int l, int bid, int nblk) {
    const GemmD g = mk_gemm((const bf16_t*)(wsp(P) + WS_H), (const bf16_t*)(wsp(P) + WS_WINT) + (size_t)l * kINW * kD, kD, kD, kTok / 256, 10, nullptr, 0, 1 << 30);
    unsigned char* r1 = wsp(P) + WS_R1;
    EpiQKV E; E.qa = (bf16_t*)(r1 + R1_QA); E.ka = (bf16_t*)(r1 + R1_KA); E.va = (bf16_t*)(r1 + R1_VA); E.qb = (bf16_t*)(r1 + R1_QB); E.kb = (bf16_t*)(r1 + R1_KB); E.vb = (bf16_t*)(r1 + R1_VB); E.ux = (bf16_t*)(r1 + R1_UX);
    E.qna = P.q_norm_a + l * 64; E.kna = P.k_norm_a + l * 64; E.qnb = P.q_norm_b + l * 64; E.knb = P.k_norm_b + l * 64;
    GEMM_RUN(g, E);
}
#ifndef USE_MFMA_ATTN
#define USE_MFMA_ATTN 1
#endif
#ifndef USE_S5_GEMM
#define USE_S5_GEMM 1
#endif
#ifndef PROBE_ATTN
#define PROBE_ATTN 1
#endif
#ifndef PROBE_GU
#define PROBE_GU 1
#endif
#ifndef PROBE_DOWN
#define PROBE_DOWN 1
#endif
#ifndef PROBE_NA
#define PROBE_NA 1
#endif
#ifndef PROBE_MIX
#define PROBE_MIX 1
#endif
#ifndef PROBE_RT
#define PROBE_RT 1
#endif
#ifndef PROBE_TK
#define PROBE_TK 1
#endif
#ifndef PROBE_GUDRY
#define PROBE_GUDRY 0
#endif
#ifndef PROBE_CONV
#define PROBE_CONV 1
#endif
DEVI void ph_dilated(const Params& P, int l, int bid, int nblk) { unsigned char* r1 = wsp(P) + WS_R1;
#if USE_MFMA_ATTN
    phase_dilated((const bf16_t*)(r1 + R1_QA), (const bf16_t*)(r1 + R1_KA), (const bf16_t*)(r1 + R1_VA), P.q_norm_a + l * 64, P.k_norm_a + l * 64, (bf16_t*)(wsp(P) + WS_R2), (float*)(wsp(P) + WS_LSE), (LAS unsigned char*)dyn_lds, bid, nblk);
#else
    phase_dilated_naive((const bf16_t*)(r1 + R1_QA), (const bf16_t*)(r1 + R1_KA), (const bf16_t*)(r1 + R1_VA), (bf16_t*)(wsp(P) + WS_R2), (float*)(wsp(P) + WS_LSE), bid, nblk);
#endif
}
DEVI void ph_na(const Params& P, int l, int bid, int nblk) { unsigned char* r1 = wsp(P) + WS_R1;
#if USE_MFMA_ATTN
    phase_na((const bf16_t*)(r1 + R1_QB), (const bf16_t*)(r1 + R1_KB), (const bf16_t*)(r1 + R1_VB), P.rpb + (size_t)l * 4 * 15 * 31, (bf16_t*)(r1 + R1_OB), (LAS unsigned char*)dyn_lds, bid, nblk);
#else
    phase_na_naive((const bf16_t*)(r1 + R1_QB), (const bf16_t*)(r1 + R1_KB), (const bf16_t*)(r1 + R1_VB), P.rpb + (size_t)l * 4 * 15 * 31, (bf16_t*)(r1 + R1_OB), bid, nblk);
#endif
}
DEVI void ph_s5(const Params& P, int l, unsigned char* lds, int bid, int nblk) { phase_s5_naive(P, l, (const bf16_t*)(wsp(P) + WS_R1 + R1_UX), (float*)(wsp(P) + WS_YS), lds, bid, nblk); }
DEVI void ph_s5_prep(const Params& P, unsigned char* lds, int bid, int nblk) { for (int it = bid; it < kL * 16; it += nblk) s5_prep_item(P, it >> 4, it & 15, lds); }
DEVI void ph_s5_state(const Params& P, int l, int bid, int nblk) {
    const GemmD g = mk_gemm((const bf16_t*)(wsp(P) + WS_R1 + R1_UX), (const bf16_t*)(wsp(P) + WS_WST) + (size_t)l * 16 * 256 * 256, 512, 256, 256, 1, nullptr, (size_t)256 * 256, 16);
    EpiF32N E; E.z = (float*)(wsp(P) + WS_R2 + R2_Z); E.ldz = 256;
    GEMM_RUN(g, E);
}
DEVI void ph_s5_scan(const Params& P, int l, unsigned char* lds, int bid, int nblk) { phase_s5_scan(P, l, (const float*)(wsp(P) + WS_R2 + R2_Z), (bf16_t*)(wsp(P) + WS_R1 + R1_UX), lds, bid, nblk); }
DEVI void ph_s5_out(const Params& P, int l, int bid, int nblk) {
    const GemmD g = mk_gemm((const bf16_t*)(wsp(P) + WS_R1 + R1_UX), (const bf16_t*)(wsp(P) + WS_WSO) + (size_t)l * 16 * 256 * 512, 512, 512, 256, 1, nullptr, (size_t)256 * 512, 16);
    EpiS5Out E; E.G = (bf16_t*)(wsp(P) + WS_R1 + R1_G);
    GEMM_RUN(g, E);
}
DEVI void ph_s5fin(const Params& P, int l, int bid, int nblk) { phase_s5_finish((const float*)(wsp(P) + WS_YS), (const bf16_t*)(wsp(P) + WS_R1 + R1_UX), P.s5_d + l * 256, (bf16_t*)(wsp(P) + WS_R1 + R1_G), bid, nblk); }
DEVI void ph_glu(const Params& P, int l, int bid, int nblk) {
    const GemmD g = mk_gemm((const bf16_t*)(wsp(P) + WS_R1 + R1_G), (const bf16_t*)(wsp(P) + WS_WGLUT) + (size_t)l * 256 * 256, 256, 256, kTok / 256, 1, nullptr, 0, 1 << 30);
    EpiGlu E; E.g = (const bf16_t*)(wsp(P) + WS_R1 + R1_G); E.oc = (bf16_t*)(wsp(P) + WS_R1 + R1_OC);
    GEMM_RUN(g, E);
}
DEVI void ph_mixnorm(const Params& P, int l, int bid, int nblk) { unsigned char* r1 = wsp(P) + WS_R1;
    phase_mixnorm((const bf16_t*)(wsp(P) + WS_R2), (const float*)(wsp(P) + WS_LSE), (const bf16_t*)(r1 + R1_OB), (const bf16_t*)(r1 + R1_OC), P.out_norm_a + l * 512, P.out_norm_b + l * 256, P.out_norm_c + l * 256, (bf16_t*)(wsp(P) + WS_H), bid, nblk); }
DEVI void ph_wout(const Params& P, int l, int bid, int nblk) {
    const GemmD g = mk_gemm((const bf16_t*)(wsp(P) + WS_H), (const bf16_t*)(wsp(P) + WS_WOUTT) + (size_t)l * kD * kD, kD, kD, kTok / 256, 4, nullptr, 0, 1 << 30);
    EpiResid E; E.xin = (l == 0) ? P.x : P.out; E.xout = P.out;
    GEMM_RUN(g, E);
}
DEVI void ph_router(const Params& P, int l, unsigned char* lds, int bid, int nblk) { phase_router(P.out, P.ffn_norm + (size_t)l * kD, P.w_router + (size_t)l * kD * kE, (bf16_t*)(wsp(P) + WS_H), (float*)(wsp(P) + WS_AFF), lds, bid, nblk); }
DEVI void ph_topk(const Params& P, unsigned char* lds, int bid, int nblk) { phase_topk((const float*)(wsp(P) + WS_AFF), (int*)(wsp(P) + WS_IDX), (float*)(wsp(P) + WS_GATE), (int*)(wsp(P) + WS_TSLOT), wsp(P) + WS_H, wsp(P) + WS_R2, FP8_GU ? kD : kD * 2, lds, bid, nblk); }
DEVI void ph_gu(const Params& P, int l, int bid, int nblk) {
#if FP8_GU
    const GemmD g = mk_gemm((const bf16_t*)(wsp(P) + WS_R2), (const bf16_t*)(wsp(P) + WS_WGUT + (size_t)l * kE * 4096 * kD), kD, kD, 512, 16, nullptr, (size_t)4096 * kD, 32);
    EpiGU E; E.hid = (bf16_t*)(wsp(P) + WS_R1); E.sc = 1.f / kW8;
    GEMM_RUN8(g, E);
#else
    const GemmD g = mk_gemm((const bf16_t*)(wsp(P) + WS_R2), (const bf16_t*)(wsp(P) + WS_WGUT) + (size_t)l * kE * 4096 * kD, kD, kD, 512, 16, nullptr, (size_t)4096 * kD, 32);
    EpiGU E; E.hid = (bf16_t*)(wsp(P) + WS_R1); E.sc = 1.f;
    GEMM_RUN(g, E);
#endif
}
DEVI void ph_gu_dry(const Params& P, int l, int bid, int nblk) {
    const GemmD g = mk_gemm((const bf16_t*)(wsp(P) + WS_R2), (const bf16_t*)(wsp(P) + WS_WGUT) + (size_t)l * kE * 4096 * kD, kD, kD, 512, 16, nullptr, (size_t)4096 * kD, 32);
    EpiDry E; E.sink = (float*)(wsp(P) + WS_YS);
    GEMM_RUN(g, E);
}
DEVI void ph_down(const Params& P, int l, int bid, int nblk) {
#if FP8_DN
    const GemmD g = mk_gemm((const bf16_t*)(wsp(P) + WS_R1), (const bf16_t*)(wsp(P) + WS_WDT + (size_t)l * kE * kD * kFF), kFF, kFF, 512, 4, nullptr, (size_t)kD * kFF, 32);
    EpiDown E; E.y = (bf16_t*)(wsp(P) + WS_R2); E.gate = (const float*)(wsp(P) + WS_GATE); E.sc = 1.f / (kW8 * kH8);
    GEMM_RUN8(g, E);
#else
    const GemmD g = mk_gemm((const bf16_t*)(wsp(P) + WS_R1), (const bf16_t*)(wsp(P) + WS_WDT) + (size_t)l * kE * kD * kFF, kFF, kFF, 512, 4, nullptr, (size_t)kD * kFF, 32);
    EpiDown E; E.y = (bf16_t*)(wsp(P) + WS_R2); E.gate = (const float*)(wsp(P) + WS_GATE); E.sc = 1.f;
    GEMM_RUN(g, E);
#endif
}
DEVI void ph_combine(const Params& P, int l, int bid, int nblk) { phase_combine(P.out, (const bf16_t*)(wsp(P) + WS_R2), (const int*)(wsp(P) + WS_TSLOT), (l + 1 < kL) ? P.attn_norm + (size_t)(l + 1) * kD : nullptr, (bf16_t*)(wsp(P) + WS_H), bid, nblk); }

typedef __attribute__((address_space(4))) const Params* CParams;
DEVI CParams kargs() { unsigned long long a = (unsigned long long)__builtin_amdgcn_kernarg_segment_ptr(); asm volatile("" : "+s"(a)); return (CParams)a; }
#if MEGA
__global__ void __launch_bounds__(kNT, 2) mega_fwd(Params P_) {
#define PK (*(const Params*)kargs())
    volatile LAS unsigned* st = (volatile LAS unsigned*)(dyn_lds + LDS_BYTES - 16);
    if (threadIdx.x == 0) { st[0] = 0u; st[1] = 0u; st[2] = 0u; st[3] = 0u; }
    __syncthreads();
    const XcdBarrier bar = xcd_barrier_post((unsigned*)(PK.ws + WS_CTL), st);
    const int bid = blockIdx.x, nblk = gridDim.x;
    unsigned char* lds = dyn_lds;
#pragma unroll 1
    for (int rep = 0; rep < PROBE_CONV; ++rep)
    phase_convert(PK, lds, lnd(bid), nblk);
#if USE_S5_GEMM
    ph_s5_prep(PK, lds, lnd(bid), nblk);
#endif
    phase_norm(PK.x, PK.attn_norm, (bf16_t*)(PK.ws + WS_H), lnd(bid), nblk);
    xcd_barrier(bar);
#pragma unroll 1
    for (int l = 0; l < kL; ++l) {
        ph_win(PK, l, lnd(bid), nblk);            xcd_barrier(bar);
#if USE_S5_GEMM
        ph_s5_state(PK, l, lnd(bid), nblk);       xcd_barrier(bar);
        ph_s5_scan(PK, l, lds, lnd(bid), nblk);
#pragma unroll 1
        for (int rep = 0; rep < PROBE_ATTN; ++rep)
        ph_dilated(PK, l, lnd(bid), nblk);
#pragma unroll 1
        for (int rep = 0; rep < PROBE_NA; ++rep)
        ph_na(PK, l, lnd(bid), nblk);             xcd_barrier(bar);
        ph_s5_out(PK, l, lnd(bid), nblk);         xcd_barrier(bar);
#else
        ph_s5(PK, l, lds, lnd(bid), nblk);
        ph_dilated(PK, l, lnd(bid), nblk);
        ph_na(PK, l, lnd(bid), nblk);             xcd_barrier(bar);
        ph_s5fin(PK, l, lnd(bid), nblk);          xcd_barrier(bar);
#endif
        ph_glu(PK, l, lnd(bid), nblk);            xcd_barrier(bar);
#pragma unroll 1
        for (int rep = 0; rep < PROBE_MIX; ++rep) {
        ph_mixnorm(PK, l, lnd(bid), nblk);        xcd_barrier(bar); }
        ph_wout(PK, l, lnd(bid), nblk);           xcd_barrier(bar);
#pragma unroll 1
        for (int rep = 0; rep < PROBE_RT; ++rep) {
        ph_router(PK, l, lds, lnd(bid), nblk);    xcd_barrier(bar); }
#pragma unroll 1
        for (int rep = 0; rep < PROBE_TK; ++rep) {
        ph_topk(PK, lds, lnd(bid), nblk);         xcd_barrier(bar); }
#pragma unroll 1
        for (int rep = 0; rep < PROBE_GU; ++rep) {
        ph_gu(PK, l, lnd(bid), nblk);             xcd_barrier(bar); }
#if PROBE_GUDRY
        ph_gu_dry(PK, l, lnd(bid), nblk);         xcd_barrier(bar);
#endif
#pragma unroll 1
        for (int rep = 0; rep < PROBE_DOWN; ++rep) {
        ph_down(PK, l, lnd(bid), nblk);           xcd_barrier(bar); }
        ph_combine(PK, l, lnd(bid), nblk);        xcd_barrier(bar);
    }
#undef PK
}
#else
#define KB __global__ void __launch_bounds__(kNT, 2)
KB k_convert(Params P) { phase_convert(P, dyn_lds, blockIdx.x, gridDim.x); }
KB k_norm(Params P) { phase_norm(P.x, P.attn_norm, (bf16_t*)(P.ws + WS_H), blockIdx.x, gridDim.x); }
KB k_win(Params P, int l) { ph_win(P, l, blockIdx.x, gridDim.x); }
KB k_dilated(Params P, int l) { ph_dilated(P, l, blockIdx.x, gridDim.x); }
KB k_na(Params P, int l) { ph_na(P, l, blockIdx.x, gridDim.x); }
KB k_s5(Params P, int l) { ph_s5(P, l, dyn_lds, blockIdx.x, gridDim.x); }
KB k_s5fin(Params P, int l) { ph_s5fin(P, l, blockIdx.x, gridDim.x); }
KB k_glu(Params P, int l) { ph_glu(P, l, blockIdx.x, gridDim.x); }
KB k_mixnorm(Params P, int l) { ph_mixnorm(P, l, blockIdx.x, gridDim.x); }
KB k_wout(Params P, int l) { ph_wout(P, l, blockIdx.x, gridDim.x); }
KB k_router(Params P, int l) { ph_router(P, l, dyn_lds, blockIdx.x, gridDim.x); }
KB k_topk(Params P) { ph_topk(P, dyn_lds, blockIdx.x, gridDim.x); }
KB k_gu(Params P, int l) { ph_gu(P, l, blockIdx.x, gridDim.x); }
KB k_down(Params P, int l) { ph_down(P, l, blockIdx.x, gridDim.x); }
KB k_combine(Params P, int l) { ph_combine(P, l, blockIdx.x, gridDim.x); }
#endif

extern "C" void kernel_launch(void* const* d_in, const int* in_sizes, int n_in, void* d_out, int out_size, void* d_ws, size_t ws_size, hipStream_t stream) {
    (void)in_sizes; (void)n_in; (void)out_size;
    if (ws_size < WS_END) { fprintf(stderr, "workspace too small: %zu < %zu\n", ws_size, (size_t)WS_END); return; }
    Params P{};
    const float** pp = (const float**)&P;
    for (int i = 0; i < 26; ++i) pp[i] = (const float*)d_in[i];
    P.out = (float*)d_out; P.ws = (unsigned char*)d_ws;
#if MEGA
    static int grid = 0;
    if (!grid) {
        int dev = 0, cus = 0, per_cu = 0;
        (void)hipGetDevice(&dev);
        (void)hipDeviceGetAttribute(&cus, hipDeviceAttributeMultiprocessorCount, dev);
        (void)hipFuncSetAttribute((const void*)mega_fwd, hipFuncAttributeMaxDynamicSharedMemorySize, LDS_BYTES);
        (void)hipOccupancyMaxActiveBlocksPerMultiprocessor(&per_cu, (const void*)mega_fwd, kNT, LDS_BYTES);
        grid = (per_cu >= 1) ? cus : 0;
        if (!grid) fprintf(stderr, "mega_fwd does not fit a CU\n");
    }
    if (!grid) return;
    (void)hipMemsetAsync(P.ws + WS_CTL, 0, XCD_BAR_WORDS * sizeof(unsigned), stream);
    mega_fwd<<<grid, kNT, LDS_BYTES, stream>>>(P);
#else
    (void)hipFuncSetAttribute((const void*)k_router, hipFuncAttributeMaxDynamicSharedMemorySize, 65536);
    const int G = 1024;
    k_convert<<<G, kNT, 256 * 72 * 2, stream>>>(P);
    k_norm<<<G, kNT, 0, stream>>>(P);
    for (int l = 0; l < kL; ++l) {
        k_win<<<G, kNT, 0, stream>>>(P, l);
        k_dilated<<<G, kNT, 0, stream>>>(P, l);
        k_na<<<G, kNT, 0, stream>>>(P, l);
        k_s5<<<256, kNT, 8 * 128 * 4, stream>>>(P, l);
        k_s5fin<<<G, kNT, 0, stream>>>(P, l);
        k_glu<<<256, kNT, 0, stream>>>(P, l);
        k_mixnorm<<<G, kNT, 0, stream>>>(P, l);
        k_wout<<<G, kNT, 0, stream>>>(P, l);
        k_router<<<512, kNT, 65536, stream>>>(P, l);
        k_topk<<<128, kNT, 4096, stream>>>(P);
        k_gu<<<G, kNT, 0, stream>>>(P, l);
        k_down<<<G, kNT, 0, stream>>>(P, l);
        k_combine<<<G, kNT, 0, stream>>>(P, l);
    }
#endif
}
```

```cpp
#include <hip/hip_runtime.h>
#include <stdint.h>
#include <stdio.h>

#define DEVI __device__ __forceinline__
#define LAS __attribute__((address_space(3)))
typedef unsigned short bf16_t;
typedef short bf16x8 __attribute__((ext_vector_type(8)));
typedef float f32x4 __attribute__((ext_vector_type(4)));
typedef float f32x2 __attribute__((ext_vector_type(2)));
typedef unsigned u32x4 __attribute__((ext_vector_type(4)));
typedef unsigned u32x2 __attribute__((ext_vector_type(2)));

constexpr int kB = 8, kS = 8192, kD = 1024, kL = 4, kTok = kB * kS;
constexpr int kINW = 2560;
constexpr int kE = 16, kCap = 1024, kFF = 2048;
constexpr int kNT = 512;
constexpr float kEps = 1e-6f;

constexpr size_t MiB = 1024ull * 1024ull;
constexpr size_t WS_CTL   = 0;
constexpr size_t WS_WINT  = 1 * MiB;
constexpr size_t WS_WOUTT = WS_WINT + 20 * MiB;
constexpr size_t WS_WGLUT = WS_WOUTT + 8 * MiB;
constexpr size_t WS_WGUT  = WS_WGLUT + 1 * MiB;
constexpr size_t WS_WDT   = WS_WGUT + 512 * MiB;
constexpr size_t WS_H     = WS_WDT + 256 * MiB;
constexpr size_t WS_R1    = WS_H + 128 * MiB;
constexpr size_t WS_R2    = WS_R1 + 512 * MiB;
constexpr size_t WS_AFF   = WS_R2 + 256 * MiB;
constexpr size_t WS_IDX   = WS_AFF + 4 * MiB;
constexpr size_t WS_GATE  = WS_IDX + 1 * MiB;
constexpr size_t WS_TSLOT = WS_GATE + 1 * MiB;
constexpr size_t WS_LSE   = WS_TSLOT + 4 * MiB;
constexpr size_t WS_WST   = WS_LSE + 8 * MiB;
constexpr size_t WS_WSO   = WS_WST + 8 * MiB;
constexpr size_t WS_YS    = WS_WSO + 16 * MiB;
constexpr size_t WS_XB    = WS_YS;
constexpr size_t WS_END   = WS_YS + 128 * MiB;
constexpr size_t R2_Z     = 192 * MiB;
constexpr size_t R1_QA = 0, R1_KA = 64 * MiB, R1_VA = 128 * MiB, R1_QB = 192 * MiB, R1_KB = 224 * MiB, R1_VB = 256 * MiB,
                 R1_UX = 288 * MiB, R1_OB = 352 * MiB, R1_OC = 384 * MiB, R1_G = 416 * MiB;

struct Params {
    const float* x; const float* attn_norm; const float* w_in; const float* q_norm_a; const float* k_norm_a; const float* q_norm_b; const float* k_norm_b;
    const float* rpb; const float* s5_a_re; const float* s5_a_im; const float* s5_log_dt; const float* s5_b_re; const float* s5_b_im; const float* s5_c_re; const float* s5_c_im;
    const float* s5_d; const float* w_glu; const float* out_norm_a; const float* out_norm_b; const float* out_norm_c; const float* w_out; const float* ffn_norm;
    const float* w_router; const float* w_gate; const float* w_up; const float* w_down;
    float* out; unsigned char* ws;
};

DEVI float bf2f(bf16_t b) { return __uint_as_float(((unsigned)b) << 16); }
DEVI bf16_t f2bf(float f) { unsigned u = __float_as_uint(f); u += 0x7FFFu + ((u >> 16) & 1u); return (bf16_t)(u >> 16); }
typedef __bf16 bf16x2_t __attribute__((ext_vector_type(2)));
DEVI unsigned pk2(float lo, float hi) { const f32x2 v = {lo, hi}; return __builtin_bit_cast(unsigned, __builtin_convertvector(v, bf16x2_t)); }
DEVI int tidx() { int t = threadIdx.x; asm volatile("" : "+v"(t)); return t; }
DEVI unsigned char* wsp(const Params& P) { unsigned long long a = (unsigned long long)P.ws; asm volatile("" : "+s"(a)); return (unsigned char*)a; }
DEVI int lnd(int v) { asm volatile("" : "+s"(v)); return v; }
DEVI float wave_sum(float v) {
#pragma unroll
    for (int m = 32; m >= 1; m >>= 1) v += __shfl_xor(v, m);
    return v;
}
DEVI float frcp(float x) { return __builtin_amdgcn_rcpf(x); }
DEVI float gelu_tanh(float y) { const float z = 0.7978845608028654f * (y + 0.044715f * y * y * y); const float t = 1.f - 2.f * frcp(1.f + __expf(2.f * z)); return 0.5f * y * (1.f + t); }

#ifndef EMU_BF16_X
#define EMU_BF16_X 0
#endif
#ifndef EMU_FP8_WIN
#define EMU_FP8_WIN 0
#endif
#ifndef EMU_FP8_WOUT
#define EMU_FP8_WOUT 0
#endif
#ifndef EMU_FP8_GU
#define EMU_FP8_GU 0
#endif
#ifndef EMU_FP8_DN
#define EMU_FP8_DN 0
#endif
DEVI float q8(float x, float sc, float inv) {
    float y = x * sc; const float ay = fabsf(y);
    if (ay < 0.015625f) y = rintf(y * 512.f) * (1.f / 512.f);
    else { unsigned u = __float_as_uint(y); u += 0x7FFFFu + ((u >> 20) & 1u); u &= 0xFFF00000u; y = __uint_as_float(u); y = fminf(fmaxf(y, -448.f), 448.f); }
    return y * inv;
}
#ifndef FP8_GU
#define FP8_GU 1
#endif
#ifndef FP8_DN
#define FP8_DN 1
#endif
constexpr float kW8 = 64.f, kH8 = 8.f;
DEVI unsigned pk4_fp8(float a, float b, float c, float d) { unsigned w = 0u; w = __builtin_amdgcn_cvt_pk_fp8_f32(a, b, w, false); w = __builtin_amdgcn_cvt_pk_fp8_f32(c, d, w, true); return w; }
DEVI int cmap_head(int cs) { const int bj = cs >> 7, wc = (cs >> 5) & 3, n = (cs >> 4) & 1, fq = (cs >> 2) & 3, j = cs & 3; return 64 * wc + 32 * bj + 8 * fq + 4 * n + j; }
DEVI int cmap_pk(int cs)   { const int bj = cs >> 7, wc = (cs >> 5) & 3, n = (cs >> 4) & 1, fq = (cs >> 2) & 3, j = cs & 3; return 128 * bj + 32 * wc + 8 * fq + 4 * n + j; }
DEVI int cmap_gu(int cs)   { const int wc = (cs >> 5) & 3, n = (cs >> 4) & 1, fq = (cs >> 2) & 3, j = cs & 3; return 32 * wc + 8 * fq + 4 * n + j; }

template <int MODE, int QEMU = 0>
DEVI void convert_item(const float* W0, const float* W1, int ldw, int K, bf16_t* Bt, int kt, int pn, unsigned char* lds) {
    bf16_t* t = (bf16_t*)lds;
    const int tid = tidx();
#pragma unroll 4
    for (int it = 0; it < 32; ++it) {
        const int e = it * kNT + tid, k = e >> 8, cs = e & 255;
        float v;
        if (MODE == 0) v = W0[(size_t)(kt * 64 + k) * ldw + pn * 256 + cs];
        else if (MODE == 1) v = W0[(size_t)(kt * 64 + k) * ldw + pn * 256 + cmap_head(cs)];
        else if (MODE == 2) v = W0[(size_t)(kt * 64 + k) * ldw + pn * 256 + cmap_pk(cs)];
        else v = ((cs >> 7) ? W1 : W0)[(size_t)(kt * 64 + k) * ldw + pn * 128 + cmap_gu(cs)];
        if (QEMU) v = q8(v, 64.f, 1.f / 64.f);
        t[cs * 72 + k] = f2bf(v);
    }
    __syncthreads();
#pragma unroll
    for (int it = 0; it < 4; ++it) {
        const int c = it * kNT + tid, row = c >> 3, part = c & 7;
        const u32x4 v = *(const u32x4*)(t + row * 72 + part * 8);
        *(u32x4*)(Bt + (size_t)(pn * 256 + row) * K + kt * 64 + part * 8) = v;
    }
    __syncthreads();
}

template <int MODE>
DEVI void convert_item8(const float* W0, const float* W1, int ldw, int K, unsigned char* Bt, int kt, int pn, unsigned char* lds) {
    unsigned char* t = lds;
    const int tid = tidx();
#pragma unroll 4
    for (int it = 0; it < 64; ++it) {
        const int e = it * kNT + tid, k = e >> 8, cs = e & 255;
        float v;
        if (MODE == 2) v = W0[(size_t)(kt * 128 + k) * ldw + pn * 256 + cmap_pk(cs)];
        else v = ((cs >> 7) ? W1 : W0)[(size_t)(kt * 128 + k) * ldw + pn * 128 + cmap_gu(cs)];
        v *= kW8;
        t[cs * 144 + k] = (unsigned char)(__builtin_amdgcn_cvt_pk_fp8_f32(v, v, 0u, false) & 0xFFu);
    }
    __syncthreads();
#pragma unroll
    for (int it = 0; it < 4; ++it) {
        const int c = it * kNT + tid, row = c >> 3, part = c & 7;
        const u32x4 v = *(const u32x4*)(t + row * 144 + part * 16);
        *(u32x4*)(Bt + (size_t)(pn * 256 + row) * K + kt * 128 + part * 16) = v;
    }
    __syncthreads();
}

DEVI void phase_convert(const Params& P, unsigned char* lds, int bid, int nblk) {
    constexpr int N_WIN = kL * 16 * 10, N_WOUT = kL * 16 * 4, N_WGLU = kL * 4 * 1, N_WGU = kL * kE * (FP8_GU ? 8 : 16) * 16, N_WD = kL * kE * (FP8_DN ? 16 : 32) * 4;
    constexpr int TOT = N_WIN + N_WOUT + N_WGLU + N_WGU + N_WD;
    for (int it = bid; it < TOT; it += nblk) {
        int i = it;
        if (i < N_WIN) { const int l = i / 160, r = i % 160, kt = r / 10, pn = r % 10;
            convert_item<1, EMU_FP8_WIN>(P.w_in + (size_t)l * kD * kINW, nullptr, kINW, kD, (bf16_t*)(wsp(P) + WS_WINT) + (size_t)l * kINW * kD, kt, pn, lds); continue; }
        i -= N_WIN;
        if (i < N_WOUT) { const int l = i / 64, r = i % 64, kt = r / 4, pn = r % 4;
            convert_item<2, EMU_FP8_WOUT>(P.w_out + (size_t)l * kD * kD, nullptr, kD, kD, (bf16_t*)(wsp(P) + WS_WOUTT) + (size_t)l * kD * kD, kt, pn, lds); continue; }
        i -= N_WOUT;
        if (i < N_WGLU) { const int l = i / 4, kt = i % 4;
            convert_item<2>(P.w_glu + (size_t)l * 256 * 256, nullptr, 256, 256, (bf16_t*)(wsp(P) + WS_WGLUT) + (size_t)l * 256 * 256, kt, 0, lds); continue; }
        i -= N_WGLU;
#if FP8_GU
        if (i < N_WGU) { const int le = i / 128, r = i % 128, kt = r / 16, pn = r % 16;
            convert_item8<3>(P.w_gate + (size_t)le * kD * kFF, P.w_up + (size_t)le * kD * kFF, kFF, kD, wsp(P) + WS_WGUT + (size_t)le * 4096 * kD, kt, pn, lds); continue; }
#else
        if (i < N_WGU) { const int le = i / 256, r = i % 256, kt = r / 16, pn = r % 16;
            convert_item<3, EMU_FP8_GU>(P.w_gate + (size_t)le * kD * kFF, P.w_up + (size_t)le * kD * kFF, kFF, kD, (bf16_t*)(wsp(P) + WS_WGUT) + (size_t)le * 4096 * kD, kt, pn, lds); continue; }
#endif
        i -= N_WGU;
#if FP8_DN
        { const int le = i / 64, r = i % 64, kt = r / 4, pn = r % 4;
            convert_item8<2>(P.w_down + (size_t)le * kFF * kD, nullptr, kD, kFF, wsp(P) + WS_WDT + (size_t)le * kD * kFF, kt, pn, lds); }
#else
        { const int le = i / 128, r = i % 128, kt = r / 4, pn = r % 4;
            convert_item<2, EMU_FP8_DN>(P.w_down + (size_t)le * kFF * kD, nullptr, kD, kFF, (bf16_t*)(wsp(P) + WS_WDT) + (size_t)le * kD * kFF, kt, pn, lds); }
#endif
    }
}

DEVI void phase_norm(const float* x, const float* gain, bf16_t* h, int bid, int nblk) {
    const int wid = tidx() >> 6, lane = tidx() & 63;
    f32x4 g[4];
#pragma unroll
    for (int q = 0; q < 4; ++q) g[q] = *(const f32x4*)(gain + q * 256 + lane * 4);
    for (int row = bid * 8 + wid; row < kTok; row += nblk * 8) {
        f32x4 v[4]; float ss = 0.f;
#pragma unroll
        for (int q = 0; q < 4; ++q) { v[q] = *(const f32x4*)(x + (size_t)row * kD + q * 256 + lane * 4); ss += v[q].x * v[q].x + v[q].y * v[q].y + v[q].z * v[q].z + v[q].w * v[q].w; }
        ss = wave_sum(ss);
        const float rstd = rsqrtf(ss * (1.f / kD) + kEps);
#pragma unroll
        for (int q = 0; q < 4; ++q) { f32x4 t = v[q] * rstd * g[q]; if (EMU_FP8_WIN) { t.x = q8(t.x, 1.f, 1.f); t.y = q8(t.y, 1.f, 1.f); t.z = q8(t.z, 1.f, 1.f); t.w = q8(t.w, 1.f, 1.f); }
            u32x2 o; o.x = pk2(t.x, t.y); o.y = pk2(t.z, t.w);
            *(u32x2*)(h + (size_t)row * kD + q * 256 + lane * 4) = o; }
    }
}

DEVI void phase_router(const bf16_t* x, const float* gain, const float* wr  , bf16_t* h, float* aff, unsigned char* lds, int bid, int nblk) {
    float* wT = (float*)lds;
    for (int i = tidx(); i < 16 * 1024; i += kNT) { const int k = i >> 4, e = i & 15; wT[e * 1024 + k] = wr[i]; }
    __syncthreads();
    const int wid = tidx() >> 6, lane = tidx() & 63;
    f32x4 g[4];
#pragma unroll
    for (int q = 0; q < 4; ++q) g[q] = *(const f32x4*)(gain + q * 256 + lane * 4);
    u32x2 nvx[2][4];
    { const int r0 = (bid * 8 + wid) * 2;
      if (r0 < kTok) {
#pragma unroll
        for (int r = 0; r < 2; ++r)
#pragma unroll
            for (int q = 0; q < 4; ++q) nvx[r][q] = *(const u32x2*)(x + (size_t)(r0 + r) * kD + q * 256 + lane * 4); } }
    for (int row0 = (bid * 8 + wid) * 2; row0 < kTok; row0 += nblk * 8 * 2) {
        asm volatile("" ::: "memory");
        f32x4 v[2][4];
#pragma unroll
        for (int r = 0; r < 2; ++r)
#pragma unroll
            for (int q = 0; q < 4; ++q) { const u32x2 w = nvx[r][q]; v[r][q] = (f32x4){__uint_as_float(w.x << 16), __uint_as_float(w.x & 0xFFFF0000u), __uint_as_float(w.y << 16), __uint_as_float(w.y & 0xFFFF0000u)}; }
        { const int nr0 = row0 + nblk * 8 * 2;
          if (nr0 < kTok) {
#pragma unroll
            for (int r = 0; r < 2; ++r)
#pragma unroll
                for (int q = 0; q < 4; ++q) nvx[r][q] = *(const u32x2*)(x + (size_t)(nr0 + r) * kD + q * 256 + lane * 4); } }
#pragma unroll
        for (int r = 0; r < 2; ++r) { float ss = 0.f;
#pragma unroll
            for (int q = 0; q < 4; ++q) { ss += v[r][q].x * v[r][q].x + v[r][q].y * v[r][q].y + v[r][q].z * v[r][q].z + v[r][q].w * v[r][q].w; }
            ss = wave_sum(ss); const float rstd = rsqrtf(ss * (1.f / kD) + kEps);
#pragma unroll
            for (int q = 0; q < 4; ++q) { v[r][q] = v[r][q] * rstd * g[q];
#if FP8_GU
                *(unsigned*)((unsigned char*)h + (size_t)(row0 + r) * kD + q * 256 + lane * 4) = pk4_fp8(v[r][q].x, v[r][q].y, v[r][q].z, v[r][q].w); }
#else
                u32x2 o;
                if (EMU_FP8_GU) { o.x = pk2(q8(v[r][q].x, 1.f, 1.f), q8(v[r][q].y, 1.f, 1.f)); o.y = pk2(q8(v[r][q].z, 1.f, 1.f), q8(v[r][q].w, 1.f, 1.f)); }
                else { o.x = pk2(v[r][q].x, v[r][q].y); o.y = pk2(v[r][q].z, v[r][q].w); }
                *(u32x2*)(h + (size_t)(row0 + r) * kD + q * 256 + lane * 4) = o; }
#endif
        }
        float pa[32];
#pragma unroll
        for (int e = 0; e < 16; ++e) {
            float s0 = 0.f, s1 = 0.f;
#pragma unroll
            for (int q = 0; q < 4; ++q) { const f32x4 w = *(const f32x4*)(wT + e * 1024 + q * 256 + lane * 4);
                s0 += v[0][q].x * w.x + v[0][q].y * w.y + v[0][q].z * w.z + v[0][q].w * w.w;
                s1 += v[1][q].x * w.x + v[1][q].y * w.y + v[1][q].z * w.z + v[1][q].w * w.w; }
            pa[e] = s0; pa[16 + e] = s1;
        }
#define RS_STEP(HALF, MASK) { const bool up = (lane & (MASK)) != 0; _Pragma("unroll") for (int i = 0; i < (HALF); ++i) { const float keep = up ? pa[i + (HALF)] : pa[i], send = up ? pa[i] : pa[i + (HALF)]; pa[i] = keep + __shfl_xor(send, (MASK)); } }
        RS_STEP(16, 32) RS_STEP(8, 16) RS_STEP(4, 8) RS_STEP(2, 4) RS_STEP(1, 2)
#undef RS_STEP
        const float logit = pa[0] + __shfl_xor(pa[0], 1);
        float mx = logit;
#pragma unroll
        for (int m = 16; m >= 2; m >>= 1) mx = fmaxf(mx, __shfl_xor(mx, m));
        const float ex = __expf(logit - mx);
        float sm = ex;
#pragma unroll
        for (int m = 16; m >= 2; m >>= 1) sm += __shfl_xor(sm, m);
        const int row = row0 + (lane >> 5), e = (lane >> 1) & 15, b = row >> 13, s = row & (kS - 1);
        if (!(lane & 1)) aff[((size_t)(b * kE + e)) * kS + s] = ex * frcp(sm);
    }
    __syncthreads();
}

DEVI int block_excl_scan(int v, int* sh  , int& total) {
    const int lane = tidx() & 63, wid = tidx() >> 6;
    int incl = v;
#pragma unroll
    for (int d = 1; d < 64; d <<= 1) { const int o = __shfl_up(incl, d); if (lane >= d) incl += o; }
    __syncthreads();
    if (lane == 63) sh[wid] = incl;
    __syncthreads();
    int base = 0, tot = 0;
#pragma unroll
    for (int w = 0; w < 8; ++w) { const int c = sh[w]; if (w < wid) base += c; tot += c; }
    total = tot;
    return base + incl - v;
}

DEVI void phase_topk(const float* aff, int* idx, float* gate, int* tokslot, const unsigned char* hsrc, unsigned char* xe, int rowbytes, unsigned char* lds, int bid, int nblk) {
    int* hist = (int*)lds;
    int* sh = hist + 256;
    int* res = sh + 16;
    int* lsel = res + 16;
    const int tid = tidx(), lane = tid & 63, wid = tid >> 6;
    for (int item = bid; item < kB * kE; item += nblk) {
        const int b = item >> 4, e = item & 15;
        const float* a = aff + (size_t)item * kS;
        unsigned key[16];
#pragma unroll
        for (int q = 0; q < 4; ++q) { const u32x4 v = *(const u32x4*)(a + tid * 16 + q * 4); key[q * 4 + 0] = v.x; key[q * 4 + 1] = v.y; key[q * 4 + 2] = v.z; key[q * 4 + 3] = v.w; }
        unsigned prefix = 0; int kk = kCap;
#pragma unroll 1
        for (int pass = 0; pass < 4; ++pass) {
            const int shift = 24 - 8 * pass;
            __syncthreads();
            if (tid < 256) hist[tid] = 0;
            __syncthreads();
#pragma unroll
            for (int i = 0; i < 16; ++i) { const bool in = (pass == 0) || ((key[i] >> (shift + 8)) == prefix); if (in) atomicAdd(&hist[(key[i] >> shift) & 255], 1); }
            __syncthreads();
            if (wid == 0) {
                int c[4], loc = 0;
#pragma unroll
                for (int j = 0; j < 4; ++j) { c[j] = hist[255 - 4 * lane - j]; loc += c[j]; }
                int incl = loc;
#pragma unroll
                for (int d = 1; d < 64; d <<= 1) { const int o = __shfl_up(incl, d); if (lane >= d) incl += o; }
                const int excl = incl - loc;
                if (excl < kk && kk <= incl) { int run = excl; int bin = 0, nk = 0; bool found = false;
#pragma unroll
                    for (int j = 0; j < 4; ++j) { if (!found && run + c[j] >= kk) { bin = 255 - 4 * lane - j; nk = kk - run; found = true; } if (!found) run += c[j]; }
                    res[0] = bin; res[1] = nk; }
            }
            __syncthreads();
            prefix = (prefix << 8) | (unsigned)res[0]; kk = res[1];
        }
        const unsigned T = prefix;
        int ceq = 0;
#pragma unroll
        for (int i = 0; i < 16; ++i) ceq += (key[i] == T) ? 1 : 0;
        int tot;
        int eqb = block_excl_scan(ceq, sh, tot);
        int csel = 0; unsigned selmask = 0;
#pragma unroll
        for (int i = 0; i < 16; ++i) { bool s = key[i] > T; if (key[i] == T) { s = eqb < kk; ++eqb; } if (s) { selmask |= 1u << i; ++csel; } }
        int slot = block_excl_scan(csel, sh, tot);
        const size_t rbase = (size_t)(e * kB + b) * kCap;
#pragma unroll
        for (int i = 0; i < 16; ++i) { const int s = tid * 16 + i; const bool sel = (selmask >> i) & 1u;
            if (sel) { idx[rbase + slot] = b * kS + s; gate[rbase + slot] = __uint_as_float(key[i]); lsel[slot] = b * kS + s; }
            tokslot[((size_t)(b * kS + s)) * kE + e] = sel ? slot : -1;
            if (sel) ++slot; }
        __syncthreads();
        { const int cpr = rowbytes >> 4;
          for (int c0 = tid; c0 < kCap * cpr; c0 += kNT * 4) {
              u32x4 v[4];
#pragma unroll
              for (int j = 0; j < 4; ++j) { const int c = c0 + j * kNT; const int r = c / cpr, ch = c - r * cpr; v[j] = *(const u32x4*)(hsrc + (size_t)lsel[r] * rowbytes + ch * 16); }
#pragma unroll
              for (int j = 0; j < 4; ++j) { const int c = c0 + j * kNT; const int r = c / cpr, ch = c - r * cpr; *(u32x4*)(xe + (rbase + r) * rowbytes + ch * 16) = v[j]; }
          } }
    }
    __syncthreads();
}

struct Unit { int pm, pn; };
DEVI bool unit_of(int Lid, int nM, int nN, Unit& u) {
    const int nwg = nM * nN; if (Lid >= nwg) return false;
    int wgid = Lid; { const int q = nwg / 8, r = nwg % 8, xcd = wgid % 8, off = wgid / 8; wgid = (xcd < r ? xcd * (q + 1) : r * (q + 1) + (xcd - r) * q) + off; }
    const int nig = 8 * nN, gid = wgid / nig, fm = gid * 8, gsz = (nM - fm) < 8 ? (nM - fm) : 8;
    u.pm = fm + ((wgid % nig) % gsz); u.pn = (wgid % nig) / gsz; return true;
}
struct GemmD { const bf16_t* A; const bf16_t* Bt; int lda, K, nM, nN; const int* rowidx; size_t bstride; int pmg; };

template <class Epi>
DEVI void gemm_simple(const GemmD g, const Epi& E, int bid, int nblk) {
    const int tid = tidx(), wid = tid >> 6, lane = tid & 63, wr = wid >> 2, wc = wid & 3, fr = lane & 15, fq = lane >> 4;
    for (int i = 0;; ++i) {
        Unit u; if (!unit_of(i * nblk + bid, g.nM, g.nN, u)) break;
        f32x4 acc[2][2][4][2];
#pragma unroll
        for (int a = 0; a < 2; ++a)
#pragma unroll
            for (int b = 0; b < 2; ++b)
#pragma unroll
                for (int m = 0; m < 4; ++m)
#pragma unroll
                    for (int n = 0; n < 2; ++n) acc[a][b][m][n] = (f32x4){0.f, 0.f, 0.f, 0.f};
        const bf16_t* Bu = g.Bt + (size_t)(u.pm / g.pmg) * g.bstride + (size_t)u.pn * 256 * g.K;
        unsigned ao[2][4], bo[2][2];
#pragma unroll
        for (int a = 0; a < 2; ++a)
#pragma unroll
            for (int m = 0; m < 4; ++m) { const int r = u.pm * 256 + 128 * a + 64 * wr + 16 * m + fr; const unsigned rr = g.rowidx ? (unsigned)g.rowidx[r] : (unsigned)r; ao[a][m] = rr * (unsigned)g.lda + 8u * fq; }
#pragma unroll
        for (int b = 0; b < 2; ++b)
#pragma unroll
            for (int n = 0; n < 2; ++n) bo[b][n] = (unsigned)(128 * b + 32 * wc + 16 * n + fr) * (unsigned)g.K + 8u * fq;
#pragma unroll 1
        for (int k0 = 0; k0 < g.K; k0 += 32) {
            bf16x8 av[2][4], bv[2][2];
#pragma unroll
            for (int a = 0; a < 2; ++a)
#pragma unroll
                for (int m = 0; m < 4; ++m) av[a][m] = *(const bf16x8*)(g.A + ao[a][m] + k0);
#pragma unroll
            for (int b = 0; b < 2; ++b)
#pragma unroll
                for (int n = 0; n < 2; ++n) bv[b][n] = *(const bf16x8*)(Bu + bo[b][n] + k0);
#pragma unroll
            for (int a = 0; a < 2; ++a)
#pragma unroll
                for (int b = 0; b < 2; ++b)
#pragma unroll
                    for (int m = 0; m < 4; ++m)
#pragma unroll
                        for (int n = 0; n < 2; ++n) acc[a][b][m][n] = __builtin_amdgcn_mfma_f32_16x16x32_bf16(bv[b][n], av[a][m], acc[a][b][m][n], 0, 0, 0);
        }
        E(acc, u, wr, wc, fr, fq);
    }
}


constexpr int PG_HTB = 128 * 64 * 2;
DEVI int pg_lds_byte(int r, int c) { const int st = (r >> 4) * 2 + (c >> 5), rr = r & 15, cc = c & 31, ob = rr * 64 + cc * 2; return st * 1024 + (ob ^ (((ob >> 9) & 1) << 5)); }
DEVI void pg_stage_rc(int b, int& R, int& C) { const int st = b / 1024, sb = b % 1024, swz = sb ^ (((sb >> 9) & 1) << 5); R = (st >> 1) * 16 + swz / 64; C = (st & 1) * 32 + (swz % 64) / 2; }

typedef int v4i __attribute__((ext_vector_type(4)));
typedef int v8i __attribute__((ext_vector_type(8)));
template <class Epi, bool ALIGN_EPI, bool SP2, bool FP8 = false>
DEVI void gemm_engine(LAS unsigned char* lds, const GemmD g, const Epi& E, int bid, int nblk) {
    const int tid = tidx(), wid = __builtin_amdgcn_readfirstlane(tid >> 6), lane = tid & 63, wr = wid >> 2, wc = wid & 3, fr = lane & 15, fq = lane >> 4;
    constexpr int ES = FP8 ? 1 : 2;
    const int K = g.K * ES  , nt = K / 128; const unsigned ldaB = (unsigned)g.lda * ES;
    unsigned voffA[2], voffB[2];
#pragma unroll
    for (int i = 0; i < 2; ++i) { int R, C; pg_stage_rc(tid * 16 + i * 8192, R, C); voffA[i] = (unsigned)R * ldaB + (unsigned)C * 2u; voffB[i] = (unsigned)(R * K + C * 2); }
    const size_t kstep = 128;
    const size_t hstepB = (size_t)128 * K, hstepA = (size_t)128 * ldaB, tstepA = 2 * hstepA;
    const unsigned ldsw = (unsigned)wid * 1024u;
    const int aoff = pg_lds_byte(wr * 64 + fr, fq * 8), boff = pg_lds_byte(wc * 32 + fr, fq * 8);
#define PG8_SA(b, h) (((b) * 2 + (h)) * PG_HTB)
#define PG8_SB(b, h) ((4 + (b) * 2 + (h)) * PG_HTB)
#define PG8_STAGE(bufoff, gbase, voff) do { _Pragma("unroll") for (int _i = 0; _i < 2; ++_i) \
        __builtin_amdgcn_global_load_lds((const unsigned*)((const char*)(gbase) + (voff)[_i]), (LAS unsigned*)(lds + (bufoff) + ldsw + _i * 8192), 16, 0, 0); } while (0)
#define PG8_RD16(off) (*(const LAS v4i*)(lds + (off)))
#define PG8_CAT2(off) __builtin_shufflevector(PG8_RD16(off), PG8_RD16((off) + 1024), 0, 1, 2, 3, 4, 5, 6, 7)
#define PG8_LDA(dst, b, h) do { _Pragma("unroll") for (int m = 0; m < 4; ++m) { if constexpr (FP8) dst##8[m] = PG8_CAT2(PG8_SA(b, h) + aoff + m * 2048); \
        else { _Pragma("unroll") for (int k = 0; k < 2; ++k) dst[m][k] = *(const LAS bf16x8*)(lds + PG8_SA(b, h) + aoff + m * 2048 + k * 1024); } } } while (0)
#define PG8_LDB(dst, b, h) do { _Pragma("unroll") for (int n = 0; n < 2; ++n) { if constexpr (FP8) dst##8[n] = PG8_CAT2(PG8_SB(b, h) + boff + n * 2048); \
        else { _Pragma("unroll") for (int k = 0; k < 2; ++k) dst[n][k] = *(const LAS bf16x8*)(lds + PG8_SB(b, h) + boff + n * 2048 + k * 1024); } } } while (0)
#define PG8_MMA(ai, bj, At, Bt) do { __builtin_amdgcn_s_setprio(1); _Pragma("unroll") for (int m = 0; m < 4; ++m) _Pragma("unroll") for (int n = 0; n < 2; ++n) { \
        if constexpr (FP8) asm volatile("v_mfma_f32_16x16x128_f8f6f4 %0, %1, %2, %0" : "+v"(acc[ai][bj][m][n]) : "v"(Bt##8[n]), "v"(At##8[m]));   \
        else { _Pragma("unroll") for (int k = 0; k < 2; ++k) acc[ai][bj][m][n] = __builtin_amdgcn_mfma_f32_16x16x32_bf16(Bt[n][k], At[m][k], acc[ai][bj][m][n], 0, 0, 0); } } \
        __builtin_amdgcn_s_setprio(0); } while (0)
#define PG8_WAIT_V(n) asm volatile("s_waitcnt vmcnt(" #n ")" ::: "memory")
#define PG8_WAIT_L(n) asm volatile("s_waitcnt lgkmcnt(" #n ")" ::: "memory")
#define PG8_BAR __builtin_amdgcn_s_barrier()
#define PG8_SCHED __builtin_amdgcn_sched_barrier(0)
    Unit cur, nxt; int ui = 0;
    if (!unit_of(bid, g.nM, g.nN, cur)) return;
    f32x4 acc[2][2][4][2];
#pragma unroll
    for (int a = 0; a < 2; ++a)
#pragma unroll
        for (int b = 0; b < 2; ++b)
#pragma unroll
            for (int m = 0; m < 4; ++m)
#pragma unroll
                for (int n = 0; n < 2; ++n) acc[a][b][m][n] = (f32x4){0.f, 0.f, 0.f, 0.f};
    bf16x8 At[4][2], B0[2][2], B1[2][2]; v8i At8[4], B08[2], B18[2];
    (void)At; (void)B0; (void)B1; (void)At8; (void)B08; (void)B18;
    static_assert(SP2, "only the two-super-phase K-loop is kept");
    const char* cA = (const char*)g.A + (size_t)cur.pm * tstepA;
    const char* cB = (const char*)g.Bt + (size_t)(cur.pm / g.pmg) * g.bstride * ES + (size_t)cur.pn * 256 * K;
    PG8_STAGE(PG8_SB(0, 0), cB, voffB); PG8_STAGE(PG8_SB(0, 1), cB + hstepB, voffB); PG8_STAGE(PG8_SA(0, 0), cA, voffA); PG8_STAGE(PG8_SA(0, 1), cA + hstepA, voffA);
    if (wr == 1) PG8_BAR;
    PG8_WAIT_V(2); PG8_BAR;
    PG8_STAGE(PG8_SB(1, 0), cB + kstep, voffB); PG8_STAGE(PG8_SA(1, 0), cA + kstep, voffA); PG8_STAGE(PG8_SB(1, 1), cB + hstepB + kstep, voffB);
    PG8_WAIT_V(6); PG8_BAR;
    for (;;) {
        const bool has_next = unit_of((ui + 1) * nblk + bid, g.nM, g.nN, nxt);
        const char* nA = has_next ? (const char*)g.A + (size_t)nxt.pm * tstepA : cA;
        const char* nB = has_next ? (const char*)g.Bt + (size_t)(nxt.pm / g.pmg) * g.bstride * ES + (size_t)nxt.pn * 256 * K : cB;
#pragma unroll 1
        for (int t = 0; t < nt; t += 2) {
            const bool last = (t == nt - 2);
            const char* a1 = cA + (size_t)(t + 1) * kstep;
            const char* a2 = last ? nA : cA + (size_t)(t + 2) * kstep; const char* b2 = last ? nB : cB + (size_t)(t + 2) * kstep;
            const char* a3 = a2 + kstep; const char* b3 = b2 + kstep;
            PG8_LDB(B0, 0, 0); PG8_LDB(B1, 0, 1); PG8_SCHED; PG8_LDA(At, 0, 0); PG8_STAGE(PG8_SA(1, 1), a1 + hstepA, voffA);
            PG8_WAIT_V(8); PG8_WAIT_L(0); PG8_BAR; PG8_MMA(0, 0, At, B0); PG8_MMA(0, 1, At, B1); PG8_BAR; PG8_SCHED;
            PG8_LDA(At, 0, 1); PG8_STAGE(PG8_SB(0, 0), b2, voffB); PG8_STAGE(PG8_SB(0, 1), b2 + hstepB, voffB); PG8_STAGE(PG8_SA(0, 0), a2, voffA);
            PG8_WAIT_V(8); PG8_WAIT_L(0); PG8_BAR; PG8_MMA(1, 0, At, B0); PG8_MMA(1, 1, At, B1); PG8_BAR; PG8_SCHED;
            PG8_LDB(B0, 1, 0); PG8_LDB(B1, 1, 1); PG8_SCHED; PG8_LDA(At, 1, 0); PG8_STAGE(PG8_SA(0, 1), a2 + hstepA, voffA);
            PG8_WAIT_V(8); PG8_WAIT_L(0); PG8_BAR; PG8_MMA(0, 0, At, B0); PG8_MMA(0, 1, At, B1); PG8_BAR; PG8_SCHED;
            PG8_LDA(At, 1, 1); PG8_STAGE(PG8_SB(1, 0), b3, voffB); PG8_STAGE(PG8_SB(1, 1), b3 + hstepB, voffB); PG8_STAGE(PG8_SA(1, 0), a3, voffA);
            PG8_WAIT_V(8); PG8_WAIT_L(0); PG8_BAR; PG8_MMA(1, 0, At, B0); PG8_MMA(1, 1, At, B1); PG8_BAR; PG8_SCHED;
        }
        if constexpr (ALIGN_EPI) { if (wr == 0) PG8_BAR; }
        if constexpr (FP8) asm volatile("s_nop 15\n\ts_nop 15" ::: "memory");
        E(acc, cur, wr, wc, fr, fq);
        if (!has_next) break;
#pragma unroll
        for (int a = 0; a < 2; ++a)
#pragma unroll
            for (int b = 0; b < 2; ++b)
#pragma unroll
                for (int m = 0; m < 4; ++m)
#pragma unroll
                    for (int n = 0; n < 2; ++n) acc[a][b][m][n] = (f32x4){0.f, 0.f, 0.f, 0.f};
        cur = nxt; cA = nA; cB = nB; ++ui;
        if constexpr (ALIGN_EPI) { if (wr == 1) PG8_BAR; }
    }
    PG8_WAIT_V(0);
    if constexpr (!ALIGN_EPI) { if (wr == 0) PG8_BAR; }
    PG8_BAR;
#undef PG8_SA
#undef PG8_SB
#undef PG8_STAGE
#undef PG8_LDA
#undef PG8_LDB
#undef PG8_MMA
#undef PG8_RD16
#undef PG8_CAT2
#undef PG8_WAIT_V
#undef PG8_WAIT_L
#undef PG8_BAR
#undef PG8_SCHED
}

struct EpiQKV {
    static constexpr int VMOPS = 16;
    bf16_t *qa, *ka, *va, *qb, *kb, *vb, *ux; const float *qna, *kna, *qnb, *knb;
    DEVI void operator()(const f32x4 (&acc)[2][2][4][2], const Unit& u, int wr, int wc, int fr, int fq) const {
        bf16_t* dst; const float* gn = nullptr; int H = 8, head0 = 0; const int pn = u.pn;
        if (pn < 2) { dst = qa; gn = qna; head0 = pn * 4; }
        else if (pn < 4) { dst = ka; gn = kna; head0 = (pn - 2) * 4; }
        else if (pn < 6) { dst = va; head0 = (pn - 4) * 4; }
        else if (pn == 6) { dst = qb; gn = qnb; H = 4; }
        else if (pn == 7) { dst = kb; gn = knb; H = 4; }
        else if (pn == 8) { dst = vb; H = 4; }
        else { dst = ux; }
        const int head = head0 + wc;
        f32x4 gv[2][2];
#pragma unroll
        for (int bj = 0; bj < 2; ++bj)
#pragma unroll
            for (int n = 0; n < 2; ++n) gv[bj][n] = gn ? *(const f32x4*)(gn + 32 * bj + 8 * fq + 4 * n) : (f32x4){1.f, 1.f, 1.f, 1.f};
#pragma unroll
        for (int ai = 0; ai < 2; ++ai)
#pragma unroll
            for (int m = 0; m < 4; ++m) {
                const int row = u.pm * 256 + 128 * ai + 64 * wr + 16 * m + fr;
                float rstd = 1.f;
                if (gn) { float ss = 0.f;
#pragma unroll
                    for (int bj = 0; bj < 2; ++bj)
#pragma unroll
                        for (int n = 0; n < 2; ++n) { const f32x4 v = acc[ai][bj][m][n]; ss += v.x * v.x + v.y * v.y + v.z * v.z + v.w * v.w; }
                    ss += __shfl_xor(ss, 16); ss += __shfl_xor(ss, 32);
                    rstd = rsqrtf(ss * (1.f / 64.f) + kEps); }
#pragma unroll
                for (int bj = 0; bj < 2; ++bj) {
                    const f32x4 v0 = acc[ai][bj][m][0] * rstd * gv[bj][0], v1 = acc[ai][bj][m][1] * rstd * gv[bj][1];
                    u32x4 w; w.x = pk2(v0.x, v0.y); w.y = pk2(v0.z, v0.w); w.z = pk2(v1.x, v1.y); w.w = pk2(v1.z, v1.w);
                    if (pn < 9) { const int b = row >> 13, s = row & (kS - 1);
                        *(u32x4*)(dst + (((size_t)(b * H + head)) * kS + s) * 64 + 32 * bj + 8 * fq) = w; }
                    else { const int gidx = 4 * wc + 2 * bj + (fq >> 1), c0 = 8 * (fq & 1);
                        *(u32x4*)(dst + ((size_t)gidx * 4096 + (row >> 4)) * 512 + (row & 15) * 16 + c0) = w; }
                }
            }
    }
};
struct EpiResid {
    static constexpr int VMOPS = 16;
    const float* x32; bf16_t* xb;
    DEVI void operator()(const f32x4 (&acc)[2][2][4][2], const Unit& u, int wr, int wc, int fr, int fq) const {
#pragma unroll
        for (int ai = 0; ai < 2; ++ai)
#pragma unroll
            for (int m = 0; m < 4; ++m) { const size_t ro = (size_t)(u.pm * 256 + 128 * ai + 64 * wr + 16 * m + fr) * kD + u.pn * 256 + 32 * wc + 8 * fq;
#pragma unroll
                for (int bj = 0; bj < 2; ++bj) { const size_t o = ro + 128 * bj; f32x4 v0, v1;
                    if (x32) { v0 = *(const f32x4*)(x32 + o); v1 = *(const f32x4*)(x32 + o + 4); }
                    else { const u32x4 w = *(const u32x4*)(xb + o); v0 = (f32x4){__uint_as_float(w.x << 16), __uint_as_float(w.x & 0xFFFF0000u), __uint_as_float(w.y << 16), __uint_as_float(w.y & 0xFFFF0000u)};
                        v1 = (f32x4){__uint_as_float(w.z << 16), __uint_as_float(w.z & 0xFFFF0000u), __uint_as_float(w.w << 16), __uint_as_float(w.w & 0xFFFF0000u)}; }
                    v0 += acc[ai][bj][m][0]; v1 += acc[ai][bj][m][1];
                    u32x4 r; r.x = pk2(v0.x, v0.y); r.y = pk2(v0.z, v0.w); r.z = pk2(v1.x, v1.y); r.w = pk2(v1.z, v1.w);
                    *(u32x4*)(xb + o) = r; } }
    }
};
struct EpiGU {
    static constexpr int VMOPS = 8;
    bf16_t* hid; float sc;
    DEVI void operator()(const f32x4 (&acc)[2][2][4][2], const Unit& u, int wr, int wc, int fr, int fq) const {
#pragma unroll
        for (int ai = 0; ai < 2; ++ai)
#pragma unroll
            for (int m = 0; m < 4; ++m) { const size_t row = (size_t)(u.pm * 256 + 128 * ai + 64 * wr + 16 * m + fr);
                float o[8];
#pragma unroll
                for (int n = 0; n < 2; ++n)
#pragma unroll
                    for (int j = 0; j < 4; ++j) { const float gt = acc[ai][0][m][n][j] * sc, up = acc[ai][1][m][n][j] * sc; o[n * 4 + j] = gt * frcp(1.f + __expf(-gt)) * up; if (EMU_FP8_DN) o[n * 4 + j] = q8(o[n * 4 + j], 8.f, 0.125f); }
#if FP8_DN
                u32x2 w;
#pragma unroll
                for (int t = 0; t < 8; ++t) o[t] = fminf(fmaxf(o[t] * kH8, -448.f), 448.f);
                w.x = pk4_fp8(o[0], o[1], o[2], o[3]); w.y = pk4_fp8(o[4], o[5], o[6], o[7]);
                *(u32x2*)((unsigned char*)hid + row * kFF + u.pn * 128 + 32 * wc + 8 * fq) = w;
#else
                u32x4 w; w.x = pk2(o[0], o[1]); w.y = pk2(o[2], o[3]); w.z = pk2(o[4], o[5]); w.w = pk2(o[6], o[7]);
                *(u32x4*)(hid + row * kFF + u.pn * 128 + 32 * wc + 8 * fq) = w;
#endif
            }
    }
};
struct EpiDry {
    static constexpr int VMOPS = 0;
    float* sink;
    DEVI void operator()(const f32x4 (&acc)[2][2][4][2], const Unit& u, int wr, int wc, int fr, int fq) const {
        float t = 0.f;
#pragma unroll
        for (int ai = 0; ai < 2; ++ai)
#pragma unroll
            for (int bj = 0; bj < 2; ++bj)
#pragma unroll
                for (int m = 0; m < 4; ++m)
#pragma unroll
                    for (int n = 0; n < 2; ++n) t += acc[ai][bj][m][n].x + acc[ai][bj][m][n].y + acc[ai][bj][m][n].z + acc[ai][bj][m][n].w;
        if (t == 1.2345e30f) sink[0] = t;
    }
};
struct EpiDown {
    static constexpr int VMOPS = 16;
    bf16_t* y; const float* gate; float sc;
    DEVI void operator()(const f32x4 (&acc)[2][2][4][2], const Unit& u, int wr, int wc, int fr, int fq) const {
#pragma unroll
        for (int ai = 0; ai < 2; ++ai)
#pragma unroll
            for (int m = 0; m < 4; ++m) { const size_t row = (size_t)(u.pm * 256 + 128 * ai + 64 * wr + 16 * m + fr); const float gv = gate[row] * sc;
#pragma unroll
                for (int bj = 0; bj < 2; ++bj) { const f32x4 v0 = acc[ai][bj][m][0] * gv, v1 = acc[ai][bj][m][1] * gv;
                    u32x4 w; w.x = pk2(v0.x, v0.y); w.y = pk2(v0.z, v0.w); w.z = pk2(v1.x, v1.y); w.w = pk2(v1.z, v1.w);
                    *(u32x4*)(y + row * kD + u.pn * 256 + 128 * bj + 32 * wc + 8 * fq) = w; } }
    }
};
struct EpiGlu {
    static constexpr int VMOPS = 16;
    const bf16_t* g; bf16_t* oc;
    DEVI void operator()(const f32x4 (&acc)[2][2][4][2], const Unit& u, int wr, int wc, int fr, int fq) const {
#pragma unroll
        for (int ai = 0; ai < 2; ++ai)
#pragma unroll
            for (int m = 0; m < 4; ++m) { const size_t row = (size_t)(u.pm * 256 + 128 * ai + 64 * wr + 16 * m + fr);
#pragma unroll
                for (int bj = 0; bj < 2; ++bj) { const size_t o = row * 256 + 128 * bj + 32 * wc + 8 * fq;
                    const u32x4 gw = *(const u32x4*)(g + o); float o8[8];
#pragma unroll
                    for (int n = 0; n < 2; ++n)
#pragma unroll
                        for (int j = 0; j < 4; ++j) { const int t = n * 4 + j; const unsigned wv = (t < 2) ? gw.x : (t < 4) ? gw.y : (t < 6) ? gw.z : gw.w;
                            const float gg = __uint_as_float((t & 1) ? (wv & 0xFFFF0000u) : (wv << 16)); o8[t] = gg * frcp(1.f + __expf(-acc[ai][bj][m][n][j])); }
                    u32x4 w; w.x = pk2(o8[0], o8[1]); w.y = pk2(o8[2], o8[3]); w.z = pk2(o8[4], o8[5]); w.w = pk2(o8[6], o8[7]);
                    *(u32x4*)(oc + o) = w; } }
    }
};

DEVI void load_row64(const bf16_t* p, float* d) {
#pragma unroll
    for (int i = 0; i < 8; ++i) { const u32x4 v = *(const u32x4*)(p + i * 8);
        d[i * 8 + 0] = __uint_as_float(v.x << 16); d[i * 8 + 1] = __uint_as_float(v.x & 0xFFFF0000u); d[i * 8 + 2] = __uint_as_float(v.y << 16); d[i * 8 + 3] = __uint_as_float(v.y & 0xFFFF0000u);
        d[i * 8 + 4] = __uint_as_float(v.z << 16); d[i * 8 + 5] = __uint_as_float(v.z & 0xFFFF0000u); d[i * 8 + 6] = __uint_as_float(v.w << 16); d[i * 8 + 7] = __uint_as_float(v.w & 0xFFFF0000u); }
}
DEVI void store_row64(bf16_t* p, const float* d, float sc) {
#pragma unroll
    for (int i = 0; i < 8; ++i) { u32x4 w; w.x = pk2(d[i * 8] * sc, d[i * 8 + 1] * sc); w.y = pk2(d[i * 8 + 2] * sc, d[i * 8 + 3] * sc); w.z = pk2(d[i * 8 + 4] * sc, d[i * 8 + 5] * sc); w.w = pk2(d[i * 8 + 6] * sc, d[i * 8 + 7] * sc);
        *(u32x4*)(p + i * 8) = w; }
}
DEVI void phase_dilated_naive(const bf16_t* qa, const bf16_t* ka, const bf16_t* va, bf16_t* oac, float* lse, int bid, int nblk) {
    const int nitems = 3 * kB * 8 * (kS / kNT);
    for (int it = bid; it < nitems; it += nblk) {
        const int c = it / (kB * 8 * 16), r = it % (kB * 8 * 16), bh = r / 16, t = (r % 16) * kNT + tidx(), b = bh >> 3, h = bh & 7;
        const int dil = (c == 0) ? 1 : (c == 1) ? 4 : 16;
        const float slope = exp2f(-(float)(h + 1));
        const bf16_t* kb_ = ka + (size_t)bh * kS * 64; const bf16_t* vb_ = va + (size_t)bh * kS * 64;
        float q[64], o[64];
        load_row64(qa + ((size_t)bh * kS + t) * 64, q);
#pragma unroll
        for (int d = 0; d < 64; ++d) o[d] = 0.f;
        float m = -1e30f, l = 0.f;
        for (int rel = -64; rel <= 64; ++rel) {
            const int pos = t + rel * dil;
            if (pos < 0 || pos >= kS) continue;
            float kv[64]; load_row64(kb_ + (size_t)pos * 64, kv);
            float dot = 0.f;
#pragma unroll
            for (int d = 0; d < 64; ++d) dot += q[d] * kv[d];
            const float sc = dot * 0.125f - slope * (float)(dil * (rel < 0 ? -rel : rel));
            const float mn = fmaxf(m, sc), corr = __expf(m - mn), p = __expf(sc - mn);
            load_row64(vb_ + (size_t)pos * 64, kv);
            l = l * corr + p;
#pragma unroll
            for (int d = 0; d < 64; ++d) o[d] = o[d] * corr + p * kv[d];
            m = mn;
        }
        const size_t tok = (size_t)b * kS + t;
        store_row64(oac + ((size_t)c * kTok + tok) * 512 + h * 64, o, 1.f / l);
        lse[((size_t)c * kTok + tok) * 8 + h] = m + __logf(l);
    }
}
DEVI void phase_na_naive(const bf16_t* qb, const bf16_t* kbuf, const bf16_t* vbuf, const float* rpb  , bf16_t* ob, int bid, int nblk) {
    const int nitems = kB * 4 * (kS / kNT);
    for (int it = bid; it < nitems; it += nblk) {
        const int bh = it / 16, t = (it % 16) * kNT + tidx(), b = bh >> 2, h = bh & 3;
        const int r = t >> 6, cq = t & 63;
        int rs = r - 4; rs = rs < 0 ? 0 : (rs > 120 ? 120 : rs);
        int cs = cq - 8; cs = cs < 0 ? 0 : (cs > 48 ? 48 : cs);
        const bf16_t* kb_ = kbuf + (size_t)bh * kS * 64; const bf16_t* vb_ = vbuf + (size_t)bh * kS * 64;
        float q[64], o[64];
        load_row64(qb + ((size_t)bh * kS + t) * 64, q);
#pragma unroll
        for (int d = 0; d < 64; ++d) o[d] = 0.f;
        float m = -1e30f, l = 0.f;
        for (int kr = 0; kr < 8; ++kr)
            for (int kc = 0; kc < 16; ++kc) {
                const int krow = rs + kr, kcol = cs + kc, pos = krow * 64 + kcol;
                float kv[64]; load_row64(kb_ + (size_t)pos * 64, kv);
                float dot = 0.f;
#pragma unroll
                for (int d = 0; d < 64; ++d) dot += q[d] * kv[d];
                const float sc = dot * 0.125f + rpb[(h * 15 + (krow - r + 7)) * 31 + (kcol - cq + 15)];
                const float mn = fmaxf(m, sc), corr = __expf(m - mn), p = __expf(sc - mn);
                load_row64(vb_ + (size_t)pos * 64, kv);
                l = l * corr + p;
#pragma unroll
                for (int d = 0; d < 64; ++d) o[d] = o[d] * corr + p * kv[d];
                m = mn;
            }
        store_row64(ob + ((size_t)b * kS + t) * 256 + h * 64, o, 1.f / l);
    }
}

typedef float f32x16 __attribute__((ext_vector_type(16)));
typedef short s16x4 __attribute__((ext_vector_type(4)));
constexpr float kLog2e = 1.4426950408889634f, kLn2 = 0.6931471805599453f;
DEVI bf16x8 tr_pair(LAS unsigned char* p0, LAS unsigned char* p1) {
    const s16x4 a = __builtin_amdgcn_ds_read_tr16_b64_v4i16((LAS s16x4*)p0), b = __builtin_amdgcn_ds_read_tr16_b64_v4i16((LAS s16x4*)p1);
    return (bf16x8){a.x, a.y, a.z, a.w, b.x, b.y, b.z, b.w};
}
DEVI void phase_dilated(const bf16_t* qa, const bf16_t* ka, const bf16_t* va, const float* gq, const float* gk, bf16_t* oac, float* lse, LAS unsigned char* lds, int bid, int nblk) {
    const int tid = tidx(), wid = __builtin_amdgcn_readfirstlane(tid >> 6), lane = tid & 63, h5 = lane >> 5, qc = lane & 31;
    LAS unsigned char* Kimg = lds; LAS unsigned char* Vimg = lds + 49152;
    float Mn;
    { float a = fabsf(gq[lane]), b = fabsf(gk[lane]);
#pragma unroll
      for (int m = 32; m >= 1; m >>= 1) { a = fmaxf(a, __shfl_xor(a, m)); b = fmaxf(b, __shfl_xor(b, m)); }
      Mn = 8.f * a * b; }
    const float Mb = Mn * kLog2e;
    unsigned koff[4];
#pragma unroll
    for (int s = 0; s < 4; ++s) koff[s] = (unsigned)((32 * wid + qc) * 128 + (((2 * s + h5) ^ (qc & 7)) << 4));
    unsigned voff[2];
    { const int g = lane >> 4, i16 = lane & 15, q = i16 >> 2, p = i16 & 3;
#pragma unroll
      for (int dt = 0; dt < 2; ++dt) { const int c = (2 * (g & 1) + (p >> 1) + 4 * dt) ^ ((q >> 1) << 2); voff[dt] = (unsigned)((32 * wid + 4 * h5 + q) * 128 + (c << 4) + 8 * (p & 1)); } }
    float dv[16];
#pragma unroll
    for (int i = 0; i < 16; ++i) dv[i] = (float)((i & 3) + 8 * (i >> 2) + 4 * h5 - qc);
    u32x4 pK[6], pV[6]; bf16x8 pQ[4];
#define DIL_DECODE(unit_) const int c = (unit_) >> 11, rem = (unit_) & 2047, bh = rem >> 5, ub = rem & 31; \
        const int dsh = 2 * c, L = kS >> dsh, upc = 32 >> dsh, cls = ub >> (5 - dsh), u0 = (ub & (upc - 1)) << 8;
#define DIL_PREFETCH(unit_) do { DIL_DECODE(unit_) \
        const bf16_t* kbase = ka + (size_t)bh * kS * 64; const bf16_t* vbase = va + (size_t)bh * kS * 64; \
        { const int qtok_ = ((u0 + 32 * wid + qc) << dsh) + cls; _Pragma("unroll") for (int s = 0; s < 4; ++s) pQ[s] = *(const bf16x8*)(qa + ((size_t)bh * kS + qtok_) * 64 + 16 * s + 8 * h5); } \
        _Pragma("unroll") for (int it = 0; it < 6; ++it) { const int id = it * kNT + tid, row = id >> 3, ch = id & 7; \
            int ki = u0 - 64 + row; ki = ki < 0 ? 0 : (ki > L - 1 ? L - 1 : ki); const size_t tok = (size_t)((ki << dsh) + cls); \
            pK[it] = *(const u32x4*)(kbase + tok * 64 + ch * 8); pV[it] = *(const u32x4*)(vbase + tok * 64 + ch * 8); } } while (0)
    if (bid < 6144) DIL_PREFETCH(bid);
    for (int unit = bid; unit < 6144; unit += nblk) {
        DIL_DECODE(unit)
        __syncthreads();
#pragma unroll
        for (int it = 0; it < 6; ++it) { const int id = it * kNT + tid, row = id >> 3, ch = id & 7;
            *(LAS u32x4*)(Kimg + row * 128 + ((ch ^ (row & 7)) << 4)) = pK[it];
            *(LAS u32x4*)(Vimg + row * 128 + ((ch ^ (((row >> 1) & 1) << 2)) << 4)) = pV[it]; }
        bf16x8 Qf[4];
#pragma unroll
        for (int s = 0; s < 4; ++s) Qf[s] = pQ[s];
        __syncthreads();
        if (unit + nblk < 6144) DIL_PREFETCH(unit + nblk);
        const int q0 = u0 + 32 * wid, qtok = ((q0 + qc) << dsh) + cls;
        const float slope = exp2f(-(float)((bh & 7) + 1));
        const float c1 = 0.125f * kLog2e, c2 = slope * (float)(1 << dsh) * kLog2e;
        float sum = 0.f;
        f32x16 O[2];
#pragma unroll
        for (int dt = 0; dt < 2; ++dt)
#pragma unroll
            for (int i = 0; i < 16; ++i) O[dt][i] = 0.f;
#pragma unroll
        for (int kt = 0; kt < 5; ++kt) {
            const int kp0 = q0 - 64 + 32 * kt;
            if (kp0 >= 0 && kp0 < L) {
                f32x16 S;
#pragma unroll
                for (int i = 0; i < 16; ++i) S[i] = 0.f;
#pragma unroll
                for (int s = 0; s < 4; ++s) { const bf16x8 Kf = *(const LAS bf16x8*)(Kimg + koff[s] + kt * 4096); S = __builtin_amdgcn_mfma_f32_32x32x16_bf16(Kf, Qf[s], S, 0, 0, 0); }
                const float cs = (kt < 2) ? c2 : -c2, c0 = ((kt == 0 || kt == 4) ? -64.f : (kt == 2 ? 0.f : -32.f)) * c2 - Mb;
#pragma unroll
                for (int i = 0; i < 16; ++i) {
                    const float d = (kt == 2) ? fabsf(dv[i]) : dv[i];
                    float sv = S[i] * c1 + (d * cs + c0);
                    if (kt == 0) sv = (dv[i] >= 0.f) ? sv : -1e30f;
                    if (kt == 4) sv = (dv[i] <= 0.f) ? sv : -1e30f;
                    const float pv = __builtin_amdgcn_exp2f(sv); S[i] = pv; sum += pv;
                }
#pragma unroll
                for (int s2 = 0; s2 < 2; ++s2) {
                    u32x4 pw; pw.x = pk2(S[8 * s2 + 0], S[8 * s2 + 1]); pw.y = pk2(S[8 * s2 + 2], S[8 * s2 + 3]); pw.z = pk2(S[8 * s2 + 4], S[8 * s2 + 5]); pw.w = pk2(S[8 * s2 + 6], S[8 * s2 + 7]);
                    const bf16x8 Pf = __builtin_bit_cast(bf16x8, pw);
#pragma unroll
                    for (int dt = 0; dt < 2; ++dt) { LAS unsigned char* vp = Vimg + voff[dt] + kt * 4096 + s2 * 2048;
                        const bf16x8 Vf = tr_pair(vp, vp + 1024);
                        O[dt] = __builtin_amdgcn_mfma_f32_32x32x16_bf16(Vf, Pf, O[dt], 0, 0, 0); }
                }
            }
        }
        sum += __shfl_xor(sum, 32);
        const float inv = 1.f / sum;
        const size_t tok = (size_t)(bh >> 3) * kS + qtok;
        bf16_t* orow = oac + ((size_t)c * kTok + tok) * 512 + (bh & 7) * 64;
#pragma unroll
        for (int dt = 0; dt < 2; ++dt)
#pragma unroll
            for (int g4 = 0; g4 < 4; ++g4) { u32x2 w; w.x = pk2(O[dt][4 * g4] * inv, O[dt][4 * g4 + 1] * inv); w.y = pk2(O[dt][4 * g4 + 2] * inv, O[dt][4 * g4 + 3] * inv);
                *(u32x2*)(orow + 32 * dt + 8 * g4 + 4 * h5) = w; }
        if (h5 == 0) lse[((size_t)c * kTok + tok) * 8 + (bh & 7)] = Mn + __logf(sum);
    }
#undef DIL_DECODE
#undef DIL_PREFETCH
    __syncthreads();
}
DEVI void phase_na(const bf16_t* qb, const bf16_t* kb, const bf16_t* vb, const float* rpb  , bf16_t* ob, LAS unsigned char* lds, int bid, int nblk) {
    const int tid = tidx(), wid = __builtin_amdgcn_readfirstlane(tid >> 6), lane = tid & 63, g4 = lane >> 4, i16 = lane & 15;
    LAS unsigned char* Kimg = lds; LAS unsigned char* Vimg = lds + 73728; LAS float* tab = (LAS float*)(lds + 147456);
    for (int i = tid; i < 4 * 465; i += kNT) tab[i] = rpb[i];
    const int g = wid & 3, kcs = (16 * g - 8) < 0 ? 0 : ((16 * g - 8) > 32 ? 32 : (16 * g - 8));
    const int qcol = 16 * g + i16, cs = (qcol - 8) < 0 ? 0 : ((qcol - 8) > 48 ? 48 : (qcol - 8));
    unsigned kswz[2];
#pragma unroll
    for (int s = 0; s < 2; ++s) kswz[s] = (unsigned)(((4 * s + g4) ^ (i16 & 7)) << 4);
    const int q = i16 >> 2, p = i16 & 3, sw = 2 * (g4 & 1) + (q >> 1);
    unsigned vsw[4];
#pragma unroll
    for (int dt = 0; dt < 4; ++dt) vsw[dt] = (unsigned)((((2 * dt + (p >> 1)) ^ (sw << 1)) << 4) + 8 * (p & 1));
    for (int unit = bid; unit < 2048; unit += nblk) {
        const int bh = unit >> 6, rp = unit & 63, r0 = 2 * rp, h = bh & 3;
        const int rsA = (r0 - 4) < 0 ? 0 : ((r0 - 4) > 120 ? 120 : (r0 - 4));
        const bf16_t* kbase = kb + (size_t)bh * kS * 64; const bf16_t* vbase = vb + (size_t)bh * kS * 64;
        __syncthreads();
#pragma unroll
        for (int it = 0; it < 9; ++it) {
            const int id = it * kNT + tid, row = id >> 3, ch = id & 7;
            int gr = rsA + (row >> 6); gr = gr > 127 ? 127 : gr;
            const size_t tok = (size_t)(gr * 64 + (row & 63));
            const u32x4 kv = *(const u32x4*)(kbase + tok * 64 + ch * 8), vv = *(const u32x4*)(vbase + tok * 64 + ch * 8);
            *(LAS u32x4*)(Kimg + row * 128 + ((ch ^ (row & 7)) << 4)) = kv;
            *(LAS u32x4*)(Vimg + row * 128 + ((ch ^ (((row >> 1) & 3) << 1)) << 4)) = vv;
        }
        __syncthreads();
        const int rr = r0 + (wid >> 2);
        const int rs = (rr - 4) < 0 ? 0 : ((rr - 4) > 120 ? 120 : (rr - 4)), ro = rs - rsA;
        const int qtok = rr * 64 + qcol;
        bf16x8 Qf[2];
#pragma unroll
        for (int s = 0; s < 2; ++s) Qf[s] = *(const bf16x8*)(qb + ((size_t)bh * kS + qtok) * 64 + 32 * s + 8 * g4);
        f32x4 S[16];
        const unsigned kb0 = (unsigned)((ro * 64 + kcs + i16) * 128);
#pragma unroll
        for (int t = 0; t < 16; ++t) { S[t] = (f32x4){0.f, 0.f, 0.f, 0.f};
#pragma unroll
            for (int s = 0; s < 2; ++s) { const bf16x8 Kf = *(const LAS bf16x8*)(Kimg + kb0 + (t >> 1) * 8192 + (t & 1) * 2048 + kswz[s]); S[t] = __builtin_amdgcn_mfma_f32_16x16x32_bf16(Kf, Qf[s], S[t], 0, 0, 0); } }
        float mx = -1e30f;
        const LAS float* th = tab + h * 465;
        int g4v = g4; asm volatile("" : "+v"(g4v));
#pragma unroll
        for (int t = 0; t < 16; ++t)
#pragma unroll
            for (int j = 0; j < 4; ++j) {
                const int krow = rs + (t >> 1), kcol = kcs + 16 * (t & 1) + 4 * g4v + j;
                const bool valid = (kcol >= cs) && (kcol < cs + 16);
                int dc = kcol - qcol + 15; dc = dc < 0 ? 0 : (dc > 30 ? 30 : dc);
                const float bias = th[(krow - rr + 7) * 31 + dc];
                const float sv = valid ? (S[t][j] * 0.125f + bias) * kLog2e : -1e30f;
                S[t][j] = sv; mx = fmaxf(mx, sv);
            }
        mx = fmaxf(mx, __shfl_xor(mx, 16)); mx = fmaxf(mx, __shfl_xor(mx, 32));
        float sum = 0.f;
#pragma unroll
        for (int t = 0; t < 16; ++t)
#pragma unroll
            for (int j = 0; j < 4; ++j) { const float pv = __builtin_amdgcn_exp2f(S[t][j] - mx); S[t][j] = pv; sum += pv; }
        sum += __shfl_xor(sum, 16); sum += __shfl_xor(sum, 32);
        f32x4 O[4];
#pragma unroll
        for (int dt = 0; dt < 4; ++dt) O[dt] = (f32x4){0.f, 0.f, 0.f, 0.f};
        const unsigned vb0 = (unsigned)((ro * 64 + kcs + 4 * g4 + q) * 128);
#pragma unroll
        for (int u = 0; u < 8; ++u) {
            u32x4 pw; pw.x = pk2(S[2 * u][0], S[2 * u][1]); pw.y = pk2(S[2 * u][2], S[2 * u][3]); pw.z = pk2(S[2 * u + 1][0], S[2 * u + 1][1]); pw.w = pk2(S[2 * u + 1][2], S[2 * u + 1][3]);
            const bf16x8 Pf = __builtin_bit_cast(bf16x8, pw);
#pragma unroll
            for (int dt = 0; dt < 4; ++dt) { LAS unsigned char* vp = Vimg + vb0 + u * 8192 + vsw[dt];
                const bf16x8 Vf = tr_pair(vp, vp + 2048);
                O[dt] = __builtin_amdgcn_mfma_f32_16x16x32_bf16(Vf, Pf, O[dt], 0, 0, 0); }
        }
        const float inv = 1.f / sum;
        bf16_t* orow = ob + ((size_t)(bh >> 2) * kS + qtok) * 256 + h * 64;
#pragma unroll
        for (int dt = 0; dt < 4; ++dt) { u32x2 w; w.x = pk2(O[dt][0] * inv, O[dt][1] * inv); w.y = pk2(O[dt][2] * inv, O[dt][3] * inv); *(u32x2*)(orow + 16 * dt + 4 * g4) = w; }
    }
    __syncthreads();
}
DEVI void phase_s5_naive(const Params& P, int l, const bf16_t* ux, float* ys, unsigned char* lds, int bid, int nblk) {
    const int wid = tidx() >> 6, lane = tidx() & 63;
    float* xs = (float*)lds + wid * 128;
    for (int item = wid * nblk + bid; item < kB * 16 * 2; item += nblk * 8) {
        const int dir = item & 1, g = (item >> 1) & 15, b = item >> 5;
        const size_t pbase = (((size_t)l * 2 + dir) * 16 + g) * 64;
        const float dt = __expf(P.s5_log_dt[((size_t)l * 2 + dir) * 16 + g]);
        const float a = fminf(P.s5_a_re[pbase + lane], -1e-4f), w = P.s5_a_im[pbase + lane];
        const float mag = __expf(a * dt), ar = mag * cosf(w * dt), ai = mag * sinf(w * dt);
        const float den = a * a + w * w, zr = ar - 1.f, gr = (zr * a + ai * w) / den, gi = (ai * a - zr * w) / den;
        float bbr[16], bbi[16];
#pragma unroll
        for (int c = 0; c < 16; ++c) { const float br = P.s5_b_re[(pbase + lane) * 16 + c], bi = P.s5_b_im[(pbase + lane) * 16 + c]; bbr[c] = gr * br - gi * bi; bbi[c] = gr * bi + gi * br; }
        const int cch = lane & 15, qt = lane >> 4;
        float cre[16], cim[16];
#pragma unroll
        for (int pp = 0; pp < 16; ++pp) { cre[pp] = P.s5_c_re[(pbase / 64 * 16 + cch) * 64 + qt * 16 + pp]; cim[pp] = P.s5_c_im[(pbase / 64 * 16 + cch) * 64 + qt * 16 + pp]; }
        float xr = 0.f, xi = 0.f;
        const bf16_t* ug = ux + (size_t)g * 4096 * 512;
        for (int st = 0; st < kS; ++st) {
            const int s = dir ? (kS - 1 - st) : st; const size_t tok = (size_t)b * kS + s;
            const bf16_t* up = ug + (tok >> 4) * 512 + (tok & 15) * 16;
            const u32x4 u0 = *(const u32x4*)up, u1 = *(const u32x4*)(up + 8);
            float uv[16];
            uv[0] = __uint_as_float(u0.x << 16); uv[1] = __uint_as_float(u0.x & 0xFFFF0000u); uv[2] = __uint_as_float(u0.y << 16); uv[3] = __uint_as_float(u0.y & 0xFFFF0000u);
            uv[4] = __uint_as_float(u0.z << 16); uv[5] = __uint_as_float(u0.z & 0xFFFF0000u); uv[6] = __uint_as_float(u0.w << 16); uv[7] = __uint_as_float(u0.w & 0xFFFF0000u);
            uv[8] = __uint_as_float(u1.x << 16); uv[9] = __uint_as_float(u1.x & 0xFFFF0000u); uv[10] = __uint_as_float(u1.y << 16); uv[11] = __uint_as_float(u1.y & 0xFFFF0000u);
            uv[12] = __uint_as_float(u1.z << 16); uv[13] = __uint_as_float(u1.z & 0xFFFF0000u); uv[14] = __uint_as_float(u1.w << 16); uv[15] = __uint_as_float(u1.w & 0xFFFF0000u);
            float bur = 0.f, bui = 0.f;
#pragma unroll
            for (int c = 0; c < 16; ++c) { bur += bbr[c] * uv[c]; bui += bbi[c] * uv[c]; }
            const float nr = ar * xr - ai * xi + bur, ni = ar * xi + ai * xr + bui; xr = nr; xi = ni;
            xs[lane] = xr; xs[64 + lane] = xi;
            asm volatile("s_waitcnt lgkmcnt(0)" ::: "memory");
            float y = 0.f;
#pragma unroll
            for (int pp = 0; pp < 16; ++pp) y += cre[pp] * xs[qt * 16 + pp] - cim[pp] * xs[64 + qt * 16 + pp];
            asm volatile("s_waitcnt lgkmcnt(0)" ::: "memory");
            y += __shfl_xor(y, 16); y += __shfl_xor(y, 32);
            if (lane < 16) ys[((size_t)dir * kTok + tok) * 256 + g * 16 + cch] = y;
        }
    }
}
DEVI void phase_s5_finish(const float* ys, const bf16_t* ux, const float* dskip, bf16_t* G, int bid, int nblk) {
    for (size_t i = (size_t)bid * kNT + tidx(); i < (size_t)kTok * 256; i += (size_t)nblk * kNT) {
        const size_t tok = i >> 8; const int ch = (int)(i & 255), g = ch >> 4, c = ch & 15;
        const float u = bf2f(ux[((size_t)g * 4096 + (tok >> 4)) * 512 + (tok & 15) * 16 + c]);
        const float y = ys[i] + ys[(size_t)kTok * 256 + i] + dskip[ch] * u;
        G[i] = f2bf(gelu_tanh(y));
    }
}
DEVI void unpk8(float* d, const u32x4 q, const float sc) {
    d[0] += sc * __uint_as_float(q.x << 16); d[1] += sc * __uint_as_float(q.x & 0xFFFF0000u); d[2] += sc * __uint_as_float(q.y << 16); d[3] += sc * __uint_as_float(q.y & 0xFFFF0000u);
    d[4] += sc * __uint_as_float(q.z << 16); d[5] += sc * __uint_as_float(q.z & 0xFFFF0000u); d[6] += sc * __uint_as_float(q.w << 16); d[7] += sc * __uint_as_float(q.w & 0xFFFF0000u);
}
DEVI void phase_mixnorm(const bf16_t* oac, const float* lse, const bf16_t* ob, const bf16_t* oc, const float* ga, const float* gb, const float* gc, bf16_t* mix, int bid, int nblk) {
    const int wid = tidx() >> 6, lane = tidx() & 63;
    float gn[16];
    { const float* gp = (lane < 32) ? ga + lane * 16 : (lane < 48) ? gb + (lane - 32) * 16 : gc + (lane - 48) * 16;
#pragma unroll
      for (int i = 0; i < 16; ++i) gn[i] = gp[i]; }
    for (int row = bid * 8 + wid; row < kTok; row += nblk * 8) {
        float v[16];
#pragma unroll
        for (int i = 0; i < 16; ++i) v[i] = 0.f;
        if (lane < 32) {
            const int h = lane >> 2;
            const float l0 = lse[(size_t)row * 8 + h], l1 = lse[((size_t)kTok + row) * 8 + h], l2 = lse[((size_t)2 * kTok + row) * 8 + h];
            const bf16_t* p0 = oac + (size_t)row * 512 + lane * 16; const bf16_t* p1 = p0 + (size_t)kTok * 512; const bf16_t* p2 = p1 + (size_t)kTok * 512;
            const u32x4 a0 = *(const u32x4*)p0, a1 = *(const u32x4*)(p0 + 8), b0 = *(const u32x4*)p1, b1 = *(const u32x4*)(p1 + 8), c0 = *(const u32x4*)p2, c1 = *(const u32x4*)(p2 + 8);
            const float mx = fmaxf(l0, fmaxf(l1, l2)); float w0 = __expf(l0 - mx), w1 = __expf(l1 - mx), w2 = __expf(l2 - mx); const float inv = frcp(w0 + w1 + w2); w0 *= inv; w1 *= inv; w2 *= inv;
            unpk8(v, a0, w0); unpk8(v + 8, a1, w0); unpk8(v, b0, w1); unpk8(v + 8, b1, w1); unpk8(v, c0, w2); unpk8(v + 8, c1, w2);
        } else {
            const bf16_t* p = (lane < 48) ? ob + (size_t)row * 256 + (lane - 32) * 16 : oc + (size_t)row * 256 + (lane - 48) * 16;
            const u32x4 a0 = *(const u32x4*)p, a1 = *(const u32x4*)(p + 8);
            unpk8(v, a0, 1.f); unpk8(v + 8, a1, 1.f);
        }
        float ss = 0.f;
#pragma unroll
        for (int i = 0; i < 16; ++i) ss += v[i] * v[i];
#pragma unroll
        for (int m = 1; m <= 8; m <<= 1) ss += __shfl_xor(ss, m);
        const float o16 = __shfl_xor(ss, 16);
        if (lane < 32) ss += o16;
        const float rstd = rsqrtf(ss * ((lane < 32) ? (1.f / 512.f) : (1.f / 256.f)) + kEps);
        if (EMU_FP8_WOUT) {
#pragma unroll
            for (int i = 0; i < 16; ++i) v[i] = q8(v[i] * rstd * gn[i], 1.f, 1.f) / (rstd * gn[i]);
        }
        u32x4 w0, w1;
        w0.x = pk2(v[0] * rstd * gn[0], v[1] * rstd * gn[1]); w0.y = pk2(v[2] * rstd * gn[2], v[3] * rstd * gn[3]); w0.z = pk2(v[4] * rstd * gn[4], v[5] * rstd * gn[5]); w0.w = pk2(v[6] * rstd * gn[6], v[7] * rstd * gn[7]);
        w1.x = pk2(v[8] * rstd * gn[8], v[9] * rstd * gn[9]); w1.y = pk2(v[10] * rstd * gn[10], v[11] * rstd * gn[11]); w1.z = pk2(v[12] * rstd * gn[12], v[13] * rstd * gn[13]); w1.w = pk2(v[14] * rstd * gn[14], v[15] * rstd * gn[15]);
        *(u32x4*)(mix + (size_t)row * kD + lane * 16) = w0; *(u32x4*)(mix + (size_t)row * kD + lane * 16 + 8) = w1;
    }
}
DEVI void phase_combine(bf16_t* xb, float* out32, const bf16_t* y, const int* tokslot, const float* gain_next, bf16_t* h, int bid, int nblk) {
    const int wid = tidx() >> 6, lane = tidx() & 63;
    f32x4 g[4];
#pragma unroll
    for (int q = 0; q < 4; ++q) g[q] = gain_next ? *(const f32x4*)(gain_next + q * 256 + lane * 4) : (f32x4){0.f, 0.f, 0.f, 0.f};
    const int stride = nblk * 8;
    int row = bid * 8 + wid;
    u32x2 nv[4]; int nts = 0;
    if (row < kTok) { nts = tokslot[(size_t)row * kE + (lane & 15)];
#pragma unroll
        for (int q = 0; q < 4; ++q) nv[q] = *(const u32x2*)(xb + (size_t)row * kD + q * 256 + lane * 4); }
    for (; row < kTok; row += stride) {
        const int b = row >> 13;
        const int ts = nts;
        f32x4 v[4];
#pragma unroll
        for (int q = 0; q < 4; ++q) { const u32x2 w = nv[q]; v[q] = (f32x4){__uint_as_float(w.x << 16), __uint_as_float(w.x & 0xFFFF0000u), __uint_as_float(w.y << 16), __uint_as_float(w.y & 0xFFFF0000u)}; }
        const int nrow = row + stride;
        if (nrow < kTok) { nts = tokslot[(size_t)nrow * kE + (lane & 15)];
#pragma unroll
            for (int q = 0; q < 4; ++q) nv[q] = *(const u32x2*)(xb + (size_t)nrow * kD + q * 256 + lane * 4); }
#pragma unroll
        for (int e0 = 0; e0 < kE; e0 += 8) {
            u32x2 yv[8][4];
#pragma unroll
            for (int e = 0; e < 8; ++e) { const int slot = __builtin_amdgcn_readlane(ts, e0 + e);
                if (slot >= 0) { const bf16_t* yr = y + ((size_t)((e0 + e) * kB + b) * kCap + slot) * kD;
#pragma unroll
                    for (int q = 0; q < 4; ++q) yv[e][q] = *(const u32x2*)(yr + q * 256 + lane * 4); } }
#pragma unroll
            for (int e = 0; e < 8; ++e) { const int slot = __builtin_amdgcn_readlane(ts, e0 + e);
                if (slot >= 0) {
#pragma unroll
                    for (int q = 0; q < 4; ++q) { const u32x2 w = yv[e][q];
                        v[q].x += __uint_as_float(w.x << 16); v[q].y += __uint_as_float(w.x & 0xFFFF0000u); v[q].z += __uint_as_float(w.y << 16); v[q].w += __uint_as_float(w.y & 0xFFFF0000u); } } }
        }
        if (!gain_next) {
#pragma unroll
            for (int q = 0; q < 4; ++q) *(f32x4*)(out32 + (size_t)row * kD + q * 256 + lane * 4) = v[q];
        } else {
            float ss = 0.f;
#pragma unroll
            for (int q = 0; q < 4; ++q) { u32x2 o; o.x = pk2(v[q].x, v[q].y); o.y = pk2(v[q].z, v[q].w); *(u32x2*)(xb + (size_t)row * kD + q * 256 + lane * 4) = o;
                v[q] = (f32x4){__uint_as_float(o.x << 16), __uint_as_float(o.x & 0xFFFF0000u), __uint_as_float(o.y << 16), __uint_as_float(o.y & 0xFFFF0000u)};
                ss += v[q].x * v[q].x + v[q].y * v[q].y + v[q].z * v[q].z + v[q].w * v[q].w; }
            ss = wave_sum(ss); const float rstd = rsqrtf(ss * (1.f / kD) + kEps);
#pragma unroll
            for (int q = 0; q < 4; ++q) { const f32x4 t = v[q] * rstd * g[q]; u32x2 o; o.x = pk2(t.x, t.y); o.y = pk2(t.z, t.w);
                *(u32x2*)(h + (size_t)row * kD + q * 256 + lane * 4) = o; }
        }
    }
}

DEVI void cpow_m(double a, double w, double dt, int m, float& re, float& im) {
    const float mag = __expf((float)m * (float)a * (float)dt);
    const double turns = (double)m * w * dt * 0.15915494309189535; const float ang = (float)((turns - floor(turns)) * 6.283185307179586);
    re = mag * cosf(ang); im = mag * sinf(ang);
}
DEVI void s5_prep_item(const Params& P, int l, int g, unsigned char* lds_) {
    float* pw = (float*)lds_;
    float* bb = pw + 4352;
    float* cc = bb + 4096;
    float* kt = cc + 4096;
    const int tid = tidx();
    __syncthreads();
    for (int i = tid; i < 128; i += kNT) { const int dir = i >> 6, p = i & 63; const size_t pb = (((size_t)l * 2 + dir) * 16 + g) * 64 + p;
        const double dt = (double)__expf(P.s5_log_dt[((size_t)l * 2 + dir) * 16 + g]); const double a = (double)fminf(P.s5_a_re[pb], -1e-4f), w = (double)P.s5_a_im[pb];
        for (int m = 0; m < 17; ++m) { float re, im; cpow_m(a, w, dt, m, re, im); pw[((dir * 64 + p) * 17 + m) * 2] = re; pw[((dir * 64 + p) * 17 + m) * 2 + 1] = im; }
        const float af = (float)a, wf = (float)w, ar = pw[((dir * 64 + p) * 17 + 1) * 2], ai = pw[((dir * 64 + p) * 17 + 1) * 2 + 1];
        const float den = af * af + wf * wf, zr = ar - 1.f, gr = (zr * af + ai * wf) / den, gi = (ai * af - zr * wf) / den;
        for (int c = 0; c < 16; ++c) { const float br = P.s5_b_re[pb * 16 + c], bi = P.s5_b_im[pb * 16 + c]; bb[((dir * 64 + p) * 16 + c) * 2] = gr * br - gi * bi; bb[((dir * 64 + p) * 16 + c) * 2 + 1] = gr * bi + gi * br; }
    }
    for (int i = tid; i < 2048; i += kNT) { const int dir = i >> 10, c = (i >> 6) & 15, p = i & 63; const size_t o = ((((size_t)l * 2 + dir) * 16 + g) * 16 + c) * 64 + p; cc[i * 2] = P.s5_c_re[o]; cc[i * 2 + 1] = P.s5_c_im[o]; }
    __syncthreads();
    for (int i = tid; i < 8192; i += kNT) { const int dir = i >> 12, m = (i >> 8) & 15, c = (i >> 4) & 15, c2 = i & 15; float acc = 0.f;
        for (int p = 0; p < 64; ++p) { const float cr = cc[((dir * 16 + c) * 64 + p) * 2], ci = cc[((dir * 16 + c) * 64 + p) * 2 + 1], wr_ = pw[((dir * 64 + p) * 17 + m) * 2], wi_ = pw[((dir * 64 + p) * 17 + m) * 2 + 1];
            const float br = bb[((dir * 64 + p) * 16 + c2) * 2], bi = bb[((dir * 64 + p) * 16 + c2) * 2 + 1]; const float tr = cr * wr_ - ci * wi_, ti = cr * wi_ + ci * wr_; acc += tr * br - ti * bi; }
        kt[i] = acc; }
    __syncthreads();
    bf16_t* wst = (bf16_t*)(wsp(P) + WS_WST) + ((size_t)l * 16 + g) * 256 * 256;
    bf16_t* wso = (bf16_t*)(wsp(P) + WS_WSO) + ((size_t)l * 16 + g) * 256 * 512;
    for (int id = tid; id < 8192; id += kNT) { const int n = id >> 5, k0 = (id & 31) * 8, dir = n >> 7, p = (n >> 1) & 63, ri = n & 1; float v[8];
#pragma unroll
        for (int kk = 0; kk < 8; ++kk) { const int k = k0 + kk, t = k >> 4, c = k & 15, e = dir ? t : 15 - t; const float wr_ = pw[((dir * 64 + p) * 17 + e) * 2], wi_ = pw[((dir * 64 + p) * 17 + e) * 2 + 1], br = bb[((dir * 64 + p) * 16 + c) * 2], bi = bb[((dir * 64 + p) * 16 + c) * 2 + 1];
            v[kk] = ri ? (wr_ * bi + wi_ * br) : (wr_ * br - wi_ * bi); }
        u32x4 o; o.x = pk2(v[0], v[1]); o.y = pk2(v[2], v[3]); o.z = pk2(v[4], v[5]); o.w = pk2(v[6], v[7]); *(u32x4*)(wst + (size_t)n * 256 + k0) = o; }
    for (int id = tid; id < 16384; id += kNT) { const int ns = id >> 6, k0 = (id & 63) * 8, n = cmap_pk(ns), t = n >> 4, c = n & 15; float v[8];
#pragma unroll
        for (int kk = 0; kk < 8; ++kk) { const int k = k0 + kk; float x;
            if (k < 256) { const int j = k >> 4, c2 = k & 15; x = 0.f; if (j <= t) x += kt[(t - j) * 256 + c * 16 + c2]; if (j >= t) x += kt[4096 + (j - t) * 256 + c * 16 + c2]; if (j == t && c == c2) x += P.s5_d[l * 256 + g * 16 + c]; }
            else { const int q = k - 256, dir = q >> 7, p = (q >> 1) & 63, ri = q & 1, e = dir ? 16 - t : t + 1; const float cr = cc[((dir * 16 + c) * 64 + p) * 2], ci = cc[((dir * 16 + c) * 64 + p) * 2 + 1], wr_ = pw[((dir * 64 + p) * 17 + e) * 2], wi_ = pw[((dir * 64 + p) * 17 + e) * 2 + 1];
                x = ri ? -(cr * wi_ + ci * wr_) : (cr * wr_ - ci * wi_); }
            v[kk] = x; }
        u32x4 o; o.x = pk2(v[0], v[1]); o.y = pk2(v[2], v[3]); o.z = pk2(v[4], v[5]); o.w = pk2(v[6], v[7]); *(u32x4*)(wso + (size_t)ns * 512 + k0) = o; }
    __syncthreads();
}
DEVI void phase_s5_scan(const Params& P, int l, const float* Z, bf16_t* ux, unsigned char* lds_, int bid, int nblk) {
    const int tid = tidx(), wid = tid >> 6, lane = tid & 63;
    float* E = (float*)lds_;
    for (int item = bid; item < 256; item += nblk) {
        const int dir = item & 1, g = (item >> 1) & 15, b = item >> 5;
        const size_t pb = (((size_t)l * 2 + dir) * 16 + g) * 64 + lane;
        const double dt = (double)__expf(P.s5_log_dt[((size_t)l * 2 + dir) * 16 + g]); const double a = (double)fminf(P.s5_a_re[pb], -1e-4f), w = (double)P.s5_a_im[pb];
        float a16r, a16i, Ar, Ai; cpow_m(a, w, dt, 16, a16r, a16i); cpow_m(a, w, dt, 1024, Ar, Ai);
        const int kk0 = dir ? 511 - 64 * wid : 64 * wid; const long sstep = dir ? -1 : 1;
        const float* zp = Z + ((size_t)g * 4096 + b * 512 + kk0) * 256 + dir * 128 + 2 * lane;
        f32x2 z[64];
#pragma unroll
        for (int i = 0; i < 64; ++i) { z[i] = *(const f32x2*)zp; zp += sstep * 256; }
        float xr = 0.f, xi = 0.f;
#pragma unroll
        for (int i = 0; i < 64; ++i) { const float nr = a16r * xr - a16i * xi + z[i].x, ni = a16r * xi + a16i * xr + z[i].y; xr = nr; xi = ni; }
        __syncthreads();
        E[(wid * 64 + lane) * 2] = xr; E[(wid * 64 + lane) * 2 + 1] = xi;
        __syncthreads();
        float sr = 0.f, si = 0.f;
#pragma unroll
        for (int s2 = 0; s2 < 7; ++s2) if (s2 < wid) { const float er = E[(s2 * 64 + lane) * 2], ei = E[(s2 * 64 + lane) * 2 + 1]; const float nr = Ar * sr - Ai * si + er, ni = Ar * si + Ai * sr + ei; sr = nr; si = ni; }
        bf16_t* up = ux + ((size_t)g * 4096 + b * 512 + kk0) * 512 + 256 + dir * 128 + 2 * lane;
#pragma unroll
        for (int i = 0; i < 64; ++i) { *(unsigned*)up = pk2(sr, si); up += sstep * 512;
            const float nr = a16r * sr - a16i * si + z[i].x, ni = a16r * si + a16i * sr + z[i].y; sr = nr; si = ni; }
    }
    __syncthreads();
}
struct EpiF32N {
    static constexpr int VMOPS = 32;
    float* z; int ldz;
    DEVI void operator()(const f32x4 (&acc)[2][2][4][2], const Unit& u, int wr, int wc, int fr, int fq) const {
#pragma unroll
        for (int ai = 0; ai < 2; ++ai)
#pragma unroll
            for (int m = 0; m < 4; ++m) { const size_t ro = (size_t)(u.pm * 256 + 128 * ai + 64 * wr + 16 * m + fr) * ldz + u.pn * 256 + 32 * wc + 4 * fq;
#pragma unroll
                for (int bj = 0; bj < 2; ++bj)
#pragma unroll
                    for (int n = 0; n < 2; ++n) *(f32x4*)(z + ro + 128 * bj + 16 * n) = acc[ai][bj][m][n]; }
    }
};
struct EpiS5Out {
    static constexpr int VMOPS = 16;
    bf16_t* G;
    DEVI void operator()(const f32x4 (&acc)[2][2][4][2], const Unit& u, int wr, int wc, int fr, int fq) const {
#pragma unroll
        for (int ai = 0; ai < 2; ++ai)
#pragma unroll
            for (int m = 0; m < 4; ++m) { const int R = u.pm * 256 + 128 * ai + 64 * wr + 16 * m + fr, g = R >> 12, ck = R & 4095;
#pragma unroll
                for (int bj = 0; bj < 2; ++bj) { const int t = 8 * bj + 2 * wc + (fq >> 1), c0 = 8 * (fq & 1);
                    const f32x4 v0 = acc[ai][bj][m][0], v1 = acc[ai][bj][m][1];
                    u32x4 w; w.x = pk2(gelu_tanh(v0.x), gelu_tanh(v0.y)); w.y = pk2(gelu_tanh(v0.z), gelu_tanh(v0.w)); w.z = pk2(gelu_tanh(v1.x), gelu_tanh(v1.y)); w.w = pk2(gelu_tanh(v1.z), gelu_tanh(v1.w));
                    *(u32x4*)(G + ((size_t)ck * 16 + t) * 256 + g * 16 + c0) = w; } }
    }
};
#define XB_TMO      128
#define XB_XCNT(j)  (256  + 64 * (j))
#define XB_XSUB(j)  (1280 + 64 * (j))
#define XB_XGEN(j)  (2304 + 64 * (j))
#define XB_TOP      3328
#define XB_TOPGEN   3392
#define XCD_BAR_WORDS 3456
#define XB_SPIN_CAP (1u << 26)
DEVI unsigned xb_ld(unsigned* p)              { return __hip_atomic_load(p, __ATOMIC_RELAXED, __HIP_MEMORY_SCOPE_AGENT); }
DEVI unsigned xb_add(unsigned* p, unsigned v) { return __hip_atomic_fetch_add(p, v, __ATOMIC_RELAXED, __HIP_MEMORY_SCOPE_AGENT); }
DEVI unsigned xb_xcc_id() { return (unsigned)__builtin_amdgcn_s_getreg((3 << 11) | 20) & 0xFu; }
#define XB_SPIN(cond, bar) do { unsigned _sp = 0; while (cond) { __builtin_amdgcn_s_sleep(1); \
    if ((++_sp & 255u) == 0u) { if (xb_ld(&(bar)[XB_TMO])) break; if (_sp > XB_SPIN_CAP) { atomicAdd(&(bar)[XB_TMO], 1u); break; } } } } while (0)
struct XcdBarrier { unsigned* bar; unsigned x; volatile LAS unsigned* st; };
DEVI XcdBarrier xcd_barrier_post(unsigned* bar, volatile LAS unsigned* st) {
    XcdBarrier b; b.bar = bar; b.x = xb_xcc_id(); b.st = st;
    if (threadIdx.x == 0) (void)xb_add(&bar[XB_XCNT(b.x)], 1u);
    return b;
}
DEVI void xcd_barrier_complete(unsigned* bar, unsigned x, unsigned& nloc, unsigned& nx) {
    const unsigned G = gridDim.x * gridDim.y * gridDim.z;
    unsigned sum, cnt, mine, sp = 0u;
    for (;;) {
        sum = 0u; cnt = 0u; mine = 0u;
#pragma unroll
        for (unsigned j = 0; j < 16; ++j) { const unsigned c = xb_ld(&bar[XB_XCNT(j)]); sum += c; cnt += (c > 0u) ? 1u : 0u; mine = (j == x) ? c : mine; }
        if (sum == G) break;
        __builtin_amdgcn_s_sleep(1);
        if ((++sp & 255u) == 0u) { if (xb_ld(&bar[XB_TMO])) break; if (sp > XB_SPIN_CAP) { atomicAdd(&bar[XB_TMO], 1u); break; } }
    }
    nloc = mine > 0u ? mine : 1u; nx = cnt > 0u ? cnt : 1u;
}
DEVI void xcd_barrier(const XcdBarrier& b) {
    asm volatile("s_waitcnt vmcnt(0)" ::: "memory");
    __syncthreads();
    if (threadIdx.x == 0) {
        unsigned long long bp_ = (unsigned long long)b.bar; asm volatile("" : "+s"(bp_));
        unsigned* bar = (unsigned*)bp_;
        const unsigned bx = xb_xcc_id();
        __builtin_amdgcn_s_waitcnt(0);
        unsigned nloc = b.st[0], nx = b.st[1];
        if (nloc == 0u) { xcd_barrier_complete(bar, bx, nloc, nx); b.st[0] = nloc; b.st[1] = nx; }
        const unsigned old = xb_add(&bar[XB_XSUB(bx)], 1u);
        const unsigned gen = old / nloc;
        if (old + 1u == (gen + 1u) * nloc) {
            __builtin_amdgcn_fence(__ATOMIC_RELEASE, "agent");
            asm volatile("s_waitcnt vmcnt(0)" ::: "memory");
            const unsigned og = xb_add(&bar[XB_TOP], 1u);
            const unsigned tg = og / nx;
            if (og + 1u == (tg + 1u) * nx) xb_add(&bar[XB_TOPGEN], 1u);
            else XB_SPIN(xb_ld(&bar[XB_TOPGEN]) == tg, bar);
            __builtin_amdgcn_fence(__ATOMIC_ACQUIRE, "agent");
            xb_add(&bar[XB_XGEN(bx)], 1u);
            asm volatile("s_waitcnt vmcnt(0)" ::: "memory");
        } else {
            XB_SPIN(xb_ld(&bar[XB_XGEN(bx)]) == gen, bar);
            __builtin_amdgcn_fence(__ATOMIC_ACQUIRE, "agent");
            asm volatile("s_waitcnt vmcnt(0)" ::: "memory");
        }
    }
    __syncthreads();
}

#ifndef MEGA
#define MEGA 1
#endif
#ifndef USE_ENGINE
#define USE_ENGINE 1
#endif
constexpr int LDS_BYTES = 147456 + 8192 + 16;
#if USE_ENGINE
#define GEMM_RUN(g, E) gemm_engine<decltype(E), true, true>((LAS unsigned char*)dyn_lds, g, E, bid, nblk)
#define GEMM_RUN8(g, E) gemm_engine<decltype(E), true, true, true>((LAS unsigned char*)dyn_lds, g, E, bid, nblk)
#else
#define GEMM_RUN(g, E) gemm_simple(g, E, bid, nblk)
#endif
extern __shared__ __attribute__((aligned(16))) unsigned char dyn_lds[];

DEVI GemmD mk_gemm(const bf16_t* A, const bf16_t* Bt, int lda, int K, int nM, int nN, const int* rowidx, size_t bstride, int pmg) {
    GemmD g; g.A = A; g.Bt = Bt; g.lda = lda; g.K = K; g.nM = nM; g.nN = nN; g.rowidx = rowidx; g.bstride = bstride; g.pmg = pmg; return g; }

DEVI void ph_win(const Params& P, int l, int bid, int nblk) {
    const GemmD g = mk_gemm((const bf16_t*)(wsp(P) + WS_H), (const bf16_t*)(wsp(P) + WS_WINT) + (size_t)l * kINW * kD, kD, kD, kTok / 256, 10, nullptr, 0, 1 << 30);
    unsigned char* r1 = wsp(P) + WS_R1;
    EpiQKV E; E.qa = (bf16_t*)(r1 + R1_QA); E.ka = (bf16_t*)(r1 + R1_KA); E.va = (bf16_t*)(r1 + R1_VA); E.qb = (bf16_t*)(r1 + R1_QB); E.kb = (bf16_t*)(r1 + R1_KB); E.vb = (bf16_t*)(r1 + R1_VB); E.ux = (bf16_t*)(r1 + R1_UX);
    E.qna = P.q_norm_a + l * 64; E.kna = P.k_norm_a + l * 64; E.qnb = P.q_norm_b + l * 64; E.knb = P.k_norm_b + l * 64;
    GEMM_RUN(g, E);
}
#ifndef USE_MFMA_ATTN
#define USE_MFMA_ATTN 1
#endif
#ifndef USE_S5_GEMM
#define USE_S5_GEMM 1
#endif
#ifndef PROBE_ATTN
#define PROBE_ATTN 1
#endif
#ifndef PROBE_GU
#define PROBE_GU 1
#endif
#ifndef PROBE_DOWN
#define PROBE_DOWN 1
#endif
#ifndef PROBE_NA
#define PROBE_NA 1
#endif
#ifndef PROBE_MIX
#define PROBE_MIX 1
#endif
#ifndef PROBE_RT
#define PROBE_RT 1
#endif
#ifndef PROBE_TK
#define PROBE_TK 1
#endif
#ifndef PROBE_GUDRY
#define PROBE_GUDRY 0
#endif
#ifndef PROBE_CONV
#define PROBE_CONV 1
#endif
DEVI void ph_dilated(const Params& P, int l, int bid, int nblk) { unsigned char* r1 = wsp(P) + WS_R1;
#if USE_MFMA_ATTN
    phase_dilated((const bf16_t*)(r1 + R1_QA), (const bf16_t*)(r1 + R1_KA), (const bf16_t*)(r1 + R1_VA), P.q_norm_a + l * 64, P.k_norm_a + l * 64, (bf16_t*)(wsp(P) + WS_R2), (float*)(wsp(P) + WS_LSE), (LAS unsigned char*)dyn_lds, bid, nblk);
#else
    phase_dilated_naive((const bf16_t*)(r1 + R1_QA), (const bf16_t*)(r1 + R1_KA), (const bf16_t*)(r1 + R1_VA), (bf16_t*)(wsp(P) + WS_R2), (float*)(wsp(P) + WS_LSE), bid, nblk);
#endif
}
DEVI void ph_na(const Params& P, int l, int bid, int nblk) { unsigned char* r1 = wsp(P) + WS_R1;
#if USE_MFMA_ATTN
    phase_na((const bf16_t*)(r1 + R1_QB), (const bf16_t*)(r1 + R1_KB), (const bf16_t*)(r1 + R1_VB), P.rpb + (size_t)l * 4 * 15 * 31, (bf16_t*)(r1 + R1_OB), (LAS unsigned char*)dyn_lds, bid, nblk);
#else
    phase_na_naive((const bf16_t*)(r1 + R1_QB), (const bf16_t*)(r1 + R1_KB), (const bf16_t*)(r1 + R1_VB), P.rpb + (size_t)l * 4 * 15 * 31, (bf16_t*)(r1 + R1_OB), bid, nblk);
#endif
}
DEVI void ph_s5(const Params& P, int l, unsigned char* lds, int bid, int nblk) { phase_s5_naive(P, l, (const bf16_t*)(wsp(P) + WS_R1 + R1_UX), (float*)(wsp(P) + WS_YS), lds, bid, nblk); }
DEVI void ph_s5_prep(const Params& P, unsigned char* lds, int bid, int nblk) { for (int it = bid; it < kL * 16; it += nblk) s5_prep_item(P, it >> 4, it & 15, lds); }
DEVI void ph_s5_state(const Params& P, int l, int bid, int nblk) {
    const GemmD g = mk_gemm((const bf16_t*)(wsp(P) + WS_R1 + R1_UX), (const bf16_t*)(wsp(P) + WS_WST) + (size_t)l * 16 * 256 * 256, 512, 256, 256, 1, nullptr, (size_t)256 * 256, 16);
    EpiF32N E; E.z = (float*)(wsp(P) + WS_R2 + R2_Z); E.ldz = 256;
    GEMM_RUN(g, E);
}
DEVI void ph_s5_scan(const Params& P, int l, unsigned char* lds, int bid, int nblk) { phase_s5_scan(P, l, (const float*)(wsp(P) + WS_R2 + R2_Z), (bf16_t*)(wsp(P) + WS_R1 + R1_UX), lds, bid, nblk); }
DEVI void ph_s5_out(const Params& P, int l, int bid, int nblk) {
    const GemmD g = mk_gemm((const bf16_t*)(wsp(P) + WS_R1 + R1_UX), (const bf16_t*)(wsp(P) + WS_WSO) + (size_t)l * 16 * 256 * 512, 512, 512, 256, 1, nullptr, (size_t)256 * 512, 16);
    EpiS5Out E; E.G = (bf16_t*)(wsp(P) + WS_R1 + R1_G);
    GEMM_RUN(g, E);
}
DEVI void ph_s5fin(const Params& P, int l, int bid, int nblk) { phase_s5_finish((const float*)(wsp(P) + WS_YS), (const bf16_t*)(wsp(P) + WS_R1 + R1_UX), P.s5_d + l * 256, (bf16_t*)(wsp(P) + WS_R1 + R1_G), bid, nblk); }
DEVI void ph_glu(const Params& P, int l, int bid, int nblk) {
    const GemmD g = mk_gemm((const bf16_t*)(wsp(P) + WS_R1 + R1_G), (const bf16_t*)(wsp(P) + WS_WGLUT) + (size_t)l * 256 * 256, 256, 256, kTok / 256, 1, nullptr, 0, 1 << 30);
    EpiGlu E; E.g = (const bf16_t*)(wsp(P) + WS_R1 + R1_G); E.oc = (bf16_t*)(wsp(P) + WS_R1 + R1_OC);
    GEMM_RUN(g, E);
}
DEVI void ph_mixnorm(const Params& P, int l, int bid, int nblk) { unsigned char* r1 = wsp(P) + WS_R1;
    phase_mixnorm((const bf16_t*)(wsp(P) + WS_R2), (const float*)(wsp(P) + WS_LSE), (const bf16_t*)(r1 + R1_OB), (const bf16_t*)(r1 + R1_OC), P.out_norm_a + l * 512, P.out_norm_b + l * 256, P.out_norm_c + l * 256, (bf16_t*)(wsp(P) + WS_H), bid, nblk); }
DEVI void ph_wout(const Params& P, int l, int bid, int nblk) {
    const GemmD g = mk_gemm((const bf16_t*)(wsp(P) + WS_H), (const bf16_t*)(wsp(P) + WS_WOUTT) + (size_t)l * kD * kD, kD, kD, kTok / 256, 4, nullptr, 0, 1 << 30);
    EpiResid E; E.x32 = (l == 0) ? P.x : nullptr; E.xb = (bf16_t*)(wsp(P) + WS_XB);
    GEMM_RUN(g, E);
}
DEVI void ph_router(const Params& P, int l, unsigned char* lds, int bid, int nblk) { phase_router((const bf16_t*)(wsp(P) + WS_XB), P.ffn_norm + (size_t)l * kD, P.w_router + (size_t)l * kD * kE, (bf16_t*)(wsp(P) + WS_H), (float*)(wsp(P) + WS_AFF), lds, bid, nblk); }
DEVI void ph_topk(const Params& P, unsigned char* lds, int bid, int nblk) { phase_topk((const float*)(wsp(P) + WS_AFF), (int*)(wsp(P) + WS_IDX), (float*)(wsp(P) + WS_GATE), (int*)(wsp(P) + WS_TSLOT), wsp(P) + WS_H, wsp(P) + WS_R2, FP8_GU ? kD : kD * 2, lds, bid, nblk); }
DEVI void ph_gu(const Params& P, int l, int bid, int nblk) {
#if FP8_GU
    const GemmD g = mk_gemm((const bf16_t*)(wsp(P) + WS_R2), (const bf16_t*)(wsp(P) + WS_WGUT + (size_t)l * kE * 4096 * kD), kD, kD, 512, 16, nullptr, (size_t)4096 * kD, 32);
    EpiGU E; E.hid = (bf16_t*)(wsp(P) + WS_R1); E.sc = 1.f / kW8;
    GEMM_RUN8(g, E);
#else
    const GemmD g = mk_gemm((const bf16_t*)(wsp(P) + WS_R2), (const bf16_t*)(wsp(P) + WS_WGUT) + (size_t)l * kE * 4096 * kD, kD, kD, 512, 16, nullptr, (size_t)4096 * kD, 32);
    EpiGU E; E.hid = (bf16_t*)(wsp(P) + WS_R1); E.sc = 1.f;
    GEMM_RUN(g, E);
#endif
}
DEVI void ph_gu_dry(const Params& P, int l, int bid, int nblk) {
    const GemmD g = mk_gemm((const bf16_t*)(wsp(P) + WS_R2), (const bf16_t*)(wsp(P) + WS_WGUT) + (size_t)l * kE * 4096 * kD, kD, kD, 512, 16, nullptr, (size_t)4096 * kD, 32);
    EpiDry E; E.sink = (float*)(wsp(P) + WS_YS);
    GEMM_RUN(g, E);
}
DEVI void ph_down(const Params& P, int l, int bid, int nblk) {
#if FP8_DN
    const GemmD g = mk_gemm((const bf16_t*)(wsp(P) + WS_R1), (const bf16_t*)(wsp(P) + WS_WDT + (size_t)l * kE * kD * kFF), kFF, kFF, 512, 4, nullptr, (size_t)kD * kFF, 32);
    EpiDown E; E.y = (bf16_t*)(wsp(P) + WS_R2); E.gate = (const float*)(wsp(P) + WS_GATE); E.sc = 1.f / (kW8 * kH8);
    GEMM_RUN8(g, E);
#else
    const GemmD g = mk_gemm((const bf16_t*)(wsp(P) + WS_R1), (const bf16_t*)(wsp(P) + WS_WDT) + (size_t)l * kE * kD * kFF, kFF, kFF, 512, 4, nullptr, (size_t)kD * kFF, 32);
    EpiDown E; E.y = (bf16_t*)(wsp(P) + WS_R2); E.gate = (const float*)(wsp(P) + WS_GATE); E.sc = 1.f;
    GEMM_RUN(g, E);
#endif
}
DEVI void ph_combine(const Params& P, int l, int bid, int nblk) { phase_combine((bf16_t*)(wsp(P) + WS_XB), P.out, (const bf16_t*)(wsp(P) + WS_R2), (const int*)(wsp(P) + WS_TSLOT), (l + 1 < kL) ? P.attn_norm + (size_t)(l + 1) * kD : nullptr, (bf16_t*)(wsp(P) + WS_H), bid, nblk); }

typedef __attribute__((address_space(4))) const Params* CParams;
DEVI CParams kargs() { unsigned long long a = (unsigned long long)__builtin_amdgcn_kernarg_segment_ptr(); asm volatile("" : "+s"(a)); return (CParams)a; }
#if MEGA
__global__ void __launch_bounds__(kNT, 2) mega_fwd(Params P_) {
#define PK (*(const Params*)kargs())
    volatile LAS unsigned* st = (volatile LAS unsigned*)(dyn_lds + LDS_BYTES - 16);
    if (threadIdx.x == 0) { st[0] = 0u; st[1] = 0u; st[2] = 0u; st[3] = 0u; }
    __syncthreads();
    const XcdBarrier bar = xcd_barrier_post((unsigned*)(PK.ws + WS_CTL), st);
    const int bid = blockIdx.x, nblk = gridDim.x;
    unsigned char* lds = dyn_lds;
#pragma unroll 1
    for (int rep = 0; rep < PROBE_CONV; ++rep)
    phase_convert(PK, lds, lnd(bid), nblk);
#if USE_S5_GEMM
    ph_s5_prep(PK, lds, lnd(bid), nblk);
#endif
    phase_norm(PK.x, PK.attn_norm, (bf16_t*)(PK.ws + WS_H), lnd(bid), nblk);
    xcd_barrier(bar);
#pragma unroll 1
    for (int l = 0; l < kL; ++l) {
        ph_win(PK, l, lnd(bid), nblk);            xcd_barrier(bar);
#if USE_S5_GEMM
        ph_s5_state(PK, l, lnd(bid), nblk);       xcd_barrier(bar);
        ph_s5_scan(PK, l, lds, lnd(bid), nblk);
#pragma unroll 1
        for (int rep = 0; rep < PROBE_ATTN; ++rep)
        ph_dilated(PK, l, lnd(bid), nblk);
#pragma unroll 1
        for (int rep = 0; rep < PROBE_NA; ++rep)
        ph_na(PK, l, lnd(bid), nblk);             xcd_barrier(bar);
        ph_s5_out(PK, l, lnd(bid), nblk);         xcd_barrier(bar);
#else
        ph_s5(PK, l, lds, lnd(bid), nblk);
        ph_dilated(PK, l, lnd(bid), nblk);
        ph_na(PK, l, lnd(bid), nblk);             xcd_barrier(bar);
        ph_s5fin(PK, l, lnd(bid), nblk);          xcd_barrier(bar);
#endif
        ph_glu(PK, l, lnd(bid), nblk);            xcd_barrier(bar);
#pragma unroll 1
        for (int rep = 0; rep < PROBE_MIX; ++rep) {
        ph_mixnorm(PK, l, lnd(bid), nblk);        xcd_barrier(bar); }
        ph_wout(PK, l, lnd(bid), nblk);           xcd_barrier(bar);
#pragma unroll 1
        for (int rep = 0; rep < PROBE_RT; ++rep) {
        ph_router(PK, l, lds, lnd(bid), nblk);    xcd_barrier(bar); }
#pragma unroll 1
        for (int rep = 0; rep < PROBE_TK; ++rep) {
        ph_topk(PK, lds, lnd(bid), nblk);         xcd_barrier(bar); }
#pragma unroll 1
        for (int rep = 0; rep < PROBE_GU; ++rep) {
        ph_gu(PK, l, lnd(bid), nblk);             xcd_barrier(bar); }
#if PROBE_GUDRY
        ph_gu_dry(PK, l, lnd(bid), nblk);         xcd_barrier(bar);
#endif
#pragma unroll 1
        for (int rep = 0; rep < PROBE_DOWN; ++rep) {
        ph_down(PK, l, lnd(bid), nblk);           xcd_barrier(bar); }
        ph_combine(PK, l, lnd(bid), nblk);        xcd_barrier(bar);
    }
#undef PK
}
#else
#define KB __global__ void __launch_bounds__(kNT, 2)
KB k_convert(Params P) { phase_convert(P, dyn_lds, blockIdx.x, gridDim.x); }
KB k_norm(Params P) { phase_norm(P.x, P.attn_norm, (bf16_t*)(P.ws + WS_H), blockIdx.x, gridDim.x); }
KB k_win(Params P, int l) { ph_win(P, l, blockIdx.x, gridDim.x); }
KB k_dilated(Params P, int l) { ph_dilated(P, l, blockIdx.x, gridDim.x); }
KB k_na(Params P, int l) { ph_na(P, l, blockIdx.x, gridDim.x); }
KB k_s5(Params P, int l) { ph_s5(P, l, dyn_lds, blockIdx.x, gridDim.x); }
KB k_s5fin(Params P, int l) { ph_s5fin(P, l, blockIdx.x, gridDim.x); }
KB k_glu(Params P, int l) { ph_glu(P, l, blockIdx.x, gridDim.x); }
KB k_mixnorm(Params P, int l) { ph_mixnorm(P, l, blockIdx.x, gridDim.x); }
KB k_wout(Params P, int l) { ph_wout(P, l, blockIdx.x, gridDim.x); }
KB k_router(Params P, int l) { ph_router(P, l, dyn_lds, blockIdx.x, gridDim.x); }
KB k_topk(Params P) { ph_topk(P, dyn_lds, blockIdx.x, gridDim.x); }
KB k_gu(Params P, int l) { ph_gu(P, l, blockIdx.x, gridDim.x); }
KB k_down(Params P, int l) { ph_down(P, l, blockIdx.x, gridDim.x); }
KB k_combine(Params P, int l) { ph_combine(P, l, blockIdx.x, gridDim.x); }
#endif

extern "C" void kernel_launch(void* const* d_in, const int* in_sizes, int n_in, void* d_out, int out_size, void* d_ws, size_t ws_size, hipStream_t stream) {
    (void)in_sizes; (void)n_in; (void)out_size;
    if (ws_size < WS_END) { fprintf(stderr, "workspace too small: %zu < %zu\n", ws_size, (size_t)WS_END); return; }
    Params P{};
    const float** pp = (const float**)&P;
    for (int i = 0; i < 26; ++i) pp[i] = (const float*)d_in[i];
    P.out = (float*)d_out; P.ws = (unsigned char*)d_ws;
#if MEGA
    static int grid = 0;
    if (!grid) {
        int dev = 0, cus = 0, per_cu = 0;
        (void)hipGetDevice(&dev);
        (void)hipDeviceGetAttribute(&cus, hipDeviceAttributeMultiprocessorCount, dev);
        (void)hipFuncSetAttribute((const void*)mega_fwd, hipFuncAttributeMaxDynamicSharedMemorySize, LDS_BYTES);
        (void)hipOccupancyMaxActiveBlocksPerMultiprocessor(&per_cu, (const void*)mega_fwd, kNT, LDS_BYTES);
        grid = (per_cu >= 1) ? cus : 0;
        if (!grid) fprintf(stderr, "mega_fwd does not fit a CU\n");
    }
    if (!grid) return;
    (void)hipMemsetAsync(P.ws + WS_CTL, 0, XCD_BAR_WORDS * sizeof(unsigned), stream);
    mega_fwd<<<grid, kNT, LDS_BYTES, stream>>>(P);
#else
    (void)hipFuncSetAttribute((const void*)k_router, hipFuncAttributeMaxDynamicSharedMemorySize, 65536);
    const int G = 1024;
    k_convert<<<G, kNT, 256 * 72 * 2, stream>>>(P);
    k_norm<<<G, kNT, 0, stream>>>(P);
    for (int l = 0; l < kL; ++l) {
        k_win<<<G, kNT, 0, stream>>>(P, l);
        k_dilated<<<G, kNT, 0, stream>>>(P, l);
        k_na<<<G, kNT, 0, stream>>>(P, l);
        k_s5<<<256, kNT, 8 * 128 * 4, stream>>>(P, l);
        k_s5fin<<<G, kNT, 0, stream>>>(P, l);
        k_glu<<<256, kNT, 0, stream>>>(P, l);
        k_mixnorm<<<G, kNT, 0, stream>>>(P, l);
        k_wout<<<G, kNT, 0, stream>>>(P, l);
        k_router<<<512, kNT, 65536, stream>>>(P, l);
        k_topk<<<128, kNT, 4096, stream>>>(P);
        k_gu<<<G, kNT, 0, stream>>>(P, l);
        k_down<<<G, kNT, 0, stream>>>(P, l);
        k_combine<<<G, kNT, 0, stream>>>(P, l);
    }
#endif
}
```

```cpp
#include <hip/hip_runtime.h>
#include <stdint.h>
#include <stdio.h>

#define DEVI __device__ __forceinline__
#define LAS __attribute__((address_space(3)))
typedef unsigned short bf16_t;
typedef short bf16x8 __attribute__((ext_vector_type(8)));
typedef float f32x4 __attribute__((ext_vector_type(4)));
typedef float f32x2 __attribute__((ext_vector_type(2)));
typedef unsigned u32x4 __attribute__((ext_vector_type(4)));
typedef unsigned u32x2 __attribute__((ext_vector_type(2)));

constexpr int kB = 8, kS = 8192, kD = 1024, kL = 4, kTok = kB * kS;
constexpr int kINW = 2560;
constexpr int kE = 16, kCap = 1024, kFF = 2048;
constexpr int kNT = 512;
constexpr float kEps = 1e-6f;

constexpr size_t MiB = 1024ull * 1024ull;
constexpr size_t WS_CTL   = 0;
constexpr size_t WS_WINT  = 1 * MiB;
constexpr size_t WS_WOUTT = WS_WINT + 20 * MiB;
constexpr size_t WS_WGLUT = WS_WOUTT + 8 * MiB;
constexpr size_t WS_WGUT  = WS_WGLUT + 1 * MiB;
constexpr size_t WS_WDT   = WS_WGUT + 512 * MiB;
constexpr size_t WS_H     = WS_WDT + 256 * MiB;
constexpr size_t WS_R1    = WS_H + 128 * MiB;
constexpr size_t WS_R2    = WS_R1 + 512 * MiB;
constexpr size_t WS_AFF   = WS_R2 + 256 * MiB;
constexpr size_t WS_IDX   = WS_AFF + 4 * MiB;
constexpr size_t WS_GATE  = WS_IDX + 1 * MiB;
constexpr size_t WS_TSLOT = WS_GATE + 1 * MiB;
constexpr size_t WS_LSE   = WS_TSLOT + 4 * MiB;
constexpr size_t WS_WST   = WS_LSE + 8 * MiB;
constexpr size_t WS_WSO   = WS_WST + 8 * MiB;
constexpr size_t WS_YS    = WS_WSO + 16 * MiB;
constexpr size_t WS_XB    = WS_YS;
constexpr size_t WS_END   = WS_YS + 128 * MiB;
constexpr size_t R2_Z     = 192 * MiB;
constexpr size_t R1_QA = 0, R1_KA = 64 * MiB, R1_VA = 128 * MiB, R1_QB = 192 * MiB, R1_KB = 224 * MiB, R1_VB = 256 * MiB,
                 R1_UX = 288 * MiB, R1_OB = 352 * MiB, R1_OC = 384 * MiB, R1_G = 416 * MiB;

struct Params {
    const float* x; const float* attn_norm; const float* w_in; const float* q_norm_a; const float* k_norm_a; const float* q_norm_b; const float* k_norm_b;
    const float* rpb; const float* s5_a_re; const float* s5_a_im; const float* s5_log_dt; const float* s5_b_re; const float* s5_b_im; const float* s5_c_re; const float* s5_c_im;
    const float* s5_d; const float* w_glu; const float* out_norm_a; const float* out_norm_b; const float* out_norm_c; const float* w_out; const float* ffn_norm;
    const float* w_router; const float* w_gate; const float* w_up; const float* w_down;
    float* out; unsigned char* ws;
};

DEVI float bf2f(bf16_t b) { return __uint_as_float(((unsigned)b) << 16); }
DEVI bf16_t f2bf(float f) { unsigned u = __float_as_uint(f); u += 0x7FFFu + ((u >> 16) & 1u); return (bf16_t)(u >> 16); }
typedef __bf16 bf16x2_t __attribute__((ext_vector_type(2)));
DEVI unsigned pk2(float lo, float hi) { const f32x2 v = {lo, hi}; return __builtin_bit_cast(unsigned, __builtin_convertvector(v, bf16x2_t)); }
DEVI int tidx() { int t = threadIdx.x; asm volatile("" : "+v"(t)); return t; }
#define GAS __attribute__((address_space(1)))
DEVI unsigned char* wsp(const Params& P) { unsigned long long a = (unsigned long long)P.ws; asm volatile("" : "+s"(a)); return (unsigned char*)(GAS unsigned char*)a; }
DEVI int lnd(int v) { asm volatile("" : "+s"(v)); return v; }
DEVI float wave_sum(float v) {
#pragma unroll
    for (int m = 32; m >= 1; m >>= 1) v += __shfl_xor(v, m);
    return v;
}
DEVI float frcp(float x) { return __builtin_amdgcn_rcpf(x); }
DEVI float gelu_tanh(float y) { const float z = 0.7978845608028654f * (y + 0.044715f * y * y * y); const float t = 1.f - 2.f * frcp(1.f + __expf(2.f * z)); return 0.5f * y * (1.f + t); }

#ifndef EMU_BF16_X
#define EMU_BF16_X 0
#endif
#ifndef EMU_FP8_WIN
#define EMU_FP8_WIN 0
#endif
#ifndef EMU_FP8_WOUT
#define EMU_FP8_WOUT 0
#endif
#ifndef EMU_FP8_GU
#define EMU_FP8_GU 0
#endif
#ifndef EMU_FP8_DN
#define EMU_FP8_DN 0
#endif
DEVI float q8(float x, float sc, float inv) {
    float y = x * sc; const float ay = fabsf(y);
    if (ay < 0.015625f) y = rintf(y * 512.f) * (1.f / 512.f);
    else { unsigned u = __float_as_uint(y); u += 0x7FFFFu + ((u >> 20) & 1u); u &= 0xFFF00000u; y = __uint_as_float(u); y = fminf(fmaxf(y, -448.f), 448.f); }
    return y * inv;
}
#ifndef FP8_GU
#define FP8_GU 1
#endif
#ifndef FP8_DN
#define FP8_DN 1
#endif
constexpr float kW8 = 64.f, kH8 = 8.f;
DEVI unsigned pk4_fp8(float a, float b, float c, float d) { unsigned w = 0u; w = __builtin_amdgcn_cvt_pk_fp8_f32(a, b, w, false); w = __builtin_amdgcn_cvt_pk_fp8_f32(c, d, w, true); return w; }
DEVI int cmap_head(int cs) { const int bj = cs >> 7, wc = (cs >> 5) & 3, n = (cs >> 4) & 1, fq = (cs >> 2) & 3, j = cs & 3; return 64 * wc + 32 * bj + 8 * fq + 4 * n + j; }
DEVI int cmap_pk(int cs)   { const int bj = cs >> 7, wc = (cs >> 5) & 3, n = (cs >> 4) & 1, fq = (cs >> 2) & 3, j = cs & 3; return 128 * bj + 32 * wc + 8 * fq + 4 * n + j; }
DEVI int cmap_gu(int cs)   { const int wc = (cs >> 5) & 3, n = (cs >> 4) & 1, fq = (cs >> 2) & 3, j = cs & 3; return 32 * wc + 8 * fq + 4 * n + j; }

template <int MODE, int QEMU = 0>
DEVI void convert_item(const float* W0, const float* W1, int ldw, int K, bf16_t* Bt, int kt, int pn, unsigned char* lds) {
    bf16_t* t = (bf16_t*)lds;
    const int tid = tidx();
#pragma unroll 4
    for (int it = 0; it < 32; ++it) {
        const int e = it * kNT + tid, k = e >> 8, cs = e & 255;
        float v;
        if (MODE == 0) v = W0[(size_t)(kt * 64 + k) * ldw + pn * 256 + cs];
        else if (MODE == 1) v = W0[(size_t)(kt * 64 + k) * ldw + pn * 256 + cmap_head(cs)];
        else if (MODE == 2) v = W0[(size_t)(kt * 64 + k) * ldw + pn * 256 + cmap_pk(cs)];
        else v = ((cs >> 7) ? W1 : W0)[(size_t)(kt * 64 + k) * ldw + pn * 128 + cmap_gu(cs)];
        if (QEMU) v = q8(v, 64.f, 1.f / 64.f);
        t[cs * 72 + k] = f2bf(v);
    }
    __syncthreads();
#pragma unroll
    for (int it = 0; it < 4; ++it) {
        const int c = it * kNT + tid, row = c >> 3, part = c & 7;
        const u32x4 v = *(const u32x4*)(t + row * 72 + part * 8);
        *(u32x4*)(Bt + (size_t)(pn * 256 + row) * K + kt * 64 + part * 8) = v;
    }
    __syncthreads();
}

template <int MODE>
DEVI void convert_item8(const float* W0, const float* W1, int ldw, int K, unsigned char* Bt, int kt, int pn, unsigned char* lds) {
    unsigned char* t = lds;
    const int tid = tidx();
#pragma unroll 4
    for (int it = 0; it < 64; ++it) {
        const int e = it * kNT + tid, k = e >> 8, cs = e & 255;
        float v;
        if (MODE == 2) v = W0[(size_t)(kt * 128 + k) * ldw + pn * 256 + cmap_pk(cs)];
        else v = ((cs >> 7) ? W1 : W0)[(size_t)(kt * 128 + k) * ldw + pn * 128 + cmap_gu(cs)];
        v *= kW8;
        t[cs * 144 + k] = (unsigned char)(__builtin_amdgcn_cvt_pk_fp8_f32(v, v, 0u, false) & 0xFFu);
    }
    __syncthreads();
#pragma unroll
    for (int it = 0; it < 4; ++it) {
        const int c = it * kNT + tid, row = c >> 3, part = c & 7;
        const u32x4 v = *(const u32x4*)(t + row * 144 + part * 16);
        *(u32x4*)(Bt + (size_t)(pn * 256 + row) * K + kt * 128 + part * 16) = v;
    }
    __syncthreads();
}

DEVI void phase_convert(const Params& P, unsigned char* lds, int bid, int nblk) {
    constexpr int N_WIN = kL * 16 * 10, N_WOUT = kL * 16 * 4, N_WGLU = kL * 4 * 1, N_WGU = kL * kE * (FP8_GU ? 8 : 16) * 16, N_WD = kL * kE * (FP8_DN ? 16 : 32) * 4;
    constexpr int TOT = N_WIN + N_WOUT + N_WGLU + N_WGU + N_WD;
    for (int it = bid; it < TOT; it += nblk) {
        int i = it;
        if (i < N_WIN) { const int l = i / 160, r = i % 160, kt = r / 10, pn = r % 10;
            convert_item<1, EMU_FP8_WIN>(P.w_in + (size_t)l * kD * kINW, nullptr, kINW, kD, (bf16_t*)(wsp(P) + WS_WINT) + (size_t)l * kINW * kD, kt, pn, lds); continue; }
        i -= N_WIN;
        if (i < N_WOUT) { const int l = i / 64, r = i % 64, kt = r / 4, pn = r % 4;
            convert_item<2, EMU_FP8_WOUT>(P.w_out + (size_t)l * kD * kD, nullptr, kD, kD, (bf16_t*)(wsp(P) + WS_WOUTT) + (size_t)l * kD * kD, kt, pn, lds); continue; }
        i -= N_WOUT;
        if (i < N_WGLU) { const int l = i / 4, kt = i % 4;
            convert_item<2>(P.w_glu + (size_t)l * 256 * 256, nullptr, 256, 256, (bf16_t*)(wsp(P) + WS_WGLUT) + (size_t)l * 256 * 256, kt, 0, lds); continue; }
        i -= N_WGLU;
#if FP8_GU
        if (i < N_WGU) { const int le = i / 128, r = i % 128, kt = r / 16, pn = r % 16;
            convert_item8<3>(P.w_gate + (size_t)le * kD * kFF, P.w_up + (size_t)le * kD * kFF, kFF, kD, wsp(P) + WS_WGUT + (size_t)le * 4096 * kD, kt, pn, lds); continue; }
#else
        if (i < N_WGU) { const int le = i / 256, r = i % 256, kt = r / 16, pn = r % 16;
            convert_item<3, EMU_FP8_GU>(P.w_gate + (size_t)le * kD * kFF, P.w_up + (size_t)le * kD * kFF, kFF, kD, (bf16_t*)(wsp(P) + WS_WGUT) + (size_t)le * 4096 * kD, kt, pn, lds); continue; }
#endif
        i -= N_WGU;
#if FP8_DN
        { const int le = i / 64, r = i % 64, kt = r / 4, pn = r % 4;
            convert_item8<2>(P.w_down + (size_t)le * kFF * kD, nullptr, kD, kFF, wsp(P) + WS_WDT + (size_t)le * kD * kFF, kt, pn, lds); }
#else
        { const int le = i / 128, r = i % 128, kt = r / 4, pn = r % 4;
            convert_item<2, EMU_FP8_DN>(P.w_down + (size_t)le * kFF * kD, nullptr, kD, kFF, (bf16_t*)(wsp(P) + WS_WDT) + (size_t)le * kD * kFF, kt, pn, lds); }
#endif
    }
}

DEVI void phase_norm(const float* x, const float* gain, bf16_t* h, int bid, int nblk) {
    const int wid = tidx() >> 6, lane = tidx() & 63;
    f32x4 g[4];
#pragma unroll
    for (int q = 0; q < 4; ++q) g[q] = *(const f32x4*)(gain + q * 256 + lane * 4);
    for (int row = bid * 8 + wid; row < kTok; row += nblk * 8) {
        f32x4 v[4]; float ss = 0.f;
#pragma unroll
        for (int q = 0; q < 4; ++q) { v[q] = *(const f32x4*)(x + (size_t)row * kD + q * 256 + lane * 4); ss += v[q].x * v[q].x + v[q].y * v[q].y + v[q].z * v[q].z + v[q].w * v[q].w; }
        ss = wave_sum(ss);
        const float rstd = rsqrtf(ss * (1.f / kD) + kEps);
#pragma unroll
        for (int q = 0; q < 4; ++q) { f32x4 t = v[q] * rstd * g[q]; if (EMU_FP8_WIN) { t.x = q8(t.x, 1.f, 1.f); t.y = q8(t.y, 1.f, 1.f); t.z = q8(t.z, 1.f, 1.f); t.w = q8(t.w, 1.f, 1.f); }
            u32x2 o; o.x = pk2(t.x, t.y); o.y = pk2(t.z, t.w);
            *(u32x2*)(h + (size_t)row * kD + q * 256 + lane * 4) = o; }
    }
}

DEVI void phase_router(const bf16_t* x, const float* gain, const float* wr  , bf16_t* h, float* aff, unsigned char* lds, int bid, int nblk) {
    float* wT = (float*)lds;
    for (int i = tidx(); i < 16 * 1024; i += kNT) { const int k = i >> 4, e = i & 15; wT[e * 1024 + k] = wr[i]; }
    __syncthreads();
    const int wid = tidx() >> 6, lane = tidx() & 63;
    f32x4 g[4];
#pragma unroll
    for (int q = 0; q < 4; ++q) g[q] = *(const f32x4*)(gain + q * 256 + lane * 4);
    u32x2 nvx[2][4];
    { const int r0 = (bid * 8 + wid) * 2;
      if (r0 < kTok) {
#pragma unroll
        for (int r = 0; r < 2; ++r)
#pragma unroll
            for (int q = 0; q < 4; ++q) nvx[r][q] = *(const u32x2*)(x + (size_t)(r0 + r) * kD + q * 256 + lane * 4); } }
    for (int row0 = (bid * 8 + wid) * 2; row0 < kTok; row0 += nblk * 8 * 2) {
        asm volatile("" ::: "memory");
        f32x4 v[2][4];
#pragma unroll
        for (int r = 0; r < 2; ++r)
#pragma unroll
            for (int q = 0; q < 4; ++q) { const u32x2 w = nvx[r][q]; v[r][q] = (f32x4){__uint_as_float(w.x << 16), __uint_as_float(w.x & 0xFFFF0000u), __uint_as_float(w.y << 16), __uint_as_float(w.y & 0xFFFF0000u)}; }
        { const int nr0 = row0 + nblk * 8 * 2;
          if (nr0 < kTok) {
#pragma unroll
            for (int r = 0; r < 2; ++r)
#pragma unroll
                for (int q = 0; q < 4; ++q) nvx[r][q] = *(const u32x2*)(x + (size_t)(nr0 + r) * kD + q * 256 + lane * 4); } }
#pragma unroll
        for (int r = 0; r < 2; ++r) { float ss = 0.f;
#pragma unroll
            for (int q = 0; q < 4; ++q) { ss += v[r][q].x * v[r][q].x + v[r][q].y * v[r][q].y + v[r][q].z * v[r][q].z + v[r][q].w * v[r][q].w; }
            ss = wave_sum(ss); const float rstd = rsqrtf(ss * (1.f / kD) + kEps);
#pragma unroll
            for (int q = 0; q < 4; ++q) { v[r][q] = v[r][q] * rstd * g[q];
#if FP8_GU
                *(unsigned*)((unsigned char*)h + (size_t)(row0 + r) * kD + q * 256 + lane * 4) = pk4_fp8(v[r][q].x, v[r][q].y, v[r][q].z, v[r][q].w); }
#else
                u32x2 o;
                if (EMU_FP8_GU) { o.x = pk2(q8(v[r][q].x, 1.f, 1.f), q8(v[r][q].y, 1.f, 1.f)); o.y = pk2(q8(v[r][q].z, 1.f, 1.f), q8(v[r][q].w, 1.f, 1.f)); }
                else { o.x = pk2(v[r][q].x, v[r][q].y); o.y = pk2(v[r][q].z, v[r][q].w); }
                *(u32x2*)(h + (size_t)(row0 + r) * kD + q * 256 + lane * 4) = o; }
#endif
        }
        float pa[32];
#pragma unroll
        for (int e = 0; e < 16; ++e) {
            float s0 = 0.f, s1 = 0.f;
#pragma unroll
            for (int q = 0; q < 4; ++q) { const f32x4 w = *(const f32x4*)(wT + e * 1024 + q * 256 + lane * 4);
                s0 += v[0][q].x * w.x + v[0][q].y * w.y + v[0][q].z * w.z + v[0][q].w * w.w;
                s1 += v[1][q].x * w.x + v[1][q].y * w.y + v[1][q].z * w.z + v[1][q].w * w.w; }
            pa[e] = s0; pa[16 + e] = s1;
        }
#define RS_STEP(HALF, MASK) { const bool up = (lane & (MASK)) != 0; _Pragma("unroll") for (int i = 0; i < (HALF); ++i) { const float keep = up ? pa[i + (HALF)] : pa[i], send = up ? pa[i] : pa[i + (HALF)]; pa[i] = keep + __shfl_xor(send, (MASK)); } }
        RS_STEP(16, 32) RS_STEP(8, 16) RS_STEP(4, 8) RS_STEP(2, 4) RS_STEP(1, 2)
#undef RS_STEP
        const float logit = pa[0] + __shfl_xor(pa[0], 1);
        float mx = logit;
#pragma unroll
        for (int m = 16; m >= 2; m >>= 1) mx = fmaxf(mx, __shfl_xor(mx, m));
        const float ex = __expf(logit - mx);
        float sm = ex;
#pragma unroll
        for (int m = 16; m >= 2; m >>= 1) sm += __shfl_xor(sm, m);
        const int row = row0 + (lane >> 5), e = (lane >> 1) & 15, b = row >> 13, s = row & (kS - 1);
        if (!(lane & 1)) aff[((size_t)(b * kE + e)) * kS + s] = ex * frcp(sm);
    }
    __syncthreads();
}

DEVI int block_excl_scan(int v, int* sh  , int& total) {
    const int lane = tidx() & 63, wid = tidx() >> 6;
    int incl = v;
#pragma unroll
    for (int d = 1; d < 64; d <<= 1) { const int o = __shfl_up(incl, d); if (lane >= d) incl += o; }
    __syncthreads();
    if (lane == 63) sh[wid] = incl;
    __syncthreads();
    int base = 0, tot = 0;
#pragma unroll
    for (int w = 0; w < 8; ++w) { const int c = sh[w]; if (w < wid) base += c; tot += c; }
    total = tot;
    return base + incl - v;
}

DEVI void phase_topk(const float* aff, int* idx, float* gate, int* tokslot, const unsigned char* hsrc, unsigned char* xe, int rowbytes, unsigned char* lds, int bid, int nblk) {
    int* hist = (int*)lds;
    int* sh = hist + 256;
    int* res = sh + 16;
    int* lsel = res + 16;
    const int tid = tidx(), lane = tid & 63, wid = tid >> 6;
    for (int item = bid; item < kB * kE; item += nblk) {
        const int b = item >> 4, e = item & 15;
        const float* a = aff + (size_t)item * kS;
        unsigned key[16];
#pragma unroll
        for (int q = 0; q < 4; ++q) { const u32x4 v = *(const u32x4*)(a + tid * 16 + q * 4); key[q * 4 + 0] = v.x; key[q * 4 + 1] = v.y; key[q * 4 + 2] = v.z; key[q * 4 + 3] = v.w; }
        unsigned prefix = 0; int kk = kCap;
#pragma unroll 1
        for (int pass = 0; pass < 4; ++pass) {
            const int shift = 24 - 8 * pass;
            __syncthreads();
            if (tid < 256) hist[tid] = 0;
            __syncthreads();
#pragma unroll
            for (int i = 0; i < 16; ++i) { const bool in = (pass == 0) || ((key[i] >> (shift + 8)) == prefix); if (in) atomicAdd(&hist[(key[i] >> shift) & 255], 1); }
            __syncthreads();
            if (wid == 0) {
                int c[4], loc = 0;
#pragma unroll
                for (int j = 0; j < 4; ++j) { c[j] = hist[255 - 4 * lane - j]; loc += c[j]; }
                int incl = loc;
#pragma unroll
                for (int d = 1; d < 64; d <<= 1) { const int o = __shfl_up(incl, d); if (lane >= d) incl += o; }
                const int excl = incl - loc;
                if (excl < kk && kk <= incl) { int run = excl; int bin = 0, nk = 0; bool found = false;
#pragma unroll
                    for (int j = 0; j < 4; ++j) { if (!found && run + c[j] >= kk) { bin = 255 - 4 * lane - j; nk = kk - run; found = true; } if (!found) run += c[j]; }
                    res[0] = bin; res[1] = nk; }
            }
            __syncthreads();
            prefix = (prefix << 8) | (unsigned)res[0]; kk = res[1];
        }
        const unsigned T = prefix;
        int ceq = 0;
#pragma unroll
        for (int i = 0; i < 16; ++i) ceq += (key[i] == T) ? 1 : 0;
        int tot;
        int eqb = block_excl_scan(ceq, sh, tot);
        int csel = 0; unsigned selmask = 0;
#pragma unroll
        for (int i = 0; i < 16; ++i) { bool s = key[i] > T; if (key[i] == T) { s = eqb < kk; ++eqb; } if (s) { selmask |= 1u << i; ++csel; } }
        int slot = block_excl_scan(csel, sh, tot);
        const size_t rbase = (size_t)(e * kB + b) * kCap;
#pragma unroll
        for (int i = 0; i < 16; ++i) { const int s = tid * 16 + i; const bool sel = (selmask >> i) & 1u;
            if (sel) { idx[rbase + slot] = b * kS + s; gate[rbase + slot] = __uint_as_float(key[i]); lsel[slot] = b * kS + s; }
            tokslot[((size_t)(b * kS + s)) * kE + e] = sel ? slot : -1;
            if (sel) ++slot; }
        __syncthreads();
        { const int cpr = rowbytes >> 4;
          for (int c0 = tid; c0 < kCap * cpr; c0 += kNT * 4) {
              u32x4 v[4];
#pragma unroll
              for (int j = 0; j < 4; ++j) { const int c = c0 + j * kNT; const int r = c / cpr, ch = c - r * cpr; v[j] = *(const u32x4*)(hsrc + (size_t)lsel[r] * rowbytes + ch * 16); }
#pragma unroll
              for (int j = 0; j < 4; ++j) { const int c = c0 + j * kNT; const int r = c / cpr, ch = c - r * cpr; *(u32x4*)(xe + (rbase + r) * rowbytes + ch * 16) = v[j]; }
          } }
    }
    __syncthreads();
}

struct Unit { int pm, pn; };
DEVI bool unit_of(int Lid, int nM, int nN, Unit& u) {
    const int nwg = nM * nN; if (Lid >= nwg) return false;
    int wgid = Lid; { const int q = nwg / 8, r = nwg % 8, xcd = wgid % 8, off = wgid / 8; wgid = (xcd < r ? xcd * (q + 1) : r * (q + 1) + (xcd - r) * q) + off; }
    const int nig = 8 * nN, gid = wgid / nig, fm = gid * 8, gsz = (nM - fm) < 8 ? (nM - fm) : 8;
    u.pm = fm + ((wgid % nig) % gsz); u.pn = (wgid % nig) / gsz; return true;
}
struct GemmD { const bf16_t* A; const bf16_t* Bt; int lda, K, nM, nN; const int* rowidx; size_t bstride; int pmg; };

template <class Epi>
DEVI void gemm_simple(const GemmD g, const Epi& E, int bid, int nblk) {
    const int tid = tidx(), wid = tid >> 6, lane = tid & 63, wr = wid >> 2, wc = wid & 3, fr = lane & 15, fq = lane >> 4;
    for (int i = 0;; ++i) {
        Unit u; if (!unit_of(i * nblk + bid, g.nM, g.nN, u)) break;
        f32x4 acc[2][2][4][2];
#pragma unroll
        for (int a = 0; a < 2; ++a)
#pragma unroll
            for (int b = 0; b < 2; ++b)
#pragma unroll
                for (int m = 0; m < 4; ++m)
#pragma unroll
                    for (int n = 0; n < 2; ++n) acc[a][b][m][n] = (f32x4){0.f, 0.f, 0.f, 0.f};
        const bf16_t* Bu = g.Bt + (size_t)(u.pm / g.pmg) * g.bstride + (size_t)u.pn * 256 * g.K;
        unsigned ao[2][4], bo[2][2];
#pragma unroll
        for (int a = 0; a < 2; ++a)
#pragma unroll
            for (int m = 0; m < 4; ++m) { const int r = u.pm * 256 + 128 * a + 64 * wr + 16 * m + fr; const unsigned rr = g.rowidx ? (unsigned)g.rowidx[r] : (unsigned)r; ao[a][m] = rr * (unsigned)g.lda + 8u * fq; }
#pragma unroll
        for (int b = 0; b < 2; ++b)
#pragma unroll
            for (int n = 0; n < 2; ++n) bo[b][n] = (unsigned)(128 * b + 32 * wc + 16 * n + fr) * (unsigned)g.K + 8u * fq;
#pragma unroll 1
        for (int k0 = 0; k0 < g.K; k0 += 32) {
            bf16x8 av[2][4], bv[2][2];
#pragma unroll
            for (int a = 0; a < 2; ++a)
#pragma unroll
                for (int m = 0; m < 4; ++m) av[a][m] = *(const bf16x8*)(g.A + ao[a][m] + k0);
#pragma unroll
            for (int b = 0; b < 2; ++b)
#pragma unroll
                for (int n = 0; n < 2; ++n) bv[b][n] = *(const bf16x8*)(Bu + bo[b][n] + k0);
#pragma unroll
            for (int a = 0; a < 2; ++a)
#pragma unroll
                for (int b = 0; b < 2; ++b)
#pragma unroll
                    for (int m = 0; m < 4; ++m)
#pragma unroll
                        for (int n = 0; n < 2; ++n) acc[a][b][m][n] = __builtin_amdgcn_mfma_f32_16x16x32_bf16(bv[b][n], av[a][m], acc[a][b][m][n], 0, 0, 0);
        }
        E(acc, u, wr, wc, fr, fq);
    }
}


constexpr int PG_HTB = 128 * 64 * 2;
DEVI int pg_lds_byte(int r, int c) { const int st = (r >> 4) * 2 + (c >> 5), rr = r & 15, cc = c & 31, ob = rr * 64 + cc * 2; return st * 1024 + (ob ^ (((ob >> 9) & 1) << 5)); }
DEVI void pg_stage_rc(int b, int& R, int& C) { const int st = b / 1024, sb = b % 1024, swz = sb ^ (((sb >> 9) & 1) << 5); R = (st >> 1) * 16 + swz / 64; C = (st & 1) * 32 + (swz % 64) / 2; }

typedef int v4i __attribute__((ext_vector_type(4)));
typedef int v8i __attribute__((ext_vector_type(8)));
template <class Epi, bool ALIGN_EPI, bool SP2, bool FP8 = false>
DEVI void gemm_engine(LAS unsigned char* lds, const GemmD g, const Epi& E, int bid, int nblk) {
    const int tid = tidx(), wid = __builtin_amdgcn_readfirstlane(tid >> 6), lane = tid & 63, wr = wid >> 2, wc = wid & 3, fr = lane & 15, fq = lane >> 4;
    constexpr int ES = FP8 ? 1 : 2;
    const int K = g.K * ES  , nt = K / 128; const unsigned ldaB = (unsigned)g.lda * ES;
    unsigned voffA[2], voffB[2];
#pragma unroll
    for (int i = 0; i < 2; ++i) { int R, C; pg_stage_rc(tid * 16 + i * 8192, R, C); voffA[i] = (unsigned)R * ldaB + (unsigned)C * 2u; voffB[i] = (unsigned)(R * K + C * 2); }
    const size_t kstep = 128;
    const size_t hstepB = (size_t)128 * K, hstepA = (size_t)128 * ldaB, tstepA = 2 * hstepA;
    const unsigned ldsw = (unsigned)wid * 1024u;
    const int aoff = pg_lds_byte(wr * 64 + fr, fq * 8), boff = pg_lds_byte(wc * 32 + fr, fq * 8);
#define PG8_SA(b, h) (((b) * 2 + (h)) * PG_HTB)
#define PG8_SB(b, h) ((4 + (b) * 2 + (h)) * PG_HTB)
#define PG8_STAGE(bufoff, gbase, voff) do { _Pragma("unroll") for (int _i = 0; _i < 2; ++_i) \
        __builtin_amdgcn_global_load_lds((const unsigned*)((const char*)(gbase) + (voff)[_i]), (LAS unsigned*)(lds + (bufoff) + ldsw + _i * 8192), 16, 0, 0); } while (0)
#define PG8_RD16(off) (*(const LAS v4i*)(lds + (off)))
#define PG8_CAT2(off) __builtin_shufflevector(PG8_RD16(off), PG8_RD16((off) + 1024), 0, 1, 2, 3, 4, 5, 6, 7)
#define PG8_LDA(dst, b, h) do { _Pragma("unroll") for (int m = 0; m < 4; ++m) { if constexpr (FP8) dst##8[m] = PG8_CAT2(PG8_SA(b, h) + aoff + m * 2048); \
        else { _Pragma("unroll") for (int k = 0; k < 2; ++k) dst[m][k] = *(const LAS bf16x8*)(lds + PG8_SA(b, h) + aoff + m * 2048 + k * 1024); } } } while (0)
#define PG8_LDB(dst, b, h) do { _Pragma("unroll") for (int n = 0; n < 2; ++n) { if constexpr (FP8) dst##8[n] = PG8_CAT2(PG8_SB(b, h) + boff + n * 2048); \
        else { _Pragma("unroll") for (int k = 0; k < 2; ++k) dst[n][k] = *(const LAS bf16x8*)(lds + PG8_SB(b, h) + boff + n * 2048 + k * 1024); } } } while (0)
#define PG8_MMA(ai, bj, At, Bt) do { __builtin_amdgcn_s_setprio(1); _Pragma("unroll") for (int m = 0; m < 4; ++m) _Pragma("unroll") for (int n = 0; n < 2; ++n) { \
        if constexpr (FP8) asm volatile("v_mfma_f32_16x16x128_f8f6f4 %0, %1, %2, %0" : "+v"(acc[ai][bj][m][n]) : "v"(Bt##8[n]), "v"(At##8[m]));   \
        else { _Pragma("unroll") for (int k = 0; k < 2; ++k) acc[ai][bj][m][n] = __builtin_amdgcn_mfma_f32_16x16x32_bf16(Bt[n][k], At[m][k], acc[ai][bj][m][n], 0, 0, 0); } } \
        __builtin_amdgcn_s_setprio(0); } while (0)
#define PG8_WAIT_V(n) asm volatile("s_waitcnt vmcnt(" #n ")" ::: "memory")
#define PG8_WAIT_L(n) asm volatile("s_waitcnt lgkmcnt(" #n ")" ::: "memory")
#define PG8_BAR __builtin_amdgcn_s_barrier()
#define PG8_SCHED __builtin_amdgcn_sched_barrier(0)
    Unit cur, nxt; int ui = 0;
    if (!unit_of(bid, g.nM, g.nN, cur)) return;
    f32x4 acc[2][2][4][2];
#pragma unroll
    for (int a = 0; a < 2; ++a)
#pragma unroll
        for (int b = 0; b < 2; ++b)
#pragma unroll
            for (int m = 0; m < 4; ++m)
#pragma unroll
                for (int n = 0; n < 2; ++n) acc[a][b][m][n] = (f32x4){0.f, 0.f, 0.f, 0.f};
    bf16x8 At[4][2], B0[2][2], B1[2][2]; v8i At8[4], B08[2], B18[2];
    (void)At; (void)B0; (void)B1; (void)At8; (void)B08; (void)B18;
    static_assert(SP2, "only the two-super-phase K-loop is kept");
    const char* cA = (const char*)g.A + (size_t)cur.pm * tstepA;
    const char* cB = (const char*)g.Bt + (size_t)(cur.pm / g.pmg) * g.bstride * ES + (size_t)cur.pn * 256 * K;
    PG8_STAGE(PG8_SB(0, 0), cB, voffB); PG8_STAGE(PG8_SB(0, 1), cB + hstepB, voffB); PG8_STAGE(PG8_SA(0, 0), cA, voffA); PG8_STAGE(PG8_SA(0, 1), cA + hstepA, voffA);
    if (wr == 1) PG8_BAR;
    PG8_WAIT_V(2); PG8_BAR;
    PG8_STAGE(PG8_SB(1, 0), cB + kstep, voffB); PG8_STAGE(PG8_SA(1, 0), cA + kstep, voffA); PG8_STAGE(PG8_SB(1, 1), cB + hstepB + kstep, voffB);
    PG8_WAIT_V(6); PG8_BAR;
    for (;;) {
        const bool has_next = unit_of((ui + 1) * nblk + bid, g.nM, g.nN, nxt);
        const char* nA = has_next ? (const char*)g.A + (size_t)nxt.pm * tstepA : cA;
        const char* nB = has_next ? (const char*)g.Bt + (size_t)(nxt.pm / g.pmg) * g.bstride * ES + (size_t)nxt.pn * 256 * K : cB;
#pragma unroll 1
        for (int t = 0; t < nt; t += 2) {
            const bool last = (t == nt - 2);
            const char* a1 = cA + (size_t)(t + 1) * kstep;
            const char* a2 = last ? nA : cA + (size_t)(t + 2) * kstep; const char* b2 = last ? nB : cB + (size_t)(t + 2) * kstep;
            const char* a3 = a2 + kstep; const char* b3 = b2 + kstep;
            PG8_LDB(B0, 0, 0); PG8_LDB(B1, 0, 1); PG8_SCHED; PG8_LDA(At, 0, 0); PG8_STAGE(PG8_SA(1, 1), a1 + hstepA, voffA);
            PG8_WAIT_V(8); PG8_WAIT_L(0); PG8_BAR; PG8_MMA(0, 0, At, B0); PG8_MMA(0, 1, At, B1); PG8_BAR; PG8_SCHED;
            PG8_LDA(At, 0, 1); PG8_STAGE(PG8_SB(0, 0), b2, voffB); PG8_STAGE(PG8_SB(0, 1), b2 + hstepB, voffB); PG8_STAGE(PG8_SA(0, 0), a2, voffA);
            PG8_WAIT_V(8); PG8_WAIT_L(0); PG8_BAR; PG8_MMA(1, 0, At, B0); PG8_MMA(1, 1, At, B1); PG8_BAR; PG8_SCHED;
            PG8_LDB(B0, 1, 0); PG8_LDB(B1, 1, 1); PG8_SCHED; PG8_LDA(At, 1, 0); PG8_STAGE(PG8_SA(0, 1), a2 + hstepA, voffA);
            PG8_WAIT_V(8); PG8_WAIT_L(0); PG8_BAR; PG8_MMA(0, 0, At, B0); PG8_MMA(0, 1, At, B1); PG8_BAR; PG8_SCHED;
            PG8_LDA(At, 1, 1); PG8_STAGE(PG8_SB(1, 0), b3, voffB); PG8_STAGE(PG8_SB(1, 1), b3 + hstepB, voffB); PG8_STAGE(PG8_SA(1, 0), a3, voffA);
            PG8_WAIT_V(8); PG8_WAIT_L(0); PG8_BAR; PG8_MMA(1, 0, At, B0); PG8_MMA(1, 1, At, B1); PG8_BAR; PG8_SCHED;
        }
        if constexpr (ALIGN_EPI) { if (wr == 0) PG8_BAR; }
        if constexpr (FP8) asm volatile("s_nop 15\n\ts_nop 15" ::: "memory");
        E(acc, cur, wr, wc, fr, fq);
        if (!has_next) break;
#pragma unroll
        for (int a = 0; a < 2; ++a)
#pragma unroll
            for (int b = 0; b < 2; ++b)
#pragma unroll
                for (int m = 0; m < 4; ++m)
#pragma unroll
                    for (int n = 0; n < 2; ++n) acc[a][b][m][n] = (f32x4){0.f, 0.f, 0.f, 0.f};
        cur = nxt; cA = nA; cB = nB; ++ui;
        if constexpr (ALIGN_EPI) { if (wr == 1) PG8_BAR; }
    }
    PG8_WAIT_V(0);
    if constexpr (!ALIGN_EPI) { if (wr == 0) PG8_BAR; }
    PG8_BAR;
#undef PG8_SA
#undef PG8_SB
#undef PG8_STAGE
#undef PG8_LDA
#undef PG8_LDB
#undef PG8_MMA
#undef PG8_RD16
#undef PG8_CAT2
#undef PG8_WAIT_V
#undef PG8_WAIT_L
#undef PG8_BAR
#undef PG8_SCHED
}

struct EpiQKV {
    static constexpr int VMOPS = 16;
    bf16_t *qa, *ka, *va, *qb, *kb, *vb, *ux; const float *qna, *kna, *qnb, *knb;
    DEVI void operator()(const f32x4 (&acc)[2][2][4][2], const Unit& u, int wr, int wc, int fr, int fq) const {
        bf16_t* dst; const float* gn = nullptr; int H = 8, head0 = 0; const int pn = u.pn;
        if (pn < 2) { dst = qa; gn = qna; head0 = pn * 4; }
        else if (pn < 4) { dst = ka; gn = kna; head0 = (pn - 2) * 4; }
        else if (pn < 6) { dst = va; head0 = (pn - 4) * 4; }
        else if (pn == 6) { dst = qb; gn = qnb; H = 4; }
        else if (pn == 7) { dst = kb; gn = knb; H = 4; }
        else if (pn == 8) { dst = vb; H = 4; }
        else { dst = ux; }
        const int head = head0 + wc;
        f32x4 gv[2][2];
#pragma unroll
        for (int bj = 0; bj < 2; ++bj)
#pragma unroll
            for (int n = 0; n < 2; ++n) gv[bj][n] = gn ? *(const f32x4*)(gn + 32 * bj + 8 * fq + 4 * n) : (f32x4){1.f, 1.f, 1.f, 1.f};
#pragma unroll
        for (int ai = 0; ai < 2; ++ai)
#pragma unroll
            for (int m = 0; m < 4; ++m) {
                const int row = u.pm * 256 + 128 * ai + 64 * wr + 16 * m + fr;
                float rstd = 1.f;
                if (gn) { float ss = 0.f;
#pragma unroll
                    for (int bj = 0; bj < 2; ++bj)
#pragma unroll
                        for (int n = 0; n < 2; ++n) { const f32x4 v = acc[ai][bj][m][n]; ss += v.x * v.x + v.y * v.y + v.z * v.z + v.w * v.w; }
                    ss += __shfl_xor(ss, 16); ss += __shfl_xor(ss, 32);
                    rstd = rsqrtf(ss * (1.f / 64.f) + kEps); }
#pragma unroll
                for (int bj = 0; bj < 2; ++bj) {
                    const f32x4 v0 = acc[ai][bj][m][0] * rstd * gv[bj][0], v1 = acc[ai][bj][m][1] * rstd * gv[bj][1];
                    u32x4 w; w.x = pk2(v0.x, v0.y); w.y = pk2(v0.z, v0.w); w.z = pk2(v1.x, v1.y); w.w = pk2(v1.z, v1.w);
                    if (pn < 9) { const int b = row >> 13, s = row & (kS - 1);
                        *(u32x4*)(dst + (((size_t)(b * H + head)) * kS + s) * 64 + 32 * bj + 8 * fq) = w; }
                    else { const int gidx = 4 * wc + 2 * bj + (fq >> 1), c0 = 8 * (fq & 1);
                        *(u32x4*)(dst + ((size_t)gidx * 4096 + (row >> 4)) * 512 + (row & 15) * 16 + c0) = w; }
                }
            }
    }
};
struct EpiResid {
    static constexpr int VMOPS = 16;
    const float* x32; bf16_t* xb;
    DEVI void operator()(const f32x4 (&acc)[2][2][4][2], const Unit& u, int wr, int wc, int fr, int fq) const {
#pragma unroll
        for (int ai = 0; ai < 2; ++ai)
#pragma unroll
            for (int m = 0; m < 4; ++m) { const size_t ro = (size_t)(u.pm * 256 + 128 * ai + 64 * wr + 16 * m + fr) * kD + u.pn * 256 + 32 * wc + 8 * fq;
#pragma unroll
                for (int bj = 0; bj < 2; ++bj) { const size_t o = ro + 128 * bj; f32x4 v0, v1;
                    if (x32) { v0 = *(const f32x4*)(x32 + o); v1 = *(const f32x4*)(x32 + o + 4); }
                    else { const u32x4 w = *(const u32x4*)(xb + o); v0 = (f32x4){__uint_as_float(w.x << 16), __uint_as_float(w.x & 0xFFFF0000u), __uint_as_float(w.y << 16), __uint_as_float(w.y & 0xFFFF0000u)};
                        v1 = (f32x4){__uint_as_float(w.z << 16), __uint_as_float(w.z & 0xFFFF0000u), __uint_as_float(w.w << 16), __uint_as_float(w.w & 0xFFFF0000u)}; }
                    v0 += acc[ai][bj][m][0]; v1 += acc[ai][bj][m][1];
                    u32x4 r; r.x = pk2(v0.x, v0.y); r.y = pk2(v0.z, v0.w); r.z = pk2(v1.x, v1.y); r.w = pk2(v1.z, v1.w);
                    *(u32x4*)(xb + o) = r; } }
    }
};
struct EpiGU {
    static constexpr int VMOPS = 8;
    bf16_t* hid; float sc;
    DEVI void operator()(const f32x4 (&acc)[2][2][4][2], const Unit& u, int wr, int wc, int fr, int fq) const {
#pragma unroll
        for (int ai = 0; ai < 2; ++ai)
#pragma unroll
            for (int m = 0; m < 4; ++m) { const size_t row = (size_t)(u.pm * 256 + 128 * ai + 64 * wr + 16 * m + fr);
                float o[8];
#pragma unroll
                for (int n = 0; n < 2; ++n)
#pragma unroll
                    for (int j = 0; j < 4; ++j) { const float gt = acc[ai][0][m][n][j] * sc, up = acc[ai][1][m][n][j] * sc; o[n * 4 + j] = gt * frcp(1.f + __expf(-gt)) * up; if (EMU_FP8_DN) o[n * 4 + j] = q8(o[n * 4 + j], 8.f, 0.125f); }
#if FP8_DN
                u32x2 w;
#pragma unroll
                for (int t = 0; t < 8; ++t) o[t] = fminf(fmaxf(o[t] * kH8, -448.f), 448.f);
                w.x = pk4_fp8(o[0], o[1], o[2], o[3]); w.y = pk4_fp8(o[4], o[5], o[6], o[7]);
                *(u32x2*)((unsigned char*)hid + row * kFF + u.pn * 128 + 32 * wc + 8 * fq) = w;
#else
                u32x4 w; w.x = pk2(o[0], o[1]); w.y = pk2(o[2], o[3]); w.z = pk2(o[4], o[5]); w.w = pk2(o[6], o[7]);
                *(u32x4*)(hid + row * kFF + u.pn * 128 + 32 * wc + 8 * fq) = w;
#endif
            }
    }
};
struct EpiDry {
    static constexpr int VMOPS = 0;
    float* sink;
    DEVI void operator()(const f32x4 (&acc)[2][2][4][2], const Unit& u, int wr, int wc, int fr, int fq) const {
        float t = 0.f;
#pragma unroll
        for (int ai = 0; ai < 2; ++ai)
#pragma unroll
            for (int bj = 0; bj < 2; ++bj)
#pragma unroll
                for (int m = 0; m < 4; ++m)
#pragma unroll
                    for (int n = 0; n < 2; ++n) t += acc[ai][bj][m][n].x + acc[ai][bj][m][n].y + acc[ai][bj][m][n].z + acc[ai][bj][m][n].w;
        if (t == 1.2345e30f) sink[0] = t;
    }
};
struct EpiDown {
    static constexpr int VMOPS = 16;
    bf16_t* y; const float* gate; float sc;
    DEVI void operator()(const f32x4 (&acc)[2][2][4][2], const Unit& u, int wr, int wc, int fr, int fq) const {
#pragma unroll
        for (int ai = 0; ai < 2; ++ai)
#pragma unroll
            for (int m = 0; m < 4; ++m) { const size_t row = (size_t)(u.pm * 256 + 128 * ai + 64 * wr + 16 * m + fr); const float gv = gate[row] * sc;
#pragma unroll
                for (int bj = 0; bj < 2; ++bj) { const f32x4 v0 = acc[ai][bj][m][0] * gv, v1 = acc[ai][bj][m][1] * gv;
                    u32x4 w; w.x = pk2(v0.x, v0.y); w.y = pk2(v0.z, v0.w); w.z = pk2(v1.x, v1.y); w.w = pk2(v1.z, v1.w);
                    *(u32x4*)(y + row * kD + u.pn * 256 + 128 * bj + 32 * wc + 8 * fq) = w; } }
    }
};
struct EpiGlu {
    static constexpr int VMOPS = 16;
    const bf16_t* g; bf16_t* oc;
    DEVI void operator()(const f32x4 (&acc)[2][2][4][2], const Unit& u, int wr, int wc, int fr, int fq) const {
#pragma unroll
        for (int ai = 0; ai < 2; ++ai)
#pragma unroll
            for (int m = 0; m < 4; ++m) { const size_t row = (size_t)(u.pm * 256 + 128 * ai + 64 * wr + 16 * m + fr);
#pragma unroll
                for (int bj = 0; bj < 2; ++bj) { const size_t o = row * 256 + 128 * bj + 32 * wc + 8 * fq;
                    const u32x4 gw = *(const u32x4*)(g + o); float o8[8];
#pragma unroll
                    for (int n = 0; n < 2; ++n)
#pragma unroll
                        for (int j = 0; j < 4; ++j) { const int t = n * 4 + j; const unsigned wv = (t < 2) ? gw.x : (t < 4) ? gw.y : (t < 6) ? gw.z : gw.w;
                            const float gg = __uint_as_float((t & 1) ? (wv & 0xFFFF0000u) : (wv << 16)); o8[t] = gg * frcp(1.f + __expf(-acc[ai][bj][m][n][j])); }
                    u32x4 w; w.x = pk2(o8[0], o8[1]); w.y = pk2(o8[2], o8[3]); w.z = pk2(o8[4], o8[5]); w.w = pk2(o8[6], o8[7]);
                    *(u32x4*)(oc + o) = w; } }
    }
};

DEVI void load_row64(const bf16_t* p, float* d) {
#pragma unroll
    for (int i = 0; i < 8; ++i) { const u32x4 v = *(const u32x4*)(p + i * 8);
        d[i * 8 + 0] = __uint_as_float(v.x << 16); d[i * 8 + 1] = __uint_as_float(v.x & 0xFFFF0000u); d[i * 8 + 2] = __uint_as_float(v.y << 16); d[i * 8 + 3] = __uint_as_float(v.y & 0xFFFF0000u);
        d[i * 8 + 4] = __uint_as_float(v.z << 16); d[i * 8 + 5] = __uint_as_float(v.z & 0xFFFF0000u); d[i * 8 + 6] = __uint_as_float(v.w << 16); d[i * 8 + 7] = __uint_as_float(v.w & 0xFFFF0000u); }
}
DEVI void store_row64(bf16_t* p, const float* d, float sc) {
#pragma unroll
    for (int i = 0; i < 8; ++i) { u32x4 w; w.x = pk2(d[i * 8] * sc, d[i * 8 + 1] * sc); w.y = pk2(d[i * 8 + 2] * sc, d[i * 8 + 3] * sc); w.z = pk2(d[i * 8 + 4] * sc, d[i * 8 + 5] * sc); w.w = pk2(d[i * 8 + 6] * sc, d[i * 8 + 7] * sc);
        *(u32x4*)(p + i * 8) = w; }
}
DEVI void phase_dilated_naive(const bf16_t* qa, const bf16_t* ka, const bf16_t* va, bf16_t* oac, float* lse, int bid, int nblk) {
    const int nitems = 3 * kB * 8 * (kS / kNT);
    for (int it = bid; it < nitems; it += nblk) {
        const int c = it / (kB * 8 * 16), r = it % (kB * 8 * 16), bh = r / 16, t = (r % 16) * kNT + tidx(), b = bh >> 3, h = bh & 7;
        const int dil = (c == 0) ? 1 : (c == 1) ? 4 : 16;
        const float slope = exp2f(-(float)(h + 1));
        const bf16_t* kb_ = ka + (size_t)bh * kS * 64; const bf16_t* vb_ = va + (size_t)bh * kS * 64;
        float q[64], o[64];
        load_row64(qa + ((size_t)bh * kS + t) * 64, q);
#pragma unroll
        for (int d = 0; d < 64; ++d) o[d] = 0.f;
        float m = -1e30f, l = 0.f;
        for (int rel = -64; rel <= 64; ++rel) {
            const int pos = t + rel * dil;
            if (pos < 0 || pos >= kS) continue;
            float kv[64]; load_row64(kb_ + (size_t)pos * 64, kv);
            float dot = 0.f;
#pragma unroll
            for (int d = 0; d < 64; ++d) dot += q[d] * kv[d];
            const float sc = dot * 0.125f - slope * (float)(dil * (rel < 0 ? -rel : rel));
            const float mn = fmaxf(m, sc), corr = __expf(m - mn), p = __expf(sc - mn);
            load_row64(vb_ + (size_t)pos * 64, kv);
            l = l * corr + p;
#pragma unroll
            for (int d = 0; d < 64; ++d) o[d] = o[d] * corr + p * kv[d];
            m = mn;
        }
        const size_t tok = (size_t)b * kS + t;
        store_row64(oac + ((size_t)c * kTok + tok) * 512 + h * 64, o, 1.f / l);
        lse[((size_t)c * kTok + tok) * 8 + h] = m + __logf(l);
    }
}
DEVI void phase_na_naive(const bf16_t* qb, const bf16_t* kbuf, const bf16_t* vbuf, const float* rpb  , bf16_t* ob, int bid, int nblk) {
    const int nitems = kB * 4 * (kS / kNT);
    for (int it = bid; it < nitems; it += nblk) {
        const int bh = it / 16, t = (it % 16) * kNT + tidx(), b = bh >> 2, h = bh & 3;
        const int r = t >> 6, cq = t & 63;
        int rs = r - 4; rs = rs < 0 ? 0 : (rs > 120 ? 120 : rs);
        int cs = cq - 8; cs = cs < 0 ? 0 : (cs > 48 ? 48 : cs);
        const bf16_t* kb_ = kbuf + (size_t)bh * kS * 64; const bf16_t* vb_ = vbuf + (size_t)bh * kS * 64;
        float q[64], o[64];
        load_row64(qb + ((size_t)bh * kS + t) * 64, q);
#pragma unroll
        for (int d = 0; d < 64; ++d) o[d] = 0.f;
        float m = -1e30f, l = 0.f;
        for (int kr = 0; kr < 8; ++kr)
            for (int kc = 0; kc < 16; ++kc) {
                const int krow = rs + kr, kcol = cs + kc, pos = krow * 64 + kcol;
                float kv[64]; load_row64(kb_ + (size_t)pos * 64, kv);
                float dot = 0.f;
#pragma unroll
                for (int d = 0; d < 64; ++d) dot += q[d] * kv[d];
                const float sc = dot * 0.125f + rpb[(h * 15 + (krow - r + 7)) * 31 + (kcol - cq + 15)];
                const float mn = fmaxf(m, sc), corr = __expf(m - mn), p = __expf(sc - mn);
                load_row64(vb_ + (size_t)pos * 64, kv);
                l = l * corr + p;
#pragma unroll
                for (int d = 0; d < 64; ++d) o[d] = o[d] * corr + p * kv[d];
                m = mn;
            }
        store_row64(ob + ((size_t)b * kS + t) * 256 + h * 64, o, 1.f / l);
    }
}

typedef float f32x16 __attribute__((ext_vector_type(16)));
typedef short s16x4 __attribute__((ext_vector_type(4)));
constexpr float kLog2e = 1.4426950408889634f, kLn2 = 0.6931471805599453f;
DEVI bf16x8 tr_pair(LAS unsigned char* p0, LAS unsigned char* p1) {
    const s16x4 a = __builtin_amdgcn_ds_read_tr16_b64_v4i16((LAS s16x4*)p0), b = __builtin_amdgcn_ds_read_tr16_b64_v4i16((LAS s16x4*)p1);
    return (bf16x8){a.x, a.y, a.z, a.w, b.x, b.y, b.z, b.w};
}
template <int VAR = 0>
DEVI void phase_dilated(const bf16_t* qa, const bf16_t* ka, const bf16_t* va, const float* gq, const float* gk, bf16_t* oac, float* lse, LAS unsigned char* lds, int bid, int nblk) {
    const int tid = tidx(), wid = __builtin_amdgcn_readfirstlane(tid >> 6), lane = tid & 63, h5 = lane >> 5, qc = lane & 31;
    LAS unsigned char* Kimg = lds; LAS unsigned char* Vimg = lds + 49152;
    float Mn;
    { float a = fabsf(gq[lane]), b = fabsf(gk[lane]);
#pragma unroll
      for (int m = 32; m >= 1; m >>= 1) { a = fmaxf(a, __shfl_xor(a, m)); b = fmaxf(b, __shfl_xor(b, m)); }
      Mn = 8.f * a * b; }
    const float Mb = Mn * kLog2e;
    unsigned koff[4];
#pragma unroll
    for (int s = 0; s < 4; ++s) koff[s] = (unsigned)((32 * wid + qc) * 128 + (((2 * s + h5) ^ (qc & 7)) << 4));
    unsigned voff[2];
    { const int g = lane >> 4, i16 = lane & 15, q = i16 >> 2, p = i16 & 3;
#pragma unroll
      for (int dt = 0; dt < 2; ++dt) { const int c = (2 * (g & 1) + (p >> 1) + 4 * dt) ^ ((q >> 1) << 2); voff[dt] = (unsigned)((32 * wid + 4 * h5 + q) * 128 + (c << 4) + 8 * (p & 1)); } }
    const float dbase = (float)(4 * h5 - qc);
    u32x4 pK[6], pV[6];
#define DIL_DECODE(unit_) const int c = (unit_) >> 11, rem = (unit_) & 2047, bh = rem >> 5, ub = rem & 31; \
        const int dsh = 2 * c, L = kS >> dsh, upc = 32 >> dsh, cls = ub >> (5 - dsh), u0 = (ub & (upc - 1)) << 8;
#define DIL_PREFETCH(unit_) do { DIL_DECODE(unit_) \
        const bf16_t* kbase = ka + (size_t)bh * kS * 64; const bf16_t* vbase = va + (size_t)bh * kS * 64; \
        _Pragma("unroll") for (int it = 0; it < 6; ++it) { const int id = it * kNT + tid, row = id >> 3, ch = id & 7; \
            int ki = u0 - 64 + row; ki = ki < 0 ? 0 : (ki > L - 1 ? L - 1 : ki); const size_t tok = (size_t)((ki << dsh) + cls); \
            pK[it] = *(const u32x4*)(kbase + tok * 64 + ch * 8); pV[it] = *(const u32x4*)(vbase + tok * 64 + ch * 8); } } while (0)
    if ((VAR & 8) || bid < 6144) DIL_PREFETCH(bid);
    for (int unit = bid; unit < 6144; unit += nblk) {
        DIL_DECODE(unit)
        const int q0 = u0 + 32 * wid, qtok = ((q0 + qc) << dsh) + cls;
        bf16x8 Qf[4];
#pragma unroll
        for (int s = 0; s < 4; ++s) Qf[s] = *(const bf16x8*)(qa + ((size_t)bh * kS + qtok) * 64 + 16 * s + 8 * h5);
        __syncthreads();
        if (!(VAR & 8)) {
#pragma unroll
        for (int it = 0; it < 6; ++it) { const int id = it * kNT + tid, row = id >> 3, ch = id & 7;
            *(LAS u32x4*)(Kimg + row * 128 + ((ch ^ (row & 7)) << 4)) = pK[it];
            *(LAS u32x4*)(Vimg + row * 128 + ((ch ^ (((row >> 1) & 1) << 2)) << 4)) = pV[it]; } }
        __syncthreads();
        if (!(VAR & 8) && unit + nblk < 6144) DIL_PREFETCH(unit + nblk);
        const float slope = exp2f(-(float)((bh & 7) + 1));
        const float c1 = 0.125f * kLog2e, c2 = slope * (float)(1 << dsh) * kLog2e;
        float sum = 0.f;
        f32x16 O[2];
#pragma unroll
        for (int dt = 0; dt < 2; ++dt)
#pragma unroll
            for (int i = 0; i < 16; ++i) O[dt][i] = 0.f;
#pragma unroll
        for (int kt = 0; kt < 5; ++kt) {
            const int kp0 = q0 - 64 + 32 * kt;
            if (kp0 >= 0 && kp0 < L) {
                f32x16 S;
#pragma unroll
                for (int i = 0; i < 16; ++i) S[i] = 0.f;
#pragma unroll
                for (int s = 0; s < 4; ++s) { const bf16x8 Kf = *(const LAS bf16x8*)(Kimg + koff[s] + kt * 4096); S = __builtin_amdgcn_mfma_f32_32x32x16_bf16(Kf, Qf[s], S, 0, 0, 0); }
                const float cs = (kt < 2) ? c2 : -c2, c0 = ((kt == 0 || kt == 4) ? -64.f : (kt == 2 ? 0.f : -32.f)) * c2 - Mb;
#pragma unroll
                for (int i = 0; i < 16; ++i) {
                    const float dvi = dbase + (float)((i & 3) + 8 * (i >> 2));
                    const float d = (kt == 2) ? fabsf(dvi) : dvi;
                    float sv = S[i] * c1 + (d * cs + c0);
                    if (kt == 0) sv = (dvi >= 0.f) ? sv : -1e30f;
                    if (kt == 4) sv = (dvi <= 0.f) ? sv : -1e30f;
                    const float pv = (VAR & 4) ? S[i] : __builtin_amdgcn_exp2f(sv); S[i] = pv; sum += pv;
                }
                if (VAR & 2) { _Pragma("unroll") for (int i = 0; i < 16; ++i) O[0][i] += S[i]; }
                else
#pragma unroll
                for (int s2 = 0; s2 < 2; ++s2) {
                    u32x4 pw; pw.x = pk2(S[8 * s2 + 0], S[8 * s2 + 1]); pw.y = pk2(S[8 * s2 + 2], S[8 * s2 + 3]); pw.z = pk2(S[8 * s2 + 4], S[8 * s2 + 5]); pw.w = pk2(S[8 * s2 + 6], S[8 * s2 + 7]);
                    const bf16x8 Pf = __builtin_bit_cast(bf16x8, pw);
#pragma unroll
                    for (int dt = 0; dt < 2; ++dt) { LAS unsigned char* vp = Vimg + voff[dt] + kt * 4096 + s2 * 2048;
                        const bf16x8 Vf = tr_pair(vp, vp + 1024);
                        O[dt] = __builtin_amdgcn_mfma_f32_32x32x16_bf16(Vf, Pf, O[dt], 0, 0, 0); }
                }
            }
        }
        sum += __shfl_xor(sum, 32);
        const float inv = 1.f / sum;
        const size_t tok = (size_t)(bh >> 3) * kS + qtok;
        if (VAR & 1) { float t = inv; _Pragma("unroll") for (int dt = 0; dt < 2; ++dt) _Pragma("unroll") for (int i = 0; i < 16; ++i) t += O[dt][i]; if (t == 1.2345e30f) lse[0] = t; }
        else {
        LAS unsigned char* ost = lds + 98304 + wid * 4096;
#pragma unroll
        for (int dt = 0; dt < 2; ++dt)
#pragma unroll
            for (int g4 = 0; g4 < 4; ++g4) { u32x2 w; w.x = pk2(O[dt][4 * g4] * inv, O[dt][4 * g4 + 1] * inv); w.y = pk2(O[dt][4 * g4 + 2] * inv, O[dt][4 * g4 + 3] * inv);
                *(LAS u32x2*)(ost + qc * 128 + (((4 * dt + g4) ^ (qc & 7)) << 4) + 8 * h5) = w; }
        if (h5 == 0) lse[((size_t)c * kTok + tok) * 8 + (bh & 7)] = Mn + __logf(sum);
        bf16_t* obase = oac + ((size_t)c * kTok + (size_t)(bh >> 3) * kS) * 512 + (bh & 7) * 64;
#pragma unroll
        for (int it = 0; it < 4; ++it) { const int r = it * 8 + (lane >> 3), ch = lane & 7;
            const u32x4 v = *(const LAS u32x4*)(ost + r * 128 + ((ch ^ (r & 7)) << 4));
            const size_t t2 = (size_t)(((q0 + r) << dsh) + cls);
            *(u32x4*)(obase + t2 * 512 + ch * 8) = v; }
        }
    }
#undef DIL_DECODE
#undef DIL_PREFETCH
    __syncthreads();
}
DEVI void phase_na(const bf16_t* qb, const bf16_t* kb, const bf16_t* vb, const float* rpb  , bf16_t* ob, LAS unsigned char* lds, int bid, int nblk) {
    const int tid = tidx(), wid = __builtin_amdgcn_readfirstlane(tid >> 6), lane = tid & 63, g4 = lane >> 4, i16 = lane & 15;
    LAS unsigned char* Kimg = lds; LAS unsigned char* Vimg = lds + 73728; LAS float* tab = (LAS float*)(lds + 147456);
    for (int i = tid; i < 4 * 465; i += kNT) tab[i] = rpb[i];
    const int g = wid & 3, kcs = (16 * g - 8) < 0 ? 0 : ((16 * g - 8) > 32 ? 32 : (16 * g - 8));
    const int qcol = 16 * g + i16, cs = (qcol - 8) < 0 ? 0 : ((qcol - 8) > 48 ? 48 : (qcol - 8));
    unsigned kswz[2];
#pragma unroll
    for (int s = 0; s < 2; ++s) kswz[s] = (unsigned)(((4 * s + g4) ^ (i16 & 7)) << 4);
    const int q = i16 >> 2, p = i16 & 3, sw = 2 * (g4 & 1) + (q >> 1);
    unsigned vsw[4];
#pragma unroll
    for (int dt = 0; dt < 4; ++dt) vsw[dt] = (unsigned)((((2 * dt + (p >> 1)) ^ (sw << 1)) << 4) + 8 * (p & 1));
    for (int unit = bid; unit < 2048; unit += nblk) {
        const int bh = unit >> 6, rp = unit & 63, r0 = 2 * rp, h = bh & 3;
        const int rsA = (r0 - 4) < 0 ? 0 : ((r0 - 4) > 120 ? 120 : (r0 - 4));
        const bf16_t* kbase = kb + (size_t)bh * kS * 64; const bf16_t* vbase = vb + (size_t)bh * kS * 64;
        __syncthreads();
#pragma unroll
        for (int it = 0; it < 9; ++it) {
            const int id = it * kNT + tid, row = id >> 3, ch = id & 7;
            int gr = rsA + (row >> 6); gr = gr > 127 ? 127 : gr;
            const size_t tok = (size_t)(gr * 64 + (row & 63));
            const u32x4 kv = *(const u32x4*)(kbase + tok * 64 + ch * 8), vv = *(const u32x4*)(vbase + tok * 64 + ch * 8);
            *(LAS u32x4*)(Kimg + row * 128 + ((ch ^ (row & 7)) << 4)) = kv;
            *(LAS u32x4*)(Vimg + row * 128 + ((ch ^ (((row >> 1) & 3) << 1)) << 4)) = vv;
        }
        __syncthreads();
        const int rr = r0 + (wid >> 2);
        const int rs = (rr - 4) < 0 ? 0 : ((rr - 4) > 120 ? 120 : (rr - 4)), ro = rs - rsA;
        const int qtok = rr * 64 + qcol;
        bf16x8 Qf[2];
#pragma unroll
        for (int s = 0; s < 2; ++s) Qf[s] = *(const bf16x8*)(qb + ((size_t)bh * kS + qtok) * 64 + 32 * s + 8 * g4);
        f32x4 S[16];
        const unsigned kb0 = (unsigned)((ro * 64 + kcs + i16) * 128);
#pragma unroll
        for (int t = 0; t < 16; ++t) { S[t] = (f32x4){0.f, 0.f, 0.f, 0.f};
#pragma unroll
            for (int s = 0; s < 2; ++s) { const bf16x8 Kf = *(const LAS bf16x8*)(Kimg + kb0 + (t >> 1) * 8192 + (t & 1) * 2048 + kswz[s]); S[t] = __builtin_amdgcn_mfma_f32_16x16x32_bf16(Kf, Qf[s], S[t], 0, 0, 0); } }
        float mx = -1e30f;
        const LAS float* th = tab + h * 465;
        int g4v = g4; asm volatile("" : "+v"(g4v));
#pragma unroll
        for (int t = 0; t < 16; ++t)
#pragma unroll
            for (int j = 0; j < 4; ++j) {
                const int krow = rs + (t >> 1), kcol = kcs + 16 * (t & 1) + 4 * g4v + j;
                const bool valid = (kcol >= cs) && (kcol < cs + 16);
                int dc = kcol - qcol + 15; dc = dc < 0 ? 0 : (dc > 30 ? 30 : dc);
                const float bias = th[(krow - rr + 7) * 31 + dc];
                const float sv = valid ? (S[t][j] * 0.125f + bias) * kLog2e : -1e30f;
                S[t][j] = sv; mx = fmaxf(mx, sv);
            }
        mx = fmaxf(mx, __shfl_xor(mx, 16)); mx = fmaxf(mx, __shfl_xor(mx, 32));
        float sum = 0.f;
#pragma unroll
        for (int t = 0; t < 16; ++t)
#pragma unroll
            for (int j = 0; j < 4; ++j) { const float pv = __builtin_amdgcn_exp2f(S[t][j] - mx); S[t][j] = pv; sum += pv; }
        sum += __shfl_xor(sum, 16); sum += __shfl_xor(sum, 32);
        f32x4 O[4];
#pragma unroll
        for (int dt = 0; dt < 4; ++dt) O[dt] = (f32x4){0.f, 0.f, 0.f, 0.f};
        const unsigned vb0 = (unsigned)((ro * 64 + kcs + 4 * g4 + q) * 128);
#pragma unroll
        for (int u = 0; u < 8; ++u) {
            u32x4 pw; pw.x = pk2(S[2 * u][0], S[2 * u][1]); pw.y = pk2(S[2 * u][2], S[2 * u][3]); pw.z = pk2(S[2 * u + 1][0], S[2 * u + 1][1]); pw.w = pk2(S[2 * u + 1][2], S[2 * u + 1][3]);
            const bf16x8 Pf = __builtin_bit_cast(bf16x8, pw);
#pragma unroll
            for (int dt = 0; dt < 4; ++dt) { LAS unsigned char* vp = Vimg + vb0 + u * 8192 + vsw[dt];
                const bf16x8 Vf = tr_pair(vp, vp + 2048);
                O[dt] = __builtin_amdgcn_mfma_f32_16x16x32_bf16(Vf, Pf, O[dt], 0, 0, 0); }
        }
        const float inv = 1.f / sum;
        bf16_t* orow = ob + ((size_t)(bh >> 2) * kS + qtok) * 256 + h * 64;
#pragma unroll
        for (int dt = 0; dt < 4; ++dt) { u32x2 w; w.x = pk2(O[dt][0] * inv, O[dt][1] * inv); w.y = pk2(O[dt][2] * inv, O[dt][3] * inv); *(u32x2*)(orow + 16 * dt + 4 * g4) = w; }
    }
    __syncthreads();
}
DEVI void phase_s5_naive(const Params& P, int l, const bf16_t* ux, float* ys, unsigned char* lds, int bid, int nblk) {
    const int wid = tidx() >> 6, lane = tidx() & 63;
    float* xs = (float*)lds + wid * 128;
    for (int item = wid * nblk + bid; item < kB * 16 * 2; item += nblk * 8) {
        const int dir = item & 1, g = (item >> 1) & 15, b = item >> 5;
        const size_t pbase = (((size_t)l * 2 + dir) * 16 + g) * 64;
        const float dt = __expf(P.s5_log_dt[((size_t)l * 2 + dir) * 16 + g]);
        const float a = fminf(P.s5_a_re[pbase + lane], -1e-4f), w = P.s5_a_im[pbase + lane];
        const float mag = __expf(a * dt), ar = mag * cosf(w * dt), ai = mag * sinf(w * dt);
        const float den = a * a + w * w, zr = ar - 1.f, gr = (zr * a + ai * w) / den, gi = (ai * a - zr * w) / den;
        float bbr[16], bbi[16];
#pragma unroll
        for (int c = 0; c < 16; ++c) { const float br = P.s5_b_re[(pbase + lane) * 16 + c], bi = P.s5_b_im[(pbase + lane) * 16 + c]; bbr[c] = gr * br - gi * bi; bbi[c] = gr * bi + gi * br; }
        const int cch = lane & 15, qt = lane >> 4;
        float cre[16], cim[16];
#pragma unroll
        for (int pp = 0; pp < 16; ++pp) { cre[pp] = P.s5_c_re[(pbase / 64 * 16 + cch) * 64 + qt * 16 + pp]; cim[pp] = P.s5_c_im[(pbase / 64 * 16 + cch) * 64 + qt * 16 + pp]; }
        float xr = 0.f, xi = 0.f;
        const bf16_t* ug = ux + (size_t)g * 4096 * 512;
        for (int st = 0; st < kS; ++st) {
            const int s = dir ? (kS - 1 - st) : st; const size_t tok = (size_t)b * kS + s;
            const bf16_t* up = ug + (tok >> 4) * 512 + (tok & 15) * 16;
            const u32x4 u0 = *(const u32x4*)up, u1 = *(const u32x4*)(up + 8);
            float uv[16];
            uv[0] = __uint_as_float(u0.x << 16); uv[1] = __uint_as_float(u0.x & 0xFFFF0000u); uv[2] = __uint_as_float(u0.y << 16); uv[3] = __uint_as_float(u0.y & 0xFFFF0000u);
            uv[4] = __uint_as_float(u0.z << 16); uv[5] = __uint_as_float(u0.z & 0xFFFF0000u); uv[6] = __uint_as_float(u0.w << 16); uv[7] = __uint_as_float(u0.w & 0xFFFF0000u);
            uv[8] = __uint_as_float(u1.x << 16); uv[9] = __uint_as_float(u1.x & 0xFFFF0000u); uv[10] = __uint_as_float(u1.y << 16); uv[11] = __uint_as_float(u1.y & 0xFFFF0000u);
            uv[12] = __uint_as_float(u1.z << 16); uv[13] = __uint_as_float(u1.z & 0xFFFF0000u); uv[14] = __uint_as_float(u1.w << 16); uv[15] = __uint_as_float(u1.w & 0xFFFF0000u);
            float bur = 0.f, bui = 0.f;
#pragma unroll
            for (int c = 0; c < 16; ++c) { bur += bbr[c] * uv[c]; bui += bbi[c] * uv[c]; }
            const float nr = ar * xr - ai * xi + bur, ni = ar * xi + ai * xr + bui; xr = nr; xi = ni;
            xs[lane] = xr; xs[64 + lane] = xi;
            asm volatile("s_waitcnt lgkmcnt(0)" ::: "memory");
            float y = 0.f;
#pragma unroll
            for (int pp = 0; pp < 16; ++pp) y += cre[pp] * xs[qt * 16 + pp] - cim[pp] * xs[64 + qt * 16 + pp];
            asm volatile("s_waitcnt lgkmcnt(0)" ::: "memory");
            y += __shfl_xor(y, 16); y += __shfl_xor(y, 32);
            if (lane < 16) ys[((size_t)dir * kTok + tok) * 256 + g * 16 + cch] = y;
        }
    }
}
DEVI void phase_s5_finish(const float* ys, const bf16_t* ux, const float* dskip, bf16_t* G, int bid, int nblk) {
    for (size_t i = (size_t)bid * kNT + tidx(); i < (size_t)kTok * 256; i += (size_t)nblk * kNT) {
        const size_t tok = i >> 8; const int ch = (int)(i & 255), g = ch >> 4, c = ch & 15;
        const float u = bf2f(ux[((size_t)g * 4096 + (tok >> 4)) * 512 + (tok & 15) * 16 + c]);
        const float y = ys[i] + ys[(size_t)kTok * 256 + i] + dskip[ch] * u;
        G[i] = f2bf(gelu_tanh(y));
    }
}
DEVI void unpk8(float* d, const u32x4 q, const float sc) {
    d[0] += sc * __uint_as_float(q.x << 16); d[1] += sc * __uint_as_float(q.x & 0xFFFF0000u); d[2] += sc * __uint_as_float(q.y << 16); d[3] += sc * __uint_as_float(q.y & 0xFFFF0000u);
    d[4] += sc * __uint_as_float(q.z << 16); d[5] += sc * __uint_as_float(q.z & 0xFFFF0000u); d[6] += sc * __uint_as_float(q.w << 16); d[7] += sc * __uint_as_float(q.w & 0xFFFF0000u);
}
DEVI void phase_mixnorm(const bf16_t* oac, const float* lse, const bf16_t* ob, const bf16_t* oc, const float* ga, const float* gb, const float* gc, bf16_t* mix, int bid, int nblk) {
    const int wid = tidx() >> 6, lane = tidx() & 63;
    float gn[16];
    { const float* gp = (lane < 32) ? ga + lane * 16 : (lane < 48) ? gb + (lane - 32) * 16 : gc + (lane - 48) * 16;
#pragma unroll
      for (int i = 0; i < 16; ++i) gn[i] = gp[i]; }
    for (int row = bid * 8 + wid; row < kTok; row += nblk * 8) {
        float v[16];
#pragma unroll
        for (int i = 0; i < 16; ++i) v[i] = 0.f;
        if (lane < 32) {
            const int h = lane >> 2;
            const float l0 = lse[(size_t)row * 8 + h], l1 = lse[((size_t)kTok + row) * 8 + h], l2 = lse[((size_t)2 * kTok + row) * 8 + h];
            const bf16_t* p0 = oac + (size_t)row * 512 + lane * 16; const bf16_t* p1 = p0 + (size_t)kTok * 512; const bf16_t* p2 = p1 + (size_t)kTok * 512;
            const u32x4 a0 = *(const u32x4*)p0, a1 = *(const u32x4*)(p0 + 8), b0 = *(const u32x4*)p1, b1 = *(const u32x4*)(p1 + 8), c0 = *(const u32x4*)p2, c1 = *(const u32x4*)(p2 + 8);
            const float mx = fmaxf(l0, fmaxf(l1, l2)); float w0 = __expf(l0 - mx), w1 = __expf(l1 - mx), w2 = __expf(l2 - mx); const float inv = frcp(w0 + w1 + w2); w0 *= inv; w1 *= inv; w2 *= inv;
            unpk8(v, a0, w0); unpk8(v + 8, a1, w0); unpk8(v, b0, w1); unpk8(v + 8, b1, w1); unpk8(v, c0, w2); unpk8(v + 8, c1, w2);
        } else {
            const bf16_t* p = (lane < 48) ? ob + (size_t)row * 256 + (lane - 32) * 16 : oc + (size_t)row * 256 + (lane - 48) * 16;
            const u32x4 a0 = *(const u32x4*)p, a1 = *(const u32x4*)(p + 8);
            unpk8(v, a0, 1.f); unpk8(v + 8, a1, 1.f);
        }
        float ss = 0.f;
#pragma unroll
        for (int i = 0; i < 16; ++i) ss += v[i] * v[i];
#pragma unroll
        for (int m = 1; m <= 8; m <<= 1) ss += __shfl_xor(ss, m);
        const float o16 = __shfl_xor(ss, 16);
        if (lane < 32) ss += o16;
        const float rstd = rsqrtf(ss * ((lane < 32) ? (1.f / 512.f) : (1.f / 256.f)) + kEps);
        if (EMU_FP8_WOUT) {
#pragma unroll
            for (int i = 0; i < 16; ++i) v[i] = q8(v[i] * rstd * gn[i], 1.f, 1.f) / (rstd * gn[i]);
        }
        u32x4 w0, w1;
        w0.x = pk2(v[0] * rstd * gn[0], v[1] * rstd * gn[1]); w0.y = pk2(v[2] * rstd * gn[2], v[3] * rstd * gn[3]); w0.z = pk2(v[4] * rstd * gn[4], v[5] * rstd * gn[5]); w0.w = pk2(v[6] * rstd * gn[6], v[7] * rstd * gn[7]);
        w1.x = pk2(v[8] * rstd * gn[8], v[9] * rstd * gn[9]); w1.y = pk2(v[10] * rstd * gn[10], v[11] * rstd * gn[11]); w1.z = pk2(v[12] * rstd * gn[12], v[13] * rstd * gn[13]); w1.w = pk2(v[14] * rstd * gn[14], v[15] * rstd * gn[15]);
        *(u32x4*)(mix + (size_t)row * kD + lane * 16) = w0; *(u32x4*)(mix + (size_t)row * kD + lane * 16 + 8) = w1;
    }
}
DEVI void phase_combine(bf16_t* xb, float* out32, const bf16_t* y, const int* tokslot, const float* gain_next, bf16_t* h, int bid, int nblk) {
    const int wid = tidx() >> 6, lane = tidx() & 63;
    f32x4 g[4];
#pragma unroll
    for (int q = 0; q < 4; ++q) g[q] = gain_next ? *(const f32x4*)(gain_next + q * 256 + lane * 4) : (f32x4){0.f, 0.f, 0.f, 0.f};
    const int stride = nblk * 8;
    int row = bid * 8 + wid;
    u32x2 nv[4]; int nts = 0;
    if (row < kTok) { nts = tokslot[(size_t)row * kE + (lane & 15)];
#pragma unroll
        for (int q = 0; q < 4; ++q) nv[q] = *(const u32x2*)(xb + (size_t)row * kD + q * 256 + lane * 4); }
    for (; row < kTok; row += stride) {
        const int b = row >> 13;
        const int ts = nts;
        f32x4 v[4];
#pragma unroll
        for (int q = 0; q < 4; ++q) { const u32x2 w = nv[q]; v[q] = (f32x4){__uint_as_float(w.x << 16), __uint_as_float(w.x & 0xFFFF0000u), __uint_as_float(w.y << 16), __uint_as_float(w.y & 0xFFFF0000u)}; }
        const int nrow = row + stride;
        if (nrow < kTok) { nts = tokslot[(size_t)nrow * kE + (lane & 15)];
#pragma unroll
            for (int q = 0; q < 4; ++q) nv[q] = *(const u32x2*)(xb + (size_t)nrow * kD + q * 256 + lane * 4); }
#pragma unroll
        for (int e0 = 0; e0 < kE; e0 += 8) {
            u32x2 yv[8][4];
#pragma unroll
            for (int e = 0; e < 8; ++e) { const int slot = __builtin_amdgcn_readlane(ts, e0 + e);
                if (slot >= 0) { const bf16_t* yr = y + ((size_t)((e0 + e) * kB + b) * kCap + slot) * kD;
#pragma unroll
                    for (int q = 0; q < 4; ++q) yv[e][q] = *(const u32x2*)(yr + q * 256 + lane * 4); } }
#pragma unroll
            for (int e = 0; e < 8; ++e) { const int slot = __builtin_amdgcn_readlane(ts, e0 + e);
                if (slot >= 0) {
#pragma unroll
                    for (int q = 0; q < 4; ++q) { const u32x2 w = yv[e][q];
                        v[q].x += __uint_as_float(w.x << 16); v[q].y += __uint_as_float(w.x & 0xFFFF0000u); v[q].z += __uint_as_float(w.y << 16); v[q].w += __uint_as_float(w.y & 0xFFFF0000u); } } }
        }
        if (!gain_next) {
#pragma unroll
            for (int q = 0; q < 4; ++q) *(f32x4*)(out32 + (size_t)row * kD + q * 256 + lane * 4) = v[q];
        } else {
            float ss = 0.f;
#pragma unroll
            for (int q = 0; q < 4; ++q) { u32x2 o; o.x = pk2(v[q].x, v[q].y); o.y = pk2(v[q].z, v[q].w); *(u32x2*)(xb + (size_t)row * kD + q * 256 + lane * 4) = o;
                v[q] = (f32x4){__uint_as_float(o.x << 16), __uint_as_float(o.x & 0xFFFF0000u), __uint_as_float(o.y << 16), __uint_as_float(o.y & 0xFFFF0000u)};
                ss += v[q].x * v[q].x + v[q].y * v[q].y + v[q].z * v[q].z + v[q].w * v[q].w; }
            ss = wave_sum(ss); const float rstd = rsqrtf(ss * (1.f / kD) + kEps);
#pragma unroll
            for (int q = 0; q < 4; ++q) { const f32x4 t = v[q] * rstd * g[q]; u32x2 o; o.x = pk2(t.x, t.y); o.y = pk2(t.z, t.w);
                *(u32x2*)(h + (size_t)row * kD + q * 256 + lane * 4) = o; }
        }
    }
}

DEVI void cpow_m(double a, double w, double dt, int m, float& re, float& im) {
    const float mag = __expf((float)m * (float)a * (float)dt);
    const double turns = (double)m * w * dt * 0.15915494309189535; const float ang = (float)((turns - floor(turns)) * 6.283185307179586);
    re = mag * cosf(ang); im = mag * sinf(ang);
}
DEVI void s5_prep_item(const Params& P, int l, int g, unsigned char* lds_) {
    float* pw = (float*)lds_;
    float* bb = pw + 4352;
    float* cc = bb + 4096;
    float* kt = cc + 4096;
    const int tid = tidx();
    __syncthreads();
    for (int i = tid; i < 128; i += kNT) { const int dir = i >> 6, p = i & 63; const size_t pb = (((size_t)l * 2 + dir) * 16 + g) * 64 + p;
        const double dt = (double)__expf(P.s5_log_dt[((size_t)l * 2 + dir) * 16 + g]); const double a = (double)fminf(P.s5_a_re[pb], -1e-4f), w = (double)P.s5_a_im[pb];
        for (int m = 0; m < 17; ++m) { float re, im; cpow_m(a, w, dt, m, re, im); pw[((dir * 64 + p) * 17 + m) * 2] = re; pw[((dir * 64 + p) * 17 + m) * 2 + 1] = im; }
        const float af = (float)a, wf = (float)w, ar = pw[((dir * 64 + p) * 17 + 1) * 2], ai = pw[((dir * 64 + p) * 17 + 1) * 2 + 1];
        const float den = af * af + wf * wf, zr = ar - 1.f, gr = (zr * af + ai * wf) / den, gi = (ai * af - zr * wf) / den;
        for (int c = 0; c < 16; ++c) { const float br = P.s5_b_re[pb * 16 + c], bi = P.s5_b_im[pb * 16 + c]; bb[((dir * 64 + p) * 16 + c) * 2] = gr * br - gi * bi; bb[((dir * 64 + p) * 16 + c) * 2 + 1] = gr * bi + gi * br; }
    }
    for (int i = tid; i < 2048; i += kNT) { const int dir = i >> 10, c = (i >> 6) & 15, p = i & 63; const size_t o = ((((size_t)l * 2 + dir) * 16 + g) * 16 + c) * 64 + p; cc[i * 2] = P.s5_c_re[o]; cc[i * 2 + 1] = P.s5_c_im[o]; }
    __syncthreads();
    for (int i = tid; i < 8192; i += kNT) { const int dir = i >> 12, m = (i >> 8) & 15, c = (i >> 4) & 15, c2 = i & 15; float acc = 0.f;
        for (int p = 0; p < 64; ++p) { const float cr = cc[((dir * 16 + c) * 64 + p) * 2], ci = cc[((dir * 16 + c) * 64 + p) * 2 + 1], wr_ = pw[((dir * 64 + p) * 17 + m) * 2], wi_ = pw[((dir * 64 + p) * 17 + m) * 2 + 1];
            const float br = bb[((dir * 64 + p) * 16 + c2) * 2], bi = bb[((dir * 64 + p) * 16 + c2) * 2 + 1]; const float tr = cr * wr_ - ci * wi_, ti = cr * wi_ + ci * wr_; acc += tr * br - ti * bi; }
        kt[i] = acc; }
    __syncthreads();
    bf16_t* wst = (bf16_t*)(wsp(P) + WS_WST) + ((size_t)l * 16 + g) * 256 * 256;
    bf16_t* wso = (bf16_t*)(wsp(P) + WS_WSO) + ((size_t)l * 16 + g) * 256 * 512;
    for (int id = tid; id < 8192; id += kNT) { const int n = id >> 5, k0 = (id & 31) * 8, dir = n >> 7, p = (n >> 1) & 63, ri = n & 1; float v[8];
#pragma unroll
        for (int kk = 0; kk < 8; ++kk) { const int k = k0 + kk, t = k >> 4, c = k & 15, e = dir ? t : 15 - t; const float wr_ = pw[((dir * 64 + p) * 17 + e) * 2], wi_ = pw[((dir * 64 + p) * 17 + e) * 2 + 1], br = bb[((dir * 64 + p) * 16 + c) * 2], bi = bb[((dir * 64 + p) * 16 + c) * 2 + 1];
            v[kk] = ri ? (wr_ * bi + wi_ * br) : (wr_ * br - wi_ * bi); }
        u32x4 o; o.x = pk2(v[0], v[1]); o.y = pk2(v[2], v[3]); o.z = pk2(v[4], v[5]); o.w = pk2(v[6], v[7]); *(u32x4*)(wst + (size_t)n * 256 + k0) = o; }
    for (int id = tid; id < 16384; id += kNT) { const int ns = id >> 6, k0 = (id & 63) * 8, n = cmap_pk(ns), t = n >> 4, c = n & 15; float v[8];
#pragma unroll
        for (int kk = 0; kk < 8; ++kk) { const int k = k0 + kk; float x;
            if (k < 256) { const int j = k >> 4, c2 = k & 15; x = 0.f; if (j <= t) x += kt[(t - j) * 256 + c * 16 + c2]; if (j >= t) x += kt[4096 + (j - t) * 256 + c * 16 + c2]; if (j == t && c == c2) x += P.s5_d[l * 256 + g * 16 + c]; }
            else { const int q = k - 256, dir = q >> 7, p = (q >> 1) & 63, ri = q & 1, e = dir ? 16 - t : t + 1; const float cr = cc[((dir * 16 + c) * 64 + p) * 2], ci = cc[((dir * 16 + c) * 64 + p) * 2 + 1], wr_ = pw[((dir * 64 + p) * 17 + e) * 2], wi_ = pw[((dir * 64 + p) * 17 + e) * 2 + 1];
                x = ri ? -(cr * wi_ + ci * wr_) : (cr * wr_ - ci * wi_); }
            v[kk] = x; }
        u32x4 o; o.x = pk2(v[0], v[1]); o.y = pk2(v[2], v[3]); o.z = pk2(v[4], v[5]); o.w = pk2(v[6], v[7]); *(u32x4*)(wso + (size_t)ns * 512 + k0) = o; }
    __syncthreads();
}
DEVI void phase_s5_scan(const Params& P, int l, const float* Z, bf16_t* ux, unsigned char* lds_, int bid, int nblk) {
    const int tid = tidx(), wid = tid >> 6, lane = tid & 63;
    float* E = (float*)lds_;
    for (int item = bid; item < 256; item += nblk) {
        const int dir = item & 1, g = (item >> 1) & 15, b = item >> 5;
        const size_t pb = (((size_t)l * 2 + dir) * 16 + g) * 64 + lane;
        const double dt = (double)__expf(P.s5_log_dt[((size_t)l * 2 + dir) * 16 + g]); const double a = (double)fminf(P.s5_a_re[pb], -1e-4f), w = (double)P.s5_a_im[pb];
        float a16r, a16i, Ar, Ai; cpow_m(a, w, dt, 16, a16r, a16i); cpow_m(a, w, dt, 1024, Ar, Ai);
        const int kk0 = dir ? 511 - 64 * wid : 64 * wid; const long sstep = dir ? -1 : 1;
        const float* zp = Z + ((size_t)g * 4096 + b * 512 + kk0) * 256 + dir * 128 + 2 * lane;
        f32x2 z[64];
#pragma unroll
        for (int i = 0; i < 64; ++i) { z[i] = *(const f32x2*)zp; zp += sstep * 256; }
        float xr = 0.f, xi = 0.f;
#pragma unroll
        for (int i = 0; i < 64; ++i) { const float nr = a16r * xr - a16i * xi + z[i].x, ni = a16r * xi + a16i * xr + z[i].y; xr = nr; xi = ni; }
        __syncthreads();
        E[(wid * 64 + lane) * 2] = xr; E[(wid * 64 + lane) * 2 + 1] = xi;
        __syncthreads();
        float sr = 0.f, si = 0.f;
#pragma unroll
        for (int s2 = 0; s2 < 7; ++s2) if (s2 < wid) { const float er = E[(s2 * 64 + lane) * 2], ei = E[(s2 * 64 + lane) * 2 + 1]; const float nr = Ar * sr - Ai * si + er, ni = Ar * si + Ai * sr + ei; sr = nr; si = ni; }
        bf16_t* up = ux + ((size_t)g * 4096 + b * 512 + kk0) * 512 + 256 + dir * 128 + 2 * lane;
#pragma unroll
        for (int i = 0; i < 64; ++i) { *(unsigned*)up = pk2(sr, si); up += sstep * 512;
            const float nr = a16r * sr - a16i * si + z[i].x, ni = a16r * si + a16i * sr + z[i].y; sr = nr; si = ni; }
    }
    __syncthreads();
}
struct EpiF32N {
    static constexpr int VMOPS = 32;
    float* z; int ldz;
    DEVI void operator()(const f32x4 (&acc)[2][2][4][2], const Unit& u, int wr, int wc, int fr, int fq) const {
#pragma unroll
        for (int ai = 0; ai < 2; ++ai)
#pragma unroll
            for (int m = 0; m < 4; ++m) { const size_t ro = (size_t)(u.pm * 256 + 128 * ai + 64 * wr + 16 * m + fr) * ldz + u.pn * 256 + 32 * wc + 4 * fq;
#pragma unroll
                for (int bj = 0; bj < 2; ++bj)
#pragma unroll
                    for (int n = 0; n < 2; ++n) *(f32x4*)(z + ro + 128 * bj + 16 * n) = acc[ai][bj][m][n]; }
    }
};
struct EpiS5Out {
    static constexpr int VMOPS = 16;
    bf16_t* G;
    DEVI void operator()(const f32x4 (&acc)[2][2][4][2], const Unit& u, int wr, int wc, int fr, int fq) const {
#pragma unroll
        for (int ai = 0; ai < 2; ++ai)
#pragma unroll
            for (int m = 0; m < 4; ++m) { const int R = u.pm * 256 + 128 * ai + 64 * wr + 16 * m + fr, g = R >> 12, ck = R & 4095;
#pragma unroll
                for (int bj = 0; bj < 2; ++bj) { const int t = 8 * bj + 2 * wc + (fq >> 1), c0 = 8 * (fq & 1);
                    const f32x4 v0 = acc[ai][bj][m][0], v1 = acc[ai][bj][m][1];
                    u32x4 w; w.x = pk2(gelu_tanh(v0.x), gelu_tanh(v0.y)); w.y = pk2(gelu_tanh(v0.z), gelu_tanh(v0.w)); w.z = pk2(gelu_tanh(v1.x), gelu_tanh(v1.y)); w.w = pk2(gelu_tanh(v1.z), gelu_tanh(v1.w));
                    *(u32x4*)(G + ((size_t)ck * 16 + t) * 256 + g * 16 + c0) = w; } }
    }
};
#define XB_TMO      128
#define XB_XCNT(j)  (256  + 64 * (j))
#define XB_XSUB(j)  (1280 + 64 * (j))
#define XB_XGEN(j)  (2304 + 64 * (j))
#define XB_TOP      3328
#define XB_TOPGEN   3392
#define XCD_BAR_WORDS 3456
#define XB_SPIN_CAP (1u << 26)
DEVI unsigned xb_ld(unsigned* p)              { return __hip_atomic_load(p, __ATOMIC_RELAXED, __HIP_MEMORY_SCOPE_AGENT); }
DEVI unsigned xb_add(unsigned* p, unsigned v) { return __hip_atomic_fetch_add(p, v, __ATOMIC_RELAXED, __HIP_MEMORY_SCOPE_AGENT); }
DEVI unsigned xb_xcc_id() { return (unsigned)__builtin_amdgcn_s_getreg((3 << 11) | 20) & 0xFu; }
#define XB_SPIN(cond, bar) do { unsigned _sp = 0; while (cond) { __builtin_amdgcn_s_sleep(1); \
    if ((++_sp & 255u) == 0u) { if (xb_ld(&(bar)[XB_TMO])) break; if (_sp > XB_SPIN_CAP) { atomicAdd(&(bar)[XB_TMO], 1u); break; } } } } while (0)
struct XcdBarrier { unsigned* bar; unsigned x; volatile LAS unsigned* st; };
DEVI XcdBarrier xcd_barrier_post(unsigned* bar, volatile LAS unsigned* st) {
    XcdBarrier b; b.bar = bar; b.x = xb_xcc_id(); b.st = st;
    if (threadIdx.x == 0) (void)xb_add(&bar[XB_XCNT(b.x)], 1u);
    return b;
}
DEVI void xcd_barrier_complete(unsigned* bar, unsigned x, unsigned& nloc, unsigned& nx) {
    const unsigned G = gridDim.x * gridDim.y * gridDim.z;
    unsigned sum, cnt, mine, sp = 0u;
    for (;;) {
        sum = 0u; cnt = 0u; mine = 0u;
#pragma unroll
        for (unsigned j = 0; j < 16; ++j) { const unsigned c = xb_ld(&bar[XB_XCNT(j)]); sum += c; cnt += (c > 0u) ? 1u : 0u; mine = (j == x) ? c : mine; }
        if (sum == G) break;
        __builtin_amdgcn_s_sleep(1);
        if ((++sp & 255u) == 0u) { if (xb_ld(&bar[XB_TMO])) break; if (sp > XB_SPIN_CAP) { atomicAdd(&bar[XB_TMO], 1u); break; } }
    }
    nloc = mine > 0u ? mine : 1u; nx = cnt > 0u ? cnt : 1u;
}
DEVI void xcd_barrier(const XcdBarrier& b) {
    asm volatile("s_waitcnt vmcnt(0)" ::: "memory");
    __syncthreads();
    if (threadIdx.x == 0) {
        unsigned long long bp_ = (unsigned long long)b.bar; asm volatile("" : "+s"(bp_));
        unsigned* bar = (unsigned*)bp_;
        const unsigned bx = xb_xcc_id();
        __builtin_amdgcn_s_waitcnt(0);
        unsigned nloc = b.st[0], nx = b.st[1];
        if (nloc == 0u) { xcd_barrier_complete(bar, bx, nloc, nx); b.st[0] = nloc; b.st[1] = nx; }
        const unsigned old = xb_add(&bar[XB_XSUB(bx)], 1u);
        const unsigned gen = old / nloc;
        if (old + 1u == (gen + 1u) * nloc) {
            __builtin_amdgcn_fence(__ATOMIC_RELEASE, "agent");
            asm volatile("s_waitcnt vmcnt(0)" ::: "memory");
            const unsigned og = xb_add(&bar[XB_TOP], 1u);
            const unsigned tg = og / nx;
            if (og + 1u == (tg + 1u) * nx) xb_add(&bar[XB_TOPGEN], 1u);
            else XB_SPIN(xb_ld(&bar[XB_TOPGEN]) == tg, bar);
            __builtin_amdgcn_fence(__ATOMIC_ACQUIRE, "agent");
            xb_add(&bar[XB_XGEN(bx)], 1u);
            asm volatile("s_waitcnt vmcnt(0)" ::: "memory");
        } else {
            XB_SPIN(xb_ld(&bar[XB_XGEN(bx)]) == gen, bar);
            __builtin_amdgcn_fence(__ATOMIC_ACQUIRE, "agent");
            asm volatile("s_waitcnt vmcnt(0)" ::: "memory");
        }
    }
    __syncthreads();
}

#ifndef MEGA
#define MEGA 1
#endif
#ifndef USE_ENGINE
#define USE_ENGINE 1
#endif
constexpr int LDS_BYTES = 147456 + 8192 + 16;
#if USE_ENGINE
#define GEMM_RUN(g, E) gemm_engine<decltype(E), true, true>((LAS unsigned char*)dyn_lds, g, E, bid, nblk)
#define GEMM_RUN8(g, E) gemm_engine<decltype(E), true, true, true>((LAS unsigned char*)dyn_lds, g, E, bid, nblk)
#else
#define GEMM_RUN(g, E) gemm_simple(g, E, bid, nblk)
#endif
extern __shared__ __attribute__((aligned(16))) unsigned char dyn_lds[];

DEVI GemmD mk_gemm(const bf16_t* A, const bf16_t* Bt, int lda, int K, int nM, int nN, const int* rowidx, size_t bstride, int pmg) {
    GemmD g; g.A = A; g.Bt = Bt; g.lda = lda; g.K = K; g.nM = nM; g.nN = nN; g.rowidx = rowidx; g.bstride = bstride; g.pmg = pmg; return g; }

DEVI void ph_win(const Params& P, int l, int bid, int nblk) {
    const GemmD g = mk_gemm((const bf16_t*)(wsp(P) + WS_H), (const bf16_t*)(wsp(P) + WS_WINT) + (size_t)l * kINW * kD, kD, kD, kTok / 256, 10, nullptr, 0, 1 << 30);
    unsigned char* r1 = wsp(P) + WS_R1;
    EpiQKV E; E.qa = (bf16_t*)(r1 + R1_QA); E.ka = (bf16_t*)(r1 + R1_KA); E.va = (bf16_t*)(r1 + R1_VA); E.qb = (bf16_t*)(r1 + R1_QB); E.kb = (bf16_t*)(r1 + R1_KB); E.vb = (bf16_t*)(r1 + R1_VB); E.ux = (bf16_t*)(r1 + R1_UX);
    E.qna = P.q_norm_a + l * 64; E.kna = P.k_norm_a + l * 64; E.qnb = P.q_norm_b + l * 64; E.knb = P.k_norm_b + l * 64;
    GEMM_RUN(g, E);
}
#ifndef USE_MFMA_ATTN
#define USE_MFMA_ATTN 1
#endif
#ifndef USE_S5_GEMM
#define USE_S5_GEMM 1
#endif
#ifndef PROBE_ATTN
#define PROBE_ATTN 1
#endif
#ifndef PROBE_GU
#define PROBE_GU 1
#endif
#ifndef PROBE_DOWN
#define PROBE_DOWN 1
#endif
#ifndef PROBE_NA
#define PROBE_NA 1
#endif
#ifndef PROBE_MIX
#define PROBE_MIX 1
#endif
#ifndef PROBE_RT
#define PROBE_RT 1
#endif
#ifndef PROBE_TK
#define PROBE_TK 1
#endif
#ifndef PROBE_GUDRY
#define PROBE_GUDRY 0
#endif
#ifndef PROBE_DILVAR
#define PROBE_DILVAR 0
#endif
#ifndef PROBE_CONV
#define PROBE_CONV 1
#endif
DEVI void ph_dilated(const Params& P, int l, int bid, int nblk) { unsigned char* r1 = wsp(P) + WS_R1;
#if PROBE_DILVAR
    phase_dilated<PROBE_DILVAR>((const bf16_t*)(r1 + R1_QA), (const bf16_t*)(r1 + R1_KA), (const bf16_t*)(r1 + R1_VA), P.q_norm_a + l * 64, P.k_norm_a + l * 64, (bf16_t*)(wsp(P) + WS_R2), (float*)(wsp(P) + WS_LSE), (LAS unsigned char*)dyn_lds, bid, nblk);
#endif
#if USE_MFMA_ATTN
    phase_dilated((const bf16_t*)(r1 + R1_QA), (const bf16_t*)(r1 + R1_KA), (const bf16_t*)(r1 + R1_VA), P.q_norm_a + l * 64, P.k_norm_a + l * 64, (bf16_t*)(wsp(P) + WS_R2), (float*)(wsp(P) + WS_LSE), (LAS unsigned char*)dyn_lds, bid, nblk);
#else
    phase_dilated_naive((const bf16_t*)(r1 + R1_QA), (const bf16_t*)(r1 + R1_KA), (const bf16_t*)(r1 + R1_VA), (bf16_t*)(wsp(P) + WS_R2), (float*)(wsp(P) + WS_LSE), bid, nblk);
#endif
}
DEVI void ph_na(const Params& P, int l, int bid, int nblk) { unsigned char* r1 = wsp(P) + WS_R1;
#if USE_MFMA_ATTN
    phase_na((const bf16_t*)(r1 + R1_QB), (const bf16_t*)(r1 + R1_KB), (const bf16_t*)(r1 + R1_VB), P.rpb + (size_t)l * 4 * 15 * 31, (bf16_t*)(r1 + R1_OB), (LAS unsigned char*)dyn_lds, bid, nblk);
#else
    phase_na_naive((const bf16_t*)(r1 + R1_QB), (const bf16_t*)(r1 + R1_KB), (const bf16_t*)(r1 + R1_VB), P.rpb + (size_t)l * 4 * 15 * 31, (bf16_t*)(r1 + R1_OB), bid, nblk);
#endif
}
DEVI void ph_s5(const Params& P, int l, unsigned char* lds, int bid, int nblk) { phase_s5_naive(P, l, (const bf16_t*)(wsp(P) + WS_R1 + R1_UX), (float*)(wsp(P) + WS_YS), lds, bid, nblk); }
DEVI void ph_s5_prep(const Params& P, unsigned char* lds, int bid, int nblk) { for (int it = bid; it < kL * 16; it += nblk) s5_prep_item(P, it >> 4, it & 15, lds); }
DEVI void ph_s5_state(const Params& P, int l, int bid, int nblk) {
    const GemmD g = mk_gemm((const bf16_t*)(wsp(P) + WS_R1 + R1_UX), (const bf16_t*)(wsp(P) + WS_WST) + (size_t)l * 16 * 256 * 256, 512, 256, 256, 1, nullptr, (size_t)256 * 256, 16);
    EpiF32N E; E.z = (float*)(wsp(P) + WS_R2 + R2_Z); E.ldz = 256;
    GEMM_RUN(g, E);
}
DEVI void ph_s5_scan(const Params& P, int l, unsigned char* lds, int bid, int nblk) { phase_s5_scan(P, l, (const float*)(wsp(P) + WS_R2 + R2_Z), (bf16_t*)(wsp(P) + WS_R1 + R1_UX), lds, bid, nblk); }
DEVI void ph_s5_out(const Params& P, int l, int bid, int nblk) {
    const GemmD g = mk_gemm((const bf16_t*)(wsp(P) + WS_R1 + R1_UX), (const bf16_t*)(wsp(P) + WS_WSO) + (size_t)l * 16 * 256 * 512, 512, 512, 256, 1, nullptr, (size_t)256 * 512, 16);
    EpiS5Out E; E.G = (bf16_t*)(wsp(P) + WS_R1 + R1_G);
    GEMM_RUN(g, E);
}
DEVI void ph_s5fin(const Params& P, int l, int bid, int nblk) { phase_s5_finish((const float*)(wsp(P) + WS_YS), (const bf16_t*)(wsp(P) + WS_R1 + R1_UX), P.s5_d + l * 256, (bf16_t*)(wsp(P) + WS_R1 + R1_G), bid, nblk); }
DEVI void ph_glu(const Params& P, int l, int bid, int nblk) {
    const GemmD g = mk_gemm((const bf16_t*)(wsp(P) + WS_R1 + R1_G), (const bf16_t*)(wsp(P) + WS_WGLUT) + (size_t)l * 256 * 256, 256, 256, kTok / 256, 1, nullptr, 0, 1 << 30);
    EpiGlu E; E.g = (const bf16_t*)(wsp(P) + WS_R1 + R1_G); E.oc = (bf16_t*)(wsp(P) + WS_R1 + R1_OC);
    GEMM_RUN(g, E);
}
DEVI void ph_mixnorm(const Params& P, int l, int bid, int nblk) { unsigned char* r1 = wsp(P) + WS_R1;
    phase_mixnorm((const bf16_t*)(wsp(P) + WS_R2), (const float*)(wsp(P) + WS_LSE), (const bf16_t*)(r1 + R1_OB), (const bf16_t*)(r1 + R1_OC), P.out_norm_a + l * 512, P.out_norm_b + l * 256, P.out_norm_c + l * 256, (bf16_t*)(wsp(P) + WS_H), bid, nblk); }
DEVI void ph_wout(const Params& P, int l, int bid, int nblk) {
    const GemmD g = mk_gemm((const bf16_t*)(wsp(P) + WS_H), (const bf16_t*)(wsp(P) + WS_WOUTT) + (size_t)l * kD * kD, kD, kD, kTok / 256, 4, nullptr, 0, 1 << 30);
    EpiResid E; E.x32 = (l == 0) ? P.x : nullptr; E.xb = (bf16_t*)(wsp(P) + WS_XB);
    GEMM_RUN(g, E);
}
DEVI void ph_router(const Params& P, int l, unsigned char* lds, int bid, int nblk) { phase_router((const bf16_t*)(wsp(P) + WS_XB), P.ffn_norm + (size_t)l * kD, P.w_router + (size_t)l * kD * kE, (bf16_t*)(wsp(P) + WS_H), (float*)(wsp(P) + WS_AFF), lds, bid, nblk); }
DEVI void ph_topk(const Params& P, unsigned char* lds, int bid, int nblk) { phase_topk((const float*)(wsp(P) + WS_AFF), (int*)(wsp(P) + WS_IDX), (float*)(wsp(P) + WS_GATE), (int*)(wsp(P) + WS_TSLOT), wsp(P) + WS_H, wsp(P) + WS_R2, FP8_GU ? kD : kD * 2, lds, bid, nblk); }
DEVI void ph_gu(const Params& P, int l, int bid, int nblk) {
#if FP8_GU
    const GemmD g = mk_gemm((const bf16_t*)(wsp(P) + WS_R2), (const bf16_t*)(wsp(P) + WS_WGUT + (size_t)l * kE * 4096 * kD), kD, kD, 512, 16, nullptr, (size_t)4096 * kD, 32);
    EpiGU E; E.hid = (bf16_t*)(wsp(P) + WS_R1); E.sc = 1.f / kW8;
    GEMM_RUN8(g, E);
#else
    const GemmD g = mk_gemm((const bf16_t*)(wsp(P) + WS_R2), (const bf16_t*)(wsp(P) + WS_WGUT) + (size_t)l * kE * 4096 * kD, kD, kD, 512, 16, nullptr, (size_t)4096 * kD, 32);
    EpiGU E; E.hid = (bf16_t*)(wsp(P) + WS_R1); E.sc = 1.f;
    GEMM_RUN(g, E);
#endif
}
DEVI void ph_gu_dry(const Params& P, int l, int bid, int nblk) {
    const GemmD g = mk_gemm((const bf16_t*)(wsp(P) + WS_R2), (const bf16_t*)(wsp(P) + WS_WGUT) + (size_t)l * kE * 4096 * kD, kD, kD, 512, 16, nullptr, (size_t)4096 * kD, 32);
    EpiDry E; E.sink = (float*)(wsp(P) + WS_YS);
    GEMM_RUN(g, E);
}
DEVI void ph_down(const Params& P, int l, int bid, int nblk) {
#if FP8_DN
    const GemmD g = mk_gemm((const bf16_t*)(wsp(P) + WS_R1), (const bf16_t*)(wsp(P) + WS_WDT + (size_t)l * kE * kD * kFF), kFF, kFF, 512, 4, nullptr, (size_t)kD * kFF, 32);
    EpiDown E; E.y = (bf16_t*)(wsp(P) + WS_R2); E.gate = (const float*)(wsp(P) + WS_GATE); E.sc = 1.f / (kW8 * kH8);
    GEMM_RUN8(g, E);
#else
    const GemmD g = mk_gemm((const bf16_t*)(wsp(P) + WS_R1), (const bf16_t*)(wsp(P) + WS_WDT) + (size_t)l * kE * kD * kFF, kFF, kFF, 512, 4, nullptr, (size_t)kD * kFF, 32);
    EpiDown E; E.y = (bf16_t*)(wsp(P) + WS_R2); E.gate = (const float*)(wsp(P) + WS_GATE); E.sc = 1.f;
    GEMM_RUN(g, E);
#endif
}
DEVI void ph_combine(const Params& P, int l, int bid, int nblk) { phase_combine((bf16_t*)(wsp(P) + WS_XB), P.out, (const bf16_t*)(wsp(P) + WS_R2), (const int*)(wsp(P) + WS_TSLOT), (l + 1 < kL) ? P.attn_norm + (size_t)(l + 1) * kD : nullptr, (bf16_t*)(wsp(P) + WS_H), bid, nblk); }

typedef __attribute__((address_space(4))) const Params* CParams;
DEVI CParams kargs() { unsigned long long a = (unsigned long long)__builtin_amdgcn_kernarg_segment_ptr(); asm volatile("" : "+s"(a)); return (CParams)a; }
#if MEGA
__global__ void __launch_bounds__(kNT, 2) mega_fwd(Params P_) {
#define PK P_
    volatile LAS unsigned* st = (volatile LAS unsigned*)(dyn_lds + LDS_BYTES - 16);
    if (threadIdx.x == 0) { st[0] = 0u; st[1] = 0u; st[2] = 0u; st[3] = 0u; }
    __syncthreads();
    const XcdBarrier bar = xcd_barrier_post((unsigned*)(PK.ws + WS_CTL), st);
    const int bid = blockIdx.x, nblk = gridDim.x;
    unsigned char* lds = dyn_lds;
#pragma unroll 1
    for (int rep = 0; rep < PROBE_CONV; ++rep)
    phase_convert(PK, lds, lnd(bid), nblk);
#if USE_S5_GEMM
    ph_s5_prep(PK, lds, lnd(bid), nblk);
#endif
    phase_norm(PK.x, PK.attn_norm, (bf16_t*)(PK.ws + WS_H), lnd(bid), nblk);
    xcd_barrier(bar);
#pragma unroll 1
    for (int l = 0; l < kL; ++l) {
        ph_win(PK, l, lnd(bid), nblk);            xcd_barrier(bar);
#if USE_S5_GEMM
        ph_s5_state(PK, l, lnd(bid), nblk);       xcd_barrier(bar);
        ph_s5_scan(PK, l, lds, lnd(bid), nblk);
#pragma unroll 1
        for (int rep = 0; rep < PROBE_ATTN; ++rep)
        ph_dilated(PK, l, lnd(bid), nblk);
#pragma unroll 1
        for (int rep = 0; rep < PROBE_NA; ++rep)
        ph_na(PK, l, lnd(bid), nblk);             xcd_barrier(bar);
        ph_s5_out(PK, l, lnd(bid), nblk);         xcd_barrier(bar);
#else
        ph_s5(PK, l, lds, lnd(bid), nblk);
        ph_dilated(PK, l, lnd(bid), nblk);
        ph_na(PK, l, lnd(bid), nblk);             xcd_barrier(bar);
        ph_s5fin(PK, l, lnd(bid), nblk);          xcd_barrier(bar);
#endif
        ph_glu(PK, l, lnd(bid), nblk);            xcd_barrier(bar);
#pragma unroll 1
        for (int rep = 0; rep < PROBE_MIX; ++rep) {
        ph_mixnorm(PK, l, lnd(bid), nblk);        xcd_barrier(bar); }
        ph_wout(PK, l, lnd(bid), nblk);           xcd_barrier(bar);
#pragma unroll 1
        for (int rep = 0; rep < PROBE_RT; ++rep) {
        ph_router(PK, l, lds, lnd(bid), nblk);    xcd_barrier(bar); }
#pragma unroll 1
        for (int rep = 0; rep < PROBE_TK; ++rep) {
        ph_topk(PK, lds, lnd(bid), nblk);         xcd_barrier(bar); }
#pragma unroll 1
        for (int rep = 0; rep < PROBE_GU; ++rep) {
        ph_gu(PK, l, lnd(bid), nblk);             xcd_barrier(bar); }
#if PROBE_GUDRY
        ph_gu_dry(PK, l, lnd(bid), nblk);         xcd_barrier(bar);
#endif
#pragma unroll 1
        for (int rep = 0; rep < PROBE_DOWN; ++rep) {
        ph_down(PK, l, lnd(bid), nblk);           xcd_barrier(bar); }
        ph_combine(PK, l, lnd(bid), nblk);        xcd_barrier(bar);
    }
#undef PK
}
#else
#define KB __global__ void __launch_bounds__(kNT, 2)
KB k_convert(Params P) { phase_convert(P, dyn_lds, blockIdx.x, gridDim.x); }
KB k_norm(Params P) { phase_norm(P.x, P.attn_norm, (bf16_t*)(P.ws + WS_H), blockIdx.x, gridDim.x); }
KB k_win(Params P, int l) { ph_win(P, l, blockIdx.x, gridDim.x); }
KB k_dilated(Params P, int l) { ph_dilated(P, l, blockIdx.x, gridDim.x); }
KB k_na(Params P, int l) { ph_na(P, l, blockIdx.x, gridDim.x); }
KB k_s5(Params P, int l) { ph_s5(P, l, dyn_lds, blockIdx.x, gridDim.x); }
KB k_s5fin(Params P, int l) { ph_s5fin(P, l, blockIdx.x, gridDim.x); }
KB k_glu(Params P, int l) { ph_glu(P, l, blockIdx.x, gridDim.x); }
KB k_mixnorm(Params P, int l) { ph_mixnorm(P, l, blockIdx.x, gridDim.x); }
KB k_wout(Params P, int l) { ph_wout(P, l, blockIdx.x, gridDim.x); }
KB k_router(Params P, int l) { ph_router(P, l, dyn_lds, blockIdx.x, gridDim.x); }
KB k_topk(Params P) { ph_topk(P, dyn_lds, blockIdx.x, gridDim.x); }
KB k_gu(Params P, int l) { ph_gu(P, l, blockIdx.x, gridDim.x); }
KB k_down(Params P, int l) { ph_down(P, l, blockIdx.x, gridDim.x); }
KB k_combine(Params P, int l) { ph_combine(P, l, blockIdx.x, gridDim.x); }
#endif

extern "C" void kernel_launch(void* const* d_in, const int* in_sizes, int n_in, void* d_out, int out_size, void* d_ws, size_t ws_size, hipStream_t stream) {
    (void)in_sizes; (void)n_in; (void)out_size;
    if (ws_size < WS_END) { fprintf(stderr, "workspace too small: %zu < %zu\n", ws_size, (size_t)WS_END); return; }
    Params P{};
    const float** pp = (const float**)&P;
    for (int i = 0; i < 26; ++i) pp[i] = (const float*)d_in[i];
    P.out = (float*)d_out; P.ws = (unsigned char*)d_ws;
#if MEGA
    static int grid = 0;
    if (!grid) {
        int dev = 0, cus = 0, per_cu = 0;
        (void)hipGetDevice(&dev);
        (void)hipDeviceGetAttribute(&cus, hipDeviceAttributeMultiprocessorCount, dev);
        (void)hipFuncSetAttribute((const void*)mega_fwd, hipFuncAttributeMaxDynamicSharedMemorySize, LDS_BYTES);
        (void)hipOccupancyMaxActiveBlocksPerMultiprocessor(&per_cu, (const void*)mega_fwd, kNT, LDS_BYTES);
        grid = (per_cu >= 1) ? cus : 0;
        if (!grid) fprintf(stderr, "mega_fwd does not fit a CU\n");
    }
    if (!grid) return;
    (void)hipMemsetAsync(P.ws + WS_CTL, 0, XCD_BAR_WORDS * sizeof(unsigned), stream);
    mega_fwd<<<grid, kNT, LDS_BYTES, stream>>>(P);
#else
    (void)hipFuncSetAttribute((const void*)k_router, hipFuncAttributeMaxDynamicSharedMemorySize, 65536);
    const int G = 1024;
    k_convert<<<G, kNT, 256 * 72 * 2, stream>>>(P);
    k_norm<<<G, kNT, 0, stream>>>(P);
    for (int l = 0; l < kL; ++l) {
        k_win<<<G, kNT, 0, stream>>>(P, l);
        k_dilated<<<G, kNT, 0, stream>>>(P, l);
        k_na<<<G, kNT, 0, stream>>>(P, l);
        k_s5<<<256, kNT, 8 * 128 * 4, stream>>>(P, l);
        k_s5fin<<<G, kNT, 0, stream>>>(P, l);
        k_glu<<<256, kNT, 0, stream>>>(P, l);
        k_mixnorm<<<G, kNT, 0, stream>>>(P, l);
        k_wout<<<G, kNT, 0, stream>>>(P, l);
        k_router<<<512, kNT, 65536, stream>>>(P, l);
        k_topk<<<128, kNT, 4096, stream>>>(P);
        k_gu<<<G, kNT, 0, stream>>>(P, l);
        k_down<<<G, kNT, 0, stream>>>(P, l);
        k_combine<<<G, kNT, 0, stream>>>(P, l);
    }
#endif
}
```

```cpp
#include <hip/hip_runtime.h>
#include <stdint.h>
#include <stdio.h>

#define DEVI __device__ __forceinline__
#define LAS __attribute__((address_space(3)))
typedef unsigned short bf16_t;
typedef short bf16x8 __attribute__((ext_vector_type(8)));
typedef float f32x4 __attribute__((ext_vector_type(4)));
typedef float f32x2 __attribute__((ext_vector_type(2)));
typedef unsigned u32x4 __attribute__((ext_vector_type(4)));
typedef unsigned u32x2 __attribute__((ext_vector_type(2)));

constexpr int kB = 8, kS = 8192, kD = 1024, kL = 4, kTok = kB * kS;
constexpr int kINW = 2560;
constexpr int kE = 16, kCap = 1024, kFF = 2048;
constexpr int kNT = 512;
constexpr float kEps = 1e-6f;
constexpr float kLog2e = 1.4426950408889634f, kLn2 = 0.6931471805599453f;

constexpr size_t MiB = 1024ull * 1024ull;
constexpr size_t WS_CTL   = 0;
constexpr size_t WS_WINT  = 1 * MiB;
constexpr size_t WS_WOUTT = WS_WINT + 20 * MiB;
constexpr size_t WS_WGLUT = WS_WOUTT + 8 * MiB;
constexpr size_t WS_WGUT  = WS_WGLUT + 1 * MiB;
constexpr size_t WS_WDT   = WS_WGUT + 512 * MiB;
constexpr size_t WS_H     = WS_WDT + 256 * MiB;
constexpr size_t WS_R1    = WS_H + 128 * MiB;
constexpr size_t WS_R2    = WS_R1 + 512 * MiB;
constexpr size_t WS_AFF   = WS_R2 + 256 * MiB;
constexpr size_t WS_IDX   = WS_AFF + 4 * MiB;
constexpr size_t WS_GATE  = WS_IDX + 1 * MiB;
constexpr size_t WS_TSLOT = WS_GATE + 1 * MiB;
constexpr size_t WS_LSE   = WS_TSLOT + 4 * MiB;
constexpr size_t WS_WST   = WS_LSE + 8 * MiB;
constexpr size_t WS_WSO   = WS_WST + 8 * MiB;
constexpr size_t WS_YS    = WS_WSO + 16 * MiB;
constexpr size_t WS_XB    = WS_YS;
constexpr size_t WS_END   = WS_YS + 128 * MiB;
constexpr size_t R2_Z     = 192 * MiB;
constexpr size_t R1_QA = 0, R1_KA = 64 * MiB, R1_VA = 128 * MiB, R1_QB = 192 * MiB, R1_KB = 224 * MiB, R1_VB = 256 * MiB,
                 R1_UX = 288 * MiB, R1_OB = 352 * MiB, R1_OC = 384 * MiB, R1_G = 416 * MiB;

struct Params {
    const float* x; const float* attn_norm; const float* w_in; const float* q_norm_a; const float* k_norm_a; const float* q_norm_b; const float* k_norm_b;
    const float* rpb; const float* s5_a_re; const float* s5_a_im; const float* s5_log_dt; const float* s5_b_re; const float* s5_b_im; const float* s5_c_re; const float* s5_c_im;
    const float* s5_d; const float* w_glu; const float* out_norm_a; const float* out_norm_b; const float* out_norm_c; const float* w_out; const float* ffn_norm;
    const float* w_router; const float* w_gate; const float* w_up; const float* w_down;
    float* out; unsigned char* ws;
};

DEVI float bf2f(bf16_t b) { return __uint_as_float(((unsigned)b) << 16); }
DEVI bf16_t f2bf(float f) { unsigned u = __float_as_uint(f); u += 0x7FFFu + ((u >> 16) & 1u); return (bf16_t)(u >> 16); }
typedef __bf16 bf16x2_t __attribute__((ext_vector_type(2)));
DEVI unsigned pk2(float lo, float hi) { const f32x2 v = {lo, hi}; return __builtin_bit_cast(unsigned, __builtin_convertvector(v, bf16x2_t)); }
DEVI int tidx() { int t = threadIdx.x; asm volatile("" : "+v"(t)); return t; }
#define GAS __attribute__((address_space(1)))
DEVI unsigned char* wsp(const Params& P) { unsigned long long a = (unsigned long long)P.ws; asm volatile("" : "+s"(a)); return (unsigned char*)(GAS unsigned char*)a; }
DEVI int lnd(int v) { asm volatile("" : "+s"(v)); return v; }
DEVI float wave_sum(float v) {
#pragma unroll
    for (int m = 32; m >= 1; m >>= 1) v += __shfl_xor(v, m);
    return v;
}
DEVI float frcp(float x) { return __builtin_amdgcn_rcpf(x); }
DEVI float gelu_tanh(float y) { const float z = 0.7978845608028654f * (y + 0.044715f * y * y * y); const float t = 1.f - 2.f * frcp(1.f + __expf(2.f * z)); return 0.5f * y * (1.f + t); }

#ifndef EMU_BF16_X
#define EMU_BF16_X 0
#endif
#ifndef EMU_FP8_WIN
#define EMU_FP8_WIN 0
#endif
#ifndef EMU_FP8_WOUT
#define EMU_FP8_WOUT 0
#endif
#ifndef EMU_FP8_GU
#define EMU_FP8_GU 0
#endif
#ifndef EMU_FP8_DN
#define EMU_FP8_DN 0
#endif
DEVI float q8(float x, float sc, float inv) {
    float y = x * sc; const float ay = fabsf(y);
    if (ay < 0.015625f) y = rintf(y * 512.f) * (1.f / 512.f);
    else { unsigned u = __float_as_uint(y); u += 0x7FFFFu + ((u >> 20) & 1u); u &= 0xFFF00000u; y = __uint_as_float(u); y = fminf(fmaxf(y, -448.f), 448.f); }
    return y * inv;
}
#ifndef FP8_GU
#define FP8_GU 1
#endif
#ifndef FP8_DN
#define FP8_DN 1
#endif
constexpr float kW8 = 64.f, kH8 = 8.f;
DEVI unsigned pk4_fp8(float a, float b, float c, float d) { unsigned w = 0u; w = __builtin_amdgcn_cvt_pk_fp8_f32(a, b, w, false); w = __builtin_amdgcn_cvt_pk_fp8_f32(c, d, w, true); return w; }
DEVI int cmap_head(int cs) { const int bj = cs >> 7, wc = (cs >> 5) & 3, n = (cs >> 4) & 1, fq = (cs >> 2) & 3, j = cs & 3; return 64 * wc + 32 * bj + 8 * fq + 4 * n + j; }
DEVI int cmap_pk(int cs)   { const int bj = cs >> 7, wc = (cs >> 5) & 3, n = (cs >> 4) & 1, fq = (cs >> 2) & 3, j = cs & 3; return 128 * bj + 32 * wc + 8 * fq + 4 * n + j; }
DEVI int cmap_gu(int cs)   { const int wc = (cs >> 5) & 3, n = (cs >> 4) & 1, fq = (cs >> 2) & 3, j = cs & 3; return 32 * wc + 8 * fq + 4 * n + j; }

template <int MODE, int QEMU = 0>
DEVI void convert_item(const float* W0, const float* W1, int ldw, int K, bf16_t* Bt, int kt, int pn, unsigned char* lds) {
    bf16_t* t = (bf16_t*)lds;
    const int tid = tidx();
#pragma unroll 4
    for (int it = 0; it < 32; ++it) {
        const int e = it * kNT + tid, k = e >> 8, cs = e & 255;
        float v;
        if (MODE == 0) v = W0[(size_t)(kt * 64 + k) * ldw + pn * 256 + cs];
        else if (MODE == 1) v = W0[(size_t)(kt * 64 + k) * ldw + pn * 256 + cmap_head(cs)];
        else if (MODE == 2) v = W0[(size_t)(kt * 64 + k) * ldw + pn * 256 + cmap_pk(cs)];
        else v = ((cs >> 7) ? W1 : W0)[(size_t)(kt * 64 + k) * ldw + pn * 128 + cmap_gu(cs)];
        if (QEMU) v = q8(v, 64.f, 1.f / 64.f);
        t[cs * 72 + k] = f2bf(v);
    }
    __syncthreads();
#pragma unroll
    for (int it = 0; it < 4; ++it) {
        const int c = it * kNT + tid, row = c >> 3, part = c & 7;
        const u32x4 v = *(const u32x4*)(t + row * 72 + part * 8);
        *(u32x4*)(Bt + (size_t)(pn * 256 + row) * K + kt * 64 + part * 8) = v;
    }
    __syncthreads();
}

template <int MODE>
DEVI void convert_item8(const float* W0, const float* W1, int ldw, int K, unsigned char* Bt, int kt, int pn, unsigned char* lds) {
    unsigned char* t = lds;
    const int tid = tidx();
#pragma unroll 4
    for (int it = 0; it < 64; ++it) {
        const int e = it * kNT + tid, k = e >> 8, cs = e & 255;
        float v;
        if (MODE == 2) v = W0[(size_t)(kt * 128 + k) * ldw + pn * 256 + cmap_pk(cs)];
        else v = ((cs >> 7) ? W1 : W0)[(size_t)(kt * 128 + k) * ldw + pn * 128 + cmap_gu(cs)];
        v *= kW8;
        t[cs * 144 + k] = (unsigned char)(__builtin_amdgcn_cvt_pk_fp8_f32(v, v, 0u, false) & 0xFFu);
    }
    __syncthreads();
#pragma unroll
    for (int it = 0; it < 4; ++it) {
        const int c = it * kNT + tid, row = c >> 3, part = c & 7;
        const u32x4 v = *(const u32x4*)(t + row * 144 + part * 16);
        *(u32x4*)(Bt + (size_t)(pn * 256 + row) * K + kt * 128 + part * 16) = v;
    }
    __syncthreads();
}

DEVI void phase_convert(const Params& P, unsigned char* lds, int bid, int nblk) {
    constexpr int N_WIN = kL * 16 * 10, N_WOUT = kL * 16 * 4, N_WGLU = kL * 4 * 1, N_WGU = kL * kE * (FP8_GU ? 8 : 16) * 16, N_WD = kL * kE * (FP8_DN ? 16 : 32) * 4;
    constexpr int TOT = N_WIN + N_WOUT + N_WGLU + N_WGU + N_WD;
    for (int it = bid; it < TOT; it += nblk) {
        int i = it;
        if (i < N_WIN) { const int l = i / 160, r = i % 160, kt = r / 10, pn = r % 10;
            convert_item<1, EMU_FP8_WIN>(P.w_in + (size_t)l * kD * kINW, nullptr, kINW, kD, (bf16_t*)(wsp(P) + WS_WINT) + (size_t)l * kINW * kD, kt, pn, lds); continue; }
        i -= N_WIN;
        if (i < N_WOUT) { const int l = i / 64, r = i % 64, kt = r / 4, pn = r % 4;
            convert_item<2, EMU_FP8_WOUT>(P.w_out + (size_t)l * kD * kD, nullptr, kD, kD, (bf16_t*)(wsp(P) + WS_WOUTT) + (size_t)l * kD * kD, kt, pn, lds); continue; }
        i -= N_WOUT;
        if (i < N_WGLU) { const int l = i / 4, kt = i % 4;
            convert_item<2>(P.w_glu + (size_t)l * 256 * 256, nullptr, 256, 256, (bf16_t*)(wsp(P) + WS_WGLUT) + (size_t)l * 256 * 256, kt, 0, lds); continue; }
        i -= N_WGLU;
#if FP8_GU
        if (i < N_WGU) { const int le = i / 128, r = i % 128, kt = r / 16, pn = r % 16;
            convert_item8<3>(P.w_gate + (size_t)le * kD * kFF, P.w_up + (size_t)le * kD * kFF, kFF, kD, wsp(P) + WS_WGUT + (size_t)le * 4096 * kD, kt, pn, lds); continue; }
#else
        if (i < N_WGU) { const int le = i / 256, r = i % 256, kt = r / 16, pn = r % 16;
            convert_item<3, EMU_FP8_GU>(P.w_gate + (size_t)le * kD * kFF, P.w_up + (size_t)le * kD * kFF, kFF, kD, (bf16_t*)(wsp(P) + WS_WGUT) + (size_t)le * 4096 * kD, kt, pn, lds); continue; }
#endif
        i -= N_WGU;
#if FP8_DN
        { const int le = i / 64, r = i % 64, kt = r / 4, pn = r % 4;
            convert_item8<2>(P.w_down + (size_t)le * kFF * kD, nullptr, kD, kFF, wsp(P) + WS_WDT + (size_t)le * kD * kFF, kt, pn, lds); }
#else
        { const int le = i / 128, r = i % 128, kt = r / 4, pn = r % 4;
            convert_item<2, EMU_FP8_DN>(P.w_down + (size_t)le * kFF * kD, nullptr, kD, kFF, (bf16_t*)(wsp(P) + WS_WDT) + (size_t)le * kD * kFF, kt, pn, lds); }
#endif
    }
}

DEVI void phase_norm(const float* x, const float* gain, bf16_t* h, int bid, int nblk) {
    const int wid = tidx() >> 6, lane = tidx() & 63;
    f32x4 g[4];
#pragma unroll
    for (int q = 0; q < 4; ++q) g[q] = *(const f32x4*)(gain + q * 256 + lane * 4);
    for (int row = bid * 8 + wid; row < kTok; row += nblk * 8) {
        f32x4 v[4]; float ss = 0.f;
#pragma unroll
        for (int q = 0; q < 4; ++q) { v[q] = *(const f32x4*)(x + (size_t)row * kD + q * 256 + lane * 4); ss += v[q].x * v[q].x + v[q].y * v[q].y + v[q].z * v[q].z + v[q].w * v[q].w; }
        ss = wave_sum(ss);
        const float rstd = rsqrtf(ss * (1.f / kD) + kEps);
#pragma unroll
        for (int q = 0; q < 4; ++q) { f32x4 t = v[q] * rstd * g[q]; if (EMU_FP8_WIN) { t.x = q8(t.x, 1.f, 1.f); t.y = q8(t.y, 1.f, 1.f); t.z = q8(t.z, 1.f, 1.f); t.w = q8(t.w, 1.f, 1.f); }
            u32x2 o; o.x = pk2(t.x, t.y); o.y = pk2(t.z, t.w);
            *(u32x2*)(h + (size_t)row * kD + q * 256 + lane * 4) = o; }
    }
}

DEVI void phase_router(const bf16_t* x, const float* gain, const float* wr  , bf16_t* h, float* aff, unsigned char* lds, int bid, int nblk) {
    float* wT = (float*)lds;
    for (int i = tidx(); i < 16 * 1024; i += kNT) { const int k = i >> 4, e = i & 15; wT[e * 1024 + k] = wr[i]; }
    __syncthreads();
    const int wid = tidx() >> 6, lane = tidx() & 63;
    f32x4 g[4];
#pragma unroll
    for (int q = 0; q < 4; ++q) g[q] = *(const f32x4*)(gain + q * 256 + lane * 4);
    u32x2 nvx[2][4];
    { const int r0 = (bid * 8 + wid) * 2;
      if (r0 < kTok) {
#pragma unroll
        for (int r = 0; r < 2; ++r)
#pragma unroll
            for (int q = 0; q < 4; ++q) nvx[r][q] = *(const u32x2*)(x + (size_t)(r0 + r) * kD + q * 256 + lane * 4); } }
    for (int row0 = (bid * 8 + wid) * 2; row0 < kTok; row0 += nblk * 8 * 2) {
        asm volatile("" ::: "memory");
        f32x4 v[2][4];
#pragma unroll
        for (int r = 0; r < 2; ++r)
#pragma unroll
            for (int q = 0; q < 4; ++q) { const u32x2 w = nvx[r][q]; v[r][q] = (f32x4){__uint_as_float(w.x << 16), __uint_as_float(w.x & 0xFFFF0000u), __uint_as_float(w.y << 16), __uint_as_float(w.y & 0xFFFF0000u)}; }
        { const int nr0 = row0 + nblk * 8 * 2;
          if (nr0 < kTok) {
#pragma unroll
            for (int r = 0; r < 2; ++r)
#pragma unroll
                for (int q = 0; q < 4; ++q) nvx[r][q] = *(const u32x2*)(x + (size_t)(nr0 + r) * kD + q * 256 + lane * 4); } }
#pragma unroll
        for (int r = 0; r < 2; ++r) { float ss = 0.f;
#pragma unroll
            for (int q = 0; q < 4; ++q) { ss += v[r][q].x * v[r][q].x + v[r][q].y * v[r][q].y + v[r][q].z * v[r][q].z + v[r][q].w * v[r][q].w; }
            ss = wave_sum(ss); const float rstd = rsqrtf(ss * (1.f / kD) + kEps);
#pragma unroll
            for (int q = 0; q < 4; ++q) { v[r][q] = v[r][q] * rstd * g[q];
#if FP8_GU
                *(unsigned*)((unsigned char*)h + (size_t)(row0 + r) * kD + q * 256 + lane * 4) = pk4_fp8(v[r][q].x, v[r][q].y, v[r][q].z, v[r][q].w); }
#else
                u32x2 o;
                if (EMU_FP8_GU) { o.x = pk2(q8(v[r][q].x, 1.f, 1.f), q8(v[r][q].y, 1.f, 1.f)); o.y = pk2(q8(v[r][q].z, 1.f, 1.f), q8(v[r][q].w, 1.f, 1.f)); }
                else { o.x = pk2(v[r][q].x, v[r][q].y); o.y = pk2(v[r][q].z, v[r][q].w); }
                *(u32x2*)(h + (size_t)(row0 + r) * kD + q * 256 + lane * 4) = o; }
#endif
        }
        float pa[32];
#pragma unroll
        for (int e = 0; e < 16; ++e) {
            float s0 = 0.f, s1 = 0.f;
#pragma unroll
            for (int q = 0; q < 4; ++q) { const f32x4 w = *(const f32x4*)(wT + e * 1024 + q * 256 + lane * 4);
                s0 += v[0][q].x * w.x + v[0][q].y * w.y + v[0][q].z * w.z + v[0][q].w * w.w;
                s1 += v[1][q].x * w.x + v[1][q].y * w.y + v[1][q].z * w.z + v[1][q].w * w.w; }
            pa[e] = s0; pa[16 + e] = s1;
        }
#define RS_STEP(HALF, MASK) { const bool up = (lane & (MASK)) != 0; _Pragma("unroll") for (int i = 0; i < (HALF); ++i) { const float keep = up ? pa[i + (HALF)] : pa[i], send = up ? pa[i] : pa[i + (HALF)]; pa[i] = keep + __shfl_xor(send, (MASK)); } }
        RS_STEP(16, 32) RS_STEP(8, 16) RS_STEP(4, 8) RS_STEP(2, 4) RS_STEP(1, 2)
#undef RS_STEP
        const float logit = pa[0] + __shfl_xor(pa[0], 1);
        float mx = logit;
#pragma unroll
        for (int m = 16; m >= 2; m >>= 1) mx = fmaxf(mx, __shfl_xor(mx, m));
        const float ex = __expf(logit - mx);
        float sm = ex;
#pragma unroll
        for (int m = 16; m >= 2; m >>= 1) sm += __shfl_xor(sm, m);
        const int row = row0 + (lane >> 5), e = (lane >> 1) & 15, b = row >> 13, s = row & (kS - 1);
        if (!(lane & 1)) aff[((size_t)(b * kE + e)) * kS + s] = ex * frcp(sm);
    }
    __syncthreads();
}

DEVI int block_excl_scan(int v, int* sh  , int& total) {
    const int lane = tidx() & 63, wid = tidx() >> 6;
    int incl = v;
#pragma unroll
    for (int d = 1; d < 64; d <<= 1) { const int o = __shfl_up(incl, d); if (lane >= d) incl += o; }
    __syncthreads();
    if (lane == 63) sh[wid] = incl;
    __syncthreads();
    int base = 0, tot = 0;
#pragma unroll
    for (int w = 0; w < 8; ++w) { const int c = sh[w]; if (w < wid) base += c; tot += c; }
    total = tot;
    return base + incl - v;
}

DEVI void phase_topk(const float* aff, int* idx, float* gate, int* tokslot, const unsigned char* hsrc, unsigned char* xe, int rowbytes, unsigned char* lds, int bid, int nblk) {
    int* hist = (int*)lds;
    int* sh = hist + 256;
    int* res = sh + 16;
    int* lsel = res + 16;
    const int tid = tidx(), lane = tid & 63, wid = tid >> 6;
    const int share = (nblk >= 2 * kB * kE) ? 2 : 1;
    for (int wi = bid; wi < kB * kE * share; wi += nblk) {
        const int item = wi / share, part = wi - item * share;
        const int b = item >> 4, e = item & 15;
        const float* a = aff + (size_t)item * kS;
        unsigned key[16];
#pragma unroll
        for (int q = 0; q < 4; ++q) { const u32x4 v = *(const u32x4*)(a + tid * 16 + q * 4); key[q * 4 + 0] = v.x; key[q * 4 + 1] = v.y; key[q * 4 + 2] = v.z; key[q * 4 + 3] = v.w; }
        unsigned prefix = 0; int kk = kCap;
#pragma unroll 1
        for (int pass = 0; pass < 4; ++pass) {
            const int shift = 24 - 8 * pass;
            __syncthreads();
            if (tid < 256) hist[tid] = 0;
            __syncthreads();
#pragma unroll
            for (int i = 0; i < 16; ++i) { const bool in = (pass == 0) || ((key[i] >> (shift + 8)) == prefix); if (in) atomicAdd(&hist[(key[i] >> shift) & 255], 1); }
            __syncthreads();
            if (wid == 0) {
                int c[4], loc = 0;
#pragma unroll
                for (int j = 0; j < 4; ++j) { c[j] = hist[255 - 4 * lane - j]; loc += c[j]; }
                int incl = loc;
#pragma unroll
                for (int d = 1; d < 64; d <<= 1) { const int o = __shfl_up(incl, d); if (lane >= d) incl += o; }
                const int excl = incl - loc;
                if (excl < kk && kk <= incl) { int run = excl; int bin = 0, nk = 0; bool found = false;
#pragma unroll
                    for (int j = 0; j < 4; ++j) { if (!found && run + c[j] >= kk) { bin = 255 - 4 * lane - j; nk = kk - run; found = true; } if (!found) run += c[j]; }
                    res[0] = bin; res[1] = nk; }
            }
            __syncthreads();
            prefix = (prefix << 8) | (unsigned)res[0]; kk = res[1];
        }
        const unsigned T = prefix;
        int ceq = 0;
#pragma unroll
        for (int i = 0; i < 16; ++i) ceq += (key[i] == T) ? 1 : 0;
        int tot;
        int eqb = block_excl_scan(ceq, sh, tot);
        int csel = 0; unsigned selmask = 0;
#pragma unroll
        for (int i = 0; i < 16; ++i) { bool s = key[i] > T; if (key[i] == T) { s = eqb < kk; ++eqb; } if (s) { selmask |= 1u << i; ++csel; } }
        int slot = block_excl_scan(csel, sh, tot);
        const size_t rbase = (size_t)(e * kB + b) * kCap;
#pragma unroll
        for (int i = 0; i < 16; ++i) { const int s = tid * 16 + i; const bool sel = (selmask >> i) & 1u;
            if (sel) { if (part == 0) { idx[rbase + slot] = b * kS + s; gate[rbase + slot] = __uint_as_float(key[i]); } lsel[slot] = b * kS + s; }
            if (part == 0) tokslot[((size_t)(b * kS + s)) * kE + e] = sel ? slot : -1;
            if (sel) ++slot; }
        __syncthreads();
        { const int cpr = rowbytes >> 4;
          const int cbeg = part * (kCap / share) * cpr, cend = cbeg + (kCap / share) * cpr;
          for (int c0 = cbeg + tid; c0 < cend; c0 += kNT * 4) {
              u32x4 v[4];
#pragma unroll
              for (int j = 0; j < 4; ++j) { const int c = c0 + j * kNT; const int r = c / cpr, ch = c - r * cpr; v[j] = *(const u32x4*)(hsrc + (size_t)lsel[r] * rowbytes + ch * 16); }
#pragma unroll
              for (int j = 0; j < 4; ++j) { const int c = c0 + j * kNT; const int r = c / cpr, ch = c - r * cpr; *(u32x4*)(xe + (rbase + r) * rowbytes + ch * 16) = v[j]; }
          } }
    }
    __syncthreads();
}

struct Unit { int pm, pn; };
DEVI bool unit_of(int Lid, int nM, int nN, Unit& u) {
    const int nwg = nM * nN; if (Lid >= nwg) return false;
    int wgid = Lid; { const int q = nwg / 8, r = nwg % 8, xcd = wgid % 8, off = wgid / 8; wgid = (xcd < r ? xcd * (q + 1) : r * (q + 1) + (xcd - r) * q) + off; }
    const int nig = 8 * nN, gid = wgid / nig, fm = gid * 8, gsz = (nM - fm) < 8 ? (nM - fm) : 8;
    u.pm = fm + ((wgid % nig) % gsz); u.pn = (wgid % nig) / gsz; return true;
}
struct GemmD { const bf16_t* A; const bf16_t* Bt; int lda, K, nM, nN; const int* rowidx; size_t bstride; int pmg; };

template <class Epi>
DEVI void gemm_simple(const GemmD g, const Epi& E, int bid, int nblk) {
    const int tid = tidx(), wid = tid >> 6, lane = tid & 63, wr = wid >> 2, wc = wid & 3, fr = lane & 15, fq = lane >> 4;
    for (int i = 0;; ++i) {
        Unit u; if (!unit_of(i * nblk + bid, g.nM, g.nN, u)) break;
        f32x4 acc[2][2][4][2];
#pragma unroll
        for (int a = 0; a < 2; ++a)
#pragma unroll
            for (int b = 0; b < 2; ++b)
#pragma unroll
                for (int m = 0; m < 4; ++m)
#pragma unroll
                    for (int n = 0; n < 2; ++n) acc[a][b][m][n] = (f32x4){0.f, 0.f, 0.f, 0.f};
        const bf16_t* Bu = g.Bt + (size_t)(u.pm / g.pmg) * g.bstride + (size_t)u.pn * 256 * g.K;
        unsigned ao[2][4], bo[2][2];
#pragma unroll
        for (int a = 0; a < 2; ++a)
#pragma unroll
            for (int m = 0; m < 4; ++m) { const int r = u.pm * 256 + 128 * a + 64 * wr + 16 * m + fr; const unsigned rr = g.rowidx ? (unsigned)g.rowidx[r] : (unsigned)r; ao[a][m] = rr * (unsigned)g.lda + 8u * fq; }
#pragma unroll
        for (int b = 0; b < 2; ++b)
#pragma unroll
            for (int n = 0; n < 2; ++n) bo[b][n] = (unsigned)(128 * b + 32 * wc + 16 * n + fr) * (unsigned)g.K + 8u * fq;
#pragma unroll 1
        for (int k0 = 0; k0 < g.K; k0 += 32) {
            bf16x8 av[2][4], bv[2][2];
#pragma unroll
            for (int a = 0; a < 2; ++a)
#pragma unroll
                for (int m = 0; m < 4; ++m) av[a][m] = *(const bf16x8*)(g.A + ao[a][m] + k0);
#pragma unroll
            for (int b = 0; b < 2; ++b)
#pragma unroll
                for (int n = 0; n < 2; ++n) bv[b][n] = *(const bf16x8*)(Bu + bo[b][n] + k0);
#pragma unroll
            for (int a = 0; a < 2; ++a)
#pragma unroll
                for (int b = 0; b < 2; ++b)
#pragma unroll
                    for (int m = 0; m < 4; ++m)
#pragma unroll
                        for (int n = 0; n < 2; ++n) acc[a][b][m][n] = __builtin_amdgcn_mfma_f32_16x16x32_bf16(bv[b][n], av[a][m], acc[a][b][m][n], 0, 0, 0);
        }
        E(acc, u, wr, wc, fr, fq);
    }
}


constexpr int PG_HTB = 128 * 64 * 2;
DEVI int pg_lds_byte(int r, int c) { const int st = (r >> 4) * 2 + (c >> 5), rr = r & 15, cc = c & 31, ob = rr * 64 + cc * 2; return st * 1024 + (ob ^ (((ob >> 9) & 1) << 5)); }
DEVI void pg_stage_rc(int b, int& R, int& C) { const int st = b / 1024, sb = b % 1024, swz = sb ^ (((sb >> 9) & 1) << 5); R = (st >> 1) * 16 + swz / 64; C = (st & 1) * 32 + (swz % 64) / 2; }

typedef int v4i __attribute__((ext_vector_type(4)));
typedef int v8i __attribute__((ext_vector_type(8)));
template <class Epi, bool ALIGN_EPI, bool SP2, bool FP8 = false>
DEVI void gemm_engine(LAS unsigned char* lds, const GemmD g, const Epi& E, int bid, int nblk) {
    const int tid = tidx(), wid = __builtin_amdgcn_readfirstlane(tid >> 6), lane = tid & 63, wr = wid >> 2, wc = wid & 3, fr = lane & 15, fq = lane >> 4;
    constexpr int ES = FP8 ? 1 : 2;
    const int K = g.K * ES  , nt = K / 128; const unsigned ldaB = (unsigned)g.lda * ES;
    unsigned voffA[2], voffB[2];
#pragma unroll
    for (int i = 0; i < 2; ++i) { int R, C; pg_stage_rc(tid * 16 + i * 8192, R, C); voffA[i] = (unsigned)R * ldaB + (unsigned)C * 2u; voffB[i] = (unsigned)(R * K + C * 2); }
    const size_t kstep = 128;
    const size_t hstepB = (size_t)128 * K, hstepA = (size_t)128 * ldaB, tstepA = 2 * hstepA;
    const unsigned ldsw = (unsigned)wid * 1024u;
    const int aoff = pg_lds_byte(wr * 64 + fr, fq * 8), boff = pg_lds_byte(wc * 32 + fr, fq * 8);
#define PG8_SA(b, h) (((b) * 2 + (h)) * PG_HTB)
#define PG8_SB(b, h) ((4 + (b) * 2 + (h)) * PG_HTB)
#define PG8_STAGE(bufoff, gbase, voff) do { _Pragma("unroll") for (int _i = 0; _i < 2; ++_i) \
        __builtin_amdgcn_global_load_lds((const unsigned*)((const char*)(gbase) + (voff)[_i]), (LAS unsigned*)(lds + (bufoff) + ldsw + _i * 8192), 16, 0, 0); } while (0)
#define PG8_RD16(off) (*(const LAS v4i*)(lds + (off)))
#define PG8_CAT2(off) __builtin_shufflevector(PG8_RD16(off), PG8_RD16((off) + 1024), 0, 1, 2, 3, 4, 5, 6, 7)
#define PG8_LDA(dst, b, h) do { _Pragma("unroll") for (int m = 0; m < 4; ++m) { if constexpr (FP8) dst##8[m] = PG8_CAT2(PG8_SA(b, h) + aoff + m * 2048); \
        else { _Pragma("unroll") for (int k = 0; k < 2; ++k) dst[m][k] = *(const LAS bf16x8*)(lds + PG8_SA(b, h) + aoff + m * 2048 + k * 1024); } } } while (0)
#define PG8_LDB(dst, b, h) do { _Pragma("unroll") for (int n = 0; n < 2; ++n) { if constexpr (FP8) dst##8[n] = PG8_CAT2(PG8_SB(b, h) + boff + n * 2048); \
        else { _Pragma("unroll") for (int k = 0; k < 2; ++k) dst[n][k] = *(const LAS bf16x8*)(lds + PG8_SB(b, h) + boff + n * 2048 + k * 1024); } } } while (0)
#define PG8_MMA(ai, bj, At, Bt) do { __builtin_amdgcn_s_setprio(1); _Pragma("unroll") for (int m = 0; m < 4; ++m) _Pragma("unroll") for (int n = 0; n < 2; ++n) { \
        if constexpr (FP8) asm volatile("v_mfma_f32_16x16x128_f8f6f4 %0, %1, %2, %0" : "+v"(acc[ai][bj][m][n]) : "v"(Bt##8[n]), "v"(At##8[m]));   \
        else { _Pragma("unroll") for (int k = 0; k < 2; ++k) acc[ai][bj][m][n] = __builtin_amdgcn_mfma_f32_16x16x32_bf16(Bt[n][k], At[m][k], acc[ai][bj][m][n], 0, 0, 0); } } \
        __builtin_amdgcn_s_setprio(0); } while (0)
#define PG8_WAIT_V(n) asm volatile("s_waitcnt vmcnt(" #n ")" ::: "memory")
#define PG8_WAIT_L(n) asm volatile("s_waitcnt lgkmcnt(" #n ")" ::: "memory")
#define PG8_BAR __builtin_amdgcn_s_barrier()
#define PG8_SCHED __builtin_amdgcn_sched_barrier(0)
    Unit cur, nxt; int ui = 0;
    if (!unit_of(bid, g.nM, g.nN, cur)) return;
    f32x4 acc[2][2][4][2];
#pragma unroll
    for (int a = 0; a < 2; ++a)
#pragma unroll
        for (int b = 0; b < 2; ++b)
#pragma unroll
            for (int m = 0; m < 4; ++m)
#pragma unroll
                for (int n = 0; n < 2; ++n) acc[a][b][m][n] = (f32x4){0.f, 0.f, 0.f, 0.f};
    bf16x8 At[4][2], B0[2][2], B1[2][2]; v8i At8[4], B08[2], B18[2];
    (void)At; (void)B0; (void)B1; (void)At8; (void)B08; (void)B18;
    static_assert(SP2, "only the two-super-phase K-loop is kept");
    const char* cA = (const char*)g.A + (size_t)cur.pm * tstepA;
    const char* cB = (const char*)g.Bt + (size_t)(cur.pm / g.pmg) * g.bstride * ES + (size_t)cur.pn * 256 * K;
    PG8_STAGE(PG8_SB(0, 0), cB, voffB); PG8_STAGE(PG8_SB(0, 1), cB + hstepB, voffB); PG8_STAGE(PG8_SA(0, 0), cA, voffA); PG8_STAGE(PG8_SA(0, 1), cA + hstepA, voffA);
    if (wr == 1) PG8_BAR;
    PG8_WAIT_V(2); PG8_BAR;
    PG8_STAGE(PG8_SB(1, 0), cB + kstep, voffB); PG8_STAGE(PG8_SA(1, 0), cA + kstep, voffA); PG8_STAGE(PG8_SB(1, 1), cB + hstepB + kstep, voffB);
    PG8_WAIT_V(6); PG8_BAR;
    for (;;) {
        const bool has_next = unit_of((ui + 1) * nblk + bid, g.nM, g.nN, nxt);
        const char* nA = has_next ? (const char*)g.A + (size_t)nxt.pm * tstepA : cA;
        const char* nB = has_next ? (const char*)g.Bt + (size_t)(nxt.pm / g.pmg) * g.bstride * ES + (size_t)nxt.pn * 256 * K : cB;
#pragma unroll 1
        for (int t = 0; t < nt; t += 2) {
            const bool last = (t == nt - 2);
            const char* a1 = cA + (size_t)(t + 1) * kstep;
            const char* a2 = last ? nA : cA + (size_t)(t + 2) * kstep; const char* b2 = last ? nB : cB + (size_t)(t + 2) * kstep;
            const char* a3 = a2 + kstep; const char* b3 = b2 + kstep;
            PG8_LDB(B0, 0, 0); PG8_LDB(B1, 0, 1); PG8_SCHED; PG8_LDA(At, 0, 0); PG8_STAGE(PG8_SA(1, 1), a1 + hstepA, voffA);
            PG8_WAIT_V(8); PG8_WAIT_L(0); PG8_BAR; PG8_MMA(0, 0, At, B0); PG8_MMA(0, 1, At, B1); PG8_BAR; PG8_SCHED;
            PG8_LDA(At, 0, 1); PG8_STAGE(PG8_SB(0, 0), b2, voffB); PG8_STAGE(PG8_SB(0, 1), b2 + hstepB, voffB); PG8_STAGE(PG8_SA(0, 0), a2, voffA);
            PG8_WAIT_V(8); PG8_WAIT_L(0); PG8_BAR; PG8_MMA(1, 0, At, B0); PG8_MMA(1, 1, At, B1); PG8_BAR; PG8_SCHED;
            PG8_LDB(B0, 1, 0); PG8_LDB(B1, 1, 1); PG8_SCHED; PG8_LDA(At, 1, 0); PG8_STAGE(PG8_SA(0, 1), a2 + hstepA, voffA);
            PG8_WAIT_V(8); PG8_WAIT_L(0); PG8_BAR; PG8_MMA(0, 0, At, B0); PG8_MMA(0, 1, At, B1); PG8_BAR; PG8_SCHED;
            PG8_LDA(At, 1, 1); PG8_STAGE(PG8_SB(1, 0), b3, voffB); PG8_STAGE(PG8_SB(1, 1), b3 + hstepB, voffB); PG8_STAGE(PG8_SA(1, 0), a3, voffA);
            PG8_WAIT_V(8); PG8_WAIT_L(0); PG8_BAR; PG8_MMA(1, 0, At, B0); PG8_MMA(1, 1, At, B1); PG8_BAR; PG8_SCHED;
        }
        if constexpr (ALIGN_EPI) { if (wr == 0) PG8_BAR; }
        if constexpr (FP8) asm volatile("s_nop 15\n\ts_nop 15" ::: "memory");
        E(acc, cur, wr, wc, fr, fq);
        if (!has_next) break;
#pragma unroll
        for (int a = 0; a < 2; ++a)
#pragma unroll
            for (int b = 0; b < 2; ++b)
#pragma unroll
                for (int m = 0; m < 4; ++m)
#pragma unroll
                    for (int n = 0; n < 2; ++n) acc[a][b][m][n] = (f32x4){0.f, 0.f, 0.f, 0.f};
        cur = nxt; cA = nA; cB = nB; ++ui;
        if constexpr (ALIGN_EPI) { if (wr == 1) PG8_BAR; }
    }
    PG8_WAIT_V(0);
    if constexpr (!ALIGN_EPI) { if (wr == 0) PG8_BAR; }
    PG8_BAR;
#undef PG8_SA
#undef PG8_SB
#undef PG8_STAGE
#undef PG8_LDA
#undef PG8_LDB
#undef PG8_MMA
#undef PG8_RD16
#undef PG8_CAT2
#undef PG8_WAIT_V
#undef PG8_WAIT_L
#undef PG8_BAR
#undef PG8_SCHED
}

struct EpiQKV {
    static constexpr int VMOPS = 16;
    bf16_t *qa, *ka, *va, *qb, *kb, *vb, *ux; const float *qna, *kna, *qnb, *knb;
    DEVI void operator()(const f32x4 (&acc)[2][2][4][2], const Unit& u, int wr, int wc, int fr, int fq) const {
        bf16_t* dst; const float* gn = nullptr; int H = 8, head0 = 0; const int pn = u.pn;
        if (pn < 2) { dst = qa; gn = qna; head0 = pn * 4; }
        else if (pn < 4) { dst = ka; gn = kna; head0 = (pn - 2) * 4; }
        else if (pn < 6) { dst = va; head0 = (pn - 4) * 4; }
        else if (pn == 6) { dst = qb; gn = qnb; H = 4; }
        else if (pn == 7) { dst = kb; gn = knb; H = 4; }
        else if (pn == 8) { dst = vb; H = 4; }
        else { dst = ux; }
        const int head = head0 + wc;
        f32x4 gv[2][2];
#pragma unroll
        for (int bj = 0; bj < 2; ++bj)
#pragma unroll
            for (int n = 0; n < 2; ++n) gv[bj][n] = gn ? *(const f32x4*)(gn + 32 * bj + 8 * fq + 4 * n) : (f32x4){1.f, 1.f, 1.f, 1.f};
#pragma unroll
        for (int ai = 0; ai < 2; ++ai)
#pragma unroll
            for (int m = 0; m < 4; ++m) {
                const int row = u.pm * 256 + 128 * ai + 64 * wr + 16 * m + fr;
                float rstd = 1.f;
                if (gn) { float ss = 0.f;
#pragma unroll
                    for (int bj = 0; bj < 2; ++bj)
#pragma unroll
                        for (int n = 0; n < 2; ++n) { const f32x4 v = acc[ai][bj][m][n]; ss += v.x * v.x + v.y * v.y + v.z * v.z + v.w * v.w; }
                    ss += __shfl_xor(ss, 16); ss += __shfl_xor(ss, 32);
                    rstd = rsqrtf(ss * (1.f / 64.f) + kEps); }
#pragma unroll
                for (int bj = 0; bj < 2; ++bj) {
                    const f32x4 v0 = acc[ai][bj][m][0] * rstd * gv[bj][0], v1 = acc[ai][bj][m][1] * rstd * gv[bj][1];
                    u32x4 w; w.x = pk2(v0.x, v0.y); w.y = pk2(v0.z, v0.w); w.z = pk2(v1.x, v1.y); w.w = pk2(v1.z, v1.w);
                    if (pn < 9) { const int b = row >> 13, s = row & (kS - 1);
                        *(u32x4*)(dst + (((size_t)(b * H + head)) * kS + s) * 64 + 32 * bj + 8 * fq) = w; }
                    else { const int gidx = 4 * wc + 2 * bj + (fq >> 1), c0 = 8 * (fq & 1);
                        *(u32x4*)(dst + ((size_t)gidx * 4096 + (row >> 4)) * 512 + (row & 15) * 16 + c0) = w; }
                }
            }
    }
};
struct EpiResid {
    static constexpr int VMOPS = 16;
    const float* x32; bf16_t* xb;
    DEVI void operator()(const f32x4 (&acc)[2][2][4][2], const Unit& u, int wr, int wc, int fr, int fq) const {
#pragma unroll
        for (int ai = 0; ai < 2; ++ai)
#pragma unroll
            for (int m = 0; m < 4; ++m) { const size_t ro = (size_t)(u.pm * 256 + 128 * ai + 64 * wr + 16 * m + fr) * kD + u.pn * 256 + 32 * wc + 8 * fq;
#pragma unroll
                for (int bj = 0; bj < 2; ++bj) { const size_t o = ro + 128 * bj; f32x4 v0, v1;
                    if (x32) { v0 = *(const f32x4*)(x32 + o); v1 = *(const f32x4*)(x32 + o + 4); }
                    else { const u32x4 w = *(const u32x4*)(xb + o); v0 = (f32x4){__uint_as_float(w.x << 16), __uint_as_float(w.x & 0xFFFF0000u), __uint_as_float(w.y << 16), __uint_as_float(w.y & 0xFFFF0000u)};
                        v1 = (f32x4){__uint_as_float(w.z << 16), __uint_as_float(w.z & 0xFFFF0000u), __uint_as_float(w.w << 16), __uint_as_float(w.w & 0xFFFF0000u)}; }
                    v0 += acc[ai][bj][m][0]; v1 += acc[ai][bj][m][1];
                    u32x4 r; r.x = pk2(v0.x, v0.y); r.y = pk2(v0.z, v0.w); r.z = pk2(v1.x, v1.y); r.w = pk2(v1.z, v1.w);
                    *(u32x4*)(xb + o) = r; } }
    }
};
struct EpiGU {
    static constexpr int VMOPS = 8;
    bf16_t* hid; float sc; bool nomath;
    DEVI void operator()(const f32x4 (&acc)[2][2][4][2], const Unit& u, int wr, int wc, int fr, int fq) const {
#pragma unroll
        for (int ai = 0; ai < 2; ++ai)
#pragma unroll
            for (int m = 0; m < 4; ++m) { const size_t row = (size_t)(u.pm * 256 + 128 * ai + 64 * wr + 16 * m + fr);
                float o[8];
                const float k1 = -sc * kLog2e, k2 = sc * sc * (FP8_DN ? kH8 : 1.f);
#pragma unroll
                for (int n = 0; n < 2; ++n)
#pragma unroll
                    for (int j = 0; j < 4; j += 2) { const f32x2 a = {acc[ai][0][m][n][j], acc[ai][0][m][n][j + 1]}, b = {acc[ai][1][m][n][j], acc[ai][1][m][n][j + 1]};
                        const f32x2 ab = a * b, t = a * k1; f32x2 d; d.x = __builtin_amdgcn_exp2f(t.x); d.y = __builtin_amdgcn_exp2f(t.y); d = d + 1.f;
                        f32x2 r; r.x = frcp(d.x); r.y = frcp(d.y); const f32x2 v = nomath ? ab * k2 : (ab * r) * k2;
                        o[n * 4 + j] = v.x; o[n * 4 + j + 1] = v.y; }
#if FP8_DN
                u32x2 w;
#pragma unroll
                for (int t = 0; t < 8; ++t) o[t] = __builtin_amdgcn_fmed3f(o[t], -448.f, 448.f);
                w.x = pk4_fp8(o[0], o[1], o[2], o[3]); w.y = pk4_fp8(o[4], o[5], o[6], o[7]);
                *(u32x2*)((unsigned char*)hid + row * kFF + u.pn * 128 + 32 * wc + 8 * fq) = w;
#else
                u32x4 w; w.x = pk2(o[0], o[1]); w.y = pk2(o[2], o[3]); w.z = pk2(o[4], o[5]); w.w = pk2(o[6], o[7]);
                *(u32x4*)(hid + row * kFF + u.pn * 128 + 32 * wc + 8 * fq) = w;
#endif
            }
    }
};
struct EpiDry {
    static constexpr int VMOPS = 0;
    float* sink;
    DEVI void operator()(const f32x4 (&acc)[2][2][4][2], const Unit& u, int wr, int wc, int fr, int fq) const {
        float t = 0.f;
#pragma unroll
        for (int ai = 0; ai < 2; ++ai)
#pragma unroll
            for (int bj = 0; bj < 2; ++bj)
#pragma unroll
                for (int m = 0; m < 4; ++m)
#pragma unroll
                    for (int n = 0; n < 2; ++n) t += acc[ai][bj][m][n].x + acc[ai][bj][m][n].y + acc[ai][bj][m][n].z + acc[ai][bj][m][n].w;
        if (t == 1.2345e30f) sink[0] = t;
    }
};
struct EpiDown {
    static constexpr int VMOPS = 16;
    bf16_t* y; const float* gate; float sc;
    DEVI void operator()(const f32x4 (&acc)[2][2][4][2], const Unit& u, int wr, int wc, int fr, int fq) const {
#pragma unroll
        for (int ai = 0; ai < 2; ++ai)
#pragma unroll
            for (int m = 0; m < 4; ++m) { const size_t row = (size_t)(u.pm * 256 + 128 * ai + 64 * wr + 16 * m + fr); const float gv = gate[row] * sc;
#pragma unroll
                for (int bj = 0; bj < 2; ++bj) { const f32x4 v0 = acc[ai][bj][m][0] * gv, v1 = acc[ai][bj][m][1] * gv;
                    u32x4 w; w.x = pk2(v0.x, v0.y); w.y = pk2(v0.z, v0.w); w.z = pk2(v1.x, v1.y); w.w = pk2(v1.z, v1.w);
                    *(u32x4*)(y + row * kD + u.pn * 256 + 128 * bj + 32 * wc + 8 * fq) = w; } }
    }
};
struct EpiGlu {
    static constexpr int VMOPS = 16;
    const bf16_t* g; bf16_t* oc;
    DEVI void operator()(const f32x4 (&acc)[2][2][4][2], const Unit& u, int wr, int wc, int fr, int fq) const {
#pragma unroll
        for (int ai = 0; ai < 2; ++ai)
#pragma unroll
            for (int m = 0; m < 4; ++m) { const size_t row = (size_t)(u.pm * 256 + 128 * ai + 64 * wr + 16 * m + fr);
#pragma unroll
                for (int bj = 0; bj < 2; ++bj) { const size_t o = row * 256 + 128 * bj + 32 * wc + 8 * fq;
                    const u32x4 gw = *(const u32x4*)(g + o); float o8[8];
#pragma unroll
                    for (int n = 0; n < 2; ++n)
#pragma unroll
                        for (int j = 0; j < 4; ++j) { const int t = n * 4 + j; const unsigned wv = (t < 2) ? gw.x : (t < 4) ? gw.y : (t < 6) ? gw.z : gw.w;
                            const float gg = __uint_as_float((t & 1) ? (wv & 0xFFFF0000u) : (wv << 16)); o8[t] = gg * frcp(1.f + __expf(-acc[ai][bj][m][n][j])); }
                    u32x4 w; w.x = pk2(o8[0], o8[1]); w.y = pk2(o8[2], o8[3]); w.z = pk2(o8[4], o8[5]); w.w = pk2(o8[6], o8[7]);
                    *(u32x4*)(oc + o) = w; } }
    }
};

DEVI void load_row64(const bf16_t* p, float* d) {
#pragma unroll
    for (int i = 0; i < 8; ++i) { const u32x4 v = *(const u32x4*)(p + i * 8);
        d[i * 8 + 0] = __uint_as_float(v.x << 16); d[i * 8 + 1] = __uint_as_float(v.x & 0xFFFF0000u); d[i * 8 + 2] = __uint_as_float(v.y << 16); d[i * 8 + 3] = __uint_as_float(v.y & 0xFFFF0000u);
        d[i * 8 + 4] = __uint_as_float(v.z << 16); d[i * 8 + 5] = __uint_as_float(v.z & 0xFFFF0000u); d[i * 8 + 6] = __uint_as_float(v.w << 16); d[i * 8 + 7] = __uint_as_float(v.w & 0xFFFF0000u); }
}
DEVI void store_row64(bf16_t* p, const float* d, float sc) {
#pragma unroll
    for (int i = 0; i < 8; ++i) { u32x4 w; w.x = pk2(d[i * 8] * sc, d[i * 8 + 1] * sc); w.y = pk2(d[i * 8 + 2] * sc, d[i * 8 + 3] * sc); w.z = pk2(d[i * 8 + 4] * sc, d[i * 8 + 5] * sc); w.w = pk2(d[i * 8 + 6] * sc, d[i * 8 + 7] * sc);
        *(u32x4*)(p + i * 8) = w; }
}
DEVI void phase_dilated_naive(const bf16_t* qa, const bf16_t* ka, const bf16_t* va, bf16_t* oac, float* lse, int bid, int nblk) {
    const int nitems = 3 * kB * 8 * (kS / kNT);
    for (int it = bid; it < nitems; it += nblk) {
        const int c = it / (kB * 8 * 16), r = it % (kB * 8 * 16), bh = r / 16, t = (r % 16) * kNT + tidx(), b = bh >> 3, h = bh & 7;
        const int dil = (c == 0) ? 1 : (c == 1) ? 4 : 16;
        const float slope = exp2f(-(float)(h + 1));
        const bf16_t* kb_ = ka + (size_t)bh * kS * 64; const bf16_t* vb_ = va + (size_t)bh * kS * 64;
        float q[64], o[64];
        load_row64(qa + ((size_t)bh * kS + t) * 64, q);
#pragma unroll
        for (int d = 0; d < 64; ++d) o[d] = 0.f;
        float m = -1e30f, l = 0.f;
        for (int rel = -64; rel <= 64; ++rel) {
            const int pos = t + rel * dil;
            if (pos < 0 || pos >= kS) continue;
            float kv[64]; load_row64(kb_ + (size_t)pos * 64, kv);
            float dot = 0.f;
#pragma unroll
            for (int d = 0; d < 64; ++d) dot += q[d] * kv[d];
            const float sc = dot * 0.125f - slope * (float)(dil * (rel < 0 ? -rel : rel));
            const float mn = fmaxf(m, sc), corr = __expf(m - mn), p = __expf(sc - mn);
            load_row64(vb_ + (size_t)pos * 64, kv);
            l = l * corr + p;
#pragma unroll
            for (int d = 0; d < 64; ++d) o[d] = o[d] * corr + p * kv[d];
            m = mn;
        }
        const size_t tok = (size_t)b * kS + t;
        store_row64(oac + ((size_t)c * kTok + tok) * 512 + h * 64, o, 1.f / l);
        lse[((size_t)c * kTok + tok) * 8 + h] = m + __logf(l);
    }
}
DEVI void phase_na_naive(const bf16_t* qb, const bf16_t* kbuf, const bf16_t* vbuf, const float* rpb  , bf16_t* ob, int bid, int nblk) {
    const int nitems = kB * 4 * (kS / kNT);
    for (int it = bid; it < nitems; it += nblk) {
        const int bh = it / 16, t = (it % 16) * kNT + tidx(), b = bh >> 2, h = bh & 3;
        const int r = t >> 6, cq = t & 63;
        int rs = r - 4; rs = rs < 0 ? 0 : (rs > 120 ? 120 : rs);
        int cs = cq - 8; cs = cs < 0 ? 0 : (cs > 48 ? 48 : cs);
        const bf16_t* kb_ = kbuf + (size_t)bh * kS * 64; const bf16_t* vb_ = vbuf + (size_t)bh * kS * 64;
        float q[64], o[64];
        load_row64(qb + ((size_t)bh * kS + t) * 64, q);
#pragma unroll
        for (int d = 0; d < 64; ++d) o[d] = 0.f;
        float m = -1e30f, l = 0.f;
        for (int kr = 0; kr < 8; ++kr)
            for (int kc = 0; kc < 16; ++kc) {
                const int krow = rs + kr, kcol = cs + kc, pos = krow * 64 + kcol;
                float kv[64]; load_row64(kb_ + (size_t)pos * 64, kv);
                float dot = 0.f;
#pragma unroll
                for (int d = 0; d < 64; ++d) dot += q[d] * kv[d];
                const float sc = dot * 0.125f + rpb[(h * 15 + (krow - r + 7)) * 31 + (kcol - cq + 15)];
                const float mn = fmaxf(m, sc), corr = __expf(m - mn), p = __expf(sc - mn);
                load_row64(vb_ + (size_t)pos * 64, kv);
                l = l * corr + p;
#pragma unroll
                for (int d = 0; d < 64; ++d) o[d] = o[d] * corr + p * kv[d];
                m = mn;
            }
        store_row64(ob + ((size_t)b * kS + t) * 256 + h * 64, o, 1.f / l);
    }
}

typedef float f32x16 __attribute__((ext_vector_type(16)));
typedef short s16x4 __attribute__((ext_vector_type(4)));
DEVI bf16x8 tr_pair(LAS unsigned char* p0, LAS unsigned char* p1) {
    const s16x4 a = __builtin_amdgcn_ds_read_tr16_b64_v4i16((LAS s16x4*)p0), b = __builtin_amdgcn_ds_read_tr16_b64_v4i16((LAS s16x4*)p1);
    return (bf16x8){a.x, a.y, a.z, a.w, b.x, b.y, b.z, b.w};
}
template <int VAR = 0>
DEVI void phase_dilated(const bf16_t* qa, const bf16_t* ka, const bf16_t* va, const float* gq, const float* gk, bf16_t* oac, float* lse, LAS unsigned char* lds, int bid, int nblk) {
    const int tid = tidx(), wid = __builtin_amdgcn_readfirstlane(tid >> 6), lane = tid & 63, h5 = lane >> 5, qc = lane & 31;
    LAS unsigned char* Kimg = lds; LAS unsigned char* Vimg = lds + 49152;
    float Mn;
    { float a = fabsf(gq[lane]), b = fabsf(gk[lane]);
#pragma unroll
      for (int m = 32; m >= 1; m >>= 1) { a = fmaxf(a, __shfl_xor(a, m)); b = fmaxf(b, __shfl_xor(b, m)); }
      Mn = 8.f * a * b; }
    const float Mb = Mn * kLog2e;
    unsigned koff[4];
#pragma unroll
    for (int s = 0; s < 4; ++s) koff[s] = (unsigned)((32 * wid + qc) * 128 + (((2 * s + h5) ^ (qc & 7)) << 4));
    unsigned voff[2];
    { const int g = lane >> 4, i16 = lane & 15, q = i16 >> 2, p = i16 & 3;
#pragma unroll
      for (int dt = 0; dt < 2; ++dt) { const int c = (2 * (g & 1) + (p >> 1) + 4 * dt) ^ ((q >> 1) << 2); voff[dt] = (unsigned)((32 * wid + 4 * h5 + q) * 128 + (c << 4) + 8 * (p & 1)); } }
    const float dbase = (float)(4 * h5 - qc);
    u32x4 pK[6], pV[6];
#define DIL_DECODE(unit_) const int c = (unit_) >> 11, rem = (unit_) & 2047, bh = rem >> 5, ub = rem & 31; \
        const int dsh = 2 * c, L = kS >> dsh, upc = 32 >> dsh, cls = ub >> (5 - dsh), u0 = (ub & (upc - 1)) << 8;
#define DIL_PREFETCH(unit_) do { DIL_DECODE(unit_) \
        const bf16_t* kbase = ka + (size_t)bh * kS * 64; const bf16_t* vbase = va + (size_t)bh * kS * 64; \
        _Pragma("unroll") for (int it = 0; it < 6; ++it) { const int id = it * kNT + tid, row = id >> 3, ch = id & 7; \
            int ki = u0 - 64 + row; ki = ki < 0 ? 0 : (ki > L - 1 ? L - 1 : ki); const size_t tok = (size_t)((ki << dsh) + cls); \
            pK[it] = *(const u32x4*)(kbase + tok * 64 + ch * 8); pV[it] = *(const u32x4*)(vbase + tok * 64 + ch * 8); } } while (0)
    if ((VAR & 8) || bid < 6144) DIL_PREFETCH(bid);
    for (int unit = bid; unit < 6144; unit += nblk) {
        DIL_DECODE(unit)
        const int q0 = u0 + 32 * wid, qtok = ((q0 + qc) << dsh) + cls;
        bf16x8 Qf[4];
#pragma unroll
        for (int s = 0; s < 4; ++s) Qf[s] = *(const bf16x8*)(qa + ((size_t)bh * kS + qtok) * 64 + 16 * s + 8 * h5);
        __syncthreads();
        if (!(VAR & 8)) {
#pragma unroll
        for (int it = 0; it < 6; ++it) { const int id = it * kNT + tid, row = id >> 3, ch = id & 7;
            *(LAS u32x4*)(Kimg + row * 128 + ((ch ^ (row & 7)) << 4)) = pK[it];
            *(LAS u32x4*)(Vimg + row * 128 + ((ch ^ (((row >> 1) & 1) << 2)) << 4)) = pV[it]; } }
        __syncthreads();
        if (!(VAR & 8) && unit + nblk < 6144) DIL_PREFETCH(unit + nblk);
        const float slope = exp2f(-(float)((bh & 7) + 1));
        const float c1 = 0.125f * kLog2e, c2 = slope * (float)(1 << dsh) * kLog2e;
        float sum = 0.f;
        f32x16 O[2];
#pragma unroll
        for (int dt = 0; dt < 2; ++dt)
#pragma unroll
            for (int i = 0; i < 16; ++i) O[dt][i] = 0.f;
#pragma unroll
        for (int kt = 0; kt < 5; ++kt) {
            const int kp0 = q0 - 64 + 32 * kt;
            if (kp0 >= 0 && kp0 < L) {
                f32x16 S;
#pragma unroll
                for (int i = 0; i < 16; ++i) S[i] = 0.f;
#pragma unroll
                for (int s = 0; s < 4; ++s) { const bf16x8 Kf = *(const LAS bf16x8*)(Kimg + koff[s] + kt * 4096); S = __builtin_amdgcn_mfma_f32_32x32x16_bf16(Kf, Qf[s], S, 0, 0, 0); }
                const float cs = (kt < 2) ? c2 : -c2, c0 = ((kt == 0 || kt == 4) ? -64.f : (kt == 2 ? 0.f : -32.f)) * c2 - Mb;
#pragma unroll
                for (int i = 0; i < 16; ++i) {
                    const float dvi = dbase + (float)((i & 3) + 8 * (i >> 2));
                    const float d = (kt == 2) ? fabsf(dvi) : dvi;
                    float sv = S[i] * c1 + (d * cs + c0);
                    if (kt == 0) sv = (dvi >= 0.f) ? sv : -1e30f;
                    if (kt == 4) sv = (dvi <= 0.f) ? sv : -1e30f;
                    const float pv = (VAR & 4) ? S[i] : __builtin_amdgcn_exp2f(sv); S[i] = pv; sum += pv;
                }
                if (VAR & 2) { _Pragma("unroll") for (int i = 0; i < 16; ++i) O[0][i] += S[i]; }
                else
#pragma unroll
                for (int s2 = 0; s2 < 2; ++s2) {
                    u32x4 pw; pw.x = pk2(S[8 * s2 + 0], S[8 * s2 + 1]); pw.y = pk2(S[8 * s2 + 2], S[8 * s2 + 3]); pw.z = pk2(S[8 * s2 + 4], S[8 * s2 + 5]); pw.w = pk2(S[8 * s2 + 6], S[8 * s2 + 7]);
                    const bf16x8 Pf = __builtin_bit_cast(bf16x8, pw);
#pragma unroll
                    for (int dt = 0; dt < 2; ++dt) { LAS unsigned char* vp = Vimg + voff[dt] + kt * 4096 + s2 * 2048;
                        const bf16x8 Vf = tr_pair(vp, vp + 1024);
                        O[dt] = __builtin_amdgcn_mfma_f32_32x32x16_bf16(Vf, Pf, O[dt], 0, 0, 0); }
                }
            }
        }
        sum += __shfl_xor(sum, 32);
        const float inv = 1.f / sum;
        const size_t tok = (size_t)(bh >> 3) * kS + qtok;
        if (VAR & 1) { float t = inv; _Pragma("unroll") for (int dt = 0; dt < 2; ++dt) _Pragma("unroll") for (int i = 0; i < 16; ++i) t += O[dt][i]; if (t == 1.2345e30f) lse[0] = t; }
        else {
        LAS unsigned char* ost = lds + 98304 + wid * 4096;
#pragma unroll
        for (int dt = 0; dt < 2; ++dt)
#pragma unroll
            for (int g4 = 0; g4 < 4; ++g4) { u32x2 w; w.x = pk2(O[dt][4 * g4] * inv, O[dt][4 * g4 + 1] * inv); w.y = pk2(O[dt][4 * g4 + 2] * inv, O[dt][4 * g4 + 3] * inv);
                *(LAS u32x2*)(ost + qc * 128 + (((4 * dt + g4) ^ (qc & 7)) << 4) + 8 * h5) = w; }
        if (h5 == 0) lse[((size_t)c * kTok + tok) * 8 + (bh & 7)] = Mn + __logf(sum);
        bf16_t* obase = oac + ((size_t)c * kTok + (size_t)(bh >> 3) * kS) * 512 + (bh & 7) * 64;
#pragma unroll
        for (int it = 0; it < 4; ++it) { const int r = it * 8 + (lane >> 3), ch = lane & 7;
            const u32x4 v = *(const LAS u32x4*)(ost + r * 128 + ((ch ^ (r & 7)) << 4));
            const size_t t2 = (size_t)(((q0 + r) << dsh) + cls);
            *(u32x4*)(obase + t2 * 512 + ch * 8) = v; }
        }
    }
#undef DIL_DECODE
#undef DIL_PREFETCH
    __syncthreads();
}
DEVI void phase_na(const bf16_t* qb, const bf16_t* kb, const bf16_t* vb, const float* rpb  , bf16_t* ob, LAS unsigned char* lds, int bid, int nblk) {
    const int tid = tidx(), wid = __builtin_amdgcn_readfirstlane(tid >> 6), lane = tid & 63, g4 = lane >> 4, i16 = lane & 15;
    LAS unsigned char* Kimg = lds; LAS unsigned char* Vimg = lds + 73728; LAS float* tab = (LAS float*)(lds + 147456);
    for (int i = tid; i < 4 * 465; i += kNT) tab[i] = rpb[i];
    const int g = wid & 3, kcs = (16 * g - 8) < 0 ? 0 : ((16 * g - 8) > 32 ? 32 : (16 * g - 8));
    const int qcol = 16 * g + i16, cs = (qcol - 8) < 0 ? 0 : ((qcol - 8) > 48 ? 48 : (qcol - 8));
    unsigned kswz[2];
#pragma unroll
    for (int s = 0; s < 2; ++s) kswz[s] = (unsigned)(((4 * s + g4) ^ (i16 & 7)) << 4);
    const int q = i16 >> 2, p = i16 & 3, sw = 2 * (g4 & 1) + (q >> 1);
    unsigned vsw[4];
#pragma unroll
    for (int dt = 0; dt < 4; ++dt) vsw[dt] = (unsigned)((((2 * dt + (p >> 1)) ^ (sw << 1)) << 4) + 8 * (p & 1));
    for (int unit = bid; unit < 2048; unit += nblk) {
        const int bh = unit >> 6, rp = unit & 63, r0 = 2 * rp, h = bh & 3;
        const int rsA = (r0 - 4) < 0 ? 0 : ((r0 - 4) > 120 ? 120 : (r0 - 4));
        const bf16_t* kbase = kb + (size_t)bh * kS * 64; const bf16_t* vbase = vb + (size_t)bh * kS * 64;
        __syncthreads();
#pragma unroll
        for (int it = 0; it < 9; ++it) {
            const int id = it * kNT + tid, row = id >> 3, ch = id & 7;
            int gr = rsA + (row >> 6); gr = gr > 127 ? 127 : gr;
            const size_t tok = (size_t)(gr * 64 + (row & 63));
            const u32x4 kv = *(const u32x4*)(kbase + tok * 64 + ch * 8), vv = *(const u32x4*)(vbase + tok * 64 + ch * 8);
            *(LAS u32x4*)(Kimg + row * 128 + ((ch ^ (row & 7)) << 4)) = kv;
            *(LAS u32x4*)(Vimg + row * 128 + ((ch ^ (((row >> 1) & 3) << 1)) << 4)) = vv;
        }
        __syncthreads();
        const int rr = r0 + (wid >> 2);
        const int rs = (rr - 4) < 0 ? 0 : ((rr - 4) > 120 ? 120 : (rr - 4)), ro = rs - rsA;
        const int qtok = rr * 64 + qcol;
        bf16x8 Qf[2];
#pragma unroll
        for (int s = 0; s < 2; ++s) Qf[s] = *(const bf16x8*)(qb + ((size_t)bh * kS + qtok) * 64 + 32 * s + 8 * g4);
        f32x4 S[16];
        const unsigned kb0 = (unsigned)((ro * 64 + kcs + i16) * 128);
#pragma unroll
        for (int t = 0; t < 16; ++t) { S[t] = (f32x4){0.f, 0.f, 0.f, 0.f};
#pragma unroll
            for (int s = 0; s < 2; ++s) { const bf16x8 Kf = *(const LAS bf16x8*)(Kimg + kb0 + (t >> 1) * 8192 + (t & 1) * 2048 + kswz[s]); S[t] = __builtin_amdgcn_mfma_f32_16x16x32_bf16(Kf, Qf[s], S[t], 0, 0, 0); } }
        float mx = -1e30f;
        const LAS float* th = tab + h * 465;
        int g4v = g4; asm volatile("" : "+v"(g4v));
#pragma unroll
        for (int t = 0; t < 16; ++t)
#pragma unroll
            for (int j = 0; j < 4; ++j) {
                const int krow = rs + (t >> 1), kcol = kcs + 16 * (t & 1) + 4 * g4v + j;
                const bool valid = (kcol >= cs) && (kcol < cs + 16);
                int dc = kcol - qcol + 15; dc = dc < 0 ? 0 : (dc > 30 ? 30 : dc);
                const float bias = th[(krow - rr + 7) * 31 + dc];
                const float sv = valid ? (S[t][j] * 0.125f + bias) * kLog2e : -1e30f;
                S[t][j] = sv; mx = fmaxf(mx, sv);
            }
        mx = fmaxf(mx, __shfl_xor(mx, 16)); mx = fmaxf(mx, __shfl_xor(mx, 32));
        float sum = 0.f;
#pragma unroll
        for (int t = 0; t < 16; ++t)
#pragma unroll
            for (int j = 0; j < 4; ++j) { const float pv = __builtin_amdgcn_exp2f(S[t][j] - mx); S[t][j] = pv; sum += pv; }
        sum += __shfl_xor(sum, 16); sum += __shfl_xor(sum, 32);
        f32x4 O[4];
#pragma unroll
        for (int dt = 0; dt < 4; ++dt) O[dt] = (f32x4){0.f, 0.f, 0.f, 0.f};
        const unsigned vb0 = (unsigned)((ro * 64 + kcs + 4 * g4 + q) * 128);
#pragma unroll
        for (int u = 0; u < 8; ++u) {
            u32x4 pw; pw.x = pk2(S[2 * u][0], S[2 * u][1]); pw.y = pk2(S[2 * u][2], S[2 * u][3]); pw.z = pk2(S[2 * u + 1][0], S[2 * u + 1][1]); pw.w = pk2(S[2 * u + 1][2], S[2 * u + 1][3]);
            const bf16x8 Pf = __builtin_bit_cast(bf16x8, pw);
#pragma unroll
            for (int dt = 0; dt < 4; ++dt) { LAS unsigned char* vp = Vimg + vb0 + u * 8192 + vsw[dt];
                const bf16x8 Vf = tr_pair(vp, vp + 2048);
                O[dt] = __builtin_amdgcn_mfma_f32_16x16x32_bf16(Vf, Pf, O[dt], 0, 0, 0); }
        }
        const float inv = 1.f / sum;
        bf16_t* orow = ob + ((size_t)(bh >> 2) * kS + qtok) * 256 + h * 64;
#pragma unroll
        for (int dt = 0; dt < 4; ++dt) { u32x2 w; w.x = pk2(O[dt][0] * inv, O[dt][1] * inv); w.y = pk2(O[dt][2] * inv, O[dt][3] * inv); *(u32x2*)(orow + 16 * dt + 4 * g4) = w; }
    }
    __syncthreads();
}
DEVI void phase_s5_naive(const Params& P, int l, const bf16_t* ux, float* ys, unsigned char* lds, int bid, int nblk) {
    const int wid = tidx() >> 6, lane = tidx() & 63;
    float* xs = (float*)lds + wid * 128;
    for (int item = wid * nblk + bid; item < kB * 16 * 2; item += nblk * 8) {
        const int dir = item & 1, g = (item >> 1) & 15, b = item >> 5;
        const size_t pbase = (((size_t)l * 2 + dir) * 16 + g) * 64;
        const float dt = __expf(P.s5_log_dt[((size_t)l * 2 + dir) * 16 + g]);
        const float a = fminf(P.s5_a_re[pbase + lane], -1e-4f), w = P.s5_a_im[pbase + lane];
        const float mag = __expf(a * dt), ar = mag * cosf(w * dt), ai = mag * sinf(w * dt);
        const float den = a * a + w * w, zr = ar - 1.f, gr = (zr * a + ai * w) / den, gi = (ai * a - zr * w) / den;
        float bbr[16], bbi[16];
#pragma unroll
        for (int c = 0; c < 16; ++c) { const float br = P.s5_b_re[(pbase + lane) * 16 + c], bi = P.s5_b_im[(pbase + lane) * 16 + c]; bbr[c] = gr * br - gi * bi; bbi[c] = gr * bi + gi * br; }
        const int cch = lane & 15, qt = lane >> 4;
        float cre[16], cim[16];
#pragma unroll
        for (int pp = 0; pp < 16; ++pp) { cre[pp] = P.s5_c_re[(pbase / 64 * 16 + cch) * 64 + qt * 16 + pp]; cim[pp] = P.s5_c_im[(pbase / 64 * 16 + cch) * 64 + qt * 16 + pp]; }
        float xr = 0.f, xi = 0.f;
        const bf16_t* ug = ux + (size_t)g * 4096 * 512;
        for (int st = 0; st < kS; ++st) {
            const int s = dir ? (kS - 1 - st) : st; const size_t tok = (size_t)b * kS + s;
            const bf16_t* up = ug + (tok >> 4) * 512 + (tok & 15) * 16;
            const u32x4 u0 = *(const u32x4*)up, u1 = *(const u32x4*)(up + 8);
            float uv[16];
            uv[0] = __uint_as_float(u0.x << 16); uv[1] = __uint_as_float(u0.x & 0xFFFF0000u); uv[2] = __uint_as_float(u0.y << 16); uv[3] = __uint_as_float(u0.y & 0xFFFF0000u);
            uv[4] = __uint_as_float(u0.z << 16); uv[5] = __uint_as_float(u0.z & 0xFFFF0000u); uv[6] = __uint_as_float(u0.w << 16); uv[7] = __uint_as_float(u0.w & 0xFFFF0000u);
            uv[8] = __uint_as_float(u1.x << 16); uv[9] = __uint_as_float(u1.x & 0xFFFF0000u); uv[10] = __uint_as_float(u1.y << 16); uv[11] = __uint_as_float(u1.y & 0xFFFF0000u);
            uv[12] = __uint_as_float(u1.z << 16); uv[13] = __uint_as_float(u1.z & 0xFFFF0000u); uv[14] = __uint_as_float(u1.w << 16); uv[15] = __uint_as_float(u1.w & 0xFFFF0000u);
            float bur = 0.f, bui = 0.f;
#pragma unroll
            for (int c = 0; c < 16; ++c) { bur += bbr[c] * uv[c]; bui += bbi[c] * uv[c]; }
            const float nr = ar * xr - ai * xi + bur, ni = ar * xi + ai * xr + bui; xr = nr; xi = ni;
            xs[lane] = xr; xs[64 + lane] = xi;
            asm volatile("s_waitcnt lgkmcnt(0)" ::: "memory");
            float y = 0.f;
#pragma unroll
            for (int pp = 0; pp < 16; ++pp) y += cre[pp] * xs[qt * 16 + pp] - cim[pp] * xs[64 + qt * 16 + pp];
            asm volatile("s_waitcnt lgkmcnt(0)" ::: "memory");
            y += __shfl_xor(y, 16); y += __shfl_xor(y, 32);
            if (lane < 16) ys[((size_t)dir * kTok + tok) * 256 + g * 16 + cch] = y;
        }
    }
}
DEVI void phase_s5_finish(const float* ys, const bf16_t* ux, const float* dskip, bf16_t* G, int bid, int nblk) {
    for (size_t i = (size_t)bid * kNT + tidx(); i < (size_t)kTok * 256; i += (size_t)nblk * kNT) {
        const size_t tok = i >> 8; const int ch = (int)(i & 255), g = ch >> 4, c = ch & 15;
        const float u = bf2f(ux[((size_t)g * 4096 + (tok >> 4)) * 512 + (tok & 15) * 16 + c]);
        const float y = ys[i] + ys[(size_t)kTok * 256 + i] + dskip[ch] * u;
        G[i] = f2bf(gelu_tanh(y));
    }
}
DEVI void unpk8(float* d, const u32x4 q, const float sc) {
    d[0] += sc * __uint_as_float(q.x << 16); d[1] += sc * __uint_as_float(q.x & 0xFFFF0000u); d[2] += sc * __uint_as_float(q.y << 16); d[3] += sc * __uint_as_float(q.y & 0xFFFF0000u);
    d[4] += sc * __uint_as_float(q.z << 16); d[5] += sc * __uint_as_float(q.z & 0xFFFF0000u); d[6] += sc * __uint_as_float(q.w << 16); d[7] += sc * __uint_as_float(q.w & 0xFFFF0000u);
}
DEVI void phase_mixnorm(const bf16_t* oac, const float* lse, const bf16_t* ob, const bf16_t* oc, const float* ga, const float* gb, const float* gc, bf16_t* mix, int bid, int nblk) {
    const int wid = tidx() >> 6, lane = tidx() & 63;
    float gn[16];
    { const float* gp = (lane < 32) ? ga + lane * 16 : (lane < 48) ? gb + (lane - 32) * 16 : gc + (lane - 48) * 16;
#pragma unroll
      for (int i = 0; i < 16; ++i) gn[i] = gp[i]; }
    for (int row = bid * 8 + wid; row < kTok; row += nblk * 8) {
        float v[16];
#pragma unroll
        for (int i = 0; i < 16; ++i) v[i] = 0.f;
        if (lane < 32) {
            const int h = lane >> 2;
            const float l0 = lse[(size_t)row * 8 + h], l1 = lse[((size_t)kTok + row) * 8 + h], l2 = lse[((size_t)2 * kTok + row) * 8 + h];
            const bf16_t* p0 = oac + (size_t)row * 512 + lane * 16; const bf16_t* p1 = p0 + (size_t)kTok * 512; const bf16_t* p2 = p1 + (size_t)kTok * 512;
            const u32x4 a0 = *(const u32x4*)p0, a1 = *(const u32x4*)(p0 + 8), b0 = *(const u32x4*)p1, b1 = *(const u32x4*)(p1 + 8), c0 = *(const u32x4*)p2, c1 = *(const u32x4*)(p2 + 8);
            const float mx = fmaxf(l0, fmaxf(l1, l2)); float w0 = __expf(l0 - mx), w1 = __expf(l1 - mx), w2 = __expf(l2 - mx); const float inv = frcp(w0 + w1 + w2); w0 *= inv; w1 *= inv; w2 *= inv;
            unpk8(v, a0, w0); unpk8(v + 8, a1, w0); unpk8(v, b0, w1); unpk8(v + 8, b1, w1); unpk8(v, c0, w2); unpk8(v + 8, c1, w2);
        } else {
            const bf16_t* p = (lane < 48) ? ob + (size_t)row * 256 + (lane - 32) * 16 : oc + (size_t)row * 256 + (lane - 48) * 16;
            const u32x4 a0 = *(const u32x4*)p, a1 = *(const u32x4*)(p + 8);
            unpk8(v, a0, 1.f); unpk8(v + 8, a1, 1.f);
        }
        float ss = 0.f;
#pragma unroll
        for (int i = 0; i < 16; ++i) ss += v[i] * v[i];
#pragma unroll
        for (int m = 1; m <= 8; m <<= 1) ss += __shfl_xor(ss, m);
        const float o16 = __shfl_xor(ss, 16);
        if (lane < 32) ss += o16;
        const float rstd = rsqrtf(ss * ((lane < 32) ? (1.f / 512.f) : (1.f / 256.f)) + kEps);
        if (EMU_FP8_WOUT) {
#pragma unroll
            for (int i = 0; i < 16; ++i) v[i] = q8(v[i] * rstd * gn[i], 1.f, 1.f) / (rstd * gn[i]);
        }
        u32x4 w0, w1;
        w0.x = pk2(v[0] * rstd * gn[0], v[1] * rstd * gn[1]); w0.y = pk2(v[2] * rstd * gn[2], v[3] * rstd * gn[3]); w0.z = pk2(v[4] * rstd * gn[4], v[5] * rstd * gn[5]); w0.w = pk2(v[6] * rstd * gn[6], v[7] * rstd * gn[7]);
        w1.x = pk2(v[8] * rstd * gn[8], v[9] * rstd * gn[9]); w1.y = pk2(v[10] * rstd * gn[10], v[11] * rstd * gn[11]); w1.z = pk2(v[12] * rstd * gn[12], v[13] * rstd * gn[13]); w1.w = pk2(v[14] * rstd * gn[14], v[15] * rstd * gn[15]);
        *(u32x4*)(mix + (size_t)row * kD + lane * 16) = w0; *(u32x4*)(mix + (size_t)row * kD + lane * 16 + 8) = w1;
    }
}
DEVI void phase_combine(bf16_t* xb, float* out32, const bf16_t* y, const int* tokslot, const float* gain_next, bf16_t* h, int bid, int nblk) {
    const int wid = tidx() >> 6, lane = tidx() & 63;
    f32x4 g[4];
#pragma unroll
    for (int q = 0; q < 4; ++q) g[q] = gain_next ? *(const f32x4*)(gain_next + q * 256 + lane * 4) : (f32x4){0.f, 0.f, 0.f, 0.f};
    const int stride = nblk * 8;
    int row = bid * 8 + wid;
    u32x2 nv[4]; int nts = 0;
    if (row < kTok) { nts = tokslot[(size_t)row * kE + (lane & 15)];
#pragma unroll
        for (int q = 0; q < 4; ++q) nv[q] = *(const u32x2*)(xb + (size_t)row * kD + q * 256 + lane * 4); }
    for (; row < kTok; row += stride) {
        const int b = row >> 13;
        const int ts = nts;
        f32x4 v[4];
#pragma unroll
        for (int q = 0; q < 4; ++q) { const u32x2 w = nv[q]; v[q] = (f32x4){__uint_as_float(w.x << 16), __uint_as_float(w.x & 0xFFFF0000u), __uint_as_float(w.y << 16), __uint_as_float(w.y & 0xFFFF0000u)}; }
        const int nrow = row + stride;
        if (nrow < kTok) { nts = tokslot[(size_t)nrow * kE + (lane & 15)];
#pragma unroll
            for (int q = 0; q < 4; ++q) nv[q] = *(const u32x2*)(xb + (size_t)nrow * kD + q * 256 + lane * 4); }
#pragma unroll
        for (int e0 = 0; e0 < kE; e0 += 8) {
            u32x2 yv[8][4];
#pragma unroll
            for (int e = 0; e < 8; ++e) { const int slot = __builtin_amdgcn_readlane(ts, e0 + e);
                if (slot >= 0) { const bf16_t* yr = y + ((size_t)((e0 + e) * kB + b) * kCap + slot) * kD;
#pragma unroll
                    for (int q = 0; q < 4; ++q) yv[e][q] = *(const u32x2*)(yr + q * 256 + lane * 4); } }
#pragma unroll
            for (int e = 0; e < 8; ++e) { const int slot = __builtin_amdgcn_readlane(ts, e0 + e);
                if (slot >= 0) {
#pragma unroll
                    for (int q = 0; q < 4; ++q) { const u32x2 w = yv[e][q];
                        v[q].x += __uint_as_float(w.x << 16); v[q].y += __uint_as_float(w.x & 0xFFFF0000u); v[q].z += __uint_as_float(w.y << 16); v[q].w += __uint_as_float(w.y & 0xFFFF0000u); } } }
        }
        if (!gain_next) {
#pragma unroll
            for (int q = 0; q < 4; ++q) *(f32x4*)(out32 + (size_t)row * kD + q * 256 + lane * 4) = v[q];
        } else {
            float ss = 0.f;
#pragma unroll
            for (int q = 0; q < 4; ++q) { u32x2 o; o.x = pk2(v[q].x, v[q].y); o.y = pk2(v[q].z, v[q].w); *(u32x2*)(xb + (size_t)row * kD + q * 256 + lane * 4) = o;
                v[q] = (f32x4){__uint_as_float(o.x << 16), __uint_as_float(o.x & 0xFFFF0000u), __uint_as_float(o.y << 16), __uint_as_float(o.y & 0xFFFF0000u)};
                ss += v[q].x * v[q].x + v[q].y * v[q].y + v[q].z * v[q].z + v[q].w * v[q].w; }
            ss = wave_sum(ss); const float rstd = rsqrtf(ss * (1.f / kD) + kEps);
#pragma unroll
            for (int q = 0; q < 4; ++q) { const f32x4 t = v[q] * rstd * g[q]; u32x2 o; o.x = pk2(t.x, t.y); o.y = pk2(t.z, t.w);
                *(u32x2*)(h + (size_t)row * kD + q * 256 + lane * 4) = o; }
        }
    }
}

DEVI void cpow_m(double a, double w, double dt, int m, float& re, float& im) {
    const float mag = __expf((float)m * (float)a * (float)dt);
    const double turns = (double)m * w * dt * 0.15915494309189535; const float ang = (float)((turns - floor(turns)) * 6.283185307179586);
    re = mag * cosf(ang); im = mag * sinf(ang);
}
DEVI void s5_prep_item(const Params& P, int l, int g, unsigned char* lds_) {
    float* pw = (float*)lds_;
    float* bb = pw + 4352;
    float* cc = bb + 4096;
    float* kt = cc + 4096;
    const int tid = tidx();
    __syncthreads();
    for (int i = tid; i < 128; i += kNT) { const int dir = i >> 6, p = i & 63; const size_t pb = (((size_t)l * 2 + dir) * 16 + g) * 64 + p;
        const double dt = (double)__expf(P.s5_log_dt[((size_t)l * 2 + dir) * 16 + g]); const double a = (double)fminf(P.s5_a_re[pb], -1e-4f), w = (double)P.s5_a_im[pb];
        for (int m = 0; m < 17; ++m) { float re, im; cpow_m(a, w, dt, m, re, im); pw[((dir * 64 + p) * 17 + m) * 2] = re; pw[((dir * 64 + p) * 17 + m) * 2 + 1] = im; }
        const float af = (float)a, wf = (float)w, ar = pw[((dir * 64 + p) * 17 + 1) * 2], ai = pw[((dir * 64 + p) * 17 + 1) * 2 + 1];
        const float den = af * af + wf * wf, zr = ar - 1.f, gr = (zr * af + ai * wf) / den, gi = (ai * af - zr * wf) / den;
        for (int c = 0; c < 16; ++c) { const float br = P.s5_b_re[pb * 16 + c], bi = P.s5_b_im[pb * 16 + c]; bb[((dir * 64 + p) * 16 + c) * 2] = gr * br - gi * bi; bb[((dir * 64 + p) * 16 + c) * 2 + 1] = gr * bi + gi * br; }
    }
    for (int i = tid; i < 2048; i += kNT) { const int dir = i >> 10, c = (i >> 6) & 15, p = i & 63; const size_t o = ((((size_t)l * 2 + dir) * 16 + g) * 16 + c) * 64 + p; cc[i * 2] = P.s5_c_re[o]; cc[i * 2 + 1] = P.s5_c_im[o]; }
    __syncthreads();
    for (int i = tid; i < 8192; i += kNT) { const int dir = i >> 12, m = (i >> 8) & 15, c = (i >> 4) & 15, c2 = i & 15; float acc = 0.f;
        for (int p = 0; p < 64; ++p) { const float cr = cc[((dir * 16 + c) * 64 + p) * 2], ci = cc[((dir * 16 + c) * 64 + p) * 2 + 1], wr_ = pw[((dir * 64 + p) * 17 + m) * 2], wi_ = pw[((dir * 64 + p) * 17 + m) * 2 + 1];
            const float br = bb[((dir * 64 + p) * 16 + c2) * 2], bi = bb[((dir * 64 + p) * 16 + c2) * 2 + 1]; const float tr = cr * wr_ - ci * wi_, ti = cr * wi_ + ci * wr_; acc += tr * br - ti * bi; }
        kt[i] = acc; }
    __syncthreads();
    bf16_t* wst = (bf16_t*)(wsp(P) + WS_WST) + ((size_t)l * 16 + g) * 256 * 256;
    bf16_t* wso = (bf16_t*)(wsp(P) + WS_WSO) + ((size_t)l * 16 + g) * 256 * 512;
    for (int id = tid; id < 8192; id += kNT) { const int n = id >> 5, k0 = (id & 31) * 8, dir = n >> 7, p = (n >> 1) & 63, ri = n & 1; float v[8];
#pragma unroll
        for (int kk = 0; kk < 8; ++kk) { const int k = k0 + kk, t = k >> 4, c = k & 15, e = dir ? t : 15 - t; const float wr_ = pw[((dir * 64 + p) * 17 + e) * 2], wi_ = pw[((dir * 64 + p) * 17 + e) * 2 + 1], br = bb[((dir * 64 + p) * 16 + c) * 2], bi = bb[((dir * 64 + p) * 16 + c) * 2 + 1];
            v[kk] = ri ? (wr_ * bi + wi_ * br) : (wr_ * br - wi_ * bi); }
        u32x4 o; o.x = pk2(v[0], v[1]); o.y = pk2(v[2], v[3]); o.z = pk2(v[4], v[5]); o.w = pk2(v[6], v[7]); *(u32x4*)(wst + (size_t)n * 256 + k0) = o; }
    for (int id = tid; id < 16384; id += kNT) { const int ns = id >> 6, k0 = (id & 63) * 8, n = cmap_pk(ns), t = n >> 4, c = n & 15; float v[8];
#pragma unroll
        for (int kk = 0; kk < 8; ++kk) { const int k = k0 + kk; float x;
            if (k < 256) { const int j = k >> 4, c2 = k & 15; x = 0.f; if (j <= t) x += kt[(t - j) * 256 + c * 16 + c2]; if (j >= t) x += kt[4096 + (j - t) * 256 + c * 16 + c2]; if (j == t && c == c2) x += P.s5_d[l * 256 + g * 16 + c]; }
            else { const int q = k - 256, dir = q >> 7, p = (q >> 1) & 63, ri = q & 1, e = dir ? 16 - t : t + 1; const float cr = cc[((dir * 16 + c) * 64 + p) * 2], ci = cc[((dir * 16 + c) * 64 + p) * 2 + 1], wr_ = pw[((dir * 64 + p) * 17 + e) * 2], wi_ = pw[((dir * 64 + p) * 17 + e) * 2 + 1];
                x = ri ? -(cr * wi_ + ci * wr_) : (cr * wr_ - ci * wi_); }
            v[kk] = x; }
        u32x4 o; o.x = pk2(v[0], v[1]); o.y = pk2(v[2], v[3]); o.z = pk2(v[4], v[5]); o.w = pk2(v[6], v[7]); *(u32x4*)(wso + (size_t)ns * 512 + k0) = o; }
    __syncthreads();
}
DEVI void phase_s5_scan(const Params& P, int l, const float* Z, bf16_t* ux, unsigned char* lds_, int bid, int nblk) {
    const int tid = tidx(), wid = tid >> 6, lane = tid & 63;
    float* E = (float*)lds_;
    for (int item = bid; item < 256; item += nblk) {
        const int dir = item & 1, g = (item >> 1) & 15, b = item >> 5;
        const size_t pb = (((size_t)l * 2 + dir) * 16 + g) * 64 + lane;
        const double dt = (double)__expf(P.s5_log_dt[((size_t)l * 2 + dir) * 16 + g]); const double a = (double)fminf(P.s5_a_re[pb], -1e-4f), w = (double)P.s5_a_im[pb];
        float a16r, a16i, Ar, Ai; cpow_m(a, w, dt, 16, a16r, a16i); cpow_m(a, w, dt, 1024, Ar, Ai);
        const int kk0 = dir ? 511 - 64 * wid : 64 * wid; const long sstep = dir ? -1 : 1;
        const float* zp = Z + ((size_t)g * 4096 + b * 512 + kk0) * 256 + dir * 128 + 2 * lane;
        f32x2 z[64];
#pragma unroll
        for (int i = 0; i < 64; ++i) { z[i] = *(const f32x2*)zp; zp += sstep * 256; }
        float xr = 0.f, xi = 0.f;
#pragma unroll
        for (int i = 0; i < 64; ++i) { const float nr = a16r * xr - a16i * xi + z[i].x, ni = a16r * xi + a16i * xr + z[i].y; xr = nr; xi = ni; }
        __syncthreads();
        E[(wid * 64 + lane) * 2] = xr; E[(wid * 64 + lane) * 2 + 1] = xi;
        __syncthreads();
        float sr = 0.f, si = 0.f;
#pragma unroll
        for (int s2 = 0; s2 < 7; ++s2) if (s2 < wid) { const float er = E[(s2 * 64 + lane) * 2], ei = E[(s2 * 64 + lane) * 2 + 1]; const float nr = Ar * sr - Ai * si + er, ni = Ar * si + Ai * sr + ei; sr = nr; si = ni; }
        bf16_t* up = ux + ((size_t)g * 4096 + b * 512 + kk0) * 512 + 256 + dir * 128 + 2 * lane;
#pragma unroll
        for (int i = 0; i < 64; ++i) { *(unsigned*)up = pk2(sr, si); up += sstep * 512;
            const float nr = a16r * sr - a16i * si + z[i].x, ni = a16r * si + a16i * sr + z[i].y; sr = nr; si = ni; }
    }
    __syncthreads();
}
struct EpiF32N {
    static constexpr int VMOPS = 32;
    float* z; int ldz;
    DEVI void operator()(const f32x4 (&acc)[2][2][4][2], const Unit& u, int wr, int wc, int fr, int fq) const {
#pragma unroll
        for (int ai = 0; ai < 2; ++ai)
#pragma unroll
            for (int m = 0; m < 4; ++m) { const size_t ro = (size_t)(u.pm * 256 + 128 * ai + 64 * wr + 16 * m + fr) * ldz + u.pn * 256 + 32 * wc + 4 * fq;
#pragma unroll
                for (int bj = 0; bj < 2; ++bj)
#pragma unroll
                    for (int n = 0; n < 2; ++n) *(f32x4*)(z + ro + 128 * bj + 16 * n) = acc[ai][bj][m][n]; }
    }
};
struct EpiS5Out {
    static constexpr int VMOPS = 16;
    bf16_t* G;
    DEVI void operator()(const f32x4 (&acc)[2][2][4][2], const Unit& u, int wr, int wc, int fr, int fq) const {
#pragma unroll
        for (int ai = 0; ai < 2; ++ai)
#pragma unroll
            for (int m = 0; m < 4; ++m) { const int R = u.pm * 256 + 128 * ai + 64 * wr + 16 * m + fr, g = R >> 12, ck = R & 4095;
#pragma unroll
                for (int bj = 0; bj < 2; ++bj) { const int t = 8 * bj + 2 * wc + (fq >> 1), c0 = 8 * (fq & 1);
                    const f32x4 v0 = acc[ai][bj][m][0], v1 = acc[ai][bj][m][1];
                    u32x4 w; w.x = pk2(gelu_tanh(v0.x), gelu_tanh(v0.y)); w.y = pk2(gelu_tanh(v0.z), gelu_tanh(v0.w)); w.z = pk2(gelu_tanh(v1.x), gelu_tanh(v1.y)); w.w = pk2(gelu_tanh(v1.z), gelu_tanh(v1.w));
                    *(u32x4*)(G + ((size_t)ck * 16 + t) * 256 + g * 16 + c0) = w; } }
    }
};
#define XB_TMO      128
#define XB_XCNT(j)  (256  + 64 * (j))
#define XB_XSUB(j)  (1280 + 64 * (j))
#define XB_XGEN(j)  (2304 + 64 * (j))
#define XB_TOP      3328
#define XB_TOPGEN   3392
#define XCD_BAR_WORDS 3456
#define XB_SPIN_CAP (1u << 26)
DEVI unsigned xb_ld(unsigned* p)              { return __hip_atomic_load(p, __ATOMIC_RELAXED, __HIP_MEMORY_SCOPE_AGENT); }
DEVI unsigned xb_add(unsigned* p, unsigned v) { return __hip_atomic_fetch_add(p, v, __ATOMIC_RELAXED, __HIP_MEMORY_SCOPE_AGENT); }
DEVI unsigned xb_xcc_id() { return (unsigned)__builtin_amdgcn_s_getreg((3 << 11) | 20) & 0xFu; }
#define XB_SPIN(cond, bar) do { unsigned _sp = 0; while (cond) { __builtin_amdgcn_s_sleep(1); \
    if ((++_sp & 255u) == 0u) { if (xb_ld(&(bar)[XB_TMO])) break; if (_sp > XB_SPIN_CAP) { atomicAdd(&(bar)[XB_TMO], 1u); break; } } } } while (0)
struct XcdBarrier { unsigned* bar; unsigned x; volatile LAS unsigned* st; };
DEVI XcdBarrier xcd_barrier_post(unsigned* bar, volatile LAS unsigned* st) {
    XcdBarrier b; b.bar = bar; b.x = xb_xcc_id(); b.st = st;
    if (threadIdx.x == 0) (void)xb_add(&bar[XB_XCNT(b.x)], 1u);
    return b;
}
DEVI void xcd_barrier_complete(unsigned* bar, unsigned x, unsigned& nloc, unsigned& nx) {
    const unsigned G = gridDim.x * gridDim.y * gridDim.z;
    unsigned sum, cnt, mine, sp = 0u;
    for (;;) {
        sum = 0u; cnt = 0u; mine = 0u;
#pragma unroll
        for (unsigned j = 0; j < 16; ++j) { const unsigned c = xb_ld(&bar[XB_XCNT(j)]); sum += c; cnt += (c > 0u) ? 1u : 0u; mine = (j == x) ? c : mine; }
        if (sum == G) break;
        __builtin_amdgcn_s_sleep(1);
        if ((++sp & 255u) == 0u) { if (xb_ld(&bar[XB_TMO])) break; if (sp > XB_SPIN_CAP) { atomicAdd(&bar[XB_TMO], 1u); break; } }
    }
    nloc = mine > 0u ? mine : 1u; nx = cnt > 0u ? cnt : 1u;
}
DEVI void xcd_barrier(const XcdBarrier& b) {
    asm volatile("s_waitcnt vmcnt(0)" ::: "memory");
    __syncthreads();
    if (threadIdx.x == 0) {
        unsigned long long bp_ = (unsigned long long)b.bar; asm volatile("" : "+s"(bp_));
        unsigned* bar = (unsigned*)bp_;
        const unsigned bx = xb_xcc_id();
        __builtin_amdgcn_s_waitcnt(0);
        unsigned nloc = b.st[0], nx = b.st[1];
        if (nloc == 0u) { xcd_barrier_complete(bar, bx, nloc, nx); b.st[0] = nloc; b.st[1] = nx; }
        const unsigned old = xb_add(&bar[XB_XSUB(bx)], 1u);
        const unsigned gen = old / nloc;
        if (old + 1u == (gen + 1u) * nloc) {
            __builtin_amdgcn_fence(__ATOMIC_RELEASE, "agent");
            asm volatile("s_waitcnt vmcnt(0)" ::: "memory");
            const unsigned og = xb_add(&bar[XB_TOP], 1u);
            const unsigned tg = og / nx;
            if (og + 1u == (tg + 1u) * nx) xb_add(&bar[XB_TOPGEN], 1u);
            else XB_SPIN(xb_ld(&bar[XB_TOPGEN]) == tg, bar);
            __builtin_amdgcn_fence(__ATOMIC_ACQUIRE, "agent");
            xb_add(&bar[XB_XGEN(bx)], 1u);
            asm volatile("s_waitcnt vmcnt(0)" ::: "memory");
        } else {
            XB_SPIN(xb_ld(&bar[XB_XGEN(bx)]) == gen, bar);
            __builtin_amdgcn_fence(__ATOMIC_ACQUIRE, "agent");
            asm volatile("s_waitcnt vmcnt(0)" ::: "memory");
        }
    }
    __syncthreads();
}

#ifndef MEGA
#define MEGA 1
#endif
#ifndef USE_ENGINE
#define USE_ENGINE 1
#endif
constexpr int LDS_BYTES = 147456 + 8192 + 16;
#if USE_ENGINE
#define GEMM_RUN(g, E) gemm_engine<decltype(E), true, true>((LAS unsigned char*)dyn_lds, g, E, bid, nblk)
#define GEMM_RUN8(g, E) gemm_engine<decltype(E), true, true, true>((LAS unsigned char*)dyn_lds, g, E, bid, nblk)
#else
#define GEMM_RUN(g, E) gemm_simple(g, E, bid, nblk)
#endif
extern __shared__ __attribute__((aligned(16))) unsigned char dyn_lds[];

DEVI GemmD mk_gemm(const bf16_t* A, const bf16_t* Bt, int lda, int K, int nM, int nN, const int* rowidx, size_t bstride, int pmg) {
    GemmD g; g.A = A; g.Bt = Bt; g.lda = lda; g.K = K; g.nM = nM; g.nN = nN; g.rowidx = rowidx; g.bstride = bstride; g.pmg = pmg; return g; }

DEVI void ph_win(const Params& P, int l, int bid, int nblk) {
    const GemmD g = mk_gemm((const bf16_t*)(wsp(P) + WS_H), (const bf16_t*)(wsp(P) + WS_WINT) + (size_t)l * kINW * kD, kD, kD, kTok / 256, 10, nullptr, 0, 1 << 30);
    unsigned char* r1 = wsp(P) + WS_R1;
    EpiQKV E; E.qa = (bf16_t*)(r1 + R1_QA); E.ka = (bf16_t*)(r1 + R1_KA); E.va = (bf16_t*)(r1 + R1_VA); E.qb = (bf16_t*)(r1 + R1_QB); E.kb = (bf16_t*)(r1 + R1_KB); E.vb = (bf16_t*)(r1 + R1_VB); E.ux = (bf16_t*)(r1 + R1_UX);
    E.qna = P.q_norm_a + l * 64; E.kna = P.k_norm_a + l * 64; E.qnb = P.q_norm_b + l * 64; E.knb = P.k_norm_b + l * 64;
    GEMM_RUN(g, E);
}
#ifndef USE_MFMA_ATTN
#define USE_MFMA_ATTN 1
#endif
#ifndef USE_S5_GEMM
#define USE_S5_GEMM 1
#endif
#ifndef PROBE_ATTN
#define PROBE_ATTN 1
#endif
#ifndef PROBE_GU
#define PROBE_GU 1
#endif
#ifndef PROBE_DOWN
#define PROBE_DOWN 1
#endif
#ifndef PROBE_NA
#define PROBE_NA 1
#endif
#ifndef PROBE_MIX
#define PROBE_MIX 1
#endif
#ifndef PROBE_RT
#define PROBE_RT 1
#endif
#ifndef PROBE_TK
#define PROBE_TK 1
#endif
#ifndef PROBE_GUDRY
#define PROBE_GUDRY 0
#endif
#ifndef PROBE_DILVAR
#define PROBE_DILVAR 0
#endif
#ifndef PROBE_CONV
#define PROBE_CONV 1
#endif
DEVI void ph_dilated(const Params& P, int l, int bid, int nblk) { unsigned char* r1 = wsp(P) + WS_R1;
#if PROBE_DILVAR
    phase_dilated<PROBE_DILVAR>((const bf16_t*)(r1 + R1_QA), (const bf16_t*)(r1 + R1_KA), (const bf16_t*)(r1 + R1_VA), P.q_norm_a + l * 64, P.k_norm_a + l * 64, (bf16_t*)(wsp(P) + WS_R2), (float*)(wsp(P) + WS_LSE), (LAS unsigned char*)dyn_lds, bid, nblk);
#endif
#if USE_MFMA_ATTN
    phase_dilated((const bf16_t*)(r1 + R1_QA), (const bf16_t*)(r1 + R1_KA), (const bf16_t*)(r1 + R1_VA), P.q_norm_a + l * 64, P.k_norm_a + l * 64, (bf16_t*)(wsp(P) + WS_R2), (float*)(wsp(P) + WS_LSE), (LAS unsigned char*)dyn_lds, bid, nblk);
#else
    phase_dilated_naive((const bf16_t*)(r1 + R1_QA), (const bf16_t*)(r1 + R1_KA), (const bf16_t*)(r1 + R1_VA), (bf16_t*)(wsp(P) + WS_R2), (float*)(wsp(P) + WS_LSE), bid, nblk);
#endif
}
DEVI void ph_na(const Params& P, int l, int bid, int nblk) { unsigned char* r1 = wsp(P) + WS_R1;
#if USE_MFMA_ATTN
    phase_na((const bf16_t*)(r1 + R1_QB), (const bf16_t*)(r1 + R1_KB), (const bf16_t*)(r1 + R1_VB), P.rpb + (size_t)l * 4 * 15 * 31, (bf16_t*)(r1 + R1_OB), (LAS unsigned char*)dyn_lds, bid, nblk);
#else
    phase_na_naive((const bf16_t*)(r1 + R1_QB), (const bf16_t*)(r1 + R1_KB), (const bf16_t*)(r1 + R1_VB), P.rpb + (size_t)l * 4 * 15 * 31, (bf16_t*)(r1 + R1_OB), bid, nblk);
#endif
}
DEVI void ph_s5(const Params& P, int l, unsigned char* lds, int bid, int nblk) { phase_s5_naive(P, l, (const bf16_t*)(wsp(P) + WS_R1 + R1_UX), (float*)(wsp(P) + WS_YS), lds, bid, nblk); }
DEVI void ph_s5_prep(const Params& P, unsigned char* lds, int bid, int nblk) { for (int it = bid; it < kL * 16; it += nblk) s5_prep_item(P, it >> 4, it & 15, lds); }
DEVI void ph_s5_state(const Params& P, int l, int bid, int nblk) {
    const GemmD g = mk_gemm((const bf16_t*)(wsp(P) + WS_R1 + R1_UX), (const bf16_t*)(wsp(P) + WS_WST) + (size_t)l * 16 * 256 * 256, 512, 256, 256, 1, nullptr, (size_t)256 * 256, 16);
    EpiF32N E; E.z = (float*)(wsp(P) + WS_R2 + R2_Z); E.ldz = 256;
    GEMM_RUN(g, E);
}
DEVI void ph_s5_scan(const Params& P, int l, unsigned char* lds, int bid, int nblk) { phase_s5_scan(P, l, (const float*)(wsp(P) + WS_R2 + R2_Z), (bf16_t*)(wsp(P) + WS_R1 + R1_UX), lds, bid, nblk); }
DEVI void ph_s5_out(const Params& P, int l, int bid, int nblk) {
    const GemmD g = mk_gemm((const bf16_t*)(wsp(P) + WS_R1 + R1_UX), (const bf16_t*)(wsp(P) + WS_WSO) + (size_t)l * 16 * 256 * 512, 512, 512, 256, 1, nullptr, (size_t)256 * 512, 16);
    EpiS5Out E; E.G = (bf16_t*)(wsp(P) + WS_R1 + R1_G);
    GEMM_RUN(g, E);
}
DEVI void ph_s5fin(const Params& P, int l, int bid, int nblk) { phase_s5_finish((const float*)(wsp(P) + WS_YS), (const bf16_t*)(wsp(P) + WS_R1 + R1_UX), P.s5_d + l * 256, (bf16_t*)(wsp(P) + WS_R1 + R1_G), bid, nblk); }
DEVI void ph_glu(const Params& P, int l, int bid, int nblk) {
    const GemmD g = mk_gemm((const bf16_t*)(wsp(P) + WS_R1 + R1_G), (const bf16_t*)(wsp(P) + WS_WGLUT) + (size_t)l * 256 * 256, 256, 256, kTok / 256, 1, nullptr, 0, 1 << 30);
    EpiGlu E; E.g = (const bf16_t*)(wsp(P) + WS_R1 + R1_G); E.oc = (bf16_t*)(wsp(P) + WS_R1 + R1_OC);
    GEMM_RUN(g, E);
}
DEVI void ph_mixnorm(const Params& P, int l, int bid, int nblk) { unsigned char* r1 = wsp(P) + WS_R1;
    phase_mixnorm((const bf16_t*)(wsp(P) + WS_R2), (const float*)(wsp(P) + WS_LSE), (const bf16_t*)(r1 + R1_OB), (const bf16_t*)(r1 + R1_OC), P.out_norm_a + l * 512, P.out_norm_b + l * 256, P.out_norm_c + l * 256, (bf16_t*)(wsp(P) + WS_H), bid, nblk); }
DEVI void ph_wout(const Params& P, int l, int bid, int nblk) {
    const GemmD g = mk_gemm((const bf16_t*)(wsp(P) + WS_H), (const bf16_t*)(wsp(P) + WS_WOUTT) + (size_t)l * kD * kD, kD, kD, kTok / 256, 4, nullptr, 0, 1 << 30);
    EpiResid E; E.x32 = (l == 0) ? P.x : nullptr; E.xb = (bf16_t*)(wsp(P) + WS_XB);
    GEMM_RUN(g, E);
}
DEVI void ph_router(const Params& P, int l, unsigned char* lds, int bid, int nblk) { phase_router((const bf16_t*)(wsp(P) + WS_XB), P.ffn_norm + (size_t)l * kD, P.w_router + (size_t)l * kD * kE, (bf16_t*)(wsp(P) + WS_H), (float*)(wsp(P) + WS_AFF), lds, bid, nblk); }
DEVI void ph_topk(const Params& P, unsigned char* lds, int bid, int nblk) { phase_topk((const float*)(wsp(P) + WS_AFF), (int*)(wsp(P) + WS_IDX), (float*)(wsp(P) + WS_GATE), (int*)(wsp(P) + WS_TSLOT), wsp(P) + WS_H, wsp(P) + WS_R2, FP8_GU ? kD : kD * 2, lds, bid, nblk); }
DEVI void ph_gu(const Params& P, int l, int bid, int nblk) {
#if FP8_GU
    const GemmD g = mk_gemm((const bf16_t*)(wsp(P) + WS_R2), (const bf16_t*)(wsp(P) + WS_WGUT + (size_t)l * kE * 4096 * kD), kD, kD, 512, 16, nullptr, (size_t)4096 * kD, 32);
    EpiGU E; E.hid = (bf16_t*)(wsp(P) + WS_R1); E.sc = 1.f / kW8; E.nomath = false;
    GEMM_RUN8(g, E);
#else
    const GemmD g = mk_gemm((const bf16_t*)(wsp(P) + WS_R2), (const bf16_t*)(wsp(P) + WS_WGUT) + (size_t)l * kE * 4096 * kD, kD, kD, 512, 16, nullptr, (size_t)4096 * kD, 32);
    EpiGU E; E.hid = (bf16_t*)(wsp(P) + WS_R1); E.sc = 1.f; E.nomath = false;
    GEMM_RUN(g, E);
#endif
}
DEVI void ph_gu_dry(const Params& P, int l, int bid, int nblk) {
    const GemmD g = mk_gemm((const bf16_t*)(wsp(P) + WS_R2), (const bf16_t*)(wsp(P) + WS_WGUT + (size_t)l * kE * 4096 * kD), kD, kD, 512, 16, nullptr, (size_t)4096 * kD, 32);
#if PROBE_GUDRY == 2
    EpiGU E; E.hid = (bf16_t*)(wsp(P) + WS_R1); E.sc = 1.f / kW8; E.nomath = true;
#else
    EpiDry E; E.sink = (float*)(wsp(P) + WS_LSE);
#endif
    GEMM_RUN8(g, E);
}
DEVI void ph_down(const Params& P, int l, int bid, int nblk) {
#if FP8_DN
    const GemmD g = mk_gemm((const bf16_t*)(wsp(P) + WS_R1), (const bf16_t*)(wsp(P) + WS_WDT + (size_t)l * kE * kD * kFF), kFF, kFF, 512, 4, nullptr, (size_t)kD * kFF, 32);
    EpiDown E; E.y = (bf16_t*)(wsp(P) + WS_R2); E.gate = (const float*)(wsp(P) + WS_GATE); E.sc = 1.f / (kW8 * kH8);
    GEMM_RUN8(g, E);
#else
    const GemmD g = mk_gemm((const bf16_t*)(wsp(P) + WS_R1), (const bf16_t*)(wsp(P) + WS_WDT) + (size_t)l * kE * kD * kFF, kFF, kFF, 512, 4, nullptr, (size_t)kD * kFF, 32);
    EpiDown E; E.y = (bf16_t*)(wsp(P) + WS_R2); E.gate = (const float*)(wsp(P) + WS_GATE); E.sc = 1.f;
    GEMM_RUN(g, E);
#endif
}
DEVI void ph_combine(const Params& P, int l, int bid, int nblk) { phase_combine((bf16_t*)(wsp(P) + WS_XB), P.out, (const bf16_t*)(wsp(P) + WS_R2), (const int*)(wsp(P) + WS_TSLOT), (l + 1 < kL) ? P.attn_norm + (size_t)(l + 1) * kD : nullptr, (bf16_t*)(wsp(P) + WS_H), bid, nblk); }

typedef __attribute__((address_space(4))) const Params* CParams;
DEVI CParams kargs() { unsigned long long a = (unsigned long long)__builtin_amdgcn_kernarg_segment_ptr(); asm volatile("" : "+s"(a)); return (CParams)a; }
#if MEGA
__global__ void __launch_bounds__(kNT, 2) mega_fwd(Params P_) {
#define PK P_
    volatile LAS unsigned* st = (volatile LAS unsigned*)(dyn_lds + LDS_BYTES - 16);
    if (threadIdx.x == 0) { st[0] = 0u; st[1] = 0u; st[2] = 0u; st[3] = 0u; }
    __syncthreads();
    const XcdBarrier bar = xcd_barrier_post((unsigned*)(PK.ws + WS_CTL), st);
    const int bid = blockIdx.x, nblk = gridDim.x;
    unsigned char* lds = dyn_lds;
#pragma unroll 1
    for (int rep = 0; rep < PROBE_CONV; ++rep)
    phase_convert(PK, lds, lnd(bid), nblk);
#if USE_S5_GEMM
    ph_s5_prep(PK, lds, lnd(bid), nblk);
#endif
    phase_norm(PK.x, PK.attn_norm, (bf16_t*)(PK.ws + WS_H), lnd(bid), nblk);
    xcd_barrier(bar);
#pragma unroll 1
    for (int l = 0; l < kL; ++l) {
        ph_win(PK, l, lnd(bid), nblk);            xcd_barrier(bar);
#if USE_S5_GEMM
        ph_s5_state(PK, l, lnd(bid), nblk);       xcd_barrier(bar);
        ph_s5_scan(PK, l, lds, lnd(bid), nblk);
#pragma unroll 1
        for (int rep = 0; rep < PROBE_ATTN; ++rep)
        ph_dilated(PK, l, lnd(bid), nblk);
#pragma unroll 1
        for (int rep = 0; rep < PROBE_NA; ++rep)
        ph_na(PK, l, lnd(bid), nblk);             xcd_barrier(bar);
        ph_s5_out(PK, l, lnd(bid), nblk);         xcd_barrier(bar);
#else
        ph_s5(PK, l, lds, lnd(bid), nblk);
        ph_dilated(PK, l, lnd(bid), nblk);
        ph_na(PK, l, lnd(bid), nblk);             xcd_barrier(bar);
        ph_s5fin(PK, l, lnd(bid), nblk);          xcd_barrier(bar);
#endif
        ph_glu(PK, l, lnd(bid), nblk);            xcd_barrier(bar);
#pragma unroll 1
        for (int rep = 0; rep < PROBE_MIX; ++rep) {
        ph_mixnorm(PK, l, lnd(bid), nblk);        xcd_barrier(bar); }
        ph_wout(PK, l, lnd(bid), nblk);           xcd_barrier(bar);
#pragma unroll 1
        for (int rep = 0; rep < PROBE_RT; ++rep) {
        ph_router(PK, l, lds, lnd(bid), nblk);    xcd_barrier(bar); }
#pragma unroll 1
        for (int rep = 0; rep < PROBE_TK; ++rep) {
        ph_topk(PK, lds, lnd(bid), nblk);         xcd_barrier(bar); }
#if PROBE_GUDRY
        ph_gu_dry(PK, l, lnd(bid), nblk);         xcd_barrier(bar);
#endif
#pragma unroll 1
        for (int rep = 0; rep < PROBE_GU; ++rep) {
        ph_gu(PK, l, lnd(bid), nblk);             xcd_barrier(bar); }
#pragma unroll 1
        for (int rep = 0; rep < PROBE_DOWN; ++rep) {
        ph_down(PK, l, lnd(bid), nblk);           xcd_barrier(bar); }
        ph_combine(PK, l, lnd(bid), nblk);        xcd_barrier(bar);
    }
#undef PK
}
#else
#define KB __global__ void __launch_bounds__(kNT, 2)
KB k_convert(Params P) { phase_convert(P, dyn_lds, blockIdx.x, gridDim.x); }
KB k_norm(Params P) { phase_norm(P.x, P.attn_norm, (bf16_t*)(P.ws + WS_H), blockIdx.x, gridDim.x); }
KB k_win(Params P, int l) { ph_win(P, l, blockIdx.x, gridDim.x); }
KB k_dilated(Params P, int l) { ph_dilated(P, l, blockIdx.x, gridDim.x); }
KB k_na(Params P, int l) { ph_na(P, l, blockIdx.x, gridDim.x); }
KB k_s5(Params P, int l) { ph_s5(P, l, dyn_lds, blockIdx.x, gridDim.x); }
KB k_s5fin(Params P, int l) { ph_s5fin(P, l, blockIdx.x, gridDim.x); }
KB k_glu(Params P, int l) { ph_glu(P, l, blockIdx.x, gridDim.x); }
KB k_mixnorm(Params P, int l) { ph_mixnorm(P, l, blockIdx.x, gridDim.x); }
KB k_wout(Params P, int l) { ph_wout(P, l, blockIdx.x, gridDim.x); }
KB k_router(Params P, int l) { ph_router(P, l, dyn_lds, blockIdx.x, gridDim.x); }
KB k_topk(Params P) { ph_topk(P, dyn_lds, blockIdx.x, gridDim.x); }
KB k_gu(Params P, int l) { ph_gu(P, l, blockIdx.x, gridDim.x); }
KB k_down(Params P, int l) { ph_down(P, l, blockIdx.x, gridDim.x); }
KB k_combine(Params P, int l) { ph_combine(P, l, blockIdx.x, gridDim.x); }
#endif

extern "C" void kernel_launch(void* const* d_in, const int* in_sizes, int n_in, void* d_out, int out_size, void* d_ws, size_t ws_size, hipStream_t stream) {
    (void)in_sizes; (void)n_in; (void)out_size;
    if (ws_size < WS_END) { fprintf(stderr, "workspace too small: %zu < %zu\n", ws_size, (size_t)WS_END); return; }
    Params P{};
    const float** pp = (const float**)&P;
    for (int i = 0; i < 26; ++i) pp[i] = (const float*)d_in[i];
    P.out = (float*)d_out; P.ws = (unsigned char*)d_ws;
#if MEGA
    static int grid = 0;
    if (!grid) {
        int dev = 0, cus = 0, per_cu = 0;
        (void)hipGetDevice(&dev);
        (void)hipDeviceGetAttribute(&cus, hipDeviceAttributeMultiprocessorCount, dev);
        (void)hipFuncSetAttribute((const void*)mega_fwd, hipFuncAttributeMaxDynamicSharedMemorySize, LDS_BYTES);
        (void)hipOccupancyMaxActiveBlocksPerMultiprocessor(&per_cu, (const void*)mega_fwd, kNT, LDS_BYTES);
        grid = (per_cu >= 1) ? cus : 0;
        if (!grid) fprintf(stderr, "mega_fwd does not fit a CU\n");
    }
    if (!grid) return;
    (void)hipMemsetAsync(P.ws + WS_CTL, 0, XCD_BAR_WORDS * sizeof(unsigned), stream);
    mega_fwd<<<grid, kNT, LDS_BYTES, stream>>>(P);
#else
    (void)hipFuncSetAttribute((const void*)k_router, hipFuncAttributeMaxDynamicSharedMemorySize, 65536);
    const int G = 1024;
    k_convert<<<G, kNT, 256 * 72 * 2, stream>>>(P);
    k_norm<<<G, kNT, 0, stream>>>(P);
    for (int l = 0; l < kL; ++l) {
        k_win<<<G, kNT, 0, stream>>>(P, l);
        k_dilated<<<G, kNT, 0, stream>>>(P, l);
        k_na<<<G, kNT, 0, stream>>>(P, l);
        k_s5<<<256, kNT, 8 * 128 * 4, stream>>>(P, l);
        k_s5fin<<<G, kNT, 0, stream>>>(P, l);
        k_glu<<<256, kNT, 0, stream>>>(P, l);
        k_mixnorm<<<G, kNT, 0, stream>>>(P, l);
        k_wout<<<G, kNT, 0, stream>>>(P, l);
        k_router<<<512, kNT, 65536, stream>>>(P, l);
        k_topk<<<128, kNT, 4096, stream>>>(P);
        k_gu<<<G, kNT, 0, stream>>>(P, l);
        k_down<<<G, kNT, 0, stream>>>(P, l);
        k_combine<<<G, kNT, 0, stream>>>(P, l);
    }
#endif
}
```

```cpp
#include <hip/hip_runtime.h>
#include <stdint.h>
#include <stdio.h>

#define DEVI __device__ __forceinline__
#define LAS __attribute__((address_space(3)))
typedef unsigned short bf16_t;
typedef short bf16x8 __attribute__((ext_vector_type(8)));
typedef float f32x4 __attribute__((ext_vector_type(4)));
typedef float f32x2 __attribute__((ext_vector_type(2)));
typedef unsigned u32x4 __attribute__((ext_vector_type(4)));
typedef unsigned u32x2 __attribute__((ext_vector_type(2)));

constexpr int kB = 8, kS = 8192, kD = 1024, kL = 4, kTok = kB * kS;
constexpr int kINW = 2560;
constexpr int kE = 16, kCap = 1024, kFF = 2048;
constexpr int kNT = 512;
constexpr float kEps = 1e-6f;
constexpr float kLog2e = 1.4426950408889634f, kLn2 = 0.6931471805599453f;

constexpr size_t MiB = 1024ull * 1024ull;
constexpr size_t WS_CTL   = 0;
constexpr size_t WS_WINT  = 1 * MiB;
constexpr size_t WS_WOUTT = WS_WINT + 20 * MiB;
constexpr size_t WS_WGLUT = WS_WOUTT + 8 * MiB;
constexpr size_t WS_WGUT  = WS_WGLUT + 1 * MiB;
constexpr size_t WS_WDT   = WS_WGUT + 512 * MiB;
constexpr size_t WS_H     = WS_WDT + 256 * MiB;
constexpr size_t WS_R1    = WS_H + 128 * MiB;
constexpr size_t WS_R2    = WS_R1 + 512 * MiB;
constexpr size_t WS_AFF   = WS_R2 + 256 * MiB;
constexpr size_t WS_IDX   = WS_AFF + 4 * MiB;
constexpr size_t WS_GATE  = WS_IDX + 1 * MiB;
constexpr size_t WS_TSLOT = WS_GATE + 1 * MiB;
constexpr size_t WS_LSE   = WS_TSLOT + 4 * MiB;
constexpr size_t WS_WST   = WS_LSE + 8 * MiB;
constexpr size_t WS_WSO   = WS_WST + 8 * MiB;
constexpr size_t WS_YS    = WS_WSO + 16 * MiB;
constexpr size_t WS_XB    = WS_YS;
constexpr size_t WS_END   = WS_YS + 128 * MiB;
constexpr size_t R2_Z     = 192 * MiB;
constexpr size_t R1_QA = 0, R1_KA = 64 * MiB, R1_VA = 128 * MiB, R1_QB = 192 * MiB, R1_KB = 224 * MiB, R1_VB = 256 * MiB,
                 R1_UX = 288 * MiB, R1_OB = 352 * MiB, R1_OC = 384 * MiB, R1_G = 416 * MiB;

struct Params {
    const float* x; const float* attn_norm; const float* w_in; const float* q_norm_a; const float* k_norm_a; const float* q_norm_b; const float* k_norm_b;
    const float* rpb; const float* s5_a_re; const float* s5_a_im; const float* s5_log_dt; const float* s5_b_re; const float* s5_b_im; const float* s5_c_re; const float* s5_c_im;
    const float* s5_d; const float* w_glu; const float* out_norm_a; const float* out_norm_b; const float* out_norm_c; const float* w_out; const float* ffn_norm;
    const float* w_router; const float* w_gate; const float* w_up; const float* w_down;
    float* out; unsigned char* ws;
};

DEVI float bf2f(bf16_t b) { return __uint_as_float(((unsigned)b) << 16); }
DEVI bf16_t f2bf(float f) { unsigned u = __float_as_uint(f); u += 0x7FFFu + ((u >> 16) & 1u); return (bf16_t)(u >> 16); }
typedef __bf16 bf16x2_t __attribute__((ext_vector_type(2)));
DEVI unsigned pk2(float lo, float hi) { const f32x2 v = {lo, hi}; return __builtin_bit_cast(unsigned, __builtin_convertvector(v, bf16x2_t)); }
DEVI int tidx() { int t = threadIdx.x; asm volatile("" : "+v"(t)); return t; }
#define GAS __attribute__((address_space(1)))
DEVI unsigned char* wsp(const Params& P) { unsigned long long a = (unsigned long long)P.ws; asm volatile("" : "+s"(a)); return (unsigned char*)(GAS unsigned char*)a; }
DEVI int lnd(int v) { asm volatile("" : "+s"(v)); return v; }
DEVI float wave_sum(float v) {
#pragma unroll
    for (int m = 32; m >= 1; m >>= 1) v += __shfl_xor(v, m);
    return v;
}
DEVI float frcp(float x) { return __builtin_amdgcn_rcpf(x); }
DEVI float gelu_tanh(float y) { const float z = 0.7978845608028654f * (y + 0.044715f * y * y * y); const float t = 1.f - 2.f * frcp(1.f + __expf(2.f * z)); return 0.5f * y * (1.f + t); }

#ifndef EMU_BF16_X
#define EMU_BF16_X 0
#endif
#ifndef EMU_FP8_WIN
#define EMU_FP8_WIN 0
#endif
#ifndef EMU_FP8_WOUT
#define EMU_FP8_WOUT 0
#endif
#ifndef EMU_FP8_GU
#define EMU_FP8_GU 0
#endif
#ifndef EMU_FP8_DN
#define EMU_FP8_DN 0
#endif
DEVI float q8(float x, float sc, float inv) {
    float y = x * sc; const float ay = fabsf(y);
    if (ay < 0.015625f) y = rintf(y * 512.f) * (1.f / 512.f);
    else { unsigned u = __float_as_uint(y); u += 0x7FFFFu + ((u >> 20) & 1u); u &= 0xFFF00000u; y = __uint_as_float(u); y = fminf(fmaxf(y, -448.f), 448.f); }
    return y * inv;
}
#ifndef FP8_GU
#define FP8_GU 1
#endif
#ifndef FP8_DN
#define FP8_DN 1
#endif
#ifndef FP8_Y
#define FP8_Y 1
#endif
constexpr float kY8 = 64.f;
constexpr float kW8 = 64.f, kH8 = 8.f;
DEVI unsigned pk4_fp8(float a, float b, float c, float d) { unsigned w = 0u; w = __builtin_amdgcn_cvt_pk_fp8_f32(a, b, w, false); w = __builtin_amdgcn_cvt_pk_fp8_f32(c, d, w, true); return w; }
DEVI int cmap_head(int cs) { const int bj = cs >> 7, wc = (cs >> 5) & 3, n = (cs >> 4) & 1, fq = (cs >> 2) & 3, j = cs & 3; return 64 * wc + 32 * bj + 8 * fq + 4 * n + j; }
DEVI int cmap_pk(int cs)   { const int bj = cs >> 7, wc = (cs >> 5) & 3, n = (cs >> 4) & 1, fq = (cs >> 2) & 3, j = cs & 3; return 128 * bj + 32 * wc + 8 * fq + 4 * n + j; }
DEVI int cmap_gu(int cs)   { const int wc = (cs >> 5) & 3, n = (cs >> 4) & 1, fq = (cs >> 2) & 3, j = cs & 3; return 32 * wc + 8 * fq + 4 * n + j; }

template <int MODE, int QEMU = 0>
DEVI void convert_item(const float* W0, const float* W1, int ldw, int K, bf16_t* Bt, int kt, int pn, unsigned char* lds) {
    bf16_t* t = (bf16_t*)lds;
    const int tid = tidx();
#pragma unroll 4
    for (int it = 0; it < 32; ++it) {
        const int e = it * kNT + tid, k = e >> 8, cs = e & 255;
        float v;
        if (MODE == 0) v = W0[(size_t)(kt * 64 + k) * ldw + pn * 256 + cs];
        else if (MODE == 1) v = W0[(size_t)(kt * 64 + k) * ldw + pn * 256 + cmap_head(cs)];
        else if (MODE == 2) v = W0[(size_t)(kt * 64 + k) * ldw + pn * 256 + cmap_pk(cs)];
        else v = ((cs >> 7) ? W1 : W0)[(size_t)(kt * 64 + k) * ldw + pn * 128 + cmap_gu(cs)];
        if (QEMU) v = q8(v, 64.f, 1.f / 64.f);
        t[cs * 72 + k] = f2bf(v);
    }
    __syncthreads();
#pragma unroll
    for (int it = 0; it < 4; ++it) {
        const int c = it * kNT + tid, row = c >> 3, part = c & 7;
        const u32x4 v = *(const u32x4*)(t + row * 72 + part * 8);
        *(u32x4*)(Bt + (size_t)(pn * 256 + row) * K + kt * 64 + part * 8) = v;
    }
    __syncthreads();
}

template <int MODE>
DEVI void convert_item8(const float* W0, const float* W1, int ldw, int K, unsigned char* Bt, int kt, int pn, unsigned char* lds) {
    unsigned char* t = lds;
    const int tid = tidx();
#pragma unroll 4
    for (int it = 0; it < 64; ++it) {
        const int e = it * kNT + tid, k = e >> 8, cs = e & 255;
        float v;
        if (MODE == 2) v = W0[(size_t)(kt * 128 + k) * ldw + pn * 256 + cmap_pk(cs)];
        else v = ((cs >> 7) ? W1 : W0)[(size_t)(kt * 128 + k) * ldw + pn * 128 + cmap_gu(cs)];
        v *= kW8;
        t[cs * 144 + k] = (unsigned char)(__builtin_amdgcn_cvt_pk_fp8_f32(v, v, 0u, false) & 0xFFu);
    }
    __syncthreads();
#pragma unroll
    for (int it = 0; it < 4; ++it) {
        const int c = it * kNT + tid, row = c >> 3, part = c & 7;
        const u32x4 v = *(const u32x4*)(t + row * 144 + part * 16);
        *(u32x4*)(Bt + (size_t)(pn * 256 + row) * K + kt * 128 + part * 16) = v;
    }
    __syncthreads();
}

DEVI void phase_convert(const Params& P, unsigned char* lds, int bid, int nblk) {
    constexpr int N_WIN = kL * 16 * 10, N_WOUT = kL * 16 * 4, N_WGLU = kL * 4 * 1, N_WGU = kL * kE * (FP8_GU ? 8 : 16) * 16, N_WD = kL * kE * (FP8_DN ? 16 : 32) * 4;
    constexpr int TOT = N_WIN + N_WOUT + N_WGLU + N_WGU + N_WD;
    for (int it = bid; it < TOT; it += nblk) {
        int i = it;
        if (i < N_WIN) { const int l = i / 160, r = i % 160, kt = r / 10, pn = r % 10;
            convert_item<1, EMU_FP8_WIN>(P.w_in + (size_t)l * kD * kINW, nullptr, kINW, kD, (bf16_t*)(wsp(P) + WS_WINT) + (size_t)l * kINW * kD, kt, pn, lds); continue; }
        i -= N_WIN;
        if (i < N_WOUT) { const int l = i / 64, r = i % 64, kt = r / 4, pn = r % 4;
            convert_item<2, EMU_FP8_WOUT>(P.w_out + (size_t)l * kD * kD, nullptr, kD, kD, (bf16_t*)(wsp(P) + WS_WOUTT) + (size_t)l * kD * kD, kt, pn, lds); continue; }
        i -= N_WOUT;
        if (i < N_WGLU) { const int l = i / 4, kt = i % 4;
            convert_item<2>(P.w_glu + (size_t)l * 256 * 256, nullptr, 256, 256, (bf16_t*)(wsp(P) + WS_WGLUT) + (size_t)l * 256 * 256, kt, 0, lds); continue; }
        i -= N_WGLU;
#if FP8_GU
        if (i < N_WGU) { const int le = i / 128, r = i % 128, kt = r / 16, pn = r % 16;
            convert_item8<3>(P.w_gate + (size_t)le * kD * kFF, P.w_up + (size_t)le * kD * kFF, kFF, kD, wsp(P) + WS_WGUT + (size_t)le * 4096 * kD, kt, pn, lds); continue; }
#else
        if (i < N_WGU) { const int le = i / 256, r = i % 256, kt = r / 16, pn = r % 16;
            convert_item<3, EMU_FP8_GU>(P.w_gate + (size_t)le * kD * kFF, P.w_up + (size_t)le * kD * kFF, kFF, kD, (bf16_t*)(wsp(P) + WS_WGUT) + (size_t)le * 4096 * kD, kt, pn, lds); continue; }
#endif
        i -= N_WGU;
#if FP8_DN
        { const int le = i / 64, r = i % 64, kt = r / 4, pn = r % 4;
            convert_item8<2>(P.w_down + (size_t)le * kFF * kD, nullptr, kD, kFF, wsp(P) + WS_WDT + (size_t)le * kD * kFF, kt, pn, lds); }
#else
        { const int le = i / 128, r = i % 128, kt = r / 4, pn = r % 4;
            convert_item<2, EMU_FP8_DN>(P.w_down + (size_t)le * kFF * kD, nullptr, kD, kFF, (bf16_t*)(wsp(P) + WS_WDT) + (size_t)le * kD * kFF, kt, pn, lds); }
#endif
    }
}

DEVI void phase_norm(const float* x, const float* gain, bf16_t* h, int bid, int nblk) {
    const int wid = tidx() >> 6, lane = tidx() & 63;
    f32x4 g[4];
#pragma unroll
    for (int q = 0; q < 4; ++q) g[q] = *(const f32x4*)(gain + q * 256 + lane * 4);
    for (int row = bid * 8 + wid; row < kTok; row += nblk * 8) {
        f32x4 v[4]; float ss = 0.f;
#pragma unroll
        for (int q = 0; q < 4; ++q) { v[q] = *(const f32x4*)(x + (size_t)row * kD + q * 256 + lane * 4); ss += v[q].x * v[q].x + v[q].y * v[q].y + v[q].z * v[q].z + v[q].w * v[q].w; }
        ss = wave_sum(ss);
        const float rstd = rsqrtf(ss * (1.f / kD) + kEps);
#pragma unroll
        for (int q = 0; q < 4; ++q) { f32x4 t = v[q] * rstd * g[q]; if (EMU_FP8_WIN) { t.x = q8(t.x, 1.f, 1.f); t.y = q8(t.y, 1.f, 1.f); t.z = q8(t.z, 1.f, 1.f); t.w = q8(t.w, 1.f, 1.f); }
            u32x2 o; o.x = pk2(t.x, t.y); o.y = pk2(t.z, t.w);
            *(u32x2*)(h + (size_t)row * kD + q * 256 + lane * 4) = o; }
    }
}

DEVI void phase_router(const bf16_t* x, const float* gain, const float* wr  , bf16_t* h, float* aff, unsigned char* lds, int bid, int nblk) {
    float* wT = (float*)lds;
    for (int i = tidx(); i < 16 * 1024; i += kNT) { const int k = i >> 4, e = i & 15; wT[e * 1024 + k] = wr[i]; }
    __syncthreads();
    const int wid = tidx() >> 6, lane = tidx() & 63;
    f32x4 g[4];
#pragma unroll
    for (int q = 0; q < 4; ++q) g[q] = *(const f32x4*)(gain + q * 256 + lane * 4);
    u32x2 nvx[2][4];
    { const int r0 = (bid * 8 + wid) * 2;
      if (r0 < kTok) {
#pragma unroll
        for (int r = 0; r < 2; ++r)
#pragma unroll
            for (int q = 0; q < 4; ++q) nvx[r][q] = *(const u32x2*)(x + (size_t)(r0 + r) * kD + q * 256 + lane * 4); } }
    for (int row0 = (bid * 8 + wid) * 2; row0 < kTok; row0 += nblk * 8 * 2) {
        asm volatile("" ::: "memory");
        f32x4 v[2][4];
#pragma unroll
        for (int r = 0; r < 2; ++r)
#pragma unroll
            for (int q = 0; q < 4; ++q) { const u32x2 w = nvx[r][q]; v[r][q] = (f32x4){__uint_as_float(w.x << 16), __uint_as_float(w.x & 0xFFFF0000u), __uint_as_float(w.y << 16), __uint_as_float(w.y & 0xFFFF0000u)}; }
        { const int nr0 = row0 + nblk * 8 * 2;
          if (nr0 < kTok) {
#pragma unroll
            for (int r = 0; r < 2; ++r)
#pragma unroll
                for (int q = 0; q < 4; ++q) nvx[r][q] = *(const u32x2*)(x + (size_t)(nr0 + r) * kD + q * 256 + lane * 4); } }
#pragma unroll
        for (int r = 0; r < 2; ++r) { float ss = 0.f;
#pragma unroll
            for (int q = 0; q < 4; ++q) { ss += v[r][q].x * v[r][q].x + v[r][q].y * v[r][q].y + v[r][q].z * v[r][q].z + v[r][q].w * v[r][q].w; }
            ss = wave_sum(ss); const float rstd = rsqrtf(ss * (1.f / kD) + kEps);
#pragma unroll
            for (int q = 0; q < 4; ++q) { v[r][q] = v[r][q] * rstd * g[q];
#if FP8_GU
                *(unsigned*)((unsigned char*)h + (size_t)(row0 + r) * kD + q * 256 + lane * 4) = pk4_fp8(v[r][q].x, v[r][q].y, v[r][q].z, v[r][q].w); }
#else
                u32x2 o;
                if (EMU_FP8_GU) { o.x = pk2(q8(v[r][q].x, 1.f, 1.f), q8(v[r][q].y, 1.f, 1.f)); o.y = pk2(q8(v[r][q].z, 1.f, 1.f), q8(v[r][q].w, 1.f, 1.f)); }
                else { o.x = pk2(v[r][q].x, v[r][q].y); o.y = pk2(v[r][q].z, v[r][q].w); }
                *(u32x2*)(h + (size_t)(row0 + r) * kD + q * 256 + lane * 4) = o; }
#endif
        }
        float pa[32];
#pragma unroll
        for (int e = 0; e < 16; ++e) {
            float s0 = 0.f, s1 = 0.f;
#pragma unroll
            for (int q = 0; q < 4; ++q) { const f32x4 w = *(const f32x4*)(wT + e * 1024 + q * 256 + lane * 4);
                s0 += v[0][q].x * w.x + v[0][q].y * w.y + v[0][q].z * w.z + v[0][q].w * w.w;
                s1 += v[1][q].x * w.x + v[1][q].y * w.y + v[1][q].z * w.z + v[1][q].w * w.w; }
            pa[e] = s0; pa[16 + e] = s1;
        }
#define RS_STEP(HALF, MASK) { const bool up = (lane & (MASK)) != 0; _Pragma("unroll") for (int i = 0; i < (HALF); ++i) { const float keep = up ? pa[i + (HALF)] : pa[i], send = up ? pa[i] : pa[i + (HALF)]; pa[i] = keep + __shfl_xor(send, (MASK)); } }
        RS_STEP(16, 32) RS_STEP(8, 16) RS_STEP(4, 8) RS_STEP(2, 4) RS_STEP(1, 2)
#undef RS_STEP
        const float logit = pa[0] + __shfl_xor(pa[0], 1);
        float mx = logit;
#pragma unroll
        for (int m = 16; m >= 2; m >>= 1) mx = fmaxf(mx, __shfl_xor(mx, m));
        const float ex = __expf(logit - mx);
        float sm = ex;
#pragma unroll
        for (int m = 16; m >= 2; m >>= 1) sm += __shfl_xor(sm, m);
        const int row = row0 + (lane >> 5), e = (lane >> 1) & 15, b = row >> 13, s = row & (kS - 1);
        if (!(lane & 1)) aff[((size_t)(b * kE + e)) * kS + s] = ex * frcp(sm);
    }
    __syncthreads();
}

DEVI int block_excl_scan(int v, int* sh  , int& total) {
    const int lane = tidx() & 63, wid = tidx() >> 6;
    int incl = v;
#pragma unroll
    for (int d = 1; d < 64; d <<= 1) { const int o = __shfl_up(incl, d); if (lane >= d) incl += o; }
    __syncthreads();
    if (lane == 63) sh[wid] = incl;
    __syncthreads();
    int base = 0, tot = 0;
#pragma unroll
    for (int w = 0; w < 8; ++w) { const int c = sh[w]; if (w < wid) base += c; tot += c; }
    total = tot;
    return base + incl - v;
}

DEVI void phase_topk(const float* aff, int* idx, float* gate, int* tokslot, const unsigned char* hsrc, unsigned char* xe, int rowbytes, unsigned char* lds, int bid, int nblk) {
    int* hist = (int*)lds;
    int* sh = hist + 256;
    int* res = sh + 16;
    int* lsel = res + 16;
    const int tid = tidx(), lane = tid & 63, wid = tid >> 6;
    const int share = (nblk >= 2 * kB * kE) ? 2 : 1;
    for (int wi = bid; wi < kB * kE * share; wi += nblk) {
        const int item = wi / share, part = wi - item * share;
        const int b = item >> 4, e = item & 15;
        const float* a = aff + (size_t)item * kS;
        unsigned key[16];
#pragma unroll
        for (int q = 0; q < 4; ++q) { const u32x4 v = *(const u32x4*)(a + tid * 16 + q * 4); key[q * 4 + 0] = v.x; key[q * 4 + 1] = v.y; key[q * 4 + 2] = v.z; key[q * 4 + 3] = v.w; }
        unsigned prefix = 0; int kk = kCap;
#pragma unroll 1
        for (int pass = 0; pass < 4; ++pass) {
            const int shift = 24 - 8 * pass;
            __syncthreads();
            if (tid < 256) hist[tid] = 0;
            __syncthreads();
#pragma unroll
            for (int i = 0; i < 16; ++i) { const bool in = (pass == 0) || ((key[i] >> (shift + 8)) == prefix); if (in) atomicAdd(&hist[(key[i] >> shift) & 255], 1); }
            __syncthreads();
            if (wid == 0) {
                int c[4], loc = 0;
#pragma unroll
                for (int j = 0; j < 4; ++j) { c[j] = hist[255 - 4 * lane - j]; loc += c[j]; }
                int incl = loc;
#pragma unroll
                for (int d = 1; d < 64; d <<= 1) { const int o = __shfl_up(incl, d); if (lane >= d) incl += o; }
                const int excl = incl - loc;
                if (excl < kk && kk <= incl) { int run = excl; int bin = 0, nk = 0; bool found = false;
#pragma unroll
                    for (int j = 0; j < 4; ++j) { if (!found && run + c[j] >= kk) { bin = 255 - 4 * lane - j; nk = kk - run; found = true; } if (!found) run += c[j]; }
                    res[0] = bin; res[1] = nk; }
            }
            __syncthreads();
            prefix = (prefix << 8) | (unsigned)res[0]; kk = res[1];
        }
        const unsigned T = prefix;
        int ceq = 0;
#pragma unroll
        for (int i = 0; i < 16; ++i) ceq += (key[i] == T) ? 1 : 0;
        int tot;
        int eqb = block_excl_scan(ceq, sh, tot);
        int csel = 0; unsigned selmask = 0;
#pragma unroll
        for (int i = 0; i < 16; ++i) { bool s = key[i] > T; if (key[i] == T) { s = eqb < kk; ++eqb; } if (s) { selmask |= 1u << i; ++csel; } }
        int slot = block_excl_scan(csel, sh, tot);
        const size_t rbase = (size_t)(e * kB + b) * kCap;
#pragma unroll
        for (int i = 0; i < 16; ++i) { const int s = tid * 16 + i; const bool sel = (selmask >> i) & 1u;
            if (sel) { if (part == 0) { idx[rbase + slot] = b * kS + s; gate[rbase + slot] = __uint_as_float(key[i]); } lsel[slot] = b * kS + s; }
            if (part == 0) tokslot[((size_t)(b * kS + s)) * kE + e] = sel ? slot : -1;
            if (sel) ++slot; }
        __syncthreads();
        { const int cpr = rowbytes >> 4;
          const int cbeg = part * (kCap / share) * cpr, cend = cbeg + (kCap / share) * cpr;
          for (int c0 = cbeg + tid; c0 < cend; c0 += kNT * 4) {
              u32x4 v[4];
#pragma unroll
              for (int j = 0; j < 4; ++j) { const int c = c0 + j * kNT; const int r = c / cpr, ch = c - r * cpr; v[j] = *(const u32x4*)(hsrc + (size_t)lsel[r] * rowbytes + ch * 16); }
#pragma unroll
              for (int j = 0; j < 4; ++j) { const int c = c0 + j * kNT; const int r = c / cpr, ch = c - r * cpr; *(u32x4*)(xe + (rbase + r) * rowbytes + ch * 16) = v[j]; }
          } }
    }
    __syncthreads();
}

struct Unit { int pm, pn; };
DEVI bool unit_of(int Lid, int nM, int nN, Unit& u) {
    const int nwg = nM * nN; if (Lid >= nwg) return false;
    int wgid = Lid; { const int q = nwg / 8, r = nwg % 8, xcd = wgid % 8, off = wgid / 8; wgid = (xcd < r ? xcd * (q + 1) : r * (q + 1) + (xcd - r) * q) + off; }
    const int nig = 8 * nN, gid = wgid / nig, fm = gid * 8, gsz = (nM - fm) < 8 ? (nM - fm) : 8;
    u.pm = fm + ((wgid % nig) % gsz); u.pn = (wgid % nig) / gsz; return true;
}
struct GemmD { const bf16_t* A; const bf16_t* Bt; int lda, K, nM, nN; const int* rowidx; size_t bstride; int pmg; };

template <class Epi>
DEVI void gemm_simple(const GemmD g, const Epi& E, int bid, int nblk) {
    const int tid = tidx(), wid = tid >> 6, lane = tid & 63, wr = wid >> 2, wc = wid & 3, fr = lane & 15, fq = lane >> 4;
    for (int i = 0;; ++i) {
        Unit u; if (!unit_of(i * nblk + bid, g.nM, g.nN, u)) break;
        f32x4 acc[2][2][4][2];
#pragma unroll
        for (int a = 0; a < 2; ++a)
#pragma unroll
            for (int b = 0; b < 2; ++b)
#pragma unroll
                for (int m = 0; m < 4; ++m)
#pragma unroll
                    for (int n = 0; n < 2; ++n) acc[a][b][m][n] = (f32x4){0.f, 0.f, 0.f, 0.f};
        const bf16_t* Bu = g.Bt + (size_t)(u.pm / g.pmg) * g.bstride + (size_t)u.pn * 256 * g.K;
        unsigned ao[2][4], bo[2][2];
#pragma unroll
        for (int a = 0; a < 2; ++a)
#pragma unroll
            for (int m = 0; m < 4; ++m) { const int r = u.pm * 256 + 128 * a + 64 * wr + 16 * m + fr; const unsigned rr = g.rowidx ? (unsigned)g.rowidx[r] : (unsigned)r; ao[a][m] = rr * (unsigned)g.lda + 8u * fq; }
#pragma unroll
        for (int b = 0; b < 2; ++b)
#pragma unroll
            for (int n = 0; n < 2; ++n) bo[b][n] = (unsigned)(128 * b + 32 * wc + 16 * n + fr) * (unsigned)g.K + 8u * fq;
#pragma unroll 1
        for (int k0 = 0; k0 < g.K; k0 += 32) {
            bf16x8 av[2][4], bv[2][2];
#pragma unroll
            for (int a = 0; a < 2; ++a)
#pragma unroll
                for (int m = 0; m < 4; ++m) av[a][m] = *(const bf16x8*)(g.A + ao[a][m] + k0);
#pragma unroll
            for (int b = 0; b < 2; ++b)
#pragma unroll
                for (int n = 0; n < 2; ++n) bv[b][n] = *(const bf16x8*)(Bu + bo[b][n] + k0);
#pragma unroll
            for (int a = 0; a < 2; ++a)
#pragma unroll
                for (int b = 0; b < 2; ++b)
#pragma unroll
                    for (int m = 0; m < 4; ++m)
#pragma unroll
                        for (int n = 0; n < 2; ++n) acc[a][b][m][n] = __builtin_amdgcn_mfma_f32_16x16x32_bf16(bv[b][n], av[a][m], acc[a][b][m][n], 0, 0, 0);
        }
        E(acc, u, wr, wc, fr, fq);
    }
}


constexpr int PG_HTB = 128 * 64 * 2;
DEVI int pg_lds_byte(int r, int c) { const int st = (r >> 4) * 2 + (c >> 5), rr = r & 15, cc = c & 31, ob = rr * 64 + cc * 2; return st * 1024 + (ob ^ (((ob >> 9) & 1) << 5)); }
DEVI void pg_stage_rc(int b, int& R, int& C) { const int st = b / 1024, sb = b % 1024, swz = sb ^ (((sb >> 9) & 1) << 5); R = (st >> 1) * 16 + swz / 64; C = (st & 1) * 32 + (swz % 64) / 2; }

typedef int v4i __attribute__((ext_vector_type(4)));
typedef int v8i __attribute__((ext_vector_type(8)));
template <class Epi, bool ALIGN_EPI, bool SP2, bool FP8 = false>
DEVI void gemm_engine(LAS unsigned char* lds, const GemmD g, const Epi& E, int bid, int nblk) {
    const int tid = tidx(), wid = __builtin_amdgcn_readfirstlane(tid >> 6), lane = tid & 63, wr = wid >> 2, wc = wid & 3, fr = lane & 15, fq = lane >> 4;
    constexpr int ES = FP8 ? 1 : 2;
    const int K = g.K * ES  , nt = K / 128; const unsigned ldaB = (unsigned)g.lda * ES;
    unsigned voffA[2], voffB[2];
#pragma unroll
    for (int i = 0; i < 2; ++i) { int R, C; pg_stage_rc(tid * 16 + i * 8192, R, C); voffA[i] = (unsigned)R * ldaB + (unsigned)C * 2u; voffB[i] = (unsigned)(R * K + C * 2); }
    const size_t kstep = 128;
    const size_t hstepB = (size_t)128 * K, hstepA = (size_t)128 * ldaB, tstepA = 2 * hstepA;
    const unsigned ldsw = (unsigned)wid * 1024u;
    const int aoff = pg_lds_byte(wr * 64 + fr, fq * 8), boff = pg_lds_byte(wc * 32 + fr, fq * 8);
#define PG8_SA(b, h) (((b) * 2 + (h)) * PG_HTB)
#define PG8_SB(b, h) ((4 + (b) * 2 + (h)) * PG_HTB)
#define PG8_STAGE(bufoff, gbase, voff) do { _Pragma("unroll") for (int _i = 0; _i < 2; ++_i) \
        __builtin_amdgcn_global_load_lds((const unsigned*)((const char*)(gbase) + (voff)[_i]), (LAS unsigned*)(lds + (bufoff) + ldsw + _i * 8192), 16, 0, 0); } while (0)
#define PG8_RD16(off) (*(const LAS v4i*)(lds + (off)))
#define PG8_CAT2(off) __builtin_shufflevector(PG8_RD16(off), PG8_RD16((off) + 1024), 0, 1, 2, 3, 4, 5, 6, 7)
#define PG8_LDA(dst, b, h) do { _Pragma("unroll") for (int m = 0; m < 4; ++m) { if constexpr (FP8) dst##8[m] = PG8_CAT2(PG8_SA(b, h) + aoff + m * 2048); \
        else { _Pragma("unroll") for (int k = 0; k < 2; ++k) dst[m][k] = *(const LAS bf16x8*)(lds + PG8_SA(b, h) + aoff + m * 2048 + k * 1024); } } } while (0)
#define PG8_LDB(dst, b, h) do { _Pragma("unroll") for (int n = 0; n < 2; ++n) { if constexpr (FP8) dst##8[n] = PG8_CAT2(PG8_SB(b, h) + boff + n * 2048); \
        else { _Pragma("unroll") for (int k = 0; k < 2; ++k) dst[n][k] = *(const LAS bf16x8*)(lds + PG8_SB(b, h) + boff + n * 2048 + k * 1024); } } } while (0)
#define PG8_MMA(ai, bj, At, Bt) do { __builtin_amdgcn_s_setprio(1); _Pragma("unroll") for (int m = 0; m < 4; ++m) _Pragma("unroll") for (int n = 0; n < 2; ++n) { \
        if constexpr (FP8) asm volatile("v_mfma_f32_16x16x128_f8f6f4 %0, %1, %2, %0" : "+v"(acc[ai][bj][m][n]) : "v"(Bt##8[n]), "v"(At##8[m]));   \
        else { _Pragma("unroll") for (int k = 0; k < 2; ++k) acc[ai][bj][m][n] = __builtin_amdgcn_mfma_f32_16x16x32_bf16(Bt[n][k], At[m][k], acc[ai][bj][m][n], 0, 0, 0); } } \
        __builtin_amdgcn_s_setprio(0); } while (0)
#define PG8_WAIT_V(n) asm volatile("s_waitcnt vmcnt(" #n ")" ::: "memory")
#define PG8_WAIT_L(n) asm volatile("s_waitcnt lgkmcnt(" #n ")" ::: "memory")
#define PG8_BAR __builtin_amdgcn_s_barrier()
#define PG8_SCHED __builtin_amdgcn_sched_barrier(0)
    Unit cur, nxt; int ui = 0;
    if (!unit_of(bid, g.nM, g.nN, cur)) return;
    f32x4 acc[2][2][4][2];
#pragma unroll
    for (int a = 0; a < 2; ++a)
#pragma unroll
        for (int b = 0; b < 2; ++b)
#pragma unroll
            for (int m = 0; m < 4; ++m)
#pragma unroll
                for (int n = 0; n < 2; ++n) acc[a][b][m][n] = (f32x4){0.f, 0.f, 0.f, 0.f};
    bf16x8 At[4][2], B0[2][2], B1[2][2]; v8i At8[4], B08[2], B18[2];
    (void)At; (void)B0; (void)B1; (void)At8; (void)B08; (void)B18;
    static_assert(SP2, "only the two-super-phase K-loop is kept");
    const char* cA = (const char*)g.A + (size_t)cur.pm * tstepA;
    const char* cB = (const char*)g.Bt + (size_t)(cur.pm / g.pmg) * g.bstride * ES + (size_t)cur.pn * 256 * K;
    PG8_STAGE(PG8_SB(0, 0), cB, voffB); PG8_STAGE(PG8_SB(0, 1), cB + hstepB, voffB); PG8_STAGE(PG8_SA(0, 0), cA, voffA); PG8_STAGE(PG8_SA(0, 1), cA + hstepA, voffA);
    if (wr == 1) PG8_BAR;
    PG8_WAIT_V(2); PG8_BAR;
    PG8_STAGE(PG8_SB(1, 0), cB + kstep, voffB); PG8_STAGE(PG8_SA(1, 0), cA + kstep, voffA); PG8_STAGE(PG8_SB(1, 1), cB + hstepB + kstep, voffB);
    PG8_WAIT_V(6); PG8_BAR;
    for (;;) {
        const bool has_next = unit_of((ui + 1) * nblk + bid, g.nM, g.nN, nxt);
        const char* nA = has_next ? (const char*)g.A + (size_t)nxt.pm * tstepA : cA;
        const char* nB = has_next ? (const char*)g.Bt + (size_t)(nxt.pm / g.pmg) * g.bstride * ES + (size_t)nxt.pn * 256 * K : cB;
#pragma unroll 1
        for (int t = 0; t < nt; t += 2) {
            const bool last = (t == nt - 2);
            const char* a1 = cA + (size_t)(t + 1) * kstep;
            const char* a2 = last ? nA : cA + (size_t)(t + 2) * kstep; const char* b2 = last ? nB : cB + (size_t)(t + 2) * kstep;
            const char* a3 = a2 + kstep; const char* b3 = b2 + kstep;
            PG8_LDB(B0, 0, 0); PG8_LDB(B1, 0, 1); PG8_SCHED; PG8_LDA(At, 0, 0); PG8_STAGE(PG8_SA(1, 1), a1 + hstepA, voffA);
            PG8_WAIT_V(8); PG8_WAIT_L(0); PG8_BAR; PG8_MMA(0, 0, At, B0); PG8_MMA(0, 1, At, B1); PG8_BAR; PG8_SCHED;
            PG8_LDA(At, 0, 1); PG8_STAGE(PG8_SB(0, 0), b2, voffB); PG8_STAGE(PG8_SB(0, 1), b2 + hstepB, voffB); PG8_STAGE(PG8_SA(0, 0), a2, voffA);
            PG8_WAIT_V(8); PG8_WAIT_L(0); PG8_BAR; PG8_MMA(1, 0, At, B0); PG8_MMA(1, 1, At, B1); PG8_BAR; PG8_SCHED;
            PG8_LDB(B0, 1, 0); PG8_LDB(B1, 1, 1); PG8_SCHED; PG8_LDA(At, 1, 0); PG8_STAGE(PG8_SA(0, 1), a2 + hstepA, voffA);
            PG8_WAIT_V(8); PG8_WAIT_L(0); PG8_BAR; PG8_MMA(0, 0, At, B0); PG8_MMA(0, 1, At, B1); PG8_BAR; PG8_SCHED;
            PG8_LDA(At, 1, 1); PG8_STAGE(PG8_SB(1, 0), b3, voffB); PG8_STAGE(PG8_SB(1, 1), b3 + hstepB, voffB); PG8_STAGE(PG8_SA(1, 0), a3, voffA);
            PG8_WAIT_V(8); PG8_WAIT_L(0); PG8_BAR; PG8_MMA(1, 0, At, B0); PG8_MMA(1, 1, At, B1); PG8_BAR; PG8_SCHED;
        }
        if constexpr (ALIGN_EPI) { if (wr == 0) PG8_BAR; }
        if constexpr (FP8) asm volatile("s_nop 15\n\ts_nop 15" ::: "memory");
        E(acc, cur, wr, wc, fr, fq);
        if (!has_next) break;
#pragma unroll
        for (int a = 0; a < 2; ++a)
#pragma unroll
            for (int b = 0; b < 2; ++b)
#pragma unroll
                for (int m = 0; m < 4; ++m)
#pragma unroll
                    for (int n = 0; n < 2; ++n) acc[a][b][m][n] = (f32x4){0.f, 0.f, 0.f, 0.f};
        cur = nxt; cA = nA; cB = nB; ++ui;
        if constexpr (ALIGN_EPI) { if (wr == 1) PG8_BAR; }
    }
    PG8_WAIT_V(0);
    if constexpr (!ALIGN_EPI) { if (wr == 0) PG8_BAR; }
    PG8_BAR;
#undef PG8_SA
#undef PG8_SB
#undef PG8_STAGE
#undef PG8_LDA
#undef PG8_LDB
#undef PG8_MMA
#undef PG8_RD16
#undef PG8_CAT2
#undef PG8_WAIT_V
#undef PG8_WAIT_L
#undef PG8_BAR
#undef PG8_SCHED
}

struct EpiQKV {
    static constexpr int VMOPS = 16;
    bf16_t *qa, *ka, *va, *qb, *kb, *vb, *ux; const float *qna, *kna, *qnb, *knb;
    DEVI void operator()(const f32x4 (&acc)[2][2][4][2], const Unit& u, int wr, int wc, int fr, int fq) const {
        bf16_t* dst; const float* gn = nullptr; int H = 8, head0 = 0; const int pn = u.pn;
        if (pn < 2) { dst = qa; gn = qna; head0 = pn * 4; }
        else if (pn < 4) { dst = ka; gn = kna; head0 = (pn - 2) * 4; }
        else if (pn < 6) { dst = va; head0 = (pn - 4) * 4; }
        else if (pn == 6) { dst = qb; gn = qnb; H = 4; }
        else if (pn == 7) { dst = kb; gn = knb; H = 4; }
        else if (pn == 8) { dst = vb; H = 4; }
        else { dst = ux; }
        const int head = head0 + wc;
        f32x4 gv[2][2];
#pragma unroll
        for (int bj = 0; bj < 2; ++bj)
#pragma unroll
            for (int n = 0; n < 2; ++n) gv[bj][n] = gn ? *(const f32x4*)(gn + 32 * bj + 8 * fq + 4 * n) : (f32x4){1.f, 1.f, 1.f, 1.f};
#pragma unroll
        for (int ai = 0; ai < 2; ++ai)
#pragma unroll
            for (int m = 0; m < 4; ++m) {
                const int row = u.pm * 256 + 128 * ai + 64 * wr + 16 * m + fr;
                float rstd = 1.f;
                if (gn) { float ss = 0.f;
#pragma unroll
                    for (int bj = 0; bj < 2; ++bj)
#pragma unroll
                        for (int n = 0; n < 2; ++n) { const f32x4 v = acc[ai][bj][m][n]; ss += v.x * v.x + v.y * v.y + v.z * v.z + v.w * v.w; }
                    ss += __shfl_xor(ss, 16); ss += __shfl_xor(ss, 32);
                    rstd = rsqrtf(ss * (1.f / 64.f) + kEps); }
#pragma unroll
                for (int bj = 0; bj < 2; ++bj) {
                    const f32x4 v0 = acc[ai][bj][m][0] * rstd * gv[bj][0], v1 = acc[ai][bj][m][1] * rstd * gv[bj][1];
                    u32x4 w; w.x = pk2(v0.x, v0.y); w.y = pk2(v0.z, v0.w); w.z = pk2(v1.x, v1.y); w.w = pk2(v1.z, v1.w);
                    if (pn < 9) { const int b = row >> 13, s = row & (kS - 1);
                        *(u32x4*)(dst + (((size_t)(b * H + head)) * kS + s) * 64 + 32 * bj + 8 * fq) = w; }
                    else { const int gidx = 4 * wc + 2 * bj + (fq >> 1), c0 = 8 * (fq & 1);
                        *(u32x4*)(dst + ((size_t)gidx * 4096 + (row >> 4)) * 512 + (row & 15) * 16 + c0) = w; }
                }
            }
    }
};
struct EpiResid {
    static constexpr int VMOPS = 16;
    const float* x32; bf16_t* xb;
    DEVI void operator()(const f32x4 (&acc)[2][2][4][2], const Unit& u, int wr, int wc, int fr, int fq) const {
#pragma unroll
        for (int ai = 0; ai < 2; ++ai)
#pragma unroll
            for (int m = 0; m < 4; ++m) { const size_t ro = (size_t)(u.pm * 256 + 128 * ai + 64 * wr + 16 * m + fr) * kD + u.pn * 256 + 32 * wc + 8 * fq;
#pragma unroll
                for (int bj = 0; bj < 2; ++bj) { const size_t o = ro + 128 * bj; f32x4 v0, v1;
                    if (x32) { v0 = *(const f32x4*)(x32 + o); v1 = *(const f32x4*)(x32 + o + 4); }
                    else { const u32x4 w = *(const u32x4*)(xb + o); v0 = (f32x4){__uint_as_float(w.x << 16), __uint_as_float(w.x & 0xFFFF0000u), __uint_as_float(w.y << 16), __uint_as_float(w.y & 0xFFFF0000u)};
                        v1 = (f32x4){__uint_as_float(w.z << 16), __uint_as_float(w.z & 0xFFFF0000u), __uint_as_float(w.w << 16), __uint_as_float(w.w & 0xFFFF0000u)}; }
                    v0 += acc[ai][bj][m][0]; v1 += acc[ai][bj][m][1];
                    u32x4 r; r.x = pk2(v0.x, v0.y); r.y = pk2(v0.z, v0.w); r.z = pk2(v1.x, v1.y); r.w = pk2(v1.z, v1.w);
                    *(u32x4*)(xb + o) = r; } }
    }
};
struct EpiGU {
    static constexpr int VMOPS = 8;
    bf16_t* hid; float sc; bool nomath;
    DEVI void operator()(const f32x4 (&acc)[2][2][4][2], const Unit& u, int wr, int wc, int fr, int fq) const {
#pragma unroll
        for (int ai = 0; ai < 2; ++ai)
#pragma unroll
            for (int m = 0; m < 4; ++m) { const size_t row = (size_t)(u.pm * 256 + 128 * ai + 64 * wr + 16 * m + fr);
                float o[8];
                const float k1 = -sc * kLog2e, k2 = sc * sc * (FP8_DN ? kH8 : 1.f);
#pragma unroll
                for (int n = 0; n < 2; ++n)
#pragma unroll
                    for (int j = 0; j < 4; j += 2) { const f32x2 a = {acc[ai][0][m][n][j], acc[ai][0][m][n][j + 1]}, b = {acc[ai][1][m][n][j], acc[ai][1][m][n][j + 1]};
                        const f32x2 ab = a * b, t = a * k1; f32x2 d; d.x = __builtin_amdgcn_exp2f(t.x); d.y = __builtin_amdgcn_exp2f(t.y); d = d + 1.f;
                        f32x2 r; r.x = frcp(d.x); r.y = frcp(d.y); const f32x2 v = nomath ? ab * k2 : (ab * r) * k2;
                        o[n * 4 + j] = v.x; o[n * 4 + j + 1] = v.y; }
#if FP8_DN
                u32x2 w;
#pragma unroll
                for (int t = 0; t < 8; ++t) o[t] = __builtin_amdgcn_fmed3f(o[t], -448.f, 448.f);
                w.x = pk4_fp8(o[0], o[1], o[2], o[3]); w.y = pk4_fp8(o[4], o[5], o[6], o[7]);
                *(u32x2*)((unsigned char*)hid + row * kFF + u.pn * 128 + 32 * wc + 8 * fq) = w;
#else
                u32x4 w; w.x = pk2(o[0], o[1]); w.y = pk2(o[2], o[3]); w.z = pk2(o[4], o[5]); w.w = pk2(o[6], o[7]);
                *(u32x4*)(hid + row * kFF + u.pn * 128 + 32 * wc + 8 * fq) = w;
#endif
            }
    }
};
struct EpiDry {
    static constexpr int VMOPS = 0;
    float* sink;
    DEVI void operator()(const f32x4 (&acc)[2][2][4][2], const Unit& u, int wr, int wc, int fr, int fq) const {
        float t = 0.f;
#pragma unroll
        for (int ai = 0; ai < 2; ++ai)
#pragma unroll
            for (int bj = 0; bj < 2; ++bj)
#pragma unroll
                for (int m = 0; m < 4; ++m)
#pragma unroll
                    for (int n = 0; n < 2; ++n) t += acc[ai][bj][m][n].x + acc[ai][bj][m][n].y + acc[ai][bj][m][n].z + acc[ai][bj][m][n].w;
        if (t == 1.2345e30f) sink[0] = t;
    }
};
struct EpiDown {
    static constexpr int VMOPS = 16;
    bf16_t* y; const float* gate; float sc;
    DEVI void operator()(const f32x4 (&acc)[2][2][4][2], const Unit& u, int wr, int wc, int fr, int fq) const {
#pragma unroll
        for (int ai = 0; ai < 2; ++ai)
#pragma unroll
            for (int m = 0; m < 4; ++m) { const size_t row = (size_t)(u.pm * 256 + 128 * ai + 64 * wr + 16 * m + fr); const float gv = gate[row] * sc * (FP8_Y ? kY8 : 1.f);
#pragma unroll
                for (int bj = 0; bj < 2; ++bj) { const f32x4 v0 = acc[ai][bj][m][0] * gv, v1 = acc[ai][bj][m][1] * gv;
#if FP8_Y
                    u32x2 w; w.x = pk4_fp8(__builtin_amdgcn_fmed3f(v0.x, -448.f, 448.f), __builtin_amdgcn_fmed3f(v0.y, -448.f, 448.f), __builtin_amdgcn_fmed3f(v0.z, -448.f, 448.f), __builtin_amdgcn_fmed3f(v0.w, -448.f, 448.f));
                    w.y = pk4_fp8(__builtin_amdgcn_fmed3f(v1.x, -448.f, 448.f), __builtin_amdgcn_fmed3f(v1.y, -448.f, 448.f), __builtin_amdgcn_fmed3f(v1.z, -448.f, 448.f), __builtin_amdgcn_fmed3f(v1.w, -448.f, 448.f));
                    *(u32x2*)((unsigned char*)y + row * kD + u.pn * 256 + 128 * bj + 32 * wc + 8 * fq) = w;
#else
                    u32x4 w; w.x = pk2(v0.x, v0.y); w.y = pk2(v0.z, v0.w); w.z = pk2(v1.x, v1.y); w.w = pk2(v1.z, v1.w);
                    *(u32x4*)(y + row * kD + u.pn * 256 + 128 * bj + 32 * wc + 8 * fq) = w;
#endif
                } }
    }
};
struct EpiGlu {
    static constexpr int VMOPS = 16;
    const bf16_t* g; bf16_t* oc;
    DEVI void operator()(const f32x4 (&acc)[2][2][4][2], const Unit& u, int wr, int wc, int fr, int fq) const {
#pragma unroll
        for (int ai = 0; ai < 2; ++ai)
#pragma unroll
            for (int m = 0; m < 4; ++m) { const size_t row = (size_t)(u.pm * 256 + 128 * ai + 64 * wr + 16 * m + fr);
#pragma unroll
                for (int bj = 0; bj < 2; ++bj) { const size_t o = row * 256 + 128 * bj + 32 * wc + 8 * fq;
                    const u32x4 gw = *(const u32x4*)(g + o); float o8[8];
#pragma unroll
                    for (int n = 0; n < 2; ++n)
#pragma unroll
                        for (int j = 0; j < 4; ++j) { const int t = n * 4 + j; const unsigned wv = (t < 2) ? gw.x : (t < 4) ? gw.y : (t < 6) ? gw.z : gw.w;
                            const float gg = __uint_as_float((t & 1) ? (wv & 0xFFFF0000u) : (wv << 16)); o8[t] = gg * frcp(1.f + __expf(-acc[ai][bj][m][n][j])); }
                    u32x4 w; w.x = pk2(o8[0], o8[1]); w.y = pk2(o8[2], o8[3]); w.z = pk2(o8[4], o8[5]); w.w = pk2(o8[6], o8[7]);
                    *(u32x4*)(oc + o) = w; } }
    }
};

DEVI void load_row64(const bf16_t* p, float* d) {
#pragma unroll
    for (int i = 0; i < 8; ++i) { const u32x4 v = *(const u32x4*)(p + i * 8);
        d[i * 8 + 0] = __uint_as_float(v.x << 16); d[i * 8 + 1] = __uint_as_float(v.x & 0xFFFF0000u); d[i * 8 + 2] = __uint_as_float(v.y << 16); d[i * 8 + 3] = __uint_as_float(v.y & 0xFFFF0000u);
        d[i * 8 + 4] = __uint_as_float(v.z << 16); d[i * 8 + 5] = __uint_as_float(v.z & 0xFFFF0000u); d[i * 8 + 6] = __uint_as_float(v.w << 16); d[i * 8 + 7] = __uint_as_float(v.w & 0xFFFF0000u); }
}
DEVI void store_row64(bf16_t* p, const float* d, float sc) {
#pragma unroll
    for (int i = 0; i < 8; ++i) { u32x4 w; w.x = pk2(d[i * 8] * sc, d[i * 8 + 1] * sc); w.y = pk2(d[i * 8 + 2] * sc, d[i * 8 + 3] * sc); w.z = pk2(d[i * 8 + 4] * sc, d[i * 8 + 5] * sc); w.w = pk2(d[i * 8 + 6] * sc, d[i * 8 + 7] * sc);
        *(u32x4*)(p + i * 8) = w; }
}
DEVI void phase_dilated_naive(const bf16_t* qa, const bf16_t* ka, const bf16_t* va, bf16_t* oac, float* lse, int bid, int nblk) {
    const int nitems = 3 * kB * 8 * (kS / kNT);
    for (int it = bid; it < nitems; it += nblk) {
        const int c = it / (kB * 8 * 16), r = it % (kB * 8 * 16), bh = r / 16, t = (r % 16) * kNT + tidx(), b = bh >> 3, h = bh & 7;
        const int dil = (c == 0) ? 1 : (c == 1) ? 4 : 16;
        const float slope = exp2f(-(float)(h + 1));
        const bf16_t* kb_ = ka + (size_t)bh * kS * 64; const bf16_t* vb_ = va + (size_t)bh * kS * 64;
        float q[64], o[64];
        load_row64(qa + ((size_t)bh * kS + t) * 64, q);
#pragma unroll
        for (int d = 0; d < 64; ++d) o[d] = 0.f;
        float m = -1e30f, l = 0.f;
        for (int rel = -64; rel <= 64; ++rel) {
            const int pos = t + rel * dil;
            if (pos < 0 || pos >= kS) continue;
            float kv[64]; load_row64(kb_ + (size_t)pos * 64, kv);
            float dot = 0.f;
#pragma unroll
            for (int d = 0; d < 64; ++d) dot += q[d] * kv[d];
            const float sc = dot * 0.125f - slope * (float)(dil * (rel < 0 ? -rel : rel));
            const float mn = fmaxf(m, sc), corr = __expf(m - mn), p = __expf(sc - mn);
            load_row64(vb_ + (size_t)pos * 64, kv);
            l = l * corr + p;
#pragma unroll
            for (int d = 0; d < 64; ++d) o[d] = o[d] * corr + p * kv[d];
            m = mn;
        }
        const size_t tok = (size_t)b * kS + t;
        store_row64(oac + ((size_t)c * kTok + tok) * 512 + h * 64, o, 1.f / l);
        lse[((size_t)c * kTok + tok) * 8 + h] = m + __logf(l);
    }
}
DEVI void phase_na_naive(const bf16_t* qb, const bf16_t* kbuf, const bf16_t* vbuf, const float* rpb  , bf16_t* ob, int bid, int nblk) {
    const int nitems = kB * 4 * (kS / kNT);
    for (int it = bid; it < nitems; it += nblk) {
        const int bh = it / 16, t = (it % 16) * kNT + tidx(), b = bh >> 2, h = bh & 3;
        const int r = t >> 6, cq = t & 63;
        int rs = r - 4; rs = rs < 0 ? 0 : (rs > 120 ? 120 : rs);
        int cs = cq - 8; cs = cs < 0 ? 0 : (cs > 48 ? 48 : cs);
        const bf16_t* kb_ = kbuf + (size_t)bh * kS * 64; const bf16_t* vb_ = vbuf + (size_t)bh * kS * 64;
        float q[64], o[64];
        load_row64(qb + ((size_t)bh * kS + t) * 64, q);
#pragma unroll
        for (int d = 0; d < 64; ++d) o[d] = 0.f;
        float m = -1e30f, l = 0.f;
        for (int kr = 0; kr < 8; ++kr)
            for (int kc = 0; kc < 16; ++kc) {
                const int krow = rs + kr, kcol = cs + kc, pos = krow * 64 + kcol;
                float kv[64]; load_row64(kb_ + (size_t)pos * 64, kv);
                float dot = 0.f;
#pragma unroll
                for (int d = 0; d < 64; ++d) dot += q[d] * kv[d];
                const float sc = dot * 0.125f + rpb[(h * 15 + (krow - r + 7)) * 31 + (kcol - cq + 15)];
                const float mn = fmaxf(m, sc), corr = __expf(m - mn), p = __expf(sc - mn);
                load_row64(vb_ + (size_t)pos * 64, kv);
                l = l * corr + p;
#pragma unroll
                for (int d = 0; d < 64; ++d) o[d] = o[d] * corr + p * kv[d];
                m = mn;
            }
        store_row64(ob + ((size_t)b * kS + t) * 256 + h * 64, o, 1.f / l);
    }
}

typedef float f32x16 __attribute__((ext_vector_type(16)));
typedef short s16x4 __attribute__((ext_vector_type(4)));
DEVI bf16x8 tr_pair(LAS unsigned char* p0, LAS unsigned char* p1) {
    const s16x4 a = __builtin_amdgcn_ds_read_tr16_b64_v4i16((LAS s16x4*)p0), b = __builtin_amdgcn_ds_read_tr16_b64_v4i16((LAS s16x4*)p1);
    return (bf16x8){a.x, a.y, a.z, a.w, b.x, b.y, b.z, b.w};
}
template <int VAR = 0>
DEVI void phase_dilated(const bf16_t* qa, const bf16_t* ka, const bf16_t* va, const float* gq, const float* gk, bf16_t* oac, float* lse, LAS unsigned char* lds, int bid, int nblk) {
    const int tid = tidx(), wid = __builtin_amdgcn_readfirstlane(tid >> 6), lane = tid & 63, h5 = lane >> 5, qc = lane & 31;
    LAS unsigned char* Kimg = lds; LAS unsigned char* Vimg = lds + 49152;
    float Mn;
    { float a = fabsf(gq[lane]), b = fabsf(gk[lane]);
#pragma unroll
      for (int m = 32; m >= 1; m >>= 1) { a = fmaxf(a, __shfl_xor(a, m)); b = fmaxf(b, __shfl_xor(b, m)); }
      Mn = 8.f * a * b; }
    const float Mb = Mn * kLog2e;
    unsigned koff[4];
#pragma unroll
    for (int s = 0; s < 4; ++s) koff[s] = (unsigned)((32 * wid + qc) * 128 + (((2 * s + h5) ^ (qc & 7)) << 4));
    unsigned voff[2];
    { const int g = lane >> 4, i16 = lane & 15, q = i16 >> 2, p = i16 & 3;
#pragma unroll
      for (int dt = 0; dt < 2; ++dt) { const int c = (2 * (g & 1) + (p >> 1) + 4 * dt) ^ ((q >> 1) << 2); voff[dt] = (unsigned)((32 * wid + 4 * h5 + q) * 128 + (c << 4) + 8 * (p & 1)); } }
    const float dbase = (float)(4 * h5 - qc);
    u32x4 pK[6], pV[6];
#define DIL_DECODE(unit_) const int c = (unit_) >> 11, rem = (unit_) & 2047, bh = rem >> 5, ub = rem & 31; \
        const int dsh = 2 * c, L = kS >> dsh, upc = 32 >> dsh, cls = ub >> (5 - dsh), u0 = (ub & (upc - 1)) << 8;
#define DIL_PREFETCH(unit_) do { DIL_DECODE(unit_) \
        const bf16_t* kbase = ka + (size_t)bh * kS * 64; const bf16_t* vbase = va + (size_t)bh * kS * 64; \
        _Pragma("unroll") for (int it = 0; it < 6; ++it) { const int id = it * kNT + tid, row = id >> 3, ch = id & 7; \
            int ki = u0 - 64 + row; ki = ki < 0 ? 0 : (ki > L - 1 ? L - 1 : ki); const size_t tok = (size_t)((ki << dsh) + cls); \
            pK[it] = *(const u32x4*)(kbase + tok * 64 + ch * 8); pV[it] = *(const u32x4*)(vbase + tok * 64 + ch * 8); } } while (0)
    if ((VAR & 8) || bid < 6144) DIL_PREFETCH(bid);
    for (int unit = bid; unit < 6144; unit += nblk) {
        DIL_DECODE(unit)
        const int q0 = u0 + 32 * wid, qtok = ((q0 + qc) << dsh) + cls;
        bf16x8 Qf[4];
#pragma unroll
        for (int s = 0; s < 4; ++s) Qf[s] = *(const bf16x8*)(qa + ((size_t)bh * kS + qtok) * 64 + 16 * s + 8 * h5);
        __syncthreads();
        if (!(VAR & 8)) {
#pragma unroll
        for (int it = 0; it < 6; ++it) { const int id = it * kNT + tid, row = id >> 3, ch = id & 7;
            *(LAS u32x4*)(Kimg + row * 128 + ((ch ^ (row & 7)) << 4)) = pK[it];
            *(LAS u32x4*)(Vimg + row * 128 + ((ch ^ (((row >> 1) & 1) << 2)) << 4)) = pV[it]; } }
        __syncthreads();
        if (!(VAR & 8) && unit + nblk < 6144) DIL_PREFETCH(unit + nblk);
        const float slope = exp2f(-(float)((bh & 7) + 1));
        const float c1 = 0.125f * kLog2e, c2 = slope * (float)(1 << dsh) * kLog2e;
        float sum = 0.f;
        f32x16 O[2];
#pragma unroll
        for (int dt = 0; dt < 2; ++dt)
#pragma unroll
            for (int i = 0; i < 16; ++i) O[dt][i] = 0.f;
#pragma unroll
        for (int kt = 0; kt < 5; ++kt) {
            const int kp0 = q0 - 64 + 32 * kt;
            if (kp0 >= 0 && kp0 < L) {
                f32x16 S;
#pragma unroll
                for (int i = 0; i < 16; ++i) S[i] = 0.f;
#pragma unroll
                for (int s = 0; s < 4; ++s) { const bf16x8 Kf = *(const LAS bf16x8*)(Kimg + koff[s] + kt * 4096); S = __builtin_amdgcn_mfma_f32_32x32x16_bf16(Kf, Qf[s], S, 0, 0, 0); }
                const float cs = (kt < 2) ? c2 : -c2, c0 = ((kt == 0 || kt == 4) ? -64.f : (kt == 2 ? 0.f : -32.f)) * c2 - Mb;
#pragma unroll
                for (int i = 0; i < 16; ++i) {
                    const float dvi = dbase + (float)((i & 3) + 8 * (i >> 2));
                    const float d = (kt == 2) ? fabsf(dvi) : dvi;
                    float sv = S[i] * c1 + (d * cs + c0);
                    if (kt == 0) sv = (dvi >= 0.f) ? sv : -1e30f;
                    if (kt == 4) sv = (dvi <= 0.f) ? sv : -1e30f;
                    const float pv = (VAR & 4) ? S[i] : __builtin_amdgcn_exp2f(sv); S[i] = pv; sum += pv;
                }
                if (VAR & 2) { _Pragma("unroll") for (int i = 0; i < 16; ++i) O[0][i] += S[i]; }
                else
#pragma unroll
                for (int s2 = 0; s2 < 2; ++s2) {
                    u32x4 pw; pw.x = pk2(S[8 * s2 + 0], S[8 * s2 + 1]); pw.y = pk2(S[8 * s2 + 2], S[8 * s2 + 3]); pw.z = pk2(S[8 * s2 + 4], S[8 * s2 + 5]); pw.w = pk2(S[8 * s2 + 6], S[8 * s2 + 7]);
                    const bf16x8 Pf = __builtin_bit_cast(bf16x8, pw);
#pragma unroll
                    for (int dt = 0; dt < 2; ++dt) { LAS unsigned char* vp = Vimg + voff[dt] + kt * 4096 + s2 * 2048;
                        const bf16x8 Vf = tr_pair(vp, vp + 1024);
                        O[dt] = __builtin_amdgcn_mfma_f32_32x32x16_bf16(Vf, Pf, O[dt], 0, 0, 0); }
                }
            }
        }
        sum += __shfl_xor(sum, 32);
        const float inv = 1.f / sum;
        const size_t tok = (size_t)(bh >> 3) * kS + qtok;
        if (VAR & 1) { float t = inv; _Pragma("unroll") for (int dt = 0; dt < 2; ++dt) _Pragma("unroll") for (int i = 0; i < 16; ++i) t += O[dt][i]; if (t == 1.2345e30f) lse[0] = t; }
        else {
        LAS unsigned char* ost = lds + 98304 + wid * 4096;
#pragma unroll
        for (int dt = 0; dt < 2; ++dt)
#pragma unroll
            for (int g4 = 0; g4 < 4; ++g4) { u32x2 w; w.x = pk2(O[dt][4 * g4] * inv, O[dt][4 * g4 + 1] * inv); w.y = pk2(O[dt][4 * g4 + 2] * inv, O[dt][4 * g4 + 3] * inv);
                *(LAS u32x2*)(ost + qc * 128 + (((4 * dt + g4) ^ (qc & 7)) << 4) + 8 * h5) = w; }
        if (h5 == 0) lse[((size_t)c * kTok + tok) * 8 + (bh & 7)] = Mn + __logf(sum);
        bf16_t* obase = oac + ((size_t)c * kTok + (size_t)(bh >> 3) * kS) * 512 + (bh & 7) * 64;
#pragma unroll
        for (int it = 0; it < 4; ++it) { const int r = it * 8 + (lane >> 3), ch = lane & 7;
            const u32x4 v = *(const LAS u32x4*)(ost + r * 128 + ((ch ^ (r & 7)) << 4));
            const size_t t2 = (size_t)(((q0 + r) << dsh) + cls);
            *(u32x4*)(obase + t2 * 512 + ch * 8) = v; }
        }
    }
#undef DIL_DECODE
#undef DIL_PREFETCH
    __syncthreads();
}
DEVI void phase_na(const bf16_t* qb, const bf16_t* kb, const bf16_t* vb, const float* rpb  , bf16_t* ob, LAS unsigned char* lds, int bid, int nblk) {
    const int tid = tidx(), wid = __builtin_amdgcn_readfirstlane(tid >> 6), lane = tid & 63, g4 = lane >> 4, i16 = lane & 15;
    LAS unsigned char* Kimg = lds; LAS unsigned char* Vimg = lds + 73728; LAS float* tab = (LAS float*)(lds + 147456);
    for (int i = tid; i < 4 * 465; i += kNT) tab[i] = rpb[i];
    const int g = wid & 3, kcs = (16 * g - 8) < 0 ? 0 : ((16 * g - 8) > 32 ? 32 : (16 * g - 8));
    const int qcol = 16 * g + i16, cs = (qcol - 8) < 0 ? 0 : ((qcol - 8) > 48 ? 48 : (qcol - 8));
    unsigned kswz[2];
#pragma unroll
    for (int s = 0; s < 2; ++s) kswz[s] = (unsigned)(((4 * s + g4) ^ (i16 & 7)) << 4);
    const int q = i16 >> 2, p = i16 & 3, sw = 2 * (g4 & 1) + (q >> 1);
    unsigned vsw[4];
#pragma unroll
    for (int dt = 0; dt < 4; ++dt) vsw[dt] = (unsigned)((((2 * dt + (p >> 1)) ^ (sw << 1)) << 4) + 8 * (p & 1));
    for (int unit = bid; unit < 2048; unit += nblk) {
        const int bh = unit >> 6, rp = unit & 63, r0 = 2 * rp, h = bh & 3;
        const int rsA = (r0 - 4) < 0 ? 0 : ((r0 - 4) > 120 ? 120 : (r0 - 4));
        const bf16_t* kbase = kb + (size_t)bh * kS * 64; const bf16_t* vbase = vb + (size_t)bh * kS * 64;
        __syncthreads();
#pragma unroll
        for (int it = 0; it < 9; ++it) {
            const int id = it * kNT + tid, row = id >> 3, ch = id & 7;
            int gr = rsA + (row >> 6); gr = gr > 127 ? 127 : gr;
            const size_t tok = (size_t)(gr * 64 + (row & 63));
            const u32x4 kv = *(const u32x4*)(kbase + tok * 64 + ch * 8), vv = *(const u32x4*)(vbase + tok * 64 + ch * 8);
            *(LAS u32x4*)(Kimg + row * 128 + ((ch ^ (row & 7)) << 4)) = kv;
            *(LAS u32x4*)(Vimg + row * 128 + ((ch ^ (((row >> 1) & 3) << 1)) << 4)) = vv;
        }
        __syncthreads();
        const int rr = r0 + (wid >> 2);
        const int rs = (rr - 4) < 0 ? 0 : ((rr - 4) > 120 ? 120 : (rr - 4)), ro = rs - rsA;
        const int qtok = rr * 64 + qcol;
        bf16x8 Qf[2];
#pragma unroll
        for (int s = 0; s < 2; ++s) Qf[s] = *(const bf16x8*)(qb + ((size_t)bh * kS + qtok) * 64 + 32 * s + 8 * g4);
        f32x4 S[16];
        const unsigned kb0 = (unsigned)((ro * 64 + kcs + i16) * 128);
#pragma unroll
        for (int t = 0; t < 16; ++t) { S[t] = (f32x4){0.f, 0.f, 0.f, 0.f};
#pragma unroll
            for (int s = 0; s < 2; ++s) { const bf16x8 Kf = *(const LAS bf16x8*)(Kimg + kb0 + (t >> 1) * 8192 + (t & 1) * 2048 + kswz[s]); S[t] = __builtin_amdgcn_mfma_f32_16x16x32_bf16(Kf, Qf[s], S[t], 0, 0, 0); } }
        float mx = -1e30f;
        const LAS float* th = tab + h * 465;
        int g4v = g4; asm volatile("" : "+v"(g4v));
#pragma unroll
        for (int t = 0; t < 16; ++t)
#pragma unroll
            for (int j = 0; j < 4; ++j) {
                const int krow = rs + (t >> 1), kcol = kcs + 16 * (t & 1) + 4 * g4v + j;
                const bool valid = (kcol >= cs) && (kcol < cs + 16);
                int dc = kcol - qcol + 15; dc = dc < 0 ? 0 : (dc > 30 ? 30 : dc);
                const float bias = th[(krow - rr + 7) * 31 + dc];
                const float sv = valid ? (S[t][j] * 0.125f + bias) * kLog2e : -1e30f;
                S[t][j] = sv; mx = fmaxf(mx, sv);
            }
        mx = fmaxf(mx, __shfl_xor(mx, 16)); mx = fmaxf(mx, __shfl_xor(mx, 32));
        float sum = 0.f;
#pragma unroll
        for (int t = 0; t < 16; ++t)
#pragma unroll
            for (int j = 0; j < 4; ++j) { const float pv = __builtin_amdgcn_exp2f(S[t][j] - mx); S[t][j] = pv; sum += pv; }
        sum += __shfl_xor(sum, 16); sum += __shfl_xor(sum, 32);
        f32x4 O[4];
#pragma unroll
        for (int dt = 0; dt < 4; ++dt) O[dt] = (f32x4){0.f, 0.f, 0.f, 0.f};
        const unsigned vb0 = (unsigned)((ro * 64 + kcs + 4 * g4 + q) * 128);
#pragma unroll
        for (int u = 0; u < 8; ++u) {
            u32x4 pw; pw.x = pk2(S[2 * u][0], S[2 * u][1]); pw.y = pk2(S[2 * u][2], S[2 * u][3]); pw.z = pk2(S[2 * u + 1][0], S[2 * u + 1][1]); pw.w = pk2(S[2 * u + 1][2], S[2 * u + 1][3]);
            const bf16x8 Pf = __builtin_bit_cast(bf16x8, pw);
#pragma unroll
            for (int dt = 0; dt < 4; ++dt) { LAS unsigned char* vp = Vimg + vb0 + u * 8192 + vsw[dt];
                const bf16x8 Vf = tr_pair(vp, vp + 2048);
                O[dt] = __builtin_amdgcn_mfma_f32_16x16x32_bf16(Vf, Pf, O[dt], 0, 0, 0); }
        }
        const float inv = 1.f / sum;
        bf16_t* orow = ob + ((size_t)(bh >> 2) * kS + qtok) * 256 + h * 64;
#pragma unroll
        for (int dt = 0; dt < 4; ++dt) { u32x2 w; w.x = pk2(O[dt][0] * inv, O[dt][1] * inv); w.y = pk2(O[dt][2] * inv, O[dt][3] * inv); *(u32x2*)(orow + 16 * dt + 4 * g4) = w; }
    }
    __syncthreads();
}
DEVI void phase_s5_naive(const Params& P, int l, const bf16_t* ux, float* ys, unsigned char* lds, int bid, int nblk) {
    const int wid = tidx() >> 6, lane = tidx() & 63;
    float* xs = (float*)lds + wid * 128;
    for (int item = wid * nblk + bid; item < kB * 16 * 2; item += nblk * 8) {
        const int dir = item & 1, g = (item >> 1) & 15, b = item >> 5;
        const size_t pbase = (((size_t)l * 2 + dir) * 16 + g) * 64;
        const float dt = __expf(P.s5_log_dt[((size_t)l * 2 + dir) * 16 + g]);
        const float a = fminf(P.s5_a_re[pbase + lane], -1e-4f), w = P.s5_a_im[pbase + lane];
        const float mag = __expf(a * dt), ar = mag * cosf(w * dt), ai = mag * sinf(w * dt);
        const float den = a * a + w * w, zr = ar - 1.f, gr = (zr * a + ai * w) / den, gi = (ai * a - zr * w) / den;
        float bbr[16], bbi[16];
#pragma unroll
        for (int c = 0; c < 16; ++c) { const float br = P.s5_b_re[(pbase + lane) * 16 + c], bi = P.s5_b_im[(pbase + lane) * 16 + c]; bbr[c] = gr * br - gi * bi; bbi[c] = gr * bi + gi * br; }
        const int cch = lane & 15, qt = lane >> 4;
        float cre[16], cim[16];
#pragma unroll
        for (int pp = 0; pp < 16; ++pp) { cre[pp] = P.s5_c_re[(pbase / 64 * 16 + cch) * 64 + qt * 16 + pp]; cim[pp] = P.s5_c_im[(pbase / 64 * 16 + cch) * 64 + qt * 16 + pp]; }
        float xr = 0.f, xi = 0.f;
        const bf16_t* ug = ux + (size_t)g * 4096 * 512;
        for (int st = 0; st < kS; ++st) {
            const int s = dir ? (kS - 1 - st) : st; const size_t tok = (size_t)b * kS + s;
            const bf16_t* up = ug + (tok >> 4) * 512 + (tok & 15) * 16;
            const u32x4 u0 = *(const u32x4*)up, u1 = *(const u32x4*)(up + 8);
            float uv[16];
            uv[0] = __uint_as_float(u0.x << 16); uv[1] = __uint_as_float(u0.x & 0xFFFF0000u); uv[2] = __uint_as_float(u0.y << 16); uv[3] = __uint_as_float(u0.y & 0xFFFF0000u);
            uv[4] = __uint_as_float(u0.z << 16); uv[5] = __uint_as_float(u0.z & 0xFFFF0000u); uv[6] = __uint_as_float(u0.w << 16); uv[7] = __uint_as_float(u0.w & 0xFFFF0000u);
            uv[8] = __uint_as_float(u1.x << 16); uv[9] = __uint_as_float(u1.x & 0xFFFF0000u); uv[10] = __uint_as_float(u1.y << 16); uv[11] = __uint_as_float(u1.y & 0xFFFF0000u);
            uv[12] = __uint_as_float(u1.z << 16); uv[13] = __uint_as_float(u1.z & 0xFFFF0000u); uv[14] = __uint_as_float(u1.w << 16); uv[15] = __uint_as_float(u1.w & 0xFFFF0000u);
            float bur = 0.f, bui = 0.f;
#pragma unroll
            for (int c = 0; c < 16; ++c) { bur += bbr[c] * uv[c]; bui += bbi[c] * uv[c]; }
            const float nr = ar * xr - ai * xi + bur, ni = ar * xi + ai * xr + bui; xr = nr; xi = ni;
            xs[lane] = xr; xs[64 + lane] = xi;
            asm volatile("s_waitcnt lgkmcnt(0)" ::: "memory");
            float y = 0.f;
#pragma unroll
            for (int pp = 0; pp < 16; ++pp) y += cre[pp] * xs[qt * 16 + pp] - cim[pp] * xs[64 + qt * 16 + pp];
            asm volatile("s_waitcnt lgkmcnt(0)" ::: "memory");
            y += __shfl_xor(y, 16); y += __shfl_xor(y, 32);
            if (lane < 16) ys[((size_t)dir * kTok + tok) * 256 + g * 16 + cch] = y;
        }
    }
}
DEVI void phase_s5_finish(const float* ys, const bf16_t* ux, const float* dskip, bf16_t* G, int bid, int nblk) {
    for (size_t i = (size_t)bid * kNT + tidx(); i < (size_t)kTok * 256; i += (size_t)nblk * kNT) {
        const size_t tok = i >> 8; const int ch = (int)(i & 255), g = ch >> 4, c = ch & 15;
        const float u = bf2f(ux[((size_t)g * 4096 + (tok >> 4)) * 512 + (tok & 15) * 16 + c]);
        const float y = ys[i] + ys[(size_t)kTok * 256 + i] + dskip[ch] * u;
        G[i] = f2bf(gelu_tanh(y));
    }
}
DEVI void unpk8(float* d, const u32x4 q, const float sc) {
    d[0] += sc * __uint_as_float(q.x << 16); d[1] += sc * __uint_as_float(q.x & 0xFFFF0000u); d[2] += sc * __uint_as_float(q.y << 16); d[3] += sc * __uint_as_float(q.y & 0xFFFF0000u);
    d[4] += sc * __uint_as_float(q.z << 16); d[5] += sc * __uint_as_float(q.z & 0xFFFF0000u); d[6] += sc * __uint_as_float(q.w << 16); d[7] += sc * __uint_as_float(q.w & 0xFFFF0000u);
}
DEVI void phase_mixnorm(const bf16_t* oac, const float* lse, const bf16_t* ob, const bf16_t* oc, const float* ga, const float* gb, const float* gc, bf16_t* mix, int bid, int nblk) {
    const int wid = tidx() >> 6, lane = tidx() & 63;
    float gn[16];
    { const float* gp = (lane < 32) ? ga + lane * 16 : (lane < 48) ? gb + (lane - 32) * 16 : gc + (lane - 48) * 16;
#pragma unroll
      for (int i = 0; i < 16; ++i) gn[i] = gp[i]; }
    for (int row = bid * 8 + wid; row < kTok; row += nblk * 8) {
        float v[16];
#pragma unroll
        for (int i = 0; i < 16; ++i) v[i] = 0.f;
        if (lane < 32) {
            const int h = lane >> 2;
            const float l0 = lse[(size_t)row * 8 + h], l1 = lse[((size_t)kTok + row) * 8 + h], l2 = lse[((size_t)2 * kTok + row) * 8 + h];
            const bf16_t* p0 = oac + (size_t)row * 512 + lane * 16; const bf16_t* p1 = p0 + (size_t)kTok * 512; const bf16_t* p2 = p1 + (size_t)kTok * 512;
            const u32x4 a0 = *(const u32x4*)p0, a1 = *(const u32x4*)(p0 + 8), b0 = *(const u32x4*)p1, b1 = *(const u32x4*)(p1 + 8), c0 = *(const u32x4*)p2, c1 = *(const u32x4*)(p2 + 8);
            const float mx = fmaxf(l0, fmaxf(l1, l2)); float w0 = __expf(l0 - mx), w1 = __expf(l1 - mx), w2 = __expf(l2 - mx); const float inv = frcp(w0 + w1 + w2); w0 *= inv; w1 *= inv; w2 *= inv;
            unpk8(v, a0, w0); unpk8(v + 8, a1, w0); unpk8(v, b0, w1); unpk8(v + 8, b1, w1); unpk8(v, c0, w2); unpk8(v + 8, c1, w2);
        } else {
            const bf16_t* p = (lane < 48) ? ob + (size_t)row * 256 + (lane - 32) * 16 : oc + (size_t)row * 256 + (lane - 48) * 16;
            const u32x4 a0 = *(const u32x4*)p, a1 = *(const u32x4*)(p + 8);
            unpk8(v, a0, 1.f); unpk8(v + 8, a1, 1.f);
        }
        float ss = 0.f;
#pragma unroll
        for (int i = 0; i < 16; ++i) ss += v[i] * v[i];
#pragma unroll
        for (int m = 1; m <= 8; m <<= 1) ss += __shfl_xor(ss, m);
        const float o16 = __shfl_xor(ss, 16);
        if (lane < 32) ss += o16;
        const float rstd = rsqrtf(ss * ((lane < 32) ? (1.f / 512.f) : (1.f / 256.f)) + kEps);
        if (EMU_FP8_WOUT) {
#pragma unroll
            for (int i = 0; i < 16; ++i) v[i] = q8(v[i] * rstd * gn[i], 1.f, 1.f) / (rstd * gn[i]);
        }
        u32x4 w0, w1;
        w0.x = pk2(v[0] * rstd * gn[0], v[1] * rstd * gn[1]); w0.y = pk2(v[2] * rstd * gn[2], v[3] * rstd * gn[3]); w0.z = pk2(v[4] * rstd * gn[4], v[5] * rstd * gn[5]); w0.w = pk2(v[6] * rstd * gn[6], v[7] * rstd * gn[7]);
        w1.x = pk2(v[8] * rstd * gn[8], v[9] * rstd * gn[9]); w1.y = pk2(v[10] * rstd * gn[10], v[11] * rstd * gn[11]); w1.z = pk2(v[12] * rstd * gn[12], v[13] * rstd * gn[13]); w1.w = pk2(v[14] * rstd * gn[14], v[15] * rstd * gn[15]);
        *(u32x4*)(mix + (size_t)row * kD + lane * 16) = w0; *(u32x4*)(mix + (size_t)row * kD + lane * 16 + 8) = w1;
    }
}
DEVI void unpk8s(float* d, const u32x4 q) {
    d[0] = __uint_as_float(q.x << 16); d[1] = __uint_as_float(q.x & 0xFFFF0000u); d[2] = __uint_as_float(q.y << 16); d[3] = __uint_as_float(q.y & 0xFFFF0000u);
    d[4] = __uint_as_float(q.z << 16); d[5] = __uint_as_float(q.z & 0xFFFF0000u); d[6] = __uint_as_float(q.w << 16); d[7] = __uint_as_float(q.w & 0xFFFF0000u);
}
DEVI void phase_combine(bf16_t* xb, float* out32, const bf16_t* y, const int* tokslot, const float* gain_next, bf16_t* h, int bid, int nblk) {
    const int wid = tidx() >> 6, lane = tidx() & 63;
    float g[16];
#pragma unroll
    for (int i = 0; i < 16; ++i) g[i] = gain_next ? gain_next[lane * 16 + i] : 0.f;
    const int stride = nblk * 8;
    int row = bid * 8 + wid;
    u32x4 nv0, nv1; int nts = 0;
    if (row < kTok) { nts = tokslot[(size_t)row * kE + (lane & 15)]; nv0 = *(const u32x4*)(xb + (size_t)row * kD + lane * 16); nv1 = *(const u32x4*)(xb + (size_t)row * kD + lane * 16 + 8); }
    for (; row < kTok; row += stride) {
        const int b = row >> 13;
        const int ts = nts;
        float v[16];
        unpk8s(v, nv0); unpk8s(v + 8, nv1);
        const int nrow = row + stride;
        if (nrow < kTok) { nts = tokslot[(size_t)nrow * kE + (lane & 15)]; nv0 = *(const u32x4*)(xb + (size_t)nrow * kD + lane * 16); nv1 = *(const u32x4*)(xb + (size_t)nrow * kD + lane * 16 + 8); }
#pragma unroll
        for (int e0 = 0; e0 < kE; e0 += 8) {
#if FP8_Y
            u32x4 yv[8];
#pragma unroll
            for (int e = 0; e < 8; ++e) { const int slot = __builtin_amdgcn_readlane(ts, e0 + e);
                if (slot >= 0) yv[e] = *(const u32x4*)((const unsigned char*)y + ((size_t)((e0 + e) * kB + b) * kCap + slot) * kD + lane * 16); }
#pragma unroll
            for (int e = 0; e < 8; ++e) { const int slot = __builtin_amdgcn_readlane(ts, e0 + e);
                if (slot >= 0) { const unsigned ww[4] = {yv[e].x, yv[e].y, yv[e].z, yv[e].w};
#pragma unroll
                    for (int k = 0; k < 4; ++k) { const f32x2 lo = __builtin_amdgcn_cvt_pk_f32_fp8(ww[k], false), hi = __builtin_amdgcn_cvt_pk_f32_fp8(ww[k], true);
                        v[4 * k] += lo.x * (1.f / kY8); v[4 * k + 1] += lo.y * (1.f / kY8); v[4 * k + 2] += hi.x * (1.f / kY8); v[4 * k + 3] += hi.y * (1.f / kY8); } } }
#else
            u32x4 yv[8][2];
#pragma unroll
            for (int e = 0; e < 8; ++e) { const int slot = __builtin_amdgcn_readlane(ts, e0 + e);
                if (slot >= 0) { const bf16_t* yr = y + ((size_t)((e0 + e) * kB + b) * kCap + slot) * kD + lane * 16; yv[e][0] = *(const u32x4*)yr; yv[e][1] = *(const u32x4*)(yr + 8); } }
#pragma unroll
            for (int e = 0; e < 8; ++e) { const int slot = __builtin_amdgcn_readlane(ts, e0 + e);
                if (slot >= 0) { unpk8(v, yv[e][0], 1.f); unpk8(v + 8, yv[e][1], 1.f); } }
#endif
        }
        if (!gain_next) {
#pragma unroll
            for (int k = 0; k < 4; ++k) *(f32x4*)(out32 + (size_t)row * kD + lane * 16 + 4 * k) = (f32x4){v[4 * k], v[4 * k + 1], v[4 * k + 2], v[4 * k + 3]};
        } else {
            u32x4 o0, o1;
            o0.x = pk2(v[0], v[1]); o0.y = pk2(v[2], v[3]); o0.z = pk2(v[4], v[5]); o0.w = pk2(v[6], v[7]); o1.x = pk2(v[8], v[9]); o1.y = pk2(v[10], v[11]); o1.z = pk2(v[12], v[13]); o1.w = pk2(v[14], v[15]);
            *(u32x4*)(xb + (size_t)row * kD + lane * 16) = o0; *(u32x4*)(xb + (size_t)row * kD + lane * 16 + 8) = o1;
            unpk8s(v, o0); unpk8s(v + 8, o1);
            float ss = 0.f;
#pragma unroll
            for (int i = 0; i < 16; ++i) ss += v[i] * v[i];
            ss = wave_sum(ss); const float rstd = rsqrtf(ss * (1.f / kD) + kEps);
            u32x4 h0, h1;
            h0.x = pk2(v[0] * rstd * g[0], v[1] * rstd * g[1]); h0.y = pk2(v[2] * rstd * g[2], v[3] * rstd * g[3]); h0.z = pk2(v[4] * rstd * g[4], v[5] * rstd * g[5]); h0.w = pk2(v[6] * rstd * g[6], v[7] * rstd * g[7]);
            h1.x = pk2(v[8] * rstd * g[8], v[9] * rstd * g[9]); h1.y = pk2(v[10] * rstd * g[10], v[11] * rstd * g[11]); h1.z = pk2(v[12] * rstd * g[12], v[13] * rstd * g[13]); h1.w = pk2(v[14] * rstd * g[14], v[15] * rstd * g[15]);
            *(u32x4*)(h + (size_t)row * kD + lane * 16) = h0; *(u32x4*)(h + (size_t)row * kD + lane * 16 + 8) = h1;
        }
    }
}

DEVI void cpow_m(double a, double w, double dt, int m, float& re, float& im) {
    const float mag = __expf((float)m * (float)a * (float)dt);
    const double turns = (double)m * w * dt * 0.15915494309189535; const float ang = (float)((turns - floor(turns)) * 6.283185307179586);
    re = mag * cosf(ang); im = mag * sinf(ang);
}
DEVI void s5_prep_item(const Params& P, int l, int g, unsigned char* lds_) {
    float* pw = (float*)lds_;
    float* bb = pw + 4352;
    float* cc = bb + 4096;
    float* kt = cc + 4096;
    const int tid = tidx();
    __syncthreads();
    for (int i = tid; i < 128; i += kNT) { const int dir = i >> 6, p = i & 63; const size_t pb = (((size_t)l * 2 + dir) * 16 + g) * 64 + p;
        const double dt = (double)__expf(P.s5_log_dt[((size_t)l * 2 + dir) * 16 + g]); const double a = (double)fminf(P.s5_a_re[pb], -1e-4f), w = (double)P.s5_a_im[pb];
        for (int m = 0; m < 17; ++m) { float re, im; cpow_m(a, w, dt, m, re, im); pw[((dir * 64 + p) * 17 + m) * 2] = re; pw[((dir * 64 + p) * 17 + m) * 2 + 1] = im; }
        const float af = (float)a, wf = (float)w, ar = pw[((dir * 64 + p) * 17 + 1) * 2], ai = pw[((dir * 64 + p) * 17 + 1) * 2 + 1];
        const float den = af * af + wf * wf, zr = ar - 1.f, gr = (zr * af + ai * wf) / den, gi = (ai * af - zr * wf) / den;
        for (int c = 0; c < 16; ++c) { const float br = P.s5_b_re[pb * 16 + c], bi = P.s5_b_im[pb * 16 + c]; bb[((dir * 64 + p) * 16 + c) * 2] = gr * br - gi * bi; bb[((dir * 64 + p) * 16 + c) * 2 + 1] = gr * bi + gi * br; }
    }
    for (int i = tid; i < 2048; i += kNT) { const int dir = i >> 10, c = (i >> 6) & 15, p = i & 63; const size_t o = ((((size_t)l * 2 + dir) * 16 + g) * 16 + c) * 64 + p; cc[i * 2] = P.s5_c_re[o]; cc[i * 2 + 1] = P.s5_c_im[o]; }
    __syncthreads();
    for (int i = tid; i < 8192; i += kNT) { const int dir = i >> 12, m = (i >> 8) & 15, c = (i >> 4) & 15, c2 = i & 15; float acc = 0.f;
        for (int p = 0; p < 64; ++p) { const float cr = cc[((dir * 16 + c) * 64 + p) * 2], ci = cc[((dir * 16 + c) * 64 + p) * 2 + 1], wr_ = pw[((dir * 64 + p) * 17 + m) * 2], wi_ = pw[((dir * 64 + p) * 17 + m) * 2 + 1];
            const float br = bb[((dir * 64 + p) * 16 + c2) * 2], bi = bb[((dir * 64 + p) * 16 + c2) * 2 + 1]; const float tr = cr * wr_ - ci * wi_, ti = cr * wi_ + ci * wr_; acc += tr * br - ti * bi; }
        kt[i] = acc; }
    __syncthreads();
    bf16_t* wst = (bf16_t*)(wsp(P) + WS_WST) + ((size_t)l * 16 + g) * 256 * 256;
    bf16_t* wso = (bf16_t*)(wsp(P) + WS_WSO) + ((size_t)l * 16 + g) * 256 * 512;
    for (int id = tid; id < 8192; id += kNT) { const int n = id >> 5, k0 = (id & 31) * 8, dir = n >> 7, p = (n >> 1) & 63, ri = n & 1; float v[8];
#pragma unroll
        for (int kk = 0; kk < 8; ++kk) { const int k = k0 + kk, t = k >> 4, c = k & 15, e = dir ? t : 15 - t; const float wr_ = pw[((dir * 64 + p) * 17 + e) * 2], wi_ = pw[((dir * 64 + p) * 17 + e) * 2 + 1], br = bb[((dir * 64 + p) * 16 + c) * 2], bi = bb[((dir * 64 + p) * 16 + c) * 2 + 1];
            v[kk] = ri ? (wr_ * bi + wi_ * br) : (wr_ * br - wi_ * bi); }
        u32x4 o; o.x = pk2(v[0], v[1]); o.y = pk2(v[2], v[3]); o.z = pk2(v[4], v[5]); o.w = pk2(v[6], v[7]); *(u32x4*)(wst + (size_t)n * 256 + k0) = o; }
    for (int id = tid; id < 16384; id += kNT) { const int ns = id >> 6, k0 = (id & 63) * 8, n = cmap_pk(ns), t = n >> 4, c = n & 15; float v[8];
#pragma unroll
        for (int kk = 0; kk < 8; ++kk) { const int k = k0 + kk; float x;
            if (k < 256) { const int j = k >> 4, c2 = k & 15; x = 0.f; if (j <= t) x += kt[(t - j) * 256 + c * 16 + c2]; if (j >= t) x += kt[4096 + (j - t) * 256 + c * 16 + c2]; if (j == t && c == c2) x += P.s5_d[l * 256 + g * 16 + c]; }
            else { const int q = k - 256, dir = q >> 7, p = (q >> 1) & 63, ri = q & 1, e = dir ? 16 - t : t + 1; const float cr = cc[((dir * 16 + c) * 64 + p) * 2], ci = cc[((dir * 16 + c) * 64 + p) * 2 + 1], wr_ = pw[((dir * 64 + p) * 17 + e) * 2], wi_ = pw[((dir * 64 + p) * 17 + e) * 2 + 1];
                x = ri ? -(cr * wi_ + ci * wr_) : (cr * wr_ - ci * wi_); }
            v[kk] = x; }
        u32x4 o; o.x = pk2(v[0], v[1]); o.y = pk2(v[2], v[3]); o.z = pk2(v[4], v[5]); o.w = pk2(v[6], v[7]); *(u32x4*)(wso + (size_t)ns * 512 + k0) = o; }
    __syncthreads();
}
DEVI void phase_s5_scan(const Params& P, int l, const float* Z, bf16_t* ux, unsigned char* lds_, int bid, int nblk) {
    const int tid = tidx(), wid = tid >> 6, lane = tid & 63;
    float* E = (float*)lds_;
    for (int item = bid; item < 256; item += nblk) {
        const int dir = item & 1, g = (item >> 1) & 15, b = item >> 5;
        const size_t pb = (((size_t)l * 2 + dir) * 16 + g) * 64 + lane;
        const double dt = (double)__expf(P.s5_log_dt[((size_t)l * 2 + dir) * 16 + g]); const double a = (double)fminf(P.s5_a_re[pb], -1e-4f), w = (double)P.s5_a_im[pb];
        float a16r, a16i, Ar, Ai; cpow_m(a, w, dt, 16, a16r, a16i); cpow_m(a, w, dt, 1024, Ar, Ai);
        const int kk0 = dir ? 511 - 64 * wid : 64 * wid; const long sstep = dir ? -1 : 1;
        const float* zp = Z + ((size_t)g * 4096 + b * 512 + kk0) * 256 + dir * 128 + 2 * lane;
        f32x2 z[64];
#pragma unroll
        for (int i = 0; i < 64; ++i) { z[i] = *(const f32x2*)zp; zp += sstep * 256; }
        float xr = 0.f, xi = 0.f;
#pragma unroll
        for (int i = 0; i < 64; ++i) { const float nr = a16r * xr - a16i * xi + z[i].x, ni = a16r * xi + a16i * xr + z[i].y; xr = nr; xi = ni; }
        __syncthreads();
        E[(wid * 64 + lane) * 2] = xr; E[(wid * 64 + lane) * 2 + 1] = xi;
        __syncthreads();
        float sr = 0.f, si = 0.f;
#pragma unroll
        for (int s2 = 0; s2 < 7; ++s2) if (s2 < wid) { const float er = E[(s2 * 64 + lane) * 2], ei = E[(s2 * 64 + lane) * 2 + 1]; const float nr = Ar * sr - Ai * si + er, ni = Ar * si + Ai * sr + ei; sr = nr; si = ni; }
        bf16_t* up = ux + ((size_t)g * 4096 + b * 512 + kk0) * 512 + 256 + dir * 128 + 2 * lane;
#pragma unroll
        for (int i = 0; i < 64; ++i) { *(unsigned*)up = pk2(sr, si); up += sstep * 512;
            const float nr = a16r * sr - a16i * si + z[i].x, ni = a16r * si + a16i * sr + z[i].y; sr = nr; si = ni; }
    }
    __syncthreads();
}
struct EpiF32N {
    static constexpr int VMOPS = 32;
    float* z; int ldz;
    DEVI void operator()(const f32x4 (&acc)[2][2][4][2], const Unit& u, int wr, int wc, int fr, int fq) const {
#pragma unroll
        for (int ai = 0; ai < 2; ++ai)
#pragma unroll
            for (int m = 0; m < 4; ++m) { const size_t ro = (size_t)(u.pm * 256 + 128 * ai + 64 * wr + 16 * m + fr) * ldz + u.pn * 256 + 32 * wc + 4 * fq;
#pragma unroll
                for (int bj = 0; bj < 2; ++bj)
#pragma unroll
                    for (int n = 0; n < 2; ++n) *(f32x4*)(z + ro + 128 * bj + 16 * n) = acc[ai][bj][m][n]; }
    }
};
struct EpiS5Out {
    static constexpr int VMOPS = 16;
    bf16_t* G;
    DEVI void operator()(const f32x4 (&acc)[2][2][4][2], const Unit& u, int wr, int wc, int fr, int fq) const {
#pragma unroll
        for (int ai = 0; ai < 2; ++ai)
#pragma unroll
            for (int m = 0; m < 4; ++m) { const int R = u.pm * 256 + 128 * ai + 64 * wr + 16 * m + fr, g = R >> 12, ck = R & 4095;
#pragma unroll
                for (int bj = 0; bj < 2; ++bj) { const int t = 8 * bj + 2 * wc + (fq >> 1), c0 = 8 * (fq & 1);
                    const f32x4 v0 = acc[ai][bj][m][0], v1 = acc[ai][bj][m][1];
                    u32x4 w; w.x = pk2(gelu_tanh(v0.x), gelu_tanh(v0.y)); w.y = pk2(gelu_tanh(v0.z), gelu_tanh(v0.w)); w.z = pk2(gelu_tanh(v1.x), gelu_tanh(v1.y)); w.w = pk2(gelu_tanh(v1.z), gelu_tanh(v1.w));
                    *(u32x4*)(G + ((size_t)ck * 16 + t) * 256 + g * 16 + c0) = w; } }
    }
};
#define XB_TMO      128
#define XB_XCNT(j)  (256  + 64 * (j))
#define XB_XSUB(j)  (1280 + 64 * (j))
#define XB_XGEN(j)  (2304 + 64 * (j))
#define XB_TOP      3328
#define XB_TOPGEN   3392
#define XCD_BAR_WORDS 3456
#define XB_SPIN_CAP (1u << 26)
DEVI unsigned xb_ld(unsigned* p)              { return __hip_atomic_load(p, __ATOMIC_RELAXED, __HIP_MEMORY_SCOPE_AGENT); }
DEVI unsigned xb_add(unsigned* p, unsigned v) { return __hip_atomic_fetch_add(p, v, __ATOMIC_RELAXED, __HIP_MEMORY_SCOPE_AGENT); }
DEVI unsigned xb_xcc_id() { return (unsigned)__builtin_amdgcn_s_getreg((3 << 11) | 20) & 0xFu; }
#define XB_SPIN(cond, bar) do { unsigned _sp = 0; while (cond) { __builtin_amdgcn_s_sleep(1); \
    if ((++_sp & 255u) == 0u) { if (xb_ld(&(bar)[XB_TMO])) break; if (_sp > XB_SPIN_CAP) { atomicAdd(&(bar)[XB_TMO], 1u); break; } } } } while (0)
struct XcdBarrier { unsigned* bar; unsigned x; volatile LAS unsigned* st; };
DEVI XcdBarrier xcd_barrier_post(unsigned* bar, volatile LAS unsigned* st) {
    XcdBarrier b; b.bar = bar; b.x = xb_xcc_id(); b.st = st;
    if (threadIdx.x == 0) (void)xb_add(&bar[XB_XCNT(b.x)], 1u);
    return b;
}
DEVI void xcd_barrier_complete(unsigned* bar, unsigned x, unsigned& nloc, unsigned& nx) {
    const unsigned G = gridDim.x * gridDim.y * gridDim.z;
    unsigned sum, cnt, mine, sp = 0u;
    for (;;) {
        sum = 0u; cnt = 0u; mine = 0u;
#pragma unroll
        for (unsigned j = 0; j < 16; ++j) { const unsigned c = xb_ld(&bar[XB_XCNT(j)]); sum += c; cnt += (c > 0u) ? 1u : 0u; mine = (j == x) ? c : mine; }
        if (sum == G) break;
        __builtin_amdgcn_s_sleep(1);
        if ((++sp & 255u) == 0u) { if (xb_ld(&bar[XB_TMO])) break; if (sp > XB_SPIN_CAP) { atomicAdd(&bar[XB_TMO], 1u); break; } }
    }
    nloc = mine > 0u ? mine : 1u; nx = cnt > 0u ? cnt : 1u;
}
DEVI void xcd_barrier(const XcdBarrier& b) {
    asm volatile("s_waitcnt vmcnt(0)" ::: "memory");
    __syncthreads();
    if (threadIdx.x == 0) {
        unsigned long long bp_ = (unsigned long long)b.bar; asm volatile("" : "+s"(bp_));
        unsigned* bar = (unsigned*)bp_;
        const unsigned bx = xb_xcc_id();
        __builtin_amdgcn_s_waitcnt(0);
        unsigned nloc = b.st[0], nx = b.st[1];
        if (nloc == 0u) { xcd_barrier_complete(bar, bx, nloc, nx); b.st[0] = nloc; b.st[1] = nx; }
        const unsigned old = xb_add(&bar[XB_XSUB(bx)], 1u);
        const unsigned gen = old / nloc;
        if (old + 1u == (gen + 1u) * nloc) {
            __builtin_amdgcn_fence(__ATOMIC_RELEASE, "agent");
            asm volatile("s_waitcnt vmcnt(0)" ::: "memory");
            const unsigned og = xb_add(&bar[XB_TOP], 1u);
            const unsigned tg = og / nx;
            if (og + 1u == (tg + 1u) * nx) xb_add(&bar[XB_TOPGEN], 1u);
            else XB_SPIN(xb_ld(&bar[XB_TOPGEN]) == tg, bar);
            __builtin_amdgcn_fence(__ATOMIC_ACQUIRE, "agent");
            xb_add(&bar[XB_XGEN(bx)], 1u);
            asm volatile("s_waitcnt vmcnt(0)" ::: "memory");
        } else {
            XB_SPIN(xb_ld(&bar[XB_XGEN(bx)]) == gen, bar);
            __builtin_amdgcn_fence(__ATOMIC_ACQUIRE, "agent");
            asm volatile("s_waitcnt vmcnt(0)" ::: "memory");
        }
    }
    __syncthreads();
}

#ifndef MEGA
#define MEGA 1
#endif
#ifndef USE_ENGINE
#define USE_ENGINE 1
#endif
constexpr int LDS_BYTES = 147456 + 8192 + 16;
#if USE_ENGINE
#define GEMM_RUN(g, E) gemm_engine<decltype(E), true, true>((LAS unsigned char*)dyn_lds, g, E, bid, nblk)
#define GEMM_RUN8(g, E) gemm_engine<decltype(E), true, true, true>((LAS unsigned char*)dyn_lds, g, E, bid, nblk)
#else
#define GEMM_RUN(g, E) gemm_simple(g, E, bid, nblk)
#endif
extern __shared__ __attribute__((aligned(16))) unsigned char dyn_lds[];

DEVI GemmD mk_gemm(const bf16_t* A, const bf16_t* Bt, int lda, int K, int nM, int nN, const int* rowidx, size_t bstride, int pmg) {
    GemmD g; g.A = A; g.Bt = Bt; g.lda = lda; g.K = K; g.nM = nM; g.nN = nN; g.rowidx = rowidx; g.bstride = bstride; g.pmg = pmg; return g; }

DEVI void ph_win(const Params& P, int l, int bid, int nblk) {
    const GemmD g = mk_gemm((const bf16_t*)(wsp(P) + WS_H), (const bf16_t*)(wsp(P) + WS_WINT) + (size_t)l * kINW * kD, kD, kD, kTok / 256, 10, nullptr, 0, 1 << 30);
    unsigned char* r1 = wsp(P) + WS_R1;
    EpiQKV E; E.qa = (bf16_t*)(r1 + R1_QA); E.ka = (bf16_t*)(r1 + R1_KA); E.va = (bf16_t*)(r1 + R1_VA); E.qb = (bf16_t*)(r1 + R1_QB); E.kb = (bf16_t*)(r1 + R1_KB); E.vb = (bf16_t*)(r1 + R1_VB); E.ux = (bf16_t*)(r1 + R1_UX);
    E.qna = P.q_norm_a + l * 64; E.kna = P.k_norm_a + l * 64; E.qnb = P.q_norm_b + l * 64; E.knb = P.k_norm_b + l * 64;
    GEMM_RUN(g, E);
}
#ifndef USE_MFMA_ATTN
#define USE_MFMA_ATTN 1
#endif
#ifndef USE_S5_GEMM
#define USE_S5_GEMM 1
#endif
#ifndef PROBE_ATTN
#define PROBE_ATTN 1
#endif
#ifndef PROBE_GU
#define PROBE_GU 1
#endif
#ifndef PROBE_DOWN
#define PROBE_DOWN 1
#endif
#ifndef PROBE_NA
#define PROBE_NA 1
#endif
#ifndef PROBE_MIX
#define PROBE_MIX 1
#endif
#ifndef PROBE_RT
#define PROBE_RT 1
#endif
#ifndef PROBE_TK
#define PROBE_TK 1
#endif
#ifndef PROBE_GUDRY
#define PROBE_GUDRY 0
#endif
#ifndef PROBE_DILVAR
#define PROBE_DILVAR 0
#endif
#ifndef PROBE_CONV
#define PROBE_CONV 1
#endif
DEVI void ph_dilated(const Params& P, int l, int bid, int nblk) { unsigned char* r1 = wsp(P) + WS_R1;
#if PROBE_DILVAR
    phase_dilated<PROBE_DILVAR>((const bf16_t*)(r1 + R1_QA), (const bf16_t*)(r1 + R1_KA), (const bf16_t*)(r1 + R1_VA), P.q_norm_a + l * 64, P.k_norm_a + l * 64, (bf16_t*)(wsp(P) + WS_R2), (float*)(wsp(P) + WS_LSE), (LAS unsigned char*)dyn_lds, bid, nblk);
#endif
#if USE_MFMA_ATTN
    phase_dilated((const bf16_t*)(r1 + R1_QA), (const bf16_t*)(r1 + R1_KA), (const bf16_t*)(r1 + R1_VA), P.q_norm_a + l * 64, P.k_norm_a + l * 64, (bf16_t*)(wsp(P) + WS_R2), (float*)(wsp(P) + WS_LSE), (LAS unsigned char*)dyn_lds, bid, nblk);
#else
    phase_dilated_naive((const bf16_t*)(r1 + R1_QA), (const bf16_t*)(r1 + R1_KA), (const bf16_t*)(r1 + R1_VA), (bf16_t*)(wsp(P) + WS_R2), (float*)(wsp(P) + WS_LSE), bid, nblk);
#endif
}
DEVI void ph_na(const Params& P, int l, int bid, int nblk) { unsigned char* r1 = wsp(P) + WS_R1;
#if USE_MFMA_ATTN
    phase_na((const bf16_t*)(r1 + R1_QB), (const bf16_t*)(r1 + R1_KB), (const bf16_t*)(r1 + R1_VB), P.rpb + (size_t)l * 4 * 15 * 31, (bf16_t*)(r1 + R1_OB), (LAS unsigned char*)dyn_lds, bid, nblk);
#else
    phase_na_naive((const bf16_t*)(r1 + R1_QB), (const bf16_t*)(r1 + R1_KB), (const bf16_t*)(r1 + R1_VB), P.rpb + (size_t)l * 4 * 15 * 31, (bf16_t*)(r1 + R1_OB), bid, nblk);
#endif
}
DEVI void ph_s5(const Params& P, int l, unsigned char* lds, int bid, int nblk) { phase_s5_naive(P, l, (const bf16_t*)(wsp(P) + WS_R1 + R1_UX), (float*)(wsp(P) + WS_YS), lds, bid, nblk); }
DEVI void ph_s5_prep(const Params& P, unsigned char* lds, int bid, int nblk) { for (int it = bid; it < kL * 16; it += nblk) s5_prep_item(P, it >> 4, it & 15, lds); }
DEVI void ph_s5_state(const Params& P, int l, int bid, int nblk) {
    const GemmD g = mk_gemm((const bf16_t*)(wsp(P) + WS_R1 + R1_UX), (const bf16_t*)(wsp(P) + WS_WST) + (size_t)l * 16 * 256 * 256, 512, 256, 256, 1, nullptr, (size_t)256 * 256, 16);
    EpiF32N E; E.z = (float*)(wsp(P) + WS_R2 + R2_Z); E.ldz = 256;
    GEMM_RUN(g, E);
}
DEVI void ph_s5_scan(const Params& P, int l, unsigned char* lds, int bid, int nblk) { phase_s5_scan(P, l, (const float*)(wsp(P) + WS_R2 + R2_Z), (bf16_t*)(wsp(P) + WS_R1 + R1_UX), lds, bid, nblk); }
DEVI void ph_s5_out(const Params& P, int l, int bid, int nblk) {
    const GemmD g = mk_gemm((const bf16_t*)(wsp(P) + WS_R1 + R1_UX), (const bf16_t*)(wsp(P) + WS_WSO) + (size_t)l * 16 * 256 * 512, 512, 512, 256, 1, nullptr, (size_t)256 * 512, 16);
    EpiS5Out E; E.G = (bf16_t*)(wsp(P) + WS_R1 + R1_G);
    GEMM_RUN(g, E);
}
DEVI void ph_s5fin(const Params& P, int l, int bid, int nblk) { phase_s5_finish((const float*)(wsp(P) + WS_YS), (const bf16_t*)(wsp(P) + WS_R1 + R1_UX), P.s5_d + l * 256, (bf16_t*)(wsp(P) + WS_R1 + R1_G), bid, nblk); }
DEVI void ph_glu(const Params& P, int l, int bid, int nblk) {
    const GemmD g = mk_gemm((const bf16_t*)(wsp(P) + WS_R1 + R1_G), (const bf16_t*)(wsp(P) + WS_WGLUT) + (size_t)l * 256 * 256, 256, 256, kTok / 256, 1, nullptr, 0, 1 << 30);
    EpiGlu E; E.g = (const bf16_t*)(wsp(P) + WS_R1 + R1_G); E.oc = (bf16_t*)(wsp(P) + WS_R1 + R1_OC);
    GEMM_RUN(g, E);
}
DEVI void ph_mixnorm(const Params& P, int l, int bid, int nblk) { unsigned char* r1 = wsp(P) + WS_R1;
    phase_mixnorm((const bf16_t*)(wsp(P) + WS_R2), (const float*)(wsp(P) + WS_LSE), (const bf16_t*)(r1 + R1_OB), (const bf16_t*)(r1 + R1_OC), P.out_norm_a + l * 512, P.out_norm_b + l * 256, P.out_norm_c + l * 256, (bf16_t*)(wsp(P) + WS_H), bid, nblk); }
DEVI void ph_wout(const Params& P, int l, int bid, int nblk) {
    const GemmD g = mk_gemm((const bf16_t*)(wsp(P) + WS_H), (const bf16_t*)(wsp(P) + WS_WOUTT) + (size_t)l * kD * kD, kD, kD, kTok / 256, 4, nullptr, 0, 1 << 30);
    EpiResid E; E.x32 = (l == 0) ? P.x : nullptr; E.xb = (bf16_t*)(wsp(P) + WS_XB);
    GEMM_RUN(g, E);
}
DEVI void ph_router(const Params& P, int l, unsigned char* lds, int bid, int nblk) { phase_router((const bf16_t*)(wsp(P) + WS_XB), P.ffn_norm + (size_t)l * kD, P.w_router + (size_t)l * kD * kE, (bf16_t*)(wsp(P) + WS_H), (float*)(wsp(P) + WS_AFF), lds, bid, nblk); }
DEVI void ph_topk(const Params& P, unsigned char* lds, int bid, int nblk) { phase_topk((const float*)(wsp(P) + WS_AFF), (int*)(wsp(P) + WS_IDX), (float*)(wsp(P) + WS_GATE), (int*)(wsp(P) + WS_TSLOT), wsp(P) + WS_H, wsp(P) + WS_R2, FP8_GU ? kD : kD * 2, lds, bid, nblk); }
DEVI void ph_gu(const Params& P, int l, int bid, int nblk) {
#if FP8_GU
    const GemmD g = mk_gemm((const bf16_t*)(wsp(P) + WS_R2), (const bf16_t*)(wsp(P) + WS_WGUT + (size_t)l * kE * 4096 * kD), kD, kD, 512, 16, nullptr, (size_t)4096 * kD, 32);
    EpiGU E; E.hid = (bf16_t*)(wsp(P) + WS_R1); E.sc = 1.f / kW8; E.nomath = false;
    GEMM_RUN8(g, E);
#else
    const GemmD g = mk_gemm((const bf16_t*)(wsp(P) + WS_R2), (const bf16_t*)(wsp(P) + WS_WGUT) + (size_t)l * kE * 4096 * kD, kD, kD, 512, 16, nullptr, (size_t)4096 * kD, 32);
    EpiGU E; E.hid = (bf16_t*)(wsp(P) + WS_R1); E.sc = 1.f; E.nomath = false;
    GEMM_RUN(g, E);
#endif
}
DEVI void ph_gu_dry(const Params& P, int l, int bid, int nblk) {
    const GemmD g = mk_gemm((const bf16_t*)(wsp(P) + WS_R2), (const bf16_t*)(wsp(P) + WS_WGUT + (size_t)l * kE * 4096 * kD), kD, kD, 512, 16, nullptr, (size_t)4096 * kD, 32);
#if PROBE_GUDRY == 2
    EpiGU E; E.hid = (bf16_t*)(wsp(P) + WS_R1); E.sc = 1.f / kW8; E.nomath = true;
#else
    EpiDry E; E.sink = (float*)(wsp(P) + WS_LSE);
#endif
    GEMM_RUN8(g, E);
}
DEVI void ph_down(const Params& P, int l, int bid, int nblk) {
#if FP8_DN
    const GemmD g = mk_gemm((const bf16_t*)(wsp(P) + WS_R1), (const bf16_t*)(wsp(P) + WS_WDT + (size_t)l * kE * kD * kFF), kFF, kFF, 512, 4, nullptr, (size_t)kD * kFF, 32);
    EpiDown E; E.y = (bf16_t*)(wsp(P) + WS_R2); E.gate = (const float*)(wsp(P) + WS_GATE); E.sc = 1.f / (kW8 * kH8);
    GEMM_RUN8(g, E);
#else
    const GemmD g = mk_gemm((const bf16_t*)(wsp(P) + WS_R1), (const bf16_t*)(wsp(P) + WS_WDT) + (size_t)l * kE * kD * kFF, kFF, kFF, 512, 4, nullptr, (size_t)kD * kFF, 32);
    EpiDown E; E.y = (bf16_t*)(wsp(P) + WS_R2); E.gate = (const float*)(wsp(P) + WS_GATE); E.sc = 1.f;
    GEMM_RUN(g, E);
#endif
}
DEVI void ph_combine(const Params& P, int l, int bid, int nblk) { phase_combine((bf16_t*)(wsp(P) + WS_XB), P.out, (const bf16_t*)(wsp(P) + WS_R2), (const int*)(wsp(P) + WS_TSLOT), (l + 1 < kL) ? P.attn_norm + (size_t)(l + 1) * kD : nullptr, (bf16_t*)(wsp(P) + WS_H), bid, nblk); }

typedef __attribute__((address_space(4))) const Params* CParams;
DEVI CParams kargs() { unsigned long long a = (unsigned long long)__builtin_amdgcn_kernarg_segment_ptr(); asm volatile("" : "+s"(a)); return (CParams)a; }
#if MEGA
__global__ void __launch_bounds__(kNT, 2) mega_fwd(Params P_) {
#define PK P_
    volatile LAS unsigned* st = (volatile LAS unsigned*)(dyn_lds + LDS_BYTES - 16);
    if (threadIdx.x == 0) { st[0] = 0u; st[1] = 0u; st[2] = 0u; st[3] = 0u; }
    __syncthreads();
    const XcdBarrier bar = xcd_barrier_post((unsigned*)(PK.ws + WS_CTL), st);
    const int bid = blockIdx.x, nblk = gridDim.x;
    unsigned char* lds = dyn_lds;
#pragma unroll 1
    for (int rep = 0; rep < PROBE_CONV; ++rep)
    phase_convert(PK, lds, lnd(bid), nblk);
#if USE_S5_GEMM
    ph_s5_prep(PK, lds, lnd(bid), nblk);
#endif
    phase_norm(PK.x, PK.attn_norm, (bf16_t*)(PK.ws + WS_H), lnd(bid), nblk);
    xcd_barrier(bar);
#pragma unroll 1
    for (int l = 0; l < kL; ++l) {
        ph_win(PK, l, lnd(bid), nblk);            xcd_barrier(bar);
#if USE_S5_GEMM
        ph_s5_state(PK, l, lnd(bid), nblk);       xcd_barrier(bar);
        ph_s5_scan(PK, l, lds, lnd(bid), nblk);
#pragma unroll 1
        for (int rep = 0; rep < PROBE_ATTN; ++rep)
        ph_dilated(PK, l, lnd(bid), nblk);
#pragma unroll 1
        for (int rep = 0; rep < PROBE_NA; ++rep)
        ph_na(PK, l, lnd(bid), nblk);             xcd_barrier(bar);
        ph_s5_out(PK, l, lnd(bid), nblk);         xcd_barrier(bar);
#else
        ph_s5(PK, l, lds, lnd(bid), nblk);
        ph_dilated(PK, l, lnd(bid), nblk);
        ph_na(PK, l, lnd(bid), nblk);             xcd_barrier(bar);
        ph_s5fin(PK, l, lnd(bid), nblk);          xcd_barrier(bar);
#endif
        ph_glu(PK, l, lnd(bid), nblk);            xcd_barrier(bar);
#pragma unroll 1
        for (int rep = 0; rep < PROBE_MIX; ++rep) {
        ph_mixnorm(PK, l, lnd(bid), nblk);        xcd_barrier(bar); }
        ph_wout(PK, l, lnd(bid), nblk);           xcd_barrier(bar);
#pragma unroll 1
        for (int rep = 0; rep < PROBE_RT; ++rep) {
        ph_router(PK, l, lds, lnd(bid), nblk);    xcd_barrier(bar); }
#pragma unroll 1
        for (int rep = 0; rep < PROBE_TK; ++rep) {
        ph_topk(PK, lds, lnd(bid), nblk);         xcd_barrier(bar); }
#if PROBE_GUDRY
        ph_gu_dry(PK, l, lnd(bid), nblk);         xcd_barrier(bar);
#endif
#pragma unroll 1
        for (int rep = 0; rep < PROBE_GU; ++rep) {
        ph_gu(PK, l, lnd(bid), nblk);             xcd_barrier(bar); }
#pragma unroll 1
        for (int rep = 0; rep < PROBE_DOWN; ++rep) {
        ph_down(PK, l, lnd(bid), nblk);           xcd_barrier(bar); }
        ph_combine(PK, l, lnd(bid), nblk);        xcd_barrier(bar);
    }
#undef PK
}
#else
#define KB __global__ void __launch_bounds__(kNT, 2)
KB k_convert(Params P) { phase_convert(P, dyn_lds, blockIdx.x, gridDim.x); }
KB k_norm(Params P) { phase_norm(P.x, P.attn_norm, (bf16_t*)(P.ws + WS_H), blockIdx.x, gridDim.x); }
KB k_win(Params P, int l) { ph_win(P, l, blockIdx.x, gridDim.x); }
KB k_dilated(Params P, int l) { ph_dilated(P, l, blockIdx.x, gridDim.x); }
KB k_na(Params P, int l) { ph_na(P, l, blockIdx.x, gridDim.x); }
KB k_s5(Params P, int l) { ph_s5(P, l, dyn_lds, blockIdx.x, gridDim.x); }
KB k_s5fin(Params P, int l) { ph_s5fin(P, l, blockIdx.x, gridDim.x); }
KB k_glu(Params P, int l) { ph_glu(P, l, blockIdx.x, gridDim.x); }
KB k_mixnorm(Params P, int l) { ph_mixnorm(P, l, blockIdx.x, gridDim.x); }
KB k_wout(Params P, int l) { ph_wout(P, l, blockIdx.x, gridDim.x); }
KB k_router(Params P, int l) { ph_router(P, l, dyn_lds, blockIdx.x, gridDim.x); }
KB k_topk(Params P) { ph_topk(P, dyn_lds, blockIdx.x, gridDim.x); }
KB k_gu(Params P, int l) { ph_gu(P, l, blockIdx.x, gridDim.x); }
KB k_down(Params P, int l) { ph_down(P, l, blockIdx.x, gridDim.x); }
KB k_combine(Params P, int l) { ph_combine(P, l, blockIdx.x, gridDim.x); }
#endif

extern "C" void kernel_launch(void* const* d_in, const int* in_sizes, int n_in, void* d_out, int out_size, void* d_ws, size_t ws_size, hipStream_t stream) {
    (void)in_sizes; (void)n_in; (void)out_size;
    if (ws_size < WS_END) { fprintf(stderr, "workspace too small: %zu < %zu\n", ws_size, (size_t)WS_END); return; }
    Params P{};
    const float** pp = (const float**)&P;
    for (int i = 0; i < 26; ++i) pp[i] = (const float*)d_in[i];
    P.out = (float*)d_out; P.ws = (unsigned char*)d_ws;
#if MEGA
    static int grid = 0;
    if (!grid) {
        int dev = 0, cus = 0, per_cu = 0;
        (void)hipGetDevice(&dev);
        (void)hipDeviceGetAttribute(&cus, hipDeviceAttributeMultiprocessorCount, dev);
        (void)hipFuncSetAttribute((const void*)mega_fwd, hipFuncAttributeMaxDynamicSharedMemorySize, LDS_BYTES);
        (void)hipOccupancyMaxActiveBlocksPerMultiprocessor(&per_cu, (const void*)mega_fwd, kNT, LDS_BYTES);
        grid = (per_cu >= 1) ? cus : 0;
        if (!grid) fprintf(stderr, "mega_fwd does not fit a CU\n");
    }
    if (!grid) return;
    (void)hipMemsetAsync(P.ws + WS_CTL, 0, XCD_BAR_WORDS * sizeof(unsigned), stream);
    mega_fwd<<<grid, kNT, LDS_BYTES, stream>>>(P);
#else
    (void)hipFuncSetAttribute((const void*)k_router, hipFuncAttributeMaxDynamicSharedMemorySize, 65536);
    const int G = 1024;
    k_convert<<<G, kNT, 256 * 72 * 2, stream>>>(P);
    k_norm<<<G, kNT, 0, stream>>>(P);
    for (int l = 0; l < kL; ++l) {
        k_win<<<G, kNT, 0, stream>>>(P, l);
        k_dilated<<<G, kNT, 0, stream>>>(P, l);
        k_na<<<G, kNT, 0, stream>>>(P, l);
        k_s5<<<256, kNT, 8 * 128 * 4, stream>>>(P, l);
        k_s5fin<<<G, kNT, 0, stream>>>(P, l);
        k_glu<<<256, kNT, 0, stream>>>(P, l);
        k_mixnorm<<<G, kNT, 0, stream>>>(P, l);
        k_wout<<<G, kNT, 0, stream>>>(P, l);
        k_router<<<512, kNT, 65536, stream>>>(P, l);
        k_topk<<<128, kNT, 4096, stream>>>(P);
        k_gu<<<G, kNT, 0, stream>>>(P, l);
        k_down<<<G, kNT, 0, stream>>>(P, l);
        k_combine<<<G, kNT, 0, stream>>>(P, l);
    }
#endif
}
```

```cpp
#include <hip/hip_runtime.h>
#include <stdint.h>
#include <stdio.h>

#define DEVI __device__ __forceinline__
#define LAS __attribute__((address_space(3)))
typedef unsigned short bf16_t;
typedef short bf16x8 __attribute__((ext_vector_type(8)));
typedef float f32x4 __attribute__((ext_vector_type(4)));
typedef float f32x2 __attribute__((ext_vector_type(2)));
typedef unsigned u32x4 __attribute__((ext_vector_type(4)));
typedef unsigned u32x2 __attribute__((ext_vector_type(2)));

constexpr int kB = 8, kS = 8192, kD = 1024, kL = 4, kTok = kB * kS;
constexpr int kINW = 2560;
constexpr int kE = 16, kCap = 1024, kFF = 2048;
constexpr int kNT = 512;
constexpr float kEps = 1e-6f;
constexpr float kLog2e = 1.4426950408889634f, kLn2 = 0.6931471805599453f;

constexpr size_t MiB = 1024ull * 1024ull;
constexpr size_t WS_CTL   = 0;
constexpr size_t WS_WINT  = 1 * MiB;
constexpr size_t WS_WOUTT = WS_WINT + 20 * MiB;
constexpr size_t WS_WGLUT = WS_WOUTT + 8 * MiB;
constexpr size_t WS_WGUT  = WS_WGLUT + 1 * MiB;
constexpr size_t WS_WDT   = WS_WGUT + 512 * MiB;
constexpr size_t WS_H     = WS_WDT + 256 * MiB;
constexpr size_t WS_R1    = WS_H + 128 * MiB;
constexpr size_t WS_R2    = WS_R1 + 512 * MiB;
constexpr size_t WS_AFF   = WS_R2 + 256 * MiB;
constexpr size_t WS_IDX   = WS_AFF + 4 * MiB;
constexpr size_t WS_GATE  = WS_IDX + 1 * MiB;
constexpr size_t WS_TSLOT = WS_GATE + 1 * MiB;
constexpr size_t WS_LSE   = WS_TSLOT + 4 * MiB;
constexpr size_t WS_WST   = WS_LSE + 8 * MiB;
constexpr size_t WS_WSO   = WS_WST + 8 * MiB;
constexpr size_t WS_YS    = WS_WSO + 16 * MiB;
constexpr size_t WS_XB    = WS_YS;
constexpr size_t WS_END   = WS_YS + 128 * MiB;
constexpr size_t R2_Z     = 192 * MiB;
constexpr size_t R1_QA = 0, R1_KA = 64 * MiB, R1_VA = 128 * MiB, R1_QB = 192 * MiB, R1_KB = 224 * MiB, R1_VB = 256 * MiB,
                 R1_UX = 288 * MiB, R1_OB = 352 * MiB, R1_OC = 384 * MiB, R1_G = 416 * MiB;

struct Params {
    const float* x; const float* attn_norm; const float* w_in; const float* q_norm_a; const float* k_norm_a; const float* q_norm_b; const float* k_norm_b;
    const float* rpb; const float* s5_a_re; const float* s5_a_im; const float* s5_log_dt; const float* s5_b_re; const float* s5_b_im; const float* s5_c_re; const float* s5_c_im;
    const float* s5_d; const float* w_glu; const float* out_norm_a; const float* out_norm_b; const float* out_norm_c; const float* w_out; const float* ffn_norm;
    const float* w_router; const float* w_gate; const float* w_up; const float* w_down;
    float* out; unsigned char* ws;
};

DEVI float bf2f(bf16_t b) { return __uint_as_float(((unsigned)b) << 16); }
DEVI bf16_t f2bf(float f) { unsigned u = __float_as_uint(f); u += 0x7FFFu + ((u >> 16) & 1u); return (bf16_t)(u >> 16); }
typedef __bf16 bf16x2_t __attribute__((ext_vector_type(2)));
DEVI unsigned pk2(float lo, float hi) { const f32x2 v = {lo, hi}; return __builtin_bit_cast(unsigned, __builtin_convertvector(v, bf16x2_t)); }
DEVI int tidx() { int t = threadIdx.x; asm volatile("" : "+v"(t)); return t; }
#define GAS __attribute__((address_space(1)))
DEVI unsigned char* wsp(const Params& P) { unsigned long long a = (unsigned long long)P.ws; asm volatile("" : "+s"(a)); return (unsigned char*)(GAS unsigned char*)a; }
DEVI int lnd(int v) { asm volatile("" : "+s"(v)); return v; }
DEVI float wave_sum(float v) {
#pragma unroll
    for (int m = 32; m >= 1; m >>= 1) v += __shfl_xor(v, m);
    return v;
}
DEVI float frcp(float x) { return __builtin_amdgcn_rcpf(x); }
DEVI float gelu_tanh(float y) { const float z = 0.7978845608028654f * (y + 0.044715f * y * y * y); const float t = 1.f - 2.f * frcp(1.f + __expf(2.f * z)); return 0.5f * y * (1.f + t); }

#ifndef EMU_BF16_X
#define EMU_BF16_X 0
#endif
#ifndef EMU_FP8_WIN
#define EMU_FP8_WIN 0
#endif
#ifndef EMU_FP8_WOUT
#define EMU_FP8_WOUT 0
#endif
#ifndef EMU_FP8_GU
#define EMU_FP8_GU 0
#endif
#ifndef EMU_FP8_DN
#define EMU_FP8_DN 0
#endif
DEVI float q8(float x, float sc, float inv) {
    float y = x * sc; const float ay = fabsf(y);
    if (ay < 0.015625f) y = rintf(y * 512.f) * (1.f / 512.f);
    else { unsigned u = __float_as_uint(y); u += 0x7FFFFu + ((u >> 20) & 1u); u &= 0xFFF00000u; y = __uint_as_float(u); y = fminf(fmaxf(y, -448.f), 448.f); }
    return y * inv;
}
#ifndef FP8_GU
#define FP8_GU 1
#endif
#ifndef FP8_DN
#define FP8_DN 1
#endif
#ifndef FP8_Y
#define FP8_Y 1
#endif
constexpr float kY8 = 64.f;
constexpr float kW8 = 64.f, kH8 = 8.f;
DEVI unsigned pk4_fp8(float a, float b, float c, float d) { unsigned w = 0u; w = __builtin_amdgcn_cvt_pk_fp8_f32(a, b, w, false); w = __builtin_amdgcn_cvt_pk_fp8_f32(c, d, w, true); return w; }
DEVI int cmap_head(int cs) { const int bj = cs >> 7, wc = (cs >> 5) & 3, n = (cs >> 4) & 1, fq = (cs >> 2) & 3, j = cs & 3; return 64 * wc + 32 * bj + 8 * fq + 4 * n + j; }
DEVI int cmap_pk(int cs)   { const int bj = cs >> 7, wc = (cs >> 5) & 3, n = (cs >> 4) & 1, fq = (cs >> 2) & 3, j = cs & 3; return 128 * bj + 32 * wc + 8 * fq + 4 * n + j; }
DEVI int cmap_gu(int cs)   { const int wc = (cs >> 5) & 3, n = (cs >> 4) & 1, fq = (cs >> 2) & 3, j = cs & 3; return 32 * wc + 8 * fq + 4 * n + j; }

template <int MODE, int QEMU = 0>
DEVI void convert_item(const float* W0, const float* W1, int ldw, int K, bf16_t* Bt, int kt, int pn, unsigned char* lds) {
    bf16_t* t = (bf16_t*)lds;
    const int tid = tidx();
#pragma unroll 4
    for (int it = 0; it < 32; ++it) {
        const int e = it * kNT + tid, k = e >> 8, cs = e & 255;
        float v;
        if (MODE == 0) v = W0[(size_t)(kt * 64 + k) * ldw + pn * 256 + cs];
        else if (MODE == 1) v = W0[(size_t)(kt * 64 + k) * ldw + pn * 256 + cmap_head(cs)];
        else if (MODE == 2) v = W0[(size_t)(kt * 64 + k) * ldw + pn * 256 + cmap_pk(cs)];
        else v = ((cs >> 7) ? W1 : W0)[(size_t)(kt * 64 + k) * ldw + pn * 128 + cmap_gu(cs)];
        if (QEMU) v = q8(v, 64.f, 1.f / 64.f);
        t[cs * 72 + k] = f2bf(v);
    }
    __syncthreads();
#pragma unroll
    for (int it = 0; it < 4; ++it) {
        const int c = it * kNT + tid, row = c >> 3, part = c & 7;
        const u32x4 v = *(const u32x4*)(t + row * 72 + part * 8);
        *(u32x4*)(Bt + (size_t)(pn * 256 + row) * K + kt * 64 + part * 8) = v;
    }
    __syncthreads();
}

template <int MODE>
DEVI void convert_item8(const float* W0, const float* W1, int ldw, int K, unsigned char* Bt, int kt, int pn, unsigned char* lds) {
    unsigned char* t = lds;
    const int tid = tidx();
#pragma unroll 4
    for (int it = 0; it < 64; ++it) {
        const int e = it * kNT + tid, k = e >> 8, cs = e & 255;
        float v;
        if (MODE == 2) v = W0[(size_t)(kt * 128 + k) * ldw + pn * 256 + cmap_pk(cs)];
        else v = ((cs >> 7) ? W1 : W0)[(size_t)(kt * 128 + k) * ldw + pn * 128 + cmap_gu(cs)];
        v *= kW8;
        t[cs * 144 + k] = (unsigned char)(__builtin_amdgcn_cvt_pk_fp8_f32(v, v, 0u, false) & 0xFFu);
    }
    __syncthreads();
#pragma unroll
    for (int it = 0; it < 4; ++it) {
        const int c = it * kNT + tid, row = c >> 3, part = c & 7;
        const u32x4 v = *(const u32x4*)(t + row * 144 + part * 16);
        *(u32x4*)(Bt + (size_t)(pn * 256 + row) * K + kt * 128 + part * 16) = v;
    }
    __syncthreads();
}

DEVI void phase_convert(const Params& P, unsigned char* lds, int bid, int nblk) {
    constexpr int N_WIN = kL * 16 * 10, N_WOUT = kL * 16 * 4, N_WGLU = kL * 4 * 1, N_WGU = kL * kE * (FP8_GU ? 8 : 16) * 16, N_WD = kL * kE * (FP8_DN ? 16 : 32) * 4;
    constexpr int TOT = N_WIN + N_WOUT + N_WGLU + N_WGU + N_WD;
    for (int it = bid; it < TOT; it += nblk) {
        int i = it;
        if (i < N_WIN) { const int l = i / 160, r = i % 160, kt = r / 10, pn = r % 10;
            convert_item<1, EMU_FP8_WIN>(P.w_in + (size_t)l * kD * kINW, nullptr, kINW, kD, (bf16_t*)(wsp(P) + WS_WINT) + (size_t)l * kINW * kD, kt, pn, lds); continue; }
        i -= N_WIN;
        if (i < N_WOUT) { const int l = i / 64, r = i % 64, kt = r / 4, pn = r % 4;
            convert_item<2, EMU_FP8_WOUT>(P.w_out + (size_t)l * kD * kD, nullptr, kD, kD, (bf16_t*)(wsp(P) + WS_WOUTT) + (size_t)l * kD * kD, kt, pn, lds); continue; }
        i -= N_WOUT;
        if (i < N_WGLU) { const int l = i / 4, kt = i % 4;
            convert_item<2>(P.w_glu + (size_t)l * 256 * 256, nullptr, 256, 256, (bf16_t*)(wsp(P) + WS_WGLUT) + (size_t)l * 256 * 256, kt, 0, lds); continue; }
        i -= N_WGLU;
#if FP8_GU
        if (i < N_WGU) { const int le = i / 128, r = i % 128, kt = r / 16, pn = r % 16;
            convert_item8<3>(P.w_gate + (size_t)le * kD * kFF, P.w_up + (size_t)le * kD * kFF, kFF, kD, wsp(P) + WS_WGUT + (size_t)le * 4096 * kD, kt, pn, lds); continue; }
#else
        if (i < N_WGU) { const int le = i / 256, r = i % 256, kt = r / 16, pn = r % 16;
            convert_item<3, EMU_FP8_GU>(P.w_gate + (size_t)le * kD * kFF, P.w_up + (size_t)le * kD * kFF, kFF, kD, (bf16_t*)(wsp(P) + WS_WGUT) + (size_t)le * 4096 * kD, kt, pn, lds); continue; }
#endif
        i -= N_WGU;
#if FP8_DN
        { const int le = i / 64, r = i % 64, kt = r / 4, pn = r % 4;
            convert_item8<2>(P.w_down + (size_t)le * kFF * kD, nullptr, kD, kFF, wsp(P) + WS_WDT + (size_t)le * kD * kFF, kt, pn, lds); }
#else
        { const int le = i / 128, r = i % 128, kt = r / 4, pn = r % 4;
            convert_item<2, EMU_FP8_DN>(P.w_down + (size_t)le * kFF * kD, nullptr, kD, kFF, (bf16_t*)(wsp(P) + WS_WDT) + (size_t)le * kD * kFF, kt, pn, lds); }
#endif
    }
}

DEVI void phase_norm(const float* x, const float* gain, bf16_t* h, int bid, int nblk) {
    const int wid = tidx() >> 6, lane = tidx() & 63;
    f32x4 g[4];
#pragma unroll
    for (int q = 0; q < 4; ++q) g[q] = *(const f32x4*)(gain + q * 256 + lane * 4);
    for (int row = bid * 8 + wid; row < kTok; row += nblk * 8) {
        f32x4 v[4]; float ss = 0.f;
#pragma unroll
        for (int q = 0; q < 4; ++q) { v[q] = *(const f32x4*)(x + (size_t)row * kD + q * 256 + lane * 4); ss += v[q].x * v[q].x + v[q].y * v[q].y + v[q].z * v[q].z + v[q].w * v[q].w; }
        ss = wave_sum(ss);
        const float rstd = rsqrtf(ss * (1.f / kD) + kEps);
#pragma unroll
        for (int q = 0; q < 4; ++q) { f32x4 t = v[q] * rstd * g[q]; if (EMU_FP8_WIN) { t.x = q8(t.x, 1.f, 1.f); t.y = q8(t.y, 1.f, 1.f); t.z = q8(t.z, 1.f, 1.f); t.w = q8(t.w, 1.f, 1.f); }
            u32x2 o; o.x = pk2(t.x, t.y); o.y = pk2(t.z, t.w);
            *(u32x2*)(h + (size_t)row * kD + q * 256 + lane * 4) = o; }
    }
}

DEVI void phase_router(const bf16_t* x, const float* gain, const float* wr  , bf16_t* h, float* aff, unsigned char* lds, int bid, int nblk) {
    float* wT = (float*)lds;
    for (int i = tidx(); i < 16 * 1024; i += kNT) { const int k = i >> 4, e = i & 15; wT[e * 1024 + k] = wr[i]; }
    __syncthreads();
    const int wid = tidx() >> 6, lane = tidx() & 63;
    f32x4 g[4];
#pragma unroll
    for (int q = 0; q < 4; ++q) g[q] = *(const f32x4*)(gain + q * 256 + lane * 4);
    u32x2 nvx[2][4];
    { const int r0 = (bid * 8 + wid) * 2;
      if (r0 < kTok) {
#pragma unroll
        for (int r = 0; r < 2; ++r)
#pragma unroll
            for (int q = 0; q < 4; ++q) nvx[r][q] = *(const u32x2*)(x + (size_t)(r0 + r) * kD + q * 256 + lane * 4); } }
    for (int row0 = (bid * 8 + wid) * 2; row0 < kTok; row0 += nblk * 8 * 2) {
        asm volatile("" ::: "memory");
        f32x4 v[2][4];
#pragma unroll
        for (int r = 0; r < 2; ++r)
#pragma unroll
            for (int q = 0; q < 4; ++q) { const u32x2 w = nvx[r][q]; v[r][q] = (f32x4){__uint_as_float(w.x << 16), __uint_as_float(w.x & 0xFFFF0000u), __uint_as_float(w.y << 16), __uint_as_float(w.y & 0xFFFF0000u)}; }
        { const int nr0 = row0 + nblk * 8 * 2;
          if (nr0 < kTok) {
#pragma unroll
            for (int r = 0; r < 2; ++r)
#pragma unroll
                for (int q = 0; q < 4; ++q) nvx[r][q] = *(const u32x2*)(x + (size_t)(nr0 + r) * kD + q * 256 + lane * 4); } }
#pragma unroll
        for (int r = 0; r < 2; ++r) { float ss = 0.f;
#pragma unroll
            for (int q = 0; q < 4; ++q) { ss += v[r][q].x * v[r][q].x + v[r][q].y * v[r][q].y + v[r][q].z * v[r][q].z + v[r][q].w * v[r][q].w; }
            ss = wave_sum(ss); const float rstd = rsqrtf(ss * (1.f / kD) + kEps);
#pragma unroll
            for (int q = 0; q < 4; ++q) { v[r][q] = v[r][q] * rstd * g[q];
#if FP8_GU
                *(unsigned*)((unsigned char*)h + (size_t)(row0 + r) * kD + q * 256 + lane * 4) = pk4_fp8(v[r][q].x, v[r][q].y, v[r][q].z, v[r][q].w); }
#else
                u32x2 o;
                if (EMU_FP8_GU) { o.x = pk2(q8(v[r][q].x, 1.f, 1.f), q8(v[r][q].y, 1.f, 1.f)); o.y = pk2(q8(v[r][q].z, 1.f, 1.f), q8(v[r][q].w, 1.f, 1.f)); }
                else { o.x = pk2(v[r][q].x, v[r][q].y); o.y = pk2(v[r][q].z, v[r][q].w); }
                *(u32x2*)(h + (size_t)(row0 + r) * kD + q * 256 + lane * 4) = o; }
#endif
        }
        float pa[32];
#pragma unroll
        for (int e = 0; e < 16; ++e) {
            float s0 = 0.f, s1 = 0.f;
#pragma unroll
            for (int q = 0; q < 4; ++q) { const f32x4 w = *(const f32x4*)(wT + e * 1024 + q * 256 + lane * 4);
                s0 += v[0][q].x * w.x + v[0][q].y * w.y + v[0][q].z * w.z + v[0][q].w * w.w;
                s1 += v[1][q].x * w.x + v[1][q].y * w.y + v[1][q].z * w.z + v[1][q].w * w.w; }
            pa[e] = s0; pa[16 + e] = s1;
        }
#define RS_STEP(HALF, MASK) { const bool up = (lane & (MASK)) != 0; _Pragma("unroll") for (int i = 0; i < (HALF); ++i) { const float keep = up ? pa[i + (HALF)] : pa[i], send = up ? pa[i] : pa[i + (HALF)]; pa[i] = keep + __shfl_xor(send, (MASK)); } }
        RS_STEP(16, 32) RS_STEP(8, 16) RS_STEP(4, 8) RS_STEP(2, 4) RS_STEP(1, 2)
#undef RS_STEP
        const float logit = pa[0] + __shfl_xor(pa[0], 1);
        float mx = logit;
#pragma unroll
        for (int m = 16; m >= 2; m >>= 1) mx = fmaxf(mx, __shfl_xor(mx, m));
        const float ex = __expf(logit - mx);
        float sm = ex;
#pragma unroll
        for (int m = 16; m >= 2; m >>= 1) sm += __shfl_xor(sm, m);
        const int row = row0 + (lane >> 5), e = (lane >> 1) & 15, b = row >> 13, s = row & (kS - 1);
        if (!(lane & 1)) aff[((size_t)(b * kE + e)) * kS + s] = ex * frcp(sm);
    }
    __syncthreads();
}

DEVI int block_excl_scan(int v, int* sh  , int& total) {
    const int lane = tidx() & 63, wid = tidx() >> 6;
    int incl = v;
#pragma unroll
    for (int d = 1; d < 64; d <<= 1) { const int o = __shfl_up(incl, d); if (lane >= d) incl += o; }
    __syncthreads();
    if (lane == 63) sh[wid] = incl;
    __syncthreads();
    int base = 0, tot = 0;
#pragma unroll
    for (int w = 0; w < 8; ++w) { const int c = sh[w]; if (w < wid) base += c; tot += c; }
    total = tot;
    return base + incl - v;
}

DEVI void phase_topk(const float* aff, int* idx, float* gate, int* tokslot, const unsigned char* hsrc, unsigned char* xe, int rowbytes, unsigned char* lds, int bid, int nblk) {
    int* hist = (int*)lds;
    int* sh = hist + 256;
    int* res = sh + 16;
    int* lsel = res + 16;
    const int tid = tidx(), lane = tid & 63, wid = tid >> 6;
    const int share = (nblk >= 2 * kB * kE) ? 2 : 1;
    for (int wi = bid; wi < kB * kE * share; wi += nblk) {
        const int item = wi / share, part = wi - item * share;
        const int b = item >> 4, e = item & 15;
        const float* a = aff + (size_t)item * kS;
        unsigned key[16];
#pragma unroll
        for (int q = 0; q < 4; ++q) { const u32x4 v = *(const u32x4*)(a + tid * 16 + q * 4); key[q * 4 + 0] = v.x; key[q * 4 + 1] = v.y; key[q * 4 + 2] = v.z; key[q * 4 + 3] = v.w; }
        unsigned prefix = 0; int kk = kCap;
#pragma unroll 1
        for (int pass = 0; pass < 4; ++pass) {
            const int shift = 24 - 8 * pass;
            __syncthreads();
            if (tid < 256) hist[tid] = 0;
            __syncthreads();
#pragma unroll
            for (int i = 0; i < 16; ++i) { const bool in = (pass == 0) || ((key[i] >> (shift + 8)) == prefix); if (in) atomicAdd(&hist[(key[i] >> shift) & 255], 1); }
            __syncthreads();
            if (wid == 0) {
                int c[4], loc = 0;
#pragma unroll
                for (int j = 0; j < 4; ++j) { c[j] = hist[255 - 4 * lane - j]; loc += c[j]; }
                int incl = loc;
#pragma unroll
                for (int d = 1; d < 64; d <<= 1) { const int o = __shfl_up(incl, d); if (lane >= d) incl += o; }
                const int excl = incl - loc;
                if (excl < kk && kk <= incl) { int run = excl; int bin = 0, nk = 0; bool found = false;
#pragma unroll
                    for (int j = 0; j < 4; ++j) { if (!found && run + c[j] >= kk) { bin = 255 - 4 * lane - j; nk = kk - run; found = true; } if (!found) run += c[j]; }
                    res[0] = bin; res[1] = nk; }
            }
            __syncthreads();
            prefix = (prefix << 8) | (unsigned)res[0]; kk = res[1];
        }
        const unsigned T = prefix;
        int ceq = 0;
#pragma unroll
        for (int i = 0; i < 16; ++i) ceq += (key[i] == T) ? 1 : 0;
        int tot;
        int eqb = block_excl_scan(ceq, sh, tot);
        int csel = 0; unsigned selmask = 0;
#pragma unroll
        for (int i = 0; i < 16; ++i) { bool s = key[i] > T; if (key[i] == T) { s = eqb < kk; ++eqb; } if (s) { selmask |= 1u << i; ++csel; } }
        int slot = block_excl_scan(csel, sh, tot);
        const size_t rbase = (size_t)(e * kB + b) * kCap;
#pragma unroll
        for (int i = 0; i < 16; ++i) { const int s = tid * 16 + i; const bool sel = (selmask >> i) & 1u;
            if (sel) { if (part == 0) { idx[rbase + slot] = b * kS + s; gate[rbase + slot] = __uint_as_float(key[i]); } lsel[slot] = b * kS + s; }
            if (part == 0) tokslot[((size_t)(b * kS + s)) * kE + e] = sel ? slot : -1;
            if (sel) ++slot; }
        __syncthreads();
        { const int cpr = rowbytes >> 4;
          const int cbeg = part * (kCap / share) * cpr, cend = cbeg + (kCap / share) * cpr;
          for (int c0 = cbeg + tid; c0 < cend; c0 += kNT * 4) {
              u32x4 v[4];
#pragma unroll
              for (int j = 0; j < 4; ++j) { const int c = c0 + j * kNT; const int r = c / cpr, ch = c - r * cpr; v[j] = *(const u32x4*)(hsrc + (size_t)lsel[r] * rowbytes + ch * 16); }
#pragma unroll
              for (int j = 0; j < 4; ++j) { const int c = c0 + j * kNT; const int r = c / cpr, ch = c - r * cpr; *(u32x4*)(xe + (rbase + r) * rowbytes + ch * 16) = v[j]; }
          } }
    }
    __syncthreads();
}

struct Unit { int pm, pn; };
DEVI bool unit_of(int Lid, int nM, int nN, Unit& u) {
    const int nwg = nM * nN; if (Lid >= nwg) return false;
    int wgid = Lid; { const int q = nwg / 8, r = nwg % 8, xcd = wgid % 8, off = wgid / 8; wgid = (xcd < r ? xcd * (q + 1) : r * (q + 1) + (xcd - r) * q) + off; }
    const int nig = 8 * nN, gid = wgid / nig, fm = gid * 8, gsz = (nM - fm) < 8 ? (nM - fm) : 8;
    u.pm = fm + ((wgid % nig) % gsz); u.pn = (wgid % nig) / gsz; return true;
}
struct GemmD { const bf16_t* A; const bf16_t* Bt; int lda, K, nM, nN; const int* rowidx; size_t bstride; int pmg; };

template <class Epi>
DEVI void gemm_simple(const GemmD g, const Epi& E, int bid, int nblk) {
    const int tid = tidx(), wid = tid >> 6, lane = tid & 63, wr = wid >> 2, wc = wid & 3, fr = lane & 15, fq = lane >> 4;
    for (int i = 0;; ++i) {
        Unit u; if (!unit_of(i * nblk + bid, g.nM, g.nN, u)) break;
        f32x4 acc[2][2][4][2];
#pragma unroll
        for (int a = 0; a < 2; ++a)
#pragma unroll
            for (int b = 0; b < 2; ++b)
#pragma unroll
                for (int m = 0; m < 4; ++m)
#pragma unroll
                    for (int n = 0; n < 2; ++n) acc[a][b][m][n] = (f32x4){0.f, 0.f, 0.f, 0.f};
        const bf16_t* Bu = g.Bt + (size_t)(u.pm / g.pmg) * g.bstride + (size_t)u.pn * 256 * g.K;
        unsigned ao[2][4], bo[2][2];
#pragma unroll
        for (int a = 0; a < 2; ++a)
#pragma unroll
            for (int m = 0; m < 4; ++m) { const int r = u.pm * 256 + 128 * a + 64 * wr + 16 * m + fr; const unsigned rr = g.rowidx ? (unsigned)g.rowidx[r] : (unsigned)r; ao[a][m] = rr * (unsigned)g.lda + 8u * fq; }
#pragma unroll
        for (int b = 0; b < 2; ++b)
#pragma unroll
            for (int n = 0; n < 2; ++n) bo[b][n] = (unsigned)(128 * b + 32 * wc + 16 * n + fr) * (unsigned)g.K + 8u * fq;
#pragma unroll 1
        for (int k0 = 0; k0 < g.K; k0 += 32) {
            bf16x8 av[2][4], bv[2][2];
#pragma unroll
            for (int a = 0; a < 2; ++a)
#pragma unroll
                for (int m = 0; m < 4; ++m) av[a][m] = *(const bf16x8*)(g.A + ao[a][m] + k0);
#pragma unroll
            for (int b = 0; b < 2; ++b)
#pragma unroll
                for (int n = 0; n < 2; ++n) bv[b][n] = *(const bf16x8*)(Bu + bo[b][n] + k0);
#pragma unroll
            for (int a = 0; a < 2; ++a)
#pragma unroll
                for (int b = 0; b < 2; ++b)
#pragma unroll
                    for (int m = 0; m < 4; ++m)
#pragma unroll
                        for (int n = 0; n < 2; ++n) acc[a][b][m][n] = __builtin_amdgcn_mfma_f32_16x16x32_bf16(bv[b][n], av[a][m], acc[a][b][m][n], 0, 0, 0);
        }
        E(acc, u, wr, wc, fr, fq);
    }
}


constexpr int PG_HTB = 128 * 64 * 2;
DEVI int pg_lds_byte(int r, int c) { const int st = (r >> 4) * 2 + (c >> 5), rr = r & 15, cc = c & 31, ob = rr * 64 + cc * 2; return st * 1024 + (ob ^ (((ob >> 9) & 1) << 5)); }
DEVI void pg_stage_rc(int b, int& R, int& C) { const int st = b / 1024, sb = b % 1024, swz = sb ^ (((sb >> 9) & 1) << 5); R = (st >> 1) * 16 + swz / 64; C = (st & 1) * 32 + (swz % 64) / 2; }

typedef int v4i __attribute__((ext_vector_type(4)));
typedef int v8i __attribute__((ext_vector_type(8)));
template <class Epi, bool ALIGN_EPI, bool SP2, bool FP8 = false>
DEVI void gemm_engine(LAS unsigned char* lds, const GemmD g, const Epi& E, int bid, int nblk) {
    const int tid = tidx(), wid = __builtin_amdgcn_readfirstlane(tid >> 6), lane = tid & 63, wr = wid >> 2, wc = wid & 3, fr = lane & 15, fq = lane >> 4;
    constexpr int ES = FP8 ? 1 : 2;
    const int K = g.K * ES  , nt = K / 128; const unsigned ldaB = (unsigned)g.lda * ES;
    unsigned voffA[2], voffB[2];
#pragma unroll
    for (int i = 0; i < 2; ++i) { int R, C; pg_stage_rc(tid * 16 + i * 8192, R, C); voffA[i] = (unsigned)R * ldaB + (unsigned)C * 2u; voffB[i] = (unsigned)(R * K + C * 2); }
    const size_t kstep = 128;
    const size_t hstepB = (size_t)128 * K, hstepA = (size_t)128 * ldaB, tstepA = 2 * hstepA;
    const unsigned ldsw = (unsigned)wid * 1024u;
    const int aoff = pg_lds_byte(wr * 64 + fr, fq * 8), boff = pg_lds_byte(wc * 32 + fr, fq * 8);
#define PG8_SA(b, h) (((b) * 2 + (h)) * PG_HTB)
#define PG8_SB(b, h) ((4 + (b) * 2 + (h)) * PG_HTB)
#define PG8_STAGE(bufoff, gbase, voff) do { _Pragma("unroll") for (int _i = 0; _i < 2; ++_i) \
        __builtin_amdgcn_global_load_lds((const unsigned*)((const char*)(gbase) + (voff)[_i]), (LAS unsigned*)(lds + (bufoff) + ldsw + _i * 8192), 16, 0, 0); } while (0)
#define PG8_RD16(off) (*(const LAS v4i*)(lds + (off)))
#define PG8_CAT2(off) __builtin_shufflevector(PG8_RD16(off), PG8_RD16((off) + 1024), 0, 1, 2, 3, 4, 5, 6, 7)
#define PG8_LDA(dst, b, h) do { _Pragma("unroll") for (int m = 0; m < 4; ++m) { if constexpr (FP8) dst##8[m] = PG8_CAT2(PG8_SA(b, h) + aoff + m * 2048); \
        else { _Pragma("unroll") for (int k = 0; k < 2; ++k) dst[m][k] = *(const LAS bf16x8*)(lds + PG8_SA(b, h) + aoff + m * 2048 + k * 1024); } } } while (0)
#define PG8_LDB(dst, b, h) do { _Pragma("unroll") for (int n = 0; n < 2; ++n) { if constexpr (FP8) dst##8[n] = PG8_CAT2(PG8_SB(b, h) + boff + n * 2048); \
        else { _Pragma("unroll") for (int k = 0; k < 2; ++k) dst[n][k] = *(const LAS bf16x8*)(lds + PG8_SB(b, h) + boff + n * 2048 + k * 1024); } } } while (0)
#define PG8_MMA(ai, bj, At, Bt) do { __builtin_amdgcn_s_setprio(1); _Pragma("unroll") for (int m = 0; m < 4; ++m) _Pragma("unroll") for (int n = 0; n < 2; ++n) { \
        if constexpr (FP8) asm volatile("v_mfma_f32_16x16x128_f8f6f4 %0, %1, %2, %0" : "+v"(acc[ai][bj][m][n]) : "v"(Bt##8[n]), "v"(At##8[m]));   \
        else { _Pragma("unroll") for (int k = 0; k < 2; ++k) acc[ai][bj][m][n] = __builtin_amdgcn_mfma_f32_16x16x32_bf16(Bt[n][k], At[m][k], acc[ai][bj][m][n], 0, 0, 0); } } \
        __builtin_amdgcn_s_setprio(0); } while (0)
#define PG8_WAIT_V(n) asm volatile("s_waitcnt vmcnt(" #n ")" ::: "memory")
#define PG8_WAIT_L(n) asm volatile("s_waitcnt lgkmcnt(" #n ")" ::: "memory")
#define PG8_BAR __builtin_amdgcn_s_barrier()
#define PG8_SCHED __builtin_amdgcn_sched_barrier(0)
    Unit cur, nxt; int ui = 0;
    if (!unit_of(bid, g.nM, g.nN, cur)) return;
    f32x4 acc[2][2][4][2];
#pragma unroll
    for (int a = 0; a < 2; ++a)
#pragma unroll
        for (int b = 0; b < 2; ++b)
#pragma unroll
            for (int m = 0; m < 4; ++m)
#pragma unroll
                for (int n = 0; n < 2; ++n) acc[a][b][m][n] = (f32x4){0.f, 0.f, 0.f, 0.f};
    bf16x8 At[4][2], B0[2][2], B1[2][2]; v8i At8[4], B08[2], B18[2];
    (void)At; (void)B0; (void)B1; (void)At8; (void)B08; (void)B18;
    static_assert(SP2, "only the two-super-phase K-loop is kept");
    const char* cA = (const char*)g.A + (size_t)cur.pm * tstepA;
    const char* cB = (const char*)g.Bt + (size_t)(cur.pm / g.pmg) * g.bstride * ES + (size_t)cur.pn * 256 * K;
    PG8_STAGE(PG8_SB(0, 0), cB, voffB); PG8_STAGE(PG8_SB(0, 1), cB + hstepB, voffB); PG8_STAGE(PG8_SA(0, 0), cA, voffA); PG8_STAGE(PG8_SA(0, 1), cA + hstepA, voffA);
    if (wr == 1) PG8_BAR;
    PG8_WAIT_V(2); PG8_BAR;
    PG8_STAGE(PG8_SB(1, 0), cB + kstep, voffB); PG8_STAGE(PG8_SA(1, 0), cA + kstep, voffA); PG8_STAGE(PG8_SB(1, 1), cB + hstepB + kstep, voffB);
    PG8_WAIT_V(6); PG8_BAR;
    for (;;) {
        const bool has_next = unit_of((ui + 1) * nblk + bid, g.nM, g.nN, nxt);
        const char* nA = has_next ? (const char*)g.A + (size_t)nxt.pm * tstepA : cA;
        const char* nB = has_next ? (const char*)g.Bt + (size_t)(nxt.pm / g.pmg) * g.bstride * ES + (size_t)nxt.pn * 256 * K : cB;
#pragma unroll 1
        for (int t = 0; t < nt; t += 2) {
            const bool last = (t == nt - 2);
            const char* a1 = cA + (size_t)(t + 1) * kstep;
            const char* a2 = last ? nA : cA + (size_t)(t + 2) * kstep; const char* b2 = last ? nB : cB + (size_t)(t + 2) * kstep;
            const char* a3 = a2 + kstep; const char* b3 = b2 + kstep;
            PG8_LDB(B0, 0, 0); PG8_LDB(B1, 0, 1); PG8_SCHED; PG8_LDA(At, 0, 0); PG8_STAGE(PG8_SA(1, 1), a1 + hstepA, voffA);
            PG8_WAIT_V(8); PG8_WAIT_L(0); PG8_BAR; PG8_MMA(0, 0, At, B0); PG8_MMA(0, 1, At, B1); PG8_BAR; PG8_SCHED;
            PG8_LDA(At, 0, 1); PG8_STAGE(PG8_SB(0, 0), b2, voffB); PG8_STAGE(PG8_SB(0, 1), b2 + hstepB, voffB); PG8_STAGE(PG8_SA(0, 0), a2, voffA);
            PG8_WAIT_V(8); PG8_WAIT_L(0); PG8_BAR; PG8_MMA(1, 0, At, B0); PG8_MMA(1, 1, At, B1); PG8_BAR; PG8_SCHED;
            PG8_LDB(B0, 1, 0); PG8_LDB(B1, 1, 1); PG8_SCHED; PG8_LDA(At, 1, 0); PG8_STAGE(PG8_SA(0, 1), a2 + hstepA, voffA);
            PG8_WAIT_V(8); PG8_WAIT_L(0); PG8_BAR; PG8_MMA(0, 0, At, B0); PG8_MMA(0, 1, At, B1); PG8_BAR; PG8_SCHED;
            PG8_LDA(At, 1, 1); PG8_STAGE(PG8_SB(1, 0), b3, voffB); PG8_STAGE(PG8_SB(1, 1), b3 + hstepB, voffB); PG8_STAGE(PG8_SA(1, 0), a3, voffA);
            PG8_WAIT_V(8); PG8_WAIT_L(0); PG8_BAR; PG8_MMA(1, 0, At, B0); PG8_MMA(1, 1, At, B1); PG8_BAR; PG8_SCHED;
        }
        if constexpr (ALIGN_EPI) { if (wr == 0) PG8_BAR; }
        if constexpr (FP8) asm volatile("s_nop 15\n\ts_nop 15" ::: "memory");
        E(acc, cur, wr, wc, fr, fq);
        if (!has_next) break;
#pragma unroll
        for (int a = 0; a < 2; ++a)
#pragma unroll
            for (int b = 0; b < 2; ++b)
#pragma unroll
                for (int m = 0; m < 4; ++m)
#pragma unroll
                    for (int n = 0; n < 2; ++n) acc[a][b][m][n] = (f32x4){0.f, 0.f, 0.f, 0.f};
        cur = nxt; cA = nA; cB = nB; ++ui;
        if constexpr (ALIGN_EPI) { if (wr == 1) PG8_BAR; }
    }
    PG8_WAIT_V(0);
    if constexpr (!ALIGN_EPI) { if (wr == 0) PG8_BAR; }
    PG8_BAR;
#undef PG8_SA
#undef PG8_SB
#undef PG8_STAGE
#undef PG8_LDA
#undef PG8_LDB
#undef PG8_MMA
#undef PG8_RD16
#undef PG8_CAT2
#undef PG8_WAIT_V
#undef PG8_WAIT_L
#undef PG8_BAR
#undef PG8_SCHED
}

struct EpiQKV {
    static constexpr int VMOPS = 16;
    bf16_t *qa, *ka, *va, *qb, *kb, *vb, *ux; const float *qna, *kna, *qnb, *knb;
    DEVI void operator()(const f32x4 (&acc)[2][2][4][2], const Unit& u, int wr, int wc, int fr, int fq) const {
        bf16_t* dst; const float* gn = nullptr; int H = 8, head0 = 0; const int pn = u.pn;
        if (pn < 2) { dst = qa; gn = qna; head0 = pn * 4; }
        else if (pn < 4) { dst = ka; gn = kna; head0 = (pn - 2) * 4; }
        else if (pn < 6) { dst = va; head0 = (pn - 4) * 4; }
        else if (pn == 6) { dst = qb; gn = qnb; H = 4; }
        else if (pn == 7) { dst = kb; gn = knb; H = 4; }
        else if (pn == 8) { dst = vb; H = 4; }
        else { dst = ux; }
        const int head = head0 + wc;
        f32x4 gv[2][2];
#pragma unroll
        for (int bj = 0; bj < 2; ++bj)
#pragma unroll
            for (int n = 0; n < 2; ++n) gv[bj][n] = gn ? *(const f32x4*)(gn + 32 * bj + 8 * fq + 4 * n) : (f32x4){1.f, 1.f, 1.f, 1.f};
#pragma unroll
        for (int ai = 0; ai < 2; ++ai)
#pragma unroll
            for (int m = 0; m < 4; ++m) {
                const int row = u.pm * 256 + 128 * ai + 64 * wr + 16 * m + fr;
                float rstd = 1.f;
                if (gn) { float ss = 0.f;
#pragma unroll
                    for (int bj = 0; bj < 2; ++bj)
#pragma unroll
                        for (int n = 0; n < 2; ++n) { const f32x4 v = acc[ai][bj][m][n]; ss += v.x * v.x + v.y * v.y + v.z * v.z + v.w * v.w; }
                    ss += __shfl_xor(ss, 16); ss += __shfl_xor(ss, 32);
                    rstd = rsqrtf(ss * (1.f / 64.f) + kEps); }
#pragma unroll
                for (int bj = 0; bj < 2; ++bj) {
                    const f32x4 v0 = acc[ai][bj][m][0] * rstd * gv[bj][0], v1 = acc[ai][bj][m][1] * rstd * gv[bj][1];
                    u32x4 w; w.x = pk2(v0.x, v0.y); w.y = pk2(v0.z, v0.w); w.z = pk2(v1.x, v1.y); w.w = pk2(v1.z, v1.w);
                    if (pn < 9) { const int b = row >> 13, s = row & (kS - 1);
                        *(u32x4*)(dst + (((size_t)(b * H + head)) * kS + s) * 64 + 32 * bj + 8 * fq) = w; }
                    else { const int gidx = 4 * wc + 2 * bj + (fq >> 1), c0 = 8 * (fq & 1);
                        *(u32x4*)(dst + ((size_t)gidx * 4096 + (row >> 4)) * 512 + (row & 15) * 16 + c0) = w; }
                }
            }
    }
};
struct EpiResid {
    static constexpr int VMOPS = 16;
    const float* x32; bf16_t* xb;
    DEVI void operator()(const f32x4 (&acc)[2][2][4][2], const Unit& u, int wr, int wc, int fr, int fq) const {
#pragma unroll
        for (int ai = 0; ai < 2; ++ai)
#pragma unroll
            for (int m = 0; m < 4; ++m) { const size_t ro = (size_t)(u.pm * 256 + 128 * ai + 64 * wr + 16 * m + fr) * kD + u.pn * 256 + 32 * wc + 8 * fq;
#pragma unroll
                for (int bj = 0; bj < 2; ++bj) { const size_t o = ro + 128 * bj; f32x4 v0, v1;
                    if (x32) { v0 = *(const f32x4*)(x32 + o); v1 = *(const f32x4*)(x32 + o + 4); }
                    else { const u32x4 w = *(const u32x4*)(xb + o); v0 = (f32x4){__uint_as_float(w.x << 16), __uint_as_float(w.x & 0xFFFF0000u), __uint_as_float(w.y << 16), __uint_as_float(w.y & 0xFFFF0000u)};
                        v1 = (f32x4){__uint_as_float(w.z << 16), __uint_as_float(w.z & 0xFFFF0000u), __uint_as_float(w.w << 16), __uint_as_float(w.w & 0xFFFF0000u)}; }
                    v0 += acc[ai][bj][m][0]; v1 += acc[ai][bj][m][1];
                    u32x4 r; r.x = pk2(v0.x, v0.y); r.y = pk2(v0.z, v0.w); r.z = pk2(v1.x, v1.y); r.w = pk2(v1.z, v1.w);
                    *(u32x4*)(xb + o) = r; } }
    }
};
struct EpiGU {
    static constexpr int VMOPS = 8;
    bf16_t* hid; float sc; bool nomath;
    DEVI void operator()(const f32x4 (&acc)[2][2][4][2], const Unit& u, int wr, int wc, int fr, int fq) const {
#pragma unroll
        for (int ai = 0; ai < 2; ++ai)
#pragma unroll
            for (int m = 0; m < 4; ++m) { const size_t row = (size_t)(u.pm * 256 + 128 * ai + 64 * wr + 16 * m + fr);
                float o[8];
                const float k1 = -sc * kLog2e, k2 = sc * sc * (FP8_DN ? kH8 : 1.f);
#pragma unroll
                for (int n = 0; n < 2; ++n)
#pragma unroll
                    for (int j = 0; j < 4; j += 2) { const f32x2 a = {acc[ai][0][m][n][j], acc[ai][0][m][n][j + 1]}, b = {acc[ai][1][m][n][j], acc[ai][1][m][n][j + 1]};
                        const f32x2 ab = a * b, t = a * k1; f32x2 d; d.x = __builtin_amdgcn_exp2f(t.x); d.y = __builtin_amdgcn_exp2f(t.y); d = d + 1.f;
                        f32x2 r; r.x = frcp(d.x); r.y = frcp(d.y); const f32x2 v = nomath ? ab * k2 : (ab * r) * k2;
                        o[n * 4 + j] = v.x; o[n * 4 + j + 1] = v.y; }
#if FP8_DN
                u32x2 w;
#pragma unroll
                for (int t = 0; t < 8; ++t) o[t] = __builtin_amdgcn_fmed3f(o[t], -448.f, 448.f);
                w.x = pk4_fp8(o[0], o[1], o[2], o[3]); w.y = pk4_fp8(o[4], o[5], o[6], o[7]);
                *(u32x2*)((unsigned char*)hid + row * kFF + u.pn * 128 + 32 * wc + 8 * fq) = w;
#else
                u32x4 w; w.x = pk2(o[0], o[1]); w.y = pk2(o[2], o[3]); w.z = pk2(o[4], o[5]); w.w = pk2(o[6], o[7]);
                *(u32x4*)(hid + row * kFF + u.pn * 128 + 32 * wc + 8 * fq) = w;
#endif
            }
    }
};
struct EpiDry {
    static constexpr int VMOPS = 0;
    float* sink;
    DEVI void operator()(const f32x4 (&acc)[2][2][4][2], const Unit& u, int wr, int wc, int fr, int fq) const {
        float t = 0.f;
#pragma unroll
        for (int ai = 0; ai < 2; ++ai)
#pragma unroll
            for (int bj = 0; bj < 2; ++bj)
#pragma unroll
                for (int m = 0; m < 4; ++m)
#pragma unroll
                    for (int n = 0; n < 2; ++n) t += acc[ai][bj][m][n].x + acc[ai][bj][m][n].y + acc[ai][bj][m][n].z + acc[ai][bj][m][n].w;
        if (t == 1.2345e30f) sink[0] = t;
    }
};
struct EpiDown {
    static constexpr int VMOPS = 16;
    bf16_t* y; const float* gate; float sc;
    DEVI void operator()(const f32x4 (&acc)[2][2][4][2], const Unit& u, int wr, int wc, int fr, int fq) const {
#pragma unroll
        for (int ai = 0; ai < 2; ++ai)
#pragma unroll
            for (int m = 0; m < 4; ++m) { const size_t row = (size_t)(u.pm * 256 + 128 * ai + 64 * wr + 16 * m + fr); const float gv = gate[row] * sc * (FP8_Y ? kY8 : 1.f);
#pragma unroll
                for (int bj = 0; bj < 2; ++bj) { const f32x4 v0 = acc[ai][bj][m][0] * gv, v1 = acc[ai][bj][m][1] * gv;
#if FP8_Y
                    u32x2 w; w.x = pk4_fp8(__builtin_amdgcn_fmed3f(v0.x, -448.f, 448.f), __builtin_amdgcn_fmed3f(v0.y, -448.f, 448.f), __builtin_amdgcn_fmed3f(v0.z, -448.f, 448.f), __builtin_amdgcn_fmed3f(v0.w, -448.f, 448.f));
                    w.y = pk4_fp8(__builtin_amdgcn_fmed3f(v1.x, -448.f, 448.f), __builtin_amdgcn_fmed3f(v1.y, -448.f, 448.f), __builtin_amdgcn_fmed3f(v1.z, -448.f, 448.f), __builtin_amdgcn_fmed3f(v1.w, -448.f, 448.f));
                    *(u32x2*)((unsigned char*)y + row * kD + u.pn * 256 + 128 * bj + 32 * wc + 8 * fq) = w;
#else
                    u32x4 w; w.x = pk2(v0.x, v0.y); w.y = pk2(v0.z, v0.w); w.z = pk2(v1.x, v1.y); w.w = pk2(v1.z, v1.w);
                    *(u32x4*)(y + row * kD + u.pn * 256 + 128 * bj + 32 * wc + 8 * fq) = w;
#endif
                } }
    }
};
struct EpiGlu {
    static constexpr int VMOPS = 16;
    const bf16_t* g; bf16_t* oc;
    DEVI void operator()(const f32x4 (&acc)[2][2][4][2], const Unit& u, int wr, int wc, int fr, int fq) const {
#pragma unroll
        for (int ai = 0; ai < 2; ++ai)
#pragma unroll
            for (int m = 0; m < 4; ++m) { const size_t row = (size_t)(u.pm * 256 + 128 * ai + 64 * wr + 16 * m + fr);
#pragma unroll
                for (int bj = 0; bj < 2; ++bj) { const size_t o = row * 256 + 128 * bj + 32 * wc + 8 * fq;
                    const u32x4 gw = *(const u32x4*)(g + o); float o8[8];
#pragma unroll
                    for (int n = 0; n < 2; ++n)
#pragma unroll
                        for (int j = 0; j < 4; ++j) { const int t = n * 4 + j; const unsigned wv = (t < 2) ? gw.x : (t < 4) ? gw.y : (t < 6) ? gw.z : gw.w;
                            const float gg = __uint_as_float((t & 1) ? (wv & 0xFFFF0000u) : (wv << 16)); o8[t] = gg * frcp(1.f + __expf(-acc[ai][bj][m][n][j])); }
                    u32x4 w; w.x = pk2(o8[0], o8[1]); w.y = pk2(o8[2], o8[3]); w.z = pk2(o8[4], o8[5]); w.w = pk2(o8[6], o8[7]);
                    *(u32x4*)(oc + o) = w; } }
    }
};

DEVI void load_row64(const bf16_t* p, float* d) {
#pragma unroll
    for (int i = 0; i < 8; ++i) { const u32x4 v = *(const u32x4*)(p + i * 8);
        d[i * 8 + 0] = __uint_as_float(v.x << 16); d[i * 8 + 1] = __uint_as_float(v.x & 0xFFFF0000u); d[i * 8 + 2] = __uint_as_float(v.y << 16); d[i * 8 + 3] = __uint_as_float(v.y & 0xFFFF0000u);
        d[i * 8 + 4] = __uint_as_float(v.z << 16); d[i * 8 + 5] = __uint_as_float(v.z & 0xFFFF0000u); d[i * 8 + 6] = __uint_as_float(v.w << 16); d[i * 8 + 7] = __uint_as_float(v.w & 0xFFFF0000u); }
}
DEVI void store_row64(bf16_t* p, const float* d, float sc) {
#pragma unroll
    for (int i = 0; i < 8; ++i) { u32x4 w; w.x = pk2(d[i * 8] * sc, d[i * 8 + 1] * sc); w.y = pk2(d[i * 8 + 2] * sc, d[i * 8 + 3] * sc); w.z = pk2(d[i * 8 + 4] * sc, d[i * 8 + 5] * sc); w.w = pk2(d[i * 8 + 6] * sc, d[i * 8 + 7] * sc);
        *(u32x4*)(p + i * 8) = w; }
}
DEVI void phase_dilated_naive(const bf16_t* qa, const bf16_t* ka, const bf16_t* va, bf16_t* oac, float* lse, int bid, int nblk) {
    const int nitems = 3 * kB * 8 * (kS / kNT);
    for (int it = bid; it < nitems; it += nblk) {
        const int c = it / (kB * 8 * 16), r = it % (kB * 8 * 16), bh = r / 16, t = (r % 16) * kNT + tidx(), b = bh >> 3, h = bh & 7;
        const int dil = (c == 0) ? 1 : (c == 1) ? 4 : 16;
        const float slope = exp2f(-(float)(h + 1));
        const bf16_t* kb_ = ka + (size_t)bh * kS * 64; const bf16_t* vb_ = va + (size_t)bh * kS * 64;
        float q[64], o[64];
        load_row64(qa + ((size_t)bh * kS + t) * 64, q);
#pragma unroll
        for (int d = 0; d < 64; ++d) o[d] = 0.f;
        float m = -1e30f, l = 0.f;
        for (int rel = -64; rel <= 64; ++rel) {
            const int pos = t + rel * dil;
            if (pos < 0 || pos >= kS) continue;
            float kv[64]; load_row64(kb_ + (size_t)pos * 64, kv);
            float dot = 0.f;
#pragma unroll
            for (int d = 0; d < 64; ++d) dot += q[d] * kv[d];
            const float sc = dot * 0.125f - slope * (float)(dil * (rel < 0 ? -rel : rel));
            const float mn = fmaxf(m, sc), corr = __expf(m - mn), p = __expf(sc - mn);
            load_row64(vb_ + (size_t)pos * 64, kv);
            l = l * corr + p;
#pragma unroll
            for (int d = 0; d < 64; ++d) o[d] = o[d] * corr + p * kv[d];
            m = mn;
        }
        const size_t tok = (size_t)b * kS + t;
        store_row64(oac + ((size_t)c * kTok + tok) * 512 + h * 64, o, 1.f / l);
        lse[((size_t)c * kTok + tok) * 8 + h] = m + __logf(l);
    }
}
DEVI void phase_na_naive(const bf16_t* qb, const bf16_t* kbuf, const bf16_t* vbuf, const float* rpb  , bf16_t* ob, int bid, int nblk) {
    const int nitems = kB * 4 * (kS / kNT);
    for (int it = bid; it < nitems; it += nblk) {
        const int bh = it / 16, t = (it % 16) * kNT + tidx(), b = bh >> 2, h = bh & 3;
        const int r = t >> 6, cq = t & 63;
        int rs = r - 4; rs = rs < 0 ? 0 : (rs > 120 ? 120 : rs);
        int cs = cq - 8; cs = cs < 0 ? 0 : (cs > 48 ? 48 : cs);
        const bf16_t* kb_ = kbuf + (size_t)bh * kS * 64; const bf16_t* vb_ = vbuf + (size_t)bh * kS * 64;
        float q[64], o[64];
        load_row64(qb + ((size_t)bh * kS + t) * 64, q);
#pragma unroll
        for (int d = 0; d < 64; ++d) o[d] = 0.f;
        float m = -1e30f, l = 0.f;
        for (int kr = 0; kr < 8; ++kr)
            for (int kc = 0; kc < 16; ++kc) {
                const int krow = rs + kr, kcol = cs + kc, pos = krow * 64 + kcol;
                float kv[64]; load_row64(kb_ + (size_t)pos * 64, kv);
                float dot = 0.f;
#pragma unroll
                for (int d = 0; d < 64; ++d) dot += q[d] * kv[d];
                const float sc = dot * 0.125f + rpb[(h * 15 + (krow - r + 7)) * 31 + (kcol - cq + 15)];
                const float mn = fmaxf(m, sc), corr = __expf(m - mn), p = __expf(sc - mn);
                load_row64(vb_ + (size_t)pos * 64, kv);
                l = l * corr + p;
#pragma unroll
                for (int d = 0; d < 64; ++d) o[d] = o[d] * corr + p * kv[d];
                m = mn;
            }
        store_row64(ob + ((size_t)b * kS + t) * 256 + h * 64, o, 1.f / l);
    }
}

typedef float f32x16 __attribute__((ext_vector_type(16)));
typedef short s16x4 __attribute__((ext_vector_type(4)));
DEVI bf16x8 tr_pair(LAS unsigned char* p0, LAS unsigned char* p1) {
    const s16x4 a = __builtin_amdgcn_ds_read_tr16_b64_v4i16((LAS s16x4*)p0), b = __builtin_amdgcn_ds_read_tr16_b64_v4i16((LAS s16x4*)p1);
    return (bf16x8){a.x, a.y, a.z, a.w, b.x, b.y, b.z, b.w};
}
template <int VAR = 0>
DEVI void phase_dilated(const bf16_t* qa, const bf16_t* ka, const bf16_t* va, const float* gq, const float* gk, bf16_t* oac, float* lse, LAS unsigned char* lds, int bid, int nblk) {
    const int tid = tidx(), wid = __builtin_amdgcn_readfirstlane(tid >> 6), lane = tid & 63, h5 = lane >> 5, qc = lane & 31;
    LAS unsigned char* Kimg = lds; LAS unsigned char* Vimg = lds + 49152;
    float Mn;
    { float a = fabsf(gq[lane]), b = fabsf(gk[lane]);
#pragma unroll
      for (int m = 32; m >= 1; m >>= 1) { a = fmaxf(a, __shfl_xor(a, m)); b = fmaxf(b, __shfl_xor(b, m)); }
      Mn = 8.f * a * b; }
    const float Mb = Mn * kLog2e;
    unsigned koff[4];
#pragma unroll
    for (int s = 0; s < 4; ++s) koff[s] = (unsigned)((32 * wid + qc) * 128 + (((2 * s + h5) ^ (qc & 7)) << 4));
    unsigned voff[2];
    { const int g = lane >> 4, i16 = lane & 15, q = i16 >> 2, p = i16 & 3;
#pragma unroll
      for (int dt = 0; dt < 2; ++dt) { const int c = (2 * (g & 1) + (p >> 1) + 4 * dt) ^ ((q >> 1) << 2); voff[dt] = (unsigned)((32 * wid + 4 * h5 + q) * 128 + (c << 4) + 8 * (p & 1)); } }
    const float dbase = (float)(4 * h5 - qc);
    u32x4 pK[6], pV[6];
#define DIL_DECODE(unit_) const int c = (unit_) >> 11, rem = (unit_) & 2047, bh = rem >> 5, ub = rem & 31; \
        const int dsh = 2 * c, L = kS >> dsh, upc = 32 >> dsh, cls = ub >> (5 - dsh), u0 = (ub & (upc - 1)) << 8;
#define DIL_PREFETCH(unit_) do { DIL_DECODE(unit_) \
        const bf16_t* kbase = ka + (size_t)bh * kS * 64; const bf16_t* vbase = va + (size_t)bh * kS * 64; \
        _Pragma("unroll") for (int it = 0; it < 6; ++it) { const int id = it * kNT + tid, row = id >> 3, ch = id & 7; \
            int ki = u0 - 64 + row; ki = ki < 0 ? 0 : (ki > L - 1 ? L - 1 : ki); const size_t tok = (size_t)((ki << dsh) + cls); \
            pK[it] = *(const u32x4*)(kbase + tok * 64 + ch * 8); pV[it] = *(const u32x4*)(vbase + tok * 64 + ch * 8); } } while (0)
    if ((VAR & 8) || bid < 6144) DIL_PREFETCH(bid);
    for (int unit = bid; unit < 6144; unit += nblk) {
        DIL_DECODE(unit)
        const int q0 = u0 + 32 * wid, qtok = ((q0 + qc) << dsh) + cls;
        bf16x8 Qf[4];
#pragma unroll
        for (int s = 0; s < 4; ++s) Qf[s] = *(const bf16x8*)(qa + ((size_t)bh * kS + qtok) * 64 + 16 * s + 8 * h5);
        __syncthreads();
        if (!(VAR & 8)) {
#pragma unroll
        for (int it = 0; it < 6; ++it) { const int id = it * kNT + tid, row = id >> 3, ch = id & 7;
            *(LAS u32x4*)(Kimg + row * 128 + ((ch ^ (row & 7)) << 4)) = pK[it];
            *(LAS u32x4*)(Vimg + row * 128 + ((ch ^ (((row >> 1) & 1) << 2)) << 4)) = pV[it]; } }
        __syncthreads();
        if (!(VAR & 8) && unit + nblk < 6144) DIL_PREFETCH(unit + nblk);
        const float slope = exp2f(-(float)((bh & 7) + 1));
        const float c1 = 0.125f * kLog2e, c2 = slope * (float)(1 << dsh) * kLog2e;
        float sum = 0.f;
        f32x16 O[2];
#pragma unroll
        for (int dt = 0; dt < 2; ++dt)
#pragma unroll
            for (int i = 0; i < 16; ++i) O[dt][i] = 0.f;
#define DIL_QK(dst, kt_) do { _Pragma("unroll") for (int i = 0; i < 16; ++i) dst[i] = 0.f; \
            _Pragma("unroll") for (int s = 0; s < 4; ++s) { const bf16x8 Kf = *(const LAS bf16x8*)(Kimg + koff[s] + (kt_) * 4096); dst = __builtin_amdgcn_mfma_f32_32x32x16_bf16(Kf, Qf[s], dst, 0, 0, 0); } } while (0)
        f32x16 S, Sn;
        DIL_QK(S, 0);
        f32x2 sum2 = {0.f, 0.f};
        const float ndb = -dbase;
#pragma unroll
        for (int kt = 0; kt < 5; ++kt) {
            if (kt < 4) DIL_QK(Sn, kt + 1);
            const int kp0 = q0 - 64 + 32 * kt;
            const float tm = (kp0 >= 0 && kp0 < L) ? 0.f : -1e30f;
            const float cs = (kt < 2) ? c2 : -c2, c0 = ((kt == 0 || kt == 4) ? -64.f : (kt == 2 ? 0.f : -32.f)) * c2 - Mb + tm;
            const float bt = dbase * cs + c0;
#pragma unroll
            for (int i = 0; i < 16; i += 2) {
                const float k0 = (float)((i & 3) + 8 * (i >> 2)), k1 = (float)(((i + 1) & 3) + 8 * ((i + 1) >> 2));
                f32x2 t;
                if (kt == 2) { const f32x2 d = {fabsf(dbase + k0), fabsf(dbase + k1)}; t = d * cs + c0; }
                else t = (f32x2){k0, k1} * cs + bt;
                f32x2 sv = (f32x2){S[i], S[i + 1]} * c1 + t;
                if (kt == 0) { sv.x = (k0 >= ndb) ? sv.x : -1e30f; sv.y = (k1 >= ndb) ? sv.y : -1e30f; }
                if (kt == 4) { sv.x = (k0 <= ndb) ? sv.x : -1e30f; sv.y = (k1 <= ndb) ? sv.y : -1e30f; }
                f32x2 pv; pv.x = (VAR & 4) ? S[i] : __builtin_amdgcn_exp2f(sv.x); pv.y = (VAR & 4) ? S[i + 1] : __builtin_amdgcn_exp2f(sv.y);
                S[i] = pv.x; S[i + 1] = pv.y; sum2 += pv;
            }
            if (VAR & 2) { _Pragma("unroll") for (int i = 0; i < 16; ++i) O[0][i] += S[i]; }
            else
#pragma unroll
            for (int s2 = 0; s2 < 2; ++s2) {
                u32x4 pw; pw.x = pk2(S[8 * s2 + 0], S[8 * s2 + 1]); pw.y = pk2(S[8 * s2 + 2], S[8 * s2 + 3]); pw.z = pk2(S[8 * s2 + 4], S[8 * s2 + 5]); pw.w = pk2(S[8 * s2 + 6], S[8 * s2 + 7]);
                const bf16x8 Pf = __builtin_bit_cast(bf16x8, pw);
#pragma unroll
                for (int dt = 0; dt < 2; ++dt) { LAS unsigned char* vp = Vimg + voff[dt] + kt * 4096 + s2 * 2048;
                    const bf16x8 Vf = tr_pair(vp, vp + 1024);
                    O[dt] = __builtin_amdgcn_mfma_f32_32x32x16_bf16(Vf, Pf, O[dt], 0, 0, 0); }
            }
            if (kt < 4) S = Sn;
        }
#undef DIL_QK
        sum = sum2.x + sum2.y;
        sum += __shfl_xor(sum, 32);
        const float inv = 1.f / sum;
        const size_t tok = (size_t)(bh >> 3) * kS + qtok;
        if (VAR & 1) { float t = inv; _Pragma("unroll") for (int dt = 0; dt < 2; ++dt) _Pragma("unroll") for (int i = 0; i < 16; ++i) t += O[dt][i]; if (t == 1.2345e30f) lse[0] = t; }
        else {
        LAS unsigned char* ost = lds + 98304 + wid * 4096;
#pragma unroll
        for (int dt = 0; dt < 2; ++dt)
#pragma unroll
            for (int g4 = 0; g4 < 4; ++g4) { u32x2 w; w.x = pk2(O[dt][4 * g4] * inv, O[dt][4 * g4 + 1] * inv); w.y = pk2(O[dt][4 * g4 + 2] * inv, O[dt][4 * g4 + 3] * inv);
                *(LAS u32x2*)(ost + qc * 128 + (((4 * dt + g4) ^ (qc & 7)) << 4) + 8 * h5) = w; }
        if (h5 == 0) lse[((size_t)c * kTok + tok) * 8 + (bh & 7)] = Mn + __logf(sum);
        bf16_t* obase = oac + ((size_t)c * kTok + (size_t)(bh >> 3) * kS) * 512 + (bh & 7) * 64;
#pragma unroll
        for (int it = 0; it < 4; ++it) { const int r = it * 8 + (lane >> 3), ch = lane & 7;
            const u32x4 v = *(const LAS u32x4*)(ost + r * 128 + ((ch ^ (r & 7)) << 4));
            const size_t t2 = (size_t)(((q0 + r) << dsh) + cls);
            *(u32x4*)(obase + t2 * 512 + ch * 8) = v; }
        }
    }
#undef DIL_DECODE
#undef DIL_PREFETCH
    __syncthreads();
}
DEVI void phase_na(const bf16_t* qb, const bf16_t* kb, const bf16_t* vb, const float* rpb  , bf16_t* ob, LAS unsigned char* lds, int bid, int nblk) {
    const int tid = tidx(), wid = __builtin_amdgcn_readfirstlane(tid >> 6), lane = tid & 63, g4 = lane >> 4, i16 = lane & 15;
    LAS unsigned char* Kimg = lds; LAS unsigned char* Vimg = lds + 73728; LAS float* tab = (LAS float*)(lds + 147456);
    for (int i = tid; i < 4 * 465; i += kNT) tab[i] = rpb[i];
    const int g = wid & 3, kcs = (16 * g - 8) < 0 ? 0 : ((16 * g - 8) > 32 ? 32 : (16 * g - 8));
    const int qcol = 16 * g + i16, cs = (qcol - 8) < 0 ? 0 : ((qcol - 8) > 48 ? 48 : (qcol - 8));
    unsigned kswz[2];
#pragma unroll
    for (int s = 0; s < 2; ++s) kswz[s] = (unsigned)(((4 * s + g4) ^ (i16 & 7)) << 4);
    const int q = i16 >> 2, p = i16 & 3, sw = 2 * (g4 & 1) + (q >> 1);
    unsigned vsw[4];
#pragma unroll
    for (int dt = 0; dt < 4; ++dt) vsw[dt] = (unsigned)((((2 * dt + (p >> 1)) ^ (sw << 1)) << 4) + 8 * (p & 1));
    for (int unit = bid; unit < 2048; unit += nblk) {
        const int bh = unit >> 6, rp = unit & 63, r0 = 2 * rp, h = bh & 3;
        const int rsA = (r0 - 4) < 0 ? 0 : ((r0 - 4) > 120 ? 120 : (r0 - 4));
        const bf16_t* kbase = kb + (size_t)bh * kS * 64; const bf16_t* vbase = vb + (size_t)bh * kS * 64;
        __syncthreads();
#pragma unroll
        for (int it = 0; it < 9; ++it) {
            const int id = it * kNT + tid, row = id >> 3, ch = id & 7;
            int gr = rsA + (row >> 6); gr = gr > 127 ? 127 : gr;
            const size_t tok = (size_t)(gr * 64 + (row & 63));
            const u32x4 kv = *(const u32x4*)(kbase + tok * 64 + ch * 8), vv = *(const u32x4*)(vbase + tok * 64 + ch * 8);
            *(LAS u32x4*)(Kimg + row * 128 + ((ch ^ (row & 7)) << 4)) = kv;
            *(LAS u32x4*)(Vimg + row * 128 + ((ch ^ (((row >> 1) & 3) << 1)) << 4)) = vv;
        }
        __syncthreads();
        const int rr = r0 + (wid >> 2);
        const int rs = (rr - 4) < 0 ? 0 : ((rr - 4) > 120 ? 120 : (rr - 4)), ro = rs - rsA;
        const int qtok = rr * 64 + qcol;
        bf16x8 Qf[2];
#pragma unroll
        for (int s = 0; s < 2; ++s) Qf[s] = *(const bf16x8*)(qb + ((size_t)bh * kS + qtok) * 64 + 32 * s + 8 * g4);
        f32x4 S[16];
        const unsigned kb0 = (unsigned)((ro * 64 + kcs + i16) * 128);
#pragma unroll
        for (int t = 0; t < 16; ++t) { S[t] = (f32x4){0.f, 0.f, 0.f, 0.f};
#pragma unroll
            for (int s = 0; s < 2; ++s) { const bf16x8 Kf = *(const LAS bf16x8*)(Kimg + kb0 + (t >> 1) * 8192 + (t & 1) * 2048 + kswz[s]); S[t] = __builtin_amdgcn_mfma_f32_16x16x32_bf16(Kf, Qf[s], S[t], 0, 0, 0); } }
        float mx = -1e30f;
        const LAS float* th = tab + h * 465;
        int g4v = g4; asm volatile("" : "+v"(g4v));
#pragma unroll
        for (int t = 0; t < 16; ++t)
#pragma unroll
            for (int j = 0; j < 4; ++j) {
                const int krow = rs + (t >> 1), kcol = kcs + 16 * (t & 1) + 4 * g4v + j;
                const bool valid = (kcol >= cs) && (kcol < cs + 16);
                int dc = kcol - qcol + 15; dc = dc < 0 ? 0 : (dc > 30 ? 30 : dc);
                const float bias = th[(krow - rr + 7) * 31 + dc];
                const float sv = valid ? (S[t][j] * 0.125f + bias) * kLog2e : -1e30f;
                S[t][j] = sv; mx = fmaxf(mx, sv);
            }
        mx = fmaxf(mx, __shfl_xor(mx, 16)); mx = fmaxf(mx, __shfl_xor(mx, 32));
        float sum = 0.f;
#pragma unroll
        for (int t = 0; t < 16; ++t)
#pragma unroll
            for (int j = 0; j < 4; ++j) { const float pv = __builtin_amdgcn_exp2f(S[t][j] - mx); S[t][j] = pv; sum += pv; }
        sum += __shfl_xor(sum, 16); sum += __shfl_xor(sum, 32);
        f32x4 O[4];
#pragma unroll
        for (int dt = 0; dt < 4; ++dt) O[dt] = (f32x4){0.f, 0.f, 0.f, 0.f};
        const unsigned vb0 = (unsigned)((ro * 64 + kcs + 4 * g4 + q) * 128);
#pragma unroll
        for (int u = 0; u < 8; ++u) {
            u32x4 pw; pw.x = pk2(S[2 * u][0], S[2 * u][1]); pw.y = pk2(S[2 * u][2], S[2 * u][3]); pw.z = pk2(S[2 * u + 1][0], S[2 * u + 1][1]); pw.w = pk2(S[2 * u + 1][2], S[2 * u + 1][3]);
            const bf16x8 Pf = __builtin_bit_cast(bf16x8, pw);
#pragma unroll
            for (int dt = 0; dt < 4; ++dt) { LAS unsigned char* vp = Vimg + vb0 + u * 8192 + vsw[dt];
                const bf16x8 Vf = tr_pair(vp, vp + 2048);
                O[dt] = __builtin_amdgcn_mfma_f32_16x16x32_bf16(Vf, Pf, O[dt], 0, 0, 0); }
        }
        const float inv = 1.f / sum;
        bf16_t* orow = ob + ((size_t)(bh >> 2) * kS + qtok) * 256 + h * 64;
#pragma unroll
        for (int dt = 0; dt < 4; ++dt) { u32x2 w; w.x = pk2(O[dt][0] * inv, O[dt][1] * inv); w.y = pk2(O[dt][2] * inv, O[dt][3] * inv); *(u32x2*)(orow + 16 * dt + 4 * g4) = w; }
    }
    __syncthreads();
}
DEVI void phase_s5_naive(const Params& P, int l, const bf16_t* ux, float* ys, unsigned char* lds, int bid, int nblk) {
    const int wid = tidx() >> 6, lane = tidx() & 63;
    float* xs = (float*)lds + wid * 128;
    for (int item = wid * nblk + bid; item < kB * 16 * 2; item += nblk * 8) {
        const int dir = item & 1, g = (item >> 1) & 15, b = item >> 5;
        const size_t pbase = (((size_t)l * 2 + dir) * 16 + g) * 64;
        const float dt = __expf(P.s5_log_dt[((size_t)l * 2 + dir) * 16 + g]);
        const float a = fminf(P.s5_a_re[pbase + lane], -1e-4f), w = P.s5_a_im[pbase + lane];
        const float mag = __expf(a * dt), ar = mag * cosf(w * dt), ai = mag * sinf(w * dt);
        const float den = a * a + w * w, zr = ar - 1.f, gr = (zr * a + ai * w) / den, gi = (ai * a - zr * w) / den;
        float bbr[16], bbi[16];
#pragma unroll
        for (int c = 0; c < 16; ++c) { const float br = P.s5_b_re[(pbase + lane) * 16 + c], bi = P.s5_b_im[(pbase + lane) * 16 + c]; bbr[c] = gr * br - gi * bi; bbi[c] = gr * bi + gi * br; }
        const int cch = lane & 15, qt = lane >> 4;
        float cre[16], cim[16];
#pragma unroll
        for (int pp = 0; pp < 16; ++pp) { cre[pp] = P.s5_c_re[(pbase / 64 * 16 + cch) * 64 + qt * 16 + pp]; cim[pp] = P.s5_c_im[(pbase / 64 * 16 + cch) * 64 + qt * 16 + pp]; }
        float xr = 0.f, xi = 0.f;
        const bf16_t* ug = ux + (size_t)g * 4096 * 512;
        for (int st = 0; st < kS; ++st) {
            const int s = dir ? (kS - 1 - st) : st; const size_t tok = (size_t)b * kS + s;
            const bf16_t* up = ug + (tok >> 4) * 512 + (tok & 15) * 16;
            const u32x4 u0 = *(const u32x4*)up, u1 = *(const u32x4*)(up + 8);
            float uv[16];
            uv[0] = __uint_as_float(u0.x << 16); uv[1] = __uint_as_float(u0.x & 0xFFFF0000u); uv[2] = __uint_as_float(u0.y << 16); uv[3] = __uint_as_float(u0.y & 0xFFFF0000u);
            uv[4] = __uint_as_float(u0.z << 16); uv[5] = __uint_as_float(u0.z & 0xFFFF0000u); uv[6] = __uint_as_float(u0.w << 16); uv[7] = __uint_as_float(u0.w & 0xFFFF0000u);
            uv[8] = __uint_as_float(u1.x << 16); uv[9] = __uint_as_float(u1.x & 0xFFFF0000u); uv[10] = __uint_as_float(u1.y << 16); uv[11] = __uint_as_float(u1.y & 0xFFFF0000u);
            uv[12] = __uint_as_float(u1.z << 16); uv[13] = __uint_as_float(u1.z & 0xFFFF0000u); uv[14] = __uint_as_float(u1.w << 16); uv[15] = __uint_as_float(u1.w & 0xFFFF0000u);
            float bur = 0.f, bui = 0.f;
#pragma unroll
            for (int c = 0; c < 16; ++c) { bur += bbr[c] * uv[c]; bui += bbi[c] * uv[c]; }
            const float nr = ar * xr - ai * xi + bur, ni = ar * xi + ai * xr + bui; xr = nr; xi = ni;
            xs[lane] = xr; xs[64 + lane] = xi;
            asm volatile("s_waitcnt lgkmcnt(0)" ::: "memory");
            float y = 0.f;
#pragma unroll
            for (int pp = 0; pp < 16; ++pp) y += cre[pp] * xs[qt * 16 + pp] - cim[pp] * xs[64 + qt * 16 + pp];
            asm volatile("s_waitcnt lgkmcnt(0)" ::: "memory");
            y += __shfl_xor(y, 16); y += __shfl_xor(y, 32);
            if (lane < 16) ys[((size_t)dir * kTok + tok) * 256 + g * 16 + cch] = y;
        }
    }
}
DEVI void phase_s5_finish(const float* ys, const bf16_t* ux, const float* dskip, bf16_t* G, int bid, int nblk) {
    for (size_t i = (size_t)bid * kNT + tidx(); i < (size_t)kTok * 256; i += (size_t)nblk * kNT) {
        const size_t tok = i >> 8; const int ch = (int)(i & 255), g = ch >> 4, c = ch & 15;
        const float u = bf2f(ux[((size_t)g * 4096 + (tok >> 4)) * 512 + (tok & 15) * 16 + c]);
        const float y = ys[i] + ys[(size_t)kTok * 256 + i] + dskip[ch] * u;
        G[i] = f2bf(gelu_tanh(y));
    }
}
DEVI void unpk8(float* d, const u32x4 q, const float sc) {
    d[0] += sc * __uint_as_float(q.x << 16); d[1] += sc * __uint_as_float(q.x & 0xFFFF0000u); d[2] += sc * __uint_as_float(q.y << 16); d[3] += sc * __uint_as_float(q.y & 0xFFFF0000u);
    d[4] += sc * __uint_as_float(q.z << 16); d[5] += sc * __uint_as_float(q.z & 0xFFFF0000u); d[6] += sc * __uint_as_float(q.w << 16); d[7] += sc * __uint_as_float(q.w & 0xFFFF0000u);
}
DEVI void phase_mixnorm(const bf16_t* oac, const float* lse, const bf16_t* ob, const bf16_t* oc, const float* ga, const float* gb, const float* gc, bf16_t* mix, int bid, int nblk) {
    const int wid = tidx() >> 6, lane = tidx() & 63;
    float gn[16];
    { const float* gp = (lane < 32) ? ga + lane * 16 : (lane < 48) ? gb + (lane - 32) * 16 : gc + (lane - 48) * 16;
#pragma unroll
      for (int i = 0; i < 16; ++i) gn[i] = gp[i]; }
    for (int row = bid * 8 + wid; row < kTok; row += nblk * 8) {
        float v[16];
#pragma unroll
        for (int i = 0; i < 16; ++i) v[i] = 0.f;
        if (lane < 32) {
            const int h = lane >> 2;
            const float l0 = lse[(size_t)row * 8 + h], l1 = lse[((size_t)kTok + row) * 8 + h], l2 = lse[((size_t)2 * kTok + row) * 8 + h];
            const bf16_t* p0 = oac + (size_t)row * 512 + lane * 16; const bf16_t* p1 = p0 + (size_t)kTok * 512; const bf16_t* p2 = p1 + (size_t)kTok * 512;
            const u32x4 a0 = *(const u32x4*)p0, a1 = *(const u32x4*)(p0 + 8), b0 = *(const u32x4*)p1, b1 = *(const u32x4*)(p1 + 8), c0 = *(const u32x4*)p2, c1 = *(const u32x4*)(p2 + 8);
            const float mx = fmaxf(l0, fmaxf(l1, l2)); float w0 = __expf(l0 - mx), w1 = __expf(l1 - mx), w2 = __expf(l2 - mx); const float inv = frcp(w0 + w1 + w2); w0 *= inv; w1 *= inv; w2 *= inv;
            unpk8(v, a0, w0); unpk8(v + 8, a1, w0); unpk8(v, b0, w1); unpk8(v + 8, b1, w1); unpk8(v, c0, w2); unpk8(v + 8, c1, w2);
        } else {
            const bf16_t* p = (lane < 48) ? ob + (size_t)row * 256 + (lane - 32) * 16 : oc + (size_t)row * 256 + (lane - 48) * 16;
            const u32x4 a0 = *(const u32x4*)p, a1 = *(const u32x4*)(p + 8);
            unpk8(v, a0, 1.f); unpk8(v + 8, a1, 1.f);
        }
        float ss = 0.f;
#pragma unroll
        for (int i = 0; i < 16; ++i) ss += v[i] * v[i];
#pragma unroll
        for (int m = 1; m <= 8; m <<= 1) ss += __shfl_xor(ss, m);
        const float o16 = __shfl_xor(ss, 16);
        if (lane < 32) ss += o16;
        const float rstd = rsqrtf(ss * ((lane < 32) ? (1.f / 512.f) : (1.f / 256.f)) + kEps);
        if (EMU_FP8_WOUT) {
#pragma unroll
            for (int i = 0; i < 16; ++i) v[i] = q8(v[i] * rstd * gn[i], 1.f, 1.f) / (rstd * gn[i]);
        }
        u32x4 w0, w1;
        w0.x = pk2(v[0] * rstd * gn[0], v[1] * rstd * gn[1]); w0.y = pk2(v[2] * rstd * gn[2], v[3] * rstd * gn[3]); w0.z = pk2(v[4] * rstd * gn[4], v[5] * rstd * gn[5]); w0.w = pk2(v[6] * rstd * gn[6], v[7] * rstd * gn[7]);
        w1.x = pk2(v[8] * rstd * gn[8], v[9] * rstd * gn[9]); w1.y = pk2(v[10] * rstd * gn[10], v[11] * rstd * gn[11]); w1.z = pk2(v[12] * rstd * gn[12], v[13] * rstd * gn[13]); w1.w = pk2(v[14] * rstd * gn[14], v[15] * rstd * gn[15]);
        *(u32x4*)(mix + (size_t)row * kD + lane * 16) = w0; *(u32x4*)(mix + (size_t)row * kD + lane * 16 + 8) = w1;
    }
}
DEVI void unpk8s(float* d, const u32x4 q) {
    d[0] = __uint_as_float(q.x << 16); d[1] = __uint_as_float(q.x & 0xFFFF0000u); d[2] = __uint_as_float(q.y << 16); d[3] = __uint_as_float(q.y & 0xFFFF0000u);
    d[4] = __uint_as_float(q.z << 16); d[5] = __uint_as_float(q.z & 0xFFFF0000u); d[6] = __uint_as_float(q.w << 16); d[7] = __uint_as_float(q.w & 0xFFFF0000u);
}
DEVI void phase_combine(bf16_t* xb, float* out32, const bf16_t* y, const int* tokslot, const float* gain_next, bf16_t* h, int bid, int nblk) {
    const int wid = tidx() >> 6, lane = tidx() & 63;
    float g[16];
#pragma unroll
    for (int i = 0; i < 16; ++i) g[i] = gain_next ? gain_next[lane * 16 + i] : 0.f;
    const int stride = nblk * 8;
    int row = bid * 8 + wid;
    u32x4 nv0, nv1; int nts = 0;
    if (row < kTok) { nts = tokslot[(size_t)row * kE + (lane & 15)]; nv0 = *(const u32x4*)(xb + (size_t)row * kD + lane * 16); nv1 = *(const u32x4*)(xb + (size_t)row * kD + lane * 16 + 8); }
    for (; row < kTok; row += stride) {
        const int b = row >> 13;
        const int ts = nts;
        float v[16];
        unpk8s(v, nv0); unpk8s(v + 8, nv1);
        const int nrow = row + stride;
        if (nrow < kTok) { nts = tokslot[(size_t)nrow * kE + (lane & 15)]; nv0 = *(const u32x4*)(xb + (size_t)nrow * kD + lane * 16); nv1 = *(const u32x4*)(xb + (size_t)nrow * kD + lane * 16 + 8); }
#pragma unroll
        for (int e0 = 0; e0 < kE; e0 += 8) {
#if FP8_Y
            u32x4 yv[8];
#pragma unroll
            for (int e = 0; e < 8; ++e) { const int slot = __builtin_amdgcn_readlane(ts, e0 + e);
                if (slot >= 0) yv[e] = *(const u32x4*)((const unsigned char*)y + ((size_t)((e0 + e) * kB + b) * kCap + slot) * kD + lane * 16); }
#pragma unroll
            for (int e = 0; e < 8; ++e) { const int slot = __builtin_amdgcn_readlane(ts, e0 + e);
                if (slot >= 0) { const unsigned ww[4] = {yv[e].x, yv[e].y, yv[e].z, yv[e].w};
#pragma unroll
                    for (int k = 0; k < 4; ++k) { const f32x2 lo = __builtin_amdgcn_cvt_pk_f32_fp8(ww[k], false), hi = __builtin_amdgcn_cvt_pk_f32_fp8(ww[k], true);
                        v[4 * k] += lo.x * (1.f / kY8); v[4 * k + 1] += lo.y * (1.f / kY8); v[4 * k + 2] += hi.x * (1.f / kY8); v[4 * k + 3] += hi.y * (1.f / kY8); } } }
#else
            u32x4 yv[8][2];
#pragma unroll
            for (int e = 0; e < 8; ++e) { const int slot = __builtin_amdgcn_readlane(ts, e0 + e);
                if (slot >= 0) { const bf16_t* yr = y + ((size_t)((e0 + e) * kB + b) * kCap + slot) * kD + lane * 16; yv[e][0] = *(const u32x4*)yr; yv[e][1] = *(const u32x4*)(yr + 8); } }
#pragma unroll
            for (int e = 0; e < 8; ++e) { const int slot = __builtin_amdgcn_readlane(ts, e0 + e);
                if (slot >= 0) { unpk8(v, yv[e][0], 1.f); unpk8(v + 8, yv[e][1], 1.f); } }
#endif
        }
        if (!gain_next) {
#pragma unroll
            for (int k = 0; k < 4; ++k) *(f32x4*)(out32 + (size_t)row * kD + lane * 16 + 4 * k) = (f32x4){v[4 * k], v[4 * k + 1], v[4 * k + 2], v[4 * k + 3]};
        } else {
            u32x4 o0, o1;
            o0.x = pk2(v[0], v[1]); o0.y = pk2(v[2], v[3]); o0.z = pk2(v[4], v[5]); o0.w = pk2(v[6], v[7]); o1.x = pk2(v[8], v[9]); o1.y = pk2(v[10], v[11]); o1.z = pk2(v[12], v[13]); o1.w = pk2(v[14], v[15]);
            *(u32x4*)(xb + (size_t)row * kD + lane * 16) = o0; *(u32x4*)(xb + (size_t)row * kD + lane * 16 + 8) = o1;
            unpk8s(v, o0); unpk8s(v + 8, o1);
            float ss = 0.f;
#pragma unroll
            for (int i = 0; i < 16; ++i) ss += v[i] * v[i];
            ss = wave_sum(ss); const float rstd = rsqrtf(ss * (1.f / kD) + kEps);
            u32x4 h0, h1;
            h0.x = pk2(v[0] * rstd * g[0], v[1] * rstd * g[1]); h0.y = pk2(v[2] * rstd * g[2], v[3] * rstd * g[3]); h0.z = pk2(v[4] * rstd * g[4], v[5] * rstd * g[5]); h0.w = pk2(v[6] * rstd * g[6], v[7] * rstd * g[7]);
            h1.x = pk2(v[8] * rstd * g[8], v[9] * rstd * g[9]); h1.y = pk2(v[10] * rstd * g[10], v[11] * rstd * g[11]); h1.z = pk2(v[12] * rstd * g[12], v[13] * rstd * g[13]); h1.w = pk2(v[14] * rstd * g[14], v[15] * rstd * g[15]);
            *(u32x4*)(h + (size_t)row * kD + lane * 16) = h0; *(u32x4*)(h + (size_t)row * kD + lane * 16 + 8) = h1;
        }
    }
}

DEVI void cpow_m(double a, double w, double dt, int m, float& re, float& im) {
    const float mag = __expf((float)m * (float)a * (float)dt);
    const double turns = (double)m * w * dt * 0.15915494309189535; const float ang = (float)((turns - floor(turns)) * 6.283185307179586);
    re = mag * cosf(ang); im = mag * sinf(ang);
}
DEVI void s5_prep_item(const Params& P, int l, int g, unsigned char* lds_) {
    float* pw = (float*)lds_;
    float* bb = pw + 4352;
    float* cc = bb + 4096;
    float* kt = cc + 4096;
    const int tid = tidx();
    __syncthreads();
    for (int i = tid; i < 128; i += kNT) { const int dir = i >> 6, p = i & 63; const size_t pb = (((size_t)l * 2 + dir) * 16 + g) * 64 + p;
        const double dt = (double)__expf(P.s5_log_dt[((size_t)l * 2 + dir) * 16 + g]); const double a = (double)fminf(P.s5_a_re[pb], -1e-4f), w = (double)P.s5_a_im[pb];
        for (int m = 0; m < 17; ++m) { float re, im; cpow_m(a, w, dt, m, re, im); pw[((dir * 64 + p) * 17 + m) * 2] = re; pw[((dir * 64 + p) * 17 + m) * 2 + 1] = im; }
        const float af = (float)a, wf = (float)w, ar = pw[((dir * 64 + p) * 17 + 1) * 2], ai = pw[((dir * 64 + p) * 17 + 1) * 2 + 1];
        const float den = af * af + wf * wf, zr = ar - 1.f, gr = (zr * af + ai * wf) / den, gi = (ai * af - zr * wf) / den;
        for (int c = 0; c < 16; ++c) { const float br = P.s5_b_re[pb * 16 + c], bi = P.s5_b_im[pb * 16 + c]; bb[((dir * 64 + p) * 16 + c) * 2] = gr * br - gi * bi; bb[((dir * 64 + p) * 16 + c) * 2 + 1] = gr * bi + gi * br; }
    }
    for (int i = tid; i < 2048; i += kNT) { const int dir = i >> 10, c = (i >> 6) & 15, p = i & 63; const size_t o = ((((size_t)l * 2 + dir) * 16 + g) * 16 + c) * 64 + p; cc[i * 2] = P.s5_c_re[o]; cc[i * 2 + 1] = P.s5_c_im[o]; }
    __syncthreads();
    for (int i = tid; i < 8192; i += kNT) { const int dir = i >> 12, m = (i >> 8) & 15, c = (i >> 4) & 15, c2 = i & 15; float acc = 0.f;
        for (int p = 0; p < 64; ++p) { const float cr = cc[((dir * 16 + c) * 64 + p) * 2], ci = cc[((dir * 16 + c) * 64 + p) * 2 + 1], wr_ = pw[((dir * 64 + p) * 17 + m) * 2], wi_ = pw[((dir * 64 + p) * 17 + m) * 2 + 1];
            const float br = bb[((dir * 64 + p) * 16 + c2) * 2], bi = bb[((dir * 64 + p) * 16 + c2) * 2 + 1]; const float tr = cr * wr_ - ci * wi_, ti = cr * wi_ + ci * wr_; acc += tr * br - ti * bi; }
        kt[i] = acc; }
    __syncthreads();
    bf16_t* wst = (bf16_t*)(wsp(P) + WS_WST) + ((size_t)l * 16 + g) * 256 * 256;
    bf16_t* wso = (bf16_t*)(wsp(P) + WS_WSO) + ((size_t)l * 16 + g) * 256 * 512;
    for (int id = tid; id < 8192; id += kNT) { const int n = id >> 5, k0 = (id & 31) * 8, dir = n >> 7, p = (n >> 1) & 63, ri = n & 1; float v[8];
#pragma unroll
        for (int kk = 0; kk < 8; ++kk) { const int k = k0 + kk, t = k >> 4, c = k & 15, e = dir ? t : 15 - t; const float wr_ = pw[((dir * 64 + p) * 17 + e) * 2], wi_ = pw[((dir * 64 + p) * 17 + e) * 2 + 1], br = bb[((dir * 64 + p) * 16 + c) * 2], bi = bb[((dir * 64 + p) * 16 + c) * 2 + 1];
            v[kk] = ri ? (wr_ * bi + wi_ * br) : (wr_ * br - wi_ * bi); }
        u32x4 o; o.x = pk2(v[0], v[1]); o.y = pk2(v[2], v[3]); o.z = pk2(v[4], v[5]); o.w = pk2(v[6], v[7]); *(u32x4*)(wst + (size_t)n * 256 + k0) = o; }
    for (int id = tid; id < 16384; id += kNT) { const int ns = id >> 6, k0 = (id & 63) * 8, n = cmap_pk(ns), t = n >> 4, c = n & 15; float v[8];
#pragma unroll
        for (int kk = 0; kk < 8; ++kk) { const int k = k0 + kk; float x;
            if (k < 256) { const int j = k >> 4, c2 = k & 15; x = 0.f; if (j <= t) x += kt[(t - j) * 256 + c * 16 + c2]; if (j >= t) x += kt[4096 + (j - t) * 256 + c * 16 + c2]; if (j == t && c == c2) x += P.s5_d[l * 256 + g * 16 + c]; }
            else { const int q = k - 256, dir = q >> 7, p = (q >> 1) & 63, ri = q & 1, e = dir ? 16 - t : t + 1; const float cr = cc[((dir * 16 + c) * 64 + p) * 2], ci = cc[((dir * 16 + c) * 64 + p) * 2 + 1], wr_ = pw[((dir * 64 + p) * 17 + e) * 2], wi_ = pw[((dir * 64 + p) * 17 + e) * 2 + 1];
                x = ri ? -(cr * wi_ + ci * wr_) : (cr * wr_ - ci * wi_); }
            v[kk] = x; }
        u32x4 o; o.x = pk2(v[0], v[1]); o.y = pk2(v[2], v[3]); o.z = pk2(v[4], v[5]); o.w = pk2(v[6], v[7]); *(u32x4*)(wso + (size_t)ns * 512 + k0) = o; }
    __syncthreads();
}
DEVI void phase_s5_scan(const Params& P, int l, const float* Z, bf16_t* ux, unsigned char* lds_, int bid, int nblk) {
    const int tid = tidx(), wid = tid >> 6, lane = tid & 63;
    float* E = (float*)lds_;
    for (int item = bid; item < 256; item += nblk) {
        const int dir = item & 1, g = (item >> 1) & 15, b = item >> 5;
        const size_t pb = (((size_t)l * 2 + dir) * 16 + g) * 64 + lane;
        const double dt = (double)__expf(P.s5_log_dt[((size_t)l * 2 + dir) * 16 + g]); const double a = (double)fminf(P.s5_a_re[pb], -1e-4f), w = (double)P.s5_a_im[pb];
        float a16r, a16i, Ar, Ai; cpow_m(a, w, dt, 16, a16r, a16i); cpow_m(a, w, dt, 1024, Ar, Ai);
        const int kk0 = dir ? 511 - 64 * wid : 64 * wid; const long sstep = dir ? -1 : 1;
        const float* zp = Z + ((size_t)g * 4096 + b * 512 + kk0) * 256 + dir * 128 + 2 * lane;
        f32x2 z[64];
#pragma unroll
        for (int i = 0; i < 64; ++i) { z[i] = *(const f32x2*)zp; zp += sstep * 256; }
        float xr = 0.f, xi = 0.f;
#pragma unroll
        for (int i = 0; i < 64; ++i) { const float nr = a16r * xr - a16i * xi + z[i].x, ni = a16r * xi + a16i * xr + z[i].y; xr = nr; xi = ni; }
        __syncthreads();
        E[(wid * 64 + lane) * 2] = xr; E[(wid * 64 + lane) * 2 + 1] = xi;
        __syncthreads();
        float sr = 0.f, si = 0.f;
#pragma unroll
        for (int s2 = 0; s2 < 7; ++s2) if (s2 < wid) { const float er = E[(s2 * 64 + lane) * 2], ei = E[(s2 * 64 + lane) * 2 + 1]; const float nr = Ar * sr - Ai * si + er, ni = Ar * si + Ai * sr + ei; sr = nr; si = ni; }
        bf16_t* up = ux + ((size_t)g * 4096 + b * 512 + kk0) * 512 + 256 + dir * 128 + 2 * lane;
#pragma unroll
        for (int i = 0; i < 64; ++i) { *(unsigned*)up = pk2(sr, si); up += sstep * 512;
            const float nr = a16r * sr - a16i * si + z[i].x, ni = a16r * si + a16i * sr + z[i].y; sr = nr; si = ni; }
    }
    __syncthreads();
}
struct EpiF32N {
    static constexpr int VMOPS = 32;
    float* z; int ldz;
    DEVI void operator()(const f32x4 (&acc)[2][2][4][2], const Unit& u, int wr, int wc, int fr, int fq) const {
#pragma unroll
        for (int ai = 0; ai < 2; ++ai)
#pragma unroll
            for (int m = 0; m < 4; ++m) { const size_t ro = (size_t)(u.pm * 256 + 128 * ai + 64 * wr + 16 * m + fr) * ldz + u.pn * 256 + 32 * wc + 4 * fq;
#pragma unroll
                for (int bj = 0; bj < 2; ++bj)
#pragma unroll
                    for (int n = 0; n < 2; ++n) *(f32x4*)(z + ro + 128 * bj + 16 * n) = acc[ai][bj][m][n]; }
    }
};
struct EpiS5Out {
    static constexpr int VMOPS = 16;
    bf16_t* G;
    DEVI void operator()(const f32x4 (&acc)[2][2][4][2], const Unit& u, int wr, int wc, int fr, int fq) const {
#pragma unroll
        for (int ai = 0; ai < 2; ++ai)
#pragma unroll
            for (int m = 0; m < 4; ++m) { const int R = u.pm * 256 + 128 * ai + 64 * wr + 16 * m + fr, g = R >> 12, ck = R & 4095;
#pragma unroll
                for (int bj = 0; bj < 2; ++bj) { const int t = 8 * bj + 2 * wc + (fq >> 1), c0 = 8 * (fq & 1);
                    const f32x4 v0 = acc[ai][bj][m][0], v1 = acc[ai][bj][m][1];
                    u32x4 w; w.x = pk2(gelu_tanh(v0.x), gelu_tanh(v0.y)); w.y = pk2(gelu_tanh(v0.z), gelu_tanh(v0.w)); w.z = pk2(gelu_tanh(v1.x), gelu_tanh(v1.y)); w.w = pk2(gelu_tanh(v1.z), gelu_tanh(v1.w));
                    *(u32x4*)(G + ((size_t)ck * 16 + t) * 256 + g * 16 + c0) = w; } }
    }
};
#define XB_TMO      128
#define XB_XCNT(j)  (256  + 64 * (j))
#define XB_XSUB(j)  (1280 + 64 * (j))
#define XB_XGEN(j)  (2304 + 64 * (j))
#define XB_TOP      3328
#define XB_TOPGEN   3392
#define XCD_BAR_WORDS 3456
#define XB_SPIN_CAP (1u << 26)
DEVI unsigned xb_ld(unsigned* p)              { return __hip_atomic_load(p, __ATOMIC_RELAXED, __HIP_MEMORY_SCOPE_AGENT); }
DEVI unsigned xb_add(unsigned* p, unsigned v) { return __hip_atomic_fetch_add(p, v, __ATOMIC_RELAXED, __HIP_MEMORY_SCOPE_AGENT); }
DEVI unsigned xb_xcc_id() { return (unsigned)__builtin_amdgcn_s_getreg((3 << 11) | 20) & 0xFu; }
#define XB_SPIN(cond, bar) do { unsigned _sp = 0; while (cond) { __builtin_amdgcn_s_sleep(1); \
    if ((++_sp & 255u) == 0u) { if (xb_ld(&(bar)[XB_TMO])) break; if (_sp > XB_SPIN_CAP) { atomicAdd(&(bar)[XB_TMO], 1u); break; } } } } while (0)
struct XcdBarrier { unsigned* bar; unsigned x; volatile LAS unsigned* st; };
DEVI XcdBarrier xcd_barrier_post(unsigned* bar, volatile LAS unsigned* st) {
    XcdBarrier b; b.bar = bar; b.x = xb_xcc_id(); b.st = st;
    if (threadIdx.x == 0) (void)xb_add(&bar[XB_XCNT(b.x)], 1u);
    return b;
}
DEVI void xcd_barrier_complete(unsigned* bar, unsigned x, unsigned& nloc, unsigned& nx) {
    const unsigned G = gridDim.x * gridDim.y * gridDim.z;
    unsigned sum, cnt, mine, sp = 0u;
    for (;;) {
        sum = 0u; cnt = 0u; mine = 0u;
#pragma unroll
        for (unsigned j = 0; j < 16; ++j) { const unsigned c = xb_ld(&bar[XB_XCNT(j)]); sum += c; cnt += (c > 0u) ? 1u : 0u; mine = (j == x) ? c : mine; }
        if (sum == G) break;
        __builtin_amdgcn_s_sleep(1);
        if ((++sp & 255u) == 0u) { if (xb_ld(&bar[XB_TMO])) break; if (sp > XB_SPIN_CAP) { atomicAdd(&bar[XB_TMO], 1u); break; } }
    }
    nloc = mine > 0u ? mine : 1u; nx = cnt > 0u ? cnt : 1u;
}
DEVI void xcd_barrier(const XcdBarrier& b) {
    asm volatile("s_waitcnt vmcnt(0)" ::: "memory");
    __syncthreads();
    if (threadIdx.x == 0) {
        unsigned long long bp_ = (unsigned long long)b.bar; asm volatile("" : "+s"(bp_));
        unsigned* bar = (unsigned*)bp_;
        const unsigned bx = xb_xcc_id();
        __builtin_amdgcn_s_waitcnt(0);
        unsigned nloc = b.st[0], nx = b.st[1];
        if (nloc == 0u) { xcd_barrier_complete(bar, bx, nloc, nx); b.st[0] = nloc; b.st[1] = nx; }
        const unsigned old = xb_add(&bar[XB_XSUB(bx)], 1u);
        const unsigned gen = old / nloc;
        if (old + 1u == (gen + 1u) * nloc) {
            __builtin_amdgcn_fence(__ATOMIC_RELEASE, "agent");
            asm volatile("s_waitcnt vmcnt(0)" ::: "memory");
            const unsigned og = xb_add(&bar[XB_TOP], 1u);
            const unsigned tg = og / nx;
            if (og + 1u == (tg + 1u) * nx) xb_add(&bar[XB_TOPGEN], 1u);
            else XB_SPIN(xb_ld(&bar[XB_TOPGEN]) == tg, bar);
            __builtin_amdgcn_fence(__ATOMIC_ACQUIRE, "agent");
            xb_add(&bar[XB_XGEN(bx)], 1u);
            asm volatile("s_waitcnt vmcnt(0)" ::: "memory");
        } else {
            XB_SPIN(xb_ld(&bar[XB_XGEN(bx)]) == gen, bar);
            __builtin_amdgcn_fence(__ATOMIC_ACQUIRE, "agent");
            asm volatile("s_waitcnt vmcnt(0)" ::: "memory");
        }
    }
    __syncthreads();
}

#ifndef MEGA
#define MEGA 1
#endif
#ifndef USE_ENGINE
#define USE_ENGINE 1
#endif
constexpr int LDS_BYTES = 147456 + 8192 + 16;
#if USE_ENGINE
#define GEMM_RUN(g, E) gemm_engine<decltype(E), true, true>((LAS unsigned char*)dyn_lds, g, E, bid, nblk)
#define GEMM_RUN8(g, E) gemm_engine<decltype(E), true, true, true>((LAS unsigned char*)dyn_lds, g, E, bid, nblk)
#else
#define GEMM_RUN(g, E) gemm_simple(g, E, bid, nblk)
#endif
extern __shared__ __attribute__((aligned(16))) unsigned char dyn_lds[];

DEVI GemmD mk_gemm(const bf16_t* A, const bf16_t* Bt, int lda, int K, int nM, int nN, const int* rowidx, size_t bstride, int pmg) {
    GemmD g; g.A = A; g.Bt = Bt; g.lda = lda; g.K = K; g.nM = nM; g.nN = nN; g.rowidx = rowidx; g.bstride = bstride; g.pmg = pmg; return g; }

DEVI void ph_win(const Params& P, int l, int bid, int nblk) {
    const GemmD g = mk_gemm((const bf16_t*)(wsp(P) + WS_H), (const bf16_t*)(wsp(P) + WS_WINT) + (size_t)l * kINW * kD, kD, kD, kTok / 256, 10, nullptr, 0, 1 << 30);
    unsigned char* r1 = wsp(P) + WS_R1;
    EpiQKV E; E.qa = (bf16_t*)(r1 + R1_QA); E.ka = (bf16_t*)(r1 + R1_KA); E.va = (bf16_t*)(r1 + R1_VA); E.qb = (bf16_t*)(r1 + R1_QB); E.kb = (bf16_t*)(r1 + R1_KB); E.vb = (bf16_t*)(r1 + R1_VB); E.ux = (bf16_t*)(r1 + R1_UX);
    E.qna = P.q_norm_a + l * 64; E.kna = P.k_norm_a + l * 64; E.qnb = P.q_norm_b + l * 64; E.knb = P.k_norm_b + l * 64;
    GEMM_RUN(g, E);
}
#ifndef USE_MFMA_ATTN
#define USE_MFMA_ATTN 1
#endif
#ifndef USE_S5_GEMM
#define USE_S5_GEMM 1
#endif
#ifndef PROBE_ATTN
#define PROBE_ATTN 1
#endif
#ifndef PROBE_GU
#define PROBE_GU 1
#endif
#ifndef PROBE_DOWN
#define PROBE_DOWN 1
#endif
#ifndef PROBE_NA
#define PROBE_NA 1
#endif
#ifndef PROBE_MIX
#define PROBE_MIX 1
#endif
#ifndef PROBE_RT
#define PROBE_RT 1
#endif
#ifndef PROBE_TK
#define PROBE_TK 1
#endif
#ifndef PROBE_GUDRY
#define PROBE_GUDRY 0
#endif
#ifndef PROBE_DILVAR
#define PROBE_DILVAR 0
#endif
#ifndef PROBE_CONV
#define PROBE_CONV 1
#endif
DEVI void ph_dilated(const Params& P, int l, int bid, int nblk) { unsigned char* r1 = wsp(P) + WS_R1;
#if PROBE_DILVAR
    phase_dilated<PROBE_DILVAR>((const bf16_t*)(r1 + R1_QA), (const bf16_t*)(r1 + R1_KA), (const bf16_t*)(r1 + R1_VA), P.q_norm_a + l * 64, P.k_norm_a + l * 64, (bf16_t*)(wsp(P) + WS_R2), (float*)(wsp(P) + WS_LSE), (LAS unsigned char*)dyn_lds, bid, nblk);
#endif
#if USE_MFMA_ATTN
    phase_dilated((const bf16_t*)(r1 + R1_QA), (const bf16_t*)(r1 + R1_KA), (const bf16_t*)(r1 + R1_VA), P.q_norm_a + l * 64, P.k_norm_a + l * 64, (bf16_t*)(wsp(P) + WS_R2), (float*)(wsp(P) + WS_LSE), (LAS unsigned char*)dyn_lds, bid, nblk);
#else
    phase_dilated_naive((const bf16_t*)(r1 + R1_QA), (const bf16_t*)(r1 + R1_KA), (const bf16_t*)(r1 + R1_VA), (bf16_t*)(wsp(P) + WS_R2), (float*)(wsp(P) + WS_LSE), bid, nblk);
#endif
}
DEVI void ph_na(const Params& P, int l, int bid, int nblk) { unsigned char* r1 = wsp(P) + WS_R1;
#if USE_MFMA_ATTN
    phase_na((const bf16_t*)(r1 + R1_QB), (const bf16_t*)(r1 + R1_KB), (const bf16_t*)(r1 + R1_VB), P.rpb + (size_t)l * 4 * 15 * 31, (bf16_t*)(r1 + R1_OB), (LAS unsigned char*)dyn_lds, bid, nblk);
#else
    phase_na_naive((const bf16_t*)(r1 + R1_QB), (const bf16_t*)(r1 + R1_KB), (const bf16_t*)(r1 + R1_VB), P.rpb + (size_t)l * 4 * 15 * 31, (bf16_t*)(r1 + R1_OB), bid, nblk);
#endif
}
DEVI void ph_s5(const Params& P, int l, unsigned char* lds, int bid, int nblk) { phase_s5_naive(P, l, (const bf16_t*)(wsp(P) + WS_R1 + R1_UX), (float*)(wsp(P) + WS_YS), lds, bid, nblk); }
DEVI void ph_s5_prep(const Params& P, unsigned char* lds, int bid, int nblk) { for (int it = bid; it < kL * 16; it += nblk) s5_prep_item(P, it >> 4, it & 15, lds); }
DEVI void ph_s5_state(const Params& P, int l, int bid, int nblk) {
    const GemmD g = mk_gemm((const bf16_t*)(wsp(P) + WS_R1 + R1_UX), (const bf16_t*)(wsp(P) + WS_WST) + (size_t)l * 16 * 256 * 256, 512, 256, 256, 1, nullptr, (size_t)256 * 256, 16);
    EpiF32N E; E.z = (float*)(wsp(P) + WS_R2 + R2_Z); E.ldz = 256;
    GEMM_RUN(g, E);
}
DEVI void ph_s5_scan(const Params& P, int l, unsigned char* lds, int bid, int nblk) { phase_s5_scan(P, l, (const float*)(wsp(P) + WS_R2 + R2_Z), (bf16_t*)(wsp(P) + WS_R1 + R1_UX), lds, bid, nblk); }
DEVI void ph_s5_out(const Params& P, int l, int bid, int nblk) {
    const GemmD g = mk_gemm((const bf16_t*)(wsp(P) + WS_R1 + R1_UX), (const bf16_t*)(wsp(P) + WS_WSO) + (size_t)l * 16 * 256 * 512, 512, 512, 256, 1, nullptr, (size_t)256 * 512, 16);
    EpiS5Out E; E.G = (bf16_t*)(wsp(P) + WS_R1 + R1_G);
    GEMM_RUN(g, E);
}
DEVI void ph_s5fin(const Params& P, int l, int bid, int nblk) { phase_s5_finish((const float*)(wsp(P) + WS_YS), (const bf16_t*)(wsp(P) + WS_R1 + R1_UX), P.s5_d + l * 256, (bf16_t*)(wsp(P) + WS_R1 + R1_G), bid, nblk); }
DEVI void ph_glu(const Params& P, int l, int bid, int nblk) {
    const GemmD g = mk_gemm((const bf16_t*)(wsp(P) + WS_R1 + R1_G), (const bf16_t*)(wsp(P) + WS_WGLUT) + (size_t)l * 256 * 256, 256, 256, kTok / 256, 1, nullptr, 0, 1 << 30);
    EpiGlu E; E.g = (const bf16_t*)(wsp(P) + WS_R1 + R1_G); E.oc = (bf16_t*)(wsp(P) + WS_R1 + R1_OC);
    GEMM_RUN(g, E);
}
DEVI void ph_mixnorm(const Params& P, int l, int bid, int nblk) { unsigned char* r1 = wsp(P) + WS_R1;
    phase_mixnorm((const bf16_t*)(wsp(P) + WS_R2), (const float*)(wsp(P) + WS_LSE), (const bf16_t*)(r1 + R1_OB), (const bf16_t*)(r1 + R1_OC), P.out_norm_a + l * 512, P.out_norm_b + l * 256, P.out_norm_c + l * 256, (bf16_t*)(wsp(P) + WS_H), bid, nblk); }
DEVI void ph_wout(const Params& P, int l, int bid, int nblk) {
    const GemmD g = mk_gemm((const bf16_t*)(wsp(P) + WS_H), (const bf16_t*)(wsp(P) + WS_WOUTT) + (size_t)l * kD * kD, kD, kD, kTok / 256, 4, nullptr, 0, 1 << 30);
    EpiResid E; E.x32 = (l == 0) ? P.x : nullptr; E.xb = (bf16_t*)(wsp(P) + WS_XB);
    GEMM_RUN(g, E);
}
DEVI void ph_router(const Params& P, int l, unsigned char* lds, int bid, int nblk) { phase_router((const bf16_t*)(wsp(P) + WS_XB), P.ffn_norm + (size_t)l * kD, P.w_router + (size_t)l * kD * kE, (bf16_t*)(wsp(P) + WS_H), (float*)(wsp(P) + WS_AFF), lds, bid, nblk); }
DEVI void ph_topk(const Params& P, unsigned char* lds, int bid, int nblk) { phase_topk((const float*)(wsp(P) + WS_AFF), (int*)(wsp(P) + WS_IDX), (float*)(wsp(P) + WS_GATE), (int*)(wsp(P) + WS_TSLOT), wsp(P) + WS_H, wsp(P) + WS_R2, FP8_GU ? kD : kD * 2, lds, bid, nblk); }
DEVI void ph_gu(const Params& P, int l, int bid, int nblk) {
#if FP8_GU
    const GemmD g = mk_gemm((const bf16_t*)(wsp(P) + WS_R2), (const bf16_t*)(wsp(P) + WS_WGUT + (size_t)l * kE * 4096 * kD), kD, kD, 512, 16, nullptr, (size_t)4096 * kD, 32);
    EpiGU E; E.hid = (bf16_t*)(wsp(P) + WS_R1); E.sc = 1.f / kW8; E.nomath = false;
    GEMM_RUN8(g, E);
#else
    const GemmD g = mk_gemm((const bf16_t*)(wsp(P) + WS_R2), (const bf16_t*)(wsp(P) + WS_WGUT) + (size_t)l * kE * 4096 * kD, kD, kD, 512, 16, nullptr, (size_t)4096 * kD, 32);
    EpiGU E; E.hid = (bf16_t*)(wsp(P) + WS_R1); E.sc = 1.f; E.nomath = false;
    GEMM_RUN(g, E);
#endif
}
DEVI void ph_gu_dry(const Params& P, int l, int bid, int nblk) {
    const GemmD g = mk_gemm((const bf16_t*)(wsp(P) + WS_R2), (const bf16_t*)(wsp(P) + WS_WGUT + (size_t)l * kE * 4096 * kD), kD, kD, 512, 16, nullptr, (size_t)4096 * kD, 32);
#if PROBE_GUDRY == 2
    EpiGU E; E.hid = (bf16_t*)(wsp(P) + WS_R1); E.sc = 1.f / kW8; E.nomath = true;
#else
    EpiDry E; E.sink = (float*)(wsp(P) + WS_LSE);
#endif
    GEMM_RUN8(g, E);
}
DEVI void ph_down(const Params& P, int l, int bid, int nblk) {
#if FP8_DN
    const GemmD g = mk_gemm((const bf16_t*)(wsp(P) + WS_R1), (const bf16_t*)(wsp(P) + WS_WDT + (size_t)l * kE * kD * kFF), kFF, kFF, 512, 4, nullptr, (size_t)kD * kFF, 32);
    EpiDown E; E.y = (bf16_t*)(wsp(P) + WS_R2); E.gate = (const float*)(wsp(P) + WS_GATE); E.sc = 1.f / (kW8 * kH8);
    GEMM_RUN8(g, E);
#else
    const GemmD g = mk_gemm((const bf16_t*)(wsp(P) + WS_R1), (const bf16_t*)(wsp(P) + WS_WDT) + (size_t)l * kE * kD * kFF, kFF, kFF, 512, 4, nullptr, (size_t)kD * kFF, 32);
    EpiDown E; E.y = (bf16_t*)(wsp(P) + WS_R2); E.gate = (const float*)(wsp(P) + WS_GATE); E.sc = 1.f;
    GEMM_RUN(g, E);
#endif
}
DEVI void ph_combine(const Params& P, int l, int bid, int nblk) { phase_combine((bf16_t*)(wsp(P) + WS_XB), P.out, (const bf16_t*)(wsp(P) + WS_R2), (const int*)(wsp(P) + WS_TSLOT), (l + 1 < kL) ? P.attn_norm + (size_t)(l + 1) * kD : nullptr, (bf16_t*)(wsp(P) + WS_H), bid, nblk); }

typedef __attribute__((address_space(4))) const Params* CParams;
DEVI CParams kargs() { unsigned long long a = (unsigned long long)__builtin_amdgcn_kernarg_segment_ptr(); asm volatile("" : "+s"(a)); return (CParams)a; }
#if MEGA
__global__ void __launch_bounds__(kNT, 2) mega_fwd(Params P_) {
#define PK P_
    volatile LAS unsigned* st = (volatile LAS unsigned*)(dyn_lds + LDS_BYTES - 16);
    if (threadIdx.x == 0) { st[0] = 0u; st[1] = 0u; st[2] = 0u; st[3] = 0u; }
    __syncthreads();
    const XcdBarrier bar = xcd_barrier_post((unsigned*)(PK.ws + WS_CTL), st);
    const int bid = blockIdx.x, nblk = gridDim.x;
    unsigned char* lds = dyn_lds;
#pragma unroll 1
    for (int rep = 0; rep < PROBE_CONV; ++rep)
    phase_convert(PK, lds, lnd(bid), nblk);
#if USE_S5_GEMM
    ph_s5_prep(PK, lds, lnd(bid), nblk);
#endif
    phase_norm(PK.x, PK.attn_norm, (bf16_t*)(PK.ws + WS_H), lnd(bid), nblk);
    xcd_barrier(bar);
#pragma unroll 1
    for (int l = 0; l < kL; ++l) {
        ph_win(PK, l, lnd(bid), nblk);            xcd_barrier(bar);
#if USE_S5_GEMM
        ph_s5_state(PK, l, lnd(bid), nblk);       xcd_barrier(bar);
        ph_s5_scan(PK, l, lds, lnd(bid), nblk);
#pragma unroll 1
        for (int rep = 0; rep < PROBE_ATTN; ++rep)
        ph_dilated(PK, l, lnd(bid), nblk);
#pragma unroll 1
        for (int rep = 0; rep < PROBE_NA; ++rep)
        ph_na(PK, l, lnd(bid), nblk);             xcd_barrier(bar);
        ph_s5_out(PK, l, lnd(bid), nblk);         xcd_barrier(bar);
#else
        ph_s5(PK, l, lds, lnd(bid), nblk);
        ph_dilated(PK, l, lnd(bid), nblk);
        ph_na(PK, l, lnd(bid), nblk);             xcd_barrier(bar);
        ph_s5fin(PK, l, lnd(bid), nblk);          xcd_barrier(bar);
#endif
        ph_glu(PK, l, lnd(bid), nblk);            xcd_barrier(bar);
#pragma unroll 1
        for (int rep = 0; rep < PROBE_MIX; ++rep) {
        ph_mixnorm(PK, l, lnd(bid), nblk);        xcd_barrier(bar); }
        ph_wout(PK, l, lnd(bid), nblk);           xcd_barrier(bar);
#pragma unroll 1
        for (int rep = 0; rep < PROBE_RT; ++rep) {
        ph_router(PK, l, lds, lnd(bid), nblk);    xcd_barrier(bar); }
#pragma unroll 1
        for (int rep = 0; rep < PROBE_TK; ++rep) {
        ph_topk(PK, lds, lnd(bid), nblk);         xcd_barrier(bar); }
#if PROBE_GUDRY
        ph_gu_dry(PK, l, lnd(bid), nblk);         xcd_barrier(bar);
#endif
#pragma unroll 1
        for (int rep = 0; rep < PROBE_GU; ++rep) {
        ph_gu(PK, l, lnd(bid), nblk);             xcd_barrier(bar); }
#pragma unroll 1
        for (int rep = 0; rep < PROBE_DOWN; ++rep) {
        ph_down(PK, l, lnd(bid), nblk);           xcd_barrier(bar); }
        ph_combine(PK, l, lnd(bid), nblk);        xcd_barrier(bar);
    }
#undef PK
}
#else
#define KB __global__ void __launch_bounds__(kNT, 2)
KB k_convert(Params P) { phase_convert(P, dyn_lds, blockIdx.x, gridDim.x); }
KB k_norm(Params P) { phase_norm(P.x, P.attn_norm, (bf16_t*)(P.ws + WS_H), blockIdx.x, gridDim.x); }
KB k_win(Params P, int l) { ph_win(P, l, blockIdx.x, gridDim.x); }
KB k_dilated(Params P, int l) { ph_dilated(P, l, blockIdx.x, gridDim.x); }
KB k_na(Params P, int l) { ph_na(P, l, blockIdx.x, gridDim.x); }
KB k_s5(Params P, int l) { ph_s5(P, l, dyn_lds, blockIdx.x, gridDim.x); }
KB k_s5fin(Params P, int l) { ph_s5fin(P, l, blockIdx.x, gridDim.x); }
KB k_glu(Params P, int l) { ph_glu(P, l, blockIdx.x, gridDim.x); }
KB k_mixnorm(Params P, int l) { ph_mixnorm(P, l, blockIdx.x, gridDim.x); }
KB k_wout(Params P, int l) { ph_wout(P, l, blockIdx.x, gridDim.x); }
KB k_router(Params P, int l) { ph_router(P, l, dyn_lds, blockIdx.x, gridDim.x); }
KB k_topk(Params P) { ph_topk(P, dyn_lds, blockIdx.x, gridDim.x); }
KB k_gu(Params P, int l) { ph_gu(P, l, blockIdx.x, gridDim.x); }
KB k_down(Params P, int l) { ph_down(P, l, blockIdx.x, gridDim.x); }
KB k_combine(Params P, int l) { ph_combine(P, l, blockIdx.x, gridDim.x); }
#endif

extern "C" void kernel_launch(void* const* d_in, const int* in_sizes, int n_in, void* d_out, int out_size, void* d_ws, size_t ws_size, hipStream_t stream) {
    (void)in_sizes; (void)n_in; (void)out_size;
    if (ws_size < WS_END) { fprintf(stderr, "workspace too small: %zu < %zu\n", ws_size, (size_t)WS_END); return; }
    Params P{};
    const float** pp = (const float**)&P;
    for (int i = 0; i < 26; ++i) pp[i] = (const float*)d_in[i];
    P.out = (float*)d_out; P.ws = (unsigned char*)d_ws;
#if MEGA
    static int grid = 0;
    if (!grid) {
        int dev = 0, cus = 0, per_cu = 0;
        (void)hipGetDevice(&dev);
        (void)hipDeviceGetAttribute(&cus, hipDeviceAttributeMultiprocessorCount, dev);
        (void)hipFuncSetAttribute((const void*)mega_fwd, hipFuncAttributeMaxDynamicSharedMemorySize, LDS_BYTES);
        (void)hipOccupancyMaxActiveBlocksPerMultiprocessor(&per_cu, (const void*)mega_fwd, kNT, LDS_BYTES);
        grid = (per_cu >= 1) ? cus : 0;
        if (!grid) fprintf(stderr, "mega_fwd does not fit a CU\n");
    }
    if (!grid) return;
    (void)hipMemsetAsync(P.ws + WS_CTL, 0, XCD_BAR_WORDS * sizeof(unsigned), stream);
    mega_fwd<<<grid, kNT, LDS_BYTES, stream>>>(P);
#else
    (void)hipFuncSetAttribute((const void*)k_router, hipFuncAttributeMaxDynamicSharedMemorySize, 65536);
    const int G = 1024;
    k_convert<<<G, kNT, 256 * 72 * 2, stream>>>(P);
    k_norm<<<G, kNT, 0, stream>>>(P);
    for (int l = 0; l < kL; ++l) {
        k_win<<<G, kNT, 0, stream>>>(P, l);
        k_dilated<<<G, kNT, 0, stream>>>(P, l);
        k_na<<<G, kNT, 0, stream>>>(P, l);
        k_s5<<<256, kNT, 8 * 128 * 4, stream>>>(P, l);
        k_s5fin<<<G, kNT, 0, stream>>>(P, l);
        k_glu<<<256, kNT, 0, stream>>>(P, l);
        k_mixnorm<<<G, kNT, 0, stream>>>(P, l);
        k_wout<<<G, kNT, 0, stream>>>(P, l);
        k_router<<<512, kNT, 65536, stream>>>(P, l);
        k_topk<<<128, kNT, 4096, stream>>>(P);
        k_gu<<<G, kNT, 0, stream>>>(P, l);
        k_down<<<G, kNT, 0, stream>>>(P, l);
        k_combine<<<G, kNT, 0, stream>>>(P, l);
    }
#endif
}
```

```cpp
#include <hip/hip_runtime.h>
#include <stdint.h>
#include <stdio.h>

#define DEVI __device__ __forceinline__
#define LAS __attribute__((address_space(3)))
typedef unsigned short bf16_t;
typedef short bf16x8 __attribute__((ext_vector_type(8)));
typedef float f32x4 __attribute__((ext_vector_type(4)));
typedef float f32x2 __attribute__((ext_vector_type(2)));
typedef unsigned u32x4 __attribute__((ext_vector_type(4)));
typedef unsigned u32x2 __attribute__((ext_vector_type(2)));

constexpr int kB = 8, kS = 8192, kD = 1024, kL = 4, kTok = kB * kS;
constexpr int kINW = 2560;
constexpr int kE = 16, kCap = 1024, kFF = 2048;
constexpr int kNT = 512;
constexpr float kEps = 1e-6f;
constexpr float kLog2e = 1.4426950408889634f, kLn2 = 0.6931471805599453f;

constexpr size_t MiB = 1024ull * 1024ull;
constexpr size_t WS_CTL   = 0;
constexpr size_t WS_WINT  = 1 * MiB;
constexpr size_t WS_WOUTT = WS_WINT + 20 * MiB;
constexpr size_t WS_WGLUT = WS_WOUTT + 8 * MiB;
constexpr size_t WS_WGUT  = WS_WGLUT + 1 * MiB;
constexpr size_t WS_WDT   = WS_WGUT + 512 * MiB;
constexpr size_t WS_H     = WS_WDT + 256 * MiB;
constexpr size_t WS_R1    = WS_H + 128 * MiB;
constexpr size_t WS_R2    = WS_R1 + 512 * MiB;
constexpr size_t WS_AFF   = WS_R2 + 256 * MiB;
constexpr size_t WS_IDX   = WS_AFF + 4 * MiB;
constexpr size_t WS_GATE  = WS_IDX + 1 * MiB;
constexpr size_t WS_TSLOT = WS_GATE + 1 * MiB;
constexpr size_t WS_LSE   = WS_TSLOT + 4 * MiB;
constexpr size_t WS_WST   = WS_LSE + 8 * MiB;
constexpr size_t WS_WSO   = WS_WST + 8 * MiB;
constexpr size_t WS_YS    = WS_WSO + 16 * MiB;
constexpr size_t WS_XB    = WS_YS;
constexpr size_t WS_END   = WS_YS + 128 * MiB;
constexpr size_t R2_Z     = 192 * MiB;
constexpr size_t R1_QA = 0, R1_KA = 64 * MiB, R1_VA = 128 * MiB, R1_QB = 192 * MiB, R1_KB = 224 * MiB, R1_VB = 256 * MiB,
                 R1_UX = 288 * MiB, R1_OB = 352 * MiB, R1_OC = 384 * MiB, R1_G = 416 * MiB;

struct Params {
    const float* x; const float* attn_norm; const float* w_in; const float* q_norm_a; const float* k_norm_a; const float* q_norm_b; const float* k_norm_b;
    const float* rpb; const float* s5_a_re; const float* s5_a_im; const float* s5_log_dt; const float* s5_b_re; const float* s5_b_im; const float* s5_c_re; const float* s5_c_im;
    const float* s5_d; const float* w_glu; const float* out_norm_a; const float* out_norm_b; const float* out_norm_c; const float* w_out; const float* ffn_norm;
    const float* w_router; const float* w_gate; const float* w_up; const float* w_down;
    float* out; unsigned char* ws;
};

DEVI float bf2f(bf16_t b) { return __uint_as_float(((unsigned)b) << 16); }
DEVI bf16_t f2bf(float f) { unsigned u = __float_as_uint(f); u += 0x7FFFu + ((u >> 16) & 1u); return (bf16_t)(u >> 16); }
typedef __bf16 bf16x2_t __attribute__((ext_vector_type(2)));
DEVI unsigned pk2(float lo, float hi) { const f32x2 v = {lo, hi}; return __builtin_bit_cast(unsigned, __builtin_convertvector(v, bf16x2_t)); }
DEVI int tidx() { int t = threadIdx.x; asm volatile("" : "+v"(t)); return t; }
#define GAS __attribute__((address_space(1)))
DEVI unsigned char* wsp(const Params& P) { unsigned long long a = (unsigned long long)P.ws; asm volatile("" : "+s"(a)); return (unsigned char*)(GAS unsigned char*)a; }
DEVI int lnd(int v) { asm volatile("" : "+s"(v)); return v; }
template <int CTRL> DEVI float dppf(float v) { return __builtin_bit_cast(float, __builtin_amdgcn_update_dpp(0, __builtin_bit_cast(int, v), CTRL, 0xF, 0xF, true)); }
DEVI void swap16(float& a, float& b) { asm volatile("s_nop 1\n\tv_permlane16_swap_b32 %0, %1" : "+v"(a), "+v"(b)); }
DEVI void swap32(float& a, float& b) { asm volatile("s_nop 1\n\tv_permlane32_swap_b32 %0, %1" : "+v"(a), "+v"(b)); }
DEVI float xsum16(float v) { float a = v, b = v; swap16(a, b); return a + b; }
DEVI float xsum32(float v) { float a = v, b = v; swap32(a, b); return a + b; }
DEVI float xmax16(float v) { float a = v, b = v; swap16(a, b); return fmaxf(a, b); }
DEVI float xmax32(float v) { float a = v, b = v; swap32(a, b); return fmaxf(a, b); }
DEVI float row_sum16(float v) {
    v += dppf<0xB1>(v); v += dppf<0x4E>(v);
    v += dppf<0x141>(v); v += dppf<0x140>(v);
    return v;
}
DEVI float wave_sum(float v) { return xsum32(xsum16(row_sum16(v))); }
DEVI float frcp(float x) { return __builtin_amdgcn_rcpf(x); }
DEVI float gelu_tanh(float y) { const float z = 0.7978845608028654f * (y + 0.044715f * y * y * y); const float t = 1.f - 2.f * frcp(1.f + __expf(2.f * z)); return 0.5f * y * (1.f + t); }

#ifndef EMU_BF16_X
#define EMU_BF16_X 0
#endif
#ifndef EMU_FP8_WIN
#define EMU_FP8_WIN 0
#endif
#ifndef EMU_FP8_WOUT
#define EMU_FP8_WOUT 0
#endif
#ifndef EMU_FP8_GU
#define EMU_FP8_GU 0
#endif
#ifndef EMU_FP8_DN
#define EMU_FP8_DN 0
#endif
DEVI float q8(float x, float sc, float inv) {
    float y = x * sc; const float ay = fabsf(y);
    if (ay < 0.015625f) y = rintf(y * 512.f) * (1.f / 512.f);
    else { unsigned u = __float_as_uint(y); u += 0x7FFFFu + ((u >> 20) & 1u); u &= 0xFFF00000u; y = __uint_as_float(u); y = fminf(fmaxf(y, -448.f), 448.f); }
    return y * inv;
}
#ifndef FP8_GU
#define FP8_GU 1
#endif
#ifndef FP8_DN
#define FP8_DN 1
#endif
#ifndef FP8_Y
#define FP8_Y 1
#endif
constexpr float kY8 = 32.f;
constexpr float kW8 = 64.f, kH8 = 8.f;
DEVI unsigned pk4_fp8(float a, float b, float c, float d) { unsigned w = 0u; w = __builtin_amdgcn_cvt_pk_fp8_f32(a, b, w, false); w = __builtin_amdgcn_cvt_pk_fp8_f32(c, d, w, true); return w; }
DEVI int cmap_head(int cs) { const int bj = cs >> 7, wc = (cs >> 5) & 3, n = (cs >> 4) & 1, fq = (cs >> 2) & 3, j = cs & 3; return 64 * wc + 32 * bj + 8 * fq + 4 * n + j; }
DEVI int cmap_pk(int cs)   { const int bj = cs >> 7, wc = (cs >> 5) & 3, n = (cs >> 4) & 1, fq = (cs >> 2) & 3, j = cs & 3; return 128 * bj + 32 * wc + 8 * fq + 4 * n + j; }
DEVI int cmap_gu(int cs)   { const int wc = (cs >> 5) & 3, n = (cs >> 4) & 1, fq = (cs >> 2) & 3, j = cs & 3; return 32 * wc + 8 * fq + 4 * n + j; }

template <int MODE, int QEMU = 0>
DEVI void convert_item(const float* W0, const float* W1, int ldw, int K, bf16_t* Bt, int kt, int pn, unsigned char* lds) {
    bf16_t* t = (bf16_t*)lds;
    const int tid = tidx();
#pragma unroll 4
    for (int it = 0; it < 32; ++it) {
        const int e = it * kNT + tid, k = e >> 8, cs = e & 255;
        float v;
        if (MODE == 0) v = W0[(size_t)(kt * 64 + k) * ldw + pn * 256 + cs];
        else if (MODE == 1) v = W0[(size_t)(kt * 64 + k) * ldw + pn * 256 + cmap_head(cs)];
        else if (MODE == 2) v = W0[(size_t)(kt * 64 + k) * ldw + pn * 256 + cmap_pk(cs)];
        else v = ((cs >> 7) ? W1 : W0)[(size_t)(kt * 64 + k) * ldw + pn * 128 + cmap_gu(cs)];
        if (QEMU) v = q8(v, 64.f, 1.f / 64.f);
        t[cs * 72 + k] = f2bf(v);
    }
    __syncthreads();
#pragma unroll
    for (int it = 0; it < 4; ++it) {
        const int c = it * kNT + tid, row = c >> 3, part = c & 7;
        const u32x4 v = *(const u32x4*)(t + row * 72 + part * 8);
        *(u32x4*)(Bt + (size_t)(pn * 256 + row) * K + kt * 64 + part * 8) = v;
    }
    __syncthreads();
}

template <int MODE>
DEVI void convert_item8(const float* W0, const float* W1, int ldw, int K, unsigned char* Bt, int kt, int pn, unsigned char* lds) {
    unsigned char* t = lds;
    const int tid = tidx();
#pragma unroll 4
    for (int it = 0; it < 64; ++it) {
        const int e = it * kNT + tid, k = e >> 8, cs = e & 255;
        float v;
        if (MODE == 2) v = W0[(size_t)(kt * 128 + k) * ldw + pn * 256 + cmap_pk(cs)];
        else v = ((cs >> 7) ? W1 : W0)[(size_t)(kt * 128 + k) * ldw + pn * 128 + cmap_gu(cs)];
        v *= kW8;
        t[cs * 144 + k] = (unsigned char)(__builtin_amdgcn_cvt_pk_fp8_f32(v, v, 0u, false) & 0xFFu);
    }
    __syncthreads();
#pragma unroll
    for (int it = 0; it < 4; ++it) {
        const int c = it * kNT + tid, row = c >> 3, part = c & 7;
        const u32x4 v = *(const u32x4*)(t + row * 144 + part * 16);
        *(u32x4*)(Bt + (size_t)(pn * 256 + row) * K + kt * 128 + part * 16) = v;
    }
    __syncthreads();
}

DEVI void phase_convert(const Params& P, unsigned char* lds, int bid, int nblk) {
    constexpr int N_WIN = kL * 16 * 10, N_WOUT = kL * 16 * 4, N_WGLU = kL * 4 * 1, N_WGU = kL * kE * (FP8_GU ? 8 : 16) * 16, N_WD = kL * kE * (FP8_DN ? 16 : 32) * 4;
    constexpr int TOT = N_WIN + N_WOUT + N_WGLU + N_WGU + N_WD;
    for (int it = bid; it < TOT; it += nblk) {
        int i = it;
        if (i < N_WIN) { const int l = i / 160, r = i % 160, kt = r / 10, pn = r % 10;
            convert_item<1, EMU_FP8_WIN>(P.w_in + (size_t)l * kD * kINW, nullptr, kINW, kD, (bf16_t*)(wsp(P) + WS_WINT) + (size_t)l * kINW * kD, kt, pn, lds); continue; }
        i -= N_WIN;
        if (i < N_WOUT) { const int l = i / 64, r = i % 64, kt = r / 4, pn = r % 4;
            convert_item<2, EMU_FP8_WOUT>(P.w_out + (size_t)l * kD * kD, nullptr, kD, kD, (bf16_t*)(wsp(P) + WS_WOUTT) + (size_t)l * kD * kD, kt, pn, lds); continue; }
        i -= N_WOUT;
        if (i < N_WGLU) { const int l = i / 4, kt = i % 4;
            convert_item<2>(P.w_glu + (size_t)l * 256 * 256, nullptr, 256, 256, (bf16_t*)(wsp(P) + WS_WGLUT) + (size_t)l * 256 * 256, kt, 0, lds); continue; }
        i -= N_WGLU;
#if FP8_GU
        if (i < N_WGU) { const int le = i / 128, r = i % 128, kt = r / 16, pn = r % 16;
            convert_item8<3>(P.w_gate + (size_t)le * kD * kFF, P.w_up + (size_t)le * kD * kFF, kFF, kD, wsp(P) + WS_WGUT + (size_t)le * 4096 * kD, kt, pn, lds); continue; }
#else
        if (i < N_WGU) { const int le = i / 256, r = i % 256, kt = r / 16, pn = r % 16;
            convert_item<3, EMU_FP8_GU>(P.w_gate + (size_t)le * kD * kFF, P.w_up + (size_t)le * kD * kFF, kFF, kD, (bf16_t*)(wsp(P) + WS_WGUT) + (size_t)le * 4096 * kD, kt, pn, lds); continue; }
#endif
        i -= N_WGU;
#if FP8_DN
        { const int le = i / 64, r = i % 64, kt = r / 4, pn = r % 4;
            convert_item8<2>(P.w_down + (size_t)le * kFF * kD, nullptr, kD, kFF, wsp(P) + WS_WDT + (size_t)le * kD * kFF, kt, pn, lds); }
#else
        { const int le = i / 128, r = i % 128, kt = r / 4, pn = r % 4;
            convert_item<2, EMU_FP8_DN>(P.w_down + (size_t)le * kFF * kD, nullptr, kD, kFF, (bf16_t*)(wsp(P) + WS_WDT) + (size_t)le * kD * kFF, kt, pn, lds); }
#endif
    }
}

DEVI void phase_norm(const float* x, const float* gain, bf16_t* h, int bid, int nblk) {
    const int wid = tidx() >> 6, lane = tidx() & 63;
    f32x4 g[4];
#pragma unroll
    for (int q = 0; q < 4; ++q) g[q] = *(const f32x4*)(gain + q * 256 + lane * 4);
    for (int row = bid * 8 + wid; row < kTok; row += nblk * 8) {
        f32x4 v[4]; float ss = 0.f;
#pragma unroll
        for (int q = 0; q < 4; ++q) { v[q] = *(const f32x4*)(x + (size_t)row * kD + q * 256 + lane * 4); ss += v[q].x * v[q].x + v[q].y * v[q].y + v[q].z * v[q].z + v[q].w * v[q].w; }
        ss = wave_sum(ss);
        const float rstd = rsqrtf(ss * (1.f / kD) + kEps);
#pragma unroll
        for (int q = 0; q < 4; ++q) { f32x4 t = v[q] * rstd * g[q]; if (EMU_FP8_WIN) { t.x = q8(t.x, 1.f, 1.f); t.y = q8(t.y, 1.f, 1.f); t.z = q8(t.z, 1.f, 1.f); t.w = q8(t.w, 1.f, 1.f); }
            u32x2 o; o.x = pk2(t.x, t.y); o.y = pk2(t.z, t.w);
            *(u32x2*)(h + (size_t)row * kD + q * 256 + lane * 4) = o; }
    }
}

DEVI void phase_router(const bf16_t* x, const float* gain, const float* wr  , bf16_t* h, float* aff, unsigned char* lds, int bid, int nblk) {
    float* wT = (float*)lds;
    for (int i = tidx(); i < 16 * 1024; i += kNT) { const int k = i >> 4, e = i & 15; wT[e * 1024 + k] = wr[i]; }
    __syncthreads();
    const int wid = tidx() >> 6, lane = tidx() & 63;
    f32x4 g[4];
#pragma unroll
    for (int q = 0; q < 4; ++q) g[q] = *(const f32x4*)(gain + q * 256 + lane * 4);
    u32x2 nvx[2][4];
    { const int r0 = (bid * 8 + wid) * 2;
      if (r0 < kTok) {
#pragma unroll
        for (int r = 0; r < 2; ++r)
#pragma unroll
            for (int q = 0; q < 4; ++q) nvx[r][q] = *(const u32x2*)(x + (size_t)(r0 + r) * kD + q * 256 + lane * 4); } }
    for (int row0 = (bid * 8 + wid) * 2; row0 < kTok; row0 += nblk * 8 * 2) {
        asm volatile("" ::: "memory");
        f32x4 v[2][4];
#pragma unroll
        for (int r = 0; r < 2; ++r)
#pragma unroll
            for (int q = 0; q < 4; ++q) { const u32x2 w = nvx[r][q]; v[r][q] = (f32x4){__uint_as_float(w.x << 16), __uint_as_float(w.x & 0xFFFF0000u), __uint_as_float(w.y << 16), __uint_as_float(w.y & 0xFFFF0000u)}; }
        { const int nr0 = row0 + nblk * 8 * 2;
          if (nr0 < kTok) {
#pragma unroll
            for (int r = 0; r < 2; ++r)
#pragma unroll
                for (int q = 0; q < 4; ++q) nvx[r][q] = *(const u32x2*)(x + (size_t)(nr0 + r) * kD + q * 256 + lane * 4); } }
#pragma unroll
        for (int r = 0; r < 2; ++r) { float ss = 0.f;
#pragma unroll
            for (int q = 0; q < 4; ++q) { ss += v[r][q].x * v[r][q].x + v[r][q].y * v[r][q].y + v[r][q].z * v[r][q].z + v[r][q].w * v[r][q].w; }
            ss = wave_sum(ss); const float rstd = rsqrtf(ss * (1.f / kD) + kEps);
#pragma unroll
            for (int q = 0; q < 4; ++q) { v[r][q] = v[r][q] * rstd * g[q];
#if FP8_GU
                *(unsigned*)((unsigned char*)h + (size_t)(row0 + r) * kD + q * 256 + lane * 4) = pk4_fp8(v[r][q].x, v[r][q].y, v[r][q].z, v[r][q].w); }
#else
                u32x2 o;
                if (EMU_FP8_GU) { o.x = pk2(q8(v[r][q].x, 1.f, 1.f), q8(v[r][q].y, 1.f, 1.f)); o.y = pk2(q8(v[r][q].z, 1.f, 1.f), q8(v[r][q].w, 1.f, 1.f)); }
                else { o.x = pk2(v[r][q].x, v[r][q].y); o.y = pk2(v[r][q].z, v[r][q].w); }
                *(u32x2*)(h + (size_t)(row0 + r) * kD + q * 256 + lane * 4) = o; }
#endif
        }
        float pa[32];
#pragma unroll
        for (int e = 0; e < 16; ++e) {
            float s0 = 0.f, s1 = 0.f;
#pragma unroll
            for (int q = 0; q < 4; ++q) { const f32x4 w = *(const f32x4*)(wT + e * 1024 + q * 256 + lane * 4);
                s0 += v[0][q].x * w.x + v[0][q].y * w.y + v[0][q].z * w.z + v[0][q].w * w.w;
                s1 += v[1][q].x * w.x + v[1][q].y * w.y + v[1][q].z * w.z + v[1][q].w * w.w; }
            pa[e] = s0; pa[16 + e] = s1;
        }
#define RS_STEP(HALF, MASK) { const bool up = (lane & (MASK)) != 0; _Pragma("unroll") for (int i = 0; i < (HALF); ++i) { const float keep = up ? pa[i + (HALF)] : pa[i], send = up ? pa[i] : pa[i + (HALF)]; pa[i] = keep + __shfl_xor(send, (MASK)); } }
        RS_STEP(16, 32) RS_STEP(8, 16) RS_STEP(4, 8) RS_STEP(2, 4) RS_STEP(1, 2)
#undef RS_STEP
        const float logit = pa[0] + __shfl_xor(pa[0], 1);
        float mx = logit;
#pragma unroll
        for (int m = 16; m >= 2; m >>= 1) mx = fmaxf(mx, __shfl_xor(mx, m));
        const float ex = __expf(logit - mx);
        float sm = ex;
#pragma unroll
        for (int m = 16; m >= 2; m >>= 1) sm += __shfl_xor(sm, m);
        const int row = row0 + (lane >> 5), e = (lane >> 1) & 15, b = row >> 13, s = row & (kS - 1);
        if (!(lane & 1)) aff[((size_t)(b * kE + e)) * kS + s] = ex * frcp(sm);
    }
    __syncthreads();
}

DEVI int block_excl_scan(int v, int* sh  , int& total) {
    const int lane = tidx() & 63, wid = tidx() >> 6;
    int incl = v;
#pragma unroll
    for (int d = 1; d < 64; d <<= 1) { const int o = __shfl_up(incl, d); if (lane >= d) incl += o; }
    __syncthreads();
    if (lane == 63) sh[wid] = incl;
    __syncthreads();
    int base = 0, tot = 0;
#pragma unroll
    for (int w = 0; w < 8; ++w) { const int c = sh[w]; if (w < wid) base += c; tot += c; }
    total = tot;
    return base + incl - v;
}

DEVI void phase_topk(const float* aff, int* idx, float* gate, int* tokslot, const unsigned char* hsrc, unsigned char* xe, int rowbytes, unsigned char* lds, int bid, int nblk) {
    int* hist = (int*)lds;
    int* sh = hist + 256;
    int* res = sh + 16;
    int* lsel = res + 16;
    const int tid = tidx(), lane = tid & 63, wid = tid >> 6;
    const int share = (nblk >= 2 * kB * kE) ? 2 : 1;
    for (int wi = bid; wi < kB * kE * share; wi += nblk) {
        const int item = wi / share, part = wi - item * share;
        const int b = item >> 4, e = item & 15;
        const float* a = aff + (size_t)item * kS;
        unsigned key[16];
#pragma unroll
        for (int q = 0; q < 4; ++q) { const u32x4 v = *(const u32x4*)(a + tid * 16 + q * 4); key[q * 4 + 0] = v.x; key[q * 4 + 1] = v.y; key[q * 4 + 2] = v.z; key[q * 4 + 3] = v.w; }
        unsigned prefix = 0; int kk = kCap;
#pragma unroll 1
        for (int pass = 0; pass < 4; ++pass) {
            const int shift = 24 - 8 * pass;
            __syncthreads();
            if (tid < 256) hist[tid] = 0;
            __syncthreads();
#pragma unroll
            for (int i = 0; i < 16; ++i) { const bool in = (pass == 0) || ((key[i] >> (shift + 8)) == prefix); if (in) atomicAdd(&hist[(key[i] >> shift) & 255], 1); }
            __syncthreads();
            if (wid == 0) {
                int c[4], loc = 0;
#pragma unroll
                for (int j = 0; j < 4; ++j) { c[j] = hist[255 - 4 * lane - j]; loc += c[j]; }
                int incl = loc;
#pragma unroll
                for (int d = 1; d < 64; d <<= 1) { const int o = __shfl_up(incl, d); if (lane >= d) incl += o; }
                const int excl = incl - loc;
                if (excl < kk && kk <= incl) { int run = excl; int bin = 0, nk = 0; bool found = false;
#pragma unroll
                    for (int j = 0; j < 4; ++j) { if (!found && run + c[j] >= kk) { bin = 255 - 4 * lane - j; nk = kk - run; found = true; } if (!found) run += c[j]; }
                    res[0] = bin; res[1] = nk; }
            }
            __syncthreads();
            prefix = (prefix << 8) | (unsigned)res[0]; kk = res[1];
        }
        const unsigned T = prefix;
        int ceq = 0;
#pragma unroll
        for (int i = 0; i < 16; ++i) ceq += (key[i] == T) ? 1 : 0;
        int tot;
        int eqb = block_excl_scan(ceq, sh, tot);
        int csel = 0; unsigned selmask = 0;
#pragma unroll
        for (int i = 0; i < 16; ++i) { bool s = key[i] > T; if (key[i] == T) { s = eqb < kk; ++eqb; } if (s) { selmask |= 1u << i; ++csel; } }
        int slot = block_excl_scan(csel, sh, tot);
        const size_t rbase = (size_t)(e * kB + b) * kCap;
#pragma unroll
        for (int i = 0; i < 16; ++i) { const int s = tid * 16 + i; const bool sel = (selmask >> i) & 1u;
            if (sel) { if (part == 0) { idx[rbase + slot] = b * kS + s; gate[rbase + slot] = __uint_as_float(key[i]); } lsel[slot] = b * kS + s; }
            if (part == 0) tokslot[((size_t)(b * kS + s)) * kE + e] = sel ? slot : -1;
            if (sel) ++slot; }
        __syncthreads();
        { const int cpr = rowbytes >> 4;
          const int cbeg = part * (kCap / share) * cpr, cend = cbeg + (kCap / share) * cpr;
          for (int c0 = cbeg + tid; c0 < cend; c0 += kNT * 4) {
              u32x4 v[4];
#pragma unroll
              for (int j = 0; j < 4; ++j) { const int c = c0 + j * kNT; const int r = c / cpr, ch = c - r * cpr; v[j] = *(const u32x4*)(hsrc + (size_t)lsel[r] * rowbytes + ch * 16); }
#pragma unroll
              for (int j = 0; j < 4; ++j) { const int c = c0 + j * kNT; const int r = c / cpr, ch = c - r * cpr; *(u32x4*)(xe + (rbase + r) * rowbytes + ch * 16) = v[j]; }
          } }
    }
    __syncthreads();
}

struct Unit { int pm, pn; };
DEVI bool unit_of(int Lid, int nM, int nN, Unit& u) {
    const int nwg = nM * nN; if (Lid >= nwg) return false;
    int wgid = Lid; { const int q = nwg / 8, r = nwg % 8, xcd = wgid % 8, off = wgid / 8; wgid = (xcd < r ? xcd * (q + 1) : r * (q + 1) + (xcd - r) * q) + off; }
    const int nig = 8 * nN, gid = wgid / nig, fm = gid * 8, gsz = (nM - fm) < 8 ? (nM - fm) : 8;
    u.pm = fm + ((wgid % nig) % gsz); u.pn = (wgid % nig) / gsz; return true;
}
struct GemmD { const bf16_t* A; const bf16_t* Bt; int lda, K, nM, nN; const int* rowidx; size_t bstride; int pmg; int stagger_10ns; };

template <class Epi>
DEVI void gemm_simple(const GemmD g, const Epi& E, int bid, int nblk) {
    const int tid = tidx(), wid = tid >> 6, lane = tid & 63, wr = wid >> 2, wc = wid & 3, fr = lane & 15, fq = lane >> 4;
    for (int i = 0;; ++i) {
        Unit u; if (!unit_of(i * nblk + bid, g.nM, g.nN, u)) break;
        f32x4 acc[2][2][4][2];
#pragma unroll
        for (int a = 0; a < 2; ++a)
#pragma unroll
            for (int b = 0; b < 2; ++b)
#pragma unroll
                for (int m = 0; m < 4; ++m)
#pragma unroll
                    for (int n = 0; n < 2; ++n) acc[a][b][m][n] = (f32x4){0.f, 0.f, 0.f, 0.f};
        const bf16_t* Bu = g.Bt + (size_t)(u.pm / g.pmg) * g.bstride + (size_t)u.pn * 256 * g.K;
        unsigned ao[2][4], bo[2][2];
#pragma unroll
        for (int a = 0; a < 2; ++a)
#pragma unroll
            for (int m = 0; m < 4; ++m) { const int r = u.pm * 256 + 128 * a + 64 * wr + 16 * m + fr; const unsigned rr = g.rowidx ? (unsigned)g.rowidx[r] : (unsigned)r; ao[a][m] = rr * (unsigned)g.lda + 8u * fq; }
#pragma unroll
        for (int b = 0; b < 2; ++b)
#pragma unroll
            for (int n = 0; n < 2; ++n) bo[b][n] = (unsigned)(128 * b + 32 * wc + 16 * n + fr) * (unsigned)g.K + 8u * fq;
#pragma unroll 1
        for (int k0 = 0; k0 < g.K; k0 += 32) {
            bf16x8 av[2][4], bv[2][2];
#pragma unroll
            for (int a = 0; a < 2; ++a)
#pragma unroll
                for (int m = 0; m < 4; ++m) av[a][m] = *(const bf16x8*)(g.A + ao[a][m] + k0);
#pragma unroll
            for (int b = 0; b < 2; ++b)
#pragma unroll
                for (int n = 0; n < 2; ++n) bv[b][n] = *(const bf16x8*)(Bu + bo[b][n] + k0);
#pragma unroll
            for (int a = 0; a < 2; ++a)
#pragma unroll
                for (int b = 0; b < 2; ++b)
#pragma unroll
                    for (int m = 0; m < 4; ++m)
#pragma unroll
                        for (int n = 0; n < 2; ++n) acc[a][b][m][n] = __builtin_amdgcn_mfma_f32_16x16x32_bf16(bv[b][n], av[a][m], acc[a][b][m][n], 0, 0, 0);
        }
        E(acc, u, wr, wc, fr, fq);
    }
}


constexpr int PG_HTB = 128 * 64 * 2;
DEVI int pg_lds_byte(int r, int c) { const int st = (r >> 4) * 2 + (c >> 5), rr = r & 15, cc = c & 31, ob = rr * 64 + cc * 2; return st * 1024 + (ob ^ (((ob >> 9) & 1) << 5)); }
DEVI void pg_stage_rc(int b, int& R, int& C) { const int st = b / 1024, sb = b % 1024, swz = sb ^ (((sb >> 9) & 1) << 5); R = (st >> 1) * 16 + swz / 64; C = (st & 1) * 32 + (swz % 64) / 2; }

typedef int v4i __attribute__((ext_vector_type(4)));
typedef int v8i __attribute__((ext_vector_type(8)));
template <class Epi, bool ALIGN_EPI, bool SP2, bool FP8 = false>
DEVI void gemm_engine(LAS unsigned char* lds, const GemmD g, const Epi& E, int bid, int nblk) {
    const int tid = tidx(), wid = __builtin_amdgcn_readfirstlane(tid >> 6), lane = tid & 63, wr = wid >> 2, wc = wid & 3, fr = lane & 15, fq = lane >> 4;
    constexpr int ES = FP8 ? 1 : 2;
    const int K = g.K * ES  , nt = K / 128; const unsigned ldaB = (unsigned)g.lda * ES;
    unsigned voffA[2], voffB[2];
#pragma unroll
    for (int i = 0; i < 2; ++i) { int R, C; pg_stage_rc(tid * 16 + i * 8192, R, C); voffA[i] = (unsigned)R * ldaB + (unsigned)C * 2u; voffB[i] = (unsigned)(R * K + C * 2); }
    const size_t kstep = 128;
    const size_t hstepB = (size_t)128 * K, hstepA = (size_t)128 * ldaB, tstepA = 2 * hstepA;
    const unsigned ldsw = (unsigned)wid * 1024u;
    const int aoff = pg_lds_byte(wr * 64 + fr, fq * 8), boff = pg_lds_byte(wc * 32 + fr, fq * 8);
#define PG8_SA(b, h) (((b) * 2 + (h)) * PG_HTB)
#define PG8_SB(b, h) ((4 + (b) * 2 + (h)) * PG_HTB)
#define PG8_STAGE(bufoff, gbase, voff) do { _Pragma("unroll") for (int _i = 0; _i < 2; ++_i) \
        __builtin_amdgcn_global_load_lds((const unsigned*)((const char*)(gbase) + (voff)[_i]), (LAS unsigned*)(lds + (bufoff) + ldsw + _i * 8192), 16, 0, 0); } while (0)
#define PG8_RD16(off) (*(const LAS v4i*)(lds + (off)))
#define PG8_CAT2(off) __builtin_shufflevector(PG8_RD16(off), PG8_RD16((off) + 1024), 0, 1, 2, 3, 4, 5, 6, 7)
#define PG8_LDA(dst, b, h) do { _Pragma("unroll") for (int m = 0; m < 4; ++m) { if constexpr (FP8) dst##8[m] = PG8_CAT2(PG8_SA(b, h) + aoff + m * 2048); \
        else { _Pragma("unroll") for (int k = 0; k < 2; ++k) dst[m][k] = *(const LAS bf16x8*)(lds + PG8_SA(b, h) + aoff + m * 2048 + k * 1024); } } } while (0)
#define PG8_LDB(dst, b, h) do { _Pragma("unroll") for (int n = 0; n < 2; ++n) { if constexpr (FP8) dst##8[n] = PG8_CAT2(PG8_SB(b, h) + boff + n * 2048); \
        else { _Pragma("unroll") for (int k = 0; k < 2; ++k) dst[n][k] = *(const LAS bf16x8*)(lds + PG8_SB(b, h) + boff + n * 2048 + k * 1024); } } } while (0)
#define PG8_MMA(ai, bj, At, Bt) do { __builtin_amdgcn_s_setprio(1); _Pragma("unroll") for (int m = 0; m < 4; ++m) _Pragma("unroll") for (int n = 0; n < 2; ++n) { \
        if constexpr (FP8) asm volatile("v_mfma_f32_16x16x128_f8f6f4 %0, %1, %2, %0" : "+v"(acc[ai][bj][m][n]) : "v"(Bt##8[n]), "v"(At##8[m]));   \
        else { _Pragma("unroll") for (int k = 0; k < 2; ++k) acc[ai][bj][m][n] = __builtin_amdgcn_mfma_f32_16x16x32_bf16(Bt[n][k], At[m][k], acc[ai][bj][m][n], 0, 0, 0); } } \
        __builtin_amdgcn_s_setprio(0); } while (0)
#define PG8_WAIT_V(n) asm volatile("s_waitcnt vmcnt(" #n ")" ::: "memory")
#define PG8_WAIT_L(n) asm volatile("s_waitcnt lgkmcnt(" #n ")" ::: "memory")
#define PG8_BAR __builtin_amdgcn_s_barrier()
#define PG8_SCHED __builtin_amdgcn_sched_barrier(0)
    Unit cur, nxt; int ui = 0;
    if (!unit_of(bid, g.nM, g.nN, cur)) return;
    if (g.stagger_10ns) { const unsigned long long t0 = __builtin_amdgcn_s_memrealtime(), dt = (unsigned long long)(((bid >> 3) & 3) * g.stagger_10ns);
        while (__builtin_amdgcn_s_memrealtime() - t0 < dt) __builtin_amdgcn_s_sleep(8); }
    f32x4 acc[2][2][4][2];
#pragma unroll
    for (int a = 0; a < 2; ++a)
#pragma unroll
        for (int b = 0; b < 2; ++b)
#pragma unroll
            for (int m = 0; m < 4; ++m)
#pragma unroll
                for (int n = 0; n < 2; ++n) acc[a][b][m][n] = (f32x4){0.f, 0.f, 0.f, 0.f};
    bf16x8 At[4][2], B0[2][2], B1[2][2]; v8i At8[4], B08[2], B18[2];
    (void)At; (void)B0; (void)B1; (void)At8; (void)B08; (void)B18;
    static_assert(SP2, "only the two-super-phase K-loop is kept");
    const char* cA = (const char*)g.A + (size_t)cur.pm * tstepA;
    const char* cB = (const char*)g.Bt + (size_t)(cur.pm / g.pmg) * g.bstride * ES + (size_t)cur.pn * 256 * K;
    PG8_STAGE(PG8_SB(0, 0), cB, voffB); PG8_STAGE(PG8_SB(0, 1), cB + hstepB, voffB); PG8_STAGE(PG8_SA(0, 0), cA, voffA); PG8_STAGE(PG8_SA(0, 1), cA + hstepA, voffA);
    if (wr == 1) PG8_BAR;
    PG8_WAIT_V(2); PG8_BAR;
    PG8_STAGE(PG8_SB(1, 0), cB + kstep, voffB); PG8_STAGE(PG8_SA(1, 0), cA + kstep, voffA); PG8_STAGE(PG8_SB(1, 1), cB + hstepB + kstep, voffB);
    PG8_WAIT_V(6); PG8_BAR;
    for (;;) {
        const bool has_next = unit_of((ui + 1) * nblk + bid, g.nM, g.nN, nxt);
        const char* nA = has_next ? (const char*)g.A + (size_t)nxt.pm * tstepA : cA;
        const char* nB = has_next ? (const char*)g.Bt + (size_t)(nxt.pm / g.pmg) * g.bstride * ES + (size_t)nxt.pn * 256 * K : cB;
#pragma unroll 1
        for (int t = 0; t < nt; t += 2) {
            const bool last = (t == nt - 2);
            const char* a1 = cA + (size_t)(t + 1) * kstep;
            const char* a2 = last ? nA : cA + (size_t)(t + 2) * kstep; const char* b2 = last ? nB : cB + (size_t)(t + 2) * kstep;
            const char* a3 = a2 + kstep; const char* b3 = b2 + kstep;
            PG8_LDB(B0, 0, 0); PG8_LDB(B1, 0, 1); PG8_SCHED; PG8_LDA(At, 0, 0); PG8_STAGE(PG8_SA(1, 1), a1 + hstepA, voffA);
            PG8_WAIT_V(8); PG8_WAIT_L(0); PG8_BAR; PG8_MMA(0, 0, At, B0); PG8_MMA(0, 1, At, B1); PG8_BAR; PG8_SCHED;
            PG8_LDA(At, 0, 1); PG8_STAGE(PG8_SB(0, 0), b2, voffB); PG8_STAGE(PG8_SB(0, 1), b2 + hstepB, voffB); PG8_STAGE(PG8_SA(0, 0), a2, voffA);
            PG8_WAIT_V(8); PG8_WAIT_L(0); PG8_BAR; PG8_MMA(1, 0, At, B0); PG8_MMA(1, 1, At, B1); PG8_BAR; PG8_SCHED;
            PG8_LDB(B0, 1, 0); PG8_LDB(B1, 1, 1); PG8_SCHED; PG8_LDA(At, 1, 0); PG8_STAGE(PG8_SA(0, 1), a2 + hstepA, voffA);
            PG8_WAIT_V(8); PG8_WAIT_L(0); PG8_BAR; PG8_MMA(0, 0, At, B0); PG8_MMA(0, 1, At, B1); PG8_BAR; PG8_SCHED;
            PG8_LDA(At, 1, 1); PG8_STAGE(PG8_SB(1, 0), b3, voffB); PG8_STAGE(PG8_SB(1, 1), b3 + hstepB, voffB); PG8_STAGE(PG8_SA(1, 0), a3, voffA);
            PG8_WAIT_V(8); PG8_WAIT_L(0); PG8_BAR; PG8_MMA(1, 0, At, B0); PG8_MMA(1, 1, At, B1); PG8_BAR; PG8_SCHED;
        }
        if constexpr (ALIGN_EPI) { if (wr == 0) PG8_BAR; }
        if constexpr (FP8) asm volatile("s_nop 15\n\ts_nop 15" ::: "memory");
        E(acc, cur, wr, wc, fr, fq);
        if (!has_next) break;
#pragma unroll
        for (int a = 0; a < 2; ++a)
#pragma unroll
            for (int b = 0; b < 2; ++b)
#pragma unroll
                for (int m = 0; m < 4; ++m)
#pragma unroll
                    for (int n = 0; n < 2; ++n) acc[a][b][m][n] = (f32x4){0.f, 0.f, 0.f, 0.f};
        cur = nxt; cA = nA; cB = nB; ++ui;
        if constexpr (ALIGN_EPI) { if (wr == 1) PG8_BAR; }
    }
    PG8_WAIT_V(0);
    if constexpr (!ALIGN_EPI) { if (wr == 0) PG8_BAR; }
    PG8_BAR;
#undef PG8_SA
#undef PG8_SB
#undef PG8_STAGE
#undef PG8_LDA
#undef PG8_LDB
#undef PG8_MMA
#undef PG8_RD16
#undef PG8_CAT2
#undef PG8_WAIT_V
#undef PG8_WAIT_L
#undef PG8_BAR
#undef PG8_SCHED
}

struct EpiQKV {
    static constexpr int VMOPS = 16;
    bf16_t *qa, *ka, *va, *qb, *kb, *vb, *ux;
    int probe;
    const LAS float* gtab;
    DEVI void operator()(const f32x4 (&acc)[2][2][4][2], const Unit& u, int wr, int wc, int fr, int fq) const {
        const int pn = u.pn;
        bf16_t* dst = (pn < 2) ? qa : (pn < 4) ? ka : (pn < 6) ? va : (pn == 6) ? qb : (pn == 7) ? kb : (pn == 8) ? vb : ux;
        const int H = (pn < 6) ? 8 : 4, head = ((pn < 6) ? (pn & 1) * 4 : 0) + wc;
        const int trow = (pn < 2) ? 0 : (pn < 4) ? 1 : (pn == 6) ? 2 : (pn == 7) ? 3 : 4;
        const bool nrm = trow < 4;
        f32x4 gv[2][2];
#pragma unroll
        for (int bj = 0; bj < 2; ++bj)
#pragma unroll
            for (int n = 0; n < 2; ++n) gv[bj][n] = *(const LAS f32x4*)(gtab + trow * 64 + 32 * bj + 8 * fq + 4 * n);
        const size_t hb = (size_t)head * kS * 64 + 8 * fq;
        const int g0 = 4 * wc + (fq >> 1), c0 = 8 * (fq & 1);
#pragma unroll
        for (int ai = 0; ai < 2; ++ai)
#pragma unroll
            for (int m = 0; m < 4; ++m) {
                const int row = u.pm * 256 + 128 * ai + 64 * wr + 16 * m + fr;
                float ss = 0.f;
#pragma unroll
                for (int bj = 0; bj < 2; ++bj)
#pragma unroll
                    for (int n = 0; n < 2; ++n) { const f32x4 v = acc[ai][bj][m][n]; ss += v.x * v.x + v.y * v.y + v.z * v.z + v.w * v.w; }
                ss = xsum32(xsum16(ss));
                const float rs = (probe == 2) ? 1.f : __builtin_amdgcn_rsqf(ss * (1.f / 64.f) + kEps), rstd = nrm ? rs : 1.f;
                const int b = row >> 13, sq = row & (kS - 1);
                const size_t o_qkv = ((size_t)b * H * kS + sq) * 64 + hb, o_u = ((size_t)g0 * 4096 + (row >> 4)) * 512 + (row & 15) * 16 + c0;
#pragma unroll
                for (int bj = 0; bj < 2; ++bj) {
                    const f32x4 v0 = acc[ai][bj][m][0] * rstd * gv[bj][0], v1 = acc[ai][bj][m][1] * rstd * gv[bj][1];
                    u32x4 w; w.x = pk2(v0.x, v0.y); w.y = pk2(v0.z, v0.w); w.z = pk2(v1.x, v1.y); w.w = pk2(v1.z, v1.w);
                    const size_t o = (pn < 9) ? o_qkv + 32 * bj : o_u + (size_t)bj * 2 * 4096 * 512;
                    if (probe == 1) { if (w.x == 0x7FC12345u && w.y == 0x7FC12345u) *(u32x4*)(dst + o) = w; }
                    else *(u32x4*)(dst + o) = w;
                }
            }
    }
};
struct EpiResid {
    static constexpr int VMOPS = 16;
    const float* x32; bf16_t* xb;
    DEVI void operator()(const f32x4 (&acc)[2][2][4][2], const Unit& u, int wr, int wc, int fr, int fq) const {
#pragma unroll
        for (int ai = 0; ai < 2; ++ai)
#pragma unroll
            for (int m = 0; m < 4; ++m) { const size_t ro = (size_t)(u.pm * 256 + 128 * ai + 64 * wr + 16 * m + fr) * kD + u.pn * 256 + 32 * wc + 8 * fq;
#pragma unroll
                for (int bj = 0; bj < 2; ++bj) { const size_t o = ro + 128 * bj; f32x4 v0, v1;
                    if (x32) { v0 = *(const f32x4*)(x32 + o); v1 = *(const f32x4*)(x32 + o + 4); }
                    else { const u32x4 w = *(const u32x4*)(xb + o); v0 = (f32x4){__uint_as_float(w.x << 16), __uint_as_float(w.x & 0xFFFF0000u), __uint_as_float(w.y << 16), __uint_as_float(w.y & 0xFFFF0000u)};
                        v1 = (f32x4){__uint_as_float(w.z << 16), __uint_as_float(w.z & 0xFFFF0000u), __uint_as_float(w.w << 16), __uint_as_float(w.w & 0xFFFF0000u)}; }
                    v0 += acc[ai][bj][m][0]; v1 += acc[ai][bj][m][1];
                    u32x4 r; r.x = pk2(v0.x, v0.y); r.y = pk2(v0.z, v0.w); r.z = pk2(v1.x, v1.y); r.w = pk2(v1.z, v1.w);
                    *(u32x4*)(xb + o) = r; } }
    }
};
struct EpiGU {
    static constexpr int VMOPS = 8;
    bf16_t* hid; float sc; bool nomath;
    DEVI void operator()(const f32x4 (&acc)[2][2][4][2], const Unit& u, int wr, int wc, int fr, int fq) const {
#pragma unroll
        for (int ai = 0; ai < 2; ++ai)
#pragma unroll
            for (int m = 0; m < 4; ++m) { const size_t row = (size_t)(u.pm * 256 + 128 * ai + 64 * wr + 16 * m + fr);
                float o[8];
                const float k1 = -sc * kLog2e, k2 = sc * sc * (FP8_DN ? kH8 : 1.f);
#pragma unroll
                for (int n = 0; n < 2; ++n)
#pragma unroll
                    for (int j = 0; j < 4; j += 2) { const f32x2 a = {acc[ai][0][m][n][j], acc[ai][0][m][n][j + 1]}, b = {acc[ai][1][m][n][j], acc[ai][1][m][n][j + 1]};
                        const f32x2 ab = a * b, t = a * k1; f32x2 d; d.x = __builtin_amdgcn_exp2f(t.x); d.y = __builtin_amdgcn_exp2f(t.y); d = d + 1.f;
                        f32x2 r; r.x = frcp(d.x); r.y = frcp(d.y); const f32x2 v = nomath ? ab * k2 : (ab * r) * k2;
                        o[n * 4 + j] = v.x; o[n * 4 + j + 1] = v.y; }
#if FP8_DN
                u32x2 w;
#pragma unroll
                for (int t = 0; t < 8; ++t) o[t] = __builtin_amdgcn_fmed3f(o[t], -448.f, 448.f);
                w.x = pk4_fp8(o[0], o[1], o[2], o[3]); w.y = pk4_fp8(o[4], o[5], o[6], o[7]);
                *(u32x2*)((unsigned char*)hid + row * kFF + u.pn * 128 + 32 * wc + 8 * fq) = w;
#else
                u32x4 w; w.x = pk2(o[0], o[1]); w.y = pk2(o[2], o[3]); w.z = pk2(o[4], o[5]); w.w = pk2(o[6], o[7]);
                *(u32x4*)(hid + row * kFF + u.pn * 128 + 32 * wc + 8 * fq) = w;
#endif
            }
    }
};
struct EpiDry {
    static constexpr int VMOPS = 0;
    float* sink;
    DEVI void operator()(const f32x4 (&acc)[2][2][4][2], const Unit& u, int wr, int wc, int fr, int fq) const {
        float t = 0.f;
#pragma unroll
        for (int ai = 0; ai < 2; ++ai)
#pragma unroll
            for (int bj = 0; bj < 2; ++bj)
#pragma unroll
                for (int m = 0; m < 4; ++m)
#pragma unroll
                    for (int n = 0; n < 2; ++n) t += acc[ai][bj][m][n].x + acc[ai][bj][m][n].y + acc[ai][bj][m][n].z + acc[ai][bj][m][n].w;
        if (t == 1.2345e30f) sink[0] = t;
    }
};
struct EpiDown {
    static constexpr int VMOPS = 16;
    bf16_t* y; const float* gate; float sc;
    DEVI void operator()(const f32x4 (&acc)[2][2][4][2], const Unit& u, int wr, int wc, int fr, int fq) const {
#pragma unroll
        for (int ai = 0; ai < 2; ++ai)
#pragma unroll
            for (int m = 0; m < 4; ++m) { const size_t row = (size_t)(u.pm * 256 + 128 * ai + 64 * wr + 16 * m + fr); const float gv = sc * (FP8_Y ? kY8 : 1.f);
#pragma unroll
                for (int bj = 0; bj < 2; ++bj) { const f32x4 v0 = acc[ai][bj][m][0] * gv, v1 = acc[ai][bj][m][1] * gv;
#if FP8_Y
                    u32x2 w; w.x = pk4_fp8(__builtin_amdgcn_fmed3f(v0.x, -448.f, 448.f), __builtin_amdgcn_fmed3f(v0.y, -448.f, 448.f), __builtin_amdgcn_fmed3f(v0.z, -448.f, 448.f), __builtin_amdgcn_fmed3f(v0.w, -448.f, 448.f));
                    w.y = pk4_fp8(__builtin_amdgcn_fmed3f(v1.x, -448.f, 448.f), __builtin_amdgcn_fmed3f(v1.y, -448.f, 448.f), __builtin_amdgcn_fmed3f(v1.z, -448.f, 448.f), __builtin_amdgcn_fmed3f(v1.w, -448.f, 448.f));
                    *(u32x2*)((unsigned char*)y + row * kD + u.pn * 256 + 128 * bj + 32 * wc + 8 * fq) = w;
#else
                    u32x4 w; w.x = pk2(v0.x, v0.y); w.y = pk2(v0.z, v0.w); w.z = pk2(v1.x, v1.y); w.w = pk2(v1.z, v1.w);
                    *(u32x4*)(y + row * kD + u.pn * 256 + 128 * bj + 32 * wc + 8 * fq) = w;
#endif
                } }
    }
};
struct EpiGlu {
    static constexpr int VMOPS = 16;
    const bf16_t* g; bf16_t* oc;
    DEVI void operator()(const f32x4 (&acc)[2][2][4][2], const Unit& u, int wr, int wc, int fr, int fq) const {
#pragma unroll
        for (int ai = 0; ai < 2; ++ai)
#pragma unroll
            for (int m = 0; m < 4; ++m) { const size_t row = (size_t)(u.pm * 256 + 128 * ai + 64 * wr + 16 * m + fr);
#pragma unroll
                for (int bj = 0; bj < 2; ++bj) { const size_t o = row * 256 + 128 * bj + 32 * wc + 8 * fq;
                    const u32x4 gw = *(const u32x4*)(g + o); float o8[8];
#pragma unroll
                    for (int n = 0; n < 2; ++n)
#pragma unroll
                        for (int j = 0; j < 4; ++j) { const int t = n * 4 + j; const unsigned wv = (t < 2) ? gw.x : (t < 4) ? gw.y : (t < 6) ? gw.z : gw.w;
                            const float gg = __uint_as_float((t & 1) ? (wv & 0xFFFF0000u) : (wv << 16)); o8[t] = gg * frcp(1.f + __expf(-acc[ai][bj][m][n][j])); }
                    u32x4 w; w.x = pk2(o8[0], o8[1]); w.y = pk2(o8[2], o8[3]); w.z = pk2(o8[4], o8[5]); w.w = pk2(o8[6], o8[7]);
                    *(u32x4*)(oc + o) = w; } }
    }
};

DEVI void load_row64(const bf16_t* p, float* d) {
#pragma unroll
    for (int i = 0; i < 8; ++i) { const u32x4 v = *(const u32x4*)(p + i * 8);
        d[i * 8 + 0] = __uint_as_float(v.x << 16); d[i * 8 + 1] = __uint_as_float(v.x & 0xFFFF0000u); d[i * 8 + 2] = __uint_as_float(v.y << 16); d[i * 8 + 3] = __uint_as_float(v.y & 0xFFFF0000u);
        d[i * 8 + 4] = __uint_as_float(v.z << 16); d[i * 8 + 5] = __uint_as_float(v.z & 0xFFFF0000u); d[i * 8 + 6] = __uint_as_float(v.w << 16); d[i * 8 + 7] = __uint_as_float(v.w & 0xFFFF0000u); }
}
DEVI void store_row64(bf16_t* p, const float* d, float sc) {
#pragma unroll
    for (int i = 0; i < 8; ++i) { u32x4 w; w.x = pk2(d[i * 8] * sc, d[i * 8 + 1] * sc); w.y = pk2(d[i * 8 + 2] * sc, d[i * 8 + 3] * sc); w.z = pk2(d[i * 8 + 4] * sc, d[i * 8 + 5] * sc); w.w = pk2(d[i * 8 + 6] * sc, d[i * 8 + 7] * sc);
        *(u32x4*)(p + i * 8) = w; }
}
DEVI void phase_dilated_naive(const bf16_t* qa, const bf16_t* ka, const bf16_t* va, bf16_t* oac, float* lse, int bid, int nblk) {
    const int nitems = 3 * kB * 8 * (kS / kNT);
    for (int it = bid; it < nitems; it += nblk) {
        const int c = it / (kB * 8 * 16), r = it % (kB * 8 * 16), bh = r / 16, t = (r % 16) * kNT + tidx(), b = bh >> 3, h = bh & 7;
        const int dil = (c == 0) ? 1 : (c == 1) ? 4 : 16;
        const float slope = exp2f(-(float)(h + 1));
        const bf16_t* kb_ = ka + (size_t)bh * kS * 64; const bf16_t* vb_ = va + (size_t)bh * kS * 64;
        float q[64], o[64];
        load_row64(qa + ((size_t)bh * kS + t) * 64, q);
#pragma unroll
        for (int d = 0; d < 64; ++d) o[d] = 0.f;
        float m = -1e30f, l = 0.f;
        for (int rel = -64; rel <= 64; ++rel) {
            const int pos = t + rel * dil;
            if (pos < 0 || pos >= kS) continue;
            float kv[64]; load_row64(kb_ + (size_t)pos * 64, kv);
            float dot = 0.f;
#pragma unroll
            for (int d = 0; d < 64; ++d) dot += q[d] * kv[d];
            const float sc = dot * 0.125f - slope * (float)(dil * (rel < 0 ? -rel : rel));
            const float mn = fmaxf(m, sc), corr = __expf(m - mn), p = __expf(sc - mn);
            load_row64(vb_ + (size_t)pos * 64, kv);
            l = l * corr + p;
#pragma unroll
            for (int d = 0; d < 64; ++d) o[d] = o[d] * corr + p * kv[d];
            m = mn;
        }
        const size_t tok = (size_t)b * kS + t;
        store_row64(oac + ((size_t)c * kTok + tok) * 512 + h * 64, o, 1.f / l);
        lse[((size_t)c * kTok + tok) * 8 + h] = m + __logf(l);
    }
}
DEVI void phase_na_naive(const bf16_t* qb, const bf16_t* kbuf, const bf16_t* vbuf, const float* rpb  , bf16_t* ob, int bid, int nblk) {
    const int nitems = kB * 4 * (kS / kNT);
    for (int it = bid; it < nitems; it += nblk) {
        const int bh = it / 16, t = (it % 16) * kNT + tidx(), b = bh >> 2, h = bh & 3;
        const int r = t >> 6, cq = t & 63;
        int rs = r - 4; rs = rs < 0 ? 0 : (rs > 120 ? 120 : rs);
        int cs = cq - 8; cs = cs < 0 ? 0 : (cs > 48 ? 48 : cs);
        const bf16_t* kb_ = kbuf + (size_t)bh * kS * 64; const bf16_t* vb_ = vbuf + (size_t)bh * kS * 64;
        float q[64], o[64];
        load_row64(qb + ((size_t)bh * kS + t) * 64, q);
#pragma unroll
        for (int d = 0; d < 64; ++d) o[d] = 0.f;
        float m = -1e30f, l = 0.f;
        for (int kr = 0; kr < 8; ++kr)
            for (int kc = 0; kc < 16; ++kc) {
                const int krow = rs + kr, kcol = cs + kc, pos = krow * 64 + kcol;
                float kv[64]; load_row64(kb_ + (size_t)pos * 64, kv);
                float dot = 0.f;
#pragma unroll
                for (int d = 0; d < 64; ++d) dot += q[d] * kv[d];
                const float sc = dot * 0.125f + rpb[(h * 15 + (krow - r + 7)) * 31 + (kcol - cq + 15)];
                const float mn = fmaxf(m, sc), corr = __expf(m - mn), p = __expf(sc - mn);
                load_row64(vb_ + (size_t)pos * 64, kv);
                l = l * corr + p;
#pragma unroll
                for (int d = 0; d < 64; ++d) o[d] = o[d] * corr + p * kv[d];
                m = mn;
            }
        store_row64(ob + ((size_t)b * kS + t) * 256 + h * 64, o, 1.f / l);
    }
}

typedef float f32x16 __attribute__((ext_vector_type(16)));
typedef short s16x4 __attribute__((ext_vector_type(4)));
DEVI bf16x8 tr_pair(LAS unsigned char* p0, LAS unsigned char* p1) {
    const s16x4 a = __builtin_amdgcn_ds_read_tr16_b64_v4i16((LAS s16x4*)p0), b = __builtin_amdgcn_ds_read_tr16_b64_v4i16((LAS s16x4*)p1);
    return (bf16x8){a.x, a.y, a.z, a.w, b.x, b.y, b.z, b.w};
}
template <int VAR = 0>
DEVI void phase_dilated(const bf16_t* qa, const bf16_t* ka, const bf16_t* va, const float* gq, const float* gk, bf16_t* oac, float* lse, LAS unsigned char* lds, int bid, int nblk) {
    const int tid = tidx(), wid = __builtin_amdgcn_readfirstlane(tid >> 6), lane = tid & 63, h5 = lane >> 5, qc = lane & 31;
    LAS unsigned char* Kimg = lds; LAS unsigned char* Vimg = lds + 49152;
    float Mn;
    { float a = fabsf(gq[lane]), b = fabsf(gk[lane]);
#pragma unroll
      for (int m = 32; m >= 1; m >>= 1) { a = fmaxf(a, __shfl_xor(a, m)); b = fmaxf(b, __shfl_xor(b, m)); }
      Mn = 8.f * a * b; }
    const float Mb = Mn * kLog2e;
    unsigned koff[4];
#pragma unroll
    for (int s = 0; s < 4; ++s) koff[s] = (unsigned)((32 * wid + qc) * 128 + (((2 * s + h5) ^ (qc & 7)) << 4));
    unsigned voff[2];
    { const int g = lane >> 4, i16 = lane & 15, q = i16 >> 2, p = i16 & 3;
#pragma unroll
      for (int dt = 0; dt < 2; ++dt) { const int c = (2 * (g & 1) + (p >> 1) + 4 * dt) ^ ((q >> 1) << 2); voff[dt] = (unsigned)((32 * wid + 4 * h5 + q) * 128 + (c << 4) + 8 * (p & 1)); } }
    const float dbase = (float)(4 * h5 - qc);
    u32x4 pK[6], pV[6];
#define DIL_DECODE(unit_) const int c = (unit_) >> 11, rem = (unit_) & 2047, bh = rem >> 5, ub = rem & 31; \
        const int dsh = 2 * c, L = kS >> dsh, upc = 32 >> dsh, cls = ub >> (5 - dsh), u0 = (ub & (upc - 1)) << 8;
#define DIL_PREFETCH(unit_) do { DIL_DECODE(unit_) \
        const bf16_t* kbase = ka + (size_t)bh * kS * 64; const bf16_t* vbase = va + (size_t)bh * kS * 64; \
        _Pragma("unroll") for (int it = 0; it < 6; ++it) { const int id = it * kNT + tid, row = id >> 3, ch = id & 7; \
            int ki = u0 - 64 + row; ki = ki < 0 ? 0 : (ki > L - 1 ? L - 1 : ki); const size_t tok = (size_t)((ki << dsh) + cls); \
            pK[it] = *(const u32x4*)(kbase + tok * 64 + ch * 8); pV[it] = *(const u32x4*)(vbase + tok * 64 + ch * 8); } } while (0)
    if ((VAR & 8) || bid < 6144) DIL_PREFETCH(bid);
    for (int unit = bid; unit < 6144; unit += nblk) {
        DIL_DECODE(unit)
        const int q0 = u0 + 32 * wid, qtok = ((q0 + qc) << dsh) + cls;
        bf16x8 Qf[4];
#pragma unroll
        for (int s = 0; s < 4; ++s) Qf[s] = *(const bf16x8*)(qa + ((size_t)bh * kS + qtok) * 64 + 16 * s + 8 * h5);
        __syncthreads();
        if (!(VAR & 8)) {
#pragma unroll
        for (int it = 0; it < 6; ++it) { const int id = it * kNT + tid, row = id >> 3, ch = id & 7;
            *(LAS u32x4*)(Kimg + row * 128 + ((ch ^ (row & 7)) << 4)) = pK[it];
            *(LAS u32x4*)(Vimg + row * 128 + ((ch ^ (((row >> 1) & 1) << 2)) << 4)) = pV[it]; } }
        __syncthreads();
        if (!(VAR & 8) && unit + nblk < 6144) DIL_PREFETCH(unit + nblk);
        const float slope = exp2f(-(float)((bh & 7) + 1));
        const float c1 = 0.125f * kLog2e, c2 = slope * (float)(1 << dsh) * kLog2e;
        float sum = 0.f;
        f32x16 O[2];
#pragma unroll
        for (int dt = 0; dt < 2; ++dt)
#pragma unroll
            for (int i = 0; i < 16; ++i) O[dt][i] = 0.f;
#define DIL_QK(dst, kt_) do { _Pragma("unroll") for (int i = 0; i < 16; ++i) dst[i] = 0.f; \
            _Pragma("unroll") for (int s = 0; s < 4; ++s) { const bf16x8 Kf = *(const LAS bf16x8*)(Kimg + koff[s] + (kt_) * 4096); dst = __builtin_amdgcn_mfma_f32_32x32x16_bf16(Kf, Qf[s], dst, 0, 0, 0); } } while (0)
        f32x16 S, Sn;
        DIL_QK(S, 0);
        f32x2 sum2 = {0.f, 0.f};
        const float ndb = -dbase;
#pragma unroll
        for (int kt = 0; kt < 5; ++kt) {
            if (kt < 4) DIL_QK(Sn, kt + 1);
            const int kp0 = q0 - 64 + 32 * kt;
            const float tm = (kp0 >= 0 && kp0 < L) ? 0.f : -1e30f;
            const float cs = (kt < 2) ? c2 : -c2, c0 = ((kt == 0 || kt == 4) ? -64.f : (kt == 2 ? 0.f : -32.f)) * c2 - Mb + tm;
            const float bt = dbase * cs + c0;
#pragma unroll
            for (int i = 0; i < 16; i += 2) {
                const float k0 = (float)((i & 3) + 8 * (i >> 2)), k1 = (float)(((i + 1) & 3) + 8 * ((i + 1) >> 2));
                f32x2 t;
                if (kt == 2) { const f32x2 d = {fabsf(dbase + k0), fabsf(dbase + k1)}; t = d * cs + c0; }
                else t = (f32x2){k0, k1} * cs + bt;
                f32x2 sv = (f32x2){S[i], S[i + 1]} * c1 + t;
                if (kt == 0) { sv.x = (k0 >= ndb) ? sv.x : -1e30f; sv.y = (k1 >= ndb) ? sv.y : -1e30f; }
                if (kt == 4) { sv.x = (k0 <= ndb) ? sv.x : -1e30f; sv.y = (k1 <= ndb) ? sv.y : -1e30f; }
                f32x2 pv; pv.x = (VAR & 4) ? S[i] : __builtin_amdgcn_exp2f(sv.x); pv.y = (VAR & 4) ? S[i + 1] : __builtin_amdgcn_exp2f(sv.y);
                S[i] = pv.x; S[i + 1] = pv.y; sum2 += pv;
            }
            if (VAR & 2) { _Pragma("unroll") for (int i = 0; i < 16; ++i) O[0][i] += S[i]; }
            else
#pragma unroll
            for (int s2 = 0; s2 < 2; ++s2) {
                u32x4 pw; pw.x = pk2(S[8 * s2 + 0], S[8 * s2 + 1]); pw.y = pk2(S[8 * s2 + 2], S[8 * s2 + 3]); pw.z = pk2(S[8 * s2 + 4], S[8 * s2 + 5]); pw.w = pk2(S[8 * s2 + 6], S[8 * s2 + 7]);
                const bf16x8 Pf = __builtin_bit_cast(bf16x8, pw);
#pragma unroll
                for (int dt = 0; dt < 2; ++dt) { LAS unsigned char* vp = Vimg + voff[dt] + kt * 4096 + s2 * 2048;
                    const bf16x8 Vf = tr_pair(vp, vp + 1024);
                    O[dt] = __builtin_amdgcn_mfma_f32_32x32x16_bf16(Vf, Pf, O[dt], 0, 0, 0); }
            }
            if (kt < 4) S = Sn;
        }
#undef DIL_QK
        sum = sum2.x + sum2.y;
        sum = xsum32(sum);
        const float inv = 1.f / sum;
        const size_t tok = (size_t)(bh >> 3) * kS + qtok;
        if (VAR & 1) { float t = inv; _Pragma("unroll") for (int dt = 0; dt < 2; ++dt) _Pragma("unroll") for (int i = 0; i < 16; ++i) t += O[dt][i]; if (t == 1.2345e30f) lse[0] = t; }
        else {
        LAS unsigned char* ost = lds + 98304 + wid * 4096;
#pragma unroll
        for (int dt = 0; dt < 2; ++dt)
#pragma unroll
            for (int g4 = 0; g4 < 4; ++g4) { u32x2 w; w.x = pk2(O[dt][4 * g4] * inv, O[dt][4 * g4 + 1] * inv); w.y = pk2(O[dt][4 * g4 + 2] * inv, O[dt][4 * g4 + 3] * inv);
                *(LAS u32x2*)(ost + qc * 128 + (((4 * dt + g4) ^ (qc & 7)) << 4) + 8 * h5) = w; }
        if (h5 == 0) lse[((size_t)c * kTok + tok) * 8 + (bh & 7)] = Mn + __logf(sum);
        bf16_t* obase = oac + ((size_t)c * kTok + (size_t)(bh >> 3) * kS) * 512 + (bh & 7) * 64;
#pragma unroll
        for (int it = 0; it < 4; ++it) { const int r = it * 8 + (lane >> 3), ch = lane & 7;
            const u32x4 v = *(const LAS u32x4*)(ost + r * 128 + ((ch ^ (r & 7)) << 4));
            const size_t t2 = (size_t)(((q0 + r) << dsh) + cls);
            *(u32x4*)(obase + t2 * 512 + ch * 8) = v; }
        }
    }
#undef DIL_DECODE
#undef DIL_PREFETCH
    __syncthreads();
}
DEVI void phase_na(const bf16_t* qb, const bf16_t* kb, const bf16_t* vb, const float* rpb  , bf16_t* ob, LAS unsigned char* lds, int bid, int nblk) {
    const int tid = tidx(), wid = __builtin_amdgcn_readfirstlane(tid >> 6), lane = tid & 63, g4 = lane >> 4, i16 = lane & 15;
    LAS unsigned char* Kimg = lds; LAS unsigned char* Vimg = lds + 73728; LAS float* tab = (LAS float*)(lds + 147456);
    for (int i = tid; i < 4 * 465; i += kNT) tab[i] = rpb[i];
    const int g = wid & 3, kcs = (16 * g - 8) < 0 ? 0 : ((16 * g - 8) > 32 ? 32 : (16 * g - 8));
    const int qcol = 16 * g + i16, cs = (qcol - 8) < 0 ? 0 : ((qcol - 8) > 48 ? 48 : (qcol - 8));
    unsigned kswz[2];
#pragma unroll
    for (int s = 0; s < 2; ++s) kswz[s] = (unsigned)(((4 * s + g4) ^ (i16 & 7)) << 4);
    const int q = i16 >> 2, p = i16 & 3, sw = 2 * (g4 & 1) + (q >> 1);
    unsigned vsw[4];
#pragma unroll
    for (int dt = 0; dt < 4; ++dt) vsw[dt] = (unsigned)((((2 * dt + (p >> 1)) ^ (sw << 1)) << 4) + 8 * (p & 1));
    for (int unit = bid; unit < 2048; unit += nblk) {
        const int bh = unit >> 6, rp = unit & 63, r0 = 2 * rp, h = bh & 3;
        const int rsA = (r0 - 4) < 0 ? 0 : ((r0 - 4) > 120 ? 120 : (r0 - 4));
        const bf16_t* kbase = kb + (size_t)bh * kS * 64; const bf16_t* vbase = vb + (size_t)bh * kS * 64;
        __syncthreads();
#pragma unroll
        for (int it = 0; it < 9; ++it) {
            const int id = it * kNT + tid, row = id >> 3, ch = id & 7;
            int gr = rsA + (row >> 6); gr = gr > 127 ? 127 : gr;
            const size_t tok = (size_t)(gr * 64 + (row & 63));
            const u32x4 kv = *(const u32x4*)(kbase + tok * 64 + ch * 8), vv = *(const u32x4*)(vbase + tok * 64 + ch * 8);
            *(LAS u32x4*)(Kimg + row * 128 + ((ch ^ (row & 7)) << 4)) = kv;
            *(LAS u32x4*)(Vimg + row * 128 + ((ch ^ (((row >> 1) & 3) << 1)) << 4)) = vv;
        }
        __syncthreads();
        const int rr = r0 + (wid >> 2);
        const int rs = (rr - 4) < 0 ? 0 : ((rr - 4) > 120 ? 120 : (rr - 4)), ro = rs - rsA;
        const int qtok = rr * 64 + qcol;
        bf16x8 Qf[2];
#pragma unroll
        for (int s = 0; s < 2; ++s) Qf[s] = *(const bf16x8*)(qb + ((size_t)bh * kS + qtok) * 64 + 32 * s + 8 * g4);
        f32x4 S[16];
        const unsigned kb0 = (unsigned)((ro * 64 + kcs + i16) * 128);
#pragma unroll
        for (int t = 0; t < 16; ++t) { S[t] = (f32x4){0.f, 0.f, 0.f, 0.f};
#pragma unroll
            for (int s = 0; s < 2; ++s) { const bf16x8 Kf = *(const LAS bf16x8*)(Kimg + kb0 + (t >> 1) * 8192 + (t & 1) * 2048 + kswz[s]); S[t] = __builtin_amdgcn_mfma_f32_16x16x32_bf16(Kf, Qf[s], S[t], 0, 0, 0); } }
        float mx = -1e30f;
        const LAS float* th = tab + h * 465;
        int g4v = g4; asm volatile("" : "+v"(g4v));
#pragma unroll
        for (int t = 0; t < 16; ++t)
#pragma unroll
            for (int j = 0; j < 4; ++j) {
                const int krow = rs + (t >> 1), kcol = kcs + 16 * (t & 1) + 4 * g4v + j;
                const bool valid = (kcol >= cs) && (kcol < cs + 16);
                int dc = kcol - qcol + 15; dc = dc < 0 ? 0 : (dc > 30 ? 30 : dc);
                const float bias = th[(krow - rr + 7) * 31 + dc];
                const float sv = valid ? (S[t][j] * 0.125f + bias) * kLog2e : -1e30f;
                S[t][j] = sv; mx = fmaxf(mx, sv);
            }
        mx = xmax32(xmax16(mx));
        float sum = 0.f;
#pragma unroll
        for (int t = 0; t < 16; ++t)
#pragma unroll
            for (int j = 0; j < 4; ++j) { const float pv = __builtin_amdgcn_exp2f(S[t][j] - mx); S[t][j] = pv; sum += pv; }
        sum = xsum32(xsum16(sum));
        f32x4 O[4];
#pragma unroll
        for (int dt = 0; dt < 4; ++dt) O[dt] = (f32x4){0.f, 0.f, 0.f, 0.f};
        const unsigned vb0 = (unsigned)((ro * 64 + kcs + 4 * g4 + q) * 128);
#pragma unroll
        for (int u = 0; u < 8; ++u) {
            u32x4 pw; pw.x = pk2(S[2 * u][0], S[2 * u][1]); pw.y = pk2(S[2 * u][2], S[2 * u][3]); pw.z = pk2(S[2 * u + 1][0], S[2 * u + 1][1]); pw.w = pk2(S[2 * u + 1][2], S[2 * u + 1][3]);
            const bf16x8 Pf = __builtin_bit_cast(bf16x8, pw);
#pragma unroll
            for (int dt = 0; dt < 4; ++dt) { LAS unsigned char* vp = Vimg + vb0 + u * 8192 + vsw[dt];
                const bf16x8 Vf = tr_pair(vp, vp + 2048);
                O[dt] = __builtin_amdgcn_mfma_f32_16x16x32_bf16(Vf, Pf, O[dt], 0, 0, 0); }
        }
        const float inv = 1.f / sum;
        bf16_t* orow = ob + ((size_t)(bh >> 2) * kS + qtok) * 256 + h * 64;
#pragma unroll
        for (int dt = 0; dt < 4; ++dt) { u32x2 w; w.x = pk2(O[dt][0] * inv, O[dt][1] * inv); w.y = pk2(O[dt][2] * inv, O[dt][3] * inv); *(u32x2*)(orow + 16 * dt + 4 * g4) = w; }
    }
    __syncthreads();
}
DEVI void phase_s5_naive(const Params& P, int l, const bf16_t* ux, float* ys, unsigned char* lds, int bid, int nblk) {
    const int wid = tidx() >> 6, lane = tidx() & 63;
    float* xs = (float*)lds + wid * 128;
    for (int item = wid * nblk + bid; item < kB * 16 * 2; item += nblk * 8) {
        const int dir = item & 1, g = (item >> 1) & 15, b = item >> 5;
        const size_t pbase = (((size_t)l * 2 + dir) * 16 + g) * 64;
        const float dt = __expf(P.s5_log_dt[((size_t)l * 2 + dir) * 16 + g]);
        const float a = fminf(P.s5_a_re[pbase + lane], -1e-4f), w = P.s5_a_im[pbase + lane];
        const float mag = __expf(a * dt), ar = mag * cosf(w * dt), ai = mag * sinf(w * dt);
        const float den = a * a + w * w, zr = ar - 1.f, gr = (zr * a + ai * w) / den, gi = (ai * a - zr * w) / den;
        float bbr[16], bbi[16];
#pragma unroll
        for (int c = 0; c < 16; ++c) { const float br = P.s5_b_re[(pbase + lane) * 16 + c], bi = P.s5_b_im[(pbase + lane) * 16 + c]; bbr[c] = gr * br - gi * bi; bbi[c] = gr * bi + gi * br; }
        const int cch = lane & 15, qt = lane >> 4;
        float cre[16], cim[16];
#pragma unroll
        for (int pp = 0; pp < 16; ++pp) { cre[pp] = P.s5_c_re[(pbase / 64 * 16 + cch) * 64 + qt * 16 + pp]; cim[pp] = P.s5_c_im[(pbase / 64 * 16 + cch) * 64 + qt * 16 + pp]; }
        float xr = 0.f, xi = 0.f;
        const bf16_t* ug = ux + (size_t)g * 4096 * 512;
        for (int st = 0; st < kS; ++st) {
            const int s = dir ? (kS - 1 - st) : st; const size_t tok = (size_t)b * kS + s;
            const bf16_t* up = ug + (tok >> 4) * 512 + (tok & 15) * 16;
            const u32x4 u0 = *(const u32x4*)up, u1 = *(const u32x4*)(up + 8);
            float uv[16];
            uv[0] = __uint_as_float(u0.x << 16); uv[1] = __uint_as_float(u0.x & 0xFFFF0000u); uv[2] = __uint_as_float(u0.y << 16); uv[3] = __uint_as_float(u0.y & 0xFFFF0000u);
            uv[4] = __uint_as_float(u0.z << 16); uv[5] = __uint_as_float(u0.z & 0xFFFF0000u); uv[6] = __uint_as_float(u0.w << 16); uv[7] = __uint_as_float(u0.w & 0xFFFF0000u);
            uv[8] = __uint_as_float(u1.x << 16); uv[9] = __uint_as_float(u1.x & 0xFFFF0000u); uv[10] = __uint_as_float(u1.y << 16); uv[11] = __uint_as_float(u1.y & 0xFFFF0000u);
            uv[12] = __uint_as_float(u1.z << 16); uv[13] = __uint_as_float(u1.z & 0xFFFF0000u); uv[14] = __uint_as_float(u1.w << 16); uv[15] = __uint_as_float(u1.w & 0xFFFF0000u);
            float bur = 0.f, bui = 0.f;
#pragma unroll
            for (int c = 0; c < 16; ++c) { bur += bbr[c] * uv[c]; bui += bbi[c] * uv[c]; }
            const float nr = ar * xr - ai * xi + bur, ni = ar * xi + ai * xr + bui; xr = nr; xi = ni;
            xs[lane] = xr; xs[64 + lane] = xi;
            asm volatile("s_waitcnt lgkmcnt(0)" ::: "memory");
            float y = 0.f;
#pragma unroll
            for (int pp = 0; pp < 16; ++pp) y += cre[pp] * xs[qt * 16 + pp] - cim[pp] * xs[64 + qt * 16 + pp];
            asm volatile("s_waitcnt lgkmcnt(0)" ::: "memory");
            y += __shfl_xor(y, 16); y += __shfl_xor(y, 32);
            if (lane < 16) ys[((size_t)dir * kTok + tok) * 256 + g * 16 + cch] = y;
        }
    }
}
DEVI void phase_s5_finish(const float* ys, const bf16_t* ux, const float* dskip, bf16_t* G, int bid, int nblk) {
    for (size_t i = (size_t)bid * kNT + tidx(); i < (size_t)kTok * 256; i += (size_t)nblk * kNT) {
        const size_t tok = i >> 8; const int ch = (int)(i & 255), g = ch >> 4, c = ch & 15;
        const float u = bf2f(ux[((size_t)g * 4096 + (tok >> 4)) * 512 + (tok & 15) * 16 + c]);
        const float y = ys[i] + ys[(size_t)kTok * 256 + i] + dskip[ch] * u;
        G[i] = f2bf(gelu_tanh(y));
    }
}
DEVI void unpk8(float* d, const u32x4 q, const float sc) {
    d[0] += sc * __uint_as_float(q.x << 16); d[1] += sc * __uint_as_float(q.x & 0xFFFF0000u); d[2] += sc * __uint_as_float(q.y << 16); d[3] += sc * __uint_as_float(q.y & 0xFFFF0000u);
    d[4] += sc * __uint_as_float(q.z << 16); d[5] += sc * __uint_as_float(q.z & 0xFFFF0000u); d[6] += sc * __uint_as_float(q.w << 16); d[7] += sc * __uint_as_float(q.w & 0xFFFF0000u);
}
DEVI void phase_mixnorm(const bf16_t* oac, const float* lse, const bf16_t* ob, const bf16_t* oc, const float* ga, const float* gb, const float* gc, bf16_t* mix, int bid, int nblk) {
    const int wid = tidx() >> 6, lane = tidx() & 63;
    float gn[16];
    { const float* gp = (lane < 32) ? ga + lane * 16 : (lane < 48) ? gb + (lane - 32) * 16 : gc + (lane - 48) * 16;
#pragma unroll
      for (int i = 0; i < 16; ++i) gn[i] = gp[i]; }
    for (int row = bid * 8 + wid; row < kTok; row += nblk * 8) {
        float v[16];
#pragma unroll
        for (int i = 0; i < 16; ++i) v[i] = 0.f;
        if (lane < 32) {
            const int h = lane >> 2;
            const float l0 = lse[(size_t)row * 8 + h], l1 = lse[((size_t)kTok + row) * 8 + h], l2 = lse[((size_t)2 * kTok + row) * 8 + h];
            const bf16_t* p0 = oac + (size_t)row * 512 + lane * 16; const bf16_t* p1 = p0 + (size_t)kTok * 512; const bf16_t* p2 = p1 + (size_t)kTok * 512;
            const u32x4 a0 = *(const u32x4*)p0, a1 = *(const u32x4*)(p0 + 8), b0 = *(const u32x4*)p1, b1 = *(const u32x4*)(p1 + 8), c0 = *(const u32x4*)p2, c1 = *(const u32x4*)(p2 + 8);
            const float mx = fmaxf(l0, fmaxf(l1, l2)); float w0 = __expf(l0 - mx), w1 = __expf(l1 - mx), w2 = __expf(l2 - mx); const float inv = frcp(w0 + w1 + w2); w0 *= inv; w1 *= inv; w2 *= inv;
            unpk8(v, a0, w0); unpk8(v + 8, a1, w0); unpk8(v, b0, w1); unpk8(v + 8, b1, w1); unpk8(v, c0, w2); unpk8(v + 8, c1, w2);
        } else {
            const bf16_t* p = (lane < 48) ? ob + (size_t)row * 256 + (lane - 32) * 16 : oc + (size_t)row * 256 + (lane - 48) * 16;
            const u32x4 a0 = *(const u32x4*)p, a1 = *(const u32x4*)(p + 8);
            unpk8(v, a0, 1.f); unpk8(v + 8, a1, 1.f);
        }
        float ss = 0.f;
#pragma unroll
        for (int i = 0; i < 16; ++i) ss += v[i] * v[i];
        ss = row_sum16(ss);
        { float a = ss, b = ss; swap16(a, b); if (lane < 32) ss = a + b; }
        const float rstd = rsqrtf(ss * ((lane < 32) ? (1.f / 512.f) : (1.f / 256.f)) + kEps);
        if (EMU_FP8_WOUT) {
#pragma unroll
            for (int i = 0; i < 16; ++i) v[i] = q8(v[i] * rstd * gn[i], 1.f, 1.f) / (rstd * gn[i]);
        }
        u32x4 w0, w1;
        w0.x = pk2(v[0] * rstd * gn[0], v[1] * rstd * gn[1]); w0.y = pk2(v[2] * rstd * gn[2], v[3] * rstd * gn[3]); w0.z = pk2(v[4] * rstd * gn[4], v[5] * rstd * gn[5]); w0.w = pk2(v[6] * rstd * gn[6], v[7] * rstd * gn[7]);
        w1.x = pk2(v[8] * rstd * gn[8], v[9] * rstd * gn[9]); w1.y = pk2(v[10] * rstd * gn[10], v[11] * rstd * gn[11]); w1.z = pk2(v[12] * rstd * gn[12], v[13] * rstd * gn[13]); w1.w = pk2(v[14] * rstd * gn[14], v[15] * rstd * gn[15]);
        *(u32x4*)(mix + (size_t)row * kD + lane * 16) = w0; *(u32x4*)(mix + (size_t)row * kD + lane * 16 + 8) = w1;
    }
}
DEVI void unpk8s(float* d, const u32x4 q) {
    d[0] = __uint_as_float(q.x << 16); d[1] = __uint_as_float(q.x & 0xFFFF0000u); d[2] = __uint_as_float(q.y << 16); d[3] = __uint_as_float(q.y & 0xFFFF0000u);
    d[4] = __uint_as_float(q.z << 16); d[5] = __uint_as_float(q.z & 0xFFFF0000u); d[6] = __uint_as_float(q.w << 16); d[7] = __uint_as_float(q.w & 0xFFFF0000u);
}
DEVI void phase_combine(bf16_t* xb, float* out32, const bf16_t* y, const float* gate, const int* tokslot, const float* gain_next, bf16_t* h, int bid, int nblk) {
    const int wid = tidx() >> 6, lane = tidx() & 63;
    float g[16];
#pragma unroll
    for (int i = 0; i < 16; ++i) g[i] = gain_next ? gain_next[lane * 16 + i] : 0.f;
    const int stride = nblk * 8;
    int row = bid * 8 + wid;
    u32x4 nv0, nv1; int nts = 0;
    if (row < kTok) { nts = tokslot[(size_t)row * kE + (lane & 15)]; nv0 = *(const u32x4*)(xb + (size_t)row * kD + lane * 16); nv1 = *(const u32x4*)(xb + (size_t)row * kD + lane * 16 + 8); }
    for (; row < kTok; row += stride) {
        const int b = row >> 13;
        const int ts = nts;
        float v[16];
        unpk8s(v, nv0); unpk8s(v + 8, nv1);
        const int nrow = row + stride;
        if (nrow < kTok) { nts = tokslot[(size_t)nrow * kE + (lane & 15)]; nv0 = *(const u32x4*)(xb + (size_t)nrow * kD + lane * 16); nv1 = *(const u32x4*)(xb + (size_t)nrow * kD + lane * 16 + 8); }
#pragma unroll
        for (int e0 = 0; e0 < kE; e0 += 8) {
#if FP8_Y
            u32x4 yv[8]; float gt[8];
#pragma unroll
            for (int e = 0; e < 8; ++e) { const int slot = __builtin_amdgcn_readlane(ts, e0 + e);
                if (slot >= 0) { const size_t r = (size_t)((e0 + e) * kB + b) * kCap + slot; yv[e] = *(const u32x4*)((const unsigned char*)y + r * kD + lane * 16); gt[e] = gate[r]; } }
#pragma unroll
            for (int e = 0; e < 8; ++e) { const int slot = __builtin_amdgcn_readlane(ts, e0 + e);
                if (slot >= 0) { const unsigned ww[4] = {yv[e].x, yv[e].y, yv[e].z, yv[e].w}; const float gs = gt[e] * (1.f / kY8);
#pragma unroll
                    for (int k = 0; k < 4; ++k) { const f32x2 lo = __builtin_amdgcn_cvt_pk_f32_fp8(ww[k], false), hi = __builtin_amdgcn_cvt_pk_f32_fp8(ww[k], true);
                        v[4 * k] += lo.x * gs; v[4 * k + 1] += lo.y * gs; v[4 * k + 2] += hi.x * gs; v[4 * k + 3] += hi.y * gs; } } }
#else
            u32x4 yv[8][2];
#pragma unroll
            for (int e = 0; e < 8; ++e) { const int slot = __builtin_amdgcn_readlane(ts, e0 + e);
                if (slot >= 0) { const bf16_t* yr = y + ((size_t)((e0 + e) * kB + b) * kCap + slot) * kD + lane * 16; yv[e][0] = *(const u32x4*)yr; yv[e][1] = *(const u32x4*)(yr + 8); } }
#pragma unroll
            for (int e = 0; e < 8; ++e) { const int slot = __builtin_amdgcn_readlane(ts, e0 + e);
                if (slot >= 0) { const float gs = gate[(size_t)((e0 + e) * kB + b) * kCap + slot]; unpk8(v, yv[e][0], gs); unpk8(v + 8, yv[e][1], gs); } }
#endif
        }
        if (!gain_next) {
#pragma unroll
            for (int k = 0; k < 4; ++k) *(f32x4*)(out32 + (size_t)row * kD + lane * 16 + 4 * k) = (f32x4){v[4 * k], v[4 * k + 1], v[4 * k + 2], v[4 * k + 3]};
        } else {
            u32x4 o0, o1;
            o0.x = pk2(v[0], v[1]); o0.y = pk2(v[2], v[3]); o0.z = pk2(v[4], v[5]); o0.w = pk2(v[6], v[7]); o1.x = pk2(v[8], v[9]); o1.y = pk2(v[10], v[11]); o1.z = pk2(v[12], v[13]); o1.w = pk2(v[14], v[15]);
            *(u32x4*)(xb + (size_t)row * kD + lane * 16) = o0; *(u32x4*)(xb + (size_t)row * kD + lane * 16 + 8) = o1;
            unpk8s(v, o0); unpk8s(v + 8, o1);
            float ss = 0.f;
#pragma unroll
            for (int i = 0; i < 16; ++i) ss += v[i] * v[i];
            ss = wave_sum(ss); const float rstd = rsqrtf(ss * (1.f / kD) + kEps);
            u32x4 h0, h1;
            h0.x = pk2(v[0] * rstd * g[0], v[1] * rstd * g[1]); h0.y = pk2(v[2] * rstd * g[2], v[3] * rstd * g[3]); h0.z = pk2(v[4] * rstd * g[4], v[5] * rstd * g[5]); h0.w = pk2(v[6] * rstd * g[6], v[7] * rstd * g[7]);
            h1.x = pk2(v[8] * rstd * g[8], v[9] * rstd * g[9]); h1.y = pk2(v[10] * rstd * g[10], v[11] * rstd * g[11]); h1.z = pk2(v[12] * rstd * g[12], v[13] * rstd * g[13]); h1.w = pk2(v[14] * rstd * g[14], v[15] * rstd * g[15]);
            *(u32x4*)(h + (size_t)row * kD + lane * 16) = h0; *(u32x4*)(h + (size_t)row * kD + lane * 16 + 8) = h1;
        }
    }
}

DEVI void cpow_m(double a, double w, double dt, int m, float& re, float& im) {
    const float mag = __expf((float)m * (float)a * (float)dt);
    const double turns = (double)m * w * dt * 0.15915494309189535; const float ang = (float)((turns - floor(turns)) * 6.283185307179586);
    re = mag * cosf(ang); im = mag * sinf(ang);
}
DEVI void s5_prep_item(const Params& P, int l, int g, unsigned char* lds_) {
    float* pw = (float*)lds_;
    float* bb = pw + 4352;
    float* cc = bb + 4096;
    float* kt = cc + 4096;
    const int tid = tidx();
    __syncthreads();
    for (int i = tid; i < 128; i += kNT) { const int dir = i >> 6, p = i & 63; const size_t pb = (((size_t)l * 2 + dir) * 16 + g) * 64 + p;
        const double dt = (double)__expf(P.s5_log_dt[((size_t)l * 2 + dir) * 16 + g]); const double a = (double)fminf(P.s5_a_re[pb], -1e-4f), w = (double)P.s5_a_im[pb];
        for (int m = 0; m < 17; ++m) { float re, im; cpow_m(a, w, dt, m, re, im); pw[((dir * 64 + p) * 17 + m) * 2] = re; pw[((dir * 64 + p) * 17 + m) * 2 + 1] = im; }
        const float af = (float)a, wf = (float)w, ar = pw[((dir * 64 + p) * 17 + 1) * 2], ai = pw[((dir * 64 + p) * 17 + 1) * 2 + 1];
        const float den = af * af + wf * wf, zr = ar - 1.f, gr = (zr * af + ai * wf) / den, gi = (ai * af - zr * wf) / den;
        for (int c = 0; c < 16; ++c) { const float br = P.s5_b_re[pb * 16 + c], bi = P.s5_b_im[pb * 16 + c]; bb[((dir * 64 + p) * 16 + c) * 2] = gr * br - gi * bi; bb[((dir * 64 + p) * 16 + c) * 2 + 1] = gr * bi + gi * br; }
    }
    for (int i = tid; i < 2048; i += kNT) { const int dir = i >> 10, c = (i >> 6) & 15, p = i & 63; const size_t o = ((((size_t)l * 2 + dir) * 16 + g) * 16 + c) * 64 + p; cc[i * 2] = P.s5_c_re[o]; cc[i * 2 + 1] = P.s5_c_im[o]; }
    __syncthreads();
    for (int i = tid; i < 8192; i += kNT) { const int dir = i >> 12, m = (i >> 8) & 15, c = (i >> 4) & 15, c2 = i & 15; float acc = 0.f;
        for (int p = 0; p < 64; ++p) { const float cr = cc[((dir * 16 + c) * 64 + p) * 2], ci = cc[((dir * 16 + c) * 64 + p) * 2 + 1], wr_ = pw[((dir * 64 + p) * 17 + m) * 2], wi_ = pw[((dir * 64 + p) * 17 + m) * 2 + 1];
            const float br = bb[((dir * 64 + p) * 16 + c2) * 2], bi = bb[((dir * 64 + p) * 16 + c2) * 2 + 1]; const float tr = cr * wr_ - ci * wi_, ti = cr * wi_ + ci * wr_; acc += tr * br - ti * bi; }
        kt[i] = acc; }
    __syncthreads();
    bf16_t* wst = (bf16_t*)(wsp(P) + WS_WST) + ((size_t)l * 16 + g) * 256 * 256;
    bf16_t* wso = (bf16_t*)(wsp(P) + WS_WSO) + ((size_t)l * 16 + g) * 256 * 512;
    for (int id = tid; id < 8192; id += kNT) { const int n = id >> 5, k0 = (id & 31) * 8, dir = n >> 7, p = (n >> 1) & 63, ri = n & 1; float v[8];
#pragma unroll
        for (int kk = 0; kk < 8; ++kk) { const int k = k0 + kk, t = k >> 4, c = k & 15, e = dir ? t : 15 - t; const float wr_ = pw[((dir * 64 + p) * 17 + e) * 2], wi_ = pw[((dir * 64 + p) * 17 + e) * 2 + 1], br = bb[((dir * 64 + p) * 16 + c) * 2], bi = bb[((dir * 64 + p) * 16 + c) * 2 + 1];
            v[kk] = ri ? (wr_ * bi + wi_ * br) : (wr_ * br - wi_ * bi); }
        u32x4 o; o.x = pk2(v[0], v[1]); o.y = pk2(v[2], v[3]); o.z = pk2(v[4], v[5]); o.w = pk2(v[6], v[7]); *(u32x4*)(wst + (size_t)n * 256 + k0) = o; }
    for (int id = tid; id < 16384; id += kNT) { const int ns = id >> 6, k0 = (id & 63) * 8, n = cmap_pk(ns), t = n >> 4, c = n & 15; float v[8];
#pragma unroll
        for (int kk = 0; kk < 8; ++kk) { const int k = k0 + kk; float x;
            if (k < 256) { const int j = k >> 4, c2 = k & 15; x = 0.f; if (j <= t) x += kt[(t - j) * 256 + c * 16 + c2]; if (j >= t) x += kt[4096 + (j - t) * 256 + c * 16 + c2]; if (j == t && c == c2) x += P.s5_d[l * 256 + g * 16 + c]; }
            else { const int q = k - 256, dir = q >> 7, p = (q >> 1) & 63, ri = q & 1, e = dir ? 16 - t : t + 1; const float cr = cc[((dir * 16 + c) * 64 + p) * 2], ci = cc[((dir * 16 + c) * 64 + p) * 2 + 1], wr_ = pw[((dir * 64 + p) * 17 + e) * 2], wi_ = pw[((dir * 64 + p) * 17 + e) * 2 + 1];
                x = ri ? -(cr * wi_ + ci * wr_) : (cr * wr_ - ci * wi_); }
            v[kk] = x; }
        u32x4 o; o.x = pk2(v[0], v[1]); o.y = pk2(v[2], v[3]); o.z = pk2(v[4], v[5]); o.w = pk2(v[6], v[7]); *(u32x4*)(wso + (size_t)ns * 512 + k0) = o; }
    __syncthreads();
}
DEVI void phase_s5_scan(const Params& P, int l, const float* Z, bf16_t* ux, unsigned char* lds_, int bid, int nblk) {
    const int tid = tidx(), wid = tid >> 6, lane = tid & 63;
    float* E = (float*)lds_;
    for (int item = bid; item < 256; item += nblk) {
        const int dir = item & 1, g = (item >> 1) & 15, b = item >> 5;
        const size_t pb = (((size_t)l * 2 + dir) * 16 + g) * 64 + lane;
        const double dt = (double)__expf(P.s5_log_dt[((size_t)l * 2 + dir) * 16 + g]); const double a = (double)fminf(P.s5_a_re[pb], -1e-4f), w = (double)P.s5_a_im[pb];
        float a16r, a16i, Ar, Ai; cpow_m(a, w, dt, 16, a16r, a16i); cpow_m(a, w, dt, 1024, Ar, Ai);
        const int kk0 = dir ? 511 - 64 * wid : 64 * wid; const long sstep = dir ? -1 : 1;
        const float* zp = Z + ((size_t)g * 4096 + b * 512 + kk0) * 256 + dir * 128 + 2 * lane;
        f32x2 z[64];
#pragma unroll
        for (int i = 0; i < 64; ++i) { z[i] = *(const f32x2*)zp; zp += sstep * 256; }
        float xr = 0.f, xi = 0.f;
#pragma unroll
        for (int i = 0; i < 64; ++i) { const float nr = a16r * xr - a16i * xi + z[i].x, ni = a16r * xi + a16i * xr + z[i].y; xr = nr; xi = ni; }
        __syncthreads();
        E[(wid * 64 + lane) * 2] = xr; E[(wid * 64 + lane) * 2 + 1] = xi;
        __syncthreads();
        float sr = 0.f, si = 0.f;
#pragma unroll
        for (int s2 = 0; s2 < 7; ++s2) if (s2 < wid) { const float er = E[(s2 * 64 + lane) * 2], ei = E[(s2 * 64 + lane) * 2 + 1]; const float nr = Ar * sr - Ai * si + er, ni = Ar * si + Ai * sr + ei; sr = nr; si = ni; }
        bf16_t* up = ux + ((size_t)g * 4096 + b * 512 + kk0) * 512 + 256 + dir * 128 + 2 * lane;
#pragma unroll
        for (int i = 0; i < 64; ++i) { *(unsigned*)up = pk2(sr, si); up += sstep * 512;
            const float nr = a16r * sr - a16i * si + z[i].x, ni = a16r * si + a16i * sr + z[i].y; sr = nr; si = ni; }
    }
    __syncthreads();
}
struct EpiF32N {
    static constexpr int VMOPS = 32;
    float* z; int ldz;
    DEVI void operator()(const f32x4 (&acc)[2][2][4][2], const Unit& u, int wr, int wc, int fr, int fq) const {
#pragma unroll
        for (int ai = 0; ai < 2; ++ai)
#pragma unroll
            for (int m = 0; m < 4; ++m) { const size_t ro = (size_t)(u.pm * 256 + 128 * ai + 64 * wr + 16 * m + fr) * ldz + u.pn * 256 + 32 * wc + 4 * fq;
#pragma unroll
                for (int bj = 0; bj < 2; ++bj)
#pragma unroll
                    for (int n = 0; n < 2; ++n) *(f32x4*)(z + ro + 128 * bj + 16 * n) = acc[ai][bj][m][n]; }
    }
};
struct EpiS5Out {
    static constexpr int VMOPS = 16;
    bf16_t* G;
    DEVI void operator()(const f32x4 (&acc)[2][2][4][2], const Unit& u, int wr, int wc, int fr, int fq) const {
#pragma unroll
        for (int ai = 0; ai < 2; ++ai)
#pragma unroll
            for (int m = 0; m < 4; ++m) { const int R = u.pm * 256 + 128 * ai + 64 * wr + 16 * m + fr, g = R >> 12, ck = R & 4095;
#pragma unroll
                for (int bj = 0; bj < 2; ++bj) { const int t = 8 * bj + 2 * wc + (fq >> 1), c0 = 8 * (fq & 1);
                    const f32x4 v0 = acc[ai][bj][m][0], v1 = acc[ai][bj][m][1];
                    u32x4 w; w.x = pk2(gelu_tanh(v0.x), gelu_tanh(v0.y)); w.y = pk2(gelu_tanh(v0.z), gelu_tanh(v0.w)); w.z = pk2(gelu_tanh(v1.x), gelu_tanh(v1.y)); w.w = pk2(gelu_tanh(v1.z), gelu_tanh(v1.w));
                    *(u32x4*)(G + ((size_t)ck * 16 + t) * 256 + g * 16 + c0) = w; } }
    }
};
#define XB_TMO      128
#define XB_XCNT(j)  (256  + 64 * (j))
#define XB_XSUB(j)  (1280 + 64 * (j))
#define XB_XGEN(j)  (2304 + 64 * (j))
#define XB_TOP      3328
#define XB_TOPGEN   3392
#define XCD_BAR_WORDS 3456
#define XB_SPIN_CAP (1u << 26)
DEVI unsigned xb_ld(unsigned* p)              { return __hip_atomic_load(p, __ATOMIC_RELAXED, __HIP_MEMORY_SCOPE_AGENT); }
DEVI unsigned xb_add(unsigned* p, unsigned v) { return __hip_atomic_fetch_add(p, v, __ATOMIC_RELAXED, __HIP_MEMORY_SCOPE_AGENT); }
DEVI unsigned xb_xcc_id() { return (unsigned)__builtin_amdgcn_s_getreg((3 << 11) | 20) & 0xFu; }
#define XB_SPIN(cond, bar) do { unsigned _sp = 0; while (cond) { __builtin_amdgcn_s_sleep(1); \
    if ((++_sp & 255u) == 0u) { if (xb_ld(&(bar)[XB_TMO])) break; if (_sp > XB_SPIN_CAP) { atomicAdd(&(bar)[XB_TMO], 1u); break; } } } } while (0)
struct XcdBarrier { unsigned* bar; unsigned x; volatile LAS unsigned* st; };
DEVI XcdBarrier xcd_barrier_post(unsigned* bar, volatile LAS unsigned* st) {
    XcdBarrier b; b.bar = bar; b.x = xb_xcc_id(); b.st = st;
    if (threadIdx.x == 0) (void)xb_add(&bar[XB_XCNT(b.x)], 1u);
    return b;
}
DEVI void xcd_barrier_complete(unsigned* bar, unsigned x, unsigned& nloc, unsigned& nx) {
    const unsigned G = gridDim.x * gridDim.y * gridDim.z;
    unsigned sum, cnt, mine, sp = 0u;
    for (;;) {
        sum = 0u; cnt = 0u; mine = 0u;
#pragma unroll
        for (unsigned j = 0; j < 16; ++j) { const unsigned c = xb_ld(&bar[XB_XCNT(j)]); sum += c; cnt += (c > 0u) ? 1u : 0u; mine = (j == x) ? c : mine; }
        if (sum == G) break;
        __builtin_amdgcn_s_sleep(1);
        if ((++sp & 255u) == 0u) { if (xb_ld(&bar[XB_TMO])) break; if (sp > XB_SPIN_CAP) { atomicAdd(&bar[XB_TMO], 1u); break; } }
    }
    nloc = mine > 0u ? mine : 1u; nx = cnt > 0u ? cnt : 1u;
}
DEVI void xcd_barrier(const XcdBarrier& b) {
    asm volatile("s_waitcnt vmcnt(0)" ::: "memory");
    __syncthreads();
    if (threadIdx.x == 0) {
        unsigned long long bp_ = (unsigned long long)b.bar; asm volatile("" : "+s"(bp_));
        unsigned* bar = (unsigned*)bp_;
        const unsigned bx = xb_xcc_id();
        __builtin_amdgcn_s_waitcnt(0);
        unsigned nloc = b.st[0], nx = b.st[1];
        if (nloc == 0u) { xcd_barrier_complete(bar, bx, nloc, nx); b.st[0] = nloc; b.st[1] = nx; }
        const unsigned old = xb_add(&bar[XB_XSUB(bx)], 1u);
        const unsigned gen = old / nloc;
        if (old + 1u == (gen + 1u) * nloc) {
            __builtin_amdgcn_fence(__ATOMIC_RELEASE, "agent");
            asm volatile("s_waitcnt vmcnt(0)" ::: "memory");
            const unsigned og = xb_add(&bar[XB_TOP], 1u);
            const unsigned tg = og / nx;
            if (og + 1u == (tg + 1u) * nx) xb_add(&bar[XB_TOPGEN], 1u);
            else XB_SPIN(xb_ld(&bar[XB_TOPGEN]) == tg, bar);
            __builtin_amdgcn_fence(__ATOMIC_ACQUIRE, "agent");
            xb_add(&bar[XB_XGEN(bx)], 1u);
            asm volatile("s_waitcnt vmcnt(0)" ::: "memory");
        } else {
            XB_SPIN(xb_ld(&bar[XB_XGEN(bx)]) == gen, bar);
            __builtin_amdgcn_fence(__ATOMIC_ACQUIRE, "agent");
            asm volatile("s_waitcnt vmcnt(0)" ::: "memory");
        }
    }
    __syncthreads();
}

#ifndef MEGA
#define MEGA 1
#endif
#ifndef STAGGER_WIN
#define STAGGER_WIN 0
#endif
#ifndef USE_ENGINE
#define USE_ENGINE 1
#endif
constexpr int LDS_BYTES = 147456 + 8192 + 16;
#if USE_ENGINE
#define GEMM_RUN(g, E) gemm_engine<decltype(E), true, true>((LAS unsigned char*)dyn_lds, g, E, bid, nblk)
#define GEMM_RUN8(g, E) gemm_engine<decltype(E), true, true, true>((LAS unsigned char*)dyn_lds, g, E, bid, nblk)
#else
#define GEMM_RUN(g, E) gemm_simple(g, E, bid, nblk)
#endif
extern __shared__ __attribute__((aligned(16))) unsigned char dyn_lds[];

DEVI GemmD mk_gemm(const bf16_t* A, const bf16_t* Bt, int lda, int K, int nM, int nN, const int* rowidx, size_t bstride, int pmg) {
    GemmD g; g.A = A; g.Bt = Bt; g.lda = lda; g.K = K; g.nM = nM; g.nN = nN; g.rowidx = rowidx; g.bstride = bstride; g.pmg = pmg; g.stagger_10ns = 0; return g; }

DEVI void ph_win(const Params& P, int l, int bid, int nblk, int probe = 0) {
    const GemmD g = mk_gemm((const bf16_t*)(wsp(P) + WS_H), (const bf16_t*)(wsp(P) + WS_WINT) + (size_t)l * kINW * kD, kD, kD, kTok / 256, 10, nullptr, 0, 1 << 30);
    unsigned char* r1 = wsp(P) + WS_R1;
    EpiQKV E; E.qa = (bf16_t*)(r1 + R1_QA); E.ka = (bf16_t*)(r1 + R1_KA); E.va = (bf16_t*)(r1 + R1_VA); E.qb = (bf16_t*)(r1 + R1_QB); E.kb = (bf16_t*)(r1 + R1_KB); E.vb = (bf16_t*)(r1 + R1_VB); E.ux = (bf16_t*)(r1 + R1_UX);
    { LAS float* tab = (LAS float*)((LAS unsigned char*)dyn_lds + 131072);
      const int t = tidx();
      if (t < 320) { const int r = t >> 6, c = t & 63; tab[t] = (r == 0) ? P.q_norm_a[l * 64 + c] : (r == 1) ? P.k_norm_a[l * 64 + c] : (r == 2) ? P.q_norm_b[l * 64 + c] : (r == 3) ? P.k_norm_b[l * 64 + c] : 1.f; }
      __syncthreads();
      E.gtab = tab; E.probe = probe; }
    GEMM_RUN(g, E);
}
#ifndef USE_MFMA_ATTN
#define USE_MFMA_ATTN 1
#endif
#ifndef USE_S5_GEMM
#define USE_S5_GEMM 1
#endif
#ifndef PROBE_ATTN
#define PROBE_ATTN 1
#endif
#ifndef PROBE_GU
#define PROBE_GU 1
#endif
#ifndef PROBE_WINDRY
#define PROBE_WINDRY 0
#endif
#ifndef PROBE_WIN
#define PROBE_WIN 1
#endif
#ifndef PROBE_DOWN
#define PROBE_DOWN 1
#endif
#ifndef PROBE_NA
#define PROBE_NA 1
#endif
#ifndef PROBE_MIX
#define PROBE_MIX 1
#endif
#ifndef PROBE_RT
#define PROBE_RT 1
#endif
#ifndef PROBE_TK
#define PROBE_TK 1
#endif
#ifndef PROBE_GUDRY
#define PROBE_GUDRY 0
#endif
#ifndef PROBE_DILVAR
#define PROBE_DILVAR 0
#endif
#ifndef PROBE_CONV
#define PROBE_CONV 1
#endif
DEVI void ph_win_dry(const Params& P, int l, int bid, int nblk) {
    const GemmD g = mk_gemm((const bf16_t*)(wsp(P) + WS_H), (const bf16_t*)(wsp(P) + WS_WINT) + (size_t)l * kINW * kD, kD, kD, kTok / 256, 10, nullptr, 0, 1 << 30);
    EpiDry E; E.sink = (float*)(wsp(P) + WS_LSE);
    GEMM_RUN(g, E);
}
DEVI void ph_dilated(const Params& P, int l, int bid, int nblk) { unsigned char* r1 = wsp(P) + WS_R1;
#if PROBE_DILVAR
    phase_dilated<PROBE_DILVAR>((const bf16_t*)(r1 + R1_QA), (const bf16_t*)(r1 + R1_KA), (const bf16_t*)(r1 + R1_VA), P.q_norm_a + l * 64, P.k_norm_a + l * 64, (bf16_t*)(wsp(P) + WS_R2), (float*)(wsp(P) + WS_LSE), (LAS unsigned char*)dyn_lds, bid, nblk);
#endif
#if USE_MFMA_ATTN
    phase_dilated((const bf16_t*)(r1 + R1_QA), (const bf16_t*)(r1 + R1_KA), (const bf16_t*)(r1 + R1_VA), P.q_norm_a + l * 64, P.k_norm_a + l * 64, (bf16_t*)(wsp(P) + WS_R2), (float*)(wsp(P) + WS_LSE), (LAS unsigned char*)dyn_lds, bid, nblk);
#else
    phase_dilated_naive((const bf16_t*)(r1 + R1_QA), (const bf16_t*)(r1 + R1_KA), (const bf16_t*)(r1 + R1_VA), (bf16_t*)(wsp(P) + WS_R2), (float*)(wsp(P) + WS_LSE), bid, nblk);
#endif
}
DEVI void ph_na(const Params& P, int l, int bid, int nblk) { unsigned char* r1 = wsp(P) + WS_R1;
#if USE_MFMA_ATTN
    phase_na((const bf16_t*)(r1 + R1_QB), (const bf16_t*)(r1 + R1_KB), (const bf16_t*)(r1 + R1_VB), P.rpb + (size_t)l * 4 * 15 * 31, (bf16_t*)(r1 + R1_OB), (LAS unsigned char*)dyn_lds, bid, nblk);
#else
    phase_na_naive((const bf16_t*)(r1 + R1_QB), (const bf16_t*)(r1 + R1_KB), (const bf16_t*)(r1 + R1_VB), P.rpb + (size_t)l * 4 * 15 * 31, (bf16_t*)(r1 + R1_OB), bid, nblk);
#endif
}
DEVI void ph_s5(const Params& P, int l, unsigned char* lds, int bid, int nblk) { phase_s5_naive(P, l, (const bf16_t*)(wsp(P) + WS_R1 + R1_UX), (float*)(wsp(P) + WS_YS), lds, bid, nblk); }
DEVI void ph_s5_prep(const Params& P, unsigned char* lds, int bid, int nblk) { for (int it = bid; it < kL * 16; it += nblk) s5_prep_item(P, it >> 4, it & 15, lds); }
DEVI void ph_s5_state(const Params& P, int l, int bid, int nblk) {
    const GemmD g = mk_gemm((const bf16_t*)(wsp(P) + WS_R1 + R1_UX), (const bf16_t*)(wsp(P) + WS_WST) + (size_t)l * 16 * 256 * 256, 512, 256, 256, 1, nullptr, (size_t)256 * 256, 16);
    EpiF32N E; E.z = (float*)(wsp(P) + WS_R2 + R2_Z); E.ldz = 256;
    GEMM_RUN(g, E);
}
DEVI void ph_s5_scan(const Params& P, int l, unsigned char* lds, int bid, int nblk) { phase_s5_scan(P, l, (const float*)(wsp(P) + WS_R2 + R2_Z), (bf16_t*)(wsp(P) + WS_R1 + R1_UX), lds, bid, nblk); }
DEVI void ph_s5_out(const Params& P, int l, int bid, int nblk) {
    const GemmD g = mk_gemm((const bf16_t*)(wsp(P) + WS_R1 + R1_UX), (const bf16_t*)(wsp(P) + WS_WSO) + (size_t)l * 16 * 256 * 512, 512, 512, 256, 1, nullptr, (size_t)256 * 512, 16);
    EpiS5Out E; E.G = (bf16_t*)(wsp(P) + WS_R1 + R1_G);
    GEMM_RUN(g, E);
}
DEVI void ph_s5fin(const Params& P, int l, int bid, int nblk) { phase_s5_finish((const float*)(wsp(P) + WS_YS), (const bf16_t*)(wsp(P) + WS_R1 + R1_UX), P.s5_d + l * 256, (bf16_t*)(wsp(P) + WS_R1 + R1_G), bid, nblk); }
DEVI void ph_glu(const Params& P, int l, int bid, int nblk) {
    const GemmD g = mk_gemm((const bf16_t*)(wsp(P) + WS_R1 + R1_G), (const bf16_t*)(wsp(P) + WS_WGLUT) + (size_t)l * 256 * 256, 256, 256, kTok / 256, 1, nullptr, 0, 1 << 30);
    EpiGlu E; E.g = (const bf16_t*)(wsp(P) + WS_R1 + R1_G); E.oc = (bf16_t*)(wsp(P) + WS_R1 + R1_OC);
    GEMM_RUN(g, E);
}
DEVI void ph_mixnorm(const Params& P, int l, int bid, int nblk) { unsigned char* r1 = wsp(P) + WS_R1;
    phase_mixnorm((const bf16_t*)(wsp(P) + WS_R2), (const float*)(wsp(P) + WS_LSE), (const bf16_t*)(r1 + R1_OB), (const bf16_t*)(r1 + R1_OC), P.out_norm_a + l * 512, P.out_norm_b + l * 256, P.out_norm_c + l * 256, (bf16_t*)(wsp(P) + WS_H), bid, nblk); }
DEVI void ph_wout(const Params& P, int l, int bid, int nblk) {
    const GemmD g = mk_gemm((const bf16_t*)(wsp(P) + WS_H), (const bf16_t*)(wsp(P) + WS_WOUTT) + (size_t)l * kD * kD, kD, kD, kTok / 256, 4, nullptr, 0, 1 << 30);
    EpiResid E; E.x32 = (l == 0) ? P.x : nullptr; E.xb = (bf16_t*)(wsp(P) + WS_XB);
    GEMM_RUN(g, E);
}
DEVI void ph_router(const Params& P, int l, unsigned char* lds, int bid, int nblk) { phase_router((const bf16_t*)(wsp(P) + WS_XB), P.ffn_norm + (size_t)l * kD, P.w_router + (size_t)l * kD * kE, (bf16_t*)(wsp(P) + WS_H), (float*)(wsp(P) + WS_AFF), lds, bid, nblk); }
DEVI void ph_topk(const Params& P, unsigned char* lds, int bid, int nblk) { phase_topk((const float*)(wsp(P) + WS_AFF), (int*)(wsp(P) + WS_IDX), (float*)(wsp(P) + WS_GATE), (int*)(wsp(P) + WS_TSLOT), wsp(P) + WS_H, wsp(P) + WS_R2, FP8_GU ? kD : kD * 2, lds, bid, nblk); }
DEVI void ph_gu(const Params& P, int l, int bid, int nblk) {
#if FP8_GU
    const GemmD g = mk_gemm((const bf16_t*)(wsp(P) + WS_R2), (const bf16_t*)(wsp(P) + WS_WGUT + (size_t)l * kE * 4096 * kD), kD, kD, 512, 16, nullptr, (size_t)4096 * kD, 32);
    EpiGU E; E.hid = (bf16_t*)(wsp(P) + WS_R1); E.sc = 1.f / kW8; E.nomath = false;
    GEMM_RUN8(g, E);
#else
    const GemmD g = mk_gemm((const bf16_t*)(wsp(P) + WS_R2), (const bf16_t*)(wsp(P) + WS_WGUT) + (size_t)l * kE * 4096 * kD, kD, kD, 512, 16, nullptr, (size_t)4096 * kD, 32);
    EpiGU E; E.hid = (bf16_t*)(wsp(P) + WS_R1); E.sc = 1.f; E.nomath = false;
    GEMM_RUN(g, E);
#endif
}
DEVI void ph_gu_dry(const Params& P, int l, int bid, int nblk) {
    const GemmD g = mk_gemm((const bf16_t*)(wsp(P) + WS_R2), (const bf16_t*)(wsp(P) + WS_WGUT + (size_t)l * kE * 4096 * kD), kD, kD, 512, 16, nullptr, (size_t)4096 * kD, 32);
#if PROBE_GUDRY == 2
    EpiGU E; E.hid = (bf16_t*)(wsp(P) + WS_R1); E.sc = 1.f / kW8; E.nomath = true;
#else
    EpiDry E; E.sink = (float*)(wsp(P) + WS_LSE);
#endif
    GEMM_RUN8(g, E);
}
DEVI void ph_down(const Params& P, int l, int bid, int nblk) {
#if FP8_DN
    const GemmD g = mk_gemm((const bf16_t*)(wsp(P) + WS_R1), (const bf16_t*)(wsp(P) + WS_WDT + (size_t)l * kE * kD * kFF), kFF, kFF, 512, 4, nullptr, (size_t)kD * kFF, 32);
    EpiDown E; E.y = (bf16_t*)(wsp(P) + WS_R2); E.gate = (const float*)(wsp(P) + WS_GATE); E.sc = 1.f / (kW8 * kH8);
    GEMM_RUN8(g, E);
#else
    const GemmD g = mk_gemm((const bf16_t*)(wsp(P) + WS_R1), (const bf16_t*)(wsp(P) + WS_WDT) + (size_t)l * kE * kD * kFF, kFF, kFF, 512, 4, nullptr, (size_t)kD * kFF, 32);
    EpiDown E; E.y = (bf16_t*)(wsp(P) + WS_R2); E.gate = (const float*)(wsp(P) + WS_GATE); E.sc = 1.f;
    GEMM_RUN(g, E);
#endif
}
DEVI void ph_combine(const Params& P, int l, int bid, int nblk) { phase_combine((bf16_t*)(wsp(P) + WS_XB), P.out, (const bf16_t*)(wsp(P) + WS_R2), (const float*)(wsp(P) + WS_GATE), (const int*)(wsp(P) + WS_TSLOT), (l + 1 < kL) ? P.attn_norm + (size_t)(l + 1) * kD : nullptr, (bf16_t*)(wsp(P) + WS_H), bid, nblk); }

typedef __attribute__((address_space(4))) const Params* CParams;
DEVI CParams kargs() { unsigned long long a = (unsigned long long)__builtin_amdgcn_kernarg_segment_ptr(); asm volatile("" : "+s"(a)); return (CParams)a; }
#if MEGA
__global__ void __launch_bounds__(kNT, 2) mega_fwd(Params P_) {
#define PK P_
    volatile LAS unsigned* st = (volatile LAS unsigned*)(dyn_lds + LDS_BYTES - 16);
    if (threadIdx.x == 0) { st[0] = 0u; st[1] = 0u; st[2] = 0u; st[3] = 0u; }
    __syncthreads();
    const XcdBarrier bar = xcd_barrier_post((unsigned*)(PK.ws + WS_CTL), st);
    const int bid = blockIdx.x, nblk = gridDim.x;
    unsigned char* lds = dyn_lds;
#pragma unroll 1
    for (int rep = 0; rep < PROBE_CONV; ++rep)
    phase_convert(PK, lds, lnd(bid), nblk);
#if USE_S5_GEMM
    ph_s5_prep(PK, lds, lnd(bid), nblk);
#endif
    phase_norm(PK.x, PK.attn_norm, (bf16_t*)(PK.ws + WS_H), lnd(bid), nblk);
    xcd_barrier(bar);
#pragma unroll 1
    for (int l = 0; l < kL; ++l) {
#if PROBE_WINDRY == 1
        ph_win_dry(PK, l, lnd(bid), nblk);        xcd_barrier(bar);
#elif PROBE_WINDRY > 1
        ph_win(PK, l, lnd(bid), nblk, PROBE_WINDRY - 1);   xcd_barrier(bar);
#endif
#pragma unroll 1
        for (int rep = 0; rep < PROBE_WIN; ++rep) {
        ph_win(PK, l, lnd(bid), nblk);            xcd_barrier(bar); }
#if USE_S5_GEMM
        ph_s5_state(PK, l, lnd(bid), nblk);       xcd_barrier(bar);
        ph_s5_scan(PK, l, lds, lnd(bid), nblk);
#pragma unroll 1
        for (int rep = 0; rep < PROBE_ATTN; ++rep)
        ph_dilated(PK, l, lnd(bid), nblk);
#pragma unroll 1
        for (int rep = 0; rep < PROBE_NA; ++rep)
        ph_na(PK, l, lnd(bid), nblk);             xcd_barrier(bar);
        ph_s5_out(PK, l, lnd(bid), nblk);         xcd_barrier(bar);
#else
        ph_s5(PK, l, lds, lnd(bid), nblk);
        ph_dilated(PK, l, lnd(bid), nblk);
        ph_na(PK, l, lnd(bid), nblk);             xcd_barrier(bar);
        ph_s5fin(PK, l, lnd(bid), nblk);          xcd_barrier(bar);
#endif
        ph_glu(PK, l, lnd(bid), nblk);            xcd_barrier(bar);
#pragma unroll 1
        for (int rep = 0; rep < PROBE_MIX; ++rep) {
        ph_mixnorm(PK, l, lnd(bid), nblk);        xcd_barrier(bar); }
        ph_wout(PK, l, lnd(bid), nblk);           xcd_barrier(bar);
#pragma unroll 1
        for (int rep = 0; rep < PROBE_RT; ++rep) {
        ph_router(PK, l, lds, lnd(bid), nblk);    xcd_barrier(bar); }
#pragma unroll 1
        for (int rep = 0; rep < PROBE_TK; ++rep) {
        ph_topk(PK, lds, lnd(bid), nblk);         xcd_barrier(bar); }
#if PROBE_GUDRY
        ph_gu_dry(PK, l, lnd(bid), nblk);         xcd_barrier(bar);
#endif
#pragma unroll 1
        for (int rep = 0; rep < PROBE_GU; ++rep) {
        ph_gu(PK, l, lnd(bid), nblk);             xcd_barrier(bar); }
#pragma unroll 1
        for (int rep = 0; rep < PROBE_DOWN; ++rep) {
        ph_down(PK, l, lnd(bid), nblk);           xcd_barrier(bar); }
        ph_combine(PK, l, lnd(bid), nblk);        xcd_barrier(bar);
    }
#undef PK
}
#else
#define KB __global__ void __launch_bounds__(kNT, 2)
KB k_convert(Params P) { phase_convert(P, dyn_lds, blockIdx.x, gridDim.x); }
KB k_norm(Params P) { phase_norm(P.x, P.attn_norm, (bf16_t*)(P.ws + WS_H), blockIdx.x, gridDim.x); }
KB k_win(Params P, int l) { ph_win(P, l, blockIdx.x, gridDim.x); }
KB k_dilated(Params P, int l) { ph_dilated(P, l, blockIdx.x, gridDim.x); }
KB k_na(Params P, int l) { ph_na(P, l, blockIdx.x, gridDim.x); }
KB k_s5(Params P, int l) { ph_s5(P, l, dyn_lds, blockIdx.x, gridDim.x); }
KB k_s5fin(Params P, int l) { ph_s5fin(P, l, blockIdx.x, gridDim.x); }
KB k_glu(Params P, int l) { ph_glu(P, l, blockIdx.x, gridDim.x); }
KB k_mixnorm(Params P, int l) { ph_mixnorm(P, l, blockIdx.x, gridDim.x); }
KB k_wout(Params P, int l) { ph_wout(P, l, blockIdx.x, gridDim.x); }
KB k_router(Params P, int l) { ph_router(P, l, dyn_lds, blockIdx.x, gridDim.x); }
KB k_topk(Params P) { ph_topk(P, dyn_lds, blockIdx.x, gridDim.x); }
KB k_gu(Params P, int l) { ph_gu(P, l, blockIdx.x, gridDim.x); }
KB k_down(Params P, int l) { ph_down(P, l, blockIdx.x, gridDim.x); }
KB k_combine(Params P, int l) { ph_combine(P, l, blockIdx.x, gridDim.x); }
#endif

extern "C" void kernel_launch(void* const* d_in, const int* in_sizes, int n_in, void* d_out, int out_size, void* d_ws, size_t ws_size, hipStream_t stream) {
    (void)in_sizes; (void)n_in; (void)out_size;
    if (ws_size < WS_END) { fprintf(stderr, "workspace too small: %zu < %zu\n", ws_size, (size_t)WS_END); return; }
    Params P{};
    const float** pp = (const float**)&P;
    for (int i = 0; i < 26; ++i) pp[i] = (const float*)d_in[i];
    P.out = (float*)d_out; P.ws = (unsigned char*)d_ws;
#if MEGA
    static int grid = 0;
    if (!grid) {
        int dev = 0, cus = 0, per_cu = 0;
        (void)hipGetDevice(&dev);
        (void)hipDeviceGetAttribute(&cus, hipDeviceAttributeMultiprocessorCount, dev);
        (void)hipFuncSetAttribute((const void*)mega_fwd, hipFuncAttributeMaxDynamicSharedMemorySize, LDS_BYTES);
        (void)hipOccupancyMaxActiveBlocksPerMultiprocessor(&per_cu, (const void*)mega_fwd, kNT, LDS_BYTES);
        grid = (per_cu >= 1) ? cus : 0;
        if (!grid) fprintf(stderr, "mega_fwd does not fit a CU\n");
    }
    if (!grid) return;
    (void)hipMemsetAsync(P.ws + WS_CTL, 0, XCD_BAR_WORDS * sizeof(unsigned), stream);
    mega_fwd<<<grid, kNT, LDS_BYTES, stream>>>(P);
#else
    (void)hipFuncSetAttribute((const void*)k_router, hipFuncAttributeMaxDynamicSharedMemorySize, 65536);
    const int G = 1024;
    k_convert<<<G, kNT, 256 * 72 * 2, stream>>>(P);
    k_norm<<<G, kNT, 0, stream>>>(P);
    for (int l = 0; l < kL; ++l) {
        k_win<<<G, kNT, 0, stream>>>(P, l);
        k_dilated<<<G, kNT, 0, stream>>>(P, l);
        k_na<<<G, kNT, 0, stream>>>(P, l);
        k_s5<<<256, kNT, 8 * 128 * 4, stream>>>(P, l);
        k_s5fin<<<G, kNT, 0, stream>>>(P, l);
        k_glu<<<256, kNT, 0, stream>>>(P, l);
        k_mixnorm<<<G, kNT, 0, stream>>>(P, l);
        k_wout<<<G, kNT, 0, stream>>>(P, l);
        k_router<<<512, kNT, 65536, stream>>>(P, l);
        k_topk<<<128, kNT, 4096, stream>>>(P);
        k_gu<<<G, kNT, 0, stream>>>(P, l);
        k_down<<<G, kNT, 0, stream>>>(P, l);
        k_combine<<<G, kNT, 0, stream>>>(P, l);
    }
#endif
}
```

```cpp
#include <hip/hip_runtime.h>
#include <stdint.h>
#include <stdio.h>

#define DEVI __device__ __forceinline__
#define LAS __attribute__((address_space(3)))
typedef unsigned short bf16_t;
typedef short bf16x8 __attribute__((ext_vector_type(8)));
typedef float f32x4 __attribute__((ext_vector_type(4)));
typedef float f32x2 __attribute__((ext_vector_type(2)));
typedef unsigned u32x4 __attribute__((ext_vector_type(4)));
typedef unsigned u32x2 __attribute__((ext_vector_type(2)));

constexpr int kB = 8, kS = 8192, kD = 1024, kL = 4, kTok = kB * kS;
constexpr int kINW = 2560;
constexpr int kE = 16, kCap = 1024, kFF = 2048;
constexpr int kNT = 512;
constexpr float kEps = 1e-6f;
constexpr float kLog2e = 1.4426950408889634f, kLn2 = 0.6931471805599453f;

constexpr size_t MiB = 1024ull * 1024ull;
constexpr size_t WS_CTL   = 0;
constexpr size_t WS_WINT  = 1 * MiB;
constexpr size_t WS_WOUTT = WS_WINT + 20 * MiB;
constexpr size_t WS_WGLUT = WS_WOUTT + 8 * MiB;
constexpr size_t WS_WGUT  = WS_WGLUT + 1 * MiB;
constexpr size_t WS_WDT   = WS_WGUT + 512 * MiB;
constexpr size_t WS_H     = WS_WDT + 256 * MiB;
constexpr size_t WS_R1    = WS_H + 128 * MiB;
constexpr size_t WS_R2    = WS_R1 + 512 * MiB;
constexpr size_t WS_AFF   = WS_R2 + 256 * MiB;
constexpr size_t WS_IDX   = WS_AFF + 4 * MiB;
constexpr size_t WS_GATE  = WS_IDX + 1 * MiB;
constexpr size_t WS_TSLOT = WS_GATE + 1 * MiB;
constexpr size_t WS_LSE   = WS_TSLOT + 4 * MiB;
constexpr size_t WS_WST   = WS_LSE + 8 * MiB;
constexpr size_t WS_WSO   = WS_WST + 8 * MiB;
constexpr size_t WS_YS    = WS_WSO + 16 * MiB;
constexpr size_t WS_XB    = WS_YS;
constexpr size_t WS_END   = WS_YS + 128 * MiB;
constexpr size_t R2_Z     = 192 * MiB;
constexpr size_t R1_QA = 0, R1_KA = 64 * MiB, R1_VA = 128 * MiB, R1_QB = 192 * MiB, R1_KB = 224 * MiB, R1_VB = 256 * MiB,
                 R1_UX = 288 * MiB, R1_OB = 352 * MiB, R1_OC = 384 * MiB, R1_G = 416 * MiB;

struct Params {
    const float* x; const float* attn_norm; const float* w_in; const float* q_norm_a; const float* k_norm_a; const float* q_norm_b; const float* k_norm_b;
    const float* rpb; const float* s5_a_re; const float* s5_a_im; const float* s5_log_dt; const float* s5_b_re; const float* s5_b_im; const float* s5_c_re; const float* s5_c_im;
    const float* s5_d; const float* w_glu; const float* out_norm_a; const float* out_norm_b; const float* out_norm_c; const float* w_out; const float* ffn_norm;
    const float* w_router; const float* w_gate; const float* w_up; const float* w_down;
    float* out; unsigned char* ws;
};

DEVI float bf2f(bf16_t b) { return __uint_as_float(((unsigned)b) << 16); }
DEVI bf16_t f2bf(float f) { unsigned u = __float_as_uint(f); u += 0x7FFFu + ((u >> 16) & 1u); return (bf16_t)(u >> 16); }
typedef __bf16 bf16x2_t __attribute__((ext_vector_type(2)));
DEVI unsigned pk2(float lo, float hi) { const f32x2 v = {lo, hi}; return __builtin_bit_cast(unsigned, __builtin_convertvector(v, bf16x2_t)); }
DEVI int tidx() { int t = threadIdx.x; asm volatile("" : "+v"(t)); return t; }
#define GAS __attribute__((address_space(1)))
DEVI unsigned char* wsp(const Params& P) { unsigned long long a = (unsigned long long)P.ws; asm volatile("" : "+s"(a)); return (unsigned char*)(GAS unsigned char*)a; }
DEVI int lnd(int v) { asm volatile("" : "+s"(v)); return v; }
template <int CTRL> DEVI float dppf(float v) { return __builtin_bit_cast(float, __builtin_amdgcn_update_dpp(0, __builtin_bit_cast(int, v), CTRL, 0xF, 0xF, true)); }
DEVI void swap16(float& a, float& b) { asm volatile("s_nop 1\n\tv_permlane16_swap_b32 %0, %1" : "+v"(a), "+v"(b)); }
DEVI void swap32(float& a, float& b) { asm volatile("s_nop 1\n\tv_permlane32_swap_b32 %0, %1" : "+v"(a), "+v"(b)); }
DEVI void swap16u(unsigned& a, unsigned& b) { asm volatile("s_nop 1\n\tv_permlane16_swap_b32 %0, %1" : "+v"(a), "+v"(b)); }
DEVI float xsum16(float v) { float a = v, b = v; swap16(a, b); return a + b; }
DEVI float xsum32(float v) { float a = v, b = v; swap32(a, b); return a + b; }
DEVI float xmax16(float v) { float a = v, b = v; swap16(a, b); return fmaxf(a, b); }
DEVI float xmax32(float v) { float a = v, b = v; swap32(a, b); return fmaxf(a, b); }
DEVI float row_sum16(float v) {
    v += dppf<0xB1>(v); v += dppf<0x4E>(v);
    v += dppf<0x141>(v); v += dppf<0x140>(v);
    return v;
}
DEVI float wave_sum(float v) { return xsum32(xsum16(row_sum16(v))); }
DEVI void unpk8s(float* d, const u32x4 q) {
    d[0] = __uint_as_float(q.x << 16); d[1] = __uint_as_float(q.x & 0xFFFF0000u); d[2] = __uint_as_float(q.y << 16); d[3] = __uint_as_float(q.y & 0xFFFF0000u);
    d[4] = __uint_as_float(q.z << 16); d[5] = __uint_as_float(q.z & 0xFFFF0000u); d[6] = __uint_as_float(q.w << 16); d[7] = __uint_as_float(q.w & 0xFFFF0000u);
}
DEVI float frcp(float x) { return __builtin_amdgcn_rcpf(x); }
DEVI float gelu_tanh(float y) { const float z = 0.7978845608028654f * (y + 0.044715f * y * y * y); const float t = 1.f - 2.f * frcp(1.f + __expf(2.f * z)); return 0.5f * y * (1.f + t); }

#ifndef EMU_BF16_X
#define EMU_BF16_X 0
#endif
#ifndef EMU_FP8_WIN
#define EMU_FP8_WIN 0
#endif
#ifndef EMU_FP8_WOUT
#define EMU_FP8_WOUT 0
#endif
#ifndef EMU_FP8_GU
#define EMU_FP8_GU 0
#endif
#ifndef EMU_FP8_DN
#define EMU_FP8_DN 0
#endif
DEVI float q8(float x, float sc, float inv) {
    float y = x * sc; const float ay = fabsf(y);
    if (ay < 0.015625f) y = rintf(y * 512.f) * (1.f / 512.f);
    else { unsigned u = __float_as_uint(y); u += 0x7FFFFu + ((u >> 20) & 1u); u &= 0xFFF00000u; y = __uint_as_float(u); y = fminf(fmaxf(y, -448.f), 448.f); }
    return y * inv;
}
#ifndef FP8_GU
#define FP8_GU 1
#endif
#ifndef FP8_DN
#define FP8_DN 1
#endif
#ifndef FP8_Y
#define FP8_Y 1
#endif
constexpr float kY8 = 32.f;
constexpr float kW8 = 64.f, kH8 = 8.f;
DEVI unsigned pk4_fp8(float a, float b, float c, float d) { unsigned w = 0u; w = __builtin_amdgcn_cvt_pk_fp8_f32(a, b, w, false); w = __builtin_amdgcn_cvt_pk_fp8_f32(c, d, w, true); return w; }
DEVI int cmap_head(int cs) { const int bj = cs >> 7, wc = (cs >> 5) & 3, n = (cs >> 4) & 1, fq = (cs >> 2) & 3, j = cs & 3; return 64 * wc + 32 * bj + 8 * fq + 4 * n + j; }
DEVI int cmap_pk(int cs)   { const int bj = cs >> 7, wc = (cs >> 5) & 3, n = (cs >> 4) & 1, fq = (cs >> 2) & 3, j = cs & 3; return 128 * bj + 32 * wc + 8 * fq + 4 * n + j; }
DEVI int cmap_gu(int cs)   { const int wc = (cs >> 5) & 3, n = (cs >> 4) & 1, fq = (cs >> 2) & 3, j = cs & 3; return 32 * wc + 8 * fq + 4 * n + j; }

template <int MODE, int QEMU = 0>
DEVI void convert_item(const float* W0, const float* W1, int ldw, int K, bf16_t* Bt, int kt, int pn, unsigned char* lds) {
    bf16_t* t = (bf16_t*)lds;
    const int tid = tidx();
#pragma unroll 4
    for (int it = 0; it < 32; ++it) {
        const int e = it * kNT + tid, k = e >> 8, cs = e & 255;
        float v;
        if (MODE == 0) v = W0[(size_t)(kt * 64 + k) * ldw + pn * 256 + cs];
        else if (MODE == 1) v = W0[(size_t)(kt * 64 + k) * ldw + pn * 256 + cmap_head(cs)];
        else if (MODE == 2) v = W0[(size_t)(kt * 64 + k) * ldw + pn * 256 + cmap_pk(cs)];
        else v = ((cs >> 7) ? W1 : W0)[(size_t)(kt * 64 + k) * ldw + pn * 128 + cmap_gu(cs)];
        if (QEMU) v = q8(v, 64.f, 1.f / 64.f);
        t[cs * 72 + k] = f2bf(v);
    }
    __syncthreads();
#pragma unroll
    for (int it = 0; it < 4; ++it) {
        const int c = it * kNT + tid, row = c >> 3, part = c & 7;
        const u32x4 v = *(const u32x4*)(t + row * 72 + part * 8);
        *(u32x4*)(Bt + (size_t)(pn * 256 + row) * K + kt * 64 + part * 8) = v;
    }
    __syncthreads();
}

template <int MODE>
DEVI void convert_item8(const float* W0, const float* W1, int ldw, int K, unsigned char* Bt, int kt, int pn, unsigned char* lds) {
    unsigned char* t = lds;
    const int tid = tidx();
#pragma unroll 4
    for (int it = 0; it < 64; ++it) {
        const int e = it * kNT + tid, k = e >> 8, cs = e & 255;
        float v;
        if (MODE == 2) v = W0[(size_t)(kt * 128 + k) * ldw + pn * 256 + cmap_pk(cs)];
        else v = ((cs >> 7) ? W1 : W0)[(size_t)(kt * 128 + k) * ldw + pn * 128 + cmap_gu(cs)];
        v *= kW8;
        t[cs * 144 + k] = (unsigned char)(__builtin_amdgcn_cvt_pk_fp8_f32(v, v, 0u, false) & 0xFFu);
    }
    __syncthreads();
#pragma unroll
    for (int it = 0; it < 4; ++it) {
        const int c = it * kNT + tid, row = c >> 3, part = c & 7;
        const u32x4 v = *(const u32x4*)(t + row * 144 + part * 16);
        *(u32x4*)(Bt + (size_t)(pn * 256 + row) * K + kt * 128 + part * 16) = v;
    }
    __syncthreads();
}

DEVI void phase_convert(const Params& P, unsigned char* lds, int bid, int nblk) {
    constexpr int N_WIN = kL * 16 * 10, N_WOUT = kL * 16 * 4, N_WGLU = kL * 4 * 1, N_WGU = kL * kE * (FP8_GU ? 8 : 16) * 16, N_WD = kL * kE * (FP8_DN ? 16 : 32) * 4;
    constexpr int TOT = N_WIN + N_WOUT + N_WGLU + N_WGU + N_WD;
    for (int it = bid; it < TOT; it += nblk) {
        int i = it;
        if (i < N_WIN) { const int l = i / 160, r = i % 160, kt = r / 10, pn = r % 10;
            convert_item<1, EMU_FP8_WIN>(P.w_in + (size_t)l * kD * kINW, nullptr, kINW, kD, (bf16_t*)(wsp(P) + WS_WINT) + (size_t)l * kINW * kD, kt, pn, lds); continue; }
        i -= N_WIN;
        if (i < N_WOUT) { const int l = i / 64, r = i % 64, kt = r / 4, pn = r % 4;
            convert_item<2, EMU_FP8_WOUT>(P.w_out + (size_t)l * kD * kD, nullptr, kD, kD, (bf16_t*)(wsp(P) + WS_WOUTT) + (size_t)l * kD * kD, kt, pn, lds); continue; }
        i -= N_WOUT;
        if (i < N_WGLU) { const int l = i / 4, kt = i % 4;
            convert_item<2>(P.w_glu + (size_t)l * 256 * 256, nullptr, 256, 256, (bf16_t*)(wsp(P) + WS_WGLUT) + (size_t)l * 256 * 256, kt, 0, lds); continue; }
        i -= N_WGLU;
#if FP8_GU
        if (i < N_WGU) { const int le = i / 128, r = i % 128, kt = r / 16, pn = r % 16;
            convert_item8<3>(P.w_gate + (size_t)le * kD * kFF, P.w_up + (size_t)le * kD * kFF, kFF, kD, wsp(P) + WS_WGUT + (size_t)le * 4096 * kD, kt, pn, lds); continue; }
#else
        if (i < N_WGU) { const int le = i / 256, r = i % 256, kt = r / 16, pn = r % 16;
            convert_item<3, EMU_FP8_GU>(P.w_gate + (size_t)le * kD * kFF, P.w_up + (size_t)le * kD * kFF, kFF, kD, (bf16_t*)(wsp(P) + WS_WGUT) + (size_t)le * 4096 * kD, kt, pn, lds); continue; }
#endif
        i -= N_WGU;
#if FP8_DN
        { const int le = i / 64, r = i % 64, kt = r / 4, pn = r % 4;
            convert_item8<2>(P.w_down + (size_t)le * kFF * kD, nullptr, kD, kFF, wsp(P) + WS_WDT + (size_t)le * kD * kFF, kt, pn, lds); }
#else
        { const int le = i / 128, r = i % 128, kt = r / 4, pn = r % 4;
            convert_item<2, EMU_FP8_DN>(P.w_down + (size_t)le * kFF * kD, nullptr, kD, kFF, (bf16_t*)(wsp(P) + WS_WDT) + (size_t)le * kD * kFF, kt, pn, lds); }
#endif
    }
}

DEVI void phase_norm(const float* x, const float* gain, bf16_t* h, int bid, int nblk) {
    const int wid = tidx() >> 6, lane = tidx() & 63;
    f32x4 g[4];
#pragma unroll
    for (int q = 0; q < 4; ++q) g[q] = *(const f32x4*)(gain + q * 256 + lane * 4);
    for (int row = bid * 8 + wid; row < kTok; row += nblk * 8) {
        f32x4 v[4]; float ss = 0.f;
#pragma unroll
        for (int q = 0; q < 4; ++q) { v[q] = *(const f32x4*)(x + (size_t)row * kD + q * 256 + lane * 4); ss += v[q].x * v[q].x + v[q].y * v[q].y + v[q].z * v[q].z + v[q].w * v[q].w; }
        ss = wave_sum(ss);
        const float rstd = rsqrtf(ss * (1.f / kD) + kEps);
#pragma unroll
        for (int q = 0; q < 4; ++q) { f32x4 t = v[q] * rstd * g[q]; if (EMU_FP8_WIN) { t.x = q8(t.x, 1.f, 1.f); t.y = q8(t.y, 1.f, 1.f); t.z = q8(t.z, 1.f, 1.f); t.w = q8(t.w, 1.f, 1.f); }
            u32x2 o; o.x = pk2(t.x, t.y); o.y = pk2(t.z, t.w);
            *(u32x2*)(h + (size_t)row * kD + q * 256 + lane * 4) = o; }
    }
}

DEVI void phase_router(const bf16_t* x, const float* gain, const float* wr  , bf16_t* h, float* aff, unsigned char* lds, int bid, int nblk) {
    float* wT = (float*)lds;
    for (int i = tidx(); i < 16 * 1024; i += kNT) { const int k = i >> 4, e = i & 15; wT[e * 1024 + k] = wr[i]; }
    __syncthreads();
    const int wid = tidx() >> 6, lane = tidx() & 63;
    f32x4 g[4];
#pragma unroll
    for (int q = 0; q < 4; ++q) g[q] = *(const f32x4*)(gain + q * 256 + lane * 4);
    u32x2 nvx[2][4];
    { const int r0 = (bid * 8 + wid) * 2;
      if (r0 < kTok) {
#pragma unroll
        for (int r = 0; r < 2; ++r)
#pragma unroll
            for (int q = 0; q < 4; ++q) nvx[r][q] = *(const u32x2*)(x + (size_t)(r0 + r) * kD + q * 256 + lane * 4); } }
    for (int row0 = (bid * 8 + wid) * 2; row0 < kTok; row0 += nblk * 8 * 2) {
        asm volatile("" ::: "memory");
        f32x4 v[2][4];
#pragma unroll
        for (int r = 0; r < 2; ++r)
#pragma unroll
            for (int q = 0; q < 4; ++q) { const u32x2 w = nvx[r][q]; v[r][q] = (f32x4){__uint_as_float(w.x << 16), __uint_as_float(w.x & 0xFFFF0000u), __uint_as_float(w.y << 16), __uint_as_float(w.y & 0xFFFF0000u)}; }
        { const int nr0 = row0 + nblk * 8 * 2;
          if (nr0 < kTok) {
#pragma unroll
            for (int r = 0; r < 2; ++r)
#pragma unroll
                for (int q = 0; q < 4; ++q) nvx[r][q] = *(const u32x2*)(x + (size_t)(nr0 + r) * kD + q * 256 + lane * 4); } }
#pragma unroll
        for (int r = 0; r < 2; ++r) { float ss = 0.f;
#pragma unroll
            for (int q = 0; q < 4; ++q) { ss += v[r][q].x * v[r][q].x + v[r][q].y * v[r][q].y + v[r][q].z * v[r][q].z + v[r][q].w * v[r][q].w; }
            ss = wave_sum(ss); const float rstd = rsqrtf(ss * (1.f / kD) + kEps);
#pragma unroll
            for (int q = 0; q < 4; ++q) { v[r][q] = v[r][q] * rstd * g[q];
#if FP8_GU
                *(unsigned*)((unsigned char*)h + (size_t)(row0 + r) * kD + q * 256 + lane * 4) = pk4_fp8(v[r][q].x, v[r][q].y, v[r][q].z, v[r][q].w); }
#else
                u32x2 o;
                if (EMU_FP8_GU) { o.x = pk2(q8(v[r][q].x, 1.f, 1.f), q8(v[r][q].y, 1.f, 1.f)); o.y = pk2(q8(v[r][q].z, 1.f, 1.f), q8(v[r][q].w, 1.f, 1.f)); }
                else { o.x = pk2(v[r][q].x, v[r][q].y); o.y = pk2(v[r][q].z, v[r][q].w); }
                *(u32x2*)(h + (size_t)(row0 + r) * kD + q * 256 + lane * 4) = o; }
#endif
        }
        float pa[32];
#pragma unroll
        for (int e = 0; e < 16; ++e) {
            float s0 = 0.f, s1 = 0.f;
#pragma unroll
            for (int q = 0; q < 4; ++q) { const f32x4 w = *(const f32x4*)(wT + e * 1024 + q * 256 + lane * 4);
                s0 += v[0][q].x * w.x + v[0][q].y * w.y + v[0][q].z * w.z + v[0][q].w * w.w;
                s1 += v[1][q].x * w.x + v[1][q].y * w.y + v[1][q].z * w.z + v[1][q].w * w.w; }
            pa[e] = s0; pa[16 + e] = s1;
        }
#define RS_STEP(HALF, MASK) { const bool up = (lane & (MASK)) != 0; _Pragma("unroll") for (int i = 0; i < (HALF); ++i) { const float keep = up ? pa[i + (HALF)] : pa[i], send = up ? pa[i] : pa[i + (HALF)]; pa[i] = keep + __shfl_xor(send, (MASK)); } }
        RS_STEP(16, 32) RS_STEP(8, 16) RS_STEP(4, 8) RS_STEP(2, 4) RS_STEP(1, 2)
#undef RS_STEP
        const float logit = pa[0] + __shfl_xor(pa[0], 1);
        float mx = logit;
#pragma unroll
        for (int m = 16; m >= 2; m >>= 1) mx = fmaxf(mx, __shfl_xor(mx, m));
        const float ex = __expf(logit - mx);
        float sm = ex;
#pragma unroll
        for (int m = 16; m >= 2; m >>= 1) sm += __shfl_xor(sm, m);
        const int row = row0 + (lane >> 5), e = (lane >> 1) & 15, b = row >> 13, s = row & (kS - 1);
        if (!(lane & 1)) aff[((size_t)(b * kE + e)) * kS + s] = ex * frcp(sm);
    }
    __syncthreads();
}

DEVI int block_excl_scan(int v, int* sh  , int& total) {
    const int lane = tidx() & 63, wid = tidx() >> 6;
    int incl = v;
#pragma unroll
    for (int d = 1; d < 64; d <<= 1) { const int o = __shfl_up(incl, d); if (lane >= d) incl += o; }
    __syncthreads();
    if (lane == 63) sh[wid] = incl;
    __syncthreads();
    int base = 0, tot = 0;
#pragma unroll
    for (int w = 0; w < 8; ++w) { const int c = sh[w]; if (w < wid) base += c; tot += c; }
    total = tot;
    return base + incl - v;
}

DEVI void phase_topk(const float* aff, int* idx, float* gate, int* tokslot, const unsigned char* hsrc, unsigned char* xe, int rowbytes, unsigned char* lds, int bid, int nblk) {
    int* hist = (int*)lds;
    int* sh = hist + 256;
    int* res = sh + 16;
    int* lsel = res + 16;
    const int tid = tidx(), lane = tid & 63, wid = tid >> 6;
    const int share = (nblk >= 2 * kB * kE) ? 2 : 1;
    for (int wi = bid; wi < kB * kE * share; wi += nblk) {
        const int item = wi / share, part = wi - item * share;
        const int b = item >> 4, e = item & 15;
        const float* a = aff + (size_t)item * kS;
        unsigned key[16];
#pragma unroll
        for (int q = 0; q < 4; ++q) { const u32x4 v = *(const u32x4*)(a + tid * 16 + q * 4); key[q * 4 + 0] = v.x; key[q * 4 + 1] = v.y; key[q * 4 + 2] = v.z; key[q * 4 + 3] = v.w; }
        unsigned prefix = 0; int kk = kCap;
#pragma unroll 1
        for (int pass = 0; pass < 4; ++pass) {
            const int shift = 24 - 8 * pass;
            __syncthreads();
            if (tid < 256) hist[tid] = 0;
            __syncthreads();
#pragma unroll
            for (int i = 0; i < 16; ++i) { const bool in = (pass == 0) || ((key[i] >> (shift + 8)) == prefix); if (in) atomicAdd(&hist[(key[i] >> shift) & 255], 1); }
            __syncthreads();
            if (wid == 0) {
                int c[4], loc = 0;
#pragma unroll
                for (int j = 0; j < 4; ++j) { c[j] = hist[255 - 4 * lane - j]; loc += c[j]; }
                int incl = loc;
#pragma unroll
                for (int d = 1; d < 64; d <<= 1) { const int o = __shfl_up(incl, d); if (lane >= d) incl += o; }
                const int excl = incl - loc;
                if (excl < kk && kk <= incl) { int run = excl; int bin = 0, nk = 0; bool found = false;
#pragma unroll
                    for (int j = 0; j < 4; ++j) { if (!found && run + c[j] >= kk) { bin = 255 - 4 * lane - j; nk = kk - run; found = true; } if (!found) run += c[j]; }
                    res[0] = bin; res[1] = nk; }
            }
            __syncthreads();
            prefix = (prefix << 8) | (unsigned)res[0]; kk = res[1];
        }
        const unsigned T = prefix;
        int ceq = 0;
#pragma unroll
        for (int i = 0; i < 16; ++i) ceq += (key[i] == T) ? 1 : 0;
        int tot;
        int eqb = block_excl_scan(ceq, sh, tot);
        int csel = 0; unsigned selmask = 0;
#pragma unroll
        for (int i = 0; i < 16; ++i) { bool s = key[i] > T; if (key[i] == T) { s = eqb < kk; ++eqb; } if (s) { selmask |= 1u << i; ++csel; } }
        int slot = block_excl_scan(csel, sh, tot);
        const size_t rbase = (size_t)(e * kB + b) * kCap;
#pragma unroll
        for (int i = 0; i < 16; ++i) { const int s = tid * 16 + i; const bool sel = (selmask >> i) & 1u;
            if (sel) { if (part == 0) { idx[rbase + slot] = b * kS + s; gate[rbase + slot] = __uint_as_float(key[i]); } lsel[slot] = b * kS + s; }
            if (part == 0) tokslot[((size_t)(b * kS + s)) * kE + e] = sel ? slot : -1;
            if (sel) ++slot; }
        __syncthreads();
        { const int cpr = rowbytes >> 4;
          const int cbeg = part * (kCap / share) * cpr, cend = cbeg + (kCap / share) * cpr;
          for (int c0 = cbeg + tid; c0 < cend; c0 += kNT * 4) {
              u32x4 v[4];
#pragma unroll
              for (int j = 0; j < 4; ++j) { const int c = c0 + j * kNT; const int r = c / cpr, ch = c - r * cpr; v[j] = *(const u32x4*)(hsrc + (size_t)lsel[r] * rowbytes + ch * 16); }
#pragma unroll
              for (int j = 0; j < 4; ++j) { const int c = c0 + j * kNT; const int r = c / cpr, ch = c - r * cpr; *(u32x4*)(xe + (rbase + r) * rowbytes + ch * 16) = v[j]; }
          } }
    }
    __syncthreads();
}

struct Unit { int pm, pn; };
DEVI bool unit_of(int Lid, int nM, int nN, Unit& u) {
    const int nwg = nM * nN; if (Lid >= nwg) return false;
    int wgid = Lid; { const int q = nwg / 8, r = nwg % 8, xcd = wgid % 8, off = wgid / 8; wgid = (xcd < r ? xcd * (q + 1) : r * (q + 1) + (xcd - r) * q) + off; }
    const int nig = 8 * nN, gid = wgid / nig, fm = gid * 8, gsz = (nM - fm) < 8 ? (nM - fm) : 8;
    u.pm = fm + ((wgid % nig) % gsz); u.pn = (wgid % nig) / gsz; return true;
}
struct GemmD { const bf16_t* A; const bf16_t* Bt; int lda, K, nM, nN; const int* rowidx; size_t bstride; int pmg; int stagger_10ns; };

template <class Epi>
DEVI void gemm_simple(const GemmD g, const Epi& E, int bid, int nblk) {
    const int tid = tidx(), wid = tid >> 6, lane = tid & 63, wr = wid >> 2, wc = wid & 3, fr = lane & 15, fq = lane >> 4;
    for (int i = 0;; ++i) {
        Unit u; if (!unit_of(i * nblk + bid, g.nM, g.nN, u)) break;
        f32x4 acc[2][2][4][2];
#pragma unroll
        for (int a = 0; a < 2; ++a)
#pragma unroll
            for (int b = 0; b < 2; ++b)
#pragma unroll
                for (int m = 0; m < 4; ++m)
#pragma unroll
                    for (int n = 0; n < 2; ++n) acc[a][b][m][n] = (f32x4){0.f, 0.f, 0.f, 0.f};
        const bf16_t* Bu = g.Bt + (size_t)(u.pm / g.pmg) * g.bstride + (size_t)u.pn * 256 * g.K;
        unsigned ao[2][4], bo[2][2];
#pragma unroll
        for (int a = 0; a < 2; ++a)
#pragma unroll
            for (int m = 0; m < 4; ++m) { const int r = u.pm * 256 + 128 * a + 64 * wr + 16 * m + fr; const unsigned rr = g.rowidx ? (unsigned)g.rowidx[r] : (unsigned)r; ao[a][m] = rr * (unsigned)g.lda + 8u * fq; }
#pragma unroll
        for (int b = 0; b < 2; ++b)
#pragma unroll
            for (int n = 0; n < 2; ++n) bo[b][n] = (unsigned)(128 * b + 32 * wc + 16 * n + fr) * (unsigned)g.K + 8u * fq;
#pragma unroll 1
        for (int k0 = 0; k0 < g.K; k0 += 32) {
            bf16x8 av[2][4], bv[2][2];
#pragma unroll
            for (int a = 0; a < 2; ++a)
#pragma unroll
                for (int m = 0; m < 4; ++m) av[a][m] = *(const bf16x8*)(g.A + ao[a][m] + k0);
#pragma unroll
            for (int b = 0; b < 2; ++b)
#pragma unroll
                for (int n = 0; n < 2; ++n) bv[b][n] = *(const bf16x8*)(Bu + bo[b][n] + k0);
#pragma unroll
            for (int a = 0; a < 2; ++a)
#pragma unroll
                for (int b = 0; b < 2; ++b)
#pragma unroll
                    for (int m = 0; m < 4; ++m)
#pragma unroll
                        for (int n = 0; n < 2; ++n) acc[a][b][m][n] = __builtin_amdgcn_mfma_f32_16x16x32_bf16(bv[b][n], av[a][m], acc[a][b][m][n], 0, 0, 0);
        }
        E(acc, u, wr, wc, fr, fq);
    }
}


constexpr int PG_HTB = 128 * 64 * 2;
DEVI int pg_lds_byte(int r, int c) { const int st = (r >> 4) * 2 + (c >> 5), rr = r & 15, cc = c & 31, ob = rr * 64 + cc * 2; return st * 1024 + (ob ^ (((ob >> 9) & 1) << 5)); }
DEVI void pg_stage_rc(int b, int& R, int& C) { const int st = b / 1024, sb = b % 1024, swz = sb ^ (((sb >> 9) & 1) << 5); R = (st >> 1) * 16 + swz / 64; C = (st & 1) * 32 + (swz % 64) / 2; }

typedef int v4i __attribute__((ext_vector_type(4)));
typedef int v8i __attribute__((ext_vector_type(8)));
template <class Epi, bool ALIGN_EPI, bool SP2, bool FP8 = false>
DEVI void gemm_engine(LAS unsigned char* lds, const GemmD g, const Epi& E, int bid, int nblk) {
    const int tid = tidx(), wid = __builtin_amdgcn_readfirstlane(tid >> 6), lane = tid & 63, wr = wid >> 2, wc = wid & 3, fr = lane & 15, fq = lane >> 4;
    constexpr int ES = FP8 ? 1 : 2;
    const int K = g.K * ES  , nt = K / 128; const unsigned ldaB = (unsigned)g.lda * ES;
    unsigned voffA[2], voffB[2];
#pragma unroll
    for (int i = 0; i < 2; ++i) { int R, C; pg_stage_rc(tid * 16 + i * 8192, R, C); voffA[i] = (unsigned)R * ldaB + (unsigned)C * 2u; voffB[i] = (unsigned)(R * K + C * 2); }
    const size_t kstep = 128;
    const size_t hstepB = (size_t)128 * K, hstepA = (size_t)128 * ldaB, tstepA = 2 * hstepA;
    const unsigned ldsw = (unsigned)wid * 1024u;
    const int aoff = pg_lds_byte(wr * 64 + fr, fq * 8), boff = pg_lds_byte(wc * 32 + fr, fq * 8);
#define PG8_SA(b, h) (((b) * 2 + (h)) * PG_HTB)
#define PG8_SB(b, h) ((4 + (b) * 2 + (h)) * PG_HTB)
#define PG8_STAGE(bufoff, gbase, voff) do { _Pragma("unroll") for (int _i = 0; _i < 2; ++_i) \
        __builtin_amdgcn_global_load_lds((const unsigned*)((const char*)(gbase) + (voff)[_i]), (LAS unsigned*)(lds + (bufoff) + ldsw + _i * 8192), 16, 0, 0); } while (0)
#define PG8_RD16(off) (*(const LAS v4i*)(lds + (off)))
#define PG8_CAT2(off) __builtin_shufflevector(PG8_RD16(off), PG8_RD16((off) + 1024), 0, 1, 2, 3, 4, 5, 6, 7)
#define PG8_LDA(dst, b, h) do { _Pragma("unroll") for (int m = 0; m < 4; ++m) { if constexpr (FP8) dst##8[m] = PG8_CAT2(PG8_SA(b, h) + aoff + m * 2048); \
        else { _Pragma("unroll") for (int k = 0; k < 2; ++k) dst[m][k] = *(const LAS bf16x8*)(lds + PG8_SA(b, h) + aoff + m * 2048 + k * 1024); } } } while (0)
#define PG8_LDB(dst, b, h) do { _Pragma("unroll") for (int n = 0; n < 2; ++n) { if constexpr (FP8) dst##8[n] = PG8_CAT2(PG8_SB(b, h) + boff + n * 2048); \
        else { _Pragma("unroll") for (int k = 0; k < 2; ++k) dst[n][k] = *(const LAS bf16x8*)(lds + PG8_SB(b, h) + boff + n * 2048 + k * 1024); } } } while (0)
#define PG8_MMA(ai, bj, At, Bt) do { __builtin_amdgcn_s_setprio(1); _Pragma("unroll") for (int m = 0; m < 4; ++m) _Pragma("unroll") for (int n = 0; n < 2; ++n) { \
        if constexpr (FP8) asm volatile("v_mfma_f32_16x16x128_f8f6f4 %0, %1, %2, %0" : "+v"(acc[ai][bj][m][n]) : "v"(Bt##8[n]), "v"(At##8[m]));   \
        else { _Pragma("unroll") for (int k = 0; k < 2; ++k) acc[ai][bj][m][n] = __builtin_amdgcn_mfma_f32_16x16x32_bf16(Bt[n][k], At[m][k], acc[ai][bj][m][n], 0, 0, 0); } } \
        __builtin_amdgcn_s_setprio(0); } while (0)
#define PG8_WAIT_V(n) asm volatile("s_waitcnt vmcnt(" #n ")" ::: "memory")
#define PG8_WAIT_L(n) asm volatile("s_waitcnt lgkmcnt(" #n ")" ::: "memory")
#define PG8_BAR __builtin_amdgcn_s_barrier()
#define PG8_SCHED __builtin_amdgcn_sched_barrier(0)
    Unit cur, nxt; int ui = 0;
    if (!unit_of(bid, g.nM, g.nN, cur)) return;
    if (g.stagger_10ns) { const unsigned long long t0 = __builtin_amdgcn_s_memrealtime(), dt = (unsigned long long)(((bid >> 3) & 3) * g.stagger_10ns);
        while (__builtin_amdgcn_s_memrealtime() - t0 < dt) __builtin_amdgcn_s_sleep(8); }
    f32x4 acc[2][2][4][2];
#pragma unroll
    for (int a = 0; a < 2; ++a)
#pragma unroll
        for (int b = 0; b < 2; ++b)
#pragma unroll
            for (int m = 0; m < 4; ++m)
#pragma unroll
                for (int n = 0; n < 2; ++n) acc[a][b][m][n] = (f32x4){0.f, 0.f, 0.f, 0.f};
    bf16x8 At[4][2], B0[2][2], B1[2][2]; v8i At8[4], B08[2], B18[2];
    (void)At; (void)B0; (void)B1; (void)At8; (void)B08; (void)B18;
    static_assert(SP2, "only the two-super-phase K-loop is kept");
    const char* cA = (const char*)g.A + (size_t)cur.pm * tstepA;
    const char* cB = (const char*)g.Bt + (size_t)(cur.pm / g.pmg) * g.bstride * ES + (size_t)cur.pn * 256 * K;
    PG8_STAGE(PG8_SB(0, 0), cB, voffB); PG8_STAGE(PG8_SB(0, 1), cB + hstepB, voffB); PG8_STAGE(PG8_SA(0, 0), cA, voffA); PG8_STAGE(PG8_SA(0, 1), cA + hstepA, voffA);
    if (wr == 1) PG8_BAR;
    PG8_WAIT_V(2); PG8_BAR;
    PG8_STAGE(PG8_SB(1, 0), cB + kstep, voffB); PG8_STAGE(PG8_SA(1, 0), cA + kstep, voffA); PG8_STAGE(PG8_SB(1, 1), cB + hstepB + kstep, voffB);
    PG8_WAIT_V(6); PG8_BAR;
    for (;;) {
        const bool has_next = unit_of((ui + 1) * nblk + bid, g.nM, g.nN, nxt);
        const char* nA = has_next ? (const char*)g.A + (size_t)nxt.pm * tstepA : cA;
        const char* nB = has_next ? (const char*)g.Bt + (size_t)(nxt.pm / g.pmg) * g.bstride * ES + (size_t)nxt.pn * 256 * K : cB;
#pragma unroll 1
        for (int t = 0; t < nt; t += 2) {
            const bool last = (t == nt - 2);
            const char* a1 = cA + (size_t)(t + 1) * kstep;
            const char* a2 = last ? nA : cA + (size_t)(t + 2) * kstep; const char* b2 = last ? nB : cB + (size_t)(t + 2) * kstep;
            const char* a3 = a2 + kstep; const char* b3 = b2 + kstep;
            PG8_LDB(B0, 0, 0); PG8_LDB(B1, 0, 1); PG8_SCHED; PG8_LDA(At, 0, 0); PG8_STAGE(PG8_SA(1, 1), a1 + hstepA, voffA);
            PG8_WAIT_V(8); PG8_WAIT_L(0); PG8_BAR; PG8_MMA(0, 0, At, B0); PG8_MMA(0, 1, At, B1); PG8_BAR; PG8_SCHED;
            PG8_LDA(At, 0, 1); PG8_STAGE(PG8_SB(0, 0), b2, voffB); PG8_STAGE(PG8_SB(0, 1), b2 + hstepB, voffB); PG8_STAGE(PG8_SA(0, 0), a2, voffA);
            PG8_WAIT_V(8); PG8_WAIT_L(0); PG8_BAR; PG8_MMA(1, 0, At, B0); PG8_MMA(1, 1, At, B1); PG8_BAR; PG8_SCHED;
            PG8_LDB(B0, 1, 0); PG8_LDB(B1, 1, 1); PG8_SCHED; PG8_LDA(At, 1, 0); PG8_STAGE(PG8_SA(0, 1), a2 + hstepA, voffA);
            PG8_WAIT_V(8); PG8_WAIT_L(0); PG8_BAR; PG8_MMA(0, 0, At, B0); PG8_MMA(0, 1, At, B1); PG8_BAR; PG8_SCHED;
            PG8_LDA(At, 1, 1); PG8_STAGE(PG8_SB(1, 0), b3, voffB); PG8_STAGE(PG8_SB(1, 1), b3 + hstepB, voffB); PG8_STAGE(PG8_SA(1, 0), a3, voffA);
            PG8_WAIT_V(8); PG8_WAIT_L(0); PG8_BAR; PG8_MMA(1, 0, At, B0); PG8_MMA(1, 1, At, B1); PG8_BAR; PG8_SCHED;
        }
        if constexpr (ALIGN_EPI) { if (wr == 0) PG8_BAR; }
        if constexpr (FP8) asm volatile("s_nop 15\n\ts_nop 15" ::: "memory");
        E(acc, cur, wr, wc, fr, fq);
        if (!has_next) break;
#pragma unroll
        for (int a = 0; a < 2; ++a)
#pragma unroll
            for (int b = 0; b < 2; ++b)
#pragma unroll
                for (int m = 0; m < 4; ++m)
#pragma unroll
                    for (int n = 0; n < 2; ++n) acc[a][b][m][n] = (f32x4){0.f, 0.f, 0.f, 0.f};
        cur = nxt; cA = nA; cB = nB; ++ui;
        if constexpr (ALIGN_EPI) { if (wr == 1) PG8_BAR; }
    }
    PG8_WAIT_V(0);
    if constexpr (!ALIGN_EPI) { if (wr == 0) PG8_BAR; }
    PG8_BAR;
#undef PG8_SA
#undef PG8_SB
#undef PG8_STAGE
#undef PG8_LDA
#undef PG8_LDB
#undef PG8_MMA
#undef PG8_RD16
#undef PG8_CAT2
#undef PG8_WAIT_V
#undef PG8_WAIT_L
#undef PG8_BAR
#undef PG8_SCHED
}

template <int PROBE = 0> struct EpiQKV {
    static constexpr int VMOPS = 16;
    bf16_t *qa, *ka, *va, *qb, *kb, *vb, *ux;
    bf16_t* scratch;
    const LAS float* gtab;
    DEVI void operator()(const f32x4 (&acc)[2][2][4][2], const Unit& u, int wr, int wc, int fr, int fq) const {
        const int pn = u.pn;
        bf16_t* dst = (pn < 2) ? qa : (pn < 4) ? ka : (pn < 6) ? va : (pn == 6) ? qb : (pn == 7) ? kb : (pn == 8) ? vb : ux;
        const int H = (pn < 6) ? 8 : 4, head = ((pn < 6) ? (pn & 1) * 4 : 0) + wc;
        const int trow = (pn < 2) ? 0 : (pn < 4) ? 1 : (pn == 6) ? 2 : (pn == 7) ? 3 : 4;
        const bool nrm = trow < 4;
        f32x4 gv[2][2];
#pragma unroll
        for (int bj = 0; bj < 2; ++bj)
#pragma unroll
            for (int n = 0; n < 2; ++n) gv[bj][n] = *(const LAS f32x4*)(gtab + trow * 64 + 32 * bj + 8 * fq + 4 * n);
        const size_t hb = (size_t)head * kS * 64 + 8 * fq;
        const int g0 = 4 * wc + (fq >> 1), c0 = 8 * (fq & 1);
#pragma unroll
        for (int ai = 0; ai < 2; ++ai)
#pragma unroll
            for (int m = 0; m < 4; ++m) {
                const int row = u.pm * 256 + 128 * ai + 64 * wr + 16 * m + fr;
                float ss = 0.f;
#pragma unroll
                for (int bj = 0; bj < 2; ++bj)
#pragma unroll
                    for (int n = 0; n < 2; ++n) { const f32x4 v = acc[ai][bj][m][n]; ss += v.x * v.x + v.y * v.y + v.z * v.z + v.w * v.w; }
                ss = xsum32(xsum16(ss));
                const float rs = (PROBE == 2) ? 1.f : __builtin_amdgcn_rsqf(ss * (1.f / 64.f) + kEps), rstd = nrm ? rs : 1.f;
                const int b = row >> 13, sq = row & (kS - 1);
                const size_t o_qkv = ((size_t)b * H * kS + sq) * 64 + hb, o_u = ((size_t)g0 * 4096 + (row >> 4)) * 512 + (row & 15) * 16 + c0;
#pragma unroll
                for (int bj = 0; bj < 2; ++bj) {
                    const f32x4 v0 = acc[ai][bj][m][0] * rstd * gv[bj][0], v1 = acc[ai][bj][m][1] * rstd * gv[bj][1];
                    u32x4 w; w.x = pk2(v0.x, v0.y); w.y = pk2(v0.z, v0.w); w.z = pk2(v1.x, v1.y); w.w = pk2(v1.z, v1.w);
                    if constexpr (PROBE == 3) { *(u32x4*)(scratch + (size_t)blockIdx.x * 65536 + ((ai * 4 + m) * 2 + bj) * 4096 + tidx() * 8) = w; }
                    else { const size_t o = (pn < 9) ? o_qkv + 32 * bj : o_u + (size_t)bj * 2 * 4096 * 512;
                        if constexpr (PROBE == 1) { if (w.x == 0x7FC12345u && w.y == 0x7FC12345u) *(u32x4*)(dst + o) = w; }
                        else *(u32x4*)(dst + o) = w; }
                }
            }
    }
};
struct EpiResid {
    static constexpr int VMOPS = 16;
    const float* x32; bf16_t* xb; bf16_t* xbo;
    DEVI void operator()(const f32x4 (&acc)[2][2][4][2], const Unit& u, int wr, int wc, int fr, int fq) const {
#pragma unroll
        for (int ai = 0; ai < 2; ++ai) {
            const size_t r0 = (size_t)(u.pm * 256 + 128 * ai + 64 * wr + fr) * kD + u.pn * 256 + 32 * wc + 8 * fq;
            if (x32) {
                f32x4 a[4][2][2];
#pragma unroll
                for (int m = 0; m < 4; ++m)
#pragma unroll
                    for (int bj = 0; bj < 2; ++bj) { const size_t o = r0 + (size_t)m * 16 * kD + 128 * bj; a[m][bj][0] = *(const f32x4*)(x32 + o); a[m][bj][1] = *(const f32x4*)(x32 + o + 4); }
#pragma unroll
                for (int m = 0; m < 4; ++m)
#pragma unroll
                    for (int bj = 0; bj < 2; ++bj) { const size_t o = r0 + (size_t)m * 16 * kD + 128 * bj; const f32x4 v0 = a[m][bj][0] + acc[ai][bj][m][0], v1 = a[m][bj][1] + acc[ai][bj][m][1];
                        u32x4 r; r.x = pk2(v0.x, v0.y); r.y = pk2(v0.z, v0.w); r.z = pk2(v1.x, v1.y); r.w = pk2(v1.z, v1.w); *(u32x4*)(xbo + o) = r; }
            } else {
                u32x4 a[4][2];
#pragma unroll
                for (int m = 0; m < 4; ++m)
#pragma unroll
                    for (int bj = 0; bj < 2; ++bj) a[m][bj] = *(const u32x4*)(xb + r0 + (size_t)m * 16 * kD + 128 * bj);
#pragma unroll
                for (int m = 0; m < 4; ++m)
#pragma unroll
                    for (int bj = 0; bj < 2; ++bj) { const size_t o = r0 + (size_t)m * 16 * kD + 128 * bj; const u32x4 w = a[m][bj];
                        const f32x4 v0 = (f32x4){__uint_as_float(w.x << 16), __uint_as_float(w.x & 0xFFFF0000u), __uint_as_float(w.y << 16), __uint_as_float(w.y & 0xFFFF0000u)} + acc[ai][bj][m][0];
                        const f32x4 v1 = (f32x4){__uint_as_float(w.z << 16), __uint_as_float(w.z & 0xFFFF0000u), __uint_as_float(w.w << 16), __uint_as_float(w.w & 0xFFFF0000u)} + acc[ai][bj][m][1];
                        u32x4 r; r.x = pk2(v0.x, v0.y); r.y = pk2(v0.z, v0.w); r.z = pk2(v1.x, v1.y); r.w = pk2(v1.z, v1.w); *(u32x4*)(xbo + o) = r; }
            }
        }
    }
};
struct EpiGU {
    static constexpr int VMOPS = 4;
    bf16_t* hid; float sc; bool nomath;
    DEVI void silu8(const f32x4 (&acc)[2][2][4][2], int ai, int m, float (&o)[8]) const {
        const float k1 = -sc * kLog2e, k2 = sc * sc * (FP8_DN ? kH8 : 1.f);
#pragma unroll
        for (int n = 0; n < 2; ++n)
#pragma unroll
            for (int j = 0; j < 4; j += 2) { const f32x2 a = {acc[ai][0][m][n][j], acc[ai][0][m][n][j + 1]}, b = {acc[ai][1][m][n][j], acc[ai][1][m][n][j + 1]};
                const f32x2 ab = a * b, t = a * k1; f32x2 d; d.x = __builtin_amdgcn_exp2f(t.x); d.y = __builtin_amdgcn_exp2f(t.y); d = d + 1.f;
                f32x2 r; r.x = frcp(d.x); r.y = frcp(d.y); const f32x2 v = nomath ? ab * k2 : (ab * r) * k2;
                o[n * 4 + j] = v.x; o[n * 4 + j + 1] = v.y; }
    }
    DEVI void operator()(const f32x4 (&acc)[2][2][4][2], const Unit& u, int wr, int wc, int fr, int fq) const {
#pragma unroll
        for (int ai = 0; ai < 2; ++ai)
#if FP8_DN
#pragma unroll
            for (int m = 0; m < 4; m += 2) {
                float o0[8], o1[8]; silu8(acc, ai, m, o0); silu8(acc, ai, m + 1, o1);
#pragma unroll
                for (int t = 0; t < 8; ++t) { o0[t] = __builtin_amdgcn_fmed3f(o0[t], -448.f, 448.f); o1[t] = __builtin_amdgcn_fmed3f(o1[t], -448.f, 448.f); }
                unsigned ax = pk4_fp8(o0[0], o0[1], o0[2], o0[3]), ay = pk4_fp8(o0[4], o0[5], o0[6], o0[7]), bx = pk4_fp8(o1[0], o1[1], o1[2], o1[3]), by = pk4_fp8(o1[4], o1[5], o1[6], o1[7]);
                swap16u(ax, bx); swap16u(ay, by);
                const size_t row = (size_t)(u.pm * 256 + 128 * ai + 64 * wr + 16 * (m + (fq & 1)) + fr);
                u32x4 w; w.x = ax; w.y = ay; w.z = bx; w.w = by;
                *(u32x4*)((unsigned char*)hid + row * kFF + u.pn * 128 + 32 * wc + 8 * (fq & ~1)) = w;
            }
#else
#pragma unroll
            for (int m = 0; m < 4; ++m) { const size_t row = (size_t)(u.pm * 256 + 128 * ai + 64 * wr + 16 * m + fr);
                float o[8]; silu8(acc, ai, m, o);
                u32x4 w; w.x = pk2(o[0], o[1]); w.y = pk2(o[2], o[3]); w.z = pk2(o[4], o[5]); w.w = pk2(o[6], o[7]);
                *(u32x4*)(hid + row * kFF + u.pn * 128 + 32 * wc + 8 * fq) = w;
            }
#endif
    }
};
struct EpiDry {
    static constexpr int VMOPS = 0;
    float* sink;
    DEVI void operator()(const f32x4 (&acc)[2][2][4][2], const Unit& u, int wr, int wc, int fr, int fq) const {
        float t = 0.f;
#pragma unroll
        for (int ai = 0; ai < 2; ++ai)
#pragma unroll
            for (int bj = 0; bj < 2; ++bj)
#pragma unroll
                for (int m = 0; m < 4; ++m)
#pragma unroll
                    for (int n = 0; n < 2; ++n) t += acc[ai][bj][m][n].x + acc[ai][bj][m][n].y + acc[ai][bj][m][n].z + acc[ai][bj][m][n].w;
        if (t == 1.2345e30f) sink[0] = t;
    }
};
struct EpiDown {
    static constexpr int VMOPS = 8;
    bf16_t* y; const float* gate; float sc;
    DEVI static unsigned pk4c(const f32x4 v) { return pk4_fp8(__builtin_amdgcn_fmed3f(v.x, -448.f, 448.f), __builtin_amdgcn_fmed3f(v.y, -448.f, 448.f), __builtin_amdgcn_fmed3f(v.z, -448.f, 448.f), __builtin_amdgcn_fmed3f(v.w, -448.f, 448.f)); }
    DEVI void operator()(const f32x4 (&acc)[2][2][4][2], const Unit& u, int wr, int wc, int fr, int fq) const {
        const float gv = sc * (FP8_Y ? kY8 : 1.f);
#pragma unroll
        for (int ai = 0; ai < 2; ++ai)
#if FP8_Y
#pragma unroll
            for (int m = 0; m < 4; m += 2)
#pragma unroll
                for (int bj = 0; bj < 2; ++bj) {
                    unsigned ax = pk4c(acc[ai][bj][m][0] * gv), ay = pk4c(acc[ai][bj][m][1] * gv), bx = pk4c(acc[ai][bj][m + 1][0] * gv), by = pk4c(acc[ai][bj][m + 1][1] * gv);
                    swap16u(ax, bx); swap16u(ay, by);
                    const size_t row = (size_t)(u.pm * 256 + 128 * ai + 64 * wr + 16 * (m + (fq & 1)) + fr);
                    u32x4 w; w.x = ax; w.y = ay; w.z = bx; w.w = by;
                    *(u32x4*)((unsigned char*)y + row * kD + u.pn * 256 + 128 * bj + 32 * wc + 8 * (fq & ~1)) = w;
                }
#else
#pragma unroll
            for (int m = 0; m < 4; ++m) { const size_t row = (size_t)(u.pm * 256 + 128 * ai + 64 * wr + 16 * m + fr);
#pragma unroll
                for (int bj = 0; bj < 2; ++bj) { const f32x4 v0 = acc[ai][bj][m][0] * gv, v1 = acc[ai][bj][m][1] * gv;
                    u32x4 w; w.x = pk2(v0.x, v0.y); w.y = pk2(v0.z, v0.w); w.z = pk2(v1.x, v1.y); w.w = pk2(v1.z, v1.w);
                    *(u32x4*)(y + row * kD + u.pn * 256 + 128 * bj + 32 * wc + 8 * fq) = w; } }
#endif
    }
};
struct EpiGlu {
    static constexpr int VMOPS = 16;
    const bf16_t* g; bf16_t* oc;
    DEVI void operator()(const f32x4 (&acc)[2][2][4][2], const Unit& u, int wr, int wc, int fr, int fq) const {
#pragma unroll
        for (int ai = 0; ai < 2; ++ai) {
            const size_t r0 = (size_t)(u.pm * 256 + 128 * ai + 64 * wr + fr) * 256 + 32 * wc + 8 * fq;
            u32x4 gw[4][2];
#pragma unroll
            for (int m = 0; m < 4; ++m)
#pragma unroll
                for (int bj = 0; bj < 2; ++bj) gw[m][bj] = *(const u32x4*)(g + r0 + (size_t)m * 16 * 256 + 128 * bj);
#pragma unroll
            for (int m = 0; m < 4; ++m)
#pragma unroll
                for (int bj = 0; bj < 2; ++bj) { const size_t o = r0 + (size_t)m * 16 * 256 + 128 * bj; float gg[8]; unpk8s(gg, gw[m][bj]); float o8[8];
#pragma unroll
                    for (int n = 0; n < 2; ++n)
#pragma unroll
                        for (int j = 0; j < 4; ++j) o8[n * 4 + j] = gg[n * 4 + j] * frcp(1.f + __expf(-acc[ai][bj][m][n][j]));
                    u32x4 w; w.x = pk2(o8[0], o8[1]); w.y = pk2(o8[2], o8[3]); w.z = pk2(o8[4], o8[5]); w.w = pk2(o8[6], o8[7]);
                    *(u32x4*)(oc + o) = w; }
        }
    }
};

DEVI void load_row64(const bf16_t* p, float* d) {
#pragma unroll
    for (int i = 0; i < 8; ++i) { const u32x4 v = *(const u32x4*)(p + i * 8);
        d[i * 8 + 0] = __uint_as_float(v.x << 16); d[i * 8 + 1] = __uint_as_float(v.x & 0xFFFF0000u); d[i * 8 + 2] = __uint_as_float(v.y << 16); d[i * 8 + 3] = __uint_as_float(v.y & 0xFFFF0000u);
        d[i * 8 + 4] = __uint_as_float(v.z << 16); d[i * 8 + 5] = __uint_as_float(v.z & 0xFFFF0000u); d[i * 8 + 6] = __uint_as_float(v.w << 16); d[i * 8 + 7] = __uint_as_float(v.w & 0xFFFF0000u); }
}
DEVI void store_row64(bf16_t* p, const float* d, float sc) {
#pragma unroll
    for (int i = 0; i < 8; ++i) { u32x4 w; w.x = pk2(d[i * 8] * sc, d[i * 8 + 1] * sc); w.y = pk2(d[i * 8 + 2] * sc, d[i * 8 + 3] * sc); w.z = pk2(d[i * 8 + 4] * sc, d[i * 8 + 5] * sc); w.w = pk2(d[i * 8 + 6] * sc, d[i * 8 + 7] * sc);
        *(u32x4*)(p + i * 8) = w; }
}
DEVI void phase_dilated_naive(const bf16_t* qa, const bf16_t* ka, const bf16_t* va, bf16_t* oac, float* lse, int bid, int nblk) {
    const int nitems = 3 * kB * 8 * (kS / kNT);
    for (int it = bid; it < nitems; it += nblk) {
        const int c = it / (kB * 8 * 16), r = it % (kB * 8 * 16), bh = r / 16, t = (r % 16) * kNT + tidx(), b = bh >> 3, h = bh & 7;
        const int dil = (c == 0) ? 1 : (c == 1) ? 4 : 16;
        const float slope = exp2f(-(float)(h + 1));
        const bf16_t* kb_ = ka + (size_t)bh * kS * 64; const bf16_t* vb_ = va + (size_t)bh * kS * 64;
        float q[64], o[64];
        load_row64(qa + ((size_t)bh * kS + t) * 64, q);
#pragma unroll
        for (int d = 0; d < 64; ++d) o[d] = 0.f;
        float m = -1e30f, l = 0.f;
        for (int rel = -64; rel <= 64; ++rel) {
            const int pos = t + rel * dil;
            if (pos < 0 || pos >= kS) continue;
            float kv[64]; load_row64(kb_ + (size_t)pos * 64, kv);
            float dot = 0.f;
#pragma unroll
            for (int d = 0; d < 64; ++d) dot += q[d] * kv[d];
            const float sc = dot * 0.125f - slope * (float)(dil * (rel < 0 ? -rel : rel));
            const float mn = fmaxf(m, sc), corr = __expf(m - mn), p = __expf(sc - mn);
            load_row64(vb_ + (size_t)pos * 64, kv);
            l = l * corr + p;
#pragma unroll
            for (int d = 0; d < 64; ++d) o[d] = o[d] * corr + p * kv[d];
            m = mn;
        }
        const size_t tok = (size_t)b * kS + t;
        store_row64(oac + ((size_t)c * kTok + tok) * 512 + h * 64, o, 1.f / l);
        lse[((size_t)c * kTok + tok) * 8 + h] = m + __logf(l);
    }
}
DEVI void phase_na_naive(const bf16_t* qb, const bf16_t* kbuf, const bf16_t* vbuf, const float* rpb  , bf16_t* ob, int bid, int nblk) {
    const int nitems = kB * 4 * (kS / kNT);
    for (int it = bid; it < nitems; it += nblk) {
        const int bh = it / 16, t = (it % 16) * kNT + tidx(), b = bh >> 2, h = bh & 3;
        const int r = t >> 6, cq = t & 63;
        int rs = r - 4; rs = rs < 0 ? 0 : (rs > 120 ? 120 : rs);
        int cs = cq - 8; cs = cs < 0 ? 0 : (cs > 48 ? 48 : cs);
        const bf16_t* kb_ = kbuf + (size_t)bh * kS * 64; const bf16_t* vb_ = vbuf + (size_t)bh * kS * 64;
        float q[64], o[64];
        load_row64(qb + ((size_t)bh * kS + t) * 64, q);
#pragma unroll
        for (int d = 0; d < 64; ++d) o[d] = 0.f;
        float m = -1e30f, l = 0.f;
        for (int kr = 0; kr < 8; ++kr)
            for (int kc = 0; kc < 16; ++kc) {
                const int krow = rs + kr, kcol = cs + kc, pos = krow * 64 + kcol;
                float kv[64]; load_row64(kb_ + (size_t)pos * 64, kv);
                float dot = 0.f;
#pragma unroll
                for (int d = 0; d < 64; ++d) dot += q[d] * kv[d];
                const float sc = dot * 0.125f + rpb[(h * 15 + (krow - r + 7)) * 31 + (kcol - cq + 15)];
                const float mn = fmaxf(m, sc), corr = __expf(m - mn), p = __expf(sc - mn);
                load_row64(vb_ + (size_t)pos * 64, kv);
                l = l * corr + p;
#pragma unroll
                for (int d = 0; d < 64; ++d) o[d] = o[d] * corr + p * kv[d];
                m = mn;
            }
        store_row64(ob + ((size_t)b * kS + t) * 256 + h * 64, o, 1.f / l);
    }
}

typedef float f32x16 __attribute__((ext_vector_type(16)));
typedef short s16x4 __attribute__((ext_vector_type(4)));
DEVI bf16x8 tr_pair(LAS unsigned char* p0, LAS unsigned char* p1) {
    const s16x4 a = __builtin_amdgcn_ds_read_tr16_b64_v4i16((LAS s16x4*)p0), b = __builtin_amdgcn_ds_read_tr16_b64_v4i16((LAS s16x4*)p1);
    return (bf16x8){a.x, a.y, a.z, a.w, b.x, b.y, b.z, b.w};
}
template <int VAR = 0>
DEVI void phase_dilated(const bf16_t* qa, const bf16_t* ka, const bf16_t* va, const float* gq, const float* gk, bf16_t* oac, float* lse, LAS unsigned char* lds, int bid, int nblk) {
    const int tid = tidx(), wid = __builtin_amdgcn_readfirstlane(tid >> 6), lane = tid & 63, h5 = lane >> 5, qc = lane & 31;
    LAS unsigned char* Kimg = lds; LAS unsigned char* Vimg = lds + 49152;
    float Mn;
    { float a = fabsf(gq[lane]), b = fabsf(gk[lane]);
#pragma unroll
      for (int m = 32; m >= 1; m >>= 1) { a = fmaxf(a, __shfl_xor(a, m)); b = fmaxf(b, __shfl_xor(b, m)); }
      Mn = 8.f * a * b; }
    const float Mb = Mn * kLog2e;
    unsigned koff[4];
#pragma unroll
    for (int s = 0; s < 4; ++s) koff[s] = (unsigned)((32 * wid + qc) * 128 + (((2 * s + h5) ^ (qc & 7)) << 4));
    unsigned voff[2];
    { const int g = lane >> 4, i16 = lane & 15, q = i16 >> 2, p = i16 & 3;
#pragma unroll
      for (int dt = 0; dt < 2; ++dt) { const int c = (2 * (g & 1) + (p >> 1) + 4 * dt) ^ ((q >> 1) << 2); voff[dt] = (unsigned)((32 * wid + 4 * h5 + q) * 128 + (c << 4) + 8 * (p & 1)); } }
    const float dbase = (float)(4 * h5 - qc);
    u32x4 pK[6], pV[6];
#define DIL_DECODE(unit_) const int c = (unit_) >> 11, rem = (unit_) & 2047, bh = rem >> 5, ub = rem & 31; \
        const int dsh = 2 * c, L = kS >> dsh, upc = 32 >> dsh, cls = ub >> (5 - dsh), u0 = (ub & (upc - 1)) << 8;
#define DIL_PREFETCH(unit_) do { DIL_DECODE(unit_) \
        const bf16_t* kbase = ka + (size_t)bh * kS * 64; const bf16_t* vbase = va + (size_t)bh * kS * 64; \
        _Pragma("unroll") for (int it = 0; it < 6; ++it) { const int id = it * kNT + tid, row = id >> 3, ch = id & 7; \
            int ki = u0 - 64 + row; ki = ki < 0 ? 0 : (ki > L - 1 ? L - 1 : ki); const size_t tok = (size_t)((ki << dsh) + cls); \
            pK[it] = *(const u32x4*)(kbase + tok * 64 + ch * 8); pV[it] = *(const u32x4*)(vbase + tok * 64 + ch * 8); } } while (0)
    if ((VAR & 8) || bid < 6144) DIL_PREFETCH(bid);
    for (int unit = bid; unit < 6144; unit += nblk) {
        DIL_DECODE(unit)
        const int q0 = u0 + 32 * wid, qtok = ((q0 + qc) << dsh) + cls;
        bf16x8 Qf[4];
#pragma unroll
        for (int s = 0; s < 4; ++s) Qf[s] = *(const bf16x8*)(qa + ((size_t)bh * kS + qtok) * 64 + 16 * s + 8 * h5);
        __syncthreads();
        if (!(VAR & 8)) {
#pragma unroll
        for (int it = 0; it < 6; ++it) { const int id = it * kNT + tid, row = id >> 3, ch = id & 7;
            *(LAS u32x4*)(Kimg + row * 128 + ((ch ^ (row & 7)) << 4)) = pK[it];
            *(LAS u32x4*)(Vimg + row * 128 + ((ch ^ (((row >> 1) & 1) << 2)) << 4)) = pV[it]; } }
        __syncthreads();
        if (!(VAR & 8) && unit + nblk < 6144) DIL_PREFETCH(unit + nblk);
        const float slope = exp2f(-(float)((bh & 7) + 1));
        const float c1 = 0.125f * kLog2e, c2 = slope * (float)(1 << dsh) * kLog2e;
        float sum = 0.f;
        f32x16 O[2];
#pragma unroll
        for (int dt = 0; dt < 2; ++dt)
#pragma unroll
            for (int i = 0; i < 16; ++i) O[dt][i] = 0.f;
#define DIL_QK(dst, kt_) do { _Pragma("unroll") for (int i = 0; i < 16; ++i) dst[i] = 0.f; \
            _Pragma("unroll") for (int s = 0; s < 4; ++s) { const bf16x8 Kf = *(const LAS bf16x8*)(Kimg + koff[s] + (kt_) * 4096); dst = __builtin_amdgcn_mfma_f32_32x32x16_bf16(Kf, Qf[s], dst, 0, 0, 0); } } while (0)
        f32x16 S, Sn;
        DIL_QK(S, 0);
        f32x2 sum2 = {0.f, 0.f};
        const float ndb = -dbase;
#pragma unroll
        for (int kt = 0; kt < 5; ++kt) {
            if (kt < 4) DIL_QK(Sn, kt + 1);
            const int kp0 = q0 - 64 + 32 * kt;
            const float tm = (kp0 >= 0 && kp0 < L) ? 0.f : -1e30f;
            const float cs = (kt < 2) ? c2 : -c2, c0 = ((kt == 0 || kt == 4) ? -64.f : (kt == 2 ? 0.f : -32.f)) * c2 - Mb + tm;
            const float bt = dbase * cs + c0;
#pragma unroll
            for (int i = 0; i < 16; i += 2) {
                const float k0 = (float)((i & 3) + 8 * (i >> 2)), k1 = (float)(((i + 1) & 3) + 8 * ((i + 1) >> 2));
                f32x2 t;
                if (kt == 2) { const f32x2 d = {fabsf(dbase + k0), fabsf(dbase + k1)}; t = d * cs + c0; }
                else t = (f32x2){k0, k1} * cs + bt;
                f32x2 sv = (f32x2){S[i], S[i + 1]} * c1 + t;
                if (kt == 0) { sv.x = (k0 >= ndb) ? sv.x : -1e30f; sv.y = (k1 >= ndb) ? sv.y : -1e30f; }
                if (kt == 4) { sv.x = (k0 <= ndb) ? sv.x : -1e30f; sv.y = (k1 <= ndb) ? sv.y : -1e30f; }
                f32x2 pv; pv.x = (VAR & 4) ? S[i] : __builtin_amdgcn_exp2f(sv.x); pv.y = (VAR & 4) ? S[i + 1] : __builtin_amdgcn_exp2f(sv.y);
                S[i] = pv.x; S[i + 1] = pv.y; sum2 += pv;
            }
            if (VAR & 2) { _Pragma("unroll") for (int i = 0; i < 16; ++i) O[0][i] += S[i]; }
            else
#pragma unroll
            for (int s2 = 0; s2 < 2; ++s2) {
                u32x4 pw; pw.x = pk2(S[8 * s2 + 0], S[8 * s2 + 1]); pw.y = pk2(S[8 * s2 + 2], S[8 * s2 + 3]); pw.z = pk2(S[8 * s2 + 4], S[8 * s2 + 5]); pw.w = pk2(S[8 * s2 + 6], S[8 * s2 + 7]);
                const bf16x8 Pf = __builtin_bit_cast(bf16x8, pw);
#pragma unroll
                for (int dt = 0; dt < 2; ++dt) { LAS unsigned char* vp = Vimg + voff[dt] + kt * 4096 + s2 * 2048;
                    const bf16x8 Vf = tr_pair(vp, vp + 1024);
                    O[dt] = __builtin_amdgcn_mfma_f32_32x32x16_bf16(Vf, Pf, O[dt], 0, 0, 0); }
            }
            if (kt < 4) S = Sn;
        }
#undef DIL_QK
        sum = sum2.x + sum2.y;
        sum = xsum32(sum);
        const float inv = 1.f / sum;
        const size_t tok = (size_t)(bh >> 3) * kS + qtok;
        if (VAR & 1) { float t = inv; _Pragma("unroll") for (int dt = 0; dt < 2; ++dt) _Pragma("unroll") for (int i = 0; i < 16; ++i) t += O[dt][i]; if (t == 1.2345e30f) lse[0] = t; }
        else {
        LAS unsigned char* ost = lds + 98304 + wid * 4096;
#pragma unroll
        for (int dt = 0; dt < 2; ++dt)
#pragma unroll
            for (int g4 = 0; g4 < 4; ++g4) { u32x2 w; w.x = pk2(O[dt][4 * g4] * inv, O[dt][4 * g4 + 1] * inv); w.y = pk2(O[dt][4 * g4 + 2] * inv, O[dt][4 * g4 + 3] * inv);
                *(LAS u32x2*)(ost + qc * 128 + (((4 * dt + g4) ^ (qc & 7)) << 4) + 8 * h5) = w; }
        if (h5 == 0) lse[((size_t)c * kTok + tok) * 8 + (bh & 7)] = Mn + __logf(sum);
        bf16_t* obase = oac + ((size_t)c * kTok + (size_t)(bh >> 3) * kS) * 512 + (bh & 7) * 64;
#pragma unroll
        for (int it = 0; it < 4; ++it) { const int r = it * 8 + (lane >> 3), ch = lane & 7;
            const u32x4 v = *(const LAS u32x4*)(ost + r * 128 + ((ch ^ (r & 7)) << 4));
            const size_t t2 = (size_t)(((q0 + r) << dsh) + cls);
            *(u32x4*)(obase + t2 * 512 + ch * 8) = v; }
        }
    }
#undef DIL_DECODE
#undef DIL_PREFETCH
    __syncthreads();
}
DEVI void phase_na(const bf16_t* qb, const bf16_t* kb, const bf16_t* vb, const float* rpb  , bf16_t* ob, LAS unsigned char* lds, int bid, int nblk) {
    const int tid = tidx(), wid = __builtin_amdgcn_readfirstlane(tid >> 6), lane = tid & 63, g4 = lane >> 4, i16 = lane & 15;
    LAS unsigned char* Kimg = lds; LAS unsigned char* Vimg = lds + 73728; LAS float* tab = (LAS float*)(lds + 147456);
    for (int i = tid; i < 4 * 465; i += kNT) tab[i] = rpb[i];
    const int g = wid & 3, kcs = (16 * g - 8) < 0 ? 0 : ((16 * g - 8) > 32 ? 32 : (16 * g - 8));
    const int qcol = 16 * g + i16, cs = (qcol - 8) < 0 ? 0 : ((qcol - 8) > 48 ? 48 : (qcol - 8));
    unsigned kswz[2];
#pragma unroll
    for (int s = 0; s < 2; ++s) kswz[s] = (unsigned)(((4 * s + g4) ^ (i16 & 7)) << 4);
    const int q = i16 >> 2, p = i16 & 3, sw = 2 * (g4 & 1) + (q >> 1);
    unsigned vsw[4];
#pragma unroll
    for (int dt = 0; dt < 4; ++dt) vsw[dt] = (unsigned)((((2 * dt + (p >> 1)) ^ (sw << 1)) << 4) + 8 * (p & 1));
    for (int unit = bid; unit < 2048; unit += nblk) {
        const int bh = unit >> 6, rp = unit & 63, r0 = 2 * rp, h = bh & 3;
        const int rsA = (r0 - 4) < 0 ? 0 : ((r0 - 4) > 120 ? 120 : (r0 - 4));
        const bf16_t* kbase = kb + (size_t)bh * kS * 64; const bf16_t* vbase = vb + (size_t)bh * kS * 64;
        __syncthreads();
#pragma unroll
        for (int it = 0; it < 9; ++it) {
            const int id = it * kNT + tid, row = id >> 3, ch = id & 7;
            int gr = rsA + (row >> 6); gr = gr > 127 ? 127 : gr;
            const size_t tok = (size_t)(gr * 64 + (row & 63));
            const u32x4 kv = *(const u32x4*)(kbase + tok * 64 + ch * 8), vv = *(const u32x4*)(vbase + tok * 64 + ch * 8);
            *(LAS u32x4*)(Kimg + row * 128 + ((ch ^ (row & 7)) << 4)) = kv;
            *(LAS u32x4*)(Vimg + row * 128 + ((ch ^ (((row >> 1) & 3) << 1)) << 4)) = vv;
        }
        __syncthreads();
        const int rr = r0 + (wid >> 2);
        const int rs = (rr - 4) < 0 ? 0 : ((rr - 4) > 120 ? 120 : (rr - 4)), ro = rs - rsA;
        const int qtok = rr * 64 + qcol;
        bf16x8 Qf[2];
#pragma unroll
        for (int s = 0; s < 2; ++s) Qf[s] = *(const bf16x8*)(qb + ((size_t)bh * kS + qtok) * 64 + 32 * s + 8 * g4);
        f32x4 S[16];
        const unsigned kb0 = (unsigned)((ro * 64 + kcs + i16) * 128);
#pragma unroll
        for (int t = 0; t < 16; ++t) { S[t] = (f32x4){0.f, 0.f, 0.f, 0.f};
#pragma unroll
            for (int s = 0; s < 2; ++s) { const bf16x8 Kf = *(const LAS bf16x8*)(Kimg + kb0 + (t >> 1) * 8192 + (t & 1) * 2048 + kswz[s]); S[t] = __builtin_amdgcn_mfma_f32_16x16x32_bf16(Kf, Qf[s], S[t], 0, 0, 0); } }
        float mx = -1e30f;
        const LAS float* th = tab + h * 465;
        int g4v = g4; asm volatile("" : "+v"(g4v));
#pragma unroll
        for (int t = 0; t < 16; ++t)
#pragma unroll
            for (int j = 0; j < 4; ++j) {
                const int krow = rs + (t >> 1), kcol = kcs + 16 * (t & 1) + 4 * g4v + j;
                const bool valid = (kcol >= cs) && (kcol < cs + 16);
                int dc = kcol - qcol + 15; dc = dc < 0 ? 0 : (dc > 30 ? 30 : dc);
                const float bias = th[(krow - rr + 7) * 31 + dc];
                const float sv = valid ? (S[t][j] * 0.125f + bias) * kLog2e : -1e30f;
                S[t][j] = sv; mx = fmaxf(mx, sv);
            }
        mx = xmax32(xmax16(mx));
        float sum = 0.f;
#pragma unroll
        for (int t = 0; t < 16; ++t)
#pragma unroll
            for (int j = 0; j < 4; ++j) { const float pv = __builtin_amdgcn_exp2f(S[t][j] - mx); S[t][j] = pv; sum += pv; }
        sum = xsum32(xsum16(sum));
        f32x4 O[4];
#pragma unroll
        for (int dt = 0; dt < 4; ++dt) O[dt] = (f32x4){0.f, 0.f, 0.f, 0.f};
        const unsigned vb0 = (unsigned)((ro * 64 + kcs + 4 * g4 + q) * 128);
#pragma unroll
        for (int u = 0; u < 8; ++u) {
            u32x4 pw; pw.x = pk2(S[2 * u][0], S[2 * u][1]); pw.y = pk2(S[2 * u][2], S[2 * u][3]); pw.z = pk2(S[2 * u + 1][0], S[2 * u + 1][1]); pw.w = pk2(S[2 * u + 1][2], S[2 * u + 1][3]);
            const bf16x8 Pf = __builtin_bit_cast(bf16x8, pw);
#pragma unroll
            for (int dt = 0; dt < 4; ++dt) { LAS unsigned char* vp = Vimg + vb0 + u * 8192 + vsw[dt];
                const bf16x8 Vf = tr_pair(vp, vp + 2048);
                O[dt] = __builtin_amdgcn_mfma_f32_16x16x32_bf16(Vf, Pf, O[dt], 0, 0, 0); }
        }
        const float inv = 1.f / sum;
        bf16_t* orow = ob + ((size_t)(bh >> 2) * kS + qtok) * 256 + h * 64;
#pragma unroll
        for (int dt = 0; dt < 4; ++dt) { u32x2 w; w.x = pk2(O[dt][0] * inv, O[dt][1] * inv); w.y = pk2(O[dt][2] * inv, O[dt][3] * inv); *(u32x2*)(orow + 16 * dt + 4 * g4) = w; }
    }
    __syncthreads();
}
DEVI void phase_s5_naive(const Params& P, int l, const bf16_t* ux, float* ys, unsigned char* lds, int bid, int nblk) {
    const int wid = tidx() >> 6, lane = tidx() & 63;
    float* xs = (float*)lds + wid * 128;
    for (int item = wid * nblk + bid; item < kB * 16 * 2; item += nblk * 8) {
        const int dir = item & 1, g = (item >> 1) & 15, b = item >> 5;
        const size_t pbase = (((size_t)l * 2 + dir) * 16 + g) * 64;
        const float dt = __expf(P.s5_log_dt[((size_t)l * 2 + dir) * 16 + g]);
        const float a = fminf(P.s5_a_re[pbase + lane], -1e-4f), w = P.s5_a_im[pbase + lane];
        const float mag = __expf(a * dt), ar = mag * cosf(w * dt), ai = mag * sinf(w * dt);
        const float den = a * a + w * w, zr = ar - 1.f, gr = (zr * a + ai * w) / den, gi = (ai * a - zr * w) / den;
        float bbr[16], bbi[16];
#pragma unroll
        for (int c = 0; c < 16; ++c) { const float br = P.s5_b_re[(pbase + lane) * 16 + c], bi = P.s5_b_im[(pbase + lane) * 16 + c]; bbr[c] = gr * br - gi * bi; bbi[c] = gr * bi + gi * br; }
        const int cch = lane & 15, qt = lane >> 4;
        float cre[16], cim[16];
#pragma unroll
        for (int pp = 0; pp < 16; ++pp) { cre[pp] = P.s5_c_re[(pbase / 64 * 16 + cch) * 64 + qt * 16 + pp]; cim[pp] = P.s5_c_im[(pbase / 64 * 16 + cch) * 64 + qt * 16 + pp]; }
        float xr = 0.f, xi = 0.f;
        const bf16_t* ug = ux + (size_t)g * 4096 * 512;
        for (int st = 0; st < kS; ++st) {
            const int s = dir ? (kS - 1 - st) : st; const size_t tok = (size_t)b * kS + s;
            const bf16_t* up = ug + (tok >> 4) * 512 + (tok & 15) * 16;
            const u32x4 u0 = *(const u32x4*)up, u1 = *(const u32x4*)(up + 8);
            float uv[16];
            uv[0] = __uint_as_float(u0.x << 16); uv[1] = __uint_as_float(u0.x & 0xFFFF0000u); uv[2] = __uint_as_float(u0.y << 16); uv[3] = __uint_as_float(u0.y & 0xFFFF0000u);
            uv[4] = __uint_as_float(u0.z << 16); uv[5] = __uint_as_float(u0.z & 0xFFFF0000u); uv[6] = __uint_as_float(u0.w << 16); uv[7] = __uint_as_float(u0.w & 0xFFFF0000u);
            uv[8] = __uint_as_float(u1.x << 16); uv[9] = __uint_as_float(u1.x & 0xFFFF0000u); uv[10] = __uint_as_float(u1.y << 16); uv[11] = __uint_as_float(u1.y & 0xFFFF0000u);
            uv[12] = __uint_as_float(u1.z << 16); uv[13] = __uint_as_float(u1.z & 0xFFFF0000u); uv[14] = __uint_as_float(u1.w << 16); uv[15] = __uint_as_float(u1.w & 0xFFFF0000u);
            float bur = 0.f, bui = 0.f;
#pragma unroll
            for (int c = 0; c < 16; ++c) { bur += bbr[c] * uv[c]; bui += bbi[c] * uv[c]; }
            const float nr = ar * xr - ai * xi + bur, ni = ar * xi + ai * xr + bui; xr = nr; xi = ni;
            xs[lane] = xr; xs[64 + lane] = xi;
            asm volatile("s_waitcnt lgkmcnt(0)" ::: "memory");
            float y = 0.f;
#pragma unroll
            for (int pp = 0; pp < 16; ++pp) y += cre[pp] * xs[qt * 16 + pp] - cim[pp] * xs[64 + qt * 16 + pp];
            asm volatile("s_waitcnt lgkmcnt(0)" ::: "memory");
            y += __shfl_xor(y, 16); y += __shfl_xor(y, 32);
            if (lane < 16) ys[((size_t)dir * kTok + tok) * 256 + g * 16 + cch] = y;
        }
    }
}
DEVI void phase_s5_finish(const float* ys, const bf16_t* ux, const float* dskip, bf16_t* G, int bid, int nblk) {
    for (size_t i = (size_t)bid * kNT + tidx(); i < (size_t)kTok * 256; i += (size_t)nblk * kNT) {
        const size_t tok = i >> 8; const int ch = (int)(i & 255), g = ch >> 4, c = ch & 15;
        const float u = bf2f(ux[((size_t)g * 4096 + (tok >> 4)) * 512 + (tok & 15) * 16 + c]);
        const float y = ys[i] + ys[(size_t)kTok * 256 + i] + dskip[ch] * u;
        G[i] = f2bf(gelu_tanh(y));
    }
}
DEVI void unpk8(float* d, const u32x4 q, const float sc) {
    d[0] += sc * __uint_as_float(q.x << 16); d[1] += sc * __uint_as_float(q.x & 0xFFFF0000u); d[2] += sc * __uint_as_float(q.y << 16); d[3] += sc * __uint_as_float(q.y & 0xFFFF0000u);
    d[4] += sc * __uint_as_float(q.z << 16); d[5] += sc * __uint_as_float(q.z & 0xFFFF0000u); d[6] += sc * __uint_as_float(q.w << 16); d[7] += sc * __uint_as_float(q.w & 0xFFFF0000u);
}
DEVI void phase_mixnorm(const bf16_t* oac, const float* lse, const bf16_t* ob, const bf16_t* oc, const float* ga, const float* gb, const float* gc, bf16_t* mix, int bid, int nblk) {
    const int wid = tidx() >> 6, lane = tidx() & 63;
    float gn[16];
    { const float* gp = (lane < 32) ? ga + lane * 16 : (lane < 48) ? gb + (lane - 32) * 16 : gc + (lane - 48) * 16;
#pragma unroll
      for (int i = 0; i < 16; ++i) gn[i] = gp[i]; }
    for (int row = bid * 8 + wid; row < kTok; row += nblk * 8) {
        float v[16];
#pragma unroll
        for (int i = 0; i < 16; ++i) v[i] = 0.f;
        if (lane < 32) {
            const int h = lane >> 2;
            const float l0 = lse[(size_t)row * 8 + h], l1 = lse[((size_t)kTok + row) * 8 + h], l2 = lse[((size_t)2 * kTok + row) * 8 + h];
            const bf16_t* p0 = oac + (size_t)row * 512 + lane * 16; const bf16_t* p1 = p0 + (size_t)kTok * 512; const bf16_t* p2 = p1 + (size_t)kTok * 512;
            const u32x4 a0 = *(const u32x4*)p0, a1 = *(const u32x4*)(p0 + 8), b0 = *(const u32x4*)p1, b1 = *(const u32x4*)(p1 + 8), c0 = *(const u32x4*)p2, c1 = *(const u32x4*)(p2 + 8);
            const float mx = fmaxf(l0, fmaxf(l1, l2)); float w0 = __expf(l0 - mx), w1 = __expf(l1 - mx), w2 = __expf(l2 - mx); const float inv = frcp(w0 + w1 + w2); w0 *= inv; w1 *= inv; w2 *= inv;
            unpk8(v, a0, w0); unpk8(v + 8, a1, w0); unpk8(v, b0, w1); unpk8(v + 8, b1, w1); unpk8(v, c0, w2); unpk8(v + 8, c1, w2);
        } else {
            const bf16_t* p = (lane < 48) ? ob + (size_t)row * 256 + (lane - 32) * 16 : oc + (size_t)row * 256 + (lane - 48) * 16;
            const u32x4 a0 = *(const u32x4*)p, a1 = *(const u32x4*)(p + 8);
            unpk8(v, a0, 1.f); unpk8(v + 8, a1, 1.f);
        }
        float ss = 0.f;
#pragma unroll
        for (int i = 0; i < 16; ++i) ss += v[i] * v[i];
        ss = row_sum16(ss);
        { float a = ss, b = ss; swap16(a, b); if (lane < 32) ss = a + b; }
        const float rstd = rsqrtf(ss * ((lane < 32) ? (1.f / 512.f) : (1.f / 256.f)) + kEps);
        if (EMU_FP8_WOUT) {
#pragma unroll
            for (int i = 0; i < 16; ++i) v[i] = q8(v[i] * rstd * gn[i], 1.f, 1.f) / (rstd * gn[i]);
        }
        u32x4 w0, w1;
        w0.x = pk2(v[0] * rstd * gn[0], v[1] * rstd * gn[1]); w0.y = pk2(v[2] * rstd * gn[2], v[3] * rstd * gn[3]); w0.z = pk2(v[4] * rstd * gn[4], v[5] * rstd * gn[5]); w0.w = pk2(v[6] * rstd * gn[6], v[7] * rstd * gn[7]);
        w1.x = pk2(v[8] * rstd * gn[8], v[9] * rstd * gn[9]); w1.y = pk2(v[10] * rstd * gn[10], v[11] * rstd * gn[11]); w1.z = pk2(v[12] * rstd * gn[12], v[13] * rstd * gn[13]); w1.w = pk2(v[14] * rstd * gn[14], v[15] * rstd * gn[15]);
        *(u32x4*)(mix + (size_t)row * kD + lane * 16) = w0; *(u32x4*)(mix + (size_t)row * kD + lane * 16 + 8) = w1;
    }
}
DEVI void phase_combine(bf16_t* xb, bf16_t* xbo, float* out32, const bf16_t* y, const float* gate, const int* tokslot, const float* gain_next, bf16_t* h, int bid, int nblk) {
    const int wid = tidx() >> 6, lane = tidx() & 63;
    float g[16];
#pragma unroll
    for (int i = 0; i < 16; ++i) g[i] = gain_next ? gain_next[lane * 16 + i] : 0.f;
    const int stride = nblk * 8;
    int row = bid * 8 + wid;
    u32x4 nv0, nv1; int nts = 0;
    if (row < kTok) { nts = tokslot[(size_t)row * kE + (lane & 15)]; nv0 = *(const u32x4*)(xb + (size_t)row * kD + lane * 16); nv1 = *(const u32x4*)(xb + (size_t)row * kD + lane * 16 + 8); }
    for (; row < kTok; row += stride) {
        const int b = row >> 13;
        const int ts = nts;
        float v[16];
        unpk8s(v, nv0); unpk8s(v + 8, nv1);
        const int nrow = row + stride;
        if (nrow < kTok) { nts = tokslot[(size_t)nrow * kE + (lane & 15)]; nv0 = *(const u32x4*)(xb + (size_t)nrow * kD + lane * 16); nv1 = *(const u32x4*)(xb + (size_t)nrow * kD + lane * 16 + 8); }
#pragma unroll
        for (int e0 = 0; e0 < kE; e0 += 8) {
#if FP8_Y
            u32x4 yv[8]; float gt[8];
#pragma unroll
            for (int e = 0; e < 8; ++e) { const int slot = __builtin_amdgcn_readlane(ts, e0 + e);
                if (slot >= 0) { const size_t r = (size_t)((e0 + e) * kB + b) * kCap + slot; yv[e] = *(const u32x4*)((const unsigned char*)y + r * kD + lane * 16); gt[e] = gate[r]; } }
#pragma unroll
            for (int e = 0; e < 8; ++e) { const int slot = __builtin_amdgcn_readlane(ts, e0 + e);
                if (slot >= 0) { const unsigned ww[4] = {yv[e].x, yv[e].y, yv[e].z, yv[e].w}; const float gs = gt[e] * (1.f / kY8);
#pragma unroll
                    for (int k = 0; k < 4; ++k) { const f32x2 lo = __builtin_amdgcn_cvt_pk_f32_fp8(ww[k], false), hi = __builtin_amdgcn_cvt_pk_f32_fp8(ww[k], true);
                        v[4 * k] += lo.x * gs; v[4 * k + 1] += lo.y * gs; v[4 * k + 2] += hi.x * gs; v[4 * k + 3] += hi.y * gs; } } }
#else
            u32x4 yv[8][2];
#pragma unroll
            for (int e = 0; e < 8; ++e) { const int slot = __builtin_amdgcn_readlane(ts, e0 + e);
                if (slot >= 0) { const bf16_t* yr = y + ((size_t)((e0 + e) * kB + b) * kCap + slot) * kD + lane * 16; yv[e][0] = *(const u32x4*)yr; yv[e][1] = *(const u32x4*)(yr + 8); } }
#pragma unroll
            for (int e = 0; e < 8; ++e) { const int slot = __builtin_amdgcn_readlane(ts, e0 + e);
                if (slot >= 0) { const float gs = gate[(size_t)((e0 + e) * kB + b) * kCap + slot]; unpk8(v, yv[e][0], gs); unpk8(v + 8, yv[e][1], gs); } }
#endif
        }
        if (!gain_next) {
#pragma unroll
            for (int k = 0; k < 4; ++k) *(f32x4*)(out32 + (size_t)row * kD + lane * 16 + 4 * k) = (f32x4){v[4 * k], v[4 * k + 1], v[4 * k + 2], v[4 * k + 3]};
        } else {
            u32x4 o0, o1;
            o0.x = pk2(v[0], v[1]); o0.y = pk2(v[2], v[3]); o0.z = pk2(v[4], v[5]); o0.w = pk2(v[6], v[7]); o1.x = pk2(v[8], v[9]); o1.y = pk2(v[10], v[11]); o1.z = pk2(v[12], v[13]); o1.w = pk2(v[14], v[15]);
            *(u32x4*)(xbo + (size_t)row * kD + lane * 16) = o0; *(u32x4*)(xbo + (size_t)row * kD + lane * 16 + 8) = o1;
            unpk8s(v, o0); unpk8s(v + 8, o1);
            float ss = 0.f;
#pragma unroll
            for (int i = 0; i < 16; ++i) ss += v[i] * v[i];
            ss = wave_sum(ss); const float rstd = rsqrtf(ss * (1.f / kD) + kEps);
            u32x4 h0, h1;
            h0.x = pk2(v[0] * rstd * g[0], v[1] * rstd * g[1]); h0.y = pk2(v[2] * rstd * g[2], v[3] * rstd * g[3]); h0.z = pk2(v[4] * rstd * g[4], v[5] * rstd * g[5]); h0.w = pk2(v[6] * rstd * g[6], v[7] * rstd * g[7]);
            h1.x = pk2(v[8] * rstd * g[8], v[9] * rstd * g[9]); h1.y = pk2(v[10] * rstd * g[10], v[11] * rstd * g[11]); h1.z = pk2(v[12] * rstd * g[12], v[13] * rstd * g[13]); h1.w = pk2(v[14] * rstd * g[14], v[15] * rstd * g[15]);
            *(u32x4*)(h + (size_t)row * kD + lane * 16) = h0; *(u32x4*)(h + (size_t)row * kD + lane * 16 + 8) = h1;
        }
    }
}

DEVI void cpow_m(double a, double w, double dt, int m, float& re, float& im) {
    const float mag = __expf((float)m * (float)a * (float)dt);
    const double turns = (double)m * w * dt * 0.15915494309189535; const float ang = (float)((turns - floor(turns)) * 6.283185307179586);
    re = mag * cosf(ang); im = mag * sinf(ang);
}
DEVI void s5_prep_item(const Params& P, int l, int g, unsigned char* lds_) {
    float* pw = (float*)lds_;
    float* bb = pw + 4352;
    float* cc = bb + 4096;
    float* kt = cc + 4096;
    const int tid = tidx();
    __syncthreads();
    for (int i = tid; i < 128; i += kNT) { const int dir = i >> 6, p = i & 63; const size_t pb = (((size_t)l * 2 + dir) * 16 + g) * 64 + p;
        const double dt = (double)__expf(P.s5_log_dt[((size_t)l * 2 + dir) * 16 + g]); const double a = (double)fminf(P.s5_a_re[pb], -1e-4f), w = (double)P.s5_a_im[pb];
        for (int m = 0; m < 17; ++m) { float re, im; cpow_m(a, w, dt, m, re, im); pw[((dir * 64 + p) * 17 + m) * 2] = re; pw[((dir * 64 + p) * 17 + m) * 2 + 1] = im; }
        const float af = (float)a, wf = (float)w, ar = pw[((dir * 64 + p) * 17 + 1) * 2], ai = pw[((dir * 64 + p) * 17 + 1) * 2 + 1];
        const float den = af * af + wf * wf, zr = ar - 1.f, gr = (zr * af + ai * wf) / den, gi = (ai * af - zr * wf) / den;
        for (int c = 0; c < 16; ++c) { const float br = P.s5_b_re[pb * 16 + c], bi = P.s5_b_im[pb * 16 + c]; bb[((dir * 64 + p) * 16 + c) * 2] = gr * br - gi * bi; bb[((dir * 64 + p) * 16 + c) * 2 + 1] = gr * bi + gi * br; }
    }
    for (int i = tid; i < 2048; i += kNT) { const int dir = i >> 10, c = (i >> 6) & 15, p = i & 63; const size_t o = ((((size_t)l * 2 + dir) * 16 + g) * 16 + c) * 64 + p; cc[i * 2] = P.s5_c_re[o]; cc[i * 2 + 1] = P.s5_c_im[o]; }
    __syncthreads();
    for (int i = tid; i < 8192; i += kNT) { const int dir = i >> 12, m = (i >> 8) & 15, c = (i >> 4) & 15, c2 = i & 15; float acc = 0.f;
        for (int p = 0; p < 64; ++p) { const float cr = cc[((dir * 16 + c) * 64 + p) * 2], ci = cc[((dir * 16 + c) * 64 + p) * 2 + 1], wr_ = pw[((dir * 64 + p) * 17 + m) * 2], wi_ = pw[((dir * 64 + p) * 17 + m) * 2 + 1];
            const float br = bb[((dir * 64 + p) * 16 + c2) * 2], bi = bb[((dir * 64 + p) * 16 + c2) * 2 + 1]; const float tr = cr * wr_ - ci * wi_, ti = cr * wi_ + ci * wr_; acc += tr * br - ti * bi; }
        kt[i] = acc; }
    __syncthreads();
    bf16_t* wst = (bf16_t*)(wsp(P) + WS_WST) + ((size_t)l * 16 + g) * 256 * 256;
    bf16_t* wso = (bf16_t*)(wsp(P) + WS_WSO) + ((size_t)l * 16 + g) * 256 * 512;
    for (int id = tid; id < 8192; id += kNT) { const int n = id >> 5, k0 = (id & 31) * 8, dir = n >> 7, p = (n >> 1) & 63, ri = n & 1; float v[8];
#pragma unroll
        for (int kk = 0; kk < 8; ++kk) { const int k = k0 + kk, t = k >> 4, c = k & 15, e = dir ? t : 15 - t; const float wr_ = pw[((dir * 64 + p) * 17 + e) * 2], wi_ = pw[((dir * 64 + p) * 17 + e) * 2 + 1], br = bb[((dir * 64 + p) * 16 + c) * 2], bi = bb[((dir * 64 + p) * 16 + c) * 2 + 1];
            v[kk] = ri ? (wr_ * bi + wi_ * br) : (wr_ * br - wi_ * bi); }
        u32x4 o; o.x = pk2(v[0], v[1]); o.y = pk2(v[2], v[3]); o.z = pk2(v[4], v[5]); o.w = pk2(v[6], v[7]); *(u32x4*)(wst + (size_t)n * 256 + k0) = o; }
    for (int id = tid; id < 16384; id += kNT) { const int ns = id >> 6, k0 = (id & 63) * 8, n = cmap_pk(ns), t = n >> 4, c = n & 15; float v[8];
#pragma unroll
        for (int kk = 0; kk < 8; ++kk) { const int k = k0 + kk; float x;
            if (k < 256) { const int j = k >> 4, c2 = k & 15; x = 0.f; if (j <= t) x += kt[(t - j) * 256 + c * 16 + c2]; if (j >= t) x += kt[4096 + (j - t) * 256 + c * 16 + c2]; if (j == t && c == c2) x += P.s5_d[l * 256 + g * 16 + c]; }
            else { const int q = k - 256, dir = q >> 7, p = (q >> 1) & 63, ri = q & 1, e = dir ? 16 - t : t + 1; const float cr = cc[((dir * 16 + c) * 64 + p) * 2], ci = cc[((dir * 16 + c) * 64 + p) * 2 + 1], wr_ = pw[((dir * 64 + p) * 17 + e) * 2], wi_ = pw[((dir * 64 + p) * 17 + e) * 2 + 1];
                x = ri ? -(cr * wi_ + ci * wr_) : (cr * wr_ - ci * wi_); }
            v[kk] = x; }
        u32x4 o; o.x = pk2(v[0], v[1]); o.y = pk2(v[2], v[3]); o.z = pk2(v[4], v[5]); o.w = pk2(v[6], v[7]); *(u32x4*)(wso + (size_t)ns * 512 + k0) = o; }
    __syncthreads();
}
DEVI void phase_s5_scan(const Params& P, int l, const float* Z, bf16_t* ux, unsigned char* lds_, int bid, int nblk) {
    const int tid = tidx(), wid = tid >> 6, lane = tid & 63;
    float* E = (float*)lds_;
    for (int item = bid; item < 256; item += nblk) {
        const int dir = item & 1, g = (item >> 1) & 15, b = item >> 5;
        const size_t pb = (((size_t)l * 2 + dir) * 16 + g) * 64 + lane;
        const double dt = (double)__expf(P.s5_log_dt[((size_t)l * 2 + dir) * 16 + g]); const double a = (double)fminf(P.s5_a_re[pb], -1e-4f), w = (double)P.s5_a_im[pb];
        float a16r, a16i, Ar, Ai; cpow_m(a, w, dt, 16, a16r, a16i); cpow_m(a, w, dt, 1024, Ar, Ai);
        const int kk0 = dir ? 511 - 64 * wid : 64 * wid; const long sstep = dir ? -1 : 1;
        const float* zp = Z + ((size_t)g * 4096 + b * 512 + kk0) * 256 + dir * 128 + 2 * lane;
        f32x2 z[64];
#pragma unroll
        for (int i = 0; i < 64; ++i) { z[i] = *(const f32x2*)zp; zp += sstep * 256; }
        float xr = 0.f, xi = 0.f;
#pragma unroll
        for (int i = 0; i < 64; ++i) { const float nr = a16r * xr - a16i * xi + z[i].x, ni = a16r * xi + a16i * xr + z[i].y; xr = nr; xi = ni; }
        __syncthreads();
        E[(wid * 64 + lane) * 2] = xr; E[(wid * 64 + lane) * 2 + 1] = xi;
        __syncthreads();
        float sr = 0.f, si = 0.f;
#pragma unroll
        for (int s2 = 0; s2 < 7; ++s2) if (s2 < wid) { const float er = E[(s2 * 64 + lane) * 2], ei = E[(s2 * 64 + lane) * 2 + 1]; const float nr = Ar * sr - Ai * si + er, ni = Ar * si + Ai * sr + ei; sr = nr; si = ni; }
        bf16_t* up = ux + ((size_t)g * 4096 + b * 512 + kk0) * 512 + 256 + dir * 128 + 2 * lane;
#pragma unroll
        for (int i = 0; i < 64; ++i) { *(unsigned*)up = pk2(sr, si); up += sstep * 512;
            const float nr = a16r * sr - a16i * si + z[i].x, ni = a16r * si + a16i * sr + z[i].y; sr = nr; si = ni; }
    }
    __syncthreads();
}
struct EpiF32N {
    static constexpr int VMOPS = 32;
    float* z; int ldz;
    DEVI void operator()(const f32x4 (&acc)[2][2][4][2], const Unit& u, int wr, int wc, int fr, int fq) const {
#pragma unroll
        for (int ai = 0; ai < 2; ++ai)
#pragma unroll
            for (int m = 0; m < 4; ++m) { const size_t ro = (size_t)(u.pm * 256 + 128 * ai + 64 * wr + 16 * m + fr) * ldz + u.pn * 256 + 32 * wc + 4 * fq;
#pragma unroll
                for (int bj = 0; bj < 2; ++bj)
#pragma unroll
                    for (int n = 0; n < 2; ++n) *(f32x4*)(z + ro + 128 * bj + 16 * n) = acc[ai][bj][m][n]; }
    }
};
struct EpiS5Out {
    static constexpr int VMOPS = 16;
    bf16_t* G;
    DEVI void operator()(const f32x4 (&acc)[2][2][4][2], const Unit& u, int wr, int wc, int fr, int fq) const {
#pragma unroll
        for (int ai = 0; ai < 2; ++ai)
#pragma unroll
            for (int m = 0; m < 4; ++m) { const int R = u.pm * 256 + 128 * ai + 64 * wr + 16 * m + fr, g = R >> 12, ck = R & 4095;
#pragma unroll
                for (int bj = 0; bj < 2; ++bj) { const int t = 8 * bj + 2 * wc + (fq >> 1), c0 = 8 * (fq & 1);
                    const f32x4 v0 = acc[ai][bj][m][0], v1 = acc[ai][bj][m][1];
                    u32x4 w; w.x = pk2(gelu_tanh(v0.x), gelu_tanh(v0.y)); w.y = pk2(gelu_tanh(v0.z), gelu_tanh(v0.w)); w.z = pk2(gelu_tanh(v1.x), gelu_tanh(v1.y)); w.w = pk2(gelu_tanh(v1.z), gelu_tanh(v1.w));
                    *(u32x4*)(G + ((size_t)ck * 16 + t) * 256 + g * 16 + c0) = w; } }
    }
};
#define XB_TMO      128
#define XB_XCNT(j)  (256  + 64 * (j))
#define XB_XSUB(j)  (1280 + 64 * (j))
#define XB_XGEN(j)  (2304 + 64 * (j))
#define XB_TOP      3328
#define XB_TOPGEN   3392
#define XCD_BAR_WORDS 3456
#define XB_SPIN_CAP (1u << 26)
DEVI unsigned xb_ld(unsigned* p)              { return __hip_atomic_load(p, __ATOMIC_RELAXED, __HIP_MEMORY_SCOPE_AGENT); }
DEVI unsigned xb_add(unsigned* p, unsigned v) { return __hip_atomic_fetch_add(p, v, __ATOMIC_RELAXED, __HIP_MEMORY_SCOPE_AGENT); }
DEVI unsigned xb_xcc_id() { return (unsigned)__builtin_amdgcn_s_getreg((3 << 11) | 20) & 0xFu; }
#define XB_SPIN(cond, bar) do { unsigned _sp = 0; while (cond) { __builtin_amdgcn_s_sleep(1); \
    if ((++_sp & 255u) == 0u) { if (xb_ld(&(bar)[XB_TMO])) break; if (_sp > XB_SPIN_CAP) { atomicAdd(&(bar)[XB_TMO], 1u); break; } } } } while (0)
struct XcdBarrier { unsigned* bar; unsigned x; volatile LAS unsigned* st; };
DEVI XcdBarrier xcd_barrier_post(unsigned* bar, volatile LAS unsigned* st) {
    XcdBarrier b; b.bar = bar; b.x = xb_xcc_id(); b.st = st;
    if (threadIdx.x == 0) (void)xb_add(&bar[XB_XCNT(b.x)], 1u);
    return b;
}
DEVI void xcd_barrier_complete(unsigned* bar, unsigned x, unsigned& nloc, unsigned& nx) {
    const unsigned G = gridDim.x * gridDim.y * gridDim.z;
    unsigned sum, cnt, mine, sp = 0u;
    for (;;) {
        sum = 0u; cnt = 0u; mine = 0u;
#pragma unroll
        for (unsigned j = 0; j < 16; ++j) { const unsigned c = xb_ld(&bar[XB_XCNT(j)]); sum += c; cnt += (c > 0u) ? 1u : 0u; mine = (j == x) ? c : mine; }
        if (sum == G) break;
        __builtin_amdgcn_s_sleep(1);
        if ((++sp & 255u) == 0u) { if (xb_ld(&bar[XB_TMO])) break; if (sp > XB_SPIN_CAP) { atomicAdd(&bar[XB_TMO], 1u); break; } }
    }
    nloc = mine > 0u ? mine : 1u; nx = cnt > 0u ? cnt : 1u;
}
DEVI void xcd_barrier(const XcdBarrier& b) {
    asm volatile("s_waitcnt vmcnt(0)" ::: "memory");
    __syncthreads();
    if (threadIdx.x == 0) {
        unsigned long long bp_ = (unsigned long long)b.bar; asm volatile("" : "+s"(bp_));
        unsigned* bar = (unsigned*)bp_;
        const unsigned bx = xb_xcc_id();
        __builtin_amdgcn_s_waitcnt(0);
        unsigned nloc = b.st[0], nx = b.st[1];
        if (nloc == 0u) { xcd_barrier_complete(bar, bx, nloc, nx); b.st[0] = nloc; b.st[1] = nx; }
        const unsigned old = xb_add(&bar[XB_XSUB(bx)], 1u);
        const unsigned gen = old / nloc;
        if (old + 1u == (gen + 1u) * nloc) {
            __builtin_amdgcn_fence(__ATOMIC_RELEASE, "agent");
            asm volatile("s_waitcnt vmcnt(0)" ::: "memory");
            const unsigned og = xb_add(&bar[XB_TOP], 1u);
            const unsigned tg = og / nx;
            if (og + 1u == (tg + 1u) * nx) xb_add(&bar[XB_TOPGEN], 1u);
            else XB_SPIN(xb_ld(&bar[XB_TOPGEN]) == tg, bar);
            __builtin_amdgcn_fence(__ATOMIC_ACQUIRE, "agent");
            xb_add(&bar[XB_XGEN(bx)], 1u);
            asm volatile("s_waitcnt vmcnt(0)" ::: "memory");
        } else {
            XB_SPIN(xb_ld(&bar[XB_XGEN(bx)]) == gen, bar);
            __builtin_amdgcn_fence(__ATOMIC_ACQUIRE, "agent");
            asm volatile("s_waitcnt vmcnt(0)" ::: "memory");
        }
    }
    __syncthreads();
}

#ifndef MEGA
#define MEGA 1
#endif
#ifndef STAGGER_WIN
#define STAGGER_WIN 0
#endif
#ifndef USE_ENGINE
#define USE_ENGINE 1
#endif
constexpr int LDS_BYTES = 147456 + 8192 + 16;
#if USE_ENGINE
#define GEMM_RUN(g, E) gemm_engine<decltype(E), true, true>((LAS unsigned char*)dyn_lds, g, E, bid, nblk)
#define GEMM_RUN8(g, E) gemm_engine<decltype(E), true, true, true>((LAS unsigned char*)dyn_lds, g, E, bid, nblk)
#else
#define GEMM_RUN(g, E) gemm_simple(g, E, bid, nblk)
#endif
extern __shared__ __attribute__((aligned(16))) unsigned char dyn_lds[];

DEVI GemmD mk_gemm(const bf16_t* A, const bf16_t* Bt, int lda, int K, int nM, int nN, const int* rowidx, size_t bstride, int pmg) {
    GemmD g; g.A = A; g.Bt = Bt; g.lda = lda; g.K = K; g.nM = nM; g.nN = nN; g.rowidx = rowidx; g.bstride = bstride; g.pmg = pmg; g.stagger_10ns = 0; return g; }

template <int PROBE = 0> DEVI void ph_win(const Params& P, int l, int bid, int nblk) {
    const GemmD g = mk_gemm((const bf16_t*)(wsp(P) + WS_H), (const bf16_t*)(wsp(P) + WS_WINT) + (size_t)l * kINW * kD, kD, kD, kTok / 256, 10, nullptr, 0, 1 << 30);
    unsigned char* r1 = wsp(P) + WS_R1;
    EpiQKV<PROBE> E; E.qa = (bf16_t*)(r1 + R1_QA); E.ka = (bf16_t*)(r1 + R1_KA); E.va = (bf16_t*)(r1 + R1_VA); E.qb = (bf16_t*)(r1 + R1_QB); E.kb = (bf16_t*)(r1 + R1_KB); E.vb = (bf16_t*)(r1 + R1_VB); E.ux = (bf16_t*)(r1 + R1_UX);
    { LAS float* tab = (LAS float*)((LAS unsigned char*)dyn_lds + 131072);
      const int t = tidx();
      if (t < 320) { const int r = t >> 6, c = t & 63; tab[t] = (r == 0) ? P.q_norm_a[l * 64 + c] : (r == 1) ? P.k_norm_a[l * 64 + c] : (r == 2) ? P.q_norm_b[l * 64 + c] : (r == 3) ? P.k_norm_b[l * 64 + c] : 1.f; }
      __syncthreads();
      E.gtab = tab; E.scratch = (bf16_t*)(wsp(P) + WS_R2 + R2_Z); }
    GEMM_RUN(g, E);
}
#ifndef USE_MFMA_ATTN
#define USE_MFMA_ATTN 1
#endif
#ifndef USE_S5_GEMM
#define USE_S5_GEMM 1
#endif
#ifndef PROBE_ATTN
#define PROBE_ATTN 1
#endif
#ifndef PROBE_GU
#define PROBE_GU 1
#endif
#ifndef PROBE_WINDRY
#define PROBE_WINDRY 0
#endif
#ifndef PROBE_WIN
#define PROBE_WIN 1
#endif
#ifndef PROBE_DOWN
#define PROBE_DOWN 1
#endif
#ifndef PROBE_NA
#define PROBE_NA 1
#endif
#ifndef PROBE_MIX
#define PROBE_MIX 1
#endif
#ifndef PROBE_RT
#define PROBE_RT 1
#endif
#ifndef PROBE_TK
#define PROBE_TK 1
#endif
#ifndef PROBE_GUDRY
#define PROBE_GUDRY 0
#endif
#ifndef PROBE_DILVAR
#define PROBE_DILVAR 0
#endif
#ifndef PROBE_XBAR
#define PROBE_XBAR 0
#endif
#ifndef PROBE_CMB
#define PROBE_CMB 0
#endif
#ifndef PROBE_WOUT
#define PROBE_WOUT 0
#endif
#ifndef PROBE_CONV
#define PROBE_CONV 1
#endif
DEVI void ph_win_dry(const Params& P, int l, int bid, int nblk) {
    const GemmD g = mk_gemm((const bf16_t*)(wsp(P) + WS_H), (const bf16_t*)(wsp(P) + WS_WINT) + (size_t)l * kINW * kD, kD, kD, kTok / 256, 10, nullptr, 0, 1 << 30);
    EpiDry E; E.sink = (float*)(wsp(P) + WS_LSE);
    GEMM_RUN(g, E);
}
DEVI void ph_dilated(const Params& P, int l, int bid, int nblk) { unsigned char* r1 = wsp(P) + WS_R1;
#if PROBE_DILVAR
    phase_dilated<PROBE_DILVAR>((const bf16_t*)(r1 + R1_QA), (const bf16_t*)(r1 + R1_KA), (const bf16_t*)(r1 + R1_VA), P.q_norm_a + l * 64, P.k_norm_a + l * 64, (bf16_t*)(wsp(P) + WS_R2), (float*)(wsp(P) + WS_LSE), (LAS unsigned char*)dyn_lds, bid, nblk);
#endif
#if USE_MFMA_ATTN
    phase_dilated((const bf16_t*)(r1 + R1_QA), (const bf16_t*)(r1 + R1_KA), (const bf16_t*)(r1 + R1_VA), P.q_norm_a + l * 64, P.k_norm_a + l * 64, (bf16_t*)(wsp(P) + WS_R2), (float*)(wsp(P) + WS_LSE), (LAS unsigned char*)dyn_lds, bid, nblk);
#else
    phase_dilated_naive((const bf16_t*)(r1 + R1_QA), (const bf16_t*)(r1 + R1_KA), (const bf16_t*)(r1 + R1_VA), (bf16_t*)(wsp(P) + WS_R2), (float*)(wsp(P) + WS_LSE), bid, nblk);
#endif
}
DEVI void ph_na(const Params& P, int l, int bid, int nblk) { unsigned char* r1 = wsp(P) + WS_R1;
#if USE_MFMA_ATTN
    phase_na((const bf16_t*)(r1 + R1_QB), (const bf16_t*)(r1 + R1_KB), (const bf16_t*)(r1 + R1_VB), P.rpb + (size_t)l * 4 * 15 * 31, (bf16_t*)(r1 + R1_OB), (LAS unsigned char*)dyn_lds, bid, nblk);
#else
    phase_na_naive((const bf16_t*)(r1 + R1_QB), (const bf16_t*)(r1 + R1_KB), (const bf16_t*)(r1 + R1_VB), P.rpb + (size_t)l * 4 * 15 * 31, (bf16_t*)(r1 + R1_OB), bid, nblk);
#endif
}
DEVI void ph_s5(const Params& P, int l, unsigned char* lds, int bid, int nblk) { phase_s5_naive(P, l, (const bf16_t*)(wsp(P) + WS_R1 + R1_UX), (float*)(wsp(P) + WS_YS), lds, bid, nblk); }
DEVI void ph_s5_prep(const Params& P, unsigned char* lds, int bid, int nblk) { for (int it = bid; it < kL * 16; it += nblk) s5_prep_item(P, it >> 4, it & 15, lds); }
DEVI void ph_s5_state(const Params& P, int l, int bid, int nblk) {
    const GemmD g = mk_gemm((const bf16_t*)(wsp(P) + WS_R1 + R1_UX), (const bf16_t*)(wsp(P) + WS_WST) + (size_t)l * 16 * 256 * 256, 512, 256, 256, 1, nullptr, (size_t)256 * 256, 16);
    EpiF32N E; E.z = (float*)(wsp(P) + WS_R2 + R2_Z); E.ldz = 256;
    GEMM_RUN(g, E);
}
DEVI void ph_s5_scan(const Params& P, int l, unsigned char* lds, int bid, int nblk) { phase_s5_scan(P, l, (const float*)(wsp(P) + WS_R2 + R2_Z), (bf16_t*)(wsp(P) + WS_R1 + R1_UX), lds, bid, nblk); }
DEVI void ph_s5_out(const Params& P, int l, int bid, int nblk) {
    const GemmD g = mk_gemm((const bf16_t*)(wsp(P) + WS_R1 + R1_UX), (const bf16_t*)(wsp(P) + WS_WSO) + (size_t)l * 16 * 256 * 512, 512, 512, 256, 1, nullptr, (size_t)256 * 512, 16);
    EpiS5Out E; E.G = (bf16_t*)(wsp(P) + WS_R1 + R1_G);
    GEMM_RUN(g, E);
}
DEVI void ph_s5fin(const Params& P, int l, int bid, int nblk) { phase_s5_finish((const float*)(wsp(P) + WS_YS), (const bf16_t*)(wsp(P) + WS_R1 + R1_UX), P.s5_d + l * 256, (bf16_t*)(wsp(P) + WS_R1 + R1_G), bid, nblk); }
DEVI void ph_glu(const Params& P, int l, int bid, int nblk) {
    const GemmD g = mk_gemm((const bf16_t*)(wsp(P) + WS_R1 + R1_G), (const bf16_t*)(wsp(P) + WS_WGLUT) + (size_t)l * 256 * 256, 256, 256, kTok / 256, 1, nullptr, 0, 1 << 30);
    EpiGlu E; E.g = (const bf16_t*)(wsp(P) + WS_R1 + R1_G); E.oc = (bf16_t*)(wsp(P) + WS_R1 + R1_OC);
    GEMM_RUN(g, E);
}
DEVI void ph_mixnorm(const Params& P, int l, int bid, int nblk) { unsigned char* r1 = wsp(P) + WS_R1;
    phase_mixnorm((const bf16_t*)(wsp(P) + WS_R2), (const float*)(wsp(P) + WS_LSE), (const bf16_t*)(r1 + R1_OB), (const bf16_t*)(r1 + R1_OC), P.out_norm_a + l * 512, P.out_norm_b + l * 256, P.out_norm_c + l * 256, (bf16_t*)(wsp(P) + WS_H), bid, nblk); }
DEVI void ph_wout(const Params& P, int l, int bid, int nblk, bool shadow = false) {
    const GemmD g = mk_gemm((const bf16_t*)(wsp(P) + WS_H), (const bf16_t*)(wsp(P) + WS_WOUTT) + (size_t)l * kD * kD, kD, kD, kTok / 256, 4, nullptr, 0, 1 << 30);
    EpiResid E; E.x32 = (l == 0) ? P.x : nullptr; E.xb = (bf16_t*)(wsp(P) + WS_XB); E.xbo = shadow ? (bf16_t*)(wsp(P) + WS_R1 + 256 * MiB) : E.xb;
    GEMM_RUN(g, E);
}
DEVI void ph_router(const Params& P, int l, unsigned char* lds, int bid, int nblk) { phase_router((const bf16_t*)(wsp(P) + WS_XB), P.ffn_norm + (size_t)l * kD, P.w_router + (size_t)l * kD * kE, (bf16_t*)(wsp(P) + WS_H), (float*)(wsp(P) + WS_AFF), lds, bid, nblk); }
DEVI void ph_topk(const Params& P, unsigned char* lds, int bid, int nblk) { phase_topk((const float*)(wsp(P) + WS_AFF), (int*)(wsp(P) + WS_IDX), (float*)(wsp(P) + WS_GATE), (int*)(wsp(P) + WS_TSLOT), wsp(P) + WS_H, wsp(P) + WS_R2, FP8_GU ? kD : kD * 2, lds, bid, nblk); }
DEVI void ph_gu(const Params& P, int l, int bid, int nblk) {
#if FP8_GU
    const GemmD g = mk_gemm((const bf16_t*)(wsp(P) + WS_R2), (const bf16_t*)(wsp(P) + WS_WGUT + (size_t)l * kE * 4096 * kD), kD, kD, 512, 16, nullptr, (size_t)4096 * kD, 32);
    EpiGU E; E.hid = (bf16_t*)(wsp(P) + WS_R1); E.sc = 1.f / kW8; E.nomath = false;
    GEMM_RUN8(g, E);
#else
    const GemmD g = mk_gemm((const bf16_t*)(wsp(P) + WS_R2), (const bf16_t*)(wsp(P) + WS_WGUT) + (size_t)l * kE * 4096 * kD, kD, kD, 512, 16, nullptr, (size_t)4096 * kD, 32);
    EpiGU E; E.hid = (bf16_t*)(wsp(P) + WS_R1); E.sc = 1.f; E.nomath = false;
    GEMM_RUN(g, E);
#endif
}
DEVI void ph_gu_dry(const Params& P, int l, int bid, int nblk) {
    const GemmD g = mk_gemm((const bf16_t*)(wsp(P) + WS_R2), (const bf16_t*)(wsp(P) + WS_WGUT + (size_t)l * kE * 4096 * kD), kD, kD, 512, 16, nullptr, (size_t)4096 * kD, 32);
#if PROBE_GUDRY == 2
    EpiGU E; E.hid = (bf16_t*)(wsp(P) + WS_R1); E.sc = 1.f / kW8; E.nomath = true;
#else
    EpiDry E; E.sink = (float*)(wsp(P) + WS_LSE);
#endif
    GEMM_RUN8(g, E);
}
DEVI void ph_down(const Params& P, int l, int bid, int nblk) {
#if FP8_DN
    const GemmD g = mk_gemm((const bf16_t*)(wsp(P) + WS_R1), (const bf16_t*)(wsp(P) + WS_WDT + (size_t)l * kE * kD * kFF), kFF, kFF, 512, 4, nullptr, (size_t)kD * kFF, 32);
    EpiDown E; E.y = (bf16_t*)(wsp(P) + WS_R2); E.gate = (const float*)(wsp(P) + WS_GATE); E.sc = 1.f / (kW8 * kH8);
    GEMM_RUN8(g, E);
#else
    const GemmD g = mk_gemm((const bf16_t*)(wsp(P) + WS_R1), (const bf16_t*)(wsp(P) + WS_WDT) + (size_t)l * kE * kD * kFF, kFF, kFF, 512, 4, nullptr, (size_t)kD * kFF, 32);
    EpiDown E; E.y = (bf16_t*)(wsp(P) + WS_R2); E.gate = (const float*)(wsp(P) + WS_GATE); E.sc = 1.f;
    GEMM_RUN(g, E);
#endif
}
DEVI void ph_combine_shadow(const Params& P, int l, int bid, int nblk) {
    phase_combine((bf16_t*)(wsp(P) + WS_XB), (bf16_t*)(wsp(P) + WS_R1), P.out, (const bf16_t*)(wsp(P) + WS_R2), (const float*)(wsp(P) + WS_GATE), (const int*)(wsp(P) + WS_TSLOT), P.attn_norm + (size_t)((l + 1) % kL) * kD, (bf16_t*)(wsp(P) + WS_R1 + 128 * MiB), bid, nblk); }
DEVI void ph_combine(const Params& P, int l, int bid, int nblk) { phase_combine((bf16_t*)(wsp(P) + WS_XB), (bf16_t*)(wsp(P) + WS_XB), P.out, (const bf16_t*)(wsp(P) + WS_R2), (const float*)(wsp(P) + WS_GATE), (const int*)(wsp(P) + WS_TSLOT), (l + 1 < kL) ? P.attn_norm + (size_t)(l + 1) * kD : nullptr, (bf16_t*)(wsp(P) + WS_H), bid, nblk); }

typedef __attribute__((address_space(4))) const Params* CParams;
DEVI CParams kargs() { unsigned long long a = (unsigned long long)__builtin_amdgcn_kernarg_segment_ptr(); asm volatile("" : "+s"(a)); return (CParams)a; }
#if MEGA
__global__ void __launch_bounds__(kNT, 2) mega_fwd(Params P_) {
#define PK P_
    volatile LAS unsigned* st = (volatile LAS unsigned*)(dyn_lds + LDS_BYTES - 16);
    if (threadIdx.x == 0) { st[0] = 0u; st[1] = 0u; st[2] = 0u; st[3] = 0u; }
    __syncthreads();
    const XcdBarrier bar = xcd_barrier_post((unsigned*)(PK.ws + WS_CTL), st);
    const int bid = blockIdx.x, nblk = gridDim.x;
    unsigned char* lds = dyn_lds;
#pragma unroll 1
    for (int rep = 0; rep < PROBE_CONV; ++rep)
    phase_convert(PK, lds, lnd(bid), nblk);
#if USE_S5_GEMM
    ph_s5_prep(PK, lds, lnd(bid), nblk);
#endif
    phase_norm(PK.x, PK.attn_norm, (bf16_t*)(PK.ws + WS_H), lnd(bid), nblk);
    xcd_barrier(bar);
#pragma unroll 1
    for (int l = 0; l < kL; ++l) {
#if PROBE_WINDRY == 1
        ph_win_dry(PK, l, lnd(bid), nblk);        xcd_barrier(bar);
#elif PROBE_WINDRY > 1
        ph_win<PROBE_WINDRY - 1>(PK, l, lnd(bid), nblk);   xcd_barrier(bar);
#endif
#pragma unroll 1
        for (int rep = 0; rep < PROBE_WIN; ++rep) {
        ph_win(PK, l, lnd(bid), nblk);            xcd_barrier(bar); }
#if USE_S5_GEMM
        ph_s5_state(PK, l, lnd(bid), nblk);       xcd_barrier(bar);
#if PROBE_XBAR
        xcd_barrier(bar); xcd_barrier(bar); xcd_barrier(bar); xcd_barrier(bar);
#endif
        ph_s5_scan(PK, l, lds, lnd(bid), nblk);
#pragma unroll 1
        for (int rep = 0; rep < PROBE_ATTN; ++rep)
        ph_dilated(PK, l, lnd(bid), nblk);
#pragma unroll 1
        for (int rep = 0; rep < PROBE_NA; ++rep)
        ph_na(PK, l, lnd(bid), nblk);             xcd_barrier(bar);
        ph_s5_out(PK, l, lnd(bid), nblk);         xcd_barrier(bar);
#else
        ph_s5(PK, l, lds, lnd(bid), nblk);
        ph_dilated(PK, l, lnd(bid), nblk);
        ph_na(PK, l, lnd(bid), nblk);             xcd_barrier(bar);
        ph_s5fin(PK, l, lnd(bid), nblk);          xcd_barrier(bar);
#endif
        ph_glu(PK, l, lnd(bid), nblk);            xcd_barrier(bar);
#pragma unroll 1
        for (int rep = 0; rep < PROBE_MIX; ++rep) {
        ph_mixnorm(PK, l, lnd(bid), nblk);        xcd_barrier(bar); }
#if PROBE_WOUT
        ph_wout(PK, l, lnd(bid), nblk, true);     xcd_barrier(bar);
#endif
        ph_wout(PK, l, lnd(bid), nblk);           xcd_barrier(bar);
#pragma unroll 1
        for (int rep = 0; rep < PROBE_RT; ++rep) {
        ph_router(PK, l, lds, lnd(bid), nblk);    xcd_barrier(bar); }
#pragma unroll 1
        for (int rep = 0; rep < PROBE_TK; ++rep) {
        ph_topk(PK, lds, lnd(bid), nblk);         xcd_barrier(bar); }
#if PROBE_GUDRY
        ph_gu_dry(PK, l, lnd(bid), nblk);         xcd_barrier(bar);
#endif
#pragma unroll 1
        for (int rep = 0; rep < PROBE_GU; ++rep) {
        ph_gu(PK, l, lnd(bid), nblk);             xcd_barrier(bar); }
#pragma unroll 1
        for (int rep = 0; rep < PROBE_DOWN; ++rep) {
        ph_down(PK, l, lnd(bid), nblk);           xcd_barrier(bar); }
#if PROBE_CMB
        ph_combine_shadow(PK, l, lnd(bid), nblk); xcd_barrier(bar);
#endif
        ph_combine(PK, l, lnd(bid), nblk);        xcd_barrier(bar);
    }
#undef PK
}
#else
#define KB __global__ void __launch_bounds__(kNT, 2)
KB k_convert(Params P) { phase_convert(P, dyn_lds, blockIdx.x, gridDim.x); }
KB k_norm(Params P) { phase_norm(P.x, P.attn_norm, (bf16_t*)(P.ws + WS_H), blockIdx.x, gridDim.x); }
KB k_win(Params P, int l) { ph_win(P, l, blockIdx.x, gridDim.x); }
KB k_dilated(Params P, int l) { ph_dilated(P, l, blockIdx.x, gridDim.x); }
KB k_na(Params P, int l) { ph_na(P, l, blockIdx.x, gridDim.x); }
KB k_s5(Params P, int l) { ph_s5(P, l, dyn_lds, blockIdx.x, gridDim.x); }
KB k_s5fin(Params P, int l) { ph_s5fin(P, l, blockIdx.x, gridDim.x); }
KB k_glu(Params P, int l) { ph_glu(P, l, blockIdx.x, gridDim.x); }
KB k_mixnorm(Params P, int l) { ph_mixnorm(P, l, blockIdx.x, gridDim.x); }
KB k_wout(Params P, int l) { ph_wout(P, l, blockIdx.x, gridDim.x); }
KB k_router(Params P, int l) { ph_router(P, l, dyn_lds, blockIdx.x, gridDim.x); }
KB k_topk(Params P) { ph_topk(P, dyn_lds, blockIdx.x, gridDim.x); }
KB k_gu(Params P, int l) { ph_gu(P, l, blockIdx.x, gridDim.x); }
KB k_down(Params P, int l) { ph_down(P, l, blockIdx.x, gridDim.x); }
KB k_combine(Params P, int l) { ph_combine(P, l, blockIdx.x, gridDim.x); }
#endif

extern "C" void kernel_launch(void* const* d_in, const int* in_sizes, int n_in, void* d_out, int out_size, void* d_ws, size_t ws_size, hipStream_t stream) {
    (void)in_sizes; (void)n_in; (void)out_size;
    if (ws_size < WS_END) { fprintf(stderr, "workspace too small: %zu < %zu\n", ws_size, (size_t)WS_END); return; }
    Params P{};
    const float** pp = (const float**)&P;
    for (int i = 0; i < 26; ++i) pp[i] = (const float*)d_in[i];
    P.out = (float*)d_out; P.ws = (unsigned char*)d_ws;
#if MEGA
    static int grid = 0;
    if (!grid) {
        int dev = 0, cus = 0, per_cu = 0;
        (void)hipGetDevice(&dev);
        (void)hipDeviceGetAttribute(&cus, hipDeviceAttributeMultiprocessorCount, dev);
        (void)hipFuncSetAttribute((const void*)mega_fwd, hipFuncAttributeMaxDynamicSharedMemorySize, LDS_BYTES);
        (void)hipOccupancyMaxActiveBlocksPerMultiprocessor(&per_cu, (const void*)mega_fwd, kNT, LDS_BYTES);
        grid = (per_cu >= 1) ? cus : 0;
        if (!grid) fprintf(stderr, "mega_fwd does not fit a CU\n");
    }
    if (!grid) return;
    (void)hipMemsetAsync(P.ws + WS_CTL, 0, XCD_BAR_WORDS * sizeof(unsigned), stream);
    mega_fwd<<<grid, kNT, LDS_BYTES, stream>>>(P);
#else
    (void)hipFuncSetAttribute((const void*)k_router, hipFuncAttributeMaxDynamicSharedMemorySize, 65536);
    const int G = 1024;
    k_convert<<<G, kNT, 256 * 72 * 2, stream>>>(P);
    k_norm<<<G, kNT, 0, stream>>>(P);
    for (int l = 0; l < kL; ++l) {
        k_win<<<G, kNT, 0, stream>>>(P, l);
        k_dilated<<<G, kNT, 0, stream>>>(P, l);
        k_na<<<G, kNT, 0, stream>>>(P, l);
        k_s5<<<256, kNT, 8 * 128 * 4, stream>>>(P, l);
        k_s5fin<<<G, kNT, 0, stream>>>(P, l);
        k_glu<<<256, kNT, 0, stream>>>(P, l);
        k_mixnorm<<<G, kNT, 0, stream>>>(P, l);
        k_wout<<<G, kNT, 0, stream>>>(P, l);
        k_router<<<512, kNT, 65536, stream>>>(P, l);
        k_topk<<<128, kNT, 4096, stream>>>(P);
        k_gu<<<G, kNT, 0, stream>>>(P, l);
        k_down<<<G, kNT, 0, stream>>>(P, l);
        k_combine<<<G, kNT, 0, stream>>>(P, l);
    }
#endif
}
```

```cpp
#include <hip/hip_runtime.h>
#include <stdint.h>
#include <stdio.h>

#define DEVI __device__ __forceinline__
#define LAS __attribute__((address_space(3)))
typedef unsigned short bf16_t;
typedef short bf16x8 __attribute__((ext_vector_type(8)));
typedef float f32x4 __attribute__((ext_vector_type(4)));
typedef float f32x2 __attribute__((ext_vector_type(2)));
typedef unsigned u32x4 __attribute__((ext_vector_type(4)));
typedef unsigned u32x2 __attribute__((ext_vector_type(2)));

constexpr int kB = 8, kS = 8192, kD = 1024, kL = 4, kTok = kB * kS;
constexpr int kINW = 2560;
constexpr int kE = 16, kCap = 1024, kFF = 2048;
constexpr int kNT = 512;
constexpr float kEps = 1e-6f;
constexpr float kLog2e = 1.4426950408889634f, kLn2 = 0.6931471805599453f;

constexpr size_t MiB = 1024ull * 1024ull;
constexpr size_t WS_CTL   = 0;
constexpr size_t WS_WINT  = 1 * MiB;
constexpr size_t WS_WOUTT = WS_WINT + 20 * MiB;
constexpr size_t WS_WGLUT = WS_WOUTT + 8 * MiB;
constexpr size_t WS_WGUT  = WS_WGLUT + 1 * MiB;
constexpr size_t WS_WDT   = WS_WGUT + 512 * MiB;
constexpr size_t WS_H     = WS_WDT + 256 * MiB;
constexpr size_t WS_R1    = WS_H + 128 * MiB;
constexpr size_t WS_R2    = WS_R1 + 512 * MiB;
constexpr size_t WS_AFF   = WS_R2 + 256 * MiB;
constexpr size_t WS_IDX   = WS_AFF + 4 * MiB;
constexpr size_t WS_GATE  = WS_IDX + 1 * MiB;
constexpr size_t WS_TSLOT = WS_GATE + 1 * MiB;
constexpr size_t WS_LSE   = WS_TSLOT + 4 * MiB;
constexpr size_t WS_WST   = WS_LSE + 8 * MiB;
constexpr size_t WS_WSO   = WS_WST + 8 * MiB;
constexpr size_t WS_YS    = WS_WSO + 16 * MiB;
constexpr size_t WS_XB    = WS_YS;
constexpr size_t WS_END   = WS_YS + 128 * MiB;
constexpr size_t R2_Z     = 192 * MiB;
constexpr size_t R1_QA = 0, R1_KA = 64 * MiB, R1_VA = 128 * MiB, R1_QB = 192 * MiB, R1_KB = 224 * MiB, R1_VB = 256 * MiB,
                 R1_UX = 288 * MiB, R1_OB = 352 * MiB, R1_OC = 384 * MiB, R1_G = 416 * MiB;

struct Params {
    const float* x; const float* attn_norm; const float* w_in; const float* q_norm_a; const float* k_norm_a; const float* q_norm_b; const float* k_norm_b;
    const float* rpb; const float* s5_a_re; const float* s5_a_im; const float* s5_log_dt; const float* s5_b_re; const float* s5_b_im; const float* s5_c_re; const float* s5_c_im;
    const float* s5_d; const float* w_glu; const float* out_norm_a; const float* out_norm_b; const float* out_norm_c; const float* w_out; const float* ffn_norm;
    const float* w_router; const float* w_gate; const float* w_up; const float* w_down;
    float* out; unsigned char* ws;
};

DEVI float bf2f(bf16_t b) { return __uint_as_float(((unsigned)b) << 16); }
DEVI bf16_t f2bf(float f) { unsigned u = __float_as_uint(f); u += 0x7FFFu + ((u >> 16) & 1u); return (bf16_t)(u >> 16); }
typedef __bf16 bf16x2_t __attribute__((ext_vector_type(2)));
DEVI unsigned pk2(float lo, float hi) { const f32x2 v = {lo, hi}; return __builtin_bit_cast(unsigned, __builtin_convertvector(v, bf16x2_t)); }
DEVI int tidx() { int t = threadIdx.x; asm volatile("" : "+v"(t)); return t; }
#define GAS __attribute__((address_space(1)))
DEVI unsigned char* wsp(const Params& P) { unsigned long long a = (unsigned long long)P.ws; asm volatile("" : "+s"(a)); return (unsigned char*)(GAS unsigned char*)a; }
DEVI int lnd(int v) { asm volatile("" : "+s"(v)); return v; }
template <int CTRL> DEVI float dppf(float v) { return __builtin_bit_cast(float, __builtin_amdgcn_update_dpp(0, __builtin_bit_cast(int, v), CTRL, 0xF, 0xF, true)); }
DEVI void swap16(float& a, float& b) { asm volatile("s_nop 1\n\tv_permlane16_swap_b32 %0, %1" : "+v"(a), "+v"(b)); }
DEVI void swap32(float& a, float& b) { asm volatile("s_nop 1\n\tv_permlane32_swap_b32 %0, %1" : "+v"(a), "+v"(b)); }
DEVI void swap16u(unsigned& a, unsigned& b) { asm volatile("s_nop 1\n\tv_permlane16_swap_b32 %0, %1" : "+v"(a), "+v"(b)); }
DEVI float xsum16(float v) { float a = v, b = v; swap16(a, b); return a + b; }
DEVI float xsum32(float v) { float a = v, b = v; swap32(a, b); return a + b; }
DEVI float xmax16(float v) { float a = v, b = v; swap16(a, b); return fmaxf(a, b); }
DEVI float xmax32(float v) { float a = v, b = v; swap32(a, b); return fmaxf(a, b); }
DEVI float row_sum16(float v) {
    v += dppf<0xB1>(v); v += dppf<0x4E>(v);
    v += dppf<0x141>(v); v += dppf<0x140>(v);
    return v;
}
DEVI float wave_sum(float v) { return xsum32(xsum16(row_sum16(v))); }
DEVI void unpk8s(float* d, const u32x4 q) {
    d[0] = __uint_as_float(q.x << 16); d[1] = __uint_as_float(q.x & 0xFFFF0000u); d[2] = __uint_as_float(q.y << 16); d[3] = __uint_as_float(q.y & 0xFFFF0000u);
    d[4] = __uint_as_float(q.z << 16); d[5] = __uint_as_float(q.z & 0xFFFF0000u); d[6] = __uint_as_float(q.w << 16); d[7] = __uint_as_float(q.w & 0xFFFF0000u);
}
DEVI float frcp(float x) { return __builtin_amdgcn_rcpf(x); }
DEVI float gelu_tanh(float y) { const float z = 0.7978845608028654f * (y + 0.044715f * y * y * y); const float t = 1.f - 2.f * frcp(1.f + __expf(2.f * z)); return 0.5f * y * (1.f + t); }

#ifndef EMU_BF16_X
#define EMU_BF16_X 0
#endif
#ifndef EMU_FP8_WIN
#define EMU_FP8_WIN 0
#endif
#ifndef EMU_FP8_WOUT
#define EMU_FP8_WOUT 0
#endif
#ifndef EMU_FP8_GU
#define EMU_FP8_GU 0
#endif
#ifndef EMU_FP8_DN
#define EMU_FP8_DN 0
#endif
DEVI float q8(float x, float sc, float inv) {
    float y = x * sc; const float ay = fabsf(y);
    if (ay < 0.015625f) y = rintf(y * 512.f) * (1.f / 512.f);
    else { unsigned u = __float_as_uint(y); u += 0x7FFFFu + ((u >> 20) & 1u); u &= 0xFFF00000u; y = __uint_as_float(u); y = fminf(fmaxf(y, -448.f), 448.f); }
    return y * inv;
}
#ifndef FP8_GU
#define FP8_GU 1
#endif
#ifndef FP8_DN
#define FP8_DN 1
#endif
#ifndef FP8_Y
#define FP8_Y 1
#endif
constexpr float kY8 = 32.f;
constexpr float kW8 = 64.f, kH8 = 8.f;
DEVI unsigned pk4_fp8(float a, float b, float c, float d) { unsigned w = 0u; w = __builtin_amdgcn_cvt_pk_fp8_f32(a, b, w, false); w = __builtin_amdgcn_cvt_pk_fp8_f32(c, d, w, true); return w; }
DEVI int cmap_head(int cs) { const int bj = cs >> 7, wc = (cs >> 5) & 3, n = (cs >> 4) & 1, fq = (cs >> 2) & 3, j = cs & 3; return 64 * wc + 32 * bj + 8 * fq + 4 * n + j; }
DEVI int cmap_pk(int cs)   { const int bj = cs >> 7, wc = (cs >> 5) & 3, n = (cs >> 4) & 1, fq = (cs >> 2) & 3, j = cs & 3; return 128 * bj + 32 * wc + 8 * fq + 4 * n + j; }
DEVI int cmap_gu(int cs)   { const int wc = (cs >> 5) & 3, n = (cs >> 4) & 1, fq = (cs >> 2) & 3, j = cs & 3; return 32 * wc + 8 * fq + 4 * n + j; }

template <int MODE, int QEMU = 0>
DEVI void convert_item(const float* W0, const float* W1, int ldw, int K, bf16_t* Bt, int kt, int pn, unsigned char* lds) {
    bf16_t* t = (bf16_t*)lds;
    const int tid = tidx();
#pragma unroll 4
    for (int it = 0; it < 32; ++it) {
        const int e = it * kNT + tid, k = e >> 8, cs = e & 255;
        float v;
        if (MODE == 0) v = W0[(size_t)(kt * 64 + k) * ldw + pn * 256 + cs];
        else if (MODE == 1) v = W0[(size_t)(kt * 64 + k) * ldw + pn * 256 + cmap_head(cs)];
        else if (MODE == 2) v = W0[(size_t)(kt * 64 + k) * ldw + pn * 256 + cmap_pk(cs)];
        else v = ((cs >> 7) ? W1 : W0)[(size_t)(kt * 64 + k) * ldw + pn * 128 + cmap_gu(cs)];
        if (QEMU) v = q8(v, 64.f, 1.f / 64.f);
        t[cs * 72 + k] = f2bf(v);
    }
    __syncthreads();
#pragma unroll
    for (int it = 0; it < 4; ++it) {
        const int c = it * kNT + tid, row = c >> 3, part = c & 7;
        const u32x4 v = *(const u32x4*)(t + row * 72 + part * 8);
        *(u32x4*)(Bt + (size_t)(pn * 256 + row) * K + kt * 64 + part * 8) = v;
    }
    __syncthreads();
}

template <int MODE>
DEVI void convert_item8(const float* W0, const float* W1, int ldw, int K, unsigned char* Bt, int kt, int pn, unsigned char* lds) {
    unsigned char* t = lds;
    const int tid = tidx();
#pragma unroll 4
    for (int it = 0; it < 64; ++it) {
        const int e = it * kNT + tid, k = e >> 8, cs = e & 255;
        float v;
        if (MODE == 2) v = W0[(size_t)(kt * 128 + k) * ldw + pn * 256 + cmap_pk(cs)];
        else v = ((cs >> 7) ? W1 : W0)[(size_t)(kt * 128 + k) * ldw + pn * 128 + cmap_gu(cs)];
        v *= kW8;
        t[cs * 144 + k] = (unsigned char)(__builtin_amdgcn_cvt_pk_fp8_f32(v, v, 0u, false) & 0xFFu);
    }
    __syncthreads();
#pragma unroll
    for (int it = 0; it < 4; ++it) {
        const int c = it * kNT + tid, row = c >> 3, part = c & 7;
        const u32x4 v = *(const u32x4*)(t + row * 144 + part * 16);
        *(u32x4*)(Bt + (size_t)(pn * 256 + row) * K + kt * 128 + part * 16) = v;
    }
    __syncthreads();
}

DEVI void phase_convert(const Params& P, unsigned char* lds, int bid, int nblk) {
    constexpr int N_WIN = kL * 16 * 10, N_WOUT = kL * 16 * 4, N_WGLU = kL * 4 * 1, N_WGU = kL * kE * (FP8_GU ? 8 : 16) * 16, N_WD = kL * kE * (FP8_DN ? 16 : 32) * 4;
    constexpr int TOT = N_WIN + N_WOUT + N_WGLU + N_WGU + N_WD;
    for (int it = bid; it < TOT; it += nblk) {
        int i = it;
        if (i < N_WIN) { const int l = i / 160, r = i % 160, kt = r / 10, pn = r % 10;
            convert_item<1, EMU_FP8_WIN>(P.w_in + (size_t)l * kD * kINW, nullptr, kINW, kD, (bf16_t*)(wsp(P) + WS_WINT) + (size_t)l * kINW * kD, kt, pn, lds); continue; }
        i -= N_WIN;
        if (i < N_WOUT) { const int l = i / 64, r = i % 64, kt = r / 4, pn = r % 4;
            convert_item<2, EMU_FP8_WOUT>(P.w_out + (size_t)l * kD * kD, nullptr, kD, kD, (bf16_t*)(wsp(P) + WS_WOUTT) + (size_t)l * kD * kD, kt, pn, lds); continue; }
        i -= N_WOUT;
        if (i < N_WGLU) { const int l = i / 4, kt = i % 4;
            convert_item<2>(P.w_glu + (size_t)l * 256 * 256, nullptr, 256, 256, (bf16_t*)(wsp(P) + WS_WGLUT) + (size_t)l * 256 * 256, kt, 0, lds); continue; }
        i -= N_WGLU;
#if FP8_GU
        if (i < N_WGU) { const int le = i / 128, r = i % 128, kt = r / 16, pn = r % 16;
            convert_item8<3>(P.w_gate + (size_t)le * kD * kFF, P.w_up + (size_t)le * kD * kFF, kFF, kD, wsp(P) + WS_WGUT + (size_t)le * 4096 * kD, kt, pn, lds); continue; }
#else
        if (i < N_WGU) { const int le = i / 256, r = i % 256, kt = r / 16, pn = r % 16;
            convert_item<3, EMU_FP8_GU>(P.w_gate + (size_t)le * kD * kFF, P.w_up + (size_t)le * kD * kFF, kFF, kD, (bf16_t*)(wsp(P) + WS_WGUT) + (size_t)le * 4096 * kD, kt, pn, lds); continue; }
#endif
        i -= N_WGU;
#if FP8_DN
        { const int le = i / 64, r = i % 64, kt = r / 4, pn = r % 4;
            convert_item8<2>(P.w_down + (size_t)le * kFF * kD, nullptr, kD, kFF, wsp(P) + WS_WDT + (size_t)le * kD * kFF, kt, pn, lds); }
#else
        { const int le = i / 128, r = i % 128, kt = r / 4, pn = r % 4;
            convert_item<2, EMU_FP8_DN>(P.w_down + (size_t)le * kFF * kD, nullptr, kD, kFF, (bf16_t*)(wsp(P) + WS_WDT) + (size_t)le * kD * kFF, kt, pn, lds); }
#endif
    }
}

DEVI void phase_norm(const float* x, const float* gain, bf16_t* h, int bid, int nblk) {
    const int wid = tidx() >> 6, lane = tidx() & 63;
    f32x4 g[4];
#pragma unroll
    for (int q = 0; q < 4; ++q) g[q] = *(const f32x4*)(gain + q * 256 + lane * 4);
    for (int row = bid * 8 + wid; row < kTok; row += nblk * 8) {
        f32x4 v[4]; float ss = 0.f;
#pragma unroll
        for (int q = 0; q < 4; ++q) { v[q] = *(const f32x4*)(x + (size_t)row * kD + q * 256 + lane * 4); ss += v[q].x * v[q].x + v[q].y * v[q].y + v[q].z * v[q].z + v[q].w * v[q].w; }
        ss = wave_sum(ss);
        const float rstd = rsqrtf(ss * (1.f / kD) + kEps);
#pragma unroll
        for (int q = 0; q < 4; ++q) { f32x4 t = v[q] * rstd * g[q]; if (EMU_FP8_WIN) { t.x = q8(t.x, 1.f, 1.f); t.y = q8(t.y, 1.f, 1.f); t.z = q8(t.z, 1.f, 1.f); t.w = q8(t.w, 1.f, 1.f); }
            u32x2 o; o.x = pk2(t.x, t.y); o.y = pk2(t.z, t.w);
            *(u32x2*)(h + (size_t)row * kD + q * 256 + lane * 4) = o; }
    }
}

DEVI void phase_router(const bf16_t* x, const float* gain, const float* wr  , bf16_t* h, float* aff, unsigned char* lds, int bid, int nblk) {
    float* wT = (float*)lds;
    for (int i = tidx(); i < 16 * 1024; i += kNT) { const int k = i >> 4, e = i & 15; wT[e * 1024 + k] = wr[i]; }
    __syncthreads();
    const int wid = tidx() >> 6, lane = tidx() & 63;
    f32x4 g[4];
#pragma unroll
    for (int q = 0; q < 4; ++q) g[q] = *(const f32x4*)(gain + q * 256 + lane * 4);
    u32x2 nvx[2][4];
    { const int r0 = (bid * 8 + wid) * 2;
      if (r0 < kTok) {
#pragma unroll
        for (int r = 0; r < 2; ++r)
#pragma unroll
            for (int q = 0; q < 4; ++q) nvx[r][q] = *(const u32x2*)(x + (size_t)(r0 + r) * kD + q * 256 + lane * 4); } }
    for (int row0 = (bid * 8 + wid) * 2; row0 < kTok; row0 += nblk * 8 * 2) {
        asm volatile("" ::: "memory");
        f32x4 v[2][4];
#pragma unroll
        for (int r = 0; r < 2; ++r)
#pragma unroll
            for (int q = 0; q < 4; ++q) { const u32x2 w = nvx[r][q]; v[r][q] = (f32x4){__uint_as_float(w.x << 16), __uint_as_float(w.x & 0xFFFF0000u), __uint_as_float(w.y << 16), __uint_as_float(w.y & 0xFFFF0000u)}; }
        { const int nr0 = row0 + nblk * 8 * 2;
          if (nr0 < kTok) {
#pragma unroll
            for (int r = 0; r < 2; ++r)
#pragma unroll
                for (int q = 0; q < 4; ++q) nvx[r][q] = *(const u32x2*)(x + (size_t)(nr0 + r) * kD + q * 256 + lane * 4); } }
#pragma unroll
        for (int r = 0; r < 2; ++r) { float ss = 0.f;
#pragma unroll
            for (int q = 0; q < 4; ++q) { ss += v[r][q].x * v[r][q].x + v[r][q].y * v[r][q].y + v[r][q].z * v[r][q].z + v[r][q].w * v[r][q].w; }
            ss = wave_sum(ss); const float rstd = rsqrtf(ss * (1.f / kD) + kEps);
#pragma unroll
            for (int q = 0; q < 4; ++q) { v[r][q] = v[r][q] * rstd * g[q];
#if FP8_GU
                *(unsigned*)((unsigned char*)h + (size_t)(row0 + r) * kD + q * 256 + lane * 4) = pk4_fp8(v[r][q].x, v[r][q].y, v[r][q].z, v[r][q].w); }
#else
                u32x2 o;
                if (EMU_FP8_GU) { o.x = pk2(q8(v[r][q].x, 1.f, 1.f), q8(v[r][q].y, 1.f, 1.f)); o.y = pk2(q8(v[r][q].z, 1.f, 1.f), q8(v[r][q].w, 1.f, 1.f)); }
                else { o.x = pk2(v[r][q].x, v[r][q].y); o.y = pk2(v[r][q].z, v[r][q].w); }
                *(u32x2*)(h + (size_t)(row0 + r) * kD + q * 256 + lane * 4) = o; }
#endif
        }
        float pa[32];
#pragma unroll
        for (int e = 0; e < 16; ++e) {
            float s0 = 0.f, s1 = 0.f;
#pragma unroll
            for (int q = 0; q < 4; ++q) { const f32x4 w = *(const f32x4*)(wT + e * 1024 + q * 256 + lane * 4);
                s0 += v[0][q].x * w.x + v[0][q].y * w.y + v[0][q].z * w.z + v[0][q].w * w.w;
                s1 += v[1][q].x * w.x + v[1][q].y * w.y + v[1][q].z * w.z + v[1][q].w * w.w; }
            pa[e] = s0; pa[16 + e] = s1;
        }
#define RS_STEP(HALF, MASK) { const bool up = (lane & (MASK)) != 0; _Pragma("unroll") for (int i = 0; i < (HALF); ++i) { const float keep = up ? pa[i + (HALF)] : pa[i], send = up ? pa[i] : pa[i + (HALF)]; pa[i] = keep + __shfl_xor(send, (MASK)); } }
        RS_STEP(16, 32) RS_STEP(8, 16) RS_STEP(4, 8) RS_STEP(2, 4) RS_STEP(1, 2)
#undef RS_STEP
        const float logit = pa[0] + __shfl_xor(pa[0], 1);
        float mx = logit;
#pragma unroll
        for (int m = 16; m >= 2; m >>= 1) mx = fmaxf(mx, __shfl_xor(mx, m));
        const float ex = __expf(logit - mx);
        float sm = ex;
#pragma unroll
        for (int m = 16; m >= 2; m >>= 1) sm += __shfl_xor(sm, m);
        const int row = row0 + (lane >> 5), e = (lane >> 1) & 15, b = row >> 13, s = row & (kS - 1);
        if (!(lane & 1)) aff[((size_t)(b * kE + e)) * kS + s] = ex * frcp(sm);
    }
    __syncthreads();
}

DEVI int block_excl_scan(int v, int* sh  , int& total) {
    const int lane = tidx() & 63, wid = tidx() >> 6;
    int incl = v;
#pragma unroll
    for (int d = 1; d < 64; d <<= 1) { const int o = __shfl_up(incl, d); if (lane >= d) incl += o; }
    __syncthreads();
    if (lane == 63) sh[wid] = incl;
    __syncthreads();
    int base = 0, tot = 0;
#pragma unroll
    for (int w = 0; w < 8; ++w) { const int c = sh[w]; if (w < wid) base += c; tot += c; }
    total = tot;
    return base + incl - v;
}

DEVI void phase_topk(const float* aff, int* idx, float* gate, int* tokslot, const unsigned char* hsrc, unsigned char* xe, int rowbytes, unsigned char* lds, int bid, int nblk) {
    int* hist = (int*)lds;
    int* sh = hist + 256;
    int* res = sh + 16;
    int* lsel = res + 16;
    const int tid = tidx(), lane = tid & 63, wid = tid >> 6;
    const int share = (nblk >= 2 * kB * kE) ? 2 : 1;
    for (int wi = bid; wi < kB * kE * share; wi += nblk) {
        const int item = wi / share, part = wi - item * share;
        const int b = item >> 4, e = item & 15;
        const float* a = aff + (size_t)item * kS;
        unsigned key[16];
#pragma unroll
        for (int q = 0; q < 4; ++q) { const u32x4 v = *(const u32x4*)(a + tid * 16 + q * 4); key[q * 4 + 0] = v.x; key[q * 4 + 1] = v.y; key[q * 4 + 2] = v.z; key[q * 4 + 3] = v.w; }
        unsigned prefix = 0; int kk = kCap;
#pragma unroll 1
        for (int pass = 0; pass < 4; ++pass) {
            const int shift = 24 - 8 * pass;
            __syncthreads();
            if (tid < 256) hist[tid] = 0;
            __syncthreads();
#pragma unroll
            for (int i = 0; i < 16; ++i) { const bool in = (pass == 0) || ((key[i] >> (shift + 8)) == prefix); if (in) atomicAdd(&hist[(key[i] >> shift) & 255], 1); }
            __syncthreads();
            if (wid == 0) {
                int c[4], loc = 0;
#pragma unroll
                for (int j = 0; j < 4; ++j) { c[j] = hist[255 - 4 * lane - j]; loc += c[j]; }
                int incl = loc;
#pragma unroll
                for (int d = 1; d < 64; d <<= 1) { const int o = __shfl_up(incl, d); if (lane >= d) incl += o; }
                const int excl = incl - loc;
                if (excl < kk && kk <= incl) { int run = excl; int bin = 0, nk = 0; bool found = false;
#pragma unroll
                    for (int j = 0; j < 4; ++j) { if (!found && run + c[j] >= kk) { bin = 255 - 4 * lane - j; nk = kk - run; found = true; } if (!found) run += c[j]; }
                    res[0] = bin; res[1] = nk; }
            }
            __syncthreads();
            prefix = (prefix << 8) | (unsigned)res[0]; kk = res[1];
        }
        const unsigned T = prefix;
        int ceq = 0;
#pragma unroll
        for (int i = 0; i < 16; ++i) ceq += (key[i] == T) ? 1 : 0;
        int tot;
        int eqb = block_excl_scan(ceq, sh, tot);
        int csel = 0; unsigned selmask = 0;
#pragma unroll
        for (int i = 0; i < 16; ++i) { bool s = key[i] > T; if (key[i] == T) { s = eqb < kk; ++eqb; } if (s) { selmask |= 1u << i; ++csel; } }
        int slot = block_excl_scan(csel, sh, tot);
        const size_t rbase = (size_t)(e * kB + b) * kCap;
#pragma unroll
        for (int i = 0; i < 16; ++i) { const int s = tid * 16 + i; const bool sel = (selmask >> i) & 1u;
            if (sel) { if (part == 0) { idx[rbase + slot] = b * kS + s; gate[rbase + slot] = __uint_as_float(key[i]); } lsel[slot] = b * kS + s; }
            if (part == 0) tokslot[((size_t)(b * kS + s)) * kE + e] = sel ? slot : -1;
            if (sel) ++slot; }
        __syncthreads();
        { const int cpr = rowbytes >> 4;
          const int cbeg = part * (kCap / share) * cpr, cend = cbeg + (kCap / share) * cpr;
          for (int c0 = cbeg + tid; c0 < cend; c0 += kNT * 4) {
              u32x4 v[4];
#pragma unroll
              for (int j = 0; j < 4; ++j) { const int c = c0 + j * kNT; const int r = c / cpr, ch = c - r * cpr; v[j] = *(const u32x4*)(hsrc + (size_t)lsel[r] * rowbytes + ch * 16); }
#pragma unroll
              for (int j = 0; j < 4; ++j) { const int c = c0 + j * kNT; const int r = c / cpr, ch = c - r * cpr; *(u32x4*)(xe + (rbase + r) * rowbytes + ch * 16) = v[j]; }
          } }
    }
    __syncthreads();
}

struct Unit { int pm, pn; };
DEVI bool unit_of(int Lid, int nM, int nN, Unit& u) {
    const int nwg = nM * nN; if (Lid >= nwg) return false;
    int wgid = Lid; { const int q = nwg / 8, r = nwg % 8, xcd = wgid % 8, off = wgid / 8; wgid = (xcd < r ? xcd * (q + 1) : r * (q + 1) + (xcd - r) * q) + off; }
    const int nig = 8 * nN, gid = wgid / nig, fm = gid * 8, gsz = (nM - fm) < 8 ? (nM - fm) : 8;
    u.pm = fm + ((wgid % nig) % gsz); u.pn = (wgid % nig) / gsz; return true;
}
struct GemmD { const bf16_t* A; const bf16_t* Bt; int lda, K, nM, nN; const int* rowidx; size_t bstride; int pmg; int stagger_10ns; };

template <class Epi>
DEVI void gemm_simple(const GemmD g, const Epi& E, int bid, int nblk) {
    const int tid = tidx(), wid = tid >> 6, lane = tid & 63, wr = wid >> 2, wc = wid & 3, fr = lane & 15, fq = lane >> 4;
    for (int i = 0;; ++i) {
        Unit u; if (!unit_of(i * nblk + bid, g.nM, g.nN, u)) break;
        f32x4 acc[2][2][4][2];
#pragma unroll
        for (int a = 0; a < 2; ++a)
#pragma unroll
            for (int b = 0; b < 2; ++b)
#pragma unroll
                for (int m = 0; m < 4; ++m)
#pragma unroll
                    for (int n = 0; n < 2; ++n) acc[a][b][m][n] = (f32x4){0.f, 0.f, 0.f, 0.f};
        const bf16_t* Bu = g.Bt + (size_t)(u.pm / g.pmg) * g.bstride + (size_t)u.pn * 256 * g.K;
        unsigned ao[2][4], bo[2][2];
#pragma unroll
        for (int a = 0; a < 2; ++a)
#pragma unroll
            for (int m = 0; m < 4; ++m) { const int r = u.pm * 256 + 128 * a + 64 * wr + 16 * m + fr; const unsigned rr = g.rowidx ? (unsigned)g.rowidx[r] : (unsigned)r; ao[a][m] = rr * (unsigned)g.lda + 8u * fq; }
#pragma unroll
        for (int b = 0; b < 2; ++b)
#pragma unroll
            for (int n = 0; n < 2; ++n) bo[b][n] = (unsigned)(128 * b + 32 * wc + 16 * n + fr) * (unsigned)g.K + 8u * fq;
#pragma unroll 1
        for (int k0 = 0; k0 < g.K; k0 += 32) {
            bf16x8 av[2][4], bv[2][2];
#pragma unroll
            for (int a = 0; a < 2; ++a)
#pragma unroll
                for (int m = 0; m < 4; ++m) av[a][m] = *(const bf16x8*)(g.A + ao[a][m] + k0);
#pragma unroll
            for (int b = 0; b < 2; ++b)
#pragma unroll
                for (int n = 0; n < 2; ++n) bv[b][n] = *(const bf16x8*)(Bu + bo[b][n] + k0);
#pragma unroll
            for (int a = 0; a < 2; ++a)
#pragma unroll
                for (int b = 0; b < 2; ++b)
#pragma unroll
                    for (int m = 0; m < 4; ++m)
#pragma unroll
                        for (int n = 0; n < 2; ++n) acc[a][b][m][n] = __builtin_amdgcn_mfma_f32_16x16x32_bf16(bv[b][n], av[a][m], acc[a][b][m][n], 0, 0, 0);
        }
        E(acc, u, wr, wc, fr, fq);
    }
}


constexpr int PG_HTB = 128 * 64 * 2;
DEVI int pg_lds_byte(int r, int c) { const int st = (r >> 4) * 2 + (c >> 5), rr = r & 15, cc = c & 31, ob = rr * 64 + cc * 2; return st * 1024 + (ob ^ (((ob >> 9) & 1) << 5)); }
DEVI void pg_stage_rc(int b, int& R, int& C) { const int st = b / 1024, sb = b % 1024, swz = sb ^ (((sb >> 9) & 1) << 5); R = (st >> 1) * 16 + swz / 64; C = (st & 1) * 32 + (swz % 64) / 2; }

typedef int v4i __attribute__((ext_vector_type(4)));
typedef int v8i __attribute__((ext_vector_type(8)));
template <class Epi, bool ALIGN_EPI, bool SP2, bool FP8 = false>
DEVI void gemm_engine(LAS unsigned char* lds, const GemmD g, const Epi& E, int bid, int nblk) {
    const int tid = tidx(), wid = __builtin_amdgcn_readfirstlane(tid >> 6), lane = tid & 63, wr = wid >> 2, wc = wid & 3, fr = lane & 15, fq = lane >> 4;
    constexpr int ES = FP8 ? 1 : 2;
    const int K = g.K * ES  , nt = K / 128; const unsigned ldaB = (unsigned)g.lda * ES;
    unsigned voffA[2], voffB[2];
#pragma unroll
    for (int i = 0; i < 2; ++i) { int R, C; pg_stage_rc(tid * 16 + i * 8192, R, C); voffA[i] = (unsigned)R * ldaB + (unsigned)C * 2u; voffB[i] = (unsigned)(R * K + C * 2); }
    const size_t kstep = 128;
    const size_t hstepB = (size_t)128 * K, hstepA = (size_t)128 * ldaB, tstepA = 2 * hstepA;
    const unsigned ldsw = (unsigned)wid * 1024u;
    const int aoff = pg_lds_byte(wr * 64 + fr, fq * 8), boff = pg_lds_byte(wc * 32 + fr, fq * 8);
#define PG8_SA(b, h) (((b) * 2 + (h)) * PG_HTB)
#define PG8_SB(b, h) ((4 + (b) * 2 + (h)) * PG_HTB)
#define PG8_STAGE(bufoff, gbase, voff) do { _Pragma("unroll") for (int _i = 0; _i < 2; ++_i) \
        __builtin_amdgcn_global_load_lds((const unsigned*)((const char*)(gbase) + (voff)[_i]), (LAS unsigned*)(lds + (bufoff) + ldsw + _i * 8192), 16, 0, 0); } while (0)
#define PG8_RD16(off) (*(const LAS v4i*)(lds + (off)))
#define PG8_CAT2(off) __builtin_shufflevector(PG8_RD16(off), PG8_RD16((off) + 1024), 0, 1, 2, 3, 4, 5, 6, 7)
#define PG8_LDA(dst, b, h) do { _Pragma("unroll") for (int m = 0; m < 4; ++m) { if constexpr (FP8) dst##8[m] = PG8_CAT2(PG8_SA(b, h) + aoff + m * 2048); \
        else { _Pragma("unroll") for (int k = 0; k < 2; ++k) dst[m][k] = *(const LAS bf16x8*)(lds + PG8_SA(b, h) + aoff + m * 2048 + k * 1024); } } } while (0)
#define PG8_LDB(dst, b, h) do { _Pragma("unroll") for (int n = 0; n < 2; ++n) { if constexpr (FP8) dst##8[n] = PG8_CAT2(PG8_SB(b, h) + boff + n * 2048); \
        else { _Pragma("unroll") for (int k = 0; k < 2; ++k) dst[n][k] = *(const LAS bf16x8*)(lds + PG8_SB(b, h) + boff + n * 2048 + k * 1024); } } } while (0)
#define PG8_MMA(ai, bj, At, Bt) do { __builtin_amdgcn_s_setprio(1); _Pragma("unroll") for (int m = 0; m < 4; ++m) _Pragma("unroll") for (int n = 0; n < 2; ++n) { \
        if constexpr (FP8) asm volatile("v_mfma_f32_16x16x128_f8f6f4 %0, %1, %2, %0" : "+v"(acc[ai][bj][m][n]) : "v"(Bt##8[n]), "v"(At##8[m]));   \
        else { _Pragma("unroll") for (int k = 0; k < 2; ++k) acc[ai][bj][m][n] = __builtin_amdgcn_mfma_f32_16x16x32_bf16(Bt[n][k], At[m][k], acc[ai][bj][m][n], 0, 0, 0); } } \
        __builtin_amdgcn_s_setprio(0); } while (0)
#define PG8_WAIT_V(n) asm volatile("s_waitcnt vmcnt(" #n ")" ::: "memory")
#define PG8_WAIT_L(n) asm volatile("s_waitcnt lgkmcnt(" #n ")" ::: "memory")
#define PG8_BAR __builtin_amdgcn_s_barrier()
#define PG8_SCHED __builtin_amdgcn_sched_barrier(0)
    Unit cur, nxt; int ui = 0;
    if (!unit_of(bid, g.nM, g.nN, cur)) return;
    if (g.stagger_10ns) { const unsigned long long t0 = __builtin_amdgcn_s_memrealtime(), dt = (unsigned long long)(((bid >> 3) & 3) * g.stagger_10ns);
        while (__builtin_amdgcn_s_memrealtime() - t0 < dt) __builtin_amdgcn_s_sleep(8); }
    f32x4 acc[2][2][4][2];
#pragma unroll
    for (int a = 0; a < 2; ++a)
#pragma unroll
        for (int b = 0; b < 2; ++b)
#pragma unroll
            for (int m = 0; m < 4; ++m)
#pragma unroll
                for (int n = 0; n < 2; ++n) acc[a][b][m][n] = (f32x4){0.f, 0.f, 0.f, 0.f};
    bf16x8 At[4][2], B0[2][2], B1[2][2]; v8i At8[4], B08[2], B18[2];
    (void)At; (void)B0; (void)B1; (void)At8; (void)B08; (void)B18;
    static_assert(SP2, "only the two-super-phase K-loop is kept");
    const char* cA = (const char*)g.A + (size_t)cur.pm * tstepA;
    const char* cB = (const char*)g.Bt + (size_t)(cur.pm / g.pmg) * g.bstride * ES + (size_t)cur.pn * 256 * K;
    PG8_STAGE(PG8_SB(0, 0), cB, voffB); PG8_STAGE(PG8_SB(0, 1), cB + hstepB, voffB); PG8_STAGE(PG8_SA(0, 0), cA, voffA); PG8_STAGE(PG8_SA(0, 1), cA + hstepA, voffA);
    if (wr == 1) PG8_BAR;
    PG8_WAIT_V(2); PG8_BAR;
    PG8_STAGE(PG8_SB(1, 0), cB + kstep, voffB); PG8_STAGE(PG8_SA(1, 0), cA + kstep, voffA); PG8_STAGE(PG8_SB(1, 1), cB + hstepB + kstep, voffB);
    PG8_WAIT_V(6); PG8_BAR;
    for (;;) {
        const bool has_next = unit_of((ui + 1) * nblk + bid, g.nM, g.nN, nxt);
        const char* nA = has_next ? (const char*)g.A + (size_t)nxt.pm * tstepA : cA;
        const char* nB = has_next ? (const char*)g.Bt + (size_t)(nxt.pm / g.pmg) * g.bstride * ES + (size_t)nxt.pn * 256 * K : cB;
#pragma unroll 1
        for (int t = 0; t < nt; t += 2) {
            const bool last = (t == nt - 2);
            const char* a1 = cA + (size_t)(t + 1) * kstep;
            const char* a2 = last ? nA : cA + (size_t)(t + 2) * kstep; const char* b2 = last ? nB : cB + (size_t)(t + 2) * kstep;
            const char* a3 = a2 + kstep; const char* b3 = b2 + kstep;
            PG8_LDB(B0, 0, 0); PG8_LDB(B1, 0, 1); PG8_SCHED; PG8_LDA(At, 0, 0); PG8_STAGE(PG8_SA(1, 1), a1 + hstepA, voffA);
            PG8_WAIT_V(8); PG8_WAIT_L(0); PG8_BAR; PG8_MMA(0, 0, At, B0); PG8_MMA(0, 1, At, B1); PG8_BAR; PG8_SCHED;
            PG8_LDA(At, 0, 1); PG8_STAGE(PG8_SB(0, 0), b2, voffB); PG8_STAGE(PG8_SB(0, 1), b2 + hstepB, voffB); PG8_STAGE(PG8_SA(0, 0), a2, voffA);
            PG8_WAIT_V(8); PG8_WAIT_L(0); PG8_BAR; PG8_MMA(1, 0, At, B0); PG8_MMA(1, 1, At, B1); PG8_BAR; PG8_SCHED;
            PG8_LDB(B0, 1, 0); PG8_LDB(B1, 1, 1); PG8_SCHED; PG8_LDA(At, 1, 0); PG8_STAGE(PG8_SA(0, 1), a2 + hstepA, voffA);
            PG8_WAIT_V(8); PG8_WAIT_L(0); PG8_BAR; PG8_MMA(0, 0, At, B0); PG8_MMA(0, 1, At, B1); PG8_BAR; PG8_SCHED;
            PG8_LDA(At, 1, 1); PG8_STAGE(PG8_SB(1, 0), b3, voffB); PG8_STAGE(PG8_SB(1, 1), b3 + hstepB, voffB); PG8_STAGE(PG8_SA(1, 0), a3, voffA);
            PG8_WAIT_V(8); PG8_WAIT_L(0); PG8_BAR; PG8_MMA(1, 0, At, B0); PG8_MMA(1, 1, At, B1); PG8_BAR; PG8_SCHED;
        }
        if constexpr (ALIGN_EPI) { if (wr == 0) PG8_BAR; }
        if constexpr (FP8) asm volatile("s_nop 15\n\ts_nop 15" ::: "memory");
        E(acc, cur, wr, wc, fr, fq);
        if (!has_next) break;
#pragma unroll
        for (int a = 0; a < 2; ++a)
#pragma unroll
            for (int b = 0; b < 2; ++b)
#pragma unroll
                for (int m = 0; m < 4; ++m)
#pragma unroll
                    for (int n = 0; n < 2; ++n) acc[a][b][m][n] = (f32x4){0.f, 0.f, 0.f, 0.f};
        cur = nxt; cA = nA; cB = nB; ++ui;
        if constexpr (ALIGN_EPI) { if (wr == 1) PG8_BAR; }
    }
    PG8_WAIT_V(0);
    if constexpr (!ALIGN_EPI) { if (wr == 0) PG8_BAR; }
    PG8_BAR;
#undef PG8_SA
#undef PG8_SB
#undef PG8_STAGE
#undef PG8_LDA
#undef PG8_LDB
#undef PG8_MMA
#undef PG8_RD16
#undef PG8_CAT2
#undef PG8_WAIT_V
#undef PG8_WAIT_L
#undef PG8_BAR
#undef PG8_SCHED
}

template <int PROBE = 0> struct EpiQKV {
    static constexpr int VMOPS = 16;
    bf16_t *qa, *ka, *va, *qb, *kb, *vb, *ux;
    bf16_t* scratch;
    const LAS float* gtab;
    DEVI void operator()(const f32x4 (&acc)[2][2][4][2], const Unit& u, int wr, int wc, int fr, int fq) const {
        const int pn = u.pn;
        bf16_t* dst = (pn < 2) ? qa : (pn < 4) ? ka : (pn < 6) ? va : (pn == 6) ? qb : (pn == 7) ? kb : (pn == 8) ? vb : ux;
        const int H = (pn < 6) ? 8 : 4, head = ((pn < 6) ? (pn & 1) * 4 : 0) + wc;
        const int trow = (pn < 2) ? 0 : (pn < 4) ? 1 : (pn == 6) ? 2 : (pn == 7) ? 3 : 4;
        const bool nrm = trow < 4;
        f32x4 gv[2][2];
#pragma unroll
        for (int bj = 0; bj < 2; ++bj)
#pragma unroll
            for (int n = 0; n < 2; ++n) gv[bj][n] = *(const LAS f32x4*)(gtab + trow * 64 + 32 * bj + 8 * fq + 4 * n);
        const size_t hb = (size_t)head * kS * 64 + 8 * fq;
        const int g0 = 4 * wc + (fq >> 1), c0 = 8 * (fq & 1);
#pragma unroll
        for (int ai = 0; ai < 2; ++ai)
#pragma unroll
            for (int m = 0; m < 4; ++m) {
                const int row = u.pm * 256 + 128 * ai + 64 * wr + 16 * m + fr;
                float ss = 0.f;
#pragma unroll
                for (int bj = 0; bj < 2; ++bj)
#pragma unroll
                    for (int n = 0; n < 2; ++n) { const f32x4 v = acc[ai][bj][m][n]; ss += v.x * v.x + v.y * v.y + v.z * v.z + v.w * v.w; }
                ss = xsum32(xsum16(ss));
                const float rs = (PROBE == 2) ? 1.f : __builtin_amdgcn_rsqf(ss * (1.f / 64.f) + kEps), rstd = nrm ? rs : 1.f;
                const int b = row >> 13, sq = row & (kS - 1);
                const size_t o_qkv = ((size_t)b * H * kS + sq) * 64 + hb, o_u = ((size_t)g0 * 4096 + (row >> 4)) * 512 + (row & 15) * 16 + c0;
#pragma unroll
                for (int bj = 0; bj < 2; ++bj) {
                    const f32x4 v0 = acc[ai][bj][m][0] * rstd * gv[bj][0], v1 = acc[ai][bj][m][1] * rstd * gv[bj][1];
                    u32x4 w; w.x = pk2(v0.x, v0.y); w.y = pk2(v0.z, v0.w); w.z = pk2(v1.x, v1.y); w.w = pk2(v1.z, v1.w);
                    if constexpr (PROBE == 3) { *(u32x4*)(scratch + (size_t)blockIdx.x * 65536 + ((ai * 4 + m) * 2 + bj) * 4096 + tidx() * 8) = w; }
                    else { const size_t o = (pn < 9) ? o_qkv + 32 * bj : o_u + (size_t)bj * 2 * 4096 * 512;
                        if constexpr (PROBE == 1) { if (w.x == 0x7FC12345u && w.y == 0x7FC12345u) *(u32x4*)(dst + o) = w; }
                        else *(u32x4*)(dst + o) = w; }
                }
            }
    }
};
struct EpiResid {
    static constexpr int VMOPS = 16;
    const float* x32; bf16_t* xb; bf16_t* xbo;
    DEVI void operator()(const f32x4 (&acc)[2][2][4][2], const Unit& u, int wr, int wc, int fr, int fq) const {
#pragma unroll
        for (int ai = 0; ai < 2; ++ai) {
            const size_t r0 = (size_t)(u.pm * 256 + 128 * ai + 64 * wr + fr) * kD + u.pn * 256 + 32 * wc + 8 * fq;
            if (x32) {
                f32x4 a[4][2][2];
#pragma unroll
                for (int m = 0; m < 4; ++m)
#pragma unroll
                    for (int bj = 0; bj < 2; ++bj) { const size_t o = r0 + (size_t)m * 16 * kD + 128 * bj; a[m][bj][0] = *(const f32x4*)(x32 + o); a[m][bj][1] = *(const f32x4*)(x32 + o + 4); }
#pragma unroll
                for (int m = 0; m < 4; ++m)
#pragma unroll
                    for (int bj = 0; bj < 2; ++bj) { const size_t o = r0 + (size_t)m * 16 * kD + 128 * bj; const f32x4 v0 = a[m][bj][0] + acc[ai][bj][m][0], v1 = a[m][bj][1] + acc[ai][bj][m][1];
                        u32x4 r; r.x = pk2(v0.x, v0.y); r.y = pk2(v0.z, v0.w); r.z = pk2(v1.x, v1.y); r.w = pk2(v1.z, v1.w); *(u32x4*)(xbo + o) = r; }
            } else {
                u32x4 a[4][2];
#pragma unroll
                for (int m = 0; m < 4; ++m)
#pragma unroll
                    for (int bj = 0; bj < 2; ++bj) a[m][bj] = *(const u32x4*)(xb + r0 + (size_t)m * 16 * kD + 128 * bj);
#pragma unroll
                for (int m = 0; m < 4; ++m)
#pragma unroll
                    for (int bj = 0; bj < 2; ++bj) { const size_t o = r0 + (size_t)m * 16 * kD + 128 * bj; const u32x4 w = a[m][bj];
                        const f32x4 v0 = (f32x4){__uint_as_float(w.x << 16), __uint_as_float(w.x & 0xFFFF0000u), __uint_as_float(w.y << 16), __uint_as_float(w.y & 0xFFFF0000u)} + acc[ai][bj][m][0];
                        const f32x4 v1 = (f32x4){__uint_as_float(w.z << 16), __uint_as_float(w.z & 0xFFFF0000u), __uint_as_float(w.w << 16), __uint_as_float(w.w & 0xFFFF0000u)} + acc[ai][bj][m][1];
                        u32x4 r; r.x = pk2(v0.x, v0.y); r.y = pk2(v0.z, v0.w); r.z = pk2(v1.x, v1.y); r.w = pk2(v1.z, v1.w); *(u32x4*)(xbo + o) = r; }
            }
        }
    }
};
struct EpiGU {
    static constexpr int VMOPS = 4;
    bf16_t* hid; float sc; bool nomath;
    DEVI void silu8(const f32x4 (&acc)[2][2][4][2], int ai, int m, float (&o)[8]) const {
        const float k1 = -sc * kLog2e, k2 = sc * sc * (FP8_DN ? kH8 : 1.f);
#pragma unroll
        for (int n = 0; n < 2; ++n)
#pragma unroll
            for (int j = 0; j < 4; j += 2) { const f32x2 a = {acc[ai][0][m][n][j], acc[ai][0][m][n][j + 1]}, b = {acc[ai][1][m][n][j], acc[ai][1][m][n][j + 1]};
                const f32x2 ab = a * b, t = a * k1; f32x2 d; d.x = __builtin_amdgcn_exp2f(t.x); d.y = __builtin_amdgcn_exp2f(t.y); d = d + 1.f;
                f32x2 r; r.x = frcp(d.x); r.y = frcp(d.y); const f32x2 v = nomath ? ab * k2 : (ab * r) * k2;
                o[n * 4 + j] = v.x; o[n * 4 + j + 1] = v.y; }
    }
    DEVI void operator()(const f32x4 (&acc)[2][2][4][2], const Unit& u, int wr, int wc, int fr, int fq) const {
#pragma unroll
        for (int ai = 0; ai < 2; ++ai)
#if FP8_DN
#pragma unroll
            for (int m = 0; m < 4; m += 2) {
                float o0[8], o1[8]; silu8(acc, ai, m, o0); silu8(acc, ai, m + 1, o1);
#pragma unroll
                for (int t = 0; t < 8; ++t) { o0[t] = __builtin_amdgcn_fmed3f(o0[t], -448.f, 448.f); o1[t] = __builtin_amdgcn_fmed3f(o1[t], -448.f, 448.f); }
                unsigned ax = pk4_fp8(o0[0], o0[1], o0[2], o0[3]), ay = pk4_fp8(o0[4], o0[5], o0[6], o0[7]), bx = pk4_fp8(o1[0], o1[1], o1[2], o1[3]), by = pk4_fp8(o1[4], o1[5], o1[6], o1[7]);
                swap16u(ax, bx); swap16u(ay, by);
                const size_t row = (size_t)(u.pm * 256 + 128 * ai + 64 * wr + 16 * (m + (fq & 1)) + fr);
                u32x4 w; w.x = ax; w.y = ay; w.z = bx; w.w = by;
                *(u32x4*)((unsigned char*)hid + row * kFF + u.pn * 128 + 32 * wc + 8 * (fq & ~1)) = w;
            }
#else
#pragma unroll
            for (int m = 0; m < 4; ++m) { const size_t row = (size_t)(u.pm * 256 + 128 * ai + 64 * wr + 16 * m + fr);
                float o[8]; silu8(acc, ai, m, o);
                u32x4 w; w.x = pk2(o[0], o[1]); w.y = pk2(o[2], o[3]); w.z = pk2(o[4], o[5]); w.w = pk2(o[6], o[7]);
                *(u32x4*)(hid + row * kFF + u.pn * 128 + 32 * wc + 8 * fq) = w;
            }
#endif
    }
};
struct EpiDry {
    static constexpr int VMOPS = 0;
    float* sink;
    DEVI void operator()(const f32x4 (&acc)[2][2][4][2], const Unit& u, int wr, int wc, int fr, int fq) const {
        float t = 0.f;
#pragma unroll
        for (int ai = 0; ai < 2; ++ai)
#pragma unroll
            for (int bj = 0; bj < 2; ++bj)
#pragma unroll
                for (int m = 0; m < 4; ++m)
#pragma unroll
                    for (int n = 0; n < 2; ++n) t += acc[ai][bj][m][n].x + acc[ai][bj][m][n].y + acc[ai][bj][m][n].z + acc[ai][bj][m][n].w;
        if (t == 1.2345e30f) sink[0] = t;
    }
};
struct EpiDown {
    static constexpr int VMOPS = 8;
    bf16_t* y; const float* gate; float sc;
    DEVI static unsigned pk4c(const f32x4 v) { return pk4_fp8(__builtin_amdgcn_fmed3f(v.x, -448.f, 448.f), __builtin_amdgcn_fmed3f(v.y, -448.f, 448.f), __builtin_amdgcn_fmed3f(v.z, -448.f, 448.f), __builtin_amdgcn_fmed3f(v.w, -448.f, 448.f)); }
    DEVI void operator()(const f32x4 (&acc)[2][2][4][2], const Unit& u, int wr, int wc, int fr, int fq) const {
        const float gv = sc * (FP8_Y ? kY8 : 1.f);
#pragma unroll
        for (int ai = 0; ai < 2; ++ai)
#if FP8_Y
#pragma unroll
            for (int m = 0; m < 4; m += 2)
#pragma unroll
                for (int bj = 0; bj < 2; ++bj) {
                    unsigned ax = pk4c(acc[ai][bj][m][0] * gv), ay = pk4c(acc[ai][bj][m][1] * gv), bx = pk4c(acc[ai][bj][m + 1][0] * gv), by = pk4c(acc[ai][bj][m + 1][1] * gv);
                    swap16u(ax, bx); swap16u(ay, by);
                    const size_t row = (size_t)(u.pm * 256 + 128 * ai + 64 * wr + 16 * (m + (fq & 1)) + fr);
                    u32x4 w; w.x = ax; w.y = ay; w.z = bx; w.w = by;
                    *(u32x4*)((unsigned char*)y + row * kD + u.pn * 256 + 128 * bj + 32 * wc + 8 * (fq & ~1)) = w;
                }
#else
#pragma unroll
            for (int m = 0; m < 4; ++m) { const size_t row = (size_t)(u.pm * 256 + 128 * ai + 64 * wr + 16 * m + fr);
#pragma unroll
                for (int bj = 0; bj < 2; ++bj) { const f32x4 v0 = acc[ai][bj][m][0] * gv, v1 = acc[ai][bj][m][1] * gv;
                    u32x4 w; w.x = pk2(v0.x, v0.y); w.y = pk2(v0.z, v0.w); w.z = pk2(v1.x, v1.y); w.w = pk2(v1.z, v1.w);
                    *(u32x4*)(y + row * kD + u.pn * 256 + 128 * bj + 32 * wc + 8 * fq) = w; } }
#endif
    }
};
struct EpiGlu {
    static constexpr int VMOPS = 16;
    const bf16_t* g; bf16_t* oc;
    DEVI void operator()(const f32x4 (&acc)[2][2][4][2], const Unit& u, int wr, int wc, int fr, int fq) const {
#pragma unroll
        for (int ai = 0; ai < 2; ++ai) {
            const size_t r0 = (size_t)(u.pm * 256 + 128 * ai + 64 * wr + fr) * 256 + 32 * wc + 8 * fq;
            u32x4 gw[4][2];
#pragma unroll
            for (int m = 0; m < 4; ++m)
#pragma unroll
                for (int bj = 0; bj < 2; ++bj) gw[m][bj] = *(const u32x4*)(g + r0 + (size_t)m * 16 * 256 + 128 * bj);
#pragma unroll
            for (int m = 0; m < 4; ++m)
#pragma unroll
                for (int bj = 0; bj < 2; ++bj) { const size_t o = r0 + (size_t)m * 16 * 256 + 128 * bj; float gg[8]; unpk8s(gg, gw[m][bj]); float o8[8];
#pragma unroll
                    for (int n = 0; n < 2; ++n)
#pragma unroll
                        for (int j = 0; j < 4; ++j) o8[n * 4 + j] = gg[n * 4 + j] * frcp(1.f + __expf(-acc[ai][bj][m][n][j]));
                    u32x4 w; w.x = pk2(o8[0], o8[1]); w.y = pk2(o8[2], o8[3]); w.z = pk2(o8[4], o8[5]); w.w = pk2(o8[6], o8[7]);
                    *(u32x4*)(oc + o) = w; }
        }
    }
};

DEVI void load_row64(const bf16_t* p, float* d) {
#pragma unroll
    for (int i = 0; i < 8; ++i) { const u32x4 v = *(const u32x4*)(p + i * 8);
        d[i * 8 + 0] = __uint_as_float(v.x << 16); d[i * 8 + 1] = __uint_as_float(v.x & 0xFFFF0000u); d[i * 8 + 2] = __uint_as_float(v.y << 16); d[i * 8 + 3] = __uint_as_float(v.y & 0xFFFF0000u);
        d[i * 8 + 4] = __uint_as_float(v.z << 16); d[i * 8 + 5] = __uint_as_float(v.z & 0xFFFF0000u); d[i * 8 + 6] = __uint_as_float(v.w << 16); d[i * 8 + 7] = __uint_as_float(v.w & 0xFFFF0000u); }
}
DEVI void store_row64(bf16_t* p, const float* d, float sc) {
#pragma unroll
    for (int i = 0; i < 8; ++i) { u32x4 w; w.x = pk2(d[i * 8] * sc, d[i * 8 + 1] * sc); w.y = pk2(d[i * 8 + 2] * sc, d[i * 8 + 3] * sc); w.z = pk2(d[i * 8 + 4] * sc, d[i * 8 + 5] * sc); w.w = pk2(d[i * 8 + 6] * sc, d[i * 8 + 7] * sc);
        *(u32x4*)(p + i * 8) = w; }
}
DEVI void phase_dilated_naive(const bf16_t* qa, const bf16_t* ka, const bf16_t* va, bf16_t* oac, float* lse, int bid, int nblk) {
    const int nitems = 3 * kB * 8 * (kS / kNT);
    for (int it = bid; it < nitems; it += nblk) {
        const int c = it / (kB * 8 * 16), r = it % (kB * 8 * 16), bh = r / 16, t = (r % 16) * kNT + tidx(), b = bh >> 3, h = bh & 7;
        const int dil = (c == 0) ? 1 : (c == 1) ? 4 : 16;
        const float slope = exp2f(-(float)(h + 1));
        const bf16_t* kb_ = ka + (size_t)bh * kS * 64; const bf16_t* vb_ = va + (size_t)bh * kS * 64;
        float q[64], o[64];
        load_row64(qa + ((size_t)bh * kS + t) * 64, q);
#pragma unroll
        for (int d = 0; d < 64; ++d) o[d] = 0.f;
        float m = -1e30f, l = 0.f;
        for (int rel = -64; rel <= 64; ++rel) {
            const int pos = t + rel * dil;
            if (pos < 0 || pos >= kS) continue;
            float kv[64]; load_row64(kb_ + (size_t)pos * 64, kv);
            float dot = 0.f;
#pragma unroll
            for (int d = 0; d < 64; ++d) dot += q[d] * kv[d];
            const float sc = dot * 0.125f - slope * (float)(dil * (rel < 0 ? -rel : rel));
            const float mn = fmaxf(m, sc), corr = __expf(m - mn), p = __expf(sc - mn);
            load_row64(vb_ + (size_t)pos * 64, kv);
            l = l * corr + p;
#pragma unroll
            for (int d = 0; d < 64; ++d) o[d] = o[d] * corr + p * kv[d];
            m = mn;
        }
        const size_t tok = (size_t)b * kS + t;
        store_row64(oac + ((size_t)c * kTok + tok) * 512 + h * 64, o, 1.f / l);
        lse[((size_t)c * kTok + tok) * 8 + h] = m + __logf(l);
    }
}
DEVI void phase_na_naive(const bf16_t* qb, const bf16_t* kbuf, const bf16_t* vbuf, const float* rpb  , bf16_t* ob, int bid, int nblk) {
    const int nitems = kB * 4 * (kS / kNT);
    for (int it = bid; it < nitems; it += nblk) {
        const int bh = it / 16, t = (it % 16) * kNT + tidx(), b = bh >> 2, h = bh & 3;
        const int r = t >> 6, cq = t & 63;
        int rs = r - 4; rs = rs < 0 ? 0 : (rs > 120 ? 120 : rs);
        int cs = cq - 8; cs = cs < 0 ? 0 : (cs > 48 ? 48 : cs);
        const bf16_t* kb_ = kbuf + (size_t)bh * kS * 64; const bf16_t* vb_ = vbuf + (size_t)bh * kS * 64;
        float q[64], o[64];
        load_row64(qb + ((size_t)bh * kS + t) * 64, q);
#pragma unroll
        for (int d = 0; d < 64; ++d) o[d] = 0.f;
        float m = -1e30f, l = 0.f;
        for (int kr = 0; kr < 8; ++kr)
            for (int kc = 0; kc < 16; ++kc) {
                const int krow = rs + kr, kcol = cs + kc, pos = krow * 64 + kcol;
                float kv[64]; load_row64(kb_ + (size_t)pos * 64, kv);
                float dot = 0.f;
#pragma unroll
                for (int d = 0; d < 64; ++d) dot += q[d] * kv[d];
                const float sc = dot * 0.125f + rpb[(h * 15 + (krow - r + 7)) * 31 + (kcol - cq + 15)];
                const float mn = fmaxf(m, sc), corr = __expf(m - mn), p = __expf(sc - mn);
                load_row64(vb_ + (size_t)pos * 64, kv);
                l = l * corr + p;
#pragma unroll
                for (int d = 0; d < 64; ++d) o[d] = o[d] * corr + p * kv[d];
                m = mn;
            }
        store_row64(ob + ((size_t)b * kS + t) * 256 + h * 64, o, 1.f / l);
    }
}

typedef float f32x16 __attribute__((ext_vector_type(16)));
typedef short s16x4 __attribute__((ext_vector_type(4)));
DEVI bf16x8 tr_pair(LAS unsigned char* p0, LAS unsigned char* p1) {
    const s16x4 a = __builtin_amdgcn_ds_read_tr16_b64_v4i16((LAS s16x4*)p0), b = __builtin_amdgcn_ds_read_tr16_b64_v4i16((LAS s16x4*)p1);
    return (bf16x8){a.x, a.y, a.z, a.w, b.x, b.y, b.z, b.w};
}
template <int VAR = 0>
DEVI void phase_dilated(const bf16_t* qa, const bf16_t* ka, const bf16_t* va, const float* gq, const float* gk, bf16_t* oac, float* lse, LAS unsigned char* lds, int bid, int nblk) {
    const int tid = tidx(), wid = __builtin_amdgcn_readfirstlane(tid >> 6), lane = tid & 63, h5 = lane >> 5, qc = lane & 31;
    LAS unsigned char* Kimg = lds; LAS unsigned char* Vimg = lds + 49152;
    float Mn;
    { float a = fabsf(gq[lane]), b = fabsf(gk[lane]);
#pragma unroll
      for (int m = 32; m >= 1; m >>= 1) { a = fmaxf(a, __shfl_xor(a, m)); b = fmaxf(b, __shfl_xor(b, m)); }
      Mn = 8.f * a * b; }
    const float Mb = Mn * kLog2e;
    unsigned koff[4];
#pragma unroll
    for (int s = 0; s < 4; ++s) koff[s] = (unsigned)((32 * wid + qc) * 128 + (((2 * s + h5) ^ (qc & 7)) << 4));
    unsigned voff[2];
    { const int g = lane >> 4, i16 = lane & 15, q = i16 >> 2, p = i16 & 3;
#pragma unroll
      for (int dt = 0; dt < 2; ++dt) { const int c = (2 * (g & 1) + (p >> 1) + 4 * dt) ^ ((q >> 1) << 2); voff[dt] = (unsigned)((32 * wid + 4 * h5 + q) * 128 + (c << 4) + 8 * (p & 1)); } }
    const float dbase = (float)(4 * h5 - qc);
    u32x4 pK[6], pV[6];
#define DIL_DECODE(unit_) const int c = (unit_) >> 11, rem = (unit_) & 2047, bh = rem >> 5, ub = rem & 31; \
        const int dsh = 2 * c, L = kS >> dsh, upc = 32 >> dsh, cls = ub >> (5 - dsh), u0 = (ub & (upc - 1)) << 8;
#define DIL_PREFETCH(unit_) do { DIL_DECODE(unit_) \
        const bf16_t* kbase = ka + (size_t)bh * kS * 64; const bf16_t* vbase = va + (size_t)bh * kS * 64; \
        _Pragma("unroll") for (int it = 0; it < 6; ++it) { const int id = it * kNT + tid, row = id >> 3, ch = id & 7; \
            int ki = u0 - 64 + row; ki = ki < 0 ? 0 : (ki > L - 1 ? L - 1 : ki); const size_t tok = (size_t)((ki << dsh) + cls); \
            pK[it] = *(const u32x4*)(kbase + tok * 64 + ch * 8); pV[it] = *(const u32x4*)(vbase + tok * 64 + ch * 8); } } while (0)
    if ((VAR & 8) || bid < 6144) DIL_PREFETCH(bid);
    for (int unit = bid; unit < 6144; unit += nblk) {
        DIL_DECODE(unit)
        const int q0 = u0 + 32 * wid, qtok = ((q0 + qc) << dsh) + cls;
        bf16x8 Qf[4];
#pragma unroll
        for (int s = 0; s < 4; ++s) Qf[s] = *(const bf16x8*)(qa + ((size_t)bh * kS + qtok) * 64 + 16 * s + 8 * h5);
        __syncthreads();
        if (!(VAR & 8)) {
#pragma unroll
        for (int it = 0; it < 6; ++it) { const int id = it * kNT + tid, row = id >> 3, ch = id & 7;
            *(LAS u32x4*)(Kimg + row * 128 + ((ch ^ (row & 7)) << 4)) = pK[it];
            *(LAS u32x4*)(Vimg + row * 128 + ((ch ^ (((row >> 1) & 1) << 2)) << 4)) = pV[it]; } }
        __syncthreads();
        if (!(VAR & 8) && unit + nblk < 6144) DIL_PREFETCH(unit + nblk);
        const float slope = exp2f(-(float)((bh & 7) + 1));
        const float c1 = 0.125f * kLog2e, c2 = slope * (float)(1 << dsh) * kLog2e;
        float sum = 0.f;
        f32x16 O[2];
#pragma unroll
        for (int dt = 0; dt < 2; ++dt)
#pragma unroll
            for (int i = 0; i < 16; ++i) O[dt][i] = 0.f;
#define DIL_QK(dst, kt_) do { _Pragma("unroll") for (int i = 0; i < 16; ++i) dst[i] = 0.f; \
            _Pragma("unroll") for (int s = 0; s < 4; ++s) { const bf16x8 Kf = *(const LAS bf16x8*)(Kimg + koff[s] + (kt_) * 4096); dst = __builtin_amdgcn_mfma_f32_32x32x16_bf16(Kf, Qf[s], dst, 0, 0, 0); } } while (0)
        f32x16 S, Sn;
        DIL_QK(S, 0);
        f32x2 sum2 = {0.f, 0.f};
        const float ndb = -dbase;
#pragma unroll
        for (int kt = 0; kt < 5; ++kt) {
            if (kt < 4) DIL_QK(Sn, kt + 1);
            const int kp0 = q0 - 64 + 32 * kt;
            const float tm = (kp0 >= 0 && kp0 < L) ? 0.f : -1e30f;
            const float cs = (kt < 2) ? c2 : -c2, c0 = ((kt == 0 || kt == 4) ? -64.f : (kt == 2 ? 0.f : -32.f)) * c2 - Mb + tm;
            const float bt = dbase * cs + c0;
#pragma unroll
            for (int i = 0; i < 16; i += 2) {
                const float k0 = (float)((i & 3) + 8 * (i >> 2)), k1 = (float)(((i + 1) & 3) + 8 * ((i + 1) >> 2));
                f32x2 t;
                if (kt == 2) { const f32x2 d = {fabsf(dbase + k0), fabsf(dbase + k1)}; t = d * cs + c0; }
                else t = (f32x2){k0, k1} * cs + bt;
                f32x2 sv = (f32x2){S[i], S[i + 1]} * c1 + t;
                if (kt == 0) { sv.x = (k0 >= ndb) ? sv.x : -1e30f; sv.y = (k1 >= ndb) ? sv.y : -1e30f; }
                if (kt == 4) { sv.x = (k0 <= ndb) ? sv.x : -1e30f; sv.y = (k1 <= ndb) ? sv.y : -1e30f; }
                f32x2 pv; pv.x = (VAR & 4) ? S[i] : __builtin_amdgcn_exp2f(sv.x); pv.y = (VAR & 4) ? S[i + 1] : __builtin_amdgcn_exp2f(sv.y);
                S[i] = pv.x; S[i + 1] = pv.y; sum2 += pv;
            }
            if (VAR & 2) { _Pragma("unroll") for (int i = 0; i < 16; ++i) O[0][i] += S[i]; }
            else
#pragma unroll
            for (int s2 = 0; s2 < 2; ++s2) {
                u32x4 pw; pw.x = pk2(S[8 * s2 + 0], S[8 * s2 + 1]); pw.y = pk2(S[8 * s2 + 2], S[8 * s2 + 3]); pw.z = pk2(S[8 * s2 + 4], S[8 * s2 + 5]); pw.w = pk2(S[8 * s2 + 6], S[8 * s2 + 7]);
                const bf16x8 Pf = __builtin_bit_cast(bf16x8, pw);
#pragma unroll
                for (int dt = 0; dt < 2; ++dt) { LAS unsigned char* vp = Vimg + voff[dt] + kt * 4096 + s2 * 2048;
                    const bf16x8 Vf = tr_pair(vp, vp + 1024);
                    O[dt] = __builtin_amdgcn_mfma_f32_32x32x16_bf16(Vf, Pf, O[dt], 0, 0, 0); }
            }
            if (kt < 4) S = Sn;
        }
#undef DIL_QK
        sum = sum2.x + sum2.y;
        sum = xsum32(sum);
        const float inv = 1.f / sum;
        const size_t tok = (size_t)(bh >> 3) * kS + qtok;
        if (VAR & 1) { float t = inv; _Pragma("unroll") for (int dt = 0; dt < 2; ++dt) _Pragma("unroll") for (int i = 0; i < 16; ++i) t += O[dt][i]; if (t == 1.2345e30f) lse[0] = t; }
        else {
        LAS unsigned char* ost = lds + 98304 + wid * 4096;
#pragma unroll
        for (int dt = 0; dt < 2; ++dt)
#pragma unroll
            for (int g4 = 0; g4 < 4; ++g4) { u32x2 w; w.x = pk2(O[dt][4 * g4] * inv, O[dt][4 * g4 + 1] * inv); w.y = pk2(O[dt][4 * g4 + 2] * inv, O[dt][4 * g4 + 3] * inv);
                *(LAS u32x2*)(ost + qc * 128 + (((4 * dt + g4) ^ (qc & 7)) << 4) + 8 * h5) = w; }
        if (h5 == 0) lse[((size_t)c * kTok + tok) * 8 + (bh & 7)] = Mn + __logf(sum);
        bf16_t* obase = oac + ((size_t)c * kTok + (size_t)(bh >> 3) * kS) * 512 + (bh & 7) * 64;
#pragma unroll
        for (int it = 0; it < 4; ++it) { const int r = it * 8 + (lane >> 3), ch = lane & 7;
            const u32x4 v = *(const LAS u32x4*)(ost + r * 128 + ((ch ^ (r & 7)) << 4));
            const size_t t2 = (size_t)(((q0 + r) << dsh) + cls);
            *(u32x4*)(obase + t2 * 512 + ch * 8) = v; }
        }
    }
#undef DIL_DECODE
#undef DIL_PREFETCH
    __syncthreads();
}
DEVI void phase_na(const bf16_t* qb, const bf16_t* kb, const bf16_t* vb, const float* rpb  , const float* gq, const float* gk, bf16_t* ob, LAS unsigned char* lds, int bid, int nblk) {
    const int tid = tidx(), wid = __builtin_amdgcn_readfirstlane(tid >> 6), lane = tid & 63, g4 = lane >> 4, i16 = lane & 15;
    LAS unsigned char* Kimg = lds; LAS unsigned char* Vimg = lds + 73728; LAS float* tab = (LAS float*)(lds + 147456);
    __syncthreads();
    for (int i = tid; i < 4 * 465; i += kNT) tab[i] = rpb[i];
    float Mq;
    { float a = fabsf(gq[lane]), b = fabsf(gk[lane]);
#pragma unroll
      for (int m = 32; m >= 1; m >>= 1) { a = fmaxf(a, __shfl_xor(a, m)); b = fmaxf(b, __shfl_xor(b, m)); }
      Mq = 8.f * a * b; }
    __syncthreads();
    if (wid < 4) { float m = 0.f; for (int i = lane; i < 465; i += 64) m = fmaxf(m, fabsf(tab[wid * 465 + i]));
#pragma unroll
        for (int k = 32; k >= 1; k >>= 1) m = fmaxf(m, __shfl_xor(m, k));
        if (lane == 0) tab[1860 + wid] = m; }
    __syncthreads();
    const int g = wid & 3, kcs = (16 * g - 8) < 0 ? 0 : ((16 * g - 8) > 32 ? 32 : (16 * g - 8));
    const int qcol = 16 * g + i16, cs = (qcol - 8) < 0 ? 0 : ((qcol - 8) > 48 ? 48 : (qcol - 8));
    unsigned kswz[2];
#pragma unroll
    for (int s = 0; s < 2; ++s) kswz[s] = (unsigned)(((4 * s + g4) ^ (i16 & 7)) << 4);
    const int q = i16 >> 2, p = i16 & 3, sw = 2 * (g4 & 1) + (q >> 1);
    unsigned vsw[4];
#pragma unroll
    for (int dt = 0; dt < 4; ++dt) vsw[dt] = (unsigned)((((2 * dt + (p >> 1)) ^ (sw << 1)) << 4) + 8 * (p & 1));
    u32x4 pK[9], pV[9];
#define NA_PREFETCH(unit_) do { const int bh_ = (unit_) >> 6, r0_ = 2 * ((unit_) & 63); const int rsA_ = (r0_ - 4) < 0 ? 0 : ((r0_ - 4) > 120 ? 120 : (r0_ - 4)); \
        const bf16_t* kbase = kb + (size_t)bh_ * kS * 64; const bf16_t* vbase = vb + (size_t)bh_ * kS * 64; \
        _Pragma("unroll") for (int it = 0; it < 9; ++it) { const int id = it * kNT + tid, row = id >> 3, ch = id & 7; int gr = rsA_ + (row >> 6); gr = gr > 127 ? 127 : gr; \
            const size_t tok = (size_t)(gr * 64 + (row & 63)); pK[it] = *(const u32x4*)(kbase + tok * 64 + ch * 8); pV[it] = *(const u32x4*)(vbase + tok * 64 + ch * 8); } } while (0)
    if (bid < 2048) NA_PREFETCH(bid);
    for (int unit = bid; unit < 2048; unit += nblk) {
        const int bh = unit >> 6, rp = unit & 63, r0 = 2 * rp, h = bh & 3;
        const int rsA = (r0 - 4) < 0 ? 0 : ((r0 - 4) > 120 ? 120 : (r0 - 4));
        const int rr = r0 + (wid >> 2);
        const int rs = (rr - 4) < 0 ? 0 : ((rr - 4) > 120 ? 120 : (rr - 4)), ro = rs - rsA;
        const int qtok = rr * 64 + qcol;
        bf16x8 Qf[2];
#pragma unroll
        for (int s = 0; s < 2; ++s) Qf[s] = *(const bf16x8*)(qb + ((size_t)bh * kS + qtok) * 64 + 32 * s + 8 * g4);
        __syncthreads();
#pragma unroll
        for (int it = 0; it < 9; ++it) { const int id = it * kNT + tid, row = id >> 3, ch = id & 7;
            *(LAS u32x4*)(Kimg + row * 128 + ((ch ^ (row & 7)) << 4)) = pK[it];
            *(LAS u32x4*)(Vimg + row * 128 + ((ch ^ (((row >> 1) & 3) << 1)) << 4)) = pV[it]; }
        __syncthreads();
        if (unit + nblk < 2048) NA_PREFETCH(unit + nblk);
        const LAS float* th = tab + h * 465;
        const float Mb = (Mq + tab[1860 + h]) * kLog2e, c1 = 0.125f * kLog2e;
        int g4v = g4; asm volatile("" : "+v"(g4v));
        const int ecol = kcs + 4 * g4v - cs, dcb = kcs + 4 * g4v - qcol + 15;
        const unsigned kb0 = (unsigned)((ro * 64 + kcs + i16) * 128), vb0 = (unsigned)((ro * 64 + kcs + 4 * g4 + q) * 128);
        float sum = 0.f;
        f32x4 O[4];
#pragma unroll
        for (int dt = 0; dt < 4; ++dt) O[dt] = (f32x4){0.f, 0.f, 0.f, 0.f};
#pragma unroll
        for (int u = 0; u < 8; ++u) {
            f32x4 S[2];
#pragma unroll
            for (int tt = 0; tt < 2; ++tt) { S[tt] = (f32x4){0.f, 0.f, 0.f, 0.f};
#pragma unroll
                for (int s = 0; s < 2; ++s) { const bf16x8 Kf = *(const LAS bf16x8*)(Kimg + kb0 + u * 8192 + tt * 2048 + kswz[s]); S[tt] = __builtin_amdgcn_mfma_f32_16x16x32_bf16(Kf, Qf[s], S[tt], 0, 0, 0); } }
            const LAS float* tr = th + (rs + u - rr + 7) * 31;
#pragma unroll
            for (int tt = 0; tt < 2; ++tt)
#pragma unroll
                for (int j = 0; j < 4; ++j) {
                    const int e = ecol + 16 * tt + j; int dc = dcb + 16 * tt + j; dc = dc < 0 ? 0 : (dc > 30 ? 30 : dc);
                    const float bias = tr[dc];
                    const float sv = ((unsigned)e < 16u) ? S[tt][j] * c1 + (bias * kLog2e - Mb) : -1e30f;
                    const float pv = __builtin_amdgcn_exp2f(sv); S[tt][j] = pv; sum += pv;
                }
            u32x4 pw; pw.x = pk2(S[0][0], S[0][1]); pw.y = pk2(S[0][2], S[0][3]); pw.z = pk2(S[1][0], S[1][1]); pw.w = pk2(S[1][2], S[1][3]);
            const bf16x8 Pf = __builtin_bit_cast(bf16x8, pw);
#pragma unroll
            for (int dt = 0; dt < 4; ++dt) { LAS unsigned char* vp = Vimg + vb0 + u * 8192 + vsw[dt];
                const bf16x8 Vf = tr_pair(vp, vp + 2048);
                O[dt] = __builtin_amdgcn_mfma_f32_16x16x32_bf16(Vf, Pf, O[dt], 0, 0, 0); }
        }
        sum = xsum32(xsum16(sum));
        const float inv = 1.f / sum;
        bf16_t* orow = ob + ((size_t)(bh >> 2) * kS + qtok) * 256 + h * 64;
#pragma unroll
        for (int dt = 0; dt < 4; ++dt) { u32x2 w; w.x = pk2(O[dt][0] * inv, O[dt][1] * inv); w.y = pk2(O[dt][2] * inv, O[dt][3] * inv); *(u32x2*)(orow + 16 * dt + 4 * g4) = w; }
    }
#undef NA_PREFETCH
    __syncthreads();
}
DEVI void phase_s5_naive(const Params& P, int l, const bf16_t* ux, float* ys, unsigned char* lds, int bid, int nblk) {
    const int wid = tidx() >> 6, lane = tidx() & 63;
    float* xs = (float*)lds + wid * 128;
    for (int item = wid * nblk + bid; item < kB * 16 * 2; item += nblk * 8) {
        const int dir = item & 1, g = (item >> 1) & 15, b = item >> 5;
        const size_t pbase = (((size_t)l * 2 + dir) * 16 + g) * 64;
        const float dt = __expf(P.s5_log_dt[((size_t)l * 2 + dir) * 16 + g]);
        const float a = fminf(P.s5_a_re[pbase + lane], -1e-4f), w = P.s5_a_im[pbase + lane];
        const float mag = __expf(a * dt), ar = mag * cosf(w * dt), ai = mag * sinf(w * dt);
        const float den = a * a + w * w, zr = ar - 1.f, gr = (zr * a + ai * w) / den, gi = (ai * a - zr * w) / den;
        float bbr[16], bbi[16];
#pragma unroll
        for (int c = 0; c < 16; ++c) { const float br = P.s5_b_re[(pbase + lane) * 16 + c], bi = P.s5_b_im[(pbase + lane) * 16 + c]; bbr[c] = gr * br - gi * bi; bbi[c] = gr * bi + gi * br; }
        const int cch = lane & 15, qt = lane >> 4;
        float cre[16], cim[16];
#pragma unroll
        for (int pp = 0; pp < 16; ++pp) { cre[pp] = P.s5_c_re[(pbase / 64 * 16 + cch) * 64 + qt * 16 + pp]; cim[pp] = P.s5_c_im[(pbase / 64 * 16 + cch) * 64 + qt * 16 + pp]; }
        float xr = 0.f, xi = 0.f;
        const bf16_t* ug = ux + (size_t)g * 4096 * 512;
        for (int st = 0; st < kS; ++st) {
            const int s = dir ? (kS - 1 - st) : st; const size_t tok = (size_t)b * kS + s;
            const bf16_t* up = ug + (tok >> 4) * 512 + (tok & 15) * 16;
            const u32x4 u0 = *(const u32x4*)up, u1 = *(const u32x4*)(up + 8);
            float uv[16];
            uv[0] = __uint_as_float(u0.x << 16); uv[1] = __uint_as_float(u0.x & 0xFFFF0000u); uv[2] = __uint_as_float(u0.y << 16); uv[3] = __uint_as_float(u0.y & 0xFFFF0000u);
            uv[4] = __uint_as_float(u0.z << 16); uv[5] = __uint_as_float(u0.z & 0xFFFF0000u); uv[6] = __uint_as_float(u0.w << 16); uv[7] = __uint_as_float(u0.w & 0xFFFF0000u);
            uv[8] = __uint_as_float(u1.x << 16); uv[9] = __uint_as_float(u1.x & 0xFFFF0000u); uv[10] = __uint_as_float(u1.y << 16); uv[11] = __uint_as_float(u1.y & 0xFFFF0000u);
            uv[12] = __uint_as_float(u1.z << 16); uv[13] = __uint_as_float(u1.z & 0xFFFF0000u); uv[14] = __uint_as_float(u1.w << 16); uv[15] = __uint_as_float(u1.w & 0xFFFF0000u);
            float bur = 0.f, bui = 0.f;
#pragma unroll
            for (int c = 0; c < 16; ++c) { bur += bbr[c] * uv[c]; bui += bbi[c] * uv[c]; }
            const float nr = ar * xr - ai * xi + bur, ni = ar * xi + ai * xr + bui; xr = nr; xi = ni;
            xs[lane] = xr; xs[64 + lane] = xi;
            asm volatile("s_waitcnt lgkmcnt(0)" ::: "memory");
            float y = 0.f;
#pragma unroll
            for (int pp = 0; pp < 16; ++pp) y += cre[pp] * xs[qt * 16 + pp] - cim[pp] * xs[64 + qt * 16 + pp];
            asm volatile("s_waitcnt lgkmcnt(0)" ::: "memory");
            y += __shfl_xor(y, 16); y += __shfl_xor(y, 32);
            if (lane < 16) ys[((size_t)dir * kTok + tok) * 256 + g * 16 + cch] = y;
        }
    }
}
DEVI void phase_s5_finish(const float* ys, const bf16_t* ux, const float* dskip, bf16_t* G, int bid, int nblk) {
    for (size_t i = (size_t)bid * kNT + tidx(); i < (size_t)kTok * 256; i += (size_t)nblk * kNT) {
        const size_t tok = i >> 8; const int ch = (int)(i & 255), g = ch >> 4, c = ch & 15;
        const float u = bf2f(ux[((size_t)g * 4096 + (tok >> 4)) * 512 + (tok & 15) * 16 + c]);
        const float y = ys[i] + ys[(size_t)kTok * 256 + i] + dskip[ch] * u;
        G[i] = f2bf(gelu_tanh(y));
    }
}
DEVI void unpk8(float* d, const u32x4 q, const float sc) {
    d[0] += sc * __uint_as_float(q.x << 16); d[1] += sc * __uint_as_float(q.x & 0xFFFF0000u); d[2] += sc * __uint_as_float(q.y << 16); d[3] += sc * __uint_as_float(q.y & 0xFFFF0000u);
    d[4] += sc * __uint_as_float(q.z << 16); d[5] += sc * __uint_as_float(q.z & 0xFFFF0000u); d[6] += sc * __uint_as_float(q.w << 16); d[7] += sc * __uint_as_float(q.w & 0xFFFF0000u);
}
DEVI void phase_mixnorm(const bf16_t* oac, const float* lse, const bf16_t* ob, const bf16_t* oc, const float* ga, const float* gb, const float* gc, bf16_t* mix, int bid, int nblk) {
    const int wid = tidx() >> 6, lane = tidx() & 63;
    float gn[16];
    { const float* gp = (lane < 32) ? ga + lane * 16 : (lane < 48) ? gb + (lane - 32) * 16 : gc + (lane - 48) * 16;
#pragma unroll
      for (int i = 0; i < 16; ++i) gn[i] = gp[i]; }
    for (int row = bid * 8 + wid; row < kTok; row += nblk * 8) {
        float v[16];
#pragma unroll
        for (int i = 0; i < 16; ++i) v[i] = 0.f;
        if (lane < 32) {
            const int h = lane >> 2;
            const float l0 = lse[(size_t)row * 8 + h], l1 = lse[((size_t)kTok + row) * 8 + h], l2 = lse[((size_t)2 * kTok + row) * 8 + h];
            const bf16_t* p0 = oac + (size_t)row * 512 + lane * 16; const bf16_t* p1 = p0 + (size_t)kTok * 512; const bf16_t* p2 = p1 + (size_t)kTok * 512;
            const u32x4 a0 = *(const u32x4*)p0, a1 = *(const u32x4*)(p0 + 8), b0 = *(const u32x4*)p1, b1 = *(const u32x4*)(p1 + 8), c0 = *(const u32x4*)p2, c1 = *(const u32x4*)(p2 + 8);
            const float mx = fmaxf(l0, fmaxf(l1, l2)); float w0 = __expf(l0 - mx), w1 = __expf(l1 - mx), w2 = __expf(l2 - mx); const float inv = frcp(w0 + w1 + w2); w0 *= inv; w1 *= inv; w2 *= inv;
            unpk8(v, a0, w0); unpk8(v + 8, a1, w0); unpk8(v, b0, w1); unpk8(v + 8, b1, w1); unpk8(v, c0, w2); unpk8(v + 8, c1, w2);
        } else {
            const bf16_t* p = (lane < 48) ? ob + (size_t)row * 256 + (lane - 32) * 16 : oc + (size_t)row * 256 + (lane - 48) * 16;
            const u32x4 a0 = *(const u32x4*)p, a1 = *(const u32x4*)(p + 8);
            unpk8(v, a0, 1.f); unpk8(v + 8, a1, 1.f);
        }
        float ss = 0.f;
#pragma unroll
        for (int i = 0; i < 16; ++i) ss += v[i] * v[i];
        ss = row_sum16(ss);
        { float a = ss, b = ss; swap16(a, b); if (lane < 32) ss = a + b; }
        const float rstd = rsqrtf(ss * ((lane < 32) ? (1.f / 512.f) : (1.f / 256.f)) + kEps);
        if (EMU_FP8_WOUT) {
#pragma unroll
            for (int i = 0; i < 16; ++i) v[i] = q8(v[i] * rstd * gn[i], 1.f, 1.f) / (rstd * gn[i]);
        }
        u32x4 w0, w1;
        w0.x = pk2(v[0] * rstd * gn[0], v[1] * rstd * gn[1]); w0.y = pk2(v[2] * rstd * gn[2], v[3] * rstd * gn[3]); w0.z = pk2(v[4] * rstd * gn[4], v[5] * rstd * gn[5]); w0.w = pk2(v[6] * rstd * gn[6], v[7] * rstd * gn[7]);
        w1.x = pk2(v[8] * rstd * gn[8], v[9] * rstd * gn[9]); w1.y = pk2(v[10] * rstd * gn[10], v[11] * rstd * gn[11]); w1.z = pk2(v[12] * rstd * gn[12], v[13] * rstd * gn[13]); w1.w = pk2(v[14] * rstd * gn[14], v[15] * rstd * gn[15]);
        *(u32x4*)(mix + (size_t)row * kD + lane * 16) = w0; *(u32x4*)(mix + (size_t)row * kD + lane * 16 + 8) = w1;
    }
}
DEVI void phase_combine(bf16_t* xb, bf16_t* xbo, float* out32, const bf16_t* y, const float* gate, const int* tokslot, const float* gain_next, bf16_t* h, int bid, int nblk) {
    const int wid = tidx() >> 6, lane = tidx() & 63;
    float g[16];
#pragma unroll
    for (int i = 0; i < 16; ++i) g[i] = gain_next ? gain_next[lane * 16 + i] : 0.f;
    const int stride = nblk * 8;
    int row = bid * 8 + wid;
    u32x4 nv0, nv1; int nts = 0;
    if (row < kTok) { nts = tokslot[(size_t)row * kE + (lane & 15)]; nv0 = *(const u32x4*)(xb + (size_t)row * kD + lane * 16); nv1 = *(const u32x4*)(xb + (size_t)row * kD + lane * 16 + 8); }
    for (; row < kTok; row += stride) {
        const int b = row >> 13;
        const int ts = nts;
        float v[16];
        unpk8s(v, nv0); unpk8s(v + 8, nv1);
        const int nrow = row + stride;
        if (nrow < kTok) { nts = tokslot[(size_t)nrow * kE + (lane & 15)]; nv0 = *(const u32x4*)(xb + (size_t)nrow * kD + lane * 16); nv1 = *(const u32x4*)(xb + (size_t)nrow * kD + lane * 16 + 8); }
#pragma unroll
        for (int e0 = 0; e0 < kE; e0 += 8) {
#if FP8_Y
            u32x4 yv[8]; float gt[8];
#pragma unroll
            for (int e = 0; e < 8; ++e) { const int slot = __builtin_amdgcn_readlane(ts, e0 + e);
                if (slot >= 0) { const size_t r = (size_t)((e0 + e) * kB + b) * kCap + slot; yv[e] = *(const u32x4*)((const unsigned char*)y + r * kD + lane * 16); gt[e] = gate[r]; } }
#pragma unroll
            for (int e = 0; e < 8; ++e) { const int slot = __builtin_amdgcn_readlane(ts, e0 + e);
                if (slot >= 0) { const unsigned ww[4] = {yv[e].x, yv[e].y, yv[e].z, yv[e].w}; const float gs = gt[e] * (1.f / kY8);
#pragma unroll
                    for (int k = 0; k < 4; ++k) { const f32x2 lo = __builtin_amdgcn_cvt_pk_f32_fp8(ww[k], false), hi = __builtin_amdgcn_cvt_pk_f32_fp8(ww[k], true);
                        v[4 * k] += lo.x * gs; v[4 * k + 1] += lo.y * gs; v[4 * k + 2] += hi.x * gs; v[4 * k + 3] += hi.y * gs; } } }
#else
            u32x4 yv[8][2];
#pragma unroll
            for (int e = 0; e < 8; ++e) { const int slot = __builtin_amdgcn_readlane(ts, e0 + e);
                if (slot >= 0) { const bf16_t* yr = y + ((size_t)((e0 + e) * kB + b) * kCap + slot) * kD + lane * 16; yv[e][0] = *(const u32x4*)yr; yv[e][1] = *(const u32x4*)(yr + 8); } }
#pragma unroll
            for (int e = 0; e < 8; ++e) { const int slot = __builtin_amdgcn_readlane(ts, e0 + e);
                if (slot >= 0) { const float gs = gate[(size_t)((e0 + e) * kB + b) * kCap + slot]; unpk8(v, yv[e][0], gs); unpk8(v + 8, yv[e][1], gs); } }
#endif
        }
        if (!gain_next) {
#pragma unroll
            for (int k = 0; k < 4; ++k) *(f32x4*)(out32 + (size_t)row * kD + lane * 16 + 4 * k) = (f32x4){v[4 * k], v[4 * k + 1], v[4 * k + 2], v[4 * k + 3]};
        } else {
            u32x4 o0, o1;
            o0.x = pk2(v[0], v[1]); o0.y = pk2(v[2], v[3]); o0.z = pk2(v[4], v[5]); o0.w = pk2(v[6], v[7]); o1.x = pk2(v[8], v[9]); o1.y = pk2(v[10], v[11]); o1.z = pk2(v[12], v[13]); o1.w = pk2(v[14], v[15]);
            *(u32x4*)(xbo + (size_t)row * kD + lane * 16) = o0; *(u32x4*)(xbo + (size_t)row * kD + lane * 16 + 8) = o1;
            unpk8s(v, o0); unpk8s(v + 8, o1);
            float ss = 0.f;
#pragma unroll
            for (int i = 0; i < 16; ++i) ss += v[i] * v[i];
            ss = wave_sum(ss); const float rstd = rsqrtf(ss * (1.f / kD) + kEps);
            u32x4 h0, h1;
            h0.x = pk2(v[0] * rstd * g[0], v[1] * rstd * g[1]); h0.y = pk2(v[2] * rstd * g[2], v[3] * rstd * g[3]); h0.z = pk2(v[4] * rstd * g[4], v[5] * rstd * g[5]); h0.w = pk2(v[6] * rstd * g[6], v[7] * rstd * g[7]);
            h1.x = pk2(v[8] * rstd * g[8], v[9] * rstd * g[9]); h1.y = pk2(v[10] * rstd * g[10], v[11] * rstd * g[11]); h1.z = pk2(v[12] * rstd * g[12], v[13] * rstd * g[13]); h1.w = pk2(v[14] * rstd * g[14], v[15] * rstd * g[15]);
            *(u32x4*)(h + (size_t)row * kD + lane * 16) = h0; *(u32x4*)(h + (size_t)row * kD + lane * 16 + 8) = h1;
        }
    }
}

DEVI void cpow_m(double a, double w, double dt, int m, float& re, float& im) {
    const float mag = __expf((float)m * (float)a * (float)dt);
    const double turns = (double)m * w * dt * 0.15915494309189535; const float ang = (float)((turns - floor(turns)) * 6.283185307179586);
    re = mag * cosf(ang); im = mag * sinf(ang);
}
DEVI void s5_prep_item(const Params& P, int l, int g, unsigned char* lds_) {
    float* pw = (float*)lds_;
    float* bb = pw + 4352;
    float* cc = bb + 4096;
    float* kt = cc + 4096;
    const int tid = tidx();
    __syncthreads();
    for (int i = tid; i < 128; i += kNT) { const int dir = i >> 6, p = i & 63; const size_t pb = (((size_t)l * 2 + dir) * 16 + g) * 64 + p;
        const double dt = (double)__expf(P.s5_log_dt[((size_t)l * 2 + dir) * 16 + g]); const double a = (double)fminf(P.s5_a_re[pb], -1e-4f), w = (double)P.s5_a_im[pb];
        for (int m = 0; m < 17; ++m) { float re, im; cpow_m(a, w, dt, m, re, im); pw[((dir * 64 + p) * 17 + m) * 2] = re; pw[((dir * 64 + p) * 17 + m) * 2 + 1] = im; }
        const float af = (float)a, wf = (float)w, ar = pw[((dir * 64 + p) * 17 + 1) * 2], ai = pw[((dir * 64 + p) * 17 + 1) * 2 + 1];
        const float den = af * af + wf * wf, zr = ar - 1.f, gr = (zr * af + ai * wf) / den, gi = (ai * af - zr * wf) / den;
        for (int c = 0; c < 16; ++c) { const float br = P.s5_b_re[pb * 16 + c], bi = P.s5_b_im[pb * 16 + c]; bb[((dir * 64 + p) * 16 + c) * 2] = gr * br - gi * bi; bb[((dir * 64 + p) * 16 + c) * 2 + 1] = gr * bi + gi * br; }
    }
    for (int i = tid; i < 2048; i += kNT) { const int dir = i >> 10, c = (i >> 6) & 15, p = i & 63; const size_t o = ((((size_t)l * 2 + dir) * 16 + g) * 16 + c) * 64 + p; cc[i * 2] = P.s5_c_re[o]; cc[i * 2 + 1] = P.s5_c_im[o]; }
    __syncthreads();
    for (int i = tid; i < 8192; i += kNT) { const int dir = i >> 12, m = (i >> 8) & 15, c = (i >> 4) & 15, c2 = i & 15; float acc = 0.f;
        for (int p = 0; p < 64; ++p) { const float cr = cc[((dir * 16 + c) * 64 + p) * 2], ci = cc[((dir * 16 + c) * 64 + p) * 2 + 1], wr_ = pw[((dir * 64 + p) * 17 + m) * 2], wi_ = pw[((dir * 64 + p) * 17 + m) * 2 + 1];
            const float br = bb[((dir * 64 + p) * 16 + c2) * 2], bi = bb[((dir * 64 + p) * 16 + c2) * 2 + 1]; const float tr = cr * wr_ - ci * wi_, ti = cr * wi_ + ci * wr_; acc += tr * br - ti * bi; }
        kt[i] = acc; }
    __syncthreads();
    bf16_t* wst = (bf16_t*)(wsp(P) + WS_WST) + ((size_t)l * 16 + g) * 256 * 256;
    bf16_t* wso = (bf16_t*)(wsp(P) + WS_WSO) + ((size_t)l * 16 + g) * 256 * 512;
    for (int id = tid; id < 8192; id += kNT) { const int n = id >> 5, k0 = (id & 31) * 8, dir = n >> 7, p = (n >> 1) & 63, ri = n & 1; float v[8];
#pragma unroll
        for (int kk = 0; kk < 8; ++kk) { const int k = k0 + kk, t = k >> 4, c = k & 15, e = dir ? t : 15 - t; const float wr_ = pw[((dir * 64 + p) * 17 + e) * 2], wi_ = pw[((dir * 64 + p) * 17 + e) * 2 + 1], br = bb[((dir * 64 + p) * 16 + c) * 2], bi = bb[((dir * 64 + p) * 16 + c) * 2 + 1];
            v[kk] = ri ? (wr_ * bi + wi_ * br) : (wr_ * br - wi_ * bi); }
        u32x4 o; o.x = pk2(v[0], v[1]); o.y = pk2(v[2], v[3]); o.z = pk2(v[4], v[5]); o.w = pk2(v[6], v[7]); *(u32x4*)(wst + (size_t)n * 256 + k0) = o; }
    for (int id = tid; id < 16384; id += kNT) { const int ns = id >> 6, k0 = (id & 63) * 8, n = cmap_pk(ns), t = n >> 4, c = n & 15; float v[8];
#pragma unroll
        for (int kk = 0; kk < 8; ++kk) { const int k = k0 + kk; float x;
            if (k < 256) { const int j = k >> 4, c2 = k & 15; x = 0.f; if (j <= t) x += kt[(t - j) * 256 + c * 16 + c2]; if (j >= t) x += kt[4096 + (j - t) * 256 + c * 16 + c2]; if (j == t && c == c2) x += P.s5_d[l * 256 + g * 16 + c]; }
            else { const int q = k - 256, dir = q >> 7, p = (q >> 1) & 63, ri = q & 1, e = dir ? 16 - t : t + 1; const float cr = cc[((dir * 16 + c) * 64 + p) * 2], ci = cc[((dir * 16 + c) * 64 + p) * 2 + 1], wr_ = pw[((dir * 64 + p) * 17 + e) * 2], wi_ = pw[((dir * 64 + p) * 17 + e) * 2 + 1];
                x = ri ? -(cr * wi_ + ci * wr_) : (cr * wr_ - ci * wi_); }
            v[kk] = x; }
        u32x4 o; o.x = pk2(v[0], v[1]); o.y = pk2(v[2], v[3]); o.z = pk2(v[4], v[5]); o.w = pk2(v[6], v[7]); *(u32x4*)(wso + (size_t)ns * 512 + k0) = o; }
    __syncthreads();
}
DEVI void phase_s5_scan(const Params& P, int l, const float* Z, bf16_t* ux, unsigned char* lds_, int bid, int nblk) {
    const int tid = tidx(), wid = tid >> 6, lane = tid & 63;
    float* E = (float*)lds_;
    for (int item = bid; item < 256; item += nblk) {
        const int dir = item & 1, g = (item >> 1) & 15, b = item >> 5;
        const size_t pb = (((size_t)l * 2 + dir) * 16 + g) * 64 + lane;
        const double dt = (double)__expf(P.s5_log_dt[((size_t)l * 2 + dir) * 16 + g]); const double a = (double)fminf(P.s5_a_re[pb], -1e-4f), w = (double)P.s5_a_im[pb];
        float a16r, a16i, Ar, Ai; cpow_m(a, w, dt, 16, a16r, a16i); cpow_m(a, w, dt, 1024, Ar, Ai);
        const int kk0 = dir ? 511 - 64 * wid : 64 * wid; const long sstep = dir ? -1 : 1;
        const float* zp = Z + ((size_t)g * 4096 + b * 512 + kk0) * 256 + dir * 128 + 2 * lane;
        f32x2 z[64];
#pragma unroll
        for (int i = 0; i < 64; ++i) { z[i] = *(const f32x2*)zp; zp += sstep * 256; }
        float xr = 0.f, xi = 0.f;
#pragma unroll
        for (int i = 0; i < 64; ++i) { const float nr = a16r * xr - a16i * xi + z[i].x, ni = a16r * xi + a16i * xr + z[i].y; xr = nr; xi = ni; }
        __syncthreads();
        E[(wid * 64 + lane) * 2] = xr; E[(wid * 64 + lane) * 2 + 1] = xi;
        __syncthreads();
        float sr = 0.f, si = 0.f;
#pragma unroll
        for (int s2 = 0; s2 < 7; ++s2) if (s2 < wid) { const float er = E[(s2 * 64 + lane) * 2], ei = E[(s2 * 64 + lane) * 2 + 1]; const float nr = Ar * sr - Ai * si + er, ni = Ar * si + Ai * sr + ei; sr = nr; si = ni; }
        bf16_t* up = ux + ((size_t)g * 4096 + b * 512 + kk0) * 512 + 256 + dir * 128 + 2 * lane;
#pragma unroll
        for (int i = 0; i < 64; ++i) { *(unsigned*)up = pk2(sr, si); up += sstep * 512;
            const float nr = a16r * sr - a16i * si + z[i].x, ni = a16r * si + a16i * sr + z[i].y; sr = nr; si = ni; }
    }
    __syncthreads();
}
struct EpiF32N {
    static constexpr int VMOPS = 32;
    float* z; int ldz;
    DEVI void operator()(const f32x4 (&acc)[2][2][4][2], const Unit& u, int wr, int wc, int fr, int fq) const {
#pragma unroll
        for (int ai = 0; ai < 2; ++ai)
#pragma unroll
            for (int m = 0; m < 4; ++m) { const size_t ro = (size_t)(u.pm * 256 + 128 * ai + 64 * wr + 16 * m + fr) * ldz + u.pn * 256 + 32 * wc + 4 * fq;
#pragma unroll
                for (int bj = 0; bj < 2; ++bj)
#pragma unroll
                    for (int n = 0; n < 2; ++n) *(f32x4*)(z + ro + 128 * bj + 16 * n) = acc[ai][bj][m][n]; }
    }
};
struct EpiS5Out {
    static constexpr int VMOPS = 16;
    bf16_t* G;
    DEVI void operator()(const f32x4 (&acc)[2][2][4][2], const Unit& u, int wr, int wc, int fr, int fq) const {
#pragma unroll
        for (int ai = 0; ai < 2; ++ai)
#pragma unroll
            for (int m = 0; m < 4; ++m) { const int R = u.pm * 256 + 128 * ai + 64 * wr + 16 * m + fr, g = R >> 12, ck = R & 4095;
#pragma unroll
                for (int bj = 0; bj < 2; ++bj) { const int t = 8 * bj + 2 * wc + (fq >> 1), c0 = 8 * (fq & 1);
                    const f32x4 v0 = acc[ai][bj][m][0], v1 = acc[ai][bj][m][1];
                    u32x4 w; w.x = pk2(gelu_tanh(v0.x), gelu_tanh(v0.y)); w.y = pk2(gelu_tanh(v0.z), gelu_tanh(v0.w)); w.z = pk2(gelu_tanh(v1.x), gelu_tanh(v1.y)); w.w = pk2(gelu_tanh(v1.z), gelu_tanh(v1.w));
                    *(u32x4*)(G + ((size_t)ck * 16 + t) * 256 + g * 16 + c0) = w; } }
    }
};
#define XB_TMO      128
#define XB_XCNT(j)  (256  + 64 * (j))
#define XB_XSUB(j)  (1280 + 64 * (j))
#define XB_XGEN(j)  (2304 + 64 * (j))
#define XB_TOP      3328
#define XB_TOPGEN   3392
#define XCD_BAR_WORDS 3456
#define XB_SPIN_CAP (1u << 26)
DEVI unsigned xb_ld(unsigned* p)              { return __hip_atomic_load(p, __ATOMIC_RELAXED, __HIP_MEMORY_SCOPE_AGENT); }
DEVI unsigned xb_add(unsigned* p, unsigned v) { return __hip_atomic_fetch_add(p, v, __ATOMIC_RELAXED, __HIP_MEMORY_SCOPE_AGENT); }
DEVI unsigned xb_xcc_id() { return (unsigned)__builtin_amdgcn_s_getreg((3 << 11) | 20) & 0xFu; }
#define XB_SPIN(cond, bar) do { unsigned _sp = 0; while (cond) { __builtin_amdgcn_s_sleep(1); \
    if ((++_sp & 255u) == 0u) { if (xb_ld(&(bar)[XB_TMO])) break; if (_sp > XB_SPIN_CAP) { atomicAdd(&(bar)[XB_TMO], 1u); break; } } } } while (0)
struct XcdBarrier { unsigned* bar; unsigned x; volatile LAS unsigned* st; };
DEVI XcdBarrier xcd_barrier_post(unsigned* bar, volatile LAS unsigned* st) {
    XcdBarrier b; b.bar = bar; b.x = xb_xcc_id(); b.st = st;
    if (threadIdx.x == 0) (void)xb_add(&bar[XB_XCNT(b.x)], 1u);
    return b;
}
DEVI void xcd_barrier_complete(unsigned* bar, unsigned x, unsigned& nloc, unsigned& nx) {
    const unsigned G = gridDim.x * gridDim.y * gridDim.z;
    unsigned sum, cnt, mine, sp = 0u;
    for (;;) {
        sum = 0u; cnt = 0u; mine = 0u;
#pragma unroll
        for (unsigned j = 0; j < 16; ++j) { const unsigned c = xb_ld(&bar[XB_XCNT(j)]); sum += c; cnt += (c > 0u) ? 1u : 0u; mine = (j == x) ? c : mine; }
        if (sum == G) break;
        __builtin_amdgcn_s_sleep(1);
        if ((++sp & 255u) == 0u) { if (xb_ld(&bar[XB_TMO])) break; if (sp > XB_SPIN_CAP) { atomicAdd(&bar[XB_TMO], 1u); break; } }
    }
    nloc = mine > 0u ? mine : 1u; nx = cnt > 0u ? cnt : 1u;
}
DEVI void xcd_barrier(const XcdBarrier& b) {
    asm volatile("s_waitcnt vmcnt(0)" ::: "memory");
    __syncthreads();
    if (threadIdx.x == 0) {
        unsigned long long bp_ = (unsigned long long)b.bar; asm volatile("" : "+s"(bp_));
        unsigned* bar = (unsigned*)bp_;
        const unsigned bx = xb_xcc_id();
        __builtin_amdgcn_s_waitcnt(0);
        unsigned nloc = b.st[0], nx = b.st[1];
        if (nloc == 0u) { xcd_barrier_complete(bar, bx, nloc, nx); b.st[0] = nloc; b.st[1] = nx; }
        const unsigned old = xb_add(&bar[XB_XSUB(bx)], 1u);
        const unsigned gen = old / nloc;
        if (old + 1u == (gen + 1u) * nloc) {
            __builtin_amdgcn_fence(__ATOMIC_RELEASE, "agent");
            asm volatile("s_waitcnt vmcnt(0)" ::: "memory");
            const unsigned og = xb_add(&bar[XB_TOP], 1u);
            const unsigned tg = og / nx;
            if (og + 1u == (tg + 1u) * nx) xb_add(&bar[XB_TOPGEN], 1u);
            else XB_SPIN(xb_ld(&bar[XB_TOPGEN]) == tg, bar);
            __builtin_amdgcn_fence(__ATOMIC_ACQUIRE, "agent");
            xb_add(&bar[XB_XGEN(bx)], 1u);
            asm volatile("s_waitcnt vmcnt(0)" ::: "memory");
        } else {
            XB_SPIN(xb_ld(&bar[XB_XGEN(bx)]) == gen, bar);
            __builtin_amdgcn_fence(__ATOMIC_ACQUIRE, "agent");
            asm volatile("s_waitcnt vmcnt(0)" ::: "memory");
        }
    }
    __syncthreads();
}

#ifndef MEGA
#define MEGA 1
#endif
#ifndef STAGGER_WIN
#define STAGGER_WIN 0
#endif
#ifndef USE_ENGINE
#define USE_ENGINE 1
#endif
constexpr int LDS_BYTES = 147456 + 8192 + 16;
#if USE_ENGINE
#define GEMM_RUN(g, E) gemm_engine<decltype(E), true, true>((LAS unsigned char*)dyn_lds, g, E, bid, nblk)
#define GEMM_RUN8(g, E) gemm_engine<decltype(E), true, true, true>((LAS unsigned char*)dyn_lds, g, E, bid, nblk)
#else
#define GEMM_RUN(g, E) gemm_simple(g, E, bid, nblk)
#endif
extern __shared__ __attribute__((aligned(16))) unsigned char dyn_lds[];

DEVI GemmD mk_gemm(const bf16_t* A, const bf16_t* Bt, int lda, int K, int nM, int nN, const int* rowidx, size_t bstride, int pmg) {
    GemmD g; g.A = A; g.Bt = Bt; g.lda = lda; g.K = K; g.nM = nM; g.nN = nN; g.rowidx = rowidx; g.bstride = bstride; g.pmg = pmg; g.stagger_10ns = 0; return g; }

template <int PROBE = 0> DEVI void ph_win(const Params& P, int l, int bid, int nblk) {
    const GemmD g = mk_gemm((const bf16_t*)(wsp(P) + WS_H), (const bf16_t*)(wsp(P) + WS_WINT) + (size_t)l * kINW * kD, kD, kD, kTok / 256, 10, nullptr, 0, 1 << 30);
    unsigned char* r1 = wsp(P) + WS_R1;
    EpiQKV<PROBE> E; E.qa = (bf16_t*)(r1 + R1_QA); E.ka = (bf16_t*)(r1 + R1_KA); E.va = (bf16_t*)(r1 + R1_VA); E.qb = (bf16_t*)(r1 + R1_QB); E.kb = (bf16_t*)(r1 + R1_KB); E.vb = (bf16_t*)(r1 + R1_VB); E.ux = (bf16_t*)(r1 + R1_UX);
    { LAS float* tab = (LAS float*)((LAS unsigned char*)dyn_lds + 131072);
      const int t = tidx();
      if (t < 320) { const int r = t >> 6, c = t & 63; tab[t] = (r == 0) ? P.q_norm_a[l * 64 + c] : (r == 1) ? P.k_norm_a[l * 64 + c] : (r == 2) ? P.q_norm_b[l * 64 + c] : (r == 3) ? P.k_norm_b[l * 64 + c] : 1.f; }
      __syncthreads();
      E.gtab = tab; E.scratch = (bf16_t*)(wsp(P) + WS_R2 + R2_Z); }
    GEMM_RUN(g, E);
}
#ifndef USE_MFMA_ATTN
#define USE_MFMA_ATTN 1
#endif
#ifndef USE_S5_GEMM
#define USE_S5_GEMM 1
#endif
#ifndef PROBE_ATTN
#define PROBE_ATTN 1
#endif
#ifndef PROBE_GU
#define PROBE_GU 1
#endif
#ifndef PROBE_WINDRY
#define PROBE_WINDRY 0
#endif
#ifndef PROBE_WIN
#define PROBE_WIN 1
#endif
#ifndef PROBE_DOWN
#define PROBE_DOWN 1
#endif
#ifndef PROBE_NA
#define PROBE_NA 1
#endif
#ifndef PROBE_MIX
#define PROBE_MIX 1
#endif
#ifndef PROBE_RT
#define PROBE_RT 1
#endif
#ifndef PROBE_TK
#define PROBE_TK 1
#endif
#ifndef PROBE_GUDRY
#define PROBE_GUDRY 0
#endif
#ifndef PROBE_DILVAR
#define PROBE_DILVAR 0
#endif
#ifndef PROBE_XBAR
#define PROBE_XBAR 0
#endif
#ifndef PROBE_CMB
#define PROBE_CMB 0
#endif
#ifndef PROBE_WOUT
#define PROBE_WOUT 0
#endif
#ifndef PROBE_S5
#define PROBE_S5 1
#endif
#ifndef PROBE_CONV
#define PROBE_CONV 1
#endif
DEVI void ph_win_dry(const Params& P, int l, int bid, int nblk) {
    const GemmD g = mk_gemm((const bf16_t*)(wsp(P) + WS_H), (const bf16_t*)(wsp(P) + WS_WINT) + (size_t)l * kINW * kD, kD, kD, kTok / 256, 10, nullptr, 0, 1 << 30);
    EpiDry E; E.sink = (float*)(wsp(P) + WS_LSE);
    GEMM_RUN(g, E);
}
DEVI void ph_dilated(const Params& P, int l, int bid, int nblk) { unsigned char* r1 = wsp(P) + WS_R1;
#if PROBE_DILVAR
    phase_dilated<PROBE_DILVAR>((const bf16_t*)(r1 + R1_QA), (const bf16_t*)(r1 + R1_KA), (const bf16_t*)(r1 + R1_VA), P.q_norm_a + l * 64, P.k_norm_a + l * 64, (bf16_t*)(wsp(P) + WS_R2), (float*)(wsp(P) + WS_LSE), (LAS unsigned char*)dyn_lds, bid, nblk);
#endif
#if USE_MFMA_ATTN
    phase_dilated((const bf16_t*)(r1 + R1_QA), (const bf16_t*)(r1 + R1_KA), (const bf16_t*)(r1 + R1_VA), P.q_norm_a + l * 64, P.k_norm_a + l * 64, (bf16_t*)(wsp(P) + WS_R2), (float*)(wsp(P) + WS_LSE), (LAS unsigned char*)dyn_lds, bid, nblk);
#else
    phase_dilated_naive((const bf16_t*)(r1 + R1_QA), (const bf16_t*)(r1 + R1_KA), (const bf16_t*)(r1 + R1_VA), (bf16_t*)(wsp(P) + WS_R2), (float*)(wsp(P) + WS_LSE), bid, nblk);
#endif
}
DEVI void ph_na(const Params& P, int l, int bid, int nblk) { unsigned char* r1 = wsp(P) + WS_R1;
#if USE_MFMA_ATTN
    phase_na((const bf16_t*)(r1 + R1_QB), (const bf16_t*)(r1 + R1_KB), (const bf16_t*)(r1 + R1_VB), P.rpb + (size_t)l * 4 * 15 * 31, P.q_norm_b + l * 64, P.k_norm_b + l * 64, (bf16_t*)(r1 + R1_OB), (LAS unsigned char*)dyn_lds, bid, nblk);
#else
    phase_na_naive((const bf16_t*)(r1 + R1_QB), (const bf16_t*)(r1 + R1_KB), (const bf16_t*)(r1 + R1_VB), P.rpb + (size_t)l * 4 * 15 * 31, (bf16_t*)(r1 + R1_OB), bid, nblk);
#endif
}
DEVI void ph_s5(const Params& P, int l, unsigned char* lds, int bid, int nblk) { phase_s5_naive(P, l, (const bf16_t*)(wsp(P) + WS_R1 + R1_UX), (float*)(wsp(P) + WS_YS), lds, bid, nblk); }
DEVI void ph_s5_prep(const Params& P, unsigned char* lds, int bid, int nblk) { for (int it = bid; it < kL * 16; it += nblk) s5_prep_item(P, it >> 4, it & 15, lds); }
DEVI void ph_s5_state(const Params& P, int l, int bid, int nblk) {
    const GemmD g = mk_gemm((const bf16_t*)(wsp(P) + WS_R1 + R1_UX), (const bf16_t*)(wsp(P) + WS_WST) + (size_t)l * 16 * 256 * 256, 512, 256, 256, 1, nullptr, (size_t)256 * 256, 16);
    EpiF32N E; E.z = (float*)(wsp(P) + WS_R2 + R2_Z); E.ldz = 256;
    GEMM_RUN(g, E);
}
DEVI void ph_s5_scan(const Params& P, int l, unsigned char* lds, int bid, int nblk) { phase_s5_scan(P, l, (const float*)(wsp(P) + WS_R2 + R2_Z), (bf16_t*)(wsp(P) + WS_R1 + R1_UX), lds, bid, nblk); }
DEVI void ph_s5_out(const Params& P, int l, int bid, int nblk) {
    const GemmD g = mk_gemm((const bf16_t*)(wsp(P) + WS_R1 + R1_UX), (const bf16_t*)(wsp(P) + WS_WSO) + (size_t)l * 16 * 256 * 512, 512, 512, 256, 1, nullptr, (size_t)256 * 512, 16);
    EpiS5Out E; E.G = (bf16_t*)(wsp(P) + WS_R1 + R1_G);
    GEMM_RUN(g, E);
}
DEVI void ph_s5fin(const Params& P, int l, int bid, int nblk) { phase_s5_finish((const float*)(wsp(P) + WS_YS), (const bf16_t*)(wsp(P) + WS_R1 + R1_UX), P.s5_d + l * 256, (bf16_t*)(wsp(P) + WS_R1 + R1_G), bid, nblk); }
DEVI void ph_glu(const Params& P, int l, int bid, int nblk) {
    const GemmD g = mk_gemm((const bf16_t*)(wsp(P) + WS_R1 + R1_G), (const bf16_t*)(wsp(P) + WS_WGLUT) + (size_t)l * 256 * 256, 256, 256, kTok / 256, 1, nullptr, 0, 1 << 30);
    EpiGlu E; E.g = (const bf16_t*)(wsp(P) + WS_R1 + R1_G); E.oc = (bf16_t*)(wsp(P) + WS_R1 + R1_OC);
    GEMM_RUN(g, E);
}
DEVI void ph_mixnorm(const Params& P, int l, int bid, int nblk) { unsigned char* r1 = wsp(P) + WS_R1;
    phase_mixnorm((const bf16_t*)(wsp(P) + WS_R2), (const float*)(wsp(P) + WS_LSE), (const bf16_t*)(r1 + R1_OB), (const bf16_t*)(r1 + R1_OC), P.out_norm_a + l * 512, P.out_norm_b + l * 256, P.out_norm_c + l * 256, (bf16_t*)(wsp(P) + WS_H), bid, nblk); }
DEVI void ph_wout(const Params& P, int l, int bid, int nblk, bool shadow = false) {
    const GemmD g = mk_gemm((const bf16_t*)(wsp(P) + WS_H), (const bf16_t*)(wsp(P) + WS_WOUTT) + (size_t)l * kD * kD, kD, kD, kTok / 256, 4, nullptr, 0, 1 << 30);
    EpiResid E; E.x32 = (l == 0) ? P.x : nullptr; E.xb = (bf16_t*)(wsp(P) + WS_XB); E.xbo = shadow ? (bf16_t*)(wsp(P) + WS_R1 + 256 * MiB) : E.xb;
    GEMM_RUN(g, E);
}
DEVI void ph_router(const Params& P, int l, unsigned char* lds, int bid, int nblk) { phase_router((const bf16_t*)(wsp(P) + WS_XB), P.ffn_norm + (size_t)l * kD, P.w_router + (size_t)l * kD * kE, (bf16_t*)(wsp(P) + WS_H), (float*)(wsp(P) + WS_AFF), lds, bid, nblk); }
DEVI void ph_topk(const Params& P, unsigned char* lds, int bid, int nblk) { phase_topk((const float*)(wsp(P) + WS_AFF), (int*)(wsp(P) + WS_IDX), (float*)(wsp(P) + WS_GATE), (int*)(wsp(P) + WS_TSLOT), wsp(P) + WS_H, wsp(P) + WS_R2, FP8_GU ? kD : kD * 2, lds, bid, nblk); }
DEVI void ph_gu(const Params& P, int l, int bid, int nblk) {
#if FP8_GU
    const GemmD g = mk_gemm((const bf16_t*)(wsp(P) + WS_R2), (const bf16_t*)(wsp(P) + WS_WGUT + (size_t)l * kE * 4096 * kD), kD, kD, 512, 16, nullptr, (size_t)4096 * kD, 32);
    EpiGU E; E.hid = (bf16_t*)(wsp(P) + WS_R1); E.sc = 1.f / kW8; E.nomath = false;
    GEMM_RUN8(g, E);
#else
    const GemmD g = mk_gemm((const bf16_t*)(wsp(P) + WS_R2), (const bf16_t*)(wsp(P) + WS_WGUT) + (size_t)l * kE * 4096 * kD, kD, kD, 512, 16, nullptr, (size_t)4096 * kD, 32);
    EpiGU E; E.hid = (bf16_t*)(wsp(P) + WS_R1); E.sc = 1.f; E.nomath = false;
    GEMM_RUN(g, E);
#endif
}
DEVI void ph_gu_dry(const Params& P, int l, int bid, int nblk) {
    const GemmD g = mk_gemm((const bf16_t*)(wsp(P) + WS_R2), (const bf16_t*)(wsp(P) + WS_WGUT + (size_t)l * kE * 4096 * kD), kD, kD, 512, 16, nullptr, (size_t)4096 * kD, 32);
#if PROBE_GUDRY == 2
    EpiGU E; E.hid = (bf16_t*)(wsp(P) + WS_R1); E.sc = 1.f / kW8; E.nomath = true;
#else
    EpiDry E; E.sink = (float*)(wsp(P) + WS_LSE);
#endif
    GEMM_RUN8(g, E);
}
DEVI void ph_down(const Params& P, int l, int bid, int nblk) {
#if FP8_DN
    const GemmD g = mk_gemm((const bf16_t*)(wsp(P) + WS_R1), (const bf16_t*)(wsp(P) + WS_WDT + (size_t)l * kE * kD * kFF), kFF, kFF, 512, 4, nullptr, (size_t)kD * kFF, 32);
    EpiDown E; E.y = (bf16_t*)(wsp(P) + WS_R2); E.gate = (const float*)(wsp(P) + WS_GATE); E.sc = 1.f / (kW8 * kH8);
    GEMM_RUN8(g, E);
#else
    const GemmD g = mk_gemm((const bf16_t*)(wsp(P) + WS_R1), (const bf16_t*)(wsp(P) + WS_WDT) + (size_t)l * kE * kD * kFF, kFF, kFF, 512, 4, nullptr, (size_t)kD * kFF, 32);
    EpiDown E; E.y = (bf16_t*)(wsp(P) + WS_R2); E.gate = (const float*)(wsp(P) + WS_GATE); E.sc = 1.f;
    GEMM_RUN(g, E);
#endif
}
DEVI void ph_combine_shadow(const Params& P, int l, int bid, int nblk) {
    phase_combine((bf16_t*)(wsp(P) + WS_XB), (bf16_t*)(wsp(P) + WS_R1), P.out, (const bf16_t*)(wsp(P) + WS_R2), (const float*)(wsp(P) + WS_GATE), (const int*)(wsp(P) + WS_TSLOT), P.attn_norm + (size_t)((l + 1) % kL) * kD, (bf16_t*)(wsp(P) + WS_R1 + 128 * MiB), bid, nblk); }
DEVI void ph_combine(const Params& P, int l, int bid, int nblk) { phase_combine((bf16_t*)(wsp(P) + WS_XB), (bf16_t*)(wsp(P) + WS_XB), P.out, (const bf16_t*)(wsp(P) + WS_R2), (const float*)(wsp(P) + WS_GATE), (const int*)(wsp(P) + WS_TSLOT), (l + 1 < kL) ? P.attn_norm + (size_t)(l + 1) * kD : nullptr, (bf16_t*)(wsp(P) + WS_H), bid, nblk); }

typedef __attribute__((address_space(4))) const Params* CParams;
DEVI CParams kargs() { unsigned long long a = (unsigned long long)__builtin_amdgcn_kernarg_segment_ptr(); asm volatile("" : "+s"(a)); return (CParams)a; }
#if MEGA
__global__ void __launch_bounds__(kNT, 2) mega_fwd(Params P_) {
#define PK P_
    volatile LAS unsigned* st = (volatile LAS unsigned*)(dyn_lds + LDS_BYTES - 16);
    if (threadIdx.x == 0) { st[0] = 0u; st[1] = 0u; st[2] = 0u; st[3] = 0u; }
    __syncthreads();
    const XcdBarrier bar = xcd_barrier_post((unsigned*)(PK.ws + WS_CTL), st);
    const int bid = blockIdx.x, nblk = gridDim.x;
    unsigned char* lds = dyn_lds;
#pragma unroll 1
    for (int rep = 0; rep < PROBE_CONV; ++rep)
    phase_convert(PK, lds, lnd(bid), nblk);
#if USE_S5_GEMM
    ph_s5_prep(PK, lds, lnd(bid), nblk);
#endif
    phase_norm(PK.x, PK.attn_norm, (bf16_t*)(PK.ws + WS_H), lnd(bid), nblk);
    xcd_barrier(bar);
#pragma unroll 1
    for (int l = 0; l < kL; ++l) {
#if PROBE_WINDRY == 1
        ph_win_dry(PK, l, lnd(bid), nblk);        xcd_barrier(bar);
#elif PROBE_WINDRY > 1
        ph_win<PROBE_WINDRY - 1>(PK, l, lnd(bid), nblk);   xcd_barrier(bar);
#endif
#pragma unroll 1
        for (int rep = 0; rep < PROBE_WIN; ++rep) {
        ph_win(PK, l, lnd(bid), nblk);            xcd_barrier(bar); }
#if USE_S5_GEMM
#pragma unroll 1
        for (int rep = 0; rep < PROBE_S5; ++rep) {
        ph_s5_state(PK, l, lnd(bid), nblk);       xcd_barrier(bar); }
#if PROBE_XBAR
        xcd_barrier(bar); xcd_barrier(bar); xcd_barrier(bar); xcd_barrier(bar);
#endif
#pragma unroll 1
        for (int rep = 0; rep < PROBE_S5; ++rep)
        ph_s5_scan(PK, l, lds, lnd(bid), nblk);
#pragma unroll 1
        for (int rep = 0; rep < PROBE_ATTN; ++rep)
        ph_dilated(PK, l, lnd(bid), nblk);
#pragma unroll 1
        for (int rep = 0; rep < PROBE_NA; ++rep)
        ph_na(PK, l, lnd(bid), nblk);             xcd_barrier(bar);
#pragma unroll 1
        for (int rep = 0; rep < PROBE_S5; ++rep) {
        ph_s5_out(PK, l, lnd(bid), nblk);         xcd_barrier(bar); }
#else
        ph_s5(PK, l, lds, lnd(bid), nblk);
        ph_dilated(PK, l, lnd(bid), nblk);
        ph_na(PK, l, lnd(bid), nblk);             xcd_barrier(bar);
        ph_s5fin(PK, l, lnd(bid), nblk);          xcd_barrier(bar);
#endif
#pragma unroll 1
        for (int rep = 0; rep < PROBE_S5; ++rep) {
        ph_glu(PK, l, lnd(bid), nblk);            xcd_barrier(bar); }
#pragma unroll 1
        for (int rep = 0; rep < PROBE_MIX; ++rep) {
        ph_mixnorm(PK, l, lnd(bid), nblk);        xcd_barrier(bar); }
#if PROBE_WOUT
        ph_wout(PK, l, lnd(bid), nblk, true);     xcd_barrier(bar);
#endif
        ph_wout(PK, l, lnd(bid), nblk);           xcd_barrier(bar);
#pragma unroll 1
        for (int rep = 0; rep < PROBE_RT; ++rep) {
        ph_router(PK, l, lds, lnd(bid), nblk);    xcd_barrier(bar); }
#pragma unroll 1
        for (int rep = 0; rep < PROBE_TK; ++rep) {
        ph_topk(PK, lds, lnd(bid), nblk);         xcd_barrier(bar); }
#if PROBE_GUDRY
        ph_gu_dry(PK, l, lnd(bid), nblk);         xcd_barrier(bar);
#endif
#pragma unroll 1
        for (int rep = 0; rep < PROBE_GU; ++rep) {
        ph_gu(PK, l, lnd(bid), nblk);             xcd_barrier(bar); }
#pragma unroll 1
        for (int rep = 0; rep < PROBE_DOWN; ++rep) {
        ph_down(PK, l, lnd(bid), nblk);           xcd_barrier(bar); }
#if PROBE_CMB
        ph_combine_shadow(PK, l, lnd(bid), nblk); xcd_barrier(bar);
#endif
        ph_combine(PK, l, lnd(bid), nblk);        xcd_barrier(bar);
    }
#undef PK
}
#else
#define KB __global__ void __launch_bounds__(kNT, 2)
KB k_convert(Params P) { phase_convert(P, dyn_lds, blockIdx.x, gridDim.x); }
KB k_norm(Params P) { phase_norm(P.x, P.attn_norm, (bf16_t*)(P.ws + WS_H), blockIdx.x, gridDim.x); }
KB k_win(Params P, int l) { ph_win(P, l, blockIdx.x, gridDim.x); }
KB k_dilated(Params P, int l) { ph_dilated(P, l, blockIdx.x, gridDim.x); }
KB k_na(Params P, int l) { ph_na(P, l, blockIdx.x, gridDim.x); }
KB k_s5(Params P, int l) { ph_s5(P, l, dyn_lds, blockIdx.x, gridDim.x); }
KB k_s5fin(Params P, int l) { ph_s5fin(P, l, blockIdx.x, gridDim.x); }
KB k_glu(Params P, int l) { ph_glu(P, l, blockIdx.x, gridDim.x); }
KB k_mixnorm(Params P, int l) { ph_mixnorm(P, l, blockIdx.x, gridDim.x); }
KB k_wout(Params P, int l) { ph_wout(P, l, blockIdx.x, gridDim.x); }
KB k_router(Params P, int l) { ph_router(P, l, dyn_lds, blockIdx.x, gridDim.x); }
KB k_topk(Params P) { ph_topk(P, dyn_lds, blockIdx.x, gridDim.x); }
KB k_gu(Params P, int l) { ph_gu(P, l, blockIdx.x, gridDim.x); }
KB k_down(Params P, int l) { ph_down(P, l, blockIdx.x, gridDim.x); }
KB k_combine(Params P, int l) { ph_combine(P, l, blockIdx.x, gridDim.x); }
#endif

extern "C" void kernel_launch(void* const* d_in, const int* in_sizes, int n_in, void* d_out, int out_size, void* d_ws, size_t ws_size, hipStream_t stream) {
    (void)in_sizes; (void)n_in; (void)out_size;
    if (ws_size < WS_END) { fprintf(stderr, "workspace too small: %zu < %zu\n", ws_size, (size_t)WS_END); return; }
    Params P{};
    const float** pp = (const float**)&P;
    for (int i = 0; i < 26; ++i) pp[i] = (const float*)d_in[i];
    P.out = (float*)d_out; P.ws = (unsigned char*)d_ws;
#if MEGA
    static int grid = 0;
    if (!grid) {
        int dev = 0, cus = 0, per_cu = 0;
        (void)hipGetDevice(&dev);
        (void)hipDeviceGetAttribute(&cus, hipDeviceAttributeMultiprocessorCount, dev);
        (void)hipFuncSetAttribute((const void*)mega_fwd, hipFuncAttributeMaxDynamicSharedMemorySize, LDS_BYTES);
        (void)hipOccupancyMaxActiveBlocksPerMultiprocessor(&per_cu, (const void*)mega_fwd, kNT, LDS_BYTES);
        grid = (per_cu >= 1) ? cus : 0;
        if (!grid) fprintf(stderr, "mega_fwd does not fit a CU\n");
    }
    if (!grid) return;
    (void)hipMemsetAsync(P.ws + WS_CTL, 0, XCD_BAR_WORDS * sizeof(unsigned), stream);
    mega_fwd<<<grid, kNT, LDS_BYTES, stream>>>(P);
#else
    (void)hipFuncSetAttribute((const void*)k_router, hipFuncAttributeMaxDynamicSharedMemorySize, 65536);
    const int G = 1024;
    k_convert<<<G, kNT, 256 * 72 * 2, stream>>>(P);
    k_norm<<<G, kNT, 0, stream>>>(P);
    for (int l = 0; l < kL; ++l) {
        k_win<<<G, kNT, 0, stream>>>(P, l);
        k_dilated<<<G, kNT, 0, stream>>>(P, l);
        k_na<<<G, kNT, 0, stream>>>(P, l);
        k_s5<<<256, kNT, 8 * 128 * 4, stream>>>(P, l);
        k_s5fin<<<G, kNT, 0, stream>>>(P, l);
        k_glu<<<256, kNT, 0, stream>>>(P, l);
        k_mixnorm<<<G, kNT, 0, stream>>>(P, l);
        k_wout<<<G, kNT, 0, stream>>>(P, l);
        k_router<<<512, kNT, 65536, stream>>>(P, l);
        k_topk<<<128, kNT, 4096, stream>>>(P);
        k_gu<<<G, kNT, 0, stream>>>(P, l);
        k_down<<<G, kNT, 0, stream>>>(P, l);
        k_combine<<<G, kNT, 0, stream>>>(P, l);
    }
#endif
}
```

```cpp
#include <hip/hip_runtime.h>
#include <stdint.h>
#include <stdio.h>

#define DEVI __device__ __forceinline__
#define LAS __attribute__((address_space(3)))
typedef unsigned short bf16_t;
typedef short bf16x8 __attribute__((ext_vector_type(8)));
typedef float f32x4 __attribute__((ext_vector_type(4)));
typedef float f32x2 __attribute__((ext_vector_type(2)));
typedef unsigned u32x4 __attribute__((ext_vector_type(4)));
typedef unsigned u32x2 __attribute__((ext_vector_type(2)));

constexpr int kB = 8, kS = 8192, kD = 1024, kL = 4, kTok = kB * kS;
constexpr int kINW = 2560;
constexpr int kE = 16, kCap = 1024, kFF = 2048;
constexpr int kNT = 512;
constexpr float kEps = 1e-6f;
constexpr float kLog2e = 1.4426950408889634f, kLn2 = 0.6931471805599453f;

constexpr size_t MiB = 1024ull * 1024ull;
constexpr size_t WS_CTL   = 0;
constexpr size_t WS_WINT  = 1 * MiB;
constexpr size_t WS_WOUTT = WS_WINT + 20 * MiB;
constexpr size_t WS_WGLUT = WS_WOUTT + 8 * MiB;
constexpr size_t WS_WGUT  = WS_WGLUT + 1 * MiB;
constexpr size_t WS_WDT   = WS_WGUT + 512 * MiB;
constexpr size_t WS_H     = WS_WDT + 256 * MiB;
constexpr size_t WS_R1    = WS_H + 128 * MiB;
constexpr size_t WS_R2    = WS_R1 + 512 * MiB;
constexpr size_t WS_AFF   = WS_R2 + 256 * MiB;
constexpr size_t WS_IDX   = WS_AFF + 4 * MiB;
constexpr size_t WS_GATE  = WS_IDX + 1 * MiB;
constexpr size_t WS_TSLOT = WS_GATE + 1 * MiB;
constexpr size_t WS_LSE   = WS_TSLOT + 4 * MiB;
constexpr size_t WS_WST   = WS_LSE + 8 * MiB;
constexpr size_t WS_WSO   = WS_WST + 8 * MiB;
constexpr size_t WS_XB    = WS_WSO + 16 * MiB;
constexpr size_t WS_END   = WS_XB + 128 * MiB;
constexpr size_t R2_Z     = 192 * MiB;
constexpr size_t R1_QA = 0, R1_KA = 64 * MiB, R1_VA = 128 * MiB, R1_QB = 192 * MiB, R1_KB = 224 * MiB, R1_VB = 256 * MiB,
                 R1_UX = 288 * MiB, R1_OB = 352 * MiB, R1_OC = 384 * MiB, R1_G = 416 * MiB;

struct Params {
    const float* x; const float* attn_norm; const float* w_in; const float* q_norm_a; const float* k_norm_a; const float* q_norm_b; const float* k_norm_b;
    const float* rpb; const float* s5_a_re; const float* s5_a_im; const float* s5_log_dt; const float* s5_b_re; const float* s5_b_im; const float* s5_c_re; const float* s5_c_im;
    const float* s5_d; const float* w_glu; const float* out_norm_a; const float* out_norm_b; const float* out_norm_c; const float* w_out; const float* ffn_norm;
    const float* w_router; const float* w_gate; const float* w_up; const float* w_down;
    float* out; unsigned char* ws;
};

DEVI float bf2f(bf16_t b) { return __uint_as_float(((unsigned)b) << 16); }
DEVI bf16_t f2bf(float f) { unsigned u = __float_as_uint(f); u += 0x7FFFu + ((u >> 16) & 1u); return (bf16_t)(u >> 16); }
typedef __bf16 bf16x2_t __attribute__((ext_vector_type(2)));
DEVI unsigned pk2(float lo, float hi) { const f32x2 v = {lo, hi}; return __builtin_bit_cast(unsigned, __builtin_convertvector(v, bf16x2_t)); }
DEVI int tidx() { int t = threadIdx.x; asm volatile("" : "+v"(t)); return t; }
#define GAS __attribute__((address_space(1)))
DEVI unsigned char* wsp(const Params& P) { unsigned long long a = (unsigned long long)P.ws; asm volatile("" : "+s"(a)); return (unsigned char*)(GAS unsigned char*)a; }
DEVI int lnd(int v) { asm volatile("" : "+s"(v)); return v; }
template <int CTRL> DEVI float dppf(float v) { return __builtin_bit_cast(float, __builtin_amdgcn_update_dpp(0, __builtin_bit_cast(int, v), CTRL, 0xF, 0xF, true)); }
DEVI void swap16(float& a, float& b) { asm volatile("s_nop 1\n\tv_permlane16_swap_b32 %0, %1" : "+v"(a), "+v"(b)); }
DEVI void swap32(float& a, float& b) { asm volatile("s_nop 1\n\tv_permlane32_swap_b32 %0, %1" : "+v"(a), "+v"(b)); }
DEVI void swap16u(unsigned& a, unsigned& b) { asm volatile("s_nop 1\n\tv_permlane16_swap_b32 %0, %1" : "+v"(a), "+v"(b)); }
DEVI float xsum16(float v) { float a = v, b = v; swap16(a, b); return a + b; }
DEVI float xsum32(float v) { float a = v, b = v; swap32(a, b); return a + b; }
DEVI float xmax16(float v) { float a = v, b = v; swap16(a, b); return fmaxf(a, b); }
DEVI float xmax32(float v) { float a = v, b = v; swap32(a, b); return fmaxf(a, b); }
DEVI float row_sum16(float v) {
    v += dppf<0xB1>(v); v += dppf<0x4E>(v);
    v += dppf<0x141>(v); v += dppf<0x140>(v);
    return v;
}
DEVI float wave_sum(float v) { return xsum32(xsum16(row_sum16(v))); }
DEVI void unpk8s(float* d, const u32x4 q) {
    d[0] = __uint_as_float(q.x << 16); d[1] = __uint_as_float(q.x & 0xFFFF0000u); d[2] = __uint_as_float(q.y << 16); d[3] = __uint_as_float(q.y & 0xFFFF0000u);
    d[4] = __uint_as_float(q.z << 16); d[5] = __uint_as_float(q.z & 0xFFFF0000u); d[6] = __uint_as_float(q.w << 16); d[7] = __uint_as_float(q.w & 0xFFFF0000u);
}
DEVI float frcp(float x) { return __builtin_amdgcn_rcpf(x); }
DEVI float gelu_tanh(float y) { const float z = 0.7978845608028654f * (y + 0.044715f * y * y * y); const float t = 1.f - 2.f * frcp(1.f + __expf(2.f * z)); return 0.5f * y * (1.f + t); }

constexpr float kY8 = 32.f;
constexpr float kW8 = 64.f, kH8 = 8.f;
DEVI unsigned pk4_fp8(float a, float b, float c, float d) { unsigned w = 0u; w = __builtin_amdgcn_cvt_pk_fp8_f32(a, b, w, false); w = __builtin_amdgcn_cvt_pk_fp8_f32(c, d, w, true); return w; }
DEVI int cmap_head(int cs) { const int bj = cs >> 7, wc = (cs >> 5) & 3, n = (cs >> 4) & 1, fq = (cs >> 2) & 3, j = cs & 3; return 64 * wc + 32 * bj + 8 * fq + 4 * n + j; }
DEVI int cmap_pk(int cs)   { const int bj = cs >> 7, wc = (cs >> 5) & 3, n = (cs >> 4) & 1, fq = (cs >> 2) & 3, j = cs & 3; return 128 * bj + 32 * wc + 8 * fq + 4 * n + j; }
DEVI int cmap_gu(int cs)   { const int wc = (cs >> 5) & 3, n = (cs >> 4) & 1, fq = (cs >> 2) & 3, j = cs & 3; return 32 * wc + 8 * fq + 4 * n + j; }

template <int MODE>
DEVI void convert_item(const float* W0, const float* W1, int ldw, int K, bf16_t* Bt, int kt, int pn, unsigned char* lds) {
    bf16_t* t = (bf16_t*)lds;
    const int tid = tidx();
#pragma unroll 4
    for (int it = 0; it < 32; ++it) {
        const int e = it * kNT + tid, k = e >> 8, cs = e & 255;
        float v;
        if (MODE == 0) v = W0[(size_t)(kt * 64 + k) * ldw + pn * 256 + cs];
        else if (MODE == 1) v = W0[(size_t)(kt * 64 + k) * ldw + pn * 256 + cmap_head(cs)];
        else if (MODE == 2) v = W0[(size_t)(kt * 64 + k) * ldw + pn * 256 + cmap_pk(cs)];
        else v = ((cs >> 7) ? W1 : W0)[(size_t)(kt * 64 + k) * ldw + pn * 128 + cmap_gu(cs)];
        t[cs * 72 + k] = f2bf(v);
    }
    __syncthreads();
#pragma unroll
    for (int it = 0; it < 4; ++it) {
        const int c = it * kNT + tid, row = c >> 3, part = c & 7;
        const u32x4 v = *(const u32x4*)(t + row * 72 + part * 8);
        *(u32x4*)(Bt + (size_t)(pn * 256 + row) * K + kt * 64 + part * 8) = v;
    }
    __syncthreads();
}

template <int MODE>
DEVI void convert_item8(const float* W0, const float* W1, int ldw, int K, unsigned char* Bt, int kt, int pn, unsigned char* lds) {
    unsigned char* t = lds;
    const int tid = tidx();
#pragma unroll 4
    for (int it = 0; it < 64; ++it) {
        const int e = it * kNT + tid, k = e >> 8, cs = e & 255;
        float v;
        if (MODE == 2) v = W0[(size_t)(kt * 128 + k) * ldw + pn * 256 + cmap_pk(cs)];
        else v = ((cs >> 7) ? W1 : W0)[(size_t)(kt * 128 + k) * ldw + pn * 128 + cmap_gu(cs)];
        v *= kW8;
        t[cs * 144 + k] = (unsigned char)(__builtin_amdgcn_cvt_pk_fp8_f32(v, v, 0u, false) & 0xFFu);
    }
    __syncthreads();
#pragma unroll
    for (int it = 0; it < 4; ++it) {
        const int c = it * kNT + tid, row = c >> 3, part = c & 7;
        const u32x4 v = *(const u32x4*)(t + row * 144 + part * 16);
        *(u32x4*)(Bt + (size_t)(pn * 256 + row) * K + kt * 128 + part * 16) = v;
    }
    __syncthreads();
}

DEVI void phase_convert(const Params& P, unsigned char* lds, int bid, int nblk) {
    constexpr int N_WIN = kL * 16 * 10, N_WOUT = kL * 16 * 4, N_WGLU = kL * 4 * 1, N_WGU = kL * kE * 8 * 16, N_WD = kL * kE * 16 * 4;
    constexpr int TOT = N_WIN + N_WOUT + N_WGLU + N_WGU + N_WD;
    for (int it = bid; it < TOT; it += nblk) {
        int i = it;
        if (i < N_WIN) { const int l = i / 160, r = i % 160, kt = r / 10, pn = r % 10;
            convert_item<1>(P.w_in + (size_t)l * kD * kINW, nullptr, kINW, kD, (bf16_t*)(wsp(P) + WS_WINT) + (size_t)l * kINW * kD, kt, pn, lds); continue; }
        i -= N_WIN;
        if (i < N_WOUT) { const int l = i / 64, r = i % 64, kt = r / 4, pn = r % 4;
            convert_item<2>(P.w_out + (size_t)l * kD * kD, nullptr, kD, kD, (bf16_t*)(wsp(P) + WS_WOUTT) + (size_t)l * kD * kD, kt, pn, lds); continue; }
        i -= N_WOUT;
        if (i < N_WGLU) { const int l = i / 4, kt = i % 4;
            convert_item<2>(P.w_glu + (size_t)l * 256 * 256, nullptr, 256, 256, (bf16_t*)(wsp(P) + WS_WGLUT) + (size_t)l * 256 * 256, kt, 0, lds); continue; }
        i -= N_WGLU;
        if (i < N_WGU) { const int le = i / 128, r = i % 128, kt = r / 16, pn = r % 16;
            convert_item8<3>(P.w_gate + (size_t)le * kD * kFF, P.w_up + (size_t)le * kD * kFF, kFF, kD, wsp(P) + WS_WGUT + (size_t)le * 4096 * kD, kt, pn, lds); continue; }
        i -= N_WGU;
        { const int le = i / 64, r = i % 64, kt = r / 4, pn = r % 4;
            convert_item8<2>(P.w_down + (size_t)le * kFF * kD, nullptr, kD, kFF, wsp(P) + WS_WDT + (size_t)le * kD * kFF, kt, pn, lds); }
    }
}

DEVI void phase_norm(const float* x, const float* gain, bf16_t* h, int bid, int nblk) {
    const int wid = tidx() >> 6, lane = tidx() & 63;
    f32x4 g[4];
#pragma unroll
    for (int q = 0; q < 4; ++q) g[q] = *(const f32x4*)(gain + q * 256 + lane * 4);
    for (int row = bid * 8 + wid; row < kTok; row += nblk * 8) {
        f32x4 v[4]; float ss = 0.f;
#pragma unroll
        for (int q = 0; q < 4; ++q) { v[q] = *(const f32x4*)(x + (size_t)row * kD + q * 256 + lane * 4); ss += v[q].x * v[q].x + v[q].y * v[q].y + v[q].z * v[q].z + v[q].w * v[q].w; }
        ss = wave_sum(ss);
        const float rstd = rsqrtf(ss * (1.f / kD) + kEps);
#pragma unroll
        for (int q = 0; q < 4; ++q) { f32x4 t = v[q] * rstd * g[q];
            u32x2 o; o.x = pk2(t.x, t.y); o.y = pk2(t.z, t.w);
            *(u32x2*)(h + (size_t)row * kD + q * 256 + lane * 4) = o; }
    }
}

DEVI void phase_router(const bf16_t* x, const float* gain, const float* wr  , bf16_t* h, float* aff, unsigned char* lds, int bid, int nblk) {
    float* wT = (float*)lds;
    for (int i = tidx(); i < 16 * 1024; i += kNT) { const int k = i >> 4, e = i & 15; wT[e * 1024 + k] = wr[i]; }
    __syncthreads();
    const int wid = tidx() >> 6, lane = tidx() & 63;
    f32x4 g[4];
#pragma unroll
    for (int q = 0; q < 4; ++q) g[q] = *(const f32x4*)(gain + q * 256 + lane * 4);
    u32x2 nvx[2][4];
    { const int r0 = (bid * 8 + wid) * 2;
      if (r0 < kTok) {
#pragma unroll
        for (int r = 0; r < 2; ++r)
#pragma unroll
            for (int q = 0; q < 4; ++q) nvx[r][q] = *(const u32x2*)(x + (size_t)(r0 + r) * kD + q * 256 + lane * 4); } }
    for (int row0 = (bid * 8 + wid) * 2; row0 < kTok; row0 += nblk * 8 * 2) {
        asm volatile("" ::: "memory");
        f32x4 v[2][4];
#pragma unroll
        for (int r = 0; r < 2; ++r)
#pragma unroll
            for (int q = 0; q < 4; ++q) { const u32x2 w = nvx[r][q]; v[r][q] = (f32x4){__uint_as_float(w.x << 16), __uint_as_float(w.x & 0xFFFF0000u), __uint_as_float(w.y << 16), __uint_as_float(w.y & 0xFFFF0000u)}; }
        { const int nr0 = row0 + nblk * 8 * 2;
          if (nr0 < kTok) {
#pragma unroll
            for (int r = 0; r < 2; ++r)
#pragma unroll
                for (int q = 0; q < 4; ++q) nvx[r][q] = *(const u32x2*)(x + (size_t)(nr0 + r) * kD + q * 256 + lane * 4); } }
#pragma unroll
        for (int r = 0; r < 2; ++r) { float ss = 0.f;
#pragma unroll
            for (int q = 0; q < 4; ++q) { ss += v[r][q].x * v[r][q].x + v[r][q].y * v[r][q].y + v[r][q].z * v[r][q].z + v[r][q].w * v[r][q].w; }
            ss = wave_sum(ss); const float rstd = rsqrtf(ss * (1.f / kD) + kEps);
#pragma unroll
            for (int q = 0; q < 4; ++q) { v[r][q] = v[r][q] * rstd * g[q];
                *(unsigned*)((unsigned char*)h + (size_t)(row0 + r) * kD + q * 256 + lane * 4) = pk4_fp8(v[r][q].x, v[r][q].y, v[r][q].z, v[r][q].w); }
        }
        float pa[32];
#pragma unroll
        for (int e = 0; e < 16; ++e) {
            float s0 = 0.f, s1 = 0.f;
#pragma unroll
            for (int q = 0; q < 4; ++q) { const f32x4 w = *(const f32x4*)(wT + e * 1024 + q * 256 + lane * 4);
                s0 += v[0][q].x * w.x + v[0][q].y * w.y + v[0][q].z * w.z + v[0][q].w * w.w;
                s1 += v[1][q].x * w.x + v[1][q].y * w.y + v[1][q].z * w.z + v[1][q].w * w.w; }
            pa[e] = s0; pa[16 + e] = s1;
        }
#define RS_STEP(HALF, MASK) { const bool up = (lane & (MASK)) != 0; _Pragma("unroll") for (int i = 0; i < (HALF); ++i) { const float keep = up ? pa[i + (HALF)] : pa[i], send = up ? pa[i] : pa[i + (HALF)]; pa[i] = keep + __shfl_xor(send, (MASK)); } }
        RS_STEP(16, 32) RS_STEP(8, 16) RS_STEP(4, 8) RS_STEP(2, 4) RS_STEP(1, 2)
#undef RS_STEP
        const float logit = pa[0] + __shfl_xor(pa[0], 1);
        float mx = logit;
#pragma unroll
        for (int m = 16; m >= 2; m >>= 1) mx = fmaxf(mx, __shfl_xor(mx, m));
        const float ex = __expf(logit - mx);
        float sm = ex;
#pragma unroll
        for (int m = 16; m >= 2; m >>= 1) sm += __shfl_xor(sm, m);
        const int row = row0 + (lane >> 5), e = (lane >> 1) & 15, b = row >> 13, s = row & (kS - 1);
        if (!(lane & 1)) aff[((size_t)(b * kE + e)) * kS + s] = ex * frcp(sm);
    }
    __syncthreads();
}

DEVI int block_excl_scan(int v, int* sh  , int& total) {
    const int lane = tidx() & 63, wid = tidx() >> 6;
    int incl = v;
#pragma unroll
    for (int d = 1; d < 64; d <<= 1) { const int o = __shfl_up(incl, d); if (lane >= d) incl += o; }
    __syncthreads();
    if (lane == 63) sh[wid] = incl;
    __syncthreads();
    int base = 0, tot = 0;
#pragma unroll
    for (int w = 0; w < 8; ++w) { const int c = sh[w]; if (w < wid) base += c; tot += c; }
    total = tot;
    return base + incl - v;
}

DEVI void phase_topk(const float* aff, int* idx, float* gate, int* tokslot, const unsigned char* hsrc, unsigned char* xe, int rowbytes, unsigned char* lds, int bid, int nblk) {
    int* hist = (int*)lds;
    int* sh = hist + 256;
    int* res = sh + 16;
    int* lsel = res + 16;
    const int tid = tidx(), lane = tid & 63, wid = tid >> 6;
    const int share = (nblk >= 2 * kB * kE) ? 2 : 1;
    for (int wi = bid; wi < kB * kE * share; wi += nblk) {
        const int item = wi / share, part = wi - item * share;
        const int b = item >> 4, e = item & 15;
        const float* a = aff + (size_t)item * kS;
        unsigned key[16];
#pragma unroll
        for (int q = 0; q < 4; ++q) { const u32x4 v = *(const u32x4*)(a + tid * 16 + q * 4); key[q * 4 + 0] = v.x; key[q * 4 + 1] = v.y; key[q * 4 + 2] = v.z; key[q * 4 + 3] = v.w; }
        unsigned prefix = 0; int kk = kCap;
#pragma unroll 1
        for (int pass = 0; pass < 4; ++pass) {
            const int shift = 24 - 8 * pass;
            __syncthreads();
            if (tid < 256) hist[tid] = 0;
            __syncthreads();
#pragma unroll
            for (int i = 0; i < 16; ++i) { const bool in = (pass == 0) || ((key[i] >> (shift + 8)) == prefix); if (in) atomicAdd(&hist[(key[i] >> shift) & 255], 1); }
            __syncthreads();
            if (wid == 0) {
                int c[4], loc = 0;
#pragma unroll
                for (int j = 0; j < 4; ++j) { c[j] = hist[255 - 4 * lane - j]; loc += c[j]; }
                int incl = loc;
#pragma unroll
                for (int d = 1; d < 64; d <<= 1) { const int o = __shfl_up(incl, d); if (lane >= d) incl += o; }
                const int excl = incl - loc;
                if (excl < kk && kk <= incl) { int run = excl; int bin = 0, nk = 0; bool found = false;
#pragma unroll
                    for (int j = 0; j < 4; ++j) { if (!found && run + c[j] >= kk) { bin = 255 - 4 * lane - j; nk = kk - run; found = true; } if (!found) run += c[j]; }
                    res[0] = bin; res[1] = nk; }
            }
            __syncthreads();
            prefix = (prefix << 8) | (unsigned)res[0]; kk = res[1];
        }
        const unsigned T = prefix;
        int ceq = 0;
#pragma unroll
        for (int i = 0; i < 16; ++i) ceq += (key[i] == T) ? 1 : 0;
        int tot;
        int eqb = block_excl_scan(ceq, sh, tot);
        int csel = 0; unsigned selmask = 0;
#pragma unroll
        for (int i = 0; i < 16; ++i) { bool s = key[i] > T; if (key[i] == T) { s = eqb < kk; ++eqb; } if (s) { selmask |= 1u << i; ++csel; } }
        int slot = block_excl_scan(csel, sh, tot);
        const size_t rbase = (size_t)(e * kB + b) * kCap;
#pragma unroll
        for (int i = 0; i < 16; ++i) { const int s = tid * 16 + i; const bool sel = (selmask >> i) & 1u;
            if (sel) { if (part == 0) { idx[rbase + slot] = b * kS + s; gate[rbase + slot] = __uint_as_float(key[i]); } lsel[slot] = b * kS + s; }
            if (part == 0) tokslot[((size_t)(b * kS + s)) * kE + e] = sel ? slot : -1;
            if (sel) ++slot; }
        __syncthreads();
        { const int cpr = rowbytes >> 4;
          const int cbeg = part * (kCap / share) * cpr, cend = cbeg + (kCap / share) * cpr;
          for (int c0 = cbeg + tid; c0 < cend; c0 += kNT * 4) {
              u32x4 v[4];
#pragma unroll
              for (int j = 0; j < 4; ++j) { const int c = c0 + j * kNT; const int r = c / cpr, ch = c - r * cpr; v[j] = *(const u32x4*)(hsrc + (size_t)lsel[r] * rowbytes + ch * 16); }
#pragma unroll
              for (int j = 0; j < 4; ++j) { const int c = c0 + j * kNT; const int r = c / cpr, ch = c - r * cpr; *(u32x4*)(xe + (rbase + r) * rowbytes + ch * 16) = v[j]; }
          } }
    }
    __syncthreads();
}

struct Unit { int pm, pn; };
DEVI bool unit_of(int Lid, int nM, int nN, Unit& u) {
    const int nwg = nM * nN; if (Lid >= nwg) return false;
    int wgid = Lid; { const int q = nwg / 8, r = nwg % 8, xcd = wgid % 8, off = wgid / 8; wgid = (xcd < r ? xcd * (q + 1) : r * (q + 1) + (xcd - r) * q) + off; }
    const int nig = 8 * nN, gid = wgid / nig, fm = gid * 8, gsz = (nM - fm) < 8 ? (nM - fm) : 8;
    u.pm = fm + ((wgid % nig) % gsz); u.pn = (wgid % nig) / gsz; return true;
}
struct GemmD { const bf16_t* A; const bf16_t* Bt; int lda, K, nM, nN; const int* rowidx; size_t bstride; int pmg; };

constexpr int PG_HTB = 128 * 64 * 2;
DEVI int pg_lds_byte(int r, int c) { const int st = (r >> 4) * 2 + (c >> 5), rr = r & 15, cc = c & 31, ob = rr * 64 + cc * 2; return st * 1024 + (ob ^ (((ob >> 9) & 1) << 5)); }
DEVI void pg_stage_rc(int b, int& R, int& C) { const int st = b / 1024, sb = b % 1024, swz = sb ^ (((sb >> 9) & 1) << 5); R = (st >> 1) * 16 + swz / 64; C = (st & 1) * 32 + (swz % 64) / 2; }

typedef int v4i __attribute__((ext_vector_type(4)));
typedef int v8i __attribute__((ext_vector_type(8)));
template <class Epi, bool ALIGN_EPI, bool SP2, bool FP8 = false>
DEVI void gemm_engine(LAS unsigned char* lds, const GemmD g, const Epi& E, int bid, int nblk) {
    const int tid = tidx(), wid = __builtin_amdgcn_readfirstlane(tid >> 6), lane = tid & 63, wr = wid >> 2, wc = wid & 3, fr = lane & 15, fq = lane >> 4;
    constexpr int ES = FP8 ? 1 : 2;
    const int K = g.K * ES  , nt = K / 128; const unsigned ldaB = (unsigned)g.lda * ES;
    unsigned voffA[2], voffB[2];
#pragma unroll
    for (int i = 0; i < 2; ++i) { int R, C; pg_stage_rc(tid * 16 + i * 8192, R, C); voffA[i] = (unsigned)R * ldaB + (unsigned)C * 2u; voffB[i] = (unsigned)(R * K + C * 2); }
    const size_t kstep = 128;
    const size_t hstepB = (size_t)128 * K, hstepA = (size_t)128 * ldaB, tstepA = 2 * hstepA;
    const unsigned ldsw = (unsigned)wid * 1024u;
    const int aoff = pg_lds_byte(wr * 64 + fr, fq * 8), boff = pg_lds_byte(wc * 32 + fr, fq * 8);
#define PG8_SA(b, h) (((b) * 2 + (h)) * PG_HTB)
#define PG8_SB(b, h) ((4 + (b) * 2 + (h)) * PG_HTB)
#define PG8_STAGE(bufoff, gbase, voff) do { _Pragma("unroll") for (int _i = 0; _i < 2; ++_i) \
        __builtin_amdgcn_global_load_lds((const unsigned*)((const char*)(gbase) + (voff)[_i]), (LAS unsigned*)(lds + (bufoff) + ldsw + _i * 8192), 16, 0, 0); } while (0)
#define PG8_RD16(off) (*(const LAS v4i*)(lds + (off)))
#define PG8_CAT2(off) __builtin_shufflevector(PG8_RD16(off), PG8_RD16((off) + 1024), 0, 1, 2, 3, 4, 5, 6, 7)
#define PG8_LDA(dst, b, h) do { _Pragma("unroll") for (int m = 0; m < 4; ++m) { if constexpr (FP8) dst##8[m] = PG8_CAT2(PG8_SA(b, h) + aoff + m * 2048); \
        else { _Pragma("unroll") for (int k = 0; k < 2; ++k) dst[m][k] = *(const LAS bf16x8*)(lds + PG8_SA(b, h) + aoff + m * 2048 + k * 1024); } } } while (0)
#define PG8_LDB(dst, b, h) do { _Pragma("unroll") for (int n = 0; n < 2; ++n) { if constexpr (FP8) dst##8[n] = PG8_CAT2(PG8_SB(b, h) + boff + n * 2048); \
        else { _Pragma("unroll") for (int k = 0; k < 2; ++k) dst[n][k] = *(const LAS bf16x8*)(lds + PG8_SB(b, h) + boff + n * 2048 + k * 1024); } } } while (0)
#define PG8_MMA(ai, bj, At, Bt) do { __builtin_amdgcn_s_setprio(1); _Pragma("unroll") for (int m = 0; m < 4; ++m) _Pragma("unroll") for (int n = 0; n < 2; ++n) { \
        if constexpr (FP8) asm volatile("v_mfma_f32_16x16x128_f8f6f4 %0, %1, %2, %0" : "+v"(acc[ai][bj][m][n]) : "v"(Bt##8[n]), "v"(At##8[m]));   \
        else { _Pragma("unroll") for (int k = 0; k < 2; ++k) acc[ai][bj][m][n] = __builtin_amdgcn_mfma_f32_16x16x32_bf16(Bt[n][k], At[m][k], acc[ai][bj][m][n], 0, 0, 0); } } \
        __builtin_amdgcn_s_setprio(0); } while (0)
#define PG8_WAIT_V(n) asm volatile("s_waitcnt vmcnt(" #n ")" ::: "memory")
#define PG8_WAIT_L(n) asm volatile("s_waitcnt lgkmcnt(" #n ")" ::: "memory")
#define PG8_BAR __builtin_amdgcn_s_barrier()
#define PG8_SCHED __builtin_amdgcn_sched_barrier(0)
    Unit cur, nxt; int ui = 0;
    if (!unit_of(bid, g.nM, g.nN, cur)) return;
    f32x4 acc[2][2][4][2];
#pragma unroll
    for (int a = 0; a < 2; ++a)
#pragma unroll
        for (int b = 0; b < 2; ++b)
#pragma unroll
            for (int m = 0; m < 4; ++m)
#pragma unroll
                for (int n = 0; n < 2; ++n) acc[a][b][m][n] = (f32x4){0.f, 0.f, 0.f, 0.f};
    bf16x8 At[4][2], B0[2][2], B1[2][2]; v8i At8[4], B08[2], B18[2];
    (void)At; (void)B0; (void)B1; (void)At8; (void)B08; (void)B18;
    static_assert(SP2, "only the two-super-phase K-loop is kept");
    const char* cA = (const char*)g.A + (size_t)cur.pm * tstepA;
    const char* cB = (const char*)g.Bt + (size_t)(cur.pm / g.pmg) * g.bstride * ES + (size_t)cur.pn * 256 * K;
    PG8_STAGE(PG8_SB(0, 0), cB, voffB); PG8_STAGE(PG8_SB(0, 1), cB + hstepB, voffB); PG8_STAGE(PG8_SA(0, 0), cA, voffA); PG8_STAGE(PG8_SA(0, 1), cA + hstepA, voffA);
    if (wr == 1) PG8_BAR;
    PG8_WAIT_V(2); PG8_BAR;
    PG8_STAGE(PG8_SB(1, 0), cB + kstep, voffB); PG8_STAGE(PG8_SA(1, 0), cA + kstep, voffA); PG8_STAGE(PG8_SB(1, 1), cB + hstepB + kstep, voffB);
    PG8_WAIT_V(6); PG8_BAR;
    for (;;) {
        const bool has_next = unit_of((ui + 1) * nblk + bid, g.nM, g.nN, nxt);
        const char* nA = has_next ? (const char*)g.A + (size_t)nxt.pm * tstepA : cA;
        const char* nB = has_next ? (const char*)g.Bt + (size_t)(nxt.pm / g.pmg) * g.bstride * ES + (size_t)nxt.pn * 256 * K : cB;
#pragma unroll 1
        for (int t = 0; t < nt; t += 2) {
            const bool last = (t == nt - 2);
            const char* a1 = cA + (size_t)(t + 1) * kstep;
            const char* a2 = last ? nA : cA + (size_t)(t + 2) * kstep; const char* b2 = last ? nB : cB + (size_t)(t + 2) * kstep;
            const char* a3 = a2 + kstep; const char* b3 = b2 + kstep;
            PG8_LDB(B0, 0, 0); PG8_LDB(B1, 0, 1); PG8_SCHED; PG8_LDA(At, 0, 0); PG8_STAGE(PG8_SA(1, 1), a1 + hstepA, voffA);
            PG8_WAIT_V(8); PG8_WAIT_L(0); PG8_BAR; PG8_MMA(0, 0, At, B0); PG8_MMA(0, 1, At, B1); PG8_BAR; PG8_SCHED;
            PG8_LDA(At, 0, 1); PG8_STAGE(PG8_SB(0, 0), b2, voffB); PG8_STAGE(PG8_SB(0, 1), b2 + hstepB, voffB); PG8_STAGE(PG8_SA(0, 0), a2, voffA);
            PG8_WAIT_V(8); PG8_WAIT_L(0); PG8_BAR; PG8_MMA(1, 0, At, B0); PG8_MMA(1, 1, At, B1); PG8_BAR; PG8_SCHED;
            PG8_LDB(B0, 1, 0); PG8_LDB(B1, 1, 1); PG8_SCHED; PG8_LDA(At, 1, 0); PG8_STAGE(PG8_SA(0, 1), a2 + hstepA, voffA);
            PG8_WAIT_V(8); PG8_WAIT_L(0); PG8_BAR; PG8_MMA(0, 0, At, B0); PG8_MMA(0, 1, At, B1); PG8_BAR; PG8_SCHED;
            PG8_LDA(At, 1, 1); PG8_STAGE(PG8_SB(1, 0), b3, voffB); PG8_STAGE(PG8_SB(1, 1), b3 + hstepB, voffB); PG8_STAGE(PG8_SA(1, 0), a3, voffA);
            PG8_WAIT_V(8); PG8_WAIT_L(0); PG8_BAR; PG8_MMA(1, 0, At, B0); PG8_MMA(1, 1, At, B1); PG8_BAR; PG8_SCHED;
        }
        if constexpr (ALIGN_EPI) { if (wr == 0) PG8_BAR; }
        if constexpr (FP8) asm volatile("s_nop 15\n\ts_nop 15" ::: "memory");
        E(acc, cur, wr, wc, fr, fq);
        if (!has_next) break;
#pragma unroll
        for (int a = 0; a < 2; ++a)
#pragma unroll
            for (int b = 0; b < 2; ++b)
#pragma unroll
                for (int m = 0; m < 4; ++m)
#pragma unroll
                    for (int n = 0; n < 2; ++n) acc[a][b][m][n] = (f32x4){0.f, 0.f, 0.f, 0.f};
        cur = nxt; cA = nA; cB = nB; ++ui;
        if constexpr (ALIGN_EPI) { if (wr == 1) PG8_BAR; }
    }
    PG8_WAIT_V(0);
    if constexpr (!ALIGN_EPI) { if (wr == 0) PG8_BAR; }
    PG8_BAR;
#undef PG8_SA
#undef PG8_SB
#undef PG8_STAGE
#undef PG8_LDA
#undef PG8_LDB
#undef PG8_MMA
#undef PG8_RD16
#undef PG8_CAT2
#undef PG8_WAIT_V
#undef PG8_WAIT_L
#undef PG8_BAR
#undef PG8_SCHED
}

struct EpiQKV {
    static constexpr int VMOPS = 16;
    bf16_t *qa, *ka, *va, *qb, *kb, *vb, *ux;
    const LAS float* gtab;
    DEVI void operator()(const f32x4 (&acc)[2][2][4][2], const Unit& u, int wr, int wc, int fr, int fq) const {
        const int pn = u.pn;
        bf16_t* dst = (pn < 2) ? qa : (pn < 4) ? ka : (pn < 6) ? va : (pn == 6) ? qb : (pn == 7) ? kb : (pn == 8) ? vb : ux;
        const int H = (pn < 6) ? 8 : 4, head = ((pn < 6) ? (pn & 1) * 4 : 0) + wc;
        const int trow = (pn < 2) ? 0 : (pn < 4) ? 1 : (pn == 6) ? 2 : (pn == 7) ? 3 : 4;
        const bool nrm = trow < 4;
        f32x4 gv[2][2];
#pragma unroll
        for (int bj = 0; bj < 2; ++bj)
#pragma unroll
            for (int n = 0; n < 2; ++n) gv[bj][n] = *(const LAS f32x4*)(gtab + trow * 64 + 32 * bj + 8 * fq + 4 * n);
        const size_t hb = (size_t)head * kS * 64 + 8 * fq;
        const int g0 = 4 * wc + (fq >> 1), c0 = 8 * (fq & 1);
#pragma unroll
        for (int ai = 0; ai < 2; ++ai)
#pragma unroll
            for (int m = 0; m < 4; ++m) {
                const int row = u.pm * 256 + 128 * ai + 64 * wr + 16 * m + fr;
                float ss = 0.f;
#pragma unroll
                for (int bj = 0; bj < 2; ++bj)
#pragma unroll
                    for (int n = 0; n < 2; ++n) { const f32x4 v = acc[ai][bj][m][n]; ss += v.x * v.x + v.y * v.y + v.z * v.z + v.w * v.w; }
                ss = xsum32(xsum16(ss));
                const float rs = __builtin_amdgcn_rsqf(ss * (1.f / 64.f) + kEps), rstd = nrm ? rs : 1.f;
                const int b = row >> 13, sq = row & (kS - 1);
                const size_t o_qkv = ((size_t)b * H * kS + sq) * 64 + hb, o_u = ((size_t)g0 * 4096 + (row >> 4)) * 512 + (row & 15) * 16 + c0;
#pragma unroll
                for (int bj = 0; bj < 2; ++bj) {
                    const f32x4 v0 = acc[ai][bj][m][0] * rstd * gv[bj][0], v1 = acc[ai][bj][m][1] * rstd * gv[bj][1];
                    u32x4 w; w.x = pk2(v0.x, v0.y); w.y = pk2(v0.z, v0.w); w.z = pk2(v1.x, v1.y); w.w = pk2(v1.z, v1.w);
                    const size_t o = (pn < 9) ? o_qkv + 32 * bj : o_u + (size_t)bj * 2 * 4096 * 512;
                    *(u32x4*)(dst + o) = w;
                }
            }
    }
};
struct EpiResid {
    static constexpr int VMOPS = 16;
    const float* x32; bf16_t* xb; bf16_t* xbo;
    DEVI void operator()(const f32x4 (&acc)[2][2][4][2], const Unit& u, int wr, int wc, int fr, int fq) const {
#pragma unroll
        for (int ai = 0; ai < 2; ++ai) {
            const size_t r0 = (size_t)(u.pm * 256 + 128 * ai + 64 * wr + fr) * kD + u.pn * 256 + 32 * wc + 8 * fq;
            if (x32) {
                f32x4 a[4][2][2];
#pragma unroll
                for (int m = 0; m < 4; ++m)
#pragma unroll
                    for (int bj = 0; bj < 2; ++bj) { const size_t o = r0 + (size_t)m * 16 * kD + 128 * bj; a[m][bj][0] = *(const f32x4*)(x32 + o); a[m][bj][1] = *(const f32x4*)(x32 + o + 4); }
#pragma unroll
                for (int m = 0; m < 4; ++m)
#pragma unroll
                    for (int bj = 0; bj < 2; ++bj) { const size_t o = r0 + (size_t)m * 16 * kD + 128 * bj; const f32x4 v0 = a[m][bj][0] + acc[ai][bj][m][0], v1 = a[m][bj][1] + acc[ai][bj][m][1];
                        u32x4 r; r.x = pk2(v0.x, v0.y); r.y = pk2(v0.z, v0.w); r.z = pk2(v1.x, v1.y); r.w = pk2(v1.z, v1.w); *(u32x4*)(xbo + o) = r; }
            } else {
                u32x4 a[4][2];
#pragma unroll
                for (int m = 0; m < 4; ++m)
#pragma unroll
                    for (int bj = 0; bj < 2; ++bj) a[m][bj] = *(const u32x4*)(xb + r0 + (size_t)m * 16 * kD + 128 * bj);
#pragma unroll
                for (int m = 0; m < 4; ++m)
#pragma unroll
                    for (int bj = 0; bj < 2; ++bj) { const size_t o = r0 + (size_t)m * 16 * kD + 128 * bj; const u32x4 w = a[m][bj];
                        const f32x4 v0 = (f32x4){__uint_as_float(w.x << 16), __uint_as_float(w.x & 0xFFFF0000u), __uint_as_float(w.y << 16), __uint_as_float(w.y & 0xFFFF0000u)} + acc[ai][bj][m][0];
                        const f32x4 v1 = (f32x4){__uint_as_float(w.z << 16), __uint_as_float(w.z & 0xFFFF0000u), __uint_as_float(w.w << 16), __uint_as_float(w.w & 0xFFFF0000u)} + acc[ai][bj][m][1];
                        u32x4 r; r.x = pk2(v0.x, v0.y); r.y = pk2(v0.z, v0.w); r.z = pk2(v1.x, v1.y); r.w = pk2(v1.z, v1.w); *(u32x4*)(xbo + o) = r; }
            }
        }
    }
};
struct EpiGU {
    static constexpr int VMOPS = 4;
    bf16_t* hid; float sc;
    DEVI void silu8(const f32x4 (&acc)[2][2][4][2], int ai, int m, float (&o)[8]) const {
        const float k1 = -sc * kLog2e, k2 = sc * sc * kH8;
#pragma unroll
        for (int n = 0; n < 2; ++n)
#pragma unroll
            for (int j = 0; j < 4; j += 2) { const f32x2 a = {acc[ai][0][m][n][j], acc[ai][0][m][n][j + 1]}, b = {acc[ai][1][m][n][j], acc[ai][1][m][n][j + 1]};
                const f32x2 ab = a * b, t = a * k1; f32x2 d; d.x = __builtin_amdgcn_exp2f(t.x); d.y = __builtin_amdgcn_exp2f(t.y); d = d + 1.f;
                f32x2 r; r.x = frcp(d.x); r.y = frcp(d.y); const f32x2 v = (ab * r) * k2;
                o[n * 4 + j] = v.x; o[n * 4 + j + 1] = v.y; }
    }
    DEVI void operator()(const f32x4 (&acc)[2][2][4][2], const Unit& u, int wr, int wc, int fr, int fq) const {
#pragma unroll
        for (int ai = 0; ai < 2; ++ai)
#pragma unroll
            for (int m = 0; m < 4; m += 2) {
                float o0[8], o1[8]; silu8(acc, ai, m, o0); silu8(acc, ai, m + 1, o1);
#pragma unroll
                for (int t = 0; t < 8; ++t) { o0[t] = __builtin_amdgcn_fmed3f(o0[t], -448.f, 448.f); o1[t] = __builtin_amdgcn_fmed3f(o1[t], -448.f, 448.f); }
                unsigned ax = pk4_fp8(o0[0], o0[1], o0[2], o0[3]), ay = pk4_fp8(o0[4], o0[5], o0[6], o0[7]), bx = pk4_fp8(o1[0], o1[1], o1[2], o1[3]), by = pk4_fp8(o1[4], o1[5], o1[6], o1[7]);
                swap16u(ax, bx); swap16u(ay, by);
                const size_t row = (size_t)(u.pm * 256 + 128 * ai + 64 * wr + 16 * (m + (fq & 1)) + fr);
                u32x4 w; w.x = ax; w.y = ay; w.z = bx; w.w = by;
                *(u32x4*)((unsigned char*)hid + row * kFF + u.pn * 128 + 32 * wc + 8 * (fq & ~1)) = w;
            }
    }
};
struct EpiDown {
    static constexpr int VMOPS = 8;
    bf16_t* y; float sc;
    DEVI static unsigned pk4c(const f32x4 v) { return pk4_fp8(__builtin_amdgcn_fmed3f(v.x, -448.f, 448.f), __builtin_amdgcn_fmed3f(v.y, -448.f, 448.f), __builtin_amdgcn_fmed3f(v.z, -448.f, 448.f), __builtin_amdgcn_fmed3f(v.w, -448.f, 448.f)); }
    DEVI void operator()(const f32x4 (&acc)[2][2][4][2], const Unit& u, int wr, int wc, int fr, int fq) const {
        const float gv = sc * kY8;
#pragma unroll
        for (int ai = 0; ai < 2; ++ai)
#pragma unroll
            for (int m = 0; m < 4; m += 2)
#pragma unroll
                for (int bj = 0; bj < 2; ++bj) {
                    unsigned ax = pk4c(acc[ai][bj][m][0] * gv), ay = pk4c(acc[ai][bj][m][1] * gv), bx = pk4c(acc[ai][bj][m + 1][0] * gv), by = pk4c(acc[ai][bj][m + 1][1] * gv);
                    swap16u(ax, bx); swap16u(ay, by);
                    const size_t row = (size_t)(u.pm * 256 + 128 * ai + 64 * wr + 16 * (m + (fq & 1)) + fr);
                    u32x4 w; w.x = ax; w.y = ay; w.z = bx; w.w = by;
                    *(u32x4*)((unsigned char*)y + row * kD + u.pn * 256 + 128 * bj + 32 * wc + 8 * (fq & ~1)) = w;
                }
    }
};
struct EpiGlu {
    static constexpr int VMOPS = 16;
    const bf16_t* g; bf16_t* oc;
    DEVI void operator()(const f32x4 (&acc)[2][2][4][2], const Unit& u, int wr, int wc, int fr, int fq) const {
#pragma unroll
        for (int ai = 0; ai < 2; ++ai) {
            const size_t r0 = (size_t)(u.pm * 256 + 128 * ai + 64 * wr + fr) * 256 + 32 * wc + 8 * fq;
            u32x4 gw[4][2];
#pragma unroll
            for (int m = 0; m < 4; ++m)
#pragma unroll
                for (int bj = 0; bj < 2; ++bj) gw[m][bj] = *(const u32x4*)(g + r0 + (size_t)m * 16 * 256 + 128 * bj);
#pragma unroll
            for (int m = 0; m < 4; ++m)
#pragma unroll
                for (int bj = 0; bj < 2; ++bj) { const size_t o = r0 + (size_t)m * 16 * 256 + 128 * bj; float gg[8]; unpk8s(gg, gw[m][bj]); float o8[8];
#pragma unroll
                    for (int n = 0; n < 2; ++n)
#pragma unroll
                        for (int j = 0; j < 4; ++j) o8[n * 4 + j] = gg[n * 4 + j] * frcp(1.f + __expf(-acc[ai][bj][m][n][j]));
                    u32x4 w; w.x = pk2(o8[0], o8[1]); w.y = pk2(o8[2], o8[3]); w.z = pk2(o8[4], o8[5]); w.w = pk2(o8[6], o8[7]);
                    *(u32x4*)(oc + o) = w; }
        }
    }
};

typedef float f32x16 __attribute__((ext_vector_type(16)));
typedef short s16x4 __attribute__((ext_vector_type(4)));
DEVI bf16x8 tr_pair(LAS unsigned char* p0, LAS unsigned char* p1) {
    const s16x4 a = __builtin_amdgcn_ds_read_tr16_b64_v4i16((LAS s16x4*)p0), b = __builtin_amdgcn_ds_read_tr16_b64_v4i16((LAS s16x4*)p1);
    return (bf16x8){a.x, a.y, a.z, a.w, b.x, b.y, b.z, b.w};
}
DEVI void phase_dilated(const bf16_t* qa, const bf16_t* ka, const bf16_t* va, const float* gq, const float* gk, bf16_t* oac, float* lse, LAS unsigned char* lds, int bid, int nblk) {
    const int tid = tidx(), wid = __builtin_amdgcn_readfirstlane(tid >> 6), lane = tid & 63, h5 = lane >> 5, qc = lane & 31;
    LAS unsigned char* Kimg = lds; LAS unsigned char* Vimg = lds + 49152;
    float Mn;
    { float a = fabsf(gq[lane]), b = fabsf(gk[lane]);
#pragma unroll
      for (int m = 32; m >= 1; m >>= 1) { a = fmaxf(a, __shfl_xor(a, m)); b = fmaxf(b, __shfl_xor(b, m)); }
      Mn = 8.f * a * b; }
    const float Mb = Mn * kLog2e;
    unsigned koff[4];
#pragma unroll
    for (int s = 0; s < 4; ++s) koff[s] = (unsigned)((32 * wid + qc) * 128 + (((2 * s + h5) ^ (qc & 7)) << 4));
    unsigned voff[2];
    { const int g = lane >> 4, i16 = lane & 15, q = i16 >> 2, p = i16 & 3;
#pragma unroll
      for (int dt = 0; dt < 2; ++dt) { const int c = (2 * (g & 1) + (p >> 1) + 4 * dt) ^ ((q >> 1) << 2); voff[dt] = (unsigned)((32 * wid + 4 * h5 + q) * 128 + (c << 4) + 8 * (p & 1)); } }
    const float dbase = (float)(4 * h5 - qc);
    u32x4 pK[6], pV[6];
#define DIL_DECODE(unit_) const int c = (unit_) >> 11, rem = (unit_) & 2047, bh = rem >> 5, ub = rem & 31; \
        const int dsh = 2 * c, L = kS >> dsh, upc = 32 >> dsh, cls = ub >> (5 - dsh), u0 = (ub & (upc - 1)) << 8;
#define DIL_PREFETCH(unit_) do { DIL_DECODE(unit_) \
        const bf16_t* kbase = ka + (size_t)bh * kS * 64; const bf16_t* vbase = va + (size_t)bh * kS * 64; \
        _Pragma("unroll") for (int it = 0; it < 6; ++it) { const int id = it * kNT + tid, row = id >> 3, ch = id & 7; \
            int ki = u0 - 64 + row; ki = ki < 0 ? 0 : (ki > L - 1 ? L - 1 : ki); const size_t tok = (size_t)((ki << dsh) + cls); \
            pK[it] = *(const u32x4*)(kbase + tok * 64 + ch * 8); pV[it] = *(const u32x4*)(vbase + tok * 64 + ch * 8); } } while (0)
    if (bid < 6144) DIL_PREFETCH(bid);
    for (int unit = bid; unit < 6144; unit += nblk) {
        DIL_DECODE(unit)
        const int q0 = u0 + 32 * wid, qtok = ((q0 + qc) << dsh) + cls;
        bf16x8 Qf[4];
#pragma unroll
        for (int s = 0; s < 4; ++s) Qf[s] = *(const bf16x8*)(qa + ((size_t)bh * kS + qtok) * 64 + 16 * s + 8 * h5);
        __syncthreads();
#pragma unroll
        for (int it = 0; it < 6; ++it) { const int id = it * kNT + tid, row = id >> 3, ch = id & 7;
            *(LAS u32x4*)(Kimg + row * 128 + ((ch ^ (row & 7)) << 4)) = pK[it];
            *(LAS u32x4*)(Vimg + row * 128 + ((ch ^ (((row >> 1) & 1) << 2)) << 4)) = pV[it]; }
        __syncthreads();
        if (unit + nblk < 6144) DIL_PREFETCH(unit + nblk);
        const float slope = exp2f(-(float)((bh & 7) + 1));
        const float c1 = 0.125f * kLog2e, c2 = slope * (float)(1 << dsh) * kLog2e;
        float sum = 0.f;
        f32x16 O[2];
#pragma unroll
        for (int dt = 0; dt < 2; ++dt)
#pragma unroll
            for (int i = 0; i < 16; ++i) O[dt][i] = 0.f;
#define DIL_QK(dst, kt_) do { _Pragma("unroll") for (int i = 0; i < 16; ++i) dst[i] = 0.f; \
            _Pragma("unroll") for (int s = 0; s < 4; ++s) { const bf16x8 Kf = *(const LAS bf16x8*)(Kimg + koff[s] + (kt_) * 4096); dst = __builtin_amdgcn_mfma_f32_32x32x16_bf16(Kf, Qf[s], dst, 0, 0, 0); } } while (0)
        f32x16 S, Sn;
        DIL_QK(S, 0);
        f32x2 sum2 = {0.f, 0.f};
        const float ndb = -dbase;
#pragma unroll
        for (int kt = 0; kt < 5; ++kt) {
            if (kt < 4) DIL_QK(Sn, kt + 1);
            const int kp0 = q0 - 64 + 32 * kt;
            const float tm = (kp0 >= 0 && kp0 < L) ? 0.f : -1e30f;
            const float cs = (kt < 2) ? c2 : -c2, c0 = ((kt == 0 || kt == 4) ? -64.f : (kt == 2 ? 0.f : -32.f)) * c2 - Mb + tm;
            const float bt = dbase * cs + c0;
#pragma unroll
            for (int i = 0; i < 16; i += 2) {
                const float k0 = (float)((i & 3) + 8 * (i >> 2)), k1 = (float)(((i + 1) & 3) + 8 * ((i + 1) >> 2));
                f32x2 t;
                if (kt == 2) { const f32x2 d = {fabsf(dbase + k0), fabsf(dbase + k1)}; t = d * cs + c0; }
                else t = (f32x2){k0, k1} * cs + bt;
                f32x2 sv = (f32x2){S[i], S[i + 1]} * c1 + t;
                if (kt == 0) { sv.x = (k0 >= ndb) ? sv.x : -1e30f; sv.y = (k1 >= ndb) ? sv.y : -1e30f; }
                if (kt == 4) { sv.x = (k0 <= ndb) ? sv.x : -1e30f; sv.y = (k1 <= ndb) ? sv.y : -1e30f; }
                f32x2 pv; pv.x = __builtin_amdgcn_exp2f(sv.x); pv.y = __builtin_amdgcn_exp2f(sv.y);
                S[i] = pv.x; S[i + 1] = pv.y; sum2 += pv;
            }
#pragma unroll
            for (int s2 = 0; s2 < 2; ++s2) {
                u32x4 pw; pw.x = pk2(S[8 * s2 + 0], S[8 * s2 + 1]); pw.y = pk2(S[8 * s2 + 2], S[8 * s2 + 3]); pw.z = pk2(S[8 * s2 + 4], S[8 * s2 + 5]); pw.w = pk2(S[8 * s2 + 6], S[8 * s2 + 7]);
                const bf16x8 Pf = __builtin_bit_cast(bf16x8, pw);
#pragma unroll
                for (int dt = 0; dt < 2; ++dt) { LAS unsigned char* vp = Vimg + voff[dt] + kt * 4096 + s2 * 2048;
                    const bf16x8 Vf = tr_pair(vp, vp + 1024);
                    O[dt] = __builtin_amdgcn_mfma_f32_32x32x16_bf16(Vf, Pf, O[dt], 0, 0, 0); }
            }
            if (kt < 4) S = Sn;
        }
#undef DIL_QK
        sum = sum2.x + sum2.y;
        sum = xsum32(sum);
        const float inv = 1.f / sum;
        const size_t tok = (size_t)(bh >> 3) * kS + qtok;
        {
        LAS unsigned char* ost = lds + 98304 + wid * 4096;
#pragma unroll
        for (int dt = 0; dt < 2; ++dt)
#pragma unroll
            for (int g4 = 0; g4 < 4; ++g4) { u32x2 w; w.x = pk2(O[dt][4 * g4] * inv, O[dt][4 * g4 + 1] * inv); w.y = pk2(O[dt][4 * g4 + 2] * inv, O[dt][4 * g4 + 3] * inv);
                *(LAS u32x2*)(ost + qc * 128 + (((4 * dt + g4) ^ (qc & 7)) << 4) + 8 * h5) = w; }
        if (h5 == 0) lse[((size_t)c * kTok + tok) * 8 + (bh & 7)] = Mn + __logf(sum);
        bf16_t* obase = oac + ((size_t)c * kTok + (size_t)(bh >> 3) * kS) * 512 + (bh & 7) * 64;
#pragma unroll
        for (int it = 0; it < 4; ++it) { const int r = it * 8 + (lane >> 3), ch = lane & 7;
            const u32x4 v = *(const LAS u32x4*)(ost + r * 128 + ((ch ^ (r & 7)) << 4));
            const size_t t2 = (size_t)(((q0 + r) << dsh) + cls);
            *(u32x4*)(obase + t2 * 512 + ch * 8) = v; }
        }
    }
#undef DIL_DECODE
#undef DIL_PREFETCH
    __syncthreads();
}
DEVI void phase_na(const bf16_t* qb, const bf16_t* kb, const bf16_t* vb, const float* rpb  , const float* gq, const float* gk, bf16_t* ob, LAS unsigned char* lds, int bid, int nblk) {
    const int tid = tidx(), wid = __builtin_amdgcn_readfirstlane(tid >> 6), lane = tid & 63, g4 = lane >> 4, i16 = lane & 15;
    LAS unsigned char* Kimg = lds; LAS unsigned char* Vimg = lds + 73728; LAS float* tab = (LAS float*)(lds + 147456);
    __syncthreads();
    for (int i = tid; i < 4 * 465; i += kNT) tab[i] = rpb[i];
    float Mq;
    { float a = fabsf(gq[lane]), b = fabsf(gk[lane]);
#pragma unroll
      for (int m = 32; m >= 1; m >>= 1) { a = fmaxf(a, __shfl_xor(a, m)); b = fmaxf(b, __shfl_xor(b, m)); }
      Mq = 8.f * a * b; }
    __syncthreads();
    if (wid < 4) { float m = 0.f; for (int i = lane; i < 465; i += 64) m = fmaxf(m, fabsf(tab[wid * 465 + i]));
#pragma unroll
        for (int k = 32; k >= 1; k >>= 1) m = fmaxf(m, __shfl_xor(m, k));
        if (lane == 0) tab[1860 + wid] = m; }
    __syncthreads();
    const int g = wid & 3, kcs = (16 * g - 8) < 0 ? 0 : ((16 * g - 8) > 32 ? 32 : (16 * g - 8));
    const int qcol = 16 * g + i16, cs = (qcol - 8) < 0 ? 0 : ((qcol - 8) > 48 ? 48 : (qcol - 8));
    unsigned kswz[2];
#pragma unroll
    for (int s = 0; s < 2; ++s) kswz[s] = (unsigned)(((4 * s + g4) ^ (i16 & 7)) << 4);
    const int q = i16 >> 2, p = i16 & 3, sw = 2 * (g4 & 1) + (q >> 1);
    unsigned vsw[4];
#pragma unroll
    for (int dt = 0; dt < 4; ++dt) vsw[dt] = (unsigned)((((2 * dt + (p >> 1)) ^ (sw << 1)) << 4) + 8 * (p & 1));
    u32x4 pK[9], pV[9];
#define NA_PREFETCH(unit_) do { const int bh_ = (unit_) >> 6, r0_ = 2 * ((unit_) & 63); const int rsA_ = (r0_ - 4) < 0 ? 0 : ((r0_ - 4) > 120 ? 120 : (r0_ - 4)); \
        const bf16_t* kbase = kb + (size_t)bh_ * kS * 64; const bf16_t* vbase = vb + (size_t)bh_ * kS * 64; \
        _Pragma("unroll") for (int it = 0; it < 9; ++it) { const int id = it * kNT + tid, row = id >> 3, ch = id & 7; int gr = rsA_ + (row >> 6); gr = gr > 127 ? 127 : gr; \
            const size_t tok = (size_t)(gr * 64 + (row & 63)); pK[it] = *(const u32x4*)(kbase + tok * 64 + ch * 8); pV[it] = *(const u32x4*)(vbase + tok * 64 + ch * 8); } } while (0)
    if (bid < 2048) NA_PREFETCH(bid);
    for (int unit = bid; unit < 2048; unit += nblk) {
        const int bh = unit >> 6, rp = unit & 63, r0 = 2 * rp, h = bh & 3;
        const int rsA = (r0 - 4) < 0 ? 0 : ((r0 - 4) > 120 ? 120 : (r0 - 4));
        const int rr = r0 + (wid >> 2);
        const int rs = (rr - 4) < 0 ? 0 : ((rr - 4) > 120 ? 120 : (rr - 4)), ro = rs - rsA;
        const int qtok = rr * 64 + qcol;
        bf16x8 Qf[2];
#pragma unroll
        for (int s = 0; s < 2; ++s) Qf[s] = *(const bf16x8*)(qb + ((size_t)bh * kS + qtok) * 64 + 32 * s + 8 * g4);
        __syncthreads();
#pragma unroll
        for (int it = 0; it < 9; ++it) { const int id = it * kNT + tid, row = id >> 3, ch = id & 7;
            *(LAS u32x4*)(Kimg + row * 128 + ((ch ^ (row & 7)) << 4)) = pK[it];
            *(LAS u32x4*)(Vimg + row * 128 + ((ch ^ (((row >> 1) & 3) << 1)) << 4)) = pV[it]; }
        __syncthreads();
        if (unit + nblk < 2048) NA_PREFETCH(unit + nblk);
        const LAS float* th = tab + h * 465;
        const float Mb = (Mq + tab[1860 + h]) * kLog2e, c1 = 0.125f * kLog2e;
        int g4v = g4; asm volatile("" : "+v"(g4v));
        const int ecol = kcs + 4 * g4v - cs, dcb = kcs + 4 * g4v - qcol + 15;
        const unsigned kb0 = (unsigned)((ro * 64 + kcs + i16) * 128), vb0 = (unsigned)((ro * 64 + kcs + 4 * g4 + q) * 128);
        float sum = 0.f;
        f32x4 O[4];
#pragma unroll
        for (int dt = 0; dt < 4; ++dt) O[dt] = (f32x4){0.f, 0.f, 0.f, 0.f};
#pragma unroll
        for (int u = 0; u < 8; ++u) {
            f32x4 S[2];
#pragma unroll
            for (int tt = 0; tt < 2; ++tt) { S[tt] = (f32x4){0.f, 0.f, 0.f, 0.f};
#pragma unroll
                for (int s = 0; s < 2; ++s) { const bf16x8 Kf = *(const LAS bf16x8*)(Kimg + kb0 + u * 8192 + tt * 2048 + kswz[s]); S[tt] = __builtin_amdgcn_mfma_f32_16x16x32_bf16(Kf, Qf[s], S[tt], 0, 0, 0); } }
            const LAS float* tr = th + (rs + u - rr + 7) * 31;
#pragma unroll
            for (int tt = 0; tt < 2; ++tt)
#pragma unroll
                for (int j = 0; j < 4; ++j) {
                    const int e = ecol + 16 * tt + j; int dc = dcb + 16 * tt + j; dc = dc < 0 ? 0 : (dc > 30 ? 30 : dc);
                    const float bias = tr[dc];
                    const float sv = ((unsigned)e < 16u) ? S[tt][j] * c1 + (bias * kLog2e - Mb) : -1e30f;
                    const float pv = __builtin_amdgcn_exp2f(sv); S[tt][j] = pv; sum += pv;
                }
            u32x4 pw; pw.x = pk2(S[0][0], S[0][1]); pw.y = pk2(S[0][2], S[0][3]); pw.z = pk2(S[1][0], S[1][1]); pw.w = pk2(S[1][2], S[1][3]);
            const bf16x8 Pf = __builtin_bit_cast(bf16x8, pw);
#pragma unroll
            for (int dt = 0; dt < 4; ++dt) { LAS unsigned char* vp = Vimg + vb0 + u * 8192 + vsw[dt];
                const bf16x8 Vf = tr_pair(vp, vp + 2048);
                O[dt] = __builtin_amdgcn_mfma_f32_16x16x32_bf16(Vf, Pf, O[dt], 0, 0, 0); }
        }
        sum = xsum32(xsum16(sum));
        const float inv = 1.f / sum;
        bf16_t* orow = ob + ((size_t)(bh >> 2) * kS + qtok) * 256 + h * 64;
#pragma unroll
        for (int dt = 0; dt < 4; ++dt) { u32x2 w; w.x = pk2(O[dt][0] * inv, O[dt][1] * inv); w.y = pk2(O[dt][2] * inv, O[dt][3] * inv); *(u32x2*)(orow + 16 * dt + 4 * g4) = w; }
    }
#undef NA_PREFETCH
    __syncthreads();
}
DEVI void unpk8(float* d, const u32x4 q, const float sc) {
    d[0] += sc * __uint_as_float(q.x << 16); d[1] += sc * __uint_as_float(q.x & 0xFFFF0000u); d[2] += sc * __uint_as_float(q.y << 16); d[3] += sc * __uint_as_float(q.y & 0xFFFF0000u);
    d[4] += sc * __uint_as_float(q.z << 16); d[5] += sc * __uint_as_float(q.z & 0xFFFF0000u); d[6] += sc * __uint_as_float(q.w << 16); d[7] += sc * __uint_as_float(q.w & 0xFFFF0000u);
}
DEVI void phase_mixnorm(const bf16_t* oac, const float* lse, const bf16_t* ob, const bf16_t* oc, const float* ga, const float* gb, const float* gc, bf16_t* mix, int bid, int nblk) {
    const int wid = tidx() >> 6, lane = tidx() & 63;
    float gn[16];
    { const float* gp = (lane < 32) ? ga + lane * 16 : (lane < 48) ? gb + (lane - 32) * 16 : gc + (lane - 48) * 16;
#pragma unroll
      for (int i = 0; i < 16; ++i) gn[i] = gp[i]; }
    for (int row = bid * 8 + wid; row < kTok; row += nblk * 8) {
        float v[16];
#pragma unroll
        for (int i = 0; i < 16; ++i) v[i] = 0.f;
        if (lane < 32) {
            const int h = lane >> 2;
            const float l0 = lse[(size_t)row * 8 + h], l1 = lse[((size_t)kTok + row) * 8 + h], l2 = lse[((size_t)2 * kTok + row) * 8 + h];
            const bf16_t* p0 = oac + (size_t)row * 512 + lane * 16; const bf16_t* p1 = p0 + (size_t)kTok * 512; const bf16_t* p2 = p1 + (size_t)kTok * 512;
            const u32x4 a0 = *(const u32x4*)p0, a1 = *(const u32x4*)(p0 + 8), b0 = *(const u32x4*)p1, b1 = *(const u32x4*)(p1 + 8), c0 = *(const u32x4*)p2, c1 = *(const u32x4*)(p2 + 8);
            const float mx = fmaxf(l0, fmaxf(l1, l2)); float w0 = __expf(l0 - mx), w1 = __expf(l1 - mx), w2 = __expf(l2 - mx); const float inv = frcp(w0 + w1 + w2); w0 *= inv; w1 *= inv; w2 *= inv;
            unpk8(v, a0, w0); unpk8(v + 8, a1, w0); unpk8(v, b0, w1); unpk8(v + 8, b1, w1); unpk8(v, c0, w2); unpk8(v + 8, c1, w2);
        } else {
            const bf16_t* p = (lane < 48) ? ob + (size_t)row * 256 + (lane - 32) * 16 : oc + (size_t)row * 256 + (lane - 48) * 16;
            const u32x4 a0 = *(const u32x4*)p, a1 = *(const u32x4*)(p + 8);
            unpk8(v, a0, 1.f); unpk8(v + 8, a1, 1.f);
        }
        float ss = 0.f;
#pragma unroll
        for (int i = 0; i < 16; ++i) ss += v[i] * v[i];
        ss = row_sum16(ss);
        { float a = ss, b = ss; swap16(a, b); if (lane < 32) ss = a + b; }
        const float rstd = rsqrtf(ss * ((lane < 32) ? (1.f / 512.f) : (1.f / 256.f)) + kEps);
        u32x4 w0, w1;
        w0.x = pk2(v[0] * rstd * gn[0], v[1] * rstd * gn[1]); w0.y = pk2(v[2] * rstd * gn[2], v[3] * rstd * gn[3]); w0.z = pk2(v[4] * rstd * gn[4], v[5] * rstd * gn[5]); w0.w = pk2(v[6] * rstd * gn[6], v[7] * rstd * gn[7]);
        w1.x = pk2(v[8] * rstd * gn[8], v[9] * rstd * gn[9]); w1.y = pk2(v[10] * rstd * gn[10], v[11] * rstd * gn[11]); w1.z = pk2(v[12] * rstd * gn[12], v[13] * rstd * gn[13]); w1.w = pk2(v[14] * rstd * gn[14], v[15] * rstd * gn[15]);
        *(u32x4*)(mix + (size_t)row * kD + lane * 16) = w0; *(u32x4*)(mix + (size_t)row * kD + lane * 16 + 8) = w1;
    }
}
DEVI void phase_combine(bf16_t* xb, bf16_t* xbo, float* out32, const bf16_t* y, const float* gate, const int* tokslot, const float* gain_next, bf16_t* h, int bid, int nblk) {
    const int wid = tidx() >> 6, lane = tidx() & 63;
    float g[16];
#pragma unroll
    for (int i = 0; i < 16; ++i) g[i] = gain_next ? gain_next[lane * 16 + i] : 0.f;
    const int stride = nblk * 8;
    int row = bid * 8 + wid;
    u32x4 nv0, nv1; int nts = 0;
    if (row < kTok) { nts = tokslot[(size_t)row * kE + (lane & 15)]; nv0 = *(const u32x4*)(xb + (size_t)row * kD + lane * 16); nv1 = *(const u32x4*)(xb + (size_t)row * kD + lane * 16 + 8); }
    for (; row < kTok; row += stride) {
        const int b = row >> 13;
        const int ts = nts;
        float v[16];
        unpk8s(v, nv0); unpk8s(v + 8, nv1);
        const int nrow = row + stride;
        if (nrow < kTok) { nts = tokslot[(size_t)nrow * kE + (lane & 15)]; nv0 = *(const u32x4*)(xb + (size_t)nrow * kD + lane * 16); nv1 = *(const u32x4*)(xb + (size_t)nrow * kD + lane * 16 + 8); }
#pragma unroll
        for (int e0 = 0; e0 < kE; e0 += 8) {
            u32x4 yv[8]; float gt[8];
#pragma unroll
            for (int e = 0; e < 8; ++e) { const int slot = __builtin_amdgcn_readlane(ts, e0 + e);
                if (slot >= 0) { const size_t r = (size_t)((e0 + e) * kB + b) * kCap + slot; yv[e] = *(const u32x4*)((const unsigned char*)y + r * kD + lane * 16); gt[e] = gate[r]; } }
#pragma unroll
            for (int e = 0; e < 8; ++e) { const int slot = __builtin_amdgcn_readlane(ts, e0 + e);
                if (slot >= 0) { const unsigned ww[4] = {yv[e].x, yv[e].y, yv[e].z, yv[e].w}; const float gs = gt[e] * (1.f / kY8);
#pragma unroll
                    for (int k = 0; k < 4; ++k) { const f32x2 lo = __builtin_amdgcn_cvt_pk_f32_fp8(ww[k], false), hi = __builtin_amdgcn_cvt_pk_f32_fp8(ww[k], true);
                        v[4 * k] += lo.x * gs; v[4 * k + 1] += lo.y * gs; v[4 * k + 2] += hi.x * gs; v[4 * k + 3] += hi.y * gs; } } }
        }
        if (!gain_next) {
#pragma unroll
            for (int k = 0; k < 4; ++k) *(f32x4*)(out32 + (size_t)row * kD + lane * 16 + 4 * k) = (f32x4){v[4 * k], v[4 * k + 1], v[4 * k + 2], v[4 * k + 3]};
        } else {
            u32x4 o0, o1;
            o0.x = pk2(v[0], v[1]); o0.y = pk2(v[2], v[3]); o0.z = pk2(v[4], v[5]); o0.w = pk2(v[6], v[7]); o1.x = pk2(v[8], v[9]); o1.y = pk2(v[10], v[11]); o1.z = pk2(v[12], v[13]); o1.w = pk2(v[14], v[15]);
            *(u32x4*)(xbo + (size_t)row * kD + lane * 16) = o0; *(u32x4*)(xbo + (size_t)row * kD + lane * 16 + 8) = o1;
            unpk8s(v, o0); unpk8s(v + 8, o1);
            float ss = 0.f;
#pragma unroll
            for (int i = 0; i < 16; ++i) ss += v[i] * v[i];
            ss = wave_sum(ss); const float rstd = rsqrtf(ss * (1.f / kD) + kEps);
            u32x4 h0, h1;
            h0.x = pk2(v[0] * rstd * g[0], v[1] * rstd * g[1]); h0.y = pk2(v[2] * rstd * g[2], v[3] * rstd * g[3]); h0.z = pk2(v[4] * rstd * g[4], v[5] * rstd * g[5]); h0.w = pk2(v[6] * rstd * g[6], v[7] * rstd * g[7]);
            h1.x = pk2(v[8] * rstd * g[8], v[9] * rstd * g[9]); h1.y = pk2(v[10] * rstd * g[10], v[11] * rstd * g[11]); h1.z = pk2(v[12] * rstd * g[12], v[13] * rstd * g[13]); h1.w = pk2(v[14] * rstd * g[14], v[15] * rstd * g[15]);
            *(u32x4*)(h + (size_t)row * kD + lane * 16) = h0; *(u32x4*)(h + (size_t)row * kD + lane * 16 + 8) = h1;
        }
    }
}

DEVI void cpow_m(double a, double w, double dt, int m, float& re, float& im) {
    const float mag = __expf((float)m * (float)a * (float)dt);
    const double turns = (double)m * w * dt * 0.15915494309189535; const float ang = (float)((turns - floor(turns)) * 6.283185307179586);
    re = mag * cosf(ang); im = mag * sinf(ang);
}
DEVI void s5_prep_item(const Params& P, int l, int g, unsigned char* lds_) {
    float* pw = (float*)lds_;
    float* bb = pw + 4352;
    float* cc = bb + 4096;
    float* kt = cc + 4096;
    const int tid = tidx();
    __syncthreads();
    for (int i = tid; i < 128; i += kNT) { const int dir = i >> 6, p = i & 63; const size_t pb = (((size_t)l * 2 + dir) * 16 + g) * 64 + p;
        const double dt = (double)__expf(P.s5_log_dt[((size_t)l * 2 + dir) * 16 + g]); const double a = (double)fminf(P.s5_a_re[pb], -1e-4f), w = (double)P.s5_a_im[pb];
        for (int m = 0; m < 17; ++m) { float re, im; cpow_m(a, w, dt, m, re, im); pw[((dir * 64 + p) * 17 + m) * 2] = re; pw[((dir * 64 + p) * 17 + m) * 2 + 1] = im; }
        const float af = (float)a, wf = (float)w, ar = pw[((dir * 64 + p) * 17 + 1) * 2], ai = pw[((dir * 64 + p) * 17 + 1) * 2 + 1];
        const float den = af * af + wf * wf, zr = ar - 1.f, gr = (zr * af + ai * wf) / den, gi = (ai * af - zr * wf) / den;
        for (int c = 0; c < 16; ++c) { const float br = P.s5_b_re[pb * 16 + c], bi = P.s5_b_im[pb * 16 + c]; bb[((dir * 64 + p) * 16 + c) * 2] = gr * br - gi * bi; bb[((dir * 64 + p) * 16 + c) * 2 + 1] = gr * bi + gi * br; }
    }
    for (int i = tid; i < 2048; i += kNT) { const int dir = i >> 10, c = (i >> 6) & 15, p = i & 63; const size_t o = ((((size_t)l * 2 + dir) * 16 + g) * 16 + c) * 64 + p; cc[i * 2] = P.s5_c_re[o]; cc[i * 2 + 1] = P.s5_c_im[o]; }
    __syncthreads();
    for (int i = tid; i < 8192; i += kNT) { const int dir = i >> 12, m = (i >> 8) & 15, c = (i >> 4) & 15, c2 = i & 15; float acc = 0.f;
        for (int p = 0; p < 64; ++p) { const float cr = cc[((dir * 16 + c) * 64 + p) * 2], ci = cc[((dir * 16 + c) * 64 + p) * 2 + 1], wr_ = pw[((dir * 64 + p) * 17 + m) * 2], wi_ = pw[((dir * 64 + p) * 17 + m) * 2 + 1];
            const float br = bb[((dir * 64 + p) * 16 + c2) * 2], bi = bb[((dir * 64 + p) * 16 + c2) * 2 + 1]; const float tr = cr * wr_ - ci * wi_, ti = cr * wi_ + ci * wr_; acc += tr * br - ti * bi; }
        kt[i] = acc; }
    __syncthreads();
    bf16_t* wst = (bf16_t*)(wsp(P) + WS_WST) + ((size_t)l * 16 + g) * 256 * 256;
    bf16_t* wso = (bf16_t*)(wsp(P) + WS_WSO) + ((size_t)l * 16 + g) * 256 * 512;
    for (int id = tid; id < 8192; id += kNT) { const int n = id >> 5, k0 = (id & 31) * 8, dir = n >> 7, p = (n >> 1) & 63, ri = n & 1; float v[8];
#pragma unroll
        for (int kk = 0; kk < 8; ++kk) { const int k = k0 + kk, t = k >> 4, c = k & 15, e = dir ? t : 15 - t; const float wr_ = pw[((dir * 64 + p) * 17 + e) * 2], wi_ = pw[((dir * 64 + p) * 17 + e) * 2 + 1], br = bb[((dir * 64 + p) * 16 + c) * 2], bi = bb[((dir * 64 + p) * 16 + c) * 2 + 1];
            v[kk] = ri ? (wr_ * bi + wi_ * br) : (wr_ * br - wi_ * bi); }
        u32x4 o; o.x = pk2(v[0], v[1]); o.y = pk2(v[2], v[3]); o.z = pk2(v[4], v[5]); o.w = pk2(v[6], v[7]); *(u32x4*)(wst + (size_t)n * 256 + k0) = o; }
    for (int id = tid; id < 16384; id += kNT) { const int ns = id >> 6, k0 = (id & 63) * 8, n = cmap_pk(ns), t = n >> 4, c = n & 15; float v[8];
#pragma unroll
        for (int kk = 0; kk < 8; ++kk) { const int k = k0 + kk; float x;
            if (k < 256) { const int j = k >> 4, c2 = k & 15; x = 0.f; if (j <= t) x += kt[(t - j) * 256 + c * 16 + c2]; if (j >= t) x += kt[4096 + (j - t) * 256 + c * 16 + c2]; if (j == t && c == c2) x += P.s5_d[l * 256 + g * 16 + c]; }
            else { const int q = k - 256, dir = q >> 7, p = (q >> 1) & 63, ri = q & 1, e = dir ? 16 - t : t + 1; const float cr = cc[((dir * 16 + c) * 64 + p) * 2], ci = cc[((dir * 16 + c) * 64 + p) * 2 + 1], wr_ = pw[((dir * 64 + p) * 17 + e) * 2], wi_ = pw[((dir * 64 + p) * 17 + e) * 2 + 1];
                x = ri ? -(cr * wi_ + ci * wr_) : (cr * wr_ - ci * wi_); }
            v[kk] = x; }
        u32x4 o; o.x = pk2(v[0], v[1]); o.y = pk2(v[2], v[3]); o.z = pk2(v[4], v[5]); o.w = pk2(v[6], v[7]); *(u32x4*)(wso + (size_t)ns * 512 + k0) = o; }
    __syncthreads();
}
DEVI void phase_s5_scan(const Params& P, int l, const float* Z, bf16_t* ux, unsigned char* lds_, int bid, int nblk) {
    const int tid = tidx(), wid = tid >> 6, lane = tid & 63;
    float* E = (float*)lds_;
    for (int item = bid; item < 256; item += nblk) {
        const int dir = item & 1, g = (item >> 1) & 15, b = item >> 5;
        const size_t pb = (((size_t)l * 2 + dir) * 16 + g) * 64 + lane;
        const double dt = (double)__expf(P.s5_log_dt[((size_t)l * 2 + dir) * 16 + g]); const double a = (double)fminf(P.s5_a_re[pb], -1e-4f), w = (double)P.s5_a_im[pb];
        float a16r, a16i, Ar, Ai; cpow_m(a, w, dt, 16, a16r, a16i); cpow_m(a, w, dt, 1024, Ar, Ai);
        const int kk0 = dir ? 511 - 64 * wid : 64 * wid; const long sstep = dir ? -1 : 1;
        const float* zp = Z + ((size_t)g * 4096 + b * 512 + kk0) * 256 + dir * 128 + 2 * lane;
        f32x2 z[64];
#pragma unroll
        for (int i = 0; i < 64; ++i) { z[i] = *(const f32x2*)zp; zp += sstep * 256; }
        float xr = 0.f, xi = 0.f;
#pragma unroll
        for (int i = 0; i < 64; ++i) { const float nr = a16r * xr - a16i * xi + z[i].x, ni = a16r * xi + a16i * xr + z[i].y; xr = nr; xi = ni; }
        __syncthreads();
        E[(wid * 64 + lane) * 2] = xr; E[(wid * 64 + lane) * 2 + 1] = xi;
        __syncthreads();
        float sr = 0.f, si = 0.f;
#pragma unroll
        for (int s2 = 0; s2 < 7; ++s2) if (s2 < wid) { const float er = E[(s2 * 64 + lane) * 2], ei = E[(s2 * 64 + lane) * 2 + 1]; const float nr = Ar * sr - Ai * si + er, ni = Ar * si + Ai * sr + ei; sr = nr; si = ni; }
        bf16_t* up = ux + ((size_t)g * 4096 + b * 512 + kk0) * 512 + 256 + dir * 128 + 2 * lane;
#pragma unroll
        for (int i = 0; i < 64; ++i) { *(unsigned*)up = pk2(sr, si); up += sstep * 512;
            const float nr = a16r * sr - a16i * si + z[i].x, ni = a16r * si + a16i * sr + z[i].y; sr = nr; si = ni; }
    }
    __syncthreads();
}
struct EpiF32N {
    static constexpr int VMOPS = 32;
    float* z; int ldz;
    DEVI void operator()(const f32x4 (&acc)[2][2][4][2], const Unit& u, int wr, int wc, int fr, int fq) const {
#pragma unroll
        for (int ai = 0; ai < 2; ++ai)
#pragma unroll
            for (int m = 0; m < 4; ++m) { const size_t ro = (size_t)(u.pm * 256 + 128 * ai + 64 * wr + 16 * m + fr) * ldz + u.pn * 256 + 32 * wc + 4 * fq;
#pragma unroll
                for (int bj = 0; bj < 2; ++bj)
#pragma unroll
                    for (int n = 0; n < 2; ++n) *(f32x4*)(z + ro + 128 * bj + 16 * n) = acc[ai][bj][m][n]; }
    }
};
struct EpiS5Out {
    static constexpr int VMOPS = 16;
    bf16_t* G;
    DEVI void operator()(const f32x4 (&acc)[2][2][4][2], const Unit& u, int wr, int wc, int fr, int fq) const {
#pragma unroll
        for (int ai = 0; ai < 2; ++ai)
#pragma unroll
            for (int m = 0; m < 4; ++m) { const int R = u.pm * 256 + 128 * ai + 64 * wr + 16 * m + fr, g = R >> 12, ck = R & 4095;
#pragma unroll
                for (int bj = 0; bj < 2; ++bj) { const int t = 8 * bj + 2 * wc + (fq >> 1), c0 = 8 * (fq & 1);
                    const f32x4 v0 = acc[ai][bj][m][0], v1 = acc[ai][bj][m][1];
                    u32x4 w; w.x = pk2(gelu_tanh(v0.x), gelu_tanh(v0.y)); w.y = pk2(gelu_tanh(v0.z), gelu_tanh(v0.w)); w.z = pk2(gelu_tanh(v1.x), gelu_tanh(v1.y)); w.w = pk2(gelu_tanh(v1.z), gelu_tanh(v1.w));
                    *(u32x4*)(G + ((size_t)ck * 16 + t) * 256 + g * 16 + c0) = w; } }
    }
};
#define XB_TMO      128
#define XB_XCNT(j)  (256  + 64 * (j))
#define XB_XSUB(j)  (1280 + 64 * (j))
#define XB_XGEN(j)  (2304 + 64 * (j))
#define XB_TOP      3328
#define XB_TOPGEN   3392
#define XCD_BAR_WORDS 3456
#define XB_SPIN_CAP (1u << 26)
DEVI unsigned xb_ld(unsigned* p)              { return __hip_atomic_load(p, __ATOMIC_RELAXED, __HIP_MEMORY_SCOPE_AGENT); }
DEVI unsigned xb_add(unsigned* p, unsigned v) { return __hip_atomic_fetch_add(p, v, __ATOMIC_RELAXED, __HIP_MEMORY_SCOPE_AGENT); }
DEVI unsigned xb_xcc_id() { return (unsigned)__builtin_amdgcn_s_getreg((3 << 11) | 20) & 0xFu; }
#define XB_SPIN(cond, bar) do { unsigned _sp = 0; while (cond) { __builtin_amdgcn_s_sleep(1); \
    if ((++_sp & 255u) == 0u) { if (xb_ld(&(bar)[XB_TMO])) break; if (_sp > XB_SPIN_CAP) { atomicAdd(&(bar)[XB_TMO], 1u); break; } } } } while (0)
struct XcdBarrier { unsigned* bar; unsigned x; volatile LAS unsigned* st; };
DEVI XcdBarrier xcd_barrier_post(unsigned* bar, volatile LAS unsigned* st) {
    XcdBarrier b; b.bar = bar; b.x = xb_xcc_id(); b.st = st;
    if (threadIdx.x == 0) (void)xb_add(&bar[XB_XCNT(b.x)], 1u);
    return b;
}
DEVI void xcd_barrier_complete(unsigned* bar, unsigned x, unsigned& nloc, unsigned& nx) {
    const unsigned G = gridDim.x * gridDim.y * gridDim.z;
    unsigned sum, cnt, mine, sp = 0u;
    for (;;) {
        sum = 0u; cnt = 0u; mine = 0u;
#pragma unroll
        for (unsigned j = 0; j < 16; ++j) { const unsigned c = xb_ld(&bar[XB_XCNT(j)]); sum += c; cnt += (c > 0u) ? 1u : 0u; mine = (j == x) ? c : mine; }
        if (sum == G) break;
        __builtin_amdgcn_s_sleep(1);
        if ((++sp & 255u) == 0u) { if (xb_ld(&bar[XB_TMO])) break; if (sp > XB_SPIN_CAP) { atomicAdd(&bar[XB_TMO], 1u); break; } }
    }
    nloc = mine > 0u ? mine : 1u; nx = cnt > 0u ? cnt : 1u;
}
DEVI void xcd_barrier(const XcdBarrier& b) {
    asm volatile("s_waitcnt vmcnt(0)" ::: "memory");
    __syncthreads();
    if (threadIdx.x == 0) {
        unsigned long long bp_ = (unsigned long long)b.bar; asm volatile("" : "+s"(bp_));
        unsigned* bar = (unsigned*)bp_;
        const unsigned bx = xb_xcc_id();
        __builtin_amdgcn_s_waitcnt(0);
        unsigned nloc = b.st[0], nx = b.st[1];
        if (nloc == 0u) { xcd_barrier_complete(bar, bx, nloc, nx); b.st[0] = nloc; b.st[1] = nx; }
        const unsigned old = xb_add(&bar[XB_XSUB(bx)], 1u);
        const unsigned gen = old / nloc;
        if (old + 1u == (gen + 1u) * nloc) {
            __builtin_amdgcn_fence(__ATOMIC_RELEASE, "agent");
            asm volatile("s_waitcnt vmcnt(0)" ::: "memory");
            const unsigned og = xb_add(&bar[XB_TOP], 1u);
            const unsigned tg = og / nx;
            if (og + 1u == (tg + 1u) * nx) xb_add(&bar[XB_TOPGEN], 1u);
            else XB_SPIN(xb_ld(&bar[XB_TOPGEN]) == tg, bar);
            __builtin_amdgcn_fence(__ATOMIC_ACQUIRE, "agent");
            xb_add(&bar[XB_XGEN(bx)], 1u);
            asm volatile("s_waitcnt vmcnt(0)" ::: "memory");
        } else {
            XB_SPIN(xb_ld(&bar[XB_XGEN(bx)]) == gen, bar);
            __builtin_amdgcn_fence(__ATOMIC_ACQUIRE, "agent");
            asm volatile("s_waitcnt vmcnt(0)" ::: "memory");
        }
    }
    __syncthreads();
}

constexpr int LDS_BYTES = 147456 + 8192 + 16;
#define GEMM_RUN(g, E) gemm_engine<decltype(E), true, true>((LAS unsigned char*)dyn_lds, g, E, bid, nblk)
#define GEMM_RUN8(g, E) gemm_engine<decltype(E), true, true, true>((LAS unsigned char*)dyn_lds, g, E, bid, nblk)
extern __shared__ __attribute__((aligned(16))) unsigned char dyn_lds[];

DEVI GemmD mk_gemm(const bf16_t* A, const bf16_t* Bt, int lda, int K, int nM, int nN, const int* rowidx, size_t bstride, int pmg) {
    GemmD g; g.A = A; g.Bt = Bt; g.lda = lda; g.K = K; g.nM = nM; g.nN = nN; g.rowidx = rowidx; g.bstride = bstride; g.pmg = pmg; return g; }

DEVI void ph_win(const Params& P, int l, int bid, int nblk) {
    const GemmD g = mk_gemm((const bf16_t*)(wsp(P) + WS_H), (const bf16_t*)(wsp(P) + WS_WINT) + (size_t)l * kINW * kD, kD, kD, kTok / 256, 10, nullptr, 0, 1 << 30);
    unsigned char* r1 = wsp(P) + WS_R1;
    EpiQKV E; E.qa = (bf16_t*)(r1 + R1_QA); E.ka = (bf16_t*)(r1 + R1_KA); E.va = (bf16_t*)(r1 + R1_VA); E.qb = (bf16_t*)(r1 + R1_QB); E.kb = (bf16_t*)(r1 + R1_KB); E.vb = (bf16_t*)(r1 + R1_VB); E.ux = (bf16_t*)(r1 + R1_UX);
    { LAS float* tab = (LAS float*)((LAS unsigned char*)dyn_lds + 131072);
      const int t = tidx();
      if (t < 320) { const int r = t >> 6, c = t & 63; tab[t] = (r == 0) ? P.q_norm_a[l * 64 + c] : (r == 1) ? P.k_norm_a[l * 64 + c] : (r == 2) ? P.q_norm_b[l * 64 + c] : (r == 3) ? P.k_norm_b[l * 64 + c] : 1.f; }
      __syncthreads();
      E.gtab = tab; }
    GEMM_RUN(g, E);
}
DEVI void ph_dilated(const Params& P, int l, int bid, int nblk) { unsigned char* r1 = wsp(P) + WS_R1;
    phase_dilated((const bf16_t*)(r1 + R1_QA), (const bf16_t*)(r1 + R1_KA), (const bf16_t*)(r1 + R1_VA), P.q_norm_a + l * 64, P.k_norm_a + l * 64, (bf16_t*)(wsp(P) + WS_R2), (float*)(wsp(P) + WS_LSE), (LAS unsigned char*)dyn_lds, bid, nblk);
}
DEVI void ph_na(const Params& P, int l, int bid, int nblk) { unsigned char* r1 = wsp(P) + WS_R1;
    phase_na((const bf16_t*)(r1 + R1_QB), (const bf16_t*)(r1 + R1_KB), (const bf16_t*)(r1 + R1_VB), P.rpb + (size_t)l * 4 * 15 * 31, P.q_norm_b + l * 64, P.k_norm_b + l * 64, (bf16_t*)(r1 + R1_OB), (LAS unsigned char*)dyn_lds, bid, nblk);
}
DEVI void ph_s5_prep(const Params& P, unsigned char* lds, int bid, int nblk) { for (int it = bid; it < kL * 16; it += nblk) s5_prep_item(P, it >> 4, it & 15, lds); }
DEVI void ph_s5_state(const Params& P, int l, int bid, int nblk) {
    const GemmD g = mk_gemm((const bf16_t*)(wsp(P) + WS_R1 + R1_UX), (const bf16_t*)(wsp(P) + WS_WST) + (size_t)l * 16 * 256 * 256, 512, 256, 256, 1, nullptr, (size_t)256 * 256, 16);
    EpiF32N E; E.z = (float*)(wsp(P) + WS_R2 + R2_Z); E.ldz = 256;
    GEMM_RUN(g, E);
}
DEVI void ph_s5_scan(const Params& P, int l, unsigned char* lds, int bid, int nblk) { phase_s5_scan(P, l, (const float*)(wsp(P) + WS_R2 + R2_Z), (bf16_t*)(wsp(P) + WS_R1 + R1_UX), lds, bid, nblk); }
DEVI void ph_s5_out(const Params& P, int l, int bid, int nblk) {
    const GemmD g = mk_gemm((const bf16_t*)(wsp(P) + WS_R1 + R1_UX), (const bf16_t*)(wsp(P) + WS_WSO) + (size_t)l * 16 * 256 * 512, 512, 512, 256, 1, nullptr, (size_t)256 * 512, 16);
    EpiS5Out E; E.G = (bf16_t*)(wsp(P) + WS_R1 + R1_G);
    GEMM_RUN(g, E);
}
DEVI void ph_glu(const Params& P, int l, int bid, int nblk) {
    const GemmD g = mk_gemm((const bf16_t*)(wsp(P) + WS_R1 + R1_G), (const bf16_t*)(wsp(P) + WS_WGLUT) + (size_t)l * 256 * 256, 256, 256, kTok / 256, 1, nullptr, 0, 1 << 30);
    EpiGlu E; E.g = (const bf16_t*)(wsp(P) + WS_R1 + R1_G); E.oc = (bf16_t*)(wsp(P) + WS_R1 + R1_OC);
    GEMM_RUN(g, E);
}
DEVI void ph_mixnorm(const Params& P, int l, int bid, int nblk) { unsigned char* r1 = wsp(P) + WS_R1;
    phase_mixnorm((const bf16_t*)(wsp(P) + WS_R2), (const float*)(wsp(P) + WS_LSE), (const bf16_t*)(r1 + R1_OB), (const bf16_t*)(r1 + R1_OC), P.out_norm_a + l * 512, P.out_norm_b + l * 256, P.out_norm_c + l * 256, (bf16_t*)(wsp(P) + WS_H), bid, nblk); }
DEVI void ph_wout(const Params& P, int l, int bid, int nblk) {
    const GemmD g = mk_gemm((const bf16_t*)(wsp(P) + WS_H), (const bf16_t*)(wsp(P) + WS_WOUTT) + (size_t)l * kD * kD, kD, kD, kTok / 256, 4, nullptr, 0, 1 << 30);
    EpiResid E; E.x32 = (l == 0) ? P.x : nullptr; E.xb = (bf16_t*)(wsp(P) + WS_XB); E.xbo = E.xb;
    GEMM_RUN(g, E);
}
DEVI void ph_router(const Params& P, int l, unsigned char* lds, int bid, int nblk) { phase_router((const bf16_t*)(wsp(P) + WS_XB), P.ffn_norm + (size_t)l * kD, P.w_router + (size_t)l * kD * kE, (bf16_t*)(wsp(P) + WS_H), (float*)(wsp(P) + WS_AFF), lds, bid, nblk); }
DEVI void ph_topk(const Params& P, unsigned char* lds, int bid, int nblk) { phase_topk((const float*)(wsp(P) + WS_AFF), (int*)(wsp(P) + WS_IDX), (float*)(wsp(P) + WS_GATE), (int*)(wsp(P) + WS_TSLOT), wsp(P) + WS_H, wsp(P) + WS_R2, kD, lds, bid, nblk); }
DEVI void ph_gu(const Params& P, int l, int bid, int nblk) {
    const GemmD g = mk_gemm((const bf16_t*)(wsp(P) + WS_R2), (const bf16_t*)(wsp(P) + WS_WGUT + (size_t)l * kE * 4096 * kD), kD, kD, 512, 16, nullptr, (size_t)4096 * kD, 32);
    EpiGU E; E.hid = (bf16_t*)(wsp(P) + WS_R1); E.sc = 1.f / kW8;
    GEMM_RUN8(g, E);
}
DEVI void ph_down(const Params& P, int l, int bid, int nblk) {
    const GemmD g = mk_gemm((const bf16_t*)(wsp(P) + WS_R1), (const bf16_t*)(wsp(P) + WS_WDT + (size_t)l * kE * kD * kFF), kFF, kFF, 512, 4, nullptr, (size_t)kD * kFF, 32);
    EpiDown E; E.y = (bf16_t*)(wsp(P) + WS_R2); E.sc = 1.f / (kW8 * kH8);
    GEMM_RUN8(g, E);
}
DEVI void ph_combine(const Params& P, int l, int bid, int nblk) { phase_combine((bf16_t*)(wsp(P) + WS_XB), (bf16_t*)(wsp(P) + WS_XB), P.out, (const bf16_t*)(wsp(P) + WS_R2), (const float*)(wsp(P) + WS_GATE), (const int*)(wsp(P) + WS_TSLOT), (l + 1 < kL) ? P.attn_norm + (size_t)(l + 1) * kD : nullptr, (bf16_t*)(wsp(P) + WS_H), bid, nblk); }

__global__ void __launch_bounds__(kNT, 2) mega_fwd(Params P) {
    volatile LAS unsigned* st = (volatile LAS unsigned*)(dyn_lds + LDS_BYTES - 16);
    if (threadIdx.x == 0) { st[0] = 0u; st[1] = 0u; st[2] = 0u; st[3] = 0u; }
    __syncthreads();
    const XcdBarrier bar = xcd_barrier_post((unsigned*)(P.ws + WS_CTL), st);
    const int bid = blockIdx.x, nblk = gridDim.x;
    unsigned char* lds = dyn_lds;
    phase_convert(P, lds, lnd(bid), nblk);
    ph_s5_prep(P, lds, lnd(bid), nblk);
    phase_norm(P.x, P.attn_norm, (bf16_t*)(wsp(P) + WS_H), lnd(bid), nblk);
    xcd_barrier(bar);
#pragma unroll 1
    for (int l = 0; l < kL; ++l) {
        ph_win(P, l, lnd(bid), nblk);             xcd_barrier(bar);
        ph_s5_state(P, l, lnd(bid), nblk);        xcd_barrier(bar);
        ph_s5_scan(P, l, lds, lnd(bid), nblk);
        ph_dilated(P, l, lnd(bid), nblk);
        ph_na(P, l, lnd(bid), nblk);              xcd_barrier(bar);
        ph_s5_out(P, l, lnd(bid), nblk);          xcd_barrier(bar);
        ph_glu(P, l, lnd(bid), nblk);             xcd_barrier(bar);
        ph_mixnorm(P, l, lnd(bid), nblk);         xcd_barrier(bar);
        ph_wout(P, l, lnd(bid), nblk);            xcd_barrier(bar);
        ph_router(P, l, lds, lnd(bid), nblk);     xcd_barrier(bar);
        ph_topk(P, lds, lnd(bid), nblk);          xcd_barrier(bar);
        ph_gu(P, l, lnd(bid), nblk);              xcd_barrier(bar);
        ph_down(P, l, lnd(bid), nblk);            xcd_barrier(bar);
        ph_combine(P, l, lnd(bid), nblk);         xcd_barrier(bar);
    }
}

extern "C" void kernel_launch(void* const* d_in, const int* in_sizes, int n_in, void* d_out, int out_size, void* d_ws, size_t ws_size, hipStream_t stream) {
    (void)in_sizes; (void)n_in; (void)out_size;
    if (ws_size < WS_END) { fprintf(stderr, "workspace too small: %zu < %zu\n", ws_size, (size_t)WS_END); return; }
    Params P{};
    const float** pp = (const float**)&P;
    for (int i = 0; i < 26; ++i) pp[i] = (const float*)d_in[i];
    P.out = (float*)d_out; P.ws = (unsigned char*)d_ws;
    static int grid = 0;
    if (!grid) {
        int dev = 0, cus = 0, per_cu = 0;
        (void)hipGetDevice(&dev);
        (void)hipDeviceGetAttribute(&cus, hipDeviceAttributeMultiprocessorCount, dev);
        (void)hipFuncSetAttribute((const void*)mega_fwd, hipFuncAttributeMaxDynamicSharedMemorySize, LDS_BYTES);
        (void)hipOccupancyMaxActiveBlocksPerMultiprocessor(&per_cu, (const void*)mega_fwd, kNT, LDS_BYTES);
        grid = (per_cu >= 1) ? cus : 0;
        if (!grid) fprintf(stderr, "mega_fwd does not fit a CU\n");
    }
    if (!grid) return;
    (void)hipMemsetAsync(P.ws + WS_CTL, 0, XCD_BAR_WORDS * sizeof(unsigned), stream);
    mega_fwd<<<grid, kNT, LDS_BYTES, stream>>>(P);
}
```

```cpp
#include <hip/hip_runtime.h>
#include <stdint.h>
#include <stdio.h>

#define DEVI __device__ __forceinline__
#define LAS __attribute__((address_space(3)))
typedef unsigned short bf16_t;
typedef short bf16x8 __attribute__((ext_vector_type(8)));
typedef float f32x4 __attribute__((ext_vector_type(4)));
typedef float f32x2 __attribute__((ext_vector_type(2)));
typedef unsigned u32x4 __attribute__((ext_vector_type(4)));
typedef unsigned u32x2 __attribute__((ext_vector_type(2)));

constexpr int kB = 8, kS = 8192, kD = 1024, kL = 4, kTok = kB * kS;
constexpr int kINW = 2560;
constexpr int kE = 16, kCap = 1024, kFF = 2048;
constexpr int kNT = 512;
constexpr float kEps = 1e-6f;
constexpr float kLog2e = 1.4426950408889634f, kLn2 = 0.6931471805599453f;

constexpr size_t MiB = 1024ull * 1024ull;
constexpr size_t WS_CTL   = 0;
constexpr size_t WS_RSTD  = 512 * 1024;
constexpr size_t WS_WINT  = 1 * MiB;
constexpr size_t WS_WOUTT = WS_WINT + 20 * MiB;
constexpr size_t WS_WGLUT = WS_WOUTT + 8 * MiB;
constexpr size_t WS_RTAB  = WS_WGLUT + 512 * 1024;
constexpr size_t WS_WGUT  = WS_WGLUT + 1 * MiB;
constexpr size_t WS_WDT   = WS_WGUT + 512 * MiB;
constexpr size_t WS_H     = WS_WDT + 256 * MiB;
constexpr size_t WS_R1    = WS_H + 128 * MiB;
constexpr size_t WS_R2    = WS_R1 + 512 * MiB;
constexpr size_t WS_AFF   = WS_R2 + 256 * MiB;
constexpr size_t WS_IDX   = WS_AFF + 4 * MiB;
constexpr size_t WS_GATE  = WS_IDX + 1 * MiB;
constexpr size_t WS_TSLOT = WS_GATE + 1 * MiB;
constexpr size_t WS_LSE   = WS_TSLOT + 4 * MiB;
constexpr size_t WS_WST   = WS_LSE + 8 * MiB;
constexpr size_t WS_WSO   = WS_WST + 8 * MiB;
constexpr size_t WS_XB    = WS_WSO + 16 * MiB;
constexpr size_t WS_END   = WS_XB + 128 * MiB;
constexpr size_t R2_Z     = 192 * MiB;
constexpr size_t R1_QA = 0, R1_KA = 64 * MiB, R1_VA = 128 * MiB, R1_QB = 192 * MiB, R1_KB = 224 * MiB, R1_VB = 256 * MiB,
                 R1_UX = 288 * MiB, R1_OB = 352 * MiB, R1_OC = 384 * MiB, R1_G = 416 * MiB;

struct Params {
    const float* x; const float* attn_norm; const float* w_in; const float* q_norm_a; const float* k_norm_a; const float* q_norm_b; const float* k_norm_b;
    const float* rpb; const float* s5_a_re; const float* s5_a_im; const float* s5_log_dt; const float* s5_b_re; const float* s5_b_im; const float* s5_c_re; const float* s5_c_im;
    const float* s5_d; const float* w_glu; const float* out_norm_a; const float* out_norm_b; const float* out_norm_c; const float* w_out; const float* ffn_norm;
    const float* w_router; const float* w_gate; const float* w_up; const float* w_down;
    float* out; unsigned char* ws;
};

DEVI float bf2f(bf16_t b) { return __uint_as_float(((unsigned)b) << 16); }
DEVI bf16_t f2bf(float f) { unsigned u = __float_as_uint(f); u += 0x7FFFu + ((u >> 16) & 1u); return (bf16_t)(u >> 16); }
typedef __bf16 bf16x2_t __attribute__((ext_vector_type(2)));
DEVI unsigned pk2(float lo, float hi) { const f32x2 v = {lo, hi}; return __builtin_bit_cast(unsigned, __builtin_convertvector(v, bf16x2_t)); }
DEVI int tidx() { int t = threadIdx.x; asm volatile("" : "+v"(t)); return t; }
#define GAS __attribute__((address_space(1)))
DEVI unsigned char* wsp(const Params& P) { unsigned long long a = (unsigned long long)P.ws; asm volatile("" : "+s"(a)); return (unsigned char*)(GAS unsigned char*)a; }
DEVI int lnd(int v) { asm volatile("" : "+s"(v)); return v; }
template <int CTRL> DEVI float dppf(float v) { return __builtin_bit_cast(float, __builtin_amdgcn_update_dpp(0, __builtin_bit_cast(int, v), CTRL, 0xF, 0xF, true)); }
DEVI void swap16(float& a, float& b) { asm volatile("s_nop 1\n\tv_permlane16_swap_b32 %0, %1" : "+v"(a), "+v"(b)); }
DEVI void swap32(float& a, float& b) { asm volatile("s_nop 1\n\tv_permlane32_swap_b32 %0, %1" : "+v"(a), "+v"(b)); }
DEVI void swap16u(unsigned& a, unsigned& b) { asm volatile("s_nop 1\n\tv_permlane16_swap_b32 %0, %1" : "+v"(a), "+v"(b)); }
DEVI float xsum16(float v) { float a = v, b = v; swap16(a, b); return a + b; }
DEVI float xsum32(float v) { float a = v, b = v; swap32(a, b); return a + b; }
DEVI float xmax16(float v) { float a = v, b = v; swap16(a, b); return fmaxf(a, b); }
DEVI float xmax32(float v) { float a = v, b = v; swap32(a, b); return fmaxf(a, b); }
DEVI float row_sum16(float v) {
    v += dppf<0xB1>(v); v += dppf<0x4E>(v);
    v += dppf<0x141>(v); v += dppf<0x140>(v);
    return v;
}
DEVI float wave_sum(float v) { return xsum32(xsum16(row_sum16(v))); }
DEVI void unpk8s(float* d, const u32x4 q) {
    d[0] = __uint_as_float(q.x << 16); d[1] = __uint_as_float(q.x & 0xFFFF0000u); d[2] = __uint_as_float(q.y << 16); d[3] = __uint_as_float(q.y & 0xFFFF0000u);
    d[4] = __uint_as_float(q.z << 16); d[5] = __uint_as_float(q.z & 0xFFFF0000u); d[6] = __uint_as_float(q.w << 16); d[7] = __uint_as_float(q.w & 0xFFFF0000u);
}
DEVI float frcp(float x) { return __builtin_amdgcn_rcpf(x); }
DEVI float gelu_tanh(float y) { const float z = 0.7978845608028654f * (y + 0.044715f * y * y * y); const float t = 1.f - 2.f * frcp(1.f + __expf(2.f * z)); return 0.5f * y * (1.f + t); }

constexpr float kY8 = 32.f;
constexpr float kW8 = 64.f, kH8 = 8.f;
DEVI unsigned pk4_fp8(float a, float b, float c, float d) { unsigned w = 0u; w = __builtin_amdgcn_cvt_pk_fp8_f32(a, b, w, false); w = __builtin_amdgcn_cvt_pk_fp8_f32(c, d, w, true); return w; }
DEVI int cmap_head(int cs) { const int bj = cs >> 7, wc = (cs >> 5) & 3, n = (cs >> 4) & 1, fq = (cs >> 2) & 3, j = cs & 3; return 64 * wc + 32 * bj + 8 * fq + 4 * n + j; }
DEVI int cmap_pk(int cs)   { const int bj = cs >> 7, wc = (cs >> 5) & 3, n = (cs >> 4) & 1, fq = (cs >> 2) & 3, j = cs & 3; return 128 * bj + 32 * wc + 8 * fq + 4 * n + j; }
DEVI int cmap_gu(int cs)   { const int wc = (cs >> 5) & 3, n = (cs >> 4) & 1, fq = (cs >> 2) & 3, j = cs & 3; return 32 * wc + 8 * fq + 4 * n + j; }

template <int MODE>
DEVI void convert_item(const float* W0, const float* W1, int ldw, int K, bf16_t* Bt, int kt, int pn, unsigned char* lds) {
    bf16_t* t = (bf16_t*)lds;
    const int tid = tidx(), cs = tid & 255, kh = tid >> 8;
    int col;
    if (MODE == 0) col = pn * 256 + cs; else if (MODE == 1) col = pn * 256 + cmap_head(cs); else if (MODE == 2) col = pn * 256 + cmap_pk(cs); else col = pn * 128 + cmap_gu(cs);
    const float* src = ((MODE == 3 && (cs >> 7)) ? W1 : W0) + (size_t)(kt * 64 + 32 * kh) * ldw + col;
    float v[32];
#pragma unroll
    for (int i = 0; i < 32; ++i) v[i] = src[(size_t)i * ldw];
    if (MODE == 1) {
#pragma unroll
        for (int i = 0; i < 32; ++i) v[i] *= W1[kt * 64 + 32 * kh + i];
    }
#pragma unroll
    for (int q = 0; q < 4; ++q) { u32x4 w; w.x = pk2(v[8 * q], v[8 * q + 1]); w.y = pk2(v[8 * q + 2], v[8 * q + 3]); w.z = pk2(v[8 * q + 4], v[8 * q + 5]); w.w = pk2(v[8 * q + 6], v[8 * q + 7]);
        *(u32x4*)(t + cs * 72 + 32 * kh + 8 * q) = w; }
    __syncthreads();
#pragma unroll
    for (int it = 0; it < 4; ++it) {
        const int c = it * kNT + tid, row = c >> 3, part = c & 7;
        const u32x4 vv = *(const u32x4*)(t + row * 72 + part * 8);
        *(u32x4*)(Bt + (size_t)(pn * 256 + row) * K + kt * 64 + part * 8) = vv;
    }
    __syncthreads();
}

template <int MODE>
DEVI void convert_item8(const float* W0, const float* W1, int ldw, int K, unsigned char* Bt, int kt, int pn, unsigned char* lds) {
    unsigned char* t = lds;
    const int tid = tidx(), cs = tid & 255, kh = tid >> 8;
    const int col = (MODE == 2) ? pn * 256 + cmap_pk(cs) : pn * 128 + cmap_gu(cs);
    const float* src = ((MODE == 3 && (cs >> 7)) ? W1 : W0) + (size_t)(kt * 128 + 64 * kh) * ldw + col;
    float v[64];
#pragma unroll
    for (int i = 0; i < 64; ++i) v[i] = src[(size_t)i * ldw];
#pragma unroll
    for (int q = 0; q < 4; ++q) { u32x4 w;
        w.x = pk4_fp8(v[16 * q] * kW8, v[16 * q + 1] * kW8, v[16 * q + 2] * kW8, v[16 * q + 3] * kW8); w.y = pk4_fp8(v[16 * q + 4] * kW8, v[16 * q + 5] * kW8, v[16 * q + 6] * kW8, v[16 * q + 7] * kW8);
        w.z = pk4_fp8(v[16 * q + 8] * kW8, v[16 * q + 9] * kW8, v[16 * q + 10] * kW8, v[16 * q + 11] * kW8); w.w = pk4_fp8(v[16 * q + 12] * kW8, v[16 * q + 13] * kW8, v[16 * q + 14] * kW8, v[16 * q + 15] * kW8);
        *(u32x4*)(t + cs * 144 + 64 * kh + 16 * q) = w; }
    __syncthreads();
#pragma unroll
    for (int it = 0; it < 4; ++it) {
        const int c = it * kNT + tid, row = c >> 3, part = c & 7;
        const u32x4 vv = *(const u32x4*)(t + row * 144 + part * 16);
        *(u32x4*)(Bt + (size_t)(pn * 256 + row) * K + kt * 128 + part * 16) = vv;
    }
    __syncthreads();
}

DEVI void phase_convert(const Params& P, unsigned char* lds, int bid, int nblk) {
    constexpr int N_WIN = kL * 16 * 10, N_WOUT = kL * 16 * 4, N_WGLU = kL * 4 * 1, N_WGU = kL * kE * 8 * 16, N_WD = kL * kE * 16 * 4;
    constexpr int TOT = N_WIN + N_WOUT + N_WGLU + N_WGU + N_WD;
    for (int it = bid; it < TOT; it += nblk) {
        int i = it;
        if (i < N_WIN) { const int l = i / 160, r = i % 160, kt = r / 10, pn = r % 10;
            convert_item<1>(P.w_in + (size_t)l * kD * kINW, P.attn_norm + (size_t)l * kD, kINW, kD, (bf16_t*)(wsp(P) + WS_WINT) + (size_t)l * kINW * kD, kt, pn, lds); continue; }
        i -= N_WIN;
        if (i < N_WOUT) { const int l = i / 64, r = i % 64, kt = r / 4, pn = r % 4;
            convert_item<2>(P.w_out + (size_t)l * kD * kD, nullptr, kD, kD, (bf16_t*)(wsp(P) + WS_WOUTT) + (size_t)l * kD * kD, kt, pn, lds); continue; }
        i -= N_WOUT;
        if (i < N_WGLU) { const int l = i / 4, kt = i % 4;
            convert_item<2>(P.w_glu + (size_t)l * 256 * 256, nullptr, 256, 256, (bf16_t*)(wsp(P) + WS_WGLUT) + (size_t)l * 256 * 256, kt, 0, lds); continue; }
        i -= N_WGLU;
        if (i < N_WGU) { const int le = i / 128, r = i % 128, kt = r / 16, pn = r % 16;
            convert_item8<3>(P.w_gate + (size_t)le * kD * kFF, P.w_up + (size_t)le * kD * kFF, kFF, kD, wsp(P) + WS_WGUT + (size_t)le * 4096 * kD, kt, pn, lds); continue; }
        i -= N_WGU;
        { const int le = i / 64, r = i % 64, kt = r / 4, pn = r % 4;
            convert_item8<2>(P.w_down + (size_t)le * kFF * kD, nullptr, kD, kFF, wsp(P) + WS_WDT + (size_t)le * kD * kFF, kt, pn, lds); }
    }
}

DEVI void phase_norm(const float* x, bf16_t* xb, float* rstdp, int bid, int nblk) {
    const int wid = tidx() >> 6, lane = tidx() & 63;
    for (int row = bid * 8 + wid; row < kTok; row += nblk * 8) {
        f32x4 v[4]; float ss = 0.f;
#pragma unroll
        for (int q = 0; q < 4; ++q) { v[q] = *(const f32x4*)(x + (size_t)row * kD + q * 256 + lane * 4); ss += v[q].x * v[q].x + v[q].y * v[q].y + v[q].z * v[q].z + v[q].w * v[q].w; }
        ss = wave_sum(ss);
        if (lane == 0) rstdp[row] = rsqrtf(ss * (1.f / kD) + kEps);
#pragma unroll
        for (int q = 0; q < 4; ++q) { const f32x4 t = v[q];
            u32x2 o; o.x = pk2(t.x, t.y); o.y = pk2(t.z, t.w);
            *(u32x2*)(xb + (size_t)row * kD + q * 256 + lane * 4) = o; }
    }
}

DEVI void router_prep(const Params& P, int bid, int nblk) {
    unsigned char* tbase = wsp(P) + WS_RTAB;
    for (int i = bid * kNT + tidx(); i < kL * 2048; i += nblk * kNT) {
        const int L = i >> 11, s = (i >> 6) & 31, l = i & 63, e = l & 15, k0 = 64 * (s >> 1) + 16 * (l >> 4) + 8 * (s & 1);
        const float* wr = P.w_router + (size_t)L * kD * kE; const float* gain = P.ffn_norm + (size_t)L * kD;
        unsigned hh[4], ll[4];
#pragma unroll
        for (int j = 0; j < 4; ++j) { const float w0 = wr[(k0 + 2 * j) * 16 + e] * gain[k0 + 2 * j], w1 = wr[(k0 + 2 * j + 1) * 16 + e] * gain[k0 + 2 * j + 1];
            const unsigned hp = pk2(w0, w1); hh[j] = hp; ll[j] = pk2(w0 - __uint_as_float(hp << 16), w1 - __uint_as_float(hp & 0xFFFF0000u)); }
        u32x4 hi, lo; hi.x = hh[0]; hi.y = hh[1]; hi.z = hh[2]; hi.w = hh[3]; lo.x = ll[0]; lo.y = ll[1]; lo.z = ll[2]; lo.w = ll[3];
        unsigned char* tb = tbase + (size_t)L * 65536;
        *(u32x4*)(tb + (2 * s) * 1024 + l * 16) = hi; *(u32x4*)(tb + (2 * s + 1) * 1024 + l * 16) = lo;
    }
}
DEVI void phase_router(const bf16_t* x, const float* gain, const unsigned char* rtab  , unsigned char* h8, float* aff, LAS unsigned char* lds, int bid, int nblk) {
    LAS unsigned char* wtab = lds;
    LAS float* gtab = (LAS float*)(lds + 65536);
    const int tid = tidx(), wid = __builtin_amdgcn_readfirstlane(tid >> 6), lane = tid & 63, r = lane & 15, c4 = lane >> 4;
    __syncthreads();
    for (int i = tid; i < 1024; i += kNT) gtab[i] = gain[i];
#pragma unroll
    for (int i = 0; i < 8; ++i)
        __builtin_amdgcn_global_load_lds((const unsigned*)(rtab + (size_t)(i * kNT + tid) * 16), (LAS unsigned*)(wtab + (i * 8 + wid) * 1024), 16, 0, 0);
    asm volatile("s_waitcnt vmcnt(0)" ::: "memory");
    __syncthreads();
    u32x4 xr[32];
    const int ntile = kTok / 16, tstride = nblk * 8;
    int tile = bid * 8 + wid;
#define RT_ISSUE(half, tile_) do { const bf16_t* xp_ = x + (size_t)((tile_) * 16 + r) * kD + 16 * c4; \
        _Pragma("unroll") for (int u = 8 * (half); u < 8 * (half) + 8; ++u) { xr[2 * u] = *(const u32x4*)(xp_ + 64 * u); xr[2 * u + 1] = *(const u32x4*)(xp_ + 64 * u + 8); } } while (0)
    if (tile < ntile) { RT_ISSUE(0, tile); RT_ISSUE(1, tile); }
    for (; tile < ntile; tile += tstride) {
        asm volatile("" ::: "memory");
        f32x4 Lh = {0.f, 0.f, 0.f, 0.f}, Ll = {0.f, 0.f, 0.f, 0.f}, G = {0.f, 0.f, 0.f, 0.f};
#pragma unroll
        for (int s = 0; s < 32; ++s) {
            const bf16x8 wh = *(const LAS bf16x8*)(wtab + (2 * s) * 1024 + lane * 16), wl = *(const LAS bf16x8*)(wtab + (2 * s + 1) * 1024 + lane * 16);
            const bf16x8 xb = __builtin_bit_cast(bf16x8, xr[s]);
            Lh = __builtin_amdgcn_mfma_f32_16x16x32_bf16(wh, xb, Lh, 0, 0, 0);
            Ll = __builtin_amdgcn_mfma_f32_16x16x32_bf16(wl, xb, Ll, 0, 0, 0);
            G = __builtin_amdgcn_mfma_f32_16x16x32_bf16(xb, xb, G, 0, 0, 0);
        }
        const float dsel = ((r & 3) == 0) ? G.x : ((r & 3) == 1) ? G.y : ((r & 3) == 2) ? G.z : G.w;
        const float ss = __builtin_bit_cast(float, __builtin_amdgcn_ds_bpermute((16 * (r >> 2) + r) * 4, __builtin_bit_cast(int, dsel)));
        const float rstd = rsqrtf(ss * (1.f / kD) + kEps);
        const f32x4 lg = (Lh + Ll) * rstd;
        float mx = fmaxf(fmaxf(lg.x, lg.y), fmaxf(lg.z, lg.w)); mx = xmax32(xmax16(mx));
        f32x4 ex; ex.x = __expf(lg.x - mx); ex.y = __expf(lg.y - mx); ex.z = __expf(lg.z - mx); ex.w = __expf(lg.w - mx);
        float sm = (ex.x + ex.y) + (ex.z + ex.w); sm = xsum32(xsum16(sm));
        const float inv = frcp(sm);
        const int row0 = tile * 16, b = row0 >> 13, s0 = (row0 & (kS - 1)) + r;
        { float* ap = aff + ((size_t)(b * kE + 4 * c4)) * kS + s0;
          ap[0] = ex.x * inv; ap[kS] = ex.y * inv; ap[2 * kS] = ex.z * inv; ap[3 * kS] = ex.w * inv; }
        unsigned char* hp = h8 + (size_t)(row0 + r) * kD + 16 * c4;
        const int ntl = tile + tstride;
#pragma unroll
        for (int half = 0; half < 2; ++half) {
#pragma unroll
            for (int u = 8 * half; u < 8 * half + 8; ++u) {
                float v[16]; unpk8s(v, xr[2 * u]); unpk8s(v + 8, xr[2 * u + 1]);
                u32x4 o; unsigned ow[4];
#pragma unroll
                for (int q = 0; q < 4; ++q) { const f32x4 gq = *(const LAS f32x4*)(gtab + 64 * u + 16 * c4 + 4 * q);
                    const f32x4 t = (f32x4){v[4 * q], v[4 * q + 1], v[4 * q + 2], v[4 * q + 3]} * gq * rstd;
                    ow[q] = pk4_fp8(t.x, t.y, t.z, t.w); }
                o.x = ow[0]; o.y = ow[1]; o.z = ow[2]; o.w = ow[3];
                *(u32x4*)(hp + 64 * u) = o;
            }
            if (ntl < ntile) { if (half == 0) RT_ISSUE(0, ntl); else RT_ISSUE(1, ntl); }
        }
    }
#undef RT_ISSUE
    __syncthreads();
}

DEVI int block_excl_scan(int v, int* sh  , int& total) {
    const int lane = tidx() & 63, wid = tidx() >> 6;
    int incl = v;
#pragma unroll
    for (int d = 1; d < 64; d <<= 1) { const int o = __shfl_up(incl, d); if (lane >= d) incl += o; }
    __syncthreads();
    if (lane == 63) sh[wid] = incl;
    __syncthreads();
    int base = 0, tot = 0;
#pragma unroll
    for (int w = 0; w < 8; ++w) { const int c = sh[w]; if (w < wid) base += c; tot += c; }
    total = tot;
    return base + incl - v;
}

DEVI void phase_topk(const float* aff, int* idx, float* gate, int* tokslot, const unsigned char* hsrc, unsigned char* xe, int rowbytes, unsigned char* lds, int bid, int nblk) {
    int* hist = (int*)lds;
    int* sh = hist + 256;
    int* res = sh + 16;
    (void)hsrc; (void)xe; (void)rowbytes;
    const int tid = tidx(), lane = tid & 63, wid = tid >> 6;
    const int share = (nblk >= 2 * kB * kE) ? 2 : 1;
    for (int wi = bid; wi < kB * kE * share; wi += nblk) {
        const int item = wi / share, part = wi - item * share;
        const int b = item >> 4, e = item & 15;
        const float* a = aff + (size_t)item * kS;
        unsigned key[16];
#pragma unroll
        for (int q = 0; q < 4; ++q) { const u32x4 v = *(const u32x4*)(a + tid * 16 + q * 4); key[q * 4 + 0] = v.x; key[q * 4 + 1] = v.y; key[q * 4 + 2] = v.z; key[q * 4 + 3] = v.w; }
        unsigned prefix = 0; int kk = kCap;
#pragma unroll 1
        for (int pass = 0; pass < 4; ++pass) {
            const int shift = 24 - 8 * pass;
            __syncthreads();
            if (tid < 256) hist[tid] = 0;
            __syncthreads();
#pragma unroll
            for (int i = 0; i < 16; ++i) { const bool in = (pass == 0) || ((key[i] >> (shift + 8)) == prefix); if (in) atomicAdd(&hist[(key[i] >> shift) & 255], 1); }
            __syncthreads();
            if (wid == 0) {
                int c[4], loc = 0;
#pragma unroll
                for (int j = 0; j < 4; ++j) { c[j] = hist[255 - 4 * lane - j]; loc += c[j]; }
                int incl = loc;
#pragma unroll
                for (int d = 1; d < 64; d <<= 1) { const int o = __shfl_up(incl, d); if (lane >= d) incl += o; }
                const int excl = incl - loc;
                if (excl < kk && kk <= incl) { int run = excl; int bin = 0, nk = 0; bool found = false;
#pragma unroll
                    for (int j = 0; j < 4; ++j) { if (!found && run + c[j] >= kk) { bin = 255 - 4 * lane - j; nk = kk - run; found = true; } if (!found) run += c[j]; }
                    res[0] = bin; res[1] = nk; }
            }
            __syncthreads();
            prefix = (prefix << 8) | (unsigned)res[0]; kk = res[1];
        }
        const unsigned T = prefix;
        int ceq = 0;
#pragma unroll
        for (int i = 0; i < 16; ++i) ceq += (key[i] == T) ? 1 : 0;
        int tot;
        int eqb = block_excl_scan(ceq, sh, tot);
        int csel = 0; unsigned selmask = 0;
#pragma unroll
        for (int i = 0; i < 16; ++i) { bool s = key[i] > T; if (key[i] == T) { s = eqb < kk; ++eqb; } if (s) { selmask |= 1u << i; ++csel; } }
        int slot = block_excl_scan(csel, sh, tot);
        const size_t rbase = (size_t)(e * kB + b) * kCap;
#pragma unroll
        for (int i = 0; i < 16; ++i) { const int s = tid * 16 + i; const bool sel = (selmask >> i) & 1u;
            const bool mine = (share == 1) || ((i >> 3) == part);
            if (sel && mine) { idx[rbase + slot] = b * kS + s; gate[rbase + slot] = __uint_as_float(key[i]) * (1.f / kY8)  ; }
            if (mine) tokslot[((size_t)(b * kS + s)) * kE + e] = sel ? slot : -1;
            if (sel) ++slot; }
    }
    __syncthreads();
}

struct Unit { int pm, pn, par; };
DEVI bool unit_of(int Lid, int nM, int nN, Unit& u) {
    const int nwg = nM * nN; if (Lid >= nwg) return false;
    int wgid = Lid; { const int q = nwg / 8, r = nwg % 8, xcd = wgid % 8, off = wgid / 8; wgid = (xcd < r ? xcd * (q + 1) : r * (q + 1) + (xcd - r) * q) + off; }
    const int nig = 8 * nN, gid = wgid / nig, fm = gid * 8, gsz = (nM - fm) < 8 ? (nM - fm) : 8;
    u.pm = fm + ((wgid % nig) % gsz); u.pn = (wgid % nig) / gsz; return true;
}
struct GemmD { const bf16_t* A; const bf16_t* Bt; int lda, K, nM, nN; const int* rowidx; size_t bstride; int pmg; };

constexpr int PG_HTB = 128 * 64 * 2;
DEVI int pg_lds_byte(int r, int c) { const int st = (r >> 4) * 2 + (c >> 5), rr = r & 15, cc = c & 31, ob = rr * 64 + cc * 2; return st * 1024 + (ob ^ (((ob >> 9) & 1) << 5)); }
DEVI void pg_stage_rc(int b, int& R, int& C) { const int st = b / 1024, sb = b % 1024, swz = sb ^ (((sb >> 9) & 1) << 5); R = (st >> 1) * 16 + swz / 64; C = (st & 1) * 32 + (swz % 64) / 2; }

typedef int v4i __attribute__((ext_vector_type(4)));
typedef int v8i __attribute__((ext_vector_type(8)));
constexpr int PG_RIDX = 131072 + 4096;
template <class Epi, bool ALIGN_EPI, bool SP2, bool FP8 = false, bool GATHER = false>
DEVI void gemm_engine(LAS unsigned char* lds, const GemmD g, const Epi& E, int bid, int nblk) {
    const int tid = tidx(), wid = __builtin_amdgcn_readfirstlane(tid >> 6), lane = tid & 63, wr = wid >> 2, wc = wid & 3, fr = lane & 15, fq = lane >> 4;
    constexpr int ES = FP8 ? 1 : 2;
    const int K = g.K * ES  , nt = K / 128; const unsigned ldaB = (unsigned)g.lda * ES;
    unsigned voffA[2], voffB[2];
#pragma unroll
    for (int i = 0; i < 2; ++i) { int R, C; pg_stage_rc(tid * 16 + i * 8192, R, C); voffA[i] = (unsigned)R * ldaB + (unsigned)C * 2u; voffB[i] = (unsigned)(R * K + C * 2); }
    const size_t kstep = 128;
    int gR0 = 0; unsigned gcb = 0; { int R, C; pg_stage_rc(tid * 16, R, C); gR0 = R; gcb = (unsigned)C * 2u; } (void)gR0; (void)gcb;
    const size_t hstepB = (size_t)128 * K, hstepA = (size_t)128 * ldaB, tstepA = 2 * hstepA;
    const unsigned ldsw = (unsigned)wid * 1024u;
    const int aoff = pg_lds_byte(wr * 64 + fr, fq * 8), boff = pg_lds_byte(wc * 32 + fr, fq * 8);
#define PG8_SA(b, h) (((b) * 2 + (h)) * PG_HTB)
#define PG8_SB(b, h) ((4 + (b) * 2 + (h)) * PG_HTB)
#define PG8_STAGE(bufoff, gbase, voff) do { _Pragma("unroll") for (int _i = 0; _i < 2; ++_i) \
        __builtin_amdgcn_global_load_lds((const unsigned*)((const char*)(gbase) + (voff)[_i]), (LAS unsigned*)(lds + (bufoff) + ldsw + _i * 8192), 16, 0, 0); } while (0)
#define PG8_STA(bufoff, ptr, koff, half, par) do { if constexpr (GATHER) { \
        const LAS int* rt_ = (const LAS int*)(lds + PG_RIDX + (par) * 1024) + 128 * (half) + gR0; \
        _Pragma("unroll") for (int _i = 0; _i < 2; ++_i) { const unsigned off_ = (unsigned)rt_[64 * _i] * ldaB + gcb; \
            __builtin_amdgcn_global_load_lds((const unsigned*)((const char*)g.A + (koff) + off_), (LAS unsigned*)(lds + (bufoff) + ldsw + _i * 8192), 16, 0, 0); } \
    } else PG8_STAGE(bufoff, ptr, voffA); } while (0)
#define PG8_RD16(off) (*(const LAS v4i*)(lds + (off)))
#define PG8_CAT2(off) __builtin_shufflevector(PG8_RD16(off), PG8_RD16((off) + 1024), 0, 1, 2, 3, 4, 5, 6, 7)
#define PG8_LDA(dst, b, h) do { _Pragma("unroll") for (int m = 0; m < 4; ++m) { if constexpr (FP8) dst##8[m] = PG8_CAT2(PG8_SA(b, h) + aoff + m * 2048); \
        else { _Pragma("unroll") for (int k = 0; k < 2; ++k) dst[m][k] = *(const LAS bf16x8*)(lds + PG8_SA(b, h) + aoff + m * 2048 + k * 1024); } } } while (0)
#define PG8_LDB(dst, b, h) do { _Pragma("unroll") for (int n = 0; n < 2; ++n) { if constexpr (FP8) dst##8[n] = PG8_CAT2(PG8_SB(b, h) + boff + n * 2048); \
        else { _Pragma("unroll") for (int k = 0; k < 2; ++k) dst[n][k] = *(const LAS bf16x8*)(lds + PG8_SB(b, h) + boff + n * 2048 + k * 1024); } } } while (0)
#define PG8_MMA(ai, bj, At, Bt) do { __builtin_amdgcn_s_setprio(1); _Pragma("unroll") for (int m = 0; m < 4; ++m) _Pragma("unroll") for (int n = 0; n < 2; ++n) { \
        if constexpr (FP8) asm volatile("v_mfma_f32_16x16x128_f8f6f4 %0, %1, %2, %0" : "+v"(acc[ai][bj][m][n]) : "v"(Bt##8[n]), "v"(At##8[m]));   \
        else { _Pragma("unroll") for (int k = 0; k < 2; ++k) acc[ai][bj][m][n] = __builtin_amdgcn_mfma_f32_16x16x32_bf16(Bt[n][k], At[m][k], acc[ai][bj][m][n], 0, 0, 0); } } \
        __builtin_amdgcn_s_setprio(0); } while (0)
#define PG8_MMAZ(ai, bj, At, Bt) do { __builtin_amdgcn_s_setprio(1); _Pragma("unroll") for (int m = 0; m < 4; ++m) _Pragma("unroll") for (int n = 0; n < 2; ++n) { \
        if constexpr (FP8) asm volatile("v_mfma_f32_16x16x128_f8f6f4 %0, %1, %2, 0" : "=&v"(acc[ai][bj][m][n]) : "v"(Bt##8[n]), "v"(At##8[m])); \
        else { asm volatile("v_mfma_f32_16x16x32_bf16 %0, %1, %2, 0" : "=&v"(acc[ai][bj][m][n]) : "v"(Bt[n][0]), "v"(At[m][0])); \
               acc[ai][bj][m][n] = __builtin_amdgcn_mfma_f32_16x16x32_bf16(Bt[n][1], At[m][1], acc[ai][bj][m][n], 0, 0, 0); } } \
        __builtin_amdgcn_s_setprio(0); } while (0)
#define PG8_WAIT_V(n) asm volatile("s_waitcnt vmcnt(" #n ")" ::: "memory")
#define PG8_WAIT_L(n) asm volatile("s_waitcnt lgkmcnt(" #n ")" ::: "memory")
#define PG8_BAR __builtin_amdgcn_s_barrier()
#define PG8_SCHED __builtin_amdgcn_sched_barrier(0)
    Unit cur, nxt; int ui = 0;
    if (!unit_of(bid, g.nM, g.nN, cur)) return;
    cur.par = 0; E.stage(lds, cur, wid, lane);
    if constexpr (GATHER) {
        if (wid < 4) __builtin_amdgcn_global_load_lds((const unsigned*)(g.rowidx + cur.pm * 256 + wid * 64 + lane), (LAS unsigned*)(lds + PG_RIDX + wid * 256), 4, 0, 0);
        asm volatile("s_waitcnt vmcnt(0)" ::: "memory"); __builtin_amdgcn_s_barrier();
    }
    f32x4 acc[2][2][4][2];
    if constexpr (!FP8) {
#pragma unroll
    for (int a = 0; a < 2; ++a)
#pragma unroll
        for (int b = 0; b < 2; ++b)
#pragma unroll
            for (int m = 0; m < 4; ++m)
#pragma unroll
                for (int n = 0; n < 2; ++n) acc[a][b][m][n] = (f32x4){0.f, 0.f, 0.f, 0.f};
    }
    bf16x8 At[4][2], B0[2][2], B1[2][2]; v8i At8[4], B08[2], B18[2];
    (void)At; (void)B0; (void)B1; (void)At8; (void)B08; (void)B18;
    static_assert(SP2, "only the two-super-phase K-loop is kept");
    const char* cA = (const char*)g.A + (size_t)cur.pm * tstepA;
    const char* cB = (const char*)g.Bt + (size_t)(cur.pm / g.pmg) * g.bstride * ES + (size_t)cur.pn * 256 * K;
    PG8_STAGE(PG8_SB(0, 0), cB, voffB); PG8_STAGE(PG8_SB(0, 1), cB + hstepB, voffB); PG8_STA(PG8_SA(0, 0), cA, 0u, 0, 0); PG8_STA(PG8_SA(0, 1), cA + hstepA, 0u, 1, 0);
    if (wr == 1) PG8_BAR;
    PG8_WAIT_V(2); PG8_BAR;
    PG8_STAGE(PG8_SB(1, 0), cB + kstep, voffB); PG8_STA(PG8_SA(1, 0), cA + kstep, 128u, 0, 0); PG8_STAGE(PG8_SB(1, 1), cB + hstepB + kstep, voffB);
    PG8_WAIT_V(6); PG8_BAR;
    for (;;) {
        const bool has_next = unit_of((ui + 1) * nblk + bid, g.nM, g.nN, nxt); nxt.par = (ui + 1) & 1;
        if constexpr (GATHER) { if (has_next && wid < 4) __builtin_amdgcn_global_load_lds((const unsigned*)(g.rowidx + nxt.pm * 256 + wid * 64 + lane), (LAS unsigned*)(lds + PG_RIDX + nxt.par * 1024 + wid * 256), 4, 0, 0); }
        const char* nA = has_next ? (const char*)g.A + (size_t)nxt.pm * tstepA : cA;
        const char* nB = has_next ? (const char*)g.Bt + (size_t)(nxt.pm / g.pmg) * g.bstride * ES + (size_t)nxt.pn * 256 * K : cB;
#define PG8_TRIP(MM) do { \
            const bool last = (t == nt - 2); \
            const char* a1 = cA + (size_t)(t + 1) * kstep; \
            const char* a2 = last ? nA : cA + (size_t)(t + 2) * kstep; const char* b2 = last ? nB : cB + (size_t)(t + 2) * kstep; \
            const char* a3 = a2 + kstep; const char* b3 = b2 + kstep; \
            const unsigned gk1 = (unsigned)(t + 1) * 128u, gk2 = last ? 0u : (unsigned)(t + 2) * 128u, gk3 = gk2 + 128u; const int gp2 = (last && has_next) ? nxt.par : cur.par; (void)gk1; (void)gk2; (void)gk3; (void)gp2; \
            PG8_LDB(B0, 0, 0); PG8_LDB(B1, 0, 1); PG8_SCHED; PG8_LDA(At, 0, 0); PG8_STA(PG8_SA(1, 1), a1 + hstepA, gk1, 1, cur.par); \
            PG8_WAIT_V(8); PG8_WAIT_L(0); PG8_BAR; MM(0, 0, At, B0); MM(0, 1, At, B1); PG8_BAR; PG8_SCHED; \
            PG8_LDA(At, 0, 1); PG8_STAGE(PG8_SB(0, 0), b2, voffB); PG8_STAGE(PG8_SB(0, 1), b2 + hstepB, voffB); PG8_STA(PG8_SA(0, 0), a2, gk2, 0, gp2); \
            PG8_WAIT_V(8); PG8_WAIT_L(0); PG8_BAR; MM(1, 0, At, B0); MM(1, 1, At, B1); PG8_BAR; PG8_SCHED; \
            PG8_LDB(B0, 1, 0); PG8_LDB(B1, 1, 1); PG8_SCHED; PG8_LDA(At, 1, 0); PG8_STA(PG8_SA(0, 1), a2 + hstepA, gk2, 1, gp2); \
            PG8_WAIT_V(8); PG8_WAIT_L(0); PG8_BAR; PG8_MMA(0, 0, At, B0); PG8_MMA(0, 1, At, B1); PG8_BAR; PG8_SCHED; \
            PG8_LDA(At, 1, 1); PG8_STAGE(PG8_SB(1, 0), b3, voffB); PG8_STAGE(PG8_SB(1, 1), b3 + hstepB, voffB); PG8_STA(PG8_SA(1, 0), a3, gk3, 0, gp2); \
            PG8_WAIT_V(8); PG8_WAIT_L(0); PG8_BAR; PG8_MMA(1, 0, At, B0); PG8_MMA(1, 1, At, B1); PG8_BAR; PG8_SCHED; } while (0)
        int t = 0;
        if constexpr (FP8) { PG8_TRIP(PG8_MMAZ); t = 2; }
#pragma unroll 1
        for (; t < nt; t += 2) PG8_TRIP(PG8_MMA);
#undef PG8_TRIP
        if constexpr (ALIGN_EPI) { if (wr == 0) PG8_BAR; }
        if constexpr (FP8) asm volatile("s_nop 15\n\ts_nop 15" ::: "memory");
        E(acc, cur, wr, wc, fr, fq);
        if (!has_next) break;
        E.stage(lds, nxt, wid, lane);
        if constexpr (!FP8) {
#pragma unroll
        for (int a = 0; a < 2; ++a)
#pragma unroll
            for (int b = 0; b < 2; ++b)
#pragma unroll
                for (int m = 0; m < 4; ++m)
#pragma unroll
                    for (int n = 0; n < 2; ++n) acc[a][b][m][n] = (f32x4){0.f, 0.f, 0.f, 0.f};
        }
        cur = nxt; cA = nA; cB = nB; ++ui;
        if constexpr (ALIGN_EPI) { if (wr == 1) PG8_BAR; }
    }
    PG8_WAIT_V(0);
    if constexpr (!ALIGN_EPI) { if (wr == 0) PG8_BAR; }
    PG8_BAR;
#undef PG8_SA
#undef PG8_SB
#undef PG8_STAGE
#undef PG8_STA
#undef PG8_LDA
#undef PG8_LDB
#undef PG8_MMA
#undef PG8_MMAZ
#undef PG8_RD16
#undef PG8_CAT2
#undef PG8_WAIT_V
#undef PG8_WAIT_L
#undef PG8_BAR
#undef PG8_SCHED
}

struct EpiQKV {
    static constexpr int VMOPS = 16;
    bf16_t *qa, *ka, *va, *qb, *kb, *vb, *ux;
    const float* rstdp;
    const LAS float* rtab;
    DEVI void stage(LAS unsigned char* lds, const Unit& u, int wid, int lane) const {
        if (wid < 4) __builtin_amdgcn_global_load_lds((const unsigned*)(rstdp + u.pm * 256 + wid * 64 + lane), (LAS unsigned*)(lds + 131072 + 2048 + u.par * 1024 + wid * 256), 4, 0, 0);
    }
    const LAS float* gtab;
    DEVI void operator()(const f32x4 (&acc)[2][2][4][2], const Unit& u, int wr, int wc, int fr, int fq) const {
        const int pn = u.pn;
        bf16_t* dst = (pn < 2) ? qa : (pn < 4) ? ka : (pn < 6) ? va : (pn == 6) ? qb : (pn == 7) ? kb : (pn == 8) ? vb : ux;
        const int H = (pn < 6) ? 8 : 4, head = ((pn < 6) ? (pn & 1) * 4 : 0) + wc;
        const int trow = (pn < 2) ? 0 : (pn < 4) ? 1 : (pn == 6) ? 2 : (pn == 7) ? 3 : 4;
        const bool nrm = trow < 4;
        f32x4 gv[2][2];
#pragma unroll
        for (int bj = 0; bj < 2; ++bj)
#pragma unroll
            for (int n = 0; n < 2; ++n) gv[bj][n] = *(const LAS f32x4*)(gtab + trow * 64 + 32 * bj + 8 * fq + 4 * n);
        const size_t hb = (size_t)head * kS * 64 + 8 * fq;
        const int g0 = 4 * wc + (fq >> 1), c0 = 8 * (fq & 1);
#pragma unroll
        for (int ai = 0; ai < 2; ++ai)
#pragma unroll
            for (int m = 0; m < 4; ++m) {
                const int row = u.pm * 256 + 128 * ai + 64 * wr + 16 * m + fr;
                float ss = 0.f;
#pragma unroll
                for (int bj = 0; bj < 2; ++bj)
#pragma unroll
                    for (int n = 0; n < 2; ++n) { const f32x4 v = acc[ai][bj][m][n]; ss += v.x * v.x + v.y * v.y + v.z * v.z + v.w * v.w; }
                ss = xsum32(xsum16(ss));
                const float rr = rtab[u.par * 256 + 128 * ai + 64 * wr + 16 * m + fr];
                const float rs = __builtin_amdgcn_rsqf(ss * rr * rr * (1.f / 64.f) + kEps) * rr, rstd = nrm ? rs : rr;
                const int b = row >> 13, sq = row & (kS - 1);
                const size_t o_qkv = ((size_t)b * H * kS + sq) * 64 + hb, o_u = ((size_t)g0 * 4096 + (row >> 4)) * 512 + (row & 15) * 16 + c0;
#pragma unroll
                for (int bj = 0; bj < 2; ++bj) {
                    const f32x4 v0 = acc[ai][bj][m][0] * rstd * gv[bj][0], v1 = acc[ai][bj][m][1] * rstd * gv[bj][1];
                    u32x4 w; w.x = pk2(v0.x, v0.y); w.y = pk2(v0.z, v0.w); w.z = pk2(v1.x, v1.y); w.w = pk2(v1.z, v1.w);
                    const size_t o = (pn < 9) ? o_qkv + 32 * bj : o_u + (size_t)bj * 2 * 4096 * 512;
                    *(u32x4*)(dst + o) = w;
                }
            }
    }
};
struct EpiResid {
    DEVI void stage(LAS unsigned char*, const Unit&, int, int) const {}
    static constexpr int VMOPS = 16;
    bf16_t* xb; bf16_t* xbo;
    DEVI void operator()(const f32x4 (&acc)[2][2][4][2], const Unit& u, int wr, int wc, int fr, int fq) const {
#pragma unroll
        for (int ai = 0; ai < 2; ++ai) {
            const size_t r0 = (size_t)(u.pm * 256 + 128 * ai + 64 * wr + fr) * kD + u.pn * 256 + 32 * wc + 8 * fq;
            {
                u32x4 a[4][2];
#pragma unroll
                for (int m = 0; m < 4; ++m)
#pragma unroll
                    for (int bj = 0; bj < 2; ++bj) a[m][bj] = *(const u32x4*)(xb + r0 + (size_t)m * 16 * kD + 128 * bj);
#pragma unroll
                for (int m = 0; m < 4; ++m)
#pragma unroll
                    for (int bj = 0; bj < 2; ++bj) { const size_t o = r0 + (size_t)m * 16 * kD + 128 * bj; const u32x4 w = a[m][bj];
                        const f32x4 v0 = (f32x4){__uint_as_float(w.x << 16), __uint_as_float(w.x & 0xFFFF0000u), __uint_as_float(w.y << 16), __uint_as_float(w.y & 0xFFFF0000u)} + acc[ai][bj][m][0];
                        const f32x4 v1 = (f32x4){__uint_as_float(w.z << 16), __uint_as_float(w.z & 0xFFFF0000u), __uint_as_float(w.w << 16), __uint_as_float(w.w & 0xFFFF0000u)} + acc[ai][bj][m][1];
                        u32x4 r; r.x = pk2(v0.x, v0.y); r.y = pk2(v0.z, v0.w); r.z = pk2(v1.x, v1.y); r.w = pk2(v1.z, v1.w); *(u32x4*)(xbo + o) = r; }
            }
        }
    }
};
struct EpiGU {
    DEVI void stage(LAS unsigned char*, const Unit&, int, int) const {}
    static constexpr int VMOPS = 4;
    bf16_t* hid; float sc;
    DEVI void silu8(const f32x4 (&acc)[2][2][4][2], int ai, int m, float (&o)[8]) const {
        const float k1 = -sc * kLog2e, k3 = 1.f / (sc * sc * kH8);
#pragma unroll
        for (int n = 0; n < 2; ++n)
#pragma unroll
            for (int j = 0; j < 4; j += 2) { const f32x2 a = {acc[ai][0][m][n][j], acc[ai][0][m][n][j + 1]}, b = {acc[ai][1][m][n][j], acc[ai][1][m][n][j + 1]};
                const f32x2 ab = a * b, t = a * k1; f32x2 d; d.x = __builtin_amdgcn_exp2f(t.x); d.y = __builtin_amdgcn_exp2f(t.y); d = d * k3 + k3;
                f32x2 r; r.x = frcp(d.x); r.y = frcp(d.y); const f32x2 v = ab * r;
                o[n * 4 + j] = v.x; o[n * 4 + j + 1] = v.y; }
    }
    DEVI void operator()(const f32x4 (&acc)[2][2][4][2], const Unit& u, int wr, int wc, int fr, int fq) const {
#pragma unroll
        for (int ai = 0; ai < 2; ++ai)
#pragma unroll
            for (int m = 0; m < 4; m += 2) {
                float o0[8], o1[8]; silu8(acc, ai, m, o0); silu8(acc, ai, m + 1, o1);
                unsigned ax = pk4_fp8(o0[0], o0[1], o0[2], o0[3]), ay = pk4_fp8(o0[4], o0[5], o0[6], o0[7]), bx = pk4_fp8(o1[0], o1[1], o1[2], o1[3]), by = pk4_fp8(o1[4], o1[5], o1[6], o1[7]);
                swap16u(ax, bx); swap16u(ay, by);
                const size_t row = (size_t)(u.pm * 256 + 128 * ai + 64 * wr + 16 * (m + (fq & 1)) + fr);
                u32x4 w; w.x = ax; w.y = ay; w.z = bx; w.w = by;
                *(u32x4*)((unsigned char*)hid + row * kFF + u.pn * 128 + 32 * wc + 8 * (fq & ~1)) = w;
            }
    }
};
struct EpiDown {
    DEVI void stage(LAS unsigned char*, const Unit&, int, int) const {}
    static constexpr int VMOPS = 8;
    bf16_t* y; float sc;
    DEVI static unsigned pk4c(const f32x4 v) { return pk4_fp8(v.x, v.y, v.z, v.w); }
    DEVI void operator()(const f32x4 (&acc)[2][2][4][2], const Unit& u, int wr, int wc, int fr, int fq) const {
        const float gv = sc * kY8;
#pragma unroll
        for (int ai = 0; ai < 2; ++ai)
#pragma unroll
            for (int m = 0; m < 4; m += 2)
#pragma unroll
                for (int bj = 0; bj < 2; ++bj) {
                    unsigned ax = pk4c(acc[ai][bj][m][0] * gv), ay = pk4c(acc[ai][bj][m][1] * gv), bx = pk4c(acc[ai][bj][m + 1][0] * gv), by = pk4c(acc[ai][bj][m + 1][1] * gv);
                    swap16u(ax, bx); swap16u(ay, by);
                    const size_t row = (size_t)(u.pm * 256 + 128 * ai + 64 * wr + 16 * (m + (fq & 1)) + fr);
                    u32x4 w; w.x = ax; w.y = ay; w.z = bx; w.w = by;
                    *(u32x4*)((unsigned char*)y + row * kD + u.pn * 256 + 128 * bj + 32 * wc + 8 * (fq & ~1)) = w;
                }
    }
};
struct EpiGlu {
    DEVI void stage(LAS unsigned char*, const Unit&, int, int) const {}
    static constexpr int VMOPS = 16;
    const bf16_t* g; bf16_t* oc;
    DEVI void operator()(const f32x4 (&acc)[2][2][4][2], const Unit& u, int wr, int wc, int fr, int fq) const {
#pragma unroll
        for (int ai = 0; ai < 2; ++ai) {
            const size_t r0 = (size_t)(u.pm * 256 + 128 * ai + 64 * wr + fr) * 256 + 32 * wc + 8 * fq;
            u32x4 gw[4][2];
#pragma unroll
            for (int m = 0; m < 4; ++m)
#pragma unroll
                for (int bj = 0; bj < 2; ++bj) gw[m][bj] = *(const u32x4*)(g + r0 + (size_t)m * 16 * 256 + 128 * bj);
#pragma unroll
            for (int m = 0; m < 4; ++m)
#pragma unroll
                for (int bj = 0; bj < 2; ++bj) { const size_t o = r0 + (size_t)m * 16 * 256 + 128 * bj; float gg[8]; unpk8s(gg, gw[m][bj]); float o8[8];
#pragma unroll
                    for (int n = 0; n < 2; ++n)
#pragma unroll
                        for (int j = 0; j < 4; ++j) o8[n * 4 + j] = gg[n * 4 + j] * frcp(1.f + __expf(-acc[ai][bj][m][n][j]));
                    u32x4 w; w.x = pk2(o8[0], o8[1]); w.y = pk2(o8[2], o8[3]); w.z = pk2(o8[4], o8[5]); w.w = pk2(o8[6], o8[7]);
                    *(u32x4*)(oc + o) = w; }
        }
    }
};

typedef float f32x16 __attribute__((ext_vector_type(16)));
typedef short s16x4 __attribute__((ext_vector_type(4)));
DEVI bf16x8 tr_pair(LAS unsigned char* p0, LAS unsigned char* p1) {
    const s16x4 a = __builtin_amdgcn_ds_read_tr16_b64_v4i16((LAS s16x4*)p0), b = __builtin_amdgcn_ds_read_tr16_b64_v4i16((LAS s16x4*)p1);
    return (bf16x8){a.x, a.y, a.z, a.w, b.x, b.y, b.z, b.w};
}
DEVI void phase_dilated(const bf16_t* qa, const bf16_t* ka, const bf16_t* va, const float* gq, const float* gk, bf16_t* oac, float* lse, LAS unsigned char* lds, int bid, int nblk) {
    const int tid = tidx(), wid = __builtin_amdgcn_readfirstlane(tid >> 6), lane = tid & 63, h5 = lane >> 5, qc = lane & 31;
    LAS unsigned char* Kimg = lds; LAS unsigned char* Vimg = lds + 49152;
    float Mn;
    { float a = fabsf(gq[lane]), b = fabsf(gk[lane]);
#pragma unroll
      for (int m = 32; m >= 1; m >>= 1) { a = fmaxf(a, __shfl_xor(a, m)); b = fmaxf(b, __shfl_xor(b, m)); }
      Mn = 8.f * a * b; }
    const float Mb = Mn * kLog2e;
    unsigned koff[4];
#pragma unroll
    for (int s = 0; s < 4; ++s) koff[s] = (unsigned)((32 * wid + qc) * 128 + (((2 * s + h5) ^ (qc & 7)) << 4));
    unsigned voff[2];
    { const int g = lane >> 4, i16 = lane & 15, q = i16 >> 2, p = i16 & 3;
#pragma unroll
      for (int dt = 0; dt < 2; ++dt) { const int c = (2 * (g & 1) + (p >> 1) + 4 * dt) ^ ((q >> 1) << 2); voff[dt] = (unsigned)((32 * wid + 4 * h5 + q) * 128 + (c << 4) + 8 * (p & 1)); } }
    const float dbase = (float)(4 * h5 - qc);
    u32x4 pK[6], pV[6];
#define DIL_DECODE(unit_) const int c = (unit_) >> 11, rem = (unit_) & 2047, bh = rem >> 5, ub = ((rem & 7) << 2) | ((rem >> 3) & 3);   \
        const int dsh = 2 * c, L = kS >> dsh, upc = 32 >> dsh, cls = ub >> (5 - dsh), u0 = (ub & (upc - 1)) << 8;
#define DIL_PREFETCH(unit_) do { DIL_DECODE(unit_) \
        const bf16_t* kbase = ka + (size_t)bh * kS * 64; const bf16_t* vbase = va + (size_t)bh * kS * 64; \
        _Pragma("unroll") for (int it = 0; it < 6; ++it) { const int id = it * kNT + tid, row = id >> 3, ch = id & 7; \
            int ki = u0 - 64 + row; ki = ki < 0 ? 0 : (ki > L - 1 ? L - 1 : ki); const size_t tok = (size_t)((ki << dsh) + cls); \
            pK[it] = *(const u32x4*)(kbase + tok * 64 + ch * 8); pV[it] = *(const u32x4*)(vbase + tok * 64 + ch * 8); } } while (0)
    if (bid < 6144) DIL_PREFETCH(bid);
    for (int unit = bid; unit < 6144; unit += nblk) {
        DIL_DECODE(unit)
        const int q0 = u0 + 32 * wid, qtok = ((q0 + qc) << dsh) + cls;
        bf16x8 Qf[4];
#pragma unroll
        for (int s = 0; s < 4; ++s) Qf[s] = *(const bf16x8*)(qa + ((size_t)bh * kS + qtok) * 64 + 16 * s + 8 * h5);
        __syncthreads();
#pragma unroll
        for (int it = 0; it < 6; ++it) { const int id = it * kNT + tid, row = id >> 3, ch = id & 7;
            *(LAS u32x4*)(Kimg + row * 128 + ((ch ^ (row & 7)) << 4)) = pK[it];
            *(LAS u32x4*)(Vimg + row * 128 + ((ch ^ (((row >> 1) & 1) << 2)) << 4)) = pV[it]; }
        __syncthreads();
        if (unit + nblk < 6144) DIL_PREFETCH(unit + nblk);
        const float slope = exp2f(-(float)((bh & 7) + 1));
        const float c2 = slope * (float)(1 << dsh) * kLog2e;
        float sum = 0.f;
        f32x16 O[2];
#pragma unroll
        for (int dt = 0; dt < 2; ++dt)
#pragma unroll
            for (int i = 0; i < 16; ++i) O[dt][i] = 0.f;
        const float ndb = -dbase;
#define DIL_QK(dst, kt_) do { { const int kp0_ = q0 - 64 + 32 * (kt_); const float tm_ = (kp0_ >= 0 && kp0_ < L) ? 0.f : -1e30f; \
            const float cs_ = ((kt_) < 2) ? c2 : -c2, c0_ = (((kt_) == 0 || (kt_) == 4) ? -64.f : ((kt_) == 2 ? 0.f : -32.f)) * c2 - Mb + tm_; \
            const float bt_ = dbase * cs_ + c0_; \
            _Pragma("unroll") for (int i = 0; i < 16; i += 2) { const float k0 = (float)((i & 3) + 8 * (i >> 2)), k1 = (float)(((i + 1) & 3) + 8 * ((i + 1) >> 2)); f32x2 t; \
                if ((kt_) == 2) { const f32x2 d = {fabsf(dbase + k0), fabsf(dbase + k1)}; t = d * cs_ + c0_; } else t = (f32x2){k0, k1} * cs_ + bt_; \
                dst[i] = t.x; dst[i + 1] = t.y; } } \
            _Pragma("unroll") for (int s = 0; s < 4; ++s) { const bf16x8 Kf = *(const LAS bf16x8*)(Kimg + koff[s] + (kt_) * 4096); dst = __builtin_amdgcn_mfma_f32_32x32x16_bf16(Kf, Qf[s], dst, 0, 0, 0); } } while (0)
        f32x16 S, Sn;
        DIL_QK(S, 0);
        f32x2 sum2 = {0.f, 0.f};
#pragma unroll
        for (int kt = 0; kt < 5; ++kt) {
            if (kt < 4) DIL_QK(Sn, kt + 1);
#pragma unroll
            for (int i = 0; i < 16; i += 2) {
                const float k0 = (float)((i & 3) + 8 * (i >> 2)), k1 = (float)(((i + 1) & 3) + 8 * ((i + 1) >> 2));
                f32x2 sv = (f32x2){S[i], S[i + 1]};
                if (kt == 0) { sv.x = (k0 >= ndb) ? sv.x : -1e30f; sv.y = (k1 >= ndb) ? sv.y : -1e30f; }
                if (kt == 4) { sv.x = (k0 <= ndb) ? sv.x : -1e30f; sv.y = (k1 <= ndb) ? sv.y : -1e30f; }
                f32x2 pv; pv.x = __builtin_amdgcn_exp2f(sv.x); pv.y = __builtin_amdgcn_exp2f(sv.y);
                S[i] = pv.x; S[i + 1] = pv.y; sum2 += pv;
            }
#pragma unroll
            for (int s2 = 0; s2 < 2; ++s2) {
                u32x4 pw; pw.x = pk2(S[8 * s2 + 0], S[8 * s2 + 1]); pw.y = pk2(S[8 * s2 + 2], S[8 * s2 + 3]); pw.z = pk2(S[8 * s2 + 4], S[8 * s2 + 5]); pw.w = pk2(S[8 * s2 + 6], S[8 * s2 + 7]);
                const bf16x8 Pf = __builtin_bit_cast(bf16x8, pw);
#pragma unroll
                for (int dt = 0; dt < 2; ++dt) { LAS unsigned char* vp = Vimg + voff[dt] + kt * 4096 + s2 * 2048;
                    const bf16x8 Vf = tr_pair(vp, vp + 1024);
                    O[dt] = __builtin_amdgcn_mfma_f32_32x32x16_bf16(Vf, Pf, O[dt], 0, 0, 0); }
            }
            if (kt < 4) S = Sn;
        }
#undef DIL_QK
        sum = sum2.x + sum2.y;
        sum = xsum32(sum);
        const float inv = 1.f / sum;
        const size_t tok = (size_t)(bh >> 3) * kS + qtok;
        {
        LAS unsigned char* ost = lds + 98304 + wid * 4096;
#pragma unroll
        for (int dt = 0; dt < 2; ++dt)
#pragma unroll
            for (int g4 = 0; g4 < 4; ++g4) { u32x2 w; w.x = pk2(O[dt][4 * g4] * inv, O[dt][4 * g4 + 1] * inv); w.y = pk2(O[dt][4 * g4 + 2] * inv, O[dt][4 * g4 + 3] * inv);
                *(LAS u32x2*)(ost + qc * 128 + (((4 * dt + g4) ^ (qc & 7)) << 4) + 8 * h5) = w; }
        if (h5 == 0) lse[((size_t)c * kTok + tok) * 8 + (bh & 7)] = Mn + __logf(sum);
        bf16_t* obase = oac + ((size_t)c * kTok + (size_t)(bh >> 3) * kS) * 512 + (bh & 7) * 64;
#pragma unroll
        for (int it = 0; it < 4; ++it) { const int r = it * 8 + (lane >> 3), ch = lane & 7;
            const u32x4 v = *(const LAS u32x4*)(ost + r * 128 + ((ch ^ (r & 7)) << 4));
            const size_t t2 = (size_t)(((q0 + r) << dsh) + cls);
            *(u32x4*)(obase + t2 * 512 + ch * 8) = v; }
        }
    }
#undef DIL_DECODE
#undef DIL_PREFETCH
    __syncthreads();
}
DEVI void phase_na(const bf16_t* qb, const bf16_t* kb, const bf16_t* vb, const float* rpb  , const float* gq, const float* gk, bf16_t* ob, LAS unsigned char* lds, int bid, int nblk) {
    const int tid = tidx(), wid = __builtin_amdgcn_readfirstlane(tid >> 6), lane = tid & 63, g4 = lane >> 4, i16 = lane & 15;
    LAS unsigned char* Kimg = lds; LAS unsigned char* Vimg = lds + 73728; LAS float* tab = (LAS float*)(lds + 147456);
    __syncthreads();
    for (int i = tid; i < 4 * 465; i += kNT) tab[i] = rpb[i];
    float Mq;
    { float a = fabsf(gq[lane]), b = fabsf(gk[lane]);
#pragma unroll
      for (int m = 32; m >= 1; m >>= 1) { a = fmaxf(a, __shfl_xor(a, m)); b = fmaxf(b, __shfl_xor(b, m)); }
      Mq = 8.f * a * b; }
    __syncthreads();
    if (wid < 4) { float m = 0.f; for (int i = lane; i < 465; i += 64) m = fmaxf(m, fabsf(tab[wid * 465 + i]));
#pragma unroll
        for (int k = 32; k >= 1; k >>= 1) m = fmaxf(m, __shfl_xor(m, k));
        if (lane == 0) tab[1860 + wid] = m; }
    __syncthreads();
    const int g = wid & 3, kcs = (16 * g - 8) < 0 ? 0 : ((16 * g - 8) > 32 ? 32 : (16 * g - 8));
    const int qcol = 16 * g + i16, cs = (qcol - 8) < 0 ? 0 : ((qcol - 8) > 48 ? 48 : (qcol - 8));
    unsigned kswz[2];
#pragma unroll
    for (int s = 0; s < 2; ++s) kswz[s] = (unsigned)(((4 * s + g4) ^ (i16 & 7)) << 4);
    const int q = i16 >> 2, p = i16 & 3, sw = 2 * (g4 & 1) + (q >> 1);
    unsigned vsw[4];
#pragma unroll
    for (int dt = 0; dt < 4; ++dt) vsw[dt] = (unsigned)((((2 * dt + (p >> 1)) ^ (sw << 1)) << 4) + 8 * (p & 1));
    const int scol = tid >> 3, sch = tid & 7;
    const unsigned skoff = (unsigned)(scol * 128 + ((sch ^ (scol & 7)) << 4)), svoff = (unsigned)(scol * 128 + ((sch ^ (((scol >> 1) & 3) << 1)) << 4));
    u32x4 pK[2], pV[2];
    for (int run = bid; run < 256; run += nblk) {
      const int bh = run >> 3, h = bh & 3;
      const bf16_t* kbase = kb + (size_t)bh * kS * 64 + scol * 64 + sch * 8; const bf16_t* vbase = vb + (size_t)bh * kS * 64 + scol * 64 + sch * 8;
#pragma unroll 1
      for (int j = 0; j < 8; ++j) {
        const int rp = (run & 7) * 8 + j, r0 = 2 * rp;
        const int rsA = (r0 - 4) < 0 ? 0 : ((r0 - 4) > 120 ? 120 : (r0 - 4));
        const int prsA = (r0 - 6) < 0 ? 0 : ((r0 - 6) > 120 ? 120 : (r0 - 6));
        const int rr = r0 + (wid >> 2);
        const int rs = (rr - 4) < 0 ? 0 : ((rr - 4) > 120 ? 120 : (rr - 4));
        const int qtok = rr * 64 + qcol;
        bf16x8 Qf[2];
#pragma unroll
        for (int s = 0; s < 2; ++s) Qf[s] = *(const bf16x8*)(qb + ((size_t)bh * kS + qtok) * 64 + 32 * s + 8 * g4);
        __syncthreads();
        if (j == 0) {
#pragma unroll
            for (int it = 0; it < 9; ++it) { const int gr = rsA + it; if (gr < 128) { const int sl = gr % 9;
                const u32x4 kv = *(const u32x4*)(kbase + (size_t)gr * 64 * 64), vv = *(const u32x4*)(vbase + (size_t)gr * 64 * 64);
                *(LAS u32x4*)(Kimg + sl * 8192 + skoff) = kv; *(LAS u32x4*)(Vimg + sl * 8192 + svoff) = vv; } }
        } else {
#pragma unroll
            for (int it = 0; it < 2; ++it) { const int gr = prsA + 9 + it; if (gr <= rsA + 8 && gr < 128) { const int sl = gr % 9;
                *(LAS u32x4*)(Kimg + sl * 8192 + skoff) = pK[it]; *(LAS u32x4*)(Vimg + sl * 8192 + svoff) = pV[it]; } }
        }
        __syncthreads();
        if (j < 7) {
            const int nrsA = (r0 - 2) < 0 ? 0 : ((r0 - 2) > 120 ? 120 : (r0 - 2));
#pragma unroll
            for (int it = 0; it < 2; ++it) { int gr = rsA + 9 + it; gr = (gr <= nrsA + 8 && gr < 128) ? gr : 127;
                pK[it] = *(const u32x4*)(kbase + (size_t)gr * 64 * 64); pV[it] = *(const u32x4*)(vbase + (size_t)gr * 64 * 64); }
        }
        const int sb0 = rs % 9;
        const LAS float* th = tab + h * 465;
        const float Mb = (Mq + tab[1860 + h]) * kLog2e, c1 = 0.125f * kLog2e;
        int g4v = g4; asm volatile("" : "+v"(g4v));
        const int ecol = kcs + 4 * g4v - cs, dcb = kcs + 4 * g4v - qcol + 15;
        const unsigned kb0 = (unsigned)((kcs + i16) * 128), vb0 = (unsigned)((kcs + 4 * g4 + q) * 128);
        float sum = 0.f;
        f32x4 O[4];
#pragma unroll
        for (int dt = 0; dt < 4; ++dt) O[dt] = (f32x4){0.f, 0.f, 0.f, 0.f};
#pragma unroll
        for (int u = 0; u < 8; ++u) {
            const unsigned so = (unsigned)((sb0 + u >= 9 ? sb0 + u - 9 : sb0 + u) * 8192);
            f32x4 S[2];
#pragma unroll
            for (int tt = 0; tt < 2; ++tt) { S[tt] = (f32x4){0.f, 0.f, 0.f, 0.f};
#pragma unroll
                for (int s = 0; s < 2; ++s) { const bf16x8 Kf = *(const LAS bf16x8*)(Kimg + kb0 + so + tt * 2048 + kswz[s]); S[tt] = __builtin_amdgcn_mfma_f32_16x16x32_bf16(Kf, Qf[s], S[tt], 0, 0, 0); } }
            const LAS float* tr = th + (rs + u - rr + 7) * 31;
#pragma unroll
            for (int tt = 0; tt < 2; ++tt)
#pragma unroll
                for (int j = 0; j < 4; ++j) {
                    const int e = ecol + 16 * tt + j; int dc = dcb + 16 * tt + j; dc = dc < 0 ? 0 : (dc > 30 ? 30 : dc);
                    const float bias = tr[dc];
                    const float sv = ((unsigned)e < 16u) ? S[tt][j] * c1 + (bias * kLog2e - Mb) : -1e30f;
                    const float pv = __builtin_amdgcn_exp2f(sv); S[tt][j] = pv; sum += pv;
                }
            u32x4 pw; pw.x = pk2(S[0][0], S[0][1]); pw.y = pk2(S[0][2], S[0][3]); pw.z = pk2(S[1][0], S[1][1]); pw.w = pk2(S[1][2], S[1][3]);
            const bf16x8 Pf = __builtin_bit_cast(bf16x8, pw);
#pragma unroll
            for (int dt = 0; dt < 4; ++dt) { LAS unsigned char* vp = Vimg + vb0 + so + vsw[dt];
                const bf16x8 Vf = tr_pair(vp, vp + 2048);
                O[dt] = __builtin_amdgcn_mfma_f32_16x16x32_bf16(Vf, Pf, O[dt], 0, 0, 0); }
        }
        sum = xsum32(xsum16(sum));
        const float inv = 1.f / sum;
        bf16_t* orow = ob + ((size_t)(bh >> 2) * kS + qtok) * 256 + h * 64;
#pragma unroll
        for (int dt = 0; dt < 4; ++dt) { u32x2 w; w.x = pk2(O[dt][0] * inv, O[dt][1] * inv); w.y = pk2(O[dt][2] * inv, O[dt][3] * inv); *(u32x2*)(orow + 16 * dt + 4 * g4) = w; }
      }
    }
    __syncthreads();
}
DEVI void unpk8(float* d, const u32x4 q, const float sc) {
    d[0] += sc * __uint_as_float(q.x << 16); d[1] += sc * __uint_as_float(q.x & 0xFFFF0000u); d[2] += sc * __uint_as_float(q.y << 16); d[3] += sc * __uint_as_float(q.y & 0xFFFF0000u);
    d[4] += sc * __uint_as_float(q.z << 16); d[5] += sc * __uint_as_float(q.z & 0xFFFF0000u); d[6] += sc * __uint_as_float(q.w << 16); d[7] += sc * __uint_as_float(q.w & 0xFFFF0000u);
}
DEVI void phase_mixnorm(const bf16_t* oac, const float* lse, const bf16_t* ob, const bf16_t* oc, const float* ga, const float* gb, const float* gc, bf16_t* mix, int bid, int nblk) {
    const int wid = tidx() >> 6, lane = tidx() & 63;
    float gn[16];
    { const float* gp = (lane < 32) ? ga + lane * 16 : (lane < 48) ? gb + (lane - 32) * 16 : gc + (lane - 48) * 16;
#pragma unroll
      for (int i = 0; i < 16; ++i) gn[i] = gp[i]; }
    const int stride = nblk * 8;
    int row = bid * 8 + wid;
    if (row >= kTok) return;
    u32x4 Aq[6], Bq[6]; float Al[3], Bl[3];
    const bool dil = lane < 32;
    const int hh = dil ? (lane >> 2) : 0;
#define MX_ISSUE(R, Q, L) do { \
        const bf16_t* p0_ = dil ? oac + (size_t)(R) * 512 + lane * 16 : ((lane < 48) ? ob + (size_t)(R) * 256 + (lane - 32) * 16 : oc + (size_t)(R) * 256 + (lane - 48) * 16); \
        const size_t cst_ = dil ? (size_t)kTok * 512 : (size_t)0; \
        Q[0] = *(const u32x4*)p0_; Q[1] = *(const u32x4*)(p0_ + 8); Q[2] = *(const u32x4*)(p0_ + cst_); Q[3] = *(const u32x4*)(p0_ + cst_ + 8); Q[4] = *(const u32x4*)(p0_ + 2 * cst_); Q[5] = *(const u32x4*)(p0_ + 2 * cst_ + 8); \
        L[0] = lse[(size_t)(R) * 8 + hh]; L[1] = lse[((size_t)kTok + (R)) * 8 + hh]; L[2] = lse[((size_t)2 * kTok + (R)) * 8 + hh]; } while (0)
#define MX_BODY(C, N) do { \
        const int nrow_ = (row + stride < kTok) ? row + stride : row; \
        MX_ISSUE(nrow_, N##q, N##l); \
        float v[16]; \
        _Pragma("unroll") for (int i = 0; i < 16; ++i) v[i] = 0.f; \
        float w0 = 1.f, w1 = 0.f, w2 = 0.f; \
        if (dil) { const float mx = fmaxf(C##l[0], fmaxf(C##l[1], C##l[2])); w0 = __expf(C##l[0] - mx); w1 = __expf(C##l[1] - mx); w2 = __expf(C##l[2] - mx); const float inv = frcp(w0 + w1 + w2); w0 *= inv; w1 *= inv; w2 *= inv; } \
        unpk8(v, C##q[0], w0); unpk8(v + 8, C##q[1], w0); unpk8(v, C##q[2], w1); unpk8(v + 8, C##q[3], w1); unpk8(v, C##q[4], w2); unpk8(v + 8, C##q[5], w2); \
        float ss = 0.f; \
        _Pragma("unroll") for (int i = 0; i < 16; ++i) ss += v[i] * v[i]; \
        ss = row_sum16(ss); \
        { float a = ss, b = ss; swap16(a, b); if (lane < 32) ss = a + b; } \
        const float rstd = rsqrtf(ss * ((lane < 32) ? (1.f / 512.f) : (1.f / 256.f)) + kEps); \
        u32x4 o0, o1; \
        o0.x = pk2(v[0] * rstd * gn[0], v[1] * rstd * gn[1]); o0.y = pk2(v[2] * rstd * gn[2], v[3] * rstd * gn[3]); o0.z = pk2(v[4] * rstd * gn[4], v[5] * rstd * gn[5]); o0.w = pk2(v[6] * rstd * gn[6], v[7] * rstd * gn[7]); \
        o1.x = pk2(v[8] * rstd * gn[8], v[9] * rstd * gn[9]); o1.y = pk2(v[10] * rstd * gn[10], v[11] * rstd * gn[11]); o1.z = pk2(v[12] * rstd * gn[12], v[13] * rstd * gn[13]); o1.w = pk2(v[14] * rstd * gn[14], v[15] * rstd * gn[15]); \
        *(u32x4*)(mix + (size_t)row * kD + lane * 16) = o0; *(u32x4*)(mix + (size_t)row * kD + lane * 16 + 8) = o1; } while (0)
    MX_ISSUE(row, Aq, Al);
    for (;;) {
        MX_BODY(A, B); row += stride; if (row >= kTok) break;
        MX_BODY(B, A); row += stride; if (row >= kTok) break;
    }
#undef MX_BODY
#undef MX_ISSUE
}
DEVI void phase_combine(bf16_t* xb, bf16_t* xbo, float* out32, const bf16_t* y, const float* gate, const int* tokslot, bool last_layer, float* rstdp, int bid, int nblk) {
    const int wid = tidx() >> 6, lane = tidx() & 63;
    const int stride = nblk * 8;
    int row = bid * 8 + wid;
    if (row >= kTok) return;
    u32x4 Ax0, Ax1, Ay[4], Bx0, Bx1, By[4]; float Ag[4], Bg[4]; unsigned Am = 0u, Bm = 0u;
#define CB_ISSUE(R, TS, X0, X1, Y, G, M) do { const int b_ = (R) >> 13; \
        M = (unsigned)__builtin_amdgcn_ballot_w64(lane < 16 && (TS) >= 0); unsigned mm_ = M; \
        X0 = *(const u32x4*)(xb + (size_t)(R) * kD + lane * 16); X1 = *(const u32x4*)(xb + (size_t)(R) * kD + lane * 16 + 8); \
        _Pragma("unroll") for (int j = 0; j < 4; ++j) { const bool has_ = mm_ != 0u; const int e_ = has_ ? __builtin_ctz(mm_) : 0; const int sl_ = has_ ? __builtin_amdgcn_readlane((TS), e_) : 0; \
            const size_t r_ = has_ ? (size_t)(e_ * kB + b_) * kCap + sl_ : (size_t)0; Y[j] = *(const u32x4*)((const unsigned char*)y + r_ * kD + lane * 16); G[j] = gate[r_]; mm_ &= mm_ - 1u; } } while (0)
#define CB_ACC(YV, GS) do { const unsigned ww_[4] = {(YV).x, (YV).y, (YV).z, (YV).w}; const float gs_ = __builtin_bit_cast(float, __builtin_amdgcn_readfirstlane(__builtin_bit_cast(int, (GS))));   \
        _Pragma("unroll") for (int k = 0; k < 4; ++k) { const f32x2 lo = __builtin_amdgcn_cvt_pk_f32_fp8(ww_[k], false), hi = __builtin_amdgcn_cvt_pk_f32_fp8(ww_[k], true); \
            v[4 * k] += lo.x * gs_; v[4 * k + 1] += lo.y * gs_; v[4 * k + 2] += hi.x * gs_; v[4 * k + 3] += hi.y * gs_; } } while (0)
#define CB_BODY(C, N) do { \
        const int nrow_ = (row + stride < kTok) ? row + stride : row, nnrow_ = (row + 2 * stride < kTok) ? row + 2 * stride : row, b = row >> 13; \
        const int ts2 = tokslot[(size_t)nnrow_ * kE + (lane & 15)]; \
        CB_ISSUE(nrow_, ts1, N##x0, N##x1, N##y, N##g, N##m); \
        float v[16]; unpk8s(v, C##x0); unpk8s(v + 8, C##x1); \
        unsigned mm = C##m; \
        _Pragma("unroll") for (int j = 0; j < 4; ++j) { if (mm != 0u) CB_ACC(C##y[j], C##g[j]); mm &= mm - 1u; } \
        while (mm != 0u) { const int e = __builtin_ctz(mm), sl = __builtin_amdgcn_readlane(ts0, e); const size_t r = (size_t)(e * kB + b) * kCap + sl; \
            const u32x4 yv = *(const u32x4*)((const unsigned char*)y + r * kD + lane * 16); const float gs = gate[r]; CB_ACC(yv, gs); mm &= mm - 1u; } \
        if (last_layer) { \
            _Pragma("unroll") for (int k = 0; k < 4; ++k) *(f32x4*)(out32 + (size_t)row * kD + lane * 16 + 4 * k) = (f32x4){v[4 * k], v[4 * k + 1], v[4 * k + 2], v[4 * k + 3]}; \
        } else { u32x4 o0, o1; \
            o0.x = pk2(v[0], v[1]); o0.y = pk2(v[2], v[3]); o0.z = pk2(v[4], v[5]); o0.w = pk2(v[6], v[7]); o1.x = pk2(v[8], v[9]); o1.y = pk2(v[10], v[11]); o1.z = pk2(v[12], v[13]); o1.w = pk2(v[14], v[15]); \
            *(u32x4*)(xbo + (size_t)row * kD + lane * 16) = o0; *(u32x4*)(xbo + (size_t)row * kD + lane * 16 + 8) = o1; \
            unpk8s(v, o0); unpk8s(v + 8, o1);                     \
            float ss = 0.f; \
            _Pragma("unroll") for (int i = 0; i < 16; ++i) ss += v[i] * v[i]; \
            ss = wave_sum(ss); \
            if (lane == 0) rstdp[row] = rsqrtf(ss * (1.f / kD) + kEps);     \
        } \
        ts0 = ts1; ts1 = ts2; } while (0)
    int ts0 = tokslot[(size_t)row * kE + (lane & 15)];
    int ts1 = tokslot[(size_t)((row + stride < kTok) ? row + stride : row) * kE + (lane & 15)];
    CB_ISSUE(row, ts0, Ax0, Ax1, Ay, Ag, Am);
    for (;;) {
        CB_BODY(A, B); row += stride; if (row >= kTok) break;
        CB_BODY(B, A); row += stride; if (row >= kTok) break;
    }
#undef CB_BODY
#undef CB_ISSUE
#undef CB_ACC
}

DEVI void cpow_m(double a, double w, double dt, int m, float& re, float& im) {
    const float mag = __expf((float)m * (float)a * (float)dt);
    const double turns = (double)m * w * dt * 0.15915494309189535; const float ang = (float)((turns - floor(turns)) * 6.283185307179586);
    re = mag * cosf(ang); im = mag * sinf(ang);
}
DEVI void s5_prep_item(const Params& P, int l, int g, unsigned char* lds_) {
    float* pw = (float*)lds_;
    float* bb = pw + 4352;
    float* cc = bb + 4096;
    float* kt = cc + 4096;
    const int tid = tidx();
    __syncthreads();
    for (int i = tid; i < 128; i += kNT) { const int dir = i >> 6, p = i & 63; const size_t pb = (((size_t)l * 2 + dir) * 16 + g) * 64 + p;
        const double dt = (double)__expf(P.s5_log_dt[((size_t)l * 2 + dir) * 16 + g]); const double a = (double)fminf(P.s5_a_re[pb], -1e-4f), w = (double)P.s5_a_im[pb];
        for (int m = 0; m < 17; ++m) { float re, im; cpow_m(a, w, dt, m, re, im); pw[((dir * 64 + p) * 17 + m) * 2] = re; pw[((dir * 64 + p) * 17 + m) * 2 + 1] = im; }
        const float af = (float)a, wf = (float)w, ar = pw[((dir * 64 + p) * 17 + 1) * 2], ai = pw[((dir * 64 + p) * 17 + 1) * 2 + 1];
        const float den = af * af + wf * wf, zr = ar - 1.f, gr = (zr * af + ai * wf) / den, gi = (ai * af - zr * wf) / den;
        for (int c = 0; c < 16; ++c) { const float br = P.s5_b_re[pb * 16 + c], bi = P.s5_b_im[pb * 16 + c]; bb[((dir * 64 + p) * 16 + c) * 2] = gr * br - gi * bi; bb[((dir * 64 + p) * 16 + c) * 2 + 1] = gr * bi + gi * br; }
    }
    for (int i = tid; i < 2048; i += kNT) { const int dir = i >> 10, c = (i >> 6) & 15, p = i & 63; const size_t o = ((((size_t)l * 2 + dir) * 16 + g) * 16 + c) * 64 + p; cc[i * 2] = P.s5_c_re[o]; cc[i * 2 + 1] = P.s5_c_im[o]; }
    __syncthreads();
    for (int i = tid; i < 8192; i += kNT) { const int dir = i >> 12, m = (i >> 8) & 15, c = (i >> 4) & 15, c2 = i & 15; float acc = 0.f;
        for (int p = 0; p < 64; ++p) { const float cr = cc[((dir * 16 + c) * 64 + p) * 2], ci = cc[((dir * 16 + c) * 64 + p) * 2 + 1], wr_ = pw[((dir * 64 + p) * 17 + m) * 2], wi_ = pw[((dir * 64 + p) * 17 + m) * 2 + 1];
            const float br = bb[((dir * 64 + p) * 16 + c2) * 2], bi = bb[((dir * 64 + p) * 16 + c2) * 2 + 1]; const float tr = cr * wr_ - ci * wi_, ti = cr * wi_ + ci * wr_; acc += tr * br - ti * bi; }
        kt[i] = acc; }
    __syncthreads();
    bf16_t* wst = (bf16_t*)(wsp(P) + WS_WST) + ((size_t)l * 16 + g) * 256 * 256;
    bf16_t* wso = (bf16_t*)(wsp(P) + WS_WSO) + ((size_t)l * 16 + g) * 256 * 512;
    for (int id = tid; id < 8192; id += kNT) { const int n = id >> 5, k0 = (id & 31) * 8, dir = n >> 7, p = (n >> 1) & 63, ri = n & 1; float v[8];
#pragma unroll
        for (int kk = 0; kk < 8; ++kk) { const int k = k0 + kk, t = k >> 4, c = k & 15, e = dir ? t : 15 - t; const float wr_ = pw[((dir * 64 + p) * 17 + e) * 2], wi_ = pw[((dir * 64 + p) * 17 + e) * 2 + 1], br = bb[((dir * 64 + p) * 16 + c) * 2], bi = bb[((dir * 64 + p) * 16 + c) * 2 + 1];
            v[kk] = ri ? (wr_ * bi + wi_ * br) : (wr_ * br - wi_ * bi); }
        u32x4 o; o.x = pk2(v[0], v[1]); o.y = pk2(v[2], v[3]); o.z = pk2(v[4], v[5]); o.w = pk2(v[6], v[7]); *(u32x4*)(wst + (size_t)n * 256 + k0) = o; }
    for (int id = tid; id < 16384; id += kNT) { const int ns = id >> 6, k0 = (id & 63) * 8, n = cmap_pk(ns), t = n >> 4, c = n & 15; float v[8];
#pragma unroll
        for (int kk = 0; kk < 8; ++kk) { const int k = k0 + kk; float x;
            if (k < 256) { const int j = k >> 4, c2 = k & 15; x = 0.f; if (j <= t) x += kt[(t - j) * 256 + c * 16 + c2]; if (j >= t) x += kt[4096 + (j - t) * 256 + c * 16 + c2]; if (j == t && c == c2) x += P.s5_d[l * 256 + g * 16 + c]; }
            else { const int q = k - 256, dir = q >> 7, p = (q >> 1) & 63, ri = q & 1, e = dir ? 16 - t : t + 1; const float cr = cc[((dir * 16 + c) * 64 + p) * 2], ci = cc[((dir * 16 + c) * 64 + p) * 2 + 1], wr_ = pw[((dir * 64 + p) * 17 + e) * 2], wi_ = pw[((dir * 64 + p) * 17 + e) * 2 + 1];
                x = ri ? -(cr * wi_ + ci * wr_) : (cr * wr_ - ci * wi_); }
            v[kk] = x; }
        u32x4 o; o.x = pk2(v[0], v[1]); o.y = pk2(v[2], v[3]); o.z = pk2(v[4], v[5]); o.w = pk2(v[6], v[7]); *(u32x4*)(wso + (size_t)ns * 512 + k0) = o; }
    __syncthreads();
}
DEVI void phase_s5_scan(const Params& P, int l, const float* Z, bf16_t* ux, unsigned char* lds_, int bid, int nblk) {
    const int tid = tidx(), wid = tid >> 6, lane = tid & 63;
    float* E = (float*)lds_;
    for (int item = bid; item < 256; item += nblk) {
        const int dir = item & 1, g = (item >> 1) & 15, b = item >> 5;
        const size_t pb = (((size_t)l * 2 + dir) * 16 + g) * 64 + lane;
        const double dt = (double)__expf(P.s5_log_dt[((size_t)l * 2 + dir) * 16 + g]); const double a = (double)fminf(P.s5_a_re[pb], -1e-4f), w = (double)P.s5_a_im[pb];
        float a16r, a16i, Ar, Ai; cpow_m(a, w, dt, 16, a16r, a16i); cpow_m(a, w, dt, 1024, Ar, Ai);
        const int kk0 = dir ? 511 - 64 * wid : 64 * wid; const long sstep = dir ? -1 : 1;
        const float* zp = Z + ((size_t)g * 4096 + b * 512 + kk0) * 256 + dir * 128 + 2 * lane;
        f32x2 z[64];
#pragma unroll
        for (int i = 0; i < 64; ++i) { z[i] = *(const f32x2*)zp; zp += sstep * 256; }
        float xr = 0.f, xi = 0.f;
#pragma unroll
        for (int i = 0; i < 64; ++i) { const float nr = a16r * xr - a16i * xi + z[i].x, ni = a16r * xi + a16i * xr + z[i].y; xr = nr; xi = ni; }
        __syncthreads();
        E[(wid * 64 + lane) * 2] = xr; E[(wid * 64 + lane) * 2 + 1] = xi;
        __syncthreads();
        float sr = 0.f, si = 0.f;
#pragma unroll
        for (int s2 = 0; s2 < 7; ++s2) if (s2 < wid) { const float er = E[(s2 * 64 + lane) * 2], ei = E[(s2 * 64 + lane) * 2 + 1]; const float nr = Ar * sr - Ai * si + er, ni = Ar * si + Ai * sr + ei; sr = nr; si = ni; }
        bf16_t* up = ux + ((size_t)g * 4096 + b * 512 + kk0) * 512 + 256 + dir * 128 + 2 * lane;
#pragma unroll
        for (int i = 0; i < 64; ++i) { *(unsigned*)up = pk2(sr, si); up += sstep * 512;
            const float nr = a16r * sr - a16i * si + z[i].x, ni = a16r * si + a16i * sr + z[i].y; sr = nr; si = ni; }
    }
    __syncthreads();
}
struct EpiF32N {
    DEVI void stage(LAS unsigned char*, const Unit&, int, int) const {}
    static constexpr int VMOPS = 32;
    float* z; int ldz;
    DEVI void operator()(const f32x4 (&acc)[2][2][4][2], const Unit& u, int wr, int wc, int fr, int fq) const {
#pragma unroll
        for (int ai = 0; ai < 2; ++ai)
#pragma unroll
            for (int m = 0; m < 4; ++m) { const size_t ro = (size_t)(u.pm * 256 + 128 * ai + 64 * wr + 16 * m + fr) * ldz + u.pn * 256 + 32 * wc + 4 * fq;
#pragma unroll
                for (int bj = 0; bj < 2; ++bj)
#pragma unroll
                    for (int n = 0; n < 2; ++n) *(f32x4*)(z + ro + 128 * bj + 16 * n) = acc[ai][bj][m][n]; }
    }
};
struct EpiS5Out {
    DEVI void stage(LAS unsigned char*, const Unit&, int, int) const {}
    static constexpr int VMOPS = 16;
    bf16_t* G;
    DEVI void operator()(const f32x4 (&acc)[2][2][4][2], const Unit& u, int wr, int wc, int fr, int fq) const {
#pragma unroll
        for (int ai = 0; ai < 2; ++ai)
#pragma unroll
            for (int m = 0; m < 4; ++m) { const int R = u.pm * 256 + 128 * ai + 64 * wr + 16 * m + fr, g = R >> 12, ck = R & 4095;
#pragma unroll
                for (int bj = 0; bj < 2; ++bj) { const int t = 8 * bj + 2 * wc + (fq >> 1), c0 = 8 * (fq & 1);
                    const f32x4 v0 = acc[ai][bj][m][0], v1 = acc[ai][bj][m][1];
                    u32x4 w; w.x = pk2(gelu_tanh(v0.x), gelu_tanh(v0.y)); w.y = pk2(gelu_tanh(v0.z), gelu_tanh(v0.w)); w.z = pk2(gelu_tanh(v1.x), gelu_tanh(v1.y)); w.w = pk2(gelu_tanh(v1.z), gelu_tanh(v1.w));
                    *(u32x4*)(G + ((size_t)ck * 16 + t) * 256 + g * 16 + c0) = w; } }
    }
};
#define XB_TMO      128
#define XB_XCNT(j)  (256  + 64 * (j))
#define XB_XSUB(j)  (1280 + 64 * (j))
#define XB_XGEN(j)  (2304 + 64 * (j))
#define XB_TOP      3328
#define XB_TOPGEN   3392
#define XCD_BAR_WORDS 3456
#define XB_SPIN_CAP (1u << 26)
DEVI unsigned xb_ld(unsigned* p)              { return __hip_atomic_load(p, __ATOMIC_RELAXED, __HIP_MEMORY_SCOPE_AGENT); }
DEVI unsigned xb_add(unsigned* p, unsigned v) { return __hip_atomic_fetch_add(p, v, __ATOMIC_RELAXED, __HIP_MEMORY_SCOPE_AGENT); }
DEVI unsigned xb_xcc_id() { return (unsigned)__builtin_amdgcn_s_getreg((3 << 11) | 20) & 0xFu; }
#define XB_SPIN(cond, bar) do { unsigned _sp = 0; while (cond) { __builtin_amdgcn_s_sleep(1); \
    if ((++_sp & 255u) == 0u) { if (xb_ld(&(bar)[XB_TMO])) break; if (_sp > XB_SPIN_CAP) { atomicAdd(&(bar)[XB_TMO], 1u); break; } } } } while (0)
struct XcdBarrier { unsigned* bar; unsigned x; volatile LAS unsigned* st; };
DEVI XcdBarrier xcd_barrier_post(unsigned* bar, volatile LAS unsigned* st) {
    XcdBarrier b; b.bar = bar; b.x = xb_xcc_id(); b.st = st;
    if (threadIdx.x == 0) (void)xb_add(&bar[XB_XCNT(b.x)], 1u);
    return b;
}
DEVI void xcd_barrier_complete(unsigned* bar, unsigned x, unsigned& nloc, unsigned& nx) {
    const unsigned G = gridDim.x * gridDim.y * gridDim.z;
    unsigned sum, cnt, mine, sp = 0u;
    for (;;) {
        sum = 0u; cnt = 0u; mine = 0u;
#pragma unroll
        for (unsigned j = 0; j < 16; ++j) { const unsigned c = xb_ld(&bar[XB_XCNT(j)]); sum += c; cnt += (c > 0u) ? 1u : 0u; mine = (j == x) ? c : mine; }
        if (sum == G) break;
        __builtin_amdgcn_s_sleep(1);
        if ((++sp & 255u) == 0u) { if (xb_ld(&bar[XB_TMO])) break; if (sp > XB_SPIN_CAP) { atomicAdd(&bar[XB_TMO], 1u); break; } }
    }
    nloc = mine > 0u ? mine : 1u; nx = cnt > 0u ? cnt : 1u;
}
DEVI void xcd_barrier(const XcdBarrier& b) {
    asm volatile("s_waitcnt vmcnt(0)" ::: "memory");
    __syncthreads();
    if (threadIdx.x == 0) {
        unsigned long long bp_ = (unsigned long long)b.bar; asm volatile("" : "+s"(bp_));
        unsigned* bar = (unsigned*)bp_;
        const unsigned bx = xb_xcc_id();
        __builtin_amdgcn_s_waitcnt(0);
        unsigned nloc = b.st[0], nx = b.st[1];
        if (nloc == 0u) { xcd_barrier_complete(bar, bx, nloc, nx); b.st[0] = nloc; b.st[1] = nx; }
        const unsigned old = xb_add(&bar[XB_XSUB(bx)], 1u);
        const unsigned gen = old / nloc;
        if (old + 1u == (gen + 1u) * nloc) {
            __builtin_amdgcn_fence(__ATOMIC_RELEASE, "agent");
            asm volatile("s_waitcnt vmcnt(0)" ::: "memory");
            const unsigned og = xb_add(&bar[XB_TOP], 1u);
            const unsigned tg = og / nx;
            if (og + 1u == (tg + 1u) * nx) xb_add(&bar[XB_TOPGEN], 1u);
            else XB_SPIN(xb_ld(&bar[XB_TOPGEN]) == tg, bar);
            __builtin_amdgcn_fence(__ATOMIC_ACQUIRE, "agent");
            xb_add(&bar[XB_XGEN(bx)], 1u);
            asm volatile("s_waitcnt vmcnt(0)" ::: "memory");
        } else {
            XB_SPIN(xb_ld(&bar[XB_XGEN(bx)]) == gen, bar);
            __builtin_amdgcn_fence(__ATOMIC_ACQUIRE, "agent");
            asm volatile("s_waitcnt vmcnt(0)" ::: "memory");
        }
    }
    __syncthreads();
}

constexpr int LDS_BYTES = 147456 + 8192 + 16;
#define GEMM_RUN(g, E) gemm_engine<decltype(E), true, true>((LAS unsigned char*)dyn_lds, g, E, bid, nblk)
#define GEMM_RUN8(g, E) gemm_engine<decltype(E), true, true, true>((LAS unsigned char*)dyn_lds, g, E, bid, nblk)
#define GEMM_RUN8G(g, E) gemm_engine<decltype(E), true, true, true, true>((LAS unsigned char*)dyn_lds, g, E, bid, nblk)
extern __shared__ __attribute__((aligned(16))) unsigned char dyn_lds[];

DEVI GemmD mk_gemm(const bf16_t* A, const bf16_t* Bt, int lda, int K, int nM, int nN, const int* rowidx, size_t bstride, int pmg) {
    GemmD g; g.A = A; g.Bt = Bt; g.lda = lda; g.K = K; g.nM = nM; g.nN = nN; g.rowidx = rowidx; g.bstride = bstride; g.pmg = pmg; return g; }

DEVI void ph_win(const Params& P, int l, int bid, int nblk) {
    const GemmD g = mk_gemm((const bf16_t*)(wsp(P) + WS_XB), (const bf16_t*)(wsp(P) + WS_WINT) + (size_t)l * kINW * kD, kD, kD, kTok / 256, 10, nullptr, 0, 1 << 30);
    unsigned char* r1 = wsp(P) + WS_R1;
    EpiQKV E; E.qa = (bf16_t*)(r1 + R1_QA); E.ka = (bf16_t*)(r1 + R1_KA); E.va = (bf16_t*)(r1 + R1_VA); E.qb = (bf16_t*)(r1 + R1_QB); E.kb = (bf16_t*)(r1 + R1_KB); E.vb = (bf16_t*)(r1 + R1_VB); E.ux = (bf16_t*)(r1 + R1_UX);
    E.rstdp = (const float*)(wsp(P) + WS_RSTD); E.rtab = (const LAS float*)((LAS unsigned char*)dyn_lds + 131072 + 2048);
    { LAS float* tab = (LAS float*)((LAS unsigned char*)dyn_lds + 131072);
      const int t = tidx();
      if (t < 320) { const int r = t >> 6, c = t & 63; tab[t] = (r == 0) ? P.q_norm_a[l * 64 + c] * (0.125f * kLog2e)   : (r == 1) ? P.k_norm_a[l * 64 + c] : (r == 2) ? P.q_norm_b[l * 64 + c] : (r == 3) ? P.k_norm_b[l * 64 + c] : 1.f; }
      __syncthreads();
      E.gtab = tab; }
    GEMM_RUN(g, E);
}
DEVI void ph_dilated(const Params& P, int l, int bid, int nblk) { unsigned char* r1 = wsp(P) + WS_R1;
    phase_dilated((const bf16_t*)(r1 + R1_QA), (const bf16_t*)(r1 + R1_KA), (const bf16_t*)(r1 + R1_VA), P.q_norm_a + l * 64, P.k_norm_a + l * 64, (bf16_t*)(wsp(P) + WS_R2), (float*)(wsp(P) + WS_LSE), (LAS unsigned char*)dyn_lds, bid, nblk);
}
DEVI void ph_na(const Params& P, int l, int bid, int nblk) { unsigned char* r1 = wsp(P) + WS_R1;
    phase_na((const bf16_t*)(r1 + R1_QB), (const bf16_t*)(r1 + R1_KB), (const bf16_t*)(r1 + R1_VB), P.rpb + (size_t)l * 4 * 15 * 31, P.q_norm_b + l * 64, P.k_norm_b + l * 64, (bf16_t*)(r1 + R1_OB), (LAS unsigned char*)dyn_lds, bid, nblk);
}
DEVI void ph_s5_prep(const Params& P, unsigned char* lds, int bid, int nblk) { for (int it = bid; it < kL * 16; it += nblk) s5_prep_item(P, it >> 4, it & 15, lds); }
DEVI void ph_s5_state(const Params& P, int l, int bid, int nblk) {
    const GemmD g = mk_gemm((const bf16_t*)(wsp(P) + WS_R1 + R1_UX), (const bf16_t*)(wsp(P) + WS_WST) + (size_t)l * 16 * 256 * 256, 512, 256, 256, 1, nullptr, (size_t)256 * 256, 16);
    EpiF32N E; E.z = (float*)(wsp(P) + WS_R2 + R2_Z); E.ldz = 256;
    GEMM_RUN(g, E);
}
DEVI void ph_s5_scan(const Params& P, int l, unsigned char* lds, int bid, int nblk) { phase_s5_scan(P, l, (const float*)(wsp(P) + WS_R2 + R2_Z), (bf16_t*)(wsp(P) + WS_R1 + R1_UX), lds, bid, nblk); }
DEVI void ph_s5_out(const Params& P, int l, int bid, int nblk) {
    const GemmD g = mk_gemm((const bf16_t*)(wsp(P) + WS_R1 + R1_UX), (const bf16_t*)(wsp(P) + WS_WSO) + (size_t)l * 16 * 256 * 512, 512, 512, 256, 1, nullptr, (size_t)256 * 512, 16);
    EpiS5Out E; E.G = (bf16_t*)(wsp(P) + WS_R1 + R1_G);
    GEMM_RUN(g, E);
}
DEVI void ph_glu(const Params& P, int l, int bid, int nblk) {
    const GemmD g = mk_gemm((const bf16_t*)(wsp(P) + WS_R1 + R1_G), (const bf16_t*)(wsp(P) + WS_WGLUT) + (size_t)l * 256 * 256, 256, 256, kTok / 256, 1, nullptr, 0, 1 << 30);
    EpiGlu E; E.g = (const bf16_t*)(wsp(P) + WS_R1 + R1_G); E.oc = (bf16_t*)(wsp(P) + WS_R1 + R1_OC);
    GEMM_RUN(g, E);
}
DEVI void ph_mixnorm(const Params& P, int l, int bid, int nblk) { unsigned char* r1 = wsp(P) + WS_R1;
    phase_mixnorm((const bf16_t*)(wsp(P) + WS_R2), (const float*)(wsp(P) + WS_LSE), (const bf16_t*)(r1 + R1_OB), (const bf16_t*)(r1 + R1_OC), P.out_norm_a + l * 512, P.out_norm_b + l * 256, P.out_norm_c + l * 256, (bf16_t*)(wsp(P) + WS_H), bid, nblk); }
DEVI void ph_wout(const Params& P, int l, int bid, int nblk) {
    const GemmD g = mk_gemm((const bf16_t*)(wsp(P) + WS_H), (const bf16_t*)(wsp(P) + WS_WOUTT) + (size_t)l * kD * kD, kD, kD, kTok / 256, 4, nullptr, 0, 1 << 30);
    EpiResid E; E.xb = (bf16_t*)(wsp(P) + WS_XB); E.xbo = E.xb;
    GEMM_RUN(g, E);
}
DEVI void ph_router(const Params& P, int l, unsigned char* lds, int bid, int nblk) { phase_router((const bf16_t*)(wsp(P) + WS_XB), P.ffn_norm + (size_t)l * kD, wsp(P) + WS_RTAB + (size_t)l * 65536, wsp(P) + WS_H, (float*)(wsp(P) + WS_AFF), (LAS unsigned char*)dyn_lds, bid, nblk); }
DEVI void ph_topk(const Params& P, unsigned char* lds, int bid, int nblk) { phase_topk((const float*)(wsp(P) + WS_AFF), (int*)(wsp(P) + WS_IDX), (float*)(wsp(P) + WS_GATE), (int*)(wsp(P) + WS_TSLOT), wsp(P) + WS_H, nullptr  , kD, lds, bid, nblk); }
DEVI void ph_gu(const Params& P, int l, int bid, int nblk) {
    const GemmD g = mk_gemm((const bf16_t*)(wsp(P) + WS_H), (const bf16_t*)(wsp(P) + WS_WGUT + (size_t)l * kE * 4096 * kD), kD, kD, 512, 16, (const int*)(wsp(P) + WS_IDX), (size_t)4096 * kD, 32);
    EpiGU E; E.hid = (bf16_t*)(wsp(P) + WS_R1); E.sc = 1.f / kW8;
    GEMM_RUN8G(g, E);
}
DEVI void ph_down(const Params& P, int l, int bid, int nblk) {
    const GemmD g = mk_gemm((const bf16_t*)(wsp(P) + WS_R1), (const bf16_t*)(wsp(P) + WS_WDT + (size_t)l * kE * kD * kFF), kFF, kFF, 512, 4, nullptr, (size_t)kD * kFF, 32);
    EpiDown E; E.y = (bf16_t*)(wsp(P) + WS_R2); E.sc = 1.f / (kW8 * kH8);
    GEMM_RUN8(g, E);
}
DEVI void ph_combine(const Params& P, int l, int bid, int nblk) { phase_combine((bf16_t*)(wsp(P) + WS_XB), (bf16_t*)(wsp(P) + WS_XB), P.out, (const bf16_t*)(wsp(P) + WS_R2), (const float*)(wsp(P) + WS_GATE), (const int*)(wsp(P) + WS_TSLOT), l + 1 == kL, (float*)(wsp(P) + WS_RSTD), bid, nblk); }

__global__ void __launch_bounds__(kNT, 2) mega_fwd(Params P) {
    asm volatile("s_setreg_imm32_b32 hwreg(HW_REG_MODE, 23, 1), 1");

    volatile LAS unsigned* st = (volatile LAS unsigned*)(dyn_lds + LDS_BYTES - 16);
    if (threadIdx.x == 0) { st[0] = 0u; st[1] = 0u; st[2] = 0u; st[3] = 0u; }
    __syncthreads();
    const XcdBarrier bar = xcd_barrier_post((unsigned*)(P.ws + WS_CTL), st);
    const int bid = blockIdx.x, nblk = gridDim.x;
    unsigned char* lds = dyn_lds;
    phase_convert(P, lds, lnd(bid), nblk);
    ph_s5_prep(P, lds, lnd(bid), nblk);
    router_prep(P, lnd(bid), nblk);
    phase_norm(P.x, (bf16_t*)(wsp(P) + WS_XB), (float*)(wsp(P) + WS_RSTD), lnd(bid), nblk);
    xcd_barrier(bar);
#pragma unroll 1
    for (int l = 0; l < kL; ++l) {
        ph_win(P, l, lnd(bid), nblk);             xcd_barrier(bar);
        ph_s5_state(P, l, lnd(bid), nblk);        xcd_barrier(bar);
        ph_s5_scan(P, l, lds, lnd(bid), nblk);
        ph_dilated(P, l, lnd(bid), nblk);
        ph_na(P, l, lnd(bid), nblk);              xcd_barrier(bar);
        ph_s5_out(P, l, lnd(bid), nblk);          xcd_barrier(bar);
        ph_glu(P, l, lnd(bid), nblk);             xcd_barrier(bar);
        ph_mixnorm(P, l, lnd(bid), nblk);         xcd_barrier(bar);
        ph_wout(P, l, lnd(bid), nblk);            xcd_barrier(bar);
        ph_router(P, l, lds, lnd(bid), nblk);     xcd_barrier(bar);
        ph_topk(P, lds, lnd(bid), nblk);          xcd_barrier(bar);
        ph_gu(P, l, lnd(bid), nblk);              xcd_barrier(bar);
        ph_down(P, l, lnd(bid), nblk);            xcd_barrier(bar);
        ph_combine(P, l, lnd(bid), nblk);         xcd_barrier(bar);
    }
}

extern "C" void kernel_launch(void* const* d_in, const int* in_sizes, int n_in, void* d_out, int out_size, void* d_ws, size_t ws_size, hipStream_t stream) {
    (void)in_sizes; (void)n_in; (void)out_size;
    if (ws_size < WS_END) { fprintf(stderr, "workspace too small: %zu < %zu\n", ws_size, (size_t)WS_END); return; }
    Params P{};
    const float** pp = (const float**)&P;
    for (int i = 0; i < 26; ++i) pp[i] = (const float*)d_in[i];
    P.out = (float*)d_out; P.ws = (unsigned char*)d_ws;
    static int grid = 0;
    if (!grid) {
        int dev = 0, cus = 0, per_cu = 0;
        (void)hipGetDevice(&dev);
        (void)hipDeviceGetAttribute(&cus, hipDeviceAttributeMultiprocessorCount, dev);
        (void)hipFuncSetAttribute((const void*)mega_fwd, hipFuncAttributeMaxDynamicSharedMemorySize, LDS_BYTES);
        (void)hipOccupancyMaxActiveBlocksPerMultiprocessor(&per_cu, (const void*)mega_fwd, kNT, LDS_BYTES);
        grid = (per_cu >= 1) ? cus : 0;
        if (!grid) fprintf(stderr, "mega_fwd does not fit a CU\n");
    }
    if (!grid) return;
    (void)hipMemsetAsync(P.ws + WS_CTL, 0, XCD_BAR_WORDS * sizeof(unsigned), stream);
    mega_fwd<<<grid, kNT, LDS_BYTES, stream>>>(P);
}
```

```cpp
#include <hip/hip_runtime.h>
#include <stdint.h>
#include <stdio.h>

#define DEVI __device__ __forceinline__
#define LAS __attribute__((address_space(3)))
typedef unsigned short bf16_t;
typedef short bf16x8 __attribute__((ext_vector_type(8)));
typedef float f32x4 __attribute__((ext_vector_type(4)));
typedef float f32x2 __attribute__((ext_vector_type(2)));
typedef unsigned u32x4 __attribute__((ext_vector_type(4)));
typedef unsigned u32x2 __attribute__((ext_vector_type(2)));

constexpr int kB = 8, kS = 8192, kD = 1024, kL = 4, kTok = kB * kS;
constexpr int kINW = 2560;
constexpr int kE = 16, kCap = 1024, kFF = 2048;
constexpr int kNT = 512;
constexpr float kEps = 1e-6f;
constexpr float kLog2e = 1.4426950408889634f, kLn2 = 0.6931471805599453f;

constexpr size_t MiB = 1024ull * 1024ull;
constexpr size_t WS_CTL   = 0;
constexpr size_t WS_RSTD  = 512 * 1024;
constexpr size_t WS_WINT  = 1 * MiB;
constexpr size_t WS_WOUTT = WS_WINT + 20 * MiB;
constexpr size_t WS_WGLUT = WS_WOUTT + 8 * MiB;
constexpr size_t WS_RTAB  = WS_WGLUT + 512 * 1024;
constexpr size_t WS_WGUT  = WS_WGLUT + 1 * MiB;
constexpr size_t WS_WDT   = WS_WGUT + 512 * MiB;
constexpr size_t WS_H     = WS_WDT + 256 * MiB;
constexpr size_t WS_R1    = WS_H + 128 * MiB;
constexpr size_t WS_R2    = WS_R1 + 512 * MiB;
constexpr size_t WS_AFF   = WS_R2 + 256 * MiB;
constexpr size_t WS_IDX   = WS_AFF + 4 * MiB;
constexpr size_t WS_GATE  = WS_IDX + 1 * MiB;
constexpr size_t WS_TSLOT = WS_GATE + 1 * MiB;
constexpr size_t WS_LSE   = WS_TSLOT + 4 * MiB;
constexpr size_t WS_WST   = WS_LSE + 8 * MiB;
constexpr size_t WS_WSO   = WS_WST + 8 * MiB;
constexpr size_t WS_XB    = WS_WSO + 16 * MiB;
constexpr size_t WS_END   = WS_XB + 128 * MiB;
constexpr size_t R2_Z     = 192 * MiB;
constexpr size_t R1_QA = 0, R1_KA = 64 * MiB, R1_VA = 128 * MiB, R1_QB = 192 * MiB, R1_KB = 224 * MiB, R1_VB = 256 * MiB,
                 R1_UX = 288 * MiB, R1_OB = 352 * MiB, R1_OC = 384 * MiB, R1_G = 416 * MiB;

struct Params {
    const float* x; const float* attn_norm; const float* w_in; const float* q_norm_a; const float* k_norm_a; const float* q_norm_b; const float* k_norm_b;
    const float* rpb; const float* s5_a_re; const float* s5_a_im; const float* s5_log_dt; const float* s5_b_re; const float* s5_b_im; const float* s5_c_re; const float* s5_c_im;
    const float* s5_d; const float* w_glu; const float* out_norm_a; const float* out_norm_b; const float* out_norm_c; const float* w_out; const float* ffn_norm;
    const float* w_router; const float* w_gate; const float* w_up; const float* w_down;
    float* out; unsigned char* ws;
};

DEVI float bf2f(bf16_t b) { return __uint_as_float(((unsigned)b) << 16); }
DEVI bf16_t f2bf(float f) { unsigned u = __float_as_uint(f); u += 0x7FFFu + ((u >> 16) & 1u); return (bf16_t)(u >> 16); }
typedef __bf16 bf16x2_t __attribute__((ext_vector_type(2)));
DEVI unsigned pk2(float lo, float hi) { const f32x2 v = {lo, hi}; return __builtin_bit_cast(unsigned, __builtin_convertvector(v, bf16x2_t)); }
DEVI int tidx() { int t = threadIdx.x; asm volatile("" : "+v"(t)); return t; }
#define GAS __attribute__((address_space(1)))
DEVI unsigned char* wsp(const Params& P) { unsigned long long a = (unsigned long long)P.ws; asm volatile("" : "+s"(a)); return (unsigned char*)(GAS unsigned char*)a; }
DEVI int lnd(int v) { asm volatile("" : "+s"(v)); return v; }
template <int CTRL> DEVI float dppf(float v) { return __builtin_bit_cast(float, __builtin_amdgcn_update_dpp(0, __builtin_bit_cast(int, v), CTRL, 0xF, 0xF, true)); }
DEVI void swap16(float& a, float& b) { asm volatile("s_nop 1\n\tv_permlane16_swap_b32 %0, %1" : "+v"(a), "+v"(b)); }
DEVI void swap32(float& a, float& b) { asm volatile("s_nop 1\n\tv_permlane32_swap_b32 %0, %1" : "+v"(a), "+v"(b)); }
DEVI void swap16u(unsigned& a, unsigned& b) { asm volatile("s_nop 1\n\tv_permlane16_swap_b32 %0, %1" : "+v"(a), "+v"(b)); }
DEVI float xsum16(float v) { float a = v, b = v; swap16(a, b); return a + b; }
DEVI float xsum32(float v) { float a = v, b = v; swap32(a, b); return a + b; }
DEVI float xmax16(float v) { float a = v, b = v; swap16(a, b); return fmaxf(a, b); }
DEVI float xmax32(float v) { float a = v, b = v; swap32(a, b); return fmaxf(a, b); }
DEVI float row_sum16(float v) {
    v += dppf<0xB1>(v); v += dppf<0x4E>(v);
    v += dppf<0x141>(v); v += dppf<0x140>(v);
    return v;
}
DEVI float wave_sum(float v) { return xsum32(xsum16(row_sum16(v))); }
DEVI void unpk8s(float* d, const u32x4 q) {
    d[0] = __uint_as_float(q.x << 16); d[1] = __uint_as_float(q.x & 0xFFFF0000u); d[2] = __uint_as_float(q.y << 16); d[3] = __uint_as_float(q.y & 0xFFFF0000u);
    d[4] = __uint_as_float(q.z << 16); d[5] = __uint_as_float(q.z & 0xFFFF0000u); d[6] = __uint_as_float(q.w << 16); d[7] = __uint_as_float(q.w & 0xFFFF0000u);
}
DEVI float frcp(float x) { return __builtin_amdgcn_rcpf(x); }
DEVI float gelu_tanh(float y) { const float z = 0.7978845608028654f * (y + 0.044715f * y * y * y); const float t = 1.f - 2.f * frcp(1.f + __expf(2.f * z)); return 0.5f * y * (1.f + t); }

constexpr float kY8 = 32.f;
constexpr float kW8 = 64.f, kH8 = 8.f;
DEVI unsigned pk4_fp8(float a, float b, float c, float d) { unsigned w = 0u; w = __builtin_amdgcn_cvt_pk_fp8_f32(a, b, w, false); w = __builtin_amdgcn_cvt_pk_fp8_f32(c, d, w, true); return w; }
DEVI int cmap_head(int cs) { const int bj = cs >> 7, wc = (cs >> 5) & 3, n = (cs >> 4) & 1, fq = (cs >> 2) & 3, j = cs & 3; return 64 * wc + 32 * bj + 8 * fq + 4 * n + j; }
DEVI int cmap_pk(int cs)   { const int bj = cs >> 7, wc = (cs >> 5) & 3, n = (cs >> 4) & 1, fq = (cs >> 2) & 3, j = cs & 3; return 128 * bj + 32 * wc + 8 * fq + 4 * n + j; }
DEVI int cmap_gu(int cs)   { const int wc = (cs >> 5) & 3, n = (cs >> 4) & 1, fq = (cs >> 2) & 3, j = cs & 3; return 32 * wc + 8 * fq + 4 * n + j; }

template <int MODE>
DEVI void convert_item(const float* W0, const float* W1, int ldw, int K, bf16_t* Bt, int kt, int pn, unsigned char* lds) {
    bf16_t* t = (bf16_t*)lds;
    const int tid = tidx(), cs = tid & 255, kh = tid >> 8;
    int col;
    if (MODE == 0) col = pn * 256 + cs; else if (MODE == 1) col = pn * 256 + cmap_head(cs); else if (MODE == 2) col = pn * 256 + cmap_pk(cs); else col = pn * 128 + cmap_gu(cs);
    const float* src = ((MODE == 3 && (cs >> 7)) ? W1 : W0) + (size_t)(kt * 64 + 32 * kh) * ldw + col;
    float v[32];
#pragma unroll
    for (int i = 0; i < 32; ++i) v[i] = src[(size_t)i * ldw];
    if (MODE == 1) {
#pragma unroll
        for (int i = 0; i < 32; ++i) v[i] *= W1[kt * 64 + 32 * kh + i];
    }
#pragma unroll
    for (int q = 0; q < 4; ++q) { u32x4 w; w.x = pk2(v[8 * q], v[8 * q + 1]); w.y = pk2(v[8 * q + 2], v[8 * q + 3]); w.z = pk2(v[8 * q + 4], v[8 * q + 5]); w.w = pk2(v[8 * q + 6], v[8 * q + 7]);
        *(u32x4*)(t + cs * 72 + 32 * kh + 8 * q) = w; }
    __syncthreads();
#pragma unroll
    for (int it = 0; it < 4; ++it) {
        const int c = it * kNT + tid, row = c >> 3, part = c & 7;
        const u32x4 vv = *(const u32x4*)(t + row * 72 + part * 8);
        *(u32x4*)(Bt + (size_t)(pn * 256 + row) * K + kt * 64 + part * 8) = vv;
    }
    __syncthreads();
}

template <int MODE>
DEVI void convert_item8(const float* W0, const float* W1, int ldw, int K, unsigned char* Bt, int kt, int pn, unsigned char* lds) {
    unsigned char* t = lds;
    const int tid = tidx(), cs = tid & 255, kh = tid >> 8;
    const int col = (MODE == 2) ? pn * 256 + cmap_pk(cs) : pn * 128 + cmap_gu(cs);
    const float* src = ((MODE == 3 && (cs >> 7)) ? W1 : W0) + (size_t)(kt * 128 + 64 * kh) * ldw + col;
    float v[64];
#pragma unroll
    for (int i = 0; i < 64; ++i) v[i] = src[(size_t)i * ldw];
#pragma unroll
    for (int q = 0; q < 4; ++q) { u32x4 w;
        w.x = pk4_fp8(v[16 * q] * kW8, v[16 * q + 1] * kW8, v[16 * q + 2] * kW8, v[16 * q + 3] * kW8); w.y = pk4_fp8(v[16 * q + 4] * kW8, v[16 * q + 5] * kW8, v[16 * q + 6] * kW8, v[16 * q + 7] * kW8);
        w.z = pk4_fp8(v[16 * q + 8] * kW8, v[16 * q + 9] * kW8, v[16 * q + 10] * kW8, v[16 * q + 11] * kW8); w.w = pk4_fp8(v[16 * q + 12] * kW8, v[16 * q + 13] * kW8, v[16 * q + 14] * kW8, v[16 * q + 15] * kW8);
        *(u32x4*)(t + cs * 144 + 64 * kh + 16 * q) = w; }
    __syncthreads();
#pragma unroll
    for (int it = 0; it < 4; ++it) {
        const int c = it * kNT + tid, row = c >> 3, part = c & 7;
        const u32x4 vv = *(const u32x4*)(t + row * 144 + part * 16);
        *(u32x4*)(Bt + (size_t)(pn * 256 + row) * K + kt * 128 + part * 16) = vv;
    }
    __syncthreads();
}

DEVI void phase_convert(const Params& P, unsigned char* lds, int bid, int nblk) {
    constexpr int N_WIN = kL * 16 * 10, N_WOUT = kL * 16 * 4, N_WGLU = kL * 4 * 1, N_WGU = kL * kE * 8 * 16, N_WD = kL * kE * 16 * 4;
    constexpr int TOT = N_WIN + N_WOUT + N_WGLU + N_WGU + N_WD;
    for (int it = bid; it < TOT; it += nblk) {
        int i = it;
        if (i < N_WIN) { const int l = i / 160, r = i % 160, kt = r / 10, pn = r % 10;
            convert_item<1>(P.w_in + (size_t)l * kD * kINW, P.attn_norm + (size_t)l * kD, kINW, kD, (bf16_t*)(wsp(P) + WS_WINT) + (size_t)l * kINW * kD, kt, pn, lds); continue; }
        i -= N_WIN;
        if (i < N_WOUT) { const int l = i / 64, r = i % 64, kt = r / 4, pn = r % 4;
            convert_item<2>(P.w_out + (size_t)l * kD * kD, nullptr, kD, kD, (bf16_t*)(wsp(P) + WS_WOUTT) + (size_t)l * kD * kD, kt, pn, lds); continue; }
        i -= N_WOUT;
        if (i < N_WGLU) { const int l = i / 4, kt = i % 4;
            convert_item<2>(P.w_glu + (size_t)l * 256 * 256, nullptr, 256, 256, (bf16_t*)(wsp(P) + WS_WGLUT) + (size_t)l * 256 * 256, kt, 0, lds); continue; }
        i -= N_WGLU;
        if (i < N_WGU) { const int le = i / 128, r = i % 128, kt = r / 16, pn = r % 16;
            convert_item8<3>(P.w_gate + (size_t)le * kD * kFF, P.w_up + (size_t)le * kD * kFF, kFF, kD, wsp(P) + WS_WGUT + (size_t)le * 4096 * kD, kt, pn, lds); continue; }
        i -= N_WGU;
        { const int le = i / 64, r = i % 64, kt = r / 4, pn = r % 4;
            convert_item8<2>(P.w_down + (size_t)le * kFF * kD, nullptr, kD, kFF, wsp(P) + WS_WDT + (size_t)le * kD * kFF, kt, pn, lds); }
    }
}

DEVI void phase_norm(const float* x, bf16_t* xb, float* rstdp, int bid, int nblk) {
    const int wid = tidx() >> 6, lane = tidx() & 63;
    for (int row = bid * 8 + wid; row < kTok; row += nblk * 8) {
        f32x4 v[4]; float ss = 0.f;
#pragma unroll
        for (int q = 0; q < 4; ++q) { v[q] = *(const f32x4*)(x + (size_t)row * kD + q * 256 + lane * 4); ss += v[q].x * v[q].x + v[q].y * v[q].y + v[q].z * v[q].z + v[q].w * v[q].w; }
        ss = wave_sum(ss);
        if (lane == 0) rstdp[row] = rsqrtf(ss * (1.f / kD) + kEps);
#pragma unroll
        for (int q = 0; q < 4; ++q) { const f32x4 t = v[q];
            u32x2 o; o.x = pk2(t.x, t.y); o.y = pk2(t.z, t.w);
            *(u32x2*)(xb + (size_t)row * kD + q * 256 + lane * 4) = o; }
    }
}

DEVI void router_prep(const Params& P, int bid, int nblk) {
    unsigned char* tbase = wsp(P) + WS_RTAB;
    for (int i = bid * kNT + tidx(); i < kL * 2048; i += nblk * kNT) {
        const int L = i >> 11, s = (i >> 6) & 31, l = i & 63, e = l & 15, k0 = 64 * (s >> 1) + 16 * (l >> 4) + 8 * (s & 1);
        const float* wr = P.w_router + (size_t)L * kD * kE; const float* gain = P.ffn_norm + (size_t)L * kD;
        unsigned hh[4], ll[4];
#pragma unroll
        for (int j = 0; j < 4; ++j) { const float w0 = wr[(k0 + 2 * j) * 16 + e] * gain[k0 + 2 * j], w1 = wr[(k0 + 2 * j + 1) * 16 + e] * gain[k0 + 2 * j + 1];
            const unsigned hp = pk2(w0, w1); hh[j] = hp; ll[j] = pk2(w0 - __uint_as_float(hp << 16), w1 - __uint_as_float(hp & 0xFFFF0000u)); }
        u32x4 hi, lo; hi.x = hh[0]; hi.y = hh[1]; hi.z = hh[2]; hi.w = hh[3]; lo.x = ll[0]; lo.y = ll[1]; lo.z = ll[2]; lo.w = ll[3];
        unsigned char* tb = tbase + (size_t)L * 65536;
        *(u32x4*)(tb + (2 * s) * 1024 + l * 16) = hi; *(u32x4*)(tb + (2 * s + 1) * 1024 + l * 16) = lo;
    }
}
DEVI void phase_router(const bf16_t* x, const float* gain, const unsigned char* rtab  , unsigned char* h8, float* aff, LAS unsigned char* lds, int bid, int nblk) {
    LAS unsigned char* wtab = lds;
    LAS float* gtab = (LAS float*)(lds + 65536);
    const int tid = tidx(), wid = __builtin_amdgcn_readfirstlane(tid >> 6), lane = tid & 63, r = lane & 15, c4 = lane >> 4;
    __syncthreads();
    for (int i = tid; i < 1024; i += kNT) gtab[i] = gain[i];
#pragma unroll
    for (int i = 0; i < 8; ++i)
        __builtin_amdgcn_global_load_lds((const unsigned*)(rtab + (size_t)(i * kNT + tid) * 16), (LAS unsigned*)(wtab + (i * 8 + wid) * 1024), 16, 0, 0);
    asm volatile("s_waitcnt vmcnt(0)" ::: "memory");
    __syncthreads();
    u32x4 xr[32];
    const int ntile = kTok / 16, tstride = nblk * 8;
    int tile = bid * 8 + wid;
#define RT_ISSUE(half, tile_) do { const bf16_t* xp_ = x + (size_t)((tile_) * 16 + r) * kD + 16 * c4; \
        _Pragma("unroll") for (int u = 8 * (half); u < 8 * (half) + 8; ++u) { xr[2 * u] = *(const u32x4*)(xp_ + 64 * u); xr[2 * u + 1] = *(const u32x4*)(xp_ + 64 * u + 8); } } while (0)
    if (tile < ntile) { RT_ISSUE(0, tile); RT_ISSUE(1, tile); }
    for (; tile < ntile; tile += tstride) {
        asm volatile("" ::: "memory");
        f32x4 Lh = {0.f, 0.f, 0.f, 0.f}, Ll = {0.f, 0.f, 0.f, 0.f}, G = {0.f, 0.f, 0.f, 0.f};
#pragma unroll
        for (int s = 0; s < 32; ++s) {
            const bf16x8 wh = *(const LAS bf16x8*)(wtab + (2 * s) * 1024 + lane * 16), wl = *(const LAS bf16x8*)(wtab + (2 * s + 1) * 1024 + lane * 16);
            const bf16x8 xb = __builtin_bit_cast(bf16x8, xr[s]);
            Lh = __builtin_amdgcn_mfma_f32_16x16x32_bf16(wh, xb, Lh, 0, 0, 0);
            Ll = __builtin_amdgcn_mfma_f32_16x16x32_bf16(wl, xb, Ll, 0, 0, 0);
            G = __builtin_amdgcn_mfma_f32_16x16x32_bf16(xb, xb, G, 0, 0, 0);
        }
        const float dsel = ((r & 3) == 0) ? G.x : ((r & 3) == 1) ? G.y : ((r & 3) == 2) ? G.z : G.w;
        const float ss = __builtin_bit_cast(float, __builtin_amdgcn_ds_bpermute((16 * (r >> 2) + r) * 4, __builtin_bit_cast(int, dsel)));
        const float rstd = rsqrtf(ss * (1.f / kD) + kEps);
        const f32x4 lg = (Lh + Ll) * rstd;
        float mx = fmaxf(fmaxf(lg.x, lg.y), fmaxf(lg.z, lg.w)); mx = xmax32(xmax16(mx));
        f32x4 ex; ex.x = __expf(lg.x - mx); ex.y = __expf(lg.y - mx); ex.z = __expf(lg.z - mx); ex.w = __expf(lg.w - mx);
        float sm = (ex.x + ex.y) + (ex.z + ex.w); sm = xsum32(xsum16(sm));
        const float inv = frcp(sm);
        const int row0 = tile * 16, b = row0 >> 13, s0 = (row0 & (kS - 1)) + r;
        { float* ap = aff + ((size_t)(b * kE + 4 * c4)) * kS + s0;
          ap[0] = ex.x * inv; ap[kS] = ex.y * inv; ap[2 * kS] = ex.z * inv; ap[3 * kS] = ex.w * inv; }
        unsigned char* hp = h8 + (size_t)(row0 + r) * kD + 16 * c4;
        const int ntl = tile + tstride;
#pragma unroll
        for (int half = 0; half < 2; ++half) {
#pragma unroll
            for (int u = 8 * half; u < 8 * half + 8; ++u) {
                float v[16]; unpk8s(v, xr[2 * u]); unpk8s(v + 8, xr[2 * u + 1]);
                u32x4 o; unsigned ow[4];
#pragma unroll
                for (int q = 0; q < 4; ++q) { const f32x4 gq = *(const LAS f32x4*)(gtab + 64 * u + 16 * c4 + 4 * q);
                    const f32x4 t = (f32x4){v[4 * q], v[4 * q + 1], v[4 * q + 2], v[4 * q + 3]} * gq * rstd;
                    ow[q] = pk4_fp8(t.x, t.y, t.z, t.w); }
                o.x = ow[0]; o.y = ow[1]; o.z = ow[2]; o.w = ow[3];
                *(u32x4*)(hp + 64 * u) = o;
            }
            if (ntl < ntile) { if (half == 0) RT_ISSUE(0, ntl); else RT_ISSUE(1, ntl); }
        }
    }
#undef RT_ISSUE
    __syncthreads();
}

DEVI int block_excl_scan(int v, int* sh  , int& total) {
    const int lane = tidx() & 63, wid = tidx() >> 6;
    int incl = v;
#pragma unroll
    for (int d = 1; d < 64; d <<= 1) { const int o = __shfl_up(incl, d); if (lane >= d) incl += o; }
    __syncthreads();
    if (lane == 63) sh[wid] = incl;
    __syncthreads();
    int base = 0, tot = 0;
#pragma unroll
    for (int w = 0; w < 8; ++w) { const int c = sh[w]; if (w < wid) base += c; tot += c; }
    total = tot;
    return base + incl - v;
}

DEVI void phase_topk(const float* aff, int* idx, float* gate, int* tokslot, const unsigned char* hsrc, unsigned char* xe, int rowbytes, unsigned char* lds, int bid, int nblk) {
    int* hist = (int*)lds;
    int* sh = hist + 256;
    int* res = sh + 16;
    (void)hsrc; (void)xe; (void)rowbytes;
    const int tid = tidx(), lane = tid & 63, wid = tid >> 6;
    const int share = (nblk >= 2 * kB * kE) ? 2 : 1;
    for (int wi = bid; wi < kB * kE * share; wi += nblk) {
        const int item = wi / share, part = wi - item * share;
        const int b = item >> 4, e = item & 15;
        const float* a = aff + (size_t)item * kS;
        unsigned key[16];
#pragma unroll
        for (int q = 0; q < 4; ++q) { const u32x4 v = *(const u32x4*)(a + tid * 16 + q * 4); key[q * 4 + 0] = v.x; key[q * 4 + 1] = v.y; key[q * 4 + 2] = v.z; key[q * 4 + 3] = v.w; }
        unsigned prefix = 0; int kk = kCap;
#pragma unroll 1
        for (int pass = 0; pass < 4; ++pass) {
            const int shift = 24 - 8 * pass;
            __syncthreads();
            if (tid < 256) hist[tid] = 0;
            __syncthreads();
#pragma unroll
            for (int i = 0; i < 16; ++i) { const bool in = (pass == 0) || ((key[i] >> (shift + 8)) == prefix); if (in) atomicAdd(&hist[(key[i] >> shift) & 255], 1); }
            __syncthreads();
            if (wid == 0) {
                int c[4], loc = 0;
#pragma unroll
                for (int j = 0; j < 4; ++j) { c[j] = hist[255 - 4 * lane - j]; loc += c[j]; }
                int incl = loc;
#pragma unroll
                for (int d = 1; d < 64; d <<= 1) { const int o = __shfl_up(incl, d); if (lane >= d) incl += o; }
                const int excl = incl - loc;
                if (excl < kk && kk <= incl) { int run = excl; int bin = 0, nk = 0; bool found = false;
#pragma unroll
                    for (int j = 0; j < 4; ++j) { if (!found && run + c[j] >= kk) { bin = 255 - 4 * lane - j; nk = kk - run; found = true; } if (!found) run += c[j]; }
                    res[0] = bin; res[1] = nk; }
            }
            __syncthreads();
            prefix = (prefix << 8) | (unsigned)res[0]; kk = res[1];
        }
        const unsigned T = prefix;
        int ceq = 0;
#pragma unroll
        for (int i = 0; i < 16; ++i) ceq += (key[i] == T) ? 1 : 0;
        int tot;
        int eqb = block_excl_scan(ceq, sh, tot);
        int csel = 0; unsigned selmask = 0;
#pragma unroll
        for (int i = 0; i < 16; ++i) { bool s = key[i] > T; if (key[i] == T) { s = eqb < kk; ++eqb; } if (s) { selmask |= 1u << i; ++csel; } }
        int slot = block_excl_scan(csel, sh, tot);
        const size_t rbase = (size_t)(e * kB + b) * kCap;
#pragma unroll
        for (int i = 0; i < 16; ++i) { const int s = tid * 16 + i; const bool sel = (selmask >> i) & 1u;
            const bool mine = (share == 1) || ((i >> 3) == part);
            if (sel && mine) { idx[rbase + slot] = b * kS + s; gate[rbase + slot] = __uint_as_float(key[i]) * (1.f / kY8)  ; }
            if (mine) tokslot[((size_t)(b * kS + s)) * kE + e] = sel ? slot : -1;
            if (sel) ++slot; }
    }
    __syncthreads();
}

struct Unit { int pm, pn, par; };
DEVI bool unit_of(int Lid, int nM, int nN, Unit& u) {
    const int nwg = nM * nN; if (Lid >= nwg) return false;
    int wgid = Lid; { const int q = nwg / 8, r = nwg % 8, xcd = wgid % 8, off = wgid / 8; wgid = (xcd < r ? xcd * (q + 1) : r * (q + 1) + (xcd - r) * q) + off; }
    const int nig = 8 * nN, gid = wgid / nig, fm = gid * 8, gsz = (nM - fm) < 8 ? (nM - fm) : 8;
    u.pm = fm + ((wgid % nig) % gsz); u.pn = (wgid % nig) / gsz; return true;
}
struct GemmD { const bf16_t* A; const bf16_t* Bt; int lda, K, nM, nN; const int* rowidx; size_t bstride; int pmg; };

constexpr int PG_HTB = 128 * 64 * 2;
DEVI int pg_lds_byte(int r, int c) { const int st = (r >> 4) * 2 + (c >> 5), rr = r & 15, cc = c & 31, ob = rr * 64 + cc * 2; return st * 1024 + (ob ^ (((ob >> 9) & 1) << 5)); }
DEVI void pg_stage_rc(int b, int& R, int& C) { const int st = b / 1024, sb = b % 1024, swz = sb ^ (((sb >> 9) & 1) << 5); R = (st >> 1) * 16 + swz / 64; C = (st & 1) * 32 + (swz % 64) / 2; }

typedef int v4i __attribute__((ext_vector_type(4)));
typedef int v8i __attribute__((ext_vector_type(8)));
constexpr int PG_RIDX = 131072 + 4096;
template <class Epi, bool ALIGN_EPI, bool SP2, bool FP8 = false, bool GATHER = false>
DEVI void gemm_engine(LAS unsigned char* lds, const GemmD g, const Epi& E, int bid, int nblk) {
    const int tid = tidx(), wid = __builtin_amdgcn_readfirstlane(tid >> 6), lane = tid & 63, wr = wid >> 2, wc = wid & 3, fr = lane & 15, fq = lane >> 4;
    constexpr int ES = FP8 ? 1 : 2;
    const int K = g.K * ES  , nt = K / 128; const unsigned ldaB = (unsigned)g.lda * ES;
    unsigned voffA[2], voffB[2];
#pragma unroll
    for (int i = 0; i < 2; ++i) { int R, C; pg_stage_rc(tid * 16 + i * 8192, R, C); voffA[i] = (unsigned)R * ldaB + (unsigned)C * 2u; voffB[i] = (unsigned)(R * K + C * 2); }
    const size_t kstep = 128;
    int gR0 = 0; unsigned gcb = 0; { int R, C; pg_stage_rc(tid * 16, R, C); gR0 = R; gcb = (unsigned)C * 2u; } (void)gR0; (void)gcb;
    const size_t hstepB = (size_t)128 * K, hstepA = (size_t)128 * ldaB, tstepA = 2 * hstepA;
    const unsigned ldsw = (unsigned)wid * 1024u;
    const int aoff = pg_lds_byte(wr * 64 + fr, fq * 8), boff = pg_lds_byte(wc * 32 + fr, fq * 8);
#define PG8_SA(b, h) (((b) * 2 + (h)) * PG_HTB)
#define PG8_SB(b, h) ((4 + (b) * 2 + (h)) * PG_HTB)
#define PG8_STAGE(bufoff, gbase, voff) do { _Pragma("unroll") for (int _i = 0; _i < 2; ++_i) \
        __builtin_amdgcn_global_load_lds((const unsigned*)((const char*)(gbase) + (voff)[_i]), (LAS unsigned*)(lds + (bufoff) + ldsw + _i * 8192), 16, 0, 0); } while (0)
#define PG8_STA(bufoff, ptr, koff, half, par) do { if constexpr (GATHER) { \
        const LAS int* rt_ = (const LAS int*)(lds + PG_RIDX + (par) * 1024) + 128 * (half) + gR0; \
        _Pragma("unroll") for (int _i = 0; _i < 2; ++_i) { const unsigned off_ = (unsigned)rt_[64 * _i] * ldaB + gcb; \
            __builtin_amdgcn_global_load_lds((const unsigned*)((const char*)g.A + (koff) + off_), (LAS unsigned*)(lds + (bufoff) + ldsw + _i * 8192), 16, 0, 0); } \
    } else PG8_STAGE(bufoff, ptr, voffA); } while (0)
#define PG8_RD16(off) (*(const LAS v4i*)(lds + (off)))
#define PG8_CAT2(off) __builtin_shufflevector(PG8_RD16(off), PG8_RD16((off) + 1024), 0, 1, 2, 3, 4, 5, 6, 7)
#define PG8_LDA(dst, b, h) do { _Pragma("unroll") for (int m = 0; m < 4; ++m) { if constexpr (FP8) dst##8[m] = PG8_CAT2(PG8_SA(b, h) + aoff + m * 2048); \
        else { _Pragma("unroll") for (int k = 0; k < 2; ++k) dst[m][k] = *(const LAS bf16x8*)(lds + PG8_SA(b, h) + aoff + m * 2048 + k * 1024); } } } while (0)
#define PG8_LDB(dst, b, h) do { _Pragma("unroll") for (int n = 0; n < 2; ++n) { if constexpr (FP8) dst##8[n] = PG8_CAT2(PG8_SB(b, h) + boff + n * 2048); \
        else { _Pragma("unroll") for (int k = 0; k < 2; ++k) dst[n][k] = *(const LAS bf16x8*)(lds + PG8_SB(b, h) + boff + n * 2048 + k * 1024); } } } while (0)
#define PG8_MMA(ai, bj, At, Bt) do { __builtin_amdgcn_s_setprio(1); _Pragma("unroll") for (int m = 0; m < 4; ++m) _Pragma("unroll") for (int n = 0; n < 2; ++n) { \
        if constexpr (FP8) asm volatile("v_mfma_f32_16x16x128_f8f6f4 %0, %1, %2, %0" : "+v"(acc[ai][bj][m][n]) : "v"(Bt##8[n]), "v"(At##8[m]));   \
        else { _Pragma("unroll") for (int k = 0; k < 2; ++k) acc[ai][bj][m][n] = __builtin_amdgcn_mfma_f32_16x16x32_bf16(Bt[n][k], At[m][k], acc[ai][bj][m][n], 0, 0, 0); } } \
        __builtin_amdgcn_s_setprio(0); } while (0)
#define PG8_MMAZ(ai, bj, At, Bt) do { __builtin_amdgcn_s_setprio(1); _Pragma("unroll") for (int m = 0; m < 4; ++m) _Pragma("unroll") for (int n = 0; n < 2; ++n) { \
        if constexpr (FP8) asm volatile("v_mfma_f32_16x16x128_f8f6f4 %0, %1, %2, 0" : "=&v"(acc[ai][bj][m][n]) : "v"(Bt##8[n]), "v"(At##8[m])); \
        else { asm volatile("v_mfma_f32_16x16x32_bf16 %0, %1, %2, 0" : "=&v"(acc[ai][bj][m][n]) : "v"(Bt[n][0]), "v"(At[m][0])); \
               acc[ai][bj][m][n] = __builtin_amdgcn_mfma_f32_16x16x32_bf16(Bt[n][1], At[m][1], acc[ai][bj][m][n], 0, 0, 0); } } \
        __builtin_amdgcn_s_setprio(0); } while (0)
#define PG8_WAIT_V(n) asm volatile("s_waitcnt vmcnt(" #n ")" ::: "memory")
#define PG8_WAIT_L(n) asm volatile("s_waitcnt lgkmcnt(" #n ")" ::: "memory")
#define PG8_BAR __builtin_amdgcn_s_barrier()
#define PG8_SCHED __builtin_amdgcn_sched_barrier(0)
    Unit cur, nxt; int ui = 0;
    if (!unit_of(bid, g.nM, g.nN, cur)) return;
    cur.par = 0; E.stage(lds, cur, wid, lane);
    if constexpr (GATHER) {
        if (wid < 4) __builtin_amdgcn_global_load_lds((const unsigned*)(g.rowidx + cur.pm * 256 + wid * 64 + lane), (LAS unsigned*)(lds + PG_RIDX + wid * 256), 4, 0, 0);
        asm volatile("s_waitcnt vmcnt(0)" ::: "memory"); __builtin_amdgcn_s_barrier();
    }
    f32x4 acc[2][2][4][2];
    if constexpr (!FP8) {
#pragma unroll
    for (int a = 0; a < 2; ++a)
#pragma unroll
        for (int b = 0; b < 2; ++b)
#pragma unroll
            for (int m = 0; m < 4; ++m)
#pragma unroll
                for (int n = 0; n < 2; ++n) acc[a][b][m][n] = (f32x4){0.f, 0.f, 0.f, 0.f};
    }
    bf16x8 At[4][2], B0[2][2], B1[2][2]; v8i At8[4], B08[2], B18[2];
    (void)At; (void)B0; (void)B1; (void)At8; (void)B08; (void)B18;
    static_assert(SP2, "only the two-super-phase K-loop is kept");
    const char* cA = (const char*)g.A + (size_t)cur.pm * tstepA;
    const char* cB = (const char*)g.Bt + (size_t)(cur.pm / g.pmg) * g.bstride * ES + (size_t)cur.pn * 256 * K;
    PG8_STAGE(PG8_SB(0, 0), cB, voffB); PG8_STAGE(PG8_SB(0, 1), cB + hstepB, voffB); PG8_STA(PG8_SA(0, 0), cA, 0u, 0, 0); PG8_STA(PG8_SA(0, 1), cA + hstepA, 0u, 1, 0);
    if (wr == 1) PG8_BAR;
    PG8_WAIT_V(2); PG8_BAR;
    PG8_STAGE(PG8_SB(1, 0), cB + kstep, voffB); PG8_STA(PG8_SA(1, 0), cA + kstep, 128u, 0, 0); PG8_STAGE(PG8_SB(1, 1), cB + hstepB + kstep, voffB);
    PG8_WAIT_V(6); PG8_BAR;
    for (;;) {
        const bool has_next = unit_of((ui + 1) * nblk + bid, g.nM, g.nN, nxt); nxt.par = (ui + 1) & 1;
        if constexpr (GATHER) { if (has_next && wid < 4) __builtin_amdgcn_global_load_lds((const unsigned*)(g.rowidx + nxt.pm * 256 + wid * 64 + lane), (LAS unsigned*)(lds + PG_RIDX + nxt.par * 1024 + wid * 256), 4, 0, 0); }
        const char* nA = has_next ? (const char*)g.A + (size_t)nxt.pm * tstepA : cA;
        const char* nB = has_next ? (const char*)g.Bt + (size_t)(nxt.pm / g.pmg) * g.bstride * ES + (size_t)nxt.pn * 256 * K : cB;
#define PG8_TRIP(MM) do { \
            const bool last = (t == nt - 2); \
            const char* a1 = cA + (size_t)(t + 1) * kstep; \
            const char* a2 = last ? nA : cA + (size_t)(t + 2) * kstep; const char* b2 = last ? nB : cB + (size_t)(t + 2) * kstep; \
            const char* a3 = a2 + kstep; const char* b3 = b2 + kstep; \
            const unsigned gk1 = (unsigned)(t + 1) * 128u, gk2 = last ? 0u : (unsigned)(t + 2) * 128u, gk3 = gk2 + 128u; const int gp2 = (last && has_next) ? nxt.par : cur.par; (void)gk1; (void)gk2; (void)gk3; (void)gp2; \
            PG8_LDB(B0, 0, 0); PG8_LDB(B1, 0, 1); PG8_SCHED; PG8_LDA(At, 0, 0); PG8_STA(PG8_SA(1, 1), a1 + hstepA, gk1, 1, cur.par); \
            PG8_WAIT_V(8); PG8_WAIT_L(0); PG8_BAR; MM(0, 0, At, B0); MM(0, 1, At, B1); PG8_BAR; PG8_SCHED; \
            PG8_LDA(At, 0, 1); PG8_STAGE(PG8_SB(0, 0), b2, voffB); PG8_STAGE(PG8_SB(0, 1), b2 + hstepB, voffB); PG8_STA(PG8_SA(0, 0), a2, gk2, 0, gp2); \
            PG8_WAIT_V(8); PG8_WAIT_L(0); PG8_BAR; MM(1, 0, At, B0); MM(1, 1, At, B1); PG8_BAR; PG8_SCHED; \
            PG8_LDB(B0, 1, 0); PG8_LDB(B1, 1, 1); PG8_SCHED; PG8_LDA(At, 1, 0); PG8_STA(PG8_SA(0, 1), a2 + hstepA, gk2, 1, gp2); \
            PG8_WAIT_V(8); PG8_WAIT_L(0); PG8_BAR; PG8_MMA(0, 0, At, B0); PG8_MMA(0, 1, At, B1); PG8_BAR; PG8_SCHED; \
            PG8_LDA(At, 1, 1); PG8_STAGE(PG8_SB(1, 0), b3, voffB); PG8_STAGE(PG8_SB(1, 1), b3 + hstepB, voffB); PG8_STA(PG8_SA(1, 0), a3, gk3, 0, gp2); \
            PG8_WAIT_V(8); PG8_WAIT_L(0); PG8_BAR; PG8_MMA(1, 0, At, B0); PG8_MMA(1, 1, At, B1); PG8_BAR; PG8_SCHED; } while (0)
        int t = 0;
        if constexpr (FP8) { PG8_TRIP(PG8_MMAZ); t = 2; }
#pragma unroll 1
        for (; t < nt; t += 2) PG8_TRIP(PG8_MMA);
#undef PG8_TRIP
        if constexpr (ALIGN_EPI) { if (wr == 0) PG8_BAR; }
        if constexpr (FP8) asm volatile("s_nop 15\n\ts_nop 15" ::: "memory");
        E(acc, cur, wr, wc, fr, fq);
        if (!has_next) break;
        E.stage(lds, nxt, wid, lane);
        if constexpr (!FP8) {
#pragma unroll
        for (int a = 0; a < 2; ++a)
#pragma unroll
            for (int b = 0; b < 2; ++b)
#pragma unroll
                for (int m = 0; m < 4; ++m)
#pragma unroll
                    for (int n = 0; n < 2; ++n) acc[a][b][m][n] = (f32x4){0.f, 0.f, 0.f, 0.f};
        }
        cur = nxt; cA = nA; cB = nB; ++ui;
        if constexpr (ALIGN_EPI) { if (wr == 1) PG8_BAR; }
    }
    PG8_WAIT_V(0);
    if constexpr (!ALIGN_EPI) { if (wr == 0) PG8_BAR; }
    PG8_BAR;
#undef PG8_SA
#undef PG8_SB
#undef PG8_STAGE
#undef PG8_STA
#undef PG8_LDA
#undef PG8_LDB
#undef PG8_MMA
#undef PG8_MMAZ
#undef PG8_RD16
#undef PG8_CAT2
#undef PG8_WAIT_V
#undef PG8_WAIT_L
#undef PG8_BAR
#undef PG8_SCHED
}

struct EpiQKV {
    static constexpr int VMOPS = 16;
    bf16_t *qa, *ka, *va, *qb, *kb, *vb, *ux;
    const float* rstdp;
    const LAS float* rtab;
    DEVI void stage(LAS unsigned char* lds, const Unit& u, int wid, int lane) const {
        if (wid < 4) __builtin_amdgcn_global_load_lds((const unsigned*)(rstdp + u.pm * 256 + wid * 64 + lane), (LAS unsigned*)(lds + 131072 + 2048 + u.par * 1024 + wid * 256), 4, 0, 0);
    }
    const LAS float* gtab;
    DEVI void operator()(const f32x4 (&acc)[2][2][4][2], const Unit& u, int wr, int wc, int fr, int fq) const {
        const int pn = u.pn;
        bf16_t* dst = (pn < 2) ? qa : (pn < 4) ? ka : (pn < 6) ? va : (pn == 6) ? qb : (pn == 7) ? kb : (pn == 8) ? vb : ux;
        const int H = (pn < 6) ? 8 : 4, head = ((pn < 6) ? (pn & 1) * 4 : 0) + wc;
        const int trow = (pn < 2) ? 0 : (pn < 4) ? 1 : (pn == 6) ? 2 : (pn == 7) ? 3 : 4;
        const bool nrm = trow < 4;
        f32x4 gv[2][2];
#pragma unroll
        for (int bj = 0; bj < 2; ++bj)
#pragma unroll
            for (int n = 0; n < 2; ++n) gv[bj][n] = *(const LAS f32x4*)(gtab + trow * 64 + 32 * bj + 8 * fq + 4 * n);
        const size_t hb = (size_t)head * kS * 64 + 8 * fq;
        const int g0 = 4 * wc + (fq >> 1), c0 = 8 * (fq & 1);
#pragma unroll
        for (int ai = 0; ai < 2; ++ai)
#pragma unroll
            for (int m = 0; m < 4; ++m) {
                const int row = u.pm * 256 + 128 * ai + 64 * wr + 16 * m + fr;
                float ss = 0.f;
#pragma unroll
                for (int bj = 0; bj < 2; ++bj)
#pragma unroll
                    for (int n = 0; n < 2; ++n) { const f32x4 v = acc[ai][bj][m][n]; ss += v.x * v.x + v.y * v.y + v.z * v.z + v.w * v.w; }
                ss = xsum32(xsum16(ss));
                const float rr = rtab[u.par * 256 + 128 * ai + 64 * wr + 16 * m + fr];
                const float rs = __builtin_amdgcn_rsqf(ss * rr * rr * (1.f / 64.f) + kEps) * rr, rstd = nrm ? rs : rr;
                const int b = row >> 13, sq = row & (kS - 1);
                const size_t o_qkv = ((size_t)b * H * kS + sq) * 64 + hb, o_u = ((size_t)g0 * 4096 + (row >> 4)) * 512 + (row & 15) * 16 + c0;
#pragma unroll
                for (int bj = 0; bj < 2; ++bj) {
                    const f32x4 v0 = acc[ai][bj][m][0] * rstd * gv[bj][0], v1 = acc[ai][bj][m][1] * rstd * gv[bj][1];
                    u32x4 w; w.x = pk2(v0.x, v0.y); w.y = pk2(v0.z, v0.w); w.z = pk2(v1.x, v1.y); w.w = pk2(v1.z, v1.w);
                    const size_t o = (pn < 9) ? o_qkv + 32 * bj : o_u + (size_t)bj * 2 * 4096 * 512;
                    *(u32x4*)(dst + o) = w;
                }
            }
    }
};
struct EpiResid {
    DEVI void stage(LAS unsigned char*, const Unit&, int, int) const {}
    static constexpr int VMOPS = 16;
    bf16_t* xb; bf16_t* xbo;
    DEVI void operator()(const f32x4 (&acc)[2][2][4][2], const Unit& u, int wr, int wc, int fr, int fq) const {
#pragma unroll
        for (int ai = 0; ai < 2; ++ai) {
            const size_t r0 = (size_t)(u.pm * 256 + 128 * ai + 64 * wr + fr) * kD + u.pn * 256 + 32 * wc + 8 * fq;
            {
                u32x4 a[4][2];
#pragma unroll
                for (int m = 0; m < 4; ++m)
#pragma unroll
                    for (int bj = 0; bj < 2; ++bj) a[m][bj] = *(const u32x4*)(xb + r0 + (size_t)m * 16 * kD + 128 * bj);
#pragma unroll
                for (int m = 0; m < 4; ++m)
#pragma unroll
                    for (int bj = 0; bj < 2; ++bj) { const size_t o = r0 + (size_t)m * 16 * kD + 128 * bj; const u32x4 w = a[m][bj];
                        const f32x4 v0 = (f32x4){__uint_as_float(w.x << 16), __uint_as_float(w.x & 0xFFFF0000u), __uint_as_float(w.y << 16), __uint_as_float(w.y & 0xFFFF0000u)} + acc[ai][bj][m][0];
                        const f32x4 v1 = (f32x4){__uint_as_float(w.z << 16), __uint_as_float(w.z & 0xFFFF0000u), __uint_as_float(w.w << 16), __uint_as_float(w.w & 0xFFFF0000u)} + acc[ai][bj][m][1];
                        u32x4 r; r.x = pk2(v0.x, v0.y); r.y = pk2(v0.z, v0.w); r.z = pk2(v1.x, v1.y); r.w = pk2(v1.z, v1.w); *(u32x4*)(xbo + o) = r; }
            }
        }
    }
};
struct EpiGU {
    DEVI void stage(LAS unsigned char*, const Unit&, int, int) const {}
    static constexpr int VMOPS = 4;
    bf16_t* hid; float sc;
    DEVI void silu8(const f32x4 (&acc)[2][2][4][2], int ai, int m, float (&o)[8]) const {
        const float k1 = -sc * kLog2e, k3 = 1.f / (sc * sc * kH8);
#pragma unroll
        for (int n = 0; n < 2; ++n)
#pragma unroll
            for (int j = 0; j < 4; j += 2) { const f32x2 a = {acc[ai][0][m][n][j], acc[ai][0][m][n][j + 1]}, b = {acc[ai][1][m][n][j], acc[ai][1][m][n][j + 1]};
                const f32x2 ab = a * b, t = a * k1; f32x2 d; d.x = __builtin_amdgcn_exp2f(t.x); d.y = __builtin_amdgcn_exp2f(t.y); d = d * k3 + k3;
                f32x2 r; r.x = frcp(d.x); r.y = frcp(d.y); const f32x2 v = ab * r;
                o[n * 4 + j] = v.x; o[n * 4 + j + 1] = v.y; }
    }
    DEVI void operator()(const f32x4 (&acc)[2][2][4][2], const Unit& u, int wr, int wc, int fr, int fq) const {
#pragma unroll
        for (int ai = 0; ai < 2; ++ai)
#pragma unroll
            for (int m = 0; m < 4; m += 2) {
                float o0[8], o1[8]; silu8(acc, ai, m, o0); silu8(acc, ai, m + 1, o1);
                unsigned ax = pk4_fp8(o0[0], o0[1], o0[2], o0[3]), ay = pk4_fp8(o0[4], o0[5], o0[6], o0[7]), bx = pk4_fp8(o1[0], o1[1], o1[2], o1[3]), by = pk4_fp8(o1[4], o1[5], o1[6], o1[7]);
                swap16u(ax, bx); swap16u(ay, by);
                const size_t row = (size_t)(u.pm * 256 + 128 * ai + 64 * wr + 16 * (m + (fq & 1)) + fr);
                u32x4 w; w.x = ax; w.y = ay; w.z = bx; w.w = by;
                *(u32x4*)((unsigned char*)hid + row * kFF + u.pn * 128 + 32 * wc + 8 * (fq & ~1)) = w;
            }
    }
};
struct EpiDown {
    DEVI void stage(LAS unsigned char*, const Unit&, int, int) const {}
    static constexpr int VMOPS = 8;
    bf16_t* y; float sc;
    DEVI static unsigned pk4c(const f32x4 v) { return pk4_fp8(v.x, v.y, v.z, v.w); }
    DEVI void operator()(const f32x4 (&acc)[2][2][4][2], const Unit& u, int wr, int wc, int fr, int fq) const {
        const float gv = sc * kY8;
#pragma unroll
        for (int ai = 0; ai < 2; ++ai)
#pragma unroll
            for (int m = 0; m < 4; m += 2)
#pragma unroll
                for (int bj = 0; bj < 2; ++bj) {
                    unsigned ax = pk4c(acc[ai][bj][m][0] * gv), ay = pk4c(acc[ai][bj][m][1] * gv), bx = pk4c(acc[ai][bj][m + 1][0] * gv), by = pk4c(acc[ai][bj][m + 1][1] * gv);
                    swap16u(ax, bx); swap16u(ay, by);
                    const size_t row = (size_t)(u.pm * 256 + 128 * ai + 64 * wr + 16 * (m + (fq & 1)) + fr);
                    u32x4 w; w.x = ax; w.y = ay; w.z = bx; w.w = by;
                    *(u32x4*)((unsigned char*)y + row * kD + u.pn * 256 + 128 * bj + 32 * wc + 8 * (fq & ~1)) = w;
                }
    }
};
struct EpiGlu {
    DEVI void stage(LAS unsigned char*, const Unit&, int, int) const {}
    static constexpr int VMOPS = 16;
    const bf16_t* g; bf16_t* oc;
    DEVI void operator()(const f32x4 (&acc)[2][2][4][2], const Unit& u, int wr, int wc, int fr, int fq) const {
#pragma unroll
        for (int ai = 0; ai < 2; ++ai) {
            const size_t r0 = (size_t)(u.pm * 256 + 128 * ai + 64 * wr + fr) * 256 + 32 * wc + 8 * fq;
            u32x4 gw[4][2];
#pragma unroll
            for (int m = 0; m < 4; ++m)
#pragma unroll
                for (int bj = 0; bj < 2; ++bj) gw[m][bj] = *(const u32x4*)(g + r0 + (size_t)m * 16 * 256 + 128 * bj);
#pragma unroll
            for (int m = 0; m < 4; ++m)
#pragma unroll
                for (int bj = 0; bj < 2; ++bj) { const size_t o = r0 + (size_t)m * 16 * 256 + 128 * bj; float gg[8]; unpk8s(gg, gw[m][bj]); float o8[8];
#pragma unroll
                    for (int n = 0; n < 2; ++n)
#pragma unroll
                        for (int j = 0; j < 4; ++j) o8[n * 4 + j] = gg[n * 4 + j] * frcp(1.f + __expf(-acc[ai][bj][m][n][j]));
                    u32x4 w; w.x = pk2(o8[0], o8[1]); w.y = pk2(o8[2], o8[3]); w.z = pk2(o8[4], o8[5]); w.w = pk2(o8[6], o8[7]);
                    *(u32x4*)(oc + o) = w; }
        }
    }
};

typedef float f32x16 __attribute__((ext_vector_type(16)));
typedef short s16x4 __attribute__((ext_vector_type(4)));
DEVI bf16x8 tr_pair(LAS unsigned char* p0, LAS unsigned char* p1) {
    const s16x4 a = __builtin_amdgcn_ds_read_tr16_b64_v4i16((LAS s16x4*)p0), b = __builtin_amdgcn_ds_read_tr16_b64_v4i16((LAS s16x4*)p1);
    return (bf16x8){a.x, a.y, a.z, a.w, b.x, b.y, b.z, b.w};
}
DEVI void phase_dilated(const bf16_t* qa, const bf16_t* ka, const bf16_t* va, const float* gq, const float* gk, bf16_t* oac, float* lse, LAS unsigned char* lds, int bid, int nblk) {
    const int tid = tidx(), wid = __builtin_amdgcn_readfirstlane(tid >> 6), lane = tid & 63, h5 = lane >> 5, qc = lane & 31;
    LAS unsigned char* Kimg = lds; LAS unsigned char* Vimg = lds + 49152;
    float Mn;
    { float a = fabsf(gq[lane]), b = fabsf(gk[lane]);
#pragma unroll
      for (int m = 32; m >= 1; m >>= 1) { a = fmaxf(a, __shfl_xor(a, m)); b = fmaxf(b, __shfl_xor(b, m)); }
      Mn = 8.f * a * b; }
    const float Mb = Mn * kLog2e;
    unsigned koff[4];
#pragma unroll
    for (int s = 0; s < 4; ++s) koff[s] = (unsigned)((32 * wid + qc) * 128 + (((2 * s + h5) ^ (qc & 7)) << 4));
    unsigned voff[2];
    { const int g = lane >> 4, i16 = lane & 15, q = i16 >> 2, p = i16 & 3;
#pragma unroll
      for (int dt = 0; dt < 2; ++dt) { const int c = (2 * (g & 1) + (p >> 1) + 4 * dt) ^ ((q >> 1) << 2); voff[dt] = (unsigned)((32 * wid + 4 * h5 + q) * 128 + (c << 4) + 8 * (p & 1)); } }
    const float dbase = (float)(4 * h5 - qc);
    u32x4 pK[6], pV[6];
#define DIL_DECODE(unit_) const int c = (unit_) >> 11, rem = (unit_) & 2047, bh = rem >> 5, ub = ((rem & 7) << 2) | ((rem >> 3) & 3);   \
        const int dsh = 2 * c, L = kS >> dsh, upc = 32 >> dsh, cls = ub >> (5 - dsh), u0 = (ub & (upc - 1)) << 8;
#define DIL_PREFETCH(unit_) do { DIL_DECODE(unit_) \
        const bf16_t* kbase = ka + (size_t)bh * kS * 64; const bf16_t* vbase = va + (size_t)bh * kS * 64; \
        _Pragma("unroll") for (int it = 0; it < 6; ++it) { const int id = it * kNT + tid, row = id >> 3, ch = id & 7; \
            int ki = u0 - 64 + row; ki = ki < 0 ? 0 : (ki > L - 1 ? L - 1 : ki); const size_t tok = (size_t)((ki << dsh) + cls); \
            pK[it] = *(const u32x4*)(kbase + tok * 64 + ch * 8); pV[it] = *(const u32x4*)(vbase + tok * 64 + ch * 8); } } while (0)
    if (bid < 6144) DIL_PREFETCH(bid);
    for (int unit = bid; unit < 6144; unit += nblk) {
        DIL_DECODE(unit)
        const int q0 = u0 + 32 * wid, qtok = ((q0 + qc) << dsh) + cls;
        bf16x8 Qf[4];
#pragma unroll
        for (int s = 0; s < 4; ++s) Qf[s] = *(const bf16x8*)(qa + ((size_t)bh * kS + qtok) * 64 + 16 * s + 8 * h5);
        __syncthreads();
#pragma unroll
        for (int it = 0; it < 6; ++it) { const int id = it * kNT + tid, row = id >> 3, ch = id & 7;
            *(LAS u32x4*)(Kimg + row * 128 + ((ch ^ (row & 7)) << 4)) = pK[it];
            *(LAS u32x4*)(Vimg + row * 128 + ((ch ^ (((row >> 1) & 1) << 2)) << 4)) = pV[it]; }
        __syncthreads();
        if (unit + nblk < 6144) DIL_PREFETCH(unit + nblk);
        const float slope = exp2f(-(float)((bh & 7) + 1));
        const float c2 = slope * (float)(1 << dsh) * kLog2e;
        float sum = 0.f;
        f32x16 O[2];
#pragma unroll
        for (int dt = 0; dt < 2; ++dt)
#pragma unroll
            for (int i = 0; i < 16; ++i) O[dt][i] = 0.f;
        const float ndb = -dbase;
#define DIL_QK(dst, kt_) do { { const int kp0_ = q0 - 64 + 32 * (kt_); const float tm_ = (kp0_ >= 0 && kp0_ < L) ? 0.f : -1e30f; \
            const float cs_ = ((kt_) < 2) ? c2 : -c2, c0_ = (((kt_) == 0 || (kt_) == 4) ? -64.f : ((kt_) == 2 ? 0.f : -32.f)) * c2 - Mb + tm_; \
            const float bt_ = dbase * cs_ + c0_; \
            _Pragma("unroll") for (int i = 0; i < 16; i += 2) { const float k0 = (float)((i & 3) + 8 * (i >> 2)), k1 = (float)(((i + 1) & 3) + 8 * ((i + 1) >> 2)); f32x2 t; \
                if ((kt_) == 2) { const f32x2 d = {fabsf(dbase + k0), fabsf(dbase + k1)}; t = d * cs_ + c0_; } else t = (f32x2){k0, k1} * cs_ + bt_; \
                dst[i] = t.x; dst[i + 1] = t.y; } } \
            _Pragma("unroll") for (int s = 0; s < 4; ++s) { const bf16x8 Kf = *(const LAS bf16x8*)(Kimg + koff[s] + (kt_) * 4096); dst = __builtin_amdgcn_mfma_f32_32x32x16_bf16(Kf, Qf[s], dst, 0, 0, 0); } } while (0)
        f32x16 S, Sn;
        DIL_QK(S, 0);
        f32x2 sum2 = {0.f, 0.f};
#pragma unroll
        for (int kt = 0; kt < 5; ++kt) {
            if (kt < 4) DIL_QK(Sn, kt + 1);
#pragma unroll
            for (int i = 0; i < 16; i += 2) {
                const float k0 = (float)((i & 3) + 8 * (i >> 2)), k1 = (float)(((i + 1) & 3) + 8 * ((i + 1) >> 2));
                f32x2 sv = (f32x2){S[i], S[i + 1]};
                if (kt == 0) { sv.x = (k0 >= ndb) ? sv.x : -1e30f; sv.y = (k1 >= ndb) ? sv.y : -1e30f; }
                if (kt == 4) { sv.x = (k0 <= ndb) ? sv.x : -1e30f; sv.y = (k1 <= ndb) ? sv.y : -1e30f; }
                f32x2 pv; pv.x = __builtin_amdgcn_exp2f(sv.x); pv.y = __builtin_amdgcn_exp2f(sv.y);
                S[i] = pv.x; S[i + 1] = pv.y; sum2 += pv;
            }
#pragma unroll
            for (int s2 = 0; s2 < 2; ++s2) {
                u32x4 pw; pw.x = pk2(S[8 * s2 + 0], S[8 * s2 + 1]); pw.y = pk2(S[8 * s2 + 2], S[8 * s2 + 3]); pw.z = pk2(S[8 * s2 + 4], S[8 * s2 + 5]); pw.w = pk2(S[8 * s2 + 6], S[8 * s2 + 7]);
                const bf16x8 Pf = __builtin_bit_cast(bf16x8, pw);
#pragma unroll
                for (int dt = 0; dt < 2; ++dt) { LAS unsigned char* vp = Vimg + voff[dt] + kt * 4096 + s2 * 2048;
                    const bf16x8 Vf = tr_pair(vp, vp + 1024);
                    O[dt] = __builtin_amdgcn_mfma_f32_32x32x16_bf16(Vf, Pf, O[dt], 0, 0, 0); }
            }
            if (kt < 4) S = Sn;
        }
#undef DIL_QK
        sum = sum2.x + sum2.y;
        sum = xsum32(sum);
        const float inv = 1.f / sum;
        const size_t tok = (size_t)(bh >> 3) * kS + qtok;
        {
        LAS unsigned char* ost = lds + 98304 + wid * 4096;
#pragma unroll
        for (int dt = 0; dt < 2; ++dt)
#pragma unroll
            for (int g4 = 0; g4 < 4; ++g4) { u32x2 w; w.x = pk2(O[dt][4 * g4] * inv, O[dt][4 * g4 + 1] * inv); w.y = pk2(O[dt][4 * g4 + 2] * inv, O[dt][4 * g4 + 3] * inv);
                *(LAS u32x2*)(ost + qc * 128 + (((4 * dt + g4) ^ (qc & 7)) << 4) + 8 * h5) = w; }
        if (h5 == 0) lse[((size_t)c * kTok + tok) * 8 + (bh & 7)] = Mn + __logf(sum);
        bf16_t* obase = oac + ((size_t)c * kTok + (size_t)(bh >> 3) * kS) * 512 + (bh & 7) * 64;
#pragma unroll
        for (int it = 0; it < 4; ++it) { const int r = it * 8 + (lane >> 3), ch = lane & 7;
            const u32x4 v = *(const LAS u32x4*)(ost + r * 128 + ((ch ^ (r & 7)) << 4));
            const size_t t2 = (size_t)(((q0 + r) << dsh) + cls);
            *(u32x4*)(obase + t2 * 512 + ch * 8) = v; }
        }
    }
#undef DIL_DECODE
#undef DIL_PREFETCH
    __syncthreads();
}
DEVI void phase_na(const bf16_t* qb, const bf16_t* kb, const bf16_t* vb, const float* rpb  , const float* gq, const float* gk, bf16_t* ob, LAS unsigned char* lds, int bid, int nblk) {
    const int tid = tidx(), wid = __builtin_amdgcn_readfirstlane(tid >> 6), lane = tid & 63, g4 = lane >> 4, i16 = lane & 15;
    LAS unsigned char* Kimg = lds; LAS unsigned char* Vimg = lds + 73728; LAS float* tab = (LAS float*)(lds + 147456);
    __syncthreads();
    for (int i = tid; i < 4 * 465; i += kNT) tab[i] = rpb[i];
    float Mq;
    { float a = fabsf(gq[lane]), b = fabsf(gk[lane]);
#pragma unroll
      for (int m = 32; m >= 1; m >>= 1) { a = fmaxf(a, __shfl_xor(a, m)); b = fmaxf(b, __shfl_xor(b, m)); }
      Mq = 8.f * a * b; }
    __syncthreads();
    if (wid < 4) { float m = 0.f; for (int i = lane; i < 465; i += 64) m = fmaxf(m, fabsf(tab[wid * 465 + i]));
#pragma unroll
        for (int k = 32; k >= 1; k >>= 1) m = fmaxf(m, __shfl_xor(m, k));
        if (lane == 0) tab[1860 + wid] = m; }
    __syncthreads();
    const int g = wid & 3, kcs = (16 * g - 8) < 0 ? 0 : ((16 * g - 8) > 32 ? 32 : (16 * g - 8));
    const int qcol = 16 * g + i16, cs = (qcol - 8) < 0 ? 0 : ((qcol - 8) > 48 ? 48 : (qcol - 8));
    unsigned kswz[2];
#pragma unroll
    for (int s = 0; s < 2; ++s) kswz[s] = (unsigned)(((4 * s + g4) ^ (i16 & 7)) << 4);
    const int q = i16 >> 2, p = i16 & 3, sw = 2 * (g4 & 1) + (q >> 1);
    unsigned vsw[4];
#pragma unroll
    for (int dt = 0; dt < 4; ++dt) vsw[dt] = (unsigned)((((2 * dt + (p >> 1)) ^ (sw << 1)) << 4) + 8 * (p & 1));
    const int scol = tid >> 3, sch = tid & 7;
    const unsigned skoff = (unsigned)(scol * 128 + ((sch ^ (scol & 7)) << 4)), svoff = (unsigned)(scol * 128 + ((sch ^ (((scol >> 1) & 3) << 1)) << 4));
    u32x4 pK[2], pV[2];
    for (int run = bid; run < 256; run += nblk) {
      const int bh = run >> 3, h = bh & 3;
      const bf16_t* kbase = kb + (size_t)bh * kS * 64 + scol * 64 + sch * 8; const bf16_t* vbase = vb + (size_t)bh * kS * 64 + scol * 64 + sch * 8;
      const LAS float* th = tab + h * 465;
      const float Mb = (Mq + tab[1860 + h]) * kLog2e;
      const int ecol0 = kcs + 4 * g4 - cs, dcb0 = kcs + 4 * g4 - qcol + 15;
      f32x4 Bi[8][2];
#pragma unroll
      for (int u = 0; u < 8; ++u)
#pragma unroll
          for (int tt = 0; tt < 2; ++tt)
#pragma unroll
              for (int jj = 0; jj < 4; ++jj) { const int e = ecol0 + 16 * tt + jj; int dc = dcb0 + 16 * tt + jj; dc = dc < 0 ? 0 : (dc > 30 ? 30 : dc);
                  Bi[u][tt][jj] = ((unsigned)e < 16u) ? th[(u + 3) * 31 + dc] * kLog2e - Mb : -1e30f; }
#pragma unroll 1
      for (int j = 0; j < 8; ++j) {
        const int rp = (run & 7) * 8 + j, r0 = 2 * rp;
        const int rsA = (r0 - 4) < 0 ? 0 : ((r0 - 4) > 120 ? 120 : (r0 - 4));
        const int prsA = (r0 - 6) < 0 ? 0 : ((r0 - 6) > 120 ? 120 : (r0 - 6));
        const int rr = r0 + (wid >> 2);
        const int rs = (rr - 4) < 0 ? 0 : ((rr - 4) > 120 ? 120 : (rr - 4));
        const int qtok = rr * 64 + qcol;
        bf16x8 Qf[2];
#pragma unroll
        for (int s = 0; s < 2; ++s) Qf[s] = *(const bf16x8*)(qb + ((size_t)bh * kS + qtok) * 64 + 32 * s + 8 * g4);
        __syncthreads();
        if (j == 0) {
#pragma unroll
            for (int it = 0; it < 9; ++it) { const int gr = rsA + it; if (gr < 128) { const int sl = gr % 9;
                const u32x4 kv = *(const u32x4*)(kbase + (size_t)gr * 64 * 64), vv = *(const u32x4*)(vbase + (size_t)gr * 64 * 64);
                *(LAS u32x4*)(Kimg + sl * 8192 + skoff) = kv; *(LAS u32x4*)(Vimg + sl * 8192 + svoff) = vv; } }
        } else {
#pragma unroll
            for (int it = 0; it < 2; ++it) { const int gr = prsA + 9 + it; if (gr <= rsA + 8 && gr < 128) { const int sl = gr % 9;
                *(LAS u32x4*)(Kimg + sl * 8192 + skoff) = pK[it]; *(LAS u32x4*)(Vimg + sl * 8192 + svoff) = pV[it]; } }
        }
        __syncthreads();
        if (j < 7) {
            const int nrsA = (r0 - 2) < 0 ? 0 : ((r0 - 2) > 120 ? 120 : (r0 - 2));
#pragma unroll
            for (int it = 0; it < 2; ++it) { int gr = rsA + 9 + it; gr = (gr <= nrsA + 8 && gr < 128) ? gr : 127;
                pK[it] = *(const u32x4*)(kbase + (size_t)gr * 64 * 64); pV[it] = *(const u32x4*)(vbase + (size_t)gr * 64 * 64); }
        }
        const int sb0 = rs % 9;
        const unsigned kb0 = (unsigned)((kcs + i16) * 128), vb0 = (unsigned)((kcs + 4 * g4 + q) * 128);
        float sum = 0.f;
        f32x4 O[4];
#pragma unroll
        for (int dt = 0; dt < 4; ++dt) O[dt] = (f32x4){0.f, 0.f, 0.f, 0.f};
#define NA_SO(u_) ((unsigned)((sb0 + (u_) >= 9 ? sb0 + (u_) - 9 : sb0 + (u_)) * 8192))
#define NA_QK(dst, u_, INIT) do { const unsigned so_ = NA_SO(u_); _Pragma("unroll") for (int tt = 0; tt < 2; ++tt) { \
            const bf16x8 Kf0 = *(const LAS bf16x8*)(Kimg + kb0 + so_ + tt * 2048 + kswz[0]), Kf1 = *(const LAS bf16x8*)(Kimg + kb0 + so_ + tt * 2048 + kswz[1]); \
            dst[tt] = __builtin_amdgcn_mfma_f32_16x16x32_bf16(Kf0, Qf[0], INIT(u_, tt), 0, 0, 0); dst[tt] = __builtin_amdgcn_mfma_f32_16x16x32_bf16(Kf1, Qf[1], dst[tt], 0, 0, 0); } } while (0)
#define NA_SOFTPV(S_, u_) do { const unsigned so_ = NA_SO(u_); \
            _Pragma("unroll") for (int tt = 0; tt < 2; ++tt) _Pragma("unroll") for (int jj = 0; jj < 4; ++jj) { const float pv = __builtin_amdgcn_exp2f(S_[tt][jj]); S_[tt][jj] = pv; sum += pv; } \
            u32x4 pw; pw.x = pk2(S_[0][0], S_[0][1]); pw.y = pk2(S_[0][2], S_[0][3]); pw.z = pk2(S_[1][0], S_[1][1]); pw.w = pk2(S_[1][2], S_[1][3]); \
            const bf16x8 Pf = __builtin_bit_cast(bf16x8, pw); \
            _Pragma("unroll") for (int dt = 0; dt < 4; ++dt) { LAS unsigned char* vp = Vimg + vb0 + so_ + vsw[dt]; \
                const bf16x8 Vf = tr_pair(vp, vp + 2048); \
                O[dt] = __builtin_amdgcn_mfma_f32_16x16x32_bf16(Vf, Pf, O[dt], 0, 0, 0); } } while (0)
#define NA_INIT_REG(u_, tt_) Bi[u_][tt_]
        if (rs - rr == -4) {
            f32x4 S[2], Sn[2];
            NA_QK(S, 0, NA_INIT_REG);
#pragma unroll
            for (int u = 0; u < 8; ++u) {
                if (u < 7) NA_QK(Sn, u + 1, NA_INIT_REG);
                NA_SOFTPV(S, u);
                if (u < 7) { S[0] = Sn[0]; S[1] = Sn[1]; }
            }
        } else {
            int g4v = g4; asm volatile("" : "+v"(g4v));
            const int ecol = kcs + 4 * g4v - cs, dcb = kcs + 4 * g4v - qcol + 15;
#pragma unroll
            for (int u = 0; u < 8; ++u) {
                const LAS float* tr = th + (rs + u - rr + 7) * 31;
                f32x4 In[2];
#pragma unroll
                for (int tt = 0; tt < 2; ++tt)
#pragma unroll
                    for (int jj = 0; jj < 4; ++jj) { const int e = ecol + 16 * tt + jj; int dc = dcb + 16 * tt + jj; dc = dc < 0 ? 0 : (dc > 30 ? 30 : dc);
                        In[tt][jj] = ((unsigned)e < 16u) ? tr[dc] * kLog2e - Mb : -1e30f; }
#define NA_INIT_TAB(u_, tt_) In[tt_]
                f32x4 S[2];
                NA_QK(S, u, NA_INIT_TAB);
                NA_SOFTPV(S, u);
#undef NA_INIT_TAB
            }
        }
#undef NA_INIT_REG
#undef NA_SOFTPV
#undef NA_QK
#undef NA_SO
        sum = xsum32(xsum16(sum));
        const float inv = 1.f / sum;
        bf16_t* orow = ob + ((size_t)(bh >> 2) * kS + qtok) * 256 + h * 64;
#pragma unroll
        for (int dt = 0; dt < 4; ++dt) { u32x2 w; w.x = pk2(O[dt][0] * inv, O[dt][1] * inv); w.y = pk2(O[dt][2] * inv, O[dt][3] * inv); *(u32x2*)(orow + 16 * dt + 4 * g4) = w; }
      }
    }
    __syncthreads();
}
DEVI void unpk8(float* d, const u32x4 q, const float sc) {
    d[0] += sc * __uint_as_float(q.x << 16); d[1] += sc * __uint_as_float(q.x & 0xFFFF0000u); d[2] += sc * __uint_as_float(q.y << 16); d[3] += sc * __uint_as_float(q.y & 0xFFFF0000u);
    d[4] += sc * __uint_as_float(q.z << 16); d[5] += sc * __uint_as_float(q.z & 0xFFFF0000u); d[6] += sc * __uint_as_float(q.w << 16); d[7] += sc * __uint_as_float(q.w & 0xFFFF0000u);
}
DEVI void phase_mixnorm(const bf16_t* oac, const float* lse, const bf16_t* ob, const bf16_t* oc, const float* ga, const float* gb, const float* gc, bf16_t* mix, int bid, int nblk) {
    const int wid = tidx() >> 6, lane = tidx() & 63;
    float gn[16];
    { const float* gp = (lane < 32) ? ga + lane * 16 : (lane < 48) ? gb + (lane - 32) * 16 : gc + (lane - 48) * 16;
#pragma unroll
      for (int i = 0; i < 16; ++i) gn[i] = gp[i]; }
    const int stride = nblk * 8;
    int row = bid * 8 + wid;
    if (row >= kTok) return;
    u32x4 Aq[6], Bq[6]; float Al[3], Bl[3];
    const bool dil = lane < 32;
    const int hh = dil ? (lane >> 2) : 0;
#define MX_ISSUE(R, Q, L) do { \
        const bf16_t* p0_ = dil ? oac + (size_t)(R) * 512 + lane * 16 : ((lane < 48) ? ob + (size_t)(R) * 256 + (lane - 32) * 16 : oc + (size_t)(R) * 256 + (lane - 48) * 16); \
        const size_t cst_ = dil ? (size_t)kTok * 512 : (size_t)0; \
        Q[0] = *(const u32x4*)p0_; Q[1] = *(const u32x4*)(p0_ + 8); Q[2] = *(const u32x4*)(p0_ + cst_); Q[3] = *(const u32x4*)(p0_ + cst_ + 8); Q[4] = *(const u32x4*)(p0_ + 2 * cst_); Q[5] = *(const u32x4*)(p0_ + 2 * cst_ + 8); \
        L[0] = lse[(size_t)(R) * 8 + hh]; L[1] = lse[((size_t)kTok + (R)) * 8 + hh]; L[2] = lse[((size_t)2 * kTok + (R)) * 8 + hh]; } while (0)
#define MX_BODY(C, N) do { \
        const int nrow_ = (row + stride < kTok) ? row + stride : row; \
        MX_ISSUE(nrow_, N##q, N##l); \
        float v[16]; \
        _Pragma("unroll") for (int i = 0; i < 16; ++i) v[i] = 0.f; \
        float w0 = 1.f, w1 = 0.f, w2 = 0.f; \
        if (dil) { const float mx = fmaxf(C##l[0], fmaxf(C##l[1], C##l[2])); w0 = __expf(C##l[0] - mx); w1 = __expf(C##l[1] - mx); w2 = __expf(C##l[2] - mx); const float inv = frcp(w0 + w1 + w2); w0 *= inv; w1 *= inv; w2 *= inv; } \
        unpk8(v, C##q[0], w0); unpk8(v + 8, C##q[1], w0); unpk8(v, C##q[2], w1); unpk8(v + 8, C##q[3], w1); unpk8(v, C##q[4], w2); unpk8(v + 8, C##q[5], w2); \
        float ss = 0.f; \
        _Pragma("unroll") for (int i = 0; i < 16; ++i) ss += v[i] * v[i]; \
        ss = row_sum16(ss); \
        { float a = ss, b = ss; swap16(a, b); if (lane < 32) ss = a + b; } \
        const float rstd = rsqrtf(ss * ((lane < 32) ? (1.f / 512.f) : (1.f / 256.f)) + kEps); \
        u32x4 o0, o1; \
        o0.x = pk2(v[0] * rstd * gn[0], v[1] * rstd * gn[1]); o0.y = pk2(v[2] * rstd * gn[2], v[3] * rstd * gn[3]); o0.z = pk2(v[4] * rstd * gn[4], v[5] * rstd * gn[5]); o0.w = pk2(v[6] * rstd * gn[6], v[7] * rstd * gn[7]); \
        o1.x = pk2(v[8] * rstd * gn[8], v[9] * rstd * gn[9]); o1.y = pk2(v[10] * rstd * gn[10], v[11] * rstd * gn[11]); o1.z = pk2(v[12] * rstd * gn[12], v[13] * rstd * gn[13]); o1.w = pk2(v[14] * rstd * gn[14], v[15] * rstd * gn[15]); \
        *(u32x4*)(mix + (size_t)row * kD + lane * 16) = o0; *(u32x4*)(mix + (size_t)row * kD + lane * 16 + 8) = o1; } while (0)
    MX_ISSUE(row, Aq, Al);
    for (;;) {
        MX_BODY(A, B); row += stride; if (row >= kTok) break;
        MX_BODY(B, A); row += stride; if (row >= kTok) break;
    }
#undef MX_BODY
#undef MX_ISSUE
}
DEVI void phase_combine(bf16_t* xb, bf16_t* xbo, float* out32, const bf16_t* y, const float* gate, const int* tokslot, bool last_layer, float* rstdp, int bid, int nblk) {
    const int wid = tidx() >> 6, lane = tidx() & 63;
    const int stride = nblk * 8;
    int row = bid * 8 + wid;
    if (row >= kTok) return;
    u32x4 Ax0, Ax1, Ay[4], Bx0, Bx1, By[4]; float Ag[4], Bg[4]; unsigned Am = 0u, Bm = 0u;
#define CB_ISSUE(R, TS, X0, X1, Y, G, M) do { const int b_ = (R) >> 13; \
        M = (unsigned)__builtin_amdgcn_ballot_w64(lane < 16 && (TS) >= 0); unsigned mm_ = M; \
        X0 = *(const u32x4*)(xb + (size_t)(R) * kD + lane * 16); X1 = *(const u32x4*)(xb + (size_t)(R) * kD + lane * 16 + 8); \
        _Pragma("unroll") for (int j = 0; j < 4; ++j) { const bool has_ = mm_ != 0u; const int e_ = has_ ? __builtin_ctz(mm_) : 0; const int sl_ = has_ ? __builtin_amdgcn_readlane((TS), e_) : 0; \
            const size_t r_ = has_ ? (size_t)(e_ * kB + b_) * kCap + sl_ : (size_t)0; Y[j] = *(const u32x4*)((const unsigned char*)y + r_ * kD + lane * 16); G[j] = gate[r_]; mm_ &= mm_ - 1u; } } while (0)
#define CB_ACC(YV, GS) do { const unsigned ww_[4] = {(YV).x, (YV).y, (YV).z, (YV).w}; const float gs_ = __builtin_bit_cast(float, __builtin_amdgcn_readfirstlane(__builtin_bit_cast(int, (GS))));   \
        _Pragma("unroll") for (int k = 0; k < 4; ++k) { const f32x2 lo = __builtin_amdgcn_cvt_pk_f32_fp8(ww_[k], false), hi = __builtin_amdgcn_cvt_pk_f32_fp8(ww_[k], true); \
            v[4 * k] += lo.x * gs_; v[4 * k + 1] += lo.y * gs_; v[4 * k + 2] += hi.x * gs_; v[4 * k + 3] += hi.y * gs_; } } while (0)
#define CB_BODY(C, N) do { \
        const int nrow_ = (row + stride < kTok) ? row + stride : row, nnrow_ = (row + 2 * stride < kTok) ? row + 2 * stride : row, b = row >> 13; \
        const int ts2 = tokslot[(size_t)nnrow_ * kE + (lane & 15)]; \
        CB_ISSUE(nrow_, ts1, N##x0, N##x1, N##y, N##g, N##m); \
        float v[16]; unpk8s(v, C##x0); unpk8s(v + 8, C##x1); \
        unsigned mm = C##m; \
        _Pragma("unroll") for (int j = 0; j < 4; ++j) { if (mm != 0u) CB_ACC(C##y[j], C##g[j]); mm &= mm - 1u; } \
        while (mm != 0u) { const int e = __builtin_ctz(mm), sl = __builtin_amdgcn_readlane(ts0, e); const size_t r = (size_t)(e * kB + b) * kCap + sl; \
            const u32x4 yv = *(const u32x4*)((const unsigned char*)y + r * kD + lane * 16); const float gs = gate[r]; CB_ACC(yv, gs); mm &= mm - 1u; } \
        if (last_layer) { \
            _Pragma("unroll") for (int k = 0; k < 4; ++k) *(f32x4*)(out32 + (size_t)row * kD + lane * 16 + 4 * k) = (f32x4){v[4 * k], v[4 * k + 1], v[4 * k + 2], v[4 * k + 3]}; \
        } else { u32x4 o0, o1; \
            o0.x = pk2(v[0], v[1]); o0.y = pk2(v[2], v[3]); o0.z = pk2(v[4], v[5]); o0.w = pk2(v[6], v[7]); o1.x = pk2(v[8], v[9]); o1.y = pk2(v[10], v[11]); o1.z = pk2(v[12], v[13]); o1.w = pk2(v[14], v[15]); \
            *(u32x4*)(xbo + (size_t)row * kD + lane * 16) = o0; *(u32x4*)(xbo + (size_t)row * kD + lane * 16 + 8) = o1; \
            unpk8s(v, o0); unpk8s(v + 8, o1);                     \
            float ss = 0.f; \
            _Pragma("unroll") for (int i = 0; i < 16; ++i) ss += v[i] * v[i]; \
            ss = wave_sum(ss); \
            if (lane == 0) rstdp[row] = rsqrtf(ss * (1.f / kD) + kEps);     \
        } \
        ts0 = ts1; ts1 = ts2; } while (0)
    int ts0 = tokslot[(size_t)row * kE + (lane & 15)];
    int ts1 = tokslot[(size_t)((row + stride < kTok) ? row + stride : row) * kE + (lane & 15)];
    CB_ISSUE(row, ts0, Ax0, Ax1, Ay, Ag, Am);
    for (;;) {
        CB_BODY(A, B); row += stride; if (row >= kTok) break;
        CB_BODY(B, A); row += stride; if (row >= kTok) break;
    }
#undef CB_BODY
#undef CB_ISSUE
#undef CB_ACC
}

DEVI void cpow_m(double a, double w, double dt, int m, float& re, float& im) {
    const float mag = __expf((float)m * (float)a * (float)dt);
    const double turns = (double)m * w * dt * 0.15915494309189535; const float ang = (float)((turns - floor(turns)) * 6.283185307179586);
    re = mag * cosf(ang); im = mag * sinf(ang);
}
DEVI void s5_prep_item(const Params& P, int l, int g, unsigned char* lds_) {
    float* pw = (float*)lds_;
    float* bb = pw + 4352;
    float* cc = bb + 4096;
    float* kt = cc + 4096;
    const int tid = tidx();
    __syncthreads();
    for (int i = tid; i < 128; i += kNT) { const int dir = i >> 6, p = i & 63; const size_t pb = (((size_t)l * 2 + dir) * 16 + g) * 64 + p;
        const double dt = (double)__expf(P.s5_log_dt[((size_t)l * 2 + dir) * 16 + g]); const double a = (double)fminf(P.s5_a_re[pb], -1e-4f), w = (double)P.s5_a_im[pb];
        for (int m = 0; m < 17; ++m) { float re, im; cpow_m(a, w, dt, m, re, im); pw[((dir * 64 + p) * 17 + m) * 2] = re; pw[((dir * 64 + p) * 17 + m) * 2 + 1] = im; }
        const float af = (float)a, wf = (float)w, ar = pw[((dir * 64 + p) * 17 + 1) * 2], ai = pw[((dir * 64 + p) * 17 + 1) * 2 + 1];
        const float den = af * af + wf * wf, zr = ar - 1.f, gr = (zr * af + ai * wf) / den, gi = (ai * af - zr * wf) / den;
        for (int c = 0; c < 16; ++c) { const float br = P.s5_b_re[pb * 16 + c], bi = P.s5_b_im[pb * 16 + c]; bb[((dir * 64 + p) * 16 + c) * 2] = gr * br - gi * bi; bb[((dir * 64 + p) * 16 + c) * 2 + 1] = gr * bi + gi * br; }
    }
    for (int i = tid; i < 2048; i += kNT) { const int dir = i >> 10, c = (i >> 6) & 15, p = i & 63; const size_t o = ((((size_t)l * 2 + dir) * 16 + g) * 16 + c) * 64 + p; cc[i * 2] = P.s5_c_re[o]; cc[i * 2 + 1] = P.s5_c_im[o]; }
    __syncthreads();
    for (int i = tid; i < 8192; i += kNT) { const int dir = i >> 12, m = (i >> 8) & 15, c = (i >> 4) & 15, c2 = i & 15; float acc = 0.f;
        for (int p = 0; p < 64; ++p) { const float cr = cc[((dir * 16 + c) * 64 + p) * 2], ci = cc[((dir * 16 + c) * 64 + p) * 2 + 1], wr_ = pw[((dir * 64 + p) * 17 + m) * 2], wi_ = pw[((dir * 64 + p) * 17 + m) * 2 + 1];
            const float br = bb[((dir * 64 + p) * 16 + c2) * 2], bi = bb[((dir * 64 + p) * 16 + c2) * 2 + 1]; const float tr = cr * wr_ - ci * wi_, ti = cr * wi_ + ci * wr_; acc += tr * br - ti * bi; }
        kt[i] = acc; }
    __syncthreads();
    bf16_t* wst = (bf16_t*)(wsp(P) + WS_WST) + ((size_t)l * 16 + g) * 256 * 256;
    bf16_t* wso = (bf16_t*)(wsp(P) + WS_WSO) + ((size_t)l * 16 + g) * 256 * 512;
    for (int id = tid; id < 8192; id += kNT) { const int n = id >> 5, k0 = (id & 31) * 8, dir = n >> 7, p = (n >> 1) & 63, ri = n & 1; float v[8];
#pragma unroll
        for (int kk = 0; kk < 8; ++kk) { const int k = k0 + kk, t = k >> 4, c = k & 15, e = dir ? t : 15 - t; const float wr_ = pw[((dir * 64 + p) * 17 + e) * 2], wi_ = pw[((dir * 64 + p) * 17 + e) * 2 + 1], br = bb[((dir * 64 + p) * 16 + c) * 2], bi = bb[((dir * 64 + p) * 16 + c) * 2 + 1];
            v[kk] = ri ? (wr_ * bi + wi_ * br) : (wr_ * br - wi_ * bi); }
        u32x4 o; o.x = pk2(v[0], v[1]); o.y = pk2(v[2], v[3]); o.z = pk2(v[4], v[5]); o.w = pk2(v[6], v[7]); *(u32x4*)(wst + (size_t)n * 256 + k0) = o; }
    for (int id = tid; id < 16384; id += kNT) { const int ns = id >> 6, k0 = (id & 63) * 8, n = cmap_pk(ns), t = n >> 4, c = n & 15; float v[8];
#pragma unroll
        for (int kk = 0; kk < 8; ++kk) { const int k = k0 + kk; float x;
            if (k < 256) { const int j = k >> 4, c2 = k & 15; x = 0.f; if (j <= t) x += kt[(t - j) * 256 + c * 16 + c2]; if (j >= t) x += kt[4096 + (j - t) * 256 + c * 16 + c2]; if (j == t && c == c2) x += P.s5_d[l * 256 + g * 16 + c]; }
            else { const int q = k - 256, dir = q >> 7, p = (q >> 1) & 63, ri = q & 1, e = dir ? 16 - t : t + 1; const float cr = cc[((dir * 16 + c) * 64 + p) * 2], ci = cc[((dir * 16 + c) * 64 + p) * 2 + 1], wr_ = pw[((dir * 64 + p) * 17 + e) * 2], wi_ = pw[((dir * 64 + p) * 17 + e) * 2 + 1];
                x = ri ? -(cr * wi_ + ci * wr_) : (cr * wr_ - ci * wi_); }
            v[kk] = x; }
        u32x4 o; o.x = pk2(v[0], v[1]); o.y = pk2(v[2], v[3]); o.z = pk2(v[4], v[5]); o.w = pk2(v[6], v[7]); *(u32x4*)(wso + (size_t)ns * 512 + k0) = o; }
    __syncthreads();
}
DEVI void phase_s5_scan(const Params& P, int l, const float* Z, bf16_t* ux, unsigned char* lds_, int bid, int nblk) {
    const int tid = tidx(), wid = tid >> 6, lane = tid & 63;
    float* E = (float*)lds_;
    for (int item = bid; item < 256; item += nblk) {
        const int dir = item & 1, g = (item >> 1) & 15, b = item >> 5;
        const size_t pb = (((size_t)l * 2 + dir) * 16 + g) * 64 + lane;
        const double dt = (double)__expf(P.s5_log_dt[((size_t)l * 2 + dir) * 16 + g]); const double a = (double)fminf(P.s5_a_re[pb], -1e-4f), w = (double)P.s5_a_im[pb];
        float a16r, a16i, Ar, Ai; cpow_m(a, w, dt, 16, a16r, a16i); cpow_m(a, w, dt, 1024, Ar, Ai);
        const int kk0 = dir ? 511 - 64 * wid : 64 * wid; const long sstep = dir ? -1 : 1;
        const float* zp = Z + ((size_t)g * 4096 + b * 512 + kk0) * 256 + dir * 128 + 2 * lane;
        f32x2 z[64];
#pragma unroll
        for (int i = 0; i < 64; ++i) { z[i] = *(const f32x2*)zp; zp += sstep * 256; }
        float xr = 0.f, xi = 0.f;
#pragma unroll
        for (int i = 0; i < 64; ++i) { const float nr = a16r * xr - a16i * xi + z[i].x, ni = a16r * xi + a16i * xr + z[i].y; xr = nr; xi = ni; }
        __syncthreads();
        E[(wid * 64 + lane) * 2] = xr; E[(wid * 64 + lane) * 2 + 1] = xi;
        __syncthreads();
        float sr = 0.f, si = 0.f;
#pragma unroll
        for (int s2 = 0; s2 < 7; ++s2) if (s2 < wid) { const float er = E[(s2 * 64 + lane) * 2], ei = E[(s2 * 64 + lane) * 2 + 1]; const float nr = Ar * sr - Ai * si + er, ni = Ar * si + Ai * sr + ei; sr = nr; si = ni; }
        bf16_t* up = ux + ((size_t)g * 4096 + b * 512 + kk0) * 512 + 256 + dir * 128 + 2 * lane;
#pragma unroll
        for (int i = 0; i < 64; ++i) { *(unsigned*)up = pk2(sr, si); up += sstep * 512;
            const float nr = a16r * sr - a16i * si + z[i].x, ni = a16r * si + a16i * sr + z[i].y; sr = nr; si = ni; }
    }
    __syncthreads();
}
struct EpiF32N {
    DEVI void stage(LAS unsigned char*, const Unit&, int, int) const {}
    static constexpr int VMOPS = 32;
    float* z; int ldz;
    DEVI void operator()(const f32x4 (&acc)[2][2][4][2], const Unit& u, int wr, int wc, int fr, int fq) const {
#pragma unroll
        for (int ai = 0; ai < 2; ++ai)
#pragma unroll
            for (int m = 0; m < 4; ++m) { const size_t ro = (size_t)(u.pm * 256 + 128 * ai + 64 * wr + 16 * m + fr) * ldz + u.pn * 256 + 32 * wc + 4 * fq;
#pragma unroll
                for (int bj = 0; bj < 2; ++bj)
#pragma unroll
                    for (int n = 0; n < 2; ++n) *(f32x4*)(z + ro + 128 * bj + 16 * n) = acc[ai][bj][m][n]; }
    }
};
struct EpiS5Out {
    DEVI void stage(LAS unsigned char*, const Unit&, int, int) const {}
    static constexpr int VMOPS = 16;
    bf16_t* G;
    DEVI void operator()(const f32x4 (&acc)[2][2][4][2], const Unit& u, int wr, int wc, int fr, int fq) const {
#pragma unroll
        for (int ai = 0; ai < 2; ++ai)
#pragma unroll
            for (int m = 0; m < 4; ++m) { const int R = u.pm * 256 + 128 * ai + 64 * wr + 16 * m + fr, g = R >> 12, ck = R & 4095;
#pragma unroll
                for (int bj = 0; bj < 2; ++bj) { const int t = 8 * bj + 2 * wc + (fq >> 1), c0 = 8 * (fq & 1);
                    const f32x4 v0 = acc[ai][bj][m][0], v1 = acc[ai][bj][m][1];
                    u32x4 w; w.x = pk2(gelu_tanh(v0.x), gelu_tanh(v0.y)); w.y = pk2(gelu_tanh(v0.z), gelu_tanh(v0.w)); w.z = pk2(gelu_tanh(v1.x), gelu_tanh(v1.y)); w.w = pk2(gelu_tanh(v1.z), gelu_tanh(v1.w));
                    *(u32x4*)(G + ((size_t)ck * 16 + t) * 256 + g * 16 + c0) = w; } }
    }
};
#define XB_TMO      128
#define XB_XCNT(j)  (256  + 64 * (j))
#define XB_XSUB(j)  (1280 + 64 * (j))
#define XB_XGEN(j)  (2304 + 64 * (j))
#define XB_TOP      3328
#define XB_TOPGEN   3392
#define XCD_BAR_WORDS 3456
#define XB_SPIN_CAP (1u << 26)
DEVI unsigned xb_ld(unsigned* p)              { return __hip_atomic_load(p, __ATOMIC_RELAXED, __HIP_MEMORY_SCOPE_AGENT); }
DEVI unsigned xb_add(unsigned* p, unsigned v) { return __hip_atomic_fetch_add(p, v, __ATOMIC_RELAXED, __HIP_MEMORY_SCOPE_AGENT); }
DEVI unsigned xb_xcc_id() { return (unsigned)__builtin_amdgcn_s_getreg((3 << 11) | 20) & 0xFu; }
#define XB_SPIN(cond, bar) do { unsigned _sp = 0; while (cond) { __builtin_amdgcn_s_sleep(1); \
    if ((++_sp & 255u) == 0u) { if (xb_ld(&(bar)[XB_TMO])) break; if (_sp > XB_SPIN_CAP) { atomicAdd(&(bar)[XB_TMO], 1u); break; } } } } while (0)
struct XcdBarrier { unsigned* bar; unsigned x; volatile LAS unsigned* st; };
DEVI XcdBarrier xcd_barrier_post(unsigned* bar, volatile LAS unsigned* st) {
    XcdBarrier b; b.bar = bar; b.x = xb_xcc_id(); b.st = st;
    if (threadIdx.x == 0) (void)xb_add(&bar[XB_XCNT(b.x)], 1u);
    return b;
}
DEVI void xcd_barrier_complete(unsigned* bar, unsigned x, unsigned& nloc, unsigned& nx) {
    const unsigned G = gridDim.x * gridDim.y * gridDim.z;
    unsigned sum, cnt, mine, sp = 0u;
    for (;;) {
        sum = 0u; cnt = 0u; mine = 0u;
#pragma unroll
        for (unsigned j = 0; j < 16; ++j) { const unsigned c = xb_ld(&bar[XB_XCNT(j)]); sum += c; cnt += (c > 0u) ? 1u : 0u; mine = (j == x) ? c : mine; }
        if (sum == G) break;
        __builtin_amdgcn_s_sleep(1);
        if ((++sp & 255u) == 0u) { if (xb_ld(&bar[XB_TMO])) break; if (sp > XB_SPIN_CAP) { atomicAdd(&bar[XB_TMO], 1u); break; } }
    }
    nloc = mine > 0u ? mine : 1u; nx = cnt > 0u ? cnt : 1u;
}
DEVI void xcd_barrier(const XcdBarrier& b) {
    asm volatile("s_waitcnt vmcnt(0)" ::: "memory");
    __syncthreads();
    if (threadIdx.x == 0) {
        unsigned long long bp_ = (unsigned long long)b.bar; asm volatile("" : "+s"(bp_));
        unsigned* bar = (unsigned*)bp_;
        const unsigned bx = xb_xcc_id();
        __builtin_amdgcn_s_waitcnt(0);
        unsigned nloc = b.st[0], nx = b.st[1];
        if (nloc == 0u) { xcd_barrier_complete(bar, bx, nloc, nx); b.st[0] = nloc; b.st[1] = nx; }
        const unsigned old = xb_add(&bar[XB_XSUB(bx)], 1u);
        const unsigned gen = old / nloc;
        if (old + 1u == (gen + 1u) * nloc) {
            __builtin_amdgcn_fence(__ATOMIC_RELEASE, "agent");
            asm volatile("s_waitcnt vmcnt(0)" ::: "memory");
            const unsigned og = xb_add(&bar[XB_TOP], 1u);
            const unsigned tg = og / nx;
            if (og + 1u == (tg + 1u) * nx) xb_add(&bar[XB_TOPGEN], 1u);
            else XB_SPIN(xb_ld(&bar[XB_TOPGEN]) == tg, bar);
            __builtin_amdgcn_fence(__ATOMIC_ACQUIRE, "agent");
            xb_add(&bar[XB_XGEN(bx)], 1u);
            asm volatile("s_waitcnt vmcnt(0)" ::: "memory");
        } else {
            XB_SPIN(xb_ld(&bar[XB_XGEN(bx)]) == gen, bar);
            __builtin_amdgcn_fence(__ATOMIC_ACQUIRE, "agent");
            asm volatile("s_waitcnt vmcnt(0)" ::: "memory");
        }
    }
    __syncthreads();
}

constexpr int LDS_BYTES = 147456 + 8192 + 16;
#define GEMM_RUN(g, E) gemm_engine<decltype(E), true, true>((LAS unsigned char*)dyn_lds, g, E, bid, nblk)
#define GEMM_RUN8(g, E) gemm_engine<decltype(E), true, true, true>((LAS unsigned char*)dyn_lds, g, E, bid, nblk)
#define GEMM_RUN8G(g, E) gemm_engine<decltype(E), true, true, true, true>((LAS unsigned char*)dyn_lds, g, E, bid, nblk)
extern __shared__ __attribute__((aligned(16))) unsigned char dyn_lds[];

DEVI GemmD mk_gemm(const bf16_t* A, const bf16_t* Bt, int lda, int K, int nM, int nN, const int* rowidx, size_t bstride, int pmg) {
    GemmD g; g.A = A; g.Bt = Bt; g.lda = lda; g.K = K; g.nM = nM; g.nN = nN; g.rowidx = rowidx; g.bstride = bstride; g.pmg = pmg; return g; }

DEVI void ph_win(const Params& P, int l, int bid, int nblk) {
    const GemmD g = mk_gemm((const bf16_t*)(wsp(P) + WS_XB), (const bf16_t*)(wsp(P) + WS_WINT) + (size_t)l * kINW * kD, kD, kD, kTok / 256, 10, nullptr, 0, 1 << 30);
    unsigned char* r1 = wsp(P) + WS_R1;
    EpiQKV E; E.qa = (bf16_t*)(r1 + R1_QA); E.ka = (bf16_t*)(r1 + R1_KA); E.va = (bf16_t*)(r1 + R1_VA); E.qb = (bf16_t*)(r1 + R1_QB); E.kb = (bf16_t*)(r1 + R1_KB); E.vb = (bf16_t*)(r1 + R1_VB); E.ux = (bf16_t*)(r1 + R1_UX);
    E.rstdp = (const float*)(wsp(P) + WS_RSTD); E.rtab = (const LAS float*)((LAS unsigned char*)dyn_lds + 131072 + 2048);
    { LAS float* tab = (LAS float*)((LAS unsigned char*)dyn_lds + 131072);
      const int t = tidx();
      if (t < 320) { const int r = t >> 6, c = t & 63; tab[t] = (r == 0) ? P.q_norm_a[l * 64 + c] * (0.125f * kLog2e)   : (r == 1) ? P.k_norm_a[l * 64 + c] : (r == 2) ? P.q_norm_b[l * 64 + c] * (0.125f * kLog2e)   : (r == 3) ? P.k_norm_b[l * 64 + c] : 1.f; }
      __syncthreads();
      E.gtab = tab; }
    GEMM_RUN(g, E);
}
DEVI void ph_dilated(const Params& P, int l, int bid, int nblk) { unsigned char* r1 = wsp(P) + WS_R1;
    phase_dilated((const bf16_t*)(r1 + R1_QA), (const bf16_t*)(r1 + R1_KA), (const bf16_t*)(r1 + R1_VA), P.q_norm_a + l * 64, P.k_norm_a + l * 64, (bf16_t*)(wsp(P) + WS_R2), (float*)(wsp(P) + WS_LSE), (LAS unsigned char*)dyn_lds, bid, nblk);
}
DEVI void ph_na(const Params& P, int l, int bid, int nblk) { unsigned char* r1 = wsp(P) + WS_R1;
    phase_na((const bf16_t*)(r1 + R1_QB), (const bf16_t*)(r1 + R1_KB), (const bf16_t*)(r1 + R1_VB), P.rpb + (size_t)l * 4 * 15 * 31, P.q_norm_b + l * 64, P.k_norm_b + l * 64, (bf16_t*)(r1 + R1_OB), (LAS unsigned char*)dyn_lds, bid, nblk);
}
DEVI void ph_s5_prep(const Params& P, unsigned char* lds, int bid, int nblk) { for (int it = bid; it < kL * 16; it += nblk) s5_prep_item(P, it >> 4, it & 15, lds); }
DEVI void ph_s5_state(const Params& P, int l, int bid, int nblk) {
    const GemmD g = mk_gemm((const bf16_t*)(wsp(P) + WS_R1 + R1_UX), (const bf16_t*)(wsp(P) + WS_WST) + (size_t)l * 16 * 256 * 256, 512, 256, 256, 1, nullptr, (size_t)256 * 256, 16);
    EpiF32N E; E.z = (float*)(wsp(P) + WS_R2 + R2_Z); E.ldz = 256;
    GEMM_RUN(g, E);
}
DEVI void ph_s5_scan(const Params& P, int l, unsigned char* lds, int bid, int nblk) { phase_s5_scan(P, l, (const float*)(wsp(P) + WS_R2 + R2_Z), (bf16_t*)(wsp(P) + WS_R1 + R1_UX), lds, bid, nblk); }
DEVI void ph_s5_out(const Params& P, int l, int bid, int nblk) {
    const GemmD g = mk_gemm((const bf16_t*)(wsp(P) + WS_R1 + R1_UX), (const bf16_t*)(wsp(P) + WS_WSO) + (size_t)l * 16 * 256 * 512, 512, 512, 256, 1, nullptr, (size_t)256 * 512, 16);
    EpiS5Out E; E.G = (bf16_t*)(wsp(P) + WS_R1 + R1_G);
    GEMM_RUN(g, E);
}
DEVI void ph_glu(const Params& P, int l, int bid, int nblk) {
    const GemmD g = mk_gemm((const bf16_t*)(wsp(P) + WS_R1 + R1_G), (const bf16_t*)(wsp(P) + WS_WGLUT) + (size_t)l * 256 * 256, 256, 256, kTok / 256, 1, nullptr, 0, 1 << 30);
    EpiGlu E; E.g = (const bf16_t*)(wsp(P) + WS_R1 + R1_G); E.oc = (bf16_t*)(wsp(P) + WS_R1 + R1_OC);
    GEMM_RUN(g, E);
}
DEVI void ph_mixnorm(const Params& P, int l, int bid, int nblk) { unsigned char* r1 = wsp(P) + WS_R1;
    phase_mixnorm((const bf16_t*)(wsp(P) + WS_R2), (const float*)(wsp(P) + WS_LSE), (const bf16_t*)(r1 + R1_OB), (const bf16_t*)(r1 + R1_OC), P.out_norm_a + l * 512, P.out_norm_b + l * 256, P.out_norm_c + l * 256, (bf16_t*)(wsp(P) + WS_H), bid, nblk); }
DEVI void ph_wout(const Params& P, int l, int bid, int nblk) {
    const GemmD g = mk_gemm((const bf16_t*)(wsp(P) + WS_H), (const bf16_t*)(wsp(P) + WS_WOUTT) + (size_t)l * kD * kD, kD, kD, kTok / 256, 4, nullptr, 0, 1 << 30);
    EpiResid E; E.xb = (bf16_t*)(wsp(P) + WS_XB); E.xbo = E.xb;
    GEMM_RUN(g, E);
}
DEVI void ph_router(const Params& P, int l, unsigned char* lds, int bid, int nblk) { phase_router((const bf16_t*)(wsp(P) + WS_XB), P.ffn_norm + (size_t)l * kD, wsp(P) + WS_RTAB + (size_t)l * 65536, wsp(P) + WS_H, (float*)(wsp(P) + WS_AFF), (LAS unsigned char*)dyn_lds, bid, nblk); }
DEVI void ph_topk(const Params& P, unsigned char* lds, int bid, int nblk) { phase_topk((const float*)(wsp(P) + WS_AFF), (int*)(wsp(P) + WS_IDX), (float*)(wsp(P) + WS_GATE), (int*)(wsp(P) + WS_TSLOT), wsp(P) + WS_H, nullptr  , kD, lds, bid, nblk); }
DEVI void ph_gu(const Params& P, int l, int bid, int nblk) {
    const GemmD g = mk_gemm((const bf16_t*)(wsp(P) + WS_H), (const bf16_t*)(wsp(P) + WS_WGUT + (size_t)l * kE * 4096 * kD), kD, kD, 512, 16, (const int*)(wsp(P) + WS_IDX), (size_t)4096 * kD, 32);
    EpiGU E; E.hid = (bf16_t*)(wsp(P) + WS_R1); E.sc = 1.f / kW8;
    GEMM_RUN8G(g, E);
}
DEVI void ph_down(const Params& P, int l, int bid, int nblk) {
    const GemmD g = mk_gemm((const bf16_t*)(wsp(P) + WS_R1), (const bf16_t*)(wsp(P) + WS_WDT + (size_t)l * kE * kD * kFF), kFF, kFF, 512, 4, nullptr, (size_t)kD * kFF, 32);
    EpiDown E; E.y = (bf16_t*)(wsp(P) + WS_R2); E.sc = 1.f / (kW8 * kH8);
    GEMM_RUN8(g, E);
}
DEVI void ph_combine(const Params& P, int l, int bid, int nblk) { phase_combine((bf16_t*)(wsp(P) + WS_XB), (bf16_t*)(wsp(P) + WS_XB), P.out, (const bf16_t*)(wsp(P) + WS_R2), (const float*)(wsp(P) + WS_GATE), (const int*)(wsp(P) + WS_TSLOT), l + 1 == kL, (float*)(wsp(P) + WS_RSTD), bid, nblk); }

__global__ void __launch_bounds__(kNT, 2) mega_fwd(Params P) {
    asm volatile("s_setreg_imm32_b32 hwreg(HW_REG_MODE, 23, 1), 1");

    volatile LAS unsigned* st = (volatile LAS unsigned*)(dyn_lds + LDS_BYTES - 16);
    if (threadIdx.x == 0) { st[0] = 0u; st[1] = 0u; st[2] = 0u; st[3] = 0u; }
    __syncthreads();
    const XcdBarrier bar = xcd_barrier_post((unsigned*)(P.ws + WS_CTL), st);
    const int bid = blockIdx.x, nblk = gridDim.x;
    unsigned char* lds = dyn_lds;
    phase_convert(P, lds, lnd(bid), nblk);
    ph_s5_prep(P, lds, lnd(bid), nblk);
    router_prep(P, lnd(bid), nblk);
    phase_norm(P.x, (bf16_t*)(wsp(P) + WS_XB), (float*)(wsp(P) + WS_RSTD), lnd(bid), nblk);
    xcd_barrier(bar);
#pragma unroll 1
    for (int l = 0; l < kL; ++l) {
        ph_win(P, l, lnd(bid), nblk);             xcd_barrier(bar);
        ph_s5_state(P, l, lnd(bid), nblk);        xcd_barrier(bar);
        ph_s5_scan(P, l, lds, lnd(bid), nblk);
        ph_dilated(P, l, lnd(bid), nblk);
        ph_na(P, l, lnd(bid), nblk);              xcd_barrier(bar);
        ph_s5_out(P, l, lnd(bid), nblk);          xcd_barrier(bar);
        ph_glu(P, l, lnd(bid), nblk);             xcd_barrier(bar);
        ph_mixnorm(P, l, lnd(bid), nblk);         xcd_barrier(bar);
        ph_wout(P, l, lnd(bid), nblk);            xcd_barrier(bar);
        ph_router(P, l, lds, lnd(bid), nblk);     xcd_barrier(bar);
        ph_topk(P, lds, lnd(bid), nblk);          xcd_barrier(bar);
        ph_gu(P, l, lnd(bid), nblk);              xcd_barrier(bar);
        ph_down(P, l, lnd(bid), nblk);            xcd_barrier(bar);
        ph_combine(P, l, lnd(bid), nblk);         xcd_barrier(bar);
    }
}

extern "C" void kernel_launch(void* const* d_in, const int* in_sizes, int n_in, void* d_out, int out_size, void* d_ws, size_t ws_size, hipStream_t stream) {
    (void)in_sizes; (void)n_in; (void)out_size;
    if (ws_size < WS_END) { fprintf(stderr, "workspace too small: %zu < %zu\n", ws_size, (size_t)WS_END); return; }
    Params P{};
    const float** pp = (const float**)&P;
    for (int i = 0; i < 26; ++i) pp[i] = (const float*)d_in[i];
    P.out = (float*)d_out; P.ws = (unsigned char*)d_ws;
    static int grid = 0;
    if (!grid) {
        int dev = 0, cus = 0, per_cu = 0;
        (void)hipGetDevice(&dev);
        (void)hipDeviceGetAttribute(&cus, hipDeviceAttributeMultiprocessorCount, dev);
        (void)hipFuncSetAttribute((const void*)mega_fwd, hipFuncAttributeMaxDynamicSharedMemorySize, LDS_BYTES);
        (void)hipOccupancyMaxActiveBlocksPerMultiprocessor(&per_cu, (const void*)mega_fwd, kNT, LDS_BYTES);
        grid = (per_cu >= 1) ? cus : 0;
        if (!grid) fprintf(stderr, "mega_fwd does not fit a CU\n");
    }
    if (!grid) return;
    (void)hipMemsetAsync(P.ws + WS_CTL, 0, XCD_BAR_WORDS * sizeof(unsigned), stream);
    mega_fwd<<<grid, kNT, LDS_BYTES, stream>>>(P);
}
```

```cpp
#include <hip/hip_runtime.h>
#include <stdint.h>
#include <stdio.h>

#define DEVI __device__ __forceinline__
#define LAS __attribute__((address_space(3)))
typedef unsigned short bf16_t;
typedef short bf16x8 __attribute__((ext_vector_type(8)));
typedef float f32x4 __attribute__((ext_vector_type(4)));
typedef float f32x2 __attribute__((ext_vector_type(2)));
typedef unsigned u32x4 __attribute__((ext_vector_type(4)));
typedef unsigned u32x2 __attribute__((ext_vector_type(2)));

constexpr int kB = 8, kS = 8192, kD = 1024, kL = 4, kTok = kB * kS;
constexpr int kINW = 2560;
constexpr int kE = 16, kCap = 1024, kFF = 2048;
constexpr int kNT = 512;
constexpr float kEps = 1e-6f;
constexpr float kLog2e = 1.4426950408889634f, kLn2 = 0.6931471805599453f;

constexpr size_t MiB = 1024ull * 1024ull;
constexpr size_t WS_CTL   = 0;
constexpr size_t WS_RSTD  = 512 * 1024;
constexpr size_t WS_WINT  = 1 * MiB;
constexpr size_t WS_WOUTT = WS_WINT + 20 * MiB;
constexpr size_t WS_WGLUT = WS_WOUTT + 8 * MiB;
constexpr size_t WS_RTAB  = WS_WGLUT + 512 * 1024;
constexpr size_t WS_WGUT  = WS_WGLUT + 1 * MiB;
constexpr size_t WS_WDT   = WS_WGUT + 512 * MiB;
constexpr size_t WS_H     = WS_WDT + 256 * MiB;
constexpr size_t WS_R1    = WS_H + 128 * MiB;
constexpr size_t WS_R2    = WS_R1 + 512 * MiB;
constexpr size_t WS_AFF   = WS_R2 + 256 * MiB;
constexpr size_t WS_IDX   = WS_AFF + 4 * MiB;
constexpr size_t WS_GATE  = WS_IDX + 1 * MiB;
constexpr size_t WS_TSLOT = WS_GATE + 1 * MiB;
constexpr size_t WS_LSE   = WS_TSLOT + 4 * MiB;
constexpr size_t WS_WST   = WS_LSE + 8 * MiB;
constexpr size_t WS_WSO   = WS_WST + 8 * MiB;
constexpr size_t WS_XB    = WS_WSO + 16 * MiB;
constexpr size_t WS_END   = WS_XB + 128 * MiB;
constexpr size_t R2_Z     = 192 * MiB;
constexpr size_t R1_QA = 0, R1_KA = 64 * MiB, R1_VA = 128 * MiB, R1_QB = 192 * MiB, R1_KB = 224 * MiB, R1_VB = 256 * MiB,
                 R1_UX = 288 * MiB, R1_OB = 352 * MiB, R1_OC = 384 * MiB, R1_G = 416 * MiB;

struct Params {
    const float* x; const float* attn_norm; const float* w_in; const float* q_norm_a; const float* k_norm_a; const float* q_norm_b; const float* k_norm_b;
    const float* rpb; const float* s5_a_re; const float* s5_a_im; const float* s5_log_dt; const float* s5_b_re; const float* s5_b_im; const float* s5_c_re; const float* s5_c_im;
    const float* s5_d; const float* w_glu; const float* out_norm_a; const float* out_norm_b; const float* out_norm_c; const float* w_out; const float* ffn_norm;
    const float* w_router; const float* w_gate; const float* w_up; const float* w_down;
    float* out; unsigned char* ws;
};

DEVI float bf2f(bf16_t b) { return __uint_as_float(((unsigned)b) << 16); }
DEVI bf16_t f2bf(float f) { unsigned u = __float_as_uint(f); u += 0x7FFFu + ((u >> 16) & 1u); return (bf16_t)(u >> 16); }
typedef __bf16 bf16x2_t __attribute__((ext_vector_type(2)));
DEVI unsigned pk2(float lo, float hi) { const f32x2 v = {lo, hi}; return __builtin_bit_cast(unsigned, __builtin_convertvector(v, bf16x2_t)); }
DEVI int tidx() { int t = threadIdx.x; asm volatile("" : "+v"(t)); return t; }
#define GAS __attribute__((address_space(1)))
DEVI unsigned char* wsp(const Params& P) { unsigned long long a = (unsigned long long)P.ws; asm volatile("" : "+s"(a)); return (unsigned char*)(GAS unsigned char*)a; }
DEVI int lnd(int v) { asm volatile("" : "+s"(v)); return v; }
template <int CTRL> DEVI float dppf(float v) { return __builtin_bit_cast(float, __builtin_amdgcn_update_dpp(0, __builtin_bit_cast(int, v), CTRL, 0xF, 0xF, true)); }
DEVI void swap16(float& a, float& b) { asm volatile("s_nop 1\n\tv_permlane16_swap_b32 %0, %1" : "+v"(a), "+v"(b)); }
DEVI void swap32(float& a, float& b) { asm volatile("s_nop 1\n\tv_permlane32_swap_b32 %0, %1" : "+v"(a), "+v"(b)); }
DEVI void swap16u(unsigned& a, unsigned& b) { asm volatile("s_nop 1\n\tv_permlane16_swap_b32 %0, %1" : "+v"(a), "+v"(b)); }
DEVI float xsum16(float v) { float a = v, b = v; swap16(a, b); return a + b; }
DEVI float xsum32(float v) { float a = v, b = v; swap32(a, b); return a + b; }
DEVI float xmax16(float v) { float a = v, b = v; swap16(a, b); return fmaxf(a, b); }
DEVI float xmax32(float v) { float a = v, b = v; swap32(a, b); return fmaxf(a, b); }
DEVI float row_sum16(float v) {
    v += dppf<0xB1>(v); v += dppf<0x4E>(v);
    v += dppf<0x141>(v); v += dppf<0x140>(v);
    return v;
}
DEVI float wave_sum(float v) { return xsum32(xsum16(row_sum16(v))); }
DEVI void unpk8s(float* d, const u32x4 q) {
    d[0] = __uint_as_float(q.x << 16); d[1] = __uint_as_float(q.x & 0xFFFF0000u); d[2] = __uint_as_float(q.y << 16); d[3] = __uint_as_float(q.y & 0xFFFF0000u);
    d[4] = __uint_as_float(q.z << 16); d[5] = __uint_as_float(q.z & 0xFFFF0000u); d[6] = __uint_as_float(q.w << 16); d[7] = __uint_as_float(q.w & 0xFFFF0000u);
}
DEVI float frcp(float x) { return __builtin_amdgcn_rcpf(x); }
DEVI float gelu_tanh(float y) { const float z = 0.7978845608028654f * (y + 0.044715f * y * y * y); const float t = 1.f - 2.f * frcp(1.f + __expf(2.f * z)); return 0.5f * y * (1.f + t); }

constexpr float kY8 = 32.f;
constexpr float kW8 = 64.f, kH8 = 8.f;
DEVI unsigned pk4_fp8(float a, float b, float c, float d) { unsigned w = 0u; w = __builtin_amdgcn_cvt_pk_fp8_f32(a, b, w, false); w = __builtin_amdgcn_cvt_pk_fp8_f32(c, d, w, true); return w; }
DEVI int cmap_head(int cs) { const int bj = cs >> 7, wc = (cs >> 5) & 3, n = (cs >> 4) & 1, fq = (cs >> 2) & 3, j = cs & 3; return 64 * wc + 32 * bj + 8 * fq + 4 * n + j; }
DEVI int cmap_pk(int cs)   { const int bj = cs >> 7, wc = (cs >> 5) & 3, n = (cs >> 4) & 1, fq = (cs >> 2) & 3, j = cs & 3; return 128 * bj + 32 * wc + 8 * fq + 4 * n + j; }
DEVI int cmap_gu(int cs)   { const int wc = (cs >> 5) & 3, n = (cs >> 4) & 1, fq = (cs >> 2) & 3, j = cs & 3; return 32 * wc + 8 * fq + 4 * n + j; }

template <int MODE>
DEVI void convert_item(const float* W0, const float* W1, int ldw, int K, bf16_t* Bt, int kt, int pn, unsigned char* lds) {
    bf16_t* t = (bf16_t*)lds;
    const int tid = tidx(), cs = tid & 255, kh = tid >> 8;
    int col;
    if (MODE == 0) col = pn * 256 + cs; else if (MODE == 1) col = pn * 256 + cmap_head(cs); else if (MODE == 2) col = pn * 256 + cmap_pk(cs); else col = pn * 128 + cmap_gu(cs);
    const float* src = ((MODE == 3 && (cs >> 7)) ? W1 : W0) + (size_t)(kt * 64 + 32 * kh) * ldw + col;
    float v[32];
#pragma unroll
    for (int i = 0; i < 32; ++i) v[i] = src[(size_t)i * ldw];
    if (MODE == 1) {
#pragma unroll
        for (int i = 0; i < 32; ++i) v[i] *= W1[kt * 64 + 32 * kh + i];
    }
#pragma unroll
    for (int q = 0; q < 4; ++q) { u32x4 w; w.x = pk2(v[8 * q], v[8 * q + 1]); w.y = pk2(v[8 * q + 2], v[8 * q + 3]); w.z = pk2(v[8 * q + 4], v[8 * q + 5]); w.w = pk2(v[8 * q + 6], v[8 * q + 7]);
        *(u32x4*)(t + cs * 72 + 32 * kh + 8 * q) = w; }
    __syncthreads();
#pragma unroll
    for (int it = 0; it < 4; ++it) {
        const int c = it * kNT + tid, row = c >> 3, part = c & 7;
        const u32x4 vv = *(const u32x4*)(t + row * 72 + part * 8);
        *(u32x4*)(Bt + (size_t)(pn * 256 + row) * K + kt * 64 + part * 8) = vv;
    }
    __syncthreads();
}

template <int MODE>
DEVI void convert_item8(const float* W0, const float* W1, int ldw, int K, unsigned char* Bt, int kt, int pn, unsigned char* lds) {
    unsigned char* t = lds;
    const int tid = tidx(), cs = tid & 255, kh = tid >> 8;
    const int col = (MODE == 2) ? pn * 256 + cmap_pk(cs) : pn * 128 + cmap_gu(cs);
    const float* src = ((MODE == 3 && (cs >> 7)) ? W1 : W0) + (size_t)(kt * 128 + 64 * kh) * ldw + col;
    float v[64];
#pragma unroll
    for (int i = 0; i < 64; ++i) v[i] = src[(size_t)i * ldw];
#pragma unroll
    for (int q = 0; q < 4; ++q) { u32x4 w;
        w.x = pk4_fp8(v[16 * q] * kW8, v[16 * q + 1] * kW8, v[16 * q + 2] * kW8, v[16 * q + 3] * kW8); w.y = pk4_fp8(v[16 * q + 4] * kW8, v[16 * q + 5] * kW8, v[16 * q + 6] * kW8, v[16 * q + 7] * kW8);
        w.z = pk4_fp8(v[16 * q + 8] * kW8, v[16 * q + 9] * kW8, v[16 * q + 10] * kW8, v[16 * q + 11] * kW8); w.w = pk4_fp8(v[16 * q + 12] * kW8, v[16 * q + 13] * kW8, v[16 * q + 14] * kW8, v[16 * q + 15] * kW8);
        *(u32x4*)(t + cs * 144 + 64 * kh + 16 * q) = w; }
    __syncthreads();
#pragma unroll
    for (int it = 0; it < 4; ++it) {
        const int c = it * kNT + tid, row = c >> 3, part = c & 7;
        const u32x4 vv = *(const u32x4*)(t + row * 144 + part * 16);
        *(u32x4*)(Bt + (size_t)(pn * 256 + row) * K + kt * 128 + part * 16) = vv;
    }
    __syncthreads();
}

DEVI void phase_convert(const Params& P, unsigned char* lds, int bid, int nblk) {
    constexpr int N_WIN = kL * 16 * 10, N_WOUT = kL * 16 * 4, N_WGLU = kL * 4 * 1, N_WGU = kL * kE * 8 * 16, N_WD = kL * kE * 16 * 4;
    constexpr int TOT = N_WIN + N_WOUT + N_WGLU + N_WGU + N_WD;
    for (int it = bid; it < TOT; it += nblk) {
        int i = it;
        if (i < N_WIN) { const int l = i / 160, r = i % 160, kt = r / 10, pn = r % 10;
            convert_item<1>(P.w_in + (size_t)l * kD * kINW, P.attn_norm + (size_t)l * kD, kINW, kD, (bf16_t*)(wsp(P) + WS_WINT) + (size_t)l * kINW * kD, kt, pn, lds); continue; }
        i -= N_WIN;
        if (i < N_WOUT) { const int l = i / 64, r = i % 64, kt = r / 4, pn = r % 4;
            convert_item<2>(P.w_out + (size_t)l * kD * kD, nullptr, kD, kD, (bf16_t*)(wsp(P) + WS_WOUTT) + (size_t)l * kD * kD, kt, pn, lds); continue; }
        i -= N_WOUT;
        if (i < N_WGLU) { const int l = i / 4, kt = i % 4;
            convert_item<2>(P.w_glu + (size_t)l * 256 * 256, nullptr, 256, 256, (bf16_t*)(wsp(P) + WS_WGLUT) + (size_t)l * 256 * 256, kt, 0, lds); continue; }
        i -= N_WGLU;
        if (i < N_WGU) { const int le = i / 128, r = i % 128, kt = r / 16, pn = r % 16;
            convert_item8<3>(P.w_gate + (size_t)le * kD * kFF, P.w_up + (size_t)le * kD * kFF, kFF, kD, wsp(P) + WS_WGUT + (size_t)le * 4096 * kD, kt, pn, lds); continue; }
        i -= N_WGU;
        { const int le = i / 64, r = i % 64, kt = r / 4, pn = r % 4;
            convert_item8<2>(P.w_down + (size_t)le * kFF * kD, nullptr, kD, kFF, wsp(P) + WS_WDT + (size_t)le * kD * kFF, kt, pn, lds); }
    }
}

DEVI void phase_norm(const float* x, bf16_t* xb, float* rstdp, int bid, int nblk) {
    const int wid = tidx() >> 6, lane = tidx() & 63;
    for (int row = bid * 8 + wid; row < kTok; row += nblk * 8) {
        f32x4 v[4]; float ss = 0.f;
#pragma unroll
        for (int q = 0; q < 4; ++q) { v[q] = *(const f32x4*)(x + (size_t)row * kD + q * 256 + lane * 4); ss += v[q].x * v[q].x + v[q].y * v[q].y + v[q].z * v[q].z + v[q].w * v[q].w; }
        ss = wave_sum(ss);
        if (lane == 0) rstdp[row] = rsqrtf(ss * (1.f / kD) + kEps);
#pragma unroll
        for (int q = 0; q < 4; ++q) { const f32x4 t = v[q];
            u32x2 o; o.x = pk2(t.x, t.y); o.y = pk2(t.z, t.w);
            *(u32x2*)(xb + (size_t)row * kD + q * 256 + lane * 4) = o; }
    }
}

DEVI void router_prep(const Params& P, int bid, int nblk) {
    unsigned char* tbase = wsp(P) + WS_RTAB;
    for (int i = bid * kNT + tidx(); i < kL * 2048; i += nblk * kNT) {
        const int L = i >> 11, s = (i >> 6) & 31, l = i & 63, e = l & 15, k0 = 64 * (s >> 1) + 16 * (l >> 4) + 8 * (s & 1);
        const float* wr = P.w_router + (size_t)L * kD * kE; const float* gain = P.ffn_norm + (size_t)L * kD;
        unsigned hh[4], ll[4];
#pragma unroll
        for (int j = 0; j < 4; ++j) { const float w0 = wr[(k0 + 2 * j) * 16 + e] * gain[k0 + 2 * j], w1 = wr[(k0 + 2 * j + 1) * 16 + e] * gain[k0 + 2 * j + 1];
            const unsigned hp = pk2(w0, w1); hh[j] = hp; ll[j] = pk2(w0 - __uint_as_float(hp << 16), w1 - __uint_as_float(hp & 0xFFFF0000u)); }
        u32x4 hi, lo; hi.x = hh[0]; hi.y = hh[1]; hi.z = hh[2]; hi.w = hh[3]; lo.x = ll[0]; lo.y = ll[1]; lo.z = ll[2]; lo.w = ll[3];
        unsigned char* tb = tbase + (size_t)L * 65536;
        *(u32x4*)(tb + (2 * s) * 1024 + l * 16) = hi; *(u32x4*)(tb + (2 * s + 1) * 1024 + l * 16) = lo;
    }
}
DEVI void phase_router(const bf16_t* x, const float* gain, const unsigned char* rtab  , unsigned char* h8, float* aff, LAS unsigned char* lds, int bid, int nblk) {
    LAS unsigned char* wtab = lds;
    LAS float* gtab = (LAS float*)(lds + 65536);
    const int tid = tidx(), wid = __builtin_amdgcn_readfirstlane(tid >> 6), lane = tid & 63, r = lane & 15, c4 = lane >> 4;
    __syncthreads();
    for (int i = tid; i < 1024; i += kNT) gtab[i] = gain[i];
#pragma unroll
    for (int i = 0; i < 8; ++i)
        __builtin_amdgcn_global_load_lds((const unsigned*)(rtab + (size_t)(i * kNT + tid) * 16), (LAS unsigned*)(wtab + (i * 8 + wid) * 1024), 16, 0, 0);
    asm volatile("s_waitcnt vmcnt(0)" ::: "memory");
    __syncthreads();
    u32x4 xr[32];
    const int ntile = kTok / 16, tstride = nblk * 8;
    int tile = bid * 8 + wid;
#define RT_ISSUE(half, tile_) do { const bf16_t* xp_ = x + (size_t)((tile_) * 16 + r) * kD + 16 * c4; \
        _Pragma("unroll") for (int u = 8 * (half); u < 8 * (half) + 8; ++u) { xr[2 * u] = *(const u32x4*)(xp_ + 64 * u); xr[2 * u + 1] = *(const u32x4*)(xp_ + 64 * u + 8); } } while (0)
    if (tile < ntile) { RT_ISSUE(0, tile); RT_ISSUE(1, tile); }
    for (; tile < ntile; tile += tstride) {
        asm volatile("" ::: "memory");
        f32x4 Lh = {0.f, 0.f, 0.f, 0.f}, Ll = {0.f, 0.f, 0.f, 0.f}, G = {0.f, 0.f, 0.f, 0.f};
#pragma unroll
        for (int s = 0; s < 32; ++s) {
            const bf16x8 wh = *(const LAS bf16x8*)(wtab + (2 * s) * 1024 + lane * 16), wl = *(const LAS bf16x8*)(wtab + (2 * s + 1) * 1024 + lane * 16);
            const bf16x8 xb = __builtin_bit_cast(bf16x8, xr[s]);
            Lh = __builtin_amdgcn_mfma_f32_16x16x32_bf16(wh, xb, Lh, 0, 0, 0);
            Ll = __builtin_amdgcn_mfma_f32_16x16x32_bf16(wl, xb, Ll, 0, 0, 0);
            G = __builtin_amdgcn_mfma_f32_16x16x32_bf16(xb, xb, G, 0, 0, 0);
        }
        const float dsel = ((r & 3) == 0) ? G.x : ((r & 3) == 1) ? G.y : ((r & 3) == 2) ? G.z : G.w;
        const float ss = __builtin_bit_cast(float, __builtin_amdgcn_ds_bpermute((16 * (r >> 2) + r) * 4, __builtin_bit_cast(int, dsel)));
        const float rstd = rsqrtf(ss * (1.f / kD) + kEps);
        const f32x4 lg = (Lh + Ll) * rstd;
        float mx = fmaxf(fmaxf(lg.x, lg.y), fmaxf(lg.z, lg.w)); mx = xmax32(xmax16(mx));
        f32x4 ex; ex.x = __expf(lg.x - mx); ex.y = __expf(lg.y - mx); ex.z = __expf(lg.z - mx); ex.w = __expf(lg.w - mx);
        float sm = (ex.x + ex.y) + (ex.z + ex.w); sm = xsum32(xsum16(sm));
        const float inv = frcp(sm);
        const int row0 = tile * 16, b = row0 >> 13, s0 = (row0 & (kS - 1)) + r;
        { float* ap = aff + ((size_t)(b * kE + 4 * c4)) * kS + s0;
          ap[0] = ex.x * inv; ap[kS] = ex.y * inv; ap[2 * kS] = ex.z * inv; ap[3 * kS] = ex.w * inv; }
        unsigned char* hp = h8 + (size_t)(row0 + r) * kD + 16 * c4;
        const int ntl = tile + tstride;
#pragma unroll
        for (int half = 0; half < 2; ++half) {
#pragma unroll
            for (int u = 8 * half; u < 8 * half + 8; ++u) {
                float v[16]; unpk8s(v, xr[2 * u]); unpk8s(v + 8, xr[2 * u + 1]);
                u32x4 o; unsigned ow[4];
#pragma unroll
                for (int q = 0; q < 4; ++q) { const f32x4 gq = *(const LAS f32x4*)(gtab + 64 * u + 16 * c4 + 4 * q);
                    const f32x4 t = (f32x4){v[4 * q], v[4 * q + 1], v[4 * q + 2], v[4 * q + 3]} * gq * rstd;
                    ow[q] = pk4_fp8(t.x, t.y, t.z, t.w); }
                o.x = ow[0]; o.y = ow[1]; o.z = ow[2]; o.w = ow[3];
                *(u32x4*)(hp + 64 * u) = o;
            }
            if (ntl < ntile) { if (half == 0) RT_ISSUE(0, ntl); else RT_ISSUE(1, ntl); }
        }
    }
#undef RT_ISSUE
    __syncthreads();
}

DEVI int block_excl_scan(int v, int* sh  , int& total) {
    const int lane = tidx() & 63, wid = tidx() >> 6;
    int incl = v;
#pragma unroll
    for (int d = 1; d < 64; d <<= 1) { const int o = __shfl_up(incl, d); if (lane >= d) incl += o; }
    __syncthreads();
    if (lane == 63) sh[wid] = incl;
    __syncthreads();
    int base = 0, tot = 0;
#pragma unroll
    for (int w = 0; w < 8; ++w) { const int c = sh[w]; if (w < wid) base += c; tot += c; }
    total = tot;
    return base + incl - v;
}

DEVI void phase_topk(const float* aff, int* idx, float* gate, int* tokslot, const unsigned char* hsrc, unsigned char* xe, int rowbytes, unsigned char* lds, int bid, int nblk) {
    int* hist = (int*)lds;
    int* sh = hist + 256;
    int* res = sh + 16;
    (void)hsrc; (void)xe; (void)rowbytes;
    const int tid = tidx(), lane = tid & 63, wid = tid >> 6;
    const int share = (nblk >= 2 * kB * kE) ? 2 : 1;
    for (int wi = bid; wi < kB * kE * share; wi += nblk) {
        const int item = wi / share, part = wi - item * share;
        const int b = item >> 4, e = item & 15;
        const float* a = aff + (size_t)item * kS;
        unsigned key[16];
#pragma unroll
        for (int q = 0; q < 4; ++q) { const u32x4 v = *(const u32x4*)(a + tid * 16 + q * 4); key[q * 4 + 0] = v.x; key[q * 4 + 1] = v.y; key[q * 4 + 2] = v.z; key[q * 4 + 3] = v.w; }
        unsigned prefix = 0; int kk = kCap;
#pragma unroll 1
        for (int pass = 0; pass < 4; ++pass) {
            const int shift = 24 - 8 * pass;
            __syncthreads();
            if (tid < 256) hist[tid] = 0;
            __syncthreads();
#pragma unroll
            for (int i = 0; i < 16; ++i) { const bool in = (pass == 0) || ((key[i] >> (shift + 8)) == prefix); if (in) atomicAdd(&hist[(key[i] >> shift) & 255], 1); }
            __syncthreads();
            if (wid == 0) {
                int c[4], loc = 0;
#pragma unroll
                for (int j = 0; j < 4; ++j) { c[j] = hist[255 - 4 * lane - j]; loc += c[j]; }
                int incl = loc;
#pragma unroll
                for (int d = 1; d < 64; d <<= 1) { const int o = __shfl_up(incl, d); if (lane >= d) incl += o; }
                const int excl = incl - loc;
                if (excl < kk && kk <= incl) { int run = excl; int bin = 0, nk = 0; bool found = false;
#pragma unroll
                    for (int j = 0; j < 4; ++j) { if (!found && run + c[j] >= kk) { bin = 255 - 4 * lane - j; nk = kk - run; found = true; } if (!found) run += c[j]; }
                    res[0] = bin; res[1] = nk; }
            }
            __syncthreads();
            prefix = (prefix << 8) | (unsigned)res[0]; kk = res[1];
        }
        const unsigned T = prefix;
        int ceq = 0;
#pragma unroll
        for (int i = 0; i < 16; ++i) ceq += (key[i] == T) ? 1 : 0;
        int tot;
        int eqb = block_excl_scan(ceq, sh, tot);
        int csel = 0; unsigned selmask = 0;
#pragma unroll
        for (int i = 0; i < 16; ++i) { bool s = key[i] > T; if (key[i] == T) { s = eqb < kk; ++eqb; } if (s) { selmask |= 1u << i; ++csel; } }
        int slot = block_excl_scan(csel, sh, tot);
        const size_t rbase = (size_t)(e * kB + b) * kCap;
#pragma unroll
        for (int i = 0; i < 16; ++i) { const int s = tid * 16 + i; const bool sel = (selmask >> i) & 1u;
            const bool mine = (share == 1) || ((i >> 3) == part);
            if (sel && mine) { idx[rbase + slot] = b * kS + s; gate[rbase + slot] = __uint_as_float(key[i]) * (1.f / kY8)  ; }
            if (mine) tokslot[((size_t)(b * kS + s)) * kE + e] = sel ? slot : -1;
            if (sel) ++slot; }
    }
    __syncthreads();
}

struct Unit { int pm, pn, par; };
DEVI bool unit_of(int Lid, int nM, int nN, Unit& u) {
    const int nwg = nM * nN; if (Lid >= nwg) return false;
    int wgid = Lid; { const int q = nwg / 8, r = nwg % 8, xcd = wgid % 8, off = wgid / 8; wgid = (xcd < r ? xcd * (q + 1) : r * (q + 1) + (xcd - r) * q) + off; }
    const int nig = 8 * nN, gid = wgid / nig, fm = gid * 8, gsz = (nM - fm) < 8 ? (nM - fm) : 8;
    u.pm = fm + ((wgid % nig) % gsz); u.pn = (wgid % nig) / gsz; return true;
}
struct GemmD { const bf16_t* A; const bf16_t* Bt; int lda, K, nM, nN; const int* rowidx; size_t bstride; int pmg; };

constexpr int PG_HTB = 128 * 64 * 2;
DEVI int pg_lds_byte(int r, int c) { const int st = (r >> 4) * 2 + (c >> 5), rr = r & 15, cc = c & 31, ob = rr * 64 + cc * 2; return st * 1024 + (ob ^ (((ob >> 9) & 1) << 5)); }
DEVI void pg_stage_rc(int b, int& R, int& C) { const int st = b / 1024, sb = b % 1024, swz = sb ^ (((sb >> 9) & 1) << 5); R = (st >> 1) * 16 + swz / 64; C = (st & 1) * 32 + (swz % 64) / 2; }

typedef int v4i __attribute__((ext_vector_type(4)));
typedef int v8i __attribute__((ext_vector_type(8)));
constexpr int PG_RIDX = 131072 + 4096;
template <class Epi, bool ALIGN_EPI, bool SP2, bool FP8 = false, bool GATHER = false>
DEVI void gemm_engine(LAS unsigned char* lds, const GemmD g, const Epi& E, int bid, int nblk) {
    const int tid = tidx(), wid = __builtin_amdgcn_readfirstlane(tid >> 6), lane = tid & 63, wr = wid >> 2, wc = wid & 3, fr = lane & 15, fq = lane >> 4;
    constexpr int ES = FP8 ? 1 : 2;
    const int K = g.K * ES  , nt = K / 128; const unsigned ldaB = (unsigned)g.lda * ES;
    unsigned voffA[2], voffB[2];
#pragma unroll
    for (int i = 0; i < 2; ++i) { int R, C; pg_stage_rc(tid * 16 + i * 8192, R, C); voffA[i] = (unsigned)R * ldaB + (unsigned)C * 2u; voffB[i] = (unsigned)(R * K + C * 2); }
    const size_t kstep = 128;
    int gR0 = 0; unsigned gcb = 0; { int R, C; pg_stage_rc(tid * 16, R, C); gR0 = R; gcb = (unsigned)C * 2u; } (void)gR0; (void)gcb;
    const size_t hstepB = (size_t)128 * K, hstepA = (size_t)128 * ldaB, tstepA = 2 * hstepA;
    const unsigned ldsw = (unsigned)wid * 1024u;
    const int aoff = pg_lds_byte(wr * 64 + fr, fq * 8), boff = pg_lds_byte(wc * 32 + fr, fq * 8);
#define PG8_SA(b, h) (((b) * 2 + (h)) * PG_HTB)
#define PG8_SB(b, h) ((4 + (b) * 2 + (h)) * PG_HTB)
#define PG8_STAGE(bufoff, gbase, voff) do { _Pragma("unroll") for (int _i = 0; _i < 2; ++_i) \
        __builtin_amdgcn_global_load_lds((const unsigned*)((const char*)(gbase) + (voff)[_i]), (LAS unsigned*)(lds + (bufoff) + ldsw + _i * 8192), 16, 0, 0); } while (0)
#define PG8_STA(bufoff, ptr, koff, half, par) do { if constexpr (GATHER) { \
        const LAS int* rt_ = (const LAS int*)(lds + PG_RIDX + (par) * 1024) + 128 * (half) + gR0; \
        _Pragma("unroll") for (int _i = 0; _i < 2; ++_i) { const unsigned off_ = (unsigned)rt_[64 * _i] * ldaB + gcb; \
            __builtin_amdgcn_global_load_lds((const unsigned*)((const char*)g.A + (koff) + off_), (LAS unsigned*)(lds + (bufoff) + ldsw + _i * 8192), 16, 0, 0); } \
    } else PG8_STAGE(bufoff, ptr, voffA); } while (0)
#define PG8_RD16(off) (*(const LAS v4i*)(lds + (off)))
#define PG8_CAT2(off) __builtin_shufflevector(PG8_RD16(off), PG8_RD16((off) + 1024), 0, 1, 2, 3, 4, 5, 6, 7)
#define PG8_LDA(dst, b, h) do { _Pragma("unroll") for (int m = 0; m < 4; ++m) { if constexpr (FP8) dst##8[m] = PG8_CAT2(PG8_SA(b, h) + aoff + m * 2048); \
        else { _Pragma("unroll") for (int k = 0; k < 2; ++k) dst[m][k] = *(const LAS bf16x8*)(lds + PG8_SA(b, h) + aoff + m * 2048 + k * 1024); } } } while (0)
#define PG8_LDB(dst, b, h) do { _Pragma("unroll") for (int n = 0; n < 2; ++n) { if constexpr (FP8) dst##8[n] = PG8_CAT2(PG8_SB(b, h) + boff + n * 2048); \
        else { _Pragma("unroll") for (int k = 0; k < 2; ++k) dst[n][k] = *(const LAS bf16x8*)(lds + PG8_SB(b, h) + boff + n * 2048 + k * 1024); } } } while (0)
#define PG8_MMA(ai, bj, At, Bt) do { __builtin_amdgcn_s_setprio(1); _Pragma("unroll") for (int m = 0; m < 4; ++m) _Pragma("unroll") for (int n = 0; n < 2; ++n) { \
        if constexpr (FP8) asm volatile("v_mfma_f32_16x16x128_f8f6f4 %0, %1, %2, %0" : "+v"(acc[ai][bj][m][n]) : "v"(Bt##8[n]), "v"(At##8[m]));   \
        else { _Pragma("unroll") for (int k = 0; k < 2; ++k) acc[ai][bj][m][n] = __builtin_amdgcn_mfma_f32_16x16x32_bf16(Bt[n][k], At[m][k], acc[ai][bj][m][n], 0, 0, 0); } } \
        __builtin_amdgcn_s_setprio(0); } while (0)
#define PG8_MMAZ(ai, bj, At, Bt) do { __builtin_amdgcn_s_setprio(1); _Pragma("unroll") for (int m = 0; m < 4; ++m) _Pragma("unroll") for (int n = 0; n < 2; ++n) { \
        if constexpr (FP8) asm volatile("v_mfma_f32_16x16x128_f8f6f4 %0, %1, %2, 0" : "=&v"(acc[ai][bj][m][n]) : "v"(Bt##8[n]), "v"(At##8[m])); \
        else { asm volatile("v_mfma_f32_16x16x32_bf16 %0, %1, %2, 0" : "=&v"(acc[ai][bj][m][n]) : "v"(Bt[n][0]), "v"(At[m][0])); \
               acc[ai][bj][m][n] = __builtin_amdgcn_mfma_f32_16x16x32_bf16(Bt[n][1], At[m][1], acc[ai][bj][m][n], 0, 0, 0); } } \
        __builtin_amdgcn_s_setprio(0); } while (0)
#define PG8_WAIT_V(n) asm volatile("s_waitcnt vmcnt(" #n ")" ::: "memory")
#define PG8_WAIT_L(n) asm volatile("s_waitcnt lgkmcnt(" #n ")" ::: "memory")
#define PG8_BAR __builtin_amdgcn_s_barrier()
#define PG8_SCHED __builtin_amdgcn_sched_barrier(0)
    Unit cur, nxt; int ui = 0;
    if (!unit_of(bid, g.nM, g.nN, cur)) return;
    cur.par = 0; E.stage(lds, cur, wid, lane);
    if constexpr (GATHER) {
        if (wid < 4) __builtin_amdgcn_global_load_lds((const unsigned*)(g.rowidx + cur.pm * 256 + wid * 64 + lane), (LAS unsigned*)(lds + PG_RIDX + wid * 256), 4, 0, 0);
        asm volatile("s_waitcnt vmcnt(0)" ::: "memory"); __builtin_amdgcn_s_barrier();
    }
    f32x4 acc[2][2][4][2];
    if constexpr (!FP8) {
#pragma unroll
    for (int a = 0; a < 2; ++a)
#pragma unroll
        for (int b = 0; b < 2; ++b)
#pragma unroll
            for (int m = 0; m < 4; ++m)
#pragma unroll
                for (int n = 0; n < 2; ++n) acc[a][b][m][n] = (f32x4){0.f, 0.f, 0.f, 0.f};
    }
    bf16x8 At[4][2], B0[2][2], B1[2][2]; v8i At8[4], B08[2], B18[2];
    (void)At; (void)B0; (void)B1; (void)At8; (void)B08; (void)B18;
    static_assert(SP2, "only the two-super-phase K-loop is kept");
    const char* cA = (const char*)g.A + (size_t)cur.pm * tstepA;
    const char* cB = (const char*)g.Bt + (size_t)(cur.pm / g.pmg) * g.bstride * ES + (size_t)cur.pn * 256 * K;
    PG8_STAGE(PG8_SB(0, 0), cB, voffB); PG8_STAGE(PG8_SB(0, 1), cB + hstepB, voffB); PG8_STA(PG8_SA(0, 0), cA, 0u, 0, 0); PG8_STA(PG8_SA(0, 1), cA + hstepA, 0u, 1, 0);
    if (wr == 1) PG8_BAR;
    PG8_WAIT_V(2); PG8_BAR;
    PG8_STAGE(PG8_SB(1, 0), cB + kstep, voffB); PG8_STA(PG8_SA(1, 0), cA + kstep, 128u, 0, 0); PG8_STAGE(PG8_SB(1, 1), cB + hstepB + kstep, voffB);
    PG8_WAIT_V(6); PG8_BAR;
    for (;;) {
        const bool has_next = unit_of((ui + 1) * nblk + bid, g.nM, g.nN, nxt); nxt.par = (ui + 1) & 1;
        if constexpr (GATHER) { if (has_next && wid < 4) __builtin_amdgcn_global_load_lds((const unsigned*)(g.rowidx + nxt.pm * 256 + wid * 64 + lane), (LAS unsigned*)(lds + PG_RIDX + nxt.par * 1024 + wid * 256), 4, 0, 0); }
        const char* nA = has_next ? (const char*)g.A + (size_t)nxt.pm * tstepA : cA;
        const char* nB = has_next ? (const char*)g.Bt + (size_t)(nxt.pm / g.pmg) * g.bstride * ES + (size_t)nxt.pn * 256 * K : cB;
#define PG8_TRIP(MM) do { \
            const bool last = (t == nt - 2); \
            const char* a1 = cA + (size_t)(t + 1) * kstep; \
            const char* a2 = last ? nA : cA + (size_t)(t + 2) * kstep; const char* b2 = last ? nB : cB + (size_t)(t + 2) * kstep; \
            const char* a3 = a2 + kstep; const char* b3 = b2 + kstep; \
            const unsigned gk1 = (unsigned)(t + 1) * 128u, gk2 = last ? 0u : (unsigned)(t + 2) * 128u, gk3 = gk2 + 128u; const int gp2 = (last && has_next) ? nxt.par : cur.par; (void)gk1; (void)gk2; (void)gk3; (void)gp2; \
            PG8_LDB(B0, 0, 0); PG8_LDB(B1, 0, 1); PG8_SCHED; PG8_LDA(At, 0, 0); PG8_STA(PG8_SA(1, 1), a1 + hstepA, gk1, 1, cur.par); \
            PG8_WAIT_V(8); PG8_WAIT_L(0); PG8_BAR; MM(0, 0, At, B0); MM(0, 1, At, B1); PG8_BAR; PG8_SCHED; \
            PG8_LDA(At, 0, 1); PG8_STAGE(PG8_SB(0, 0), b2, voffB); PG8_STAGE(PG8_SB(0, 1), b2 + hstepB, voffB); PG8_STA(PG8_SA(0, 0), a2, gk2, 0, gp2); \
            PG8_WAIT_V(8); PG8_WAIT_L(0); PG8_BAR; MM(1, 0, At, B0); MM(1, 1, At, B1); PG8_BAR; PG8_SCHED; \
            PG8_LDB(B0, 1, 0); PG8_LDB(B1, 1, 1); PG8_SCHED; PG8_LDA(At, 1, 0); PG8_STA(PG8_SA(0, 1), a2 + hstepA, gk2, 1, gp2); \
            PG8_WAIT_V(8); PG8_WAIT_L(0); PG8_BAR; PG8_MMA(0, 0, At, B0); PG8_MMA(0, 1, At, B1); PG8_BAR; PG8_SCHED; \
            PG8_LDA(At, 1, 1); PG8_STAGE(PG8_SB(1, 0), b3, voffB); PG8_STAGE(PG8_SB(1, 1), b3 + hstepB, voffB); PG8_STA(PG8_SA(1, 0), a3, gk3, 0, gp2); \
            PG8_WAIT_V(8); PG8_WAIT_L(0); PG8_BAR; PG8_MMA(1, 0, At, B0); PG8_MMA(1, 1, At, B1); PG8_BAR; PG8_SCHED; } while (0)
        int t = 0;
        if constexpr (FP8) { PG8_TRIP(PG8_MMAZ); t = 2; }
#pragma unroll 1
        for (; t < nt; t += 2) PG8_TRIP(PG8_MMA);
#undef PG8_TRIP
        if constexpr (ALIGN_EPI) { if (wr == 0) PG8_BAR; }
        if constexpr (FP8) asm volatile("s_nop 15\n\ts_nop 15" ::: "memory");
        E(acc, cur, wr, wc, fr, fq);
        if (!has_next) break;
        E.stage(lds, nxt, wid, lane);
        if constexpr (!FP8) {
#pragma unroll
        for (int a = 0; a < 2; ++a)
#pragma unroll
            for (int b = 0; b < 2; ++b)
#pragma unroll
                for (int m = 0; m < 4; ++m)
#pragma unroll
                    for (int n = 0; n < 2; ++n) acc[a][b][m][n] = (f32x4){0.f, 0.f, 0.f, 0.f};
        }
        cur = nxt; cA = nA; cB = nB; ++ui;
        if constexpr (ALIGN_EPI) { if (wr == 1) PG8_BAR; }
    }
    PG8_WAIT_V(0);
    if constexpr (!ALIGN_EPI) { if (wr == 0) PG8_BAR; }
    PG8_BAR;
#undef PG8_SA
#undef PG8_SB
#undef PG8_STAGE
#undef PG8_STA
#undef PG8_LDA
#undef PG8_LDB
#undef PG8_MMA
#undef PG8_MMAZ
#undef PG8_RD16
#undef PG8_CAT2
#undef PG8_WAIT_V
#undef PG8_WAIT_L
#undef PG8_BAR
#undef PG8_SCHED
}

struct EpiQKV {
    static constexpr int VMOPS = 16;
    bf16_t *qa, *ka, *va, *qb, *kb, *vb, *ux;
    const float* rstdp;
    const LAS float* rtab;
    DEVI void stage(LAS unsigned char* lds, const Unit& u, int wid, int lane) const {
        if (wid < 4) __builtin_amdgcn_global_load_lds((const unsigned*)(rstdp + u.pm * 256 + wid * 64 + lane), (LAS unsigned*)(lds + 131072 + 2048 + u.par * 1024 + wid * 256), 4, 0, 0);
    }
    const LAS float* gtab;
    DEVI void operator()(const f32x4 (&acc)[2][2][4][2], const Unit& u, int wr, int wc, int fr, int fq) const {
        const int pn = u.pn;
        bf16_t* dst = (pn < 2) ? qa : (pn < 4) ? ka : (pn < 6) ? va : (pn == 6) ? qb : (pn == 7) ? kb : (pn == 8) ? vb : ux;
        const int H = (pn < 6) ? 8 : 4, head = ((pn < 6) ? (pn & 1) * 4 : 0) + wc;
        const int trow = (pn < 2) ? 0 : (pn < 4) ? 1 : (pn == 6) ? 2 : (pn == 7) ? 3 : 4;
        const bool nrm = trow < 4;
        f32x4 gv[2][2];
#pragma unroll
        for (int bj = 0; bj < 2; ++bj)
#pragma unroll
            for (int n = 0; n < 2; ++n) gv[bj][n] = *(const LAS f32x4*)(gtab + trow * 64 + 32 * bj + 8 * fq + 4 * n);
        const size_t hb = (size_t)head * kS * 64 + 8 * fq;
        const int g0 = 4 * wc + (fq >> 1), c0 = 8 * (fq & 1);
#pragma unroll
        for (int ai = 0; ai < 2; ++ai)
#pragma unroll
            for (int m = 0; m < 4; ++m) {
                const int row = u.pm * 256 + 128 * ai + 64 * wr + 16 * m + fr;
                float ss = 0.f;
#pragma unroll
                for (int bj = 0; bj < 2; ++bj)
#pragma unroll
                    for (int n = 0; n < 2; ++n) { const f32x4 v = acc[ai][bj][m][n]; ss += v.x * v.x + v.y * v.y + v.z * v.z + v.w * v.w; }
                ss = xsum32(xsum16(ss));
                const float rr = rtab[u.par * 256 + 128 * ai + 64 * wr + 16 * m + fr];
                const float rs = __builtin_amdgcn_rsqf(ss * rr * rr * (1.f / 64.f) + kEps) * rr, rstd = nrm ? rs : rr;
                const int b = row >> 13, sq = row & (kS - 1);
                const size_t o_qkv = ((size_t)b * H * kS + sq) * 64 + hb, o_u = ((size_t)g0 * 4096 + (row >> 4)) * 512 + (row & 15) * 16 + c0;
#pragma unroll
                for (int bj = 0; bj < 2; ++bj) {
                    const f32x4 v0 = acc[ai][bj][m][0] * rstd * gv[bj][0], v1 = acc[ai][bj][m][1] * rstd * gv[bj][1];
                    u32x4 w; w.x = pk2(v0.x, v0.y); w.y = pk2(v0.z, v0.w); w.z = pk2(v1.x, v1.y); w.w = pk2(v1.z, v1.w);
                    const size_t o = (pn < 9) ? o_qkv + 32 * bj : o_u + (size_t)bj * 2 * 4096 * 512;
                    *(u32x4*)(dst + o) = w;
                }
            }
    }
};
struct EpiResid {
    DEVI void stage(LAS unsigned char*, const Unit&, int, int) const {}
    static constexpr int VMOPS = 16;
    bf16_t* xb; bf16_t* xbo;
    DEVI void operator()(const f32x4 (&acc)[2][2][4][2], const Unit& u, int wr, int wc, int fr, int fq) const {
#pragma unroll
        for (int ai = 0; ai < 2; ++ai) {
            const size_t r0 = (size_t)(u.pm * 256 + 128 * ai + 64 * wr + fr) * kD + u.pn * 256 + 32 * wc + 8 * fq;
            {
                u32x4 a[4][2];
#pragma unroll
                for (int m = 0; m < 4; ++m)
#pragma unroll
                    for (int bj = 0; bj < 2; ++bj) a[m][bj] = *(const u32x4*)(xb + r0 + (size_t)m * 16 * kD + 128 * bj);
#pragma unroll
                for (int m = 0; m < 4; ++m)
#pragma unroll
                    for (int bj = 0; bj < 2; ++bj) { const size_t o = r0 + (size_t)m * 16 * kD + 128 * bj; const u32x4 w = a[m][bj];
                        const f32x4 v0 = (f32x4){__uint_as_float(w.x << 16), __uint_as_float(w.x & 0xFFFF0000u), __uint_as_float(w.y << 16), __uint_as_float(w.y & 0xFFFF0000u)} + acc[ai][bj][m][0];
                        const f32x4 v1 = (f32x4){__uint_as_float(w.z << 16), __uint_as_float(w.z & 0xFFFF0000u), __uint_as_float(w.w << 16), __uint_as_float(w.w & 0xFFFF0000u)} + acc[ai][bj][m][1];
                        u32x4 r; r.x = pk2(v0.x, v0.y); r.y = pk2(v0.z, v0.w); r.z = pk2(v1.x, v1.y); r.w = pk2(v1.z, v1.w); *(u32x4*)(xbo + o) = r; }
            }
        }
    }
};
struct EpiGU {
    DEVI void stage(LAS unsigned char*, const Unit&, int, int) const {}
    static constexpr int VMOPS = 4;
    bf16_t* hid; float sc;
    DEVI void silu8(const f32x4 (&acc)[2][2][4][2], int ai, int m, float (&o)[8]) const {
        const float k1 = -sc * kLog2e, k3 = 1.f / (sc * sc * kH8);
#pragma unroll
        for (int n = 0; n < 2; ++n)
#pragma unroll
            for (int j = 0; j < 4; j += 2) { const f32x2 a = {acc[ai][0][m][n][j], acc[ai][0][m][n][j + 1]}, b = {acc[ai][1][m][n][j], acc[ai][1][m][n][j + 1]};
                const f32x2 ab = a * b, t = a * k1; f32x2 d; d.x = __builtin_amdgcn_exp2f(t.x); d.y = __builtin_amdgcn_exp2f(t.y); d = d * k3 + k3;
                f32x2 r; r.x = frcp(d.x); r.y = frcp(d.y); const f32x2 v = ab * r;
                o[n * 4 + j] = v.x; o[n * 4 + j + 1] = v.y; }
    }
    DEVI void operator()(const f32x4 (&acc)[2][2][4][2], const Unit& u, int wr, int wc, int fr, int fq) const {
#pragma unroll
        for (int ai = 0; ai < 2; ++ai)
#pragma unroll
            for (int m = 0; m < 4; m += 2) {
                float o0[8], o1[8]; silu8(acc, ai, m, o0); silu8(acc, ai, m + 1, o1);
                unsigned ax = pk4_fp8(o0[0], o0[1], o0[2], o0[3]), ay = pk4_fp8(o0[4], o0[5], o0[6], o0[7]), bx = pk4_fp8(o1[0], o1[1], o1[2], o1[3]), by = pk4_fp8(o1[4], o1[5], o1[6], o1[7]);
                swap16u(ax, bx); swap16u(ay, by);
                const size_t row = (size_t)(u.pm * 256 + 128 * ai + 64 * wr + 16 * (m + (fq & 1)) + fr);
                u32x4 w; w.x = ax; w.y = ay; w.z = bx; w.w = by;
                *(u32x4*)((unsigned char*)hid + row * kFF + u.pn * 128 + 32 * wc + 8 * (fq & ~1)) = w;
            }
    }
};
struct EpiDown {
    DEVI void stage(LAS unsigned char*, const Unit&, int, int) const {}
    static constexpr int VMOPS = 8;
    bf16_t* y; float sc;
    DEVI static unsigned pk4c(const f32x4 v) { return pk4_fp8(v.x, v.y, v.z, v.w); }
    DEVI void operator()(const f32x4 (&acc)[2][2][4][2], const Unit& u, int wr, int wc, int fr, int fq) const {
        const float gv = sc * kY8;
#pragma unroll
        for (int ai = 0; ai < 2; ++ai)
#pragma unroll
            for (int m = 0; m < 4; m += 2)
#pragma unroll
                for (int bj = 0; bj < 2; ++bj) {
                    unsigned ax = pk4c(acc[ai][bj][m][0] * gv), ay = pk4c(acc[ai][bj][m][1] * gv), bx = pk4c(acc[ai][bj][m + 1][0] * gv), by = pk4c(acc[ai][bj][m + 1][1] * gv);
                    swap16u(ax, bx); swap16u(ay, by);
                    const size_t row = (size_t)(u.pm * 256 + 128 * ai + 64 * wr + 16 * (m + (fq & 1)) + fr);
                    u32x4 w; w.x = ax; w.y = ay; w.z = bx; w.w = by;
                    *(u32x4*)((unsigned char*)y + row * kD + u.pn * 256 + 128 * bj + 32 * wc + 8 * (fq & ~1)) = w;
                }
    }
};
struct EpiGlu {
    DEVI void stage(LAS unsigned char*, const Unit&, int, int) const {}
    static constexpr int VMOPS = 16;
    const bf16_t* g; bf16_t* oc;
    DEVI void operator()(const f32x4 (&acc)[2][2][4][2], const Unit& u, int wr, int wc, int fr, int fq) const {
#pragma unroll
        for (int ai = 0; ai < 2; ++ai) {
            const size_t r0 = (size_t)(u.pm * 256 + 128 * ai + 64 * wr + fr) * 256 + 32 * wc + 8 * fq;
            u32x4 gw[4][2];
#pragma unroll
            for (int m = 0; m < 4; ++m)
#pragma unroll
                for (int bj = 0; bj < 2; ++bj) gw[m][bj] = *(const u32x4*)(g + r0 + (size_t)m * 16 * 256 + 128 * bj);
#pragma unroll
            for (int m = 0; m < 4; ++m)
#pragma unroll
                for (int bj = 0; bj < 2; ++bj) { const size_t o = r0 + (size_t)m * 16 * 256 + 128 * bj; float gg[8]; unpk8s(gg, gw[m][bj]); float o8[8];
#pragma unroll
                    for (int n = 0; n < 2; ++n)
#pragma unroll
                        for (int j = 0; j < 4; ++j) o8[n * 4 + j] = gg[n * 4 + j] * frcp(1.f + __expf(-acc[ai][bj][m][n][j]));
                    u32x4 w; w.x = pk2(o8[0], o8[1]); w.y = pk2(o8[2], o8[3]); w.z = pk2(o8[4], o8[5]); w.w = pk2(o8[6], o8[7]);
                    *(u32x4*)(oc + o) = w; }
        }
    }
};

typedef float f32x16 __attribute__((ext_vector_type(16)));
typedef short s16x4 __attribute__((ext_vector_type(4)));
DEVI bf16x8 tr_pair(LAS unsigned char* p0, LAS unsigned char* p1) {
    const s16x4 a = __builtin_amdgcn_ds_read_tr16_b64_v4i16((LAS s16x4*)p0), b = __builtin_amdgcn_ds_read_tr16_b64_v4i16((LAS s16x4*)p1);
    return (bf16x8){a.x, a.y, a.z, a.w, b.x, b.y, b.z, b.w};
}
DEVI void phase_dilated(const bf16_t* qa, const bf16_t* ka, const bf16_t* va, const float* gq, const float* gk, bf16_t* oac, float* lse, LAS unsigned char* lds, int bid, int nblk) {
    const int tid = tidx(), wid = __builtin_amdgcn_readfirstlane(tid >> 6), lane = tid & 63, h5 = lane >> 5, qc = lane & 31;
    LAS unsigned char* Kimg = lds; LAS unsigned char* Vimg = lds + 49152;
    float Mn;
    { float a = fabsf(gq[lane]), b = fabsf(gk[lane]);
#pragma unroll
      for (int m = 32; m >= 1; m >>= 1) { a = fmaxf(a, __shfl_xor(a, m)); b = fmaxf(b, __shfl_xor(b, m)); }
      Mn = 8.f * a * b; }
    const float Mb = Mn * kLog2e;
    unsigned koff[4];
#pragma unroll
    for (int s = 0; s < 4; ++s) koff[s] = (unsigned)((32 * wid + qc) * 128 + (((2 * s + h5) ^ (qc & 7)) << 4));
    unsigned voff[2];
    { const int g = lane >> 4, i16 = lane & 15, q = i16 >> 2, p = i16 & 3;
#pragma unroll
      for (int dt = 0; dt < 2; ++dt) { const int c = (2 * (g & 1) + (p >> 1) + 4 * dt) ^ ((q >> 1) << 2); voff[dt] = (unsigned)((32 * wid + 4 * h5 + q) * 128 + (c << 4) + 8 * (p & 1)); } }
    const float dbase = (float)(4 * h5 - qc);
    u32x4 pK[6], pV[6];
#define DIL_DECODE(unit_) const int c = (unit_) >> 11, rem = (unit_) & 2047, bh = rem >> 5, ub = ((rem & 7) << 2) | ((rem >> 3) & 3);   \
        const int dsh = 2 * c, L = kS >> dsh, upc = 32 >> dsh, cls = ub >> (5 - dsh), u0 = (ub & (upc - 1)) << 8;
#define DIL_PREFETCH(unit_) do { DIL_DECODE(unit_) \
        const bf16_t* kbase = ka + (size_t)bh * kS * 64; const bf16_t* vbase = va + (size_t)bh * kS * 64; \
        _Pragma("unroll") for (int it = 0; it < 6; ++it) { const int id = it * kNT + tid, row = id >> 3, ch = id & 7; \
            int ki = u0 - 64 + row; ki = ki < 0 ? 0 : (ki > L - 1 ? L - 1 : ki); const size_t tok = (size_t)((ki << dsh) + cls); \
            pK[it] = *(const u32x4*)(kbase + tok * 64 + ch * 8); pV[it] = *(const u32x4*)(vbase + tok * 64 + ch * 8); } } while (0)
    if (bid < 6144) DIL_PREFETCH(bid);
    for (int unit = bid; unit < 6144; unit += nblk) {
        DIL_DECODE(unit)
        const int q0 = u0 + 32 * wid, qtok = ((q0 + qc) << dsh) + cls;
        bf16x8 Qf[4];
#pragma unroll
        for (int s = 0; s < 4; ++s) Qf[s] = *(const bf16x8*)(qa + ((size_t)bh * kS + qtok) * 64 + 16 * s + 8 * h5);
        __syncthreads();
#pragma unroll
        for (int it = 0; it < 6; ++it) { const int id = it * kNT + tid, row = id >> 3, ch = id & 7;
            *(LAS u32x4*)(Kimg + row * 128 + ((ch ^ (row & 7)) << 4)) = pK[it];
            *(LAS u32x4*)(Vimg + row * 128 + ((ch ^ (((row >> 1) & 1) << 2)) << 4)) = pV[it]; }
        __syncthreads();
        const float slope = exp2f(-(float)((bh & 7) + 1));
        const float c2 = slope * (float)(1 << dsh) * kLog2e;
        float sum = 0.f;
        f32x16 O[2];
#pragma unroll
        for (int dt = 0; dt < 2; ++dt)
#pragma unroll
            for (int i = 0; i < 16; ++i) O[dt][i] = 0.f;
        const float ndb = -dbase;
#define DIL_QK(dst, kt_) do { { const int kp0_ = q0 - 64 + 32 * (kt_); const float tm_ = (kp0_ >= 0 && kp0_ < L) ? 0.f : -1e30f; \
            const float cs_ = ((kt_) < 2) ? c2 : -c2, c0_ = (((kt_) == 0 || (kt_) == 4) ? -64.f : ((kt_) == 2 ? 0.f : -32.f)) * c2 - Mb + tm_; \
            const float bt_ = dbase * cs_ + c0_; \
            _Pragma("unroll") for (int i = 0; i < 16; i += 2) { const float k0 = (float)((i & 3) + 8 * (i >> 2)), k1 = (float)(((i + 1) & 3) + 8 * ((i + 1) >> 2)); f32x2 t; \
                if ((kt_) == 2) { const f32x2 d = {fabsf(dbase + k0), fabsf(dbase + k1)}; t = d * cs_ + c0_; } else t = (f32x2){k0, k1} * cs_ + bt_; \
                dst[i] = t.x; dst[i + 1] = t.y; } } \
            _Pragma("unroll") for (int s = 0; s < 4; ++s) { const bf16x8 Kf = *(const LAS bf16x8*)(Kimg + koff[s] + (kt_) * 4096); dst = __builtin_amdgcn_mfma_f32_32x32x16_bf16(Kf, Qf[s], dst, 0, 0, 0); } } while (0)
        f32x16 S, Sn;
        DIL_QK(S, 0);
        f32x2 sum2 = {0.f, 0.f};
#pragma unroll
        for (int kt = 0; kt < 5; ++kt) {
            if (kt < 4) DIL_QK(Sn, kt + 1);
            if (kt == 0) { if (unit + nblk < 6144) DIL_PREFETCH(unit + nblk); }
#pragma unroll
            for (int i = 0; i < 16; i += 2) {
                const float k0 = (float)((i & 3) + 8 * (i >> 2)), k1 = (float)(((i + 1) & 3) + 8 * ((i + 1) >> 2));
                f32x2 sv = (f32x2){S[i], S[i + 1]};
                if (kt == 0) { sv.x = (k0 >= ndb) ? sv.x : -1e30f; sv.y = (k1 >= ndb) ? sv.y : -1e30f; }
                if (kt == 4) { sv.x = (k0 <= ndb) ? sv.x : -1e30f; sv.y = (k1 <= ndb) ? sv.y : -1e30f; }
                f32x2 pv; pv.x = __builtin_amdgcn_exp2f(sv.x); pv.y = __builtin_amdgcn_exp2f(sv.y);
                S[i] = pv.x; S[i + 1] = pv.y; sum2 += pv;
            }
#pragma unroll
            for (int s2 = 0; s2 < 2; ++s2) {
                u32x4 pw; pw.x = pk2(S[8 * s2 + 0], S[8 * s2 + 1]); pw.y = pk2(S[8 * s2 + 2], S[8 * s2 + 3]); pw.z = pk2(S[8 * s2 + 4], S[8 * s2 + 5]); pw.w = pk2(S[8 * s2 + 6], S[8 * s2 + 7]);
                const bf16x8 Pf = __builtin_bit_cast(bf16x8, pw);
#pragma unroll
                for (int dt = 0; dt < 2; ++dt) { LAS unsigned char* vp = Vimg + voff[dt] + kt * 4096 + s2 * 2048;
                    const bf16x8 Vf = tr_pair(vp, vp + 1024);
                    O[dt] = __builtin_amdgcn_mfma_f32_32x32x16_bf16(Vf, Pf, O[dt], 0, 0, 0); }
            }
            if (kt < 4) S = Sn;
        }
#undef DIL_QK
        sum = sum2.x + sum2.y;
        sum = xsum32(sum);
        const float inv = 1.f / sum;
        const size_t tok = (size_t)(bh >> 3) * kS + qtok;
        {
        LAS unsigned char* ost = lds + 98304 + wid * 4096;
#pragma unroll
        for (int dt = 0; dt < 2; ++dt)
#pragma unroll
            for (int g4 = 0; g4 < 4; ++g4) { u32x2 w; w.x = pk2(O[dt][4 * g4] * inv, O[dt][4 * g4 + 1] * inv); w.y = pk2(O[dt][4 * g4 + 2] * inv, O[dt][4 * g4 + 3] * inv);
                *(LAS u32x2*)(ost + qc * 128 + (((4 * dt + g4) ^ (qc & 7)) << 4) + 8 * h5) = w; }
        if (h5 == 0) lse[((size_t)c * kTok + tok) * 8 + (bh & 7)] = Mn + __logf(sum);
        bf16_t* obase = oac + ((size_t)c * kTok + (size_t)(bh >> 3) * kS) * 512 + (bh & 7) * 64;
#pragma unroll
        for (int it = 0; it < 4; ++it) { const int r = it * 8 + (lane >> 3), ch = lane & 7;
            const u32x4 v = *(const LAS u32x4*)(ost + r * 128 + ((ch ^ (r & 7)) << 4));
            const size_t t2 = (size_t)(((q0 + r) << dsh) + cls);
            *(u32x4*)(obase + t2 * 512 + ch * 8) = v; }
        }
    }
#undef DIL_DECODE
#undef DIL_PREFETCH
    __syncthreads();
}
DEVI void phase_na(const bf16_t* qb, const bf16_t* kb, const bf16_t* vb, const float* rpb  , const float* gq, const float* gk, bf16_t* ob, LAS unsigned char* lds, int bid, int nblk) {
    const int tid = tidx(), wid = __builtin_amdgcn_readfirstlane(tid >> 6), lane = tid & 63, g4 = lane >> 4, i16 = lane & 15;
    LAS unsigned char* Kimg = lds; LAS unsigned char* Vimg = lds + 73728; LAS float* tab = (LAS float*)(lds + 147456);
    __syncthreads();
    for (int i = tid; i < 4 * 465; i += kNT) tab[i] = rpb[i];
    float Mq;
    { float a = fabsf(gq[lane]), b = fabsf(gk[lane]);
#pragma unroll
      for (int m = 32; m >= 1; m >>= 1) { a = fmaxf(a, __shfl_xor(a, m)); b = fmaxf(b, __shfl_xor(b, m)); }
      Mq = 8.f * a * b; }
    __syncthreads();
    if (wid < 4) { float m = 0.f; for (int i = lane; i < 465; i += 64) m = fmaxf(m, fabsf(tab[wid * 465 + i]));
#pragma unroll
        for (int k = 32; k >= 1; k >>= 1) m = fmaxf(m, __shfl_xor(m, k));
        if (lane == 0) tab[1860 + wid] = m; }
    __syncthreads();
    const int g = wid & 3, kcs = (16 * g - 8) < 0 ? 0 : ((16 * g - 8) > 32 ? 32 : (16 * g - 8));
    const int qcol = 16 * g + i16, cs = (qcol - 8) < 0 ? 0 : ((qcol - 8) > 48 ? 48 : (qcol - 8));
    unsigned kswz[2];
#pragma unroll
    for (int s = 0; s < 2; ++s) kswz[s] = (unsigned)(((4 * s + g4) ^ (i16 & 7)) << 4);
    const int q = i16 >> 2, p = i16 & 3, sw = 2 * (g4 & 1) + (q >> 1);
    unsigned vsw[4];
#pragma unroll
    for (int dt = 0; dt < 4; ++dt) vsw[dt] = (unsigned)((((2 * dt + (p >> 1)) ^ (sw << 1)) << 4) + 8 * (p & 1));
    const int scol = tid >> 3, sch = tid & 7;
    const unsigned skoff = (unsigned)(scol * 128 + ((sch ^ (scol & 7)) << 4)), svoff = (unsigned)(scol * 128 + ((sch ^ (((scol >> 1) & 3) << 1)) << 4));
    u32x4 pK[2], pV[2];
    for (int run = bid; run < 256; run += nblk) {
      const int bh = run >> 3, h = bh & 3;
      const bf16_t* kbase = kb + (size_t)bh * kS * 64 + scol * 64 + sch * 8; const bf16_t* vbase = vb + (size_t)bh * kS * 64 + scol * 64 + sch * 8;
      const LAS float* th = tab + h * 465;
      const float Mb = (Mq + tab[1860 + h]) * kLog2e;
      const int ecol0 = kcs + 4 * g4 - cs, dcb0 = kcs + 4 * g4 - qcol + 15;
      f32x4 Bi[8][2];
#pragma unroll
      for (int u = 0; u < 8; ++u)
#pragma unroll
          for (int tt = 0; tt < 2; ++tt)
#pragma unroll
              for (int jj = 0; jj < 4; ++jj) { const int e = ecol0 + 16 * tt + jj; int dc = dcb0 + 16 * tt + jj; dc = dc < 0 ? 0 : (dc > 30 ? 30 : dc);
                  Bi[u][tt][jj] = ((unsigned)e < 16u) ? th[(u + 3) * 31 + dc] * kLog2e - Mb : -1e30f; }
#pragma unroll 1
      for (int j = 0; j < 8; ++j) {
        const int rp = (run & 7) * 8 + j, r0 = 2 * rp;
        const int rsA = (r0 - 4) < 0 ? 0 : ((r0 - 4) > 120 ? 120 : (r0 - 4));
        const int prsA = (r0 - 6) < 0 ? 0 : ((r0 - 6) > 120 ? 120 : (r0 - 6));
        const int rr = r0 + (wid >> 2);
        const int rs = (rr - 4) < 0 ? 0 : ((rr - 4) > 120 ? 120 : (rr - 4));
        const int qtok = rr * 64 + qcol;
        bf16x8 Qf[2];
#pragma unroll
        for (int s = 0; s < 2; ++s) Qf[s] = *(const bf16x8*)(qb + ((size_t)bh * kS + qtok) * 64 + 32 * s + 8 * g4);
        __syncthreads();
        if (j == 0) {
#pragma unroll
            for (int it = 0; it < 9; ++it) { const int gr = rsA + it; if (gr < 128) { const int sl = gr % 9;
                const u32x4 kv = *(const u32x4*)(kbase + (size_t)gr * 64 * 64), vv = *(const u32x4*)(vbase + (size_t)gr * 64 * 64);
                *(LAS u32x4*)(Kimg + sl * 8192 + skoff) = kv; *(LAS u32x4*)(Vimg + sl * 8192 + svoff) = vv; } }
        } else {
#pragma unroll
            for (int it = 0; it < 2; ++it) { const int gr = prsA + 9 + it; if (gr <= rsA + 8 && gr < 128) { const int sl = gr % 9;
                *(LAS u32x4*)(Kimg + sl * 8192 + skoff) = pK[it]; *(LAS u32x4*)(Vimg + sl * 8192 + svoff) = pV[it]; } }
        }
        __syncthreads();
        if (j < 7) {
            const int nrsA = (r0 - 2) < 0 ? 0 : ((r0 - 2) > 120 ? 120 : (r0 - 2));
#pragma unroll
            for (int it = 0; it < 2; ++it) { int gr = rsA + 9 + it; gr = (gr <= nrsA + 8 && gr < 128) ? gr : 127;
                pK[it] = *(const u32x4*)(kbase + (size_t)gr * 64 * 64); pV[it] = *(const u32x4*)(vbase + (size_t)gr * 64 * 64); }
        }
        const int sb0 = rs % 9;
        const unsigned kb0 = (unsigned)((kcs + i16) * 128), vb0 = (unsigned)((kcs + 4 * g4 + q) * 128);
        float sum = 0.f;
        f32x4 O[4];
#pragma unroll
        for (int dt = 0; dt < 4; ++dt) O[dt] = (f32x4){0.f, 0.f, 0.f, 0.f};
#define NA_SO(u_) ((unsigned)((sb0 + (u_) >= 9 ? sb0 + (u_) - 9 : sb0 + (u_)) * 8192))
#define NA_QK(dst, u_, INIT) do { const unsigned so_ = NA_SO(u_); _Pragma("unroll") for (int tt = 0; tt < 2; ++tt) { \
            const bf16x8 Kf0 = *(const LAS bf16x8*)(Kimg + kb0 + so_ + tt * 2048 + kswz[0]), Kf1 = *(const LAS bf16x8*)(Kimg + kb0 + so_ + tt * 2048 + kswz[1]); \
            dst[tt] = __builtin_amdgcn_mfma_f32_16x16x32_bf16(Kf0, Qf[0], INIT(u_, tt), 0, 0, 0); dst[tt] = __builtin_amdgcn_mfma_f32_16x16x32_bf16(Kf1, Qf[1], dst[tt], 0, 0, 0); } } while (0)
#define NA_SOFTPV(S_, u_) do { const unsigned so_ = NA_SO(u_); \
            _Pragma("unroll") for (int tt = 0; tt < 2; ++tt) _Pragma("unroll") for (int jj = 0; jj < 4; ++jj) { const float pv = __builtin_amdgcn_exp2f(S_[tt][jj]); S_[tt][jj] = pv; sum += pv; } \
            u32x4 pw; pw.x = pk2(S_[0][0], S_[0][1]); pw.y = pk2(S_[0][2], S_[0][3]); pw.z = pk2(S_[1][0], S_[1][1]); pw.w = pk2(S_[1][2], S_[1][3]); \
            const bf16x8 Pf = __builtin_bit_cast(bf16x8, pw); \
            _Pragma("unroll") for (int dt = 0; dt < 4; ++dt) { LAS unsigned char* vp = Vimg + vb0 + so_ + vsw[dt]; \
                const bf16x8 Vf = tr_pair(vp, vp + 2048); \
                O[dt] = __builtin_amdgcn_mfma_f32_16x16x32_bf16(Vf, Pf, O[dt], 0, 0, 0); } } while (0)
#define NA_INIT_REG(u_, tt_) Bi[u_][tt_]
        if (rs - rr == -4) {
            f32x4 S[2], Sn[2];
            NA_QK(S, 0, NA_INIT_REG);
#pragma unroll
            for (int u = 0; u < 8; ++u) {
                if (u < 7) NA_QK(Sn, u + 1, NA_INIT_REG);
                NA_SOFTPV(S, u);
                if (u < 7) { S[0] = Sn[0]; S[1] = Sn[1]; }
            }
        } else {
            int g4v = g4; asm volatile("" : "+v"(g4v));
            const int ecol = kcs + 4 * g4v - cs, dcb = kcs + 4 * g4v - qcol + 15;
#pragma unroll
            for (int u = 0; u < 8; ++u) {
                const LAS float* tr = th + (rs + u - rr + 7) * 31;
                f32x4 In[2];
#pragma unroll
                for (int tt = 0; tt < 2; ++tt)
#pragma unroll
                    for (int jj = 0; jj < 4; ++jj) { const int e = ecol + 16 * tt + jj; int dc = dcb + 16 * tt + jj; dc = dc < 0 ? 0 : (dc > 30 ? 30 : dc);
                        In[tt][jj] = ((unsigned)e < 16u) ? tr[dc] * kLog2e - Mb : -1e30f; }
#define NA_INIT_TAB(u_, tt_) In[tt_]
                f32x4 S[2];
                NA_QK(S, u, NA_INIT_TAB);
                NA_SOFTPV(S, u);
#undef NA_INIT_TAB
            }
        }
#undef NA_INIT_REG
#undef NA_SOFTPV
#undef NA_QK
#undef NA_SO
        sum = xsum32(xsum16(sum));
        const float inv = 1.f / sum;
        bf16_t* orow = ob + ((size_t)(bh >> 2) * kS + qtok) * 256 + h * 64;
#pragma unroll
        for (int dt = 0; dt < 4; ++dt) { u32x2 w; w.x = pk2(O[dt][0] * inv, O[dt][1] * inv); w.y = pk2(O[dt][2] * inv, O[dt][3] * inv); *(u32x2*)(orow + 16 * dt + 4 * g4) = w; }
      }
    }
    __syncthreads();
}
DEVI void unpk8(float* d, const u32x4 q, const float sc) {
    d[0] += sc * __uint_as_float(q.x << 16); d[1] += sc * __uint_as_float(q.x & 0xFFFF0000u); d[2] += sc * __uint_as_float(q.y << 16); d[3] += sc * __uint_as_float(q.y & 0xFFFF0000u);
    d[4] += sc * __uint_as_float(q.z << 16); d[5] += sc * __uint_as_float(q.z & 0xFFFF0000u); d[6] += sc * __uint_as_float(q.w << 16); d[7] += sc * __uint_as_float(q.w & 0xFFFF0000u);
}
DEVI void phase_mixnorm(const bf16_t* oac, const float* lse, const bf16_t* ob, const bf16_t* oc, const float* ga, const float* gb, const float* gc, bf16_t* mix, int bid, int nblk) {
    const int wid = tidx() >> 6, lane = tidx() & 63;
    float gn[16];
    { const float* gp = (lane < 32) ? ga + lane * 16 : (lane < 48) ? gb + (lane - 32) * 16 : gc + (lane - 48) * 16;
#pragma unroll
      for (int i = 0; i < 16; ++i) gn[i] = gp[i]; }
    const int stride = nblk * 8;
    int row = bid * 8 + wid;
    if (row >= kTok) return;
    u32x4 Aq[6], Bq[6]; float Al[3], Bl[3];
    const bool dil = lane < 32;
    const int hh = dil ? (lane >> 2) : 0;
#define MX_ISSUE(R, Q, L) do { \
        const bf16_t* p0_ = dil ? oac + (size_t)(R) * 512 + lane * 16 : ((lane < 48) ? ob + (size_t)(R) * 256 + (lane - 32) * 16 : oc + (size_t)(R) * 256 + (lane - 48) * 16); \
        const size_t cst_ = dil ? (size_t)kTok * 512 : (size_t)0; \
        Q[0] = *(const u32x4*)p0_; Q[1] = *(const u32x4*)(p0_ + 8); Q[2] = *(const u32x4*)(p0_ + cst_); Q[3] = *(const u32x4*)(p0_ + cst_ + 8); Q[4] = *(const u32x4*)(p0_ + 2 * cst_); Q[5] = *(const u32x4*)(p0_ + 2 * cst_ + 8); \
        L[0] = lse[(size_t)(R) * 8 + hh]; L[1] = lse[((size_t)kTok + (R)) * 8 + hh]; L[2] = lse[((size_t)2 * kTok + (R)) * 8 + hh]; } while (0)
#define MX_BODY(C, N) do { \
        const int nrow_ = (row + stride < kTok) ? row + stride : row; \
        MX_ISSUE(nrow_, N##q, N##l); \
        float v[16]; \
        _Pragma("unroll") for (int i = 0; i < 16; ++i) v[i] = 0.f; \
        float w0 = 1.f, w1 = 0.f, w2 = 0.f; \
        if (dil) { const float mx = fmaxf(C##l[0], fmaxf(C##l[1], C##l[2])); w0 = __expf(C##l[0] - mx); w1 = __expf(C##l[1] - mx); w2 = __expf(C##l[2] - mx); const float inv = frcp(w0 + w1 + w2); w0 *= inv; w1 *= inv; w2 *= inv; } \
        unpk8(v, C##q[0], w0); unpk8(v + 8, C##q[1], w0); unpk8(v, C##q[2], w1); unpk8(v + 8, C##q[3], w1); unpk8(v, C##q[4], w2); unpk8(v + 8, C##q[5], w2); \
        float ss = 0.f; \
        _Pragma("unroll") for (int i = 0; i < 16; ++i) ss += v[i] * v[i]; \
        ss = row_sum16(ss); \
        { float a = ss, b = ss; swap16(a, b); if (lane < 32) ss = a + b; } \
        const float rstd = rsqrtf(ss * ((lane < 32) ? (1.f / 512.f) : (1.f / 256.f)) + kEps); \
        u32x4 o0, o1; \
        o0.x = pk2(v[0] * rstd * gn[0], v[1] * rstd * gn[1]); o0.y = pk2(v[2] * rstd * gn[2], v[3] * rstd * gn[3]); o0.z = pk2(v[4] * rstd * gn[4], v[5] * rstd * gn[5]); o0.w = pk2(v[6] * rstd * gn[6], v[7] * rstd * gn[7]); \
        o1.x = pk2(v[8] * rstd * gn[8], v[9] * rstd * gn[9]); o1.y = pk2(v[10] * rstd * gn[10], v[11] * rstd * gn[11]); o1.z = pk2(v[12] * rstd * gn[12], v[13] * rstd * gn[13]); o1.w = pk2(v[14] * rstd * gn[14], v[15] * rstd * gn[15]); \
        *(u32x4*)(mix + (size_t)row * kD + lane * 16) = o0; *(u32x4*)(mix + (size_t)row * kD + lane * 16 + 8) = o1; } while (0)
    MX_ISSUE(row, Aq, Al);
    for (;;) {
        MX_BODY(A, B); row += stride; if (row >= kTok) break;
        MX_BODY(B, A); row += stride; if (row >= kTok) break;
    }
#undef MX_BODY
#undef MX_ISSUE
}
DEVI void phase_combine(bf16_t* xb, bf16_t* xbo, float* out32, const bf16_t* y, const float* gate, const int* tokslot, bool last_layer, float* rstdp, int bid, int nblk) {
    const int wid = tidx() >> 6, lane = tidx() & 63;
    const int stride = nblk * 8;
    int row = bid * 8 + wid;
    if (row >= kTok) return;
    u32x4 Ax0, Ax1, Ay[4], Bx0, Bx1, By[4]; float Ag[4], Bg[4]; unsigned Am = 0u, Bm = 0u;
#define CB_ISSUE(R, TS, X0, X1, Y, G, M) do { const int b_ = (R) >> 13; \
        M = (unsigned)__builtin_amdgcn_ballot_w64(lane < 16 && (TS) >= 0); unsigned mm_ = M; \
        X0 = *(const u32x4*)(xb + (size_t)(R) * kD + lane * 16); X1 = *(const u32x4*)(xb + (size_t)(R) * kD + lane * 16 + 8); \
        _Pragma("unroll") for (int j = 0; j < 4; ++j) { const bool has_ = mm_ != 0u; const int e_ = has_ ? __builtin_ctz(mm_) : 0; const int sl_ = has_ ? __builtin_amdgcn_readlane((TS), e_) : 0; \
            const size_t r_ = has_ ? (size_t)(e_ * kB + b_) * kCap + sl_ : (size_t)0; Y[j] = *(const u32x4*)((const unsigned char*)y + r_ * kD + lane * 16); G[j] = gate[r_]; mm_ &= mm_ - 1u; } } while (0)
#define CB_ACC(YV, GS) do { const unsigned ww_[4] = {(YV).x, (YV).y, (YV).z, (YV).w}; const float gs_ = __builtin_bit_cast(float, __builtin_amdgcn_readfirstlane(__builtin_bit_cast(int, (GS))));   \
        _Pragma("unroll") for (int k = 0; k < 4; ++k) { const f32x2 lo = __builtin_amdgcn_cvt_pk_f32_fp8(ww_[k], false), hi = __builtin_amdgcn_cvt_pk_f32_fp8(ww_[k], true); \
            v[4 * k] += lo.x * gs_; v[4 * k + 1] += lo.y * gs_; v[4 * k + 2] += hi.x * gs_; v[4 * k + 3] += hi.y * gs_; } } while (0)
#define CB_BODY(C, N) do { \
        const int nrow_ = (row + stride < kTok) ? row + stride : row, nnrow_ = (row + 2 * stride < kTok) ? row + 2 * stride : row, b = row >> 13; \
        const int ts2 = tokslot[(size_t)nnrow_ * kE + (lane & 15)]; \
        CB_ISSUE(nrow_, ts1, N##x0, N##x1, N##y, N##g, N##m); \
        float v[16]; unpk8s(v, C##x0); unpk8s(v + 8, C##x1); \
        unsigned mm = C##m; \
        _Pragma("unroll") for (int j = 0; j < 4; ++j) { if (mm != 0u) CB_ACC(C##y[j], C##g[j]); mm &= mm - 1u; } \
        while (mm != 0u) { const int e = __builtin_ctz(mm), sl = __builtin_amdgcn_readlane(ts0, e); const size_t r = (size_t)(e * kB + b) * kCap + sl; \
            const u32x4 yv = *(const u32x4*)((const unsigned char*)y + r * kD + lane * 16); const float gs = gate[r]; CB_ACC(yv, gs); mm &= mm - 1u; } \
        if (last_layer) { \
            _Pragma("unroll") for (int k = 0; k < 4; ++k) *(f32x4*)(out32 + (size_t)row * kD + lane * 16 + 4 * k) = (f32x4){v[4 * k], v[4 * k + 1], v[4 * k + 2], v[4 * k + 3]}; \
        } else { u32x4 o0, o1; \
            o0.x = pk2(v[0], v[1]); o0.y = pk2(v[2], v[3]); o0.z = pk2(v[4], v[5]); o0.w = pk2(v[6], v[7]); o1.x = pk2(v[8], v[9]); o1.y = pk2(v[10], v[11]); o1.z = pk2(v[12], v[13]); o1.w = pk2(v[14], v[15]); \
            *(u32x4*)(xbo + (size_t)row * kD + lane * 16) = o0; *(u32x4*)(xbo + (size_t)row * kD + lane * 16 + 8) = o1; \
            unpk8s(v, o0); unpk8s(v + 8, o1);                     \
            float ss = 0.f; \
            _Pragma("unroll") for (int i = 0; i < 16; ++i) ss += v[i] * v[i]; \
            ss = wave_sum(ss); \
            if (lane == 0) rstdp[row] = rsqrtf(ss * (1.f / kD) + kEps);     \
        } \
        ts0 = ts1; ts1 = ts2; } while (0)
    int ts0 = tokslot[(size_t)row * kE + (lane & 15)];
    int ts1 = tokslot[(size_t)((row + stride < kTok) ? row + stride : row) * kE + (lane & 15)];
    CB_ISSUE(row, ts0, Ax0, Ax1, Ay, Ag, Am);
    for (;;) {
        CB_BODY(A, B); row += stride; if (row >= kTok) break;
        CB_BODY(B, A); row += stride; if (row >= kTok) break;
    }
#undef CB_BODY
#undef CB_ISSUE
#undef CB_ACC
}

DEVI void cpow_m(double a, double w, double dt, int m, float& re, float& im) {
    const float mag = __expf((float)m * (float)a * (float)dt);
    const double turns = (double)m * w * dt * 0.15915494309189535; const float ang = (float)((turns - floor(turns)) * 6.283185307179586);
    re = mag * cosf(ang); im = mag * sinf(ang);
}
DEVI void s5_prep_item(const Params& P, int l, int g, unsigned char* lds_) {
    float* pw = (float*)lds_;
    float* bb = pw + 4352;
    float* cc = bb + 4096;
    float* kt = cc + 4096;
    const int tid = tidx();
    __syncthreads();
    for (int i = tid; i < 128; i += kNT) { const int dir = i >> 6, p = i & 63; const size_t pb = (((size_t)l * 2 + dir) * 16 + g) * 64 + p;
        const double dt = (double)__expf(P.s5_log_dt[((size_t)l * 2 + dir) * 16 + g]); const double a = (double)fminf(P.s5_a_re[pb], -1e-4f), w = (double)P.s5_a_im[pb];
        for (int m = 0; m < 17; ++m) { float re, im; cpow_m(a, w, dt, m, re, im); pw[((dir * 64 + p) * 17 + m) * 2] = re; pw[((dir * 64 + p) * 17 + m) * 2 + 1] = im; }
        const float af = (float)a, wf = (float)w, ar = pw[((dir * 64 + p) * 17 + 1) * 2], ai = pw[((dir * 64 + p) * 17 + 1) * 2 + 1];
        const float den = af * af + wf * wf, zr = ar - 1.f, gr = (zr * af + ai * wf) / den, gi = (ai * af - zr * wf) / den;
        for (int c = 0; c < 16; ++c) { const float br = P.s5_b_re[pb * 16 + c], bi = P.s5_b_im[pb * 16 + c]; bb[((dir * 64 + p) * 16 + c) * 2] = gr * br - gi * bi; bb[((dir * 64 + p) * 16 + c) * 2 + 1] = gr * bi + gi * br; }
    }
    for (int i = tid; i < 2048; i += kNT) { const int dir = i >> 10, c = (i >> 6) & 15, p = i & 63; const size_t o = ((((size_t)l * 2 + dir) * 16 + g) * 16 + c) * 64 + p; cc[i * 2] = P.s5_c_re[o]; cc[i * 2 + 1] = P.s5_c_im[o]; }
    __syncthreads();
    for (int i = tid; i < 8192; i += kNT) { const int dir = i >> 12, m = (i >> 8) & 15, c = (i >> 4) & 15, c2 = i & 15; float acc = 0.f;
        for (int p = 0; p < 64; ++p) { const float cr = cc[((dir * 16 + c) * 64 + p) * 2], ci = cc[((dir * 16 + c) * 64 + p) * 2 + 1], wr_ = pw[((dir * 64 + p) * 17 + m) * 2], wi_ = pw[((dir * 64 + p) * 17 + m) * 2 + 1];
            const float br = bb[((dir * 64 + p) * 16 + c2) * 2], bi = bb[((dir * 64 + p) * 16 + c2) * 2 + 1]; const float tr = cr * wr_ - ci * wi_, ti = cr * wi_ + ci * wr_; acc += tr * br - ti * bi; }
        kt[i] = acc; }
    __syncthreads();
    bf16_t* wst = (bf16_t*)(wsp(P) + WS_WST) + ((size_t)l * 16 + g) * 256 * 256;
    bf16_t* wso = (bf16_t*)(wsp(P) + WS_WSO) + ((size_t)l * 16 + g) * 256 * 512;
    for (int id = tid; id < 8192; id += kNT) { const int n = id >> 5, k0 = (id & 31) * 8, dir = n >> 7, p = (n >> 1) & 63, ri = n & 1; float v[8];
#pragma unroll
        for (int kk = 0; kk < 8; ++kk) { const int k = k0 + kk, t = k >> 4, c = k & 15, e = dir ? t : 15 - t; const float wr_ = pw[((dir * 64 + p) * 17 + e) * 2], wi_ = pw[((dir * 64 + p) * 17 + e) * 2 + 1], br = bb[((dir * 64 + p) * 16 + c) * 2], bi = bb[((dir * 64 + p) * 16 + c) * 2 + 1];
            v[kk] = ri ? (wr_ * bi + wi_ * br) : (wr_ * br - wi_ * bi); }
        u32x4 o; o.x = pk2(v[0], v[1]); o.y = pk2(v[2], v[3]); o.z = pk2(v[4], v[5]); o.w = pk2(v[6], v[7]); *(u32x4*)(wst + (size_t)n * 256 + k0) = o; }
    for (int id = tid; id < 16384; id += kNT) { const int ns = id >> 6, k0 = (id & 63) * 8, n = cmap_pk(ns), t = n >> 4, c = n & 15; float v[8];
#pragma unroll
        for (int kk = 0; kk < 8; ++kk) { const int k = k0 + kk; float x;
            if (k < 256) { const int j = k >> 4, c2 = k & 15; x = 0.f; if (j <= t) x += kt[(t - j) * 256 + c * 16 + c2]; if (j >= t) x += kt[4096 + (j - t) * 256 + c * 16 + c2]; if (j == t && c == c2) x += P.s5_d[l * 256 + g * 16 + c]; }
            else { const int q = k - 256, dir = q >> 7, p = (q >> 1) & 63, ri = q & 1, e = dir ? 16 - t : t + 1; const float cr = cc[((dir * 16 + c) * 64 + p) * 2], ci = cc[((dir * 16 + c) * 64 + p) * 2 + 1], wr_ = pw[((dir * 64 + p) * 17 + e) * 2], wi_ = pw[((dir * 64 + p) * 17 + e) * 2 + 1];
                x = ri ? -(cr * wi_ + ci * wr_) : (cr * wr_ - ci * wi_); }
            v[kk] = x; }
        u32x4 o; o.x = pk2(v[0], v[1]); o.y = pk2(v[2], v[3]); o.z = pk2(v[4], v[5]); o.w = pk2(v[6], v[7]); *(u32x4*)(wso + (size_t)ns * 512 + k0) = o; }
    __syncthreads();
}
DEVI void phase_s5_scan(const Params& P, int l, const float* Z, bf16_t* ux, unsigned char* lds_, int bid, int nblk) {
    const int tid = tidx(), wid = tid >> 6, lane = tid & 63;
    float* E = (float*)lds_;
    for (int item = bid; item < 256; item += nblk) {
        const int dir = item & 1, g = (item >> 1) & 15, b = item >> 5;
        const size_t pb = (((size_t)l * 2 + dir) * 16 + g) * 64 + lane;
        const double dt = (double)__expf(P.s5_log_dt[((size_t)l * 2 + dir) * 16 + g]); const double a = (double)fminf(P.s5_a_re[pb], -1e-4f), w = (double)P.s5_a_im[pb];
        float a16r, a16i, Ar, Ai; cpow_m(a, w, dt, 16, a16r, a16i); cpow_m(a, w, dt, 1024, Ar, Ai);
        const int kk0 = dir ? 511 - 64 * wid : 64 * wid; const long sstep = dir ? -1 : 1;
        const float* zp = Z + ((size_t)g * 4096 + b * 512 + kk0) * 256 + dir * 128 + 2 * lane;
        f32x2 z[64];
#pragma unroll
        for (int i = 0; i < 64; ++i) { z[i] = *(const f32x2*)zp; zp += sstep * 256; }
        float xr = 0.f, xi = 0.f;
#pragma unroll
        for (int i = 0; i < 64; ++i) { const float nr = a16r * xr - a16i * xi + z[i].x, ni = a16r * xi + a16i * xr + z[i].y; xr = nr; xi = ni; }
        __syncthreads();
        E[(wid * 64 + lane) * 2] = xr; E[(wid * 64 + lane) * 2 + 1] = xi;
        __syncthreads();
        float sr = 0.f, si = 0.f;
#pragma unroll
        for (int s2 = 0; s2 < 7; ++s2) if (s2 < wid) { const float er = E[(s2 * 64 + lane) * 2], ei = E[(s2 * 64 + lane) * 2 + 1]; const float nr = Ar * sr - Ai * si + er, ni = Ar * si + Ai * sr + ei; sr = nr; si = ni; }
        bf16_t* up = ux + ((size_t)g * 4096 + b * 512 + kk0) * 512 + 256 + dir * 128 + 2 * lane;
#pragma unroll
        for (int i = 0; i < 64; ++i) { *(unsigned*)up = pk2(sr, si); up += sstep * 512;
            const float nr = a16r * sr - a16i * si + z[i].x, ni = a16r * si + a16i * sr + z[i].y; sr = nr; si = ni; }
    }
    __syncthreads();
}
struct EpiF32N {
    DEVI void stage(LAS unsigned char*, const Unit&, int, int) const {}
    static constexpr int VMOPS = 32;
    float* z; int ldz;
    DEVI void operator()(const f32x4 (&acc)[2][2][4][2], const Unit& u, int wr, int wc, int fr, int fq) const {
#pragma unroll
        for (int ai = 0; ai < 2; ++ai)
#pragma unroll
            for (int m = 0; m < 4; ++m) { const size_t ro = (size_t)(u.pm * 256 + 128 * ai + 64 * wr + 16 * m + fr) * ldz + u.pn * 256 + 32 * wc + 4 * fq;
#pragma unroll
                for (int bj = 0; bj < 2; ++bj)
#pragma unroll
                    for (int n = 0; n < 2; ++n) *(f32x4*)(z + ro + 128 * bj + 16 * n) = acc[ai][bj][m][n]; }
    }
};
struct EpiS5Out {
    DEVI void stage(LAS unsigned char*, const Unit&, int, int) const {}
    static constexpr int VMOPS = 16;
    bf16_t* G;
    DEVI void operator()(const f32x4 (&acc)[2][2][4][2], const Unit& u, int wr, int wc, int fr, int fq) const {
#pragma unroll
        for (int ai = 0; ai < 2; ++ai)
#pragma unroll
            for (int m = 0; m < 4; ++m) { const int R = u.pm * 256 + 128 * ai + 64 * wr + 16 * m + fr, g = R >> 12, ck = R & 4095;
#pragma unroll
                for (int bj = 0; bj < 2; ++bj) { const int t = 8 * bj + 2 * wc + (fq >> 1), c0 = 8 * (fq & 1);
                    const f32x4 v0 = acc[ai][bj][m][0], v1 = acc[ai][bj][m][1];
                    u32x4 w; w.x = pk2(gelu_tanh(v0.x), gelu_tanh(v0.y)); w.y = pk2(gelu_tanh(v0.z), gelu_tanh(v0.w)); w.z = pk2(gelu_tanh(v1.x), gelu_tanh(v1.y)); w.w = pk2(gelu_tanh(v1.z), gelu_tanh(v1.w));
                    *(u32x4*)(G + ((size_t)ck * 16 + t) * 256 + g * 16 + c0) = w; } }
    }
};
#define XB_TMO      128
#define XB_XCNT(j)  (256  + 64 * (j))
#define XB_XSUB(j)  (1280 + 64 * (j))
#define XB_XGEN(j)  (2304 + 64 * (j))
#define XB_TOP      3328
#define XB_TOPGEN   3392
#define XCD_BAR_WORDS 3456
#define XB_SPIN_CAP (1u << 26)
DEVI unsigned xb_ld(unsigned* p)              { return __hip_atomic_load(p, __ATOMIC_RELAXED, __HIP_MEMORY_SCOPE_AGENT); }
DEVI unsigned xb_add(unsigned* p, unsigned v) { return __hip_atomic_fetch_add(p, v, __ATOMIC_RELAXED, __HIP_MEMORY_SCOPE_AGENT); }
DEVI unsigned xb_xcc_id() { return (unsigned)__builtin_amdgcn_s_getreg((3 << 11) | 20) & 0xFu; }
#define XB_SPIN(cond, bar) do { unsigned _sp = 0; while (cond) { __builtin_amdgcn_s_sleep(1); \
    if ((++_sp & 255u) == 0u) { if (xb_ld(&(bar)[XB_TMO])) break; if (_sp > XB_SPIN_CAP) { atomicAdd(&(bar)[XB_TMO], 1u); break; } } } } while (0)
struct XcdBarrier { unsigned* bar; unsigned x; volatile LAS unsigned* st; };
DEVI XcdBarrier xcd_barrier_post(unsigned* bar, volatile LAS unsigned* st) {
    XcdBarrier b; b.bar = bar; b.x = xb_xcc_id(); b.st = st;
    if (threadIdx.x == 0) (void)xb_add(&bar[XB_XCNT(b.x)], 1u);
    return b;
}
DEVI void xcd_barrier_complete(unsigned* bar, unsigned x, unsigned& nloc, unsigned& nx) {
    const unsigned G = gridDim.x * gridDim.y * gridDim.z;
    unsigned sum, cnt, mine, sp = 0u;
    for (;;) {
        sum = 0u; cnt = 0u; mine = 0u;
#pragma unroll
        for (unsigned j = 0; j < 16; ++j) { const unsigned c = xb_ld(&bar[XB_XCNT(j)]); sum += c; cnt += (c > 0u) ? 1u : 0u; mine = (j == x) ? c : mine; }
        if (sum == G) break;
        __builtin_amdgcn_s_sleep(1);
        if ((++sp & 255u) == 0u) { if (xb_ld(&bar[XB_TMO])) break; if (sp > XB_SPIN_CAP) { atomicAdd(&bar[XB_TMO], 1u); break; } }
    }
    nloc = mine > 0u ? mine : 1u; nx = cnt > 0u ? cnt : 1u;
}
DEVI void xcd_barrier(const XcdBarrier& b) {
    asm volatile("s_waitcnt vmcnt(0)" ::: "memory");
    __syncthreads();
    if (threadIdx.x == 0) {
        unsigned long long bp_ = (unsigned long long)b.bar; asm volatile("" : "+s"(bp_));
        unsigned* bar = (unsigned*)bp_;
        const unsigned bx = xb_xcc_id();
        __builtin_amdgcn_s_waitcnt(0);
        unsigned nloc = b.st[0], nx = b.st[1];
        if (nloc == 0u) { xcd_barrier_complete(bar, bx, nloc, nx); b.st[0] = nloc; b.st[1] = nx; }
        const unsigned old = xb_add(&bar[XB_XSUB(bx)], 1u);
        const unsigned gen = old / nloc;
        if (old + 1u == (gen + 1u) * nloc) {
            __builtin_amdgcn_fence(__ATOMIC_RELEASE, "agent");
            asm volatile("s_waitcnt vmcnt(0)" ::: "memory");
            const unsigned og = xb_add(&bar[XB_TOP], 1u);
            const unsigned tg = og / nx;
            if (og + 1u == (tg + 1u) * nx) xb_add(&bar[XB_TOPGEN], 1u);
            else XB_SPIN(xb_ld(&bar[XB_TOPGEN]) == tg, bar);
            __builtin_amdgcn_fence(__ATOMIC_ACQUIRE, "agent");
            xb_add(&bar[XB_XGEN(bx)], 1u);
            asm volatile("s_waitcnt vmcnt(0)" ::: "memory");
        } else {
            XB_SPIN(xb_ld(&bar[XB_XGEN(bx)]) == gen, bar);
            __builtin_amdgcn_fence(__ATOMIC_ACQUIRE, "agent");
            asm volatile("s_waitcnt vmcnt(0)" ::: "memory");
        }
    }
    __syncthreads();
}

constexpr int LDS_BYTES = 147456 + 8192 + 16;
#define GEMM_RUN(g, E) gemm_engine<decltype(E), true, true>((LAS unsigned char*)dyn_lds, g, E, bid, nblk)
#define GEMM_RUN8(g, E) gemm_engine<decltype(E), true, true, true>((LAS unsigned char*)dyn_lds, g, E, bid, nblk)
#define GEMM_RUN8G(g, E) gemm_engine<decltype(E), true, true, true, true>((LAS unsigned char*)dyn_lds, g, E, bid, nblk)
extern __shared__ __attribute__((aligned(16))) unsigned char dyn_lds[];

DEVI GemmD mk_gemm(const bf16_t* A, const bf16_t* Bt, int lda, int K, int nM, int nN, const int* rowidx, size_t bstride, int pmg) {
    GemmD g; g.A = A; g.Bt = Bt; g.lda = lda; g.K = K; g.nM = nM; g.nN = nN; g.rowidx = rowidx; g.bstride = bstride; g.pmg = pmg; return g; }

DEVI void ph_win(const Params& P, int l, int bid, int nblk) {
    const GemmD g = mk_gemm((const bf16_t*)(wsp(P) + WS_XB), (const bf16_t*)(wsp(P) + WS_WINT) + (size_t)l * kINW * kD, kD, kD, kTok / 256, 10, nullptr, 0, 1 << 30);
    unsigned char* r1 = wsp(P) + WS_R1;
    EpiQKV E; E.qa = (bf16_t*)(r1 + R1_QA); E.ka = (bf16_t*)(r1 + R1_KA); E.va = (bf16_t*)(r1 + R1_VA); E.qb = (bf16_t*)(r1 + R1_QB); E.kb = (bf16_t*)(r1 + R1_KB); E.vb = (bf16_t*)(r1 + R1_VB); E.ux = (bf16_t*)(r1 + R1_UX);
    E.rstdp = (const float*)(wsp(P) + WS_RSTD); E.rtab = (const LAS float*)((LAS unsigned char*)dyn_lds + 131072 + 2048);
    { LAS float* tab = (LAS float*)((LAS unsigned char*)dyn_lds + 131072);
      const int t = tidx();
      if (t < 320) { const int r = t >> 6, c = t & 63; tab[t] = (r == 0) ? P.q_norm_a[l * 64 + c] * (0.125f * kLog2e)   : (r == 1) ? P.k_norm_a[l * 64 + c] : (r == 2) ? P.q_norm_b[l * 64 + c] * (0.125f * kLog2e)   : (r == 3) ? P.k_norm_b[l * 64 + c] : 1.f; }
      __syncthreads();
      E.gtab = tab; }
    GEMM_RUN(g, E);
}
DEVI void ph_dilated(const Params& P, int l, int bid, int nblk) { unsigned char* r1 = wsp(P) + WS_R1;
    phase_dilated((const bf16_t*)(r1 + R1_QA), (const bf16_t*)(r1 + R1_KA), (const bf16_t*)(r1 + R1_VA), P.q_norm_a + l * 64, P.k_norm_a + l * 64, (bf16_t*)(wsp(P) + WS_R2), (float*)(wsp(P) + WS_LSE), (LAS unsigned char*)dyn_lds, bid, nblk);
}
DEVI void ph_na(const Params& P, int l, int bid, int nblk) { unsigned char* r1 = wsp(P) + WS_R1;
    phase_na((const bf16_t*)(r1 + R1_QB), (const bf16_t*)(r1 + R1_KB), (const bf16_t*)(r1 + R1_VB), P.rpb + (size_t)l * 4 * 15 * 31, P.q_norm_b + l * 64, P.k_norm_b + l * 64, (bf16_t*)(r1 + R1_OB), (LAS unsigned char*)dyn_lds, bid, nblk);
}
DEVI void ph_s5_prep(const Params& P, unsigned char* lds, int bid, int nblk) { for (int it = bid; it < kL * 16; it += nblk) s5_prep_item(P, it >> 4, it & 15, lds); }
DEVI void ph_s5_state(const Params& P, int l, int bid, int nblk) {
    const GemmD g = mk_gemm((const bf16_t*)(wsp(P) + WS_R1 + R1_UX), (const bf16_t*)(wsp(P) + WS_WST) + (size_t)l * 16 * 256 * 256, 512, 256, 256, 1, nullptr, (size_t)256 * 256, 16);
    EpiF32N E; E.z = (float*)(wsp(P) + WS_R2 + R2_Z); E.ldz = 256;
    GEMM_RUN(g, E);
}
DEVI void ph_s5_scan(const Params& P, int l, unsigned char* lds, int bid, int nblk) { phase_s5_scan(P, l, (const float*)(wsp(P) + WS_R2 + R2_Z), (bf16_t*)(wsp(P) + WS_R1 + R1_UX), lds, bid, nblk); }
DEVI void ph_s5_out(const Params& P, int l, int bid, int nblk) {
    const GemmD g = mk_gemm((const bf16_t*)(wsp(P) + WS_R1 + R1_UX), (const bf16_t*)(wsp(P) + WS_WSO) + (size_t)l * 16 * 256 * 512, 512, 512, 256, 1, nullptr, (size_t)256 * 512, 16);
    EpiS5Out E; E.G = (bf16_t*)(wsp(P) + WS_R1 + R1_G);
    GEMM_RUN(g, E);
}
DEVI void ph_glu(const Params& P, int l, int bid, int nblk) {
    const GemmD g = mk_gemm((const bf16_t*)(wsp(P) + WS_R1 + R1_G), (const bf16_t*)(wsp(P) + WS_WGLUT) + (size_t)l * 256 * 256, 256, 256, kTok / 256, 1, nullptr, 0, 1 << 30);
    EpiGlu E; E.g = (const bf16_t*)(wsp(P) + WS_R1 + R1_G); E.oc = (bf16_t*)(wsp(P) + WS_R1 + R1_OC);
    GEMM_RUN(g, E);
}
DEVI void ph_mixnorm(const Params& P, int l, int bid, int nblk) { unsigned char* r1 = wsp(P) + WS_R1;
    phase_mixnorm((const bf16_t*)(wsp(P) + WS_R2), (const float*)(wsp(P) + WS_LSE), (const bf16_t*)(r1 + R1_OB), (const bf16_t*)(r1 + R1_OC), P.out_norm_a + l * 512, P.out_norm_b + l * 256, P.out_norm_c + l * 256, (bf16_t*)(wsp(P) + WS_H), bid, nblk); }
DEVI void ph_wout(const Params& P, int l, int bid, int nblk) {
    const GemmD g = mk_gemm((const bf16_t*)(wsp(P) + WS_H), (const bf16_t*)(wsp(P) + WS_WOUTT) + (size_t)l * kD * kD, kD, kD, kTok / 256, 4, nullptr, 0, 1 << 30);
    EpiResid E; E.xb = (bf16_t*)(wsp(P) + WS_XB); E.xbo = E.xb;
    GEMM_RUN(g, E);
}
DEVI void ph_router(const Params& P, int l, unsigned char* lds, int bid, int nblk) { phase_router((const bf16_t*)(wsp(P) + WS_XB), P.ffn_norm + (size_t)l * kD, wsp(P) + WS_RTAB + (size_t)l * 65536, wsp(P) + WS_H, (float*)(wsp(P) + WS_AFF), (LAS unsigned char*)dyn_lds, bid, nblk); }
DEVI void ph_topk(const Params& P, unsigned char* lds, int bid, int nblk) { phase_topk((const float*)(wsp(P) + WS_AFF), (int*)(wsp(P) + WS_IDX), (float*)(wsp(P) + WS_GATE), (int*)(wsp(P) + WS_TSLOT), wsp(P) + WS_H, nullptr  , kD, lds, bid, nblk); }
DEVI void ph_gu(const Params& P, int l, int bid, int nblk) {
    const GemmD g = mk_gemm((const bf16_t*)(wsp(P) + WS_H), (const bf16_t*)(wsp(P) + WS_WGUT + (size_t)l * kE * 4096 * kD), kD, kD, 512, 16, (const int*)(wsp(P) + WS_IDX), (size_t)4096 * kD, 32);
    EpiGU E; E.hid = (bf16_t*)(wsp(P) + WS_R1); E.sc = 1.f / kW8;
    GEMM_RUN8G(g, E);
}
DEVI void ph_down(const Params& P, int l, int bid, int nblk) {
    const GemmD g = mk_gemm((const bf16_t*)(wsp(P) + WS_R1), (const bf16_t*)(wsp(P) + WS_WDT + (size_t)l * kE * kD * kFF), kFF, kFF, 512, 4, nullptr, (size_t)kD * kFF, 32);
    EpiDown E; E.y = (bf16_t*)(wsp(P) + WS_R2); E.sc = 1.f / (kW8 * kH8);
    GEMM_RUN8(g, E);
}
DEVI void ph_combine(const Params& P, int l, int bid, int nblk) { phase_combine((bf16_t*)(wsp(P) + WS_XB), (bf16_t*)(wsp(P) + WS_XB), P.out, (const bf16_t*)(wsp(P) + WS_R2), (const float*)(wsp(P) + WS_GATE), (const int*)(wsp(P) + WS_TSLOT), l + 1 == kL, (float*)(wsp(P) + WS_RSTD), bid, nblk); }

__global__ void __launch_bounds__(kNT, 2) mega_fwd(Params P) {
    asm volatile("s_setreg_imm32_b32 hwreg(HW_REG_MODE, 23, 1), 1");

    volatile LAS unsigned* st = (volatile LAS unsigned*)(dyn_lds + LDS_BYTES - 16);
    if (threadIdx.x == 0) { st[0] = 0u; st[1] = 0u; st[2] = 0u; st[3] = 0u; }
    __syncthreads();
    const XcdBarrier bar = xcd_barrier_post((unsigned*)(P.ws + WS_CTL), st);
    const int bid = blockIdx.x, nblk = gridDim.x;
    unsigned char* lds = dyn_lds;
    phase_convert(P, lds, lnd(bid), nblk);
    ph_s5_prep(P, lds, lnd(bid), nblk);
    router_prep(P, lnd(bid), nblk);
    phase_norm(P.x, (bf16_t*)(wsp(P) + WS_XB), (float*)(wsp(P) + WS_RSTD), lnd(bid), nblk);
    xcd_barrier(bar);
#pragma unroll 1
    for (int l = 0; l < kL; ++l) {
        ph_win(P, l, lnd(bid), nblk);             xcd_barrier(bar);
        ph_s5_state(P, l, lnd(bid), nblk);        xcd_barrier(bar);
        ph_s5_scan(P, l, lds, lnd(bid), nblk);
        ph_dilated(P, l, lnd(bid), nblk);
        ph_na(P, l, lnd(bid), nblk);              xcd_barrier(bar);
        ph_s5_out(P, l, lnd(bid), nblk);          xcd_barrier(bar);
        ph_glu(P, l, lnd(bid), nblk);             xcd_barrier(bar);
        ph_mixnorm(P, l, lnd(bid), nblk);         xcd_barrier(bar);
        ph_wout(P, l, lnd(bid), nblk);            xcd_barrier(bar);
        ph_router(P, l, lds, lnd(bid), nblk);     xcd_barrier(bar);
        ph_topk(P, lds, lnd(bid), nblk);          xcd_barrier(bar);
        ph_gu(P, l, lnd(bid), nblk);              xcd_barrier(bar);
        ph_down(P, l, lnd(bid), nblk);            xcd_barrier(bar);
        ph_combine(P, l, lnd(bid), nblk);         xcd_barrier(bar);
    }
}

extern "C" void kernel_launch(void* const* d_in, const int* in_sizes, int n_in, void* d_out, int out_size, void* d_ws, size_t ws_size, hipStream_t stream) {
    (void)in_sizes; (void)n_in; (void)out_size;
    if (ws_size < WS_END) { fprintf(stderr, "workspace too small: %zu < %zu\n", ws_size, (size_t)WS_END); return; }
    Params P{};
    const float** pp = (const float**)&P;
    for (int i = 0; i < 26; ++i) pp[i] = (const float*)d_in[i];
    P.out = (float*)d_out; P.ws = (unsigned char*)d_ws;
    static int grid = 0;
    if (!grid) {
        int dev = 0, cus = 0, per_cu = 0;
        (void)hipGetDevice(&dev);
        (void)hipDeviceGetAttribute(&cus, hipDeviceAttributeMultiprocessorCount, dev);
        (void)hipFuncSetAttribute((const void*)mega_fwd, hipFuncAttributeMaxDynamicSharedMemorySize, LDS_BYTES);
        (void)hipOccupancyMaxActiveBlocksPerMultiprocessor(&per_cu, (const void*)mega_fwd, kNT, LDS_BYTES);
        grid = (per_cu >= 1) ? cus : 0;
        if (!grid) fprintf(stderr, "mega_fwd does not fit a CU\n");
    }
    if (!grid) return;
    (void)hipMemsetAsync(P.ws + WS_CTL, 0, XCD_BAR_WORDS * sizeof(unsigned), stream);
    mega_fwd<<<grid, kNT, LDS_BYTES, stream>>>(P);
}
```

```cpp
#include <hip/hip_runtime.h>
#include <stdint.h>
#include <stdio.h>

#define DEVI __device__ __forceinline__
#define LAS __attribute__((address_space(3)))
typedef unsigned short bf16_t;
typedef short bf16x8 __attribute__((ext_vector_type(8)));
typedef float f32x4 __attribute__((ext_vector_type(4)));
typedef float f32x2 __attribute__((ext_vector_type(2)));
typedef unsigned u32x4 __attribute__((ext_vector_type(4)));
typedef unsigned u32x2 __attribute__((ext_vector_type(2)));

constexpr int kB = 8, kS = 8192, kD = 1024, kL = 4, kTok = kB * kS;
constexpr int kINW = 2560;
constexpr int kE = 16, kCap = 1024, kFF = 2048;
constexpr int kNT = 512;
constexpr float kEps = 1e-6f;
constexpr float kLog2e = 1.4426950408889634f, kLn2 = 0.6931471805599453f;

constexpr size_t MiB = 1024ull * 1024ull;
constexpr size_t WS_CTL   = 0;
constexpr size_t WS_RSTD  = 512 * 1024;
constexpr size_t WS_WINT  = 1 * MiB;
constexpr size_t WS_WOUTT = WS_WINT + 20 * MiB;
constexpr size_t WS_WGLUT = WS_WOUTT + 8 * MiB;
constexpr size_t WS_RTAB  = WS_WGLUT + 512 * 1024;
constexpr size_t WS_WGUT  = WS_WGLUT + 1 * MiB;
constexpr size_t WS_WDT   = WS_WGUT + 512 * MiB;
constexpr size_t WS_H     = WS_WDT + 256 * MiB;
constexpr size_t WS_R1    = WS_H + 128 * MiB;
constexpr size_t WS_R2    = WS_R1 + 512 * MiB;
constexpr size_t WS_AFF   = WS_R2 + 256 * MiB;
constexpr size_t WS_IDX   = WS_AFF + 4 * MiB;
constexpr size_t WS_GATE  = WS_IDX + 1 * MiB;
constexpr size_t WS_TSLOT = WS_GATE + 1 * MiB;
constexpr size_t WS_LSE   = WS_TSLOT + 4 * MiB;
constexpr size_t WS_WST   = WS_LSE + 8 * MiB;
constexpr size_t WS_WSO   = WS_WST + 8 * MiB;
constexpr size_t WS_XB    = WS_WSO + 16 * MiB;
constexpr size_t WS_END   = WS_XB + 128 * MiB;
constexpr size_t R2_Z     = 192 * MiB;
constexpr size_t R1_QA = 0, R1_KA = 64 * MiB, R1_VA = 128 * MiB, R1_QB = 192 * MiB, R1_KB = 224 * MiB, R1_VB = 256 * MiB,
                 R1_UX = 288 * MiB, R1_OB = 352 * MiB, R1_OC = 384 * MiB, R1_G = 416 * MiB;

struct Params {
    const float* x; const float* attn_norm; const float* w_in; const float* q_norm_a; const float* k_norm_a; const float* q_norm_b; const float* k_norm_b;
    const float* rpb; const float* s5_a_re; const float* s5_a_im; const float* s5_log_dt; const float* s5_b_re; const float* s5_b_im; const float* s5_c_re; const float* s5_c_im;
    const float* s5_d; const float* w_glu; const float* out_norm_a; const float* out_norm_b; const float* out_norm_c; const float* w_out; const float* ffn_norm;
    const float* w_router; const float* w_gate; const float* w_up; const float* w_down;
    float* out; unsigned char* ws;
};

DEVI float bf2f(bf16_t b) { return __uint_as_float(((unsigned)b) << 16); }
DEVI bf16_t f2bf(float f) { unsigned u = __float_as_uint(f); u += 0x7FFFu + ((u >> 16) & 1u); return (bf16_t)(u >> 16); }
typedef __bf16 bf16x2_t __attribute__((ext_vector_type(2)));
DEVI unsigned pk2(float lo, float hi) { const f32x2 v = {lo, hi}; return __builtin_bit_cast(unsigned, __builtin_convertvector(v, bf16x2_t)); }
DEVI int tidx() { int t = threadIdx.x; asm volatile("" : "+v"(t)); return t; }
#define GAS __attribute__((address_space(1)))
DEVI unsigned char* wsp(const Params& P) { unsigned long long a = (unsigned long long)P.ws; asm volatile("" : "+s"(a)); return (unsigned char*)(GAS unsigned char*)a; }
DEVI int lnd(int v) { asm volatile("" : "+s"(v)); return v; }
template <int CTRL> DEVI float dppf(float v) { return __builtin_bit_cast(float, __builtin_amdgcn_update_dpp(0, __builtin_bit_cast(int, v), CTRL, 0xF, 0xF, true)); }
DEVI void swap16(float& a, float& b) { asm volatile("s_nop 1\n\tv_permlane16_swap_b32 %0, %1" : "+v"(a), "+v"(b)); }
DEVI void swap32(float& a, float& b) { asm volatile("s_nop 1\n\tv_permlane32_swap_b32 %0, %1" : "+v"(a), "+v"(b)); }
DEVI void swap16u(unsigned& a, unsigned& b) { asm volatile("s_nop 1\n\tv_permlane16_swap_b32 %0, %1" : "+v"(a), "+v"(b)); }
DEVI float xsum16(float v) { float a = v, b = v; swap16(a, b); return a + b; }
DEVI float xsum32(float v) { float a = v, b = v; swap32(a, b); return a + b; }
DEVI float xmax16(float v) { float a = v, b = v; swap16(a, b); return fmaxf(a, b); }
DEVI float xmax32(float v) { float a = v, b = v; swap32(a, b); return fmaxf(a, b); }
DEVI float row_sum16(float v) {
    v += dppf<0xB1>(v); v += dppf<0x4E>(v);
    v += dppf<0x141>(v); v += dppf<0x140>(v);
    return v;
}
DEVI float wave_sum(float v) { return xsum32(xsum16(row_sum16(v))); }
DEVI void unpk8s(float* d, const u32x4 q) {
    d[0] = __uint_as_float(q.x << 16); d[1] = __uint_as_float(q.x & 0xFFFF0000u); d[2] = __uint_as_float(q.y << 16); d[3] = __uint_as_float(q.y & 0xFFFF0000u);
    d[4] = __uint_as_float(q.z << 16); d[5] = __uint_as_float(q.z & 0xFFFF0000u); d[6] = __uint_as_float(q.w << 16); d[7] = __uint_as_float(q.w & 0xFFFF0000u);
}
DEVI float frcp(float x) { return __builtin_amdgcn_rcpf(x); }
DEVI float gelu_tanh(float y) { const float z = 0.7978845608028654f * (y + 0.044715f * y * y * y); const float t = 1.f - 2.f * frcp(1.f + __expf(2.f * z)); return 0.5f * y * (1.f + t); }

constexpr float kY8 = 32.f;
constexpr float kW8 = 64.f, kH8 = 8.f;
DEVI unsigned pk4_fp8(float a, float b, float c, float d) { unsigned w = 0u; w = __builtin_amdgcn_cvt_pk_fp8_f32(a, b, w, false); w = __builtin_amdgcn_cvt_pk_fp8_f32(c, d, w, true); return w; }
DEVI int cmap_head(int cs) { const int bj = cs >> 7, wc = (cs >> 5) & 3, n = (cs >> 4) & 1, fq = (cs >> 2) & 3, j = cs & 3; return 64 * wc + 32 * bj + 8 * fq + 4 * n + j; }
DEVI int cmap_pk(int cs)   { const int bj = cs >> 7, wc = (cs >> 5) & 3, n = (cs >> 4) & 1, fq = (cs >> 2) & 3, j = cs & 3; return 128 * bj + 32 * wc + 8 * fq + 4 * n + j; }
DEVI int cmap_gu(int cs)   { const int wc = (cs >> 5) & 3, n = (cs >> 4) & 1, fq = (cs >> 2) & 3, j = cs & 3; return 32 * wc + 8 * fq + 4 * n + j; }

template <int MODE>
DEVI void convert_item(const float* W0, const float* W1, int ldw, int K, bf16_t* Bt, int kt, int pn, unsigned char* lds) {
    bf16_t* t = (bf16_t*)lds;
    const int tid = tidx(), cs = tid & 255, kh = tid >> 8;
    int col;
    if (MODE == 0) col = pn * 256 + cs; else if (MODE == 1) col = pn * 256 + cmap_head(cs); else if (MODE == 2) col = pn * 256 + cmap_pk(cs); else col = pn * 128 + cmap_gu(cs);
    const float* src = ((MODE == 3 && (cs >> 7)) ? W1 : W0) + (size_t)(kt * 64 + 32 * kh) * ldw + col;
    float v[32];
#pragma unroll
    for (int i = 0; i < 32; ++i) v[i] = src[(size_t)i * ldw];
    if (MODE == 1) {
#pragma unroll
        for (int i = 0; i < 32; ++i) v[i] *= W1[kt * 64 + 32 * kh + i];
    }
#pragma unroll
    for (int q = 0; q < 4; ++q) { u32x4 w; w.x = pk2(v[8 * q], v[8 * q + 1]); w.y = pk2(v[8 * q + 2], v[8 * q + 3]); w.z = pk2(v[8 * q + 4], v[8 * q + 5]); w.w = pk2(v[8 * q + 6], v[8 * q + 7]);
        *(u32x4*)(t + cs * 72 + 32 * kh + 8 * q) = w; }
    __syncthreads();
#pragma unroll
    for (int it = 0; it < 4; ++it) {
        const int c = it * kNT + tid, row = c >> 3, part = c & 7;
        const u32x4 vv = *(const u32x4*)(t + row * 72 + part * 8);
        *(u32x4*)(Bt + (size_t)(pn * 256 + row) * K + kt * 64 + part * 8) = vv;
    }
    __syncthreads();
}

template <int MODE>
DEVI void convert_item8(const float* W0, const float* W1, int ldw, int K, unsigned char* Bt, int kt, int pn, unsigned char* lds) {
    unsigned char* t = lds;
    const int tid = tidx(), cs = tid & 255, kh = tid >> 8;
    const int col = (MODE == 2) ? pn * 256 + cmap_pk(cs) : pn * 128 + cmap_gu(cs);
    const float* src = ((MODE == 3 && (cs >> 7)) ? W1 : W0) + (size_t)(kt * 128 + 64 * kh) * ldw + col;
    float v[64];
#pragma unroll
    for (int i = 0; i < 64; ++i) v[i] = src[(size_t)i * ldw];
#pragma unroll
    for (int q = 0; q < 4; ++q) { u32x4 w;
        w.x = pk4_fp8(v[16 * q] * kW8, v[16 * q + 1] * kW8, v[16 * q + 2] * kW8, v[16 * q + 3] * kW8); w.y = pk4_fp8(v[16 * q + 4] * kW8, v[16 * q + 5] * kW8, v[16 * q + 6] * kW8, v[16 * q + 7] * kW8);
        w.z = pk4_fp8(v[16 * q + 8] * kW8, v[16 * q + 9] * kW8, v[16 * q + 10] * kW8, v[16 * q + 11] * kW8); w.w = pk4_fp8(v[16 * q + 12] * kW8, v[16 * q + 13] * kW8, v[16 * q + 14] * kW8, v[16 * q + 15] * kW8);
        *(u32x4*)(t + cs * 144 + 64 * kh + 16 * q) = w; }
    __syncthreads();
#pragma unroll
    for (int it = 0; it < 4; ++it) {
        const int c = it * kNT + tid, row = c >> 3, part = c & 7;
        const u32x4 vv = *(const u32x4*)(t + row * 144 + part * 16);
        *(u32x4*)(Bt + (size_t)(pn * 256 + row) * K + kt * 128 + part * 16) = vv;
    }
    __syncthreads();
}

DEVI void phase_convert(const Params& P, unsigned char* lds, int bid, int nblk) {
    constexpr int N_WIN = kL * 16 * 10, N_WOUT = kL * 16 * 4, N_WGLU = kL * 4 * 1, N_WGU = kL * kE * 8 * 16, N_WD = kL * kE * 16 * 4;
    constexpr int TOT = N_WIN + N_WOUT + N_WGLU + N_WGU + N_WD;
    for (int it = bid; it < TOT; it += nblk) {
        int i = it;
        if (i < N_WIN) { const int l = i / 160, r = i % 160, kt = r / 10, pn = r % 10;
            convert_item<1>(P.w_in + (size_t)l * kD * kINW, P.attn_norm + (size_t)l * kD, kINW, kD, (bf16_t*)(wsp(P) + WS_WINT) + (size_t)l * kINW * kD, kt, pn, lds); continue; }
        i -= N_WIN;
        if (i < N_WOUT) { const int l = i / 64, r = i % 64, kt = r / 4, pn = r % 4;
            convert_item<2>(P.w_out + (size_t)l * kD * kD, nullptr, kD, kD, (bf16_t*)(wsp(P) + WS_WOUTT) + (size_t)l * kD * kD, kt, pn, lds); continue; }
        i -= N_WOUT;
        if (i < N_WGLU) { const int l = i / 4, kt = i % 4;
            convert_item<2>(P.w_glu + (size_t)l * 256 * 256, nullptr, 256, 256, (bf16_t*)(wsp(P) + WS_WGLUT) + (size_t)l * 256 * 256, kt, 0, lds); continue; }
        i -= N_WGLU;
        if (i < N_WGU) { const int le = i / 128, r = i % 128, kt = r / 16, pn = r % 16;
            convert_item8<3>(P.w_gate + (size_t)le * kD * kFF, P.w_up + (size_t)le * kD * kFF, kFF, kD, wsp(P) + WS_WGUT + (size_t)le * 4096 * kD, kt, pn, lds); continue; }
        i -= N_WGU;
        { const int le = i / 64, r = i % 64, kt = r / 4, pn = r % 4;
            convert_item8<2>(P.w_down + (size_t)le * kFF * kD, nullptr, kD, kFF, wsp(P) + WS_WDT + (size_t)le * kD * kFF, kt, pn, lds); }
    }
}

DEVI void phase_norm(const float* x, bf16_t* xb, float* rstdp, int bid, int nblk) {
    const int wid = tidx() >> 6, lane = tidx() & 63;
    for (int row = bid * 8 + wid; row < kTok; row += nblk * 8) {
        f32x4 v[4]; float ss = 0.f;
#pragma unroll
        for (int q = 0; q < 4; ++q) { v[q] = *(const f32x4*)(x + (size_t)row * kD + q * 256 + lane * 4); ss += v[q].x * v[q].x + v[q].y * v[q].y + v[q].z * v[q].z + v[q].w * v[q].w; }
        ss = wave_sum(ss);
        if (lane == 0) rstdp[row] = rsqrtf(ss * (1.f / kD) + kEps);
#pragma unroll
        for (int q = 0; q < 4; ++q) { const f32x4 t = v[q];
            u32x2 o; o.x = pk2(t.x, t.y); o.y = pk2(t.z, t.w);
            *(u32x2*)(xb + (size_t)row * kD + q * 256 + lane * 4) = o; }
    }
}

DEVI void router_prep(const Params& P, int bid, int nblk) {
    unsigned char* tbase = wsp(P) + WS_RTAB;
    for (int i = bid * kNT + tidx(); i < kL * 2048; i += nblk * kNT) {
        const int L = i >> 11, s = (i >> 6) & 31, l = i & 63, e = l & 15, k0 = 64 * (s >> 1) + 16 * (l >> 4) + 8 * (s & 1);
        const float* wr = P.w_router + (size_t)L * kD * kE; const float* gain = P.ffn_norm + (size_t)L * kD;
        unsigned hh[4], ll[4];
#pragma unroll
        for (int j = 0; j < 4; ++j) { const float w0 = wr[(k0 + 2 * j) * 16 + e] * gain[k0 + 2 * j], w1 = wr[(k0 + 2 * j + 1) * 16 + e] * gain[k0 + 2 * j + 1];
            const unsigned hp = pk2(w0, w1); hh[j] = hp; ll[j] = pk2(w0 - __uint_as_float(hp << 16), w1 - __uint_as_float(hp & 0xFFFF0000u)); }
        u32x4 hi, lo; hi.x = hh[0]; hi.y = hh[1]; hi.z = hh[2]; hi.w = hh[3]; lo.x = ll[0]; lo.y = ll[1]; lo.z = ll[2]; lo.w = ll[3];
        unsigned char* tb = tbase + (size_t)L * 65536;
        *(u32x4*)(tb + (2 * s) * 1024 + l * 16) = hi; *(u32x4*)(tb + (2 * s + 1) * 1024 + l * 16) = lo;
    }
}
DEVI void phase_router(const bf16_t* x, const float* gain, const unsigned char* rtab  , unsigned char* h8, float* aff, LAS unsigned char* lds, int bid, int nblk) {
    LAS unsigned char* wtab = lds;
    LAS float* gtab = (LAS float*)(lds + 65536);
    const int tid = tidx(), wid = __builtin_amdgcn_readfirstlane(tid >> 6), lane = tid & 63, r = lane & 15, c4 = lane >> 4;
    __syncthreads();
    for (int i = tid; i < 1024; i += kNT) gtab[i] = gain[i];
#pragma unroll
    for (int i = 0; i < 8; ++i)
        __builtin_amdgcn_global_load_lds((const unsigned*)(rtab + (size_t)(i * kNT + tid) * 16), (LAS unsigned*)(wtab + (i * 8 + wid) * 1024), 16, 0, 0);
    asm volatile("s_waitcnt vmcnt(0)" ::: "memory");
    __syncthreads();
    u32x4 xr[32];
    const int ntile = kTok / 16, tstride = nblk * 8;
    int tile = bid * 8 + wid;
#define RT_ISSUE(half, tile_) do { const bf16_t* xp_ = x + (size_t)((tile_) * 16 + r) * kD + 16 * c4; \
        _Pragma("unroll") for (int u = 8 * (half); u < 8 * (half) + 8; ++u) { xr[2 * u] = *(const u32x4*)(xp_ + 64 * u); xr[2 * u + 1] = *(const u32x4*)(xp_ + 64 * u + 8); } } while (0)
    if (tile < ntile) { RT_ISSUE(0, tile); RT_ISSUE(1, tile); }
    for (; tile < ntile; tile += tstride) {
        asm volatile("" ::: "memory");
        f32x4 Lh = {0.f, 0.f, 0.f, 0.f}, Ll = {0.f, 0.f, 0.f, 0.f}, G = {0.f, 0.f, 0.f, 0.f};
#pragma unroll
        for (int s = 0; s < 32; ++s) {
            const bf16x8 wh = *(const LAS bf16x8*)(wtab + (2 * s) * 1024 + lane * 16), wl = *(const LAS bf16x8*)(wtab + (2 * s + 1) * 1024 + lane * 16);
            const bf16x8 xb = __builtin_bit_cast(bf16x8, xr[s]);
            Lh = __builtin_amdgcn_mfma_f32_16x16x32_bf16(wh, xb, Lh, 0, 0, 0);
            Ll = __builtin_amdgcn_mfma_f32_16x16x32_bf16(wl, xb, Ll, 0, 0, 0);
            G = __builtin_amdgcn_mfma_f32_16x16x32_bf16(xb, xb, G, 0, 0, 0);
        }
        const float dsel = ((r & 3) == 0) ? G.x : ((r & 3) == 1) ? G.y : ((r & 3) == 2) ? G.z : G.w;
        const float ss = __builtin_bit_cast(float, __builtin_amdgcn_ds_bpermute((16 * (r >> 2) + r) * 4, __builtin_bit_cast(int, dsel)));
        const float rstd = rsqrtf(ss * (1.f / kD) + kEps);
        const f32x4 lg = (Lh + Ll) * rstd;
        float mx = fmaxf(fmaxf(lg.x, lg.y), fmaxf(lg.z, lg.w)); mx = xmax32(xmax16(mx));
        f32x4 ex; ex.x = __expf(lg.x - mx); ex.y = __expf(lg.y - mx); ex.z = __expf(lg.z - mx); ex.w = __expf(lg.w - mx);
        float sm = (ex.x + ex.y) + (ex.z + ex.w); sm = xsum32(xsum16(sm));
        const float inv = frcp(sm);
        const int row0 = tile * 16, b = row0 >> 13, s0 = (row0 & (kS - 1)) + r;
        { float* ap = aff + ((size_t)(b * kE + 4 * c4)) * kS + s0;
          ap[0] = ex.x * inv; ap[kS] = ex.y * inv; ap[2 * kS] = ex.z * inv; ap[3 * kS] = ex.w * inv; }
        unsigned char* hp = h8 + (size_t)(row0 + r) * kD + 16 * c4;
        const int ntl = tile + tstride;
#pragma unroll
        for (int half = 0; half < 2; ++half) {
#pragma unroll
            for (int u = 8 * half; u < 8 * half + 8; ++u) {
                float v[16]; unpk8s(v, xr[2 * u]); unpk8s(v + 8, xr[2 * u + 1]);
                u32x4 o; unsigned ow[4];
#pragma unroll
                for (int q = 0; q < 4; ++q) { const f32x4 gq = *(const LAS f32x4*)(gtab + 64 * u + 16 * c4 + 4 * q);
                    const f32x4 t = (f32x4){v[4 * q], v[4 * q + 1], v[4 * q + 2], v[4 * q + 3]} * gq * rstd;
                    ow[q] = pk4_fp8(t.x, t.y, t.z, t.w); }
                o.x = ow[0]; o.y = ow[1]; o.z = ow[2]; o.w = ow[3];
                *(u32x4*)(hp + 64 * u) = o;
            }
            if (ntl < ntile) { if (half == 0) RT_ISSUE(0, ntl); else RT_ISSUE(1, ntl); }
        }
    }
#undef RT_ISSUE
    __syncthreads();
}

DEVI int block_excl_scan(int v, int* sh  , int& total) {
    const int lane = tidx() & 63, wid = tidx() >> 6;
    int incl = v;
#pragma unroll
    for (int d = 1; d < 64; d <<= 1) { const int o = __shfl_up(incl, d); if (lane >= d) incl += o; }
    __syncthreads();
    if (lane == 63) sh[wid] = incl;
    __syncthreads();
    int base = 0, tot = 0;
#pragma unroll
    for (int w = 0; w < 8; ++w) { const int c = sh[w]; if (w < wid) base += c; tot += c; }
    total = tot;
    return base + incl - v;
}

DEVI void phase_topk(const float* aff, int* idx, float* gate, int* tokslot, const unsigned char* hsrc, unsigned char* xe, int rowbytes, unsigned char* lds, int bid, int nblk) {
    int* hist = (int*)lds;
    int* sh = hist + 256;
    int* res = sh + 16;
    (void)hsrc; (void)xe; (void)rowbytes;
    const int tid = tidx(), lane = tid & 63, wid = tid >> 6;
    const int share = (nblk >= 2 * kB * kE) ? 2 : 1;
    for (int wi = bid; wi < kB * kE * share; wi += nblk) {
        const int item = wi / share, part = wi - item * share;
        const int b = item >> 4, e = item & 15;
        const float* a = aff + (size_t)item * kS;
        unsigned key[16];
#pragma unroll
        for (int q = 0; q < 4; ++q) { const u32x4 v = *(const u32x4*)(a + tid * 16 + q * 4); key[q * 4 + 0] = v.x; key[q * 4 + 1] = v.y; key[q * 4 + 2] = v.z; key[q * 4 + 3] = v.w; }
        unsigned prefix = 0; int kk = kCap;
#pragma unroll 1
        for (int pass = 0; pass < 4; ++pass) {
            const int shift = 24 - 8 * pass;
            __syncthreads();
            if (tid < 256) hist[tid] = 0;
            __syncthreads();
#pragma unroll
            for (int i = 0; i < 16; ++i) { const bool in = (pass == 0) || ((key[i] >> (shift + 8)) == prefix); if (in) atomicAdd(&hist[(key[i] >> shift) & 255], 1); }
            __syncthreads();
            if (wid == 0) {
                int c[4], loc = 0;
#pragma unroll
                for (int j = 0; j < 4; ++j) { c[j] = hist[255 - 4 * lane - j]; loc += c[j]; }
                int incl = loc;
#pragma unroll
                for (int d = 1; d < 64; d <<= 1) { const int o = __shfl_up(incl, d); if (lane >= d) incl += o; }
                const int excl = incl - loc;
                if (excl < kk && kk <= incl) { int run = excl; int bin = 0, nk = 0; bool found = false;
#pragma unroll
                    for (int j = 0; j < 4; ++j) { if (!found && run + c[j] >= kk) { bin = 255 - 4 * lane - j; nk = kk - run; found = true; } if (!found) run += c[j]; }
                    res[0] = bin; res[1] = nk; }
            }
            __syncthreads();
            prefix = (prefix << 8) | (unsigned)res[0]; kk = res[1];
        }
        const unsigned T = prefix;
        int ceq = 0;
#pragma unroll
        for (int i = 0; i < 16; ++i) ceq += (key[i] == T) ? 1 : 0;
        int tot;
        int eqb = block_excl_scan(ceq, sh, tot);
        int csel = 0; unsigned selmask = 0;
#pragma unroll
        for (int i = 0; i < 16; ++i) { bool s = key[i] > T; if (key[i] == T) { s = eqb < kk; ++eqb; } if (s) { selmask |= 1u << i; ++csel; } }
        int slot = block_excl_scan(csel, sh, tot);
        const size_t rbase = (size_t)(e * kB + b) * kCap;
#pragma unroll
        for (int i = 0; i < 16; ++i) { const int s = tid * 16 + i; const bool sel = (selmask >> i) & 1u;
            const bool mine = (share == 1) || ((i >> 3) == part);
            if (sel && mine) { idx[rbase + slot] = b * kS + s; gate[rbase + slot] = __uint_as_float(key[i]) * (1.f / kY8)  ; }
            if (mine) tokslot[((size_t)(b * kS + s)) * kE + e] = sel ? slot : -1;
            if (sel) ++slot; }
    }
    __syncthreads();
}

struct Unit { int pm, pn, par; };
DEVI bool unit_of(int Lid, int nM, int nN, Unit& u) {
    const int nwg = nM * nN; if (Lid >= nwg) return false;
    int wgid = Lid; { const int q = nwg / 8, r = nwg % 8, xcd = wgid % 8, off = wgid / 8; wgid = (xcd < r ? xcd * (q + 1) : r * (q + 1) + (xcd - r) * q) + off; }
    const int nig = 8 * nN, gid = wgid / nig, fm = gid * 8, gsz = (nM - fm) < 8 ? (nM - fm) : 8;
    u.pm = fm + ((wgid % nig) % gsz); u.pn = (wgid % nig) / gsz; return true;
}
struct GemmD { const bf16_t* A; const bf16_t* Bt; int lda, K, nM, nN; const int* rowidx; size_t bstride; int pmg; };

constexpr int PG_HTB = 128 * 64 * 2;
DEVI int pg_lds_byte(int r, int c) { const int st = (r >> 4) * 2 + (c >> 5), rr = r & 15, cc = c & 31, ob = rr * 64 + cc * 2; return st * 1024 + (ob ^ (((ob >> 9) & 1) << 5)); }
DEVI void pg_stage_rc(int b, int& R, int& C) { const int st = b / 1024, sb = b % 1024, swz = sb ^ (((sb >> 9) & 1) << 5); R = (st >> 1) * 16 + swz / 64; C = (st & 1) * 32 + (swz % 64) / 2; }

typedef int v4i __attribute__((ext_vector_type(4)));
typedef int v8i __attribute__((ext_vector_type(8)));
constexpr int PG_RIDX = 131072 + 4096;
template <class Epi, bool ALIGN_EPI, bool SP2, bool FP8 = false, bool GATHER = false>
DEVI void gemm_engine(LAS unsigned char* lds, const GemmD g, const Epi& E, int bid, int nblk) {
    const int tid = tidx(), wid = __builtin_amdgcn_readfirstlane(tid >> 6), lane = tid & 63, wr = wid >> 2, wc = wid & 3, fr = lane & 15, fq = lane >> 4;
    constexpr int ES = FP8 ? 1 : 2;
    const int K = g.K * ES  , nt = K / 128; const unsigned ldaB = (unsigned)g.lda * ES;
    unsigned voffA[2], voffB[2];
#pragma unroll
    for (int i = 0; i < 2; ++i) { int R, C; pg_stage_rc(tid * 16 + i * 8192, R, C); voffA[i] = (unsigned)R * ldaB + (unsigned)C * 2u; voffB[i] = (unsigned)(R * K + C * 2); }
    const size_t kstep = 128;
    int gR0 = 0; unsigned gcb = 0; { int R, C; pg_stage_rc(tid * 16, R, C); gR0 = R; gcb = (unsigned)C * 2u; } (void)gR0; (void)gcb;
    const size_t hstepB = (size_t)128 * K, hstepA = (size_t)128 * ldaB, tstepA = 2 * hstepA;
    const unsigned ldsw = (unsigned)wid * 1024u;
    const int aoff = pg_lds_byte(wr * 64 + fr, fq * 8), boff = pg_lds_byte(wc * 32 + fr, fq * 8);
#define PG8_SA(b, h) (((b) * 2 + (h)) * PG_HTB)
#define PG8_SB(b, h) ((4 + (b) * 2 + (h)) * PG_HTB)
#define PG8_STAGE(bufoff, gbase, voff) do { _Pragma("unroll") for (int _i = 0; _i < 2; ++_i) \
        __builtin_amdgcn_global_load_lds((const unsigned*)((const char*)(gbase) + (voff)[_i]), (LAS unsigned*)(lds + (bufoff) + ldsw + _i * 8192), 16, 0, 0); } while (0)
#define PG8_STA(bufoff, ptr, koff, half, par) do { if constexpr (GATHER) { \
        const LAS int* rt_ = (const LAS int*)(lds + PG_RIDX + (par) * 1024) + 128 * (half) + gR0; \
        _Pragma("unroll") for (int _i = 0; _i < 2; ++_i) { const unsigned off_ = (unsigned)rt_[64 * _i] * ldaB + gcb; \
            __builtin_amdgcn_global_load_lds((const unsigned*)((const char*)g.A + (koff) + off_), (LAS unsigned*)(lds + (bufoff) + ldsw + _i * 8192), 16, 0, 0); } \
    } else PG8_STAGE(bufoff, ptr, voffA); } while (0)
#define PG8_RD16(off) (*(const LAS v4i*)(lds + (off)))
#define PG8_CAT2(off) __builtin_shufflevector(PG8_RD16(off), PG8_RD16((off) + 1024), 0, 1, 2, 3, 4, 5, 6, 7)
#define PG8_LDA(dst, b, h) do { _Pragma("unroll") for (int m = 0; m < 4; ++m) { if constexpr (FP8) dst##8[m] = PG8_CAT2(PG8_SA(b, h) + aoff + m * 2048); \
        else { _Pragma("unroll") for (int k = 0; k < 2; ++k) dst[m][k] = *(const LAS bf16x8*)(lds + PG8_SA(b, h) + aoff + m * 2048 + k * 1024); } } } while (0)
#define PG8_LDB(dst, b, h) do { _Pragma("unroll") for (int n = 0; n < 2; ++n) { if constexpr (FP8) dst##8[n] = PG8_CAT2(PG8_SB(b, h) + boff + n * 2048); \
        else { _Pragma("unroll") for (int k = 0; k < 2; ++k) dst[n][k] = *(const LAS bf16x8*)(lds + PG8_SB(b, h) + boff + n * 2048 + k * 1024); } } } while (0)
#define PG8_MMA(ai, bj, At, Bt) do { __builtin_amdgcn_s_setprio(1); _Pragma("unroll") for (int m = 0; m < 4; ++m) _Pragma("unroll") for (int n = 0; n < 2; ++n) { \
        if constexpr (FP8) asm volatile("v_mfma_f32_16x16x128_f8f6f4 %0, %1, %2, %0" : "+v"(acc[ai][bj][m][n]) : "v"(Bt##8[n]), "v"(At##8[m]));   \
        else { _Pragma("unroll") for (int k = 0; k < 2; ++k) acc[ai][bj][m][n] = __builtin_amdgcn_mfma_f32_16x16x32_bf16(Bt[n][k], At[m][k], acc[ai][bj][m][n], 0, 0, 0); } } \
        __builtin_amdgcn_s_setprio(0); } while (0)
#define PG8_MMAZ(ai, bj, At, Bt) do { __builtin_amdgcn_s_setprio(1); _Pragma("unroll") for (int m = 0; m < 4; ++m) _Pragma("unroll") for (int n = 0; n < 2; ++n) { \
        if constexpr (FP8) asm volatile("v_mfma_f32_16x16x128_f8f6f4 %0, %1, %2, 0" : "=&v"(acc[ai][bj][m][n]) : "v"(Bt##8[n]), "v"(At##8[m])); \
        else { asm volatile("v_mfma_f32_16x16x32_bf16 %0, %1, %2, 0" : "=&v"(acc[ai][bj][m][n]) : "v"(Bt[n][0]), "v"(At[m][0])); \
               acc[ai][bj][m][n] = __builtin_amdgcn_mfma_f32_16x16x32_bf16(Bt[n][1], At[m][1], acc[ai][bj][m][n], 0, 0, 0); } } \
        __builtin_amdgcn_s_setprio(0); } while (0)
#define PG8_WAIT_V(n) asm volatile("s_waitcnt vmcnt(" #n ")" ::: "memory")
#define PG8_WAIT_L(n) asm volatile("s_waitcnt lgkmcnt(" #n ")" ::: "memory")
#define PG8_BAR __builtin_amdgcn_s_barrier()
#define PG8_SCHED __builtin_amdgcn_sched_barrier(0)
    Unit cur, nxt; int ui = 0;
    if (!unit_of(bid, g.nM, g.nN, cur)) return;
    cur.par = 0; E.stage(lds, cur, wid, lane);
    if constexpr (GATHER) {
        if (wid < 4) __builtin_amdgcn_global_load_lds((const unsigned*)(g.rowidx + cur.pm * 256 + wid * 64 + lane), (LAS unsigned*)(lds + PG_RIDX + wid * 256), 4, 0, 0);
        asm volatile("s_waitcnt vmcnt(0)" ::: "memory"); __builtin_amdgcn_s_barrier();
    }
    f32x4 acc[2][2][4][2];
    if constexpr (!FP8) {
#pragma unroll
    for (int a = 0; a < 2; ++a)
#pragma unroll
        for (int b = 0; b < 2; ++b)
#pragma unroll
            for (int m = 0; m < 4; ++m)
#pragma unroll
                for (int n = 0; n < 2; ++n) acc[a][b][m][n] = (f32x4){0.f, 0.f, 0.f, 0.f};
    }
    bf16x8 At[4][2], B0[2][2], B1[2][2]; v8i At8[4], B08[2], B18[2];
    (void)At; (void)B0; (void)B1; (void)At8; (void)B08; (void)B18;
    static_assert(SP2, "only the two-super-phase K-loop is kept");
    const char* cA = (const char*)g.A + (size_t)cur.pm * tstepA;
    const char* cB = (const char*)g.Bt + (size_t)(cur.pm / g.pmg) * g.bstride * ES + (size_t)cur.pn * 256 * K;
    PG8_STAGE(PG8_SB(0, 0), cB, voffB); PG8_STAGE(PG8_SB(0, 1), cB + hstepB, voffB); PG8_STA(PG8_SA(0, 0), cA, 0u, 0, 0); PG8_STA(PG8_SA(0, 1), cA + hstepA, 0u, 1, 0);
    if (wr == 1) PG8_BAR;
    PG8_WAIT_V(2); PG8_BAR;
    PG8_STAGE(PG8_SB(1, 0), cB + kstep, voffB); PG8_STA(PG8_SA(1, 0), cA + kstep, 128u, 0, 0); PG8_STAGE(PG8_SB(1, 1), cB + hstepB + kstep, voffB);
    PG8_WAIT_V(6); PG8_BAR;
    for (;;) {
        const bool has_next = unit_of((ui + 1) * nblk + bid, g.nM, g.nN, nxt); nxt.par = (ui + 1) & 1;
        if constexpr (GATHER) { if (has_next && wid < 4) __builtin_amdgcn_global_load_lds((const unsigned*)(g.rowidx + nxt.pm * 256 + wid * 64 + lane), (LAS unsigned*)(lds + PG_RIDX + nxt.par * 1024 + wid * 256), 4, 0, 0); }
        const char* nA = has_next ? (const char*)g.A + (size_t)nxt.pm * tstepA : cA;
        const char* nB = has_next ? (const char*)g.Bt + (size_t)(nxt.pm / g.pmg) * g.bstride * ES + (size_t)nxt.pn * 256 * K : cB;
#define PG8_TRIP(MM) do { \
            const bool last = (t == nt - 2); \
            const char* a1 = cA + (size_t)(t + 1) * kstep; \
            const char* a2 = last ? nA : cA + (size_t)(t + 2) * kstep; const char* b2 = last ? nB : cB + (size_t)(t + 2) * kstep; \
            const char* a3 = a2 + kstep; const char* b3 = b2 + kstep; \
            const unsigned gk1 = (unsigned)(t + 1) * 128u, gk2 = last ? 0u : (unsigned)(t + 2) * 128u, gk3 = gk2 + 128u; const int gp2 = (last && has_next) ? nxt.par : cur.par; (void)gk1; (void)gk2; (void)gk3; (void)gp2; \
            PG8_LDB(B0, 0, 0); PG8_LDB(B1, 0, 1); PG8_SCHED; PG8_LDA(At, 0, 0); PG8_STA(PG8_SA(1, 1), a1 + hstepA, gk1, 1, cur.par); \
            PG8_WAIT_V(8); PG8_WAIT_L(0); PG8_BAR; MM(0, 0, At, B0); MM(0, 1, At, B1); PG8_BAR; PG8_SCHED; \
            PG8_LDA(At, 0, 1); PG8_STAGE(PG8_SB(0, 0), b2, voffB); PG8_STAGE(PG8_SB(0, 1), b2 + hstepB, voffB); PG8_STA(PG8_SA(0, 0), a2, gk2, 0, gp2); \
            PG8_WAIT_V(8); PG8_WAIT_L(0); PG8_BAR; MM(1, 0, At, B0); MM(1, 1, At, B1); PG8_BAR; PG8_SCHED; \
            PG8_LDB(B0, 1, 0); PG8_LDB(B1, 1, 1); PG8_SCHED; PG8_LDA(At, 1, 0); PG8_STA(PG8_SA(0, 1), a2 + hstepA, gk2, 1, gp2); \
            PG8_WAIT_V(8); PG8_WAIT_L(0); PG8_BAR; PG8_MMA(0, 0, At, B0); PG8_MMA(0, 1, At, B1); PG8_BAR; PG8_SCHED; \
            PG8_LDA(At, 1, 1); PG8_STAGE(PG8_SB(1, 0), b3, voffB); PG8_STAGE(PG8_SB(1, 1), b3 + hstepB, voffB); PG8_STA(PG8_SA(1, 0), a3, gk3, 0, gp2); \
            PG8_WAIT_V(8); PG8_WAIT_L(0); PG8_BAR; PG8_MMA(1, 0, At, B0); PG8_MMA(1, 1, At, B1); PG8_BAR; PG8_SCHED; } while (0)
        int t = 0;
        if constexpr (FP8) { PG8_TRIP(PG8_MMAZ); t = 2; }
#pragma unroll 1
        for (; t < nt; t += 2) PG8_TRIP(PG8_MMA);
#undef PG8_TRIP
        if constexpr (ALIGN_EPI) { if (wr == 0) PG8_BAR; }
        if constexpr (FP8) asm volatile("s_nop 15\n\ts_nop 15" ::: "memory");
        E(acc, cur, wr, wc, fr, fq);
        if (!has_next) break;
        E.stage(lds, nxt, wid, lane);
        if constexpr (!FP8) {
#pragma unroll
        for (int a = 0; a < 2; ++a)
#pragma unroll
            for (int b = 0; b < 2; ++b)
#pragma unroll
                for (int m = 0; m < 4; ++m)
#pragma unroll
                    for (int n = 0; n < 2; ++n) acc[a][b][m][n] = (f32x4){0.f, 0.f, 0.f, 0.f};
        }
        cur = nxt; cA = nA; cB = nB; ++ui;
        if constexpr (ALIGN_EPI) { if (wr == 1) PG8_BAR; }
    }
    PG8_WAIT_V(0);
    if constexpr (!ALIGN_EPI) { if (wr == 0) PG8_BAR; }
    PG8_BAR;
#undef PG8_SA
#undef PG8_SB
#undef PG8_STAGE
#undef PG8_STA
#undef PG8_LDA
#undef PG8_LDB
#undef PG8_MMA
#undef PG8_MMAZ
#undef PG8_RD16
#undef PG8_CAT2
#undef PG8_WAIT_V
#undef PG8_WAIT_L
#undef PG8_BAR
#undef PG8_SCHED
}

struct EpiQKV {
    static constexpr int VMOPS = 16;
    bf16_t *qa, *ka, *va, *qb, *kb, *vb, *ux;
    const float* rstdp;
    const LAS float* rtab;
    DEVI void stage(LAS unsigned char* lds, const Unit& u, int wid, int lane) const {
        if (wid < 4) __builtin_amdgcn_global_load_lds((const unsigned*)(rstdp + u.pm * 256 + wid * 64 + lane), (LAS unsigned*)(lds + 131072 + 2048 + u.par * 1024 + wid * 256), 4, 0, 0);
    }
    const LAS float* gtab;
    DEVI void operator()(const f32x4 (&acc)[2][2][4][2], const Unit& u, int wr, int wc, int fr, int fq) const {
        const int pn = u.pn;
        bf16_t* dst = (pn < 2) ? qa : (pn < 4) ? ka : (pn < 6) ? va : (pn == 6) ? qb : (pn == 7) ? kb : (pn == 8) ? vb : ux;
        const int H = (pn < 6) ? 8 : 4, head = ((pn < 6) ? (pn & 1) * 4 : 0) + wc;
        const int trow = (pn < 2) ? 0 : (pn < 4) ? 1 : (pn == 6) ? 2 : (pn == 7) ? 3 : 4;
        const bool nrm = trow < 4;
        f32x4 gv[2][2];
#pragma unroll
        for (int bj = 0; bj < 2; ++bj)
#pragma unroll
            for (int n = 0; n < 2; ++n) gv[bj][n] = *(const LAS f32x4*)(gtab + trow * 64 + 32 * bj + 8 * fq + 4 * n);
        const size_t hb = (size_t)head * kS * 64 + 8 * fq;
        const int g0 = 4 * wc + (fq >> 1), c0 = 8 * (fq & 1);
#pragma unroll
        for (int ai = 0; ai < 2; ++ai)
#pragma unroll
            for (int m = 0; m < 4; ++m) {
                const int row = u.pm * 256 + 128 * ai + 64 * wr + 16 * m + fr;
                float ss = 0.f;
#pragma unroll
                for (int bj = 0; bj < 2; ++bj)
#pragma unroll
                    for (int n = 0; n < 2; ++n) { const f32x4 v = acc[ai][bj][m][n]; ss += v.x * v.x + v.y * v.y + v.z * v.z + v.w * v.w; }
                ss = xsum32(xsum16(ss));
                const float rr = rtab[u.par * 256 + 128 * ai + 64 * wr + 16 * m + fr];
                const float rs = __builtin_amdgcn_rsqf(ss * rr * rr * (1.f / 64.f) + kEps) * rr, rstd = nrm ? rs : rr;
                const int b = row >> 13, sq = row & (kS - 1);
                const size_t o_qkv = ((size_t)b * H * kS + sq) * 64 + hb, o_u = ((size_t)g0 * 4096 + (row >> 4)) * 512 + (row & 15) * 16 + c0;
#pragma unroll
                for (int bj = 0; bj < 2; ++bj) {
                    const f32x4 v0 = acc[ai][bj][m][0] * rstd * gv[bj][0], v1 = acc[ai][bj][m][1] * rstd * gv[bj][1];
                    u32x4 w; w.x = pk2(v0.x, v0.y); w.y = pk2(v0.z, v0.w); w.z = pk2(v1.x, v1.y); w.w = pk2(v1.z, v1.w);
                    const size_t o = (pn < 9) ? o_qkv + 32 * bj : o_u + (size_t)bj * 2 * 4096 * 512;
                    *(u32x4*)(dst + o) = w;
                }
            }
    }
};
struct EpiResid {
    DEVI void stage(LAS unsigned char*, const Unit&, int, int) const {}
    static constexpr int VMOPS = 16;
    bf16_t* xb; bf16_t* xbo;
    DEVI void operator()(const f32x4 (&acc)[2][2][4][2], const Unit& u, int wr, int wc, int fr, int fq) const {
#pragma unroll
        for (int ai = 0; ai < 2; ++ai) {
            const size_t r0 = (size_t)(u.pm * 256 + 128 * ai + 64 * wr + fr) * kD + u.pn * 256 + 32 * wc + 8 * fq;
            {
                u32x4 a[4][2];
#pragma unroll
                for (int m = 0; m < 4; ++m)
#pragma unroll
                    for (int bj = 0; bj < 2; ++bj) a[m][bj] = *(const u32x4*)(xb + r0 + (size_t)m * 16 * kD + 128 * bj);
#pragma unroll
                for (int m = 0; m < 4; ++m)
#pragma unroll
                    for (int bj = 0; bj < 2; ++bj) { const size_t o = r0 + (size_t)m * 16 * kD + 128 * bj; const u32x4 w = a[m][bj];
                        const f32x4 v0 = (f32x4){__uint_as_float(w.x << 16), __uint_as_float(w.x & 0xFFFF0000u), __uint_as_float(w.y << 16), __uint_as_float(w.y & 0xFFFF0000u)} + acc[ai][bj][m][0];
                        const f32x4 v1 = (f32x4){__uint_as_float(w.z << 16), __uint_as_float(w.z & 0xFFFF0000u), __uint_as_float(w.w << 16), __uint_as_float(w.w & 0xFFFF0000u)} + acc[ai][bj][m][1];
                        u32x4 r; r.x = pk2(v0.x, v0.y); r.y = pk2(v0.z, v0.w); r.z = pk2(v1.x, v1.y); r.w = pk2(v1.z, v1.w); *(u32x4*)(xbo + o) = r; }
            }
        }
    }
};
struct EpiGU {
    DEVI void stage(LAS unsigned char*, const Unit&, int, int) const {}
    static constexpr int VMOPS = 4;
    bf16_t* hid; float sc;
    DEVI void silu8(const f32x4 (&acc)[2][2][4][2], int ai, int m, float (&o)[8]) const {
        const float k1 = -sc * kLog2e, k3 = 1.f / (sc * sc * kH8);
#pragma unroll
        for (int n = 0; n < 2; ++n)
#pragma unroll
            for (int j = 0; j < 4; j += 2) { const f32x2 a = {acc[ai][0][m][n][j], acc[ai][0][m][n][j + 1]}, b = {acc[ai][1][m][n][j], acc[ai][1][m][n][j + 1]};
                const f32x2 ab = a * b, t = a * k1; f32x2 d; d.x = __builtin_amdgcn_exp2f(t.x); d.y = __builtin_amdgcn_exp2f(t.y); d = d * k3 + k3;
                f32x2 r; r.x = frcp(d.x); r.y = frcp(d.y); const f32x2 v = ab * r;
                o[n * 4 + j] = v.x; o[n * 4 + j + 1] = v.y; }
    }
    DEVI void operator()(const f32x4 (&acc)[2][2][4][2], const Unit& u, int wr, int wc, int fr, int fq) const {
#pragma unroll
        for (int ai = 0; ai < 2; ++ai)
#pragma unroll
            for (int m = 0; m < 4; m += 2) {
                float o0[8], o1[8]; silu8(acc, ai, m, o0); silu8(acc, ai, m + 1, o1);
                unsigned ax = pk4_fp8(o0[0], o0[1], o0[2], o0[3]), ay = pk4_fp8(o0[4], o0[5], o0[6], o0[7]), bx = pk4_fp8(o1[0], o1[1], o1[2], o1[3]), by = pk4_fp8(o1[4], o1[5], o1[6], o1[7]);
                swap16u(ax, bx); swap16u(ay, by);
                const size_t row = (size_t)(u.pm * 256 + 128 * ai + 64 * wr + 16 * (m + (fq & 1)) + fr);
                u32x4 w; w.x = ax; w.y = ay; w.z = bx; w.w = by;
                *(u32x4*)((unsigned char*)hid + row * kFF + u.pn * 128 + 32 * wc + 8 * (fq & ~1)) = w;
            }
    }
};
struct EpiDown {
    DEVI void stage(LAS unsigned char*, const Unit&, int, int) const {}
    static constexpr int VMOPS = 8;
    bf16_t* y; float sc;
    DEVI static unsigned pk4c(const f32x4 v) { return pk4_fp8(v.x, v.y, v.z, v.w); }
    DEVI void operator()(const f32x4 (&acc)[2][2][4][2], const Unit& u, int wr, int wc, int fr, int fq) const {
        const float gv = sc * kY8;
#pragma unroll
        for (int ai = 0; ai < 2; ++ai)
#pragma unroll
            for (int m = 0; m < 4; m += 2)
#pragma unroll
                for (int bj = 0; bj < 2; ++bj) {
                    unsigned ax = pk4c(acc[ai][bj][m][0] * gv), ay = pk4c(acc[ai][bj][m][1] * gv), bx = pk4c(acc[ai][bj][m + 1][0] * gv), by = pk4c(acc[ai][bj][m + 1][1] * gv);
                    swap16u(ax, bx); swap16u(ay, by);
                    const size_t row = (size_t)(u.pm * 256 + 128 * ai + 64 * wr + 16 * (m + (fq & 1)) + fr);
                    u32x4 w; w.x = ax; w.y = ay; w.z = bx; w.w = by;
                    *(u32x4*)((unsigned char*)y + row * kD + u.pn * 256 + 128 * bj + 32 * wc + 8 * (fq & ~1)) = w;
                }
    }
};
struct EpiGlu {
    DEVI void stage(LAS unsigned char*, const Unit&, int, int) const {}
    static constexpr int VMOPS = 16;
    const bf16_t* g; bf16_t* oc;
    DEVI void operator()(const f32x4 (&acc)[2][2][4][2], const Unit& u, int wr, int wc, int fr, int fq) const {
#pragma unroll
        for (int ai = 0; ai < 2; ++ai) {
            const size_t r0 = (size_t)(u.pm * 256 + 128 * ai + 64 * wr + fr) * 256 + 32 * wc + 8 * fq;
            u32x4 gw[4][2];
#pragma unroll
            for (int m = 0; m < 4; ++m)
#pragma unroll
                for (int bj = 0; bj < 2; ++bj) gw[m][bj] = *(const u32x4*)(g + r0 + (size_t)m * 16 * 256 + 128 * bj);
#pragma unroll
            for (int m = 0; m < 4; ++m)
#pragma unroll
                for (int bj = 0; bj < 2; ++bj) { const size_t o = r0 + (size_t)m * 16 * 256 + 128 * bj; float gg[8]; unpk8s(gg, gw[m][bj]); float o8[8];
#pragma unroll
                    for (int n = 0; n < 2; ++n)
#pragma unroll
                        for (int j = 0; j < 4; ++j) o8[n * 4 + j] = gg[n * 4 + j] * frcp(1.f + __expf(-acc[ai][bj][m][n][j]));
                    u32x4 w; w.x = pk2(o8[0], o8[1]); w.y = pk2(o8[2], o8[3]); w.z = pk2(o8[4], o8[5]); w.w = pk2(o8[6], o8[7]);
                    *(u32x4*)(oc + o) = w; }
        }
    }
};

typedef float f32x16 __attribute__((ext_vector_type(16)));
typedef short s16x4 __attribute__((ext_vector_type(4)));
DEVI bf16x8 tr_pair(LAS unsigned char* p0, LAS unsigned char* p1) {
    const s16x4 a = __builtin_amdgcn_ds_read_tr16_b64_v4i16((LAS s16x4*)p0), b = __builtin_amdgcn_ds_read_tr16_b64_v4i16((LAS s16x4*)p1);
    return (bf16x8){a.x, a.y, a.z, a.w, b.x, b.y, b.z, b.w};
}
DEVI void phase_dilated(const bf16_t* qa, const bf16_t* ka, const bf16_t* va, const float* gq, const float* gk, bf16_t* oac, float* lse, LAS unsigned char* lds, int bid, int nblk) {
    const int tid = tidx(), wid = __builtin_amdgcn_readfirstlane(tid >> 6), lane = tid & 63, h5 = lane >> 5, qc = lane & 31;
    LAS unsigned char* Kimg = lds; LAS unsigned char* Vimg = lds + 49152;
    float Mn;
    { float a = fabsf(gq[lane]), b = fabsf(gk[lane]);
#pragma unroll
      for (int m = 32; m >= 1; m >>= 1) { a = fmaxf(a, __shfl_xor(a, m)); b = fmaxf(b, __shfl_xor(b, m)); }
      Mn = 8.f * a * b; }
    const float Mb = Mn * kLog2e;
    unsigned koff[4];
#pragma unroll
    for (int s = 0; s < 4; ++s) koff[s] = (unsigned)((32 * wid + qc) * 128 + (((2 * s + h5) ^ (qc & 7)) << 4));
    unsigned voff[2];
    { const int g = lane >> 4, i16 = lane & 15, q = i16 >> 2, p = i16 & 3;
#pragma unroll
      for (int dt = 0; dt < 2; ++dt) { const int c = (2 * (g & 1) + (p >> 1) + 4 * dt) ^ ((q >> 1) << 2); voff[dt] = (unsigned)((32 * wid + 4 * h5 + q) * 128 + (c << 4) + 8 * (p & 1)); } }
    const float dbase = (float)(4 * h5 - qc);
    u32x4 pK[6], pV[6];
#define DIL_DECODE(unit_) const int r_ = (unit_) >> 8, bl_ = (unit_) & 255, c = r_ % 3, bh = (bl_ & 7) * 8 + r_ / 3, ub = bl_ >> 3; \
        const int dsh = 2 * c, L = kS >> dsh, upc = 32 >> dsh, cls = ub >> (5 - dsh), u0 = (ub & (upc - 1)) << 8;
#define DIL_PREFETCH(unit_) do { DIL_DECODE(unit_) \
        const bf16_t* kbase = ka + (size_t)bh * kS * 64; const bf16_t* vbase = va + (size_t)bh * kS * 64; \
        _Pragma("unroll") for (int it = 0; it < 6; ++it) { const int id = it * kNT + tid, row = id >> 3, ch = id & 7; \
            int ki = u0 - 64 + row; ki = ki < 0 ? 0 : (ki > L - 1 ? L - 1 : ki); const size_t tok = (size_t)((ki << dsh) + cls); \
            pK[it] = *(const u32x4*)(kbase + tok * 64 + ch * 8); pV[it] = *(const u32x4*)(vbase + tok * 64 + ch * 8); } } while (0)
    if (bid < 6144) DIL_PREFETCH(bid);
    for (int unit = bid; unit < 6144; unit += nblk) {
        DIL_DECODE(unit)
        const int q0 = u0 + 32 * wid, qtok = ((q0 + qc) << dsh) + cls;
        bf16x8 Qf[4];
#pragma unroll
        for (int s = 0; s < 4; ++s) Qf[s] = *(const bf16x8*)(qa + ((size_t)bh * kS + qtok) * 64 + 16 * s + 8 * h5);
        __syncthreads();
#pragma unroll
        for (int it = 0; it < 6; ++it) { const int id = it * kNT + tid, row = id >> 3, ch = id & 7;
            *(LAS u32x4*)(Kimg + row * 128 + ((ch ^ (row & 7)) << 4)) = pK[it];
            *(LAS u32x4*)(Vimg + row * 128 + ((ch ^ (((row >> 1) & 1) << 2)) << 4)) = pV[it]; }
        __syncthreads();
        const float slope = exp2f(-(float)((bh & 7) + 1));
        const float c2 = slope * (float)(1 << dsh) * kLog2e;
        float sum = 0.f;
        f32x16 O[2];
#pragma unroll
        for (int dt = 0; dt < 2; ++dt)
#pragma unroll
            for (int i = 0; i < 16; ++i) O[dt][i] = 0.f;
        const float ndb = -dbase;
#define DIL_QK(dst, kt_) do { { const int kp0_ = q0 - 64 + 32 * (kt_); const float tm_ = (kp0_ >= 0 && kp0_ < L) ? 0.f : -1e30f; \
            const float cs_ = ((kt_) < 2) ? c2 : -c2, c0_ = (((kt_) == 0 || (kt_) == 4) ? -64.f : ((kt_) == 2 ? 0.f : -32.f)) * c2 - Mb + tm_; \
            const float bt_ = dbase * cs_ + c0_; \
            _Pragma("unroll") for (int i = 0; i < 16; i += 2) { const float k0 = (float)((i & 3) + 8 * (i >> 2)), k1 = (float)(((i + 1) & 3) + 8 * ((i + 1) >> 2)); f32x2 t; \
                if ((kt_) == 2) { const f32x2 d = {fabsf(dbase + k0), fabsf(dbase + k1)}; t = d * cs_ + c0_; } else t = (f32x2){k0, k1} * cs_ + bt_; \
                dst[i] = t.x; dst[i + 1] = t.y; } } \
            _Pragma("unroll") for (int s = 0; s < 4; ++s) { const bf16x8 Kf = *(const LAS bf16x8*)(Kimg + koff[s] + (kt_) * 4096); dst = __builtin_amdgcn_mfma_f32_32x32x16_bf16(Kf, Qf[s], dst, 0, 0, 0); } } while (0)
        f32x16 S, Sn;
        DIL_QK(S, 0);
        f32x2 sum2 = {0.f, 0.f};
#pragma unroll
        for (int kt = 0; kt < 5; ++kt) {
            if (kt < 4) DIL_QK(Sn, kt + 1);
            if (kt == 0) { if (unit + nblk < 6144) DIL_PREFETCH(unit + nblk); }
#pragma unroll
            for (int i = 0; i < 16; i += 2) {
                const float k0 = (float)((i & 3) + 8 * (i >> 2)), k1 = (float)(((i + 1) & 3) + 8 * ((i + 1) >> 2));
                f32x2 sv = (f32x2){S[i], S[i + 1]};
                if (kt == 0) { sv.x = (k0 >= ndb) ? sv.x : -1e30f; sv.y = (k1 >= ndb) ? sv.y : -1e30f; }
                if (kt == 4) { sv.x = (k0 <= ndb) ? sv.x : -1e30f; sv.y = (k1 <= ndb) ? sv.y : -1e30f; }
                f32x2 pv; pv.x = __builtin_amdgcn_exp2f(sv.x); pv.y = __builtin_amdgcn_exp2f(sv.y);
                S[i] = pv.x; S[i + 1] = pv.y; sum2 += pv;
            }
#pragma unroll
            for (int s2 = 0; s2 < 2; ++s2) {
                u32x4 pw; pw.x = pk2(S[8 * s2 + 0], S[8 * s2 + 1]); pw.y = pk2(S[8 * s2 + 2], S[8 * s2 + 3]); pw.z = pk2(S[8 * s2 + 4], S[8 * s2 + 5]); pw.w = pk2(S[8 * s2 + 6], S[8 * s2 + 7]);
                const bf16x8 Pf = __builtin_bit_cast(bf16x8, pw);
#pragma unroll
                for (int dt = 0; dt < 2; ++dt) { LAS unsigned char* vp = Vimg + voff[dt] + kt * 4096 + s2 * 2048;
                    const bf16x8 Vf = tr_pair(vp, vp + 1024);
                    O[dt] = __builtin_amdgcn_mfma_f32_32x32x16_bf16(Vf, Pf, O[dt], 0, 0, 0); }
            }
            if (kt < 4) S = Sn;
        }
#undef DIL_QK
        sum = sum2.x + sum2.y;
        sum = xsum32(sum);
        const float inv = 1.f / sum;
        const size_t tok = (size_t)(bh >> 3) * kS + qtok;
        {
        LAS unsigned char* ost = lds + 98304 + wid * 4096;
#pragma unroll
        for (int dt = 0; dt < 2; ++dt)
#pragma unroll
            for (int g4 = 0; g4 < 4; ++g4) { u32x2 w; w.x = pk2(O[dt][4 * g4] * inv, O[dt][4 * g4 + 1] * inv); w.y = pk2(O[dt][4 * g4 + 2] * inv, O[dt][4 * g4 + 3] * inv);
                *(LAS u32x2*)(ost + qc * 128 + (((4 * dt + g4) ^ (qc & 7)) << 4) + 8 * h5) = w; }
        if (h5 == 0) lse[((size_t)c * kTok + tok) * 8 + (bh & 7)] = Mn + __logf(sum);
        bf16_t* obase = oac + ((size_t)c * kTok + (size_t)(bh >> 3) * kS) * 512 + (bh & 7) * 64;
#pragma unroll
        for (int it = 0; it < 4; ++it) { const int r = it * 8 + (lane >> 3), ch = lane & 7;
            const u32x4 v = *(const LAS u32x4*)(ost + r * 128 + ((ch ^ (r & 7)) << 4));
            const size_t t2 = (size_t)(((q0 + r) << dsh) + cls);
            *(u32x4*)(obase + t2 * 512 + ch * 8) = v; }
        }
    }
#undef DIL_DECODE
#undef DIL_PREFETCH
    __syncthreads();
}
DEVI void phase_na(const bf16_t* qb, const bf16_t* kb, const bf16_t* vb, const float* rpb  , const float* gq, const float* gk, bf16_t* ob, LAS unsigned char* lds, int bid, int nblk) {
    const int tid = tidx(), wid = __builtin_amdgcn_readfirstlane(tid >> 6), lane = tid & 63, g4 = lane >> 4, i16 = lane & 15;
    LAS unsigned char* Kimg = lds; LAS unsigned char* Vimg = lds + 73728; LAS float* tab = (LAS float*)(lds + 147456);
    __syncthreads();
    for (int i = tid; i < 4 * 465; i += kNT) tab[i] = rpb[i];
    float Mq;
    { float a = fabsf(gq[lane]), b = fabsf(gk[lane]);
#pragma unroll
      for (int m = 32; m >= 1; m >>= 1) { a = fmaxf(a, __shfl_xor(a, m)); b = fmaxf(b, __shfl_xor(b, m)); }
      Mq = 8.f * a * b; }
    __syncthreads();
    if (wid < 4) { float m = 0.f; for (int i = lane; i < 465; i += 64) m = fmaxf(m, fabsf(tab[wid * 465 + i]));
#pragma unroll
        for (int k = 32; k >= 1; k >>= 1) m = fmaxf(m, __shfl_xor(m, k));
        if (lane == 0) tab[1860 + wid] = m; }
    __syncthreads();
    const int g = wid & 3, kcs = (16 * g - 8) < 0 ? 0 : ((16 * g - 8) > 32 ? 32 : (16 * g - 8));
    const int qcol = 16 * g + i16, cs = (qcol - 8) < 0 ? 0 : ((qcol - 8) > 48 ? 48 : (qcol - 8));
    unsigned kswz[2];
#pragma unroll
    for (int s = 0; s < 2; ++s) kswz[s] = (unsigned)(((4 * s + g4) ^ (i16 & 7)) << 4);
    const int q = i16 >> 2, p = i16 & 3, sw = 2 * (g4 & 1) + (q >> 1);
    unsigned vsw[4];
#pragma unroll
    for (int dt = 0; dt < 4; ++dt) vsw[dt] = (unsigned)((((2 * dt + (p >> 1)) ^ (sw << 1)) << 4) + 8 * (p & 1));
    const int scol = tid >> 3, sch = tid & 7;
    const unsigned skoff = (unsigned)(scol * 128 + ((sch ^ (scol & 7)) << 4)), svoff = (unsigned)(scol * 128 + ((sch ^ (((scol >> 1) & 3) << 1)) << 4));
    u32x4 pK[2], pV[2];
    for (int run = bid; run < 256; run += nblk) {
      const int bh = run >> 3, h = bh & 3;
      const bf16_t* kbase = kb + (size_t)bh * kS * 64 + scol * 64 + sch * 8; const bf16_t* vbase = vb + (size_t)bh * kS * 64 + scol * 64 + sch * 8;
      const LAS float* th = tab + h * 465;
      const float Mb = (Mq + tab[1860 + h]) * kLog2e;
      const int ecol0 = kcs + 4 * g4 - cs, dcb0 = kcs + 4 * g4 - qcol + 15;
      f32x4 Bi[8][2];
#pragma unroll
      for (int u = 0; u < 8; ++u)
#pragma unroll
          for (int tt = 0; tt < 2; ++tt)
#pragma unroll
              for (int jj = 0; jj < 4; ++jj) { const int e = ecol0 + 16 * tt + jj; int dc = dcb0 + 16 * tt + jj; dc = dc < 0 ? 0 : (dc > 30 ? 30 : dc);
                  Bi[u][tt][jj] = ((unsigned)e < 16u) ? th[(u + 3) * 31 + dc] * kLog2e - Mb : -1e30f; }
#pragma unroll 1
      for (int j = 0; j < 8; ++j) {
        const int rp = (run & 7) * 8 + j, r0 = 2 * rp;
        const int rsA = (r0 - 4) < 0 ? 0 : ((r0 - 4) > 120 ? 120 : (r0 - 4));
        const int prsA = (r0 - 6) < 0 ? 0 : ((r0 - 6) > 120 ? 120 : (r0 - 6));
        const int rr = r0 + (wid >> 2);
        const int rs = (rr - 4) < 0 ? 0 : ((rr - 4) > 120 ? 120 : (rr - 4));
        const int qtok = rr * 64 + qcol;
        bf16x8 Qf[2];
#pragma unroll
        for (int s = 0; s < 2; ++s) Qf[s] = *(const bf16x8*)(qb + ((size_t)bh * kS + qtok) * 64 + 32 * s + 8 * g4);
        __syncthreads();
        if (j == 0) {
#pragma unroll
            for (int it = 0; it < 9; ++it) { const int gr = rsA + it; if (gr < 128) { const int sl = gr % 9;
                const u32x4 kv = *(const u32x4*)(kbase + (size_t)gr * 64 * 64), vv = *(const u32x4*)(vbase + (size_t)gr * 64 * 64);
                *(LAS u32x4*)(Kimg + sl * 8192 + skoff) = kv; *(LAS u32x4*)(Vimg + sl * 8192 + svoff) = vv; } }
        } else {
#pragma unroll
            for (int it = 0; it < 2; ++it) { const int gr = prsA + 9 + it; if (gr <= rsA + 8 && gr < 128) { const int sl = gr % 9;
                *(LAS u32x4*)(Kimg + sl * 8192 + skoff) = pK[it]; *(LAS u32x4*)(Vimg + sl * 8192 + svoff) = pV[it]; } }
        }
        __syncthreads();
        if (j < 7) {
            const int nrsA = (r0 - 2) < 0 ? 0 : ((r0 - 2) > 120 ? 120 : (r0 - 2));
#pragma unroll
            for (int it = 0; it < 2; ++it) { int gr = rsA + 9 + it; gr = (gr <= nrsA + 8 && gr < 128) ? gr : 127;
                pK[it] = *(const u32x4*)(kbase + (size_t)gr * 64 * 64); pV[it] = *(const u32x4*)(vbase + (size_t)gr * 64 * 64); }
        }
        const int sb0 = rs % 9;
        const unsigned kb0 = (unsigned)((kcs + i16) * 128), vb0 = (unsigned)((kcs + 4 * g4 + q) * 128);
        float sum = 0.f;
        f32x4 O[4];
#pragma unroll
        for (int dt = 0; dt < 4; ++dt) O[dt] = (f32x4){0.f, 0.f, 0.f, 0.f};
#define NA_SO(u_) ((unsigned)((sb0 + (u_) >= 9 ? sb0 + (u_) - 9 : sb0 + (u_)) * 8192))
#define NA_QK(dst, u_, INIT) do { const unsigned so_ = NA_SO(u_); _Pragma("unroll") for (int tt = 0; tt < 2; ++tt) { \
            const bf16x8 Kf0 = *(const LAS bf16x8*)(Kimg + kb0 + so_ + tt * 2048 + kswz[0]), Kf1 = *(const LAS bf16x8*)(Kimg + kb0 + so_ + tt * 2048 + kswz[1]); \
            dst[tt] = __builtin_amdgcn_mfma_f32_16x16x32_bf16(Kf0, Qf[0], INIT(u_, tt), 0, 0, 0); dst[tt] = __builtin_amdgcn_mfma_f32_16x16x32_bf16(Kf1, Qf[1], dst[tt], 0, 0, 0); } } while (0)
#define NA_SOFTPV(S_, u_) do { const unsigned so_ = NA_SO(u_); \
            _Pragma("unroll") for (int tt = 0; tt < 2; ++tt) _Pragma("unroll") for (int jj = 0; jj < 4; ++jj) { const float pv = __builtin_amdgcn_exp2f(S_[tt][jj]); S_[tt][jj] = pv; sum += pv; } \
            u32x4 pw; pw.x = pk2(S_[0][0], S_[0][1]); pw.y = pk2(S_[0][2], S_[0][3]); pw.z = pk2(S_[1][0], S_[1][1]); pw.w = pk2(S_[1][2], S_[1][3]); \
            const bf16x8 Pf = __builtin_bit_cast(bf16x8, pw); \
            _Pragma("unroll") for (int dt = 0; dt < 4; ++dt) { LAS unsigned char* vp = Vimg + vb0 + so_ + vsw[dt]; \
                const bf16x8 Vf = tr_pair(vp, vp + 2048); \
                O[dt] = __builtin_amdgcn_mfma_f32_16x16x32_bf16(Vf, Pf, O[dt], 0, 0, 0); } } while (0)
#define NA_INIT_REG(u_, tt_) Bi[u_][tt_]
        if (rs - rr == -4) {
            f32x4 S[2], Sn[2];
            NA_QK(S, 0, NA_INIT_REG);
#pragma unroll
            for (int u = 0; u < 8; ++u) {
                if (u < 7) NA_QK(Sn, u + 1, NA_INIT_REG);
                NA_SOFTPV(S, u);
                if (u < 7) { S[0] = Sn[0]; S[1] = Sn[1]; }
            }
        } else {
            int g4v = g4; asm volatile("" : "+v"(g4v));
            const int ecol = kcs + 4 * g4v - cs, dcb = kcs + 4 * g4v - qcol + 15;
#pragma unroll
            for (int u = 0; u < 8; ++u) {
                const LAS float* tr = th + (rs + u - rr + 7) * 31;
                f32x4 In[2];
#pragma unroll
                for (int tt = 0; tt < 2; ++tt)
#pragma unroll
                    for (int jj = 0; jj < 4; ++jj) { const int e = ecol + 16 * tt + jj; int dc = dcb + 16 * tt + jj; dc = dc < 0 ? 0 : (dc > 30 ? 30 : dc);
                        In[tt][jj] = ((unsigned)e < 16u) ? tr[dc] * kLog2e - Mb : -1e30f; }
#define NA_INIT_TAB(u_, tt_) In[tt_]
                f32x4 S[2];
                NA_QK(S, u, NA_INIT_TAB);
                NA_SOFTPV(S, u);
#undef NA_INIT_TAB
            }
        }
#undef NA_INIT_REG
#undef NA_SOFTPV
#undef NA_QK
#undef NA_SO
        sum = xsum32(xsum16(sum));
        const float inv = 1.f / sum;
        bf16_t* orow = ob + ((size_t)(bh >> 2) * kS + qtok) * 256 + h * 64;
#pragma unroll
        for (int dt = 0; dt < 4; ++dt) { u32x2 w; w.x = pk2(O[dt][0] * inv, O[dt][1] * inv); w.y = pk2(O[dt][2] * inv, O[dt][3] * inv); *(u32x2*)(orow + 16 * dt + 4 * g4) = w; }
      }
    }
    __syncthreads();
}
DEVI void unpk8(float* d, const u32x4 q, const float sc) {
    d[0] += sc * __uint_as_float(q.x << 16); d[1] += sc * __uint_as_float(q.x & 0xFFFF0000u); d[2] += sc * __uint_as_float(q.y << 16); d[3] += sc * __uint_as_float(q.y & 0xFFFF0000u);
    d[4] += sc * __uint_as_float(q.z << 16); d[5] += sc * __uint_as_float(q.z & 0xFFFF0000u); d[6] += sc * __uint_as_float(q.w << 16); d[7] += sc * __uint_as_float(q.w & 0xFFFF0000u);
}
DEVI void phase_mixnorm(const bf16_t* oac, const float* lse, const bf16_t* ob, const bf16_t* oc, const float* ga, const float* gb, const float* gc, bf16_t* mix, int bid, int nblk) {
    const int wid = tidx() >> 6, lane = tidx() & 63;
    float gn[16];
    { const float* gp = (lane < 32) ? ga + lane * 16 : (lane < 48) ? gb + (lane - 32) * 16 : gc + (lane - 48) * 16;
#pragma unroll
      for (int i = 0; i < 16; ++i) gn[i] = gp[i]; }
    const int stride = nblk * 8;
    int row = bid * 8 + wid;
    if (row >= kTok) return;
    u32x4 Aq[6], Bq[6]; float Al[3], Bl[3];
    const bool dil = lane < 32;
    const int hh = dil ? (lane >> 2) : 0;
#define MX_ISSUE(R, Q, L) do { \
        const bf16_t* p0_ = dil ? oac + (size_t)(R) * 512 + lane * 16 : ((lane < 48) ? ob + (size_t)(R) * 256 + (lane - 32) * 16 : oc + (size_t)(R) * 256 + (lane - 48) * 16); \
        const size_t cst_ = dil ? (size_t)kTok * 512 : (size_t)0; \
        Q[0] = *(const u32x4*)p0_; Q[1] = *(const u32x4*)(p0_ + 8); Q[2] = *(const u32x4*)(p0_ + cst_); Q[3] = *(const u32x4*)(p0_ + cst_ + 8); Q[4] = *(const u32x4*)(p0_ + 2 * cst_); Q[5] = *(const u32x4*)(p0_ + 2 * cst_ + 8); \
        L[0] = lse[(size_t)(R) * 8 + hh]; L[1] = lse[((size_t)kTok + (R)) * 8 + hh]; L[2] = lse[((size_t)2 * kTok + (R)) * 8 + hh]; } while (0)
#define MX_BODY(C, N) do { \
        const int nrow_ = (row + stride < kTok) ? row + stride : row; \
        MX_ISSUE(nrow_, N##q, N##l); \
        float v[16]; \
        _Pragma("unroll") for (int i = 0; i < 16; ++i) v[i] = 0.f; \
        float w0 = 1.f, w1 = 0.f, w2 = 0.f; \
        if (dil) { const float mx = fmaxf(C##l[0], fmaxf(C##l[1], C##l[2])); w0 = __expf(C##l[0] - mx); w1 = __expf(C##l[1] - mx); w2 = __expf(C##l[2] - mx); const float inv = frcp(w0 + w1 + w2); w0 *= inv; w1 *= inv; w2 *= inv; } \
        unpk8(v, C##q[0], w0); unpk8(v + 8, C##q[1], w0); unpk8(v, C##q[2], w1); unpk8(v + 8, C##q[3], w1); unpk8(v, C##q[4], w2); unpk8(v + 8, C##q[5], w2); \
        float ss = 0.f; \
        _Pragma("unroll") for (int i = 0; i < 16; ++i) ss += v[i] * v[i]; \
        ss = row_sum16(ss); \
        { float a = ss, b = ss; swap16(a, b); if (lane < 32) ss = a + b; } \
        const float rstd = rsqrtf(ss * ((lane < 32) ? (1.f / 512.f) : (1.f / 256.f)) + kEps); \
        u32x4 o0, o1; \
        o0.x = pk2(v[0] * rstd * gn[0], v[1] * rstd * gn[1]); o0.y = pk2(v[2] * rstd * gn[2], v[3] * rstd * gn[3]); o0.z = pk2(v[4] * rstd * gn[4], v[5] * rstd * gn[5]); o0.w = pk2(v[6] * rstd * gn[6], v[7] * rstd * gn[7]); \
        o1.x = pk2(v[8] * rstd * gn[8], v[9] * rstd * gn[9]); o1.y = pk2(v[10] * rstd * gn[10], v[11] * rstd * gn[11]); o1.z = pk2(v[12] * rstd * gn[12], v[13] * rstd * gn[13]); o1.w = pk2(v[14] * rstd * gn[14], v[15] * rstd * gn[15]); \
        *(u32x4*)(mix + (size_t)row * kD + lane * 16) = o0; *(u32x4*)(mix + (size_t)row * kD + lane * 16 + 8) = o1; } while (0)
    MX_ISSUE(row, Aq, Al);
    for (;;) {
        MX_BODY(A, B); row += stride; if (row >= kTok) break;
        MX_BODY(B, A); row += stride; if (row >= kTok) break;
    }
#undef MX_BODY
#undef MX_ISSUE
}
DEVI void phase_combine(bf16_t* xb, bf16_t* xbo, float* out32, const bf16_t* y, const float* gate, const int* tokslot, bool last_layer, float* rstdp, int bid, int nblk) {
    const int wid = tidx() >> 6, lane = tidx() & 63;
    const int stride = nblk * 8;
    int row = bid * 8 + wid;
    if (row >= kTok) return;
    u32x4 Ax0, Ax1, Ay[4], Bx0, Bx1, By[4]; float Ag[4], Bg[4]; unsigned Am = 0u, Bm = 0u;
#define CB_ISSUE(R, TS, X0, X1, Y, G, M) do { const int b_ = (R) >> 13; \
        M = (unsigned)__builtin_amdgcn_ballot_w64(lane < 16 && (TS) >= 0); unsigned mm_ = M; \
        X0 = *(const u32x4*)(xb + (size_t)(R) * kD + lane * 16); X1 = *(const u32x4*)(xb + (size_t)(R) * kD + lane * 16 + 8); \
        _Pragma("unroll") for (int j = 0; j < 4; ++j) { const bool has_ = mm_ != 0u; const int e_ = has_ ? __builtin_ctz(mm_) : 0; const int sl_ = has_ ? __builtin_amdgcn_readlane((TS), e_) : 0; \
            const size_t r_ = has_ ? (size_t)(e_ * kB + b_) * kCap + sl_ : (size_t)0; Y[j] = *(const u32x4*)((const unsigned char*)y + r_ * kD + lane * 16); G[j] = gate[r_]; mm_ &= mm_ - 1u; } } while (0)
#define CB_ACC(YV, GS) do { const unsigned ww_[4] = {(YV).x, (YV).y, (YV).z, (YV).w}; const float gs_ = __builtin_bit_cast(float, __builtin_amdgcn_readfirstlane(__builtin_bit_cast(int, (GS))));   \
        _Pragma("unroll") for (int k = 0; k < 4; ++k) { const f32x2 lo = __builtin_amdgcn_cvt_pk_f32_fp8(ww_[k], false), hi = __builtin_amdgcn_cvt_pk_f32_fp8(ww_[k], true); \
            v[4 * k] += lo.x * gs_; v[4 * k + 1] += lo.y * gs_; v[4 * k + 2] += hi.x * gs_; v[4 * k + 3] += hi.y * gs_; } } while (0)
#define CB_BODY(C, N) do { \
        const int nrow_ = (row + stride < kTok) ? row + stride : row, nnrow_ = (row + 2 * stride < kTok) ? row + 2 * stride : row, b = row >> 13; \
        const int ts2 = tokslot[(size_t)nnrow_ * kE + (lane & 15)]; \
        CB_ISSUE(nrow_, ts1, N##x0, N##x1, N##y, N##g, N##m); \
        float v[16]; unpk8s(v, C##x0); unpk8s(v + 8, C##x1); \
        unsigned mm = C##m; \
        _Pragma("unroll") for (int j = 0; j < 4; ++j) { if (mm != 0u) CB_ACC(C##y[j], C##g[j]); mm &= mm - 1u; } \
        while (mm != 0u) { const int e = __builtin_ctz(mm), sl = __builtin_amdgcn_readlane(ts0, e); const size_t r = (size_t)(e * kB + b) * kCap + sl; \
            const u32x4 yv = *(const u32x4*)((const unsigned char*)y + r * kD + lane * 16); const float gs = gate[r]; CB_ACC(yv, gs); mm &= mm - 1u; } \
        if (last_layer) { \
            _Pragma("unroll") for (int k = 0; k < 4; ++k) *(f32x4*)(out32 + (size_t)row * kD + lane * 16 + 4 * k) = (f32x4){v[4 * k], v[4 * k + 1], v[4 * k + 2], v[4 * k + 3]}; \
        } else { u32x4 o0, o1; \
            o0.x = pk2(v[0], v[1]); o0.y = pk2(v[2], v[3]); o0.z = pk2(v[4], v[5]); o0.w = pk2(v[6], v[7]); o1.x = pk2(v[8], v[9]); o1.y = pk2(v[10], v[11]); o1.z = pk2(v[12], v[13]); o1.w = pk2(v[14], v[15]); \
            *(u32x4*)(xbo + (size_t)row * kD + lane * 16) = o0; *(u32x4*)(xbo + (size_t)row * kD + lane * 16 + 8) = o1; \
            unpk8s(v, o0); unpk8s(v + 8, o1);                     \
            float ss = 0.f; \
            _Pragma("unroll") for (int i = 0; i < 16; ++i) ss += v[i] * v[i]; \
            ss = wave_sum(ss); \
            if (lane == 0) rstdp[row] = rsqrtf(ss * (1.f / kD) + kEps);     \
        } \
        ts0 = ts1; ts1 = ts2; } while (0)
    int ts0 = tokslot[(size_t)row * kE + (lane & 15)];
    int ts1 = tokslot[(size_t)((row + stride < kTok) ? row + stride : row) * kE + (lane & 15)];
    CB_ISSUE(row, ts0, Ax0, Ax1, Ay, Ag, Am);
    for (;;) {
        CB_BODY(A, B); row += stride; if (row >= kTok) break;
        CB_BODY(B, A); row += stride; if (row >= kTok) break;
    }
#undef CB_BODY
#undef CB_ISSUE
#undef CB_ACC
}

DEVI void cpow_m(double a, double w, double dt, int m, float& re, float& im) {
    const float mag = __expf((float)m * (float)a * (float)dt);
    const double turns = (double)m * w * dt * 0.15915494309189535; const float ang = (float)((turns - floor(turns)) * 6.283185307179586);
    re = mag * cosf(ang); im = mag * sinf(ang);
}
DEVI void s5_prep_item(const Params& P, int l, int g, unsigned char* lds_) {
    float* pw = (float*)lds_;
    float* bb = pw + 4352;
    float* cc = bb + 4096;
    float* kt = cc + 4096;
    const int tid = tidx();
    __syncthreads();
    for (int i = tid; i < 128; i += kNT) { const int dir = i >> 6, p = i & 63; const size_t pb = (((size_t)l * 2 + dir) * 16 + g) * 64 + p;
        const double dt = (double)__expf(P.s5_log_dt[((size_t)l * 2 + dir) * 16 + g]); const double a = (double)fminf(P.s5_a_re[pb], -1e-4f), w = (double)P.s5_a_im[pb];
        for (int m = 0; m < 17; ++m) { float re, im; cpow_m(a, w, dt, m, re, im); pw[((dir * 64 + p) * 17 + m) * 2] = re; pw[((dir * 64 + p) * 17 + m) * 2 + 1] = im; }
        const float af = (float)a, wf = (float)w, ar = pw[((dir * 64 + p) * 17 + 1) * 2], ai = pw[((dir * 64 + p) * 17 + 1) * 2 + 1];
        const float den = af * af + wf * wf, zr = ar - 1.f, gr = (zr * af + ai * wf) / den, gi = (ai * af - zr * wf) / den;
        for (int c = 0; c < 16; ++c) { const float br = P.s5_b_re[pb * 16 + c], bi = P.s5_b_im[pb * 16 + c]; bb[((dir * 64 + p) * 16 + c) * 2] = gr * br - gi * bi; bb[((dir * 64 + p) * 16 + c) * 2 + 1] = gr * bi + gi * br; }
    }
    for (int i = tid; i < 2048; i += kNT) { const int dir = i >> 10, c = (i >> 6) & 15, p = i & 63; const size_t o = ((((size_t)l * 2 + dir) * 16 + g) * 16 + c) * 64 + p; cc[i * 2] = P.s5_c_re[o]; cc[i * 2 + 1] = P.s5_c_im[o]; }
    __syncthreads();
    for (int i = tid; i < 8192; i += kNT) { const int dir = i >> 12, m = (i >> 8) & 15, c = (i >> 4) & 15, c2 = i & 15; float acc = 0.f;
        for (int p = 0; p < 64; ++p) { const float cr = cc[((dir * 16 + c) * 64 + p) * 2], ci = cc[((dir * 16 + c) * 64 + p) * 2 + 1], wr_ = pw[((dir * 64 + p) * 17 + m) * 2], wi_ = pw[((dir * 64 + p) * 17 + m) * 2 + 1];
            const float br = bb[((dir * 64 + p) * 16 + c2) * 2], bi = bb[((dir * 64 + p) * 16 + c2) * 2 + 1]; const float tr = cr * wr_ - ci * wi_, ti = cr * wi_ + ci * wr_; acc += tr * br - ti * bi; }
        kt[i] = acc; }
    __syncthreads();
    bf16_t* wst = (bf16_t*)(wsp(P) + WS_WST) + ((size_t)l * 16 + g) * 256 * 256;
    bf16_t* wso = (bf16_t*)(wsp(P) + WS_WSO) + ((size_t)l * 16 + g) * 256 * 512;
    for (int id = tid; id < 8192; id += kNT) { const int n = id >> 5, k0 = (id & 31) * 8, dir = n >> 7, p = (n >> 1) & 63, ri = n & 1; float v[8];
#pragma unroll
        for (int kk = 0; kk < 8; ++kk) { const int k = k0 + kk, t = k >> 4, c = k & 15, e = dir ? t : 15 - t; const float wr_ = pw[((dir * 64 + p) * 17 + e) * 2], wi_ = pw[((dir * 64 + p) * 17 + e) * 2 + 1], br = bb[((dir * 64 + p) * 16 + c) * 2], bi = bb[((dir * 64 + p) * 16 + c) * 2 + 1];
            v[kk] = ri ? (wr_ * bi + wi_ * br) : (wr_ * br - wi_ * bi); }
        u32x4 o; o.x = pk2(v[0], v[1]); o.y = pk2(v[2], v[3]); o.z = pk2(v[4], v[5]); o.w = pk2(v[6], v[7]); *(u32x4*)(wst + (size_t)n * 256 + k0) = o; }
    for (int id = tid; id < 16384; id += kNT) { const int ns = id >> 6, k0 = (id & 63) * 8, n = cmap_pk(ns), t = n >> 4, c = n & 15; float v[8];
#pragma unroll
        for (int kk = 0; kk < 8; ++kk) { const int k = k0 + kk; float x;
            if (k < 256) { const int j = k >> 4, c2 = k & 15; x = 0.f; if (j <= t) x += kt[(t - j) * 256 + c * 16 + c2]; if (j >= t) x += kt[4096 + (j - t) * 256 + c * 16 + c2]; if (j == t && c == c2) x += P.s5_d[l * 256 + g * 16 + c]; }
            else { const int q = k - 256, dir = q >> 7, p = (q >> 1) & 63, ri = q & 1, e = dir ? 16 - t : t + 1; const float cr = cc[((dir * 16 + c) * 64 + p) * 2], ci = cc[((dir * 16 + c) * 64 + p) * 2 + 1], wr_ = pw[((dir * 64 + p) * 17 + e) * 2], wi_ = pw[((dir * 64 + p) * 17 + e) * 2 + 1];
                x = ri ? -(cr * wi_ + ci * wr_) : (cr * wr_ - ci * wi_); }
            v[kk] = x; }
        u32x4 o; o.x = pk2(v[0], v[1]); o.y = pk2(v[2], v[3]); o.z = pk2(v[4], v[5]); o.w = pk2(v[6], v[7]); *(u32x4*)(wso + (size_t)ns * 512 + k0) = o; }
    __syncthreads();
}
DEVI void phase_s5_scan(const Params& P, int l, const float* Z, bf16_t* ux, unsigned char* lds_, int bid, int nblk) {
    const int tid = tidx(), wid = tid >> 6, lane = tid & 63;
    float* E = (float*)lds_;
    for (int item = bid; item < 256; item += nblk) {
        const int dir = item & 1, g = (item >> 1) & 15, b = item >> 5;
        const size_t pb = (((size_t)l * 2 + dir) * 16 + g) * 64 + lane;
        const double dt = (double)__expf(P.s5_log_dt[((size_t)l * 2 + dir) * 16 + g]); const double a = (double)fminf(P.s5_a_re[pb], -1e-4f), w = (double)P.s5_a_im[pb];
        float a16r, a16i, Ar, Ai; cpow_m(a, w, dt, 16, a16r, a16i); cpow_m(a, w, dt, 1024, Ar, Ai);
        const int kk0 = dir ? 511 - 64 * wid : 64 * wid; const long sstep = dir ? -1 : 1;
        const float* zp = Z + ((size_t)g * 4096 + b * 512 + kk0) * 256 + dir * 128 + 2 * lane;
        f32x2 z[64];
#pragma unroll
        for (int i = 0; i < 64; ++i) { z[i] = *(const f32x2*)zp; zp += sstep * 256; }
        float xr = 0.f, xi = 0.f;
#pragma unroll
        for (int i = 0; i < 64; ++i) { const float nr = a16r * xr - a16i * xi + z[i].x, ni = a16r * xi + a16i * xr + z[i].y; xr = nr; xi = ni; }
        __syncthreads();
        E[(wid * 64 + lane) * 2] = xr; E[(wid * 64 + lane) * 2 + 1] = xi;
        __syncthreads();
        float sr = 0.f, si = 0.f;
#pragma unroll
        for (int s2 = 0; s2 < 7; ++s2) if (s2 < wid) { const float er = E[(s2 * 64 + lane) * 2], ei = E[(s2 * 64 + lane) * 2 + 1]; const float nr = Ar * sr - Ai * si + er, ni = Ar * si + Ai * sr + ei; sr = nr; si = ni; }
        bf16_t* up = ux + ((size_t)g * 4096 + b * 512 + kk0) * 512 + 256 + dir * 128 + 2 * lane;
#pragma unroll
        for (int i = 0; i < 64; ++i) { *(unsigned*)up = pk2(sr, si); up += sstep * 512;
            const float nr = a16r * sr - a16i * si + z[i].x, ni = a16r * si + a16i * sr + z[i].y; sr = nr; si = ni; }
    }
    __syncthreads();
}
struct EpiF32N {
    DEVI void stage(LAS unsigned char*, const Unit&, int, int) const {}
    static constexpr int VMOPS = 32;
    float* z; int ldz;
    DEVI void operator()(const f32x4 (&acc)[2][2][4][2], const Unit& u, int wr, int wc, int fr, int fq) const {
#pragma unroll
        for (int ai = 0; ai < 2; ++ai)
#pragma unroll
            for (int m = 0; m < 4; ++m) { const size_t ro = (size_t)(u.pm * 256 + 128 * ai + 64 * wr + 16 * m + fr) * ldz + u.pn * 256 + 32 * wc + 4 * fq;
#pragma unroll
                for (int bj = 0; bj < 2; ++bj)
#pragma unroll
                    for (int n = 0; n < 2; ++n) *(f32x4*)(z + ro + 128 * bj + 16 * n) = acc[ai][bj][m][n]; }
    }
};
struct EpiS5Out {
    DEVI void stage(LAS unsigned char*, const Unit&, int, int) const {}
    static constexpr int VMOPS = 16;
    bf16_t* G;
    DEVI void operator()(const f32x4 (&acc)[2][2][4][2], const Unit& u, int wr, int wc, int fr, int fq) const {
#pragma unroll
        for (int ai = 0; ai < 2; ++ai)
#pragma unroll
            for (int m = 0; m < 4; ++m) { const int R = u.pm * 256 + 128 * ai + 64 * wr + 16 * m + fr, g = R >> 12, ck = R & 4095;
#pragma unroll
                for (int bj = 0; bj < 2; ++bj) { const int t = 8 * bj + 2 * wc + (fq >> 1), c0 = 8 * (fq & 1);
                    const f32x4 v0 = acc[ai][bj][m][0], v1 = acc[ai][bj][m][1];
                    u32x4 w; w.x = pk2(gelu_tanh(v0.x), gelu_tanh(v0.y)); w.y = pk2(gelu_tanh(v0.z), gelu_tanh(v0.w)); w.z = pk2(gelu_tanh(v1.x), gelu_tanh(v1.y)); w.w = pk2(gelu_tanh(v1.z), gelu_tanh(v1.w));
                    *(u32x4*)(G + ((size_t)ck * 16 + t) * 256 + g * 16 + c0) = w; } }
    }
};
#define XB_TMO      128
#define XB_XCNT(j)  (256  + 64 * (j))
#define XB_XSUB(j)  (1280 + 64 * (j))
#define XB_XGEN(j)  (2304 + 64 * (j))
#define XB_TOP      3328
#define XB_TOPGEN   3392
#define XCD_BAR_WORDS 3456
#define XB_SPIN_CAP (1u << 26)
DEVI unsigned xb_ld(unsigned* p)              { return __hip_atomic_load(p, __ATOMIC_RELAXED, __HIP_MEMORY_SCOPE_AGENT); }
DEVI unsigned xb_add(unsigned* p, unsigned v) { return __hip_atomic_fetch_add(p, v, __ATOMIC_RELAXED, __HIP_MEMORY_SCOPE_AGENT); }
DEVI unsigned xb_xcc_id() { return (unsigned)__builtin_amdgcn_s_getreg((3 << 11) | 20) & 0xFu; }
#define XB_SPIN(cond, bar) do { unsigned _sp = 0; while (cond) { __builtin_amdgcn_s_sleep(1); \
    if ((++_sp & 255u) == 0u) { if (xb_ld(&(bar)[XB_TMO])) break; if (_sp > XB_SPIN_CAP) { atomicAdd(&(bar)[XB_TMO], 1u); break; } } } } while (0)
struct XcdBarrier { unsigned* bar; unsigned x; volatile LAS unsigned* st; };
DEVI XcdBarrier xcd_barrier_post(unsigned* bar, volatile LAS unsigned* st) {
    XcdBarrier b; b.bar = bar; b.x = xb_xcc_id(); b.st = st;
    if (threadIdx.x == 0) (void)xb_add(&bar[XB_XCNT(b.x)], 1u);
    return b;
}
DEVI void xcd_barrier_complete(unsigned* bar, unsigned x, unsigned& nloc, unsigned& nx) {
    const unsigned G = gridDim.x * gridDim.y * gridDim.z;
    unsigned sum, cnt, mine, sp = 0u;
    for (;;) {
        sum = 0u; cnt = 0u; mine = 0u;
#pragma unroll
        for (unsigned j = 0; j < 16; ++j) { const unsigned c = xb_ld(&bar[XB_XCNT(j)]); sum += c; cnt += (c > 0u) ? 1u : 0u; mine = (j == x) ? c : mine; }
        if (sum == G) break;
        __builtin_amdgcn_s_sleep(1);
        if ((++sp & 255u) == 0u) { if (xb_ld(&bar[XB_TMO])) break; if (sp > XB_SPIN_CAP) { atomicAdd(&bar[XB_TMO], 1u); break; } }
    }
    nloc = mine > 0u ? mine : 1u; nx = cnt > 0u ? cnt : 1u;
}
DEVI void xcd_barrier(const XcdBarrier& b) {
    asm volatile("s_waitcnt vmcnt(0)" ::: "memory");
    __syncthreads();
    if (threadIdx.x == 0) {
        unsigned long long bp_ = (unsigned long long)b.bar; asm volatile("" : "+s"(bp_));
        unsigned* bar = (unsigned*)bp_;
        const unsigned bx = xb_xcc_id();
        __builtin_amdgcn_s_waitcnt(0);
        unsigned nloc = b.st[0], nx = b.st[1];
        if (nloc == 0u) { xcd_barrier_complete(bar, bx, nloc, nx); b.st[0] = nloc; b.st[1] = nx; }
        const unsigned old = xb_add(&bar[XB_XSUB(bx)], 1u);
        const unsigned gen = old / nloc;
        if (old + 1u == (gen + 1u) * nloc) {
            __builtin_amdgcn_fence(__ATOMIC_RELEASE, "agent");
            asm volatile("s_waitcnt vmcnt(0)" ::: "memory");
            const unsigned og = xb_add(&bar[XB_TOP], 1u);
            const unsigned tg = og / nx;
            if (og + 1u == (tg + 1u) * nx) xb_add(&bar[XB_TOPGEN], 1u);
            else XB_SPIN(xb_ld(&bar[XB_TOPGEN]) == tg, bar);
            __builtin_amdgcn_fence(__ATOMIC_ACQUIRE, "agent");
            xb_add(&bar[XB_XGEN(bx)], 1u);
            asm volatile("s_waitcnt vmcnt(0)" ::: "memory");
        } else {
            XB_SPIN(xb_ld(&bar[XB_XGEN(bx)]) == gen, bar);
            __builtin_amdgcn_fence(__ATOMIC_ACQUIRE, "agent");
            asm volatile("s_waitcnt vmcnt(0)" ::: "memory");
        }
    }
    __syncthreads();
}

constexpr int LDS_BYTES = 147456 + 8192 + 16;
#define GEMM_RUN(g, E) gemm_engine<decltype(E), true, true>((LAS unsigned char*)dyn_lds, g, E, bid, nblk)
#define GEMM_RUN8(g, E) gemm_engine<decltype(E), true, true, true>((LAS unsigned char*)dyn_lds, g, E, bid, nblk)
#define GEMM_RUN8G(g, E) gemm_engine<decltype(E), true, true, true, true>((LAS unsigned char*)dyn_lds, g, E, bid, nblk)
extern __shared__ __attribute__((aligned(16))) unsigned char dyn_lds[];

DEVI GemmD mk_gemm(const bf16_t* A, const bf16_t* Bt, int lda, int K, int nM, int nN, const int* rowidx, size_t bstride, int pmg) {
    GemmD g; g.A = A; g.Bt = Bt; g.lda = lda; g.K = K; g.nM = nM; g.nN = nN; g.rowidx = rowidx; g.bstride = bstride; g.pmg = pmg; return g; }

DEVI void ph_win(const Params& P, int l, int bid, int nblk) {
    const GemmD g = mk_gemm((const bf16_t*)(wsp(P) + WS_XB), (const bf16_t*)(wsp(P) + WS_WINT) + (size_t)l * kINW * kD, kD, kD, kTok / 256, 10, nullptr, 0, 1 << 30);
    unsigned char* r1 = wsp(P) + WS_R1;
    EpiQKV E; E.qa = (bf16_t*)(r1 + R1_QA); E.ka = (bf16_t*)(r1 + R1_KA); E.va = (bf16_t*)(r1 + R1_VA); E.qb = (bf16_t*)(r1 + R1_QB); E.kb = (bf16_t*)(r1 + R1_KB); E.vb = (bf16_t*)(r1 + R1_VB); E.ux = (bf16_t*)(r1 + R1_UX);
    E.rstdp = (const float*)(wsp(P) + WS_RSTD); E.rtab = (const LAS float*)((LAS unsigned char*)dyn_lds + 131072 + 2048);
    { LAS float* tab = (LAS float*)((LAS unsigned char*)dyn_lds + 131072);
      const int t = tidx();
      if (t < 320) { const int r = t >> 6, c = t & 63; tab[t] = (r == 0) ? P.q_norm_a[l * 64 + c] * (0.125f * kLog2e)   : (r == 1) ? P.k_norm_a[l * 64 + c] : (r == 2) ? P.q_norm_b[l * 64 + c] * (0.125f * kLog2e)   : (r == 3) ? P.k_norm_b[l * 64 + c] : 1.f; }
      __syncthreads();
      E.gtab = tab; }
    GEMM_RUN(g, E);
}
DEVI void ph_dilated(const Params& P, int l, int bid, int nblk) { unsigned char* r1 = wsp(P) + WS_R1;
    phase_dilated((const bf16_t*)(r1 + R1_QA), (const bf16_t*)(r1 + R1_KA), (const bf16_t*)(r1 + R1_VA), P.q_norm_a + l * 64, P.k_norm_a + l * 64, (bf16_t*)(wsp(P) + WS_R2), (float*)(wsp(P) + WS_LSE), (LAS unsigned char*)dyn_lds, bid, nblk);
}
DEVI void ph_na(const Params& P, int l, int bid, int nblk) { unsigned char* r1 = wsp(P) + WS_R1;
    phase_na((const bf16_t*)(r1 + R1_QB), (const bf16_t*)(r1 + R1_KB), (const bf16_t*)(r1 + R1_VB), P.rpb + (size_t)l * 4 * 15 * 31, P.q_norm_b + l * 64, P.k_norm_b + l * 64, (bf16_t*)(r1 + R1_OB), (LAS unsigned char*)dyn_lds, bid, nblk);
}
DEVI void ph_s5_prep(const Params& P, unsigned char* lds, int bid, int nblk) { for (int it = bid; it < kL * 16; it += nblk) s5_prep_item(P, it >> 4, it & 15, lds); }
DEVI void ph_s5_state(const Params& P, int l, int bid, int nblk) {
    const GemmD g = mk_gemm((const bf16_t*)(wsp(P) + WS_R1 + R1_UX), (const bf16_t*)(wsp(P) + WS_WST) + (size_t)l * 16 * 256 * 256, 512, 256, 256, 1, nullptr, (size_t)256 * 256, 16);
    EpiF32N E; E.z = (float*)(wsp(P) + WS_R2 + R2_Z); E.ldz = 256;
    GEMM_RUN(g, E);
}
DEVI void ph_s5_scan(const Params& P, int l, unsigned char* lds, int bid, int nblk) { phase_s5_scan(P, l, (const float*)(wsp(P) + WS_R2 + R2_Z), (bf16_t*)(wsp(P) + WS_R1 + R1_UX), lds, bid, nblk); }
DEVI void ph_s5_out(const Params& P, int l, int bid, int nblk) {
    const GemmD g = mk_gemm((const bf16_t*)(wsp(P) + WS_R1 + R1_UX), (const bf16_t*)(wsp(P) + WS_WSO) + (size_t)l * 16 * 256 * 512, 512, 512, 256, 1, nullptr, (size_t)256 * 512, 16);
    EpiS5Out E; E.G = (bf16_t*)(wsp(P) + WS_R1 + R1_G);
    GEMM_RUN(g, E);
}
DEVI void ph_glu(const Params& P, int l, int bid, int nblk) {
    const GemmD g = mk_gemm((const bf16_t*)(wsp(P) + WS_R1 + R1_G), (const bf16_t*)(wsp(P) + WS_WGLUT) + (size_t)l * 256 * 256, 256, 256, kTok / 256, 1, nullptr, 0, 1 << 30);
    EpiGlu E; E.g = (const bf16_t*)(wsp(P) + WS_R1 + R1_G); E.oc = (bf16_t*)(wsp(P) + WS_R1 + R1_OC);
    GEMM_RUN(g, E);
}
DEVI void ph_mixnorm(const Params& P, int l, int bid, int nblk) { unsigned char* r1 = wsp(P) + WS_R1;
    phase_mixnorm((const bf16_t*)(wsp(P) + WS_R2), (const float*)(wsp(P) + WS_LSE), (const bf16_t*)(r1 + R1_OB), (const bf16_t*)(r1 + R1_OC), P.out_norm_a + l * 512, P.out_norm_b + l * 256, P.out_norm_c + l * 256, (bf16_t*)(wsp(P) + WS_H), bid, nblk); }
DEVI void ph_wout(const Params& P, int l, int bid, int nblk) {
    const GemmD g = mk_gemm((const bf16_t*)(wsp(P) + WS_H), (const bf16_t*)(wsp(P) + WS_WOUTT) + (size_t)l * kD * kD, kD, kD, kTok / 256, 4, nullptr, 0, 1 << 30);
    EpiResid E; E.xb = (bf16_t*)(wsp(P) + WS_XB); E.xbo = E.xb;
    GEMM_RUN(g, E);
}
DEVI void ph_router(const Params& P, int l, unsigned char* lds, int bid, int nblk) { phase_router((const bf16_t*)(wsp(P) + WS_XB), P.ffn_norm + (size_t)l * kD, wsp(P) + WS_RTAB + (size_t)l * 65536, wsp(P) + WS_H, (float*)(wsp(P) + WS_AFF), (LAS unsigned char*)dyn_lds, bid, nblk); }
DEVI void ph_topk(const Params& P, unsigned char* lds, int bid, int nblk) { phase_topk((const float*)(wsp(P) + WS_AFF), (int*)(wsp(P) + WS_IDX), (float*)(wsp(P) + WS_GATE), (int*)(wsp(P) + WS_TSLOT), wsp(P) + WS_H, nullptr  , kD, lds, bid, nblk); }
DEVI void ph_gu(const Params& P, int l, int bid, int nblk) {
    const GemmD g = mk_gemm((const bf16_t*)(wsp(P) + WS_H), (const bf16_t*)(wsp(P) + WS_WGUT + (size_t)l * kE * 4096 * kD), kD, kD, 512, 16, (const int*)(wsp(P) + WS_IDX), (size_t)4096 * kD, 32);
    EpiGU E; E.hid = (bf16_t*)(wsp(P) + WS_R1); E.sc = 1.f / kW8;
    GEMM_RUN8G(g, E);
}
DEVI void ph_down(const Params& P, int l, int bid, int nblk) {
    const GemmD g = mk_gemm((const bf16_t*)(wsp(P) + WS_R1), (const bf16_t*)(wsp(P) + WS_WDT + (size_t)l * kE * kD * kFF), kFF, kFF, 512, 4, nullptr, (size_t)kD * kFF, 32);
    EpiDown E; E.y = (bf16_t*)(wsp(P) + WS_R2); E.sc = 1.f / (kW8 * kH8);
    GEMM_RUN8(g, E);
}
DEVI void ph_combine(const Params& P, int l, int bid, int nblk) { phase_combine((bf16_t*)(wsp(P) + WS_XB), (bf16_t*)(wsp(P) + WS_XB), P.out, (const bf16_t*)(wsp(P) + WS_R2), (const float*)(wsp(P) + WS_GATE), (const int*)(wsp(P) + WS_TSLOT), l + 1 == kL, (float*)(wsp(P) + WS_RSTD), bid, nblk); }

__global__ void __launch_bounds__(kNT, 2) mega_fwd(Params P) {
    asm volatile("s_setreg_imm32_b32 hwreg(HW_REG_MODE, 23, 1), 1");

    volatile LAS unsigned* st = (volatile LAS unsigned*)(dyn_lds + LDS_BYTES - 16);
    if (threadIdx.x == 0) { st[0] = 0u; st[1] = 0u; st[2] = 0u; st[3] = 0u; }
    __syncthreads();
    const XcdBarrier bar = xcd_barrier_post((unsigned*)(P.ws + WS_CTL), st);
    const int bid = blockIdx.x, nblk = gridDim.x;
    unsigned char* lds = dyn_lds;
    phase_convert(P, lds, lnd(bid), nblk);
    ph_s5_prep(P, lds, lnd(bid), nblk);
    router_prep(P, lnd(bid), nblk);
    phase_norm(P.x, (bf16_t*)(wsp(P) + WS_XB), (float*)(wsp(P) + WS_RSTD), lnd(bid), nblk);
    xcd_barrier(bar);
#pragma unroll 1
    for (int l = 0; l < kL; ++l) {
        ph_win(P, l, lnd(bid), nblk);             xcd_barrier(bar);
        ph_s5_state(P, l, lnd(bid), nblk);        xcd_barrier(bar);
        ph_s5_scan(P, l, lds, lnd(bid), nblk);
        ph_dilated(P, l, lnd(bid), nblk);
        ph_na(P, l, lnd(bid), nblk);              xcd_barrier(bar);
        ph_s5_out(P, l, lnd(bid), nblk);          xcd_barrier(bar);
        ph_glu(P, l, lnd(bid), nblk);             xcd_barrier(bar);
        ph_mixnorm(P, l, lnd(bid), nblk);         xcd_barrier(bar);
        ph_wout(P, l, lnd(bid), nblk);            xcd_barrier(bar);
        ph_router(P, l, lds, lnd(bid), nblk);     xcd_barrier(bar);
        ph_topk(P, lds, lnd(bid), nblk);          xcd_barrier(bar);
        ph_gu(P, l, lnd(bid), nblk);              xcd_barrier(bar);
        ph_down(P, l, lnd(bid), nblk);            xcd_barrier(bar);
        ph_combine(P, l, lnd(bid), nblk);         xcd_barrier(bar);
    }
}

extern "C" void kernel_launch(void* const* d_in, const int* in_sizes, int n_in, void* d_out, int out_size, void* d_ws, size_t ws_size, hipStream_t stream) {
    (void)in_sizes; (void)n_in; (void)out_size;
    if (ws_size < WS_END) { fprintf(stderr, "workspace too small: %zu < %zu\n", ws_size, (size_t)WS_END); return; }
    Params P{};
    const float** pp = (const float**)&P;
    for (int i = 0; i < 26; ++i) pp[i] = (const float*)d_in[i];
    P.out = (float*)d_out; P.ws = (unsigned char*)d_ws;
    static int grid = 0;
    if (!grid) {
        int dev = 0, cus = 0, per_cu = 0;
        (void)hipGetDevice(&dev);
        (void)hipDeviceGetAttribute(&cus, hipDeviceAttributeMultiprocessorCount, dev);
        (void)hipFuncSetAttribute((const void*)mega_fwd, hipFuncAttributeMaxDynamicSharedMemorySize, LDS_BYTES);
        (void)hipOccupancyMaxActiveBlocksPerMultiprocessor(&per_cu, (const void*)mega_fwd, kNT, LDS_BYTES);
        grid = (per_cu >= 1) ? cus : 0;
        if (!grid) fprintf(stderr, "mega_fwd does not fit a CU\n");
    }
    if (!grid) return;
    (void)hipMemsetAsync(P.ws + WS_CTL, 0, XCD_BAR_WORDS * sizeof(unsigned), stream);
    mega_fwd<<<grid, kNT, LDS_BYTES, stream>>>(P);
}
```

```cpp
#include <hip/hip_runtime.h>
#include <stdint.h>
#include <stdio.h>

#define DEVI __device__ __forceinline__
#define LAS __attribute__((address_space(3)))
typedef unsigned short bf16_t;
typedef short bf16x8 __attribute__((ext_vector_type(8)));
typedef float f32x4 __attribute__((ext_vector_type(4)));
typedef float f32x2 __attribute__((ext_vector_type(2)));
typedef unsigned u32x4 __attribute__((ext_vector_type(4)));
typedef unsigned u32x2 __attribute__((ext_vector_type(2)));

constexpr int kB = 8, kS = 8192, kD = 1024, kL = 4, kTok = kB * kS;
constexpr int kINW = 2560;
constexpr int kE = 16, kCap = 1024, kFF = 2048;
constexpr int kNT = 512;
constexpr float kEps = 1e-6f;
constexpr float kLog2e = 1.4426950408889634f, kLn2 = 0.6931471805599453f;

constexpr size_t MiB = 1024ull * 1024ull;
constexpr size_t WS_CTL   = 0;
constexpr size_t WS_RSTD  = 512 * 1024;
constexpr size_t WS_WINT  = 1 * MiB;
constexpr size_t WS_WOUTT = WS_WINT + 20 * MiB;
constexpr size_t WS_WGLUT = WS_WOUTT + 8 * MiB;
constexpr size_t WS_RTAB  = WS_WGLUT + 512 * 1024;
constexpr size_t WS_WGUT  = WS_WGLUT + 1 * MiB;
constexpr size_t WS_WDT   = WS_WGUT + 512 * MiB;
constexpr size_t WS_H     = WS_WDT + 256 * MiB;
constexpr size_t WS_R1    = WS_H + 128 * MiB;
constexpr size_t WS_R2    = WS_R1 + 512 * MiB;
constexpr size_t WS_AFF   = WS_R2 + 256 * MiB;
constexpr size_t WS_IDX   = WS_AFF + 4 * MiB;
constexpr size_t WS_GATE  = WS_IDX + 1 * MiB;
constexpr size_t WS_TSLOT = WS_GATE + 1 * MiB;
constexpr size_t WS_LSE   = WS_TSLOT + 4 * MiB;
constexpr size_t WS_WST   = WS_LSE + 8 * MiB;
constexpr size_t WS_WSO   = WS_WST + 8 * MiB;
constexpr size_t WS_XB    = WS_WSO + 16 * MiB;
constexpr size_t WS_END   = WS_XB + 128 * MiB;
constexpr size_t R2_Z     = 192 * MiB;
constexpr size_t R1_QA = 0, R1_KA = 64 * MiB, R1_VA = 128 * MiB, R1_QB = 192 * MiB, R1_KB = 224 * MiB, R1_VB = 256 * MiB,
                 R1_UX = 288 * MiB, R1_OB = 352 * MiB, R1_OC = 384 * MiB, R1_G = 416 * MiB;

struct Params {
    const float* x; const float* attn_norm; const float* w_in; const float* q_norm_a; const float* k_norm_a; const float* q_norm_b; const float* k_norm_b;
    const float* rpb; const float* s5_a_re; const float* s5_a_im; const float* s5_log_dt; const float* s5_b_re; const float* s5_b_im; const float* s5_c_re; const float* s5_c_im;
    const float* s5_d; const float* w_glu; const float* out_norm_a; const float* out_norm_b; const float* out_norm_c; const float* w_out; const float* ffn_norm;
    const float* w_router; const float* w_gate; const float* w_up; const float* w_down;
    float* out; unsigned char* ws;
};

DEVI float bf2f(bf16_t b) { return __uint_as_float(((unsigned)b) << 16); }
DEVI bf16_t f2bf(float f) { unsigned u = __float_as_uint(f); u += 0x7FFFu + ((u >> 16) & 1u); return (bf16_t)(u >> 16); }
typedef __bf16 bf16x2_t __attribute__((ext_vector_type(2)));
DEVI unsigned pk2(float lo, float hi) { const f32x2 v = {lo, hi}; return __builtin_bit_cast(unsigned, __builtin_convertvector(v, bf16x2_t)); }
DEVI int tidx() { int t = threadIdx.x; asm volatile("" : "+v"(t)); return t; }
#define GAS __attribute__((address_space(1)))
DEVI unsigned char* wsp(const Params& P) { unsigned long long a = (unsigned long long)P.ws; asm volatile("" : "+s"(a)); return (unsigned char*)(GAS unsigned char*)a; }
DEVI int lnd(int v) { asm volatile("" : "+s"(v)); return v; }
template <int CTRL> DEVI float dppf(float v) { return __builtin_bit_cast(float, __builtin_amdgcn_update_dpp(0, __builtin_bit_cast(int, v), CTRL, 0xF, 0xF, true)); }
DEVI void swap16(float& a, float& b) { asm volatile("s_nop 1\n\tv_permlane16_swap_b32 %0, %1" : "+v"(a), "+v"(b)); }
DEVI void swap32(float& a, float& b) { asm volatile("s_nop 1\n\tv_permlane32_swap_b32 %0, %1" : "+v"(a), "+v"(b)); }
DEVI void swap16u(unsigned& a, unsigned& b) { asm volatile("s_nop 1\n\tv_permlane16_swap_b32 %0, %1" : "+v"(a), "+v"(b)); }
DEVI float xsum16(float v) { float a = v, b = v; swap16(a, b); return a + b; }
DEVI float xsum32(float v) { float a = v, b = v; swap32(a, b); return a + b; }
DEVI float xmax16(float v) { float a = v, b = v; swap16(a, b); return fmaxf(a, b); }
DEVI float xmax32(float v) { float a = v, b = v; swap32(a, b); return fmaxf(a, b); }
DEVI float row_sum16(float v) {
    v += dppf<0xB1>(v); v += dppf<0x4E>(v);
    v += dppf<0x141>(v); v += dppf<0x140>(v);
    return v;
}
DEVI float wave_sum(float v) { return xsum32(xsum16(row_sum16(v))); }
DEVI void unpk8s(float* d, const u32x4 q) {
    d[0] = __uint_as_float(q.x << 16); d[1] = __uint_as_float(q.x & 0xFFFF0000u); d[2] = __uint_as_float(q.y << 16); d[3] = __uint_as_float(q.y & 0xFFFF0000u);
    d[4] = __uint_as_float(q.z << 16); d[5] = __uint_as_float(q.z & 0xFFFF0000u); d[6] = __uint_as_float(q.w << 16); d[7] = __uint_as_float(q.w & 0xFFFF0000u);
}
DEVI float frcp(float x) { return __builtin_amdgcn_rcpf(x); }
DEVI float gelu_tanh(float y) { const float z = 0.7978845608028654f * (y + 0.044715f * y * y * y); const float t = 1.f - 2.f * frcp(1.f + __expf(2.f * z)); return 0.5f * y * (1.f + t); }

constexpr float kY8 = 32.f;
constexpr float kW8 = 64.f, kH8 = 8.f;
DEVI unsigned pk4_fp8(float a, float b, float c, float d) { unsigned w = 0u; w = __builtin_amdgcn_cvt_pk_fp8_f32(a, b, w, false); w = __builtin_amdgcn_cvt_pk_fp8_f32(c, d, w, true); return w; }
DEVI int cmap_head(int cs) { const int bj = cs >> 7, wc = (cs >> 5) & 3, n = (cs >> 4) & 1, fq = (cs >> 2) & 3, j = cs & 3; return 64 * wc + 32 * bj + 8 * fq + 4 * n + j; }
DEVI int cmap_pk(int cs)   { const int bj = cs >> 7, wc = (cs >> 5) & 3, n = (cs >> 4) & 1, fq = (cs >> 2) & 3, j = cs & 3; return 128 * bj + 32 * wc + 8 * fq + 4 * n + j; }
DEVI int cmap_gu(int cs)   { const int wc = (cs >> 5) & 3, n = (cs >> 4) & 1, fq = (cs >> 2) & 3, j = cs & 3; return 32 * wc + 8 * fq + 4 * n + j; }

template <int MODE>
DEVI void convert_item(const float* W0, const float* W1, int ldw, int K, bf16_t* Bt, int kt, int pn, unsigned char* lds) {
    bf16_t* t = (bf16_t*)lds;
    const int tid = tidx(), cs = tid & 255, kh = tid >> 8;
    int col;
    if (MODE == 0) col = pn * 256 + cs; else if (MODE == 1) col = pn * 256 + cmap_head(cs); else if (MODE == 2) col = pn * 256 + cmap_pk(cs); else col = pn * 128 + cmap_gu(cs);
    const float* src = ((MODE == 3 && (cs >> 7)) ? W1 : W0) + (size_t)(kt * 64 + 32 * kh) * ldw + col;
    float v[32];
#pragma unroll
    for (int i = 0; i < 32; ++i) v[i] = src[(size_t)i * ldw];
    if (MODE == 1) {
#pragma unroll
        for (int i = 0; i < 32; ++i) v[i] *= W1[kt * 64 + 32 * kh + i];
    }
#pragma unroll
    for (int q = 0; q < 4; ++q) { u32x4 w; w.x = pk2(v[8 * q], v[8 * q + 1]); w.y = pk2(v[8 * q + 2], v[8 * q + 3]); w.z = pk2(v[8 * q + 4], v[8 * q + 5]); w.w = pk2(v[8 * q + 6], v[8 * q + 7]);
        *(u32x4*)(t + cs * 72 + 32 * kh + 8 * q) = w; }
    __syncthreads();
#pragma unroll
    for (int it = 0; it < 4; ++it) {
        const int c = it * kNT + tid, row = c >> 3, part = c & 7;
        const u32x4 vv = *(const u32x4*)(t + row * 72 + part * 8);
        *(u32x4*)(Bt + (size_t)(pn * 256 + row) * K + kt * 64 + part * 8) = vv;
    }
    __syncthreads();
}

template <int MODE>
DEVI void convert_item8(const float* W0, const float* W1, int ldw, int K, unsigned char* Bt, int kt, int pn, unsigned char* lds) {
    unsigned char* t = lds;
    const int tid = tidx(), cs = tid & 255, kh = tid >> 8;
    const int col = (MODE == 2) ? pn * 256 + cmap_pk(cs) : pn * 128 + cmap_gu(cs);
    const float* src = ((MODE == 3 && (cs >> 7)) ? W1 : W0) + (size_t)(kt * 128 + 64 * kh) * ldw + col;
    float v[64];
#pragma unroll
    for (int i = 0; i < 64; ++i) v[i] = src[(size_t)i * ldw];
#pragma unroll
    for (int q = 0; q < 4; ++q) { u32x4 w;
        w.x = pk4_fp8(v[16 * q] * kW8, v[16 * q + 1] * kW8, v[16 * q + 2] * kW8, v[16 * q + 3] * kW8); w.y = pk4_fp8(v[16 * q + 4] * kW8, v[16 * q + 5] * kW8, v[16 * q + 6] * kW8, v[16 * q + 7] * kW8);
        w.z = pk4_fp8(v[16 * q + 8] * kW8, v[16 * q + 9] * kW8, v[16 * q + 10] * kW8, v[16 * q + 11] * kW8); w.w = pk4_fp8(v[16 * q + 12] * kW8, v[16 * q + 13] * kW8, v[16 * q + 14] * kW8, v[16 * q + 15] * kW8);
        *(u32x4*)(t + cs * 144 + 64 * kh + 16 * q) = w; }
    __syncthreads();
#pragma unroll
    for (int it = 0; it < 4; ++it) {
        const int c = it * kNT + tid, row = c >> 3, part = c & 7;
        const u32x4 vv = *(const u32x4*)(t + row * 144 + part * 16);
        *(u32x4*)(Bt + (size_t)(pn * 256 + row) * K + kt * 128 + part * 16) = vv;
    }
    __syncthreads();
}

DEVI void phase_convert(const Params& P, unsigned char* lds, int bid, int nblk) {
    constexpr int N_WIN = kL * 16 * 10, N_WOUT = kL * 16 * 4, N_WGLU = kL * 4 * 1, N_WGU = kL * kE * 8 * 16, N_WD = kL * kE * 16 * 4;
    constexpr int TOT = N_WIN + N_WOUT + N_WGLU + N_WGU + N_WD;
    for (int it = bid; it < TOT; it += nblk) {
        int i = it;
        if (i < N_WIN) { const int l = i / 160, r = i % 160, kt = r / 10, pn = r % 10;
            convert_item<1>(P.w_in + (size_t)l * kD * kINW, P.attn_norm + (size_t)l * kD, kINW, kD, (bf16_t*)(wsp(P) + WS_WINT) + (size_t)l * kINW * kD, kt, pn, lds); continue; }
        i -= N_WIN;
        if (i < N_WOUT) { const int l = i / 64, r = i % 64, kt = r / 4, pn = r % 4;
            convert_item<2>(P.w_out + (size_t)l * kD * kD, nullptr, kD, kD, (bf16_t*)(wsp(P) + WS_WOUTT) + (size_t)l * kD * kD, kt, pn, lds); continue; }
        i -= N_WOUT;
        if (i < N_WGLU) { const int l = i / 4, kt = i % 4;
            convert_item<2>(P.w_glu + (size_t)l * 256 * 256, nullptr, 256, 256, (bf16_t*)(wsp(P) + WS_WGLUT) + (size_t)l * 256 * 256, kt, 0, lds); continue; }
        i -= N_WGLU;
        if (i < N_WGU) { const int le = i / 128, r = i % 128, kt = r / 16, pn = r % 16;
            convert_item8<3>(P.w_gate + (size_t)le * kD * kFF, P.w_up + (size_t)le * kD * kFF, kFF, kD, wsp(P) + WS_WGUT + (size_t)le * 4096 * kD, kt, pn, lds); continue; }
        i -= N_WGU;
        { const int le = i / 64, r = i % 64, kt = r / 4, pn = r % 4;
            convert_item8<2>(P.w_down + (size_t)le * kFF * kD, nullptr, kD, kFF, wsp(P) + WS_WDT + (size_t)le * kD * kFF, kt, pn, lds); }
    }
}

DEVI void phase_norm(const float* x, bf16_t* xb, float* rstdp, int bid, int nblk) {
    const int wid = tidx() >> 6, lane = tidx() & 63;
    for (int row = bid * 8 + wid; row < kTok; row += nblk * 8) {
        f32x4 v[4]; float ss = 0.f;
#pragma unroll
        for (int q = 0; q < 4; ++q) { v[q] = *(const f32x4*)(x + (size_t)row * kD + q * 256 + lane * 4); ss += v[q].x * v[q].x + v[q].y * v[q].y + v[q].z * v[q].z + v[q].w * v[q].w; }
        ss = wave_sum(ss);
        if (lane == 0) rstdp[row] = rsqrtf(ss * (1.f / kD) + kEps);
#pragma unroll
        for (int q = 0; q < 4; ++q) { const f32x4 t = v[q];
            u32x2 o; o.x = pk2(t.x, t.y); o.y = pk2(t.z, t.w);
            *(u32x2*)(xb + (size_t)row * kD + q * 256 + lane * 4) = o; }
    }
}

DEVI void router_prep(const Params& P, int bid, int nblk) {
    unsigned char* tbase = wsp(P) + WS_RTAB;
    for (int i = bid * kNT + tidx(); i < kL * 2048; i += nblk * kNT) {
        const int L = i >> 11, s = (i >> 6) & 31, l = i & 63, e = l & 15, k0 = 64 * (s >> 1) + 16 * (l >> 4) + 8 * (s & 1);
        const float* wr = P.w_router + (size_t)L * kD * kE; const float* gain = P.ffn_norm + (size_t)L * kD;
        unsigned hh[4], ll[4];
#pragma unroll
        for (int j = 0; j < 4; ++j) { const float w0 = wr[(k0 + 2 * j) * 16 + e] * gain[k0 + 2 * j], w1 = wr[(k0 + 2 * j + 1) * 16 + e] * gain[k0 + 2 * j + 1];
            const unsigned hp = pk2(w0, w1); hh[j] = hp; ll[j] = pk2(w0 - __uint_as_float(hp << 16), w1 - __uint_as_float(hp & 0xFFFF0000u)); }
        u32x4 hi, lo; hi.x = hh[0]; hi.y = hh[1]; hi.z = hh[2]; hi.w = hh[3]; lo.x = ll[0]; lo.y = ll[1]; lo.z = ll[2]; lo.w = ll[3];
        unsigned char* tb = tbase + (size_t)L * 65536;
        *(u32x4*)(tb + (2 * s) * 1024 + l * 16) = hi; *(u32x4*)(tb + (2 * s + 1) * 1024 + l * 16) = lo;
    }
}
DEVI void phase_router(const bf16_t* x, const float* gain, const unsigned char* rtab  , unsigned char* h8, float* aff, LAS unsigned char* lds, int bid, int nblk) {
    LAS unsigned char* wtab = lds;
    LAS float* gtab = (LAS float*)(lds + 65536);
    const int tid = tidx(), wid = __builtin_amdgcn_readfirstlane(tid >> 6), lane = tid & 63, r = lane & 15, c4 = lane >> 4;
    __syncthreads();
    for (int i = tid; i < 1024; i += kNT) gtab[i] = gain[i];
#pragma unroll
    for (int i = 0; i < 8; ++i)
        __builtin_amdgcn_global_load_lds((const unsigned*)(rtab + (size_t)(i * kNT + tid) * 16), (LAS unsigned*)(wtab + (i * 8 + wid) * 1024), 16, 0, 0);
    asm volatile("s_waitcnt vmcnt(0)" ::: "memory");
    __syncthreads();
    u32x4 xr[32];
    const int ntile = kTok / 16, tstride = nblk * 8;
    int tile = bid * 8 + wid;
#define RT_ISSUE(half, tile_) do { const bf16_t* xp_ = x + (size_t)((tile_) * 16 + r) * kD + 16 * c4; \
        _Pragma("unroll") for (int u = 8 * (half); u < 8 * (half) + 8; ++u) { xr[2 * u] = *(const u32x4*)(xp_ + 64 * u); xr[2 * u + 1] = *(const u32x4*)(xp_ + 64 * u + 8); } } while (0)
    if (tile < ntile) { RT_ISSUE(0, tile); RT_ISSUE(1, tile); }
    for (; tile < ntile; tile += tstride) {
        asm volatile("" ::: "memory");
        f32x4 Lh = {0.f, 0.f, 0.f, 0.f}, Ll = {0.f, 0.f, 0.f, 0.f}, G = {0.f, 0.f, 0.f, 0.f};
#pragma unroll
        for (int s = 0; s < 32; ++s) {
            const bf16x8 wh = *(const LAS bf16x8*)(wtab + (2 * s) * 1024 + lane * 16), wl = *(const LAS bf16x8*)(wtab + (2 * s + 1) * 1024 + lane * 16);
            const bf16x8 xb = __builtin_bit_cast(bf16x8, xr[s]);
            Lh = __builtin_amdgcn_mfma_f32_16x16x32_bf16(wh, xb, Lh, 0, 0, 0);
            Ll = __builtin_amdgcn_mfma_f32_16x16x32_bf16(wl, xb, Ll, 0, 0, 0);
            G = __builtin_amdgcn_mfma_f32_16x16x32_bf16(xb, xb, G, 0, 0, 0);
        }
        const float dsel = ((r & 3) == 0) ? G.x : ((r & 3) == 1) ? G.y : ((r & 3) == 2) ? G.z : G.w;
        const float ss = __builtin_bit_cast(float, __builtin_amdgcn_ds_bpermute((16 * (r >> 2) + r) * 4, __builtin_bit_cast(int, dsel)));
        const float rstd = rsqrtf(ss * (1.f / kD) + kEps);
        const f32x4 lg = (Lh + Ll) * rstd;
        float mx = fmaxf(fmaxf(lg.x, lg.y), fmaxf(lg.z, lg.w)); mx = xmax32(xmax16(mx));
        f32x4 ex; ex.x = __expf(lg.x - mx); ex.y = __expf(lg.y - mx); ex.z = __expf(lg.z - mx); ex.w = __expf(lg.w - mx);
        float sm = (ex.x + ex.y) + (ex.z + ex.w); sm = xsum32(xsum16(sm));
        const float inv = frcp(sm);
        const int row0 = tile * 16, b = row0 >> 13, s0 = (row0 & (kS - 1)) + r;
        { float* ap = aff + ((size_t)(b * kE + 4 * c4)) * kS + s0;
          ap[0] = ex.x * inv; ap[kS] = ex.y * inv; ap[2 * kS] = ex.z * inv; ap[3 * kS] = ex.w * inv; }
        unsigned char* hp = h8 + (size_t)(row0 + r) * kD + 16 * c4;
        const int ntl = tile + tstride;
#pragma unroll
        for (int half = 0; half < 2; ++half) {
#pragma unroll
            for (int u = 8 * half; u < 8 * half + 8; ++u) {
                float v[16]; unpk8s(v, xr[2 * u]); unpk8s(v + 8, xr[2 * u + 1]);
                u32x4 o; unsigned ow[4];
#pragma unroll
                for (int q = 0; q < 4; ++q) { const f32x4 gq = *(const LAS f32x4*)(gtab + 64 * u + 16 * c4 + 4 * q);
                    const f32x4 t = (f32x4){v[4 * q], v[4 * q + 1], v[4 * q + 2], v[4 * q + 3]} * gq * rstd;
                    ow[q] = pk4_fp8(t.x, t.y, t.z, t.w); }
                o.x = ow[0]; o.y = ow[1]; o.z = ow[2]; o.w = ow[3];
                *(u32x4*)(hp + 64 * u) = o;
            }
            if (ntl < ntile) { if (half == 0) RT_ISSUE(0, ntl); else RT_ISSUE(1, ntl); }
        }
    }
#undef RT_ISSUE
    __syncthreads();
}

DEVI int block_excl_scan(int v, int* sh  , int& total) {
    const int lane = tidx() & 63, wid = tidx() >> 6;
    int incl = v;
#pragma unroll
    for (int d = 1; d < 64; d <<= 1) { const int o = __shfl_up(incl, d); if (lane >= d) incl += o; }
    __syncthreads();
    if (lane == 63) sh[wid] = incl;
    __syncthreads();
    int base = 0, tot = 0;
#pragma unroll
    for (int w = 0; w < 8; ++w) { const int c = sh[w]; if (w < wid) base += c; tot += c; }
    total = tot;
    return base + incl - v;
}

DEVI void phase_topk(const float* aff, int* idx, float* gate, int* tokslot, const unsigned char* hsrc, unsigned char* xe, int rowbytes, unsigned char* lds, int bid, int nblk) {
    int* hist = (int*)lds;
    int* sh = hist + 256;
    int* res = sh + 16;
    (void)hsrc; (void)xe; (void)rowbytes;
    const int tid = tidx(), lane = tid & 63, wid = tid >> 6;
    const int share = (nblk >= 2 * kB * kE) ? 2 : 1;
    for (int wi = bid; wi < kB * kE * share; wi += nblk) {
        const int item = wi / share, part = wi - item * share;
        const int b = item >> 4, e = item & 15;
        const float* a = aff + (size_t)item * kS;
        unsigned key[16];
#pragma unroll
        for (int q = 0; q < 4; ++q) { const u32x4 v = *(const u32x4*)(a + tid * 16 + q * 4); key[q * 4 + 0] = v.x; key[q * 4 + 1] = v.y; key[q * 4 + 2] = v.z; key[q * 4 + 3] = v.w; }
        unsigned prefix = 0; int kk = kCap;
#pragma unroll 1
        for (int pass = 0; pass < 4; ++pass) {
            const int shift = 24 - 8 * pass;
            __syncthreads();
            if (tid < 256) hist[tid] = 0;
            __syncthreads();
#pragma unroll
            for (int i = 0; i < 16; ++i) { const bool in = (pass == 0) || ((key[i] >> (shift + 8)) == prefix); if (in) atomicAdd(&hist[(key[i] >> shift) & 255], 1); }
            __syncthreads();
            if (wid == 0) {
                int c[4], loc = 0;
#pragma unroll
                for (int j = 0; j < 4; ++j) { c[j] = hist[255 - 4 * lane - j]; loc += c[j]; }
                int incl = loc;
#pragma unroll
                for (int d = 1; d < 64; d <<= 1) { const int o = __shfl_up(incl, d); if (lane >= d) incl += o; }
                const int excl = incl - loc;
                if (excl < kk && kk <= incl) { int run = excl; int bin = 0, nk = 0; bool found = false;
#pragma unroll
                    for (int j = 0; j < 4; ++j) { if (!found && run + c[j] >= kk) { bin = 255 - 4 * lane - j; nk = kk - run; found = true; } if (!found) run += c[j]; }
                    res[0] = bin; res[1] = nk; }
            }
            __syncthreads();
            prefix = (prefix << 8) | (unsigned)res[0]; kk = res[1];
        }
        const unsigned T = prefix;
        int ceq = 0;
#pragma unroll
        for (int i = 0; i < 16; ++i) ceq += (key[i] == T) ? 1 : 0;
        int tot;
        int eqb = block_excl_scan(ceq, sh, tot);
        int csel = 0; unsigned selmask = 0;
#pragma unroll
        for (int i = 0; i < 16; ++i) { bool s = key[i] > T; if (key[i] == T) { s = eqb < kk; ++eqb; } if (s) { selmask |= 1u << i; ++csel; } }
        int slot = block_excl_scan(csel, sh, tot);
        const size_t rbase = (size_t)(e * kB + b) * kCap;
#pragma unroll
        for (int i = 0; i < 16; ++i) { const int s = tid * 16 + i; const bool sel = (selmask >> i) & 1u;
            const bool mine = (share == 1) || ((i >> 3) == part);
            if (sel && mine) { idx[rbase + slot] = b * kS + s; gate[rbase + slot] = __uint_as_float(key[i]) * (1.f / kY8)  ; }
            if (mine) tokslot[((size_t)(b * kS + s)) * kE + e] = sel ? slot : -1;
            if (sel) ++slot; }
    }
    __syncthreads();
}

struct Unit { int pm, pn, par; };
DEVI bool unit_of(int Lid, int nM, int nN, Unit& u) {
    const int nwg = nM * nN; if (Lid >= nwg) return false;
    int wgid = Lid; { const int q = nwg / 8, r = nwg % 8, xcd = wgid % 8, off = wgid / 8; wgid = (xcd < r ? xcd * (q + 1) : r * (q + 1) + (xcd - r) * q) + off; }
    const int nig = 8 * nN, gid = wgid / nig, fm = gid * 8, gsz = (nM - fm) < 8 ? (nM - fm) : 8;
    u.pm = fm + ((wgid % nig) % gsz); u.pn = (wgid % nig) / gsz; return true;
}
struct GemmD { const bf16_t* A; const bf16_t* Bt; int lda, K, nM, nN; const int* rowidx; size_t bstride; int pmg; };

constexpr int PG_HTB = 128 * 64 * 2;
DEVI int pg_lds_byte(int r, int c) { const int st = (r >> 4) * 2 + (c >> 5), rr = r & 15, cc = c & 31, ob = rr * 64 + cc * 2; return st * 1024 + (ob ^ (((ob >> 9) & 1) << 5)); }
DEVI void pg_stage_rc(int b, int& R, int& C) { const int st = b / 1024, sb = b % 1024, swz = sb ^ (((sb >> 9) & 1) << 5); R = (st >> 1) * 16 + swz / 64; C = (st & 1) * 32 + (swz % 64) / 2; }

typedef int v4i __attribute__((ext_vector_type(4)));
typedef int v8i __attribute__((ext_vector_type(8)));
constexpr int PG_RIDX = 131072 + 4096;
template <class Epi, bool ALIGN_EPI, bool SP2, bool FP8 = false, bool GATHER = false>
DEVI void gemm_engine(LAS unsigned char* lds, const GemmD g, const Epi& E, int bid, int nblk) {
    const int tid = tidx(), wid = __builtin_amdgcn_readfirstlane(tid >> 6), lane = tid & 63, wr = wid >> 2, wc = wid & 3, fr = lane & 15, fq = lane >> 4;
    constexpr int ES = FP8 ? 1 : 2;
    const int K = g.K * ES  , nt = K / 128; const unsigned ldaB = (unsigned)g.lda * ES;
    unsigned voffA[2], voffB[2];
#pragma unroll
    for (int i = 0; i < 2; ++i) { int R, C; pg_stage_rc(tid * 16 + i * 8192, R, C); voffA[i] = (unsigned)R * ldaB + (unsigned)C * 2u; voffB[i] = (unsigned)(R * K + C * 2); }
    const size_t kstep = 128;
    int gR0 = 0; unsigned gcb = 0; { int R, C; pg_stage_rc(tid * 16, R, C); gR0 = R; gcb = (unsigned)C * 2u; } (void)gR0; (void)gcb;
    const size_t hstepB = (size_t)128 * K, hstepA = (size_t)128 * ldaB, tstepA = 2 * hstepA;
    const unsigned ldsw = (unsigned)wid * 1024u;
    const int aoff = pg_lds_byte(wr * 64 + fr, fq * 8), boff = pg_lds_byte(wc * 32 + fr, fq * 8);
#define PG8_SA(b, h) (((b) * 2 + (h)) * PG_HTB)
#define PG8_SB(b, h) ((4 + (b) * 2 + (h)) * PG_HTB)
#define PG8_STAGE(bufoff, gbase, voff) do { _Pragma("unroll") for (int _i = 0; _i < 2; ++_i) \
        __builtin_amdgcn_global_load_lds((const unsigned*)((const char*)(gbase) + (voff)[_i]), (LAS unsigned*)(lds + (bufoff) + ldsw + _i * 8192), 16, 0, 0); } while (0)
#define PG8_STA(bufoff, ptr, koff, half, par) do { if constexpr (GATHER) { \
        const LAS int* rt_ = (const LAS int*)(lds + PG_RIDX + (par) * 1024) + 128 * (half) + gR0; \
        _Pragma("unroll") for (int _i = 0; _i < 2; ++_i) { const unsigned off_ = (unsigned)rt_[64 * _i] * ldaB + gcb; \
            __builtin_amdgcn_global_load_lds((const unsigned*)((const char*)g.A + (koff) + off_), (LAS unsigned*)(lds + (bufoff) + ldsw + _i * 8192), 16, 0, 0); } \
    } else PG8_STAGE(bufoff, ptr, voffA); } while (0)
#define PG8_RD16(off) (*(const LAS v4i*)(lds + (off)))
#define PG8_CAT2(off) __builtin_shufflevector(PG8_RD16(off), PG8_RD16((off) + 1024), 0, 1, 2, 3, 4, 5, 6, 7)
#define PG8_LDA(dst, b, h) do { _Pragma("unroll") for (int m = 0; m < 4; ++m) { if constexpr (FP8) dst##8[m] = PG8_CAT2(PG8_SA(b, h) + aoff + m * 2048); \
        else { _Pragma("unroll") for (int k = 0; k < 2; ++k) dst[m][k] = *(const LAS bf16x8*)(lds + PG8_SA(b, h) + aoff + m * 2048 + k * 1024); } } } while (0)
#define PG8_LDB(dst, b, h) do { _Pragma("unroll") for (int n = 0; n < 2; ++n) { if constexpr (FP8) dst##8[n] = PG8_CAT2(PG8_SB(b, h) + boff + n * 2048); \
        else { _Pragma("unroll") for (int k = 0; k < 2; ++k) dst[n][k] = *(const LAS bf16x8*)(lds + PG8_SB(b, h) + boff + n * 2048 + k * 1024); } } } while (0)
#define PG8_MMA(ai, bj, At, Bt) do { __builtin_amdgcn_s_setprio(1); _Pragma("unroll") for (int m = 0; m < 4; ++m) _Pragma("unroll") for (int n = 0; n < 2; ++n) { \
        if constexpr (FP8) asm volatile("v_mfma_f32_16x16x128_f8f6f4 %0, %1, %2, %0" : "+v"(acc[ai][bj][m][n]) : "v"(Bt##8[n]), "v"(At##8[m]));   \
        else { _Pragma("unroll") for (int k = 0; k < 2; ++k) acc[ai][bj][m][n] = __builtin_amdgcn_mfma_f32_16x16x32_bf16(Bt[n][k], At[m][k], acc[ai][bj][m][n], 0, 0, 0); } } \
        __builtin_amdgcn_s_setprio(0); } while (0)
#define PG8_MMAZ(ai, bj, At, Bt) do { __builtin_amdgcn_s_setprio(1); _Pragma("unroll") for (int m = 0; m < 4; ++m) _Pragma("unroll") for (int n = 0; n < 2; ++n) { \
        if constexpr (FP8) asm volatile("v_mfma_f32_16x16x128_f8f6f4 %0, %1, %2, 0" : "=&v"(acc[ai][bj][m][n]) : "v"(Bt##8[n]), "v"(At##8[m])); \
        else { asm volatile("v_mfma_f32_16x16x32_bf16 %0, %1, %2, 0" : "=&v"(acc[ai][bj][m][n]) : "v"(Bt[n][0]), "v"(At[m][0])); \
               acc[ai][bj][m][n] = __builtin_amdgcn_mfma_f32_16x16x32_bf16(Bt[n][1], At[m][1], acc[ai][bj][m][n], 0, 0, 0); } } \
        __builtin_amdgcn_s_setprio(0); } while (0)
#define PG8_WAIT_V(n) asm volatile("s_waitcnt vmcnt(" #n ")" ::: "memory")
#define PG8_WAIT_L(n) asm volatile("s_waitcnt lgkmcnt(" #n ")" ::: "memory")
#define PG8_BAR __builtin_amdgcn_s_barrier()
#define PG8_SCHED __builtin_amdgcn_sched_barrier(0)
    Unit cur, nxt; int ui = 0;
    if (!unit_of(bid, g.nM, g.nN, cur)) return;
    cur.par = 0; E.stage(lds, cur, wid, lane);
    if constexpr (GATHER) {
        if (wid < 4) __builtin_amdgcn_global_load_lds((const unsigned*)(g.rowidx + cur.pm * 256 + wid * 64 + lane), (LAS unsigned*)(lds + PG_RIDX + wid * 256), 4, 0, 0);
        asm volatile("s_waitcnt vmcnt(0)" ::: "memory"); __builtin_amdgcn_s_barrier();
    }
    f32x4 acc[2][2][4][2];
    if constexpr (!FP8) {
#pragma unroll
    for (int a = 0; a < 2; ++a)
#pragma unroll
        for (int b = 0; b < 2; ++b)
#pragma unroll
            for (int m = 0; m < 4; ++m)
#pragma unroll
                for (int n = 0; n < 2; ++n) acc[a][b][m][n] = (f32x4){0.f, 0.f, 0.f, 0.f};
    }
    bf16x8 At[4][2], B0[2][2], B1[2][2]; v8i At8[4], B08[2], B18[2];
    (void)At; (void)B0; (void)B1; (void)At8; (void)B08; (void)B18;
    static_assert(SP2, "only the two-super-phase K-loop is kept");
    const char* cA = (const char*)g.A + (size_t)cur.pm * tstepA;
    const char* cB = (const char*)g.Bt + (size_t)(cur.pm / g.pmg) * g.bstride * ES + (size_t)cur.pn * 256 * K;
    PG8_STAGE(PG8_SB(0, 0), cB, voffB); PG8_STAGE(PG8_SB(0, 1), cB + hstepB, voffB); PG8_STA(PG8_SA(0, 0), cA, 0u, 0, 0); PG8_STA(PG8_SA(0, 1), cA + hstepA, 0u, 1, 0);
    if (wr == 1) PG8_BAR;
    PG8_WAIT_V(2); PG8_BAR;
    PG8_STAGE(PG8_SB(1, 0), cB + kstep, voffB); PG8_STA(PG8_SA(1, 0), cA + kstep, 128u, 0, 0); PG8_STAGE(PG8_SB(1, 1), cB + hstepB + kstep, voffB);
    PG8_WAIT_V(6); PG8_BAR;
    for (;;) {
        const bool has_next = unit_of((ui + 1) * nblk + bid, g.nM, g.nN, nxt); nxt.par = (ui + 1) & 1;
        if constexpr (GATHER) { if (has_next && wid < 4) __builtin_amdgcn_global_load_lds((const unsigned*)(g.rowidx + nxt.pm * 256 + wid * 64 + lane), (LAS unsigned*)(lds + PG_RIDX + nxt.par * 1024 + wid * 256), 4, 0, 0); }
        const char* nA = has_next ? (const char*)g.A + (size_t)nxt.pm * tstepA : cA;
        const char* nB = has_next ? (const char*)g.Bt + (size_t)(nxt.pm / g.pmg) * g.bstride * ES + (size_t)nxt.pn * 256 * K : cB;
#define PG8_TRIP(MM) do { \
            const bool last = (t == nt - 2); \
            const char* a1 = cA + (size_t)(t + 1) * kstep; \
            const char* a2 = last ? nA : cA + (size_t)(t + 2) * kstep; const char* b2 = last ? nB : cB + (size_t)(t + 2) * kstep; \
            const char* a3 = a2 + kstep; const char* b3 = b2 + kstep; \
            const unsigned gk1 = (unsigned)(t + 1) * 128u, gk2 = last ? 0u : (unsigned)(t + 2) * 128u, gk3 = gk2 + 128u; const int gp2 = (last && has_next) ? nxt.par : cur.par; (void)gk1; (void)gk2; (void)gk3; (void)gp2; \
            PG8_LDB(B0, 0, 0); PG8_LDB(B1, 0, 1); PG8_SCHED; PG8_LDA(At, 0, 0); PG8_STA(PG8_SA(1, 1), a1 + hstepA, gk1, 1, cur.par); \
            PG8_WAIT_V(8); PG8_WAIT_L(0); PG8_BAR; MM(0, 0, At, B0); MM(0, 1, At, B1); PG8_BAR; PG8_SCHED; \
            PG8_LDA(At, 0, 1); PG8_STAGE(PG8_SB(0, 0), b2, voffB); PG8_STAGE(PG8_SB(0, 1), b2 + hstepB, voffB); PG8_STA(PG8_SA(0, 0), a2, gk2, 0, gp2); \
            PG8_WAIT_V(8); PG8_WAIT_L(0); PG8_BAR; MM(1, 0, At, B0); MM(1, 1, At, B1); PG8_BAR; PG8_SCHED; \
            PG8_LDB(B0, 1, 0); PG8_LDB(B1, 1, 1); PG8_SCHED; PG8_LDA(At, 1, 0); PG8_STA(PG8_SA(0, 1), a2 + hstepA, gk2, 1, gp2); \
            PG8_WAIT_V(8); PG8_WAIT_L(0); PG8_BAR; PG8_MMA(0, 0, At, B0); PG8_MMA(0, 1, At, B1); PG8_BAR; PG8_SCHED; \
            PG8_LDA(At, 1, 1); PG8_STAGE(PG8_SB(1, 0), b3, voffB); PG8_STAGE(PG8_SB(1, 1), b3 + hstepB, voffB); PG8_STA(PG8_SA(1, 0), a3, gk3, 0, gp2); \
            PG8_WAIT_V(8); PG8_WAIT_L(0); PG8_BAR; PG8_MMA(1, 0, At, B0); PG8_MMA(1, 1, At, B1); PG8_BAR; PG8_SCHED; } while (0)
        int t = 0;
        if constexpr (FP8) { PG8_TRIP(PG8_MMAZ); t = 2; }
#pragma unroll 1
        for (; t < nt; t += 2) PG8_TRIP(PG8_MMA);
#undef PG8_TRIP
        if constexpr (ALIGN_EPI) { if (wr == 0) PG8_BAR; }
        if constexpr (FP8) asm volatile("s_nop 15\n\ts_nop 15" ::: "memory");
        E(acc, cur, wr, wc, fr, fq);
        if (!has_next) break;
        E.stage(lds, nxt, wid, lane);
        if constexpr (!FP8) {
#pragma unroll
        for (int a = 0; a < 2; ++a)
#pragma unroll
            for (int b = 0; b < 2; ++b)
#pragma unroll
                for (int m = 0; m < 4; ++m)
#pragma unroll
                    for (int n = 0; n < 2; ++n) acc[a][b][m][n] = (f32x4){0.f, 0.f, 0.f, 0.f};
        }
        cur = nxt; cA = nA; cB = nB; ++ui;
        if constexpr (ALIGN_EPI) { if (wr == 1) PG8_BAR; }
    }
    PG8_WAIT_V(0);
    if constexpr (!ALIGN_EPI) { if (wr == 0) PG8_BAR; }
    PG8_BAR;
#undef PG8_SA
#undef PG8_SB
#undef PG8_STAGE
#undef PG8_STA
#undef PG8_LDA
#undef PG8_LDB
#undef PG8_MMA
#undef PG8_MMAZ
#undef PG8_RD16
#undef PG8_CAT2
#undef PG8_WAIT_V
#undef PG8_WAIT_L
#undef PG8_BAR
#undef PG8_SCHED
}

struct EpiQKV {
    static constexpr int VMOPS = 16;
    bf16_t *qa, *ka, *va, *qb, *kb, *vb, *ux;
    const float* rstdp;
    const LAS float* rtab;
    DEVI void stage(LAS unsigned char* lds, const Unit& u, int wid, int lane) const {
        if (wid < 4) __builtin_amdgcn_global_load_lds((const unsigned*)(rstdp + u.pm * 256 + wid * 64 + lane), (LAS unsigned*)(lds + 131072 + 2048 + u.par * 1024 + wid * 256), 4, 0, 0);
    }
    const LAS float* gtab;
    DEVI void operator()(const f32x4 (&acc)[2][2][4][2], const Unit& u, int wr, int wc, int fr, int fq) const {
        const int pn = u.pn;
        bf16_t* dst = (pn < 2) ? qa : (pn < 4) ? ka : (pn < 6) ? va : (pn == 6) ? qb : (pn == 7) ? kb : (pn == 8) ? vb : ux;
        const int H = (pn < 6) ? 8 : 4, head = ((pn < 6) ? (pn & 1) * 4 : 0) + wc;
        const int trow = (pn < 2) ? 0 : (pn < 4) ? 1 : (pn == 6) ? 2 : (pn == 7) ? 3 : 4;
        const bool nrm = trow < 4;
        f32x4 gv[2][2];
#pragma unroll
        for (int bj = 0; bj < 2; ++bj)
#pragma unroll
            for (int n = 0; n < 2; ++n) gv[bj][n] = *(const LAS f32x4*)(gtab + trow * 64 + 32 * bj + 8 * fq + 4 * n);
        const size_t hb = (size_t)head * kS * 64 + 8 * fq;
        const int g0 = 4 * wc + (fq >> 1), c0 = 8 * (fq & 1);
#pragma unroll
        for (int ai = 0; ai < 2; ++ai)
#pragma unroll
            for (int m = 0; m < 4; ++m) {
                const int row = u.pm * 256 + 128 * ai + 64 * wr + 16 * m + fr;
                float ss = 0.f;
#pragma unroll
                for (int bj = 0; bj < 2; ++bj)
#pragma unroll
                    for (int n = 0; n < 2; ++n) { const f32x4 v = acc[ai][bj][m][n]; ss += v.x * v.x + v.y * v.y + v.z * v.z + v.w * v.w; }
                ss = xsum32(xsum16(ss));
                const float rr = rtab[u.par * 256 + 128 * ai + 64 * wr + 16 * m + fr];
                const float rs = __builtin_amdgcn_rsqf(ss * rr * rr * (1.f / 64.f) + kEps) * rr, rstd = nrm ? rs : rr;
                const int b = row >> 13, sq = row & (kS - 1);
                const size_t o_qkv = ((size_t)b * H * kS + sq) * 64 + hb, o_u = ((size_t)g0 * 4096 + (row >> 4)) * 512 + (row & 15) * 16 + c0;
#pragma unroll
                for (int bj = 0; bj < 2; ++bj) {
                    const f32x4 v0 = acc[ai][bj][m][0] * rstd * gv[bj][0], v1 = acc[ai][bj][m][1] * rstd * gv[bj][1];
                    u32x4 w; w.x = pk2(v0.x, v0.y); w.y = pk2(v0.z, v0.w); w.z = pk2(v1.x, v1.y); w.w = pk2(v1.z, v1.w);
                    const size_t o = (pn < 9) ? o_qkv + 32 * bj : o_u + (size_t)bj * 2 * 4096 * 512;
                    *(u32x4*)(dst + o) = w;
                }
            }
    }
};
struct EpiResid {
    DEVI void stage(LAS unsigned char*, const Unit&, int, int) const {}
    static constexpr int VMOPS = 16;
    bf16_t* xb; bf16_t* xbo;
    DEVI void operator()(const f32x4 (&acc)[2][2][4][2], const Unit& u, int wr, int wc, int fr, int fq) const {
#pragma unroll
        for (int ai = 0; ai < 2; ++ai) {
            const size_t r0 = (size_t)(u.pm * 256 + 128 * ai + 64 * wr + fr) * kD + u.pn * 256 + 32 * wc + 8 * fq;
            {
                u32x4 a[4][2];
#pragma unroll
                for (int m = 0; m < 4; ++m)
#pragma unroll
                    for (int bj = 0; bj < 2; ++bj) a[m][bj] = *(const u32x4*)(xb + r0 + (size_t)m * 16 * kD + 128 * bj);
#pragma unroll
                for (int m = 0; m < 4; ++m)
#pragma unroll
                    for (int bj = 0; bj < 2; ++bj) { const size_t o = r0 + (size_t)m * 16 * kD + 128 * bj; const u32x4 w = a[m][bj];
                        const f32x4 v0 = (f32x4){__uint_as_float(w.x << 16), __uint_as_float(w.x & 0xFFFF0000u), __uint_as_float(w.y << 16), __uint_as_float(w.y & 0xFFFF0000u)} + acc[ai][bj][m][0];
                        const f32x4 v1 = (f32x4){__uint_as_float(w.z << 16), __uint_as_float(w.z & 0xFFFF0000u), __uint_as_float(w.w << 16), __uint_as_float(w.w & 0xFFFF0000u)} + acc[ai][bj][m][1];
                        u32x4 r; r.x = pk2(v0.x, v0.y); r.y = pk2(v0.z, v0.w); r.z = pk2(v1.x, v1.y); r.w = pk2(v1.z, v1.w); *(u32x4*)(xbo + o) = r; }
            }
        }
    }
};
struct EpiGU {
    DEVI void stage(LAS unsigned char*, const Unit&, int, int) const {}
    static constexpr int VMOPS = 4;
    bf16_t* hid; float sc;
    DEVI void silu8(const f32x4 (&acc)[2][2][4][2], int ai, int m, float (&o)[8]) const {
        const float k1 = -sc * kLog2e, k3 = 1.f / (sc * sc * kH8);
#pragma unroll
        for (int n = 0; n < 2; ++n)
#pragma unroll
            for (int j = 0; j < 4; j += 2) { const f32x2 a = {acc[ai][0][m][n][j], acc[ai][0][m][n][j + 1]}, b = {acc[ai][1][m][n][j], acc[ai][1][m][n][j + 1]};
                const f32x2 ab = a * b, t = a * k1; f32x2 d; d.x = __builtin_amdgcn_exp2f(t.x); d.y = __builtin_amdgcn_exp2f(t.y); d = d * k3 + k3;
                f32x2 r; r.x = frcp(d.x); r.y = frcp(d.y); const f32x2 v = ab * r;
                o[n * 4 + j] = v.x; o[n * 4 + j + 1] = v.y; }
    }
    DEVI void operator()(const f32x4 (&acc)[2][2][4][2], const Unit& u, int wr, int wc, int fr, int fq) const {
#pragma unroll
        for (int ai = 0; ai < 2; ++ai)
#pragma unroll
            for (int m = 0; m < 4; m += 2) {
                float o0[8], o1[8]; silu8(acc, ai, m, o0); silu8(acc, ai, m + 1, o1);
                unsigned ax = pk4_fp8(o0[0], o0[1], o0[2], o0[3]), ay = pk4_fp8(o0[4], o0[5], o0[6], o0[7]), bx = pk4_fp8(o1[0], o1[1], o1[2], o1[3]), by = pk4_fp8(o1[4], o1[5], o1[6], o1[7]);
                swap16u(ax, bx); swap16u(ay, by);
                const size_t row = (size_t)(u.pm * 256 + 128 * ai + 64 * wr + 16 * (m + (fq & 1)) + fr);
                u32x4 w; w.x = ax; w.y = ay; w.z = bx; w.w = by;
                *(u32x4*)((unsigned char*)hid + row * kFF + u.pn * 128 + 32 * wc + 8 * (fq & ~1)) = w;
            }
    }
};
struct EpiDown {
    DEVI void stage(LAS unsigned char*, const Unit&, int, int) const {}
    static constexpr int VMOPS = 8;
    bf16_t* y; float sc;
    DEVI static unsigned pk4c(const f32x4 v) { return pk4_fp8(v.x, v.y, v.z, v.w); }
    DEVI void operator()(const f32x4 (&acc)[2][2][4][2], const Unit& u, int wr, int wc, int fr, int fq) const {
        const float gv = sc * kY8;
#pragma unroll
        for (int ai = 0; ai < 2; ++ai)
#pragma unroll
            for (int m = 0; m < 4; m += 2)
#pragma unroll
                for (int bj = 0; bj < 2; ++bj) {
                    unsigned ax = pk4c(acc[ai][bj][m][0] * gv), ay = pk4c(acc[ai][bj][m][1] * gv), bx = pk4c(acc[ai][bj][m + 1][0] * gv), by = pk4c(acc[ai][bj][m + 1][1] * gv);
                    swap16u(ax, bx); swap16u(ay, by);
                    const size_t row = (size_t)(u.pm * 256 + 128 * ai + 64 * wr + 16 * (m + (fq & 1)) + fr);
                    u32x4 w; w.x = ax; w.y = ay; w.z = bx; w.w = by;
                    *(u32x4*)((unsigned char*)y + row * kD + u.pn * 256 + 128 * bj + 32 * wc + 8 * (fq & ~1)) = w;
                }
    }
};
struct EpiGlu {
    DEVI void stage(LAS unsigned char*, const Unit&, int, int) const {}
    static constexpr int VMOPS = 16;
    const bf16_t* g; bf16_t* oc;
    DEVI void operator()(const f32x4 (&acc)[2][2][4][2], const Unit& u, int wr, int wc, int fr, int fq) const {
#pragma unroll
        for (int ai = 0; ai < 2; ++ai) {
            const size_t r0 = (size_t)(u.pm * 256 + 128 * ai + 64 * wr + fr) * 256 + 32 * wc + 8 * fq;
            u32x4 gw[4][2];
#pragma unroll
            for (int m = 0; m < 4; ++m)
#pragma unroll
                for (int bj = 0; bj < 2; ++bj) gw[m][bj] = *(const u32x4*)(g + r0 + (size_t)m * 16 * 256 + 128 * bj);
#pragma unroll
            for (int m = 0; m < 4; ++m)
#pragma unroll
                for (int bj = 0; bj < 2; ++bj) { const size_t o = r0 + (size_t)m * 16 * 256 + 128 * bj; float gg[8]; unpk8s(gg, gw[m][bj]); float o8[8];
#pragma unroll
                    for (int n = 0; n < 2; ++n)
#pragma unroll
                        for (int j = 0; j < 4; ++j) o8[n * 4 + j] = gg[n * 4 + j] * frcp(1.f + __expf(-acc[ai][bj][m][n][j]));
                    u32x4 w; w.x = pk2(o8[0], o8[1]); w.y = pk2(o8[2], o8[3]); w.z = pk2(o8[4], o8[5]); w.w = pk2(o8[6], o8[7]);
                    *(u32x4*)(oc + o) = w; }
        }
    }
};

typedef float f32x16 __attribute__((ext_vector_type(16)));
typedef short s16x4 __attribute__((ext_vector_type(4)));
DEVI bf16x8 tr_pair(LAS unsigned char* p0, LAS unsigned char* p1) {
    const s16x4 a = __builtin_amdgcn_ds_read_tr16_b64_v4i16((LAS s16x4*)p0), b = __builtin_amdgcn_ds_read_tr16_b64_v4i16((LAS s16x4*)p1);
    return (bf16x8){a.x, a.y, a.z, a.w, b.x, b.y, b.z, b.w};
}
DEVI void phase_dilated(const bf16_t* qa, const bf16_t* ka, const bf16_t* va, const float* gq, const float* gk, bf16_t* oac, float* lse, LAS unsigned char* lds, int bid, int nblk) {
    const int tid = tidx(), wid = __builtin_amdgcn_readfirstlane(tid >> 6), lane = tid & 63, h5 = lane >> 5, qc = lane & 31;
    LAS unsigned char* Kimg = lds; LAS unsigned char* Vimg = lds + 49152;
    float Mn;
    { float a = fabsf(gq[lane]), b = fabsf(gk[lane]);
#pragma unroll
      for (int m = 32; m >= 1; m >>= 1) { a = fmaxf(a, __shfl_xor(a, m)); b = fmaxf(b, __shfl_xor(b, m)); }
      Mn = 8.f * a * b; }
    const float Mb = Mn * kLog2e;
    unsigned koff[4];
#pragma unroll
    for (int s = 0; s < 4; ++s) koff[s] = (unsigned)((32 * wid + qc) * 128 + (((2 * s + h5) ^ (qc & 7)) << 4));
    unsigned voff[2];
    { const int g = lane >> 4, i16 = lane & 15, q = i16 >> 2, p = i16 & 3;
#pragma unroll
      for (int dt = 0; dt < 2; ++dt) { const int c = (2 * (g & 1) + (p >> 1) + 4 * dt) ^ ((q >> 1) << 2); voff[dt] = (unsigned)((32 * wid + 4 * h5 + q) * 128 + (c << 4) + 8 * (p & 1)); } }
    const float dbase = (float)(4 * h5 - qc);
    u32x4 pK[6], pV[6];
#define DIL_DECODE(unit_) const int r_ = (unit_) >> 8, bl_ = (unit_) & 255, c = r_ % 3, bh = (bl_ & 7) * 8 + r_ / 3, ub = bl_ >> 3; \
        const int dsh = 2 * c, L = kS >> dsh, upc = 32 >> dsh, cls = ub >> (5 - dsh), u0 = (ub & (upc - 1)) << 8;
#define DIL_PREFETCH(unit_) do { DIL_DECODE(unit_) \
        const bf16_t* kbase = ka + (size_t)bh * kS * 64; const bf16_t* vbase = va + (size_t)bh * kS * 64; \
        _Pragma("unroll") for (int it = 0; it < 6; ++it) { const int id = it * kNT + tid, row = id >> 3, ch = id & 7; \
            int ki = u0 - 64 + row; ki = ki < 0 ? 0 : (ki > L - 1 ? L - 1 : ki); const size_t tok = (size_t)((ki << dsh) + cls); \
            pK[it] = *(const u32x4*)(kbase + tok * 64 + ch * 8); pV[it] = *(const u32x4*)(vbase + tok * 64 + ch * 8); } } while (0)
    if (bid < 6144) DIL_PREFETCH(bid);
    for (int unit = bid; unit < 6144; unit += nblk) {
        DIL_DECODE(unit)
        const int q0 = u0 + 32 * wid, qtok = ((q0 + qc) << dsh) + cls;
        bf16x8 Qf[4];
#pragma unroll
        for (int s = 0; s < 4; ++s) Qf[s] = *(const bf16x8*)(qa + ((size_t)bh * kS + qtok) * 64 + 16 * s + 8 * h5);
        __syncthreads();
#pragma unroll
        for (int it = 0; it < 6; ++it) { const int id = it * kNT + tid, row = id >> 3, ch = id & 7;
            *(LAS u32x4*)(Kimg + row * 128 + ((ch ^ (row & 7)) << 4)) = pK[it];
            *(LAS u32x4*)(Vimg + row * 128 + ((ch ^ (((row >> 1) & 1) << 2)) << 4)) = pV[it]; }
        __syncthreads();
        const float slope = exp2f(-(float)((bh & 7) + 1));
        const float c2 = slope * (float)(1 << dsh) * kLog2e;
        float sum = 0.f;
        f32x16 O[2];
#pragma unroll
        for (int dt = 0; dt < 2; ++dt)
#pragma unroll
            for (int i = 0; i < 16; ++i) O[dt][i] = 0.f;
        const float ndb = -dbase;
#define DIL_QK(dst, kt_) do { { const int kp0_ = q0 - 64 + 32 * (kt_); const float tm_ = (kp0_ >= 0 && kp0_ < L) ? 0.f : -1e30f; \
            const float cs_ = ((kt_) < 2) ? c2 : -c2, c0_ = (((kt_) == 0 || (kt_) == 4) ? -64.f : ((kt_) == 2 ? 0.f : -32.f)) * c2 - Mb + tm_; \
            const float bt_ = dbase * cs_ + c0_; \
            _Pragma("unroll") for (int i = 0; i < 16; i += 2) { const float k0 = (float)((i & 3) + 8 * (i >> 2)), k1 = (float)(((i + 1) & 3) + 8 * ((i + 1) >> 2)); f32x2 t; \
                if ((kt_) == 2) { const f32x2 d = {fabsf(dbase + k0), fabsf(dbase + k1)}; t = d * cs_ + c0_; } else t = (f32x2){k0, k1} * cs_ + bt_; \
                dst[i] = t.x; dst[i + 1] = t.y; } } \
            _Pragma("unroll") for (int s = 0; s < 4; ++s) { const bf16x8 Kf = *(const LAS bf16x8*)(Kimg + koff[s] + (kt_) * 4096); dst = __builtin_amdgcn_mfma_f32_32x32x16_bf16(Kf, Qf[s], dst, 0, 0, 0); } } while (0)
        f32x16 S, Sn;
        DIL_QK(S, 0);
        f32x2 sum2 = {0.f, 0.f};
#pragma unroll
        for (int kt = 0; kt < 5; ++kt) {
            if (kt < 4) DIL_QK(Sn, kt + 1);
            if (kt == 0) { if (unit + nblk < 6144) DIL_PREFETCH(unit + nblk); }
#pragma unroll
            for (int i = 0; i < 16; i += 2) {
                const float k0 = (float)((i & 3) + 8 * (i >> 2)), k1 = (float)(((i + 1) & 3) + 8 * ((i + 1) >> 2));
                f32x2 sv = (f32x2){S[i], S[i + 1]};
                if (kt == 0) { sv.x = (k0 >= ndb) ? sv.x : -1e30f; sv.y = (k1 >= ndb) ? sv.y : -1e30f; }
                if (kt == 4) { sv.x = (k0 <= ndb) ? sv.x : -1e30f; sv.y = (k1 <= ndb) ? sv.y : -1e30f; }
                f32x2 pv; pv.x = __builtin_amdgcn_exp2f(sv.x); pv.y = __builtin_amdgcn_exp2f(sv.y);
                S[i] = pv.x; S[i + 1] = pv.y; sum2 += pv;
            }
#pragma unroll
            for (int s2 = 0; s2 < 2; ++s2) {
                u32x4 pw; pw.x = pk2(S[8 * s2 + 0], S[8 * s2 + 1]); pw.y = pk2(S[8 * s2 + 2], S[8 * s2 + 3]); pw.z = pk2(S[8 * s2 + 4], S[8 * s2 + 5]); pw.w = pk2(S[8 * s2 + 6], S[8 * s2 + 7]);
                const bf16x8 Pf = __builtin_bit_cast(bf16x8, pw);
#pragma unroll
                for (int dt = 0; dt < 2; ++dt) { LAS unsigned char* vp = Vimg + voff[dt] + kt * 4096 + s2 * 2048;
                    const bf16x8 Vf = tr_pair(vp, vp + 1024);
                    O[dt] = __builtin_amdgcn_mfma_f32_32x32x16_bf16(Vf, Pf, O[dt], 0, 0, 0); }
            }
            if (kt < 4) S = Sn;
        }
#undef DIL_QK
        sum = sum2.x + sum2.y;
        sum = xsum32(sum);
        const float inv = 1.f / sum;
        const size_t tok = (size_t)(bh >> 3) * kS + qtok;
        {
        LAS unsigned char* ost = lds + 98304 + wid * 4096;
#pragma unroll
        for (int dt = 0; dt < 2; ++dt)
#pragma unroll
            for (int g4 = 0; g4 < 4; ++g4) { u32x2 w; w.x = pk2(O[dt][4 * g4] * inv, O[dt][4 * g4 + 1] * inv); w.y = pk2(O[dt][4 * g4 + 2] * inv, O[dt][4 * g4 + 3] * inv);
                *(LAS u32x2*)(ost + qc * 128 + (((4 * dt + g4) ^ (qc & 7)) << 4) + 8 * h5) = w; }
        if (h5 == 0) lse[((size_t)c * kTok + tok) * 8 + (bh & 7)] = Mn + __logf(sum);
        bf16_t* obase = oac + ((size_t)c * kTok + (size_t)(bh >> 3) * kS) * 512 + (bh & 7) * 64;
#pragma unroll
        for (int it = 0; it < 4; ++it) { const int r = it * 8 + (lane >> 3), ch = lane & 7;
            const u32x4 v = *(const LAS u32x4*)(ost + r * 128 + ((ch ^ (r & 7)) << 4));
            const size_t t2 = (size_t)(((q0 + r) << dsh) + cls);
            *(u32x4*)(obase + t2 * 512 + ch * 8) = v; }
        }
    }
#undef DIL_DECODE
#undef DIL_PREFETCH
    __syncthreads();
}
DEVI void phase_na(const bf16_t* qb, const bf16_t* kb, const bf16_t* vb, const float* rpb  , const float* gq, const float* gk, bf16_t* ob, LAS unsigned char* lds, int bid, int nblk) {
    const int tid = tidx(), wid = __builtin_amdgcn_readfirstlane(tid >> 6), lane = tid & 63, g4 = lane >> 4, i16 = lane & 15;
    LAS unsigned char* Kimg = lds; LAS unsigned char* Vimg = lds + 73728; LAS float* tab = (LAS float*)(lds + 147456);
    __syncthreads();
    for (int i = tid; i < 4 * 465; i += kNT) tab[i] = rpb[i];
    float Mq;
    { float a = fabsf(gq[lane]), b = fabsf(gk[lane]);
#pragma unroll
      for (int m = 32; m >= 1; m >>= 1) { a = fmaxf(a, __shfl_xor(a, m)); b = fmaxf(b, __shfl_xor(b, m)); }
      Mq = 8.f * a * b; }
    __syncthreads();
    if (wid < 4) { float m = 0.f; for (int i = lane; i < 465; i += 64) m = fmaxf(m, fabsf(tab[wid * 465 + i]));
#pragma unroll
        for (int k = 32; k >= 1; k >>= 1) m = fmaxf(m, __shfl_xor(m, k));
        if (lane == 0) tab[1860 + wid] = m; }
    __syncthreads();
    const int g = wid & 3, kcs = (16 * g - 8) < 0 ? 0 : ((16 * g - 8) > 32 ? 32 : (16 * g - 8));
    const int qcol = 16 * g + i16, cs = (qcol - 8) < 0 ? 0 : ((qcol - 8) > 48 ? 48 : (qcol - 8));
    unsigned kswz[2];
#pragma unroll
    for (int s = 0; s < 2; ++s) kswz[s] = (unsigned)(((4 * s + g4) ^ (i16 & 7)) << 4);
    const int q = i16 >> 2, p = i16 & 3, sw = 2 * (g4 & 1) + (q >> 1);
    unsigned vsw[4];
#pragma unroll
    for (int dt = 0; dt < 4; ++dt) vsw[dt] = (unsigned)((((2 * dt + (p >> 1)) ^ (sw << 1)) << 4) + 8 * (p & 1));
    const int scol = tid >> 3, sch = tid & 7;
    const unsigned skoff = (unsigned)(scol * 128 + ((sch ^ (scol & 7)) << 4)), svoff = (unsigned)(scol * 128 + ((sch ^ (((scol >> 1) & 3) << 1)) << 4));
    u32x4 pK[2], pV[2];
    for (int run = bid; run < 256; run += nblk) {
      const int bh = (run & 7) * 4 + ((run >> 3) & 3), h = bh & 3;
      const bf16_t* kbase = kb + (size_t)bh * kS * 64 + scol * 64 + sch * 8; const bf16_t* vbase = vb + (size_t)bh * kS * 64 + scol * 64 + sch * 8;
      const LAS float* th = tab + h * 465;
      const float Mb = (Mq + tab[1860 + h]) * kLog2e;
      const int ecol0 = kcs + 4 * g4 - cs, dcb0 = kcs + 4 * g4 - qcol + 15;
      f32x4 Bi[8][2];
#pragma unroll
      for (int u = 0; u < 8; ++u)
#pragma unroll
          for (int tt = 0; tt < 2; ++tt)
#pragma unroll
              for (int jj = 0; jj < 4; ++jj) { const int e = ecol0 + 16 * tt + jj; int dc = dcb0 + 16 * tt + jj; dc = dc < 0 ? 0 : (dc > 30 ? 30 : dc);
                  Bi[u][tt][jj] = ((unsigned)e < 16u) ? th[(u + 3) * 31 + dc] * kLog2e - Mb : -1e30f; }
#pragma unroll 1
      for (int j = 0; j < 8; ++j) {
        const int rp = (run >> 5) * 8 + j, r0 = 2 * rp;
        const int rsA = (r0 - 4) < 0 ? 0 : ((r0 - 4) > 120 ? 120 : (r0 - 4));
        const int prsA = (r0 - 6) < 0 ? 0 : ((r0 - 6) > 120 ? 120 : (r0 - 6));
        const int rr = r0 + (wid >> 2);
        const int rs = (rr - 4) < 0 ? 0 : ((rr - 4) > 120 ? 120 : (rr - 4));
        const int qtok = rr * 64 + qcol;
        bf16x8 Qf[2];
#pragma unroll
        for (int s = 0; s < 2; ++s) Qf[s] = *(const bf16x8*)(qb + ((size_t)bh * kS + qtok) * 64 + 32 * s + 8 * g4);
        __syncthreads();
        if (j == 0) {
#pragma unroll
            for (int it = 0; it < 9; ++it) { const int gr = rsA + it; if (gr < 128) { const int sl = gr % 9;
                const u32x4 kv = *(const u32x4*)(kbase + (size_t)gr * 64 * 64), vv = *(const u32x4*)(vbase + (size_t)gr * 64 * 64);
                *(LAS u32x4*)(Kimg + sl * 8192 + skoff) = kv; *(LAS u32x4*)(Vimg + sl * 8192 + svoff) = vv; } }
        } else {
#pragma unroll
            for (int it = 0; it < 2; ++it) { const int gr = prsA + 9 + it; if (gr <= rsA + 8 && gr < 128) { const int sl = gr % 9;
                *(LAS u32x4*)(Kimg + sl * 8192 + skoff) = pK[it]; *(LAS u32x4*)(Vimg + sl * 8192 + svoff) = pV[it]; } }
        }
        __syncthreads();
        if (j < 7) {
            const int nrsA = (r0 - 2) < 0 ? 0 : ((r0 - 2) > 120 ? 120 : (r0 - 2));
#pragma unroll
            for (int it = 0; it < 2; ++it) { int gr = rsA + 9 + it; gr = (gr <= nrsA + 8 && gr < 128) ? gr : 127;
                pK[it] = *(const u32x4*)(kbase + (size_t)gr * 64 * 64); pV[it] = *(const u32x4*)(vbase + (size_t)gr * 64 * 64); }
        }
        const int sb0 = rs % 9;
        const unsigned kb0 = (unsigned)((kcs + i16) * 128), vb0 = (unsigned)((kcs + 4 * g4 + q) * 128);
        float sum = 0.f;
        f32x4 O[4];
#pragma unroll
        for (int dt = 0; dt < 4; ++dt) O[dt] = (f32x4){0.f, 0.f, 0.f, 0.f};
#define NA_SO(u_) ((unsigned)((sb0 + (u_) >= 9 ? sb0 + (u_) - 9 : sb0 + (u_)) * 8192))
#define NA_QK(dst, u_, INIT) do { const unsigned so_ = NA_SO(u_); _Pragma("unroll") for (int tt = 0; tt < 2; ++tt) { \
            const bf16x8 Kf0 = *(const LAS bf16x8*)(Kimg + kb0 + so_ + tt * 2048 + kswz[0]), Kf1 = *(const LAS bf16x8*)(Kimg + kb0 + so_ + tt * 2048 + kswz[1]); \
            dst[tt] = __builtin_amdgcn_mfma_f32_16x16x32_bf16(Kf0, Qf[0], INIT(u_, tt), 0, 0, 0); dst[tt] = __builtin_amdgcn_mfma_f32_16x16x32_bf16(Kf1, Qf[1], dst[tt], 0, 0, 0); } } while (0)
#define NA_SOFTPV(S_, u_) do { const unsigned so_ = NA_SO(u_); \
            _Pragma("unroll") for (int tt = 0; tt < 2; ++tt) _Pragma("unroll") for (int jj = 0; jj < 4; ++jj) { const float pv = __builtin_amdgcn_exp2f(S_[tt][jj]); S_[tt][jj] = pv; sum += pv; } \
            u32x4 pw; pw.x = pk2(S_[0][0], S_[0][1]); pw.y = pk2(S_[0][2], S_[0][3]); pw.z = pk2(S_[1][0], S_[1][1]); pw.w = pk2(S_[1][2], S_[1][3]); \
            const bf16x8 Pf = __builtin_bit_cast(bf16x8, pw); \
            _Pragma("unroll") for (int dt = 0; dt < 4; ++dt) { LAS unsigned char* vp = Vimg + vb0 + so_ + vsw[dt]; \
                const bf16x8 Vf = tr_pair(vp, vp + 2048); \
                O[dt] = __builtin_amdgcn_mfma_f32_16x16x32_bf16(Vf, Pf, O[dt], 0, 0, 0); } } while (0)
#define NA_INIT_REG(u_, tt_) Bi[u_][tt_]
        if (rs - rr == -4) {
            f32x4 S[2], Sn[2];
            NA_QK(S, 0, NA_INIT_REG);
#pragma unroll
            for (int u = 0; u < 8; ++u) {
                if (u < 7) NA_QK(Sn, u + 1, NA_INIT_REG);
                NA_SOFTPV(S, u);
                if (u < 7) { S[0] = Sn[0]; S[1] = Sn[1]; }
            }
        } else {
            int g4v = g4; asm volatile("" : "+v"(g4v));
            const int ecol = kcs + 4 * g4v - cs, dcb = kcs + 4 * g4v - qcol + 15;
#pragma unroll
            for (int u = 0; u < 8; ++u) {
                const LAS float* tr = th + (rs + u - rr + 7) * 31;
                f32x4 In[2];
#pragma unroll
                for (int tt = 0; tt < 2; ++tt)
#pragma unroll
                    for (int jj = 0; jj < 4; ++jj) { const int e = ecol + 16 * tt + jj; int dc = dcb + 16 * tt + jj; dc = dc < 0 ? 0 : (dc > 30 ? 30 : dc);
                        In[tt][jj] = ((unsigned)e < 16u) ? tr[dc] * kLog2e - Mb : -1e30f; }
#define NA_INIT_TAB(u_, tt_) In[tt_]
                f32x4 S[2];
                NA_QK(S, u, NA_INIT_TAB);
                NA_SOFTPV(S, u);
#undef NA_INIT_TAB
            }
        }
#undef NA_INIT_REG
#undef NA_SOFTPV
#undef NA_QK
#undef NA_SO
        sum = xsum32(xsum16(sum));
        const float inv = 1.f / sum;
        bf16_t* orow = ob + ((size_t)(bh >> 2) * kS + qtok) * 256 + h * 64;
#pragma unroll
        for (int dt = 0; dt < 4; ++dt) { u32x2 w; w.x = pk2(O[dt][0] * inv, O[dt][1] * inv); w.y = pk2(O[dt][2] * inv, O[dt][3] * inv); *(u32x2*)(orow + 16 * dt + 4 * g4) = w; }
      }
    }
    __syncthreads();
}
DEVI void unpk8(float* d, const u32x4 q, const float sc) {
    d[0] += sc * __uint_as_float(q.x << 16); d[1] += sc * __uint_as_float(q.x & 0xFFFF0000u); d[2] += sc * __uint_as_float(q.y << 16); d[3] += sc * __uint_as_float(q.y & 0xFFFF0000u);
    d[4] += sc * __uint_as_float(q.z << 16); d[5] += sc * __uint_as_float(q.z & 0xFFFF0000u); d[6] += sc * __uint_as_float(q.w << 16); d[7] += sc * __uint_as_float(q.w & 0xFFFF0000u);
}
DEVI void phase_mixnorm(const bf16_t* oac, const float* lse, const bf16_t* ob, const bf16_t* oc, const float* ga, const float* gb, const float* gc, bf16_t* mix, int bid, int nblk) {
    const int wid = tidx() >> 6, lane = tidx() & 63;
    float gn[16];
    { const float* gp = (lane < 32) ? ga + lane * 16 : (lane < 48) ? gb + (lane - 32) * 16 : gc + (lane - 48) * 16;
#pragma unroll
      for (int i = 0; i < 16; ++i) gn[i] = gp[i]; }
    const int stride = nblk * 8;
    int row = bid * 8 + wid;
    if (row >= kTok) return;
    u32x4 Aq[6], Bq[6]; float Al[3], Bl[3];
    const bool dil = lane < 32;
    const int hh = dil ? (lane >> 2) : 0;
#define MX_ISSUE(R, Q, L) do { \
        const bf16_t* p0_ = dil ? oac + (size_t)(R) * 512 + lane * 16 : ((lane < 48) ? ob + (size_t)(R) * 256 + (lane - 32) * 16 : oc + (size_t)(R) * 256 + (lane - 48) * 16); \
        const size_t cst_ = dil ? (size_t)kTok * 512 : (size_t)0; \
        Q[0] = *(const u32x4*)p0_; Q[1] = *(const u32x4*)(p0_ + 8); Q[2] = *(const u32x4*)(p0_ + cst_); Q[3] = *(const u32x4*)(p0_ + cst_ + 8); Q[4] = *(const u32x4*)(p0_ + 2 * cst_); Q[5] = *(const u32x4*)(p0_ + 2 * cst_ + 8); \
        L[0] = lse[(size_t)(R) * 8 + hh]; L[1] = lse[((size_t)kTok + (R)) * 8 + hh]; L[2] = lse[((size_t)2 * kTok + (R)) * 8 + hh]; } while (0)
#define MX_BODY(C, N) do { \
        const int nrow_ = (row + stride < kTok) ? row + stride : row; \
        MX_ISSUE(nrow_, N##q, N##l); \
        float v[16]; \
        _Pragma("unroll") for (int i = 0; i < 16; ++i) v[i] = 0.f; \
        float w0 = 1.f, w1 = 0.f, w2 = 0.f; \
        if (dil) { const float mx = fmaxf(C##l[0], fmaxf(C##l[1], C##l[2])); w0 = __expf(C##l[0] - mx); w1 = __expf(C##l[1] - mx); w2 = __expf(C##l[2] - mx); const float inv = frcp(w0 + w1 + w2); w0 *= inv; w1 *= inv; w2 *= inv; } \
        unpk8(v, C##q[0], w0); unpk8(v + 8, C##q[1], w0); unpk8(v, C##q[2], w1); unpk8(v + 8, C##q[3], w1); unpk8(v, C##q[4], w2); unpk8(v + 8, C##q[5], w2); \
        float ss = 0.f; \
        _Pragma("unroll") for (int i = 0; i < 16; ++i) ss += v[i] * v[i]; \
        ss = row_sum16(ss); \
        { float a = ss, b = ss; swap16(a, b); if (lane < 32) ss = a + b; } \
        const float rstd = rsqrtf(ss * ((lane < 32) ? (1.f / 512.f) : (1.f / 256.f)) + kEps); \
        u32x4 o0, o1; \
        o0.x = pk2(v[0] * rstd * gn[0], v[1] * rstd * gn[1]); o0.y = pk2(v[2] * rstd * gn[2], v[3] * rstd * gn[3]); o0.z = pk2(v[4] * rstd * gn[4], v[5] * rstd * gn[5]); o0.w = pk2(v[6] * rstd * gn[6], v[7] * rstd * gn[7]); \
        o1.x = pk2(v[8] * rstd * gn[8], v[9] * rstd * gn[9]); o1.y = pk2(v[10] * rstd * gn[10], v[11] * rstd * gn[11]); o1.z = pk2(v[12] * rstd * gn[12], v[13] * rstd * gn[13]); o1.w = pk2(v[14] * rstd * gn[14], v[15] * rstd * gn[15]); \
        *(u32x4*)(mix + (size_t)row * kD + lane * 16) = o0; *(u32x4*)(mix + (size_t)row * kD + lane * 16 + 8) = o1; } while (0)
    MX_ISSUE(row, Aq, Al);
    for (;;) {
        MX_BODY(A, B); row += stride; if (row >= kTok) break;
        MX_BODY(B, A); row += stride; if (row >= kTok) break;
    }
#undef MX_BODY
#undef MX_ISSUE
}
DEVI void phase_combine(bf16_t* xb, bf16_t* xbo, float* out32, const bf16_t* y, const float* gate, const int* tokslot, bool last_layer, float* rstdp, int bid, int nblk) {
    const int wid = tidx() >> 6, lane = tidx() & 63;
    const int stride = nblk * 8;
    int row = bid * 8 + wid;
    if (row >= kTok) return;
    u32x4 Ax0, Ax1, Ay[4], Bx0, Bx1, By[4]; float Ag[4], Bg[4]; unsigned Am = 0u, Bm = 0u;
#define CB_ISSUE(R, TS, X0, X1, Y, G, M) do { const int b_ = (R) >> 13; \
        M = (unsigned)__builtin_amdgcn_ballot_w64(lane < 16 && (TS) >= 0); unsigned mm_ = M; \
        X0 = *(const u32x4*)(xb + (size_t)(R) * kD + lane * 16); X1 = *(const u32x4*)(xb + (size_t)(R) * kD + lane * 16 + 8); \
        _Pragma("unroll") for (int j = 0; j < 4; ++j) { const bool has_ = mm_ != 0u; const int e_ = has_ ? __builtin_ctz(mm_) : 0; const int sl_ = has_ ? __builtin_amdgcn_readlane((TS), e_) : 0; \
            const size_t r_ = has_ ? (size_t)(e_ * kB + b_) * kCap + sl_ : (size_t)0; Y[j] = *(const u32x4*)((const unsigned char*)y + r_ * kD + lane * 16); G[j] = gate[r_]; mm_ &= mm_ - 1u; } } while (0)
#define CB_ACC(YV, GS) do { const unsigned ww_[4] = {(YV).x, (YV).y, (YV).z, (YV).w}; const float gs_ = __builtin_bit_cast(float, __builtin_amdgcn_readfirstlane(__builtin_bit_cast(int, (GS))));   \
        _Pragma("unroll") for (int k = 0; k < 4; ++k) { const f32x2 lo = __builtin_amdgcn_cvt_pk_f32_fp8(ww_[k], false), hi = __builtin_amdgcn_cvt_pk_f32_fp8(ww_[k], true); \
            v[4 * k] += lo.x * gs_; v[4 * k + 1] += lo.y * gs_; v[4 * k + 2] += hi.x * gs_; v[4 * k + 3] += hi.y * gs_; } } while (0)
#define CB_BODY(C, N) do { \
        const int nrow_ = (row + stride < kTok) ? row + stride : row, nnrow_ = (row + 2 * stride < kTok) ? row + 2 * stride : row, b = row >> 13; \
        const int ts2 = tokslot[(size_t)nnrow_ * kE + (lane & 15)]; \
        CB_ISSUE(nrow_, ts1, N##x0, N##x1, N##y, N##g, N##m); \
        float v[16]; unpk8s(v, C##x0); unpk8s(v + 8, C##x1); \
        unsigned mm = C##m; \
        _Pragma("unroll") for (int j = 0; j < 4; ++j) { if (mm != 0u) CB_ACC(C##y[j], C##g[j]); mm &= mm - 1u; } \
        while (mm != 0u) { const int e = __builtin_ctz(mm), sl = __builtin_amdgcn_readlane(ts0, e); const size_t r = (size_t)(e * kB + b) * kCap + sl; \
            const u32x4 yv = *(const u32x4*)((const unsigned char*)y + r * kD + lane * 16); const float gs = gate[r]; CB_ACC(yv, gs); mm &= mm - 1u; } \
        if (last_layer) { \
            _Pragma("unroll") for (int k = 0; k < 4; ++k) *(f32x4*)(out32 + (size_t)row * kD + lane * 16 + 4 * k) = (f32x4){v[4 * k], v[4 * k + 1], v[4 * k + 2], v[4 * k + 3]}; \
        } else { u32x4 o0, o1; \
            o0.x = pk2(v[0], v[1]); o0.y = pk2(v[2], v[3]); o0.z = pk2(v[4], v[5]); o0.w = pk2(v[6], v[7]); o1.x = pk2(v[8], v[9]); o1.y = pk2(v[10], v[11]); o1.z = pk2(v[12], v[13]); o1.w = pk2(v[14], v[15]); \
            *(u32x4*)(xbo + (size_t)row * kD + lane * 16) = o0; *(u32x4*)(xbo + (size_t)row * kD + lane * 16 + 8) = o1; \
            unpk8s(v, o0); unpk8s(v + 8, o1);                     \
            float ss = 0.f; \
            _Pragma("unroll") for (int i = 0; i < 16; ++i) ss += v[i] * v[i]; \
            ss = wave_sum(ss); \
            if (lane == 0) rstdp[row] = rsqrtf(ss * (1.f / kD) + kEps);     \
        } \
        ts0 = ts1; ts1 = ts2; } while (0)
    int ts0 = tokslot[(size_t)row * kE + (lane & 15)];
    int ts1 = tokslot[(size_t)((row + stride < kTok) ? row + stride : row) * kE + (lane & 15)];
    CB_ISSUE(row, ts0, Ax0, Ax1, Ay, Ag, Am);
    for (;;) {
        CB_BODY(A, B); row += stride; if (row >= kTok) break;
        CB_BODY(B, A); row += stride; if (row >= kTok) break;
    }
#undef CB_BODY
#undef CB_ISSUE
#undef CB_ACC
}

DEVI void cpow_m(double a, double w, double dt, int m, float& re, float& im) {
    const float mag = __expf((float)m * (float)a * (float)dt);
    const double turns = (double)m * w * dt * 0.15915494309189535; const float ang = (float)((turns - floor(turns)) * 6.283185307179586);
    re = mag * cosf(ang); im = mag * sinf(ang);
}
DEVI void s5_prep_item(const Params& P, int l, int g, unsigned char* lds_) {
    float* pw = (float*)lds_;
    float* bb = pw + 4352;
    float* cc = bb + 4096;
    float* kt = cc + 4096;
    const int tid = tidx();
    __syncthreads();
    for (int i = tid; i < 128; i += kNT) { const int dir = i >> 6, p = i & 63; const size_t pb = (((size_t)l * 2 + dir) * 16 + g) * 64 + p;
        const double dt = (double)__expf(P.s5_log_dt[((size_t)l * 2 + dir) * 16 + g]); const double a = (double)fminf(P.s5_a_re[pb], -1e-4f), w = (double)P.s5_a_im[pb];
        for (int m = 0; m < 17; ++m) { float re, im; cpow_m(a, w, dt, m, re, im); pw[((dir * 64 + p) * 17 + m) * 2] = re; pw[((dir * 64 + p) * 17 + m) * 2 + 1] = im; }
        const float af = (float)a, wf = (float)w, ar = pw[((dir * 64 + p) * 17 + 1) * 2], ai = pw[((dir * 64 + p) * 17 + 1) * 2 + 1];
        const float den = af * af + wf * wf, zr = ar - 1.f, gr = (zr * af + ai * wf) / den, gi = (ai * af - zr * wf) / den;
        for (int c = 0; c < 16; ++c) { const float br = P.s5_b_re[pb * 16 + c], bi = P.s5_b_im[pb * 16 + c]; bb[((dir * 64 + p) * 16 + c) * 2] = gr * br - gi * bi; bb[((dir * 64 + p) * 16 + c) * 2 + 1] = gr * bi + gi * br; }
    }
    for (int i = tid; i < 2048; i += kNT) { const int dir = i >> 10, c = (i >> 6) & 15, p = i & 63; const size_t o = ((((size_t)l * 2 + dir) * 16 + g) * 16 + c) * 64 + p; cc[i * 2] = P.s5_c_re[o]; cc[i * 2 + 1] = P.s5_c_im[o]; }
    __syncthreads();
    for (int i = tid; i < 8192; i += kNT) { const int dir = i >> 12, m = (i >> 8) & 15, c = (i >> 4) & 15, c2 = i & 15; float acc = 0.f;
        for (int p = 0; p < 64; ++p) { const float cr = cc[((dir * 16 + c) * 64 + p) * 2], ci = cc[((dir * 16 + c) * 64 + p) * 2 + 1], wr_ = pw[((dir * 64 + p) * 17 + m) * 2], wi_ = pw[((dir * 64 + p) * 17 + m) * 2 + 1];
            const float br = bb[((dir * 64 + p) * 16 + c2) * 2], bi = bb[((dir * 64 + p) * 16 + c2) * 2 + 1]; const float tr = cr * wr_ - ci * wi_, ti = cr * wi_ + ci * wr_; acc += tr * br - ti * bi; }
        kt[i] = acc; }
    __syncthreads();
    bf16_t* wst = (bf16_t*)(wsp(P) + WS_WST) + ((size_t)l * 16 + g) * 256 * 256;
    bf16_t* wso = (bf16_t*)(wsp(P) + WS_WSO) + ((size_t)l * 16 + g) * 256 * 512;
    for (int id = tid; id < 8192; id += kNT) { const int n = id >> 5, k0 = (id & 31) * 8, dir = n >> 7, p = (n >> 1) & 63, ri = n & 1; float v[8];
#pragma unroll
        for (int kk = 0; kk < 8; ++kk) { const int k = k0 + kk, t = k >> 4, c = k & 15, e = dir ? t : 15 - t; const float wr_ = pw[((dir * 64 + p) * 17 + e) * 2], wi_ = pw[((dir * 64 + p) * 17 + e) * 2 + 1], br = bb[((dir * 64 + p) * 16 + c) * 2], bi = bb[((dir * 64 + p) * 16 + c) * 2 + 1];
            v[kk] = ri ? (wr_ * bi + wi_ * br) : (wr_ * br - wi_ * bi); }
        u32x4 o; o.x = pk2(v[0], v[1]); o.y = pk2(v[2], v[3]); o.z = pk2(v[4], v[5]); o.w = pk2(v[6], v[7]); *(u32x4*)(wst + (size_t)n * 256 + k0) = o; }
    for (int id = tid; id < 16384; id += kNT) { const int ns = id >> 6, k0 = (id & 63) * 8, n = cmap_pk(ns), t = n >> 4, c = n & 15; float v[8];
#pragma unroll
        for (int kk = 0; kk < 8; ++kk) { const int k = k0 + kk; float x;
            if (k < 256) { const int j = k >> 4, c2 = k & 15; x = 0.f; if (j <= t) x += kt[(t - j) * 256 + c * 16 + c2]; if (j >= t) x += kt[4096 + (j - t) * 256 + c * 16 + c2]; if (j == t && c == c2) x += P.s5_d[l * 256 + g * 16 + c]; }
            else { const int q = k - 256, dir = q >> 7, p = (q >> 1) & 63, ri = q & 1, e = dir ? 16 - t : t + 1; const float cr = cc[((dir * 16 + c) * 64 + p) * 2], ci = cc[((dir * 16 + c) * 64 + p) * 2 + 1], wr_ = pw[((dir * 64 + p) * 17 + e) * 2], wi_ = pw[((dir * 64 + p) * 17 + e) * 2 + 1];
                x = ri ? -(cr * wi_ + ci * wr_) : (cr * wr_ - ci * wi_); }
            v[kk] = x; }
        u32x4 o; o.x = pk2(v[0], v[1]); o.y = pk2(v[2], v[3]); o.z = pk2(v[4], v[5]); o.w = pk2(v[6], v[7]); *(u32x4*)(wso + (size_t)ns * 512 + k0) = o; }
    __syncthreads();
}
DEVI void phase_s5_scan(const Params& P, int l, const float* Z, bf16_t* ux, unsigned char* lds_, int bid, int nblk) {
    const int tid = tidx(), wid = tid >> 6, lane = tid & 63;
    float* E = (float*)lds_;
    for (int item = bid; item < 256; item += nblk) {
        const int dir = item & 1, g = (item >> 1) & 15, b = item >> 5;
        const size_t pb = (((size_t)l * 2 + dir) * 16 + g) * 64 + lane;
        const double dt = (double)__expf(P.s5_log_dt[((size_t)l * 2 + dir) * 16 + g]); const double a = (double)fminf(P.s5_a_re[pb], -1e-4f), w = (double)P.s5_a_im[pb];
        float a16r, a16i, Ar, Ai; cpow_m(a, w, dt, 16, a16r, a16i); cpow_m(a, w, dt, 1024, Ar, Ai);
        const int kk0 = dir ? 511 - 64 * wid : 64 * wid; const long sstep = dir ? -1 : 1;
        const float* zp = Z + ((size_t)g * 4096 + b * 512 + kk0) * 256 + dir * 128 + 2 * lane;
        f32x2 z[64];
#pragma unroll
        for (int i = 0; i < 64; ++i) { z[i] = *(const f32x2*)zp; zp += sstep * 256; }
        float xr = 0.f, xi = 0.f;
#pragma unroll
        for (int i = 0; i < 64; ++i) { const float nr = a16r * xr - a16i * xi + z[i].x, ni = a16r * xi + a16i * xr + z[i].y; xr = nr; xi = ni; }
        __syncthreads();
        E[(wid * 64 + lane) * 2] = xr; E[(wid * 64 + lane) * 2 + 1] = xi;
        __syncthreads();
        float sr = 0.f, si = 0.f;
#pragma unroll
        for (int s2 = 0; s2 < 7; ++s2) if (s2 < wid) { const float er = E[(s2 * 64 + lane) * 2], ei = E[(s2 * 64 + lane) * 2 + 1]; const float nr = Ar * sr - Ai * si + er, ni = Ar * si + Ai * sr + ei; sr = nr; si = ni; }
        bf16_t* up = ux + ((size_t)g * 4096 + b * 512 + kk0) * 512 + 256 + dir * 128 + 2 * lane;
#pragma unroll
        for (int i = 0; i < 64; ++i) { *(unsigned*)up = pk2(sr, si); up += sstep * 512;
            const float nr = a16r * sr - a16i * si + z[i].x, ni = a16r * si + a16i * sr + z[i].y; sr = nr; si = ni; }
    }
    __syncthreads();
}
struct EpiF32N {
    DEVI void stage(LAS unsigned char*, const Unit&, int, int) const {}
    static constexpr int VMOPS = 32;
    float* z; int ldz;
    DEVI void operator()(const f32x4 (&acc)[2][2][4][2], const Unit& u, int wr, int wc, int fr, int fq) const {
#pragma unroll
        for (int ai = 0; ai < 2; ++ai)
#pragma unroll
            for (int m = 0; m < 4; ++m) { const size_t ro = (size_t)(u.pm * 256 + 128 * ai + 64 * wr + 16 * m + fr) * ldz + u.pn * 256 + 32 * wc + 4 * fq;
#pragma unroll
                for (int bj = 0; bj < 2; ++bj)
#pragma unroll
                    for (int n = 0; n < 2; ++n) *(f32x4*)(z + ro + 128 * bj + 16 * n) = acc[ai][bj][m][n]; }
    }
};
struct EpiS5Out {
    DEVI void stage(LAS unsigned char*, const Unit&, int, int) const {}
    static constexpr int VMOPS = 16;
    bf16_t* G;
    DEVI void operator()(const f32x4 (&acc)[2][2][4][2], const Unit& u, int wr, int wc, int fr, int fq) const {
#pragma unroll
        for (int ai = 0; ai < 2; ++ai)
#pragma unroll
            for (int m = 0; m < 4; ++m) { const int R = u.pm * 256 + 128 * ai + 64 * wr + 16 * m + fr, g = R >> 12, ck = R & 4095;
#pragma unroll
                for (int bj = 0; bj < 2; ++bj) { const int t = 8 * bj + 2 * wc + (fq >> 1), c0 = 8 * (fq & 1);
                    const f32x4 v0 = acc[ai][bj][m][0], v1 = acc[ai][bj][m][1];
                    u32x4 w; w.x = pk2(gelu_tanh(v0.x), gelu_tanh(v0.y)); w.y = pk2(gelu_tanh(v0.z), gelu_tanh(v0.w)); w.z = pk2(gelu_tanh(v1.x), gelu_tanh(v1.y)); w.w = pk2(gelu_tanh(v1.z), gelu_tanh(v1.w));
                    *(u32x4*)(G + ((size_t)ck * 16 + t) * 256 + g * 16 + c0) = w; } }
    }
};
#define XB_TMO      128
#define XB_XCNT(j)  (256  + 64 * (j))
#define XB_XSUB(j)  (1280 + 64 * (j))
#define XB_XGEN(j)  (2304 + 64 * (j))
#define XB_TOP      3328
#define XB_TOPGEN   3392
#define XCD_BAR_WORDS 3456
#define XB_SPIN_CAP (1u << 26)
DEVI unsigned xb_ld(unsigned* p)              { return __hip_atomic_load(p, __ATOMIC_RELAXED, __HIP_MEMORY_SCOPE_AGENT); }
DEVI unsigned xb_add(unsigned* p, unsigned v) { return __hip_atomic_fetch_add(p, v, __ATOMIC_RELAXED, __HIP_MEMORY_SCOPE_AGENT); }
DEVI unsigned xb_xcc_id() { return (unsigned)__builtin_amdgcn_s_getreg((3 << 11) | 20) & 0xFu; }
#define XB_SPIN(cond, bar) do { unsigned _sp = 0; while (cond) { __builtin_amdgcn_s_sleep(1); \
    if ((++_sp & 255u) == 0u) { if (xb_ld(&(bar)[XB_TMO])) break; if (_sp > XB_SPIN_CAP) { atomicAdd(&(bar)[XB_TMO], 1u); break; } } } } while (0)
struct XcdBarrier { unsigned* bar; unsigned x; volatile LAS unsigned* st; };
DEVI XcdBarrier xcd_barrier_post(unsigned* bar, volatile LAS unsigned* st) {
    XcdBarrier b; b.bar = bar; b.x = xb_xcc_id(); b.st = st;
    if (threadIdx.x == 0) (void)xb_add(&bar[XB_XCNT(b.x)], 1u);
    return b;
}
DEVI void xcd_barrier_complete(unsigned* bar, unsigned x, unsigned& nloc, unsigned& nx) {
    const unsigned G = gridDim.x * gridDim.y * gridDim.z;
    unsigned sum, cnt, mine, sp = 0u;
    for (;;) {
        sum = 0u; cnt = 0u; mine = 0u;
#pragma unroll
        for (unsigned j = 0; j < 16; ++j) { const unsigned c = xb_ld(&bar[XB_XCNT(j)]); sum += c; cnt += (c > 0u) ? 1u : 0u; mine = (j == x) ? c : mine; }
        if (sum == G) break;
        __builtin_amdgcn_s_sleep(1);
        if ((++sp & 255u) == 0u) { if (xb_ld(&bar[XB_TMO])) break; if (sp > XB_SPIN_CAP) { atomicAdd(&bar[XB_TMO], 1u); break; } }
    }
    nloc = mine > 0u ? mine : 1u; nx = cnt > 0u ? cnt : 1u;
}
DEVI void xcd_barrier(const XcdBarrier& b) {
    asm volatile("s_waitcnt vmcnt(0)" ::: "memory");
    __syncthreads();
    if (threadIdx.x == 0) {
        unsigned long long bp_ = (unsigned long long)b.bar; asm volatile("" : "+s"(bp_));
        unsigned* bar = (unsigned*)bp_;
        const unsigned bx = xb_xcc_id();
        __builtin_amdgcn_s_waitcnt(0);
        unsigned nloc = b.st[0], nx = b.st[1];
        if (nloc == 0u) { xcd_barrier_complete(bar, bx, nloc, nx); b.st[0] = nloc; b.st[1] = nx; }
        const unsigned old = xb_add(&bar[XB_XSUB(bx)], 1u);
        const unsigned gen = old / nloc;
        if (old + 1u == (gen + 1u) * nloc) {
            __builtin_amdgcn_fence(__ATOMIC_RELEASE, "agent");
            asm volatile("s_waitcnt vmcnt(0)" ::: "memory");
            const unsigned og = xb_add(&bar[XB_TOP], 1u);
            const unsigned tg = og / nx;
            if (og + 1u == (tg + 1u) * nx) xb_add(&bar[XB_TOPGEN], 1u);
            else XB_SPIN(xb_ld(&bar[XB_TOPGEN]) == tg, bar);
            __builtin_amdgcn_fence(__ATOMIC_ACQUIRE, "agent");
            xb_add(&bar[XB_XGEN(bx)], 1u);
            asm volatile("s_waitcnt vmcnt(0)" ::: "memory");
        } else {
            XB_SPIN(xb_ld(&bar[XB_XGEN(bx)]) == gen, bar);
            __builtin_amdgcn_fence(__ATOMIC_ACQUIRE, "agent");
            asm volatile("s_waitcnt vmcnt(0)" ::: "memory");
        }
    }
    __syncthreads();
}

constexpr int LDS_BYTES = 147456 + 8192 + 16;
#define GEMM_RUN(g, E) gemm_engine<decltype(E), true, true>((LAS unsigned char*)dyn_lds, g, E, bid, nblk)
#define GEMM_RUN8(g, E) gemm_engine<decltype(E), true, true, true>((LAS unsigned char*)dyn_lds, g, E, bid, nblk)
#define GEMM_RUN8G(g, E) gemm_engine<decltype(E), true, true, true, true>((LAS unsigned char*)dyn_lds, g, E, bid, nblk)
extern __shared__ __attribute__((aligned(16))) unsigned char dyn_lds[];

DEVI GemmD mk_gemm(const bf16_t* A, const bf16_t* Bt, int lda, int K, int nM, int nN, const int* rowidx, size_t bstride, int pmg) {
    GemmD g; g.A = A; g.Bt = Bt; g.lda = lda; g.K = K; g.nM = nM; g.nN = nN; g.rowidx = rowidx; g.bstride = bstride; g.pmg = pmg; return g; }

DEVI void ph_win(const Params& P, int l, int bid, int nblk) {
    const GemmD g = mk_gemm((const bf16_t*)(wsp(P) + WS_XB), (const bf16_t*)(wsp(P) + WS_WINT) + (size_t)l * kINW * kD, kD, kD, kTok / 256, 10, nullptr, 0, 1 << 30);
    unsigned char* r1 = wsp(P) + WS_R1;
    EpiQKV E; E.qa = (bf16_t*)(r1 + R1_QA); E.ka = (bf16_t*)(r1 + R1_KA); E.va = (bf16_t*)(r1 + R1_VA); E.qb = (bf16_t*)(r1 + R1_QB); E.kb = (bf16_t*)(r1 + R1_KB); E.vb = (bf16_t*)(r1 + R1_VB); E.ux = (bf16_t*)(r1 + R1_UX);
    E.rstdp = (const float*)(wsp(P) + WS_RSTD); E.rtab = (const LAS float*)((LAS unsigned char*)dyn_lds + 131072 + 2048);
    { LAS float* tab = (LAS float*)((LAS unsigned char*)dyn_lds + 131072);
      const int t = tidx();
      if (t < 320) { const int r = t >> 6, c = t & 63; tab[t] = (r == 0) ? P.q_norm_a[l * 64 + c] * (0.125f * kLog2e)   : (r == 1) ? P.k_norm_a[l * 64 + c] : (r == 2) ? P.q_norm_b[l * 64 + c] * (0.125f * kLog2e)   : (r == 3) ? P.k_norm_b[l * 64 + c] : 1.f; }
      __syncthreads();
      E.gtab = tab; }
    GEMM_RUN(g, E);
}
DEVI void ph_dilated(const Params& P, int l, int bid, int nblk) { unsigned char* r1 = wsp(P) + WS_R1;
    phase_dilated((const bf16_t*)(r1 + R1_QA), (const bf16_t*)(r1 + R1_KA), (const bf16_t*)(r1 + R1_VA), P.q_norm_a + l * 64, P.k_norm_a + l * 64, (bf16_t*)(wsp(P) + WS_R2), (float*)(wsp(P) + WS_LSE), (LAS unsigned char*)dyn_lds, bid, nblk);
}
DEVI void ph_na(const Params& P, int l, int bid, int nblk) { unsigned char* r1 = wsp(P) + WS_R1;
    phase_na((const bf16_t*)(r1 + R1_QB), (const bf16_t*)(r1 + R1_KB), (const bf16_t*)(r1 + R1_VB), P.rpb + (size_t)l * 4 * 15 * 31, P.q_norm_b + l * 64, P.k_norm_b + l * 64, (bf16_t*)(r1 + R1_OB), (LAS unsigned char*)dyn_lds, bid, nblk);
}
DEVI void ph_s5_prep(const Params& P, unsigned char* lds, int bid, int nblk) { for (int it = bid; it < kL * 16; it += nblk) s5_prep_item(P, it >> 4, it & 15, lds); }
DEVI void ph_s5_state(const Params& P, int l, int bid, int nblk) {
    const GemmD g = mk_gemm((const bf16_t*)(wsp(P) + WS_R1 + R1_UX), (const bf16_t*)(wsp(P) + WS_WST) + (size_t)l * 16 * 256 * 256, 512, 256, 256, 1, nullptr, (size_t)256 * 256, 16);
    EpiF32N E; E.z = (float*)(wsp(P) + WS_R2 + R2_Z); E.ldz = 256;
    GEMM_RUN(g, E);
}
DEVI void ph_s5_scan(const Params& P, int l, unsigned char* lds, int bid, int nblk) { phase_s5_scan(P, l, (const float*)(wsp(P) + WS_R2 + R2_Z), (bf16_t*)(wsp(P) + WS_R1 + R1_UX), lds, bid, nblk); }
DEVI void ph_s5_out(const Params& P, int l, int bid, int nblk) {
    const GemmD g = mk_gemm((const bf16_t*)(wsp(P) + WS_R1 + R1_UX), (const bf16_t*)(wsp(P) + WS_WSO) + (size_t)l * 16 * 256 * 512, 512, 512, 256, 1, nullptr, (size_t)256 * 512, 16);
    EpiS5Out E; E.G = (bf16_t*)(wsp(P) + WS_R1 + R1_G);
    GEMM_RUN(g, E);
}
DEVI void ph_glu(const Params& P, int l, int bid, int nblk) {
    const GemmD g = mk_gemm((const bf16_t*)(wsp(P) + WS_R1 + R1_G), (const bf16_t*)(wsp(P) + WS_WGLUT) + (size_t)l * 256 * 256, 256, 256, kTok / 256, 1, nullptr, 0, 1 << 30);
    EpiGlu E; E.g = (const bf16_t*)(wsp(P) + WS_R1 + R1_G); E.oc = (bf16_t*)(wsp(P) + WS_R1 + R1_OC);
    GEMM_RUN(g, E);
}
DEVI void ph_mixnorm(const Params& P, int l, int bid, int nblk) { unsigned char* r1 = wsp(P) + WS_R1;
    phase_mixnorm((const bf16_t*)(wsp(P) + WS_R2), (const float*)(wsp(P) + WS_LSE), (const bf16_t*)(r1 + R1_OB), (const bf16_t*)(r1 + R1_OC), P.out_norm_a + l * 512, P.out_norm_b + l * 256, P.out_norm_c + l * 256, (bf16_t*)(wsp(P) + WS_H), bid, nblk); }
DEVI void ph_wout(const Params& P, int l, int bid, int nblk) {
    const GemmD g = mk_gemm((const bf16_t*)(wsp(P) + WS_H), (const bf16_t*)(wsp(P) + WS_WOUTT) + (size_t)l * kD * kD, kD, kD, kTok / 256, 4, nullptr, 0, 1 << 30);
    EpiResid E; E.xb = (bf16_t*)(wsp(P) + WS_XB); E.xbo = E.xb;
    GEMM_RUN(g, E);
}
DEVI void ph_router(const Params& P, int l, unsigned char* lds, int bid, int nblk) { phase_router((const bf16_t*)(wsp(P) + WS_XB), P.ffn_norm + (size_t)l * kD, wsp(P) + WS_RTAB + (size_t)l * 65536, wsp(P) + WS_H, (float*)(wsp(P) + WS_AFF), (LAS unsigned char*)dyn_lds, bid, nblk); }
DEVI void ph_topk(const Params& P, unsigned char* lds, int bid, int nblk) { phase_topk((const float*)(wsp(P) + WS_AFF), (int*)(wsp(P) + WS_IDX), (float*)(wsp(P) + WS_GATE), (int*)(wsp(P) + WS_TSLOT), wsp(P) + WS_H, nullptr  , kD, lds, bid, nblk); }
DEVI void ph_gu(const Params& P, int l, int bid, int nblk) {
    const GemmD g = mk_gemm((const bf16_t*)(wsp(P) + WS_H), (const bf16_t*)(wsp(P) + WS_WGUT + (size_t)l * kE * 4096 * kD), kD, kD, 512, 16, (const int*)(wsp(P) + WS_IDX), (size_t)4096 * kD, 32);
    EpiGU E; E.hid = (bf16_t*)(wsp(P) + WS_R1); E.sc = 1.f / kW8;
    GEMM_RUN8G(g, E);
}
DEVI void ph_down(const Params& P, int l, int bid, int nblk) {
    const GemmD g = mk_gemm((const bf16_t*)(wsp(P) + WS_R1), (const bf16_t*)(wsp(P) + WS_WDT + (size_t)l * kE * kD * kFF), kFF, kFF, 512, 4, nullptr, (size_t)kD * kFF, 32);
    EpiDown E; E.y = (bf16_t*)(wsp(P) + WS_R2); E.sc = 1.f / (kW8 * kH8);
    GEMM_RUN8(g, E);
}
DEVI void ph_combine(const Params& P, int l, int bid, int nblk) { phase_combine((bf16_t*)(wsp(P) + WS_XB), (bf16_t*)(wsp(P) + WS_XB), P.out, (const bf16_t*)(wsp(P) + WS_R2), (const float*)(wsp(P) + WS_GATE), (const int*)(wsp(P) + WS_TSLOT), l + 1 == kL, (float*)(wsp(P) + WS_RSTD), bid, nblk); }

__global__ void __launch_bounds__(kNT, 2) mega_fwd(Params P) {
    asm volatile("s_setreg_imm32_b32 hwreg(HW_REG_MODE, 23, 1), 1");

    volatile LAS unsigned* st = (volatile LAS unsigned*)(dyn_lds + LDS_BYTES - 16);
    if (threadIdx.x == 0) { st[0] = 0u; st[1] = 0u; st[2] = 0u; st[3] = 0u; }
    __syncthreads();
    const XcdBarrier bar = xcd_barrier_post((unsigned*)(P.ws + WS_CTL), st);
    const int bid = blockIdx.x, nblk = gridDim.x;
    unsigned char* lds = dyn_lds;
    phase_convert(P, lds, lnd(bid), nblk);
    ph_s5_prep(P, lds, lnd(bid), nblk);
    router_prep(P, lnd(bid), nblk);
    phase_norm(P.x, (bf16_t*)(wsp(P) + WS_XB), (float*)(wsp(P) + WS_RSTD), lnd(bid), nblk);
    xcd_barrier(bar);
#pragma unroll 1
    for (int l = 0; l < kL; ++l) {
        ph_win(P, l, lnd(bid), nblk);             xcd_barrier(bar);
        ph_s5_state(P, l, lnd(bid), nblk);        xcd_barrier(bar);
        ph_s5_scan(P, l, lds, lnd(bid), nblk);
        ph_dilated(P, l, lnd(bid), nblk);
        ph_na(P, l, lnd(bid), nblk);              xcd_barrier(bar);
        ph_s5_out(P, l, lnd(bid), nblk);          xcd_barrier(bar);
        ph_glu(P, l, lnd(bid), nblk);             xcd_barrier(bar);
        ph_mixnorm(P, l, lnd(bid), nblk);         xcd_barrier(bar);
        ph_wout(P, l, lnd(bid), nblk);            xcd_barrier(bar);
        ph_router(P, l, lds, lnd(bid), nblk);     xcd_barrier(bar);
        ph_topk(P, lds, lnd(bid), nblk);          xcd_barrier(bar);
        ph_gu(P, l, lnd(bid), nblk);              xcd_barrier(bar);
        ph_down(P, l, lnd(bid), nblk);            xcd_barrier(bar);
        ph_combine(P, l, lnd(bid), nblk);         xcd_barrier(bar);
    }
}

extern "C" void kernel_launch(void* const* d_in, const int* in_sizes, int n_in, void* d_out, int out_size, void* d_ws, size_t ws_size, hipStream_t stream) {
    (void)in_sizes; (void)n_in; (void)out_size;
    if (ws_size < WS_END) { fprintf(stderr, "workspace too small: %zu < %zu\n", ws_size, (size_t)WS_END); return; }
    Params P{};
    const float** pp = (const float**)&P;
    for (int i = 0; i < 26; ++i) pp[i] = (const float*)d_in[i];
    P.out = (float*)d_out; P.ws = (unsigned char*)d_ws;
    static int grid = 0;
    if (!grid) {
        int dev = 0, cus = 0, per_cu = 0;
        (void)hipGetDevice(&dev);
        (void)hipDeviceGetAttribute(&cus, hipDeviceAttributeMultiprocessorCount, dev);
        (void)hipFuncSetAttribute((const void*)mega_fwd, hipFuncAttributeMaxDynamicSharedMemorySize, LDS_BYTES);
        (void)hipOccupancyMaxActiveBlocksPerMultiprocessor(&per_cu, (const void*)mega_fwd, kNT, LDS_BYTES);
        grid = (per_cu >= 1) ? cus : 0;
        if (!grid) fprintf(stderr, "mega_fwd does not fit a CU\n");
    }
    if (!grid) return;
    (void)hipMemsetAsync(P.ws + WS_CTL, 0, XCD_BAR_WORDS * sizeof(unsigned), stream);
    mega_fwd<<<grid, kNT, LDS_BYTES, stream>>>(P);
}
```

```cpp
#include <hip/hip_runtime.h>
#include <stdint.h>
#include <stdio.h>

#define DEVI __device__ __forceinline__
#define LAS __attribute__((address_space(3)))
typedef unsigned short bf16_t;
typedef short bf16x8 __attribute__((ext_vector_type(8)));
typedef float f32x4 __attribute__((ext_vector_type(4)));
typedef float f32x2 __attribute__((ext_vector_type(2)));
typedef unsigned u32x4 __attribute__((ext_vector_type(4)));
typedef unsigned u32x2 __attribute__((ext_vector_type(2)));

constexpr int kB = 8, kS = 8192, kD = 1024, kL = 4, kTok = kB * kS;
constexpr int kINW = 2560;
constexpr int kE = 16, kCap = 1024, kFF = 2048;
constexpr int kNT = 512;
constexpr float kEps = 1e-6f;
constexpr float kLog2e = 1.4426950408889634f, kLn2 = 0.6931471805599453f;

constexpr size_t MiB = 1024ull * 1024ull;
constexpr size_t WS_CTL   = 0;
constexpr size_t WS_RSTD  = 512 * 1024;
constexpr size_t WS_WINT  = 1 * MiB;
constexpr size_t WS_WOUTT = WS_WINT + 20 * MiB;
constexpr size_t WS_WGLUT = WS_WOUTT + 8 * MiB;
constexpr size_t WS_RTAB  = WS_WGLUT + 512 * 1024;
constexpr size_t WS_WGUT  = WS_WGLUT + 1 * MiB;
constexpr size_t WS_WDT   = WS_WGUT + 512 * MiB;
constexpr size_t WS_H     = WS_WDT + 256 * MiB;
constexpr size_t WS_R1    = WS_H + 128 * MiB;
constexpr size_t WS_R2    = WS_R1 + 512 * MiB;
constexpr size_t WS_AFF   = WS_R2 + 256 * MiB;
constexpr size_t WS_IDX   = WS_AFF + 4 * MiB;
constexpr size_t WS_GATE  = WS_IDX + 1 * MiB;
constexpr size_t WS_TSLOT = WS_GATE + 1 * MiB;
constexpr size_t WS_LSE   = WS_TSLOT + 4 * MiB;
constexpr size_t WS_WST   = WS_LSE + 8 * MiB;
constexpr size_t WS_WSO   = WS_WST + 8 * MiB;
constexpr size_t WS_XB    = WS_WSO + 16 * MiB;
constexpr size_t WS_END   = WS_XB + 128 * MiB;
constexpr size_t R2_Z     = 192 * MiB;
constexpr size_t R1_QA = 0, R1_KA = 64 * MiB, R1_VA = 128 * MiB, R1_QB = 192 * MiB, R1_KB = 224 * MiB, R1_VB = 256 * MiB,
                 R1_UX = 288 * MiB, R1_OB = 352 * MiB, R1_OC = 384 * MiB, R1_G = 416 * MiB;

struct Params {
    const float* x; const float* attn_norm; const float* w_in; const float* q_norm_a; const float* k_norm_a; const float* q_norm_b; const float* k_norm_b;
    const float* rpb; const float* s5_a_re; const float* s5_a_im; const float* s5_log_dt; const float* s5_b_re; const float* s5_b_im; const float* s5_c_re; const float* s5_c_im;
    const float* s5_d; const float* w_glu; const float* out_norm_a; const float* out_norm_b; const float* out_norm_c; const float* w_out; const float* ffn_norm;
    const float* w_router; const float* w_gate; const float* w_up; const float* w_down;
    float* out; unsigned char* ws;
};

DEVI float bf2f(bf16_t b) { return __uint_as_float(((unsigned)b) << 16); }
DEVI bf16_t f2bf(float f) { unsigned u = __float_as_uint(f); u += 0x7FFFu + ((u >> 16) & 1u); return (bf16_t)(u >> 16); }
typedef __bf16 bf16x2_t __attribute__((ext_vector_type(2)));
DEVI unsigned pk2(float lo, float hi) { const f32x2 v = {lo, hi}; return __builtin_bit_cast(unsigned, __builtin_convertvector(v, bf16x2_t)); }
DEVI int tidx() { int t = threadIdx.x; asm volatile("" : "+v"(t)); return t; }
#define GAS __attribute__((address_space(1)))
DEVI unsigned char* wsp(const Params& P) { unsigned long long a = (unsigned long long)P.ws; asm volatile("" : "+s"(a)); return (unsigned char*)(GAS unsigned char*)a; }
DEVI int lnd(int v) { asm volatile("" : "+s"(v)); return v; }
template <int CTRL> DEVI float dppf(float v) { return __builtin_bit_cast(float, __builtin_amdgcn_update_dpp(0, __builtin_bit_cast(int, v), CTRL, 0xF, 0xF, true)); }
DEVI void swap16(float& a, float& b) { asm volatile("s_nop 1\n\tv_permlane16_swap_b32 %0, %1" : "+v"(a), "+v"(b)); }
DEVI void swap32(float& a, float& b) { asm volatile("s_nop 1\n\tv_permlane32_swap_b32 %0, %1" : "+v"(a), "+v"(b)); }
DEVI void swap16u(unsigned& a, unsigned& b) { asm volatile("s_nop 1\n\tv_permlane16_swap_b32 %0, %1" : "+v"(a), "+v"(b)); }
DEVI float xsum16(float v) { float a = v, b = v; swap16(a, b); return a + b; }
DEVI float xsum32(float v) { float a = v, b = v; swap32(a, b); return a + b; }
DEVI float xmax16(float v) { float a = v, b = v; swap16(a, b); return fmaxf(a, b); }
DEVI float xmax32(float v) { float a = v, b = v; swap32(a, b); return fmaxf(a, b); }
DEVI float row_sum16(float v) {
    v += dppf<0xB1>(v); v += dppf<0x4E>(v);
    v += dppf<0x141>(v); v += dppf<0x140>(v);
    return v;
}
DEVI float wave_sum(float v) { return xsum32(xsum16(row_sum16(v))); }
DEVI void unpk8s(float* d, const u32x4 q) {
    d[0] = __uint_as_float(q.x << 16); d[1] = __uint_as_float(q.x & 0xFFFF0000u); d[2] = __uint_as_float(q.y << 16); d[3] = __uint_as_float(q.y & 0xFFFF0000u);
    d[4] = __uint_as_float(q.z << 16); d[5] = __uint_as_float(q.z & 0xFFFF0000u); d[6] = __uint_as_float(q.w << 16); d[7] = __uint_as_float(q.w & 0xFFFF0000u);
}
DEVI float frcp(float x) { return __builtin_amdgcn_rcpf(x); }
DEVI float gelu_tanh(float y) { const float z = 0.7978845608028654f * (y + 0.044715f * y * y * y); const float t = 1.f - 2.f * frcp(1.f + __expf(2.f * z)); return 0.5f * y * (1.f + t); }

constexpr float kY8 = 32.f;
constexpr float kW8 = 64.f, kH8 = 8.f;
DEVI unsigned pk4_fp8(float a, float b, float c, float d) { unsigned w = 0u; w = __builtin_amdgcn_cvt_pk_fp8_f32(a, b, w, false); w = __builtin_amdgcn_cvt_pk_fp8_f32(c, d, w, true); return w; }
DEVI int cmap_head(int cs) { const int bj = cs >> 7, wc = (cs >> 5) & 3, n = (cs >> 4) & 1, fq = (cs >> 2) & 3, j = cs & 3; return 64 * wc + 32 * bj + 8 * fq + 4 * n + j; }
DEVI int cmap_pk(int cs)   { const int bj = cs >> 7, wc = (cs >> 5) & 3, n = (cs >> 4) & 1, fq = (cs >> 2) & 3, j = cs & 3; return 128 * bj + 32 * wc + 8 * fq + 4 * n + j; }
DEVI int cmap_gu(int cs)   { const int wc = (cs >> 5) & 3, n = (cs >> 4) & 1, fq = (cs >> 2) & 3, j = cs & 3; return 32 * wc + 8 * fq + 4 * n + j; }

template <int MODE>
DEVI void convert_item(const float* W0, const float* W1, int ldw, int K, bf16_t* Bt, int kt, int pn, unsigned char* lds) {
    bf16_t* t = (bf16_t*)lds;
    const int tid = tidx(), cs = tid & 255, kh = tid >> 8;
    int col;
    if (MODE == 0) col = pn * 256 + cs; else if (MODE == 1) col = pn * 256 + cmap_head(cs); else if (MODE == 2) col = pn * 256 + cmap_pk(cs); else col = pn * 128 + cmap_gu(cs);
    const float* src = ((MODE == 3 && (cs >> 7)) ? W1 : W0) + (size_t)(kt * 64 + 32 * kh) * ldw + col;
    float v[32];
#pragma unroll
    for (int i = 0; i < 32; ++i) v[i] = src[(size_t)i * ldw];
    if (MODE == 1) {
#pragma unroll
        for (int i = 0; i < 32; ++i) v[i] *= W1[kt * 64 + 32 * kh + i];
    }
#pragma unroll
    for (int q = 0; q < 4; ++q) { u32x4 w; w.x = pk2(v[8 * q], v[8 * q + 1]); w.y = pk2(v[8 * q + 2], v[8 * q + 3]); w.z = pk2(v[8 * q + 4], v[8 * q + 5]); w.w = pk2(v[8 * q + 6], v[8 * q + 7]);
        *(u32x4*)(t + cs * 72 + 32 * kh + 8 * q) = w; }
    __syncthreads();
#pragma unroll
    for (int it = 0; it < 4; ++it) {
        const int c = it * kNT + tid, row = c >> 3, part = c & 7;
        const u32x4 vv = *(const u32x4*)(t + row * 72 + part * 8);
        *(u32x4*)(Bt + (size_t)(pn * 256 + row) * K + kt * 64 + part * 8) = vv;
    }
    __syncthreads();
}

template <int MODE>
DEVI void convert_item8(const float* W0, const float* W1, int ldw, int K, unsigned char* Bt, int kt, int pn, unsigned char* lds) {
    unsigned char* t = lds;
    const int tid = tidx(), cs = tid & 255, kh = tid >> 8;
    const int col = (MODE == 2) ? pn * 256 + cmap_pk(cs) : pn * 128 + cmap_gu(cs);
    const float* src = ((MODE == 3 && (cs >> 7)) ? W1 : W0) + (size_t)(kt * 128 + 64 * kh) * ldw + col;
    float v[64];
#pragma unroll
    for (int i = 0; i < 64; ++i) v[i] = src[(size_t)i * ldw];
#pragma unroll
    for (int q = 0; q < 4; ++q) { u32x4 w;
        w.x = pk4_fp8(v[16 * q] * kW8, v[16 * q + 1] * kW8, v[16 * q + 2] * kW8, v[16 * q + 3] * kW8); w.y = pk4_fp8(v[16 * q + 4] * kW8, v[16 * q + 5] * kW8, v[16 * q + 6] * kW8, v[16 * q + 7] * kW8);
        w.z = pk4_fp8(v[16 * q + 8] * kW8, v[16 * q + 9] * kW8, v[16 * q + 10] * kW8, v[16 * q + 11] * kW8); w.w = pk4_fp8(v[16 * q + 12] * kW8, v[16 * q + 13] * kW8, v[16 * q + 14] * kW8, v[16 * q + 15] * kW8);
        *(u32x4*)(t + cs * 144 + 64 * kh + 16 * q) = w; }
    __syncthreads();
#pragma unroll
    for (int it = 0; it < 4; ++it) {
        const int c = it * kNT + tid, row = c >> 3, part = c & 7;
        const u32x4 vv = *(const u32x4*)(t + row * 144 + part * 16);
        *(u32x4*)(Bt + (size_t)(pn * 256 + row) * K + kt * 128 + part * 16) = vv;
    }
    __syncthreads();
}

DEVI void phase_convert(const Params& P, unsigned char* lds, int bid, int nblk) {
    constexpr int N_WIN = kL * 16 * 10, N_WOUT = kL * 16 * 4, N_WGLU = kL * 4 * 1, N_WGU = kL * kE * 8 * 16, N_WD = kL * kE * 16 * 4;
    constexpr int TOT = N_WIN + N_WOUT + N_WGLU + N_WGU + N_WD;
    for (int it = bid; it < TOT; it += nblk) {
        int i = it;
        if (i < N_WIN) { const int l = i / 160, r = i % 160, kt = r / 10, pn = r % 10;
            convert_item<1>(P.w_in + (size_t)l * kD * kINW, P.attn_norm + (size_t)l * kD, kINW, kD, (bf16_t*)(wsp(P) + WS_WINT) + (size_t)l * kINW * kD, kt, pn, lds); continue; }
        i -= N_WIN;
        if (i < N_WOUT) { const int l = i / 64, r = i % 64, kt = r / 4, pn = r % 4;
            convert_item<2>(P.w_out + (size_t)l * kD * kD, nullptr, kD, kD, (bf16_t*)(wsp(P) + WS_WOUTT) + (size_t)l * kD * kD, kt, pn, lds); continue; }
        i -= N_WOUT;
        if (i < N_WGLU) { const int l = i / 4, kt = i % 4;
            convert_item<2>(P.w_glu + (size_t)l * 256 * 256, nullptr, 256, 256, (bf16_t*)(wsp(P) + WS_WGLUT) + (size_t)l * 256 * 256, kt, 0, lds); continue; }
        i -= N_WGLU;
        if (i < N_WGU) { const int le = i / 128, r = i % 128, kt = r / 16, pn = r % 16;
            convert_item8<3>(P.w_gate + (size_t)le * kD * kFF, P.w_up + (size_t)le * kD * kFF, kFF, kD, wsp(P) + WS_WGUT + (size_t)le * 4096 * kD, kt, pn, lds); continue; }
        i -= N_WGU;
        { const int le = i / 64, r = i % 64, kt = r / 4, pn = r % 4;
            convert_item8<2>(P.w_down + (size_t)le * kFF * kD, nullptr, kD, kFF, wsp(P) + WS_WDT + (size_t)le * kD * kFF, kt, pn, lds); }
    }
}

DEVI void phase_norm(const float* x, bf16_t* xb, float* rstdp, int bid, int nblk) {
    const int wid = tidx() >> 6, lane = tidx() & 63;
    for (int row = bid * 8 + wid; row < kTok; row += nblk * 8) {
        f32x4 v[4]; float ss = 0.f;
#pragma unroll
        for (int q = 0; q < 4; ++q) { v[q] = *(const f32x4*)(x + (size_t)row * kD + q * 256 + lane * 4); ss += v[q].x * v[q].x + v[q].y * v[q].y + v[q].z * v[q].z + v[q].w * v[q].w; }
        ss = wave_sum(ss);
        if (lane == 0) rstdp[row] = rsqrtf(ss * (1.f / kD) + kEps);
#pragma unroll
        for (int q = 0; q < 4; ++q) { const f32x4 t = v[q];
            u32x2 o; o.x = pk2(t.x, t.y); o.y = pk2(t.z, t.w);
            *(u32x2*)(xb + (size_t)row * kD + q * 256 + lane * 4) = o; }
    }
}

DEVI void router_prep(const Params& P, int bid, int nblk) {
    unsigned char* tbase = wsp(P) + WS_RTAB;
    for (int i = bid * kNT + tidx(); i < kL * 2048; i += nblk * kNT) {
        const int L = i >> 11, s = (i >> 6) & 31, l = i & 63, e = l & 15, k0 = 64 * (s >> 1) + 16 * (l >> 4) + 8 * (s & 1);
        const float* wr = P.w_router + (size_t)L * kD * kE; const float* gain = P.ffn_norm + (size_t)L * kD;
        unsigned hh[4], ll[4];
#pragma unroll
        for (int j = 0; j < 4; ++j) { const float w0 = wr[(k0 + 2 * j) * 16 + e] * gain[k0 + 2 * j], w1 = wr[(k0 + 2 * j + 1) * 16 + e] * gain[k0 + 2 * j + 1];
            const unsigned hp = pk2(w0, w1); hh[j] = hp; ll[j] = pk2(w0 - __uint_as_float(hp << 16), w1 - __uint_as_float(hp & 0xFFFF0000u)); }
        u32x4 hi, lo; hi.x = hh[0]; hi.y = hh[1]; hi.z = hh[2]; hi.w = hh[3]; lo.x = ll[0]; lo.y = ll[1]; lo.z = ll[2]; lo.w = ll[3];
        unsigned char* tb = tbase + (size_t)L * 65536;
        *(u32x4*)(tb + (2 * s) * 1024 + l * 16) = hi; *(u32x4*)(tb + (2 * s + 1) * 1024 + l * 16) = lo;
    }
}
DEVI void phase_router(const bf16_t* x, const float* gain, const unsigned char* rtab  , unsigned char* h8, float* aff, LAS unsigned char* lds, int bid, int nblk) {
    LAS unsigned char* wtab = lds;
    LAS float* gtab = (LAS float*)(lds + 65536);
    const int tid = tidx(), wid = __builtin_amdgcn_readfirstlane(tid >> 6), lane = tid & 63, r = lane & 15, c4 = lane >> 4;
    __syncthreads();
    for (int i = tid; i < 1024; i += kNT) gtab[i] = gain[i];
#pragma unroll
    for (int i = 0; i < 8; ++i)
        __builtin_amdgcn_global_load_lds((const unsigned*)(rtab + (size_t)(i * kNT + tid) * 16), (LAS unsigned*)(wtab + (i * 8 + wid) * 1024), 16, 0, 0);
    asm volatile("s_waitcnt vmcnt(0)" ::: "memory");
    __syncthreads();
    u32x4 xr[32];
    const int ntile = kTok / 16, tstride = nblk * 8;
    int tile = bid * 8 + wid;
#define RT_ISSUE(half, tile_) do { const bf16_t* xp_ = x + (size_t)((tile_) * 16 + r) * kD + 16 * c4; \
        _Pragma("unroll") for (int u = 8 * (half); u < 8 * (half) + 8; ++u) { xr[2 * u] = *(const u32x4*)(xp_ + 64 * u); xr[2 * u + 1] = *(const u32x4*)(xp_ + 64 * u + 8); } } while (0)
    if (tile < ntile) { RT_ISSUE(0, tile); RT_ISSUE(1, tile); }
    for (; tile < ntile; tile += tstride) {
        asm volatile("" ::: "memory");
        f32x4 Lh = {0.f, 0.f, 0.f, 0.f}, Ll = {0.f, 0.f, 0.f, 0.f}, G = {0.f, 0.f, 0.f, 0.f};
#pragma unroll
        for (int s = 0; s < 32; ++s) {
            const bf16x8 wh = *(const LAS bf16x8*)(wtab + (2 * s) * 1024 + lane * 16), wl = *(const LAS bf16x8*)(wtab + (2 * s + 1) * 1024 + lane * 16);
            const bf16x8 xb = __builtin_bit_cast(bf16x8, xr[s]);
            Lh = __builtin_amdgcn_mfma_f32_16x16x32_bf16(wh, xb, Lh, 0, 0, 0);
            Ll = __builtin_amdgcn_mfma_f32_16x16x32_bf16(wl, xb, Ll, 0, 0, 0);
            G = __builtin_amdgcn_mfma_f32_16x16x32_bf16(xb, xb, G, 0, 0, 0);
        }
        const float dsel = ((r & 3) == 0) ? G.x : ((r & 3) == 1) ? G.y : ((r & 3) == 2) ? G.z : G.w;
        const float ss = __builtin_bit_cast(float, __builtin_amdgcn_ds_bpermute((16 * (r >> 2) + r) * 4, __builtin_bit_cast(int, dsel)));
        const float rstd = rsqrtf(ss * (1.f / kD) + kEps);
        const f32x4 lg = (Lh + Ll) * rstd;
        float mx = fmaxf(fmaxf(lg.x, lg.y), fmaxf(lg.z, lg.w)); mx = xmax32(xmax16(mx));
        f32x4 ex; ex.x = __expf(lg.x - mx); ex.y = __expf(lg.y - mx); ex.z = __expf(lg.z - mx); ex.w = __expf(lg.w - mx);
        float sm = (ex.x + ex.y) + (ex.z + ex.w); sm = xsum32(xsum16(sm));
        const float inv = frcp(sm);
        const int row0 = tile * 16, b = row0 >> 13, s0 = (row0 & (kS - 1)) + r;
        { float* ap = aff + ((size_t)(b * kE + 4 * c4)) * kS + s0;
          ap[0] = ex.x * inv; ap[kS] = ex.y * inv; ap[2 * kS] = ex.z * inv; ap[3 * kS] = ex.w * inv; }
        unsigned char* hp = h8 + (size_t)(row0 + r) * kD + 16 * c4;
        const int ntl = tile + tstride;
#pragma unroll
        for (int half = 0; half < 2; ++half) {
#pragma unroll
            for (int u = 8 * half; u < 8 * half + 8; ++u) {
                float v[16]; unpk8s(v, xr[2 * u]); unpk8s(v + 8, xr[2 * u + 1]);
                u32x4 o; unsigned ow[4];
#pragma unroll
                for (int q = 0; q < 4; ++q) { const f32x4 gq = *(const LAS f32x4*)(gtab + 64 * u + 16 * c4 + 4 * q);
                    const f32x4 t = (f32x4){v[4 * q], v[4 * q + 1], v[4 * q + 2], v[4 * q + 3]} * gq * rstd;
                    ow[q] = pk4_fp8(t.x, t.y, t.z, t.w); }
                o.x = ow[0]; o.y = ow[1]; o.z = ow[2]; o.w = ow[3];
                *(u32x4*)(hp + 64 * u) = o;
            }
            if (ntl < ntile) { if (half == 0) RT_ISSUE(0, ntl); else RT_ISSUE(1, ntl); }
        }
    }
#undef RT_ISSUE
    __syncthreads();
}

DEVI int block_excl_scan(int v, int* sh  , int& total) {
    const int lane = tidx() & 63, wid = tidx() >> 6;
    int incl = v;
#pragma unroll
    for (int d = 1; d < 64; d <<= 1) { const int o = __shfl_up(incl, d); if (lane >= d) incl += o; }
    __syncthreads();
    if (lane == 63) sh[wid] = incl;
    __syncthreads();
    int base = 0, tot = 0;
#pragma unroll
    for (int w = 0; w < 8; ++w) { const int c = sh[w]; if (w < wid) base += c; tot += c; }
    total = tot;
    return base + incl - v;
}

DEVI void phase_topk(const float* aff, int* idx, float* gate, int* tokslot, const unsigned char* hsrc, unsigned char* xe, int rowbytes, unsigned char* lds, int bid, int nblk) {
    int* hist = (int*)lds;
    int* sh = hist + 256;
    int* res = sh + 16;
    (void)hsrc; (void)xe; (void)rowbytes;
    const int tid = tidx(), lane = tid & 63, wid = tid >> 6;
    const int share = (nblk >= 2 * kB * kE) ? 2 : 1;
    for (int wi = bid; wi < kB * kE * share; wi += nblk) {
        const int item = wi / share, part = wi - item * share;
        const int b = item >> 4, e = item & 15;
        const float* a = aff + (size_t)item * kS;
        unsigned key[16];
#pragma unroll
        for (int q = 0; q < 4; ++q) { const u32x4 v = *(const u32x4*)(a + tid * 16 + q * 4); key[q * 4 + 0] = v.x; key[q * 4 + 1] = v.y; key[q * 4 + 2] = v.z; key[q * 4 + 3] = v.w; }
        unsigned prefix = 0; int kk = kCap;
#pragma unroll 1
        for (int pass = 0; pass < 4; ++pass) {
            const int shift = 24 - 8 * pass;
            __syncthreads();
            if (tid < 256) hist[tid] = 0;
            __syncthreads();
#pragma unroll
            for (int i = 0; i < 16; ++i) { const bool in = (pass == 0) || ((key[i] >> (shift + 8)) == prefix); if (in) atomicAdd(&hist[(key[i] >> shift) & 255], 1); }
            __syncthreads();
            if (wid == 0) {
                int c[4], loc = 0;
#pragma unroll
                for (int j = 0; j < 4; ++j) { c[j] = hist[255 - 4 * lane - j]; loc += c[j]; }
                int incl = loc;
#pragma unroll
                for (int d = 1; d < 64; d <<= 1) { const int o = __shfl_up(incl, d); if (lane >= d) incl += o; }
                const int excl = incl - loc;
                if (excl < kk && kk <= incl) { int run = excl; int bin = 0, nk = 0; bool found = false;
#pragma unroll
                    for (int j = 0; j < 4; ++j) { if (!found && run + c[j] >= kk) { bin = 255 - 4 * lane - j; nk = kk - run; found = true; } if (!found) run += c[j]; }
                    res[0] = bin; res[1] = nk; }
            }
            __syncthreads();
            prefix = (prefix << 8) | (unsigned)res[0]; kk = res[1];
        }
        const unsigned T = prefix;
        int ceq = 0;
#pragma unroll
        for (int i = 0; i < 16; ++i) ceq += (key[i] == T) ? 1 : 0;
        int tot;
        int eqb = block_excl_scan(ceq, sh, tot);
        int csel = 0; unsigned selmask = 0;
#pragma unroll
        for (int i = 0; i < 16; ++i) { bool s = key[i] > T; if (key[i] == T) { s = eqb < kk; ++eqb; } if (s) { selmask |= 1u << i; ++csel; } }
        int slot = block_excl_scan(csel, sh, tot);
        const size_t rbase = (size_t)(e * kB + b) * kCap;
#pragma unroll
        for (int i = 0; i < 16; ++i) { const int s = tid * 16 + i; const bool sel = (selmask >> i) & 1u;
            const bool mine = (share == 1) || ((i >> 3) == part);
            if (sel && mine) { idx[rbase + slot] = b * kS + s; gate[rbase + slot] = __uint_as_float(key[i]) * (1.f / kY8)  ; }
            if (mine) tokslot[((size_t)(b * kS + s)) * kE + e] = sel ? slot : -1;
            if (sel) ++slot; }
    }
    __syncthreads();
}

struct Unit { int pm, pn, par; };
DEVI bool unit_of(int Lid, int nM, int nN, Unit& u) {
    const int nwg = nM * nN; if (Lid >= nwg) return false;
    int wgid = Lid; { const int q = nwg / 8, r = nwg % 8, xcd = wgid % 8, off = wgid / 8; wgid = (xcd < r ? xcd * (q + 1) : r * (q + 1) + (xcd - r) * q) + off; }
    const int nig = 8 * nN, gid = wgid / nig, fm = gid * 8, gsz = (nM - fm) < 8 ? (nM - fm) : 8;
    u.pm = fm + ((wgid % nig) % gsz); u.pn = (wgid % nig) / gsz; return true;
}
struct GemmD { const bf16_t* A; const bf16_t* Bt; int lda, K, nM, nN; const int* rowidx; size_t bstride; int pmg; };

constexpr int PG_HTB = 128 * 64 * 2;
DEVI int pg_lds_byte(int r, int c) { const int st = (r >> 4) * 2 + (c >> 5), rr = r & 15, cc = c & 31, ob = rr * 64 + cc * 2; return st * 1024 + (ob ^ (((ob >> 9) & 1) << 5)); }
DEVI void pg_stage_rc(int b, int& R, int& C) { const int st = b / 1024, sb = b % 1024, swz = sb ^ (((sb >> 9) & 1) << 5); R = (st >> 1) * 16 + swz / 64; C = (st & 1) * 32 + (swz % 64) / 2; }

typedef int v4i __attribute__((ext_vector_type(4)));
typedef int v8i __attribute__((ext_vector_type(8)));
constexpr int PG_RIDX = 131072 + 4096;
template <class Epi, bool ALIGN_EPI, bool SP2, bool FP8 = false, bool GATHER = false>
DEVI void gemm_engine(LAS unsigned char* lds, const GemmD g, const Epi& E, int bid, int nblk) {
    const int tid = tidx(), wid = __builtin_amdgcn_readfirstlane(tid >> 6), lane = tid & 63, wr = wid >> 2, wc = wid & 3, fr = lane & 15, fq = lane >> 4;
    constexpr int ES = FP8 ? 1 : 2;
    const int K = g.K * ES  , nt = K / 128; const unsigned ldaB = (unsigned)g.lda * ES;
    unsigned voffA[2], voffB[2];
#pragma unroll
    for (int i = 0; i < 2; ++i) { int R, C; pg_stage_rc(tid * 16 + i * 8192, R, C); voffA[i] = (unsigned)R * ldaB + (unsigned)C * 2u; voffB[i] = (unsigned)(R * K + C * 2); }
    const size_t kstep = 128;
    int gR0 = 0; unsigned gcb = 0; { int R, C; pg_stage_rc(tid * 16, R, C); gR0 = R; gcb = (unsigned)C * 2u; } (void)gR0; (void)gcb;
    const size_t hstepB = (size_t)128 * K, hstepA = (size_t)128 * ldaB, tstepA = 2 * hstepA;
    const unsigned ldsw = (unsigned)wid * 1024u;
    const int aoff = pg_lds_byte(wr * 64 + fr, fq * 8), boff = pg_lds_byte(wc * 32 + fr, fq * 8);
#define PG8_SA(b, h) (((b) * 2 + (h)) * PG_HTB)
#define PG8_SB(b, h) ((4 + (b) * 2 + (h)) * PG_HTB)
#define PG8_STAGE(bufoff, gbase, voff) do { _Pragma("unroll") for (int _i = 0; _i < 2; ++_i) \
        __builtin_amdgcn_global_load_lds((const unsigned*)((const char*)(gbase) + (voff)[_i]), (LAS unsigned*)(lds + (bufoff) + ldsw + _i * 8192), 16, 0, 0); } while (0)
#define PG8_STA(bufoff, ptr, koff, half, par) do { if constexpr (GATHER) { \
        const LAS int* rt_ = (const LAS int*)(lds + PG_RIDX + (par) * 1024) + 128 * (half) + gR0; \
        _Pragma("unroll") for (int _i = 0; _i < 2; ++_i) { const unsigned off_ = (unsigned)rt_[64 * _i] * ldaB + gcb; \
            __builtin_amdgcn_global_load_lds((const unsigned*)((const char*)g.A + (koff) + off_), (LAS unsigned*)(lds + (bufoff) + ldsw + _i * 8192), 16, 0, 0); } \
    } else PG8_STAGE(bufoff, ptr, voffA); } while (0)
#define PG8_RD16(off) (*(const LAS v4i*)(lds + (off)))
#define PG8_CAT2(off) __builtin_shufflevector(PG8_RD16(off), PG8_RD16((off) + 1024), 0, 1, 2, 3, 4, 5, 6, 7)
#define PG8_LDA(dst, b, h) do { _Pragma("unroll") for (int m = 0; m < 4; ++m) { if constexpr (FP8) dst##8[m] = PG8_CAT2(PG8_SA(b, h) + aoff + m * 2048); \
        else { _Pragma("unroll") for (int k = 0; k < 2; ++k) dst[m][k] = *(const LAS bf16x8*)(lds + PG8_SA(b, h) + aoff + m * 2048 + k * 1024); } } } while (0)
#define PG8_LDB(dst, b, h) do { _Pragma("unroll") for (int n = 0; n < 2; ++n) { if constexpr (FP8) dst##8[n] = PG8_CAT2(PG8_SB(b, h) + boff + n * 2048); \
        else { _Pragma("unroll") for (int k = 0; k < 2; ++k) dst[n][k] = *(const LAS bf16x8*)(lds + PG8_SB(b, h) + boff + n * 2048 + k * 1024); } } } while (0)
#define PG8_MMA(ai, bj, At, Bt) do { __builtin_amdgcn_s_setprio(1); _Pragma("unroll") for (int m = 0; m < 4; ++m) _Pragma("unroll") for (int n = 0; n < 2; ++n) { \
        if constexpr (FP8) asm volatile("v_mfma_f32_16x16x128_f8f6f4 %0, %1, %2, %0" : "+v"(acc[ai][bj][m][n]) : "v"(Bt##8[n]), "v"(At##8[m]));   \
        else { _Pragma("unroll") for (int k = 0; k < 2; ++k) acc[ai][bj][m][n] = __builtin_amdgcn_mfma_f32_16x16x32_bf16(Bt[n][k], At[m][k], acc[ai][bj][m][n], 0, 0, 0); } } \
        __builtin_amdgcn_s_setprio(0); } while (0)
#define PG8_MMAZ(ai, bj, At, Bt) do { __builtin_amdgcn_s_setprio(1); _Pragma("unroll") for (int m = 0; m < 4; ++m) _Pragma("unroll") for (int n = 0; n < 2; ++n) { \
        if constexpr (FP8) asm volatile("v_mfma_f32_16x16x128_f8f6f4 %0, %1, %2, 0" : "=&v"(acc[ai][bj][m][n]) : "v"(Bt##8[n]), "v"(At##8[m])); \
        else { asm volatile("v_mfma_f32_16x16x32_bf16 %0, %1, %2, 0" : "=&v"(acc[ai][bj][m][n]) : "v"(Bt[n][0]), "v"(At[m][0])); \
               acc[ai][bj][m][n] = __builtin_amdgcn_mfma_f32_16x16x32_bf16(Bt[n][1], At[m][1], acc[ai][bj][m][n], 0, 0, 0); } } \
        __builtin_amdgcn_s_setprio(0); } while (0)
#define PG8_WAIT_V(n) asm volatile("s_waitcnt vmcnt(" #n ")" ::: "memory")
#define PG8_WAIT_L(n) asm volatile("s_waitcnt lgkmcnt(" #n ")" ::: "memory")
#define PG8_BAR __builtin_amdgcn_s_barrier()
#define PG8_SCHED __builtin_amdgcn_sched_barrier(0)
    Unit cur, nxt; int ui = 0;
    if (!unit_of(bid, g.nM, g.nN, cur)) return;
    cur.par = 0; E.stage(lds, cur, wid, lane);
    if constexpr (GATHER) {
        if (wid < 4) __builtin_amdgcn_global_load_lds((const unsigned*)(g.rowidx + cur.pm * 256 + wid * 64 + lane), (LAS unsigned*)(lds + PG_RIDX + wid * 256), 4, 0, 0);
        asm volatile("s_waitcnt vmcnt(0)" ::: "memory"); __builtin_amdgcn_s_barrier();
    }
    f32x4 acc[2][2][4][2];
    if constexpr (!FP8) {
#pragma unroll
    for (int a = 0; a < 2; ++a)
#pragma unroll
        for (int b = 0; b < 2; ++b)
#pragma unroll
            for (int m = 0; m < 4; ++m)
#pragma unroll
                for (int n = 0; n < 2; ++n) acc[a][b][m][n] = (f32x4){0.f, 0.f, 0.f, 0.f};
    }
    bf16x8 At[4][2], B0[2][2], B1[2][2]; v8i At8[4], B08[2], B18[2];
    (void)At; (void)B0; (void)B1; (void)At8; (void)B08; (void)B18;
    static_assert(SP2, "only the two-super-phase K-loop is kept");
    const char* cA = (const char*)g.A + (size_t)cur.pm * tstepA;
    const char* cB = (const char*)g.Bt + (size_t)(cur.pm / g.pmg) * g.bstride * ES + (size_t)cur.pn * 256 * K;
    PG8_STAGE(PG8_SB(0, 0), cB, voffB); PG8_STAGE(PG8_SB(0, 1), cB + hstepB, voffB); PG8_STA(PG8_SA(0, 0), cA, 0u, 0, 0); PG8_STA(PG8_SA(0, 1), cA + hstepA, 0u, 1, 0);
    if (wr == 1) PG8_BAR;
    PG8_WAIT_V(2); PG8_BAR;
    PG8_STAGE(PG8_SB(1, 0), cB + kstep, voffB); PG8_STA(PG8_SA(1, 0), cA + kstep, 128u, 0, 0); PG8_STAGE(PG8_SB(1, 1), cB + hstepB + kstep, voffB);
    PG8_WAIT_V(6); PG8_BAR;
    for (;;) {
        const bool has_next = unit_of((ui + 1) * nblk + bid, g.nM, g.nN, nxt); nxt.par = (ui + 1) & 1;
        if constexpr (GATHER) { if (has_next && wid < 4) __builtin_amdgcn_global_load_lds((const unsigned*)(g.rowidx + nxt.pm * 256 + wid * 64 + lane), (LAS unsigned*)(lds + PG_RIDX + nxt.par * 1024 + wid * 256), 4, 0, 0); }
        const char* nA = has_next ? (const char*)g.A + (size_t)nxt.pm * tstepA : cA;
        const char* nB = has_next ? (const char*)g.Bt + (size_t)(nxt.pm / g.pmg) * g.bstride * ES + (size_t)nxt.pn * 256 * K : cB;
#define PG8_TRIP(MM) do { \
            const bool last = (t == nt - 2); \
            const char* a1 = cA + (size_t)(t + 1) * kstep; \
            const char* a2 = last ? nA : cA + (size_t)(t + 2) * kstep; const char* b2 = last ? nB : cB + (size_t)(t + 2) * kstep; \
            const char* a3 = a2 + kstep; const char* b3 = b2 + kstep; \
            const unsigned gk1 = (unsigned)(t + 1) * 128u, gk2 = last ? 0u : (unsigned)(t + 2) * 128u, gk3 = gk2 + 128u; const int gp2 = (last && has_next) ? nxt.par : cur.par; (void)gk1; (void)gk2; (void)gk3; (void)gp2; \
            PG8_LDB(B0, 0, 0); PG8_LDB(B1, 0, 1); PG8_SCHED; PG8_LDA(At, 0, 0); PG8_STA(PG8_SA(1, 1), a1 + hstepA, gk1, 1, cur.par); \
            PG8_WAIT_V(8); PG8_WAIT_L(0); PG8_BAR; MM(0, 0, At, B0); MM(0, 1, At, B1); PG8_BAR; PG8_SCHED; \
            PG8_LDA(At, 0, 1); PG8_STAGE(PG8_SB(0, 0), b2, voffB); PG8_STAGE(PG8_SB(0, 1), b2 + hstepB, voffB); PG8_STA(PG8_SA(0, 0), a2, gk2, 0, gp2); \
            PG8_WAIT_V(8); PG8_WAIT_L(0); PG8_BAR; MM(1, 0, At, B0); MM(1, 1, At, B1); PG8_BAR; PG8_SCHED; \
            PG8_LDB(B0, 1, 0); PG8_LDB(B1, 1, 1); PG8_SCHED; PG8_LDA(At, 1, 0); PG8_STA(PG8_SA(0, 1), a2 + hstepA, gk2, 1, gp2); \
            PG8_WAIT_V(8); PG8_WAIT_L(0); PG8_BAR; PG8_MMA(0, 0, At, B0); PG8_MMA(0, 1, At, B1); PG8_BAR; PG8_SCHED; \
            PG8_LDA(At, 1, 1); PG8_STAGE(PG8_SB(1, 0), b3, voffB); PG8_STAGE(PG8_SB(1, 1), b3 + hstepB, voffB); PG8_STA(PG8_SA(1, 0), a3, gk3, 0, gp2); \
            PG8_WAIT_V(8); PG8_WAIT_L(0); PG8_BAR; PG8_MMA(1, 0, At, B0); PG8_MMA(1, 1, At, B1); PG8_BAR; PG8_SCHED; } while (0)
        int t = 0;
        if constexpr (FP8) { PG8_TRIP(PG8_MMAZ); t = 2; }
#pragma unroll 1
        for (; t < nt; t += 2) PG8_TRIP(PG8_MMA);
#undef PG8_TRIP
        if constexpr (ALIGN_EPI) { if (wr == 0) PG8_BAR; }
        if constexpr (FP8) asm volatile("s_nop 15\n\ts_nop 15" ::: "memory");
        E(acc, cur, wr, wc, fr, fq);
        if (!has_next) break;
        E.stage(lds, nxt, wid, lane);
        if constexpr (!FP8) {
#pragma unroll
        for (int a = 0; a < 2; ++a)
#pragma unroll
            for (int b = 0; b < 2; ++b)
#pragma unroll
                for (int m = 0; m < 4; ++m)
#pragma unroll
                    for (int n = 0; n < 2; ++n) acc[a][b][m][n] = (f32x4){0.f, 0.f, 0.f, 0.f};
        }
        cur = nxt; cA = nA; cB = nB; ++ui;
        if constexpr (ALIGN_EPI) { if (wr == 1) PG8_BAR; }
    }
    PG8_WAIT_V(0);
    if constexpr (!ALIGN_EPI) { if (wr == 0) PG8_BAR; }
    PG8_BAR;
#undef PG8_SA
#undef PG8_SB
#undef PG8_STAGE
#undef PG8_STA
#undef PG8_LDA
#undef PG8_LDB
#undef PG8_MMA
#undef PG8_MMAZ
#undef PG8_RD16
#undef PG8_CAT2
#undef PG8_WAIT_V
#undef PG8_WAIT_L
#undef PG8_BAR
#undef PG8_SCHED
}

struct EpiQKV {
    static constexpr int VMOPS = 16;
    bf16_t *qa, *ka, *va, *qb, *kb, *vb, *ux;
    const float* rstdp;
    const LAS float* rtab;
    DEVI void stage(LAS unsigned char* lds, const Unit& u, int wid, int lane) const {
        if (wid < 4) __builtin_amdgcn_global_load_lds((const unsigned*)(rstdp + u.pm * 256 + wid * 64 + lane), (LAS unsigned*)(lds + 131072 + 2048 + u.par * 1024 + wid * 256), 4, 0, 0);
    }
    const LAS float* gtab;
    DEVI void operator()(const f32x4 (&acc)[2][2][4][2], const Unit& u, int wr, int wc, int fr, int fq) const {
        const int pn = u.pn;
        bf16_t* dst = (pn < 2) ? qa : (pn < 4) ? ka : (pn < 6) ? va : (pn == 6) ? qb : (pn == 7) ? kb : (pn == 8) ? vb : ux;
        const int H = (pn < 6) ? 8 : 4, head = ((pn < 6) ? (pn & 1) * 4 : 0) + wc;
        const int trow = (pn < 2) ? 0 : (pn < 4) ? 1 : (pn == 6) ? 2 : (pn == 7) ? 3 : 4;
        const bool nrm = trow < 4;
        f32x4 gv[2][2];
#pragma unroll
        for (int bj = 0; bj < 2; ++bj)
#pragma unroll
            for (int n = 0; n < 2; ++n) gv[bj][n] = *(const LAS f32x4*)(gtab + trow * 64 + 32 * bj + 8 * fq + 4 * n);
        const size_t hb = (size_t)head * kS * 64 + 8 * fq;
        const int g0 = 4 * wc + (fq >> 1), c0 = 8 * (fq & 1);
#pragma unroll
        for (int ai = 0; ai < 2; ++ai)
#pragma unroll
            for (int m = 0; m < 4; ++m) {
                const int row = u.pm * 256 + 128 * ai + 64 * wr + 16 * m + fr;
                float ss = 0.f;
#pragma unroll
                for (int bj = 0; bj < 2; ++bj)
#pragma unroll
                    for (int n = 0; n < 2; ++n) { const f32x4 v = acc[ai][bj][m][n]; ss += v.x * v.x + v.y * v.y + v.z * v.z + v.w * v.w; }
                ss = xsum32(xsum16(ss));
                const float rr = rtab[u.par * 256 + 128 * ai + 64 * wr + 16 * m + fr];
                const float rs = __builtin_amdgcn_rsqf(ss * rr * rr * (1.f / 64.f) + kEps) * rr, rstd = nrm ? rs : rr;
                const int b = row >> 13, sq = row & (kS - 1);
                const size_t o_qkv = ((size_t)b * H * kS + sq) * 64 + hb, o_u = ((size_t)g0 * 4096 + (row >> 4)) * 512 + (row & 15) * 16 + c0;
#pragma unroll
                for (int bj = 0; bj < 2; ++bj) {
                    const f32x4 v0 = acc[ai][bj][m][0] * rstd * gv[bj][0], v1 = acc[ai][bj][m][1] * rstd * gv[bj][1];
                    u32x4 w; w.x = pk2(v0.x, v0.y); w.y = pk2(v0.z, v0.w); w.z = pk2(v1.x, v1.y); w.w = pk2(v1.z, v1.w);
                    const size_t o = (pn < 9) ? o_qkv + 32 * bj : o_u + (size_t)bj * 2 * 4096 * 512;
                    *(u32x4*)(dst + o) = w;
                }
            }
    }
};
struct EpiResid {
    DEVI void stage(LAS unsigned char*, const Unit&, int, int) const {}
    static constexpr int VMOPS = 16;
    bf16_t* xb; bf16_t* xbo;
    DEVI void operator()(const f32x4 (&acc)[2][2][4][2], const Unit& u, int wr, int wc, int fr, int fq) const {
#pragma unroll
        for (int ai = 0; ai < 2; ++ai) {
            const size_t r0 = (size_t)(u.pm * 256 + 128 * ai + 64 * wr + fr) * kD + u.pn * 256 + 32 * wc + 8 * fq;
            {
                u32x4 a[4][2];
#pragma unroll
                for (int m = 0; m < 4; ++m)
#pragma unroll
                    for (int bj = 0; bj < 2; ++bj) a[m][bj] = *(const u32x4*)(xb + r0 + (size_t)m * 16 * kD + 128 * bj);
#pragma unroll
                for (int m = 0; m < 4; ++m)
#pragma unroll
                    for (int bj = 0; bj < 2; ++bj) { const size_t o = r0 + (size_t)m * 16 * kD + 128 * bj; const u32x4 w = a[m][bj];
                        const f32x4 v0 = (f32x4){__uint_as_float(w.x << 16), __uint_as_float(w.x & 0xFFFF0000u), __uint_as_float(w.y << 16), __uint_as_float(w.y & 0xFFFF0000u)} + acc[ai][bj][m][0];
                        const f32x4 v1 = (f32x4){__uint_as_float(w.z << 16), __uint_as_float(w.z & 0xFFFF0000u), __uint_as_float(w.w << 16), __uint_as_float(w.w & 0xFFFF0000u)} + acc[ai][bj][m][1];
                        u32x4 r; r.x = pk2(v0.x, v0.y); r.y = pk2(v0.z, v0.w); r.z = pk2(v1.x, v1.y); r.w = pk2(v1.z, v1.w); *(u32x4*)(xbo + o) = r; }
            }
        }
    }
};
struct EpiGU {
    DEVI void stage(LAS unsigned char*, const Unit&, int, int) const {}
    static constexpr int VMOPS = 4;
    bf16_t* hid; float sc;
    DEVI void silu8(const f32x4 (&acc)[2][2][4][2], int ai, int m, float (&o)[8]) const {
        const float k1 = -sc * kLog2e, k3 = 1.f / (sc * sc * kH8);
#pragma unroll
        for (int n = 0; n < 2; ++n)
#pragma unroll
            for (int j = 0; j < 4; j += 2) { const f32x2 a = {acc[ai][0][m][n][j], acc[ai][0][m][n][j + 1]}, b = {acc[ai][1][m][n][j], acc[ai][1][m][n][j + 1]};
                const f32x2 ab = a * b, t = a * k1; f32x2 d; d.x = __builtin_amdgcn_exp2f(t.x); d.y = __builtin_amdgcn_exp2f(t.y); d = d * k3 + k3;
                f32x2 r; r.x = frcp(d.x); r.y = frcp(d.y); const f32x2 v = ab * r;
                o[n * 4 + j] = v.x; o[n * 4 + j + 1] = v.y; }
    }
    DEVI void operator()(const f32x4 (&acc)[2][2][4][2], const Unit& u, int wr, int wc, int fr, int fq) const {
#pragma unroll
        for (int ai = 0; ai < 2; ++ai)
#pragma unroll
            for (int m = 0; m < 4; m += 2) {
                float o0[8], o1[8]; silu8(acc, ai, m, o0); silu8(acc, ai, m + 1, o1);
                unsigned ax = pk4_fp8(o0[0], o0[1], o0[2], o0[3]), ay = pk4_fp8(o0[4], o0[5], o0[6], o0[7]), bx = pk4_fp8(o1[0], o1[1], o1[2], o1[3]), by = pk4_fp8(o1[4], o1[5], o1[6], o1[7]);
                swap16u(ax, bx); swap16u(ay, by);
                const size_t row = (size_t)(u.pm * 256 + 128 * ai + 64 * wr + 16 * (m + (fq & 1)) + fr);
                u32x4 w; w.x = ax; w.y = ay; w.z = bx; w.w = by;
                *(u32x4*)((unsigned char*)hid + row * kFF + u.pn * 128 + 32 * wc + 8 * (fq & ~1)) = w;
            }
    }
};
struct EpiDown {
    DEVI void stage(LAS unsigned char*, const Unit&, int, int) const {}
    static constexpr int VMOPS = 8;
    bf16_t* y; float sc;
    DEVI static unsigned pk4c(const f32x4 v) { return pk4_fp8(v.x, v.y, v.z, v.w); }
    DEVI void operator()(const f32x4 (&acc)[2][2][4][2], const Unit& u, int wr, int wc, int fr, int fq) const {
        const float gv = sc * kY8;
#pragma unroll
        for (int ai = 0; ai < 2; ++ai)
#pragma unroll
            for (int m = 0; m < 4; m += 2)
#pragma unroll
                for (int bj = 0; bj < 2; ++bj) {
                    unsigned ax = pk4c(acc[ai][bj][m][0] * gv), ay = pk4c(acc[ai][bj][m][1] * gv), bx = pk4c(acc[ai][bj][m + 1][0] * gv), by = pk4c(acc[ai][bj][m + 1][1] * gv);
                    swap16u(ax, bx); swap16u(ay, by);
                    const size_t row = (size_t)(u.pm * 256 + 128 * ai + 64 * wr + 16 * (m + (fq & 1)) + fr);
                    u32x4 w; w.x = ax; w.y = ay; w.z = bx; w.w = by;
                    *(u32x4*)((unsigned char*)y + row * kD + u.pn * 256 + 128 * bj + 32 * wc + 8 * (fq & ~1)) = w;
                }
    }
};
struct EpiGlu {
    DEVI void stage(LAS unsigned char*, const Unit&, int, int) const {}
    static constexpr int VMOPS = 16;
    const bf16_t* g; bf16_t* oc;
    DEVI void operator()(const f32x4 (&acc)[2][2][4][2], const Unit& u, int wr, int wc, int fr, int fq) const {
#pragma unroll
        for (int ai = 0; ai < 2; ++ai) {
            const size_t r0 = (size_t)(u.pm * 256 + 128 * ai + 64 * wr + fr) * 256 + 32 * wc + 8 * fq;
            u32x4 gw[4][2];
#pragma unroll
            for (int m = 0; m < 4; ++m)
#pragma unroll
                for (int bj = 0; bj < 2; ++bj) gw[m][bj] = *(const u32x4*)(g + r0 + (size_t)m * 16 * 256 + 128 * bj);
#pragma unroll
            for (int m = 0; m < 4; ++m)
#pragma unroll
                for (int bj = 0; bj < 2; ++bj) { const size_t o = r0 + (size_t)m * 16 * 256 + 128 * bj; float gg[8]; unpk8s(gg, gw[m][bj]); float o8[8];
#pragma unroll
                    for (int n = 0; n < 2; ++n)
#pragma unroll
                        for (int j = 0; j < 4; ++j) o8[n * 4 + j] = gg[n * 4 + j] * frcp(1.f + __expf(-acc[ai][bj][m][n][j]));
                    u32x4 w; w.x = pk2(o8[0], o8[1]); w.y = pk2(o8[2], o8[3]); w.z = pk2(o8[4], o8[5]); w.w = pk2(o8[6], o8[7]);
                    *(u32x4*)(oc + o) = w; }
        }
    }
};

typedef float f32x16 __attribute__((ext_vector_type(16)));
typedef short s16x4 __attribute__((ext_vector_type(4)));
DEVI bf16x8 tr_pair(LAS unsigned char* p0, LAS unsigned char* p1) {
    const s16x4 a = __builtin_amdgcn_ds_read_tr16_b64_v4i16((LAS s16x4*)p0), b = __builtin_amdgcn_ds_read_tr16_b64_v4i16((LAS s16x4*)p1);
    return (bf16x8){a.x, a.y, a.z, a.w, b.x, b.y, b.z, b.w};
}
DEVI void phase_dilated(const bf16_t* qa, const bf16_t* ka, const bf16_t* va, const float* gq, const float* gk, bf16_t* oac, float* lse, LAS unsigned char* lds, int bid, int nblk) {
    const int tid = tidx(), wid = __builtin_amdgcn_readfirstlane(tid >> 6), lane = tid & 63, h5 = lane >> 5, qc = lane & 31;
    LAS unsigned char* Kimg = lds; LAS unsigned char* Vimg = lds + 49152;
    float Mn;
    { float a = fabsf(gq[lane]), b = fabsf(gk[lane]);
#pragma unroll
      for (int m = 32; m >= 1; m >>= 1) { a = fmaxf(a, __shfl_xor(a, m)); b = fmaxf(b, __shfl_xor(b, m)); }
      Mn = 8.f * a * b; }
    const float Mb = Mn * kLog2e;
    unsigned koff[4];
#pragma unroll
    for (int s = 0; s < 4; ++s) koff[s] = (unsigned)((32 * wid + qc) * 128 + (((2 * s + h5) ^ (qc & 7)) << 4));
    unsigned voff[2];
    { const int g = lane >> 4, i16 = lane & 15, q = i16 >> 2, p = i16 & 3;
#pragma unroll
      for (int dt = 0; dt < 2; ++dt) { const int c = (2 * (g & 1) + (p >> 1) + 4 * dt) ^ ((q >> 1) << 2); voff[dt] = (unsigned)((32 * wid + 4 * h5 + q) * 128 + (c << 4) + 8 * (p & 1)); } }
    const float dbase = (float)(4 * h5 - qc);
    u32x4 pK[6], pV[6];
#define DIL_DECODE(unit_) const int r_ = (unit_) >> 8, bl_ = (unit_) & 255, c = r_ % 3, bh = (bl_ & 7) * 8 + r_ / 3, ub = bl_ >> 3; \
        const int dsh = 2 * c, L = kS >> dsh, upc = 32 >> dsh, cls = ub >> (5 - dsh), u0 = (ub & (upc - 1)) << 8;
#define DIL_PREFETCH(unit_) do { DIL_DECODE(unit_) \
        const bf16_t* kbase = ka + (size_t)bh * kS * 64; const bf16_t* vbase = va + (size_t)bh * kS * 64; \
        _Pragma("unroll") for (int it = 0; it < 6; ++it) { const int id = it * kNT + tid, row = id >> 3, ch = id & 7; \
            int ki = u0 - 64 + row; ki = ki < 0 ? 0 : (ki > L - 1 ? L - 1 : ki); const size_t tok = (size_t)((ki << dsh) + cls); \
            pK[it] = *(const u32x4*)(kbase + tok * 64 + ch * 8); pV[it] = *(const u32x4*)(vbase + tok * 64 + ch * 8); } } while (0)
    if (bid < 6144) DIL_PREFETCH(bid);
    for (int unit = bid; unit < 6144; unit += nblk) {
        DIL_DECODE(unit)
        const int q0 = u0 + 32 * wid, qtok = ((q0 + qc) << dsh) + cls;
        bf16x8 Qf[4];
#pragma unroll
        for (int s = 0; s < 4; ++s) Qf[s] = *(const bf16x8*)(qa + ((size_t)bh * kS + qtok) * 64 + 16 * s + 8 * h5);
        __syncthreads();
#pragma unroll
        for (int it = 0; it < 6; ++it) { const int id = it * kNT + tid, row = id >> 3, ch = id & 7;
            *(LAS u32x4*)(Kimg + row * 128 + ((ch ^ (row & 7)) << 4)) = pK[it];
            *(LAS u32x4*)(Vimg + row * 128 + ((ch ^ (((row >> 1) & 1) << 2)) << 4)) = pV[it]; }
        __syncthreads();
        const float slope = exp2f(-(float)((bh & 7) + 1));
        const float c2 = slope * (float)(1 << dsh) * kLog2e;
        float sum = 0.f;
        f32x16 O[2];
#pragma unroll
        for (int dt = 0; dt < 2; ++dt)
#pragma unroll
            for (int i = 0; i < 16; ++i) O[dt][i] = 0.f;
        const float ndb = -dbase;
#define DIL_QK(dst, kt_) do { { const int kp0_ = q0 - 64 + 32 * (kt_); const float tm_ = (kp0_ >= 0 && kp0_ < L) ? 0.f : -1e30f; \
            const float cs_ = ((kt_) < 2) ? c2 : -c2, c0_ = (((kt_) == 0 || (kt_) == 4) ? -64.f : ((kt_) == 2 ? 0.f : -32.f)) * c2 - Mb + tm_; \
            const float bt_ = dbase * cs_ + c0_; \
            _Pragma("unroll") for (int i = 0; i < 16; i += 2) { const float k0 = (float)((i & 3) + 8 * (i >> 2)), k1 = (float)(((i + 1) & 3) + 8 * ((i + 1) >> 2)); f32x2 t; \
                if ((kt_) == 2) { const f32x2 d = {fabsf(dbase + k0), fabsf(dbase + k1)}; t = d * cs_ + c0_; } else t = (f32x2){k0, k1} * cs_ + bt_; \
                dst[i] = t.x; dst[i + 1] = t.y; } } \
            _Pragma("unroll") for (int s = 0; s < 4; ++s) { const bf16x8 Kf = *(const LAS bf16x8*)(Kimg + koff[s] + (kt_) * 4096); dst = __builtin_amdgcn_mfma_f32_32x32x16_bf16(Kf, Qf[s], dst, 0, 0, 0); } } while (0)
        f32x16 S, Sn;
        DIL_QK(S, 0);
        f32x2 sum2 = {0.f, 0.f};
#pragma unroll
        for (int kt = 0; kt < 5; ++kt) {
            if (kt < 4) DIL_QK(Sn, kt + 1);
            if (kt == 0) { if (unit + nblk < 6144) DIL_PREFETCH(unit + nblk); }
#pragma unroll
            for (int i = 0; i < 16; i += 2) {
                const float k0 = (float)((i & 3) + 8 * (i >> 2)), k1 = (float)(((i + 1) & 3) + 8 * ((i + 1) >> 2));
                f32x2 sv = (f32x2){S[i], S[i + 1]};
                if (kt == 0) { sv.x = (k0 >= ndb) ? sv.x : -1e30f; sv.y = (k1 >= ndb) ? sv.y : -1e30f; }
                if (kt == 4) { sv.x = (k0 <= ndb) ? sv.x : -1e30f; sv.y = (k1 <= ndb) ? sv.y : -1e30f; }
                f32x2 pv; pv.x = __builtin_amdgcn_exp2f(sv.x); pv.y = __builtin_amdgcn_exp2f(sv.y);
                S[i] = pv.x; S[i + 1] = pv.y; sum2 += pv;
            }
#pragma unroll
            for (int s2 = 0; s2 < 2; ++s2) {
                u32x4 pw; pw.x = pk2(S[8 * s2 + 0], S[8 * s2 + 1]); pw.y = pk2(S[8 * s2 + 2], S[8 * s2 + 3]); pw.z = pk2(S[8 * s2 + 4], S[8 * s2 + 5]); pw.w = pk2(S[8 * s2 + 6], S[8 * s2 + 7]);
                const bf16x8 Pf = __builtin_bit_cast(bf16x8, pw);
#pragma unroll
                for (int dt = 0; dt < 2; ++dt) { LAS unsigned char* vp = Vimg + voff[dt] + kt * 4096 + s2 * 2048;
                    const bf16x8 Vf = tr_pair(vp, vp + 1024);
                    O[dt] = __builtin_amdgcn_mfma_f32_32x32x16_bf16(Vf, Pf, O[dt], 0, 0, 0); }
            }
            if (kt < 4) S = Sn;
        }
#undef DIL_QK
        sum = sum2.x + sum2.y;
        sum = xsum32(sum);
        const float inv = 1.f / sum;
        const size_t tok = (size_t)(bh >> 3) * kS + qtok;
        {
        LAS unsigned char* ost = lds + 98304 + wid * 4096;
#pragma unroll
        for (int dt = 0; dt < 2; ++dt)
#pragma unroll
            for (int g4 = 0; g4 < 4; ++g4) { u32x2 w; w.x = pk2(O[dt][4 * g4] * inv, O[dt][4 * g4 + 1] * inv); w.y = pk2(O[dt][4 * g4 + 2] * inv, O[dt][4 * g4 + 3] * inv);
                *(LAS u32x2*)(ost + qc * 128 + (((4 * dt + g4) ^ (qc & 7)) << 4) + 8 * h5) = w; }
        if (h5 == 0) lse[((size_t)c * kTok + tok) * 8 + (bh & 7)] = Mn + __logf(sum);
        bf16_t* obase = oac + ((size_t)c * kTok + (size_t)(bh >> 3) * kS) * 512 + (bh & 7) * 64;
#pragma unroll
        for (int it = 0; it < 4; ++it) { const int r = it * 8 + (lane >> 3), ch = lane & 7;
            const u32x4 v = *(const LAS u32x4*)(ost + r * 128 + ((ch ^ (r & 7)) << 4));
            const size_t t2 = (size_t)(((q0 + r) << dsh) + cls);
            __builtin_nontemporal_store(v, (u32x4*)(obase + t2 * 512 + ch * 8)); }
        }
    }
#undef DIL_DECODE
#undef DIL_PREFETCH
    __syncthreads();
}
DEVI void phase_na(const bf16_t* qb, const bf16_t* kb, const bf16_t* vb, const float* rpb  , const float* gq, const float* gk, bf16_t* ob, LAS unsigned char* lds, int bid, int nblk) {
    const int tid = tidx(), wid = __builtin_amdgcn_readfirstlane(tid >> 6), lane = tid & 63, g4 = lane >> 4, i16 = lane & 15;
    LAS unsigned char* Kimg = lds; LAS unsigned char* Vimg = lds + 73728; LAS float* tab = (LAS float*)(lds + 147456);
    __syncthreads();
    for (int i = tid; i < 4 * 465; i += kNT) tab[i] = rpb[i];
    float Mq;
    { float a = fabsf(gq[lane]), b = fabsf(gk[lane]);
#pragma unroll
      for (int m = 32; m >= 1; m >>= 1) { a = fmaxf(a, __shfl_xor(a, m)); b = fmaxf(b, __shfl_xor(b, m)); }
      Mq = 8.f * a * b; }
    __syncthreads();
    if (wid < 4) { float m = 0.f; for (int i = lane; i < 465; i += 64) m = fmaxf(m, fabsf(tab[wid * 465 + i]));
#pragma unroll
        for (int k = 32; k >= 1; k >>= 1) m = fmaxf(m, __shfl_xor(m, k));
        if (lane == 0) tab[1860 + wid] = m; }
    __syncthreads();
    const int g = wid & 3, kcs = (16 * g - 8) < 0 ? 0 : ((16 * g - 8) > 32 ? 32 : (16 * g - 8));
    const int qcol = 16 * g + i16, cs = (qcol - 8) < 0 ? 0 : ((qcol - 8) > 48 ? 48 : (qcol - 8));
    unsigned kswz[2];
#pragma unroll
    for (int s = 0; s < 2; ++s) kswz[s] = (unsigned)(((4 * s + g4) ^ (i16 & 7)) << 4);
    const int q = i16 >> 2, p = i16 & 3, sw = 2 * (g4 & 1) + (q >> 1);
    unsigned vsw[4];
#pragma unroll
    for (int dt = 0; dt < 4; ++dt) vsw[dt] = (unsigned)((((2 * dt + (p >> 1)) ^ (sw << 1)) << 4) + 8 * (p & 1));
    const int scol = tid >> 3, sch = tid & 7;
    const unsigned skoff = (unsigned)(scol * 128 + ((sch ^ (scol & 7)) << 4)), svoff = (unsigned)(scol * 128 + ((sch ^ (((scol >> 1) & 3) << 1)) << 4));
    u32x4 pK[2], pV[2];
    for (int run = bid; run < 256; run += nblk) {
      const int bh = (run & 7) * 4 + ((run >> 3) & 3), h = bh & 3;
      const bf16_t* kbase = kb + (size_t)bh * kS * 64 + scol * 64 + sch * 8; const bf16_t* vbase = vb + (size_t)bh * kS * 64 + scol * 64 + sch * 8;
      const LAS float* th = tab + h * 465;
      const float Mb = (Mq + tab[1860 + h]) * kLog2e;
      const int ecol0 = kcs + 4 * g4 - cs, dcb0 = kcs + 4 * g4 - qcol + 15;
      f32x4 Bi[8][2];
#pragma unroll
      for (int u = 0; u < 8; ++u)
#pragma unroll
          for (int tt = 0; tt < 2; ++tt)
#pragma unroll
              for (int jj = 0; jj < 4; ++jj) { const int e = ecol0 + 16 * tt + jj; int dc = dcb0 + 16 * tt + jj; dc = dc < 0 ? 0 : (dc > 30 ? 30 : dc);
                  Bi[u][tt][jj] = ((unsigned)e < 16u) ? th[(u + 3) * 31 + dc] * kLog2e - Mb : -1e30f; }
#pragma unroll 1
      for (int j = 0; j < 8; ++j) {
        const int rp = (run >> 5) * 8 + j, r0 = 2 * rp;
        const int rsA = (r0 - 4) < 0 ? 0 : ((r0 - 4) > 120 ? 120 : (r0 - 4));
        const int prsA = (r0 - 6) < 0 ? 0 : ((r0 - 6) > 120 ? 120 : (r0 - 6));
        const int rr = r0 + (wid >> 2);
        const int rs = (rr - 4) < 0 ? 0 : ((rr - 4) > 120 ? 120 : (rr - 4));
        const int qtok = rr * 64 + qcol;
        bf16x8 Qf[2];
#pragma unroll
        for (int s = 0; s < 2; ++s) Qf[s] = *(const bf16x8*)(qb + ((size_t)bh * kS + qtok) * 64 + 32 * s + 8 * g4);
        __syncthreads();
        if (j == 0) {
#pragma unroll
            for (int it = 0; it < 9; ++it) { const int gr = rsA + it; if (gr < 128) { const int sl = gr % 9;
                const u32x4 kv = *(const u32x4*)(kbase + (size_t)gr * 64 * 64), vv = *(const u32x4*)(vbase + (size_t)gr * 64 * 64);
                *(LAS u32x4*)(Kimg + sl * 8192 + skoff) = kv; *(LAS u32x4*)(Vimg + sl * 8192 + svoff) = vv; } }
        } else {
#pragma unroll
            for (int it = 0; it < 2; ++it) { const int gr = prsA + 9 + it; if (gr <= rsA + 8 && gr < 128) { const int sl = gr % 9;
                *(LAS u32x4*)(Kimg + sl * 8192 + skoff) = pK[it]; *(LAS u32x4*)(Vimg + sl * 8192 + svoff) = pV[it]; } }
        }
        __syncthreads();
        if (j < 7) {
            const int nrsA = (r0 - 2) < 0 ? 0 : ((r0 - 2) > 120 ? 120 : (r0 - 2));
#pragma unroll
            for (int it = 0; it < 2; ++it) { int gr = rsA + 9 + it; gr = (gr <= nrsA + 8 && gr < 128) ? gr : 127;
                pK[it] = *(const u32x4*)(kbase + (size_t)gr * 64 * 64); pV[it] = *(const u32x4*)(vbase + (size_t)gr * 64 * 64); }
        }
        const int sb0 = rs % 9;
        const unsigned kb0 = (unsigned)((kcs + i16) * 128), vb0 = (unsigned)((kcs + 4 * g4 + q) * 128);
        float sum = 0.f;
        f32x4 O[4];
#pragma unroll
        for (int dt = 0; dt < 4; ++dt) O[dt] = (f32x4){0.f, 0.f, 0.f, 0.f};
#define NA_SO(u_) ((unsigned)((sb0 + (u_) >= 9 ? sb0 + (u_) - 9 : sb0 + (u_)) * 8192))
#define NA_QK(dst, u_, INIT) do { const unsigned so_ = NA_SO(u_); _Pragma("unroll") for (int tt = 0; tt < 2; ++tt) { \
            const bf16x8 Kf0 = *(const LAS bf16x8*)(Kimg + kb0 + so_ + tt * 2048 + kswz[0]), Kf1 = *(const LAS bf16x8*)(Kimg + kb0 + so_ + tt * 2048 + kswz[1]); \
            dst[tt] = __builtin_amdgcn_mfma_f32_16x16x32_bf16(Kf0, Qf[0], INIT(u_, tt), 0, 0, 0); dst[tt] = __builtin_amdgcn_mfma_f32_16x16x32_bf16(Kf1, Qf[1], dst[tt], 0, 0, 0); } } while (0)
#define NA_SOFTPV(S_, u_) do { const unsigned so_ = NA_SO(u_); \
            _Pragma("unroll") for (int tt = 0; tt < 2; ++tt) _Pragma("unroll") for (int jj = 0; jj < 4; ++jj) { const float pv = __builtin_amdgcn_exp2f(S_[tt][jj]); S_[tt][jj] = pv; sum += pv; } \
            u32x4 pw; pw.x = pk2(S_[0][0], S_[0][1]); pw.y = pk2(S_[0][2], S_[0][3]); pw.z = pk2(S_[1][0], S_[1][1]); pw.w = pk2(S_[1][2], S_[1][3]); \
            const bf16x8 Pf = __builtin_bit_cast(bf16x8, pw); \
            _Pragma("unroll") for (int dt = 0; dt < 4; ++dt) { LAS unsigned char* vp = Vimg + vb0 + so_ + vsw[dt]; \
                const bf16x8 Vf = tr_pair(vp, vp + 2048); \
                O[dt] = __builtin_amdgcn_mfma_f32_16x16x32_bf16(Vf, Pf, O[dt], 0, 0, 0); } } while (0)
#define NA_INIT_REG(u_, tt_) Bi[u_][tt_]
        if (rs - rr == -4) {
            f32x4 S[2], Sn[2];
            NA_QK(S, 0, NA_INIT_REG);
#pragma unroll
            for (int u = 0; u < 8; ++u) {
                if (u < 7) NA_QK(Sn, u + 1, NA_INIT_REG);
                NA_SOFTPV(S, u);
                if (u < 7) { S[0] = Sn[0]; S[1] = Sn[1]; }
            }
        } else {
            int g4v = g4; asm volatile("" : "+v"(g4v));
            const int ecol = kcs + 4 * g4v - cs, dcb = kcs + 4 * g4v - qcol + 15;
#pragma unroll
            for (int u = 0; u < 8; ++u) {
                const LAS float* tr = th + (rs + u - rr + 7) * 31;
                f32x4 In[2];
#pragma unroll
                for (int tt = 0; tt < 2; ++tt)
#pragma unroll
                    for (int jj = 0; jj < 4; ++jj) { const int e = ecol + 16 * tt + jj; int dc = dcb + 16 * tt + jj; dc = dc < 0 ? 0 : (dc > 30 ? 30 : dc);
                        In[tt][jj] = ((unsigned)e < 16u) ? tr[dc] * kLog2e - Mb : -1e30f; }
#define NA_INIT_TAB(u_, tt_) In[tt_]
                f32x4 S[2];
                NA_QK(S, u, NA_INIT_TAB);
                NA_SOFTPV(S, u);
#undef NA_INIT_TAB
            }
        }
#undef NA_INIT_REG
#undef NA_SOFTPV
#undef NA_QK
#undef NA_SO
        sum = xsum32(xsum16(sum));
        const float inv = 1.f / sum;
        bf16_t* orow = ob + ((size_t)(bh >> 2) * kS + qtok) * 256 + h * 64;
#pragma unroll
        for (int dt = 0; dt < 4; ++dt) { u32x2 w; w.x = pk2(O[dt][0] * inv, O[dt][1] * inv); w.y = pk2(O[dt][2] * inv, O[dt][3] * inv); *(u32x2*)(orow + 16 * dt + 4 * g4) = w; }
      }
    }
    __syncthreads();
}
DEVI void unpk8(float* d, const u32x4 q, const float sc) {
    d[0] += sc * __uint_as_float(q.x << 16); d[1] += sc * __uint_as_float(q.x & 0xFFFF0000u); d[2] += sc * __uint_as_float(q.y << 16); d[3] += sc * __uint_as_float(q.y & 0xFFFF0000u);
    d[4] += sc * __uint_as_float(q.z << 16); d[5] += sc * __uint_as_float(q.z & 0xFFFF0000u); d[6] += sc * __uint_as_float(q.w << 16); d[7] += sc * __uint_as_float(q.w & 0xFFFF0000u);
}
DEVI void phase_mixnorm(const bf16_t* oac, const float* lse, const bf16_t* ob, const bf16_t* oc, const float* ga, const float* gb, const float* gc, bf16_t* mix, int bid, int nblk) {
    const int wid = tidx() >> 6, lane = tidx() & 63;
    float gn[16];
    { const float* gp = (lane < 32) ? ga + lane * 16 : (lane < 48) ? gb + (lane - 32) * 16 : gc + (lane - 48) * 16;
#pragma unroll
      for (int i = 0; i < 16; ++i) gn[i] = gp[i]; }
    const int stride = nblk * 8;
    int row = bid * 8 + wid;
    if (row >= kTok) return;
    u32x4 Aq[6], Bq[6]; float Al[3], Bl[3];
    const bool dil = lane < 32;
    const int hh = dil ? (lane >> 2) : 0;
#define MX_ISSUE(R, Q, L) do { \
        const bf16_t* p0_ = dil ? oac + (size_t)(R) * 512 + lane * 16 : ((lane < 48) ? ob + (size_t)(R) * 256 + (lane - 32) * 16 : oc + (size_t)(R) * 256 + (lane - 48) * 16); \
        const size_t cst_ = dil ? (size_t)kTok * 512 : (size_t)0; \
        Q[0] = *(const u32x4*)p0_; Q[1] = *(const u32x4*)(p0_ + 8); Q[2] = *(const u32x4*)(p0_ + cst_); Q[3] = *(const u32x4*)(p0_ + cst_ + 8); Q[4] = *(const u32x4*)(p0_ + 2 * cst_); Q[5] = *(const u32x4*)(p0_ + 2 * cst_ + 8); \
        L[0] = lse[(size_t)(R) * 8 + hh]; L[1] = lse[((size_t)kTok + (R)) * 8 + hh]; L[2] = lse[((size_t)2 * kTok + (R)) * 8 + hh]; } while (0)
#define MX_BODY(C, N) do { \
        const int nrow_ = (row + stride < kTok) ? row + stride : row; \
        MX_ISSUE(nrow_, N##q, N##l); \
        float v[16]; \
        _Pragma("unroll") for (int i = 0; i < 16; ++i) v[i] = 0.f; \
        float w0 = 1.f, w1 = 0.f, w2 = 0.f; \
        if (dil) { const float mx = fmaxf(C##l[0], fmaxf(C##l[1], C##l[2])); w0 = __expf(C##l[0] - mx); w1 = __expf(C##l[1] - mx); w2 = __expf(C##l[2] - mx); const float inv = frcp(w0 + w1 + w2); w0 *= inv; w1 *= inv; w2 *= inv; } \
        unpk8(v, C##q[0], w0); unpk8(v + 8, C##q[1], w0); unpk8(v, C##q[2], w1); unpk8(v + 8, C##q[3], w1); unpk8(v, C##q[4], w2); unpk8(v + 8, C##q[5], w2); \
        float ss = 0.f; \
        _Pragma("unroll") for (int i = 0; i < 16; ++i) ss += v[i] * v[i]; \
        ss = row_sum16(ss); \
        { float a = ss, b = ss; swap16(a, b); if (lane < 32) ss = a + b; } \
        const float rstd = rsqrtf(ss * ((lane < 32) ? (1.f / 512.f) : (1.f / 256.f)) + kEps); \
        u32x4 o0, o1; \
        o0.x = pk2(v[0] * rstd * gn[0], v[1] * rstd * gn[1]); o0.y = pk2(v[2] * rstd * gn[2], v[3] * rstd * gn[3]); o0.z = pk2(v[4] * rstd * gn[4], v[5] * rstd * gn[5]); o0.w = pk2(v[6] * rstd * gn[6], v[7] * rstd * gn[7]); \
        o1.x = pk2(v[8] * rstd * gn[8], v[9] * rstd * gn[9]); o1.y = pk2(v[10] * rstd * gn[10], v[11] * rstd * gn[11]); o1.z = pk2(v[12] * rstd * gn[12], v[13] * rstd * gn[13]); o1.w = pk2(v[14] * rstd * gn[14], v[15] * rstd * gn[15]); \
        *(u32x4*)(mix + (size_t)row * kD + lane * 16) = o0; *(u32x4*)(mix + (size_t)row * kD + lane * 16 + 8) = o1; } while (0)
    MX_ISSUE(row, Aq, Al);
    for (;;) {
        MX_BODY(A, B); row += stride; if (row >= kTok) break;
        MX_BODY(B, A); row += stride; if (row >= kTok) break;
    }
#undef MX_BODY
#undef MX_ISSUE
}
DEVI void phase_combine(bf16_t* xb, bf16_t* xbo, float* out32, const bf16_t* y, const float* gate, const int* tokslot, bool last_layer, float* rstdp, int bid, int nblk) {
    const int wid = tidx() >> 6, lane = tidx() & 63;
    const int stride = nblk * 8;
    int row = bid * 8 + wid;
    if (row >= kTok) return;
    u32x4 Ax0, Ax1, Ay[4], Bx0, Bx1, By[4]; float Ag[4], Bg[4]; unsigned Am = 0u, Bm = 0u;
#define CB_ISSUE(R, TS, X0, X1, Y, G, M) do { const int b_ = (R) >> 13; \
        M = (unsigned)__builtin_amdgcn_ballot_w64(lane < 16 && (TS) >= 0); unsigned mm_ = M; \
        X0 = *(const u32x4*)(xb + (size_t)(R) * kD + lane * 16); X1 = *(const u32x4*)(xb + (size_t)(R) * kD + lane * 16 + 8); \
        _Pragma("unroll") for (int j = 0; j < 4; ++j) { const bool has_ = mm_ != 0u; const int e_ = has_ ? __builtin_ctz(mm_) : 0; const int sl_ = has_ ? __builtin_amdgcn_readlane((TS), e_) : 0; \
            const size_t r_ = has_ ? (size_t)(e_ * kB + b_) * kCap + sl_ : (size_t)0; Y[j] = *(const u32x4*)((const unsigned char*)y + r_ * kD + lane * 16); G[j] = gate[r_]; mm_ &= mm_ - 1u; } } while (0)
#define CB_ACC(YV, GS) do { const unsigned ww_[4] = {(YV).x, (YV).y, (YV).z, (YV).w}; const float gs_ = __builtin_bit_cast(float, __builtin_amdgcn_readfirstlane(__builtin_bit_cast(int, (GS))));   \
        _Pragma("unroll") for (int k = 0; k < 4; ++k) { const f32x2 lo = __builtin_amdgcn_cvt_pk_f32_fp8(ww_[k], false), hi = __builtin_amdgcn_cvt_pk_f32_fp8(ww_[k], true); \
            v[4 * k] += lo.x * gs_; v[4 * k + 1] += lo.y * gs_; v[4 * k + 2] += hi.x * gs_; v[4 * k + 3] += hi.y * gs_; } } while (0)
#define CB_BODY(C, N) do { \
        const int nrow_ = (row + stride < kTok) ? row + stride : row, nnrow_ = (row + 2 * stride < kTok) ? row + 2 * stride : row, b = row >> 13; \
        const int ts2 = tokslot[(size_t)nnrow_ * kE + (lane & 15)]; \
        CB_ISSUE(nrow_, ts1, N##x0, N##x1, N##y, N##g, N##m); \
        float v[16]; unpk8s(v, C##x0); unpk8s(v + 8, C##x1); \
        unsigned mm = C##m; \
        _Pragma("unroll") for (int j = 0; j < 4; ++j) { if (mm != 0u) CB_ACC(C##y[j], C##g[j]); mm &= mm - 1u; } \
        while (mm != 0u) { const int e = __builtin_ctz(mm), sl = __builtin_amdgcn_readlane(ts0, e); const size_t r = (size_t)(e * kB + b) * kCap + sl; \
            const u32x4 yv = *(const u32x4*)((const unsigned char*)y + r * kD + lane * 16); const float gs = gate[r]; CB_ACC(yv, gs); mm &= mm - 1u; } \
        if (last_layer) { \
            _Pragma("unroll") for (int k = 0; k < 4; ++k) *(f32x4*)(out32 + (size_t)row * kD + lane * 16 + 4 * k) = (f32x4){v[4 * k], v[4 * k + 1], v[4 * k + 2], v[4 * k + 3]}; \
        } else { u32x4 o0, o1; \
            o0.x = pk2(v[0], v[1]); o0.y = pk2(v[2], v[3]); o0.z = pk2(v[4], v[5]); o0.w = pk2(v[6], v[7]); o1.x = pk2(v[8], v[9]); o1.y = pk2(v[10], v[11]); o1.z = pk2(v[12], v[13]); o1.w = pk2(v[14], v[15]); \
            *(u32x4*)(xbo + (size_t)row * kD + lane * 16) = o0; *(u32x4*)(xbo + (size_t)row * kD + lane * 16 + 8) = o1; \
            unpk8s(v, o0); unpk8s(v + 8, o1);                     \
            float ss = 0.f; \
            _Pragma("unroll") for (int i = 0; i < 16; ++i) ss += v[i] * v[i]; \
            ss = wave_sum(ss); \
            if (lane == 0) rstdp[row] = rsqrtf(ss * (1.f / kD) + kEps);     \
        } \
        ts0 = ts1; ts1 = ts2; } while (0)
    int ts0 = tokslot[(size_t)row * kE + (lane & 15)];
    int ts1 = tokslot[(size_t)((row + stride < kTok) ? row + stride : row) * kE + (lane & 15)];
    CB_ISSUE(row, ts0, Ax0, Ax1, Ay, Ag, Am);
    for (;;) {
        CB_BODY(A, B); row += stride; if (row >= kTok) break;
        CB_BODY(B, A); row += stride; if (row >= kTok) break;
    }
#undef CB_BODY
#undef CB_ISSUE
#undef CB_ACC
}

DEVI void cpow_m(double a, double w, double dt, int m, float& re, float& im) {
    const float mag = __expf((float)m * (float)a * (float)dt);
    const double turns = (double)m * w * dt * 0.15915494309189535; const float ang = (float)((turns - floor(turns)) * 6.283185307179586);
    re = mag * cosf(ang); im = mag * sinf(ang);
}
DEVI void s5_prep_item(const Params& P, int l, int g, unsigned char* lds_) {
    float* pw = (float*)lds_;
    float* bb = pw + 4352;
    float* cc = bb + 4096;
    float* kt = cc + 4096;
    const int tid = tidx();
    __syncthreads();
    for (int i = tid; i < 128; i += kNT) { const int dir = i >> 6, p = i & 63; const size_t pb = (((size_t)l * 2 + dir) * 16 + g) * 64 + p;
        const double dt = (double)__expf(P.s5_log_dt[((size_t)l * 2 + dir) * 16 + g]); const double a = (double)fminf(P.s5_a_re[pb], -1e-4f), w = (double)P.s5_a_im[pb];
        for (int m = 0; m < 17; ++m) { float re, im; cpow_m(a, w, dt, m, re, im); pw[((dir * 64 + p) * 17 + m) * 2] = re; pw[((dir * 64 + p) * 17 + m) * 2 + 1] = im; }
        const float af = (float)a, wf = (float)w, ar = pw[((dir * 64 + p) * 17 + 1) * 2], ai = pw[((dir * 64 + p) * 17 + 1) * 2 + 1];
        const float den = af * af + wf * wf, zr = ar - 1.f, gr = (zr * af + ai * wf) / den, gi = (ai * af - zr * wf) / den;
        for (int c = 0; c < 16; ++c) { const float br = P.s5_b_re[pb * 16 + c], bi = P.s5_b_im[pb * 16 + c]; bb[((dir * 64 + p) * 16 + c) * 2] = gr * br - gi * bi; bb[((dir * 64 + p) * 16 + c) * 2 + 1] = gr * bi + gi * br; }
    }
    for (int i = tid; i < 2048; i += kNT) { const int dir = i >> 10, c = (i >> 6) & 15, p = i & 63; const size_t o = ((((size_t)l * 2 + dir) * 16 + g) * 16 + c) * 64 + p; cc[i * 2] = P.s5_c_re[o]; cc[i * 2 + 1] = P.s5_c_im[o]; }
    __syncthreads();
    for (int i = tid; i < 8192; i += kNT) { const int dir = i >> 12, m = (i >> 8) & 15, c = (i >> 4) & 15, c2 = i & 15; float acc = 0.f;
        for (int p = 0; p < 64; ++p) { const float cr = cc[((dir * 16 + c) * 64 + p) * 2], ci = cc[((dir * 16 + c) * 64 + p) * 2 + 1], wr_ = pw[((dir * 64 + p) * 17 + m) * 2], wi_ = pw[((dir * 64 + p) * 17 + m) * 2 + 1];
            const float br = bb[((dir * 64 + p) * 16 + c2) * 2], bi = bb[((dir * 64 + p) * 16 + c2) * 2 + 1]; const float tr = cr * wr_ - ci * wi_, ti = cr * wi_ + ci * wr_; acc += tr * br - ti * bi; }
        kt[i] = acc; }
    __syncthreads();
    bf16_t* wst = (bf16_t*)(wsp(P) + WS_WST) + ((size_t)l * 16 + g) * 256 * 256;
    bf16_t* wso = (bf16_t*)(wsp(P) + WS_WSO) + ((size_t)l * 16 + g) * 256 * 512;
    for (int id = tid; id < 8192; id += kNT) { const int n = id >> 5, k0 = (id & 31) * 8, dir = n >> 7, p = (n >> 1) & 63, ri = n & 1; float v[8];
#pragma unroll
        for (int kk = 0; kk < 8; ++kk) { const int k = k0 + kk, t = k >> 4, c = k & 15, e = dir ? t : 15 - t; const float wr_ = pw[((dir * 64 + p) * 17 + e) * 2], wi_ = pw[((dir * 64 + p) * 17 + e) * 2 + 1], br = bb[((dir * 64 + p) * 16 + c) * 2], bi = bb[((dir * 64 + p) * 16 + c) * 2 + 1];
            v[kk] = ri ? (wr_ * bi + wi_ * br) : (wr_ * br - wi_ * bi); }
        u32x4 o; o.x = pk2(v[0], v[1]); o.y = pk2(v[2], v[3]); o.z = pk2(v[4], v[5]); o.w = pk2(v[6], v[7]); *(u32x4*)(wst + (size_t)n * 256 + k0) = o; }
    for (int id = tid; id < 16384; id += kNT) { const int ns = id >> 6, k0 = (id & 63) * 8, n = cmap_pk(ns), t = n >> 4, c = n & 15; float v[8];
#pragma unroll
        for (int kk = 0; kk < 8; ++kk) { const int k = k0 + kk; float x;
            if (k < 256) { const int j = k >> 4, c2 = k & 15; x = 0.f; if (j <= t) x += kt[(t - j) * 256 + c * 16 + c2]; if (j >= t) x += kt[4096 + (j - t) * 256 + c * 16 + c2]; if (j == t && c == c2) x += P.s5_d[l * 256 + g * 16 + c]; }
            else { const int q = k - 256, dir = q >> 7, p = (q >> 1) & 63, ri = q & 1, e = dir ? 16 - t : t + 1; const float cr = cc[((dir * 16 + c) * 64 + p) * 2], ci = cc[((dir * 16 + c) * 64 + p) * 2 + 1], wr_ = pw[((dir * 64 + p) * 17 + e) * 2], wi_ = pw[((dir * 64 + p) * 17 + e) * 2 + 1];
                x = ri ? -(cr * wi_ + ci * wr_) : (cr * wr_ - ci * wi_); }
            v[kk] = x; }
        u32x4 o; o.x = pk2(v[0], v[1]); o.y = pk2(v[2], v[3]); o.z = pk2(v[4], v[5]); o.w = pk2(v[6], v[7]); *(u32x4*)(wso + (size_t)ns * 512 + k0) = o; }
    __syncthreads();
}
DEVI void phase_s5_scan(const Params& P, int l, const float* Z, bf16_t* ux, unsigned char* lds_, int bid, int nblk) {
    const int tid = tidx(), wid = tid >> 6, lane = tid & 63;
    float* E = (float*)lds_;
    for (int item = bid; item < 256; item += nblk) {
        const int dir = item & 1, g = (item >> 1) & 15, b = item >> 5;
        const size_t pb = (((size_t)l * 2 + dir) * 16 + g) * 64 + lane;
        const double dt = (double)__expf(P.s5_log_dt[((size_t)l * 2 + dir) * 16 + g]); const double a = (double)fminf(P.s5_a_re[pb], -1e-4f), w = (double)P.s5_a_im[pb];
        float a16r, a16i, Ar, Ai; cpow_m(a, w, dt, 16, a16r, a16i); cpow_m(a, w, dt, 1024, Ar, Ai);
        const int kk0 = dir ? 511 - 64 * wid : 64 * wid; const long sstep = dir ? -1 : 1;
        const float* zp = Z + ((size_t)g * 4096 + b * 512 + kk0) * 256 + dir * 128 + 2 * lane;
        f32x2 z[64];
#pragma unroll
        for (int i = 0; i < 64; ++i) { z[i] = *(const f32x2*)zp; zp += sstep * 256; }
        float xr = 0.f, xi = 0.f;
#pragma unroll
        for (int i = 0; i < 64; ++i) { const float nr = a16r * xr - a16i * xi + z[i].x, ni = a16r * xi + a16i * xr + z[i].y; xr = nr; xi = ni; }
        __syncthreads();
        E[(wid * 64 + lane) * 2] = xr; E[(wid * 64 + lane) * 2 + 1] = xi;
        __syncthreads();
        float sr = 0.f, si = 0.f;
#pragma unroll
        for (int s2 = 0; s2 < 7; ++s2) if (s2 < wid) { const float er = E[(s2 * 64 + lane) * 2], ei = E[(s2 * 64 + lane) * 2 + 1]; const float nr = Ar * sr - Ai * si + er, ni = Ar * si + Ai * sr + ei; sr = nr; si = ni; }
        bf16_t* up = ux + ((size_t)g * 4096 + b * 512 + kk0) * 512 + 256 + dir * 128 + 2 * lane;
#pragma unroll
        for (int i = 0; i < 64; ++i) { *(unsigned*)up = pk2(sr, si); up += sstep * 512;
            const float nr = a16r * sr - a16i * si + z[i].x, ni = a16r * si + a16i * sr + z[i].y; sr = nr; si = ni; }
    }
    __syncthreads();
}
struct EpiF32N {
    DEVI void stage(LAS unsigned char*, const Unit&, int, int) const {}
    static constexpr int VMOPS = 32;
    float* z; int ldz;
    DEVI void operator()(const f32x4 (&acc)[2][2][4][2], const Unit& u, int wr, int wc, int fr, int fq) const {
#pragma unroll
        for (int ai = 0; ai < 2; ++ai)
#pragma unroll
            for (int m = 0; m < 4; ++m) { const size_t ro = (size_t)(u.pm * 256 + 128 * ai + 64 * wr + 16 * m + fr) * ldz + u.pn * 256 + 32 * wc + 4 * fq;
#pragma unroll
                for (int bj = 0; bj < 2; ++bj)
#pragma unroll
                    for (int n = 0; n < 2; ++n) *(f32x4*)(z + ro + 128 * bj + 16 * n) = acc[ai][bj][m][n]; }
    }
};
struct EpiS5Out {
    DEVI void stage(LAS unsigned char*, const Unit&, int, int) const {}
    static constexpr int VMOPS = 16;
    bf16_t* G;
    DEVI void operator()(const f32x4 (&acc)[2][2][4][2], const Unit& u, int wr, int wc, int fr, int fq) const {
#pragma unroll
        for (int ai = 0; ai < 2; ++ai)
#pragma unroll
            for (int m = 0; m < 4; ++m) { const int R = u.pm * 256 + 128 * ai + 64 * wr + 16 * m + fr, g = R >> 12, ck = R & 4095;
#pragma unroll
                for (int bj = 0; bj < 2; ++bj) { const int t = 8 * bj + 2 * wc + (fq >> 1), c0 = 8 * (fq & 1);
                    const f32x4 v0 = acc[ai][bj][m][0], v1 = acc[ai][bj][m][1];
                    u32x4 w; w.x = pk2(gelu_tanh(v0.x), gelu_tanh(v0.y)); w.y = pk2(gelu_tanh(v0.z), gelu_tanh(v0.w)); w.z = pk2(gelu_tanh(v1.x), gelu_tanh(v1.y)); w.w = pk2(gelu_tanh(v1.z), gelu_tanh(v1.w));
                    *(u32x4*)(G + ((size_t)ck * 16 + t) * 256 + g * 16 + c0) = w; } }
    }
};
#define XB_TMO      128
#define XB_XCNT(j)  (256  + 64 * (j))
#define XB_XSUB(j)  (1280 + 64 * (j))
#define XB_XGEN(j)  (2304 + 64 * (j))
#define XB_TOP      3328
#define XB_TOPGEN   3392
#define XCD_BAR_WORDS 3456
#define XB_SPIN_CAP (1u << 26)
DEVI unsigned xb_ld(unsigned* p)              { return __hip_atomic_load(p, __ATOMIC_RELAXED, __HIP_MEMORY_SCOPE_AGENT); }
DEVI unsigned xb_add(unsigned* p, unsigned v) { return __hip_atomic_fetch_add(p, v, __ATOMIC_RELAXED, __HIP_MEMORY_SCOPE_AGENT); }
DEVI unsigned xb_xcc_id() { return (unsigned)__builtin_amdgcn_s_getreg((3 << 11) | 20) & 0xFu; }
#define XB_SPIN(cond, bar) do { unsigned _sp = 0; while (cond) { __builtin_amdgcn_s_sleep(1); \
    if ((++_sp & 255u) == 0u) { if (xb_ld(&(bar)[XB_TMO])) break; if (_sp > XB_SPIN_CAP) { atomicAdd(&(bar)[XB_TMO], 1u); break; } } } } while (0)
struct XcdBarrier { unsigned* bar; unsigned x; volatile LAS unsigned* st; };
DEVI XcdBarrier xcd_barrier_post(unsigned* bar, volatile LAS unsigned* st) {
    XcdBarrier b; b.bar = bar; b.x = xb_xcc_id(); b.st = st;
    if (threadIdx.x == 0) (void)xb_add(&bar[XB_XCNT(b.x)], 1u);
    return b;
}
DEVI void xcd_barrier_complete(unsigned* bar, unsigned x, unsigned& nloc, unsigned& nx) {
    const unsigned G = gridDim.x * gridDim.y * gridDim.z;
    unsigned sum, cnt, mine, sp = 0u;
    for (;;) {
        sum = 0u; cnt = 0u; mine = 0u;
#pragma unroll
        for (unsigned j = 0; j < 16; ++j) { const unsigned c = xb_ld(&bar[XB_XCNT(j)]); sum += c; cnt += (c > 0u) ? 1u : 0u; mine = (j == x) ? c : mine; }
        if (sum == G) break;
        __builtin_amdgcn_s_sleep(1);
        if ((++sp & 255u) == 0u) { if (xb_ld(&bar[XB_TMO])) break; if (sp > XB_SPIN_CAP) { atomicAdd(&bar[XB_TMO], 1u); break; } }
    }
    nloc = mine > 0u ? mine : 1u; nx = cnt > 0u ? cnt : 1u;
}
DEVI void xcd_barrier(const XcdBarrier& b) {
    asm volatile("s_waitcnt vmcnt(0)" ::: "memory");
    __syncthreads();
    if (threadIdx.x == 0) {
        unsigned long long bp_ = (unsigned long long)b.bar; asm volatile("" : "+s"(bp_));
        unsigned* bar = (unsigned*)bp_;
        const unsigned bx = xb_xcc_id();
        __builtin_amdgcn_s_waitcnt(0);
        unsigned nloc = b.st[0], nx = b.st[1];
        if (nloc == 0u) { xcd_barrier_complete(bar, bx, nloc, nx); b.st[0] = nloc; b.st[1] = nx; }
        const unsigned old = xb_add(&bar[XB_XSUB(bx)], 1u);
        const unsigned gen = old / nloc;
        if (old + 1u == (gen + 1u) * nloc) {
            __builtin_amdgcn_fence(__ATOMIC_RELEASE, "agent");
            asm volatile("s_waitcnt vmcnt(0)" ::: "memory");
            const unsigned og = xb_add(&bar[XB_TOP], 1u);
            const unsigned tg = og / nx;
            if (og + 1u == (tg + 1u) * nx) xb_add(&bar[XB_TOPGEN], 1u);
            else XB_SPIN(xb_ld(&bar[XB_TOPGEN]) == tg, bar);
            __builtin_amdgcn_fence(__ATOMIC_ACQUIRE, "agent");
            xb_add(&bar[XB_XGEN(bx)], 1u);
            asm volatile("s_waitcnt vmcnt(0)" ::: "memory");
        } else {
            XB_SPIN(xb_ld(&bar[XB_XGEN(bx)]) == gen, bar);
            __builtin_amdgcn_fence(__ATOMIC_ACQUIRE, "agent");
            asm volatile("s_waitcnt vmcnt(0)" ::: "memory");
        }
    }
    __syncthreads();
}

constexpr int LDS_BYTES = 147456 + 8192 + 16;
#define GEMM_RUN(g, E) gemm_engine<decltype(E), true, true>((LAS unsigned char*)dyn_lds, g, E, bid, nblk)
#define GEMM_RUN8(g, E) gemm_engine<decltype(E), true, true, true>((LAS unsigned char*)dyn_lds, g, E, bid, nblk)
#define GEMM_RUN8G(g, E) gemm_engine<decltype(E), true, true, true, true>((LAS unsigned char*)dyn_lds, g, E, bid, nblk)
extern __shared__ __attribute__((aligned(16))) unsigned char dyn_lds[];

DEVI GemmD mk_gemm(const bf16_t* A, const bf16_t* Bt, int lda, int K, int nM, int nN, const int* rowidx, size_t bstride, int pmg) {
    GemmD g; g.A = A; g.Bt = Bt; g.lda = lda; g.K = K; g.nM = nM; g.nN = nN; g.rowidx = rowidx; g.bstride = bstride; g.pmg = pmg; return g; }

DEVI void ph_win(const Params& P, int l, int bid, int nblk) {
    const GemmD g = mk_gemm((const bf16_t*)(wsp(P) + WS_XB), (const bf16_t*)(wsp(P) + WS_WINT) + (size_t)l * kINW * kD, kD, kD, kTok / 256, 10, nullptr, 0, 1 << 30);
    unsigned char* r1 = wsp(P) + WS_R1;
    EpiQKV E; E.qa = (bf16_t*)(r1 + R1_QA); E.ka = (bf16_t*)(r1 + R1_KA); E.va = (bf16_t*)(r1 + R1_VA); E.qb = (bf16_t*)(r1 + R1_QB); E.kb = (bf16_t*)(r1 + R1_KB); E.vb = (bf16_t*)(r1 + R1_VB); E.ux = (bf16_t*)(r1 + R1_UX);
    E.rstdp = (const float*)(wsp(P) + WS_RSTD); E.rtab = (const LAS float*)((LAS unsigned char*)dyn_lds + 131072 + 2048);
    { LAS float* tab = (LAS float*)((LAS unsigned char*)dyn_lds + 131072);
      const int t = tidx();
      if (t < 320) { const int r = t >> 6, c = t & 63; tab[t] = (r == 0) ? P.q_norm_a[l * 64 + c] * (0.125f * kLog2e)   : (r == 1) ? P.k_norm_a[l * 64 + c] : (r == 2) ? P.q_norm_b[l * 64 + c] * (0.125f * kLog2e)   : (r == 3) ? P.k_norm_b[l * 64 + c] : 1.f; }
      __syncthreads();
      E.gtab = tab; }
    GEMM_RUN(g, E);
}
DEVI void ph_dilated(const Params& P, int l, int bid, int nblk) { unsigned char* r1 = wsp(P) + WS_R1;
    phase_dilated((const bf16_t*)(r1 + R1_QA), (const bf16_t*)(r1 + R1_KA), (const bf16_t*)(r1 + R1_VA), P.q_norm_a + l * 64, P.k_norm_a + l * 64, (bf16_t*)(wsp(P) + WS_R2), (float*)(wsp(P) + WS_LSE), (LAS unsigned char*)dyn_lds, bid, nblk);
}
DEVI void ph_na(const Params& P, int l, int bid, int nblk) { unsigned char* r1 = wsp(P) + WS_R1;
    phase_na((const bf16_t*)(r1 + R1_QB), (const bf16_t*)(r1 + R1_KB), (const bf16_t*)(r1 + R1_VB), P.rpb + (size_t)l * 4 * 15 * 31, P.q_norm_b + l * 64, P.k_norm_b + l * 64, (bf16_t*)(r1 + R1_OB), (LAS unsigned char*)dyn_lds, bid, nblk);
}
DEVI void ph_s5_prep(const Params& P, unsigned char* lds, int bid, int nblk) { for (int it = bid; it < kL * 16; it += nblk) s5_prep_item(P, it >> 4, it & 15, lds); }
DEVI void ph_s5_state(const Params& P, int l, int bid, int nblk) {
    const GemmD g = mk_gemm((const bf16_t*)(wsp(P) + WS_R1 + R1_UX), (const bf16_t*)(wsp(P) + WS_WST) + (size_t)l * 16 * 256 * 256, 512, 256, 256, 1, nullptr, (size_t)256 * 256, 16);
    EpiF32N E; E.z = (float*)(wsp(P) + WS_R2 + R2_Z); E.ldz = 256;
    GEMM_RUN(g, E);
}
DEVI void ph_s5_scan(const Params& P, int l, unsigned char* lds, int bid, int nblk) { phase_s5_scan(P, l, (const float*)(wsp(P) + WS_R2 + R2_Z), (bf16_t*)(wsp(P) + WS_R1 + R1_UX), lds, bid, nblk); }
DEVI void ph_s5_out(const Params& P, int l, int bid, int nblk) {
    const GemmD g = mk_gemm((const bf16_t*)(wsp(P) + WS_R1 + R1_UX), (const bf16_t*)(wsp(P) + WS_WSO) + (size_t)l * 16 * 256 * 512, 512, 512, 256, 1, nullptr, (size_t)256 * 512, 16);
    EpiS5Out E; E.G = (bf16_t*)(wsp(P) + WS_R1 + R1_G);
    GEMM_RUN(g, E);
}
DEVI void ph_glu(const Params& P, int l, int bid, int nblk) {
    const GemmD g = mk_gemm((const bf16_t*)(wsp(P) + WS_R1 + R1_G), (const bf16_t*)(wsp(P) + WS_WGLUT) + (size_t)l * 256 * 256, 256, 256, kTok / 256, 1, nullptr, 0, 1 << 30);
    EpiGlu E; E.g = (const bf16_t*)(wsp(P) + WS_R1 + R1_G); E.oc = (bf16_t*)(wsp(P) + WS_R1 + R1_OC);
    GEMM_RUN(g, E);
}
DEVI void ph_mixnorm(const Params& P, int l, int bid, int nblk) { unsigned char* r1 = wsp(P) + WS_R1;
    phase_mixnorm((const bf16_t*)(wsp(P) + WS_R2), (const float*)(wsp(P) + WS_LSE), (const bf16_t*)(r1 + R1_OB), (const bf16_t*)(r1 + R1_OC), P.out_norm_a + l * 512, P.out_norm_b + l * 256, P.out_norm_c + l * 256, (bf16_t*)(wsp(P) + WS_H), bid, nblk); }
DEVI void ph_wout(const Params& P, int l, int bid, int nblk) {
    const GemmD g = mk_gemm((const bf16_t*)(wsp(P) + WS_H), (const bf16_t*)(wsp(P) + WS_WOUTT) + (size_t)l * kD * kD, kD, kD, kTok / 256, 4, nullptr, 0, 1 << 30);
    EpiResid E; E.xb = (bf16_t*)(wsp(P) + WS_XB); E.xbo = E.xb;
    GEMM_RUN(g, E);
}
DEVI void ph_router(const Params& P, int l, unsigned char* lds, int bid, int nblk) { phase_router((const bf16_t*)(wsp(P) + WS_XB), P.ffn_norm + (size_t)l * kD, wsp(P) + WS_RTAB + (size_t)l * 65536, wsp(P) + WS_H, (float*)(wsp(P) + WS_AFF), (LAS unsigned char*)dyn_lds, bid, nblk); }
DEVI void ph_topk(const Params& P, unsigned char* lds, int bid, int nblk) { phase_topk((const float*)(wsp(P) + WS_AFF), (int*)(wsp(P) + WS_IDX), (float*)(wsp(P) + WS_GATE), (int*)(wsp(P) + WS_TSLOT), wsp(P) + WS_H, nullptr  , kD, lds, bid, nblk); }
DEVI void ph_gu(const Params& P, int l, int bid, int nblk) {
    const GemmD g = mk_gemm((const bf16_t*)(wsp(P) + WS_H), (const bf16_t*)(wsp(P) + WS_WGUT + (size_t)l * kE * 4096 * kD), kD, kD, 512, 16, (const int*)(wsp(P) + WS_IDX), (size_t)4096 * kD, 32);
    EpiGU E; E.hid = (bf16_t*)(wsp(P) + WS_R1); E.sc = 1.f / kW8;
    GEMM_RUN8G(g, E);
}
DEVI void ph_down(const Params& P, int l, int bid, int nblk) {
    const GemmD g = mk_gemm((const bf16_t*)(wsp(P) + WS_R1), (const bf16_t*)(wsp(P) + WS_WDT + (size_t)l * kE * kD * kFF), kFF, kFF, 512, 4, nullptr, (size_t)kD * kFF, 32);
    EpiDown E; E.y = (bf16_t*)(wsp(P) + WS_R2); E.sc = 1.f / (kW8 * kH8);
    GEMM_RUN8(g, E);
}
DEVI void ph_combine(const Params& P, int l, int bid, int nblk) { phase_combine((bf16_t*)(wsp(P) + WS_XB), (bf16_t*)(wsp(P) + WS_XB), P.out, (const bf16_t*)(wsp(P) + WS_R2), (const float*)(wsp(P) + WS_GATE), (const int*)(wsp(P) + WS_TSLOT), l + 1 == kL, (float*)(wsp(P) + WS_RSTD), bid, nblk); }

__global__ void __launch_bounds__(kNT, 2) mega_fwd(Params P) {
    asm volatile("s_setreg_imm32_b32 hwreg(HW_REG_MODE, 23, 1), 1");

    volatile LAS unsigned* st = (volatile LAS unsigned*)(dyn_lds + LDS_BYTES - 16);
    if (threadIdx.x == 0) { st[0] = 0u; st[1] = 0u; st[2] = 0u; st[3] = 0u; }
    __syncthreads();
    const XcdBarrier bar = xcd_barrier_post((unsigned*)(P.ws + WS_CTL), st);
    const int bid = blockIdx.x, nblk = gridDim.x;
    unsigned char* lds = dyn_lds;
    phase_convert(P, lds, lnd(bid), nblk);
    ph_s5_prep(P, lds, lnd(bid), nblk);
    router_prep(P, lnd(bid), nblk);
    phase_norm(P.x, (bf16_t*)(wsp(P) + WS_XB), (float*)(wsp(P) + WS_RSTD), lnd(bid), nblk);
    xcd_barrier(bar);
#pragma unroll 1
    for (int l = 0; l < kL; ++l) {
        ph_win(P, l, lnd(bid), nblk);             xcd_barrier(bar);
        ph_s5_state(P, l, lnd(bid), nblk);        xcd_barrier(bar);
        ph_s5_scan(P, l, lds, lnd(bid), nblk);
        ph_dilated(P, l, lnd(bid), nblk);
        ph_na(P, l, lnd(bid), nblk);              xcd_barrier(bar);
        ph_s5_out(P, l, lnd(bid), nblk);          xcd_barrier(bar);
        ph_glu(P, l, lnd(bid), nblk);             xcd_barrier(bar);
        ph_mixnorm(P, l, lnd(bid), nblk);         xcd_barrier(bar);
        ph_wout(P, l, lnd(bid), nblk);            xcd_barrier(bar);
        ph_router(P, l, lds, lnd(bid), nblk);     xcd_barrier(bar);
        ph_topk(P, lds, lnd(bid), nblk);          xcd_barrier(bar);
        ph_gu(P, l, lnd(bid), nblk);              xcd_barrier(bar);
        ph_down(P, l, lnd(bid), nblk);            xcd_barrier(bar);
        ph_combine(P, l, lnd(bid), nblk);         xcd_barrier(bar);
    }
}

extern "C" void kernel_launch(void* const* d_in, const int* in_sizes, int n_in, void* d_out, int out_size, void* d_ws, size_t ws_size, hipStream_t stream) {
    (void)in_sizes; (void)n_in; (void)out_size;
    if (ws_size < WS_END) { fprintf(stderr, "workspace too small: %zu < %zu\n", ws_size, (size_t)WS_END); return; }
    Params P{};
    const float** pp = (const float**)&P;
    for (int i = 0; i < 26; ++i) pp[i] = (const float*)d_in[i];
    P.out = (float*)d_out; P.ws = (unsigned char*)d_ws;
    static int grid = 0;
    if (!grid) {
        int dev = 0, cus = 0, per_cu = 0;
        (void)hipGetDevice(&dev);
        (void)hipDeviceGetAttribute(&cus, hipDeviceAttributeMultiprocessorCount, dev);
        (void)hipFuncSetAttribute((const void*)mega_fwd, hipFuncAttributeMaxDynamicSharedMemorySize, LDS_BYTES);
        (void)hipOccupancyMaxActiveBlocksPerMultiprocessor(&per_cu, (const void*)mega_fwd, kNT, LDS_BYTES);
        grid = (per_cu >= 1) ? cus : 0;
        if (!grid) fprintf(stderr, "mega_fwd does not fit a CU\n");
    }
    if (!grid) return;
    (void)hipMemsetAsync(P.ws + WS_CTL, 0, XCD_BAR_WORDS * sizeof(unsigned), stream);
    mega_fwd<<<grid, kNT, LDS_BYTES, stream>>>(P);
}
```
